# Optimizing an MI355X kernel written in HIP

```python
import jax, jax.numpy as jnp
from jax import lax
import numpy as np

D_MODEL = 1024
BATCH = 8
SEQ = 4096
DEPTH = 1
DEC_BATCH = 32
DEC_SEQ = 16
PAST_LEN = 1024

CHUNK = 64

D_CONV = 512
CONV_W = 3

RWKV_HEADS = 8
HEAD_DIM = 64
D_RWKV = RWKV_HEADS * HEAD_DIM
LORA_DECAY = 64
LORA_AAA = 64
LORA_GATE = 128
GN_EPS = 64e-5

OFF_RKV = 3 * D_CONV
OFF_GATE = OFF_RKV + 3 * D_RWKV
D_IN = OFF_GATE + 2 * D_MODEL

PEER_HEADS = 8
PEER_KEYS = 128
N_EXPERTS = PEER_KEYS * PEER_KEYS
PEER_QDIM = 256
PEER_HALF = PEER_QDIM // 2
PEER_TOPK = 16
PEER_BLOCK = 128

RMS_EPS = 1e-6

kernel_name = "hybrid_conv_rwkv7_peer_stream_step"


def rms_norm(x, g):
    xf = x.astype(jnp.float32)
    y = xf * lax.rsqrt(jnp.mean(xf * xf, axis=-1, keepdims=True) + RMS_EPS)
    return (y * g.astype(jnp.float32)).astype(x.dtype)


def wkv7_scan(s0, r, w, k, v, a, b):
    def step(S, inp):
        rt, wt, kt, vt, at, bt = inp
        sa = jnp.einsum('bhvk,bhk->bhv', S, at)
        S = S * wt[:, :, None, :] + sa[..., None] * bt[:, :, None, :] + vt[..., None] * kt[:, :, None, :]
        return S, jnp.einsum('bhvk,bhk->bhv', S, rt)
    seq = tuple(jnp.swapaxes(t, 0, 1) for t in (r, w, k, v, a, b))
    s_fin, y = lax.scan(step, s0, seq)
    return jnp.swapaxes(y, 0, 1), s_fin


def hybrid_mixer(xn, conv_state, shift_state, wkv_state, w_in, conv_w, mu_rkv, mu_wag,
                 w0, w1, w2, a0, a1, a2, g1, g2, k_k, k_a, r_k, gn_w, gn_b, w_pa, w_pb, w_o):
    bsz, T, _ = xn.shape
    dt = xn.dtype
    z = xn @ w_in
    zb = z[..., 0:D_CONV]
    zc = z[..., D_CONV:2 * D_CONV]
    zh = z[..., 2 * D_CONV:3 * D_CONV]
    zrkv = z[..., OFF_RKV:OFF_GATE]
    zga = z[..., OFF_GATE:OFF_GATE + D_MODEL]
    zgb = z[..., OFF_GATE + D_MODEL:]

    u = zc * zh
    u_full = jnp.concatenate([conv_state.astype(dt), u], axis=1)
    conv = sum(conv_w[j] * u_full[:, j:j + T] for j in range(CONV_W))
    y_a = zb * conv
    new_conv = u_full[:, T:]

    prev_row = shift_state.astype(dt)
    xprev = jnp.concatenate([prev_row[:, None], xn[:, :-1]], axis=1)
    zrkv_prev = jnp.concatenate([(prev_row @ w_in[:, OFF_RKV:OFF_GATE])[:, None], zrkv[:, :-1]], axis=1)
    zs = zrkv + mu_rkv * (zrkv_prev - zrkv)
    dx = xprev - xn
    xw = xn + dx * mu_wag[0]
    xa = xn + dx * mu_wag[1]
    xg = xn + dx * mu_wag[2]
    w_raw = -jax.nn.softplus(-(w0 + jnp.tanh(xw @ w1) @ w2)) - 0.5
    decay = jnp.exp(-jnp.exp(w_raw.astype(jnp.float32)))
    a = jax.nn.sigmoid((a0 + (xa @ a1) @ a2).astype(jnp.float32))
    g = jax.nn.sigmoid(xg @ g1) @ g2

    hs = (bsz, T, RWKV_HEADS, HEAD_DIM)
    r = zs[..., 0:D_RWKV].astype(jnp.float32).reshape(hs)
    k = zs[..., D_RWKV:2 * D_RWKV].astype(jnp.float32)
    v = zs[..., 2 * D_RWKV:].astype(jnp.float32).reshape(hs)
    kk = (k * k_k.astype(jnp.float32)).reshape(hs)
    kk = kk / jnp.maximum(jnp.sqrt(jnp.sum(kk * kk, axis=-1, keepdims=True)), 1e-12)
    k = (k * (1.0 + (a - 1.0) * k_a.astype(jnp.float32))).reshape(hs)
    a = a.reshape(hs)
    w = decay.reshape(hs)
    y, s_fin = wkv7_scan(wkv_state.astype(jnp.float32), r, w, k, v, -kk, kk * a)
    mean = jnp.mean(y, axis=-1, keepdims=True)
    var = jnp.mean(jnp.square(y - mean), axis=-1, keepdims=True)
    y = ((y - mean) * lax.rsqrt(var + GN_EPS)).reshape(bsz, T, D_RWKV)
    y = y * gn_w.astype(jnp.float32) + gn_b.astype(jnp.float32)
    bonus = jnp.sum(r * k * r_k.astype(jnp.float32), axis=-1, keepdims=True) * v
    y = y + bonus.reshape(bsz, T, D_RWKV)
    y_b = y.astype(dt) * g

    merged = jax.nn.sigmoid(zga) * (y_a @ w_pa) + jax.nn.sigmoid(zgb) * (y_b @ w_pb)
    out = merged @ w_o
    return out, new_conv, xn[:, -1], s_fin.astype(wkv_state.dtype)


def peer_ffn(x, wq, keys, U, V):
    bsz, T, D = x.shape
    n = bsz * T
    nb = -(-n // PEER_BLOCK)
    pad = nb * PEER_BLOCK - n
    xb = jnp.pad(x.reshape(n, D), ((0, pad), (0, 0))).reshape(nb, PEER_BLOCK, D)

    def block(xt):
        q = (xt @ wq).reshape(PEER_BLOCK, PEER_HEADS, 2, PEER_HALF)
        s = jnp.einsum('thpd,hpnd->thpn', q, keys).astype(jnp.float32)
        s_top, i_top = lax.top_k(s, PEER_TOPK)
        cand = (s_top[:, :, 0, :, None] + s_top[:, :, 1, None, :]).reshape(PEER_BLOCK, PEER_HEADS, PEER_TOPK * PEER_TOPK)
        cidx = (i_top[:, :, 0, :, None] * PEER_KEYS + i_top[:, :, 1, None, :]).reshape(PEER_BLOCK, PEER_HEADS, PEER_TOPK * PEER_TOPK)
        sc, pos = lax.top_k(cand, PEER_TOPK)
        eidx = jnp.take_along_axis(cidx, pos, axis=-1)
        gate = jax.nn.softmax(sc, axis=-1)
        u = jnp.take(U, eidx, axis=0)
        act = jax.nn.gelu(jnp.einsum('thkd,td->thk', u, xt).astype(jnp.float32))
        coef = (gate * act).astype(xt.dtype)
        return jnp.einsum('thk,thkd->td', coef, jnp.take(V, eidx, axis=0))

    out = lax.map(block, xb).reshape(nb * PEER_BLOCK, D)[:n]
    return out.reshape(bsz, T, D)


def run_trunk(x, st_conv, st_shift, st_wkv, weights):
    (norm1_g, w_in, conv_w, mu_rkv, mu_wag, w0, w1, w2, a0, a1, a2, g1, g2, k_k, k_a, r_k,
     gn_w, gn_b, w_pa, w_pb, w_o, norm2_g, peer_wq, peer_keys, peer_u, peer_v, norm_f_g) = weights
    convs, shifts, wkvs = [], [], []
    for l in range(DEPTH):
        xn = rms_norm(x, norm1_g[l])
        h, c_new, s_new, w_new = hybrid_mixer(
            xn, st_conv[l], st_shift[l], st_wkv[l], w_in[l], conv_w[l], mu_rkv[l], mu_wag[l],
            w0[l], w1[l], w2[l], a0[l], a1[l], a2[l], g1[l], g2[l], k_k[l], k_a[l], r_k[l],
            gn_w[l], gn_b[l], w_pa[l], w_pb[l], w_o[l])
        x = x + h
        x = x + peer_ffn(rms_norm(x, norm2_g[l]), peer_wq[l], peer_keys[l], peer_u[l], peer_v[l])
        convs.append(c_new)
        shifts.append(s_new)
        wkvs.append(w_new)
    return rms_norm(x, norm_f_g), jnp.stack(convs), jnp.stack(shifts), jnp.stack(wkvs)


def setup_inputs(seed: int = 0) -> dict:
    key = jax.random.key(seed)
    ks = jax.random.split(key, 40)
    f32 = jnp.float32

    def nrm(k, shape, scale):
        return jax.random.normal(k, shape, f32) * scale

    L = DEPTH
    return {
        "x_prompt": nrm(ks[0], (BATCH, SEQ, D_MODEL), 1.0),
        "x_sample": nrm(ks[1], (DEC_BATCH, DEC_SEQ, D_MODEL), 1.0),
        "state_conv": nrm(ks[2], (L, DEC_BATCH, CONV_W - 1, D_CONV), 1.0),
        "state_shift": nrm(ks[3], (L, DEC_BATCH, D_MODEL), 1.0),
        "state_wkv": nrm(ks[4], (L, DEC_BATCH, RWKV_HEADS, HEAD_DIM, HEAD_DIM), 0.1),
        "norm1_g": 1.0 + nrm(ks[5], (L, D_MODEL), 0.02),
        "w_in": nrm(ks[6], (L, D_MODEL, D_IN), D_MODEL ** -0.5),
        "conv_w": nrm(ks[7], (L, CONV_W, D_CONV), 0.5),
        "mu_rkv": jax.random.uniform(ks[8], (L, 3 * D_RWKV), f32),
        "mu_wag": jax.random.uniform(ks[9], (L, 3, D_MODEL), f32),
        "w0": -1.0 + nrm(ks[10], (L, D_RWKV), 1.0),
        "w1": nrm(ks[11], (L, D_MODEL, LORA_DECAY), D_MODEL ** -0.5),
        "w2": nrm(ks[12], (L, LORA_DECAY, D_RWKV), 0.5 * LORA_DECAY ** -0.5),
        "a0": nrm(ks[13], (L, D_RWKV), 0.5),
        "a1": nrm(ks[14], (L, D_MODEL, LORA_AAA), D_MODEL ** -0.5),
        "a2": nrm(ks[15], (L, LORA_AAA, D_RWKV), 0.5 * LORA_AAA ** -0.5),
        "g1": nrm(ks[16], (L, D_MODEL, LORA_GATE), D_MODEL ** -0.5),
        "g2": nrm(ks[17], (L, LORA_GATE, D_RWKV), LORA_GATE ** -0.5),
        "k_k": 0.85 + nrm(ks[18], (L, D_RWKV), 0.05),
        "k_a": 1.0 + nrm(ks[19], (L, D_RWKV), 0.05),
        "r_k": nrm(ks[20], (L, RWKV_HEADS, HEAD_DIM), 0.1),
        "gn_w": 1.0 + nrm(ks[21], (L, D_RWKV), 0.02),
        "gn_b": nrm(ks[22], (L, D_RWKV), 0.02),
        "w_pa": nrm(ks[23], (L, D_CONV, D_MODEL), D_CONV ** -0.5),
        "w_pb": nrm(ks[24], (L, D_RWKV, D_MODEL), D_RWKV ** -0.5),
        "w_o": nrm(ks[25], (L, D_MODEL, D_MODEL), D_MODEL ** -0.5),
        "norm2_g": 1.0 + nrm(ks[26], (L, D_MODEL), 0.02),
        "peer_wq": nrm(ks[27], (L, D_MODEL, PEER_HEADS * PEER_QDIM), D_MODEL ** -0.5),
        "peer_keys": nrm(ks[28], (L, PEER_HEADS, 2, PEER_KEYS, PEER_HALF), PEER_HALF ** -0.5),
        "peer_u": nrm(ks[29], (L, N_EXPERTS, D_MODEL), D_MODEL ** -0.5),
        "peer_v": nrm(ks[30], (L, N_EXPERTS, D_MODEL), 0.5 * PEER_HEADS ** -0.5),
        "norm_f_g": 1.0 + nrm(ks[31], (D_MODEL,), 0.02),
    }


def reference(x_prompt, x_sample, state_conv, state_shift, state_wkv,
              norm1_g, w_in, conv_w, mu_rkv, mu_wag, w0, w1, w2, a0, a1, a2, g1, g2,
              k_k, k_a, r_k, gn_w, gn_b, w_pa, w_pb, w_o, norm2_g,
              peer_wq, peer_keys, peer_u, peer_v, norm_f_g):
    weights = (norm1_g, w_in, conv_w, mu_rkv, mu_wag, w0, w1, w2, a0, a1, a2, g1, g2, k_k, k_a, r_k,
               gn_w, gn_b, w_pa, w_pb, w_o, norm2_g, peer_wq, peer_keys, peer_u, peer_v, norm_f_g)
    bp = x_prompt.shape[0]
    dt = x_prompt.dtype
    zero_conv = jnp.zeros((DEPTH, bp, CONV_W - 1, D_CONV), dt)
    zero_shift = jnp.zeros((DEPTH, bp, D_MODEL), dt)
    zero_wkv = jnp.zeros((DEPTH, bp, RWKV_HEADS, HEAD_DIM, HEAD_DIM), state_wkv.dtype)
    y_prompt, new_conv_prompt, new_shift_prompt, new_wkv_prompt = run_trunk(
        x_prompt, zero_conv, zero_shift, zero_wkv, weights)
    y_sample, new_conv_sample, new_shift_sample, new_wkv_sample = run_trunk(
        x_sample, state_conv, state_shift, state_wkv, weights)
    return (y_prompt, y_sample, new_conv_prompt, new_shift_prompt, new_wkv_prompt,
            new_conv_sample, new_shift_sample, new_wkv_sample)
```

```cpp
#include <hip/hip_runtime.h>
#include <cstdio>
#include <cstdint>
#define MK_N_LAUNCHES 1
#define MK_REPEAT -1
#define MK_DBGSEL 0
#define MK_EXTRA_LO -1
#define MK_EXTRA_HI -1
namespace pg8 {
#define PG8_LAS __attribute__((address_space(3)))
typedef unsigned short bf16_t;
typedef short bf16x8 __attribute__((ext_vector_type(8)));
typedef float f32x4 __attribute__((ext_vector_type(4)));
typedef unsigned u32x4 __attribute__((ext_vector_type(4)));
constexpr int BM = 256, BK = 64, HALF = 128, HTB = HALF * BK * 2  , STAGE_BYTES = 8 * HTB, NXCD = 8, WGM = 8;

__host__ __device__ __forceinline__ int lds_byte(int r, int c) { const int st = (r >> 4) * 2 + (c >> 5), rr = r & 15, cc = c & 31, ob = rr * 64 + cc * 2; return st * 1024 + (ob ^ (((ob >> 9) & 1) << 5)); }
__host__ __device__ __forceinline__ void stage_rc(int b, int& R, int& C) { const int st = b / 1024, sb = b % 1024, swz = sb ^ (((sb >> 9) & 1) << 5); R = (st >> 1) * 16 + swz / 64; C = (st & 1) * 32 + (swz % 64) / 2; }
__host__ __device__ __forceinline__ int perm32(int rho) { const int n = rho >> 4, i = rho & 15; return 8 * (i >> 2) + 4 * n + (i & 3); }

struct Unit { int pm, pn; };
struct Gemm { const bf16_t* A; const bf16_t* Bt; int M, N, K; };

struct StaticOrder {
    int nM, nN, nwg, G, c;
    __host__ __device__ void init(int M, int N, int G_, int c_) { nM = M / BM; nN = N / BM; nwg = nM * nN; G = G_; c = c_; }
    __host__ __device__ bool next(int i, Unit& u) const {
        const long L = (long)i * G + c; if (L >= nwg) return false;
        int wgid = (int)L; { const int q = nwg / NXCD, r = nwg % NXCD, xcd = wgid % NXCD, off = wgid / NXCD; wgid = (xcd < r ? xcd * (q + 1) : r * (q + 1) + (xcd - r) * q) + off; }
        const int nig = WGM * nN, gid = wgid / nig, fm = gid * WGM, gsz = (nM - fm) < WGM ? (nM - fm) : WGM;
        u.pm = fm + ((wgid % nig) % gsz); u.pn = (wgid % nig) / gsz; return true;
    }
    __device__ __forceinline__ void a_ready(const Unit&) const {}
    __device__ __forceinline__ void done(const Unit&) const {}
};

typedef __bf16 bf16x2_cv __attribute__((ext_vector_type(2))); typedef float f32x2_cv __attribute__((ext_vector_type(2)));
__device__ __forceinline__ unsigned cvt_pk_bf16(float lo, float hi) { return __builtin_bit_cast(unsigned, __builtin_convertvector((f32x2_cv){lo, hi}, bf16x2_cv)); }
__device__ __forceinline__ float bf_lo(unsigned w) { return __uint_as_float(w << 16); }
__device__ __forceinline__ float bf_hi(unsigned w) { return __uint_as_float(w & 0xffff0000u); }
__device__ __forceinline__ float sigm(float x) { return __builtin_amdgcn_rcpf(1.0f + __expf(-x)); }

struct EpiZ {
    static constexpr bool PERM = true, AFTER_DRAIN = false;
    bf16_t *Zc, *Zr, *Zg;
    __device__ __forceinline__ void operator()(const f32x4 (&acc)[2][2][4][2], const Unit& u, int wr, int wc, int fr, int fq) const {
        bf16_t* base; int ldc, colt;
        if (u.pn < 6) { base = Zc; ldc = 1536; colt = u.pn * BM; }
        else if (u.pn < 14) { base = Zr; ldc = 2048; colt = (u.pn - 6) * BM; }
        else { base = Zg; ldc = 2048; colt = (u.pn - 14) * BM; }
        const int row0 = u.pm * BM + wr * 64 + fr, col0 = colt + wc * 32 + 8 * fq;
#pragma unroll
        for (int ai = 0; ai < 2; ++ai)
#pragma unroll
            for (int m = 0; m < 4; ++m) { bf16_t* rowp = base + (size_t)(row0 + ai * HALF + m * 16) * ldc + col0;
#pragma unroll
                for (int bj = 0; bj < 2; ++bj) { const f32x4 v0 = acc[ai][bj][m][0], v1 = acc[ai][bj][m][1];
                    u32x4 w; w.x = cvt_pk_bf16(v0[0], v0[1]); w.y = cvt_pk_bf16(v0[2], v0[3]); w.z = cvt_pk_bf16(v1[0], v1[1]); w.w = cvt_pk_bf16(v1[2], v1[3]);
                    *(u32x4*)(rowp + bj * HALF) = w; } }
    }
};
struct EpiPlain {
    static constexpr bool PERM = true, AFTER_DRAIN = false;
    bf16_t* O; int ldc;
    __device__ __forceinline__ void operator()(const f32x4 (&acc)[2][2][4][2], const Unit& u, int wr, int wc, int fr, int fq) const {
        const int row0 = u.pm * BM + wr * 64 + fr, col0 = u.pn * BM + wc * 32 + 8 * fq;
#pragma unroll
        for (int ai = 0; ai < 2; ++ai)
#pragma unroll
            for (int m = 0; m < 4; ++m) { bf16_t* rowp = O + (size_t)(row0 + ai * HALF + m * 16) * ldc + col0;
#pragma unroll
                for (int bj = 0; bj < 2; ++bj) { const f32x4 v0 = acc[ai][bj][m][0], v1 = acc[ai][bj][m][1];
                    u32x4 w; w.x = cvt_pk_bf16(v0[0], v0[1]); w.y = cvt_pk_bf16(v0[2], v0[3]); w.z = cvt_pk_bf16(v1[0], v1[1]); w.w = cvt_pk_bf16(v1[2], v1[3]);
                    *(u32x4*)(rowp + bj * HALF) = w; } }
    }
};
template <int SECOND> struct EpiGate {
    static constexpr bool PERM = true, AFTER_DRAIN = false;
    const bf16_t* Zg; bf16_t* MG;
    __device__ __forceinline__ void operator()(const f32x4 (&acc)[2][2][4][2], const Unit& u, int wr, int wc, int fr, int fq) const {
        const int row0 = u.pm * BM + wr * 64 + fr, col0 = u.pn * BM + wc * 32 + 8 * fq;
#pragma unroll
        for (int ai = 0; ai < 2; ++ai) {
            u32x4 gw[4][2], pw[4][2];
#pragma unroll
            for (int m = 0; m < 4; ++m) { const int r = row0 + ai * HALF + m * 16;
#pragma unroll
                for (int bj = 0; bj < 2; ++bj) { gw[m][bj] = *(const u32x4*)(Zg + (size_t)r * 2048 + SECOND * 1024 + col0 + bj * HALF);
                    if (SECOND) pw[m][bj] = *(const u32x4*)(MG + (size_t)r * 1024 + col0 + bj * HALF); } }
#pragma unroll
            for (int m = 0; m < 4; ++m) { const int r = row0 + ai * HALF + m * 16; bf16_t* op = MG + (size_t)r * 1024 + col0;
#pragma unroll
                for (int bj = 0; bj < 2; ++bj) { const u32x4 g = gw[m][bj]; f32x4 v0 = acc[ai][bj][m][0], v1 = acc[ai][bj][m][1];
                    v0[0] *= sigm(bf_lo(g.x)); v0[1] *= sigm(bf_hi(g.x)); v0[2] *= sigm(bf_lo(g.y)); v0[3] *= sigm(bf_hi(g.y));
                    v1[0] *= sigm(bf_lo(g.z)); v1[1] *= sigm(bf_hi(g.z)); v1[2] *= sigm(bf_lo(g.w)); v1[3] *= sigm(bf_hi(g.w));
                    if (SECOND) { const u32x4 p = pw[m][bj];
                        v0[0] += bf_lo(p.x); v0[1] += bf_hi(p.x); v0[2] += bf_lo(p.y); v0[3] += bf_hi(p.y);
                        v1[0] += bf_lo(p.z); v1[1] += bf_hi(p.z); v1[2] += bf_lo(p.w); v1[3] += bf_hi(p.w); }
                    u32x4 w; w.x = cvt_pk_bf16(v0[0], v0[1]); w.y = cvt_pk_bf16(v0[2], v0[3]); w.z = cvt_pk_bf16(v1[0], v1[1]); w.w = cvt_pk_bf16(v1[2], v1[3]);
                    *(u32x4*)(op + bj * HALF) = w; } }
        }
    }
};
struct EpiX1 {
    static constexpr bool PERM = false, AFTER_DRAIN = false;
    const float* xp; const float* xs; float* X1; bf16_t* X1B; float* SSP; const float* g2; int nprompt, nrows;
    __device__ __forceinline__ void operator()(const f32x4 (&acc)[2][2][4][2], const Unit& u, int wr, int wc, int fr, int fq) const {
        typedef unsigned u32x2v __attribute__((ext_vector_type(2)));
        const int col0 = u.pn * BM + wc * 32 + 4 * fq;
        f32x4 gq[2][2];
#pragma unroll
        for (int bj = 0; bj < 2; ++bj)
#pragma unroll
            for (int n = 0; n < 2; ++n) gq[bj][n] = *(const f32x4*)(g2 + col0 + bj * HALF + n * 16);
#pragma unroll
        for (int ai = 0; ai < 2; ++ai) {
            f32x4 xv[4][2][2];
#pragma unroll
            for (int m = 0; m < 4; ++m) { int r = u.pm * BM + ai * HALF + wr * 64 + m * 16 + fr; r = r < nrows ? r : nrows - 1;
                const float* xr = r < nprompt ? xp + (size_t)r * 1024 : xs + (size_t)(r - nprompt) * 1024;
#pragma unroll
                for (int bj = 0; bj < 2; ++bj)
#pragma unroll
                    for (int n = 0; n < 2; ++n) xv[m][bj][n] = *(const f32x4*)(xr + col0 + bj * HALF + n * 16); }
#pragma unroll
            for (int m = 0; m < 4; ++m) { const int r = u.pm * BM + ai * HALF + wr * 64 + m * 16 + fr; float ss = 0.f;
#pragma unroll
                for (int bj = 0; bj < 2; ++bj)
#pragma unroll
                    for (int n = 0; n < 2; ++n) { const int c = col0 + bj * HALF + n * 16; const f32x4 o = xv[m][bj][n] + acc[ai][bj][m][n];
                        ss += (o[0] * o[0] + o[1] * o[1]) + (o[2] * o[2] + o[3] * o[3]);
                        const f32x4 q = gq[bj][n]; u32x2v w; w.x = cvt_pk_bf16(o[0] * q[0], o[1] * q[1]); w.y = cvt_pk_bf16(o[2] * q[2], o[3] * q[3]);
                        if (r < nrows) *(u32x2v*)(X1B + (size_t)r * 1024 + c) = w; }
                ss += __shfl_xor(ss, 16); ss += __shfl_xor(ss, 32);
                if (fq == 0 && r < nrows) SSP[(size_t)r * 16 + u.pn * 4 + wc] = ss;
            }
        }
    }
};
template <class Epi, class Sched, bool ALIGN_EPI = false, bool SP2 = false>
__device__ __forceinline__ void gemm_phase(PG8_LAS unsigned char* lds, const Gemm g, const Sched& S, const Epi& E) {
    const int tid = threadIdx.x, wid = __builtin_amdgcn_readfirstlane(tid >> 6), lane = tid & 63, wr = wid >> 2, wc = wid & 3, fr = lane & 15, fq = lane >> 4;
    const int K = g.K, nt = K / BK;
    unsigned voffA[2], voffB[2];
#pragma unroll
    for (int i = 0; i < 2; ++i) { int R, C; stage_rc(tid * 16 + i * 8192, R, C); const int Rb = Epi::PERM ? ((R & ~31) + perm32(R & 31)) : R;
        voffA[i] = (unsigned)(R * K + C) * 2u; voffB[i] = (unsigned)(Rb * K + C) * 2u; }
    const size_t kstep = (size_t)(BK * 2);
    const size_t hstep = (size_t)HALF * K * 2;
    const size_t tstep = 2 * hstep;
    const unsigned ldsw = (unsigned)wid * 1024u;
    const int aoff = lds_byte(wr * 64 + fr, fq * 8), boff = lds_byte(wc * 32 + fr, fq * 8);
#define PG8_SA(b, h) (((b) * 2 + (h)) * HTB)
#define PG8_SB(b, h) ((4 + (b) * 2 + (h)) * HTB)
#define PG8_STAGE(bufoff, gbase, voff) do { _Pragma("unroll") for (int _i = 0; _i < 2; ++_i) \
        __builtin_amdgcn_global_load_lds((const unsigned*)((const char*)(gbase) + (voff)[_i]), (PG8_LAS unsigned*)(lds + (bufoff) + ldsw + _i * 8192), 16, 0, 0); } while (0)
#define PG8_LDA(dst, b, h) do { _Pragma("unroll") for (int m = 0; m < 4; ++m) _Pragma("unroll") for (int k = 0; k < 2; ++k) dst[m][k] = *(const PG8_LAS bf16x8*)(lds + PG8_SA(b, h) + aoff + m * 2048 + k * 1024); } while (0)
#define PG8_LDB(dst, b, h) do { _Pragma("unroll") for (int n = 0; n < 2; ++n) _Pragma("unroll") for (int k = 0; k < 2; ++k) dst[n][k] = *(const PG8_LAS bf16x8*)(lds + PG8_SB(b, h) + boff + n * 2048 + k * 1024); } while (0)
#define PG8_MMA(ai, bj, At, Bt) do { __builtin_amdgcn_s_setprio(1); _Pragma("unroll") for (int m = 0; m < 4; ++m) _Pragma("unroll") for (int n = 0; n < 2; ++n) _Pragma("unroll") for (int k = 0; k < 2; ++k) \
        acc[ai][bj][m][n] = __builtin_amdgcn_mfma_f32_16x16x32_bf16(Bt[n][k], At[m][k], acc[ai][bj][m][n], 0, 0, 0); __builtin_amdgcn_s_setprio(0); } while (0)
#define PG8_WAIT_V(n) asm volatile("s_waitcnt vmcnt(" #n ")" ::: "memory")
#define PG8_WAIT_L(n) asm volatile("s_waitcnt lgkmcnt(" #n ")" ::: "memory")
#define PG8_BAR __builtin_amdgcn_s_barrier()
#define PG8_SCHED __builtin_amdgcn_sched_barrier(0)
    Unit cur, nxt; int ui = 0;
    if (!S.next(0, cur)) return;
    f32x4 acc[2][2][4][2];
#pragma unroll
    for (int a = 0; a < 2; ++a)
#pragma unroll
        for (int b = 0; b < 2; ++b)
#pragma unroll
            for (int m = 0; m < 4; ++m)
#pragma unroll
                for (int n = 0; n < 2; ++n) acc[a][b][m][n] = (f32x4){0.f, 0.f, 0.f, 0.f};
    bf16x8 At[4][2], B0[2][2], B1[2][2];
    const char* cA = (const char*)g.A + (size_t)cur.pm * tstep; const char* cB = (const char*)g.Bt + (size_t)cur.pn * tstep;
    S.a_ready(cur);
    if constexpr (SP2) {
        PG8_STAGE(PG8_SB(0, 0), cB, voffB); PG8_STAGE(PG8_SB(0, 1), cB + hstep, voffB); PG8_STAGE(PG8_SA(0, 0), cA, voffA); PG8_STAGE(PG8_SA(0, 1), cA + hstep, voffA);
        if (wr == 1) PG8_BAR;
        PG8_WAIT_V(2); PG8_BAR;
        PG8_STAGE(PG8_SB(1, 0), cB + kstep, voffB); PG8_STAGE(PG8_SA(1, 0), cA + kstep, voffA); PG8_STAGE(PG8_SB(1, 1), cB + hstep + kstep, voffB);
        PG8_WAIT_V(6); PG8_BAR;
    } else {
        PG8_STAGE(PG8_SB(0, 0), cB, voffB); PG8_STAGE(PG8_SA(0, 0), cA, voffA); PG8_STAGE(PG8_SB(0, 1), cB + hstep, voffB); PG8_STAGE(PG8_SA(0, 1), cA + hstep, voffA);
        if (wr == 1) PG8_BAR;
        PG8_WAIT_V(4); PG8_BAR;
        PG8_STAGE(PG8_SB(1, 0), cB + kstep, voffB); PG8_STAGE(PG8_SA(1, 0), cA + kstep, voffA); PG8_STAGE(PG8_SB(1, 1), cB + hstep + kstep, voffB);
        PG8_WAIT_V(6); PG8_BAR;
    }
    for (;;) {
        const bool has_next = S.next(ui + 1, nxt);
        const char* nA = has_next ? (const char*)g.A + (size_t)nxt.pm * tstep : cA; const char* nB = has_next ? (const char*)g.Bt + (size_t)nxt.pn * tstep : cB;
        for (int t = 0; t < nt; t += 2) {
            const bool last = (t == nt - 2);
            const char* a1 = cA + (size_t)(t + 1) * kstep;
            const char* a2 = last ? nA : cA + (size_t)(t + 2) * kstep; const char* b2 = last ? nB : cB + (size_t)(t + 2) * kstep;
            const char* a3 = a2 + kstep; const char* b3 = b2 + kstep;
            if (last && has_next) S.a_ready(nxt);
            if constexpr (SP2) {
            PG8_LDB(B0, 0, 0); PG8_LDB(B1, 0, 1); PG8_SCHED; PG8_LDA(At, 0, 0); PG8_STAGE(PG8_SA(1, 1), a1 + hstep, voffA);
            PG8_WAIT_V(8); PG8_WAIT_L(0); PG8_BAR; PG8_MMA(0, 0, At, B0); PG8_MMA(0, 1, At, B1); PG8_BAR; PG8_SCHED;
            PG8_LDA(At, 0, 1); PG8_STAGE(PG8_SB(0, 0), b2, voffB); PG8_STAGE(PG8_SB(0, 1), b2 + hstep, voffB); PG8_STAGE(PG8_SA(0, 0), a2, voffA);
            PG8_WAIT_V(8); PG8_WAIT_L(0); PG8_BAR; PG8_MMA(1, 0, At, B0); PG8_MMA(1, 1, At, B1); PG8_BAR; PG8_SCHED;
            PG8_LDB(B0, 1, 0); PG8_LDB(B1, 1, 1); PG8_SCHED; PG8_LDA(At, 1, 0); PG8_STAGE(PG8_SA(0, 1), a2 + hstep, voffA);
            PG8_WAIT_V(8); PG8_WAIT_L(0); PG8_BAR; PG8_MMA(0, 0, At, B0); PG8_MMA(0, 1, At, B1); PG8_BAR; PG8_SCHED;
            PG8_LDA(At, 1, 1); PG8_STAGE(PG8_SB(1, 0), b3, voffB); PG8_STAGE(PG8_SB(1, 1), b3 + hstep, voffB); PG8_STAGE(PG8_SA(1, 0), a3, voffA);
            PG8_WAIT_V(8); PG8_WAIT_L(0); PG8_BAR; PG8_MMA(1, 0, At, B0); PG8_MMA(1, 1, At, B1); PG8_BAR; PG8_SCHED;
            } else {
            PG8_LDB(B0, 0, 0); PG8_SCHED; PG8_LDA(At, 0, 0); PG8_STAGE(PG8_SA(1, 1), a1 + hstep, voffA);
            PG8_WAIT_L(8); PG8_BAR; PG8_WAIT_L(0); PG8_MMA(0, 0, At, B0); PG8_BAR; PG8_SCHED;
            PG8_LDB(B1, 0, 1); PG8_STAGE(PG8_SB(0, 0), b2, voffB);
            PG8_BAR; PG8_WAIT_L(0); PG8_MMA(0, 1, At, B1); PG8_BAR;
            PG8_LDA(At, 0, 1); PG8_STAGE(PG8_SA(0, 0), a2, voffA);
            PG8_BAR; PG8_WAIT_L(0); PG8_MMA(1, 0, At, B0); PG8_BAR; PG8_SCHED;
            PG8_STAGE(PG8_SB(0, 1), b2 + hstep, voffB);
            PG8_WAIT_V(6); PG8_BAR; PG8_MMA(1, 1, At, B1); PG8_BAR;
            PG8_LDB(B0, 1, 0); PG8_SCHED; PG8_LDA(At, 1, 0); PG8_STAGE(PG8_SA(0, 1), a2 + hstep, voffA);
            PG8_WAIT_L(8); PG8_BAR; PG8_WAIT_L(0); PG8_MMA(0, 0, At, B0); PG8_BAR; PG8_SCHED;
            PG8_LDB(B1, 1, 1); PG8_STAGE(PG8_SB(1, 0), b3, voffB);
            PG8_BAR; PG8_WAIT_L(0); PG8_MMA(0, 1, At, B1); PG8_BAR;
            PG8_LDA(At, 1, 1); PG8_STAGE(PG8_SA(1, 0), a3, voffA);
            PG8_BAR; PG8_WAIT_L(0); PG8_MMA(1, 0, At, B0); PG8_BAR; PG8_SCHED;
            PG8_STAGE(PG8_SB(1, 1), b3 + hstep, voffB);
            PG8_WAIT_V(6); PG8_BAR; PG8_MMA(1, 1, At, B1); PG8_BAR;
            }
        }
        if constexpr (ALIGN_EPI) { if (wr == 0) PG8_BAR; }
        if constexpr (!Epi::AFTER_DRAIN) { E(acc, cur, wr, wc, fr, fq); S.done(cur); }
        if (!has_next) break;
#pragma unroll
        for (int a = 0; a < 2; ++a)
#pragma unroll
            for (int b = 0; b < 2; ++b)
#pragma unroll
                for (int m = 0; m < 4; ++m)
#pragma unroll
                    for (int n = 0; n < 2; ++n) acc[a][b][m][n] = (f32x4){0.f, 0.f, 0.f, 0.f};
        cur = nxt; cA = nA; cB = nB; ++ui;
        if constexpr (ALIGN_EPI) { if (wr == 1) PG8_BAR; }
    }
    PG8_WAIT_V(0);
    if constexpr (!ALIGN_EPI) { if (wr == 0) PG8_BAR; }
    PG8_BAR;
    if constexpr (Epi::AFTER_DRAIN) { E.fused(acc, cur, wr, wc, fr, fq, lds, wid, lane); S.done(cur); }
#undef PG8_SA
#undef PG8_SB
#undef PG8_STAGE
#undef PG8_LDA
#undef PG8_LDB
#undef PG8_MMA
#undef PG8_WAIT_V
#undef PG8_WAIT_L
#undef PG8_BAR
#undef PG8_SCHED
}
}
constexpr int NWAVES = 8, NTHR = 512;
#ifndef MK_N_LAUNCHES
#define MK_N_LAUNCHES 1
#endif
constexpr int PER_PHASE = 14;
constexpr int N_LAUNCHES = MK_N_LAUNCHES;

constexpr int DM = 1024, NPROMPT = 32768, NSAMP = 512, NTOK = 33280, NSHIFT = 32, MPAD = 33536, N1 = 5632;
constexpr int SEQ_P = 4096, SEQ_S = 16, NB_P = 8, NB_S = 32;
constexpr size_t O_Y = 0, O_CONV_P = 34078720, O_SHIFT_P = 34086912, O_WKV_P = 34095104, O_CONV_S = 34357248, O_SHIFT_S = 34390016, O_WKV_S = 34422784;
constexpr size_t KiB = 1024, MiB = 1u << 20;
constexpr size_t WS_CTL = 0, CTL_ZERO_BYTES = 64 * KiB;
constexpr size_t WS_W1T = 64 * KiB;
constexpr size_t WS_WPA = WS_W1T + (size_t)N1 * DM * 2;
constexpr size_t WS_WPB = WS_WPA + 1 * MiB;
constexpr size_t WS_WO = WS_WPB + 1 * MiB;
constexpr size_t WS_WQ = WS_WO + 2 * MiB;
constexpr size_t WS_KEYS = WS_WQ + 4 * MiB;
constexpr size_t WS_L2T = WS_KEYS + 512 * KiB;
constexpr size_t WS_SSP = WS_L2T + 256 * KiB;
constexpr size_t WS_UB = WS_SSP + (size_t)MPAD * 16 * 4;
constexpr size_t WS_VB = WS_UB + 16 * MiB;
constexpr size_t WS_A1 = WS_VB + 16 * MiB;
constexpr size_t WS_ZC = WS_A1 + (size_t)MPAD * DM * 2;
constexpr size_t WS_ZR = WS_ZC + (size_t)MPAD * 1536 * 2;
constexpr size_t WS_ZG = WS_ZR + (size_t)MPAD * 2048 * 2;
constexpr size_t WS_END = WS_ZG + (size_t)MPAD * 2048 * 2;
constexpr size_t WS_YL = WS_ZC, WS_ZT = WS_ZC + (size_t)NTOK * 512 * 2, WS_BV = WS_ZC + (size_t)NTOK * 512 * 4;
constexpr size_t WS_EIDX = WS_ZC, WS_GATE = WS_ZC + 16 * MiB, WS_COEF = WS_ZC + 40 * MiB, WS_SS2 = WS_ZC + 64 * MiB, WS_RSTD = WS_ZC + 66 * MiB;
constexpr size_t WS_PART = WS_ZR;
constexpr size_t OB_MB = (size_t)4352 * 4096 * 4;
static_assert(WS_BV + (size_t)NTOK * 512 * 2 <= WS_ZR && OB_MB + (size_t)4352 * 4096 * 2 <= (size_t)NTOK * 1024 * 4, "scan scratch maps");
static_assert(WS_END <= 512 * MiB, "d_ws map must fit 512 MiB");
constexpr float PEER_SU = 32.0f, PEER_SV = 4.0f;
constexpr int CW_BAR = 1024;
constexpr int LDS_BYTES = 163840;
constexpr int LDSCTL_OFF = LDS_BYTES - 512, MISC_OFF = LDSCTL_OFF + 320;

#define GAS __attribute__((address_space(1)))
#define LAS __attribute__((address_space(3)))
typedef unsigned short bf16;
typedef unsigned v4u __attribute__((ext_vector_type(4)));
typedef unsigned v2u __attribute__((ext_vector_type(2)));
typedef float f32x4 __attribute__((ext_vector_type(4)));
typedef short bf16x8 __attribute__((ext_vector_type(8)));
typedef __bf16 bf16x2_t __attribute__((ext_vector_type(2)));
typedef GAS unsigned gu32;
#define RLX_AGENT __ATOMIC_RELAXED, __HIP_MEMORY_SCOPE_AGENT
#define LDS_WAIT() asm volatile("s_waitcnt lgkmcnt(0)" ::: "memory")
#define VM_WAIT() asm volatile("s_waitcnt vmcnt(0)" ::: "memory")
using pg8::cvt_pk_bf16; using pg8::bf_lo; using pg8::bf_hi; using pg8::sigm;
#define XB_TMO      128
#define XB_XCNT(j)  (256  + 64 * (j))
#define XB_XSUB(j)  (1280 + 64 * (j))
#define XB_XGEN(j)  (2304 + 64 * (j))
#define XB_TOP      3328
#define XB_TOPGEN   3392
#define XCD_BAR_WORDS 3456
#define XB_SPIN_CAP (1u << 22)

__device__ __forceinline__ unsigned xb_ld(unsigned* p)              { return __hip_atomic_load(p, __ATOMIC_RELAXED, __HIP_MEMORY_SCOPE_AGENT); }
__device__ __forceinline__ unsigned xb_add(unsigned* p, unsigned v) { return __hip_atomic_fetch_add(p, v, __ATOMIC_RELAXED, __HIP_MEMORY_SCOPE_AGENT); }
__device__ __forceinline__ unsigned xb_xcc_id() { return (unsigned)__builtin_amdgcn_s_getreg((3 << 11) | 20) & 0xFu; }
#define XB_SPIN(cond, bar) do { unsigned _sp = 0; while (cond) { __builtin_amdgcn_s_sleep(1); \
    if ((++_sp & 255u) == 0u) { if (xb_ld(&(bar)[XB_TMO])) break; if (_sp > XB_SPIN_CAP) { atomicAdd(&(bar)[XB_TMO], 1u); break; } } } } while (0)

struct XcdBarrier {
    unsigned* bar; unsigned x;
    volatile LAS unsigned* st;
};

__device__ __forceinline__ XcdBarrier xcd_barrier_post(unsigned* bar, volatile LAS unsigned* st) {
    XcdBarrier b; b.bar = bar; b.x = xb_xcc_id(); b.st = st;
    if (threadIdx.x == 0) (void)xb_add(&bar[XB_XCNT(b.x)], 1u);
    return b;
}
__device__ __forceinline__ void xcd_barrier_complete(unsigned* bar, unsigned x, unsigned& nloc, unsigned& nx) {
    const unsigned G = gridDim.x * gridDim.y * gridDim.z;
    unsigned sum, cnt, mine, sp = 0u;
    for (;;) {
        sum = 0u; cnt = 0u; mine = 0u;
#pragma unroll
        for (unsigned j = 0; j < 16; ++j) { const unsigned c = xb_ld(&bar[XB_XCNT(j)]); sum += c; cnt += (c > 0u) ? 1u : 0u; mine = (j == x) ? c : mine; }
        if (sum == G) break;
        __builtin_amdgcn_s_sleep(1);
        if ((++sp & 255u) == 0u) { if (xb_ld(&bar[XB_TMO])) break; if (sp > XB_SPIN_CAP) { atomicAdd(&bar[XB_TMO], 1u); break; } }
    }
    nloc = mine > 0u ? mine : 1u; nx = cnt > 0u ? cnt : 1u;
}

__device__ __forceinline__ void xcd_barrier(const XcdBarrier& b) {
    asm volatile("s_waitcnt vmcnt(0)" ::: "memory");
    __syncthreads();
    if (threadIdx.x == 0) {
        unsigned* bar = b.bar;
        __builtin_amdgcn_s_waitcnt(0);
        unsigned nloc = b.st[0], nx = b.st[1];
        if (nloc == 0u) { xcd_barrier_complete(bar, b.x, nloc, nx); b.st[0] = nloc; b.st[1] = nx; }
        const unsigned old = xb_add(&bar[XB_XSUB(b.x)], 1u);
        const unsigned gen = old / nloc;
        if (old + 1u == (gen + 1u) * nloc) {
            __builtin_amdgcn_fence(__ATOMIC_RELEASE, "agent");
            asm volatile("s_waitcnt vmcnt(0)" ::: "memory");
            const unsigned og = xb_add(&bar[XB_TOP], 1u);
            const unsigned tg = og / nx;
            if (og + 1u == (tg + 1u) * nx) xb_add(&bar[XB_TOPGEN], 1u);
            else XB_SPIN(xb_ld(&bar[XB_TOPGEN]) == tg, bar);
            __builtin_amdgcn_fence(__ATOMIC_ACQUIRE, "agent");
            xb_add(&bar[XB_XGEN(b.x)], 1u);
            asm volatile("s_waitcnt vmcnt(0)" ::: "memory");
        } else {
            XB_SPIN(xb_ld(&bar[XB_XGEN(b.x)]) == gen, bar);
            __builtin_amdgcn_fence(__ATOMIC_ACQUIRE, "agent");
            asm volatile("s_waitcnt vmcnt(0)" ::: "memory");
        }
    }
    __syncthreads();
}
struct Args { const float* in[32]; float* out; unsigned char* ws; int ph_lo, ph_hi, li, pad; };
enum { I_XP = 0, I_XS, I_SCONV, I_SSHIFT, I_SWKV, I_N1G, I_WIN, I_CONVW, I_MURKV, I_MUWAG, I_W0, I_W1, I_W2, I_A0, I_A1, I_A2, I_G1, I_G2, I_KK, I_KA, I_RK, I_GNW, I_GNB, I_WPA, I_WPB, I_WO, I_N2G, I_WQ, I_KEYS, I_U, I_V, I_NFG };

__device__ __forceinline__ float wave_sum(float v) {
#pragma unroll
    for (int o = 1; o < 64; o <<= 1) v += __shfl_xor(v, o);
    return v;
}
template <int CTRL> __device__ __forceinline__ float dpp_mov(float v) { return __builtin_bit_cast(float, __builtin_amdgcn_update_dpp(0, __builtin_bit_cast(int, v), CTRL, 0xF, 0xF, true)); }
__device__ __forceinline__ float sum4(float v) { v += dpp_mov<0xB1>(v); v += dpp_mov<0x4E>(v); return v; }
__device__ __forceinline__ float sum8(float v) { v = sum4(v); v += dpp_mov<0x141>(v); return v; }
__device__ __forceinline__ float sum16(float v) { v = sum8(v); v += dpp_mov<0x140>(v); return v; }
__device__ __forceinline__ float dot2bf(unsigned w, unsigned x, float acc) { return __builtin_amdgcn_fdot2_f32_bf16(__builtin_bit_cast(bf16x2_t, w), __builtin_bit_cast(bf16x2_t, x), acc, false); }

__device__ __forceinline__ void transpose_item(const float* W, int ldw, int c0, int K, bf16* WT, int nblk, int item, const float* sv, float alpha, float beta, LAS float* scr, int lane) {
    const int kb = item / nblk, nb = item % nblk, k0 = 64 * kb, n0 = 32 * nb;
#pragma unroll 8
    for (int i = 0; i < 32; ++i) { const int kk = 2 * i + (lane >> 5); float s = 1.f; if (sv) s = alpha + beta * sv[k0 + kk];
        scr[kk * 33 + (lane & 31)] = W[(size_t)(k0 + kk) * ldw + c0 + n0 + (lane & 31)] * s; }
    LDS_WAIT();
    const int c = lane & 7;
#pragma unroll
    for (int j = 0; j < 4; ++j) { const int n = (lane >> 3) + 8 * j; const LAS float* s = scr + (8 * c) * 33 + n;
        v4u o; o.x = cvt_pk_bf16(s[0 * 33], s[1 * 33]); o.y = cvt_pk_bf16(s[2 * 33], s[3 * 33]); o.z = cvt_pk_bf16(s[4 * 33], s[5 * 33]); o.w = cvt_pk_bf16(s[6 * 33], s[7 * 33]);
        *(v4u*)(WT + (size_t)(n0 + n) * K + k0 + 8 * c) = o; }
    LDS_WAIT();
}
__device__ __forceinline__ void cvt_stream(const float* src, bf16* dst, size_t n, size_t gt, size_t nthreads) {
    for (size_t i = gt * 8; i < n; i += nthreads * 8) { const f32x4 a = *(const f32x4*)(src + i), b = *(const f32x4*)(src + i + 4);
        v4u o; o.x = cvt_pk_bf16(a[0], a[1]); o.y = cvt_pk_bf16(a[2], a[3]); o.z = cvt_pk_bf16(b[0], b[1]); o.w = cvt_pk_bf16(b[2], b[3]); *(v4u*)(dst + i) = o; }
}
__device__ __forceinline__ void cvt_stream_fp8(const float* src, unsigned char* dst, size_t n, float scale, size_t gt, size_t nthreads) {
    for (size_t i = gt * 16; i < n; i += nthreads * 16) {
        const f32x4 a = *(const f32x4*)(src + i) * scale, b = *(const f32x4*)(src + i + 4) * scale, c = *(const f32x4*)(src + i + 8) * scale, d = *(const f32x4*)(src + i + 12) * scale;
        v4u o; unsigned p;
        p = __builtin_amdgcn_cvt_pk_fp8_f32(a[0], a[1], 0, false); o.x = __builtin_amdgcn_cvt_pk_fp8_f32(a[2], a[3], p, true);
        p = __builtin_amdgcn_cvt_pk_fp8_f32(b[0], b[1], 0, false); o.y = __builtin_amdgcn_cvt_pk_fp8_f32(b[2], b[3], p, true);
        p = __builtin_amdgcn_cvt_pk_fp8_f32(c[0], c[1], 0, false); o.z = __builtin_amdgcn_cvt_pk_fp8_f32(c[2], c[3], p, true);
        p = __builtin_amdgcn_cvt_pk_fp8_f32(d[0], d[1], 0, false); o.w = __builtin_amdgcn_cvt_pk_fp8_f32(d[2], d[3], p, true);
        *(v4u*)(dst + i) = o; }
}
__device__ __forceinline__ void cvt16_fp8_sliced(const float* src, unsigned char* dst, float scale, size_t i) {
    const f32x4 a = *(const f32x4*)(src + i) * scale, b = *(const f32x4*)(src + i + 4) * scale, c = *(const f32x4*)(src + i + 8) * scale, d = *(const f32x4*)(src + i + 12) * scale;
    v4u o; unsigned p;
    p = __builtin_amdgcn_cvt_pk_fp8_f32(a[0], a[1], 0, false); o.x = __builtin_amdgcn_cvt_pk_fp8_f32(a[2], a[3], p, true);
    p = __builtin_amdgcn_cvt_pk_fp8_f32(b[0], b[1], 0, false); o.y = __builtin_amdgcn_cvt_pk_fp8_f32(b[2], b[3], p, true);
    p = __builtin_amdgcn_cvt_pk_fp8_f32(c[0], c[1], 0, false); o.z = __builtin_amdgcn_cvt_pk_fp8_f32(c[2], c[3], p, true);
    p = __builtin_amdgcn_cvt_pk_fp8_f32(d[0], d[1], 0, false); o.w = __builtin_amdgcn_cvt_pk_fp8_f32(d[2], d[3], p, true);
    const size_t e = i >> 10, col = i & 1023;
    *(v4u*)(dst + (col >> 7) * ((size_t)16384 * 128) + e * 128 + (col & 127)) = o;
}
__device__ __forceinline__ void cvt_stream_fp8_sliced(const float* src, unsigned char* dst, float scale, size_t gt, size_t nthreads) {
#pragma unroll 2
    for (size_t i = gt * 16; i < (size_t)16384 * 1024; i += nthreads * 16) {
        const f32x4 a = *(const f32x4*)(src + i) * scale, b = *(const f32x4*)(src + i + 4) * scale, c = *(const f32x4*)(src + i + 8) * scale, d = *(const f32x4*)(src + i + 12) * scale;
        v4u o; unsigned p;
        p = __builtin_amdgcn_cvt_pk_fp8_f32(a[0], a[1], 0, false); o.x = __builtin_amdgcn_cvt_pk_fp8_f32(a[2], a[3], p, true);
        p = __builtin_amdgcn_cvt_pk_fp8_f32(b[0], b[1], 0, false); o.y = __builtin_amdgcn_cvt_pk_fp8_f32(b[2], b[3], p, true);
        p = __builtin_amdgcn_cvt_pk_fp8_f32(c[0], c[1], 0, false); o.z = __builtin_amdgcn_cvt_pk_fp8_f32(c[2], c[3], p, true);
        p = __builtin_amdgcn_cvt_pk_fp8_f32(d[0], d[1], 0, false); o.w = __builtin_amdgcn_cvt_pk_fp8_f32(d[2], d[3], p, true);
        const size_t e = i >> 10, col = i & 1023;
        *(v4u*)(dst + (col >> 7) * ((size_t)16384 * 128) + e * 128 + (col & 127)) = o; }
}
__device__ __forceinline__ void p0_prologue(const Args& A, LAS unsigned char* lds, int tid, int lane, int wave, int vcu, int G) {
    unsigned char* ws = A.ws;
    bf16* W1T = (bf16*)(ws + WS_W1T);
    LAS float* scr = (LAS float*)(lds + wave * 16384);
    const int gw = vcu * NWAVES + wave, NGW = G * NWAVES;
    constexpr int J0 = 16 * 96, J1 = 16 * 64, JL = 16 * 2, JG = 16 * 4, JP = 8 * 32, JO = 16 * 32, JQ = 16 * 64;
    constexpr int JW2 = 16, JG2 = 32;
    constexpr int NITEMS = J0 + J1 + 4 * JL + 2 * JG + 2 * JP + JO + JQ + 2 * JW2 + JG2;
    bf16* L2T = (bf16*)(ws + WS_L2T);
    const float* mu = A.in[I_MUWAG];
    for (int it = gw; it < NITEMS; it += NGW) {
        int r = it;
        if (r < J0) { transpose_item(A.in[I_WIN], 5120, 0, 1024, W1T, 96, r, nullptr, 0.f, 0.f, scr, lane); continue; } r -= J0;
        if (r < J1) { transpose_item(A.in[I_WIN], 5120, 3072, 1024, W1T + (size_t)3584 * 1024, 64, r, nullptr, 0.f, 0.f, scr, lane); continue; } r -= J1;
        if (r < JL) { transpose_item(A.in[I_W1], 64, 0, 1024, W1T + (size_t)3072 * 1024, 2, r, mu, 1.f, -1.f, scr, lane); continue; } r -= JL;
        if (r < JL) { transpose_item(A.in[I_W1], 64, 0, 1024, W1T + (size_t)3328 * 1024, 2, r, mu, 0.f, 1.f, scr, lane); continue; } r -= JL;
        if (r < JL) { transpose_item(A.in[I_A1], 64, 0, 1024, W1T + (size_t)(3072 + 64) * 1024, 2, r, mu + 1024, 1.f, -1.f, scr, lane); continue; } r -= JL;
        if (r < JL) { transpose_item(A.in[I_A1], 64, 0, 1024, W1T + (size_t)(3328 + 64) * 1024, 2, r, mu + 1024, 0.f, 1.f, scr, lane); continue; } r -= JL;
        if (r < JG) { transpose_item(A.in[I_G1], 128, 0, 1024, W1T + (size_t)(3072 + 128) * 1024, 4, r, mu + 2048, 1.f, -1.f, scr, lane); continue; } r -= JG;
        if (r < JG) { transpose_item(A.in[I_G1], 128, 0, 1024, W1T + (size_t)(3328 + 128) * 1024, 4, r, mu + 2048, 0.f, 1.f, scr, lane); continue; } r -= JG;
        if (r < JP) { transpose_item(A.in[I_WPA], 1024, 0, 512, (bf16*)(ws + WS_WPA), 32, r, nullptr, 0.f, 0.f, scr, lane); continue; } r -= JP;
        if (r < JP) { transpose_item(A.in[I_WPB], 1024, 0, 512, (bf16*)(ws + WS_WPB), 32, r, nullptr, 0.f, 0.f, scr, lane); continue; } r -= JP;
        if (r < JO) { transpose_item(A.in[I_WO], 1024, 0, 1024, (bf16*)(ws + WS_WO), 32, r, nullptr, 0.f, 0.f, scr, lane); continue; } r -= JO;
        if (r < JQ) { transpose_item(A.in[I_WQ], 2048, 0, 1024, (bf16*)(ws + WS_WQ), 64, r, nullptr, 0.f, 0.f, scr, lane); continue; } r -= JQ;
        if (r < JW2) { transpose_item(A.in[I_W2], 512, 0, 64, L2T, 16, r, nullptr, 0.f, 0.f, scr, lane); continue; } r -= JW2;
        if (r < JW2) { transpose_item(A.in[I_A2], 512, 0, 64, L2T + (size_t)512 * 64, 16, r, nullptr, 0.f, 0.f, scr, lane); continue; } r -= JW2;
        transpose_item(A.in[I_G2], 512, 0, 128, L2T + (size_t)1024 * 64, 16, r, nullptr, 0.f, 0.f, scr, lane);
    }
    const size_t gt = (size_t)vcu * NTHR + tid, nth = (size_t)G * NTHR;
    if (G != 256) {
        cvt_stream_fp8_sliced(A.in[I_U], ws + WS_UB, PEER_SU, gt, nth);
        cvt_stream_fp8_sliced(A.in[I_V], ws + WS_VB, PEER_SV, gt, nth); }
    cvt_stream(A.in[I_KEYS], (bf16*)(ws + WS_KEYS), (size_t)8 * 2 * 128 * 128, gt, nth);
    bf16* A1 = (bf16*)(ws + WS_A1);
    const f32x4* g1v = (const f32x4*)A.in[I_N1G] + lane;
    for (int m0 = gw; m0 < NTOK; m0 += 2 * NGW) {
        const int m1 = m0 + NGW; const bool two = m1 < NTOK; const int m1c = two ? m1 : m0;
        const f32x4* xr0 = (const f32x4*)(m0 < NPROMPT ? A.in[I_XP] + (size_t)m0 * DM : A.in[I_XS] + (size_t)(m0 - NPROMPT) * DM) + lane;
        const f32x4* xr1 = (const f32x4*)(m1c < NPROMPT ? A.in[I_XP] + (size_t)m1c * DM : A.in[I_XS] + (size_t)(m1c - NPROMPT) * DM) + lane;
        f32x4 v0[4], v1[4]; float s0 = 0.f, s1 = 0.f;
#pragma unroll
        for (int j = 0; j < 4; ++j) { v0[j] = xr0[64 * j]; v1[j] = xr1[64 * j]; }
#pragma unroll
        for (int j = 0; j < 4; ++j) { s0 += (v0[j][0] * v0[j][0] + v0[j][1] * v0[j][1]) + (v0[j][2] * v0[j][2] + v0[j][3] * v0[j][3]);
                                      s1 += (v1[j][0] * v1[j][0] + v1[j][1] * v1[j][1]) + (v1[j][2] * v1[j][2] + v1[j][3] * v1[j][3]); }
#pragma unroll
        for (int o = 1; o < 64; o <<= 1) { s0 += __shfl_xor(s0, o); s1 += __shfl_xor(s1, o); }
        const float r0 = 1.0f / sqrtf(s0 * (1.f / DM) + 1e-6f), r1 = 1.0f / sqrtf(s1 * (1.f / DM) + 1e-6f);
#pragma unroll
        for (int rr = 0; rr < 2; ++rr) {
            if (rr == 1 && !two) break;
            const int m = rr ? m1 : m0; const float rstd = rr ? r1 : r0;
            v2u* o8 = (v2u*)(A1 + (size_t)m * DM) + lane;
            float* so = nullptr;
            if (m < NPROMPT) { if ((m & (SEQ_P - 1)) == SEQ_P - 1) so = A.out + O_SHIFT_P + (size_t)(m / SEQ_P) * DM; }
            else { const int ms = m - NPROMPT; if ((ms & (SEQ_S - 1)) == SEQ_S - 1) so = A.out + O_SHIFT_S + (size_t)(ms / SEQ_S) * DM; }
#pragma unroll
            for (int j = 0; j < 4; ++j) { const f32x4 g = g1v[64 * j]; const f32x4 y = (rr ? v1[j] : v0[j]) * rstd * g;
                v2u w; w.x = cvt_pk_bf16(y[0], y[1]); w.y = cvt_pk_bf16(y[2], y[3]); o8[64 * j] = w;
                if (so) ((f32x4*)so)[lane + 64 * j] = y; }
        }
    }
    for (int m = NTOK + gw; m < MPAD; m += NGW) {
        v2u* o8 = (v2u*)(A1 + (size_t)m * DM) + lane;
        if (m < NTOK + NSHIFT) {
            const f32x4* xr = (const f32x4*)(A.in[I_SSHIFT] + (size_t)(m - NTOK) * DM) + lane;
#pragma unroll
            for (int j = 0; j < 4; ++j) { const f32x4 y = xr[64 * j]; v2u w; w.x = cvt_pk_bf16(y[0], y[1]); w.y = cvt_pk_bf16(y[2], y[3]); o8[64 * j] = w; }
        } else {
#pragma unroll
            for (int j = 0; j < 4; ++j) { v2u w; w.x = 0u; w.y = 0u; o8[64 * j] = w; }
        }
    }
}

__device__ __forceinline__ void unpack8(const v4u w, float (&f)[8]) { f[0] = bf_lo(w.x); f[1] = bf_hi(w.x); f[2] = bf_lo(w.y); f[3] = bf_hi(w.y); f[4] = bf_lo(w.z); f[5] = bf_hi(w.z); f[6] = bf_lo(w.w); f[7] = bf_hi(w.w); }
__device__ __forceinline__ void conv_phase(const Args& A, int gt, int nth) {
    const bf16* Zc = (const bf16*)(A.ws + WS_ZC); bf16* YA = (bf16*)(A.ws + WS_A1);
    const float* cw = A.in[I_CONVW];
    for (int task = gt; task < (NTOK / 16) * 64; task += nth) {
        const int seg = task >> 6, ch = (task & 63) * 8, row0 = seg * 16;
        int b, t0, T; bool prompt = row0 < NPROMPT;
        if (prompt) { b = row0 / SEQ_P; t0 = row0 % SEQ_P; T = SEQ_P; } else { b = (row0 - NPROMPT) / SEQ_S; t0 = 0; T = SEQ_S; }
        float um2[8], um1[8], c0[8], c1[8], c2[8];
#pragma unroll
        for (int i = 0; i < 8; ++i) { c0[i] = cw[ch + i]; c1[i] = cw[512 + ch + i]; c2[i] = cw[1024 + ch + i]; }
        if (t0 == 0) {
            if (prompt) {
#pragma unroll
                for (int i = 0; i < 8; ++i) { um2[i] = 0.f; um1[i] = 0.f; }
            } else { const float* sc = A.in[I_SCONV] + (size_t)b * 2 * 512 + ch;
#pragma unroll
                for (int i = 0; i < 8; ++i) { um2[i] = sc[i]; um1[i] = sc[512 + i]; } }
        } else {
            float a[8], h[8];
            unpack8(*(const v4u*)(Zc + (size_t)(row0 - 2) * 1536 + 512 + ch), a); unpack8(*(const v4u*)(Zc + (size_t)(row0 - 2) * 1536 + 1024 + ch), h);
#pragma unroll
            for (int i = 0; i < 8; ++i) um2[i] = a[i] * h[i];
            unpack8(*(const v4u*)(Zc + (size_t)(row0 - 1) * 1536 + 512 + ch), a); unpack8(*(const v4u*)(Zc + (size_t)(row0 - 1) * 1536 + 1024 + ch), h);
#pragma unroll
            for (int i = 0; i < 8; ++i) um1[i] = a[i] * h[i];
        }
#pragma unroll 4
        for (int t = 0; t < 16; ++t) {
            const size_t row = (size_t)(row0 + t);
            float zb[8], zc[8], zh[8], y[8];
            unpack8(*(const v4u*)(Zc + row * 1536 + ch), zb); unpack8(*(const v4u*)(Zc + row * 1536 + 512 + ch), zc); unpack8(*(const v4u*)(Zc + row * 1536 + 1024 + ch), zh);
#pragma unroll
            for (int i = 0; i < 8; ++i) { const float u = zc[i] * zh[i]; y[i] = zb[i] * (c0[i] * um2[i] + c1[i] * um1[i] + c2[i] * u); um2[i] = um1[i]; um1[i] = u; }
            v4u o; o.x = cvt_pk_bf16(y[0], y[1]); o.y = cvt_pk_bf16(y[2], y[3]); o.z = cvt_pk_bf16(y[4], y[5]); o.w = cvt_pk_bf16(y[6], y[7]);
            *(v4u*)(YA + row * 512 + ch) = o;
        }
        if (t0 + 16 == T) { float* oc = A.out + (prompt ? O_CONV_P : O_CONV_S) + (size_t)b * 2 * 512 + ch;
#pragma unroll
            for (int i = 0; i < 8; ++i) { oc[i] = um2[i]; oc[512 + i] = um1[i]; } }
    }
}

constexpr int NUNITS_P = NB_P * 8 * 64, NUNITS = NUNITS_P + NB_S * 8;
constexpr int HID_STRIDE = 264, SC_TB = 32;
constexpr int P1_HIDB = 0, P1_LO = 16896, P1_SEQ = 41472, P1_GG = 90624, P1_YY = 98816, P1_ZZ = 107008, P1_BON = 115200;
typedef float f32x2 __attribute__((ext_vector_type(2)));

struct P1Pre { v4u pa0, pa1, pb0, pb1; v2u zr, zk, zv, pr, pk, pv; };
struct P1Pos { int unit, t0; };
__device__ __forceinline__ void p1_decode(int unit, bool& prompt, int& b, int& h, int& ch, int& T, int& rowbase) {
    prompt = unit < NUNITS_P; b = prompt ? unit >> 9 : (unit - NUNITS_P) >> 3; h = prompt ? (unit >> 6) & 7 : unit & 7; ch = prompt ? unit & 63 : 0;
    T = prompt ? 64 : SEQ_S; rowbase = prompt ? b * SEQ_P + ch * 64 : NPROMPT + b * SEQ_S;
}
__device__ __forceinline__ void p1_rows(int unit, int t0, int tt, size_t& row, size_t& prow, bool& hasprev, int& nb) {
    bool prompt; int b, h, ch, T, rowbase; p1_decode(unit, prompt, b, h, ch, T, rowbase);
    nb = (T - t0) < SC_TB ? (T - t0) : SC_TB;
    const int tloc = tt < nb ? tt : nb - 1, t = t0 + tloc; const bool first = (ch == 0);
    row = (size_t)(rowbase + t); hasprev = (t > 0) || !first || !prompt; prow = ((t > 0) || !first) ? row - 1 : (size_t)(NTOK + b);
}
__device__ __forceinline__ void p1_load(const Args& A, int unit, int t0, int tt, int cs, P1Pre& P) {
    size_t row, prow; bool hasprev; int nb; p1_rows(unit, t0, tt, row, prow, hasprev, nb);
    const int h = unit < NUNITS_P ? (unit >> 6) & 7 : unit & 7, hc = h * 64 + cs * 4;
    const bf16* Zr = (const bf16*)(A.ws + WS_ZR);
    P.pa0 = *(const v4u*)(Zr + row * 2048 + 1536 + cs * 16); P.pa1 = *(const v4u*)(Zr + row * 2048 + 1536 + cs * 16 + 8);
    P.zr = *(const v2u*)(Zr + row * 2048 + hc); P.zk = *(const v2u*)(Zr + row * 2048 + 512 + hc); P.zv = *(const v2u*)(Zr + row * 2048 + 1024 + hc);
    const v4u z4 = (v4u){0u, 0u, 0u, 0u}; const v2u z2 = (v2u){0u, 0u};
    P.pb0 = z4; P.pb1 = z4; P.pr = z2; P.pk = z2; P.pv = z2;
    if (hasprev) { P.pb0 = *(const v4u*)(Zr + prow * 2048 + 1792 + cs * 16); P.pb1 = *(const v4u*)(Zr + prow * 2048 + 1792 + cs * 16 + 8);
        P.pr = *(const v2u*)(Zr + prow * 2048 + hc); P.pk = *(const v2u*)(Zr + prow * 2048 + 512 + hc); P.pv = *(const v2u*)(Zr + prow * 2048 + 1024 + hc); }
}
__device__ __forceinline__ bool p1_unit_at(int i, int vcu, int G, int& unit) {
    if (G == 256) { if (i > 16) return false; unit = i < 16 ? vcu * 16 + i : NUNITS_P + vcu; return true; }
    unit = vcu + i * G; return unit < NUNITS;
}

constexpr int WY_OS = 72, WY_TS = 24, WY_LS = 40;
constexpr int WY_AT = 0, WY_RT = WY_AT + 16 * WY_OS * 2, WY_BT = WY_RT + 16 * WY_OS * 2, WY_KT = WY_BT + 16 * WY_OS * 2, WY_BH = WY_KT + 16 * WY_OS * 2,
              WY_KH = WY_BH + 64 * WY_TS * 2, WY_VT = WY_KH + 64 * WY_TS * 2, WY_GC = WY_VT + 64 * WY_TS * 2, WY_BUF = WY_GC + 256;
constexpr int WY_BASE = 0;
constexpr int WY_LAB = WY_BASE + 2 * WY_BUF, WY_LAK = WY_LAB + 1024, WY_MC = WY_LAK + 16 * WY_LS * 2;
static_assert(WY_MC + 16 * WY_LS * 2 <= P1_SEQ, "UT-transform operands must fit over HIDB | LO");
constexpr int WY_XB = 115328, WY_RH = WY_XB + 128 * WY_OS * 2, WY_UT = WY_RH + 8 * 16 * 17 * 4, WY_END = WY_UT + 8 * 16 * WY_TS * 2;
static_assert(WY_END <= LDSCTL_OFF, "LDS map of pass 1");

constexpr int WY_G2 = P1_GG + 2048;
static_assert(WY_G2 + 1024 + 2 * 16 * WY_LS * 2 <= P1_YY, "second Gram set");
__device__ __forceinline__ void p1_wy(f32x4 (&X)[4], const LAS float* SEQ, LAS float* YY, LAS float* ZZ, LAS unsigned char* lds, int nb, int tid, int lane, int wave) {
    const bool pw = wave >= 4; const int nmc = nb >> 4;
    LAS bf16* Xb = (LAS bf16*)(lds + WY_XB); LAS float* RH = (LAS float*)(lds + WY_RH) + wave * 16 * 17; LAS bf16* UT = (LAS bf16*)(lds + WY_UT) + wave * 16 * WY_TS;
    const bf16x8 zero8 = (bf16x8){0, 0, 0, 0, 0, 0, 0, 0};
    for (int mc = 0; mc < nmc; ++mc) {
        asm volatile("" : "+v"(tid));
        LAS unsigned char* ob = lds + WY_BASE + mc * WY_BUF;
        LAS bf16* At = (LAS bf16*)(ob + WY_AT); LAS bf16* Rt = (LAS bf16*)(ob + WY_RT); LAS bf16* Bt = (LAS bf16*)(ob + WY_BT); LAS bf16* Kt = (LAS bf16*)(ob + WY_KT);
        LAS bf16* BhT = (LAS bf16*)(ob + WY_BH); LAS bf16* KhT = (LAS bf16*)(ob + WY_KH); LAS bf16* VT = (LAS bf16*)(ob + WY_VT); LAS float* GC = (LAS float*)(ob + WY_GC);
        const int tl = tid >> 5, c2 = (tid & 31) * 2, s0 = mc * 16;
        f32x2 cum = (f32x2){0.f, 0.f}, tot = cum, lwt = cum;
#pragma unroll
        for (int i = 0; i < 16; ++i) { const f32x2 l2 = *(const LAS f32x2*)(SEQ + (s0 + i) * 384 + 64 + c2); tot += l2; if (i <= tl) cum += l2; if (i == tl) lwt = l2; }
        const LAS float* sp = SEQ + (s0 + tl) * 384 + c2;
        const f32x2 a2 = *(const LAS f32x2*)(sp), b2 = *(const LAS f32x2*)(sp + 128), k2 = *(const LAS f32x2*)(sp + 192), r2 = *(const LAS f32x2*)(sp + 256), v2 = *(const LAS f32x2*)(sp + 320);
        const f32x2 gt = (f32x2){__expf(cum.x), __expf(cum.y)}, gp = (f32x2){__expf(cum.x - lwt.x), __expf(cum.y - lwt.y)}, gi = (f32x2){__expf(-cum.x), __expf(-cum.y)},
                    go = (f32x2){__expf(tot.x - cum.x), __expf(tot.y - cum.y)};
        *(LAS unsigned*)(At + tl * WY_OS + c2) = cvt_pk_bf16(a2.x * gp.x, a2.y * gp.y); *(LAS unsigned*)(Rt + tl * WY_OS + c2) = cvt_pk_bf16(r2.x * gt.x, r2.y * gt.y);
        *(LAS unsigned*)(Bt + tl * WY_OS + c2) = cvt_pk_bf16(b2.x * gi.x, b2.y * gi.y); *(LAS unsigned*)(Kt + tl * WY_OS + c2) = cvt_pk_bf16(k2.x * gi.x, k2.y * gi.y);
        const unsigned bh = cvt_pk_bf16(b2.x * go.x, b2.y * go.y), kh = cvt_pk_bf16(k2.x * go.x, k2.y * go.y), vv = cvt_pk_bf16(v2.x, v2.y);
        {
            const unsigned bh_o = (unsigned)__shfl_xor((int)bh, 32), kh_o = (unsigned)__shfl_xor((int)kh, 32), vv_o = (unsigned)__shfl_xor((int)vv, 32);
            const bool ev = (tl & 1) == 0; const int wo = (ev ? c2 : c2 + 1) * WY_TS + (tl & ~1);
            *(LAS unsigned*)(BhT + wo) = ev ? ((bh & 0xffffu) | (bh_o << 16)) : ((bh_o >> 16) | (bh & 0xffff0000u));
            *(LAS unsigned*)(KhT + wo) = ev ? ((kh & 0xffffu) | (kh_o << 16)) : ((kh_o >> 16) | (kh & 0xffff0000u));
            *(LAS unsigned*)(VT + wo) = ev ? ((vv & 0xffffu) | (vv_o << 16)) : ((vv_o >> 16) | (vv & 0xffff0000u)); }
        if (tl == 0) *(LAS f32x2*)(GC + c2) = (f32x2){__expf(tot.x), __expf(tot.y)};
    }
    __syncthreads();
    {
        asm volatile("" : "+v"(tid));
        const int fr = tid & 15, fq = (tid >> 4) & 3, g_ = wave & 3, m_ = wave >> 2;
        if (m_ < nmc) {
            LAS unsigned char* ob = lds + WY_BASE + m_ * WY_BUF; LAS unsigned char* gs = lds + (m_ ? WY_G2 : WY_LAB);
            LAS float* Lab = (LAS float*)gs; LAS bf16* Lak = (LAS bf16*)(gs + 1024); LAS bf16* Mc = (LAS bf16*)(gs + 1024 + 16 * WY_LS * 2);
            const LAS bf16* ab = (LAS bf16*)(ob + (g_ < 2 ? WY_AT : WY_RT)) + fr * WY_OS + fq * 8; const LAS bf16* bb = (LAS bf16*)(ob + ((g_ & 1) ? WY_KT : WY_BT)) + fr * WY_OS + fq * 8;
            f32x4 g = (f32x4){0.f, 0.f, 0.f, 0.f};
#pragma unroll
            for (int ks = 0; ks < 2; ++ks) g = __builtin_amdgcn_mfma_f32_16x16x32_bf16(*(const LAS bf16x8*)(bb + ks * 32), *(const LAS bf16x8*)(ab + ks * 32), g, 0, 0, 0);
#pragma unroll
            for (int rg = 0; rg < 4; ++rg) { const int tp = 4 * fq + rg; const bool keep = (g_ < 2) ? (fr > tp) : (fr >= tp); g[rg] = keep ? g[rg] : 0.f; }
            if (g_ == 0) *(LAS f32x4*)(Lab + fr * 16 + 4 * fq) = g;
            else { v2u w; w.x = cvt_pk_bf16(g[0], g[1]); w.y = cvt_pk_bf16(g[2], g[3]);
                if (g_ == 1) { *(LAS v2u*)(Lak + fr * WY_LS + 4 * fq) = w; *(LAS v2u*)(Lak + fr * WY_LS + 16 + 4 * fq) = (v2u){0u, 0u}; }
                else if (g_ == 2) *(LAS v2u*)(Mc + fr * WY_LS + 4 * fq) = w; else *(LAS v2u*)(Mc + fr * WY_LS + 16 + 4 * fq) = w; }
        }
    }
    __syncthreads();
    for (int mc = 0; mc < nmc; ++mc) {
        asm volatile("" : "+v"(tid));
        const int fr = tid & 15, fq = (tid >> 4) & 3;
        LAS unsigned char* ob = lds + WY_BASE + mc * WY_BUF; LAS unsigned char* gs = lds + (mc ? WY_G2 : WY_LAB);
        LAS bf16* At = (LAS bf16*)(ob + WY_AT); LAS bf16* Rt = (LAS bf16*)(ob + WY_RT);
        LAS bf16* BhT = (LAS bf16*)(ob + WY_BH); LAS bf16* KhT = (LAS bf16*)(ob + WY_KH); LAS bf16* VT = (LAS bf16*)(ob + WY_VT); LAS float* GC = (LAS float*)(ob + WY_GC);
        LAS float* Lab = (LAS float*)gs; LAS bf16* Lak = (LAS bf16*)(gs + 1024); LAS bf16* Mc = (LAS bf16*)(gs + 1024 + 16 * WY_LS * 2);
        f32x4 W1 = (f32x4){0.f, 0.f, 0.f, 0.f}, Y0 = W1;
        {
            const LAS bf16* xbp = Xb + (16 * wave + fr) * WY_OS + fq * 8;
#pragma unroll
            for (int ks = 0; ks < 2; ++ks) { const bf16x8 bx = *(const LAS bf16x8*)(xbp + ks * 32);
                W1 = __builtin_amdgcn_mfma_f32_16x16x32_bf16(*(const LAS bf16x8*)(At + fr * WY_OS + ks * 32 + fq * 8), bx, W1, 0, 0, 0);
                Y0 = __builtin_amdgcn_mfma_f32_16x16x32_bf16(*(const LAS bf16x8*)(Rt + fr * WY_OS + ks * 32 + fq * 8), bx, Y0, 0, 0, 0); }
        }
        if (!pw) { const bf16x8 la = *(const LAS bf16x8*)(Lak + fr * WY_LS + fq * 8); const bf16x8 vb0 = *(const LAS bf16x8*)(VT + (16 * wave + fr) * WY_TS + (fq & 1) * 8); const bf16x8 vb = fq < 2 ? vb0 : zero8;
            W1 = __builtin_amdgcn_mfma_f32_16x16x32_bf16(la, vb, W1, 0, 0, 0); }
#pragma unroll
        for (int rg = 0; rg < 4; ++rg) RH[(4 * fq + rg) * 17 + fr] = W1[rg];
        LDS_WAIT();
        {
            float u[16];
#pragma unroll
            for (int t = 0; t < 16; ++t) { if ((t & 3) == 0) asm volatile("" ::: "memory");
                float acc = RH[t * 17 + fr];
#pragma unroll
                for (int i4 = 0; i4 * 4 < t; ++i4) { const f32x4 l4 = *(const LAS f32x4*)(Lab + t * 16 + i4 * 4);
#pragma unroll
                    for (int e = 0; e < 4; ++e) if (i4 * 4 + e < t) acc += l4[e] * u[i4 * 4 + e]; }
                u[t] = acc; }
            if (fq == 0) { v4u o0, o1; o0.x = cvt_pk_bf16(u[0], u[1]); o0.y = cvt_pk_bf16(u[2], u[3]); o0.z = cvt_pk_bf16(u[4], u[5]); o0.w = cvt_pk_bf16(u[6], u[7]);
                o1.x = cvt_pk_bf16(u[8], u[9]); o1.y = cvt_pk_bf16(u[10], u[11]); o1.z = cvt_pk_bf16(u[12], u[13]); o1.w = cvt_pk_bf16(u[14], u[15]);
                *(LAS v4u*)(UT + fr * WY_TS) = o0; *(LAS v4u*)(UT + fr * WY_TS + 8) = o1; }
        }
        LDS_WAIT();
        {
            const bf16x8 uc = fq < 2 ? *(const LAS bf16x8*)(UT + fr * WY_TS + fq * 8) : (pw ? zero8 : *(const LAS bf16x8*)(VT + (16 * wave + fr) * WY_TS + (fq - 2) * 8));
            Y0 = __builtin_amdgcn_mfma_f32_16x16x32_bf16(*(const LAS bf16x8*)(Mc + fr * WY_LS + fq * 8), uc, Y0, 0, 0, 0);
            LAS float* yo = (pw ? ZZ + 16 * (wave - 4) : YY + 16 * wave) + fr;
#pragma unroll
            for (int rg = 0; rg < 4; ++rg) yo[(mc * 16 + 4 * fq + rg) * 64] = Y0[rg];
#pragma unroll
            for (int j = 0; j < 4; ++j) {
                const bf16x8 bc = fq < 2 ? *(const LAS bf16x8*)(BhT + (16 * j + fr) * WY_TS + fq * 8) : *(const LAS bf16x8*)(KhT + (16 * j + fr) * WY_TS + (fq - 2) * 8);
                X[j] = X[j] * *(const LAS f32x4*)(GC + 16 * j + 4 * fq);
                X[j] = __builtin_amdgcn_mfma_f32_16x16x32_bf16(bc, uc, X[j], 0, 0, 0);
                v2u w; w.x = cvt_pk_bf16(X[j][0], X[j][1]); w.y = cvt_pk_bf16(X[j][2], X[j][3]);
                *(LAS v2u*)(Xb + (16 * wave + fr) * WY_OS + 16 * j + 4 * fq) = w; }
        }
        LDS_WAIT();
    }
}

#define P1_LOAD_PARAMS(HH) do { int lf_ = fr, lq_ = fq, lt_ = tid; asm volatile("" : "+v"(lf_), "+v"(lq_), "+v"(lt_));   \
        const int h_ = (HH), ncol_ = h_ * 64 + ntl * 16 + lf_; \
        _Pragma("unroll") for (int ks = 0; ks < 2; ++ks) { bw[ks] = *(const bf16x8*)(L2T + (size_t)ncol_ * 64 + lq_ * 8 + ks * 32); ba[ks] = *(const bf16x8*)(L2T + (size_t)512 * 64 + (size_t)ncol_ * 64 + lq_ * 8 + ks * 32); } \
        _Pragma("unroll") for (int ks = 0; ks < 4; ++ks) bg[ks] = *(const bf16x8*)(L2T + (size_t)1024 * 64 + (size_t)ncol_ * 128 + lq_ * 8 + ks * 32); \
        if (lt_ < 128) { const int a_ = lt_ >> 4, c_ = (lt_ & 15) * 4; \
            const float* src_ = a_ == 0 ? A.in[I_W0] : a_ == 1 ? A.in[I_A0] : a_ == 2 ? A.in[I_KK] : a_ == 3 ? A.in[I_KA] : a_ == 4 ? A.in[I_RK] : A.in[I_MURKV] + (a_ - 5) * 512; \
            *(LAS f32x4*)(PRM + a_ * 64 + c_) = *(const f32x4*)(src_ + h_ * 64 + c_); } } while (0)
__device__ __forceinline__ void scan_pass1(const Args& A, LAS unsigned char* lds, int tid, int lane, int wave, int vcu, int G) {
    bf16* GB = (bf16*)(A.ws + WS_A1) + (size_t)MPAD * 512;
    bf16* YL = (bf16*)(A.ws + WS_YL); bf16* ZT = (bf16*)(A.ws + WS_ZT); bf16* BV = (bf16*)(A.ws + WS_BV);
    LAS bf16* HIDB = (LAS bf16*)(lds + P1_HIDB); LAS float* LO = (LAS float*)(lds + P1_LO); LAS float* SEQ = (LAS float*)(lds + P1_SEQ);
    LAS float* YY = (LAS float*)(lds + P1_YY); LAS float* ZZ = (LAS float*)(lds + P1_ZZ);
    const bf16* L2T = (const bf16*)(A.ws + WS_L2T);
    const bool prow_wave = wave >= 4;
    const int mt = wave & 1, ntl = wave >> 1;
    int tt = tid >> 4, cs = tid & 15, c4 = cs * 4, fr = lane & 15, fq = lane >> 4;
    f32x4 X[4];
    bf16x8 bw[2], ba[2], bg[4];
    LAS float* PRM = (LAS float*)(lds + P1_GG);
    int cur_h = -1;
    int ui = 0, unit; if (!p1_unit_at(0, vcu, G, unit)) return;
    int t0 = 0; P1Pre pre; p1_load(A, unit, 0, tt, cs, pre);
    for (;;) {
        { int lt_ = tid; asm volatile("" : "+v"(lt_)); tt = lt_ >> 4; cs = lt_ & 15; c4 = cs * 4; fr = lt_ & 15; fq = (lt_ >> 4) & 3; }
        bool prompt; int b, h, ch, T, rowbase; p1_decode(unit, prompt, b, h, ch, T, rowbase);
        const int hc = h * 64 + c4;
        if (t0 == 0 && G == 256 && ui < 8) {
            const size_t i16 = ((size_t)(ui * 256 + vcu) * NTHR + tid) * 16;
            cvt16_fp8_sliced(A.in[I_U], A.ws + WS_UB, PEER_SU, i16); cvt16_fp8_sliced(A.in[I_V], A.ws + WS_VB, PEER_SV, i16); }
        if (t0 == 0) {
            LAS bf16* Xb = (LAS bf16*)(lds + WY_XB);
#pragma unroll
            for (int j = 0; j < 4; ++j) { const int prow_ = 16 * (wave - 4) + fr, c0_ = 16 * j + 4 * fq;
#pragma unroll
                for (int e = 0; e < 4; ++e) X[j][e] = (prow_wave && prow_ == c0_ + e) ? 1.f : 0.f;
                v2u w; w.x = cvt_pk_bf16(X[j][0], X[j][1]); w.y = cvt_pk_bf16(X[j][2], X[j][3]);
                *(LAS v2u*)(Xb + (16 * wave + fr) * WY_OS + c0_) = w; }
        }
        if (h != cur_h) { cur_h = h; P1_LOAD_PARAMS(h); }
        size_t row, prow; bool hasprev; int nb; p1_rows(unit, t0, tt, row, prow, hasprev, nb);
        {
            float pa[16], pb[16]; float t8[8];
            unpack8(pre.pa0, t8);
#pragma unroll
            for (int i = 0; i < 8; ++i) pa[i] = t8[i];
            unpack8(pre.pa1, t8);
#pragma unroll
            for (int i = 0; i < 8; ++i) pa[8 + i] = t8[i];
            unpack8(pre.pb0, t8);
#pragma unroll
            for (int i = 0; i < 8; ++i) pb[i] = t8[i];
            unpack8(pre.pb1, t8);
#pragma unroll
            for (int i = 0; i < 8; ++i) pb[8 + i] = t8[i];
#pragma unroll
            for (int i = 0; i < 16; ++i) { float p = pa[i] + pb[i];
                if (cs < 4) p = 1.0f - 2.0f * __builtin_amdgcn_rcpf(__expf(2.0f * p) + 1.0f);
                else if (cs >= 8) p = sigm(p);
                pa[i] = p; }
            v4u o0, o1; o0.x = cvt_pk_bf16(pa[0], pa[1]); o0.y = cvt_pk_bf16(pa[2], pa[3]); o0.z = cvt_pk_bf16(pa[4], pa[5]); o0.w = cvt_pk_bf16(pa[6], pa[7]);
            o1.x = cvt_pk_bf16(pa[8], pa[9]); o1.y = cvt_pk_bf16(pa[10], pa[11]); o1.z = cvt_pk_bf16(pa[12], pa[13]); o1.w = cvt_pk_bf16(pa[14], pa[15]);
            *(LAS v4u*)(HIDB + tt * HID_STRIDE + cs * 16) = o0; *(LAS v4u*)(HIDB + tt * HID_STRIDE + cs * 16 + 8) = o1;
        }
        __syncthreads();
        {
            const LAS bf16* ap = HIDB + (mt * 16 + fr) * HID_STRIDE + fq * 8;
            f32x4 cw = (f32x4){0.f, 0.f, 0.f, 0.f}, ca = cw, cg = cw;
#pragma unroll
            for (int ks = 0; ks < 2; ++ks) { cw = __builtin_amdgcn_mfma_f32_16x16x32_bf16(*(const LAS bf16x8*)(ap + ks * 32), bw[ks], cw, 0, 0, 0);
                                             ca = __builtin_amdgcn_mfma_f32_16x16x32_bf16(*(const LAS bf16x8*)(ap + 64 + ks * 32), ba[ks], ca, 0, 0, 0); }
#pragma unroll
            for (int ks = 0; ks < 4; ++ks) cg = __builtin_amdgcn_mfma_f32_16x16x32_bf16(*(const LAS bf16x8*)(ap + 128 + ks * 32), bg[ks], cg, 0, 0, 0);
#pragma unroll
            for (int rg = 0; rg < 4; ++rg) { const int o = (mt * 16 + fq * 4 + rg) * 64 + ntl * 16 + fr; LO[o] = cw[rg]; LO[2048 + o] = ca[rg]; LO[4096 + o] = cg[rg]; }
        }
        __syncthreads();
        {
            const f32x4 w0v = *(const LAS f32x4*)(PRM + c4), a0v = *(const LAS f32x4*)(PRM + 64 + c4), kkv = *(const LAS f32x4*)(PRM + 128 + c4), kav = *(const LAS f32x4*)(PRM + 192 + c4),
                        rkv = *(const LAS f32x4*)(PRM + 256 + c4), mur = *(const LAS f32x4*)(PRM + 320 + c4), muk = *(const LAS f32x4*)(PRM + 384 + c4), muv = *(const LAS f32x4*)(PRM + 448 + c4);
            const f32x4 aw = w0v + *(const LAS f32x4*)(LO + tt * 64 + c4), aa = a0v + *(const LAS f32x4*)(LO + 2048 + tt * 64 + c4), ag = *(const LAS f32x4*)(LO + 4096 + tt * 64 + c4);
            f32x4 r = (f32x4){bf_lo(pre.zr.x), bf_hi(pre.zr.x), bf_lo(pre.zr.y), bf_hi(pre.zr.y)}, k = (f32x4){bf_lo(pre.zk.x), bf_hi(pre.zk.x), bf_lo(pre.zk.y), bf_hi(pre.zk.y)},
                  v = (f32x4){bf_lo(pre.zv.x), bf_hi(pre.zv.x), bf_lo(pre.zv.y), bf_hi(pre.zv.y)};
            const f32x4 rpv = (f32x4){bf_lo(pre.pr.x), bf_hi(pre.pr.x), bf_lo(pre.pr.y), bf_hi(pre.pr.y)}, kpv = (f32x4){bf_lo(pre.pk.x), bf_hi(pre.pk.x), bf_lo(pre.pk.y), bf_hi(pre.pk.y)},
                        vpv = (f32x4){bf_lo(pre.pv.x), bf_hi(pre.pv.x), bf_lo(pre.pv.y), bf_hi(pre.pv.y)};
            r = r + mur * (rpv - r); k = k + muk * (kpv - k); v = v + muv * (vpv - v);
            f32x4 dec, asg, kk, km, av, bv;
            float ssq = 0.f, bon = 0.f;
#pragma unroll
            for (int i = 0; i < 4; ++i) {
                const float x = -aw[i];
                const float sp = fmaxf(x, 0.f) + __logf(1.0f + __expf(-fabsf(x)));
                const float wraw = -sp - 0.5f;
                dec[i] = -__expf(wraw);
                asg[i] = sigm(aa[i]);
                kk[i] = k[i] * kkv[i]; ssq += kk[i] * kk[i];
                km[i] = k[i] * (1.0f + (asg[i] - 1.0f) * kav[i]);
                bon += r[i] * km[i] * rkv[i];
            }
            ssq = sum16(ssq); bon = sum16(bon);
            const float inv = 1.0f / fmaxf(sqrtf(ssq), 1e-12f);
#pragma unroll
            for (int i = 0; i < 4; ++i) { kk[i] *= inv; av[i] = -kk[i]; bv[i] = kk[i] * asg[i]; }
            LAS float* sq_ = SEQ + tt * 384 + c4;
            *(LAS f32x4*)(sq_) = av; *(LAS f32x4*)(sq_ + 64) = dec; *(LAS f32x4*)(sq_ + 128) = bv; *(LAS f32x4*)(sq_ + 192) = km; *(LAS f32x4*)(sq_ + 256) = r; *(LAS f32x4*)(sq_ + 320) = v;
            if (tt < nb) {
                v2u w; w.x = cvt_pk_bf16(ag[0], ag[1]); w.y = cvt_pk_bf16(ag[2], ag[3]); *(v2u*)(GB + row * 512 + hc) = w;
                w.x = cvt_pk_bf16(bon * v[0], bon * v[1]); w.y = cvt_pk_bf16(bon * v[2], bon * v[3]); *(v2u*)(BV + row * 512 + hc) = w;
            }
        }
        int nunit = unit, nt0 = t0 + SC_TB, nui = ui; bool more = true;
        if (nt0 >= T) { nt0 = 0; nui = ui + 1; more = p1_unit_at(nui, vcu, G, nunit); }
        if (more) p1_load(A, nunit, nt0, tt, cs, pre);
        __syncthreads();
        p1_wy(X, SEQ, YY, ZZ, lds, nb, tid, lane, wave);
        __syncthreads();
        if (tt < nb) {
            const f32x4 y = *(const LAS f32x4*)(YY + tt * 64 + c4), z = *(const LAS f32x4*)(ZZ + tt * 64 + c4);
            v2u w; w.x = cvt_pk_bf16(y[0], y[1]); w.y = cvt_pk_bf16(y[2], y[3]); *(v2u*)(YL + row * 512 + hc) = w;
            w.x = cvt_pk_bf16(z[0], z[1]); w.y = cvt_pk_bf16(z[2], z[3]); *(v2u*)(ZT + row * 512 + hc) = w;
        }
        if (t0 + SC_TB >= T) {
#pragma unroll
            for (int j = 0; j < 4; ++j) {
                if (!prow_wave) *(f32x4*)((float*)A.out + (size_t)unit * 4096 + (16 * wave + fr) * 64 + 16 * j + 4 * fq) = X[j];
                else { v2u o; o.x = cvt_pk_bf16(X[j][0], X[j][1]); o.y = cvt_pk_bf16(X[j][2], X[j][3]);
                    *(v2u*)((bf16*)((unsigned char*)A.out + OB_MB) + (size_t)unit * 4096 + (16 * (wave - 4) + fr) * 64 + 16 * j + 4 * fq) = o; }
            }
        }
        if (!more) break;
        unit = nunit; t0 = nt0; ui = nui;
    }
    __syncthreads();
}

constexpr int P2_SP = 68, P2_MP = 80, P2_ML = 16 * P2_SP * 4, P2_PL = P2_ML + 64 * P2_MP * 4;
__device__ __forceinline__ void scan_pass2_rows(const float* Sinit, int unit0, int nchunks, int v0, float* outfin, bool slots, const Args& A, LAS unsigned char* lds, int tid, int lane, int wave) {
    LAS float* Sl = (LAS float*)lds; LAS float* Ml = (LAS float*)(lds + P2_ML); LAS float* Pl = (LAS float*)(lds + P2_PL);
    const int nt = wave & 3, kh = wave >> 2, fr = lane & 15, fq = lane >> 4;
    float* NB = (float*)A.out; const bf16* MB = (const bf16*)((const unsigned char*)A.out + OB_MB);
    { const int idx = tid * 2, row = idx >> 6, col = idx & 63;
      const f32x2 s0 = Sinit ? *(const f32x2*)(Sinit + (size_t)(v0 + row) * 64 + col) : (f32x2){0.f, 0.f};
      *(LAS f32x2*)(Sl + row * P2_SP + col) = s0; }
    v4u mreg = *(const v4u*)(MB + (size_t)unit0 * 4096 + tid * 8);
    float nreg[4] = {0.f, 0.f, 0.f, 0.f};
    if (kh == 0) {
#pragma unroll
        for (int rg = 0; rg < 4; ++rg) nreg[rg] = NB[(size_t)unit0 * 4096 + (v0 + fq * 4 + rg) * 64 + nt * 16 + fr]; }
    f32x4 acc = (f32x4){0.f, 0.f, 0.f, 0.f};
    for (int c = 0; c < nchunks; ++c) {
        { const int row = tid >> 3, col = (tid & 7) * 8; LAS float* mp = Ml + row * P2_MP + col;
          *(LAS f32x4*)mp = (f32x4){bf_lo(mreg.x), bf_hi(mreg.x), bf_lo(mreg.y), bf_hi(mreg.y)}; *(LAS f32x4*)(mp + 4) = (f32x4){bf_lo(mreg.z), bf_hi(mreg.z), bf_lo(mreg.w), bf_hi(mreg.w)}; }
        __syncthreads();
        float ncur[4] = {nreg[0], nreg[1], nreg[2], nreg[3]};
        if (c + 1 < nchunks) { mreg = *(const v4u*)(MB + (size_t)(unit0 + c + 1) * 4096 + tid * 8);
            if (kh == 0) {
#pragma unroll
                for (int rg = 0; rg < 4; ++rg) nreg[rg] = NB[(size_t)(unit0 + c + 1) * 4096 + (v0 + fq * 4 + rg) * 64 + nt * 16 + fr]; } }
        f32x4 a0 = (f32x4){0.f, 0.f, 0.f, 0.f}, a1 = a0;
        const LAS float* sp = Sl + fr * P2_SP + kh * 32 + fq; const LAS float* mp = Ml + (kh * 32 + fq) * P2_MP + nt * 16 + fr;
#pragma unroll
        for (int ks = 0; ks < 8; ks += 2) { a0 = __builtin_amdgcn_mfma_f32_16x16x4f32(sp[4 * ks], mp[4 * ks * P2_MP], a0, 0, 0, 0); a1 = __builtin_amdgcn_mfma_f32_16x16x4f32(sp[4 * ks + 4], mp[(4 * ks + 4) * P2_MP], a1, 0, 0, 0); }
        acc = a0 + a1;
        if (kh == 1) *(LAS f32x4*)(Pl + nt * 256 + lane * 4) = acc;
        __syncthreads();
        if (kh == 0) {
            acc = acc + *(const LAS f32x4*)(Pl + nt * 256 + lane * 4) + (f32x4){ncur[0], ncur[1], ncur[2], ncur[3]};
#pragma unroll
            for (int rg = 0; rg < 4; ++rg) { Sl[(fq * 4 + rg) * P2_SP + nt * 16 + fr] = acc[rg];
                if (slots) NB[(size_t)(unit0 + c) * 4096 + (v0 + fq * 4 + rg) * 64 + nt * 16 + fr] = acc[rg]; }
        }
    }
    if (kh == 0) {
#pragma unroll
        for (int rg = 0; rg < 4; ++rg) outfin[(size_t)(v0 + fq * 4 + rg) * 64 + nt * 16 + fr] = acc[rg]; }
    __syncthreads();
}

__device__ __forceinline__ void scan_pass3_wave(const Args& A, int unit, int wq, int lane) {
    const bool prompt = unit < NUNITS_P;
    const int b = prompt ? unit >> 9 : (unit - NUNITS_P) >> 3, h = prompt ? (unit >> 6) & 7 : unit & 7, ch = prompt ? unit & 63 : 0;
    const int T = prompt ? 64 : SEQ_S, rowbase = prompt ? b * SEQ_P + ch * 64 : NPROMPT + b * SEQ_S;
    if (wq * 16 >= T) return;
    const float* S0 = prompt ? (ch > 0 ? (const float*)A.out + (size_t)(unit - 1) * 4096 : nullptr) : A.in[I_SWKV] + (size_t)(b * 8 + h) * 4096;
    const bf16* ZT = (const bf16*)(A.ws + WS_ZT); const bf16* YL = (const bf16*)(A.ws + WS_YL); const bf16* BV = (const bf16*)(A.ws + WS_BV);
    bf16* YB = (bf16*)(A.ws + WS_A1) + (size_t)MPAD * 512;
    const int fr = lane & 15, fq = lane >> 4;
    const size_t row = (size_t)(rowbase + wq * 16 + fr);
    f32x4 acc[4];
#pragma unroll
    for (int mt = 0; mt < 4; ++mt) acc[mt] = (f32x4){0.f, 0.f, 0.f, 0.f};
    if (S0) {
        bf16x8 bz[2];
#pragma unroll
        for (int ks = 0; ks < 2; ++ks) bz[ks] = *(const bf16x8*)(ZT + row * 512 + h * 64 + ks * 32 + fq * 8);
#pragma unroll
        for (int mt = 0; mt < 4; ++mt)
#pragma unroll
            for (int ks = 0; ks < 2; ++ks) { const float* sp = S0 + (size_t)(mt * 16 + fr) * 64 + ks * 32 + fq * 8; const f32x4 s0 = *(const f32x4*)sp, s1 = *(const f32x4*)(sp + 4);
                v4u pk; pk.x = cvt_pk_bf16(s0[0], s0[1]); pk.y = cvt_pk_bf16(s0[2], s0[3]); pk.z = cvt_pk_bf16(s1[0], s1[1]); pk.w = cvt_pk_bf16(s1[2], s1[3]);
                acc[mt] = __builtin_amdgcn_mfma_f32_16x16x32_bf16(__builtin_bit_cast(bf16x8, pk), bz[ks], acc[mt], 0, 0, 0); }
    }
    float sm = 0.f;
#pragma unroll
    for (int mt = 0; mt < 4; ++mt) { const v2u yl = *(const v2u*)(YL + row * 512 + h * 64 + mt * 16 + fq * 4);
        acc[mt][0] += bf_lo(yl.x); acc[mt][1] += bf_hi(yl.x); acc[mt][2] += bf_lo(yl.y); acc[mt][3] += bf_hi(yl.y);
        sm += (acc[mt][0] + acc[mt][1]) + (acc[mt][2] + acc[mt][3]); }
    sm += __shfl_xor(sm, 16); sm += __shfl_xor(sm, 32);
    const float mean = sm * (1.f / 64.f); float sv = 0.f;
#pragma unroll
    for (int mt = 0; mt < 4; ++mt) { acc[mt] = acc[mt] - mean; sv += (acc[mt][0] * acc[mt][0] + acc[mt][1] * acc[mt][1]) + (acc[mt][2] * acc[mt][2] + acc[mt][3] * acc[mt][3]); }
    sv += __shfl_xor(sv, 16); sv += __shfl_xor(sv, 32);
    const float rs = 1.0f / sqrtf(sv * (1.f / 64.f) + 64e-5f);
#pragma unroll
    for (int mt = 0; mt < 4; ++mt) { const int c = h * 64 + mt * 16 + fq * 4;
        const f32x4 gw = *(const f32x4*)(A.in[I_GNW] + c), gb = *(const f32x4*)(A.in[I_GNB] + c);
        const v2u bvw = *(const v2u*)(BV + row * 512 + c), gg = *(const v2u*)(YB + row * 512 + c);
        f32x4 o = acc[mt] * rs * gw + gb + (f32x4){bf_lo(bvw.x), bf_hi(bvw.x), bf_lo(bvw.y), bf_hi(bvw.y)};
        o = o * (f32x4){bf_lo(gg.x), bf_hi(gg.x), bf_lo(gg.y), bf_hi(gg.y)};
        v2u w; w.x = cvt_pk_bf16(o[0], o[1]); w.y = cvt_pk_bf16(o[2], o[3]); *(v2u*)(YB + row * 512 + c) = w; }
}

__device__ __forceinline__ void tk_insert(float (&tv)[16], float x) {
#pragma unroll
    for (int i = 15; i >= 1; --i) tv[i] = __builtin_amdgcn_fmed3f(tv[i - 1], x, tv[i]);
    tv[0] = __builtin_fmaxf(tv[0], x);
}
__device__ __forceinline__ float gelu_tanh(float x) {
    const float u = 0.7978845608028654f * (x + 0.044715f * x * x * x);
    const float th = 1.0f - 2.0f * __builtin_amdgcn_rcpf(__expf(2.0f * u) + 1.0f);
    return 0.5f * x * (1.0f + th);
}
constexpr int NTILE32 = NTOK / 32;
constexpr int CW_QU = 8192, CW_QV = 8192 + 512;

constexpr int TK_STRIDE = 68, TK_BYTES = 64 * TK_STRIDE * 4;
__device__ __forceinline__ void topk_scores64(const bf16* Q, const bf16* KB, LAS float* SC, int t0, int hp, int p, int half, int lane, const bf16x8 (&af)[2][2][4]) {
    const int fr = lane & 15, fq = lane >> 4;
#pragma unroll
    for (int hs = 0; hs < 2; ++hs) {
        const bf16* kbase = KB + (size_t)(((hp + 4 * hs) * 2 + p) * 128 + half * 64 + fr) * 128 + fq * 8;
#pragma unroll
        for (int n = 0; n < 4; ++n) {
            bf16x8 bfr[4];
#pragma unroll
            for (int ks = 0; ks < 4; ++ks) bfr[ks] = *(const bf16x8*)(kbase + (size_t)n * 16 * 128 + ks * 32);
            f32x4 acc0 = (f32x4){0.f, 0.f, 0.f, 0.f}, acc1 = acc0;
#pragma unroll
            for (int ks = 0; ks < 4; ++ks) { acc0 = __builtin_amdgcn_mfma_f32_16x16x32_bf16(af[hs][0][ks], bfr[ks], acc0, 0, 0, 0); acc1 = __builtin_amdgcn_mfma_f32_16x16x32_bf16(af[hs][1][ks], bfr[ks], acc1, 0, 0, 0); }
#pragma unroll
            for (int rg = 0; rg < 4; ++rg) { SC[(hs * 32 + fq * 4 + rg) * TK_STRIDE + n * 16 + fr] = acc0[rg]; SC[(hs * 32 + 16 + fq * 4 + rg) * TK_STRIDE + n * 16 + fr] = acc1[rg]; }
        }
    }
}
__device__ __forceinline__ void peer_topk_phase(const Args& A, LAS unsigned char* lds, int tid, int lane, int wave, int vcu, int G) {
    const bf16* Q = (const bf16*)(A.ws + WS_ZG); const bf16* KB = (const bf16*)(A.ws + WS_KEYS); const float* SSP = (const float*)(A.ws + WS_SSP);
    unsigned short* EIDX = (unsigned short*)(A.ws + WS_EIDX); float* GATE = (float*)(A.ws + WS_GATE); float* RSTD = (float*)(A.ws + WS_RSTD);
    LAS float* SC = (LAS float*)(lds + wave * TK_BYTES);
    const int fr = lane & 15, fq = lane >> 4, tokl = lane & 31, hsel = lane >> 5;
    for (int u = wave * G + vcu; u < NTILE32 * 4; u += G * NWAVES) {
        const int t0 = (u >> 2) * 32, hp = u & 3, h = hp + 4 * hsel;
        const float* sp = SSP + (size_t)(t0 + tokl) * 16;
        const f32x4 s0 = *(const f32x4*)sp, s1 = *(const f32x4*)(sp + 4), s2 = *(const f32x4*)(sp + 8), s3 = *(const f32x4*)(sp + 12);
        const float ssq = ((s0[0] + s0[1]) + (s0[2] + s0[3])) + ((s1[0] + s1[1]) + (s1[2] + s1[3])) + ((s2[0] + s2[1]) + (s2[2] + s2[3])) + ((s3[0] + s3[1]) + (s3[2] + s3[3]));
        const float rstd = 1.0f / sqrtf(ssq * (1.f / DM) + 1e-6f);
        float tv0[16], tv1[16], cv[16];
#pragma unroll
        for (int p = 0; p < 2; ++p) {
            bf16x8 af[2][2][4];
#pragma unroll
            for (int hs = 0; hs < 2; ++hs)
#pragma unroll
                for (int mt = 0; mt < 2; ++mt) { const bf16* qp = Q + (size_t)(t0 + mt * 16 + fr) * 2048 + (hp + 4 * hs) * 256 + p * 128 + fq * 8;
#pragma unroll
                    for (int ks = 0; ks < 4; ++ks) af[hs][mt][ks] = *(const bf16x8*)(qp + ks * 32); }
            float tv[16];
#pragma unroll
            for (int i = 0; i < 16; ++i) tv[i] = -3.0e38f;
            for (int half = 0; half < 2; ++half) {
                topk_scores64(Q, KB, SC, t0, hp, p, half, lane, af);
                LDS_WAIT();
                const LAS float* mine = SC + lane * TK_STRIDE;
#pragma unroll 2
                for (int n = 0; n < 64; n += 4) { const f32x4 x4 = *(const LAS f32x4*)(mine + n);
#pragma unroll
                    for (int e = 0; e < 4; ++e) tk_insert(tv, __uint_as_float((__float_as_uint(x4[e]) & 0xFFFFFF80u) | (unsigned)(half * 64 + n + e))); }
                LDS_WAIT();
            }
#pragma unroll
            for (int i = 0; i < 16; ++i) { if (p == 0) tv0[i] = tv[i]; else tv1[i] = tv[i]; }
        }
        LAS int* li = (LAS int*)SC + lane * 33;
#pragma unroll
        for (int q = 0; q < 16; ++q) { li[q] = (int)(__float_as_uint(tv0[q]) & 127u); li[16 + q] = (int)(__float_as_uint(tv1[q]) & 127u);
            tv0[q] = __uint_as_float(__float_as_uint(tv0[q]) & 0xFFFFFF80u); tv1[q] = __uint_as_float(__float_as_uint(tv1[q]) & 0xFFFFFF80u); }
#pragma unroll
        for (int q = 0; q < 16; ++q) cv[q] = -3.0e38f;
#pragma unroll
        for (int a = 0; a < 16; ++a)
#pragma unroll
            for (int b = 0; b < 16; ++b) if ((a + 1) * (b + 1) <= 16)
                tk_insert(cv, __uint_as_float((__float_as_uint(tv0[a] + tv1[b]) & 0xFFFFFF00u) | (unsigned)(a * 16 + b)));
        LDS_WAIT();
        float e[16], den = 0.f; unsigned ci[16];
        const float c0 = __uint_as_float(__float_as_uint(cv[0]) & 0xFFFFFF00u);
#pragma unroll
        for (int q = 0; q < 16; ++q) { const unsigned kb = __float_as_uint(cv[q]); const float cq = __uint_as_float(kb & 0xFFFFFF00u);
            e[q] = __expf((cq - c0) * rstd); den += e[q]; ci[q] = (unsigned)(li[(kb >> 4) & 15] * 128 + li[16 + (kb & 15)]); }
        const float inv = 1.0f / den;
        LDS_WAIT();
        {
            const size_t tok = (size_t)(t0 + tokl);
            v4u w0, w1; w0.x = ci[0] | (ci[1] << 16); w0.y = ci[2] | (ci[3] << 16); w0.z = ci[4] | (ci[5] << 16); w0.w = ci[6] | (ci[7] << 16);
            w1.x = ci[8] | (ci[9] << 16); w1.y = ci[10] | (ci[11] << 16); w1.z = ci[12] | (ci[13] << 16); w1.w = ci[14] | (ci[15] << 16);
            *(v4u*)(EIDX + tok * 128 + h * 16) = w0; *(v4u*)(EIDX + tok * 128 + h * 16 + 8) = w1;
#pragma unroll
            for (int q = 0; q < 4; ++q) *(f32x4*)(GATE + tok * 128 + h * 16 + 4 * q) = (f32x4){e[4 * q] * inv, e[4 * q + 1] * inv, e[4 * q + 2] * inv, e[4 * q + 3] * inv};
            if (h == 0) RSTD[tok] = rstd;
        }
    }
}

constexpr int PEER_ITEM = 40, NITEM128 = NTOK / PEER_ITEM;
__device__ __forceinline__ bool peer_next_item(gu32* qbase, int xcc, int& qs, int& slice, int& item, LAS unsigned char* lds, int tid) {
    LAS int* box = (LAS int*)(lds + LDSCTL_OFF + 64);
    for (;;) {
        if (qs >= 8) return false;
        slice = (xcc + qs) & 7;
        if (tid == 0) box[0] = (int)__hip_atomic_fetch_add((unsigned*)(qbase + 64 * slice), 1u, RLX_AGENT);
        __syncthreads();
        item = box[0];
        __syncthreads();
        if (item < NITEM128) return true;
        ++qs;
    }
}

__device__ __forceinline__ void peer_u_phase(const Args& A, LAS unsigned char* lds, int tid, int lane, int wave, gu32* ctl, int qoff) {
    const unsigned char* Uq = A.ws + WS_UB; const bf16* XG = (const bf16*)(A.ws + WS_A1);
    const unsigned short* EIDX = (const unsigned short*)(A.ws + WS_EIDX); float* PART = (float*)(A.ws + WS_PART);
    const int xcc = (int)(xb_xcc_id() & 7u), rg = lane >> 3, c8 = lane & 7;
    LAS int* we = (LAS int*)(lds + wave * 1024);
    int qs = 0, slice, item;
    while (peer_next_item(ctl + CW_QU + qoff, xcc, qs, slice, item, lds, tid)) {
        const unsigned char* us = Uq + (size_t)slice * 16384 * 128 + c8 * 16;
        size_t tok = (size_t)(item * PEER_ITEM + wave);
        unsigned pair = *(const unsigned*)(EIDX + tok * 128 + 2 * lane);
        v4u xa = *(const v4u*)(XG + tok * DM + slice * 128 + c8 * 16), xb = *(const v4u*)(XG + tok * DM + slice * 128 + c8 * 16 + 8);
        for (int tt = 0; tt < PEER_ITEM / NWAVES; ++tt) {
            we[2 * lane] = (int)(pair & 0xffffu); we[2 * lane + 1] = (int)(pair >> 16);
            const f32x2 x[8] = {(f32x2){bf_lo(xa.x), bf_hi(xa.x)}, (f32x2){bf_lo(xa.y), bf_hi(xa.y)}, (f32x2){bf_lo(xa.z), bf_hi(xa.z)}, (f32x2){bf_lo(xa.w), bf_hi(xa.w)},
                                (f32x2){bf_lo(xb.x), bf_hi(xb.x)}, (f32x2){bf_lo(xb.y), bf_hi(xb.y)}, (f32x2){bf_lo(xb.z), bf_hi(xb.z)}, (f32x2){bf_lo(xb.w), bf_hi(xb.w)}};
            LDS_WAIT();
            v4u w[16];
#pragma unroll
            for (int it = 0; it < 16; ++it) w[it] = *(const v4u*)(us + (size_t)we[it * 8 + rg] * 128);
            const size_t ctok = tok;
            if (tt + 1 < PEER_ITEM / NWAVES) { tok += NWAVES; pair = *(const unsigned*)(EIDX + tok * 128 + 2 * lane);
                xa = *(const v4u*)(XG + tok * DM + slice * 128 + c8 * 16); xb = *(const v4u*)(XG + tok * DM + slice * 128 + c8 * 16 + 8); }
            float dlo = 0.f, dhi = 0.f;
#pragma unroll
            for (int it = 0; it < 16; ++it) {
                f32x2 d = __builtin_amdgcn_cvt_pk_f32_fp8(w[it].x, false) * x[0]; d += __builtin_amdgcn_cvt_pk_f32_fp8(w[it].x, true) * x[1];
                d += __builtin_amdgcn_cvt_pk_f32_fp8(w[it].y, false) * x[2]; d += __builtin_amdgcn_cvt_pk_f32_fp8(w[it].y, true) * x[3];
                d += __builtin_amdgcn_cvt_pk_f32_fp8(w[it].z, false) * x[4]; d += __builtin_amdgcn_cvt_pk_f32_fp8(w[it].z, true) * x[5];
                d += __builtin_amdgcn_cvt_pk_f32_fp8(w[it].w, false) * x[6]; d += __builtin_amdgcn_cvt_pk_f32_fp8(w[it].w, true) * x[7];
                const float ds = sum8(d.x + d.y);
                if ((it & 7) == c8) { if (it < 8) dlo = ds; else dhi = ds; }
            }
            float* pp = PART + (ctok * 8 + slice) * 128;
            pp[c8 * 8 + rg] = dlo; pp[(c8 + 8) * 8 + rg] = dhi;
            LDS_WAIT();
        }
    }
}

__device__ __forceinline__ void peer_coef_phase(const Args& A, int lane, int wave, int vcu, int G) {
    const float* PART = (const float*)(A.ws + WS_PART); const float* GATE = (const float*)(A.ws + WS_GATE); const float* RSTD = (const float*)(A.ws + WS_RSTD);
    float* COEF = (float*)(A.ws + WS_COEF);
    for (int tok = vcu * NWAVES + wave; tok < NTOK; tok += G * NWAVES) {
        const float* pp = PART + (size_t)tok * 1024 + 2 * lane;
        f32x2 d = *(const f32x2*)pp;
#pragma unroll
        for (int j = 1; j < 8; ++j) d += *(const f32x2*)(pp + j * 128);
        const float sc = RSTD[tok] * (1.0f / PEER_SU); const f32x2 gt = *(const f32x2*)(GATE + (size_t)tok * 128 + 2 * lane);
        f32x2 cf; cf.x = gt.x * gelu_tanh(d.x * sc) * (1.0f / PEER_SV); cf.y = gt.y * gelu_tanh(d.y * sc) * (1.0f / PEER_SV);
        *(f32x2*)(COEF + (size_t)tok * 128 + 2 * lane) = cf;
    }
}

__device__ __forceinline__ void peer_v_phase(const Args& A, LAS unsigned char* lds, int tid, int lane, int wave, gu32* ctl) {
    const unsigned char* Vq = A.ws + WS_VB;
    const unsigned short* EIDX = (const unsigned short*)(A.ws + WS_EIDX); const float* COEF = (const float*)(A.ws + WS_COEF);
    float* X1 = A.out + O_Y; float* SS2 = (float*)(A.ws + WS_SS2);
    const int xcc = (int)(xb_xcc_id() & 7u), rg = lane >> 3, c8 = lane & 7;
    LAS int* we = (LAS int*)(lds + wave * 8192);
    LAS float* wc = (LAS float*)(we + 128); LAS float* wp = (LAS float*)(we + 256);
    int qs = 0, slice, item;
    while (peer_next_item(ctl + CW_QV, xcc, qs, slice, item, lds, tid)) {
        const unsigned char* vs = Vq + (size_t)slice * 16384 * 128 + c8 * 16;
        size_t tok = (size_t)(item * PEER_ITEM + wave);
        unsigned pair = *(const unsigned*)(EIDX + tok * 128 + 2 * lane); f32x2 cf = *(const f32x2*)(COEF + tok * 128 + 2 * lane);
        const bf16* XGv = (const bf16*)(A.ws + WS_A1);
        const f32x2 g2v = *(const f32x2*)(A.in[I_N2G] + slice * 128 + 2 * lane); const f32x2 rg2 = (f32x2){1.0f / g2v.x, 1.0f / g2v.y};
        unsigned xold = *(const unsigned*)(XGv + tok * DM + slice * 128 + 2 * lane);
        for (int tt = 0; tt < PEER_ITEM / NWAVES; ++tt) {
            we[2 * lane] = (int)(pair & 0xffffu); we[2 * lane + 1] = (int)(pair >> 16); *(LAS f32x2*)(wc + 2 * lane) = cf;
            const f32x2 xcur = (f32x2){bf_lo(xold) * rg2.x, bf_hi(xold) * rg2.y}; const size_t ctok = tok;
            LDS_WAIT();
            v4u w[16];
#pragma unroll
            for (int it = 0; it < 16; ++it) w[it] = *(const v4u*)(vs + (size_t)we[it * 8 + rg] * 128);
            if (tt + 1 < PEER_ITEM / NWAVES) { tok += NWAVES; pair = *(const unsigned*)(EIDX + tok * 128 + 2 * lane); cf = *(const f32x2*)(COEF + tok * 128 + 2 * lane);
                xold = *(const unsigned*)(XGv + tok * DM + slice * 128 + 2 * lane); }
            f32x2 o[8];
#pragma unroll
            for (int q = 0; q < 8; ++q) o[q] = (f32x2){0.f, 0.f};
#pragma unroll
            for (int it = 0; it < 16; ++it) {
                const float c = wc[it * 8 + rg]; const f32x2 c2 = (f32x2){c, c};
                o[0] += c2 * __builtin_amdgcn_cvt_pk_f32_fp8(w[it].x, false); o[1] += c2 * __builtin_amdgcn_cvt_pk_f32_fp8(w[it].x, true);
                o[2] += c2 * __builtin_amdgcn_cvt_pk_f32_fp8(w[it].y, false); o[3] += c2 * __builtin_amdgcn_cvt_pk_f32_fp8(w[it].y, true);
                o[4] += c2 * __builtin_amdgcn_cvt_pk_f32_fp8(w[it].z, false); o[5] += c2 * __builtin_amdgcn_cvt_pk_f32_fp8(w[it].z, true);
                o[6] += c2 * __builtin_amdgcn_cvt_pk_f32_fp8(w[it].w, false); o[7] += c2 * __builtin_amdgcn_cvt_pk_f32_fp8(w[it].w, true);
            }
#pragma unroll
            for (int q = 0; q < 4; ++q) *(LAS f32x4*)(wp + rg * 128 + c8 * 16 + 4 * q) = (f32x4){o[2 * q].x, o[2 * q].y, o[2 * q + 1].x, o[2 * q + 1].y};
            LDS_WAIT();
            f32x2 acc = *(const LAS f32x2*)(wp + 2 * lane);
#pragma unroll
            for (int r = 1; r < 8; ++r) acc += *(const LAS f32x2*)(wp + r * 128 + 2 * lane);
            const f32x2 x2 = xcur + acc;
            *(f32x2*)(X1 + ctok * DM + slice * 128 + 2 * lane) = x2;
            float ss = sum16(x2.x * x2.x + x2.y * x2.y); ss += __shfl_xor(ss, 16); ss += __shfl_xor(ss, 32);
            if (lane == 0) SS2[ctok * 8 + slice] = ss;
            LDS_WAIT();
        }
    }
}

__device__ __forceinline__ void peer_final_phase(const Args& A, int lane, int wave, int vcu, int G) {
    float* X1 = A.out + O_Y; const float* SS2 = (const float*)(A.ws + WS_SS2); const float* gf = A.in[I_NFG] + lane * 16;
    const f32x4 g0 = *(const f32x4*)gf, g1 = *(const f32x4*)(gf + 4), g2 = *(const f32x4*)(gf + 8), g3 = *(const f32x4*)(gf + 12);
    for (int tok = vcu * NWAVES + wave; tok < NTOK; tok += G * NWAVES) {
        const f32x4 sa = *(const f32x4*)(SS2 + (size_t)tok * 8), sb = *(const f32x4*)(SS2 + (size_t)tok * 8 + 4);
        const float ss = ((sa[0] + sa[1]) + (sa[2] + sa[3])) + ((sb[0] + sb[1]) + (sb[2] + sb[3]));
        const float rf = 1.0f / sqrtf(ss * (1.f / DM) + 1e-6f);
        float* yr = X1 + (size_t)tok * DM + lane * 16;
        const f32x4 y0 = *(const f32x4*)yr, y1 = *(const f32x4*)(yr + 4), y2 = *(const f32x4*)(yr + 8), y3 = *(const f32x4*)(yr + 12);
        *(f32x4*)yr = y0 * rf * g0; *(f32x4*)(yr + 4) = y1 * rf * g1; *(f32x4*)(yr + 8) = y2 * rf * g2; *(f32x4*)(yr + 12) = y3 * rf * g3;
    }
}

__global__ void __launch_bounds__(NTHR, 2) mk_fwd(Args args) {
    extern __shared__ __attribute__((aligned(16))) unsigned char lds_raw[];
    LAS unsigned char* lds = (LAS unsigned char*)lds_raw;
    const int tid = threadIdx.x, lane = tid & 63, wave = __builtin_amdgcn_readfirstlane(tid >> 6);
    const int G = gridDim.x; const int bx = blockIdx.x; const int vcu = (G % 8 == 0) ? (bx % 8) * (G / 8) + bx / 8 : bx;
    gu32* ctl = (gu32*)(args.ws + WS_CTL);
    volatile LAS unsigned* MISC = (volatile LAS unsigned*)(lds + MISC_OFF);
    for (int u = tid; u < (LDS_BYTES - LDSCTL_OFF) / 4; u += NTHR) ((LAS unsigned*)(lds + LDSCTL_OFF))[u] = 0u;
    __syncthreads();
    XcdBarrier bar; bar.bar = (unsigned*)(ctl + CW_BAR) + args.li * XCD_BAR_WORDS; bar.x = 0; bar.st = nullptr;
    if (N_LAUNCHES != PER_PHASE) bar = xcd_barrier_post((unsigned*)(ctl + CW_BAR) + args.li * XCD_BAR_WORDS, MISC + 8);
    const int lo = args.ph_lo, hi = args.ph_hi;
#define IN(k) (lo <= (k) && (k) < hi)
#define BOTH(k) (IN(k) && IN((k) + 1))
#define GRID_BAR() do { if (N_LAUNCHES != PER_PHASE) xcd_barrier(bar); } while (0)
    unsigned char* ws = args.ws;
    bf16* A1 = (bf16*)(ws + WS_A1);

    if (IN(0)) for (int rep_ = 0; rep_ < ((MK_REPEAT == 0) ? 2 : 1); ++rep_) { p0_prologue(args, lds, tid, lane, wave, vcu, G); if (BOTH(0)) GRID_BAR(); }

    if (IN(1)) for (int rep_ = 0; rep_ < ((MK_REPEAT == 1) ? 2 : 1); ++rep_) {
        pg8::Gemm g{A1, (const bf16*)(ws + WS_W1T), MPAD, N1, DM}; pg8::StaticOrder S; S.init(MPAD, N1, G, bx);
        pg8::EpiZ E{(bf16*)(ws + WS_ZC), (bf16*)(ws + WS_ZR), (bf16*)(ws + WS_ZG)};
        pg8::gemm_phase<pg8::EpiZ, pg8::StaticOrder, true, true>(lds, g, S, E);
        if (BOTH(1)) GRID_BAR();
    }

    if (IN(2)) for (int rep_ = 0; rep_ < ((MK_REPEAT == 2) ? 2 : 1); ++rep_) { conv_phase(args, vcu * NTHR + tid, G * NTHR); if (BOTH(2)) GRID_BAR(); }

    if (IN(3)) for (int rep_ = 0; rep_ < ((MK_REPEAT == 3) ? 2 : 1); ++rep_) {
        scan_pass1(args, lds, tid, lane, wave, vcu, G);
        if (BOTH(3)) GRID_BAR();
    }

    if (IN(4)) {
        for (int u = vcu; u < 512; u += G) {
            if (u < 256) { const int bh = u >> 2, vq = u & 3; scan_pass2_rows(nullptr, bh * 64, 64, vq * 16, args.out + O_WKV_P + (size_t)bh * 4096, true, args, lds, tid, lane, wave); }
            else { const int bh = u - 256;
                for (int vq = 0; vq < 4; ++vq) scan_pass2_rows(args.in[I_SWKV] + (size_t)bh * 4096, NUNITS_P + bh, 1, vq * 16, args.out + O_WKV_S + (size_t)bh * 4096, false, args, lds, tid, lane, wave); }
        }
        if (BOTH(4)) GRID_BAR();
    }

    if (IN(5)) for (int rep_ = 0; rep_ < ((MK_REPEAT == 5) ? 2 : 1); ++rep_) {
        for (int u2 = vcu; u2 < NUNITS / 2; u2 += G) scan_pass3_wave(args, u2 * 2 + (wave >> 2), wave & 3, lane);
        if (BOTH(5)) GRID_BAR();
    }

    if (IN(6)) {
        { pg8::Gemm g{A1, (const bf16*)(ws + WS_WPA), NTOK, DM, 512}; pg8::StaticOrder S; S.init(NTOK, DM, G, bx);
          pg8::EpiGate<0> E{(const bf16*)(ws + WS_ZG), (bf16*)(ws + WS_ZR)};
          pg8::gemm_phase<pg8::EpiGate<0>, pg8::StaticOrder, true, true>(lds, g, S, E); }
        { pg8::Gemm g{A1 + (size_t)MPAD * 512, (const bf16*)(ws + WS_WPB), NTOK, DM, 512}; pg8::StaticOrder S; S.init(NTOK, DM, G, bx);
          pg8::EpiGate<1> E{(const bf16*)(ws + WS_ZG), (bf16*)(ws + WS_ZR)};
          pg8::gemm_phase<pg8::EpiGate<1>, pg8::StaticOrder, true, true>(lds, g, S, E); }
        if (BOTH(6)) GRID_BAR();
    }

    if (IN(7)) for (int rep_ = 0; rep_ < ((MK_REPEAT == 7) ? 2 : 1); ++rep_) {
        pg8::Gemm g{(const bf16*)(ws + WS_ZR), (const bf16*)(ws + WS_WO), NTOK, DM, DM}; pg8::StaticOrder S; S.init(NTOK, DM, G, bx);
        pg8::EpiX1 E{args.in[I_XP], args.in[I_XS], args.out + O_Y, A1, (float*)(ws + WS_SSP), args.in[I_N2G], NPROMPT, NTOK};
        pg8::gemm_phase<pg8::EpiX1, pg8::StaticOrder, true, true>(lds, g, S, E);
        if (BOTH(7)) GRID_BAR();
    }

    if (IN(8)) for (int rep_ = 0; rep_ < ((MK_REPEAT == 8) ? 2 : 1); ++rep_) {
        pg8::Gemm g{A1, (const bf16*)(ws + WS_WQ), NTOK, 2048, DM}; pg8::StaticOrder S; S.init(NTOK, 2048, G, bx);
        pg8::EpiPlain E{(bf16*)(ws + WS_ZG), 2048};
        pg8::gemm_phase<pg8::EpiPlain, pg8::StaticOrder, true, true>(lds, g, S, E);
        if (BOTH(8)) GRID_BAR();
    }

    if (IN(9)) for (int rep_ = 0; rep_ < ((MK_REPEAT == 9) ? 2 : 1); ++rep_) { peer_topk_phase(args, lds, tid, lane, wave, vcu, G); if (BOTH(9)) GRID_BAR(); }
    if (IN(10)) for (int rep_ = 0; rep_ < ((MK_REPEAT == 10) ? 2 : 1); ++rep_) { peer_u_phase(args, lds, tid, lane, wave, ctl, rep_ * 1024); if (BOTH(10)) GRID_BAR(); }
    if (IN(11)) { peer_coef_phase(args, lane, wave, vcu, G); if (BOTH(11)) GRID_BAR(); }
    if (IN(12)) { peer_v_phase(args, lds, tid, lane, wave, ctl); if (BOTH(12)) GRID_BAR(); }
    if (IN(13)) peer_final_phase(args, lane, wave, vcu, G);
#undef IN
#undef BOTH
#undef GRID_BAR
}

extern "C" void kernel_launch(void* const* d_in, const int* in_sizes, int n_in, void* d_out, int out_size, void* d_ws, size_t ws_size, hipStream_t stream) {
    static int grid = 0;
    if (grid == 0) {
        if (n_in != 32 || ws_size < WS_END) { fprintf(stderr, "kernel_launch: built for 32 inputs and >= %zu bytes of workspace; got n_in %d ws %zu; nothing launched\n", (size_t)WS_END, n_in, ws_size); grid = -1; return; }
        int dev = 0, cus = 0, per_cu = 0;
        if (hipGetDevice(&dev) != hipSuccess || hipDeviceGetAttribute(&cus, hipDeviceAttributeMultiprocessorCount, dev) != hipSuccess) { fprintf(stderr, "kernel_launch: device query failed\n"); grid = -1; return; }
        if (hipFuncSetAttribute((const void*)mk_fwd, hipFuncAttributeMaxDynamicSharedMemorySize, LDS_BYTES) != hipSuccess) { fprintf(stderr, "kernel_launch: hipFuncSetAttribute failed\n"); grid = -1; return; }
        if (hipOccupancyMaxActiveBlocksPerMultiprocessor(&per_cu, (const void*)mk_fwd, NTHR, LDS_BYTES) != hipSuccess || per_cu < 1)
            fprintf(stderr, "kernel_launch: note: occupancy query reports %d workgroups per CU\n", per_cu);
        (void)hipGetLastError();
        grid = cus;
    }
    if (grid < 0) return;
    if (hipMemsetAsync((char*)d_ws + WS_CTL, 0, CTL_ZERO_BYTES, stream) != hipSuccess) { fprintf(stderr, "kernel_launch: hipMemsetAsync failed\n"); return; }
    Args a{};
    for (int i = 0; i < 32; ++i) a.in[i] = (const float*)d_in[i];
    a.out = (float*)d_out; a.ws = (unsigned char*)d_ws;
    constexpr int NL = (N_LAUNCHES == PER_PHASE ? PER_PHASE : 1) + ((MK_EXTRA_LO >= 0) ? 1 : 0);
    for (int li = 0; li < NL; ++li) {
        if (N_LAUNCHES == PER_PHASE) { a.ph_lo = li; a.ph_hi = li + 1; } else { a.ph_lo = 0; a.ph_hi = PER_PHASE; }
        if (MK_EXTRA_LO >= 0 && li == NL - 1) { a.ph_lo = MK_EXTRA_LO; a.ph_hi = MK_EXTRA_HI; }
        a.li = li;
        hipLaunchKernelGGL(mk_fwd, dim3(grid), dim3(NTHR), LDS_BYTES, stream, a);
        const hipError_t le = hipPeekAtLastError();
        if (le != hipSuccess) { fprintf(stderr, "kernel_launch: launch %d failed: %s\n", li, hipGetErrorName(le)); break; }
    }
}
```

```cpp
#include <hip/hip_runtime.h>
#include <cstdio>
#include <cstdint>
#define MK_N_LAUNCHES 1
#define MK_REPEAT -1
#define MK_DBGSEL 0
#define MK_EXTRA_LO -1
#define MK_EXTRA_HI -1
namespace pg8 {
#define PG8_LAS __attribute__((address_space(3)))
typedef unsigned short bf16_t;
typedef short bf16x8 __attribute__((ext_vector_type(8)));
typedef float f32x4 __attribute__((ext_vector_type(4)));
typedef unsigned u32x4 __attribute__((ext_vector_type(4)));
constexpr int BM = 256, BK = 64, HALF = 128, HTB = HALF * BK * 2  , STAGE_BYTES = 8 * HTB, NXCD = 8, WGM = 8;

__host__ __device__ __forceinline__ int lds_byte(int r, int c) { const int st = (r >> 4) * 2 + (c >> 5), rr = r & 15, cc = c & 31, ob = rr * 64 + cc * 2; return st * 1024 + (ob ^ (((ob >> 9) & 1) << 5)); }
__host__ __device__ __forceinline__ void stage_rc(int b, int& R, int& C) { const int st = b / 1024, sb = b % 1024, swz = sb ^ (((sb >> 9) & 1) << 5); R = (st >> 1) * 16 + swz / 64; C = (st & 1) * 32 + (swz % 64) / 2; }
__host__ __device__ __forceinline__ int perm32(int rho) { const int n = rho >> 4, i = rho & 15; return 8 * (i >> 2) + 4 * n + (i & 3); }

struct Unit { int pm, pn; };
struct Gemm { const bf16_t* A; const bf16_t* Bt; int M, N, K; };

struct StaticOrder {
    int nM, nN, nwg, G, c;
    __host__ __device__ void init(int M, int N, int G_, int c_) { nM = M / BM; nN = N / BM; nwg = nM * nN; G = G_; c = c_; }
    __host__ __device__ bool next(int i, Unit& u) const {
        const long L = (long)i * G + c; if (L >= nwg) return false;
        int wgid = (int)L; { const int q = nwg / NXCD, r = nwg % NXCD, xcd = wgid % NXCD, off = wgid / NXCD; wgid = (xcd < r ? xcd * (q + 1) : r * (q + 1) + (xcd - r) * q) + off; }
        const int nig = WGM * nN, gid = wgid / nig, fm = gid * WGM, gsz = (nM - fm) < WGM ? (nM - fm) : WGM;
        u.pm = fm + ((wgid % nig) % gsz); u.pn = (wgid % nig) / gsz; return true;
    }
    __device__ __forceinline__ void a_ready(const Unit&) const {}
    __device__ __forceinline__ void done(const Unit&) const {}
};

typedef __bf16 bf16x2_cv __attribute__((ext_vector_type(2))); typedef float f32x2_cv __attribute__((ext_vector_type(2)));
__device__ __forceinline__ unsigned cvt_pk_bf16(float lo, float hi) { return __builtin_bit_cast(unsigned, __builtin_convertvector((f32x2_cv){lo, hi}, bf16x2_cv)); }
__device__ __forceinline__ float bf_lo(unsigned w) { return __uint_as_float(w << 16); }
__device__ __forceinline__ float bf_hi(unsigned w) { return __uint_as_float(w & 0xffff0000u); }
__device__ __forceinline__ float sigm(float x) { return __builtin_amdgcn_rcpf(1.0f + __expf(-x)); }

struct EpiZ {
    static constexpr bool PERM = true, AFTER_DRAIN = false;
    bf16_t *Zc, *Zr, *Zg;
    __device__ __forceinline__ void operator()(const f32x4 (&acc)[2][2][4][2], const Unit& u, int wr, int wc, int fr, int fq) const {
        bf16_t* base; int ldc, colt;
        if (u.pn < 6) { base = Zc; ldc = 1536; colt = u.pn * BM; }
        else if (u.pn < 14) { base = Zr; ldc = 2048; colt = (u.pn - 6) * BM; }
        else { base = Zg; ldc = 2048; colt = (u.pn - 14) * BM; }
        const int row0 = u.pm * BM + wr * 64 + fr, col0 = colt + wc * 32 + 8 * fq;
#pragma unroll
        for (int ai = 0; ai < 2; ++ai)
#pragma unroll
            for (int m = 0; m < 4; ++m) { bf16_t* rowp = base + (size_t)(row0 + ai * HALF + m * 16) * ldc + col0;
#pragma unroll
                for (int bj = 0; bj < 2; ++bj) { const f32x4 v0 = acc[ai][bj][m][0], v1 = acc[ai][bj][m][1];
                    u32x4 w; w.x = cvt_pk_bf16(v0[0], v0[1]); w.y = cvt_pk_bf16(v0[2], v0[3]); w.z = cvt_pk_bf16(v1[0], v1[1]); w.w = cvt_pk_bf16(v1[2], v1[3]);
                    *(u32x4*)(rowp + bj * HALF) = w; } }
    }
};
struct EpiPlain {
    static constexpr bool PERM = true, AFTER_DRAIN = false;
    bf16_t* O; int ldc;
    __device__ __forceinline__ void operator()(const f32x4 (&acc)[2][2][4][2], const Unit& u, int wr, int wc, int fr, int fq) const {
        const int row0 = u.pm * BM + wr * 64 + fr, col0 = u.pn * BM + wc * 32 + 8 * fq;
#pragma unroll
        for (int ai = 0; ai < 2; ++ai)
#pragma unroll
            for (int m = 0; m < 4; ++m) { bf16_t* rowp = O + (size_t)(row0 + ai * HALF + m * 16) * ldc + col0;
#pragma unroll
                for (int bj = 0; bj < 2; ++bj) { const f32x4 v0 = acc[ai][bj][m][0], v1 = acc[ai][bj][m][1];
                    u32x4 w; w.x = cvt_pk_bf16(v0[0], v0[1]); w.y = cvt_pk_bf16(v0[2], v0[3]); w.z = cvt_pk_bf16(v1[0], v1[1]); w.w = cvt_pk_bf16(v1[2], v1[3]);
                    *(u32x4*)(rowp + bj * HALF) = w; } }
    }
};
template <int SECOND> struct EpiGate {
    static constexpr bool PERM = true, AFTER_DRAIN = false;
    const bf16_t* Zg; bf16_t* MG;
    __device__ __forceinline__ void operator()(const f32x4 (&acc)[2][2][4][2], const Unit& u, int wr, int wc, int fr, int fq) const {
        const int row0 = u.pm * BM + wr * 64 + fr, col0 = u.pn * BM + wc * 32 + 8 * fq;
#pragma unroll
        for (int ai = 0; ai < 2; ++ai) {
            u32x4 gw[4][2], pw[4][2];
#pragma unroll
            for (int m = 0; m < 4; ++m) { const int r = row0 + ai * HALF + m * 16;
#pragma unroll
                for (int bj = 0; bj < 2; ++bj) { gw[m][bj] = *(const u32x4*)(Zg + (size_t)r * 2048 + SECOND * 1024 + col0 + bj * HALF);
                    if (SECOND) pw[m][bj] = *(const u32x4*)(MG + (size_t)r * 1024 + col0 + bj * HALF); } }
#pragma unroll
            for (int m = 0; m < 4; ++m) { const int r = row0 + ai * HALF + m * 16; bf16_t* op = MG + (size_t)r * 1024 + col0;
#pragma unroll
                for (int bj = 0; bj < 2; ++bj) { const u32x4 g = gw[m][bj]; f32x4 v0 = acc[ai][bj][m][0], v1 = acc[ai][bj][m][1];
                    v0[0] *= sigm(bf_lo(g.x)); v0[1] *= sigm(bf_hi(g.x)); v0[2] *= sigm(bf_lo(g.y)); v0[3] *= sigm(bf_hi(g.y));
                    v1[0] *= sigm(bf_lo(g.z)); v1[1] *= sigm(bf_hi(g.z)); v1[2] *= sigm(bf_lo(g.w)); v1[3] *= sigm(bf_hi(g.w));
                    if (SECOND) { const u32x4 p = pw[m][bj];
                        v0[0] += bf_lo(p.x); v0[1] += bf_hi(p.x); v0[2] += bf_lo(p.y); v0[3] += bf_hi(p.y);
                        v1[0] += bf_lo(p.z); v1[1] += bf_hi(p.z); v1[2] += bf_lo(p.w); v1[3] += bf_hi(p.w); }
                    u32x4 w; w.x = cvt_pk_bf16(v0[0], v0[1]); w.y = cvt_pk_bf16(v0[2], v0[3]); w.z = cvt_pk_bf16(v1[0], v1[1]); w.w = cvt_pk_bf16(v1[2], v1[3]);
                    *(u32x4*)(op + bj * HALF) = w; } }
        }
    }
};
struct EpiX1 {
    static constexpr bool PERM = false, AFTER_DRAIN = false;
    const float* xp; const float* xs; float* X1; bf16_t* X1B; float* SSP; const float* g2; int nprompt, nrows;
    __device__ __forceinline__ void operator()(const f32x4 (&acc)[2][2][4][2], const Unit& u, int wr, int wc, int fr, int fq) const {
        typedef unsigned u32x2v __attribute__((ext_vector_type(2)));
        const int col0 = u.pn * BM + wc * 32 + 4 * fq;
        f32x4 gq[2][2];
#pragma unroll
        for (int bj = 0; bj < 2; ++bj)
#pragma unroll
            for (int n = 0; n < 2; ++n) gq[bj][n] = *(const f32x4*)(g2 + col0 + bj * HALF + n * 16);
#pragma unroll
        for (int ai = 0; ai < 2; ++ai) {
            f32x4 xv[4][2][2];
#pragma unroll
            for (int m = 0; m < 4; ++m) { int r = u.pm * BM + ai * HALF + wr * 64 + m * 16 + fr; r = r < nrows ? r : nrows - 1;
                const float* xr = r < nprompt ? xp + (size_t)r * 1024 : xs + (size_t)(r - nprompt) * 1024;
#pragma unroll
                for (int bj = 0; bj < 2; ++bj)
#pragma unroll
                    for (int n = 0; n < 2; ++n) xv[m][bj][n] = *(const f32x4*)(xr + col0 + bj * HALF + n * 16); }
#pragma unroll
            for (int m = 0; m < 4; ++m) { const int r = u.pm * BM + ai * HALF + wr * 64 + m * 16 + fr; float ss = 0.f;
#pragma unroll
                for (int bj = 0; bj < 2; ++bj)
#pragma unroll
                    for (int n = 0; n < 2; ++n) { const int c = col0 + bj * HALF + n * 16; const f32x4 o = xv[m][bj][n] + acc[ai][bj][m][n];
                        ss += (o[0] * o[0] + o[1] * o[1]) + (o[2] * o[2] + o[3] * o[3]);
                        const f32x4 q = gq[bj][n]; u32x2v w; w.x = cvt_pk_bf16(o[0] * q[0], o[1] * q[1]); w.y = cvt_pk_bf16(o[2] * q[2], o[3] * q[3]);
                        if (r < nrows) *(u32x2v*)(X1B + (size_t)r * 1024 + c) = w; }
                ss += __shfl_xor(ss, 16); ss += __shfl_xor(ss, 32);
                if (fq == 0 && r < nrows) SSP[(size_t)r * 16 + u.pn * 4 + wc] = ss;
            }
        }
    }
};
template <class Epi, class Sched, bool ALIGN_EPI = false, bool SP2 = false>
__device__ __forceinline__ void gemm_phase(PG8_LAS unsigned char* lds, const Gemm g, const Sched& S, const Epi& E) {
    const int tid = threadIdx.x, wid = __builtin_amdgcn_readfirstlane(tid >> 6), lane = tid & 63, wr = wid >> 2, wc = wid & 3, fr = lane & 15, fq = lane >> 4;
    const int K = g.K, nt = K / BK;
    unsigned voffA[2], voffB[2];
#pragma unroll
    for (int i = 0; i < 2; ++i) { int R, C; stage_rc(tid * 16 + i * 8192, R, C); const int Rb = Epi::PERM ? ((R & ~31) + perm32(R & 31)) : R;
        voffA[i] = (unsigned)(R * K + C) * 2u; voffB[i] = (unsigned)(Rb * K + C) * 2u; }
    const size_t kstep = (size_t)(BK * 2);
    const size_t hstep = (size_t)HALF * K * 2;
    const size_t tstep = 2 * hstep;
    const unsigned ldsw = (unsigned)wid * 1024u;
    const int aoff = lds_byte(wr * 64 + fr, fq * 8), boff = lds_byte(wc * 32 + fr, fq * 8);
#define PG8_SA(b, h) (((b) * 2 + (h)) * HTB)
#define PG8_SB(b, h) ((4 + (b) * 2 + (h)) * HTB)
#define PG8_STAGE(bufoff, gbase, voff) do { _Pragma("unroll") for (int _i = 0; _i < 2; ++_i) \
        __builtin_amdgcn_global_load_lds((const unsigned*)((const char*)(gbase) + (voff)[_i]), (PG8_LAS unsigned*)(lds + (bufoff) + ldsw + _i * 8192), 16, 0, 0); } while (0)
#define PG8_LDA(dst, b, h) do { _Pragma("unroll") for (int m = 0; m < 4; ++m) _Pragma("unroll") for (int k = 0; k < 2; ++k) dst[m][k] = *(const PG8_LAS bf16x8*)(lds + PG8_SA(b, h) + aoff + m * 2048 + k * 1024); } while (0)
#define PG8_LDB(dst, b, h) do { _Pragma("unroll") for (int n = 0; n < 2; ++n) _Pragma("unroll") for (int k = 0; k < 2; ++k) dst[n][k] = *(const PG8_LAS bf16x8*)(lds + PG8_SB(b, h) + boff + n * 2048 + k * 1024); } while (0)
#define PG8_MMA(ai, bj, At, Bt) do { __builtin_amdgcn_s_setprio(1); _Pragma("unroll") for (int m = 0; m < 4; ++m) _Pragma("unroll") for (int n = 0; n < 2; ++n) _Pragma("unroll") for (int k = 0; k < 2; ++k) \
        acc[ai][bj][m][n] = __builtin_amdgcn_mfma_f32_16x16x32_bf16(Bt[n][k], At[m][k], acc[ai][bj][m][n], 0, 0, 0); __builtin_amdgcn_s_setprio(0); } while (0)
#define PG8_WAIT_V(n) asm volatile("s_waitcnt vmcnt(" #n ")" ::: "memory")
#define PG8_WAIT_L(n) asm volatile("s_waitcnt lgkmcnt(" #n ")" ::: "memory")
#define PG8_BAR __builtin_amdgcn_s_barrier()
#define PG8_SCHED __builtin_amdgcn_sched_barrier(0)
    Unit cur, nxt; int ui = 0;
    if (!S.next(0, cur)) return;
    f32x4 acc[2][2][4][2];
#pragma unroll
    for (int a = 0; a < 2; ++a)
#pragma unroll
        for (int b = 0; b < 2; ++b)
#pragma unroll
            for (int m = 0; m < 4; ++m)
#pragma unroll
                for (int n = 0; n < 2; ++n) acc[a][b][m][n] = (f32x4){0.f, 0.f, 0.f, 0.f};
    bf16x8 At[4][2], B0[2][2], B1[2][2];
    const char* cA = (const char*)g.A + (size_t)cur.pm * tstep; const char* cB = (const char*)g.Bt + (size_t)cur.pn * tstep;
    S.a_ready(cur);
    if constexpr (SP2) {
        PG8_STAGE(PG8_SB(0, 0), cB, voffB); PG8_STAGE(PG8_SB(0, 1), cB + hstep, voffB); PG8_STAGE(PG8_SA(0, 0), cA, voffA); PG8_STAGE(PG8_SA(0, 1), cA + hstep, voffA);
        if (wr == 1) PG8_BAR;
        PG8_WAIT_V(2); PG8_BAR;
        PG8_STAGE(PG8_SB(1, 0), cB + kstep, voffB); PG8_STAGE(PG8_SA(1, 0), cA + kstep, voffA); PG8_STAGE(PG8_SB(1, 1), cB + hstep + kstep, voffB);
        PG8_WAIT_V(6); PG8_BAR;
    } else {
        PG8_STAGE(PG8_SB(0, 0), cB, voffB); PG8_STAGE(PG8_SA(0, 0), cA, voffA); PG8_STAGE(PG8_SB(0, 1), cB + hstep, voffB); PG8_STAGE(PG8_SA(0, 1), cA + hstep, voffA);
        if (wr == 1) PG8_BAR;
        PG8_WAIT_V(4); PG8_BAR;
        PG8_STAGE(PG8_SB(1, 0), cB + kstep, voffB); PG8_STAGE(PG8_SA(1, 0), cA + kstep, voffA); PG8_STAGE(PG8_SB(1, 1), cB + hstep + kstep, voffB);
        PG8_WAIT_V(6); PG8_BAR;
    }
    for (;;) {
        const bool has_next = S.next(ui + 1, nxt);
        const char* nA = has_next ? (const char*)g.A + (size_t)nxt.pm * tstep : cA; const char* nB = has_next ? (const char*)g.Bt + (size_t)nxt.pn * tstep : cB;
        for (int t = 0; t < nt; t += 2) {
            const bool last = (t == nt - 2);
            const char* a1 = cA + (size_t)(t + 1) * kstep;
            const char* a2 = last ? nA : cA + (size_t)(t + 2) * kstep; const char* b2 = last ? nB : cB + (size_t)(t + 2) * kstep;
            const char* a3 = a2 + kstep; const char* b3 = b2 + kstep;
            if (last && has_next) S.a_ready(nxt);
            if constexpr (SP2) {
            PG8_LDB(B0, 0, 0); PG8_LDB(B1, 0, 1); PG8_SCHED; PG8_LDA(At, 0, 0); PG8_STAGE(PG8_SA(1, 1), a1 + hstep, voffA);
            PG8_WAIT_V(8); PG8_WAIT_L(0); PG8_BAR; PG8_MMA(0, 0, At, B0); PG8_MMA(0, 1, At, B1); PG8_BAR; PG8_SCHED;
            PG8_LDA(At, 0, 1); PG8_STAGE(PG8_SB(0, 0), b2, voffB); PG8_STAGE(PG8_SB(0, 1), b2 + hstep, voffB); PG8_STAGE(PG8_SA(0, 0), a2, voffA);
            PG8_WAIT_V(8); PG8_WAIT_L(0); PG8_BAR; PG8_MMA(1, 0, At, B0); PG8_MMA(1, 1, At, B1); PG8_BAR; PG8_SCHED;
            PG8_LDB(B0, 1, 0); PG8_LDB(B1, 1, 1); PG8_SCHED; PG8_LDA(At, 1, 0); PG8_STAGE(PG8_SA(0, 1), a2 + hstep, voffA);
            PG8_WAIT_V(8); PG8_WAIT_L(0); PG8_BAR; PG8_MMA(0, 0, At, B0); PG8_MMA(0, 1, At, B1); PG8_BAR; PG8_SCHED;
            PG8_LDA(At, 1, 1); PG8_STAGE(PG8_SB(1, 0), b3, voffB); PG8_STAGE(PG8_SB(1, 1), b3 + hstep, voffB); PG8_STAGE(PG8_SA(1, 0), a3, voffA);
            PG8_WAIT_V(8); PG8_WAIT_L(0); PG8_BAR; PG8_MMA(1, 0, At, B0); PG8_MMA(1, 1, At, B1); PG8_BAR; PG8_SCHED;
            } else {
            PG8_LDB(B0, 0, 0); PG8_SCHED; PG8_LDA(At, 0, 0); PG8_STAGE(PG8_SA(1, 1), a1 + hstep, voffA);
            PG8_WAIT_L(8); PG8_BAR; PG8_WAIT_L(0); PG8_MMA(0, 0, At, B0); PG8_BAR; PG8_SCHED;
            PG8_LDB(B1, 0, 1); PG8_STAGE(PG8_SB(0, 0), b2, voffB);
            PG8_BAR; PG8_WAIT_L(0); PG8_MMA(0, 1, At, B1); PG8_BAR;
            PG8_LDA(At, 0, 1); PG8_STAGE(PG8_SA(0, 0), a2, voffA);
            PG8_BAR; PG8_WAIT_L(0); PG8_MMA(1, 0, At, B0); PG8_BAR; PG8_SCHED;
            PG8_STAGE(PG8_SB(0, 1), b2 + hstep, voffB);
            PG8_WAIT_V(6); PG8_BAR; PG8_MMA(1, 1, At, B1); PG8_BAR;
            PG8_LDB(B0, 1, 0); PG8_SCHED; PG8_LDA(At, 1, 0); PG8_STAGE(PG8_SA(0, 1), a2 + hstep, voffA);
            PG8_WAIT_L(8); PG8_BAR; PG8_WAIT_L(0); PG8_MMA(0, 0, At, B0); PG8_BAR; PG8_SCHED;
            PG8_LDB(B1, 1, 1); PG8_STAGE(PG8_SB(1, 0), b3, voffB);
            PG8_BAR; PG8_WAIT_L(0); PG8_MMA(0, 1, At, B1); PG8_BAR;
            PG8_LDA(At, 1, 1); PG8_STAGE(PG8_SA(1, 0), a3, voffA);
            PG8_BAR; PG8_WAIT_L(0); PG8_MMA(1, 0, At, B0); PG8_BAR; PG8_SCHED;
            PG8_STAGE(PG8_SB(1, 1), b3 + hstep, voffB);
            PG8_WAIT_V(6); PG8_BAR; PG8_MMA(1, 1, At, B1); PG8_BAR;
            }
        }
        if constexpr (ALIGN_EPI) { if (wr == 0) PG8_BAR; }
        if constexpr (!Epi::AFTER_DRAIN) { E(acc, cur, wr, wc, fr, fq); S.done(cur); }
        if (!has_next) break;
#pragma unroll
        for (int a = 0; a < 2; ++a)
#pragma unroll
            for (int b = 0; b < 2; ++b)
#pragma unroll
                for (int m = 0; m < 4; ++m)
#pragma unroll
                    for (int n = 0; n < 2; ++n) acc[a][b][m][n] = (f32x4){0.f, 0.f, 0.f, 0.f};
        cur = nxt; cA = nA; cB = nB; ++ui;
        if constexpr (ALIGN_EPI) { if (wr == 1) PG8_BAR; }
    }
    PG8_WAIT_V(0);
    if constexpr (!ALIGN_EPI) { if (wr == 0) PG8_BAR; }
    PG8_BAR;
    if constexpr (Epi::AFTER_DRAIN) { E.fused(acc, cur, wr, wc, fr, fq, lds, wid, lane); S.done(cur); }
#undef PG8_SA
#undef PG8_SB
#undef PG8_STAGE
#undef PG8_LDA
#undef PG8_LDB
#undef PG8_MMA
#undef PG8_WAIT_V
#undef PG8_WAIT_L
#undef PG8_BAR
#undef PG8_SCHED
}
}
constexpr int NWAVES = 8, NTHR = 512;
#ifndef MK_N_LAUNCHES
#define MK_N_LAUNCHES 1
#endif
constexpr int PER_PHASE = 14;
constexpr int N_LAUNCHES = MK_N_LAUNCHES;

constexpr int DM = 1024, NPROMPT = 32768, NSAMP = 512, NTOK = 33280, NSHIFT = 32, MPAD = 33536, N1 = 5632;
constexpr int SEQ_P = 4096, SEQ_S = 16, NB_P = 8, NB_S = 32;
constexpr size_t O_Y = 0, O_CONV_P = 34078720, O_SHIFT_P = 34086912, O_WKV_P = 34095104, O_CONV_S = 34357248, O_SHIFT_S = 34390016, O_WKV_S = 34422784;
constexpr size_t KiB = 1024, MiB = 1u << 20;
constexpr size_t WS_CTL = 0, CTL_ZERO_BYTES = 64 * KiB;
constexpr size_t WS_W1T = 64 * KiB;
constexpr size_t WS_WPA = WS_W1T + (size_t)N1 * DM * 2;
constexpr size_t WS_WPB = WS_WPA + 1 * MiB;
constexpr size_t WS_WO = WS_WPB + 1 * MiB;
constexpr size_t WS_WQ = WS_WO + 2 * MiB;
constexpr size_t WS_KEYS = WS_WQ + 4 * MiB;
constexpr size_t WS_L2T = WS_KEYS + 512 * KiB;
constexpr size_t WS_SSP = WS_L2T + 256 * KiB;
constexpr size_t WS_UB = WS_SSP + (size_t)MPAD * 16 * 4;
constexpr size_t WS_VB = WS_UB + 16 * MiB;
constexpr size_t WS_A1 = WS_VB + 16 * MiB;
constexpr size_t WS_ZC = WS_A1 + (size_t)MPAD * DM * 2;
constexpr size_t WS_ZR = WS_ZC + (size_t)MPAD * 1536 * 2;
constexpr size_t WS_ZG = WS_ZR + (size_t)MPAD * 2048 * 2;
constexpr size_t WS_END = WS_ZG + (size_t)MPAD * 2048 * 2;
constexpr size_t WS_YL = WS_ZC, WS_ZT = WS_ZC + (size_t)NTOK * 512 * 2, WS_BV = WS_ZC + (size_t)NTOK * 512 * 4;
constexpr size_t WS_EIDX = WS_ZC, WS_GATE = WS_ZC + 16 * MiB, WS_COEF = WS_ZC + 40 * MiB, WS_SS2 = WS_ZC + 64 * MiB, WS_RSTD = WS_ZC + 66 * MiB;
constexpr size_t WS_PART = WS_ZR;
constexpr size_t OB_MB = (size_t)4352 * 4096 * 4;
static_assert(WS_BV + (size_t)NTOK * 512 * 2 <= WS_ZR && OB_MB + (size_t)4352 * 4096 * 2 <= (size_t)NTOK * 1024 * 4, "scan scratch maps");
static_assert(WS_END <= 512 * MiB, "d_ws map must fit 512 MiB");
constexpr float PEER_SU = 32.0f, PEER_SV = 4.0f;
constexpr int CW_BAR = 1024;
constexpr int LDS_BYTES = 163840;
constexpr int LDSCTL_OFF = LDS_BYTES - 512, MISC_OFF = LDSCTL_OFF + 320;

#define GAS __attribute__((address_space(1)))
#define LAS __attribute__((address_space(3)))
typedef unsigned short bf16;
typedef unsigned v4u __attribute__((ext_vector_type(4)));
typedef unsigned v2u __attribute__((ext_vector_type(2)));
typedef float f32x4 __attribute__((ext_vector_type(4)));
typedef short bf16x8 __attribute__((ext_vector_type(8)));
typedef __bf16 bf16x2_t __attribute__((ext_vector_type(2)));
typedef GAS unsigned gu32;
#define RLX_AGENT __ATOMIC_RELAXED, __HIP_MEMORY_SCOPE_AGENT
#define LDS_WAIT() asm volatile("s_waitcnt lgkmcnt(0)" ::: "memory")
#define VM_WAIT() asm volatile("s_waitcnt vmcnt(0)" ::: "memory")
using pg8::cvt_pk_bf16; using pg8::bf_lo; using pg8::bf_hi; using pg8::sigm;
#define XB_TMO      128
#define XB_XCNT(j)  (256  + 64 * (j))
#define XB_XSUB(j)  (1280 + 64 * (j))
#define XB_XGEN(j)  (2304 + 64 * (j))
#define XB_TOP      3328
#define XB_TOPGEN   3392
#define XCD_BAR_WORDS 3456
#define XB_SPIN_CAP (1u << 22)

__device__ __forceinline__ unsigned xb_ld(unsigned* p)              { return __hip_atomic_load(p, __ATOMIC_RELAXED, __HIP_MEMORY_SCOPE_AGENT); }
__device__ __forceinline__ unsigned xb_add(unsigned* p, unsigned v) { return __hip_atomic_fetch_add(p, v, __ATOMIC_RELAXED, __HIP_MEMORY_SCOPE_AGENT); }
__device__ __forceinline__ unsigned xb_xcc_id() { return (unsigned)__builtin_amdgcn_s_getreg((3 << 11) | 20) & 0xFu; }
#define XB_SPIN(cond, bar) do { unsigned _sp = 0; while (cond) { __builtin_amdgcn_s_sleep(1); \
    if ((++_sp & 255u) == 0u) { if (xb_ld(&(bar)[XB_TMO])) break; if (_sp > XB_SPIN_CAP) { atomicAdd(&(bar)[XB_TMO], 1u); break; } } } } while (0)

struct XcdBarrier {
    unsigned* bar; unsigned x;
    volatile LAS unsigned* st;
};

__device__ __forceinline__ XcdBarrier xcd_barrier_post(unsigned* bar, volatile LAS unsigned* st) {
    XcdBarrier b; b.bar = bar; b.x = xb_xcc_id(); b.st = st;
    if (threadIdx.x == 0) (void)xb_add(&bar[XB_XCNT(b.x)], 1u);
    return b;
}
__device__ __forceinline__ void xcd_barrier_complete(unsigned* bar, unsigned x, unsigned& nloc, unsigned& nx) {
    const unsigned G = gridDim.x * gridDim.y * gridDim.z;
    unsigned sum, cnt, mine, sp = 0u;
    for (;;) {
        sum = 0u; cnt = 0u; mine = 0u;
#pragma unroll
        for (unsigned j = 0; j < 16; ++j) { const unsigned c = xb_ld(&bar[XB_XCNT(j)]); sum += c; cnt += (c > 0u) ? 1u : 0u; mine = (j == x) ? c : mine; }
        if (sum == G) break;
        __builtin_amdgcn_s_sleep(1);
        if ((++sp & 255u) == 0u) { if (xb_ld(&bar[XB_TMO])) break; if (sp > XB_SPIN_CAP) { atomicAdd(&bar[XB_TMO], 1u); break; } }
    }
    nloc = mine > 0u ? mine : 1u; nx = cnt > 0u ? cnt : 1u;
}

__device__ __forceinline__ void xcd_barrier(const XcdBarrier& b) {
    asm volatile("s_waitcnt vmcnt(0)" ::: "memory");
    __syncthreads();
    if (threadIdx.x == 0) {
        unsigned* bar = b.bar;
        __builtin_amdgcn_s_waitcnt(0);
        unsigned nloc = b.st[0], nx = b.st[1];
        if (nloc == 0u) { xcd_barrier_complete(bar, b.x, nloc, nx); b.st[0] = nloc; b.st[1] = nx; }
        const unsigned old = xb_add(&bar[XB_XSUB(b.x)], 1u);
        const unsigned gen = old / nloc;
        if (old + 1u == (gen + 1u) * nloc) {
            __builtin_amdgcn_fence(__ATOMIC_RELEASE, "agent");
            asm volatile("s_waitcnt vmcnt(0)" ::: "memory");
            const unsigned og = xb_add(&bar[XB_TOP], 1u);
            const unsigned tg = og / nx;
            if (og + 1u == (tg + 1u) * nx) xb_add(&bar[XB_TOPGEN], 1u);
            else XB_SPIN(xb_ld(&bar[XB_TOPGEN]) == tg, bar);
            __builtin_amdgcn_fence(__ATOMIC_ACQUIRE, "agent");
            xb_add(&bar[XB_XGEN(b.x)], 1u);
            asm volatile("s_waitcnt vmcnt(0)" ::: "memory");
        } else {
            XB_SPIN(xb_ld(&bar[XB_XGEN(b.x)]) == gen, bar);
            __builtin_amdgcn_fence(__ATOMIC_ACQUIRE, "agent");
            asm volatile("s_waitcnt vmcnt(0)" ::: "memory");
        }
    }
    __syncthreads();
}
struct Args { const float* in[32]; float* out; unsigned char* ws; int ph_lo, ph_hi, li, pad; };
enum { I_XP = 0, I_XS, I_SCONV, I_SSHIFT, I_SWKV, I_N1G, I_WIN, I_CONVW, I_MURKV, I_MUWAG, I_W0, I_W1, I_W2, I_A0, I_A1, I_A2, I_G1, I_G2, I_KK, I_KA, I_RK, I_GNW, I_GNB, I_WPA, I_WPB, I_WO, I_N2G, I_WQ, I_KEYS, I_U, I_V, I_NFG };

__device__ __forceinline__ float wave_sum(float v) {
#pragma unroll
    for (int o = 1; o < 64; o <<= 1) v += __shfl_xor(v, o);
    return v;
}
template <int CTRL> __device__ __forceinline__ float dpp_mov(float v) { return __builtin_bit_cast(float, __builtin_amdgcn_update_dpp(0, __builtin_bit_cast(int, v), CTRL, 0xF, 0xF, true)); }
__device__ __forceinline__ float sum4(float v) { v += dpp_mov<0xB1>(v); v += dpp_mov<0x4E>(v); return v; }
__device__ __forceinline__ float sum8(float v) { v = sum4(v); v += dpp_mov<0x141>(v); return v; }
__device__ __forceinline__ float sum16(float v) { v = sum8(v); v += dpp_mov<0x140>(v); return v; }
__device__ __forceinline__ float dot2bf(unsigned w, unsigned x, float acc) { return __builtin_amdgcn_fdot2_f32_bf16(__builtin_bit_cast(bf16x2_t, w), __builtin_bit_cast(bf16x2_t, x), acc, false); }

__device__ __forceinline__ void transpose_item(const float* W, int ldw, int c0, int K, bf16* WT, int nblk, int item, const float* sv, float alpha, float beta, LAS float* scr, int lane) {
    const int kb = item / nblk, nb = item % nblk, k0 = 64 * kb, n0 = 32 * nb;
#pragma unroll 8
    for (int i = 0; i < 32; ++i) { const int kk = 2 * i + (lane >> 5); float s = 1.f; if (sv) s = alpha + beta * sv[k0 + kk];
        scr[kk * 33 + (lane & 31)] = W[(size_t)(k0 + kk) * ldw + c0 + n0 + (lane & 31)] * s; }
    LDS_WAIT();
    const int c = lane & 7;
#pragma unroll
    for (int j = 0; j < 4; ++j) { const int n = (lane >> 3) + 8 * j; const LAS float* s = scr + (8 * c) * 33 + n;
        v4u o; o.x = cvt_pk_bf16(s[0 * 33], s[1 * 33]); o.y = cvt_pk_bf16(s[2 * 33], s[3 * 33]); o.z = cvt_pk_bf16(s[4 * 33], s[5 * 33]); o.w = cvt_pk_bf16(s[6 * 33], s[7 * 33]);
        *(v4u*)(WT + (size_t)(n0 + n) * K + k0 + 8 * c) = o; }
    LDS_WAIT();
}
__device__ __forceinline__ void cvt_stream(const float* src, bf16* dst, size_t n, size_t gt, size_t nthreads) {
    for (size_t i = gt * 8; i < n; i += nthreads * 8) { const f32x4 a = *(const f32x4*)(src + i), b = *(const f32x4*)(src + i + 4);
        v4u o; o.x = cvt_pk_bf16(a[0], a[1]); o.y = cvt_pk_bf16(a[2], a[3]); o.z = cvt_pk_bf16(b[0], b[1]); o.w = cvt_pk_bf16(b[2], b[3]); *(v4u*)(dst + i) = o; }
}
__device__ __forceinline__ void cvt_stream_fp8(const float* src, unsigned char* dst, size_t n, float scale, size_t gt, size_t nthreads) {
    for (size_t i = gt * 16; i < n; i += nthreads * 16) {
        const f32x4 a = *(const f32x4*)(src + i) * scale, b = *(const f32x4*)(src + i + 4) * scale, c = *(const f32x4*)(src + i + 8) * scale, d = *(const f32x4*)(src + i + 12) * scale;
        v4u o; unsigned p;
        p = __builtin_amdgcn_cvt_pk_fp8_f32(a[0], a[1], 0, false); o.x = __builtin_amdgcn_cvt_pk_fp8_f32(a[2], a[3], p, true);
        p = __builtin_amdgcn_cvt_pk_fp8_f32(b[0], b[1], 0, false); o.y = __builtin_amdgcn_cvt_pk_fp8_f32(b[2], b[3], p, true);
        p = __builtin_amdgcn_cvt_pk_fp8_f32(c[0], c[1], 0, false); o.z = __builtin_amdgcn_cvt_pk_fp8_f32(c[2], c[3], p, true);
        p = __builtin_amdgcn_cvt_pk_fp8_f32(d[0], d[1], 0, false); o.w = __builtin_amdgcn_cvt_pk_fp8_f32(d[2], d[3], p, true);
        *(v4u*)(dst + i) = o; }
}
__device__ __forceinline__ void cvt16_fp8_sliced(const float* src, unsigned char* dst, float scale, size_t i) {
    const f32x4 a = *(const f32x4*)(src + i) * scale, b = *(const f32x4*)(src + i + 4) * scale, c = *(const f32x4*)(src + i + 8) * scale, d = *(const f32x4*)(src + i + 12) * scale;
    v4u o; unsigned p;
    p = __builtin_amdgcn_cvt_pk_fp8_f32(a[0], a[1], 0, false); o.x = __builtin_amdgcn_cvt_pk_fp8_f32(a[2], a[3], p, true);
    p = __builtin_amdgcn_cvt_pk_fp8_f32(b[0], b[1], 0, false); o.y = __builtin_amdgcn_cvt_pk_fp8_f32(b[2], b[3], p, true);
    p = __builtin_amdgcn_cvt_pk_fp8_f32(c[0], c[1], 0, false); o.z = __builtin_amdgcn_cvt_pk_fp8_f32(c[2], c[3], p, true);
    p = __builtin_amdgcn_cvt_pk_fp8_f32(d[0], d[1], 0, false); o.w = __builtin_amdgcn_cvt_pk_fp8_f32(d[2], d[3], p, true);
    const size_t e = i >> 10, col = i & 1023;
    *(v4u*)(dst + (col >> 7) * ((size_t)16384 * 128) + e * 128 + (col & 127)) = o;
}
__device__ __forceinline__ void cvt_stream_fp8_sliced(const float* src, unsigned char* dst, float scale, size_t gt, size_t nthreads) {
#pragma unroll 2
    for (size_t i = gt * 16; i < (size_t)16384 * 1024; i += nthreads * 16) {
        const f32x4 a = *(const f32x4*)(src + i) * scale, b = *(const f32x4*)(src + i + 4) * scale, c = *(const f32x4*)(src + i + 8) * scale, d = *(const f32x4*)(src + i + 12) * scale;
        v4u o; unsigned p;
        p = __builtin_amdgcn_cvt_pk_fp8_f32(a[0], a[1], 0, false); o.x = __builtin_amdgcn_cvt_pk_fp8_f32(a[2], a[3], p, true);
        p = __builtin_amdgcn_cvt_pk_fp8_f32(b[0], b[1], 0, false); o.y = __builtin_amdgcn_cvt_pk_fp8_f32(b[2], b[3], p, true);
        p = __builtin_amdgcn_cvt_pk_fp8_f32(c[0], c[1], 0, false); o.z = __builtin_amdgcn_cvt_pk_fp8_f32(c[2], c[3], p, true);
        p = __builtin_amdgcn_cvt_pk_fp8_f32(d[0], d[1], 0, false); o.w = __builtin_amdgcn_cvt_pk_fp8_f32(d[2], d[3], p, true);
        const size_t e = i >> 10, col = i & 1023;
        *(v4u*)(dst + (col >> 7) * ((size_t)16384 * 128) + e * 128 + (col & 127)) = o; }
}
__device__ __forceinline__ void p0_prologue(const Args& A, LAS unsigned char* lds, int tid, int lane, int wave, int vcu, int G) {
    unsigned char* ws = A.ws;
    bf16* W1T = (bf16*)(ws + WS_W1T);
    LAS float* scr = (LAS float*)(lds + wave * 16384);
    const int gw = vcu * NWAVES + wave, NGW = G * NWAVES;
    constexpr int J0 = 16 * 96, J1 = 16 * 64, JL = 16 * 2, JG = 16 * 4, JP = 8 * 32, JO = 16 * 32, JQ = 16 * 64;
    constexpr int JW2 = 16, JG2 = 32;
    constexpr int NITEMS = J0 + J1 + 4 * JL + 2 * JG + 2 * JP + JO + JQ + 2 * JW2 + JG2;
    bf16* L2T = (bf16*)(ws + WS_L2T);
    const float* mu = A.in[I_MUWAG];
    for (int it = gw; it < NITEMS; it += NGW) {
        int r = it;
        if (r < J0) { transpose_item(A.in[I_WIN], 5120, 0, 1024, W1T, 96, r, nullptr, 0.f, 0.f, scr, lane); continue; } r -= J0;
        if (r < J1) { transpose_item(A.in[I_WIN], 5120, 3072, 1024, W1T + (size_t)3584 * 1024, 64, r, nullptr, 0.f, 0.f, scr, lane); continue; } r -= J1;
        if (r < JL) { transpose_item(A.in[I_W1], 64, 0, 1024, W1T + (size_t)3072 * 1024, 2, r, mu, 1.f, -1.f, scr, lane); continue; } r -= JL;
        if (r < JL) { transpose_item(A.in[I_W1], 64, 0, 1024, W1T + (size_t)3328 * 1024, 2, r, mu, 0.f, 1.f, scr, lane); continue; } r -= JL;
        if (r < JL) { transpose_item(A.in[I_A1], 64, 0, 1024, W1T + (size_t)(3072 + 64) * 1024, 2, r, mu + 1024, 1.f, -1.f, scr, lane); continue; } r -= JL;
        if (r < JL) { transpose_item(A.in[I_A1], 64, 0, 1024, W1T + (size_t)(3328 + 64) * 1024, 2, r, mu + 1024, 0.f, 1.f, scr, lane); continue; } r -= JL;
        if (r < JG) { transpose_item(A.in[I_G1], 128, 0, 1024, W1T + (size_t)(3072 + 128) * 1024, 4, r, mu + 2048, 1.f, -1.f, scr, lane); continue; } r -= JG;
        if (r < JG) { transpose_item(A.in[I_G1], 128, 0, 1024, W1T + (size_t)(3328 + 128) * 1024, 4, r, mu + 2048, 0.f, 1.f, scr, lane); continue; } r -= JG;
        if (r < JP) { transpose_item(A.in[I_WPA], 1024, 0, 512, (bf16*)(ws + WS_WPA), 32, r, nullptr, 0.f, 0.f, scr, lane); continue; } r -= JP;
        if (r < JP) { transpose_item(A.in[I_WPB], 1024, 0, 512, (bf16*)(ws + WS_WPB), 32, r, nullptr, 0.f, 0.f, scr, lane); continue; } r -= JP;
        if (r < JO) { transpose_item(A.in[I_WO], 1024, 0, 1024, (bf16*)(ws + WS_WO), 32, r, nullptr, 0.f, 0.f, scr, lane); continue; } r -= JO;
        if (r < JQ) { transpose_item(A.in[I_WQ], 2048, 0, 1024, (bf16*)(ws + WS_WQ), 64, r, nullptr, 0.f, 0.f, scr, lane); continue; } r -= JQ;
        if (r < JW2) { transpose_item(A.in[I_W2], 512, 0, 64, L2T, 16, r, nullptr, 0.f, 0.f, scr, lane); continue; } r -= JW2;
        if (r < JW2) { transpose_item(A.in[I_A2], 512, 0, 64, L2T + (size_t)512 * 64, 16, r, nullptr, 0.f, 0.f, scr, lane); continue; } r -= JW2;
        transpose_item(A.in[I_G2], 512, 0, 128, L2T + (size_t)1024 * 64, 16, r, nullptr, 0.f, 0.f, scr, lane);
    }
    const size_t gt = (size_t)vcu * NTHR + tid, nth = (size_t)G * NTHR;
    if (G != 256) {
        cvt_stream_fp8_sliced(A.in[I_U], ws + WS_UB, PEER_SU, gt, nth);
        cvt_stream_fp8_sliced(A.in[I_V], ws + WS_VB, PEER_SV, gt, nth); }
    cvt_stream(A.in[I_KEYS], (bf16*)(ws + WS_KEYS), (size_t)8 * 2 * 128 * 128, gt, nth);
    bf16* A1 = (bf16*)(ws + WS_A1);
    const f32x4* g1v = (const f32x4*)A.in[I_N1G] + lane;
    for (int m0 = gw; m0 < NTOK; m0 += 2 * NGW) {
        const int m1 = m0 + NGW; const bool two = m1 < NTOK; const int m1c = two ? m1 : m0;
        const f32x4* xr0 = (const f32x4*)(m0 < NPROMPT ? A.in[I_XP] + (size_t)m0 * DM : A.in[I_XS] + (size_t)(m0 - NPROMPT) * DM) + lane;
        const f32x4* xr1 = (const f32x4*)(m1c < NPROMPT ? A.in[I_XP] + (size_t)m1c * DM : A.in[I_XS] + (size_t)(m1c - NPROMPT) * DM) + lane;
        f32x4 v0[4], v1[4]; float s0 = 0.f, s1 = 0.f;
#pragma unroll
        for (int j = 0; j < 4; ++j) { v0[j] = xr0[64 * j]; v1[j] = xr1[64 * j]; }
#pragma unroll
        for (int j = 0; j < 4; ++j) { s0 += (v0[j][0] * v0[j][0] + v0[j][1] * v0[j][1]) + (v0[j][2] * v0[j][2] + v0[j][3] * v0[j][3]);
                                      s1 += (v1[j][0] * v1[j][0] + v1[j][1] * v1[j][1]) + (v1[j][2] * v1[j][2] + v1[j][3] * v1[j][3]); }
#pragma unroll
        for (int o = 1; o < 64; o <<= 1) { s0 += __shfl_xor(s0, o); s1 += __shfl_xor(s1, o); }
        const float r0 = 1.0f / sqrtf(s0 * (1.f / DM) + 1e-6f), r1 = 1.0f / sqrtf(s1 * (1.f / DM) + 1e-6f);
#pragma unroll
        for (int rr = 0; rr < 2; ++rr) {
            if (rr == 1 && !two) break;
            const int m = rr ? m1 : m0; const float rstd = rr ? r1 : r0;
            v2u* o8 = (v2u*)(A1 + (size_t)m * DM) + lane;
            float* so = nullptr;
            if (m < NPROMPT) { if ((m & (SEQ_P - 1)) == SEQ_P - 1) so = A.out + O_SHIFT_P + (size_t)(m / SEQ_P) * DM; }
            else { const int ms = m - NPROMPT; if ((ms & (SEQ_S - 1)) == SEQ_S - 1) so = A.out + O_SHIFT_S + (size_t)(ms / SEQ_S) * DM; }
#pragma unroll
            for (int j = 0; j < 4; ++j) { const f32x4 g = g1v[64 * j]; const f32x4 y = (rr ? v1[j] : v0[j]) * rstd * g;
                v2u w; w.x = cvt_pk_bf16(y[0], y[1]); w.y = cvt_pk_bf16(y[2], y[3]); o8[64 * j] = w;
                if (so) ((f32x4*)so)[lane + 64 * j] = y; }
        }
    }
    for (int m = NTOK + gw; m < MPAD; m += NGW) {
        v2u* o8 = (v2u*)(A1 + (size_t)m * DM) + lane;
        if (m < NTOK + NSHIFT) {
            const f32x4* xr = (const f32x4*)(A.in[I_SSHIFT] + (size_t)(m - NTOK) * DM) + lane;
#pragma unroll
            for (int j = 0; j < 4; ++j) { const f32x4 y = xr[64 * j]; v2u w; w.x = cvt_pk_bf16(y[0], y[1]); w.y = cvt_pk_bf16(y[2], y[3]); o8[64 * j] = w; }
        } else {
#pragma unroll
            for (int j = 0; j < 4; ++j) { v2u w; w.x = 0u; w.y = 0u; o8[64 * j] = w; }
        }
    }
}

__device__ __forceinline__ void unpack8(const v4u w, float (&f)[8]) { f[0] = bf_lo(w.x); f[1] = bf_hi(w.x); f[2] = bf_lo(w.y); f[3] = bf_hi(w.y); f[4] = bf_lo(w.z); f[5] = bf_hi(w.z); f[6] = bf_lo(w.w); f[7] = bf_hi(w.w); }
__device__ __forceinline__ void conv_phase(const Args& A, int gt, int nth) {
    const bf16* Zc = (const bf16*)(A.ws + WS_ZC); bf16* YA = (bf16*)(A.ws + WS_A1);
    const float* cw = A.in[I_CONVW];
    for (int task = gt; task < (NTOK / 16) * 64; task += nth) {
        const int seg = task >> 6, ch = (task & 63) * 8, row0 = seg * 16;
        int b, t0, T; bool prompt = row0 < NPROMPT;
        if (prompt) { b = row0 / SEQ_P; t0 = row0 % SEQ_P; T = SEQ_P; } else { b = (row0 - NPROMPT) / SEQ_S; t0 = 0; T = SEQ_S; }
        float um2[8], um1[8], c0[8], c1[8], c2[8];
#pragma unroll
        for (int i = 0; i < 8; ++i) { c0[i] = cw[ch + i]; c1[i] = cw[512 + ch + i]; c2[i] = cw[1024 + ch + i]; }
        if (t0 == 0) {
            if (prompt) {
#pragma unroll
                for (int i = 0; i < 8; ++i) { um2[i] = 0.f; um1[i] = 0.f; }
            } else { const float* sc = A.in[I_SCONV] + (size_t)b * 2 * 512 + ch;
#pragma unroll
                for (int i = 0; i < 8; ++i) { um2[i] = sc[i]; um1[i] = sc[512 + i]; } }
        } else {
            float a[8], h[8];
            unpack8(*(const v4u*)(Zc + (size_t)(row0 - 2) * 1536 + 512 + ch), a); unpack8(*(const v4u*)(Zc + (size_t)(row0 - 2) * 1536 + 1024 + ch), h);
#pragma unroll
            for (int i = 0; i < 8; ++i) um2[i] = a[i] * h[i];
            unpack8(*(const v4u*)(Zc + (size_t)(row0 - 1) * 1536 + 512 + ch), a); unpack8(*(const v4u*)(Zc + (size_t)(row0 - 1) * 1536 + 1024 + ch), h);
#pragma unroll
            for (int i = 0; i < 8; ++i) um1[i] = a[i] * h[i];
        }
#pragma unroll 4
        for (int t = 0; t < 16; ++t) {
            const size_t row = (size_t)(row0 + t);
            float zb[8], zc[8], zh[8], y[8];
            unpack8(*(const v4u*)(Zc + row * 1536 + ch), zb); unpack8(*(const v4u*)(Zc + row * 1536 + 512 + ch), zc); unpack8(*(const v4u*)(Zc + row * 1536 + 1024 + ch), zh);
#pragma unroll
            for (int i = 0; i < 8; ++i) { const float u = zc[i] * zh[i]; y[i] = zb[i] * (c0[i] * um2[i] + c1[i] * um1[i] + c2[i] * u); um2[i] = um1[i]; um1[i] = u; }
            v4u o; o.x = cvt_pk_bf16(y[0], y[1]); o.y = cvt_pk_bf16(y[2], y[3]); o.z = cvt_pk_bf16(y[4], y[5]); o.w = cvt_pk_bf16(y[6], y[7]);
            *(v4u*)(YA + row * 512 + ch) = o;
        }
        if (t0 + 16 == T) { float* oc = A.out + (prompt ? O_CONV_P : O_CONV_S) + (size_t)b * 2 * 512 + ch;
#pragma unroll
            for (int i = 0; i < 8; ++i) { oc[i] = um2[i]; oc[512 + i] = um1[i]; } }
    }
}

constexpr int NUNITS_P = NB_P * 8 * 64, NUNITS = NUNITS_P + NB_S * 8;
constexpr int HID_STRIDE = 264, SC_TB = 32;
constexpr int P1_HIDB = 0, P1_LO = 16896, P1_SEQ = 41472, P1_GG = 90624, P1_YY = 98816, P1_ZZ = 107008, P1_BON = 115200;
typedef float f32x2 __attribute__((ext_vector_type(2)));

struct P1Pre { v4u pa0, pa1, pb0, pb1; v2u zr, zk, zv, pr, pk, pv; };
struct P1Pos { int unit, t0; };
__device__ __forceinline__ void p1_decode(int unit, bool& prompt, int& b, int& h, int& ch, int& T, int& rowbase) {
    prompt = unit < NUNITS_P; b = prompt ? unit >> 9 : (unit - NUNITS_P) >> 3; h = prompt ? (unit >> 6) & 7 : unit & 7; ch = prompt ? unit & 63 : 0;
    T = prompt ? 64 : SEQ_S; rowbase = prompt ? b * SEQ_P + ch * 64 : NPROMPT + b * SEQ_S;
}
__device__ __forceinline__ void p1_rows(int unit, int t0, int tt, size_t& row, size_t& prow, bool& hasprev, int& nb) {
    bool prompt; int b, h, ch, T, rowbase; p1_decode(unit, prompt, b, h, ch, T, rowbase);
    nb = (T - t0) < SC_TB ? (T - t0) : SC_TB;
    const int tloc = tt < nb ? tt : nb - 1, t = t0 + tloc; const bool first = (ch == 0);
    row = (size_t)(rowbase + t); hasprev = (t > 0) || !first || !prompt; prow = ((t > 0) || !first) ? row - 1 : (size_t)(NTOK + b);
}
__device__ __forceinline__ void p1_load(const Args& A, int unit, int t0, int tt, int cs, P1Pre& P) {
    size_t row, prow; bool hasprev; int nb; p1_rows(unit, t0, tt, row, prow, hasprev, nb);
    const int h = unit < NUNITS_P ? (unit >> 6) & 7 : unit & 7, hc = h * 64 + cs * 4;
    const bf16* Zr = (const bf16*)(A.ws + WS_ZR);
    P.pa0 = *(const v4u*)(Zr + row * 2048 + 1536 + cs * 16); P.pa1 = *(const v4u*)(Zr + row * 2048 + 1536 + cs * 16 + 8);
    P.zr = *(const v2u*)(Zr + row * 2048 + hc); P.zk = *(const v2u*)(Zr + row * 2048 + 512 + hc); P.zv = *(const v2u*)(Zr + row * 2048 + 1024 + hc);
    const v4u z4 = (v4u){0u, 0u, 0u, 0u}; const v2u z2 = (v2u){0u, 0u};
    P.pb0 = z4; P.pb1 = z4; P.pr = z2; P.pk = z2; P.pv = z2;
    if (hasprev) { P.pb0 = *(const v4u*)(Zr + prow * 2048 + 1792 + cs * 16); P.pb1 = *(const v4u*)(Zr + prow * 2048 + 1792 + cs * 16 + 8);
        P.pr = *(const v2u*)(Zr + prow * 2048 + hc); P.pk = *(const v2u*)(Zr + prow * 2048 + 512 + hc); P.pv = *(const v2u*)(Zr + prow * 2048 + 1024 + hc); }
}
__device__ __forceinline__ bool p1_unit_at(int i, int vcu, int G, int& unit) {
    if (G == 256) { if (i > 16) return false; unit = i < 16 ? vcu * 16 + i : NUNITS_P + vcu; return true; }
    unit = vcu + i * G; return unit < NUNITS;
}

constexpr int WY_OS = 72, WY_TS = 24, WY_LS = 40;
constexpr int WY_AT = 0, WY_RT = WY_AT + 16 * WY_OS * 2, WY_BT = WY_RT + 16 * WY_OS * 2, WY_KT = WY_BT + 16 * WY_OS * 2, WY_BH = WY_KT + 16 * WY_OS * 2,
              WY_KH = WY_BH + 64 * WY_TS * 2, WY_VT = WY_KH + 64 * WY_TS * 2, WY_GC = WY_VT + 64 * WY_TS * 2, WY_BUF = WY_GC + 256;
constexpr int WY_BASE = 0;
constexpr int WY_LAB = WY_BASE + 2 * WY_BUF, WY_LAK = WY_LAB + 1024, WY_MC = WY_LAK + 16 * WY_LS * 2;
static_assert(WY_MC + 16 * WY_LS * 2 <= P1_SEQ, "UT-transform operands must fit over HIDB | LO");
constexpr int WY_XB = 115328, WY_RH = WY_XB + 128 * WY_OS * 2, WY_UT = WY_RH + 8 * 16 * 17 * 4, WY_END = WY_UT + 8 * 16 * WY_TS * 2;
static_assert(WY_END <= LDSCTL_OFF, "LDS map of pass 1");

constexpr int WY_G2 = P1_GG + 2048;
static_assert(WY_G2 + 1024 + 2 * 16 * WY_LS * 2 <= P1_YY, "second Gram set");
__device__ __forceinline__ void p1_wy(f32x4 (&X)[4], const LAS float* SEQ, LAS float* YY, LAS float* ZZ, LAS unsigned char* lds, int nb, int tid, int lane, int wave) {
    const bool pw = wave >= 4; const int nmc = nb >> 4;
    LAS bf16* Xb = (LAS bf16*)(lds + WY_XB); LAS float* RH = (LAS float*)(lds + WY_RH) + wave * 16 * 17; LAS bf16* UT = (LAS bf16*)(lds + WY_UT) + wave * 16 * WY_TS;
    const bf16x8 zero8 = (bf16x8){0, 0, 0, 0, 0, 0, 0, 0};
    for (int mc = 0; mc < nmc; ++mc) {
        asm volatile("" : "+v"(tid));
        LAS unsigned char* ob = lds + WY_BASE + mc * WY_BUF;
        LAS bf16* At = (LAS bf16*)(ob + WY_AT); LAS bf16* Rt = (LAS bf16*)(ob + WY_RT); LAS bf16* Bt = (LAS bf16*)(ob + WY_BT); LAS bf16* Kt = (LAS bf16*)(ob + WY_KT);
        LAS bf16* BhT = (LAS bf16*)(ob + WY_BH); LAS bf16* KhT = (LAS bf16*)(ob + WY_KH); LAS bf16* VT = (LAS bf16*)(ob + WY_VT); LAS float* GC = (LAS float*)(ob + WY_GC);
        const int tl = tid >> 5, c2 = (tid & 31) * 2, s0 = mc * 16;
        f32x2 cum = (f32x2){0.f, 0.f}, tot = cum, lwt = cum;
#pragma unroll
        for (int i = 0; i < 16; ++i) { const f32x2 l2 = *(const LAS f32x2*)(SEQ + (s0 + i) * 384 + 64 + c2); tot += l2; if (i <= tl) cum += l2; if (i == tl) lwt = l2; }
        const LAS float* sp = SEQ + (s0 + tl) * 384 + c2;
        const f32x2 a2 = *(const LAS f32x2*)(sp), b2 = *(const LAS f32x2*)(sp + 128), k2 = *(const LAS f32x2*)(sp + 192), r2 = *(const LAS f32x2*)(sp + 256), v2 = *(const LAS f32x2*)(sp + 320);
        const f32x2 gt = (f32x2){__expf(cum.x), __expf(cum.y)}, gp = (f32x2){__expf(cum.x - lwt.x), __expf(cum.y - lwt.y)}, gi = (f32x2){__expf(-cum.x), __expf(-cum.y)},
                    go = (f32x2){__expf(tot.x - cum.x), __expf(tot.y - cum.y)};
        *(LAS unsigned*)(At + tl * WY_OS + c2) = cvt_pk_bf16(a2.x * gp.x, a2.y * gp.y); *(LAS unsigned*)(Rt + tl * WY_OS + c2) = cvt_pk_bf16(r2.x * gt.x, r2.y * gt.y);
        *(LAS unsigned*)(Bt + tl * WY_OS + c2) = cvt_pk_bf16(b2.x * gi.x, b2.y * gi.y); *(LAS unsigned*)(Kt + tl * WY_OS + c2) = cvt_pk_bf16(k2.x * gi.x, k2.y * gi.y);
        const unsigned bh = cvt_pk_bf16(b2.x * go.x, b2.y * go.y), kh = cvt_pk_bf16(k2.x * go.x, k2.y * go.y), vv = cvt_pk_bf16(v2.x, v2.y);
        {
            const unsigned bh_o = (unsigned)__shfl_xor((int)bh, 32), kh_o = (unsigned)__shfl_xor((int)kh, 32), vv_o = (unsigned)__shfl_xor((int)vv, 32);
            const bool ev = (tl & 1) == 0; const int wo = (ev ? c2 : c2 + 1) * WY_TS + (tl & ~1);
            *(LAS unsigned*)(BhT + wo) = ev ? ((bh & 0xffffu) | (bh_o << 16)) : ((bh_o >> 16) | (bh & 0xffff0000u));
            *(LAS unsigned*)(KhT + wo) = ev ? ((kh & 0xffffu) | (kh_o << 16)) : ((kh_o >> 16) | (kh & 0xffff0000u));
            *(LAS unsigned*)(VT + wo) = ev ? ((vv & 0xffffu) | (vv_o << 16)) : ((vv_o >> 16) | (vv & 0xffff0000u)); }
        if (tl == 0) *(LAS f32x2*)(GC + c2) = (f32x2){__expf(tot.x), __expf(tot.y)};
    }
    __syncthreads();
    {
        asm volatile("" : "+v"(tid));
        const int fr = tid & 15, fq = (tid >> 4) & 3, g_ = wave & 3, m_ = wave >> 2;
        if (m_ < nmc) {
            LAS unsigned char* ob = lds + WY_BASE + m_ * WY_BUF; LAS unsigned char* gs = lds + (m_ ? WY_G2 : WY_LAB);
            LAS float* Lab = (LAS float*)gs; LAS bf16* Lak = (LAS bf16*)(gs + 1024); LAS bf16* Mc = (LAS bf16*)(gs + 1024 + 16 * WY_LS * 2);
            const LAS bf16* ab = (LAS bf16*)(ob + (g_ < 2 ? WY_AT : WY_RT)) + fr * WY_OS + fq * 8; const LAS bf16* bb = (LAS bf16*)(ob + ((g_ & 1) ? WY_KT : WY_BT)) + fr * WY_OS + fq * 8;
            f32x4 g = (f32x4){0.f, 0.f, 0.f, 0.f};
#pragma unroll
            for (int ks = 0; ks < 2; ++ks) g = __builtin_amdgcn_mfma_f32_16x16x32_bf16(*(const LAS bf16x8*)(bb + ks * 32), *(const LAS bf16x8*)(ab + ks * 32), g, 0, 0, 0);
#pragma unroll
            for (int rg = 0; rg < 4; ++rg) { const int tp = 4 * fq + rg; const bool keep = (g_ < 2) ? (fr > tp) : (fr >= tp); g[rg] = keep ? g[rg] : 0.f; }
            if (g_ == 0) *(LAS f32x4*)(Lab + fr * 16 + 4 * fq) = g;
            else { v2u w; w.x = cvt_pk_bf16(g[0], g[1]); w.y = cvt_pk_bf16(g[2], g[3]);
                if (g_ == 1) { *(LAS v2u*)(Lak + fr * WY_LS + 4 * fq) = w; *(LAS v2u*)(Lak + fr * WY_LS + 16 + 4 * fq) = (v2u){0u, 0u}; }
                else if (g_ == 2) *(LAS v2u*)(Mc + fr * WY_LS + 4 * fq) = w; else *(LAS v2u*)(Mc + fr * WY_LS + 16 + 4 * fq) = w; }
        }
    }
    __syncthreads();
    for (int mc = 0; mc < nmc; ++mc) {
        asm volatile("" : "+v"(tid));
        const int fr = tid & 15, fq = (tid >> 4) & 3;
        LAS unsigned char* ob = lds + WY_BASE + mc * WY_BUF; LAS unsigned char* gs = lds + (mc ? WY_G2 : WY_LAB);
        LAS bf16* At = (LAS bf16*)(ob + WY_AT); LAS bf16* Rt = (LAS bf16*)(ob + WY_RT);
        LAS bf16* BhT = (LAS bf16*)(ob + WY_BH); LAS bf16* KhT = (LAS bf16*)(ob + WY_KH); LAS bf16* VT = (LAS bf16*)(ob + WY_VT); LAS float* GC = (LAS float*)(ob + WY_GC);
        LAS float* Lab = (LAS float*)gs; LAS bf16* Lak = (LAS bf16*)(gs + 1024); LAS bf16* Mc = (LAS bf16*)(gs + 1024 + 16 * WY_LS * 2);
        f32x4 W1 = (f32x4){0.f, 0.f, 0.f, 0.f}, Y0 = W1;
        {
            const LAS bf16* xbp = Xb + (16 * wave + fr) * WY_OS + fq * 8;
#pragma unroll
            for (int ks = 0; ks < 2; ++ks) { const bf16x8 bx = *(const LAS bf16x8*)(xbp + ks * 32);
                W1 = __builtin_amdgcn_mfma_f32_16x16x32_bf16(*(const LAS bf16x8*)(At + fr * WY_OS + ks * 32 + fq * 8), bx, W1, 0, 0, 0);
                Y0 = __builtin_amdgcn_mfma_f32_16x16x32_bf16(*(const LAS bf16x8*)(Rt + fr * WY_OS + ks * 32 + fq * 8), bx, Y0, 0, 0, 0); }
        }
        if (!pw) { const bf16x8 la = *(const LAS bf16x8*)(Lak + fr * WY_LS + fq * 8); const bf16x8 vb0 = *(const LAS bf16x8*)(VT + (16 * wave + fr) * WY_TS + (fq & 1) * 8); const bf16x8 vb = fq < 2 ? vb0 : zero8;
            W1 = __builtin_amdgcn_mfma_f32_16x16x32_bf16(la, vb, W1, 0, 0, 0); }
#pragma unroll
        for (int rg = 0; rg < 4; ++rg) RH[(4 * fq + rg) * 17 + fr] = W1[rg];
        LDS_WAIT();
        {
            float u[16];
#pragma unroll
            for (int t = 0; t < 16; ++t) { if ((t & 3) == 0) asm volatile("" ::: "memory");
                float acc = RH[t * 17 + fr];
#pragma unroll
                for (int i4 = 0; i4 * 4 < t; ++i4) { const f32x4 l4 = *(const LAS f32x4*)(Lab + t * 16 + i4 * 4);
#pragma unroll
                    for (int e = 0; e < 4; ++e) if (i4 * 4 + e < t) acc += l4[e] * u[i4 * 4 + e]; }
                u[t] = acc; }
            if (fq == 0) { v4u o0, o1; o0.x = cvt_pk_bf16(u[0], u[1]); o0.y = cvt_pk_bf16(u[2], u[3]); o0.z = cvt_pk_bf16(u[4], u[5]); o0.w = cvt_pk_bf16(u[6], u[7]);
                o1.x = cvt_pk_bf16(u[8], u[9]); o1.y = cvt_pk_bf16(u[10], u[11]); o1.z = cvt_pk_bf16(u[12], u[13]); o1.w = cvt_pk_bf16(u[14], u[15]);
                *(LAS v4u*)(UT + fr * WY_TS) = o0; *(LAS v4u*)(UT + fr * WY_TS + 8) = o1; }
        }
        LDS_WAIT();
        {
            const bf16x8 uc = fq < 2 ? *(const LAS bf16x8*)(UT + fr * WY_TS + fq * 8) : (pw ? zero8 : *(const LAS bf16x8*)(VT + (16 * wave + fr) * WY_TS + (fq - 2) * 8));
            Y0 = __builtin_amdgcn_mfma_f32_16x16x32_bf16(*(const LAS bf16x8*)(Mc + fr * WY_LS + fq * 8), uc, Y0, 0, 0, 0);
            LAS float* yo = (pw ? ZZ + 16 * (wave - 4) : YY + 16 * wave) + fr;
#pragma unroll
            for (int rg = 0; rg < 4; ++rg) yo[(mc * 16 + 4 * fq + rg) * 64] = Y0[rg];
#pragma unroll
            for (int j = 0; j < 4; ++j) {
                const bf16x8 bc = fq < 2 ? *(const LAS bf16x8*)(BhT + (16 * j + fr) * WY_TS + fq * 8) : *(const LAS bf16x8*)(KhT + (16 * j + fr) * WY_TS + (fq - 2) * 8);
                X[j] = X[j] * *(const LAS f32x4*)(GC + 16 * j + 4 * fq);
                X[j] = __builtin_amdgcn_mfma_f32_16x16x32_bf16(bc, uc, X[j], 0, 0, 0);
                v2u w; w.x = cvt_pk_bf16(X[j][0], X[j][1]); w.y = cvt_pk_bf16(X[j][2], X[j][3]);
                *(LAS v2u*)(Xb + (16 * wave + fr) * WY_OS + 16 * j + 4 * fq) = w; }
        }
        LDS_WAIT();
    }
}

#define P1_LOAD_PARAMS(HH) do { int lf_ = fr, lq_ = fq, lt_ = tid; asm volatile("" : "+v"(lf_), "+v"(lq_), "+v"(lt_));   \
        const int h_ = (HH), ncol_ = h_ * 64 + ntl * 16 + lf_; \
        _Pragma("unroll") for (int ks = 0; ks < 2; ++ks) { bw[ks] = *(const bf16x8*)(L2T + (size_t)ncol_ * 64 + lq_ * 8 + ks * 32); ba[ks] = *(const bf16x8*)(L2T + (size_t)512 * 64 + (size_t)ncol_ * 64 + lq_ * 8 + ks * 32); } \
        _Pragma("unroll") for (int ks = 0; ks < 4; ++ks) bg[ks] = *(const bf16x8*)(L2T + (size_t)1024 * 64 + (size_t)ncol_ * 128 + lq_ * 8 + ks * 32); \
        if (lt_ < 128) { const int a_ = lt_ >> 4, c_ = (lt_ & 15) * 4; \
            const float* src_ = a_ == 0 ? A.in[I_W0] : a_ == 1 ? A.in[I_A0] : a_ == 2 ? A.in[I_KK] : a_ == 3 ? A.in[I_KA] : a_ == 4 ? A.in[I_RK] : A.in[I_MURKV] + (a_ - 5) * 512; \
            *(LAS f32x4*)(PRM + a_ * 64 + c_) = *(const f32x4*)(src_ + h_ * 64 + c_); } } while (0)
__device__ __forceinline__ void scan_pass1(const Args& A, LAS unsigned char* lds, int tid, int lane, int wave, int vcu, int G) {
    bf16* GB = (bf16*)(A.ws + WS_A1) + (size_t)MPAD * 512;
    bf16* YL = (bf16*)(A.ws + WS_YL); bf16* ZT = (bf16*)(A.ws + WS_ZT); bf16* BV = (bf16*)(A.ws + WS_BV);
    LAS bf16* HIDB = (LAS bf16*)(lds + P1_HIDB); LAS float* LO = (LAS float*)(lds + P1_LO); LAS float* SEQ = (LAS float*)(lds + P1_SEQ);
    LAS float* YY = (LAS float*)(lds + P1_YY); LAS float* ZZ = (LAS float*)(lds + P1_ZZ);
    const bf16* L2T = (const bf16*)(A.ws + WS_L2T);
    const bool prow_wave = wave >= 4;
    const int mt = wave & 1, ntl = wave >> 1;
    int tt = tid >> 4, cs = tid & 15, c4 = cs * 4, fr = lane & 15, fq = lane >> 4;
    f32x4 X[4];
    bf16x8 bw[2], ba[2], bg[4];
    LAS float* PRM = (LAS float*)(lds + P1_GG);
    int cur_h = -1;
    int ui = 0, unit; if (!p1_unit_at(0, vcu, G, unit)) return;
    int t0 = 0; P1Pre pre; p1_load(A, unit, 0, tt, cs, pre);
    for (;;) {
        { int lt_ = tid; asm volatile("" : "+v"(lt_)); tt = lt_ >> 4; cs = lt_ & 15; c4 = cs * 4; fr = lt_ & 15; fq = (lt_ >> 4) & 3; }
        bool prompt; int b, h, ch, T, rowbase; p1_decode(unit, prompt, b, h, ch, T, rowbase);
        const int hc = h * 64 + c4;
        if (t0 == 0 && G == 256 && ui < 8) {
            const size_t i16 = ((size_t)(ui * 256 + vcu) * NTHR + tid) * 16;
            cvt16_fp8_sliced(A.in[I_U], A.ws + WS_UB, PEER_SU, i16); cvt16_fp8_sliced(A.in[I_V], A.ws + WS_VB, PEER_SV, i16); }
        if (t0 == 0) {
            LAS bf16* Xb = (LAS bf16*)(lds + WY_XB);
#pragma unroll
            for (int j = 0; j < 4; ++j) { const int prow_ = 16 * (wave - 4) + fr, c0_ = 16 * j + 4 * fq;
#pragma unroll
                for (int e = 0; e < 4; ++e) X[j][e] = (prow_wave && prow_ == c0_ + e) ? 1.f : 0.f;
                v2u w; w.x = cvt_pk_bf16(X[j][0], X[j][1]); w.y = cvt_pk_bf16(X[j][2], X[j][3]);
                *(LAS v2u*)(Xb + (16 * wave + fr) * WY_OS + c0_) = w; }
        }
        if (h != cur_h) { cur_h = h; P1_LOAD_PARAMS(h); }
        size_t row, prow; bool hasprev; int nb; p1_rows(unit, t0, tt, row, prow, hasprev, nb);
        {
            float pa[16], pb[16]; float t8[8];
            unpack8(pre.pa0, t8);
#pragma unroll
            for (int i = 0; i < 8; ++i) pa[i] = t8[i];
            unpack8(pre.pa1, t8);
#pragma unroll
            for (int i = 0; i < 8; ++i) pa[8 + i] = t8[i];
            unpack8(pre.pb0, t8);
#pragma unroll
            for (int i = 0; i < 8; ++i) pb[i] = t8[i];
            unpack8(pre.pb1, t8);
#pragma unroll
            for (int i = 0; i < 8; ++i) pb[8 + i] = t8[i];
#pragma unroll
            for (int i = 0; i < 16; ++i) { float p = pa[i] + pb[i];
                if (cs < 4) p = 1.0f - 2.0f * __builtin_amdgcn_rcpf(__expf(2.0f * p) + 1.0f);
                else if (cs >= 8) p = sigm(p);
                pa[i] = p; }
            v4u o0, o1; o0.x = cvt_pk_bf16(pa[0], pa[1]); o0.y = cvt_pk_bf16(pa[2], pa[3]); o0.z = cvt_pk_bf16(pa[4], pa[5]); o0.w = cvt_pk_bf16(pa[6], pa[7]);
            o1.x = cvt_pk_bf16(pa[8], pa[9]); o1.y = cvt_pk_bf16(pa[10], pa[11]); o1.z = cvt_pk_bf16(pa[12], pa[13]); o1.w = cvt_pk_bf16(pa[14], pa[15]);
            *(LAS v4u*)(HIDB + tt * HID_STRIDE + cs * 16) = o0; *(LAS v4u*)(HIDB + tt * HID_STRIDE + cs * 16 + 8) = o1;
        }
        __syncthreads();
        {
            const LAS bf16* ap = HIDB + (mt * 16 + fr) * HID_STRIDE + fq * 8;
            f32x4 cw = (f32x4){0.f, 0.f, 0.f, 0.f}, ca = cw, cg = cw;
#pragma unroll
            for (int ks = 0; ks < 2; ++ks) { cw = __builtin_amdgcn_mfma_f32_16x16x32_bf16(*(const LAS bf16x8*)(ap + ks * 32), bw[ks], cw, 0, 0, 0);
                                             ca = __builtin_amdgcn_mfma_f32_16x16x32_bf16(*(const LAS bf16x8*)(ap + 64 + ks * 32), ba[ks], ca, 0, 0, 0); }
#pragma unroll
            for (int ks = 0; ks < 4; ++ks) cg = __builtin_amdgcn_mfma_f32_16x16x32_bf16(*(const LAS bf16x8*)(ap + 128 + ks * 32), bg[ks], cg, 0, 0, 0);
#pragma unroll
            for (int rg = 0; rg < 4; ++rg) { const int o = (mt * 16 + fq * 4 + rg) * 64 + ntl * 16 + fr; LO[o] = cw[rg]; LO[2048 + o] = ca[rg]; LO[4096 + o] = cg[rg]; }
        }
        __syncthreads();
        {
            const f32x4 w0v = *(const LAS f32x4*)(PRM + c4), a0v = *(const LAS f32x4*)(PRM + 64 + c4), kkv = *(const LAS f32x4*)(PRM + 128 + c4), kav = *(const LAS f32x4*)(PRM + 192 + c4),
                        rkv = *(const LAS f32x4*)(PRM + 256 + c4), mur = *(const LAS f32x4*)(PRM + 320 + c4), muk = *(const LAS f32x4*)(PRM + 384 + c4), muv = *(const LAS f32x4*)(PRM + 448 + c4);
            const f32x4 aw = w0v + *(const LAS f32x4*)(LO + tt * 64 + c4), aa = a0v + *(const LAS f32x4*)(LO + 2048 + tt * 64 + c4), ag = *(const LAS f32x4*)(LO + 4096 + tt * 64 + c4);
            f32x4 r = (f32x4){bf_lo(pre.zr.x), bf_hi(pre.zr.x), bf_lo(pre.zr.y), bf_hi(pre.zr.y)}, k = (f32x4){bf_lo(pre.zk.x), bf_hi(pre.zk.x), bf_lo(pre.zk.y), bf_hi(pre.zk.y)},
                  v = (f32x4){bf_lo(pre.zv.x), bf_hi(pre.zv.x), bf_lo(pre.zv.y), bf_hi(pre.zv.y)};
            const f32x4 rpv = (f32x4){bf_lo(pre.pr.x), bf_hi(pre.pr.x), bf_lo(pre.pr.y), bf_hi(pre.pr.y)}, kpv = (f32x4){bf_lo(pre.pk.x), bf_hi(pre.pk.x), bf_lo(pre.pk.y), bf_hi(pre.pk.y)},
                        vpv = (f32x4){bf_lo(pre.pv.x), bf_hi(pre.pv.x), bf_lo(pre.pv.y), bf_hi(pre.pv.y)};
            r = r + mur * (rpv - r); k = k + muk * (kpv - k); v = v + muv * (vpv - v);
            f32x4 dec, asg, kk, km, av, bv;
            float ssq = 0.f, bon = 0.f;
#pragma unroll
            for (int i = 0; i < 4; ++i) {
                const float x = -aw[i];
                const float sp = fmaxf(x, 0.f) + __logf(1.0f + __expf(-fabsf(x)));
                const float wraw = -sp - 0.5f;
                dec[i] = -__expf(wraw);
                asg[i] = sigm(aa[i]);
                kk[i] = k[i] * kkv[i]; ssq += kk[i] * kk[i];
                km[i] = k[i] * (1.0f + (asg[i] - 1.0f) * kav[i]);
                bon += r[i] * km[i] * rkv[i];
            }
            ssq = sum16(ssq); bon = sum16(bon);
            const float inv = 1.0f / fmaxf(sqrtf(ssq), 1e-12f);
#pragma unroll
            for (int i = 0; i < 4; ++i) { kk[i] *= inv; av[i] = -kk[i]; bv[i] = kk[i] * asg[i]; }
            LAS float* sq_ = SEQ + tt * 384 + c4;
            *(LAS f32x4*)(sq_) = av; *(LAS f32x4*)(sq_ + 64) = dec; *(LAS f32x4*)(sq_ + 128) = bv; *(LAS f32x4*)(sq_ + 192) = km; *(LAS f32x4*)(sq_ + 256) = r; *(LAS f32x4*)(sq_ + 320) = v;
            if (tt < nb) {
                v2u w; w.x = cvt_pk_bf16(ag[0], ag[1]); w.y = cvt_pk_bf16(ag[2], ag[3]); *(v2u*)(GB + row * 512 + hc) = w;
                w.x = cvt_pk_bf16(bon * v[0], bon * v[1]); w.y = cvt_pk_bf16(bon * v[2], bon * v[3]); *(v2u*)(BV + row * 512 + hc) = w;
            }
        }
        int nunit = unit, nt0 = t0 + SC_TB, nui = ui; bool more = true;
        if (nt0 >= T) { nt0 = 0; nui = ui + 1; more = p1_unit_at(nui, vcu, G, nunit); }
        if (more) p1_load(A, nunit, nt0, tt, cs, pre);
        __syncthreads();
        p1_wy(X, SEQ, YY, ZZ, lds, nb, tid, lane, wave);
        __syncthreads();
        if (tt < nb) {
            const f32x4 y = *(const LAS f32x4*)(YY + tt * 64 + c4), z = *(const LAS f32x4*)(ZZ + tt * 64 + c4);
            v2u w; w.x = cvt_pk_bf16(y[0], y[1]); w.y = cvt_pk_bf16(y[2], y[3]); *(v2u*)(YL + row * 512 + hc) = w;
            w.x = cvt_pk_bf16(z[0], z[1]); w.y = cvt_pk_bf16(z[2], z[3]); *(v2u*)(ZT + row * 512 + hc) = w;
        }
        if (t0 + SC_TB >= T) {
#pragma unroll
            for (int j = 0; j < 4; ++j) {
                if (!prow_wave) *(f32x4*)((float*)A.out + (size_t)unit * 4096 + (16 * wave + fr) * 64 + 16 * j + 4 * fq) = X[j];
                else { v2u o; o.x = cvt_pk_bf16(X[j][0], X[j][1]); o.y = cvt_pk_bf16(X[j][2], X[j][3]);
                    *(v2u*)((bf16*)((unsigned char*)A.out + OB_MB) + (size_t)unit * 4096 + (16 * (wave - 4) + fr) * 64 + 16 * j + 4 * fq) = o; }
            }
        }
        if (!more) break;
        unit = nunit; t0 = nt0; ui = nui;
    }
    __syncthreads();
}

constexpr int P2_SP = 68, P2_MP = 80, P2_ML = 16 * P2_SP * 4, P2_PL = P2_ML + 64 * P2_MP * 4;
__device__ __forceinline__ void scan_pass2_rows(const float* Sinit, int unit0, int nchunks, int v0, float* outfin, bool slots, const Args& A, LAS unsigned char* lds, int tid, int lane, int wave) {
    LAS float* Sl = (LAS float*)lds; LAS float* Ml = (LAS float*)(lds + P2_ML); LAS float* Pl = (LAS float*)(lds + P2_PL);
    const int nt = wave & 3, kh = wave >> 2, fr = lane & 15, fq = lane >> 4;
    float* NB = (float*)A.out; const bf16* MB = (const bf16*)((const unsigned char*)A.out + OB_MB);
    { const int idx = tid * 2, row = idx >> 6, col = idx & 63;
      const f32x2 s0 = Sinit ? *(const f32x2*)(Sinit + (size_t)(v0 + row) * 64 + col) : (f32x2){0.f, 0.f};
      *(LAS f32x2*)(Sl + row * P2_SP + col) = s0; }
    v4u mreg = *(const v4u*)(MB + (size_t)unit0 * 4096 + tid * 8);
    float nreg[4] = {0.f, 0.f, 0.f, 0.f};
    if (kh == 0) {
#pragma unroll
        for (int rg = 0; rg < 4; ++rg) nreg[rg] = NB[(size_t)unit0 * 4096 + (v0 + fq * 4 + rg) * 64 + nt * 16 + fr]; }
    f32x4 acc = (f32x4){0.f, 0.f, 0.f, 0.f};
    for (int c = 0; c < nchunks; ++c) {
        { const int row = tid >> 3, col = (tid & 7) * 8; LAS float* mp = Ml + row * P2_MP + col;
          *(LAS f32x4*)mp = (f32x4){bf_lo(mreg.x), bf_hi(mreg.x), bf_lo(mreg.y), bf_hi(mreg.y)}; *(LAS f32x4*)(mp + 4) = (f32x4){bf_lo(mreg.z), bf_hi(mreg.z), bf_lo(mreg.w), bf_hi(mreg.w)}; }
        __syncthreads();
        float ncur[4] = {nreg[0], nreg[1], nreg[2], nreg[3]};
        if (c + 1 < nchunks) { mreg = *(const v4u*)(MB + (size_t)(unit0 + c + 1) * 4096 + tid * 8);
            if (kh == 0) {
#pragma unroll
                for (int rg = 0; rg < 4; ++rg) nreg[rg] = NB[(size_t)(unit0 + c + 1) * 4096 + (v0 + fq * 4 + rg) * 64 + nt * 16 + fr]; } }
        f32x4 a0 = (f32x4){0.f, 0.f, 0.f, 0.f}, a1 = a0;
        const LAS float* sp = Sl + fr * P2_SP + kh * 32 + fq; const LAS float* mp = Ml + (kh * 32 + fq) * P2_MP + nt * 16 + fr;
#pragma unroll
        for (int ks = 0; ks < 8; ks += 2) { a0 = __builtin_amdgcn_mfma_f32_16x16x4f32(sp[4 * ks], mp[4 * ks * P2_MP], a0, 0, 0, 0); a1 = __builtin_amdgcn_mfma_f32_16x16x4f32(sp[4 * ks + 4], mp[(4 * ks + 4) * P2_MP], a1, 0, 0, 0); }
        acc = a0 + a1;
        if (kh == 1) *(LAS f32x4*)(Pl + nt * 256 + lane * 4) = acc;
        __syncthreads();
        if (kh == 0) {
            acc = acc + *(const LAS f32x4*)(Pl + nt * 256 + lane * 4) + (f32x4){ncur[0], ncur[1], ncur[2], ncur[3]};
#pragma unroll
            for (int rg = 0; rg < 4; ++rg) { Sl[(fq * 4 + rg) * P2_SP + nt * 16 + fr] = acc[rg];
                if (slots) NB[(size_t)(unit0 + c) * 4096 + (v0 + fq * 4 + rg) * 64 + nt * 16 + fr] = acc[rg]; }
        }
    }
    if (kh == 0) {
#pragma unroll
        for (int rg = 0; rg < 4; ++rg) outfin[(size_t)(v0 + fq * 4 + rg) * 64 + nt * 16 + fr] = acc[rg]; }
    __syncthreads();
}

__device__ __forceinline__ void scan_pass3_wave(const Args& A, int unit, int wq, int lane) {
    const bool prompt = unit < NUNITS_P;
    const int b = prompt ? unit >> 9 : (unit - NUNITS_P) >> 3, h = prompt ? (unit >> 6) & 7 : unit & 7, ch = prompt ? unit & 63 : 0;
    const int T = prompt ? 64 : SEQ_S, rowbase = prompt ? b * SEQ_P + ch * 64 : NPROMPT + b * SEQ_S;
    if (wq * 16 >= T) return;
    const float* S0 = prompt ? (ch > 0 ? (const float*)A.out + (size_t)(unit - 1) * 4096 : nullptr) : A.in[I_SWKV] + (size_t)(b * 8 + h) * 4096;
    const bf16* ZT = (const bf16*)(A.ws + WS_ZT); const bf16* YL = (const bf16*)(A.ws + WS_YL); const bf16* BV = (const bf16*)(A.ws + WS_BV);
    bf16* YB = (bf16*)(A.ws + WS_A1) + (size_t)MPAD * 512;
    const int fr = lane & 15, fq = lane >> 4;
    const size_t row = (size_t)(rowbase + wq * 16 + fr);
    f32x4 acc[4];
#pragma unroll
    for (int mt = 0; mt < 4; ++mt) acc[mt] = (f32x4){0.f, 0.f, 0.f, 0.f};
    if (S0) {
        bf16x8 bz[2];
#pragma unroll
        for (int ks = 0; ks < 2; ++ks) bz[ks] = *(const bf16x8*)(ZT + row * 512 + h * 64 + ks * 32 + fq * 8);
#pragma unroll
        for (int mt = 0; mt < 4; ++mt)
#pragma unroll
            for (int ks = 0; ks < 2; ++ks) { const float* sp = S0 + (size_t)(mt * 16 + fr) * 64 + ks * 32 + fq * 8; const f32x4 s0 = *(const f32x4*)sp, s1 = *(const f32x4*)(sp + 4);
                v4u pk; pk.x = cvt_pk_bf16(s0[0], s0[1]); pk.y = cvt_pk_bf16(s0[2], s0[3]); pk.z = cvt_pk_bf16(s1[0], s1[1]); pk.w = cvt_pk_bf16(s1[2], s1[3]);
                acc[mt] = __builtin_amdgcn_mfma_f32_16x16x32_bf16(__builtin_bit_cast(bf16x8, pk), bz[ks], acc[mt], 0, 0, 0); }
    }
    float sm = 0.f;
#pragma unroll
    for (int mt = 0; mt < 4; ++mt) { const v2u yl = *(const v2u*)(YL + row * 512 + h * 64 + mt * 16 + fq * 4);
        acc[mt][0] += bf_lo(yl.x); acc[mt][1] += bf_hi(yl.x); acc[mt][2] += bf_lo(yl.y); acc[mt][3] += bf_hi(yl.y);
        sm += (acc[mt][0] + acc[mt][1]) + (acc[mt][2] + acc[mt][3]); }
    sm += __shfl_xor(sm, 16); sm += __shfl_xor(sm, 32);
    const float mean = sm * (1.f / 64.f); float sv = 0.f;
#pragma unroll
    for (int mt = 0; mt < 4; ++mt) { acc[mt] = acc[mt] - mean; sv += (acc[mt][0] * acc[mt][0] + acc[mt][1] * acc[mt][1]) + (acc[mt][2] * acc[mt][2] + acc[mt][3] * acc[mt][3]); }
    sv += __shfl_xor(sv, 16); sv += __shfl_xor(sv, 32);
    const float rs = 1.0f / sqrtf(sv * (1.f / 64.f) + 64e-5f);
#pragma unroll
    for (int mt = 0; mt < 4; ++mt) { const int c = h * 64 + mt * 16 + fq * 4;
        const f32x4 gw = *(const f32x4*)(A.in[I_GNW] + c), gb = *(const f32x4*)(A.in[I_GNB] + c);
        const v2u bvw = *(const v2u*)(BV + row * 512 + c), gg = *(const v2u*)(YB + row * 512 + c);
        f32x4 o = acc[mt] * rs * gw + gb + (f32x4){bf_lo(bvw.x), bf_hi(bvw.x), bf_lo(bvw.y), bf_hi(bvw.y)};
        o = o * (f32x4){bf_lo(gg.x), bf_hi(gg.x), bf_lo(gg.y), bf_hi(gg.y)};
        v2u w; w.x = cvt_pk_bf16(o[0], o[1]); w.y = cvt_pk_bf16(o[2], o[3]); *(v2u*)(YB + row * 512 + c) = w; }
}

__device__ __forceinline__ void tk_insert(float (&tv)[16], float x) {
#pragma unroll
    for (int i = 15; i >= 1; --i) tv[i] = __builtin_amdgcn_fmed3f(tv[i - 1], x, tv[i]);
    tv[0] = __builtin_fmaxf(tv[0], x);
}
__device__ __forceinline__ float gelu_tanh(float x) {
    const float u = 0.7978845608028654f * (x + 0.044715f * x * x * x);
    const float th = 1.0f - 2.0f * __builtin_amdgcn_rcpf(__expf(2.0f * u) + 1.0f);
    return 0.5f * x * (1.0f + th);
}
constexpr int NTILE32 = NTOK / 32;
constexpr int CW_QU = 8192, CW_QV = 8192 + 512;

constexpr int TK_STRIDE = 68, TK_BYTES = 64 * TK_STRIDE * 4;
__device__ __forceinline__ void topk_scores64(const bf16* Q, const bf16* KB, LAS float* SC, int t0, int hp, int p, int half, int lane, const bf16x8 (&af)[2][2][4]) {
    const int fr = lane & 15, fq = lane >> 4;
#pragma unroll
    for (int hs = 0; hs < 2; ++hs) {
        const bf16* kbase = KB + (size_t)(((hp + 4 * hs) * 2 + p) * 128 + half * 64 + fr) * 128 + fq * 8;
#pragma unroll
        for (int n = 0; n < 4; ++n) {
            bf16x8 bfr[4];
#pragma unroll
            for (int ks = 0; ks < 4; ++ks) bfr[ks] = *(const bf16x8*)(kbase + (size_t)n * 16 * 128 + ks * 32);
            f32x4 acc0 = (f32x4){0.f, 0.f, 0.f, 0.f}, acc1 = acc0;
#pragma unroll
            for (int ks = 0; ks < 4; ++ks) { acc0 = __builtin_amdgcn_mfma_f32_16x16x32_bf16(af[hs][0][ks], bfr[ks], acc0, 0, 0, 0); acc1 = __builtin_amdgcn_mfma_f32_16x16x32_bf16(af[hs][1][ks], bfr[ks], acc1, 0, 0, 0); }
#pragma unroll
            for (int rg = 0; rg < 4; ++rg) { SC[(hs * 32 + fq * 4 + rg) * TK_STRIDE + n * 16 + fr] = acc0[rg]; SC[(hs * 32 + 16 + fq * 4 + rg) * TK_STRIDE + n * 16 + fr] = acc1[rg]; }
        }
    }
}
__device__ __forceinline__ void peer_topk_phase(const Args& A, LAS unsigned char* lds, int tid, int lane, int wave, int vcu, int G) {
    const bf16* Q = (const bf16*)(A.ws + WS_ZG); const bf16* KB = (const bf16*)(A.ws + WS_KEYS); const float* SSP = (const float*)(A.ws + WS_SSP);
    unsigned short* EIDX = (unsigned short*)(A.ws + WS_EIDX); float* GATE = (float*)(A.ws + WS_GATE); float* RSTD = (float*)(A.ws + WS_RSTD);
    LAS float* SC = (LAS float*)(lds + wave * TK_BYTES);
    const int fr = lane & 15, fq = lane >> 4, tokl = lane & 31, hsel = lane >> 5;
    for (int u = wave * G + vcu; u < NTILE32 * 4; u += G * NWAVES) {
        const int t0 = (u >> 2) * 32, hp = u & 3, h = hp + 4 * hsel;
        const float* sp = SSP + (size_t)(t0 + tokl) * 16;
        const f32x4 s0 = *(const f32x4*)sp, s1 = *(const f32x4*)(sp + 4), s2 = *(const f32x4*)(sp + 8), s3 = *(const f32x4*)(sp + 12);
        const float ssq = ((s0[0] + s0[1]) + (s0[2] + s0[3])) + ((s1[0] + s1[1]) + (s1[2] + s1[3])) + ((s2[0] + s2[1]) + (s2[2] + s2[3])) + ((s3[0] + s3[1]) + (s3[2] + s3[3]));
        const float rstd = 1.0f / sqrtf(ssq * (1.f / DM) + 1e-6f);
        float tv0[16], tv1[16], cv[16];
#pragma unroll
        for (int p = 0; p < 2; ++p) {
            bf16x8 af[2][2][4];
#pragma unroll
            for (int hs = 0; hs < 2; ++hs)
#pragma unroll
                for (int mt = 0; mt < 2; ++mt) { const bf16* qp = Q + (size_t)(t0 + mt * 16 + fr) * 2048 + (hp + 4 * hs) * 256 + p * 128 + fq * 8;
#pragma unroll
                    for (int ks = 0; ks < 4; ++ks) af[hs][mt][ks] = *(const bf16x8*)(qp + ks * 32); }
            float tv[16];
#pragma unroll
            for (int i = 0; i < 16; ++i) tv[i] = -3.0e38f;
            for (int half = 0; half < 2; ++half) {
                topk_scores64(Q, KB, SC, t0, hp, p, half, lane, af);
                LDS_WAIT();
                const LAS float* mine = SC + lane * TK_STRIDE;
#pragma unroll 2
                for (int n = 0; n < 64; n += 4) { const f32x4 x4 = *(const LAS f32x4*)(mine + n);
#pragma unroll
                    for (int e = 0; e < 4; ++e) tk_insert(tv, __uint_as_float((__float_as_uint(x4[e]) & 0xFFFFFF80u) | (unsigned)(half * 64 + n + e))); }
                LDS_WAIT();
            }
#pragma unroll
            for (int i = 0; i < 16; ++i) { if (p == 0) tv0[i] = tv[i]; else tv1[i] = tv[i]; }
        }
        LAS int* li = (LAS int*)SC + lane * 33;
#pragma unroll
        for (int q = 0; q < 16; ++q) { li[q] = (int)(__float_as_uint(tv0[q]) & 127u); li[16 + q] = (int)(__float_as_uint(tv1[q]) & 127u);
            tv0[q] = __uint_as_float(__float_as_uint(tv0[q]) & 0xFFFFFF80u); tv1[q] = __uint_as_float(__float_as_uint(tv1[q]) & 0xFFFFFF80u); }
#pragma unroll
        for (int q = 0; q < 16; ++q) cv[q] = -3.0e38f;
#pragma unroll
        for (int a = 0; a < 16; ++a)
#pragma unroll
            for (int b = 0; b < 16; ++b) if ((a + 1) * (b + 1) <= 16)
                tk_insert(cv, __uint_as_float((__float_as_uint(tv0[a] + tv1[b]) & 0xFFFFFF00u) | (unsigned)(a * 16 + b)));
        LDS_WAIT();
        float e[16], den = 0.f; unsigned ci[16];
        const float c0 = __uint_as_float(__float_as_uint(cv[0]) & 0xFFFFFF00u);
#pragma unroll
        for (int q = 0; q < 16; ++q) { const unsigned kb = __float_as_uint(cv[q]); const float cq = __uint_as_float(kb & 0xFFFFFF00u);
            e[q] = __expf((cq - c0) * rstd); den += e[q]; ci[q] = (unsigned)(li[(kb >> 4) & 15] * 128 + li[16 + (kb & 15)]); }
        const float inv = 1.0f / den;
        LDS_WAIT();
        {
            const size_t tok = (size_t)(t0 + tokl);
            v4u w0, w1; w0.x = ci[0] | (ci[1] << 16); w0.y = ci[2] | (ci[3] << 16); w0.z = ci[4] | (ci[5] << 16); w0.w = ci[6] | (ci[7] << 16);
            w1.x = ci[8] | (ci[9] << 16); w1.y = ci[10] | (ci[11] << 16); w1.z = ci[12] | (ci[13] << 16); w1.w = ci[14] | (ci[15] << 16);
            *(v4u*)(EIDX + tok * 128 + h * 16) = w0; *(v4u*)(EIDX + tok * 128 + h * 16 + 8) = w1;
#pragma unroll
            for (int q = 0; q < 4; ++q) *(f32x4*)(GATE + tok * 128 + h * 16 + 4 * q) = (f32x4){e[4 * q] * inv, e[4 * q + 1] * inv, e[4 * q + 2] * inv, e[4 * q + 3] * inv};
            if (h == 0) RSTD[tok] = rstd;
        }
    }
}

constexpr int PEER_ITEM = 40, NITEM128 = NTOK / PEER_ITEM;
__device__ __forceinline__ bool peer_next_item(gu32* qbase, int xcc, int& qs, int& slice, int& item, LAS unsigned char* lds, int tid) {
    LAS int* box = (LAS int*)(lds + LDSCTL_OFF + 64);
    for (;;) {
        if (qs >= 8) return false;
        slice = (xcc + qs) & 7;
        if (tid == 0) box[0] = (int)__hip_atomic_fetch_add((unsigned*)(qbase + 64 * slice), 1u, RLX_AGENT);
        __syncthreads();
        item = box[0];
        __syncthreads();
        if (item < NITEM128) return true;
        ++qs;
    }
}

__device__ __forceinline__ void peer_u_phase(const Args& A, LAS unsigned char* lds, int tid, int lane, int wave, gu32* ctl, int qoff) {
    const unsigned char* Uq = A.ws + WS_UB; const bf16* XG = (const bf16*)(A.ws + WS_A1);
    const unsigned short* EIDX = (const unsigned short*)(A.ws + WS_EIDX); float* PART = (float*)(A.ws + WS_PART);
    const int xcc = (int)(xb_xcc_id() & 7u), rg = lane >> 3, c8 = lane & 7;
    LAS int* we = (LAS int*)(lds + wave * 1024);
    int qs = 0, slice, item;
    while (peer_next_item(ctl + CW_QU + qoff, xcc, qs, slice, item, lds, tid)) {
        const unsigned char* us = Uq + (size_t)slice * 16384 * 128 + c8 * 16;
        size_t tok = (size_t)(item * PEER_ITEM + wave);
        unsigned pair = *(const unsigned*)(EIDX + tok * 128 + 2 * lane);
        v4u xa = *(const v4u*)(XG + tok * DM + slice * 128 + c8 * 16), xb = *(const v4u*)(XG + tok * DM + slice * 128 + c8 * 16 + 8);
        for (int tt = 0; tt < PEER_ITEM / NWAVES; ++tt) {
            we[2 * lane] = (int)(pair & 0xffffu); we[2 * lane + 1] = (int)(pair >> 16);
            const f32x2 x[8] = {(f32x2){bf_lo(xa.x), bf_hi(xa.x)}, (f32x2){bf_lo(xa.y), bf_hi(xa.y)}, (f32x2){bf_lo(xa.z), bf_hi(xa.z)}, (f32x2){bf_lo(xa.w), bf_hi(xa.w)},
                                (f32x2){bf_lo(xb.x), bf_hi(xb.x)}, (f32x2){bf_lo(xb.y), bf_hi(xb.y)}, (f32x2){bf_lo(xb.z), bf_hi(xb.z)}, (f32x2){bf_lo(xb.w), bf_hi(xb.w)}};
            LDS_WAIT();
            v4u w[16];
#pragma unroll
            for (int it = 0; it < 16; ++it) w[it] = *(const v4u*)(us + (size_t)we[it * 8 + rg] * 128);
            const size_t ctok = tok;
            if (tt + 1 < PEER_ITEM / NWAVES) { tok += NWAVES; pair = *(const unsigned*)(EIDX + tok * 128 + 2 * lane);
                xa = *(const v4u*)(XG + tok * DM + slice * 128 + c8 * 16); xb = *(const v4u*)(XG + tok * DM + slice * 128 + c8 * 16 + 8); }
            float dlo = 0.f, dhi = 0.f;
#pragma unroll
            for (int it = 0; it < 16; ++it) {
                f32x2 d = __builtin_amdgcn_cvt_pk_f32_fp8(w[it].x, false) * x[0]; d += __builtin_amdgcn_cvt_pk_f32_fp8(w[it].x, true) * x[1];
                d += __builtin_amdgcn_cvt_pk_f32_fp8(w[it].y, false) * x[2]; d += __builtin_amdgcn_cvt_pk_f32_fp8(w[it].y, true) * x[3];
                d += __builtin_amdgcn_cvt_pk_f32_fp8(w[it].z, false) * x[4]; d += __builtin_amdgcn_cvt_pk_f32_fp8(w[it].z, true) * x[5];
                d += __builtin_amdgcn_cvt_pk_f32_fp8(w[it].w, false) * x[6]; d += __builtin_amdgcn_cvt_pk_f32_fp8(w[it].w, true) * x[7];
                const float ds = sum8(d.x + d.y);
                if ((it & 7) == c8) { if (it < 8) dlo = ds; else dhi = ds; }
            }
            float* pp = PART + (ctok * 8 + slice) * 128;
            pp[c8 * 8 + rg] = dlo; pp[(c8 + 8) * 8 + rg] = dhi;
            LDS_WAIT();
        }
    }
}

__device__ __forceinline__ void peer_coef_phase(const Args& A, int lane, int wave, int vcu, int G) {
    const float* PART = (const float*)(A.ws + WS_PART); const float* GATE = (const float*)(A.ws + WS_GATE); const float* RSTD = (const float*)(A.ws + WS_RSTD);
    float* COEF = (float*)(A.ws + WS_COEF);
    for (int tok = vcu * NWAVES + wave; tok < NTOK; tok += G * NWAVES) {
        const float* pp = PART + (size_t)tok * 1024 + 2 * lane;
        f32x2 d = *(const f32x2*)pp;
#pragma unroll
        for (int j = 1; j < 8; ++j) d += *(const f32x2*)(pp + j * 128);
        const float sc = RSTD[tok] * (1.0f / PEER_SU); const f32x2 gt = *(const f32x2*)(GATE + (size_t)tok * 128 + 2 * lane);
        f32x2 cf; cf.x = gt.x * gelu_tanh(d.x * sc) * (1.0f / PEER_SV); cf.y = gt.y * gelu_tanh(d.y * sc) * (1.0f / PEER_SV);
        *(f32x2*)(COEF + (size_t)tok * 128 + 2 * lane) = cf;
    }
}

__device__ __forceinline__ void peer_v_phase(const Args& A, LAS unsigned char* lds, int tid, int lane, int wave, gu32* ctl) {
    const unsigned char* Vq = A.ws + WS_VB;
    const unsigned short* EIDX = (const unsigned short*)(A.ws + WS_EIDX); const float* COEF = (const float*)(A.ws + WS_COEF);
    float* X1 = A.out + O_Y; float* SS2 = (float*)(A.ws + WS_SS2);
    const int xcc = (int)(xb_xcc_id() & 7u), rg = lane >> 3, c8 = lane & 7;
    LAS int* we = (LAS int*)(lds + wave * 8192);
    LAS float* wc = (LAS float*)(we + 128); LAS float* wp = (LAS float*)(we + 256);
    int qs = 0, slice, item;
    while (peer_next_item(ctl + CW_QV, xcc, qs, slice, item, lds, tid)) {
        const unsigned char* vs = Vq + (size_t)slice * 16384 * 128 + c8 * 16;
        size_t tok = (size_t)(item * PEER_ITEM + wave);
        unsigned pair = *(const unsigned*)(EIDX + tok * 128 + 2 * lane); f32x2 cf = *(const f32x2*)(COEF + tok * 128 + 2 * lane);
        const bf16* XGv = (const bf16*)(A.ws + WS_A1);
        const f32x2 g2v = *(const f32x2*)(A.in[I_N2G] + slice * 128 + 2 * lane); const f32x2 rg2 = (f32x2){1.0f / g2v.x, 1.0f / g2v.y};
        unsigned xold = *(const unsigned*)(XGv + tok * DM + slice * 128 + 2 * lane);
        for (int tt = 0; tt < PEER_ITEM / NWAVES; ++tt) {
            we[2 * lane] = (int)(pair & 0xffffu); we[2 * lane + 1] = (int)(pair >> 16); *(LAS f32x2*)(wc + 2 * lane) = cf;
            const f32x2 xcur = (f32x2){bf_lo(xold) * rg2.x, bf_hi(xold) * rg2.y}; const size_t ctok = tok;
            LDS_WAIT();
            v4u w[16];
#pragma unroll
            for (int it = 0; it < 16; ++it) w[it] = *(const v4u*)(vs + (size_t)we[it * 8 + rg] * 128);
            if (tt + 1 < PEER_ITEM / NWAVES) { tok += NWAVES; pair = *(const unsigned*)(EIDX + tok * 128 + 2 * lane); cf = *(const f32x2*)(COEF + tok * 128 + 2 * lane);
                xold = *(const unsigned*)(XGv + tok * DM + slice * 128 + 2 * lane); }
            f32x2 o[8];
#pragma unroll
            for (int q = 0; q < 8; ++q) o[q] = (f32x2){0.f, 0.f};
#pragma unroll
            for (int it = 0; it < 16; ++it) {
                const float c = wc[it * 8 + rg]; const f32x2 c2 = (f32x2){c, c};
                o[0] += c2 * __builtin_amdgcn_cvt_pk_f32_fp8(w[it].x, false); o[1] += c2 * __builtin_amdgcn_cvt_pk_f32_fp8(w[it].x, true);
                o[2] += c2 * __builtin_amdgcn_cvt_pk_f32_fp8(w[it].y, false); o[3] += c2 * __builtin_amdgcn_cvt_pk_f32_fp8(w[it].y, true);
                o[4] += c2 * __builtin_amdgcn_cvt_pk_f32_fp8(w[it].z, false); o[5] += c2 * __builtin_amdgcn_cvt_pk_f32_fp8(w[it].z, true);
                o[6] += c2 * __builtin_amdgcn_cvt_pk_f32_fp8(w[it].w, false); o[7] += c2 * __builtin_amdgcn_cvt_pk_f32_fp8(w[it].w, true);
            }
#pragma unroll
            for (int q = 0; q < 4; ++q) *(LAS f32x4*)(wp + rg * 128 + c8 * 16 + 4 * q) = (f32x4){o[2 * q].x, o[2 * q].y, o[2 * q + 1].x, o[2 * q + 1].y};
            LDS_WAIT();
            f32x2 acc = *(const LAS f32x2*)(wp + 2 * lane);
#pragma unroll
            for (int r = 1; r < 8; ++r) acc += *(const LAS f32x2*)(wp + r * 128 + 2 * lane);
            const f32x2 x2 = xcur + acc;
            *(f32x2*)(X1 + ctok * DM + slice * 128 + 2 * lane) = x2;
            float ss = sum16(x2.x * x2.x + x2.y * x2.y); ss += __shfl_xor(ss, 16); ss += __shfl_xor(ss, 32);
            if (lane == 0) SS2[ctok * 8 + slice] = ss;
            LDS_WAIT();
        }
    }
}

__device__ __forceinline__ void peer_final_phase(const Args& A, int lane, int wave, int vcu, int G) {
    float* X1 = A.out + O_Y; const float* SS2 = (const float*)(A.ws + WS_SS2); const float* gf = A.in[I_NFG] + lane * 16;
    const f32x4 g0 = *(const f32x4*)gf, g1 = *(const f32x4*)(gf + 4), g2 = *(const f32x4*)(gf + 8), g3 = *(const f32x4*)(gf + 12);
    for (int tok = vcu * NWAVES + wave; tok < NTOK; tok += G * NWAVES) {
        const f32x4 sa = *(const f32x4*)(SS2 + (size_t)tok * 8), sb = *(const f32x4*)(SS2 + (size_t)tok * 8 + 4);
        const float ss = ((sa[0] + sa[1]) + (sa[2] + sa[3])) + ((sb[0] + sb[1]) + (sb[2] + sb[3]));
        const float rf = 1.0f / sqrtf(ss * (1.f / DM) + 1e-6f);
        float* yr = X1 + (size_t)tok * DM + lane * 16;
        const f32x4 y0 = *(const f32x4*)yr, y1 = *(const f32x4*)(yr + 4), y2 = *(const f32x4*)(yr + 8), y3 = *(const f32x4*)(yr + 12);
        *(f32x4*)yr = y0 * rf * g0; *(f32x4*)(yr + 4) = y1 * rf * g1; *(f32x4*)(yr + 8) = y2 * rf * g2; *(f32x4*)(yr + 12) = y3 * rf * g3;
    }
}

__device__ __forceinline__ void sg_partial(const bf16* Ap, int lda, const bf16* Bp, int ldb, LAS f32x4* red, int lane, int wave) {
    const int fr = lane & 15, fq = lane >> 4;
    bf16x8 a[2][4], b[4][4];
#pragma unroll
    for (int mi = 0; mi < 2; ++mi)
#pragma unroll
        for (int ks = 0; ks < 4; ++ks) a[mi][ks] = *(const bf16x8*)(Ap + (size_t)(16 * mi + fr) * lda + 32 * ks + 8 * fq);
#pragma unroll
    for (int nj = 0; nj < 4; ++nj)
#pragma unroll
        for (int ks = 0; ks < 4; ++ks) b[nj][ks] = *(const bf16x8*)(Bp + (size_t)(16 * nj + fr) * ldb + 32 * ks + 8 * fq);
    f32x4 acc[2][4];
#pragma unroll
    for (int mi = 0; mi < 2; ++mi)
#pragma unroll
        for (int nj = 0; nj < 4; ++nj) acc[mi][nj] = (f32x4){0.f, 0.f, 0.f, 0.f};
#pragma unroll
    for (int ks = 0; ks < 4; ++ks)
#pragma unroll
        for (int mi = 0; mi < 2; ++mi)
#pragma unroll
            for (int nj = 0; nj < 4; ++nj) acc[mi][nj] = __builtin_amdgcn_mfma_f32_16x16x32_bf16(b[nj][ks], a[mi][ks], acc[mi][nj], 0, 0, 0);
#pragma unroll
    for (int mi = 0; mi < 2; ++mi)
#pragma unroll
        for (int nj = 0; nj < 4; ++nj) red[(wave * 8 + mi * 4 + nj) * 64 + lane] = acc[mi][nj];
}
__device__ __forceinline__ f32x4 sg_sum(const LAS f32x4* red, int w0, int nw, int wave, int lane) {
    f32x4 s = red[(w0 * 8 + wave) * 64 + lane];
    for (int w = 1; w < nw; ++w) s += red[((w0 + w) * 8 + wave) * 64 + lane];
    return s;
}
__device__ __forceinline__ void sample_gemm2(const Args& A, LAS unsigned char* lds, int t, int lane, int wave) {
    unsigned char* ws = A.ws; const int fr = lane & 15, fq = lane >> 4;
    const int row0 = NPROMPT + (t >> 4) * 32, col0 = (t & 15) * 64;
    LAS f32x4* red = (LAS f32x4*)lds;
    const bf16* Ab = (const bf16*)(ws + WS_A1) + (wave >= 4 ? (size_t)MPAD * 512 : 0); const bf16* Bb = (const bf16*)(ws + (wave >= 4 ? WS_WPB : WS_WPA));
    sg_partial(Ab + (size_t)row0 * 512 + (wave & 3) * 128, 512, Bb + (size_t)col0 * 512 + (wave & 3) * 128, 512, red, lane, wave);
    const int row = row0 + 16 * (wave >> 2) + fr, c = col0 + 16 * (wave & 3) + 4 * fq;
    const bf16* Zg = (const bf16*)(ws + WS_ZG) + (size_t)row * 2048;
    const v2u ga = *(const v2u*)(Zg + c), gb = *(const v2u*)(Zg + 1024 + c);
    __syncthreads();
    const f32x4 pa = sg_sum(red, 0, 4, wave, lane), pb = sg_sum(red, 4, 4, wave, lane);
    const float o0 = sigm(bf_lo(ga.x)) * pa[0] + sigm(bf_lo(gb.x)) * pb[0], o1 = sigm(bf_hi(ga.x)) * pa[1] + sigm(bf_hi(gb.x)) * pb[1],
                o2 = sigm(bf_lo(ga.y)) * pa[2] + sigm(bf_lo(gb.y)) * pb[2], o3 = sigm(bf_hi(ga.y)) * pa[3] + sigm(bf_hi(gb.y)) * pb[3];
    v2u w; w.x = cvt_pk_bf16(o0, o1); w.y = cvt_pk_bf16(o2, o3); *(v2u*)((bf16*)(ws + WS_ZR) + (size_t)row * 1024 + c) = w;
    __syncthreads();
}
__device__ __forceinline__ void sample_gemm3(const Args& A, LAS unsigned char* lds, int t, int tid, int lane, int wave) {
    unsigned char* ws = A.ws; const int fr = lane & 15, fq = lane >> 4;
    const int row0 = NPROMPT + (t >> 4) * 32, col0 = (t & 15) * 64;
    LAS f32x4* red = (LAS f32x4*)lds; LAS float* ssl = (LAS float*)(lds + 65536);
    sg_partial((const bf16*)(ws + WS_ZR) + (size_t)row0 * 1024 + wave * 128, 1024, (const bf16*)(ws + WS_WO) + (size_t)col0 * 1024 + wave * 128, 1024, red, lane, wave);
    const int row = row0 + 16 * (wave >> 2) + fr, c = col0 + 16 * (wave & 3) + 4 * fq;
    const f32x4 xv = *(const f32x4*)(A.in[I_XS] + (size_t)(row - NPROMPT) * 1024 + c), q = *(const f32x4*)(A.in[I_N2G] + c);
    __syncthreads();
    const f32x4 o = xv + sg_sum(red, 0, 8, wave, lane);
    float ss = (o[0] * o[0] + o[1] * o[1]) + (o[2] * o[2] + o[3] * o[3]);
    v2u w; w.x = cvt_pk_bf16(o[0] * q[0], o[1] * q[1]); w.y = cvt_pk_bf16(o[2] * q[2], o[3] * q[3]); *(v2u*)((bf16*)(ws + WS_A1) + (size_t)row * 1024 + c) = w;
    ss += __shfl_xor(ss, 16); ss += __shfl_xor(ss, 32);
    if (fq == 0) ssl[wave * 16 + fr] = ss;
    __syncthreads();
    if (tid < 32) { const int mi = tid >> 4, r = tid & 15;
        ((float*)(ws + WS_SSP))[(size_t)(row0 + tid) * 16 + (t & 15)] = (ssl[(mi * 4 + 0) * 16 + r] + ssl[(mi * 4 + 1) * 16 + r]) + (ssl[(mi * 4 + 2) * 16 + r] + ssl[(mi * 4 + 3) * 16 + r]); }
}
__device__ __forceinline__ void sample_gemm4(const Args& A, LAS unsigned char* lds, int t, int lane, int wave) {
    unsigned char* ws = A.ws; const int fr = lane & 15, fq = lane >> 4;
    const int row0 = NPROMPT + (t >> 5) * 32, col0 = (t & 31) * 64;
    LAS f32x4* red = (LAS f32x4*)lds;
    sg_partial((const bf16*)(ws + WS_A1) + (size_t)row0 * 1024 + wave * 128, 1024, (const bf16*)(ws + WS_WQ) + (size_t)col0 * 1024 + wave * 128, 1024, red, lane, wave);
    const int row = row0 + 16 * (wave >> 2) + fr, c = col0 + 16 * (wave & 3) + 4 * fq;
    __syncthreads();
    const f32x4 o = sg_sum(red, 0, 8, wave, lane);
    v2u w; w.x = cvt_pk_bf16(o[0], o[1]); w.y = cvt_pk_bf16(o[2], o[3]); *(v2u*)((bf16*)(ws + WS_ZG) + (size_t)row * 2048 + c) = w;
    __syncthreads();
}

__global__ void __launch_bounds__(NTHR, 2) mk_fwd(Args args) {
    extern __shared__ __attribute__((aligned(16))) unsigned char lds_raw[];
    LAS unsigned char* lds = (LAS unsigned char*)lds_raw;
    const int tid = threadIdx.x, lane = tid & 63, wave = __builtin_amdgcn_readfirstlane(tid >> 6);
    const int G = gridDim.x; const int bx = blockIdx.x; const int vcu = (G % 8 == 0) ? (bx % 8) * (G / 8) + bx / 8 : bx;
    gu32* ctl = (gu32*)(args.ws + WS_CTL);
    volatile LAS unsigned* MISC = (volatile LAS unsigned*)(lds + MISC_OFF);
    for (int u = tid; u < (LDS_BYTES - LDSCTL_OFF) / 4; u += NTHR) ((LAS unsigned*)(lds + LDSCTL_OFF))[u] = 0u;
    __syncthreads();
    XcdBarrier bar; bar.bar = (unsigned*)(ctl + CW_BAR) + args.li * XCD_BAR_WORDS; bar.x = 0; bar.st = nullptr;
    if (N_LAUNCHES != PER_PHASE) bar = xcd_barrier_post((unsigned*)(ctl + CW_BAR) + args.li * XCD_BAR_WORDS, MISC + 8);
    const int lo = args.ph_lo, hi = args.ph_hi;
#define IN(k) (lo <= (k) && (k) < hi)
#define BOTH(k) (IN(k) && IN((k) + 1))
#define GRID_BAR() do { if (N_LAUNCHES != PER_PHASE) xcd_barrier(bar); } while (0)
    unsigned char* ws = args.ws;
    bf16* A1 = (bf16*)(ws + WS_A1);

    if (IN(0)) for (int rep_ = 0; rep_ < ((MK_REPEAT == 0) ? 2 : 1); ++rep_) { p0_prologue(args, lds, tid, lane, wave, vcu, G); if (BOTH(0)) GRID_BAR(); }

    if (IN(1)) for (int rep_ = 0; rep_ < ((MK_REPEAT == 1) ? 2 : 1); ++rep_) {
        pg8::Gemm g{A1, (const bf16*)(ws + WS_W1T), MPAD, N1, DM}; pg8::StaticOrder S; S.init(MPAD, N1, G, bx);
        pg8::EpiZ E{(bf16*)(ws + WS_ZC), (bf16*)(ws + WS_ZR), (bf16*)(ws + WS_ZG)};
        pg8::gemm_phase<pg8::EpiZ, pg8::StaticOrder, true, true>(lds, g, S, E);
        if (BOTH(1)) GRID_BAR();
    }

    if (IN(2)) for (int rep_ = 0; rep_ < ((MK_REPEAT == 2) ? 2 : 1); ++rep_) { conv_phase(args, vcu * NTHR + tid, G * NTHR); if (BOTH(2)) GRID_BAR(); }

    if (IN(3)) for (int rep_ = 0; rep_ < ((MK_REPEAT == 3) ? 2 : 1); ++rep_) {
        scan_pass1(args, lds, tid, lane, wave, vcu, G);
        if (BOTH(3)) GRID_BAR();
    }

    if (IN(4)) {
        for (int u = vcu; u < 512; u += G) {
            if (u < 256) { const int bh = u >> 2, vq = u & 3; scan_pass2_rows(nullptr, bh * 64, 64, vq * 16, args.out + O_WKV_P + (size_t)bh * 4096, true, args, lds, tid, lane, wave); }
            else { const int bh = u - 256;
                for (int vq = 0; vq < 4; ++vq) scan_pass2_rows(args.in[I_SWKV] + (size_t)bh * 4096, NUNITS_P + bh, 1, vq * 16, args.out + O_WKV_S + (size_t)bh * 4096, false, args, lds, tid, lane, wave); }
        }
        if (BOTH(4)) GRID_BAR();
    }

    if (IN(5)) for (int rep_ = 0; rep_ < ((MK_REPEAT == 5) ? 2 : 1); ++rep_) {
        for (int u2 = vcu; u2 < NUNITS / 2; u2 += G) scan_pass3_wave(args, u2 * 2 + (wave >> 2), wave & 3, lane);
        if (BOTH(5)) GRID_BAR();
    }

    if (IN(6)) {
        { pg8::Gemm g{A1, (const bf16*)(ws + WS_WPA), NPROMPT, DM, 512}; pg8::StaticOrder S; S.init(NPROMPT, DM, G, bx);
          pg8::EpiGate<0> E{(const bf16*)(ws + WS_ZG), (bf16*)(ws + WS_ZR)};
          pg8::gemm_phase<pg8::EpiGate<0>, pg8::StaticOrder, true, true>(lds, g, S, E); }
        { pg8::Gemm g{A1 + (size_t)MPAD * 512, (const bf16*)(ws + WS_WPB), NPROMPT, DM, 512}; pg8::StaticOrder S; S.init(NPROMPT, DM, G, bx);
          pg8::EpiGate<1> E{(const bf16*)(ws + WS_ZG), (bf16*)(ws + WS_ZR)};
          pg8::gemm_phase<pg8::EpiGate<1>, pg8::StaticOrder, true, true>(lds, g, S, E); }
        for (int t = vcu; t < 256; t += G) sample_gemm2(args, lds, t, lane, wave);
        if (BOTH(6)) GRID_BAR();
    }

    if (IN(7)) for (int rep_ = 0; rep_ < ((MK_REPEAT == 7) ? 2 : 1); ++rep_) {
        pg8::Gemm g{(const bf16*)(ws + WS_ZR), (const bf16*)(ws + WS_WO), NPROMPT, DM, DM}; pg8::StaticOrder S; S.init(NPROMPT, DM, G, bx);
        pg8::EpiX1 E{args.in[I_XP], args.in[I_XS], args.out + O_Y, A1, (float*)(ws + WS_SSP), args.in[I_N2G], NPROMPT, NTOK};
        pg8::gemm_phase<pg8::EpiX1, pg8::StaticOrder, true, true>(lds, g, S, E);
        for (int t = vcu; t < 256; t += G) sample_gemm3(args, lds, t, tid, lane, wave);
        if (BOTH(7)) GRID_BAR();
    }

    if (IN(8)) for (int rep_ = 0; rep_ < ((MK_REPEAT == 8) ? 2 : 1); ++rep_) {
        pg8::Gemm g{A1, (const bf16*)(ws + WS_WQ), NPROMPT, 2048, DM}; pg8::StaticOrder S; S.init(NPROMPT, 2048, G, bx);
        pg8::EpiPlain E{(bf16*)(ws + WS_ZG), 2048};
        pg8::gemm_phase<pg8::EpiPlain, pg8::StaticOrder, true, true>(lds, g, S, E);
        for (int t = vcu; t < 512; t += G) sample_gemm4(args, lds, t, lane, wave);
        if (BOTH(8)) GRID_BAR();
    }

    if (IN(9)) for (int rep_ = 0; rep_ < ((MK_REPEAT == 9) ? 2 : 1); ++rep_) { peer_topk_phase(args, lds, tid, lane, wave, vcu, G); if (BOTH(9)) GRID_BAR(); }
    if (IN(10)) for (int rep_ = 0; rep_ < ((MK_REPEAT == 10) ? 2 : 1); ++rep_) { peer_u_phase(args, lds, tid, lane, wave, ctl, rep_ * 1024); if (BOTH(10)) GRID_BAR(); }
    if (IN(11)) { peer_coef_phase(args, lane, wave, vcu, G); if (BOTH(11)) GRID_BAR(); }
    if (IN(12)) { peer_v_phase(args, lds, tid, lane, wave, ctl); if (BOTH(12)) GRID_BAR(); }
    if (IN(13)) peer_final_phase(args, lane, wave, vcu, G);
#undef IN
#undef BOTH
#undef GRID_BAR
}

extern "C" void kernel_launch(void* const* d_in, const int* in_sizes, int n_in, void* d_out, int out_size, void* d_ws, size_t ws_size, hipStream_t stream) {
    static int grid = 0;
    if (grid == 0) {
        if (n_in != 32 || ws_size < WS_END) { fprintf(stderr, "kernel_launch: built for 32 inputs and >= %zu bytes of workspace; got n_in %d ws %zu; nothing launched\n", (size_t)WS_END, n_in, ws_size); grid = -1; return; }
        int dev = 0, cus = 0, per_cu = 0;
        if (hipGetDevice(&dev) != hipSuccess || hipDeviceGetAttribute(&cus, hipDeviceAttributeMultiprocessorCount, dev) != hipSuccess) { fprintf(stderr, "kernel_launch: device query failed\n"); grid = -1; return; }
        if (hipFuncSetAttribute((const void*)mk_fwd, hipFuncAttributeMaxDynamicSharedMemorySize, LDS_BYTES) != hipSuccess) { fprintf(stderr, "kernel_launch: hipFuncSetAttribute failed\n"); grid = -1; return; }
        if (hipOccupancyMaxActiveBlocksPerMultiprocessor(&per_cu, (const void*)mk_fwd, NTHR, LDS_BYTES) != hipSuccess || per_cu < 1)
            fprintf(stderr, "kernel_launch: note: occupancy query reports %d workgroups per CU\n", per_cu);
        (void)hipGetLastError();
        grid = cus;
    }
    if (grid < 0) return;
    if (hipMemsetAsync((char*)d_ws + WS_CTL, 0, CTL_ZERO_BYTES, stream) != hipSuccess) { fprintf(stderr, "kernel_launch: hipMemsetAsync failed\n"); return; }
    Args a{};
    for (int i = 0; i < 32; ++i) a.in[i] = (const float*)d_in[i];
    a.out = (float*)d_out; a.ws = (unsigned char*)d_ws;
    constexpr int NL = (N_LAUNCHES == PER_PHASE ? PER_PHASE : 1) + ((MK_EXTRA_LO >= 0) ? 1 : 0);
    for (int li = 0; li < NL; ++li) {
        if (N_LAUNCHES == PER_PHASE) { a.ph_lo = li; a.ph_hi = li + 1; } else { a.ph_lo = 0; a.ph_hi = PER_PHASE; }
        if (MK_EXTRA_LO >= 0 && li == NL - 1) { a.ph_lo = MK_EXTRA_LO; a.ph_hi = MK_EXTRA_HI; }
        a.li = li;
        hipLaunchKernelGGL(mk_fwd, dim3(grid), dim3(NTHR), LDS_BYTES, stream, a);
        const hipError_t le = hipPeekAtLastError();
        if (le != hipSuccess) { fprintf(stderr, "kernel_launch: launch %d failed: %s\n", li, hipGetErrorName(le)); break; }
    }
}
```

```cpp
#include <hip/hip_runtime.h>
#include <cstdio>
#include <cstdint>
#define MK_N_LAUNCHES 1
#define MK_REPEAT -1
#define MK_DBGSEL 0
#define MK_EXTRA_LO -1
#define MK_EXTRA_HI -1
namespace pg8 {
#define PG8_LAS __attribute__((address_space(3)))
typedef unsigned short bf16_t;
typedef short bf16x8 __attribute__((ext_vector_type(8)));
typedef float f32x4 __attribute__((ext_vector_type(4)));
typedef unsigned u32x4 __attribute__((ext_vector_type(4)));
constexpr int BM = 256, BK = 64, HALF = 128, HTB = HALF * BK * 2  , STAGE_BYTES = 8 * HTB, NXCD = 8, WGM = 8;

__host__ __device__ __forceinline__ int lds_byte(int r, int c) { const int st = (r >> 4) * 2 + (c >> 5), rr = r & 15, cc = c & 31, ob = rr * 64 + cc * 2; return st * 1024 + (ob ^ (((ob >> 9) & 1) << 5)); }
__host__ __device__ __forceinline__ void stage_rc(int b, int& R, int& C) { const int st = b / 1024, sb = b % 1024, swz = sb ^ (((sb >> 9) & 1) << 5); R = (st >> 1) * 16 + swz / 64; C = (st & 1) * 32 + (swz % 64) / 2; }
__host__ __device__ __forceinline__ int perm32(int rho) { const int n = rho >> 4, i = rho & 15; return 8 * (i >> 2) + 4 * n + (i & 3); }

struct Unit { int pm, pn; };
struct Gemm { const bf16_t* A; const bf16_t* Bt; int M, N, K; };

struct StaticOrder {
    int nM, nN, nwg, G, c;
    __host__ __device__ void init(int M, int N, int G_, int c_) { nM = M / BM; nN = N / BM; nwg = nM * nN; G = G_; c = c_; }
    __host__ __device__ bool next(int i, Unit& u) const {
        const long L = (long)i * G + c; if (L >= nwg) return false;
        int wgid = (int)L; { const int q = nwg / NXCD, r = nwg % NXCD, xcd = wgid % NXCD, off = wgid / NXCD; wgid = (xcd < r ? xcd * (q + 1) : r * (q + 1) + (xcd - r) * q) + off; }
        const int nig = WGM * nN, gid = wgid / nig, fm = gid * WGM, gsz = (nM - fm) < WGM ? (nM - fm) : WGM;
        u.pm = fm + ((wgid % nig) % gsz); u.pn = (wgid % nig) / gsz; return true;
    }
    __device__ __forceinline__ void a_ready(const Unit&) const {}
    __device__ __forceinline__ void done(const Unit&) const {}
};

typedef __bf16 bf16x2_cv __attribute__((ext_vector_type(2))); typedef float f32x2_cv __attribute__((ext_vector_type(2)));
__device__ __forceinline__ unsigned cvt_pk_bf16(float lo, float hi) { return __builtin_bit_cast(unsigned, __builtin_convertvector((f32x2_cv){lo, hi}, bf16x2_cv)); }
__device__ __forceinline__ float bf_lo(unsigned w) { return __uint_as_float(w << 16); }
__device__ __forceinline__ float bf_hi(unsigned w) { return __uint_as_float(w & 0xffff0000u); }
__device__ __forceinline__ float sigm(float x) { return __builtin_amdgcn_rcpf(1.0f + __expf(-x)); }

struct EpiZ {
    static constexpr bool PERM = true, AFTER_DRAIN = false;
    bf16_t *Zc, *Zr, *Zg;
    __device__ __forceinline__ void operator()(const f32x4 (&acc)[2][2][4][2], const Unit& u, int wr, int wc, int fr, int fq) const {
        bf16_t* base; int ldc, colt;
        if (u.pn < 6) { base = Zc; ldc = 1536; colt = u.pn * BM; }
        else if (u.pn < 14) { base = Zr; ldc = 2048; colt = (u.pn - 6) * BM; }
        else { base = Zg; ldc = 2048; colt = (u.pn - 14) * BM; }
        const int row0 = u.pm * BM + wr * 64 + fr, col0 = colt + wc * 32 + 8 * fq;
#pragma unroll
        for (int ai = 0; ai < 2; ++ai)
#pragma unroll
            for (int m = 0; m < 4; ++m) { bf16_t* rowp = base + (size_t)(row0 + ai * HALF + m * 16) * ldc + col0;
#pragma unroll
                for (int bj = 0; bj < 2; ++bj) { const f32x4 v0 = acc[ai][bj][m][0], v1 = acc[ai][bj][m][1];
                    u32x4 w; w.x = cvt_pk_bf16(v0[0], v0[1]); w.y = cvt_pk_bf16(v0[2], v0[3]); w.z = cvt_pk_bf16(v1[0], v1[1]); w.w = cvt_pk_bf16(v1[2], v1[3]);
                    *(u32x4*)(rowp + bj * HALF) = w; } }
    }
};
struct EpiPlain {
    static constexpr bool PERM = true, AFTER_DRAIN = false;
    bf16_t* O; int ldc;
    __device__ __forceinline__ void operator()(const f32x4 (&acc)[2][2][4][2], const Unit& u, int wr, int wc, int fr, int fq) const {
        const int row0 = u.pm * BM + wr * 64 + fr, col0 = u.pn * BM + wc * 32 + 8 * fq;
#pragma unroll
        for (int ai = 0; ai < 2; ++ai)
#pragma unroll
            for (int m = 0; m < 4; ++m) { bf16_t* rowp = O + (size_t)(row0 + ai * HALF + m * 16) * ldc + col0;
#pragma unroll
                for (int bj = 0; bj < 2; ++bj) { const f32x4 v0 = acc[ai][bj][m][0], v1 = acc[ai][bj][m][1];
                    u32x4 w; w.x = cvt_pk_bf16(v0[0], v0[1]); w.y = cvt_pk_bf16(v0[2], v0[3]); w.z = cvt_pk_bf16(v1[0], v1[1]); w.w = cvt_pk_bf16(v1[2], v1[3]);
                    *(u32x4*)(rowp + bj * HALF) = w; } }
    }
};
template <int SECOND> struct EpiGate {
    static constexpr bool PERM = true, AFTER_DRAIN = false;
    const bf16_t* Zg; bf16_t* MG;
    __device__ __forceinline__ void operator()(const f32x4 (&acc)[2][2][4][2], const Unit& u, int wr, int wc, int fr, int fq) const {
        const int row0 = u.pm * BM + wr * 64 + fr, col0 = u.pn * BM + wc * 32 + 8 * fq;
#pragma unroll
        for (int ai = 0; ai < 2; ++ai) {
            u32x4 gw[4][2], pw[4][2];
#pragma unroll
            for (int m = 0; m < 4; ++m) { const int r = row0 + ai * HALF + m * 16;
#pragma unroll
                for (int bj = 0; bj < 2; ++bj) { gw[m][bj] = *(const u32x4*)(Zg + (size_t)r * 2048 + SECOND * 1024 + col0 + bj * HALF);
                    if (SECOND) pw[m][bj] = *(const u32x4*)(MG + (size_t)r * 1024 + col0 + bj * HALF); } }
#pragma unroll
            for (int m = 0; m < 4; ++m) { const int r = row0 + ai * HALF + m * 16; bf16_t* op = MG + (size_t)r * 1024 + col0;
#pragma unroll
                for (int bj = 0; bj < 2; ++bj) { const u32x4 g = gw[m][bj]; f32x4 v0 = acc[ai][bj][m][0], v1 = acc[ai][bj][m][1];
                    v0[0] *= sigm(bf_lo(g.x)); v0[1] *= sigm(bf_hi(g.x)); v0[2] *= sigm(bf_lo(g.y)); v0[3] *= sigm(bf_hi(g.y));
                    v1[0] *= sigm(bf_lo(g.z)); v1[1] *= sigm(bf_hi(g.z)); v1[2] *= sigm(bf_lo(g.w)); v1[3] *= sigm(bf_hi(g.w));
                    if (SECOND) { const u32x4 p = pw[m][bj];
                        v0[0] += bf_lo(p.x); v0[1] += bf_hi(p.x); v0[2] += bf_lo(p.y); v0[3] += bf_hi(p.y);
                        v1[0] += bf_lo(p.z); v1[1] += bf_hi(p.z); v1[2] += bf_lo(p.w); v1[3] += bf_hi(p.w); }
                    u32x4 w; w.x = cvt_pk_bf16(v0[0], v0[1]); w.y = cvt_pk_bf16(v0[2], v0[3]); w.z = cvt_pk_bf16(v1[0], v1[1]); w.w = cvt_pk_bf16(v1[2], v1[3]);
                    *(u32x4*)(op + bj * HALF) = w; } }
        }
    }
};
struct EpiX1 {
    static constexpr bool PERM = false, AFTER_DRAIN = false;
    const float* xp; const float* xs; float* X1; bf16_t* X1B; float* SSP; const float* g2; int nprompt, nrows;
    __device__ __forceinline__ void operator()(const f32x4 (&acc)[2][2][4][2], const Unit& u, int wr, int wc, int fr, int fq) const {
        typedef unsigned u32x2v __attribute__((ext_vector_type(2)));
        const int col0 = u.pn * BM + wc * 32 + 4 * fq;
        f32x4 gq[2][2];
#pragma unroll
        for (int bj = 0; bj < 2; ++bj)
#pragma unroll
            for (int n = 0; n < 2; ++n) gq[bj][n] = *(const f32x4*)(g2 + col0 + bj * HALF + n * 16);
#pragma unroll
        for (int ai = 0; ai < 2; ++ai) {
            f32x4 xv[4][2][2];
#pragma unroll
            for (int m = 0; m < 4; ++m) { int r = u.pm * BM + ai * HALF + wr * 64 + m * 16 + fr; r = r < nrows ? r : nrows - 1;
                const float* xr = r < nprompt ? xp + (size_t)r * 1024 : xs + (size_t)(r - nprompt) * 1024;
#pragma unroll
                for (int bj = 0; bj < 2; ++bj)
#pragma unroll
                    for (int n = 0; n < 2; ++n) xv[m][bj][n] = *(const f32x4*)(xr + col0 + bj * HALF + n * 16); }
#pragma unroll
            for (int m = 0; m < 4; ++m) { const int r = u.pm * BM + ai * HALF + wr * 64 + m * 16 + fr; float ss = 0.f;
#pragma unroll
                for (int bj = 0; bj < 2; ++bj)
#pragma unroll
                    for (int n = 0; n < 2; ++n) { const int c = col0 + bj * HALF + n * 16; const f32x4 o = xv[m][bj][n] + acc[ai][bj][m][n];
                        ss += (o[0] * o[0] + o[1] * o[1]) + (o[2] * o[2] + o[3] * o[3]);
                        const f32x4 q = gq[bj][n]; u32x2v w; w.x = cvt_pk_bf16(o[0] * q[0], o[1] * q[1]); w.y = cvt_pk_bf16(o[2] * q[2], o[3] * q[3]);
                        if (r < nrows) *(u32x2v*)(X1B + (size_t)r * 1024 + c) = w; }
                ss += __shfl_xor(ss, 16); ss += __shfl_xor(ss, 32);
                if (fq == 0 && r < nrows) SSP[(size_t)r * 16 + u.pn * 4 + wc] = ss;
            }
        }
    }
};
template <class Epi, class Sched, bool ALIGN_EPI = false, bool SP2 = false>
__device__ __forceinline__ void gemm_phase(PG8_LAS unsigned char* lds, const Gemm g, const Sched& S, const Epi& E) {
    const int tid = threadIdx.x, wid = __builtin_amdgcn_readfirstlane(tid >> 6), lane = tid & 63, wr = wid >> 2, wc = wid & 3, fr = lane & 15, fq = lane >> 4;
    const int K = g.K, nt = K / BK;
    unsigned voffA[2], voffB[2];
#pragma unroll
    for (int i = 0; i < 2; ++i) { int R, C; stage_rc(tid * 16 + i * 8192, R, C); const int Rb = Epi::PERM ? ((R & ~31) + perm32(R & 31)) : R;
        voffA[i] = (unsigned)(R * K + C) * 2u; voffB[i] = (unsigned)(Rb * K + C) * 2u; }
    const size_t kstep = (size_t)(BK * 2);
    const size_t hstep = (size_t)HALF * K * 2;
    const size_t tstep = 2 * hstep;
    const unsigned ldsw = (unsigned)wid * 1024u;
    const int aoff = lds_byte(wr * 64 + fr, fq * 8), boff = lds_byte(wc * 32 + fr, fq * 8);
#define PG8_SA(b, h) (((b) * 2 + (h)) * HTB)
#define PG8_SB(b, h) ((4 + (b) * 2 + (h)) * HTB)
#define PG8_STAGE(bufoff, gbase, voff) do { _Pragma("unroll") for (int _i = 0; _i < 2; ++_i) \
        __builtin_amdgcn_global_load_lds((const unsigned*)((const char*)(gbase) + (voff)[_i]), (PG8_LAS unsigned*)(lds + (bufoff) + ldsw + _i * 8192), 16, 0, 0); } while (0)
#define PG8_LDA(dst, b, h) do { _Pragma("unroll") for (int m = 0; m < 4; ++m) _Pragma("unroll") for (int k = 0; k < 2; ++k) dst[m][k] = *(const PG8_LAS bf16x8*)(lds + PG8_SA(b, h) + aoff + m * 2048 + k * 1024); } while (0)
#define PG8_LDB(dst, b, h) do { _Pragma("unroll") for (int n = 0; n < 2; ++n) _Pragma("unroll") for (int k = 0; k < 2; ++k) dst[n][k] = *(const PG8_LAS bf16x8*)(lds + PG8_SB(b, h) + boff + n * 2048 + k * 1024); } while (0)
#define PG8_MMA(ai, bj, At, Bt) do { __builtin_amdgcn_s_setprio(1); _Pragma("unroll") for (int m = 0; m < 4; ++m) _Pragma("unroll") for (int n = 0; n < 2; ++n) _Pragma("unroll") for (int k = 0; k < 2; ++k) \
        acc[ai][bj][m][n] = __builtin_amdgcn_mfma_f32_16x16x32_bf16(Bt[n][k], At[m][k], acc[ai][bj][m][n], 0, 0, 0); __builtin_amdgcn_s_setprio(0); } while (0)
#define PG8_WAIT_V(n) asm volatile("s_waitcnt vmcnt(" #n ")" ::: "memory")
#define PG8_WAIT_L(n) asm volatile("s_waitcnt lgkmcnt(" #n ")" ::: "memory")
#define PG8_BAR __builtin_amdgcn_s_barrier()
#define PG8_SCHED __builtin_amdgcn_sched_barrier(0)
    Unit cur, nxt; int ui = 0;
    if (!S.next(0, cur)) return;
    f32x4 acc[2][2][4][2];
#pragma unroll
    for (int a = 0; a < 2; ++a)
#pragma unroll
        for (int b = 0; b < 2; ++b)
#pragma unroll
            for (int m = 0; m < 4; ++m)
#pragma unroll
                for (int n = 0; n < 2; ++n) acc[a][b][m][n] = (f32x4){0.f, 0.f, 0.f, 0.f};
    bf16x8 At[4][2], B0[2][2], B1[2][2];
    const char* cA = (const char*)g.A + (size_t)cur.pm * tstep; const char* cB = (const char*)g.Bt + (size_t)cur.pn * tstep;
    S.a_ready(cur);
    if constexpr (SP2) {
        PG8_STAGE(PG8_SB(0, 0), cB, voffB); PG8_STAGE(PG8_SB(0, 1), cB + hstep, voffB); PG8_STAGE(PG8_SA(0, 0), cA, voffA); PG8_STAGE(PG8_SA(0, 1), cA + hstep, voffA);
        if (wr == 1) PG8_BAR;
        PG8_WAIT_V(2); PG8_BAR;
        PG8_STAGE(PG8_SB(1, 0), cB + kstep, voffB); PG8_STAGE(PG8_SA(1, 0), cA + kstep, voffA); PG8_STAGE(PG8_SB(1, 1), cB + hstep + kstep, voffB);
        PG8_WAIT_V(6); PG8_BAR;
    } else {
        PG8_STAGE(PG8_SB(0, 0), cB, voffB); PG8_STAGE(PG8_SA(0, 0), cA, voffA); PG8_STAGE(PG8_SB(0, 1), cB + hstep, voffB); PG8_STAGE(PG8_SA(0, 1), cA + hstep, voffA);
        if (wr == 1) PG8_BAR;
        PG8_WAIT_V(4); PG8_BAR;
        PG8_STAGE(PG8_SB(1, 0), cB + kstep, voffB); PG8_STAGE(PG8_SA(1, 0), cA + kstep, voffA); PG8_STAGE(PG8_SB(1, 1), cB + hstep + kstep, voffB);
        PG8_WAIT_V(6); PG8_BAR;
    }
    for (;;) {
        const bool has_next = S.next(ui + 1, nxt);
        const char* nA = has_next ? (const char*)g.A + (size_t)nxt.pm * tstep : cA; const char* nB = has_next ? (const char*)g.Bt + (size_t)nxt.pn * tstep : cB;
        for (int t = 0; t < nt; t += 2) {
            const bool last = (t == nt - 2);
            const char* a1 = cA + (size_t)(t + 1) * kstep;
            const char* a2 = last ? nA : cA + (size_t)(t + 2) * kstep; const char* b2 = last ? nB : cB + (size_t)(t + 2) * kstep;
            const char* a3 = a2 + kstep; const char* b3 = b2 + kstep;
            if (last && has_next) S.a_ready(nxt);
            if constexpr (SP2) {
            PG8_LDB(B0, 0, 0); PG8_LDB(B1, 0, 1); PG8_SCHED; PG8_LDA(At, 0, 0); PG8_STAGE(PG8_SA(1, 1), a1 + hstep, voffA);
            PG8_WAIT_V(8); PG8_WAIT_L(0); PG8_BAR; PG8_MMA(0, 0, At, B0); PG8_MMA(0, 1, At, B1); PG8_BAR; PG8_SCHED;
            PG8_LDA(At, 0, 1); PG8_STAGE(PG8_SB(0, 0), b2, voffB); PG8_STAGE(PG8_SB(0, 1), b2 + hstep, voffB); PG8_STAGE(PG8_SA(0, 0), a2, voffA);
            PG8_WAIT_V(8); PG8_WAIT_L(0); PG8_BAR; PG8_MMA(1, 0, At, B0); PG8_MMA(1, 1, At, B1); PG8_BAR; PG8_SCHED;
            PG8_LDB(B0, 1, 0); PG8_LDB(B1, 1, 1); PG8_SCHED; PG8_LDA(At, 1, 0); PG8_STAGE(PG8_SA(0, 1), a2 + hstep, voffA);
            PG8_WAIT_V(8); PG8_WAIT_L(0); PG8_BAR; PG8_MMA(0, 0, At, B0); PG8_MMA(0, 1, At, B1); PG8_BAR; PG8_SCHED;
            PG8_LDA(At, 1, 1); PG8_STAGE(PG8_SB(1, 0), b3, voffB); PG8_STAGE(PG8_SB(1, 1), b3 + hstep, voffB); PG8_STAGE(PG8_SA(1, 0), a3, voffA);
            PG8_WAIT_V(8); PG8_WAIT_L(0); PG8_BAR; PG8_MMA(1, 0, At, B0); PG8_MMA(1, 1, At, B1); PG8_BAR; PG8_SCHED;
            } else {
            PG8_LDB(B0, 0, 0); PG8_SCHED; PG8_LDA(At, 0, 0); PG8_STAGE(PG8_SA(1, 1), a1 + hstep, voffA);
            PG8_WAIT_L(8); PG8_BAR; PG8_WAIT_L(0); PG8_MMA(0, 0, At, B0); PG8_BAR; PG8_SCHED;
            PG8_LDB(B1, 0, 1); PG8_STAGE(PG8_SB(0, 0), b2, voffB);
            PG8_BAR; PG8_WAIT_L(0); PG8_MMA(0, 1, At, B1); PG8_BAR;
            PG8_LDA(At, 0, 1); PG8_STAGE(PG8_SA(0, 0), a2, voffA);
            PG8_BAR; PG8_WAIT_L(0); PG8_MMA(1, 0, At, B0); PG8_BAR; PG8_SCHED;
            PG8_STAGE(PG8_SB(0, 1), b2 + hstep, voffB);
            PG8_WAIT_V(6); PG8_BAR; PG8_MMA(1, 1, At, B1); PG8_BAR;
            PG8_LDB(B0, 1, 0); PG8_SCHED; PG8_LDA(At, 1, 0); PG8_STAGE(PG8_SA(0, 1), a2 + hstep, voffA);
            PG8_WAIT_L(8); PG8_BAR; PG8_WAIT_L(0); PG8_MMA(0, 0, At, B0); PG8_BAR; PG8_SCHED;
            PG8_LDB(B1, 1, 1); PG8_STAGE(PG8_SB(1, 0), b3, voffB);
            PG8_BAR; PG8_WAIT_L(0); PG8_MMA(0, 1, At, B1); PG8_BAR;
            PG8_LDA(At, 1, 1); PG8_STAGE(PG8_SA(1, 0), a3, voffA);
            PG8_BAR; PG8_WAIT_L(0); PG8_MMA(1, 0, At, B0); PG8_BAR; PG8_SCHED;
            PG8_STAGE(PG8_SB(1, 1), b3 + hstep, voffB);
            PG8_WAIT_V(6); PG8_BAR; PG8_MMA(1, 1, At, B1); PG8_BAR;
            }
        }
        if constexpr (ALIGN_EPI) { if (wr == 0) PG8_BAR; }
        if constexpr (!Epi::AFTER_DRAIN) { E(acc, cur, wr, wc, fr, fq); S.done(cur); }
        if (!has_next) break;
#pragma unroll
        for (int a = 0; a < 2; ++a)
#pragma unroll
            for (int b = 0; b < 2; ++b)
#pragma unroll
                for (int m = 0; m < 4; ++m)
#pragma unroll
                    for (int n = 0; n < 2; ++n) acc[a][b][m][n] = (f32x4){0.f, 0.f, 0.f, 0.f};
        cur = nxt; cA = nA; cB = nB; ++ui;
        if constexpr (ALIGN_EPI) { if (wr == 1) PG8_BAR; }
    }
    PG8_WAIT_V(0);
    if constexpr (!ALIGN_EPI) { if (wr == 0) PG8_BAR; }
    PG8_BAR;
    if constexpr (Epi::AFTER_DRAIN) { E.fused(acc, cur, wr, wc, fr, fq, lds, wid, lane); S.done(cur); }
#undef PG8_SA
#undef PG8_SB
#undef PG8_STAGE
#undef PG8_LDA
#undef PG8_LDB
#undef PG8_MMA
#undef PG8_WAIT_V
#undef PG8_WAIT_L
#undef PG8_BAR
#undef PG8_SCHED
}
}
constexpr int NWAVES = 8, NTHR = 512;
#ifndef MK_N_LAUNCHES
#define MK_N_LAUNCHES 1
#endif
constexpr int PER_PHASE = 14;
constexpr int N_LAUNCHES = MK_N_LAUNCHES;

constexpr int DM = 1024, NPROMPT = 32768, NSAMP = 512, NTOK = 33280, NSHIFT = 32, MPAD = 33536, N1 = 5632;
constexpr int SEQ_P = 4096, SEQ_S = 16, NB_P = 8, NB_S = 32;
constexpr size_t O_Y = 0, O_CONV_P = 34078720, O_SHIFT_P = 34086912, O_WKV_P = 34095104, O_CONV_S = 34357248, O_SHIFT_S = 34390016, O_WKV_S = 34422784;
constexpr size_t KiB = 1024, MiB = 1u << 20;
constexpr size_t WS_CTL = 0, CTL_ZERO_BYTES = 64 * KiB;
constexpr size_t WS_W1T = 64 * KiB;
constexpr size_t WS_WPA = WS_W1T + (size_t)N1 * DM * 2;
constexpr size_t WS_WPB = WS_WPA + 1 * MiB;
constexpr size_t WS_WO = WS_WPB + 1 * MiB;
constexpr size_t WS_WQ = WS_WO + 2 * MiB;
constexpr size_t WS_KEYS = WS_WQ + 4 * MiB;
constexpr size_t WS_L2T = WS_KEYS + 512 * KiB;
constexpr size_t WS_SSP = WS_L2T + 256 * KiB;
constexpr size_t WS_UB = WS_SSP + (size_t)MPAD * 16 * 4;
constexpr size_t WS_VB = WS_UB + 16 * MiB;
constexpr size_t WS_A1 = WS_VB + 16 * MiB;
constexpr size_t WS_ZC = WS_A1 + (size_t)MPAD * DM * 2;
constexpr size_t WS_ZR = WS_ZC + (size_t)MPAD * 1536 * 2;
constexpr size_t WS_ZG = WS_ZR + (size_t)MPAD * 2048 * 2;
constexpr size_t WS_END = WS_ZG + (size_t)MPAD * 2048 * 2;
constexpr size_t WS_YL = WS_ZC, WS_ZT = WS_ZC + (size_t)NTOK * 512 * 2, WS_BV = WS_ZC + (size_t)NTOK * 512 * 4;
constexpr size_t WS_EIDX = WS_ZC, WS_GATE = WS_ZC + 16 * MiB, WS_COEF = WS_ZC + 40 * MiB, WS_SS2 = WS_ZC + 64 * MiB, WS_RSTD = WS_ZC + 66 * MiB;
constexpr size_t WS_PART = WS_ZR;
constexpr size_t OB_MB = (size_t)4352 * 4096 * 4;
static_assert(WS_BV + (size_t)NTOK * 512 * 2 <= WS_ZR && OB_MB + (size_t)4352 * 4096 * 2 <= (size_t)NTOK * 1024 * 4, "scan scratch maps");
static_assert(WS_END <= 512 * MiB, "d_ws map must fit 512 MiB");
constexpr float PEER_SU = 32.0f, PEER_SV = 4.0f;
constexpr int CW_BAR = 1024;
constexpr int LDS_BYTES = 163840;
constexpr int LDSCTL_OFF = LDS_BYTES - 512, MISC_OFF = LDSCTL_OFF + 320;

#define GAS __attribute__((address_space(1)))
#define LAS __attribute__((address_space(3)))
typedef unsigned short bf16;
typedef unsigned v4u __attribute__((ext_vector_type(4)));
typedef unsigned v2u __attribute__((ext_vector_type(2)));
typedef float f32x4 __attribute__((ext_vector_type(4)));
typedef short bf16x8 __attribute__((ext_vector_type(8)));
typedef __bf16 bf16x2_t __attribute__((ext_vector_type(2)));
typedef GAS unsigned gu32;
#define RLX_AGENT __ATOMIC_RELAXED, __HIP_MEMORY_SCOPE_AGENT
#define LDS_WAIT() asm volatile("s_waitcnt lgkmcnt(0)" ::: "memory")
#define VM_WAIT() asm volatile("s_waitcnt vmcnt(0)" ::: "memory")
using pg8::cvt_pk_bf16; using pg8::bf_lo; using pg8::bf_hi; using pg8::sigm;
#define XB_TMO      128
#define XB_XCNT(j)  (256  + 64 * (j))
#define XB_XSUB(j)  (1280 + 64 * (j))
#define XB_XGEN(j)  (2304 + 64 * (j))
#define XB_TOP      3328
#define XB_TOPGEN   3392
#define XCD_BAR_WORDS 3456
#define XB_SPIN_CAP (1u << 22)

__device__ __forceinline__ unsigned xb_ld(unsigned* p)              { return __hip_atomic_load(p, __ATOMIC_RELAXED, __HIP_MEMORY_SCOPE_AGENT); }
__device__ __forceinline__ unsigned xb_add(unsigned* p, unsigned v) { return __hip_atomic_fetch_add(p, v, __ATOMIC_RELAXED, __HIP_MEMORY_SCOPE_AGENT); }
__device__ __forceinline__ unsigned xb_xcc_id() { return (unsigned)__builtin_amdgcn_s_getreg((3 << 11) | 20) & 0xFu; }
#define XB_SPIN(cond, bar) do { unsigned _sp = 0; while (cond) { __builtin_amdgcn_s_sleep(1); \
    if ((++_sp & 255u) == 0u) { if (xb_ld(&(bar)[XB_TMO])) break; if (_sp > XB_SPIN_CAP) { atomicAdd(&(bar)[XB_TMO], 1u); break; } } } } while (0)

struct XcdBarrier {
    unsigned* bar; unsigned x;
    volatile LAS unsigned* st;
};

__device__ __forceinline__ XcdBarrier xcd_barrier_post(unsigned* bar, volatile LAS unsigned* st) {
    XcdBarrier b; b.bar = bar; b.x = xb_xcc_id(); b.st = st;
    if (threadIdx.x == 0) (void)xb_add(&bar[XB_XCNT(b.x)], 1u);
    return b;
}
__device__ __forceinline__ void xcd_barrier_complete(unsigned* bar, unsigned x, unsigned& nloc, unsigned& nx) {
    const unsigned G = gridDim.x * gridDim.y * gridDim.z;
    unsigned sum, cnt, mine, sp = 0u;
    for (;;) {
        sum = 0u; cnt = 0u; mine = 0u;
#pragma unroll
        for (unsigned j = 0; j < 16; ++j) { const unsigned c = xb_ld(&bar[XB_XCNT(j)]); sum += c; cnt += (c > 0u) ? 1u : 0u; mine = (j == x) ? c : mine; }
        if (sum == G) break;
        __builtin_amdgcn_s_sleep(1);
        if ((++sp & 255u) == 0u) { if (xb_ld(&bar[XB_TMO])) break; if (sp > XB_SPIN_CAP) { atomicAdd(&bar[XB_TMO], 1u); break; } }
    }
    nloc = mine > 0u ? mine : 1u; nx = cnt > 0u ? cnt : 1u;
}

__device__ __forceinline__ void xcd_barrier(const XcdBarrier& b) {
    asm volatile("s_waitcnt vmcnt(0)" ::: "memory");
    __syncthreads();
    if (threadIdx.x == 0) {
        unsigned* bar = b.bar;
        __builtin_amdgcn_s_waitcnt(0);
        unsigned nloc = b.st[0], nx = b.st[1];
        if (nloc == 0u) { xcd_barrier_complete(bar, b.x, nloc, nx); b.st[0] = nloc; b.st[1] = nx; }
        const unsigned old = xb_add(&bar[XB_XSUB(b.x)], 1u);
        const unsigned gen = old / nloc;
        if (old + 1u == (gen + 1u) * nloc) {
            __builtin_amdgcn_fence(__ATOMIC_RELEASE, "agent");
            asm volatile("s_waitcnt vmcnt(0)" ::: "memory");
            const unsigned og = xb_add(&bar[XB_TOP], 1u);
            const unsigned tg = og / nx;
            if (og + 1u == (tg + 1u) * nx) xb_add(&bar[XB_TOPGEN], 1u);
            else XB_SPIN(xb_ld(&bar[XB_TOPGEN]) == tg, bar);
            __builtin_amdgcn_fence(__ATOMIC_ACQUIRE, "agent");
            xb_add(&bar[XB_XGEN(b.x)], 1u);
            asm volatile("s_waitcnt vmcnt(0)" ::: "memory");
        } else {
            XB_SPIN(xb_ld(&bar[XB_XGEN(b.x)]) == gen, bar);
            __builtin_amdgcn_fence(__ATOMIC_ACQUIRE, "agent");
            asm volatile("s_waitcnt vmcnt(0)" ::: "memory");
        }
    }
    __syncthreads();
}
struct Args { const float* in[32]; float* out; unsigned char* ws; int ph_lo, ph_hi, li, pad; };
enum { I_XP = 0, I_XS, I_SCONV, I_SSHIFT, I_SWKV, I_N1G, I_WIN, I_CONVW, I_MURKV, I_MUWAG, I_W0, I_W1, I_W2, I_A0, I_A1, I_A2, I_G1, I_G2, I_KK, I_KA, I_RK, I_GNW, I_GNB, I_WPA, I_WPB, I_WO, I_N2G, I_WQ, I_KEYS, I_U, I_V, I_NFG };

__device__ __forceinline__ float wave_sum(float v) {
#pragma unroll
    for (int o = 1; o < 64; o <<= 1) v += __shfl_xor(v, o);
    return v;
}
template <int CTRL> __device__ __forceinline__ float dpp_mov(float v) { return __builtin_bit_cast(float, __builtin_amdgcn_update_dpp(0, __builtin_bit_cast(int, v), CTRL, 0xF, 0xF, true)); }
__device__ __forceinline__ float sum4(float v) { v += dpp_mov<0xB1>(v); v += dpp_mov<0x4E>(v); return v; }
__device__ __forceinline__ float sum8(float v) { v = sum4(v); v += dpp_mov<0x141>(v); return v; }
__device__ __forceinline__ float sum16(float v) { v = sum8(v); v += dpp_mov<0x140>(v); return v; }
__device__ __forceinline__ float dot2bf(unsigned w, unsigned x, float acc) { return __builtin_amdgcn_fdot2_f32_bf16(__builtin_bit_cast(bf16x2_t, w), __builtin_bit_cast(bf16x2_t, x), acc, false); }

__device__ __forceinline__ void transpose_item(const float* W, int ldw, int c0, int K, bf16* WT, int nblk, int item, const float* sv, float alpha, float beta, LAS float* scr, int lane) {
    const int kb = item / nblk, nb = item % nblk, k0 = 64 * kb, n0 = 32 * nb;
#pragma unroll 8
    for (int i = 0; i < 32; ++i) { const int kk = 2 * i + (lane >> 5); float s = 1.f; if (sv) s = alpha + beta * sv[k0 + kk];
        scr[kk * 33 + (lane & 31)] = W[(size_t)(k0 + kk) * ldw + c0 + n0 + (lane & 31)] * s; }
    LDS_WAIT();
    const int c = lane & 7;
#pragma unroll
    for (int j = 0; j < 4; ++j) { const int n = (lane >> 3) + 8 * j; const LAS float* s = scr + (8 * c) * 33 + n;
        v4u o; o.x = cvt_pk_bf16(s[0 * 33], s[1 * 33]); o.y = cvt_pk_bf16(s[2 * 33], s[3 * 33]); o.z = cvt_pk_bf16(s[4 * 33], s[5 * 33]); o.w = cvt_pk_bf16(s[6 * 33], s[7 * 33]);
        *(v4u*)(WT + (size_t)(n0 + n) * K + k0 + 8 * c) = o; }
    LDS_WAIT();
}
__device__ __forceinline__ void cvt_stream(const float* src, bf16* dst, size_t n, size_t gt, size_t nthreads) {
    for (size_t i = gt * 8; i < n; i += nthreads * 8) { const f32x4 a = *(const f32x4*)(src + i), b = *(const f32x4*)(src + i + 4);
        v4u o; o.x = cvt_pk_bf16(a[0], a[1]); o.y = cvt_pk_bf16(a[2], a[3]); o.z = cvt_pk_bf16(b[0], b[1]); o.w = cvt_pk_bf16(b[2], b[3]); *(v4u*)(dst + i) = o; }
}
__device__ __forceinline__ void cvt_stream_fp8(const float* src, unsigned char* dst, size_t n, float scale, size_t gt, size_t nthreads) {
    for (size_t i = gt * 16; i < n; i += nthreads * 16) {
        const f32x4 a = *(const f32x4*)(src + i) * scale, b = *(const f32x4*)(src + i + 4) * scale, c = *(const f32x4*)(src + i + 8) * scale, d = *(const f32x4*)(src + i + 12) * scale;
        v4u o; unsigned p;
        p = __builtin_amdgcn_cvt_pk_fp8_f32(a[0], a[1], 0, false); o.x = __builtin_amdgcn_cvt_pk_fp8_f32(a[2], a[3], p, true);
        p = __builtin_amdgcn_cvt_pk_fp8_f32(b[0], b[1], 0, false); o.y = __builtin_amdgcn_cvt_pk_fp8_f32(b[2], b[3], p, true);
        p = __builtin_amdgcn_cvt_pk_fp8_f32(c[0], c[1], 0, false); o.z = __builtin_amdgcn_cvt_pk_fp8_f32(c[2], c[3], p, true);
        p = __builtin_amdgcn_cvt_pk_fp8_f32(d[0], d[1], 0, false); o.w = __builtin_amdgcn_cvt_pk_fp8_f32(d[2], d[3], p, true);
        *(v4u*)(dst + i) = o; }
}
__device__ __forceinline__ void cvt16_fp8_sliced(const float* src, unsigned char* dst, float scale, size_t i) {
    const f32x4 a = *(const f32x4*)(src + i) * scale, b = *(const f32x4*)(src + i + 4) * scale, c = *(const f32x4*)(src + i + 8) * scale, d = *(const f32x4*)(src + i + 12) * scale;
    v4u o; unsigned p;
    p = __builtin_amdgcn_cvt_pk_fp8_f32(a[0], a[1], 0, false); o.x = __builtin_amdgcn_cvt_pk_fp8_f32(a[2], a[3], p, true);
    p = __builtin_amdgcn_cvt_pk_fp8_f32(b[0], b[1], 0, false); o.y = __builtin_amdgcn_cvt_pk_fp8_f32(b[2], b[3], p, true);
    p = __builtin_amdgcn_cvt_pk_fp8_f32(c[0], c[1], 0, false); o.z = __builtin_amdgcn_cvt_pk_fp8_f32(c[2], c[3], p, true);
    p = __builtin_amdgcn_cvt_pk_fp8_f32(d[0], d[1], 0, false); o.w = __builtin_amdgcn_cvt_pk_fp8_f32(d[2], d[3], p, true);
    const size_t e = i >> 10, col = i & 1023;
    *(v4u*)(dst + (col >> 7) * ((size_t)16384 * 128) + e * 128 + (col & 127)) = o;
}
__device__ __forceinline__ void cvt_stream_fp8_sliced(const float* src, unsigned char* dst, float scale, size_t gt, size_t nthreads) {
#pragma unroll 2
    for (size_t i = gt * 16; i < (size_t)16384 * 1024; i += nthreads * 16) {
        const f32x4 a = *(const f32x4*)(src + i) * scale, b = *(const f32x4*)(src + i + 4) * scale, c = *(const f32x4*)(src + i + 8) * scale, d = *(const f32x4*)(src + i + 12) * scale;
        v4u o; unsigned p;
        p = __builtin_amdgcn_cvt_pk_fp8_f32(a[0], a[1], 0, false); o.x = __builtin_amdgcn_cvt_pk_fp8_f32(a[2], a[3], p, true);
        p = __builtin_amdgcn_cvt_pk_fp8_f32(b[0], b[1], 0, false); o.y = __builtin_amdgcn_cvt_pk_fp8_f32(b[2], b[3], p, true);
        p = __builtin_amdgcn_cvt_pk_fp8_f32(c[0], c[1], 0, false); o.z = __builtin_amdgcn_cvt_pk_fp8_f32(c[2], c[3], p, true);
        p = __builtin_amdgcn_cvt_pk_fp8_f32(d[0], d[1], 0, false); o.w = __builtin_amdgcn_cvt_pk_fp8_f32(d[2], d[3], p, true);
        const size_t e = i >> 10, col = i & 1023;
        *(v4u*)(dst + (col >> 7) * ((size_t)16384 * 128) + e * 128 + (col & 127)) = o; }
}
__device__ __forceinline__ void p0_prologue(const Args& A, LAS unsigned char* lds, int tid, int lane, int wave, int vcu, int G) {
    unsigned char* ws = A.ws;
    bf16* W1T = (bf16*)(ws + WS_W1T);
    LAS float* scr = (LAS float*)(lds + wave * 16384);
    const int gw = vcu * NWAVES + wave, NGW = G * NWAVES;
    constexpr int J0 = 16 * 96, J1 = 16 * 64, JL = 16 * 2, JG = 16 * 4, JP = 8 * 32, JO = 16 * 32, JQ = 16 * 64;
    constexpr int JW2 = 16, JG2 = 32;
    constexpr int NITEMS = J0 + J1 + 4 * JL + 2 * JG + 2 * JP + JO + JQ + 2 * JW2 + JG2;
    bf16* L2T = (bf16*)(ws + WS_L2T);
    const float* mu = A.in[I_MUWAG];
    for (int it = gw; it < NITEMS; it += NGW) {
        int r = it;
        if (r < J0) { transpose_item(A.in[I_WIN], 5120, 0, 1024, W1T, 96, r, nullptr, 0.f, 0.f, scr, lane); continue; } r -= J0;
        if (r < J1) { transpose_item(A.in[I_WIN], 5120, 3072, 1024, W1T + (size_t)3584 * 1024, 64, r, nullptr, 0.f, 0.f, scr, lane); continue; } r -= J1;
        if (r < JL) { transpose_item(A.in[I_W1], 64, 0, 1024, W1T + (size_t)3072 * 1024, 2, r, mu, 1.f, -1.f, scr, lane); continue; } r -= JL;
        if (r < JL) { transpose_item(A.in[I_W1], 64, 0, 1024, W1T + (size_t)3328 * 1024, 2, r, mu, 0.f, 1.f, scr, lane); continue; } r -= JL;
        if (r < JL) { transpose_item(A.in[I_A1], 64, 0, 1024, W1T + (size_t)(3072 + 64) * 1024, 2, r, mu + 1024, 1.f, -1.f, scr, lane); continue; } r -= JL;
        if (r < JL) { transpose_item(A.in[I_A1], 64, 0, 1024, W1T + (size_t)(3328 + 64) * 1024, 2, r, mu + 1024, 0.f, 1.f, scr, lane); continue; } r -= JL;
        if (r < JG) { transpose_item(A.in[I_G1], 128, 0, 1024, W1T + (size_t)(3072 + 128) * 1024, 4, r, mu + 2048, 1.f, -1.f, scr, lane); continue; } r -= JG;
        if (r < JG) { transpose_item(A.in[I_G1], 128, 0, 1024, W1T + (size_t)(3328 + 128) * 1024, 4, r, mu + 2048, 0.f, 1.f, scr, lane); continue; } r -= JG;
        if (r < JP) { transpose_item(A.in[I_WPA], 1024, 0, 512, (bf16*)(ws + WS_WPA), 32, r, nullptr, 0.f, 0.f, scr, lane); continue; } r -= JP;
        if (r < JP) { transpose_item(A.in[I_WPB], 1024, 0, 512, (bf16*)(ws + WS_WPB), 32, r, nullptr, 0.f, 0.f, scr, lane); continue; } r -= JP;
        if (r < JO) { transpose_item(A.in[I_WO], 1024, 0, 1024, (bf16*)(ws + WS_WO), 32, r, nullptr, 0.f, 0.f, scr, lane); continue; } r -= JO;
        if (r < JQ) { transpose_item(A.in[I_WQ], 2048, 0, 1024, (bf16*)(ws + WS_WQ), 64, r, nullptr, 0.f, 0.f, scr, lane); continue; } r -= JQ;
        if (r < JW2) { transpose_item(A.in[I_W2], 512, 0, 64, L2T, 16, r, nullptr, 0.f, 0.f, scr, lane); continue; } r -= JW2;
        if (r < JW2) { transpose_item(A.in[I_A2], 512, 0, 64, L2T + (size_t)512 * 64, 16, r, nullptr, 0.f, 0.f, scr, lane); continue; } r -= JW2;
        transpose_item(A.in[I_G2], 512, 0, 128, L2T + (size_t)1024 * 64, 16, r, nullptr, 0.f, 0.f, scr, lane);
    }
    const size_t gt = (size_t)vcu * NTHR + tid, nth = (size_t)G * NTHR;
    if (G != 256) {
        cvt_stream_fp8_sliced(A.in[I_U], ws + WS_UB, PEER_SU, gt, nth);
        cvt_stream_fp8_sliced(A.in[I_V], ws + WS_VB, PEER_SV, gt, nth); }
    cvt_stream(A.in[I_KEYS], (bf16*)(ws + WS_KEYS), (size_t)8 * 2 * 128 * 128, gt, nth);
    bf16* A1 = (bf16*)(ws + WS_A1);
    const f32x4* g1v = (const f32x4*)A.in[I_N1G] + lane;
    for (int m0 = gw; m0 < NTOK; m0 += 2 * NGW) {
        const int m1 = m0 + NGW; const bool two = m1 < NTOK; const int m1c = two ? m1 : m0;
        const f32x4* xr0 = (const f32x4*)(m0 < NPROMPT ? A.in[I_XP] + (size_t)m0 * DM : A.in[I_XS] + (size_t)(m0 - NPROMPT) * DM) + lane;
        const f32x4* xr1 = (const f32x4*)(m1c < NPROMPT ? A.in[I_XP] + (size_t)m1c * DM : A.in[I_XS] + (size_t)(m1c - NPROMPT) * DM) + lane;
        f32x4 v0[4], v1[4]; float s0 = 0.f, s1 = 0.f;
#pragma unroll
        for (int j = 0; j < 4; ++j) { v0[j] = xr0[64 * j]; v1[j] = xr1[64 * j]; }
#pragma unroll
        for (int j = 0; j < 4; ++j) { s0 += (v0[j][0] * v0[j][0] + v0[j][1] * v0[j][1]) + (v0[j][2] * v0[j][2] + v0[j][3] * v0[j][3]);
                                      s1 += (v1[j][0] * v1[j][0] + v1[j][1] * v1[j][1]) + (v1[j][2] * v1[j][2] + v1[j][3] * v1[j][3]); }
#pragma unroll
        for (int o = 1; o < 64; o <<= 1) { s0 += __shfl_xor(s0, o); s1 += __shfl_xor(s1, o); }
        const float r0 = 1.0f / sqrtf(s0 * (1.f / DM) + 1e-6f), r1 = 1.0f / sqrtf(s1 * (1.f / DM) + 1e-6f);
#pragma unroll
        for (int rr = 0; rr < 2; ++rr) {
            if (rr == 1 && !two) break;
            const int m = rr ? m1 : m0; const float rstd = rr ? r1 : r0;
            v2u* o8 = (v2u*)(A1 + (size_t)m * DM) + lane;
            float* so = nullptr;
            if (m < NPROMPT) { if ((m & (SEQ_P - 1)) == SEQ_P - 1) so = A.out + O_SHIFT_P + (size_t)(m / SEQ_P) * DM; }
            else { const int ms = m - NPROMPT; if ((ms & (SEQ_S - 1)) == SEQ_S - 1) so = A.out + O_SHIFT_S + (size_t)(ms / SEQ_S) * DM; }
#pragma unroll
            for (int j = 0; j < 4; ++j) { const f32x4 g = g1v[64 * j]; const f32x4 y = (rr ? v1[j] : v0[j]) * rstd * g;
                v2u w; w.x = cvt_pk_bf16(y[0], y[1]); w.y = cvt_pk_bf16(y[2], y[3]); o8[64 * j] = w;
                if (so) ((f32x4*)so)[lane + 64 * j] = y; }
        }
    }
    for (int m = NTOK + gw; m < MPAD; m += NGW) {
        v2u* o8 = (v2u*)(A1 + (size_t)m * DM) + lane;
        if (m < NTOK + NSHIFT) {
            const f32x4* xr = (const f32x4*)(A.in[I_SSHIFT] + (size_t)(m - NTOK) * DM) + lane;
#pragma unroll
            for (int j = 0; j < 4; ++j) { const f32x4 y = xr[64 * j]; v2u w; w.x = cvt_pk_bf16(y[0], y[1]); w.y = cvt_pk_bf16(y[2], y[3]); o8[64 * j] = w; }
        } else {
#pragma unroll
            for (int j = 0; j < 4; ++j) { v2u w; w.x = 0u; w.y = 0u; o8[64 * j] = w; }
        }
    }
}

__device__ __forceinline__ void unpack8(const v4u w, float (&f)[8]) { f[0] = bf_lo(w.x); f[1] = bf_hi(w.x); f[2] = bf_lo(w.y); f[3] = bf_hi(w.y); f[4] = bf_lo(w.z); f[5] = bf_hi(w.z); f[6] = bf_lo(w.w); f[7] = bf_hi(w.w); }
__device__ __forceinline__ void conv_phase(const Args& A, int gt, int nth) {
    const bf16* Zc = (const bf16*)(A.ws + WS_ZC); bf16* YA = (bf16*)(A.ws + WS_A1);
    const float* cw = A.in[I_CONVW];
    for (int task = gt; task < (NTOK / 16) * 64; task += nth) {
        const int seg = task >> 6, ch = (task & 63) * 8, row0 = seg * 16;
        int b, t0, T; bool prompt = row0 < NPROMPT;
        if (prompt) { b = row0 / SEQ_P; t0 = row0 % SEQ_P; T = SEQ_P; } else { b = (row0 - NPROMPT) / SEQ_S; t0 = 0; T = SEQ_S; }
        float um2[8], um1[8], c0[8], c1[8], c2[8];
#pragma unroll
        for (int i = 0; i < 8; ++i) { c0[i] = cw[ch + i]; c1[i] = cw[512 + ch + i]; c2[i] = cw[1024 + ch + i]; }
        if (t0 == 0) {
            if (prompt) {
#pragma unroll
                for (int i = 0; i < 8; ++i) { um2[i] = 0.f; um1[i] = 0.f; }
            } else { const float* sc = A.in[I_SCONV] + (size_t)b * 2 * 512 + ch;
#pragma unroll
                for (int i = 0; i < 8; ++i) { um2[i] = sc[i]; um1[i] = sc[512 + i]; } }
        } else {
            float a[8], h[8];
            unpack8(*(const v4u*)(Zc + (size_t)(row0 - 2) * 1536 + 512 + ch), a); unpack8(*(const v4u*)(Zc + (size_t)(row0 - 2) * 1536 + 1024 + ch), h);
#pragma unroll
            for (int i = 0; i < 8; ++i) um2[i] = a[i] * h[i];
            unpack8(*(const v4u*)(Zc + (size_t)(row0 - 1) * 1536 + 512 + ch), a); unpack8(*(const v4u*)(Zc + (size_t)(row0 - 1) * 1536 + 1024 + ch), h);
#pragma unroll
            for (int i = 0; i < 8; ++i) um1[i] = a[i] * h[i];
        }
#pragma unroll 4
        for (int t = 0; t < 16; ++t) {
            const size_t row = (size_t)(row0 + t);
            float zb[8], zc[8], zh[8], y[8];
            unpack8(*(const v4u*)(Zc + row * 1536 + ch), zb); unpack8(*(const v4u*)(Zc + row * 1536 + 512 + ch), zc); unpack8(*(const v4u*)(Zc + row * 1536 + 1024 + ch), zh);
#pragma unroll
            for (int i = 0; i < 8; ++i) { const float u = zc[i] * zh[i]; y[i] = zb[i] * (c0[i] * um2[i] + c1[i] * um1[i] + c2[i] * u); um2[i] = um1[i]; um1[i] = u; }
            v4u o; o.x = cvt_pk_bf16(y[0], y[1]); o.y = cvt_pk_bf16(y[2], y[3]); o.z = cvt_pk_bf16(y[4], y[5]); o.w = cvt_pk_bf16(y[6], y[7]);
            *(v4u*)(YA + row * 512 + ch) = o;
        }
        if (t0 + 16 == T) { float* oc = A.out + (prompt ? O_CONV_P : O_CONV_S) + (size_t)b * 2 * 512 + ch;
#pragma unroll
            for (int i = 0; i < 8; ++i) { oc[i] = um2[i]; oc[512 + i] = um1[i]; } }
    }
    bf16* Zr = (bf16*)(A.ws + WS_ZR);
    for (int task = nth - 1 - gt; task < NTOK * 16; task += nth) {
        const int m = task >> 4, cs = task & 15;
        bool hasprev; int prow;
        if (m < NPROMPT) { hasprev = (m & (SEQ_P - 1)) != 0; prow = m - 1; } else { const int ms = m - NPROMPT; hasprev = true; prow = (ms & (SEQ_S - 1)) ? m - 1 : NTOK + ms / SEQ_S; }
        bf16* pap = Zr + (size_t)m * 2048 + 1536 + cs * 16;
        float pa[16], t8[8];
        const v4u a0 = *(const v4u*)pap, a1 = *(const v4u*)(pap + 8);
        v4u b0 = (v4u){0u, 0u, 0u, 0u}, b1 = b0;
        if (hasprev) { const bf16* pbp = Zr + (size_t)prow * 2048 + 1792 + cs * 16; b0 = *(const v4u*)pbp; b1 = *(const v4u*)(pbp + 8); }
        unpack8(a0, t8);
#pragma unroll
        for (int i = 0; i < 8; ++i) pa[i] = t8[i];
        unpack8(a1, t8);
#pragma unroll
        for (int i = 0; i < 8; ++i) pa[8 + i] = t8[i];
        unpack8(b0, t8);
#pragma unroll
        for (int i = 0; i < 8; ++i) pa[i] += t8[i];
        unpack8(b1, t8);
#pragma unroll
        for (int i = 0; i < 8; ++i) pa[8 + i] += t8[i];
#pragma unroll
        for (int i = 0; i < 16; ++i) { float p = pa[i];
            if (cs < 4) p = 1.0f - 2.0f * __builtin_amdgcn_rcpf(__expf(2.0f * p) + 1.0f);
            else if (cs >= 8) p = sigm(p);
            pa[i] = p; }
        v4u o0, o1; o0.x = cvt_pk_bf16(pa[0], pa[1]); o0.y = cvt_pk_bf16(pa[2], pa[3]); o0.z = cvt_pk_bf16(pa[4], pa[5]); o0.w = cvt_pk_bf16(pa[6], pa[7]);
        o1.x = cvt_pk_bf16(pa[8], pa[9]); o1.y = cvt_pk_bf16(pa[10], pa[11]); o1.z = cvt_pk_bf16(pa[12], pa[13]); o1.w = cvt_pk_bf16(pa[14], pa[15]);
        *(v4u*)pap = o0; *(v4u*)(pap + 8) = o1;
    }
}

constexpr int NUNITS_P = NB_P * 8 * 64, NUNITS = NUNITS_P + NB_S * 8;
constexpr int HID_STRIDE = 264, SC_TB = 32;
constexpr int P1_HIDB = 0, P1_LO = 16896, P1_SEQ = 41472, P1_GG = 90624, P1_YY = 98816, P1_ZZ = 107008, P1_BON = 115200;
typedef float f32x2 __attribute__((ext_vector_type(2)));

struct P1Pre { v4u pa0, pa1; v2u zr, zk, zv, pr, pk, pv; };
struct P1Pos { int unit, t0; };
__device__ __forceinline__ void p1_decode(int unit, bool& prompt, int& b, int& h, int& ch, int& T, int& rowbase) {
    prompt = unit < NUNITS_P; b = prompt ? unit >> 9 : (unit - NUNITS_P) >> 3; h = prompt ? (unit >> 6) & 7 : unit & 7; ch = prompt ? unit & 63 : 0;
    T = prompt ? 64 : SEQ_S; rowbase = prompt ? b * SEQ_P + ch * 64 : NPROMPT + b * SEQ_S;
}
__device__ __forceinline__ void p1_rows(int unit, int t0, int tt, size_t& row, size_t& prow, bool& hasprev, int& nb) {
    bool prompt; int b, h, ch, T, rowbase; p1_decode(unit, prompt, b, h, ch, T, rowbase);
    nb = (T - t0) < SC_TB ? (T - t0) : SC_TB;
    const int tloc = tt < nb ? tt : nb - 1, t = t0 + tloc; const bool first = (ch == 0);
    row = (size_t)(rowbase + t); hasprev = (t > 0) || !first || !prompt; prow = ((t > 0) || !first) ? row - 1 : (size_t)(NTOK + b);
}
__device__ __forceinline__ void p1_load(const Args& A, int unit, int t0, int tt, int cs, P1Pre& P) {
    size_t row, prow; bool hasprev; int nb; p1_rows(unit, t0, tt, row, prow, hasprev, nb);
    const int h = unit < NUNITS_P ? (unit >> 6) & 7 : unit & 7, hc = h * 64 + cs * 4;
    const bf16* Zr = (const bf16*)(A.ws + WS_ZR);
    P.pa0 = *(const v4u*)(Zr + row * 2048 + 1536 + cs * 16); P.pa1 = *(const v4u*)(Zr + row * 2048 + 1536 + cs * 16 + 8);
    P.zr = *(const v2u*)(Zr + row * 2048 + hc); P.zk = *(const v2u*)(Zr + row * 2048 + 512 + hc); P.zv = *(const v2u*)(Zr + row * 2048 + 1024 + hc);
    const v2u z2 = (v2u){0u, 0u};
    P.pr = z2; P.pk = z2; P.pv = z2;
    if (hasprev) { P.pr = *(const v2u*)(Zr + prow * 2048 + hc); P.pk = *(const v2u*)(Zr + prow * 2048 + 512 + hc); P.pv = *(const v2u*)(Zr + prow * 2048 + 1024 + hc); }
}
__device__ __forceinline__ bool p1_unit_at(int i, int vcu, int G, int& unit) {
    if (G == 256) { if (i > 16) return false; unit = i < 16 ? vcu * 16 + i : NUNITS_P + vcu; return true; }
    unit = vcu + i * G; return unit < NUNITS;
}

constexpr int WY_OS = 72, WY_TS = 24, WY_LS = 40;
constexpr int WY_AT = 0, WY_RT = WY_AT + 16 * WY_OS * 2, WY_BT = WY_RT + 16 * WY_OS * 2, WY_KT = WY_BT + 16 * WY_OS * 2, WY_BH = WY_KT + 16 * WY_OS * 2,
              WY_KH = WY_BH + 64 * WY_TS * 2, WY_VT = WY_KH + 64 * WY_TS * 2, WY_GC = WY_VT + 64 * WY_TS * 2, WY_BUF = WY_GC + 256;
constexpr int WY_BASE = 0;
constexpr int WY_LAB = WY_BASE + 2 * WY_BUF, WY_LAK = WY_LAB + 1024, WY_MC = WY_LAK + 16 * WY_LS * 2;
static_assert(WY_MC + 16 * WY_LS * 2 <= P1_SEQ, "UT-transform operands must fit over HIDB | LO");
constexpr int WY_XB = 115328, WY_RH = WY_XB + 128 * WY_OS * 2, WY_UT = WY_RH + 8 * 16 * 17 * 4, WY_END = WY_UT + 8 * 16 * WY_TS * 2;
static_assert(WY_END <= LDSCTL_OFF, "LDS map of pass 1");

constexpr int WY_G2 = P1_GG + 2048;
static_assert(WY_G2 + 1024 + 2 * 16 * WY_LS * 2 <= P1_YY, "second Gram set");
__device__ __forceinline__ void p1_wy(f32x4 (&X)[4], const LAS float* SEQ, LAS float* YY, LAS float* ZZ, LAS unsigned char* lds, int nb, int tid, int lane, int wave, int part = 0) {
    const bool pw = wave >= 4; const int nmc = nb >> 4;
    LAS bf16* Xb = (LAS bf16*)(lds + WY_XB); LAS float* RH = (LAS float*)(lds + WY_RH) + wave * 16 * 17; LAS bf16* UT = (LAS bf16*)(lds + WY_UT) + wave * 16 * WY_TS;
    const bf16x8 zero8 = (bf16x8){0, 0, 0, 0, 0, 0, 0, 0};
    for (int mc = 0; mc < nmc; ++mc) {
        asm volatile("" : "+v"(tid));
        LAS unsigned char* ob = lds + WY_BASE + mc * WY_BUF;
        LAS bf16* At = (LAS bf16*)(ob + WY_AT); LAS bf16* Rt = (LAS bf16*)(ob + WY_RT); LAS bf16* Bt = (LAS bf16*)(ob + WY_BT); LAS bf16* Kt = (LAS bf16*)(ob + WY_KT);
        LAS bf16* BhT = (LAS bf16*)(ob + WY_BH); LAS bf16* KhT = (LAS bf16*)(ob + WY_KH); LAS bf16* VT = (LAS bf16*)(ob + WY_VT); LAS float* GC = (LAS float*)(ob + WY_GC);
        const int tl = tid >> 5, c2 = (tid & 31) * 2, s0 = mc * 16;
        f32x2 cum = (f32x2){0.f, 0.f}, tot = cum, lwt = cum;
#pragma unroll
        for (int i = 0; i < 16; ++i) { const f32x2 l2 = *(const LAS f32x2*)(SEQ + (s0 + i) * 384 + 64 + c2); tot += l2; if (i <= tl) cum += l2; if (i == tl) lwt = l2; }
        const LAS float* sp = SEQ + (s0 + tl) * 384 + c2;
        const f32x2 a2 = *(const LAS f32x2*)(sp), b2 = *(const LAS f32x2*)(sp + 128), k2 = *(const LAS f32x2*)(sp + 192), r2 = *(const LAS f32x2*)(sp + 256), v2 = *(const LAS f32x2*)(sp + 320);
        const f32x2 gt = (f32x2){__expf(cum.x), __expf(cum.y)}, gp = (f32x2){__expf(cum.x - lwt.x), __expf(cum.y - lwt.y)}, gi = (f32x2){__expf(-cum.x), __expf(-cum.y)},
                    go = (f32x2){__expf(tot.x - cum.x), __expf(tot.y - cum.y)};
        *(LAS unsigned*)(At + tl * WY_OS + c2) = cvt_pk_bf16(a2.x * gp.x, a2.y * gp.y); *(LAS unsigned*)(Rt + tl * WY_OS + c2) = cvt_pk_bf16(r2.x * gt.x, r2.y * gt.y);
        *(LAS unsigned*)(Bt + tl * WY_OS + c2) = cvt_pk_bf16(b2.x * gi.x, b2.y * gi.y); *(LAS unsigned*)(Kt + tl * WY_OS + c2) = cvt_pk_bf16(k2.x * gi.x, k2.y * gi.y);
        const unsigned bh = cvt_pk_bf16(b2.x * go.x, b2.y * go.y), kh = cvt_pk_bf16(k2.x * go.x, k2.y * go.y), vv = cvt_pk_bf16(v2.x, v2.y);
        {
            const unsigned bh_o = (unsigned)__shfl_xor((int)bh, 32), kh_o = (unsigned)__shfl_xor((int)kh, 32), vv_o = (unsigned)__shfl_xor((int)vv, 32);
            const bool ev = (tl & 1) == 0; const int wo = (ev ? c2 : c2 + 1) * WY_TS + (tl & ~1);
            *(LAS unsigned*)(BhT + wo) = ev ? ((bh & 0xffffu) | (bh_o << 16)) : ((bh_o >> 16) | (bh & 0xffff0000u));
            *(LAS unsigned*)(KhT + wo) = ev ? ((kh & 0xffffu) | (kh_o << 16)) : ((kh_o >> 16) | (kh & 0xffff0000u));
            *(LAS unsigned*)(VT + wo) = ev ? ((vv & 0xffffu) | (vv_o << 16)) : ((vv_o >> 16) | (vv & 0xffff0000u)); }
        if (tl == 0) *(LAS f32x2*)(GC + c2) = (f32x2){__expf(tot.x), __expf(tot.y)};
    }
    __syncthreads();
    {
        asm volatile("" : "+v"(tid));
        const int fr = tid & 15, fq = (tid >> 4) & 3, g_ = wave & 3, m_ = wave >> 2;
        if (m_ < nmc) {
            LAS unsigned char* ob = lds + WY_BASE + m_ * WY_BUF; LAS unsigned char* gs = lds + (m_ ? WY_G2 : WY_LAB);
            LAS float* Lab = (LAS float*)gs; LAS bf16* Lak = (LAS bf16*)(gs + 1024); LAS bf16* Mc = (LAS bf16*)(gs + 1024 + 16 * WY_LS * 2);
            const LAS bf16* ab = (LAS bf16*)(ob + (g_ < 2 ? WY_AT : WY_RT)) + fr * WY_OS + fq * 8; const LAS bf16* bb = (LAS bf16*)(ob + ((g_ & 1) ? WY_KT : WY_BT)) + fr * WY_OS + fq * 8;
            f32x4 g = (f32x4){0.f, 0.f, 0.f, 0.f};
#pragma unroll
            for (int ks = 0; ks < 2; ++ks) g = __builtin_amdgcn_mfma_f32_16x16x32_bf16(*(const LAS bf16x8*)(bb + ks * 32), *(const LAS bf16x8*)(ab + ks * 32), g, 0, 0, 0);
#pragma unroll
            for (int rg = 0; rg < 4; ++rg) { const int tp = 4 * fq + rg; const bool keep = (g_ < 2) ? (fr > tp) : (fr >= tp); g[rg] = keep ? g[rg] : 0.f; }
            if (g_ == 0) *(LAS f32x4*)(Lab + fr * 16 + 4 * fq) = g;
            else { v2u w; w.x = cvt_pk_bf16(g[0], g[1]); w.y = cvt_pk_bf16(g[2], g[3]);
                if (g_ == 1) { *(LAS v2u*)(Lak + fr * WY_LS + 4 * fq) = w; *(LAS v2u*)(Lak + fr * WY_LS + 16 + 4 * fq) = (v2u){0u, 0u}; }
                else if (g_ == 2) *(LAS v2u*)(Mc + fr * WY_LS + 4 * fq) = w; else *(LAS v2u*)(Mc + fr * WY_LS + 16 + 4 * fq) = w; }
        }
    }
    __syncthreads();
    if (MK_DBGSEL == 2 && part) return;
    for (int mc = 0; mc < nmc; ++mc) {
        asm volatile("" : "+v"(tid));
        const int fr = tid & 15, fq = (tid >> 4) & 3;
        LAS unsigned char* ob = lds + WY_BASE + mc * WY_BUF; LAS unsigned char* gs = lds + (mc ? WY_G2 : WY_LAB);
        LAS bf16* At = (LAS bf16*)(ob + WY_AT); LAS bf16* Rt = (LAS bf16*)(ob + WY_RT);
        LAS bf16* BhT = (LAS bf16*)(ob + WY_BH); LAS bf16* KhT = (LAS bf16*)(ob + WY_KH); LAS bf16* VT = (LAS bf16*)(ob + WY_VT); LAS float* GC = (LAS float*)(ob + WY_GC);
        LAS float* Lab = (LAS float*)gs; LAS bf16* Lak = (LAS bf16*)(gs + 1024); LAS bf16* Mc = (LAS bf16*)(gs + 1024 + 16 * WY_LS * 2);
        f32x4 W1 = (f32x4){0.f, 0.f, 0.f, 0.f}, Y0 = W1;
        {
            const LAS bf16* xbp = Xb + (16 * wave + fr) * WY_OS + fq * 8;
#pragma unroll
            for (int ks = 0; ks < 2; ++ks) { const bf16x8 bx = *(const LAS bf16x8*)(xbp + ks * 32);
                W1 = __builtin_amdgcn_mfma_f32_16x16x32_bf16(*(const LAS bf16x8*)(At + fr * WY_OS + ks * 32 + fq * 8), bx, W1, 0, 0, 0);
                Y0 = __builtin_amdgcn_mfma_f32_16x16x32_bf16(*(const LAS bf16x8*)(Rt + fr * WY_OS + ks * 32 + fq * 8), bx, Y0, 0, 0, 0); }
        }
        if (!pw) { const bf16x8 la = *(const LAS bf16x8*)(Lak + fr * WY_LS + fq * 8); const bf16x8 vb0 = *(const LAS bf16x8*)(VT + (16 * wave + fr) * WY_TS + (fq & 1) * 8); const bf16x8 vb = fq < 2 ? vb0 : zero8;
            W1 = __builtin_amdgcn_mfma_f32_16x16x32_bf16(la, vb, W1, 0, 0, 0); }
#pragma unroll
        for (int rg = 0; rg < 4; ++rg) RH[(4 * fq + rg) * 17 + fr] = W1[rg];
        LDS_WAIT();
        {
            float u[16];
#pragma unroll
            for (int t = 0; t < 16; ++t) { if ((t & 3) == 0) asm volatile("" ::: "memory");
                float acc = RH[t * 17 + fr];
                if (!(MK_DBGSEL == 3 && part))
#pragma unroll
                for (int i4 = 0; i4 * 4 < t; ++i4) { const f32x4 l4 = *(const LAS f32x4*)(Lab + t * 16 + i4 * 4);
#pragma unroll
                    for (int e = 0; e < 4; ++e) if (i4 * 4 + e < t) acc += l4[e] * u[i4 * 4 + e]; }
                u[t] = acc; }
            if (fq == 0) { v4u o0, o1; o0.x = cvt_pk_bf16(u[0], u[1]); o0.y = cvt_pk_bf16(u[2], u[3]); o0.z = cvt_pk_bf16(u[4], u[5]); o0.w = cvt_pk_bf16(u[6], u[7]);
                o1.x = cvt_pk_bf16(u[8], u[9]); o1.y = cvt_pk_bf16(u[10], u[11]); o1.z = cvt_pk_bf16(u[12], u[13]); o1.w = cvt_pk_bf16(u[14], u[15]);
                *(LAS v4u*)(UT + fr * WY_TS) = o0; *(LAS v4u*)(UT + fr * WY_TS + 8) = o1; }
        }
        LDS_WAIT();
        {
            const bf16x8 uc = fq < 2 ? *(const LAS bf16x8*)(UT + fr * WY_TS + fq * 8) : (pw ? zero8 : *(const LAS bf16x8*)(VT + (16 * wave + fr) * WY_TS + (fq - 2) * 8));
            Y0 = __builtin_amdgcn_mfma_f32_16x16x32_bf16(*(const LAS bf16x8*)(Mc + fr * WY_LS + fq * 8), uc, Y0, 0, 0, 0);
            LAS float* yo = (pw ? ZZ + 16 * (wave - 4) : YY + 16 * wave) + fr;
#pragma unroll
            for (int rg = 0; rg < 4; ++rg) yo[(mc * 16 + 4 * fq + rg) * 64] = Y0[rg];
#pragma unroll
            for (int j = 0; j < 4; ++j) {
                const bf16x8 bc = fq < 2 ? *(const LAS bf16x8*)(BhT + (16 * j + fr) * WY_TS + fq * 8) : *(const LAS bf16x8*)(KhT + (16 * j + fr) * WY_TS + (fq - 2) * 8);
                X[j] = X[j] * *(const LAS f32x4*)(GC + 16 * j + 4 * fq);
                X[j] = __builtin_amdgcn_mfma_f32_16x16x32_bf16(bc, uc, X[j], 0, 0, 0);
                v2u w; w.x = cvt_pk_bf16(X[j][0], X[j][1]); w.y = cvt_pk_bf16(X[j][2], X[j][3]);
                *(LAS v2u*)(Xb + (16 * wave + fr) * WY_OS + 16 * j + 4 * fq) = w; }
        }
        LDS_WAIT();
    }
}

#define P1_LOAD_PARAMS(HH) do { int lf_ = fr, lq_ = fq, lt_ = tid; asm volatile("" : "+v"(lf_), "+v"(lq_), "+v"(lt_));   \
        const int h_ = (HH), ncol_ = h_ * 64 + ntl * 16 + lf_; \
        _Pragma("unroll") for (int ks = 0; ks < 2; ++ks) { bw[ks] = *(const bf16x8*)(L2T + (size_t)ncol_ * 64 + lq_ * 8 + ks * 32); ba[ks] = *(const bf16x8*)(L2T + (size_t)512 * 64 + (size_t)ncol_ * 64 + lq_ * 8 + ks * 32); } \
        _Pragma("unroll") for (int ks = 0; ks < 4; ++ks) bg[ks] = *(const bf16x8*)(L2T + (size_t)1024 * 64 + (size_t)ncol_ * 128 + lq_ * 8 + ks * 32); \
        if (lt_ < 128) { const int a_ = lt_ >> 4, c_ = (lt_ & 15) * 4; \
            const float* src_ = a_ == 0 ? A.in[I_W0] : a_ == 1 ? A.in[I_A0] : a_ == 2 ? A.in[I_KK] : a_ == 3 ? A.in[I_KA] : a_ == 4 ? A.in[I_RK] : A.in[I_MURKV] + (a_ - 5) * 512; \
            *(LAS f32x4*)(PRM + a_ * 64 + c_) = *(const f32x4*)(src_ + h_ * 64 + c_); } } while (0)
__device__ __forceinline__ void scan_pass1(const Args& A, LAS unsigned char* lds, int tid, int lane, int wave, int vcu, int G, int part = 0) {
    bf16* GB = (bf16*)(A.ws + WS_A1) + (size_t)MPAD * 512;
    bf16* YL = (bf16*)(A.ws + WS_YL); bf16* ZT = (bf16*)(A.ws + WS_ZT); bf16* BV = (bf16*)(A.ws + WS_BV);
    LAS bf16* HIDB = (LAS bf16*)(lds + P1_HIDB); LAS float* LO = (LAS float*)(lds + P1_LO); LAS float* SEQ = (LAS float*)(lds + P1_SEQ);
    LAS float* YY = (LAS float*)(lds + P1_YY); LAS float* ZZ = (LAS float*)(lds + P1_ZZ);
    const bf16* L2T = (const bf16*)(A.ws + WS_L2T);
    const bool prow_wave = wave >= 4;
    const int mt = wave & 1, ntl = wave >> 1;
    int tt = tid >> 4, cs = tid & 15, c4 = cs * 4, fr = lane & 15, fq = lane >> 4;
    f32x4 X[4];
    bf16x8 bw[2], ba[2], bg[4];
    LAS float* PRM = (LAS float*)(lds + P1_GG);
    int cur_h = -1;
    int ui = 0, unit; if (!p1_unit_at(0, vcu, G, unit)) return;
    int t0 = 0; P1Pre pre; p1_load(A, unit, 0, tt, cs, pre);
    for (;;) {
        { int lt_ = tid; asm volatile("" : "+v"(lt_)); tt = lt_ >> 4; cs = lt_ & 15; c4 = cs * 4; fr = lt_ & 15; fq = (lt_ >> 4) & 3; }
        bool prompt; int b, h, ch, T, rowbase; p1_decode(unit, prompt, b, h, ch, T, rowbase);
        const int hc = h * 64 + c4;
        if (t0 == 0 && G == 256 && ui < 8) {
            const size_t i16 = ((size_t)(ui * 256 + vcu) * NTHR + tid) * 16;
            cvt16_fp8_sliced(A.in[I_U], A.ws + WS_UB, PEER_SU, i16); cvt16_fp8_sliced(A.in[I_V], A.ws + WS_VB, PEER_SV, i16); }
        if (t0 == 0) {
            LAS bf16* Xb = (LAS bf16*)(lds + WY_XB);
#pragma unroll
            for (int j = 0; j < 4; ++j) { const int prow_ = 16 * (wave - 4) + fr, c0_ = 16 * j + 4 * fq;
#pragma unroll
                for (int e = 0; e < 4; ++e) X[j][e] = (prow_wave && prow_ == c0_ + e) ? 1.f : 0.f;
                v2u w; w.x = cvt_pk_bf16(X[j][0], X[j][1]); w.y = cvt_pk_bf16(X[j][2], X[j][3]);
                *(LAS v2u*)(Xb + (16 * wave + fr) * WY_OS + c0_) = w; }
        }
        if (h != cur_h) { cur_h = h; P1_LOAD_PARAMS(h); }
        size_t row, prow; bool hasprev; int nb; p1_rows(unit, t0, tt, row, prow, hasprev, nb);
        if (!(MK_DBGSEL == 5 && part)) { *(LAS v4u*)(HIDB + tt * HID_STRIDE + cs * 16) = pre.pa0; *(LAS v4u*)(HIDB + tt * HID_STRIDE + cs * 16 + 8) = pre.pa1; }
        __syncthreads();
        if (!(MK_DBGSEL == 5 && part)) {
            const LAS bf16* ap = HIDB + (mt * 16 + fr) * HID_STRIDE + fq * 8;
            f32x4 cw = (f32x4){0.f, 0.f, 0.f, 0.f}, ca = cw, cg = cw;
#pragma unroll
            for (int ks = 0; ks < 2; ++ks) { cw = __builtin_amdgcn_mfma_f32_16x16x32_bf16(*(const LAS bf16x8*)(ap + ks * 32), bw[ks], cw, 0, 0, 0);
                                             ca = __builtin_amdgcn_mfma_f32_16x16x32_bf16(*(const LAS bf16x8*)(ap + 64 + ks * 32), ba[ks], ca, 0, 0, 0); }
#pragma unroll
            for (int ks = 0; ks < 4; ++ks) cg = __builtin_amdgcn_mfma_f32_16x16x32_bf16(*(const LAS bf16x8*)(ap + 128 + ks * 32), bg[ks], cg, 0, 0, 0);
#pragma unroll
            for (int rg = 0; rg < 4; ++rg) { const int o = (mt * 16 + fq * 4 + rg) * 64 + ntl * 16 + fr; LO[o] = cw[rg]; LO[2048 + o] = ca[rg]; LO[4096 + o] = cg[rg]; }
        }
        __syncthreads();
        if (!(MK_DBGSEL == 5 && part)) {
            const f32x4 w0v = *(const LAS f32x4*)(PRM + c4), a0v = *(const LAS f32x4*)(PRM + 64 + c4), kkv = *(const LAS f32x4*)(PRM + 128 + c4), kav = *(const LAS f32x4*)(PRM + 192 + c4),
                        rkv = *(const LAS f32x4*)(PRM + 256 + c4), mur = *(const LAS f32x4*)(PRM + 320 + c4), muk = *(const LAS f32x4*)(PRM + 384 + c4), muv = *(const LAS f32x4*)(PRM + 448 + c4);
            const f32x4 aw = w0v + *(const LAS f32x4*)(LO + tt * 64 + c4), aa = a0v + *(const LAS f32x4*)(LO + 2048 + tt * 64 + c4), ag = *(const LAS f32x4*)(LO + 4096 + tt * 64 + c4);
            f32x4 r = (f32x4){bf_lo(pre.zr.x), bf_hi(pre.zr.x), bf_lo(pre.zr.y), bf_hi(pre.zr.y)}, k = (f32x4){bf_lo(pre.zk.x), bf_hi(pre.zk.x), bf_lo(pre.zk.y), bf_hi(pre.zk.y)},
                  v = (f32x4){bf_lo(pre.zv.x), bf_hi(pre.zv.x), bf_lo(pre.zv.y), bf_hi(pre.zv.y)};
            const f32x4 rpv = (f32x4){bf_lo(pre.pr.x), bf_hi(pre.pr.x), bf_lo(pre.pr.y), bf_hi(pre.pr.y)}, kpv = (f32x4){bf_lo(pre.pk.x), bf_hi(pre.pk.x), bf_lo(pre.pk.y), bf_hi(pre.pk.y)},
                        vpv = (f32x4){bf_lo(pre.pv.x), bf_hi(pre.pv.x), bf_lo(pre.pv.y), bf_hi(pre.pv.y)};
            r = r + mur * (rpv - r); k = k + muk * (kpv - k); v = v + muv * (vpv - v);
            f32x4 dec, asg, kk, km, av, bv;
            float ssq = 0.f, bon = 0.f;
#pragma unroll
            for (int i = 0; i < 4; ++i) {
                const float x = -aw[i];
                const float sp = fmaxf(x, 0.f) + __logf(1.0f + __expf(-fabsf(x)));
                const float wraw = -sp - 0.5f;
                dec[i] = -__expf(wraw);
                asg[i] = sigm(aa[i]);
                kk[i] = k[i] * kkv[i]; ssq += kk[i] * kk[i];
                km[i] = k[i] * (1.0f + (asg[i] - 1.0f) * kav[i]);
                bon += r[i] * km[i] * rkv[i];
            }
            ssq = sum16(ssq); bon = sum16(bon);
            const float inv = 1.0f / fmaxf(sqrtf(ssq), 1e-12f);
#pragma unroll
            for (int i = 0; i < 4; ++i) { kk[i] *= inv; av[i] = -kk[i]; bv[i] = kk[i] * asg[i]; }
            LAS float* sq_ = SEQ + tt * 384 + c4;
            *(LAS f32x4*)(sq_) = av; *(LAS f32x4*)(sq_ + 64) = dec; *(LAS f32x4*)(sq_ + 128) = bv; *(LAS f32x4*)(sq_ + 192) = km; *(LAS f32x4*)(sq_ + 256) = r; *(LAS f32x4*)(sq_ + 320) = v;
            if (tt < nb) {
                v2u w; w.x = cvt_pk_bf16(ag[0], ag[1]); w.y = cvt_pk_bf16(ag[2], ag[3]); *(v2u*)(GB + row * 512 + hc) = w;
                w.x = cvt_pk_bf16(bon * v[0], bon * v[1]); w.y = cvt_pk_bf16(bon * v[2], bon * v[3]); *(v2u*)(BV + row * 512 + hc) = w;
            }
        }
        int nunit = unit, nt0 = t0 + SC_TB, nui = ui; bool more = true;
        if (nt0 >= T) { nt0 = 0; nui = ui + 1; more = p1_unit_at(nui, vcu, G, nunit); }
        if (more) p1_load(A, nunit, nt0, tt, cs, pre);
        __syncthreads();
        if (!(MK_DBGSEL == 1 && part)) p1_wy(X, SEQ, YY, ZZ, lds, nb, tid, lane, wave, part);
        __syncthreads();
        if (tt < nb) {
            const f32x4 y = *(const LAS f32x4*)(YY + tt * 64 + c4), z = *(const LAS f32x4*)(ZZ + tt * 64 + c4);
            v2u w; w.x = cvt_pk_bf16(y[0], y[1]); w.y = cvt_pk_bf16(y[2], y[3]); *(v2u*)(YL + row * 512 + hc) = w;
            w.x = cvt_pk_bf16(z[0], z[1]); w.y = cvt_pk_bf16(z[2], z[3]); *(v2u*)(ZT + row * 512 + hc) = w;
        }
        if (t0 + SC_TB >= T) {
#pragma unroll
            for (int j = 0; j < 4; ++j) {
                if (!prow_wave) *(f32x4*)((float*)A.out + (size_t)unit * 4096 + (16 * wave + fr) * 64 + 16 * j + 4 * fq) = X[j];
                else { v2u o; o.x = cvt_pk_bf16(X[j][0], X[j][1]); o.y = cvt_pk_bf16(X[j][2], X[j][3]);
                    *(v2u*)((bf16*)((unsigned char*)A.out + OB_MB) + (size_t)unit * 4096 + (16 * (wave - 4) + fr) * 64 + 16 * j + 4 * fq) = o; }
            }
        }
        if (!more) break;
        unit = nunit; t0 = nt0; ui = nui;
    }
    __syncthreads();
}

constexpr int P2_SP = 68, P2_MP = 80, P2_ML = 16 * P2_SP * 4, P2_PL = P2_ML + 64 * P2_MP * 4;
__device__ __forceinline__ void scan_pass2_rows(const float* Sinit, int unit0, int nchunks, int v0, float* outfin, bool slots, const Args& A, LAS unsigned char* lds, int tid, int lane, int wave) {
    LAS float* Sl = (LAS float*)lds; LAS float* Ml = (LAS float*)(lds + P2_ML); LAS float* Pl = (LAS float*)(lds + P2_PL);
    const int nt = wave & 3, kh = wave >> 2, fr = lane & 15, fq = lane >> 4;
    float* NB = (float*)A.out; const bf16* MB = (const bf16*)((const unsigned char*)A.out + OB_MB);
    { const int idx = tid * 2, row = idx >> 6, col = idx & 63;
      const f32x2 s0 = Sinit ? *(const f32x2*)(Sinit + (size_t)(v0 + row) * 64 + col) : (f32x2){0.f, 0.f};
      *(LAS f32x2*)(Sl + row * P2_SP + col) = s0; }
    v4u mreg = *(const v4u*)(MB + (size_t)unit0 * 4096 + tid * 8);
    float nreg[4] = {0.f, 0.f, 0.f, 0.f};
    if (kh == 0) {
#pragma unroll
        for (int rg = 0; rg < 4; ++rg) nreg[rg] = NB[(size_t)unit0 * 4096 + (v0 + fq * 4 + rg) * 64 + nt * 16 + fr]; }
    f32x4 acc = (f32x4){0.f, 0.f, 0.f, 0.f};
    for (int c = 0; c < nchunks; ++c) {
        { const int row = tid >> 3, col = (tid & 7) * 8; LAS float* mp = Ml + row * P2_MP + col;
          *(LAS f32x4*)mp = (f32x4){bf_lo(mreg.x), bf_hi(mreg.x), bf_lo(mreg.y), bf_hi(mreg.y)}; *(LAS f32x4*)(mp + 4) = (f32x4){bf_lo(mreg.z), bf_hi(mreg.z), bf_lo(mreg.w), bf_hi(mreg.w)}; }
        __syncthreads();
        float ncur[4] = {nreg[0], nreg[1], nreg[2], nreg[3]};
        if (c + 1 < nchunks) { mreg = *(const v4u*)(MB + (size_t)(unit0 + c + 1) * 4096 + tid * 8);
            if (kh == 0) {
#pragma unroll
                for (int rg = 0; rg < 4; ++rg) nreg[rg] = NB[(size_t)(unit0 + c + 1) * 4096 + (v0 + fq * 4 + rg) * 64 + nt * 16 + fr]; } }
        f32x4 a0 = (f32x4){0.f, 0.f, 0.f, 0.f}, a1 = a0;
        const LAS float* sp = Sl + fr * P2_SP + kh * 32 + fq; const LAS float* mp = Ml + (kh * 32 + fq) * P2_MP + nt * 16 + fr;
#pragma unroll
        for (int ks = 0; ks < 8; ks += 2) { a0 = __builtin_amdgcn_mfma_f32_16x16x4f32(sp[4 * ks], mp[4 * ks * P2_MP], a0, 0, 0, 0); a1 = __builtin_amdgcn_mfma_f32_16x16x4f32(sp[4 * ks + 4], mp[(4 * ks + 4) * P2_MP], a1, 0, 0, 0); }
        acc = a0 + a1;
        if (kh == 1) *(LAS f32x4*)(Pl + nt * 256 + lane * 4) = acc;
        __syncthreads();
        if (kh == 0) {
            acc = acc + *(const LAS f32x4*)(Pl + nt * 256 + lane * 4) + (f32x4){ncur[0], ncur[1], ncur[2], ncur[3]};
#pragma unroll
            for (int rg = 0; rg < 4; ++rg) { Sl[(fq * 4 + rg) * P2_SP + nt * 16 + fr] = acc[rg];
                if (slots) NB[(size_t)(unit0 + c) * 4096 + (v0 + fq * 4 + rg) * 64 + nt * 16 + fr] = acc[rg]; }
        }
    }
    if (kh == 0) {
#pragma unroll
        for (int rg = 0; rg < 4; ++rg) outfin[(size_t)(v0 + fq * 4 + rg) * 64 + nt * 16 + fr] = acc[rg]; }
    __syncthreads();
}

__device__ __forceinline__ void scan_pass3_wave(const Args& A, int unit, int wq, int lane) {
    const bool prompt = unit < NUNITS_P;
    const int b = prompt ? unit >> 9 : (unit - NUNITS_P) >> 3, h = prompt ? (unit >> 6) & 7 : unit & 7, ch = prompt ? unit & 63 : 0;
    const int T = prompt ? 64 : SEQ_S, rowbase = prompt ? b * SEQ_P + ch * 64 : NPROMPT + b * SEQ_S;
    if (wq * 16 >= T) return;
    const float* S0 = prompt ? (ch > 0 ? (const float*)A.out + (size_t)(unit - 1) * 4096 : nullptr) : A.in[I_SWKV] + (size_t)(b * 8 + h) * 4096;
    const bf16* ZT = (const bf16*)(A.ws + WS_ZT); const bf16* YL = (const bf16*)(A.ws + WS_YL); const bf16* BV = (const bf16*)(A.ws + WS_BV);
    bf16* YB = (bf16*)(A.ws + WS_A1) + (size_t)MPAD * 512;
    const int fr = lane & 15, fq = lane >> 4;
    const size_t row = (size_t)(rowbase + wq * 16 + fr);
    f32x4 acc[4];
#pragma unroll
    for (int mt = 0; mt < 4; ++mt) acc[mt] = (f32x4){0.f, 0.f, 0.f, 0.f};
    if (S0) {
        bf16x8 bz[2];
#pragma unroll
        for (int ks = 0; ks < 2; ++ks) bz[ks] = *(const bf16x8*)(ZT + row * 512 + h * 64 + ks * 32 + fq * 8);
#pragma unroll
        for (int mt = 0; mt < 4; ++mt)
#pragma unroll
            for (int ks = 0; ks < 2; ++ks) { const float* sp = S0 + (size_t)(mt * 16 + fr) * 64 + ks * 32 + fq * 8; const f32x4 s0 = *(const f32x4*)sp, s1 = *(const f32x4*)(sp + 4);
                v4u pk; pk.x = cvt_pk_bf16(s0[0], s0[1]); pk.y = cvt_pk_bf16(s0[2], s0[3]); pk.z = cvt_pk_bf16(s1[0], s1[1]); pk.w = cvt_pk_bf16(s1[2], s1[3]);
                acc[mt] = __builtin_amdgcn_mfma_f32_16x16x32_bf16(__builtin_bit_cast(bf16x8, pk), bz[ks], acc[mt], 0, 0, 0); }
    }
    float sm = 0.f;
#pragma unroll
    for (int mt = 0; mt < 4; ++mt) { const v2u yl = *(const v2u*)(YL + row * 512 + h * 64 + mt * 16 + fq * 4);
        acc[mt][0] += bf_lo(yl.x); acc[mt][1] += bf_hi(yl.x); acc[mt][2] += bf_lo(yl.y); acc[mt][3] += bf_hi(yl.y);
        sm += (acc[mt][0] + acc[mt][1]) + (acc[mt][2] + acc[mt][3]); }
    sm += __shfl_xor(sm, 16); sm += __shfl_xor(sm, 32);
    const float mean = sm * (1.f / 64.f); float sv = 0.f;
#pragma unroll
    for (int mt = 0; mt < 4; ++mt) { acc[mt] = acc[mt] - mean; sv += (acc[mt][0] * acc[mt][0] + acc[mt][1] * acc[mt][1]) + (acc[mt][2] * acc[mt][2] + acc[mt][3] * acc[mt][3]); }
    sv += __shfl_xor(sv, 16); sv += __shfl_xor(sv, 32);
    const float rs = 1.0f / sqrtf(sv * (1.f / 64.f) + 64e-5f);
#pragma unroll
    for (int mt = 0; mt < 4; ++mt) { const int c = h * 64 + mt * 16 + fq * 4;
        const f32x4 gw = *(const f32x4*)(A.in[I_GNW] + c), gb = *(const f32x4*)(A.in[I_GNB] + c);
        const v2u bvw = *(const v2u*)(BV + row * 512 + c), gg = *(const v2u*)(YB + row * 512 + c);
        f32x4 o = acc[mt] * rs * gw + gb + (f32x4){bf_lo(bvw.x), bf_hi(bvw.x), bf_lo(bvw.y), bf_hi(bvw.y)};
        o = o * (f32x4){bf_lo(gg.x), bf_hi(gg.x), bf_lo(gg.y), bf_hi(gg.y)};
        v2u w; w.x = cvt_pk_bf16(o[0], o[1]); w.y = cvt_pk_bf16(o[2], o[3]); *(v2u*)(YB + row * 512 + c) = w; }
}

__device__ __forceinline__ void tk_insert(float (&tv)[16], float x) {
#pragma unroll
    for (int i = 15; i >= 1; --i) tv[i] = __builtin_amdgcn_fmed3f(tv[i - 1], x, tv[i]);
    tv[0] = __builtin_fmaxf(tv[0], x);
}
__device__ __forceinline__ float gelu_tanh(float x) {
    const float u = 0.7978845608028654f * (x + 0.044715f * x * x * x);
    const float th = 1.0f - 2.0f * __builtin_amdgcn_rcpf(__expf(2.0f * u) + 1.0f);
    return 0.5f * x * (1.0f + th);
}
constexpr int NTILE32 = NTOK / 32;
constexpr int CW_QU = 8192, CW_QV = 8192 + 512;

constexpr int TK_STRIDE = 68, TK_BYTES = 64 * TK_STRIDE * 4;
__device__ __forceinline__ void topk_scores64(const bf16* Q, const bf16* KB, LAS float* SC, int t0, int hp, int p, int half, int lane, const bf16x8 (&af)[2][2][4]) {
    const int fr = lane & 15, fq = lane >> 4;
#pragma unroll
    for (int hs = 0; hs < 2; ++hs) {
        const bf16* kbase = KB + (size_t)(((hp + 4 * hs) * 2 + p) * 128 + half * 64 + fr) * 128 + fq * 8;
#pragma unroll
        for (int n = 0; n < 4; ++n) {
            bf16x8 bfr[4];
#pragma unroll
            for (int ks = 0; ks < 4; ++ks) bfr[ks] = *(const bf16x8*)(kbase + (size_t)n * 16 * 128 + ks * 32);
            f32x4 acc0 = (f32x4){0.f, 0.f, 0.f, 0.f}, acc1 = acc0;
#pragma unroll
            for (int ks = 0; ks < 4; ++ks) { acc0 = __builtin_amdgcn_mfma_f32_16x16x32_bf16(af[hs][0][ks], bfr[ks], acc0, 0, 0, 0); acc1 = __builtin_amdgcn_mfma_f32_16x16x32_bf16(af[hs][1][ks], bfr[ks], acc1, 0, 0, 0); }
#pragma unroll
            for (int rg = 0; rg < 4; ++rg) { SC[(hs * 32 + fq * 4 + rg) * TK_STRIDE + n * 16 + fr] = acc0[rg]; SC[(hs * 32 + 16 + fq * 4 + rg) * TK_STRIDE + n * 16 + fr] = acc1[rg]; }
        }
    }
}
__device__ __forceinline__ void peer_topk_phase(const Args& A, LAS unsigned char* lds, int tid, int lane, int wave, int vcu, int G) {
    const bf16* Q = (const bf16*)(A.ws + WS_ZG); const bf16* KB = (const bf16*)(A.ws + WS_KEYS); const float* SSP = (const float*)(A.ws + WS_SSP);
    unsigned short* EIDX = (unsigned short*)(A.ws + WS_EIDX); float* GATE = (float*)(A.ws + WS_GATE); float* RSTD = (float*)(A.ws + WS_RSTD);
    LAS float* SC = (LAS float*)(lds + wave * TK_BYTES);
    const int fr = lane & 15, fq = lane >> 4, tokl = lane & 31, hsel = lane >> 5;
    for (int u = wave * G + vcu; u < NTILE32 * 4; u += G * NWAVES) {
        const int t0 = (u >> 2) * 32, hp = u & 3, h = hp + 4 * hsel;
        const float* sp = SSP + (size_t)(t0 + tokl) * 16;
        const f32x4 s0 = *(const f32x4*)sp, s1 = *(const f32x4*)(sp + 4), s2 = *(const f32x4*)(sp + 8), s3 = *(const f32x4*)(sp + 12);
        const float ssq = ((s0[0] + s0[1]) + (s0[2] + s0[3])) + ((s1[0] + s1[1]) + (s1[2] + s1[3])) + ((s2[0] + s2[1]) + (s2[2] + s2[3])) + ((s3[0] + s3[1]) + (s3[2] + s3[3]));
        const float rstd = 1.0f / sqrtf(ssq * (1.f / DM) + 1e-6f);
        float tv0[16], tv1[16], cv[16];
#pragma unroll
        for (int p = 0; p < 2; ++p) {
            bf16x8 af[2][2][4];
#pragma unroll
            for (int hs = 0; hs < 2; ++hs)
#pragma unroll
                for (int mt = 0; mt < 2; ++mt) { const bf16* qp = Q + (size_t)(t0 + mt * 16 + fr) * 2048 + (hp + 4 * hs) * 256 + p * 128 + fq * 8;
#pragma unroll
                    for (int ks = 0; ks < 4; ++ks) af[hs][mt][ks] = *(const bf16x8*)(qp + ks * 32); }
            float tv[16];
#pragma unroll
            for (int i = 0; i < 16; ++i) tv[i] = -3.0e38f;
            for (int half = 0; half < 2; ++half) {
                topk_scores64(Q, KB, SC, t0, hp, p, half, lane, af);
                LDS_WAIT();
                const LAS float* mine = SC + lane * TK_STRIDE;
#pragma unroll 2
                for (int n = 0; n < 64; n += 4) { const f32x4 x4 = *(const LAS f32x4*)(mine + n);
#pragma unroll
                    for (int e = 0; e < 4; ++e) tk_insert(tv, __uint_as_float((__float_as_uint(x4[e]) & 0xFFFFFF80u) | (unsigned)(half * 64 + n + e))); }
                LDS_WAIT();
            }
#pragma unroll
            for (int i = 0; i < 16; ++i) { if (p == 0) tv0[i] = tv[i]; else tv1[i] = tv[i]; }
        }
        LAS int* li = (LAS int*)SC + lane * 33;
#pragma unroll
        for (int q = 0; q < 16; ++q) { li[q] = (int)(__float_as_uint(tv0[q]) & 127u); li[16 + q] = (int)(__float_as_uint(tv1[q]) & 127u);
            tv0[q] = __uint_as_float(__float_as_uint(tv0[q]) & 0xFFFFFF80u); tv1[q] = __uint_as_float(__float_as_uint(tv1[q]) & 0xFFFFFF80u); }
#pragma unroll
        for (int q = 0; q < 16; ++q) cv[q] = -3.0e38f;
#pragma unroll
        for (int a = 0; a < 16; ++a)
#pragma unroll
            for (int b = 0; b < 16; ++b) if ((a + 1) * (b + 1) <= 16)
                tk_insert(cv, __uint_as_float((__float_as_uint(tv0[a] + tv1[b]) & 0xFFFFFF00u) | (unsigned)(a * 16 + b)));
        LDS_WAIT();
        float e[16], den = 0.f; unsigned ci[16];
        const float c0 = __uint_as_float(__float_as_uint(cv[0]) & 0xFFFFFF00u);
#pragma unroll
        for (int q = 0; q < 16; ++q) { const unsigned kb = __float_as_uint(cv[q]); const float cq = __uint_as_float(kb & 0xFFFFFF00u);
            e[q] = __expf((cq - c0) * rstd); den += e[q]; ci[q] = (unsigned)(li[(kb >> 4) & 15] * 128 + li[16 + (kb & 15)]); }
        const float inv = 1.0f / den;
        LDS_WAIT();
        {
            const size_t tok = (size_t)(t0 + tokl);
            v4u w0, w1; w0.x = ci[0] | (ci[1] << 16); w0.y = ci[2] | (ci[3] << 16); w0.z = ci[4] | (ci[5] << 16); w0.w = ci[6] | (ci[7] << 16);
            w1.x = ci[8] | (ci[9] << 16); w1.y = ci[10] | (ci[11] << 16); w1.z = ci[12] | (ci[13] << 16); w1.w = ci[14] | (ci[15] << 16);
            *(v4u*)(EIDX + tok * 128 + h * 16) = w0; *(v4u*)(EIDX + tok * 128 + h * 16 + 8) = w1;
#pragma unroll
            for (int q = 0; q < 4; ++q) *(f32x4*)(GATE + tok * 128 + h * 16 + 4 * q) = (f32x4){e[4 * q] * inv, e[4 * q + 1] * inv, e[4 * q + 2] * inv, e[4 * q + 3] * inv};
            if (h == 0) RSTD[tok] = rstd;
        }
    }
}

constexpr int PEER_ITEM = 40, NITEM128 = NTOK / PEER_ITEM;
__device__ __forceinline__ bool peer_next_item(gu32* qbase, int xcc, int& qs, int& slice, int& item, LAS unsigned char* lds, int tid) {
    LAS int* box = (LAS int*)(lds + LDSCTL_OFF + 64);
    for (;;) {
        if (qs >= 8) return false;
        slice = (xcc + qs) & 7;
        if (tid == 0) box[0] = (int)__hip_atomic_fetch_add((unsigned*)(qbase + 64 * slice), 1u, RLX_AGENT);
        __syncthreads();
        item = box[0];
        __syncthreads();
        if (item < NITEM128) return true;
        ++qs;
    }
}

__device__ __forceinline__ void peer_u_phase(const Args& A, LAS unsigned char* lds, int tid, int lane, int wave, gu32* ctl, int qoff) {
    const unsigned char* Uq = A.ws + WS_UB; const bf16* XG = (const bf16*)(A.ws + WS_A1);
    const unsigned short* EIDX = (const unsigned short*)(A.ws + WS_EIDX); float* PART = (float*)(A.ws + WS_PART);
    const int xcc = (int)(xb_xcc_id() & 7u), rg = lane >> 3, c8 = lane & 7;
    LAS int* we = (LAS int*)(lds + wave * 1024);
    int qs = 0, slice, item;
    while (peer_next_item(ctl + CW_QU + qoff, xcc, qs, slice, item, lds, tid)) {
        const unsigned char* us = Uq + (size_t)slice * 16384 * 128 + c8 * 16;
        size_t tok = (size_t)(item * PEER_ITEM + wave);
        unsigned pair = *(const unsigned*)(EIDX + tok * 128 + 2 * lane);
        v4u xa = *(const v4u*)(XG + tok * DM + slice * 128 + c8 * 16), xb = *(const v4u*)(XG + tok * DM + slice * 128 + c8 * 16 + 8);
        for (int tt = 0; tt < PEER_ITEM / NWAVES; ++tt) {
            we[2 * lane] = (int)(pair & 0xffffu); we[2 * lane + 1] = (int)(pair >> 16);
            const f32x2 x[8] = {(f32x2){bf_lo(xa.x), bf_hi(xa.x)}, (f32x2){bf_lo(xa.y), bf_hi(xa.y)}, (f32x2){bf_lo(xa.z), bf_hi(xa.z)}, (f32x2){bf_lo(xa.w), bf_hi(xa.w)},
                                (f32x2){bf_lo(xb.x), bf_hi(xb.x)}, (f32x2){bf_lo(xb.y), bf_hi(xb.y)}, (f32x2){bf_lo(xb.z), bf_hi(xb.z)}, (f32x2){bf_lo(xb.w), bf_hi(xb.w)}};
            LDS_WAIT();
            v4u w[16];
#pragma unroll
            for (int it = 0; it < 16; ++it) w[it] = *(const v4u*)(us + (size_t)we[it * 8 + rg] * 128);
            const size_t ctok = tok;
            if (tt + 1 < PEER_ITEM / NWAVES) { tok += NWAVES; pair = *(const unsigned*)(EIDX + tok * 128 + 2 * lane);
                xa = *(const v4u*)(XG + tok * DM + slice * 128 + c8 * 16); xb = *(const v4u*)(XG + tok * DM + slice * 128 + c8 * 16 + 8); }
            float dlo = 0.f, dhi = 0.f;
#pragma unroll
            for (int it = 0; it < 16; ++it) {
                f32x2 d = __builtin_amdgcn_cvt_pk_f32_fp8(w[it].x, false) * x[0]; d += __builtin_amdgcn_cvt_pk_f32_fp8(w[it].x, true) * x[1];
                d += __builtin_amdgcn_cvt_pk_f32_fp8(w[it].y, false) * x[2]; d += __builtin_amdgcn_cvt_pk_f32_fp8(w[it].y, true) * x[3];
                d += __builtin_amdgcn_cvt_pk_f32_fp8(w[it].z, false) * x[4]; d += __builtin_amdgcn_cvt_pk_f32_fp8(w[it].z, true) * x[5];
                d += __builtin_amdgcn_cvt_pk_f32_fp8(w[it].w, false) * x[6]; d += __builtin_amdgcn_cvt_pk_f32_fp8(w[it].w, true) * x[7];
                const float ds = sum8(d.x + d.y);
                if ((it & 7) == c8) { if (it < 8) dlo = ds; else dhi = ds; }
            }
            float* pp = PART + (ctok * 8 + slice) * 128;
            pp[c8 * 8 + rg] = dlo; pp[(c8 + 8) * 8 + rg] = dhi;
            LDS_WAIT();
        }
    }
}

__device__ __forceinline__ void peer_coef_phase(const Args& A, int lane, int wave, int vcu, int G) {
    const float* PART = (const float*)(A.ws + WS_PART); const float* GATE = (const float*)(A.ws + WS_GATE); const float* RSTD = (const float*)(A.ws + WS_RSTD);
    float* COEF = (float*)(A.ws + WS_COEF);
    for (int tok = vcu * NWAVES + wave; tok < NTOK; tok += G * NWAVES) {
        const float* pp = PART + (size_t)tok * 1024 + 2 * lane;
        f32x2 d = *(const f32x2*)pp;
#pragma unroll
        for (int j = 1; j < 8; ++j) d += *(const f32x2*)(pp + j * 128);
        const float sc = RSTD[tok] * (1.0f / PEER_SU); const f32x2 gt = *(const f32x2*)(GATE + (size_t)tok * 128 + 2 * lane);
        f32x2 cf; cf.x = gt.x * gelu_tanh(d.x * sc) * (1.0f / PEER_SV); cf.y = gt.y * gelu_tanh(d.y * sc) * (1.0f / PEER_SV);
        *(f32x2*)(COEF + (size_t)tok * 128 + 2 * lane) = cf;
    }
}

__device__ __forceinline__ void peer_v_phase(const Args& A, LAS unsigned char* lds, int tid, int lane, int wave, gu32* ctl) {
    const unsigned char* Vq = A.ws + WS_VB;
    const unsigned short* EIDX = (const unsigned short*)(A.ws + WS_EIDX); const float* COEF = (const float*)(A.ws + WS_COEF);
    float* X1 = A.out + O_Y; float* SS2 = (float*)(A.ws + WS_SS2);
    const int xcc = (int)(xb_xcc_id() & 7u), rg = lane >> 3, c8 = lane & 7;
    LAS int* we = (LAS int*)(lds + wave * 8192);
    LAS float* wc = (LAS float*)(we + 128); LAS float* wp = (LAS float*)(we + 256);
    int qs = 0, slice, item;
    while (peer_next_item(ctl + CW_QV, xcc, qs, slice, item, lds, tid)) {
        const unsigned char* vs = Vq + (size_t)slice * 16384 * 128 + c8 * 16;
        size_t tok = (size_t)(item * PEER_ITEM + wave);
        unsigned pair = *(const unsigned*)(EIDX + tok * 128 + 2 * lane); f32x2 cf = *(const f32x2*)(COEF + tok * 128 + 2 * lane);
        const bf16* XGv = (const bf16*)(A.ws + WS_A1);
        const f32x2 g2v = *(const f32x2*)(A.in[I_N2G] + slice * 128 + 2 * lane); const f32x2 rg2 = (f32x2){1.0f / g2v.x, 1.0f / g2v.y};
        unsigned xold = *(const unsigned*)(XGv + tok * DM + slice * 128 + 2 * lane);
        for (int tt = 0; tt < PEER_ITEM / NWAVES; ++tt) {
            we[2 * lane] = (int)(pair & 0xffffu); we[2 * lane + 1] = (int)(pair >> 16); *(LAS f32x2*)(wc + 2 * lane) = cf;
            const f32x2 xcur = (f32x2){bf_lo(xold) * rg2.x, bf_hi(xold) * rg2.y}; const size_t ctok = tok;
            LDS_WAIT();
            v4u w[16];
#pragma unroll
            for (int it = 0; it < 16; ++it) w[it] = *(const v4u*)(vs + (size_t)we[it * 8 + rg] * 128);
            if (tt + 1 < PEER_ITEM / NWAVES) { tok += NWAVES; pair = *(const unsigned*)(EIDX + tok * 128 + 2 * lane); cf = *(const f32x2*)(COEF + tok * 128 + 2 * lane);
                xold = *(const unsigned*)(XGv + tok * DM + slice * 128 + 2 * lane); }
            f32x2 o[8];
#pragma unroll
            for (int q = 0; q < 8; ++q) o[q] = (f32x2){0.f, 0.f};
#pragma unroll
            for (int it = 0; it < 16; ++it) {
                const float c = wc[it * 8 + rg]; const f32x2 c2 = (f32x2){c, c};
                o[0] += c2 * __builtin_amdgcn_cvt_pk_f32_fp8(w[it].x, false); o[1] += c2 * __builtin_amdgcn_cvt_pk_f32_fp8(w[it].x, true);
                o[2] += c2 * __builtin_amdgcn_cvt_pk_f32_fp8(w[it].y, false); o[3] += c2 * __builtin_amdgcn_cvt_pk_f32_fp8(w[it].y, true);
                o[4] += c2 * __builtin_amdgcn_cvt_pk_f32_fp8(w[it].z, false); o[5] += c2 * __builtin_amdgcn_cvt_pk_f32_fp8(w[it].z, true);
                o[6] += c2 * __builtin_amdgcn_cvt_pk_f32_fp8(w[it].w, false); o[7] += c2 * __builtin_amdgcn_cvt_pk_f32_fp8(w[it].w, true);
            }
#pragma unroll
            for (int q = 0; q < 4; ++q) *(LAS f32x4*)(wp + rg * 128 + c8 * 16 + 4 * q) = (f32x4){o[2 * q].x, o[2 * q].y, o[2 * q + 1].x, o[2 * q + 1].y};
            LDS_WAIT();
            f32x2 acc = *(const LAS f32x2*)(wp + 2 * lane);
#pragma unroll
            for (int r = 1; r < 8; ++r) acc += *(const LAS f32x2*)(wp + r * 128 + 2 * lane);
            const f32x2 x2 = xcur + acc;
            *(f32x2*)(X1 + ctok * DM + slice * 128 + 2 * lane) = x2;
            float ss = sum16(x2.x * x2.x + x2.y * x2.y); ss += __shfl_xor(ss, 16); ss += __shfl_xor(ss, 32);
            if (lane == 0) SS2[ctok * 8 + slice] = ss;
            LDS_WAIT();
        }
    }
}

__device__ __forceinline__ void peer_final_phase(const Args& A, int lane, int wave, int vcu, int G) {
    float* X1 = A.out + O_Y; const float* SS2 = (const float*)(A.ws + WS_SS2); const float* gf = A.in[I_NFG] + lane * 16;
    const f32x4 g0 = *(const f32x4*)gf, g1 = *(const f32x4*)(gf + 4), g2 = *(const f32x4*)(gf + 8), g3 = *(const f32x4*)(gf + 12);
    for (int tok = vcu * NWAVES + wave; tok < NTOK; tok += G * NWAVES) {
        const f32x4 sa = *(const f32x4*)(SS2 + (size_t)tok * 8), sb = *(const f32x4*)(SS2 + (size_t)tok * 8 + 4);
        const float ss = ((sa[0] + sa[1]) + (sa[2] + sa[3])) + ((sb[0] + sb[1]) + (sb[2] + sb[3]));
        const float rf = 1.0f / sqrtf(ss * (1.f / DM) + 1e-6f);
        float* yr = X1 + (size_t)tok * DM + lane * 16;
        const f32x4 y0 = *(const f32x4*)yr, y1 = *(const f32x4*)(yr + 4), y2 = *(const f32x4*)(yr + 8), y3 = *(const f32x4*)(yr + 12);
        *(f32x4*)yr = y0 * rf * g0; *(f32x4*)(yr + 4) = y1 * rf * g1; *(f32x4*)(yr + 8) = y2 * rf * g2; *(f32x4*)(yr + 12) = y3 * rf * g3;
    }
}

__device__ __forceinline__ void sg_partial(const bf16* Ap, int lda, const bf16* Bp, int ldb, LAS f32x4* red, int lane, int wave) {
    const int fr = lane & 15, fq = lane >> 4;
    bf16x8 a[2][4], b[4][4];
#pragma unroll
    for (int mi = 0; mi < 2; ++mi)
#pragma unroll
        for (int ks = 0; ks < 4; ++ks) a[mi][ks] = *(const bf16x8*)(Ap + (size_t)(16 * mi + fr) * lda + 32 * ks + 8 * fq);
#pragma unroll
    for (int nj = 0; nj < 4; ++nj)
#pragma unroll
        for (int ks = 0; ks < 4; ++ks) b[nj][ks] = *(const bf16x8*)(Bp + (size_t)(16 * nj + fr) * ldb + 32 * ks + 8 * fq);
    f32x4 acc[2][4];
#pragma unroll
    for (int mi = 0; mi < 2; ++mi)
#pragma unroll
        for (int nj = 0; nj < 4; ++nj) acc[mi][nj] = (f32x4){0.f, 0.f, 0.f, 0.f};
#pragma unroll
    for (int ks = 0; ks < 4; ++ks)
#pragma unroll
        for (int mi = 0; mi < 2; ++mi)
#pragma unroll
            for (int nj = 0; nj < 4; ++nj) acc[mi][nj] = __builtin_amdgcn_mfma_f32_16x16x32_bf16(b[nj][ks], a[mi][ks], acc[mi][nj], 0, 0, 0);
#pragma unroll
    for (int mi = 0; mi < 2; ++mi)
#pragma unroll
        for (int nj = 0; nj < 4; ++nj) red[(wave * 8 + mi * 4 + nj) * 64 + lane] = acc[mi][nj];
}
__device__ __forceinline__ f32x4 sg_sum(const LAS f32x4* red, int w0, int nw, int wave, int lane) {
    f32x4 s = red[(w0 * 8 + wave) * 64 + lane];
    for (int w = 1; w < nw; ++w) s += red[((w0 + w) * 8 + wave) * 64 + lane];
    return s;
}
__device__ __forceinline__ void sample_gemm2(const Args& A, LAS unsigned char* lds, int t, int lane, int wave) {
    unsigned char* ws = A.ws; const int fr = lane & 15, fq = lane >> 4;
    const int row0 = NPROMPT + (t >> 4) * 32, col0 = (t & 15) * 64;
    LAS f32x4* red = (LAS f32x4*)lds;
    const bf16* Ab = (const bf16*)(ws + WS_A1) + (wave >= 4 ? (size_t)MPAD * 512 : 0); const bf16* Bb = (const bf16*)(ws + (wave >= 4 ? WS_WPB : WS_WPA));
    sg_partial(Ab + (size_t)row0 * 512 + (wave & 3) * 128, 512, Bb + (size_t)col0 * 512 + (wave & 3) * 128, 512, red, lane, wave);
    const int row = row0 + 16 * (wave >> 2) + fr, c = col0 + 16 * (wave & 3) + 4 * fq;
    const bf16* Zg = (const bf16*)(ws + WS_ZG) + (size_t)row * 2048;
    const v2u ga = *(const v2u*)(Zg + c), gb = *(const v2u*)(Zg + 1024 + c);
    __syncthreads();
    const f32x4 pa = sg_sum(red, 0, 4, wave, lane), pb = sg_sum(red, 4, 4, wave, lane);
    const float o0 = sigm(bf_lo(ga.x)) * pa[0] + sigm(bf_lo(gb.x)) * pb[0], o1 = sigm(bf_hi(ga.x)) * pa[1] + sigm(bf_hi(gb.x)) * pb[1],
                o2 = sigm(bf_lo(ga.y)) * pa[2] + sigm(bf_lo(gb.y)) * pb[2], o3 = sigm(bf_hi(ga.y)) * pa[3] + sigm(bf_hi(gb.y)) * pb[3];
    v2u w; w.x = cvt_pk_bf16(o0, o1); w.y = cvt_pk_bf16(o2, o3); *(v2u*)((bf16*)(ws + WS_ZR) + (size_t)row * 1024 + c) = w;
    __syncthreads();
}
__device__ __forceinline__ void sample_gemm3(const Args& A, LAS unsigned char* lds, int t, int tid, int lane, int wave) {
    unsigned char* ws = A.ws; const int fr = lane & 15, fq = lane >> 4;
    const int row0 = NPROMPT + (t >> 4) * 32, col0 = (t & 15) * 64;
    LAS f32x4* red = (LAS f32x4*)lds; LAS float* ssl = (LAS float*)(lds + 65536);
    sg_partial((const bf16*)(ws + WS_ZR) + (size_t)row0 * 1024 + wave * 128, 1024, (const bf16*)(ws + WS_WO) + (size_t)col0 * 1024 + wave * 128, 1024, red, lane, wave);
    const int row = row0 + 16 * (wave >> 2) + fr, c = col0 + 16 * (wave & 3) + 4 * fq;
    const f32x4 xv = *(const f32x4*)(A.in[I_XS] + (size_t)(row - NPROMPT) * 1024 + c), q = *(const f32x4*)(A.in[I_N2G] + c);
    __syncthreads();
    const f32x4 o = xv + sg_sum(red, 0, 8, wave, lane);
    float ss = (o[0] * o[0] + o[1] * o[1]) + (o[2] * o[2] + o[3] * o[3]);
    v2u w; w.x = cvt_pk_bf16(o[0] * q[0], o[1] * q[1]); w.y = cvt_pk_bf16(o[2] * q[2], o[3] * q[3]); *(v2u*)((bf16*)(ws + WS_A1) + (size_t)row * 1024 + c) = w;
    ss += __shfl_xor(ss, 16); ss += __shfl_xor(ss, 32);
    if (fq == 0) ssl[wave * 16 + fr] = ss;
    __syncthreads();
    if (tid < 32) { const int mi = tid >> 4, r = tid & 15;
        ((float*)(ws + WS_SSP))[(size_t)(row0 + tid) * 16 + (t & 15)] = (ssl[(mi * 4 + 0) * 16 + r] + ssl[(mi * 4 + 1) * 16 + r]) + (ssl[(mi * 4 + 2) * 16 + r] + ssl[(mi * 4 + 3) * 16 + r]); }
}
__device__ __forceinline__ void sample_gemm4(const Args& A, LAS unsigned char* lds, int t, int lane, int wave) {
    unsigned char* ws = A.ws; const int fr = lane & 15, fq = lane >> 4;
    const int row0 = NPROMPT + (t >> 5) * 32, col0 = (t & 31) * 64;
    LAS f32x4* red = (LAS f32x4*)lds;
    sg_partial((const bf16*)(ws + WS_A1) + (size_t)row0 * 1024 + wave * 128, 1024, (const bf16*)(ws + WS_WQ) + (size_t)col0 * 1024 + wave * 128, 1024, red, lane, wave);
    const int row = row0 + 16 * (wave >> 2) + fr, c = col0 + 16 * (wave & 3) + 4 * fq;
    __syncthreads();
    const f32x4 o = sg_sum(red, 0, 8, wave, lane);
    v2u w; w.x = cvt_pk_bf16(o[0], o[1]); w.y = cvt_pk_bf16(o[2], o[3]); *(v2u*)((bf16*)(ws + WS_ZG) + (size_t)row * 2048 + c) = w;
    __syncthreads();
}

__global__ void __launch_bounds__(NTHR, 2) mk_fwd(Args args) {
    extern __shared__ __attribute__((aligned(16))) unsigned char lds_raw[];
    LAS unsigned char* lds = (LAS unsigned char*)lds_raw;
    const int tid = threadIdx.x, lane = tid & 63, wave = __builtin_amdgcn_readfirstlane(tid >> 6);
    const int G = gridDim.x; const int bx = blockIdx.x; const int vcu = (G % 8 == 0) ? (bx % 8) * (G / 8) + bx / 8 : bx;
    gu32* ctl = (gu32*)(args.ws + WS_CTL);
    volatile LAS unsigned* MISC = (volatile LAS unsigned*)(lds + MISC_OFF);
    for (int u = tid; u < (LDS_BYTES - LDSCTL_OFF) / 4; u += NTHR) ((LAS unsigned*)(lds + LDSCTL_OFF))[u] = 0u;
    __syncthreads();
    XcdBarrier bar; bar.bar = (unsigned*)(ctl + CW_BAR) + args.li * XCD_BAR_WORDS; bar.x = 0; bar.st = nullptr;
    if (N_LAUNCHES != PER_PHASE) bar = xcd_barrier_post((unsigned*)(ctl + CW_BAR) + args.li * XCD_BAR_WORDS, MISC + 8);
    const int lo = args.ph_lo, hi = args.ph_hi;
#define IN(k) (lo <= (k) && (k) < hi)
#define BOTH(k) (IN(k) && IN((k) + 1))
#define GRID_BAR() do { if (N_LAUNCHES != PER_PHASE) xcd_barrier(bar); } while (0)
    unsigned char* ws = args.ws;
    bf16* A1 = (bf16*)(ws + WS_A1);

    if (IN(0)) for (int rep_ = 0; rep_ < ((MK_REPEAT == 0) ? 2 : 1); ++rep_) { p0_prologue(args, lds, tid, lane, wave, vcu, G); if (BOTH(0)) GRID_BAR(); }

    if (IN(1)) for (int rep_ = 0; rep_ < ((MK_REPEAT == 1) ? 2 : 1); ++rep_) {
        pg8::Gemm g{A1, (const bf16*)(ws + WS_W1T), MPAD, N1, DM}; pg8::StaticOrder S; S.init(MPAD, N1, G, bx);
        pg8::EpiZ E{(bf16*)(ws + WS_ZC), (bf16*)(ws + WS_ZR), (bf16*)(ws + WS_ZG)};
        pg8::gemm_phase<pg8::EpiZ, pg8::StaticOrder, true, true>(lds, g, S, E);
        if (BOTH(1)) GRID_BAR();
    }

    if (IN(2)) for (int rep_ = 0; rep_ < ((MK_REPEAT == 2) ? 2 : 1); ++rep_) { conv_phase(args, vcu * NTHR + tid, G * NTHR); if (BOTH(2)) GRID_BAR(); }

    if (IN(3)) for (int rep_ = 0; rep_ < ((MK_REPEAT == 3) ? 2 : 1); ++rep_) {
        scan_pass1(args, lds, tid, lane, wave, vcu, G, (MK_REPEAT == 3 && rep_ == 0) ? 1 : 0);
        if (BOTH(3)) GRID_BAR();
    }

    if (IN(4)) {
        for (int u = vcu; u < 512; u += G) {
            if (u < 256) { const int bh = u >> 2, vq = u & 3; scan_pass2_rows(nullptr, bh * 64, 64, vq * 16, args.out + O_WKV_P + (size_t)bh * 4096, true, args, lds, tid, lane, wave); }
            else { const int bh = u - 256;
                for (int vq = 0; vq < 4; ++vq) scan_pass2_rows(args.in[I_SWKV] + (size_t)bh * 4096, NUNITS_P + bh, 1, vq * 16, args.out + O_WKV_S + (size_t)bh * 4096, false, args, lds, tid, lane, wave); }
        }
        if (BOTH(4)) GRID_BAR();
    }

    if (IN(5)) for (int rep_ = 0; rep_ < ((MK_REPEAT == 5) ? 2 : 1); ++rep_) {
        for (int u2 = vcu; u2 < NUNITS / 2; u2 += G) scan_pass3_wave(args, u2 * 2 + (wave >> 2), wave & 3, lane);
        if (BOTH(5)) GRID_BAR();
    }

    if (IN(6)) {
        { pg8::Gemm g{A1, (const bf16*)(ws + WS_WPA), NPROMPT, DM, 512}; pg8::StaticOrder S; S.init(NPROMPT, DM, G, bx);
          pg8::EpiGate<0> E{(const bf16*)(ws + WS_ZG), (bf16*)(ws + WS_ZR)};
          pg8::gemm_phase<pg8::EpiGate<0>, pg8::StaticOrder, true, true>(lds, g, S, E); }
        { pg8::Gemm g{A1 + (size_t)MPAD * 512, (const bf16*)(ws + WS_WPB), NPROMPT, DM, 512}; pg8::StaticOrder S; S.init(NPROMPT, DM, G, bx);
          pg8::EpiGate<1> E{(const bf16*)(ws + WS_ZG), (bf16*)(ws + WS_ZR)};
          pg8::gemm_phase<pg8::EpiGate<1>, pg8::StaticOrder, true, true>(lds, g, S, E); }
        for (int t = vcu; t < 256; t += G) sample_gemm2(args, lds, t, lane, wave);
        if (BOTH(6)) GRID_BAR();
    }

    if (IN(7)) for (int rep_ = 0; rep_ < ((MK_REPEAT == 7) ? 2 : 1); ++rep_) {
        pg8::Gemm g{(const bf16*)(ws + WS_ZR), (const bf16*)(ws + WS_WO), NPROMPT, DM, DM}; pg8::StaticOrder S; S.init(NPROMPT, DM, G, bx);
        pg8::EpiX1 E{args.in[I_XP], args.in[I_XS], args.out + O_Y, A1, (float*)(ws + WS_SSP), args.in[I_N2G], NPROMPT, NTOK};
        pg8::gemm_phase<pg8::EpiX1, pg8::StaticOrder, true, true>(lds, g, S, E);
        for (int t = vcu; t < 256; t += G) sample_gemm3(args, lds, t, tid, lane, wave);
        if (BOTH(7)) GRID_BAR();
    }

    if (IN(8)) for (int rep_ = 0; rep_ < ((MK_REPEAT == 8) ? 2 : 1); ++rep_) {
        pg8::Gemm g{A1, (const bf16*)(ws + WS_WQ), NPROMPT, 2048, DM}; pg8::StaticOrder S; S.init(NPROMPT, 2048, G, bx);
        pg8::EpiPlain E{(bf16*)(ws + WS_ZG), 2048};
        pg8::gemm_phase<pg8::EpiPlain, pg8::StaticOrder, true, true>(lds, g, S, E);
        for (int t = vcu; t < 512; t += G) sample_gemm4(args, lds, t, lane, wave);
        if (BOTH(8)) GRID_BAR();
    }

    if (IN(9)) for (int rep_ = 0; rep_ < ((MK_REPEAT == 9) ? 2 : 1); ++rep_) { peer_topk_phase(args, lds, tid, lane, wave, vcu, G); if (BOTH(9)) GRID_BAR(); }
    if (IN(10)) for (int rep_ = 0; rep_ < ((MK_REPEAT == 10) ? 2 : 1); ++rep_) { peer_u_phase(args, lds, tid, lane, wave, ctl, rep_ * 1024); if (BOTH(10)) GRID_BAR(); }
    if (IN(11)) { peer_coef_phase(args, lane, wave, vcu, G); if (BOTH(11)) GRID_BAR(); }
    if (IN(12)) { peer_v_phase(args, lds, tid, lane, wave, ctl); if (BOTH(12)) GRID_BAR(); }
    if (IN(13)) peer_final_phase(args, lane, wave, vcu, G);
#undef IN
#undef BOTH
#undef GRID_BAR
}

extern "C" void kernel_launch(void* const* d_in, const int* in_sizes, int n_in, void* d_out, int out_size, void* d_ws, size_t ws_size, hipStream_t stream) {
    static int grid = 0;
    if (grid == 0) {
        if (n_in != 32 || ws_size < WS_END) { fprintf(stderr, "kernel_launch: built for 32 inputs and >= %zu bytes of workspace; got n_in %d ws %zu; nothing launched\n", (size_t)WS_END, n_in, ws_size); grid = -1; return; }
        int dev = 0, cus = 0, per_cu = 0;
        if (hipGetDevice(&dev) != hipSuccess || hipDeviceGetAttribute(&cus, hipDeviceAttributeMultiprocessorCount, dev) != hipSuccess) { fprintf(stderr, "kernel_launch: device query failed\n"); grid = -1; return; }
        if (hipFuncSetAttribute((const void*)mk_fwd, hipFuncAttributeMaxDynamicSharedMemorySize, LDS_BYTES) != hipSuccess) { fprintf(stderr, "kernel_launch: hipFuncSetAttribute failed\n"); grid = -1; return; }
        if (hipOccupancyMaxActiveBlocksPerMultiprocessor(&per_cu, (const void*)mk_fwd, NTHR, LDS_BYTES) != hipSuccess || per_cu < 1)
            fprintf(stderr, "kernel_launch: note: occupancy query reports %d workgroups per CU\n", per_cu);
        (void)hipGetLastError();
        grid = cus;
    }
    if (grid < 0) return;
    if (hipMemsetAsync((char*)d_ws + WS_CTL, 0, CTL_ZERO_BYTES, stream) != hipSuccess) { fprintf(stderr, "kernel_launch: hipMemsetAsync failed\n"); return; }
    Args a{};
    for (int i = 0; i < 32; ++i) a.in[i] = (const float*)d_in[i];
    a.out = (float*)d_out; a.ws = (unsigned char*)d_ws;
    constexpr int NL = (N_LAUNCHES == PER_PHASE ? PER_PHASE : 1) + ((MK_EXTRA_LO >= 0) ? 1 : 0);
    for (int li = 0; li < NL; ++li) {
        if (N_LAUNCHES == PER_PHASE) { a.ph_lo = li; a.ph_hi = li + 1; } else { a.ph_lo = 0; a.ph_hi = PER_PHASE; }
        if (MK_EXTRA_LO >= 0 && li == NL - 1) { a.ph_lo = MK_EXTRA_LO; a.ph_hi = MK_EXTRA_HI; }
        a.li = li;
        hipLaunchKernelGGL(mk_fwd, dim3(grid), dim3(NTHR), LDS_BYTES, stream, a);
        const hipError_t le = hipPeekAtLastError();
        if (le != hipSuccess) { fprintf(stderr, "kernel_launch: launch %d failed: %s\n", li, hipGetErrorName(le)); break; }
    }
}
```

```cpp
#include <hip/hip_runtime.h>
#include <cstdio>
#include <cstdint>
#define MK_N_LAUNCHES 1
#define MK_REPEAT -1
#define MK_DBGSEL 0
#define MK_EXTRA_LO -1
#define MK_EXTRA_HI -1
namespace pg8 {
#define PG8_LAS __attribute__((address_space(3)))
typedef unsigned short bf16_t;
typedef short bf16x8 __attribute__((ext_vector_type(8)));
typedef float f32x4 __attribute__((ext_vector_type(4)));
typedef unsigned u32x4 __attribute__((ext_vector_type(4)));
constexpr int BM = 256, BK = 64, HALF = 128, HTB = HALF * BK * 2  , STAGE_BYTES = 8 * HTB, NXCD = 8, WGM = 8;

__host__ __device__ __forceinline__ int lds_byte(int r, int c) { const int st = (r >> 4) * 2 + (c >> 5), rr = r & 15, cc = c & 31, ob = rr * 64 + cc * 2; return st * 1024 + (ob ^ (((ob >> 9) & 1) << 5)); }
__host__ __device__ __forceinline__ void stage_rc(int b, int& R, int& C) { const int st = b / 1024, sb = b % 1024, swz = sb ^ (((sb >> 9) & 1) << 5); R = (st >> 1) * 16 + swz / 64; C = (st & 1) * 32 + (swz % 64) / 2; }
__host__ __device__ __forceinline__ int perm32(int rho) { const int n = rho >> 4, i = rho & 15; return 8 * (i >> 2) + 4 * n + (i & 3); }

struct Unit { int pm, pn; };
struct Gemm { const bf16_t* A; const bf16_t* Bt; int M, N, K; };

struct StaticOrder {
    int nM, nN, nwg, G, c;
    __host__ __device__ void init(int M, int N, int G_, int c_) { nM = M / BM; nN = N / BM; nwg = nM * nN; G = G_; c = c_; }
    __host__ __device__ bool next(int i, Unit& u) const {
        const long L = (long)i * G + c; if (L >= nwg) return false;
        int wgid = (int)L; { const int q = nwg / NXCD, r = nwg % NXCD, xcd = wgid % NXCD, off = wgid / NXCD; wgid = (xcd < r ? xcd * (q + 1) : r * (q + 1) + (xcd - r) * q) + off; }
        const int nig = WGM * nN, gid = wgid / nig, fm = gid * WGM, gsz = (nM - fm) < WGM ? (nM - fm) : WGM;
        u.pm = fm + ((wgid % nig) % gsz); u.pn = (wgid % nig) / gsz; return true;
    }
    __device__ __forceinline__ void a_ready(const Unit&) const {}
    __device__ __forceinline__ void done(const Unit&) const {}
};

typedef __bf16 bf16x2_cv __attribute__((ext_vector_type(2))); typedef float f32x2_cv __attribute__((ext_vector_type(2)));
__device__ __forceinline__ unsigned cvt_pk_bf16(float lo, float hi) { return __builtin_bit_cast(unsigned, __builtin_convertvector((f32x2_cv){lo, hi}, bf16x2_cv)); }
__device__ __forceinline__ float bf_lo(unsigned w) { return __uint_as_float(w << 16); }
__device__ __forceinline__ float bf_hi(unsigned w) { return __uint_as_float(w & 0xffff0000u); }
__device__ __forceinline__ float sigm(float x) { return __builtin_amdgcn_rcpf(1.0f + __expf(-x)); }

struct EpiZ {
    static constexpr bool PERM = true, AFTER_DRAIN = false;
    bf16_t *Zc, *Zr, *Zg;
    __device__ __forceinline__ void operator()(const f32x4 (&acc)[2][2][4][2], const Unit& u, int wr, int wc, int fr, int fq) const {
        bf16_t* base; int ldc, colt;
        if (u.pn < 6) { base = Zc; ldc = 1536; colt = u.pn * BM; }
        else if (u.pn < 14) { base = Zr; ldc = 2048; colt = (u.pn - 6) * BM; }
        else { base = Zg; ldc = 2048; colt = (u.pn - 14) * BM; }
        const int row0 = u.pm * BM + wr * 64 + fr, col0 = colt + wc * 32 + 8 * fq;
#pragma unroll
        for (int ai = 0; ai < 2; ++ai)
#pragma unroll
            for (int m = 0; m < 4; ++m) { bf16_t* rowp = base + (size_t)(row0 + ai * HALF + m * 16) * ldc + col0;
#pragma unroll
                for (int bj = 0; bj < 2; ++bj) { const f32x4 v0 = acc[ai][bj][m][0], v1 = acc[ai][bj][m][1];
                    u32x4 w; w.x = cvt_pk_bf16(v0[0], v0[1]); w.y = cvt_pk_bf16(v0[2], v0[3]); w.z = cvt_pk_bf16(v1[0], v1[1]); w.w = cvt_pk_bf16(v1[2], v1[3]);
                    *(u32x4*)(rowp + bj * HALF) = w; } }
    }
};
struct EpiPlain {
    static constexpr bool PERM = true, AFTER_DRAIN = false;
    bf16_t* O; int ldc;
    __device__ __forceinline__ void operator()(const f32x4 (&acc)[2][2][4][2], const Unit& u, int wr, int wc, int fr, int fq) const {
        const int row0 = u.pm * BM + wr * 64 + fr, col0 = u.pn * BM + wc * 32 + 8 * fq;
#pragma unroll
        for (int ai = 0; ai < 2; ++ai)
#pragma unroll
            for (int m = 0; m < 4; ++m) { bf16_t* rowp = O + (size_t)(row0 + ai * HALF + m * 16) * ldc + col0;
#pragma unroll
                for (int bj = 0; bj < 2; ++bj) { const f32x4 v0 = acc[ai][bj][m][0], v1 = acc[ai][bj][m][1];
                    u32x4 w; w.x = cvt_pk_bf16(v0[0], v0[1]); w.y = cvt_pk_bf16(v0[2], v0[3]); w.z = cvt_pk_bf16(v1[0], v1[1]); w.w = cvt_pk_bf16(v1[2], v1[3]);
                    *(u32x4*)(rowp + bj * HALF) = w; } }
    }
};
template <int SECOND> struct EpiGate {
    static constexpr bool PERM = true, AFTER_DRAIN = false;
    const bf16_t* Zg; bf16_t* MG;
    __device__ __forceinline__ void operator()(const f32x4 (&acc)[2][2][4][2], const Unit& u, int wr, int wc, int fr, int fq) const {
        const int row0 = u.pm * BM + wr * 64 + fr, col0 = u.pn * BM + wc * 32 + 8 * fq;
#pragma unroll
        for (int ai = 0; ai < 2; ++ai) {
            u32x4 gw[4][2], pw[4][2];
#pragma unroll
            for (int m = 0; m < 4; ++m) { const int r = row0 + ai * HALF + m * 16;
#pragma unroll
                for (int bj = 0; bj < 2; ++bj) { gw[m][bj] = *(const u32x4*)(Zg + (size_t)r * 2048 + SECOND * 1024 + col0 + bj * HALF);
                    if (SECOND) pw[m][bj] = *(const u32x4*)(MG + (size_t)r * 1024 + col0 + bj * HALF); } }
#pragma unroll
            for (int m = 0; m < 4; ++m) { const int r = row0 + ai * HALF + m * 16; bf16_t* op = MG + (size_t)r * 1024 + col0;
#pragma unroll
                for (int bj = 0; bj < 2; ++bj) { const u32x4 g = gw[m][bj]; f32x4 v0 = acc[ai][bj][m][0], v1 = acc[ai][bj][m][1];
                    v0[0] *= sigm(bf_lo(g.x)); v0[1] *= sigm(bf_hi(g.x)); v0[2] *= sigm(bf_lo(g.y)); v0[3] *= sigm(bf_hi(g.y));
                    v1[0] *= sigm(bf_lo(g.z)); v1[1] *= sigm(bf_hi(g.z)); v1[2] *= sigm(bf_lo(g.w)); v1[3] *= sigm(bf_hi(g.w));
                    if (SECOND) { const u32x4 p = pw[m][bj];
                        v0[0] += bf_lo(p.x); v0[1] += bf_hi(p.x); v0[2] += bf_lo(p.y); v0[3] += bf_hi(p.y);
                        v1[0] += bf_lo(p.z); v1[1] += bf_hi(p.z); v1[2] += bf_lo(p.w); v1[3] += bf_hi(p.w); }
                    u32x4 w; w.x = cvt_pk_bf16(v0[0], v0[1]); w.y = cvt_pk_bf16(v0[2], v0[3]); w.z = cvt_pk_bf16(v1[0], v1[1]); w.w = cvt_pk_bf16(v1[2], v1[3]);
                    *(u32x4*)(op + bj * HALF) = w; } }
        }
    }
};
struct EpiX1 {
    static constexpr bool PERM = false, AFTER_DRAIN = false;
    const float* xp; const float* xs; float* X1; bf16_t* X1B; float* SSP; const float* g2; int nprompt, nrows;
    __device__ __forceinline__ void operator()(const f32x4 (&acc)[2][2][4][2], const Unit& u, int wr, int wc, int fr, int fq) const {
        typedef unsigned u32x2v __attribute__((ext_vector_type(2)));
        const int col0 = u.pn * BM + wc * 32 + 4 * fq;
        f32x4 gq[2][2];
#pragma unroll
        for (int bj = 0; bj < 2; ++bj)
#pragma unroll
            for (int n = 0; n < 2; ++n) gq[bj][n] = *(const f32x4*)(g2 + col0 + bj * HALF + n * 16);
#pragma unroll
        for (int ai = 0; ai < 2; ++ai) {
            f32x4 xv[4][2][2];
#pragma unroll
            for (int m = 0; m < 4; ++m) { int r = u.pm * BM + ai * HALF + wr * 64 + m * 16 + fr; r = r < nrows ? r : nrows - 1;
                const float* xr = r < nprompt ? xp + (size_t)r * 1024 : xs + (size_t)(r - nprompt) * 1024;
#pragma unroll
                for (int bj = 0; bj < 2; ++bj)
#pragma unroll
                    for (int n = 0; n < 2; ++n) xv[m][bj][n] = *(const f32x4*)(xr + col0 + bj * HALF + n * 16); }
#pragma unroll
            for (int m = 0; m < 4; ++m) { const int r = u.pm * BM + ai * HALF + wr * 64 + m * 16 + fr; float ss = 0.f;
#pragma unroll
                for (int bj = 0; bj < 2; ++bj)
#pragma unroll
                    for (int n = 0; n < 2; ++n) { const int c = col0 + bj * HALF + n * 16; const f32x4 o = xv[m][bj][n] + acc[ai][bj][m][n];
                        ss += (o[0] * o[0] + o[1] * o[1]) + (o[2] * o[2] + o[3] * o[3]);
                        const f32x4 q = gq[bj][n]; u32x2v w; w.x = cvt_pk_bf16(o[0] * q[0], o[1] * q[1]); w.y = cvt_pk_bf16(o[2] * q[2], o[3] * q[3]);
                        if (r < nrows) *(u32x2v*)(X1B + (size_t)r * 1024 + c) = w; }
                ss += __shfl_xor(ss, 16); ss += __shfl_xor(ss, 32);
                if (fq == 0 && r < nrows) SSP[(size_t)r * 16 + u.pn * 4 + wc] = ss;
            }
        }
    }
};
template <class Epi, class Sched, bool ALIGN_EPI = false, bool SP2 = false>
__device__ __forceinline__ void gemm_phase(PG8_LAS unsigned char* lds, const Gemm g, const Sched& S, const Epi& E) {
    const int tid = threadIdx.x, wid = __builtin_amdgcn_readfirstlane(tid >> 6), lane = tid & 63, wr = wid >> 2, wc = wid & 3, fr = lane & 15, fq = lane >> 4;
    const int K = g.K, nt = K / BK;
    unsigned voffA[2], voffB[2];
#pragma unroll
    for (int i = 0; i < 2; ++i) { int R, C; stage_rc(tid * 16 + i * 8192, R, C); const int Rb = Epi::PERM ? ((R & ~31) + perm32(R & 31)) : R;
        voffA[i] = (unsigned)(R * K + C) * 2u; voffB[i] = (unsigned)(Rb * K + C) * 2u; }
    const size_t kstep = (size_t)(BK * 2);
    const size_t hstep = (size_t)HALF * K * 2;
    const size_t tstep = 2 * hstep;
    const unsigned ldsw = (unsigned)wid * 1024u;
    const int aoff = lds_byte(wr * 64 + fr, fq * 8), boff = lds_byte(wc * 32 + fr, fq * 8);
#define PG8_SA(b, h) (((b) * 2 + (h)) * HTB)
#define PG8_SB(b, h) ((4 + (b) * 2 + (h)) * HTB)
#define PG8_STAGE(bufoff, gbase, voff) do { _Pragma("unroll") for (int _i = 0; _i < 2; ++_i) \
        __builtin_amdgcn_global_load_lds((const unsigned*)((const char*)(gbase) + (voff)[_i]), (PG8_LAS unsigned*)(lds + (bufoff) + ldsw + _i * 8192), 16, 0, 0); } while (0)
#define PG8_LDA(dst, b, h) do { _Pragma("unroll") for (int m = 0; m < 4; ++m) _Pragma("unroll") for (int k = 0; k < 2; ++k) dst[m][k] = *(const PG8_LAS bf16x8*)(lds + PG8_SA(b, h) + aoff + m * 2048 + k * 1024); } while (0)
#define PG8_LDB(dst, b, h) do { _Pragma("unroll") for (int n = 0; n < 2; ++n) _Pragma("unroll") for (int k = 0; k < 2; ++k) dst[n][k] = *(const PG8_LAS bf16x8*)(lds + PG8_SB(b, h) + boff + n * 2048 + k * 1024); } while (0)
#define PG8_MMA(ai, bj, At, Bt) do { __builtin_amdgcn_s_setprio(1); _Pragma("unroll") for (int m = 0; m < 4; ++m) _Pragma("unroll") for (int n = 0; n < 2; ++n) _Pragma("unroll") for (int k = 0; k < 2; ++k) \
        acc[ai][bj][m][n] = __builtin_amdgcn_mfma_f32_16x16x32_bf16(Bt[n][k], At[m][k], acc[ai][bj][m][n], 0, 0, 0); __builtin_amdgcn_s_setprio(0); } while (0)
#define PG8_WAIT_V(n) asm volatile("s_waitcnt vmcnt(" #n ")" ::: "memory")
#define PG8_WAIT_L(n) asm volatile("s_waitcnt lgkmcnt(" #n ")" ::: "memory")
#define PG8_BAR __builtin_amdgcn_s_barrier()
#define PG8_SCHED __builtin_amdgcn_sched_barrier(0)
    Unit cur, nxt; int ui = 0;
    if (!S.next(0, cur)) return;
    f32x4 acc[2][2][4][2];
#pragma unroll
    for (int a = 0; a < 2; ++a)
#pragma unroll
        for (int b = 0; b < 2; ++b)
#pragma unroll
            for (int m = 0; m < 4; ++m)
#pragma unroll
                for (int n = 0; n < 2; ++n) acc[a][b][m][n] = (f32x4){0.f, 0.f, 0.f, 0.f};
    bf16x8 At[4][2], B0[2][2], B1[2][2];
    const char* cA = (const char*)g.A + (size_t)cur.pm * tstep; const char* cB = (const char*)g.Bt + (size_t)cur.pn * tstep;
    S.a_ready(cur);
    if constexpr (SP2) {
        PG8_STAGE(PG8_SB(0, 0), cB, voffB); PG8_STAGE(PG8_SB(0, 1), cB + hstep, voffB); PG8_STAGE(PG8_SA(0, 0), cA, voffA); PG8_STAGE(PG8_SA(0, 1), cA + hstep, voffA);
        if (wr == 1) PG8_BAR;
        PG8_WAIT_V(2); PG8_BAR;
        PG8_STAGE(PG8_SB(1, 0), cB + kstep, voffB); PG8_STAGE(PG8_SA(1, 0), cA + kstep, voffA); PG8_STAGE(PG8_SB(1, 1), cB + hstep + kstep, voffB);
        PG8_WAIT_V(6); PG8_BAR;
    } else {
        PG8_STAGE(PG8_SB(0, 0), cB, voffB); PG8_STAGE(PG8_SA(0, 0), cA, voffA); PG8_STAGE(PG8_SB(0, 1), cB + hstep, voffB); PG8_STAGE(PG8_SA(0, 1), cA + hstep, voffA);
        if (wr == 1) PG8_BAR;
        PG8_WAIT_V(4); PG8_BAR;
        PG8_STAGE(PG8_SB(1, 0), cB + kstep, voffB); PG8_STAGE(PG8_SA(1, 0), cA + kstep, voffA); PG8_STAGE(PG8_SB(1, 1), cB + hstep + kstep, voffB);
        PG8_WAIT_V(6); PG8_BAR;
    }
    for (;;) {
        const bool has_next = S.next(ui + 1, nxt);
        const char* nA = has_next ? (const char*)g.A + (size_t)nxt.pm * tstep : cA; const char* nB = has_next ? (const char*)g.Bt + (size_t)nxt.pn * tstep : cB;
        for (int t = 0; t < nt; t += 2) {
            const bool last = (t == nt - 2);
            const char* a1 = cA + (size_t)(t + 1) * kstep;
            const char* a2 = last ? nA : cA + (size_t)(t + 2) * kstep; const char* b2 = last ? nB : cB + (size_t)(t + 2) * kstep;
            const char* a3 = a2 + kstep; const char* b3 = b2 + kstep;
            if (last && has_next) S.a_ready(nxt);
            if constexpr (SP2) {
            PG8_LDB(B0, 0, 0); PG8_LDB(B1, 0, 1); PG8_SCHED; PG8_LDA(At, 0, 0); PG8_STAGE(PG8_SA(1, 1), a1 + hstep, voffA);
            PG8_WAIT_V(8); PG8_WAIT_L(0); PG8_BAR; PG8_MMA(0, 0, At, B0); PG8_MMA(0, 1, At, B1); PG8_BAR; PG8_SCHED;
            PG8_LDA(At, 0, 1); PG8_STAGE(PG8_SB(0, 0), b2, voffB); PG8_STAGE(PG8_SB(0, 1), b2 + hstep, voffB); PG8_STAGE(PG8_SA(0, 0), a2, voffA);
            PG8_WAIT_V(8); PG8_WAIT_L(0); PG8_BAR; PG8_MMA(1, 0, At, B0); PG8_MMA(1, 1, At, B1); PG8_BAR; PG8_SCHED;
            PG8_LDB(B0, 1, 0); PG8_LDB(B1, 1, 1); PG8_SCHED; PG8_LDA(At, 1, 0); PG8_STAGE(PG8_SA(0, 1), a2 + hstep, voffA);
            PG8_WAIT_V(8); PG8_WAIT_L(0); PG8_BAR; PG8_MMA(0, 0, At, B0); PG8_MMA(0, 1, At, B1); PG8_BAR; PG8_SCHED;
            PG8_LDA(At, 1, 1); PG8_STAGE(PG8_SB(1, 0), b3, voffB); PG8_STAGE(PG8_SB(1, 1), b3 + hstep, voffB); PG8_STAGE(PG8_SA(1, 0), a3, voffA);
            PG8_WAIT_V(8); PG8_WAIT_L(0); PG8_BAR; PG8_MMA(1, 0, At, B0); PG8_MMA(1, 1, At, B1); PG8_BAR; PG8_SCHED;
            } else {
            PG8_LDB(B0, 0, 0); PG8_SCHED; PG8_LDA(At, 0, 0); PG8_STAGE(PG8_SA(1, 1), a1 + hstep, voffA);
            PG8_WAIT_L(8); PG8_BAR; PG8_WAIT_L(0); PG8_MMA(0, 0, At, B0); PG8_BAR; PG8_SCHED;
            PG8_LDB(B1, 0, 1); PG8_STAGE(PG8_SB(0, 0), b2, voffB);
            PG8_BAR; PG8_WAIT_L(0); PG8_MMA(0, 1, At, B1); PG8_BAR;
            PG8_LDA(At, 0, 1); PG8_STAGE(PG8_SA(0, 0), a2, voffA);
            PG8_BAR; PG8_WAIT_L(0); PG8_MMA(1, 0, At, B0); PG8_BAR; PG8_SCHED;
            PG8_STAGE(PG8_SB(0, 1), b2 + hstep, voffB);
            PG8_WAIT_V(6); PG8_BAR; PG8_MMA(1, 1, At, B1); PG8_BAR;
            PG8_LDB(B0, 1, 0); PG8_SCHED; PG8_LDA(At, 1, 0); PG8_STAGE(PG8_SA(0, 1), a2 + hstep, voffA);
            PG8_WAIT_L(8); PG8_BAR; PG8_WAIT_L(0); PG8_MMA(0, 0, At, B0); PG8_BAR; PG8_SCHED;
            PG8_LDB(B1, 1, 1); PG8_STAGE(PG8_SB(1, 0), b3, voffB);
            PG8_BAR; PG8_WAIT_L(0); PG8_MMA(0, 1, At, B1); PG8_BAR;
            PG8_LDA(At, 1, 1); PG8_STAGE(PG8_SA(1, 0), a3, voffA);
            PG8_BAR; PG8_WAIT_L(0); PG8_MMA(1, 0, At, B0); PG8_BAR; PG8_SCHED;
            PG8_STAGE(PG8_SB(1, 1), b3 + hstep, voffB);
            PG8_WAIT_V(6); PG8_BAR; PG8_MMA(1, 1, At, B1); PG8_BAR;
            }
        }
        if constexpr (ALIGN_EPI) { if (wr == 0) PG8_BAR; }
        if constexpr (!Epi::AFTER_DRAIN) { E(acc, cur, wr, wc, fr, fq); S.done(cur); }
        if (!has_next) break;
#pragma unroll
        for (int a = 0; a < 2; ++a)
#pragma unroll
            for (int b = 0; b < 2; ++b)
#pragma unroll
                for (int m = 0; m < 4; ++m)
#pragma unroll
                    for (int n = 0; n < 2; ++n) acc[a][b][m][n] = (f32x4){0.f, 0.f, 0.f, 0.f};
        cur = nxt; cA = nA; cB = nB; ++ui;
        if constexpr (ALIGN_EPI) { if (wr == 1) PG8_BAR; }
    }
    PG8_WAIT_V(0);
    if constexpr (!ALIGN_EPI) { if (wr == 0) PG8_BAR; }
    PG8_BAR;
    if constexpr (Epi::AFTER_DRAIN) { E.fused(acc, cur, wr, wc, fr, fq, lds, wid, lane); S.done(cur); }
#undef PG8_SA
#undef PG8_SB
#undef PG8_STAGE
#undef PG8_LDA
#undef PG8_LDB
#undef PG8_MMA
#undef PG8_WAIT_V
#undef PG8_WAIT_L
#undef PG8_BAR
#undef PG8_SCHED
}
}
constexpr int NWAVES = 8, NTHR = 512;
#ifndef MK_N_LAUNCHES
#define MK_N_LAUNCHES 1
#endif
constexpr int PER_PHASE = 14;
constexpr int N_LAUNCHES = MK_N_LAUNCHES;

constexpr int DM = 1024, NPROMPT = 32768, NSAMP = 512, NTOK = 33280, NSHIFT = 32, MPAD = 33536, N1 = 5632;
constexpr int SEQ_P = 4096, SEQ_S = 16, NB_P = 8, NB_S = 32;
constexpr size_t O_Y = 0, O_CONV_P = 34078720, O_SHIFT_P = 34086912, O_WKV_P = 34095104, O_CONV_S = 34357248, O_SHIFT_S = 34390016, O_WKV_S = 34422784;
constexpr size_t KiB = 1024, MiB = 1u << 20;
constexpr size_t WS_CTL = 0, CTL_ZERO_BYTES = 64 * KiB;
constexpr size_t WS_W1T = 64 * KiB;
constexpr size_t WS_WPA = WS_W1T + (size_t)N1 * DM * 2;
constexpr size_t WS_WPB = WS_WPA + 1 * MiB;
constexpr size_t WS_WO = WS_WPB + 1 * MiB;
constexpr size_t WS_WQ = WS_WO + 2 * MiB;
constexpr size_t WS_KEYS = WS_WQ + 4 * MiB;
constexpr size_t WS_L2T = WS_KEYS + 512 * KiB;
constexpr size_t WS_SSP = WS_L2T + 256 * KiB;
constexpr size_t WS_UB = WS_SSP + (size_t)MPAD * 16 * 4;
constexpr size_t WS_VB = WS_UB + 16 * MiB;
constexpr size_t WS_A1 = WS_VB + 16 * MiB;
constexpr size_t WS_ZC = WS_A1 + (size_t)MPAD * DM * 2;
constexpr size_t WS_ZR = WS_ZC + (size_t)MPAD * 1536 * 2;
constexpr size_t WS_ZG = WS_ZR + (size_t)MPAD * 2048 * 2;
constexpr size_t WS_END = WS_ZG + (size_t)MPAD * 2048 * 2;
constexpr size_t WS_YL = WS_ZC, WS_ZT = WS_ZC + (size_t)NTOK * 512 * 2, WS_BV = WS_ZC + (size_t)NTOK * 512 * 4;
constexpr size_t WS_EIDX = WS_ZC, WS_GATE = WS_ZC + 16 * MiB, WS_COEF = WS_ZC + 40 * MiB, WS_SS2 = WS_ZC + 64 * MiB, WS_RSTD = WS_ZC + 66 * MiB;
constexpr size_t WS_PART = WS_ZR;
constexpr size_t OB_MB = (size_t)4352 * 4096 * 4;
static_assert(WS_BV + (size_t)NTOK * 512 * 2 <= WS_ZR && OB_MB + (size_t)4352 * 4096 * 2 <= (size_t)NTOK * 1024 * 4, "scan scratch maps");
static_assert(WS_END <= 512 * MiB, "d_ws map must fit 512 MiB");
constexpr float PEER_SU = 32.0f, PEER_SV = 4.0f;
constexpr int CW_BAR = 1024;
constexpr int LDS_BYTES = 163840;
constexpr int LDSCTL_OFF = LDS_BYTES - 512, MISC_OFF = LDSCTL_OFF + 320;

#define GAS __attribute__((address_space(1)))
#define LAS __attribute__((address_space(3)))
typedef unsigned short bf16;
typedef unsigned v4u __attribute__((ext_vector_type(4)));
typedef unsigned v2u __attribute__((ext_vector_type(2)));
typedef float f32x4 __attribute__((ext_vector_type(4)));
typedef short bf16x8 __attribute__((ext_vector_type(8)));
typedef __bf16 bf16x2_t __attribute__((ext_vector_type(2)));
typedef GAS unsigned gu32;
#define RLX_AGENT __ATOMIC_RELAXED, __HIP_MEMORY_SCOPE_AGENT
#define LDS_WAIT() asm volatile("s_waitcnt lgkmcnt(0)" ::: "memory")
#define VM_WAIT() asm volatile("s_waitcnt vmcnt(0)" ::: "memory")
using pg8::cvt_pk_bf16; using pg8::bf_lo; using pg8::bf_hi; using pg8::sigm;
#define XB_TMO      128
#define XB_XCNT(j)  (256  + 64 * (j))
#define XB_XSUB(j)  (1280 + 64 * (j))
#define XB_XGEN(j)  (2304 + 64 * (j))
#define XB_TOP      3328
#define XB_TOPGEN   3392
#define XCD_BAR_WORDS 3456
#define XB_SPIN_CAP (1u << 22)

__device__ __forceinline__ unsigned xb_ld(unsigned* p)              { return __hip_atomic_load(p, __ATOMIC_RELAXED, __HIP_MEMORY_SCOPE_AGENT); }
__device__ __forceinline__ unsigned xb_add(unsigned* p, unsigned v) { return __hip_atomic_fetch_add(p, v, __ATOMIC_RELAXED, __HIP_MEMORY_SCOPE_AGENT); }
__device__ __forceinline__ unsigned xb_xcc_id() { return (unsigned)__builtin_amdgcn_s_getreg((3 << 11) | 20) & 0xFu; }
#define XB_SPIN(cond, bar) do { unsigned _sp = 0; while (cond) { __builtin_amdgcn_s_sleep(1); \
    if ((++_sp & 255u) == 0u) { if (xb_ld(&(bar)[XB_TMO])) break; if (_sp > XB_SPIN_CAP) { atomicAdd(&(bar)[XB_TMO], 1u); break; } } } } while (0)

struct XcdBarrier {
    unsigned* bar; unsigned x;
    volatile LAS unsigned* st;
};

__device__ __forceinline__ XcdBarrier xcd_barrier_post(unsigned* bar, volatile LAS unsigned* st) {
    XcdBarrier b; b.bar = bar; b.x = xb_xcc_id(); b.st = st;
    if (threadIdx.x == 0) (void)xb_add(&bar[XB_XCNT(b.x)], 1u);
    return b;
}
__device__ __forceinline__ void xcd_barrier_complete(unsigned* bar, unsigned x, unsigned& nloc, unsigned& nx) {
    const unsigned G = gridDim.x * gridDim.y * gridDim.z;
    unsigned sum, cnt, mine, sp = 0u;
    for (;;) {
        sum = 0u; cnt = 0u; mine = 0u;
#pragma unroll
        for (unsigned j = 0; j < 16; ++j) { const unsigned c = xb_ld(&bar[XB_XCNT(j)]); sum += c; cnt += (c > 0u) ? 1u : 0u; mine = (j == x) ? c : mine; }
        if (sum == G) break;
        __builtin_amdgcn_s_sleep(1);
        if ((++sp & 255u) == 0u) { if (xb_ld(&bar[XB_TMO])) break; if (sp > XB_SPIN_CAP) { atomicAdd(&bar[XB_TMO], 1u); break; } }
    }
    nloc = mine > 0u ? mine : 1u; nx = cnt > 0u ? cnt : 1u;
}

__device__ __forceinline__ void xcd_barrier(const XcdBarrier& b) {
    asm volatile("s_waitcnt vmcnt(0)" ::: "memory");
    __syncthreads();
    if (threadIdx.x == 0) {
        unsigned* bar = b.bar;
        __builtin_amdgcn_s_waitcnt(0);
        unsigned nloc = b.st[0], nx = b.st[1];
        if (nloc == 0u) { xcd_barrier_complete(bar, b.x, nloc, nx); b.st[0] = nloc; b.st[1] = nx; }
        const unsigned old = xb_add(&bar[XB_XSUB(b.x)], 1u);
        const unsigned gen = old / nloc;
        if (old + 1u == (gen + 1u) * nloc) {
            __builtin_amdgcn_fence(__ATOMIC_RELEASE, "agent");
            asm volatile("s_waitcnt vmcnt(0)" ::: "memory");
            const unsigned og = xb_add(&bar[XB_TOP], 1u);
            const unsigned tg = og / nx;
            if (og + 1u == (tg + 1u) * nx) xb_add(&bar[XB_TOPGEN], 1u);
            else XB_SPIN(xb_ld(&bar[XB_TOPGEN]) == tg, bar);
            __builtin_amdgcn_fence(__ATOMIC_ACQUIRE, "agent");
            xb_add(&bar[XB_XGEN(b.x)], 1u);
            asm volatile("s_waitcnt vmcnt(0)" ::: "memory");
        } else {
            XB_SPIN(xb_ld(&bar[XB_XGEN(b.x)]) == gen, bar);
            __builtin_amdgcn_fence(__ATOMIC_ACQUIRE, "agent");
            asm volatile("s_waitcnt vmcnt(0)" ::: "memory");
        }
    }
    __syncthreads();
}
struct Args { const float* in[32]; float* out; unsigned char* ws; int ph_lo, ph_hi, li, pad; };
enum { I_XP = 0, I_XS, I_SCONV, I_SSHIFT, I_SWKV, I_N1G, I_WIN, I_CONVW, I_MURKV, I_MUWAG, I_W0, I_W1, I_W2, I_A0, I_A1, I_A2, I_G1, I_G2, I_KK, I_KA, I_RK, I_GNW, I_GNB, I_WPA, I_WPB, I_WO, I_N2G, I_WQ, I_KEYS, I_U, I_V, I_NFG };

__device__ __forceinline__ float wave_sum(float v) {
#pragma unroll
    for (int o = 1; o < 64; o <<= 1) v += __shfl_xor(v, o);
    return v;
}
template <int CTRL> __device__ __forceinline__ float dpp_mov(float v) { return __builtin_bit_cast(float, __builtin_amdgcn_update_dpp(0, __builtin_bit_cast(int, v), CTRL, 0xF, 0xF, true)); }
__device__ __forceinline__ float sum4(float v) { v += dpp_mov<0xB1>(v); v += dpp_mov<0x4E>(v); return v; }
__device__ __forceinline__ float sum8(float v) { v = sum4(v); v += dpp_mov<0x141>(v); return v; }
__device__ __forceinline__ float sum16(float v) { v = sum8(v); v += dpp_mov<0x140>(v); return v; }
__device__ __forceinline__ float dot2bf(unsigned w, unsigned x, float acc) { return __builtin_amdgcn_fdot2_f32_bf16(__builtin_bit_cast(bf16x2_t, w), __builtin_bit_cast(bf16x2_t, x), acc, false); }

__device__ __forceinline__ void transpose_item(const float* W, int ldw, int c0, int K, bf16* WT, int nblk, int item, const float* sv, float alpha, float beta, LAS float* scr, int lane) {
    const int kb = item / nblk, nb = item % nblk, k0 = 64 * kb, n0 = 32 * nb;
#pragma unroll 8
    for (int i = 0; i < 32; ++i) { const int kk = 2 * i + (lane >> 5); float s = 1.f; if (sv) s = alpha + beta * sv[k0 + kk];
        scr[kk * 33 + (lane & 31)] = W[(size_t)(k0 + kk) * ldw + c0 + n0 + (lane & 31)] * s; }
    LDS_WAIT();
    const int c = lane & 7;
#pragma unroll
    for (int j = 0; j < 4; ++j) { const int n = (lane >> 3) + 8 * j; const LAS float* s = scr + (8 * c) * 33 + n;
        v4u o; o.x = cvt_pk_bf16(s[0 * 33], s[1 * 33]); o.y = cvt_pk_bf16(s[2 * 33], s[3 * 33]); o.z = cvt_pk_bf16(s[4 * 33], s[5 * 33]); o.w = cvt_pk_bf16(s[6 * 33], s[7 * 33]);
        *(v4u*)(WT + (size_t)(n0 + n) * K + k0 + 8 * c) = o; }
    LDS_WAIT();
}
__device__ __forceinline__ void cvt_stream(const float* src, bf16* dst, size_t n, size_t gt, size_t nthreads) {
    for (size_t i = gt * 8; i < n; i += nthreads * 8) { const f32x4 a = *(const f32x4*)(src + i), b = *(const f32x4*)(src + i + 4);
        v4u o; o.x = cvt_pk_bf16(a[0], a[1]); o.y = cvt_pk_bf16(a[2], a[3]); o.z = cvt_pk_bf16(b[0], b[1]); o.w = cvt_pk_bf16(b[2], b[3]); *(v4u*)(dst + i) = o; }
}
__device__ __forceinline__ void cvt_stream_fp8(const float* src, unsigned char* dst, size_t n, float scale, size_t gt, size_t nthreads) {
    for (size_t i = gt * 16; i < n; i += nthreads * 16) {
        const f32x4 a = *(const f32x4*)(src + i) * scale, b = *(const f32x4*)(src + i + 4) * scale, c = *(const f32x4*)(src + i + 8) * scale, d = *(const f32x4*)(src + i + 12) * scale;
        v4u o; unsigned p;
        p = __builtin_amdgcn_cvt_pk_fp8_f32(a[0], a[1], 0, false); o.x = __builtin_amdgcn_cvt_pk_fp8_f32(a[2], a[3], p, true);
        p = __builtin_amdgcn_cvt_pk_fp8_f32(b[0], b[1], 0, false); o.y = __builtin_amdgcn_cvt_pk_fp8_f32(b[2], b[3], p, true);
        p = __builtin_amdgcn_cvt_pk_fp8_f32(c[0], c[1], 0, false); o.z = __builtin_amdgcn_cvt_pk_fp8_f32(c[2], c[3], p, true);
        p = __builtin_amdgcn_cvt_pk_fp8_f32(d[0], d[1], 0, false); o.w = __builtin_amdgcn_cvt_pk_fp8_f32(d[2], d[3], p, true);
        *(v4u*)(dst + i) = o; }
}
__device__ __forceinline__ void cvt16_fp8_sliced(const float* src, unsigned char* dst, float scale, size_t i) {
    const f32x4 a = *(const f32x4*)(src + i) * scale, b = *(const f32x4*)(src + i + 4) * scale, c = *(const f32x4*)(src + i + 8) * scale, d = *(const f32x4*)(src + i + 12) * scale;
    v4u o; unsigned p;
    p = __builtin_amdgcn_cvt_pk_fp8_f32(a[0], a[1], 0, false); o.x = __builtin_amdgcn_cvt_pk_fp8_f32(a[2], a[3], p, true);
    p = __builtin_amdgcn_cvt_pk_fp8_f32(b[0], b[1], 0, false); o.y = __builtin_amdgcn_cvt_pk_fp8_f32(b[2], b[3], p, true);
    p = __builtin_amdgcn_cvt_pk_fp8_f32(c[0], c[1], 0, false); o.z = __builtin_amdgcn_cvt_pk_fp8_f32(c[2], c[3], p, true);
    p = __builtin_amdgcn_cvt_pk_fp8_f32(d[0], d[1], 0, false); o.w = __builtin_amdgcn_cvt_pk_fp8_f32(d[2], d[3], p, true);
    const size_t e = i >> 10, col = i & 1023;
    *(v4u*)(dst + (col >> 7) * ((size_t)16384 * 128) + e * 128 + (col & 127)) = o;
}
__device__ __forceinline__ void cvt_stream_fp8_sliced(const float* src, unsigned char* dst, float scale, size_t gt, size_t nthreads) {
#pragma unroll 2
    for (size_t i = gt * 16; i < (size_t)16384 * 1024; i += nthreads * 16) {
        const f32x4 a = *(const f32x4*)(src + i) * scale, b = *(const f32x4*)(src + i + 4) * scale, c = *(const f32x4*)(src + i + 8) * scale, d = *(const f32x4*)(src + i + 12) * scale;
        v4u o; unsigned p;
        p = __builtin_amdgcn_cvt_pk_fp8_f32(a[0], a[1], 0, false); o.x = __builtin_amdgcn_cvt_pk_fp8_f32(a[2], a[3], p, true);
        p = __builtin_amdgcn_cvt_pk_fp8_f32(b[0], b[1], 0, false); o.y = __builtin_amdgcn_cvt_pk_fp8_f32(b[2], b[3], p, true);
        p = __builtin_amdgcn_cvt_pk_fp8_f32(c[0], c[1], 0, false); o.z = __builtin_amdgcn_cvt_pk_fp8_f32(c[2], c[3], p, true);
        p = __builtin_amdgcn_cvt_pk_fp8_f32(d[0], d[1], 0, false); o.w = __builtin_amdgcn_cvt_pk_fp8_f32(d[2], d[3], p, true);
        const size_t e = i >> 10, col = i & 1023;
        *(v4u*)(dst + (col >> 7) * ((size_t)16384 * 128) + e * 128 + (col & 127)) = o; }
}
__device__ __forceinline__ void p0_prologue(const Args& A, LAS unsigned char* lds, int tid, int lane, int wave, int vcu, int G) {
    unsigned char* ws = A.ws;
    bf16* W1T = (bf16*)(ws + WS_W1T);
    LAS float* scr = (LAS float*)(lds + wave * 16384);
    const int gw = vcu * NWAVES + wave, NGW = G * NWAVES;
    constexpr int J0 = 16 * 96, J1 = 16 * 64, JL = 16 * 2, JG = 16 * 4, JP = 8 * 32, JO = 16 * 32, JQ = 16 * 64;
    constexpr int JW2 = 16, JG2 = 32;
    constexpr int NITEMS = J0 + J1 + 4 * JL + 2 * JG + 2 * JP + JO + JQ + 2 * JW2 + JG2;
    bf16* L2T = (bf16*)(ws + WS_L2T);
    const float* mu = A.in[I_MUWAG];
    for (int it = gw; it < NITEMS; it += NGW) {
        int r = it;
        if (r < J0) { transpose_item(A.in[I_WIN], 5120, 0, 1024, W1T, 96, r, nullptr, 0.f, 0.f, scr, lane); continue; } r -= J0;
        if (r < J1) { transpose_item(A.in[I_WIN], 5120, 3072, 1024, W1T + (size_t)3584 * 1024, 64, r, nullptr, 0.f, 0.f, scr, lane); continue; } r -= J1;
        if (r < JL) { transpose_item(A.in[I_W1], 64, 0, 1024, W1T + (size_t)3072 * 1024, 2, r, mu, 1.f, -1.f, scr, lane); continue; } r -= JL;
        if (r < JL) { transpose_item(A.in[I_W1], 64, 0, 1024, W1T + (size_t)3328 * 1024, 2, r, mu, 0.f, 1.f, scr, lane); continue; } r -= JL;
        if (r < JL) { transpose_item(A.in[I_A1], 64, 0, 1024, W1T + (size_t)(3072 + 64) * 1024, 2, r, mu + 1024, 1.f, -1.f, scr, lane); continue; } r -= JL;
        if (r < JL) { transpose_item(A.in[I_A1], 64, 0, 1024, W1T + (size_t)(3328 + 64) * 1024, 2, r, mu + 1024, 0.f, 1.f, scr, lane); continue; } r -= JL;
        if (r < JG) { transpose_item(A.in[I_G1], 128, 0, 1024, W1T + (size_t)(3072 + 128) * 1024, 4, r, mu + 2048, 1.f, -1.f, scr, lane); continue; } r -= JG;
        if (r < JG) { transpose_item(A.in[I_G1], 128, 0, 1024, W1T + (size_t)(3328 + 128) * 1024, 4, r, mu + 2048, 0.f, 1.f, scr, lane); continue; } r -= JG;
        if (r < JP) { transpose_item(A.in[I_WPA], 1024, 0, 512, (bf16*)(ws + WS_WPA), 32, r, nullptr, 0.f, 0.f, scr, lane); continue; } r -= JP;
        if (r < JP) { transpose_item(A.in[I_WPB], 1024, 0, 512, (bf16*)(ws + WS_WPB), 32, r, nullptr, 0.f, 0.f, scr, lane); continue; } r -= JP;
        if (r < JO) { transpose_item(A.in[I_WO], 1024, 0, 1024, (bf16*)(ws + WS_WO), 32, r, nullptr, 0.f, 0.f, scr, lane); continue; } r -= JO;
        if (r < JQ) { transpose_item(A.in[I_WQ], 2048, 0, 1024, (bf16*)(ws + WS_WQ), 64, r, nullptr, 0.f, 0.f, scr, lane); continue; } r -= JQ;
        if (r < JW2) { transpose_item(A.in[I_W2], 512, 0, 64, L2T, 16, r, nullptr, 0.f, 0.f, scr, lane); continue; } r -= JW2;
        if (r < JW2) { transpose_item(A.in[I_A2], 512, 0, 64, L2T + (size_t)512 * 64, 16, r, nullptr, 0.f, 0.f, scr, lane); continue; } r -= JW2;
        transpose_item(A.in[I_G2], 512, 0, 128, L2T + (size_t)1024 * 64, 16, r, nullptr, 0.f, 0.f, scr, lane);
    }
    const size_t gt = (size_t)vcu * NTHR + tid, nth = (size_t)G * NTHR;
    if (G != 256) {
        cvt_stream_fp8_sliced(A.in[I_U], ws + WS_UB, PEER_SU, gt, nth);
        cvt_stream_fp8_sliced(A.in[I_V], ws + WS_VB, PEER_SV, gt, nth); }
    cvt_stream(A.in[I_KEYS], (bf16*)(ws + WS_KEYS), (size_t)8 * 2 * 128 * 128, gt, nth);
    bf16* A1 = (bf16*)(ws + WS_A1);
    const f32x4* g1v = (const f32x4*)A.in[I_N1G] + lane;
    for (int m0 = gw; m0 < NTOK; m0 += 2 * NGW) {
        const int m1 = m0 + NGW; const bool two = m1 < NTOK; const int m1c = two ? m1 : m0;
        const f32x4* xr0 = (const f32x4*)(m0 < NPROMPT ? A.in[I_XP] + (size_t)m0 * DM : A.in[I_XS] + (size_t)(m0 - NPROMPT) * DM) + lane;
        const f32x4* xr1 = (const f32x4*)(m1c < NPROMPT ? A.in[I_XP] + (size_t)m1c * DM : A.in[I_XS] + (size_t)(m1c - NPROMPT) * DM) + lane;
        f32x4 v0[4], v1[4]; float s0 = 0.f, s1 = 0.f;
#pragma unroll
        for (int j = 0; j < 4; ++j) { v0[j] = xr0[64 * j]; v1[j] = xr1[64 * j]; }
#pragma unroll
        for (int j = 0; j < 4; ++j) { s0 += (v0[j][0] * v0[j][0] + v0[j][1] * v0[j][1]) + (v0[j][2] * v0[j][2] + v0[j][3] * v0[j][3]);
                                      s1 += (v1[j][0] * v1[j][0] + v1[j][1] * v1[j][1]) + (v1[j][2] * v1[j][2] + v1[j][3] * v1[j][3]); }
#pragma unroll
        for (int o = 1; o < 64; o <<= 1) { s0 += __shfl_xor(s0, o); s1 += __shfl_xor(s1, o); }
        const float r0 = 1.0f / sqrtf(s0 * (1.f / DM) + 1e-6f), r1 = 1.0f / sqrtf(s1 * (1.f / DM) + 1e-6f);
#pragma unroll
        for (int rr = 0; rr < 2; ++rr) {
            if (rr == 1 && !two) break;
            const int m = rr ? m1 : m0; const float rstd = rr ? r1 : r0;
            v2u* o8 = (v2u*)(A1 + (size_t)m * DM) + lane;
            float* so = nullptr;
            if (m < NPROMPT) { if ((m & (SEQ_P - 1)) == SEQ_P - 1) so = A.out + O_SHIFT_P + (size_t)(m / SEQ_P) * DM; }
            else { const int ms = m - NPROMPT; if ((ms & (SEQ_S - 1)) == SEQ_S - 1) so = A.out + O_SHIFT_S + (size_t)(ms / SEQ_S) * DM; }
#pragma unroll
            for (int j = 0; j < 4; ++j) { const f32x4 g = g1v[64 * j]; const f32x4 y = (rr ? v1[j] : v0[j]) * rstd * g;
                v2u w; w.x = cvt_pk_bf16(y[0], y[1]); w.y = cvt_pk_bf16(y[2], y[3]); o8[64 * j] = w;
                if (so) ((f32x4*)so)[lane + 64 * j] = y; }
        }
    }
    for (int m = NTOK + gw; m < MPAD; m += NGW) {
        v2u* o8 = (v2u*)(A1 + (size_t)m * DM) + lane;
        if (m < NTOK + NSHIFT) {
            const f32x4* xr = (const f32x4*)(A.in[I_SSHIFT] + (size_t)(m - NTOK) * DM) + lane;
#pragma unroll
            for (int j = 0; j < 4; ++j) { const f32x4 y = xr[64 * j]; v2u w; w.x = cvt_pk_bf16(y[0], y[1]); w.y = cvt_pk_bf16(y[2], y[3]); o8[64 * j] = w; }
        } else {
#pragma unroll
            for (int j = 0; j < 4; ++j) { v2u w; w.x = 0u; w.y = 0u; o8[64 * j] = w; }
        }
    }
}

__device__ __forceinline__ void unpack8(const v4u w, float (&f)[8]) { f[0] = bf_lo(w.x); f[1] = bf_hi(w.x); f[2] = bf_lo(w.y); f[3] = bf_hi(w.y); f[4] = bf_lo(w.z); f[5] = bf_hi(w.z); f[6] = bf_lo(w.w); f[7] = bf_hi(w.w); }
__device__ __forceinline__ void conv_phase(const Args& A, int gt, int nth) {
    const bf16* Zc = (const bf16*)(A.ws + WS_ZC); bf16* YA = (bf16*)(A.ws + WS_A1);
    const float* cw = A.in[I_CONVW];
    for (int task = gt; task < (NTOK / 16) * 64; task += nth) {
        const int seg = task >> 6, ch = (task & 63) * 8, row0 = seg * 16;
        int b, t0, T; bool prompt = row0 < NPROMPT;
        if (prompt) { b = row0 / SEQ_P; t0 = row0 % SEQ_P; T = SEQ_P; } else { b = (row0 - NPROMPT) / SEQ_S; t0 = 0; T = SEQ_S; }
        float um2[8], um1[8], c0[8], c1[8], c2[8];
#pragma unroll
        for (int i = 0; i < 8; ++i) { c0[i] = cw[ch + i]; c1[i] = cw[512 + ch + i]; c2[i] = cw[1024 + ch + i]; }
        if (t0 == 0) {
            if (prompt) {
#pragma unroll
                for (int i = 0; i < 8; ++i) { um2[i] = 0.f; um1[i] = 0.f; }
            } else { const float* sc = A.in[I_SCONV] + (size_t)b * 2 * 512 + ch;
#pragma unroll
                for (int i = 0; i < 8; ++i) { um2[i] = sc[i]; um1[i] = sc[512 + i]; } }
        } else {
            float a[8], h[8];
            unpack8(*(const v4u*)(Zc + (size_t)(row0 - 2) * 1536 + 512 + ch), a); unpack8(*(const v4u*)(Zc + (size_t)(row0 - 2) * 1536 + 1024 + ch), h);
#pragma unroll
            for (int i = 0; i < 8; ++i) um2[i] = a[i] * h[i];
            unpack8(*(const v4u*)(Zc + (size_t)(row0 - 1) * 1536 + 512 + ch), a); unpack8(*(const v4u*)(Zc + (size_t)(row0 - 1) * 1536 + 1024 + ch), h);
#pragma unroll
            for (int i = 0; i < 8; ++i) um1[i] = a[i] * h[i];
        }
#pragma unroll 4
        for (int t = 0; t < 16; ++t) {
            const size_t row = (size_t)(row0 + t);
            float zb[8], zc[8], zh[8], y[8];
            unpack8(*(const v4u*)(Zc + row * 1536 + ch), zb); unpack8(*(const v4u*)(Zc + row * 1536 + 512 + ch), zc); unpack8(*(const v4u*)(Zc + row * 1536 + 1024 + ch), zh);
#pragma unroll
            for (int i = 0; i < 8; ++i) { const float u = zc[i] * zh[i]; y[i] = zb[i] * (c0[i] * um2[i] + c1[i] * um1[i] + c2[i] * u); um2[i] = um1[i]; um1[i] = u; }
            v4u o; o.x = cvt_pk_bf16(y[0], y[1]); o.y = cvt_pk_bf16(y[2], y[3]); o.z = cvt_pk_bf16(y[4], y[5]); o.w = cvt_pk_bf16(y[6], y[7]);
            *(v4u*)(YA + row * 512 + ch) = o;
        }
        if (t0 + 16 == T) { float* oc = A.out + (prompt ? O_CONV_P : O_CONV_S) + (size_t)b * 2 * 512 + ch;
#pragma unroll
            for (int i = 0; i < 8; ++i) { oc[i] = um2[i]; oc[512 + i] = um1[i]; } }
    }
    bf16* Zr = (bf16*)(A.ws + WS_ZR);
    for (int task = nth - 1 - gt; task < NTOK * 16; task += nth) {
        const int m = task >> 4, cs = task & 15;
        bool hasprev; int prow;
        if (m < NPROMPT) { hasprev = (m & (SEQ_P - 1)) != 0; prow = m - 1; } else { const int ms = m - NPROMPT; hasprev = true; prow = (ms & (SEQ_S - 1)) ? m - 1 : NTOK + ms / SEQ_S; }
        bf16* pap = Zr + (size_t)m * 2048 + 1536 + cs * 16;
        float pa[16], t8[8];
        const v4u a0 = *(const v4u*)pap, a1 = *(const v4u*)(pap + 8);
        v4u b0 = (v4u){0u, 0u, 0u, 0u}, b1 = b0;
        if (hasprev) { const bf16* pbp = Zr + (size_t)prow * 2048 + 1792 + cs * 16; b0 = *(const v4u*)pbp; b1 = *(const v4u*)(pbp + 8); }
        unpack8(a0, t8);
#pragma unroll
        for (int i = 0; i < 8; ++i) pa[i] = t8[i];
        unpack8(a1, t8);
#pragma unroll
        for (int i = 0; i < 8; ++i) pa[8 + i] = t8[i];
        unpack8(b0, t8);
#pragma unroll
        for (int i = 0; i < 8; ++i) pa[i] += t8[i];
        unpack8(b1, t8);
#pragma unroll
        for (int i = 0; i < 8; ++i) pa[8 + i] += t8[i];
#pragma unroll
        for (int i = 0; i < 16; ++i) { float p = pa[i];
            if (cs < 4) p = 1.0f - 2.0f * __builtin_amdgcn_rcpf(__expf(2.0f * p) + 1.0f);
            else if (cs >= 8) p = sigm(p);
            pa[i] = p; }
        v4u o0, o1; o0.x = cvt_pk_bf16(pa[0], pa[1]); o0.y = cvt_pk_bf16(pa[2], pa[3]); o0.z = cvt_pk_bf16(pa[4], pa[5]); o0.w = cvt_pk_bf16(pa[6], pa[7]);
        o1.x = cvt_pk_bf16(pa[8], pa[9]); o1.y = cvt_pk_bf16(pa[10], pa[11]); o1.z = cvt_pk_bf16(pa[12], pa[13]); o1.w = cvt_pk_bf16(pa[14], pa[15]);
        *(v4u*)pap = o0; *(v4u*)(pap + 8) = o1;
    }
}

constexpr int NUNITS_P = NB_P * 8 * 64, NUNITS = NUNITS_P + NB_S * 8;
constexpr int HID_STRIDE = 264, SC_TB = 32;
constexpr int P1_HIDB = 0, P1_LO = 16896, P1_SEQ = 41472, P1_GG = 90624, P1_YY = 98816, P1_ZZ = 107008, P1_BON = 115200;
typedef float f32x2 __attribute__((ext_vector_type(2)));

struct P1Pre { v4u pa0, pa1; v2u zr, zk, zv, pr, pk, pv; };
struct P1Pos { int unit, t0; };
__device__ __forceinline__ void p1_decode(int unit, bool& prompt, int& b, int& h, int& ch, int& T, int& rowbase) {
    prompt = unit < NUNITS_P; b = prompt ? unit >> 9 : (unit - NUNITS_P) >> 3; h = prompt ? (unit >> 6) & 7 : unit & 7; ch = prompt ? unit & 63 : 0;
    T = prompt ? 64 : SEQ_S; rowbase = prompt ? b * SEQ_P + ch * 64 : NPROMPT + b * SEQ_S;
}
__device__ __forceinline__ void p1_rows(int unit, int t0, int tt, size_t& row, size_t& prow, bool& hasprev, int& nb) {
    bool prompt; int b, h, ch, T, rowbase; p1_decode(unit, prompt, b, h, ch, T, rowbase);
    nb = (T - t0) < SC_TB ? (T - t0) : SC_TB;
    const int tloc = tt < nb ? tt : nb - 1, t = t0 + tloc; const bool first = (ch == 0);
    row = (size_t)(rowbase + t); hasprev = (t > 0) || !first || !prompt; prow = ((t > 0) || !first) ? row - 1 : (size_t)(NTOK + b);
}
__device__ __forceinline__ void p1_load(const Args& A, int unit, int t0, int tt, int cs, P1Pre& P) {
    size_t row, prow; bool hasprev; int nb; p1_rows(unit, t0, tt, row, prow, hasprev, nb);
    const int h = unit < NUNITS_P ? (unit >> 6) & 7 : unit & 7, hc = h * 64 + cs * 4;
    const bf16* Zr = (const bf16*)(A.ws + WS_ZR);
    P.pa0 = *(const v4u*)(Zr + row * 2048 + 1536 + cs * 16); P.pa1 = *(const v4u*)(Zr + row * 2048 + 1536 + cs * 16 + 8);
    P.zr = *(const v2u*)(Zr + row * 2048 + hc); P.zk = *(const v2u*)(Zr + row * 2048 + 512 + hc); P.zv = *(const v2u*)(Zr + row * 2048 + 1024 + hc);
    const v2u z2 = (v2u){0u, 0u};
    P.pr = z2; P.pk = z2; P.pv = z2;
    if (hasprev) { P.pr = *(const v2u*)(Zr + prow * 2048 + hc); P.pk = *(const v2u*)(Zr + prow * 2048 + 512 + hc); P.pv = *(const v2u*)(Zr + prow * 2048 + 1024 + hc); }
}
__device__ __forceinline__ bool p1_unit_at(int i, int vcu, int G, int& unit) {
    if (G == 256) { if (i > 16) return false; unit = i < 16 ? vcu * 16 + i : NUNITS_P + vcu; return true; }
    unit = vcu + i * G; return unit < NUNITS;
}

constexpr int WY_OS = 72, WY_TS = 24, WY_LS = 40;
constexpr int WY_AT = 0, WY_RT = WY_AT + 16 * WY_OS * 2, WY_BT = WY_RT + 16 * WY_OS * 2, WY_KT = WY_BT + 16 * WY_OS * 2, WY_BH = WY_KT + 16 * WY_OS * 2,
              WY_KH = WY_BH + 64 * WY_TS * 2, WY_VT = WY_KH + 64 * WY_TS * 2, WY_GC = WY_VT + 64 * WY_TS * 2, WY_BUF = WY_GC + 256;
constexpr int WY_BASE = 0;
constexpr int WY_LAB = WY_BASE + 2 * WY_BUF, WY_LAK = WY_LAB + 1024, WY_MC = WY_LAK + 16 * WY_LS * 2;
static_assert(WY_MC + 16 * WY_LS * 2 <= P1_SEQ, "UT-transform operands must fit over HIDB | LO");
constexpr int WY_XB = 115328, WY_RH = WY_XB + 128 * WY_OS * 2, WY_UT = WY_RH + 8 * 16 * 17 * 4, WY_END = WY_UT + 8 * 16 * WY_TS * 2;
static_assert(WY_END <= LDSCTL_OFF, "LDS map of pass 1");

constexpr int WY_G2 = P1_GG + 2048;
static_assert(WY_G2 + 1024 + 2 * 16 * WY_LS * 2 <= P1_YY, "second Gram set");
__device__ __forceinline__ void p1_wy(f32x4 (&X)[4], const LAS float* SEQ, LAS float* YY, LAS float* ZZ, LAS unsigned char* lds, int nb, int tid, int lane, int wave, int part = 0) {
    const bool pw = wave >= 4; const int nmc = nb >> 4;
    LAS bf16* Xb = (LAS bf16*)(lds + WY_XB); LAS float* RH = (LAS float*)(lds + WY_RH) + wave * 16 * 17; LAS bf16* UT = (LAS bf16*)(lds + WY_UT) + wave * 16 * WY_TS;
    const bf16x8 zero8 = (bf16x8){0, 0, 0, 0, 0, 0, 0, 0};
    for (int mc = 0; mc < nmc; ++mc) {
        asm volatile("" : "+v"(tid));
        LAS unsigned char* ob = lds + WY_BASE + mc * WY_BUF;
        LAS bf16* At = (LAS bf16*)(ob + WY_AT); LAS bf16* Rt = (LAS bf16*)(ob + WY_RT); LAS bf16* Bt = (LAS bf16*)(ob + WY_BT); LAS bf16* Kt = (LAS bf16*)(ob + WY_KT);
        LAS bf16* BhT = (LAS bf16*)(ob + WY_BH); LAS bf16* KhT = (LAS bf16*)(ob + WY_KH); LAS bf16* VT = (LAS bf16*)(ob + WY_VT); LAS float* GC = (LAS float*)(ob + WY_GC);
        const int tl = tid >> 5, c2 = (tid & 31) * 2, s0 = mc * 16;
        f32x2 cum = (f32x2){0.f, 0.f}, tot = cum, lwt = cum;
#pragma unroll
        for (int i = 0; i < 16; ++i) { const f32x2 l2 = *(const LAS f32x2*)(SEQ + (s0 + i) * 384 + 64 + c2); tot += l2; if (i <= tl) cum += l2; if (i == tl) lwt = l2; }
        const LAS float* sp = SEQ + (s0 + tl) * 384 + c2;
        const f32x2 a2 = *(const LAS f32x2*)(sp), b2 = *(const LAS f32x2*)(sp + 128), k2 = *(const LAS f32x2*)(sp + 192), r2 = *(const LAS f32x2*)(sp + 256), v2 = *(const LAS f32x2*)(sp + 320);
        const f32x2 gt = (f32x2){__expf(cum.x), __expf(cum.y)}, gp = (f32x2){__expf(cum.x - lwt.x), __expf(cum.y - lwt.y)}, gi = (f32x2){__expf(-cum.x), __expf(-cum.y)},
                    go = (f32x2){__expf(tot.x - cum.x), __expf(tot.y - cum.y)};
        *(LAS unsigned*)(At + tl * WY_OS + c2) = cvt_pk_bf16(a2.x * gp.x, a2.y * gp.y); *(LAS unsigned*)(Rt + tl * WY_OS + c2) = cvt_pk_bf16(r2.x * gt.x, r2.y * gt.y);
        *(LAS unsigned*)(Bt + tl * WY_OS + c2) = cvt_pk_bf16(b2.x * gi.x, b2.y * gi.y); *(LAS unsigned*)(Kt + tl * WY_OS + c2) = cvt_pk_bf16(k2.x * gi.x, k2.y * gi.y);
        const unsigned bh = cvt_pk_bf16(b2.x * go.x, b2.y * go.y), kh = cvt_pk_bf16(k2.x * go.x, k2.y * go.y), vv = cvt_pk_bf16(v2.x, v2.y);
        {
            const unsigned bh_o = (unsigned)__shfl_xor((int)bh, 32), kh_o = (unsigned)__shfl_xor((int)kh, 32), vv_o = (unsigned)__shfl_xor((int)vv, 32);
            const bool ev = (tl & 1) == 0; const int wo = (ev ? c2 : c2 + 1) * WY_TS + (tl & ~1);
            *(LAS unsigned*)(BhT + wo) = ev ? ((bh & 0xffffu) | (bh_o << 16)) : ((bh_o >> 16) | (bh & 0xffff0000u));
            *(LAS unsigned*)(KhT + wo) = ev ? ((kh & 0xffffu) | (kh_o << 16)) : ((kh_o >> 16) | (kh & 0xffff0000u));
            *(LAS unsigned*)(VT + wo) = ev ? ((vv & 0xffffu) | (vv_o << 16)) : ((vv_o >> 16) | (vv & 0xffff0000u)); }
        if (tl == 0) *(LAS f32x2*)(GC + c2) = (f32x2){__expf(tot.x), __expf(tot.y)};
    }
    __syncthreads();
    {
        asm volatile("" : "+v"(tid));
        const int fr = tid & 15, fq = (tid >> 4) & 3, g_ = wave & 3, m_ = wave >> 2;
        if (m_ < nmc) {
            LAS unsigned char* ob = lds + WY_BASE + m_ * WY_BUF; LAS unsigned char* gs = lds + (m_ ? WY_G2 : WY_LAB);
            LAS float* Lab = (LAS float*)gs; LAS bf16* Lak = (LAS bf16*)(gs + 1024); LAS bf16* Mc = (LAS bf16*)(gs + 1024 + 16 * WY_LS * 2);
            const LAS bf16* ab = (LAS bf16*)(ob + (g_ < 2 ? WY_AT : WY_RT)) + fr * WY_OS + fq * 8; const LAS bf16* bb = (LAS bf16*)(ob + ((g_ & 1) ? WY_KT : WY_BT)) + fr * WY_OS + fq * 8;
            f32x4 g = (f32x4){0.f, 0.f, 0.f, 0.f};
#pragma unroll
            for (int ks = 0; ks < 2; ++ks) g = __builtin_amdgcn_mfma_f32_16x16x32_bf16(*(const LAS bf16x8*)(bb + ks * 32), *(const LAS bf16x8*)(ab + ks * 32), g, 0, 0, 0);
#pragma unroll
            for (int rg = 0; rg < 4; ++rg) { const int tp = 4 * fq + rg; const bool keep = (g_ < 2) ? (fr > tp) : (fr >= tp); g[rg] = keep ? g[rg] : 0.f; }
            if (g_ == 0) *(LAS f32x4*)(Lab + fr * 16 + 4 * fq) = g;
            else { v2u w; w.x = cvt_pk_bf16(g[0], g[1]); w.y = cvt_pk_bf16(g[2], g[3]);
                if (g_ == 1) { *(LAS v2u*)(Lak + fr * WY_LS + 4 * fq) = w; *(LAS v2u*)(Lak + fr * WY_LS + 16 + 4 * fq) = (v2u){0u, 0u}; }
                else if (g_ == 2) *(LAS v2u*)(Mc + fr * WY_LS + 4 * fq) = w; else *(LAS v2u*)(Mc + fr * WY_LS + 16 + 4 * fq) = w; }
        }
    }
    __syncthreads();
    if (MK_DBGSEL == 2 && part) return;
    for (int mc = 0; mc < nmc; ++mc) {
        asm volatile("" : "+v"(tid));
        const int fr = tid & 15, fq = (tid >> 4) & 3;
        LAS unsigned char* ob = lds + WY_BASE + mc * WY_BUF; LAS unsigned char* gs = lds + (mc ? WY_G2 : WY_LAB);
        LAS bf16* At = (LAS bf16*)(ob + WY_AT); LAS bf16* Rt = (LAS bf16*)(ob + WY_RT);
        LAS bf16* BhT = (LAS bf16*)(ob + WY_BH); LAS bf16* KhT = (LAS bf16*)(ob + WY_KH); LAS bf16* VT = (LAS bf16*)(ob + WY_VT); LAS float* GC = (LAS float*)(ob + WY_GC);
        LAS float* Lab = (LAS float*)gs; LAS bf16* Lak = (LAS bf16*)(gs + 1024); LAS bf16* Mc = (LAS bf16*)(gs + 1024 + 16 * WY_LS * 2);
        f32x4 W1 = (f32x4){0.f, 0.f, 0.f, 0.f}, Y0 = W1;
        {
            const LAS bf16* xbp = Xb + (16 * wave + fr) * WY_OS + fq * 8;
#pragma unroll
            for (int ks = 0; ks < 2; ++ks) { const bf16x8 bx = *(const LAS bf16x8*)(xbp + ks * 32);
                W1 = __builtin_amdgcn_mfma_f32_16x16x32_bf16(*(const LAS bf16x8*)(At + fr * WY_OS + ks * 32 + fq * 8), bx, W1, 0, 0, 0);
                Y0 = __builtin_amdgcn_mfma_f32_16x16x32_bf16(*(const LAS bf16x8*)(Rt + fr * WY_OS + ks * 32 + fq * 8), bx, Y0, 0, 0, 0); }
        }
        if (!pw) { const bf16x8 la = *(const LAS bf16x8*)(Lak + fr * WY_LS + fq * 8); const bf16x8 vb0 = *(const LAS bf16x8*)(VT + (16 * wave + fr) * WY_TS + (fq & 1) * 8); const bf16x8 vb = fq < 2 ? vb0 : zero8;
            W1 = __builtin_amdgcn_mfma_f32_16x16x32_bf16(la, vb, W1, 0, 0, 0); }
#pragma unroll
        for (int rg = 0; rg < 4; ++rg) RH[(4 * fq + rg) * 17 + fr] = W1[rg];
        LDS_WAIT();
        {
            float u[16];
#pragma unroll
            for (int t = 0; t < 16; ++t) { if ((t & 3) == 0) asm volatile("" ::: "memory");
                float acc = RH[t * 17 + fr];
                if (!(MK_DBGSEL == 3 && part))
#pragma unroll
                for (int i4 = 0; i4 * 4 < t; ++i4) { const f32x4 l4 = *(const LAS f32x4*)(Lab + t * 16 + i4 * 4);
#pragma unroll
                    for (int e = 0; e < 4; ++e) if (i4 * 4 + e < t) acc += l4[e] * u[i4 * 4 + e]; }
                u[t] = acc; }
            if (fq == 0) { v4u o0, o1; o0.x = cvt_pk_bf16(u[0], u[1]); o0.y = cvt_pk_bf16(u[2], u[3]); o0.z = cvt_pk_bf16(u[4], u[5]); o0.w = cvt_pk_bf16(u[6], u[7]);
                o1.x = cvt_pk_bf16(u[8], u[9]); o1.y = cvt_pk_bf16(u[10], u[11]); o1.z = cvt_pk_bf16(u[12], u[13]); o1.w = cvt_pk_bf16(u[14], u[15]);
                *(LAS v4u*)(UT + fr * WY_TS) = o0; *(LAS v4u*)(UT + fr * WY_TS + 8) = o1; }
        }
        LDS_WAIT();
        {
            const bf16x8 uc = fq < 2 ? *(const LAS bf16x8*)(UT + fr * WY_TS + fq * 8) : (pw ? zero8 : *(const LAS bf16x8*)(VT + (16 * wave + fr) * WY_TS + (fq - 2) * 8));
            Y0 = __builtin_amdgcn_mfma_f32_16x16x32_bf16(*(const LAS bf16x8*)(Mc + fr * WY_LS + fq * 8), uc, Y0, 0, 0, 0);
            LAS float* yo = (pw ? ZZ + 16 * (wave - 4) : YY + 16 * wave) + fr;
#pragma unroll
            for (int rg = 0; rg < 4; ++rg) yo[(mc * 16 + 4 * fq + rg) * 64] = Y0[rg];
#pragma unroll
            for (int j = 0; j < 4; ++j) {
                const bf16x8 bc = fq < 2 ? *(const LAS bf16x8*)(BhT + (16 * j + fr) * WY_TS + fq * 8) : *(const LAS bf16x8*)(KhT + (16 * j + fr) * WY_TS + (fq - 2) * 8);
                X[j] = X[j] * *(const LAS f32x4*)(GC + 16 * j + 4 * fq);
                X[j] = __builtin_amdgcn_mfma_f32_16x16x32_bf16(bc, uc, X[j], 0, 0, 0);
                v2u w; w.x = cvt_pk_bf16(X[j][0], X[j][1]); w.y = cvt_pk_bf16(X[j][2], X[j][3]);
                *(LAS v2u*)(Xb + (16 * wave + fr) * WY_OS + 16 * j + 4 * fq) = w; }
        }
        LDS_WAIT();
    }
}

#define P1_LOAD_PARAMS(HH) do { int lf_ = fr, lq_ = fq, lt_ = tid; asm volatile("" : "+v"(lf_), "+v"(lq_), "+v"(lt_));   \
        const int h_ = (HH), ncol_ = h_ * 64 + ntl * 16 + lf_; \
        _Pragma("unroll") for (int ks = 0; ks < 2; ++ks) { bw[ks] = *(const bf16x8*)(L2T + (size_t)ncol_ * 64 + lq_ * 8 + ks * 32); ba[ks] = *(const bf16x8*)(L2T + (size_t)512 * 64 + (size_t)ncol_ * 64 + lq_ * 8 + ks * 32); } \
        _Pragma("unroll") for (int ks = 0; ks < 4; ++ks) bg[ks] = *(const bf16x8*)(L2T + (size_t)1024 * 64 + (size_t)ncol_ * 128 + lq_ * 8 + ks * 32); \
        if (lt_ < 128) { const int a_ = lt_ >> 4, c_ = (lt_ & 15) * 4; \
            const float* src_ = a_ == 0 ? A.in[I_W0] : a_ == 1 ? A.in[I_A0] : a_ == 2 ? A.in[I_KK] : a_ == 3 ? A.in[I_KA] : a_ == 4 ? A.in[I_RK] : A.in[I_MURKV] + (a_ - 5) * 512; \
            *(LAS f32x4*)(PRM + a_ * 64 + c_) = *(const f32x4*)(src_ + h_ * 64 + c_); } } while (0)
__device__ __forceinline__ void scan_pass1(const Args& A, LAS unsigned char* lds, int tid, int lane, int wave, int vcu, int G, int part = 0) {
    bf16* GB = (bf16*)(A.ws + WS_A1) + (size_t)MPAD * 512;
    bf16* YL = (bf16*)(A.ws + WS_YL); bf16* ZT = (bf16*)(A.ws + WS_ZT); bf16* BV = (bf16*)(A.ws + WS_BV);
    LAS bf16* HIDB = (LAS bf16*)(lds + P1_HIDB); LAS float* LO = (LAS float*)(lds + P1_LO); LAS float* SEQ = (LAS float*)(lds + P1_SEQ);
    LAS float* YY = (LAS float*)(lds + P1_YY); LAS float* ZZ = (LAS float*)(lds + P1_ZZ);
    const bf16* L2T = (const bf16*)(A.ws + WS_L2T);
    const bool prow_wave = wave >= 4;
    const int mt = wave & 1, ntl = wave >> 1;
    int tt = tid >> 4, cs = tid & 15, c4 = cs * 4, fr = lane & 15, fq = lane >> 4;
    f32x4 X[4];
    bf16x8 bw[2], ba[2], bg[4];
    LAS float* PRM = (LAS float*)(lds + P1_GG);
    int cur_h = -1;
    int ui = 0, unit; if (!p1_unit_at(0, vcu, G, unit)) return;
    int t0 = 0; P1Pre pre; p1_load(A, unit, 0, tt, cs, pre);
    for (;;) {
        { int lt_ = tid; asm volatile("" : "+v"(lt_)); tt = lt_ >> 4; cs = lt_ & 15; c4 = cs * 4; fr = lt_ & 15; fq = (lt_ >> 4) & 3; }
        bool prompt; int b, h, ch, T, rowbase; p1_decode(unit, prompt, b, h, ch, T, rowbase);
        const int hc = h * 64 + c4;
        if (t0 == 0 && G == 256 && ui < 8) {
            const size_t i16 = ((size_t)(ui * 256 + vcu) * NTHR + tid) * 16;
            cvt16_fp8_sliced(A.in[I_U], A.ws + WS_UB, PEER_SU, i16); cvt16_fp8_sliced(A.in[I_V], A.ws + WS_VB, PEER_SV, i16); }
        if (t0 == 0) {
            LAS bf16* Xb = (LAS bf16*)(lds + WY_XB);
#pragma unroll
            for (int j = 0; j < 4; ++j) { const int prow_ = 16 * (wave - 4) + fr, c0_ = 16 * j + 4 * fq;
#pragma unroll
                for (int e = 0; e < 4; ++e) X[j][e] = (prow_wave && prow_ == c0_ + e) ? 1.f : 0.f;
                v2u w; w.x = cvt_pk_bf16(X[j][0], X[j][1]); w.y = cvt_pk_bf16(X[j][2], X[j][3]);
                *(LAS v2u*)(Xb + (16 * wave + fr) * WY_OS + c0_) = w; }
        }
        if (h != cur_h) { cur_h = h; P1_LOAD_PARAMS(h); }
        size_t row, prow; bool hasprev; int nb; p1_rows(unit, t0, tt, row, prow, hasprev, nb);
        if (!(MK_DBGSEL == 5 && part)) { *(LAS v4u*)(HIDB + tt * HID_STRIDE + cs * 16) = pre.pa0; *(LAS v4u*)(HIDB + tt * HID_STRIDE + cs * 16 + 8) = pre.pa1; }
        __syncthreads();
        if (!(MK_DBGSEL == 5 && part)) {
            const LAS bf16* ap = HIDB + (mt * 16 + fr) * HID_STRIDE + fq * 8;
            f32x4 cw = (f32x4){0.f, 0.f, 0.f, 0.f}, ca = cw, cg = cw;
#pragma unroll
            for (int ks = 0; ks < 2; ++ks) { cw = __builtin_amdgcn_mfma_f32_16x16x32_bf16(*(const LAS bf16x8*)(ap + ks * 32), bw[ks], cw, 0, 0, 0);
                                             ca = __builtin_amdgcn_mfma_f32_16x16x32_bf16(*(const LAS bf16x8*)(ap + 64 + ks * 32), ba[ks], ca, 0, 0, 0); }
#pragma unroll
            for (int ks = 0; ks < 4; ++ks) cg = __builtin_amdgcn_mfma_f32_16x16x32_bf16(*(const LAS bf16x8*)(ap + 128 + ks * 32), bg[ks], cg, 0, 0, 0);
#pragma unroll
            for (int rg = 0; rg < 4; ++rg) { const int o = (mt * 16 + fq * 4 + rg) * 64 + ntl * 16 + fr; LO[o] = cw[rg]; LO[2048 + o] = ca[rg]; LO[4096 + o] = cg[rg]; }
        }
        __syncthreads();
        if (!(MK_DBGSEL == 5 && part)) {
            const f32x4 w0v = *(const LAS f32x4*)(PRM + c4), a0v = *(const LAS f32x4*)(PRM + 64 + c4), kkv = *(const LAS f32x4*)(PRM + 128 + c4), kav = *(const LAS f32x4*)(PRM + 192 + c4),
                        rkv = *(const LAS f32x4*)(PRM + 256 + c4), mur = *(const LAS f32x4*)(PRM + 320 + c4), muk = *(const LAS f32x4*)(PRM + 384 + c4), muv = *(const LAS f32x4*)(PRM + 448 + c4);
            const f32x4 aw = w0v + *(const LAS f32x4*)(LO + tt * 64 + c4), aa = a0v + *(const LAS f32x4*)(LO + 2048 + tt * 64 + c4), ag = *(const LAS f32x4*)(LO + 4096 + tt * 64 + c4);
            f32x4 r = (f32x4){bf_lo(pre.zr.x), bf_hi(pre.zr.x), bf_lo(pre.zr.y), bf_hi(pre.zr.y)}, k = (f32x4){bf_lo(pre.zk.x), bf_hi(pre.zk.x), bf_lo(pre.zk.y), bf_hi(pre.zk.y)},
                  v = (f32x4){bf_lo(pre.zv.x), bf_hi(pre.zv.x), bf_lo(pre.zv.y), bf_hi(pre.zv.y)};
            const f32x4 rpv = (f32x4){bf_lo(pre.pr.x), bf_hi(pre.pr.x), bf_lo(pre.pr.y), bf_hi(pre.pr.y)}, kpv = (f32x4){bf_lo(pre.pk.x), bf_hi(pre.pk.x), bf_lo(pre.pk.y), bf_hi(pre.pk.y)},
                        vpv = (f32x4){bf_lo(pre.pv.x), bf_hi(pre.pv.x), bf_lo(pre.pv.y), bf_hi(pre.pv.y)};
            r = r + mur * (rpv - r); k = k + muk * (kpv - k); v = v + muv * (vpv - v);
            f32x4 dec, asg, kk, km, av, bv;
            float ssq = 0.f, bon = 0.f;
#pragma unroll
            for (int i = 0; i < 4; ++i) {
                const float x = -aw[i];
                const float sp = fmaxf(x, 0.f) + __logf(1.0f + __expf(-fabsf(x)));
                const float wraw = -sp - 0.5f;
                dec[i] = -__expf(wraw);
                asg[i] = sigm(aa[i]);
                kk[i] = k[i] * kkv[i]; ssq += kk[i] * kk[i];
                km[i] = k[i] * (1.0f + (asg[i] - 1.0f) * kav[i]);
                bon += r[i] * km[i] * rkv[i];
            }
            ssq = sum16(ssq); bon = sum16(bon);
            const float inv = 1.0f / fmaxf(sqrtf(ssq), 1e-12f);
#pragma unroll
            for (int i = 0; i < 4; ++i) { kk[i] *= inv; av[i] = -kk[i]; bv[i] = kk[i] * asg[i]; }
            LAS float* sq_ = SEQ + tt * 384 + c4;
            *(LAS f32x4*)(sq_) = av; *(LAS f32x4*)(sq_ + 64) = dec; *(LAS f32x4*)(sq_ + 128) = bv; *(LAS f32x4*)(sq_ + 192) = km; *(LAS f32x4*)(sq_ + 256) = r; *(LAS f32x4*)(sq_ + 320) = v;
            if (tt < nb) {
                v2u w; w.x = cvt_pk_bf16(ag[0], ag[1]); w.y = cvt_pk_bf16(ag[2], ag[3]); *(v2u*)(GB + row * 512 + hc) = w;
                w.x = cvt_pk_bf16(bon * v[0], bon * v[1]); w.y = cvt_pk_bf16(bon * v[2], bon * v[3]); *(v2u*)(BV + row * 512 + hc) = w;
            }
        }
        int nunit = unit, nt0 = t0 + SC_TB, nui = ui; bool more = true;
        if (nt0 >= T) { nt0 = 0; nui = ui + 1; more = p1_unit_at(nui, vcu, G, nunit); }
        if (more) p1_load(A, nunit, nt0, tt, cs, pre);
        __syncthreads();
        if (!(MK_DBGSEL == 1 && part)) p1_wy(X, SEQ, YY, ZZ, lds, nb, tid, lane, wave, part);
        __syncthreads();
        if (tt < nb) {
            const f32x4 y = *(const LAS f32x4*)(YY + tt * 64 + c4), z = *(const LAS f32x4*)(ZZ + tt * 64 + c4);
            v2u w; w.x = cvt_pk_bf16(y[0], y[1]); w.y = cvt_pk_bf16(y[2], y[3]); *(v2u*)(YL + row * 512 + hc) = w;
            w.x = cvt_pk_bf16(z[0], z[1]); w.y = cvt_pk_bf16(z[2], z[3]); *(v2u*)(ZT + row * 512 + hc) = w;
        }
        if (t0 + SC_TB >= T) {
#pragma unroll
            for (int j = 0; j < 4; ++j) {
                if (!prow_wave) *(f32x4*)((float*)A.out + (size_t)unit * 4096 + (16 * wave + fr) * 64 + 16 * j + 4 * fq) = X[j];
                else { v2u o; o.x = cvt_pk_bf16(X[j][0], X[j][1]); o.y = cvt_pk_bf16(X[j][2], X[j][3]);
                    *(v2u*)((bf16*)((unsigned char*)A.out + OB_MB) + (size_t)unit * 4096 + (16 * (wave - 4) + fr) * 64 + 16 * j + 4 * fq) = o; }
            }
        }
        if (!more) break;
        unit = nunit; t0 = nt0; ui = nui;
    }
    __syncthreads();
}

constexpr int P2_SP = 68, P2_MP = 80, P2_ML = 16 * P2_SP * 4, P2_PL = P2_ML + 64 * P2_MP * 4;
__device__ __forceinline__ void scan_pass2_rows(const float* Sinit, int unit0, int nchunks, int v0, float* outfin, bool slots, const Args& A, LAS unsigned char* lds, int tid, int lane, int wave) {
    LAS float* Sl = (LAS float*)lds; LAS float* Ml = (LAS float*)(lds + P2_ML); LAS float* Pl = (LAS float*)(lds + P2_PL);
    const int nt = wave & 3, kh = wave >> 2, fr = lane & 15, fq = lane >> 4;
    float* NB = (float*)A.out; const bf16* MB = (const bf16*)((const unsigned char*)A.out + OB_MB);
    { const int idx = tid * 2, row = idx >> 6, col = idx & 63;
      const f32x2 s0 = Sinit ? *(const f32x2*)(Sinit + (size_t)(v0 + row) * 64 + col) : (f32x2){0.f, 0.f};
      *(LAS f32x2*)(Sl + row * P2_SP + col) = s0; }
    v4u mreg = *(const v4u*)(MB + (size_t)unit0 * 4096 + tid * 8);
    float nreg[4] = {0.f, 0.f, 0.f, 0.f};
    if (kh == 0) {
#pragma unroll
        for (int rg = 0; rg < 4; ++rg) nreg[rg] = NB[(size_t)unit0 * 4096 + (v0 + fq * 4 + rg) * 64 + nt * 16 + fr]; }
    f32x4 acc = (f32x4){0.f, 0.f, 0.f, 0.f};
    for (int c = 0; c < nchunks; ++c) {
        { const int row = tid >> 3, col = (tid & 7) * 8; LAS float* mp = Ml + row * P2_MP + col;
          *(LAS f32x4*)mp = (f32x4){bf_lo(mreg.x), bf_hi(mreg.x), bf_lo(mreg.y), bf_hi(mreg.y)}; *(LAS f32x4*)(mp + 4) = (f32x4){bf_lo(mreg.z), bf_hi(mreg.z), bf_lo(mreg.w), bf_hi(mreg.w)}; }
        __syncthreads();
        float ncur[4] = {nreg[0], nreg[1], nreg[2], nreg[3]};
        if (c + 1 < nchunks) { mreg = *(const v4u*)(MB + (size_t)(unit0 + c + 1) * 4096 + tid * 8);
            if (kh == 0) {
#pragma unroll
                for (int rg = 0; rg < 4; ++rg) nreg[rg] = NB[(size_t)(unit0 + c + 1) * 4096 + (v0 + fq * 4 + rg) * 64 + nt * 16 + fr]; } }
        f32x4 a0 = (f32x4){0.f, 0.f, 0.f, 0.f}, a1 = a0;
        const LAS float* sp = Sl + fr * P2_SP + kh * 32 + fq; const LAS float* mp = Ml + (kh * 32 + fq) * P2_MP + nt * 16 + fr;
#pragma unroll
        for (int ks = 0; ks < 8; ks += 2) { a0 = __builtin_amdgcn_mfma_f32_16x16x4f32(sp[4 * ks], mp[4 * ks * P2_MP], a0, 0, 0, 0); a1 = __builtin_amdgcn_mfma_f32_16x16x4f32(sp[4 * ks + 4], mp[(4 * ks + 4) * P2_MP], a1, 0, 0, 0); }
        acc = a0 + a1;
        if (kh == 1) *(LAS f32x4*)(Pl + nt * 256 + lane * 4) = acc;
        __syncthreads();
        if (kh == 0) {
            acc = acc + *(const LAS f32x4*)(Pl + nt * 256 + lane * 4) + (f32x4){ncur[0], ncur[1], ncur[2], ncur[3]};
#pragma unroll
            for (int rg = 0; rg < 4; ++rg) { Sl[(fq * 4 + rg) * P2_SP + nt * 16 + fr] = acc[rg];
                if (slots) NB[(size_t)(unit0 + c) * 4096 + (v0 + fq * 4 + rg) * 64 + nt * 16 + fr] = acc[rg]; }
        }
    }
    if (kh == 0) {
#pragma unroll
        for (int rg = 0; rg < 4; ++rg) outfin[(size_t)(v0 + fq * 4 + rg) * 64 + nt * 16 + fr] = acc[rg]; }
    __syncthreads();
}

__device__ __forceinline__ void scan_pass3_wave(const Args& A, int unit, int wq, int lane) {
    const bool prompt = unit < NUNITS_P;
    const int b = prompt ? unit >> 9 : (unit - NUNITS_P) >> 3, h = prompt ? (unit >> 6) & 7 : unit & 7, ch = prompt ? unit & 63 : 0;
    const int T = prompt ? 64 : SEQ_S, rowbase = prompt ? b * SEQ_P + ch * 64 : NPROMPT + b * SEQ_S;
    if (wq * 16 >= T) return;
    const float* S0 = prompt ? (ch > 0 ? (const float*)A.out + (size_t)(unit - 1) * 4096 : nullptr) : A.in[I_SWKV] + (size_t)(b * 8 + h) * 4096;
    const bf16* ZT = (const bf16*)(A.ws + WS_ZT); const bf16* YL = (const bf16*)(A.ws + WS_YL); const bf16* BV = (const bf16*)(A.ws + WS_BV);
    bf16* YB = (bf16*)(A.ws + WS_A1) + (size_t)MPAD * 512;
    const int fr = lane & 15, fq = lane >> 4;
    const size_t row = (size_t)(rowbase + wq * 16 + fr);
    f32x4 acc[4];
#pragma unroll
    for (int mt = 0; mt < 4; ++mt) acc[mt] = (f32x4){0.f, 0.f, 0.f, 0.f};
    if (S0) {
        bf16x8 bz[2];
#pragma unroll
        for (int ks = 0; ks < 2; ++ks) bz[ks] = *(const bf16x8*)(ZT + row * 512 + h * 64 + ks * 32 + fq * 8);
#pragma unroll
        for (int mt = 0; mt < 4; ++mt)
#pragma unroll
            for (int ks = 0; ks < 2; ++ks) { const float* sp = S0 + (size_t)(mt * 16 + fr) * 64 + ks * 32 + fq * 8; const f32x4 s0 = *(const f32x4*)sp, s1 = *(const f32x4*)(sp + 4);
                v4u pk; pk.x = cvt_pk_bf16(s0[0], s0[1]); pk.y = cvt_pk_bf16(s0[2], s0[3]); pk.z = cvt_pk_bf16(s1[0], s1[1]); pk.w = cvt_pk_bf16(s1[2], s1[3]);
                acc[mt] = __builtin_amdgcn_mfma_f32_16x16x32_bf16(__builtin_bit_cast(bf16x8, pk), bz[ks], acc[mt], 0, 0, 0); }
    }
    float sm = 0.f;
#pragma unroll
    for (int mt = 0; mt < 4; ++mt) { const v2u yl = *(const v2u*)(YL + row * 512 + h * 64 + mt * 16 + fq * 4);
        acc[mt][0] += bf_lo(yl.x); acc[mt][1] += bf_hi(yl.x); acc[mt][2] += bf_lo(yl.y); acc[mt][3] += bf_hi(yl.y);
        sm += (acc[mt][0] + acc[mt][1]) + (acc[mt][2] + acc[mt][3]); }
    sm += __shfl_xor(sm, 16); sm += __shfl_xor(sm, 32);
    const float mean = sm * (1.f / 64.f); float sv = 0.f;
#pragma unroll
    for (int mt = 0; mt < 4; ++mt) { acc[mt] = acc[mt] - mean; sv += (acc[mt][0] * acc[mt][0] + acc[mt][1] * acc[mt][1]) + (acc[mt][2] * acc[mt][2] + acc[mt][3] * acc[mt][3]); }
    sv += __shfl_xor(sv, 16); sv += __shfl_xor(sv, 32);
    const float rs = 1.0f / sqrtf(sv * (1.f / 64.f) + 64e-5f);
#pragma unroll
    for (int mt = 0; mt < 4; ++mt) { const int c = h * 64 + mt * 16 + fq * 4;
        const f32x4 gw = *(const f32x4*)(A.in[I_GNW] + c), gb = *(const f32x4*)(A.in[I_GNB] + c);
        const v2u bvw = *(const v2u*)(BV + row * 512 + c), gg = *(const v2u*)(YB + row * 512 + c);
        f32x4 o = acc[mt] * rs * gw + gb + (f32x4){bf_lo(bvw.x), bf_hi(bvw.x), bf_lo(bvw.y), bf_hi(bvw.y)};
        o = o * (f32x4){bf_lo(gg.x), bf_hi(gg.x), bf_lo(gg.y), bf_hi(gg.y)};
        v2u w; w.x = cvt_pk_bf16(o[0], o[1]); w.y = cvt_pk_bf16(o[2], o[3]); *(v2u*)(YB + row * 512 + c) = w; }
}

__device__ __forceinline__ void tk_insert(float (&tv)[16], float x) {
#pragma unroll
    for (int i = 15; i >= 1; --i) tv[i] = __builtin_amdgcn_fmed3f(tv[i - 1], x, tv[i]);
    tv[0] = __builtin_fmaxf(tv[0], x);
}
#define TK_CE(t, i, j) { const float a_ = __builtin_fmaxf(t[i], t[j]); t[j] = __builtin_fminf(t[i], t[j]); t[i] = a_; }
__device__ __forceinline__ void tk_sort16(float (&t)[16]) {
    TK_CE(t, 0, 1) TK_CE(t, 2, 3) TK_CE(t, 0, 2) TK_CE(t, 1, 3) TK_CE(t, 1, 2) TK_CE(t, 4, 5) TK_CE(t, 6, 7) TK_CE(t, 4, 6) TK_CE(t, 5, 7) TK_CE(t, 5, 6) TK_CE(t, 0, 4) TK_CE(t, 2, 6) TK_CE(t, 2, 4) TK_CE(t, 1, 5) TK_CE(t, 3, 7) TK_CE(t, 3, 5) TK_CE(t, 1, 2) TK_CE(t, 3, 4) TK_CE(t, 5, 6) TK_CE(t, 8, 9) TK_CE(t, 10, 11) TK_CE(t, 8, 10) TK_CE(t, 9, 11) TK_CE(t, 9, 10) TK_CE(t, 12, 13) TK_CE(t, 14, 15) TK_CE(t, 12, 14) TK_CE(t, 13, 15) TK_CE(t, 13, 14) TK_CE(t, 8, 12) TK_CE(t, 10, 14) TK_CE(t, 10, 12) TK_CE(t, 9, 13) TK_CE(t, 11, 15) TK_CE(t, 11, 13) TK_CE(t, 9, 10) TK_CE(t, 11, 12) TK_CE(t, 13, 14) TK_CE(t, 0, 8) TK_CE(t, 4, 12) TK_CE(t, 4, 8) TK_CE(t, 2, 10) TK_CE(t, 6, 14) TK_CE(t, 6, 10) TK_CE(t, 2, 4) TK_CE(t, 6, 8) TK_CE(t, 10, 12) TK_CE(t, 1, 9) TK_CE(t, 5, 13) TK_CE(t, 5, 9) TK_CE(t, 3, 11) TK_CE(t, 7, 15) TK_CE(t, 7, 11) TK_CE(t, 3, 5) TK_CE(t, 7, 9) TK_CE(t, 11, 13) TK_CE(t, 1, 2) TK_CE(t, 3, 4) TK_CE(t, 5, 6) TK_CE(t, 7, 8) TK_CE(t, 9, 10) TK_CE(t, 11, 12) TK_CE(t, 13, 14)
}
__device__ __forceinline__ void tk_merge16(float (&tv)[16], const float (&g)[16]) {
#pragma unroll
    for (int i = 0; i < 16; ++i) tv[i] = __builtin_fmaxf(tv[i], g[15 - i]);
#pragma unroll
    for (int s = 8; s >= 1; s >>= 1)
#pragma unroll
        for (int i = 0; i < 16; ++i) if ((i & s) == 0) TK_CE(tv, i, i + s)
}
__device__ __forceinline__ float gelu_tanh(float x) {
    const float u = 0.7978845608028654f * (x + 0.044715f * x * x * x);
    const float th = 1.0f - 2.0f * __builtin_amdgcn_rcpf(__expf(2.0f * u) + 1.0f);
    return 0.5f * x * (1.0f + th);
}
constexpr int NTILE32 = NTOK / 32;
constexpr int CW_QU = 8192, CW_QV = 8192 + 512;

constexpr int TK_STRIDE = 68, TK_BYTES = 64 * TK_STRIDE * 4;
__device__ __forceinline__ void topk_scores64(const bf16* Q, const bf16* KB, LAS float* SC, int t0, int hp, int p, int half, int lane, const bf16x8 (&af)[2][2][4]) {
    const int fr = lane & 15, fq = lane >> 4;
#pragma unroll
    for (int hs = 0; hs < 2; ++hs) {
        const bf16* kbase = KB + (size_t)(((hp + 4 * hs) * 2 + p) * 128 + half * 64 + fr) * 128 + fq * 8;
#pragma unroll
        for (int n = 0; n < 4; ++n) {
            bf16x8 bfr[4];
#pragma unroll
            for (int ks = 0; ks < 4; ++ks) bfr[ks] = *(const bf16x8*)(kbase + (size_t)n * 16 * 128 + ks * 32);
            f32x4 acc0 = (f32x4){0.f, 0.f, 0.f, 0.f}, acc1 = acc0;
#pragma unroll
            for (int ks = 0; ks < 4; ++ks) { acc0 = __builtin_amdgcn_mfma_f32_16x16x32_bf16(af[hs][0][ks], bfr[ks], acc0, 0, 0, 0); acc1 = __builtin_amdgcn_mfma_f32_16x16x32_bf16(af[hs][1][ks], bfr[ks], acc1, 0, 0, 0); }
#pragma unroll
            for (int rg = 0; rg < 4; ++rg) { SC[(hs * 32 + fq * 4 + rg) * TK_STRIDE + n * 16 + fr] = acc0[rg]; SC[(hs * 32 + 16 + fq * 4 + rg) * TK_STRIDE + n * 16 + fr] = acc1[rg]; }
        }
    }
}
constexpr int TK_NPROMPT_UNITS = (NPROMPT / 32) * 4, TK_NSAMPLE_UNITS = (NSAMP / 32) * 4, CW_TKS = 9792;
__device__ __forceinline__ void peer_topk_units(const Args& A, LAS unsigned char* lds, int lane, int wave, int u_first, int u_end, int u_step) {
    const bf16* Q = (const bf16*)(A.ws + WS_ZG); const bf16* KB = (const bf16*)(A.ws + WS_KEYS); const float* SSP = (const float*)(A.ws + WS_SSP);
    unsigned short* EIDX = (unsigned short*)(A.ws + WS_EIDX); float* GATE = (float*)(A.ws + WS_GATE); float* RSTD = (float*)(A.ws + WS_RSTD);
    LAS float* SC = (LAS float*)(lds + wave * TK_BYTES);
    const int fr = lane & 15, fq = lane >> 4, tokl = lane & 31, hsel = lane >> 5;
    for (int u = u_first; u < u_end; u += u_step) {
        const int t0 = (u >> 2) * 32, hp = u & 3, h = hp + 4 * hsel;
        const float* sp = SSP + (size_t)(t0 + tokl) * 16;
        const f32x4 s0 = *(const f32x4*)sp, s1 = *(const f32x4*)(sp + 4), s2 = *(const f32x4*)(sp + 8), s3 = *(const f32x4*)(sp + 12);
        const float ssq = ((s0[0] + s0[1]) + (s0[2] + s0[3])) + ((s1[0] + s1[1]) + (s1[2] + s1[3])) + ((s2[0] + s2[1]) + (s2[2] + s2[3])) + ((s3[0] + s3[1]) + (s3[2] + s3[3]));
        const float rstd = 1.0f / sqrtf(ssq * (1.f / DM) + 1e-6f);
        float tv0[16], tv1[16], cv[16];
#pragma unroll
        for (int p = 0; p < 2; ++p) {
            bf16x8 af[2][2][4];
#pragma unroll
            for (int hs = 0; hs < 2; ++hs)
#pragma unroll
                for (int mt = 0; mt < 2; ++mt) { const bf16* qp = Q + (size_t)(t0 + mt * 16 + fr) * 2048 + (hp + 4 * hs) * 256 + p * 128 + fq * 8;
#pragma unroll
                    for (int ks = 0; ks < 4; ++ks) af[hs][mt][ks] = *(const bf16x8*)(qp + ks * 32); }
            float tv[16];
#pragma unroll
            for (int i = 0; i < 16; ++i) tv[i] = -3.0e38f;
            for (int half = 0; half < 2; ++half) {
                topk_scores64(Q, KB, SC, t0, hp, p, half, lane, af);
                LDS_WAIT();
                const LAS float* mine = SC + lane * TK_STRIDE;
                unsigned kmask = 0xFFFFFF80u; asm volatile("" : "+v"(kmask));
#pragma unroll 1
                for (int n = 0; n < 64; n += 16) {
                    float g[16];
#pragma unroll
                    for (int q = 0; q < 4; ++q) { const f32x4 x4 = *(const LAS f32x4*)(mine + n + 4 * q);
#pragma unroll
                        for (int e = 0; e < 4; ++e) g[4 * q + e] = __uint_as_float((__float_as_uint(x4[e]) & kmask) | (unsigned)(half * 64 + n + 4 * q + e)); }
                    tk_sort16(g); tk_merge16(tv, g);
                }
                LDS_WAIT();
            }
#pragma unroll
            for (int i = 0; i < 16; ++i) { if (p == 0) tv0[i] = tv[i]; else tv1[i] = tv[i]; }
        }
        LAS int* li = (LAS int*)SC + lane * 33;
#pragma unroll
        for (int q = 0; q < 16; ++q) { li[q] = (int)(__float_as_uint(tv0[q]) & 127u); li[16 + q] = (int)(__float_as_uint(tv1[q]) & 127u);
            tv0[q] = __uint_as_float(__float_as_uint(tv0[q]) & 0xFFFFFF80u); tv1[q] = __uint_as_float(__float_as_uint(tv1[q]) & 0xFFFFFF80u); }
#pragma unroll
        for (int q = 0; q < 16; ++q) cv[q] = -3.0e38f;
#pragma unroll
        for (int a = 0; a < 16; ++a)
#pragma unroll
            for (int b = 0; b < 16; ++b) if ((a + 1) * (b + 1) <= 16)
                tk_insert(cv, __uint_as_float((__float_as_uint(tv0[a] + tv1[b]) & 0xFFFFFF00u) | (unsigned)(a * 16 + b)));
        LDS_WAIT();
        float e[16], den = 0.f; unsigned ci[16];
        const float c0 = __uint_as_float(__float_as_uint(cv[0]) & 0xFFFFFF00u);
#pragma unroll
        for (int q = 0; q < 16; ++q) { const unsigned kb = __float_as_uint(cv[q]); const float cq = __uint_as_float(kb & 0xFFFFFF00u);
            e[q] = __expf((cq - c0) * rstd); den += e[q]; ci[q] = (unsigned)(li[(kb >> 4) & 15] * 128 + li[16 + (kb & 15)]); }
        const float inv = 1.0f / den;
        LDS_WAIT();
        {
            const size_t tok = (size_t)(t0 + tokl);
            v4u w0, w1; w0.x = ci[0] | (ci[1] << 16); w0.y = ci[2] | (ci[3] << 16); w0.z = ci[4] | (ci[5] << 16); w0.w = ci[6] | (ci[7] << 16);
            w1.x = ci[8] | (ci[9] << 16); w1.y = ci[10] | (ci[11] << 16); w1.z = ci[12] | (ci[13] << 16); w1.w = ci[14] | (ci[15] << 16);
            *(v4u*)(EIDX + tok * 128 + h * 16) = w0; *(v4u*)(EIDX + tok * 128 + h * 16 + 8) = w1;
#pragma unroll
            for (int q = 0; q < 4; ++q) *(f32x4*)(GATE + tok * 128 + h * 16 + 4 * q) = (f32x4){e[4 * q] * inv, e[4 * q + 1] * inv, e[4 * q + 2] * inv, e[4 * q + 3] * inv};
            if (h == 0) RSTD[tok] = rstd;
        }
    }
}

__device__ __forceinline__ bool peer_topk_split(int G) { return G == 256; }
__device__ __forceinline__ void peer_topk_phase(const Args& A, LAS unsigned char* lds, int tid, int lane, int wave, int vcu, int G) {
    peer_topk_units(A, lds, lane, wave, wave * G + vcu, peer_topk_split(G) ? TK_NPROMPT_UNITS : TK_NPROMPT_UNITS + TK_NSAMPLE_UNITS, G * NWAVES);
}
__device__ __forceinline__ void peer_topk_sample_prelude(const Args& A, LAS unsigned char* lds, int tid, int lane, int wave, int vcu, int G, gu32* ctl) {
    if (!peer_topk_split(G) || (vcu & 31) != 0) return;
    peer_topk_units(A, lds, lane, wave, TK_NPROMPT_UNITS + (vcu >> 5) * NWAVES + wave, TK_NPROMPT_UNITS + TK_NSAMPLE_UNITS, TK_NSAMPLE_UNITS);
    asm volatile("s_waitcnt vmcnt(0)" ::: "memory");
    __syncthreads();
    if (tid == 0) { __builtin_amdgcn_fence(__ATOMIC_RELEASE, "agent"); asm volatile("s_waitcnt vmcnt(0)" ::: "memory"); (void)__hip_atomic_fetch_add((unsigned*)(ctl + CW_TKS), 1u, RLX_AGENT); }
    __syncthreads();
}
__device__ __forceinline__ void peer_topk_sample_wait(gu32* ctl, int tid) {
    if (tid == 0) {
        unsigned sp = 0;
        while (__hip_atomic_load((unsigned*)(ctl + CW_TKS), RLX_AGENT) < (unsigned)(TK_NSAMPLE_UNITS / NWAVES)) { __builtin_amdgcn_s_sleep(2); if (++sp > (1u << 22)) break; }
        __builtin_amdgcn_fence(__ATOMIC_ACQUIRE, "agent");
        asm volatile("s_waitcnt vmcnt(0)" ::: "memory");
    }
    __syncthreads();
}

constexpr int PEER_ITEM = 40, NITEM128 = NTOK / PEER_ITEM;
__device__ __forceinline__ bool peer_next_item(gu32* qbase, int xcc, int& qs, int& slice, int& item, LAS unsigned char* lds, int tid) {
    LAS int* box = (LAS int*)(lds + LDSCTL_OFF + 64);
    for (;;) {
        if (qs >= 8) return false;
        slice = (xcc + qs) & 7;
        if (tid == 0) box[0] = (int)__hip_atomic_fetch_add((unsigned*)(qbase + 64 * slice), 1u, RLX_AGENT);
        __syncthreads();
        item = box[0];
        __syncthreads();
        if (item < NITEM128) return true;
        ++qs;
    }
}

__device__ __forceinline__ void peer_u_phase(const Args& A, LAS unsigned char* lds, int tid, int lane, int wave, gu32* ctl, int qoff) {
    const unsigned char* Uq = A.ws + WS_UB; const bf16* XG = (const bf16*)(A.ws + WS_A1);
    const unsigned short* EIDX = (const unsigned short*)(A.ws + WS_EIDX); float* PART = (float*)(A.ws + WS_PART);
    const int xcc = (int)(xb_xcc_id() & 7u), rg = lane >> 3, c8 = lane & 7;
    LAS int* we = (LAS int*)(lds + wave * 1024);
    int qs = 0, slice, item; bool lists_ready = !peer_topk_split((int)gridDim.x);
    while (peer_next_item(ctl + CW_QU + qoff, xcc, qs, slice, item, lds, tid)) {
        if (!lists_ready && (item + 1) * PEER_ITEM > NPROMPT) { peer_topk_sample_wait(ctl, tid); lists_ready = true; }
        const unsigned char* us = Uq + (size_t)slice * 16384 * 128 + c8 * 16;
        size_t tok = (size_t)(item * PEER_ITEM + wave);
        unsigned pair = *(const unsigned*)(EIDX + tok * 128 + 2 * lane);
        v4u xa = *(const v4u*)(XG + tok * DM + slice * 128 + c8 * 16), xb = *(const v4u*)(XG + tok * DM + slice * 128 + c8 * 16 + 8);
        for (int tt = 0; tt < PEER_ITEM / NWAVES; ++tt) {
            we[2 * lane] = (int)(pair & 0xffffu); we[2 * lane + 1] = (int)(pair >> 16);
            const f32x2 x[8] = {(f32x2){bf_lo(xa.x), bf_hi(xa.x)}, (f32x2){bf_lo(xa.y), bf_hi(xa.y)}, (f32x2){bf_lo(xa.z), bf_hi(xa.z)}, (f32x2){bf_lo(xa.w), bf_hi(xa.w)},
                                (f32x2){bf_lo(xb.x), bf_hi(xb.x)}, (f32x2){bf_lo(xb.y), bf_hi(xb.y)}, (f32x2){bf_lo(xb.z), bf_hi(xb.z)}, (f32x2){bf_lo(xb.w), bf_hi(xb.w)}};
            LDS_WAIT();
            v4u w[16];
#pragma unroll
            for (int it = 0; it < 16; ++it) w[it] = *(const v4u*)(us + (size_t)we[it * 8 + rg] * 128);
            const size_t ctok = tok;
            if (tt + 1 < PEER_ITEM / NWAVES) { tok += NWAVES; pair = *(const unsigned*)(EIDX + tok * 128 + 2 * lane);
                xa = *(const v4u*)(XG + tok * DM + slice * 128 + c8 * 16); xb = *(const v4u*)(XG + tok * DM + slice * 128 + c8 * 16 + 8); }
            float dlo = 0.f, dhi = 0.f;
#pragma unroll
            for (int it = 0; it < 16; ++it) {
                f32x2 d = __builtin_amdgcn_cvt_pk_f32_fp8(w[it].x, false) * x[0]; d += __builtin_amdgcn_cvt_pk_f32_fp8(w[it].x, true) * x[1];
                d += __builtin_amdgcn_cvt_pk_f32_fp8(w[it].y, false) * x[2]; d += __builtin_amdgcn_cvt_pk_f32_fp8(w[it].y, true) * x[3];
                d += __builtin_amdgcn_cvt_pk_f32_fp8(w[it].z, false) * x[4]; d += __builtin_amdgcn_cvt_pk_f32_fp8(w[it].z, true) * x[5];
                d += __builtin_amdgcn_cvt_pk_f32_fp8(w[it].w, false) * x[6]; d += __builtin_amdgcn_cvt_pk_f32_fp8(w[it].w, true) * x[7];
                const float ds = sum8(d.x + d.y);
                if ((it & 7) == c8) { if (it < 8) dlo = ds; else dhi = ds; }
            }
            float* pp = PART + (ctok * 8 + slice) * 128;
            pp[c8 * 8 + rg] = dlo; pp[(c8 + 8) * 8 + rg] = dhi;
            LDS_WAIT();
        }
    }
}

__device__ __forceinline__ void peer_coef_phase(const Args& A, int lane, int wave, int vcu, int G) {
    const float* PART = (const float*)(A.ws + WS_PART); const float* GATE = (const float*)(A.ws + WS_GATE); const float* RSTD = (const float*)(A.ws + WS_RSTD);
    float* COEF = (float*)(A.ws + WS_COEF);
    for (int tok = vcu * NWAVES + wave; tok < NTOK; tok += G * NWAVES) {
        const float* pp = PART + (size_t)tok * 1024 + 2 * lane;
        f32x2 d = *(const f32x2*)pp;
#pragma unroll
        for (int j = 1; j < 8; ++j) d += *(const f32x2*)(pp + j * 128);
        const float sc = RSTD[tok] * (1.0f / PEER_SU); const f32x2 gt = *(const f32x2*)(GATE + (size_t)tok * 128 + 2 * lane);
        f32x2 cf; cf.x = gt.x * gelu_tanh(d.x * sc) * (1.0f / PEER_SV); cf.y = gt.y * gelu_tanh(d.y * sc) * (1.0f / PEER_SV);
        *(f32x2*)(COEF + (size_t)tok * 128 + 2 * lane) = cf;
    }
}

__device__ __forceinline__ void peer_v_phase(const Args& A, LAS unsigned char* lds, int tid, int lane, int wave, gu32* ctl) {
    const unsigned char* Vq = A.ws + WS_VB;
    const unsigned short* EIDX = (const unsigned short*)(A.ws + WS_EIDX); const float* COEF = (const float*)(A.ws + WS_COEF);
    float* X1 = A.out + O_Y; float* SS2 = (float*)(A.ws + WS_SS2);
    const int xcc = (int)(xb_xcc_id() & 7u), rg = lane >> 3, c8 = lane & 7;
    LAS int* we = (LAS int*)(lds + wave * 8192);
    LAS float* wc = (LAS float*)(we + 128); LAS float* wp = (LAS float*)(we + 256);
    int qs = 0, slice, item;
    while (peer_next_item(ctl + CW_QV, xcc, qs, slice, item, lds, tid)) {
        const unsigned char* vs = Vq + (size_t)slice * 16384 * 128 + c8 * 16;
        size_t tok = (size_t)(item * PEER_ITEM + wave);
        unsigned pair = *(const unsigned*)(EIDX + tok * 128 + 2 * lane); f32x2 cf = *(const f32x2*)(COEF + tok * 128 + 2 * lane);
        const bf16* XGv = (const bf16*)(A.ws + WS_A1);
        const f32x2 g2v = *(const f32x2*)(A.in[I_N2G] + slice * 128 + 2 * lane); const f32x2 rg2 = (f32x2){1.0f / g2v.x, 1.0f / g2v.y};
        unsigned xold = *(const unsigned*)(XGv + tok * DM + slice * 128 + 2 * lane);
        for (int tt = 0; tt < PEER_ITEM / NWAVES; ++tt) {
            we[2 * lane] = (int)(pair & 0xffffu); we[2 * lane + 1] = (int)(pair >> 16); *(LAS f32x2*)(wc + 2 * lane) = cf;
            const f32x2 xcur = (f32x2){bf_lo(xold) * rg2.x, bf_hi(xold) * rg2.y}; const size_t ctok = tok;
            LDS_WAIT();
            v4u w[16];
#pragma unroll
            for (int it = 0; it < 16; ++it) w[it] = *(const v4u*)(vs + (size_t)we[it * 8 + rg] * 128);
            if (tt + 1 < PEER_ITEM / NWAVES) { tok += NWAVES; pair = *(const unsigned*)(EIDX + tok * 128 + 2 * lane); cf = *(const f32x2*)(COEF + tok * 128 + 2 * lane);
                xold = *(const unsigned*)(XGv + tok * DM + slice * 128 + 2 * lane); }
            f32x2 o[8];
#pragma unroll
            for (int q = 0; q < 8; ++q) o[q] = (f32x2){0.f, 0.f};
#pragma unroll
            for (int it = 0; it < 16; ++it) {
                const float c = wc[it * 8 + rg]; const f32x2 c2 = (f32x2){c, c};
                o[0] += c2 * __builtin_amdgcn_cvt_pk_f32_fp8(w[it].x, false); o[1] += c2 * __builtin_amdgcn_cvt_pk_f32_fp8(w[it].x, true);
                o[2] += c2 * __builtin_amdgcn_cvt_pk_f32_fp8(w[it].y, false); o[3] += c2 * __builtin_amdgcn_cvt_pk_f32_fp8(w[it].y, true);
                o[4] += c2 * __builtin_amdgcn_cvt_pk_f32_fp8(w[it].z, false); o[5] += c2 * __builtin_amdgcn_cvt_pk_f32_fp8(w[it].z, true);
                o[6] += c2 * __builtin_amdgcn_cvt_pk_f32_fp8(w[it].w, false); o[7] += c2 * __builtin_amdgcn_cvt_pk_f32_fp8(w[it].w, true);
            }
#pragma unroll
            for (int q = 0; q < 4; ++q) *(LAS f32x4*)(wp + rg * 128 + c8 * 16 + 4 * q) = (f32x4){o[2 * q].x, o[2 * q].y, o[2 * q + 1].x, o[2 * q + 1].y};
            LDS_WAIT();
            f32x2 acc = *(const LAS f32x2*)(wp + 2 * lane);
#pragma unroll
            for (int r = 1; r < 8; ++r) acc += *(const LAS f32x2*)(wp + r * 128 + 2 * lane);
            const f32x2 x2 = xcur + acc;
            *(f32x2*)(X1 + ctok * DM + slice * 128 + 2 * lane) = x2;
            float ss = sum16(x2.x * x2.x + x2.y * x2.y); ss += __shfl_xor(ss, 16); ss += __shfl_xor(ss, 32);
            if (lane == 0) SS2[ctok * 8 + slice] = ss;
            LDS_WAIT();
        }
    }
}

__device__ __forceinline__ void peer_final_phase(const Args& A, int lane, int wave, int vcu, int G) {
    float* X1 = A.out + O_Y; const float* SS2 = (const float*)(A.ws + WS_SS2); const float* gf = A.in[I_NFG] + lane * 16;
    const f32x4 g0 = *(const f32x4*)gf, g1 = *(const f32x4*)(gf + 4), g2 = *(const f32x4*)(gf + 8), g3 = *(const f32x4*)(gf + 12);
    for (int tok = vcu * NWAVES + wave; tok < NTOK; tok += G * NWAVES) {
        const f32x4 sa = *(const f32x4*)(SS2 + (size_t)tok * 8), sb = *(const f32x4*)(SS2 + (size_t)tok * 8 + 4);
        const float ss = ((sa[0] + sa[1]) + (sa[2] + sa[3])) + ((sb[0] + sb[1]) + (sb[2] + sb[3]));
        const float rf = 1.0f / sqrtf(ss * (1.f / DM) + 1e-6f);
        float* yr = X1 + (size_t)tok * DM + lane * 16;
        const f32x4 y0 = *(const f32x4*)yr, y1 = *(const f32x4*)(yr + 4), y2 = *(const f32x4*)(yr + 8), y3 = *(const f32x4*)(yr + 12);
        *(f32x4*)yr = y0 * rf * g0; *(f32x4*)(yr + 4) = y1 * rf * g1; *(f32x4*)(yr + 8) = y2 * rf * g2; *(f32x4*)(yr + 12) = y3 * rf * g3;
    }
}

__device__ __forceinline__ void sg_partial(const bf16* Ap, int lda, const bf16* Bp, int ldb, LAS f32x4* red, int lane, int wave) {
    const int fr = lane & 15, fq = lane >> 4;
    bf16x8 a[2][4], b[4][4];
#pragma unroll
    for (int mi = 0; mi < 2; ++mi)
#pragma unroll
        for (int ks = 0; ks < 4; ++ks) a[mi][ks] = *(const bf16x8*)(Ap + (size_t)(16 * mi + fr) * lda + 32 * ks + 8 * fq);
#pragma unroll
    for (int nj = 0; nj < 4; ++nj)
#pragma unroll
        for (int ks = 0; ks < 4; ++ks) b[nj][ks] = *(const bf16x8*)(Bp + (size_t)(16 * nj + fr) * ldb + 32 * ks + 8 * fq);
    f32x4 acc[2][4];
#pragma unroll
    for (int mi = 0; mi < 2; ++mi)
#pragma unroll
        for (int nj = 0; nj < 4; ++nj) acc[mi][nj] = (f32x4){0.f, 0.f, 0.f, 0.f};
#pragma unroll
    for (int ks = 0; ks < 4; ++ks)
#pragma unroll
        for (int mi = 0; mi < 2; ++mi)
#pragma unroll
            for (int nj = 0; nj < 4; ++nj) acc[mi][nj] = __builtin_amdgcn_mfma_f32_16x16x32_bf16(b[nj][ks], a[mi][ks], acc[mi][nj], 0, 0, 0);
#pragma unroll
    for (int mi = 0; mi < 2; ++mi)
#pragma unroll
        for (int nj = 0; nj < 4; ++nj) red[(wave * 8 + mi * 4 + nj) * 64 + lane] = acc[mi][nj];
}
__device__ __forceinline__ f32x4 sg_sum(const LAS f32x4* red, int w0, int nw, int wave, int lane) {
    f32x4 s = red[(w0 * 8 + wave) * 64 + lane];
    for (int w = 1; w < nw; ++w) s += red[((w0 + w) * 8 + wave) * 64 + lane];
    return s;
}
__device__ __forceinline__ void sample_gemm2(const Args& A, LAS unsigned char* lds, int t, int lane, int wave) {
    unsigned char* ws = A.ws; const int fr = lane & 15, fq = lane >> 4;
    const int row0 = NPROMPT + (t >> 4) * 32, col0 = (t & 15) * 64;
    LAS f32x4* red = (LAS f32x4*)lds;
    const bf16* Ab = (const bf16*)(ws + WS_A1) + (wave >= 4 ? (size_t)MPAD * 512 : 0); const bf16* Bb = (const bf16*)(ws + (wave >= 4 ? WS_WPB : WS_WPA));
    sg_partial(Ab + (size_t)row0 * 512 + (wave & 3) * 128, 512, Bb + (size_t)col0 * 512 + (wave & 3) * 128, 512, red, lane, wave);
    const int row = row0 + 16 * (wave >> 2) + fr, c = col0 + 16 * (wave & 3) + 4 * fq;
    const bf16* Zg = (const bf16*)(ws + WS_ZG) + (size_t)row * 2048;
    const v2u ga = *(const v2u*)(Zg + c), gb = *(const v2u*)(Zg + 1024 + c);
    __syncthreads();
    const f32x4 pa = sg_sum(red, 0, 4, wave, lane), pb = sg_sum(red, 4, 4, wave, lane);
    const float o0 = sigm(bf_lo(ga.x)) * pa[0] + sigm(bf_lo(gb.x)) * pb[0], o1 = sigm(bf_hi(ga.x)) * pa[1] + sigm(bf_hi(gb.x)) * pb[1],
                o2 = sigm(bf_lo(ga.y)) * pa[2] + sigm(bf_lo(gb.y)) * pb[2], o3 = sigm(bf_hi(ga.y)) * pa[3] + sigm(bf_hi(gb.y)) * pb[3];
    v2u w; w.x = cvt_pk_bf16(o0, o1); w.y = cvt_pk_bf16(o2, o3); *(v2u*)((bf16*)(ws + WS_ZR) + (size_t)row * 1024 + c) = w;
    __syncthreads();
}
__device__ __forceinline__ void sample_gemm3(const Args& A, LAS unsigned char* lds, int t, int tid, int lane, int wave) {
    unsigned char* ws = A.ws; const int fr = lane & 15, fq = lane >> 4;
    const int row0 = NPROMPT + (t >> 4) * 32, col0 = (t & 15) * 64;
    LAS f32x4* red = (LAS f32x4*)lds; LAS float* ssl = (LAS float*)(lds + 65536);
    sg_partial((const bf16*)(ws + WS_ZR) + (size_t)row0 * 1024 + wave * 128, 1024, (const bf16*)(ws + WS_WO) + (size_t)col0 * 1024 + wave * 128, 1024, red, lane, wave);
    const int row = row0 + 16 * (wave >> 2) + fr, c = col0 + 16 * (wave & 3) + 4 * fq;
    const f32x4 xv = *(const f32x4*)(A.in[I_XS] + (size_t)(row - NPROMPT) * 1024 + c), q = *(const f32x4*)(A.in[I_N2G] + c);
    __syncthreads();
    const f32x4 o = xv + sg_sum(red, 0, 8, wave, lane);
    float ss = (o[0] * o[0] + o[1] * o[1]) + (o[2] * o[2] + o[3] * o[3]);
    v2u w; w.x = cvt_pk_bf16(o[0] * q[0], o[1] * q[1]); w.y = cvt_pk_bf16(o[2] * q[2], o[3] * q[3]); *(v2u*)((bf16*)(ws + WS_A1) + (size_t)row * 1024 + c) = w;
    ss += __shfl_xor(ss, 16); ss += __shfl_xor(ss, 32);
    if (fq == 0) ssl[wave * 16 + fr] = ss;
    __syncthreads();
    if (tid < 32) { const int mi = tid >> 4, r = tid & 15;
        ((float*)(ws + WS_SSP))[(size_t)(row0 + tid) * 16 + (t & 15)] = (ssl[(mi * 4 + 0) * 16 + r] + ssl[(mi * 4 + 1) * 16 + r]) + (ssl[(mi * 4 + 2) * 16 + r] + ssl[(mi * 4 + 3) * 16 + r]); }
}
__device__ __forceinline__ void sample_gemm4(const Args& A, LAS unsigned char* lds, int t, int lane, int wave) {
    unsigned char* ws = A.ws; const int fr = lane & 15, fq = lane >> 4;
    const int row0 = NPROMPT + (t >> 5) * 32, col0 = (t & 31) * 64;
    LAS f32x4* red = (LAS f32x4*)lds;
    sg_partial((const bf16*)(ws + WS_A1) + (size_t)row0 * 1024 + wave * 128, 1024, (const bf16*)(ws + WS_WQ) + (size_t)col0 * 1024 + wave * 128, 1024, red, lane, wave);
    const int row = row0 + 16 * (wave >> 2) + fr, c = col0 + 16 * (wave & 3) + 4 * fq;
    __syncthreads();
    const f32x4 o = sg_sum(red, 0, 8, wave, lane);
    v2u w; w.x = cvt_pk_bf16(o[0], o[1]); w.y = cvt_pk_bf16(o[2], o[3]); *(v2u*)((bf16*)(ws + WS_ZG) + (size_t)row * 2048 + c) = w;
    __syncthreads();
}

__global__ void __launch_bounds__(NTHR, 2) mk_fwd(Args args) {
    extern __shared__ __attribute__((aligned(16))) unsigned char lds_raw[];
    LAS unsigned char* lds = (LAS unsigned char*)lds_raw;
    const int tid = threadIdx.x, lane = tid & 63, wave = __builtin_amdgcn_readfirstlane(tid >> 6);
    const int G = gridDim.x; const int bx = blockIdx.x; const int vcu = (G % 8 == 0) ? (bx % 8) * (G / 8) + bx / 8 : bx;
    gu32* ctl = (gu32*)(args.ws + WS_CTL);
    volatile LAS unsigned* MISC = (volatile LAS unsigned*)(lds + MISC_OFF);
    for (int u = tid; u < (LDS_BYTES - LDSCTL_OFF) / 4; u += NTHR) ((LAS unsigned*)(lds + LDSCTL_OFF))[u] = 0u;
    __syncthreads();
    XcdBarrier bar; bar.bar = (unsigned*)(ctl + CW_BAR) + args.li * XCD_BAR_WORDS; bar.x = 0; bar.st = nullptr;
    if (N_LAUNCHES != PER_PHASE) bar = xcd_barrier_post((unsigned*)(ctl + CW_BAR) + args.li * XCD_BAR_WORDS, MISC + 8);
    const int lo = args.ph_lo, hi = args.ph_hi;
#define IN(k) (lo <= (k) && (k) < hi)
#define BOTH(k) (IN(k) && IN((k) + 1))
#define GRID_BAR() do { if (N_LAUNCHES != PER_PHASE) xcd_barrier(bar); } while (0)
    unsigned char* ws = args.ws;
    bf16* A1 = (bf16*)(ws + WS_A1);

    if (IN(0)) for (int rep_ = 0; rep_ < ((MK_REPEAT == 0) ? 2 : 1); ++rep_) { p0_prologue(args, lds, tid, lane, wave, vcu, G); if (BOTH(0)) GRID_BAR(); }

    if (IN(1)) for (int rep_ = 0; rep_ < ((MK_REPEAT == 1) ? 2 : 1); ++rep_) {
        pg8::Gemm g{A1, (const bf16*)(ws + WS_W1T), MPAD, N1, DM}; pg8::StaticOrder S; S.init(MPAD, N1, G, bx);
        pg8::EpiZ E{(bf16*)(ws + WS_ZC), (bf16*)(ws + WS_ZR), (bf16*)(ws + WS_ZG)};
        pg8::gemm_phase<pg8::EpiZ, pg8::StaticOrder, true, true>(lds, g, S, E);
        if (BOTH(1)) GRID_BAR();
    }

    if (IN(2)) for (int rep_ = 0; rep_ < ((MK_REPEAT == 2) ? 2 : 1); ++rep_) { conv_phase(args, vcu * NTHR + tid, G * NTHR); if (BOTH(2)) GRID_BAR(); }

    if (IN(3)) for (int rep_ = 0; rep_ < ((MK_REPEAT == 3) ? 2 : 1); ++rep_) {
        scan_pass1(args, lds, tid, lane, wave, vcu, G, (MK_REPEAT == 3 && rep_ == 0) ? 1 : 0);
        if (BOTH(3)) GRID_BAR();
    }

    if (IN(4)) {
        for (int u = vcu; u < 512; u += G) {
            if (u < 256) { const int bh = u >> 2, vq = u & 3; scan_pass2_rows(nullptr, bh * 64, 64, vq * 16, args.out + O_WKV_P + (size_t)bh * 4096, true, args, lds, tid, lane, wave); }
            else { const int bh = u - 256;
                for (int vq = 0; vq < 4; ++vq) scan_pass2_rows(args.in[I_SWKV] + (size_t)bh * 4096, NUNITS_P + bh, 1, vq * 16, args.out + O_WKV_S + (size_t)bh * 4096, false, args, lds, tid, lane, wave); }
        }
        if (BOTH(4)) GRID_BAR();
    }

    if (IN(5)) for (int rep_ = 0; rep_ < ((MK_REPEAT == 5) ? 2 : 1); ++rep_) {
        for (int u2 = vcu; u2 < NUNITS / 2; u2 += G) scan_pass3_wave(args, u2 * 2 + (wave >> 2), wave & 3, lane);
        if (BOTH(5)) GRID_BAR();
    }

    if (IN(6)) {
        { pg8::Gemm g{A1, (const bf16*)(ws + WS_WPA), NPROMPT, DM, 512}; pg8::StaticOrder S; S.init(NPROMPT, DM, G, bx);
          pg8::EpiGate<0> E{(const bf16*)(ws + WS_ZG), (bf16*)(ws + WS_ZR)};
          pg8::gemm_phase<pg8::EpiGate<0>, pg8::StaticOrder, true, true>(lds, g, S, E); }
        { pg8::Gemm g{A1 + (size_t)MPAD * 512, (const bf16*)(ws + WS_WPB), NPROMPT, DM, 512}; pg8::StaticOrder S; S.init(NPROMPT, DM, G, bx);
          pg8::EpiGate<1> E{(const bf16*)(ws + WS_ZG), (bf16*)(ws + WS_ZR)};
          pg8::gemm_phase<pg8::EpiGate<1>, pg8::StaticOrder, true, true>(lds, g, S, E); }
        for (int t = vcu; t < 256; t += G) sample_gemm2(args, lds, t, lane, wave);
        if (BOTH(6)) GRID_BAR();
    }

    if (IN(7)) for (int rep_ = 0; rep_ < ((MK_REPEAT == 7) ? 2 : 1); ++rep_) {
        pg8::Gemm g{(const bf16*)(ws + WS_ZR), (const bf16*)(ws + WS_WO), NPROMPT, DM, DM}; pg8::StaticOrder S; S.init(NPROMPT, DM, G, bx);
        pg8::EpiX1 E{args.in[I_XP], args.in[I_XS], args.out + O_Y, A1, (float*)(ws + WS_SSP), args.in[I_N2G], NPROMPT, NTOK};
        pg8::gemm_phase<pg8::EpiX1, pg8::StaticOrder, true, true>(lds, g, S, E);
        for (int t = vcu; t < 256; t += G) sample_gemm3(args, lds, t, tid, lane, wave);
        if (BOTH(7)) GRID_BAR();
    }

    if (IN(8)) for (int rep_ = 0; rep_ < ((MK_REPEAT == 8) ? 2 : 1); ++rep_) {
        pg8::Gemm g{A1, (const bf16*)(ws + WS_WQ), NPROMPT, 2048, DM}; pg8::StaticOrder S; S.init(NPROMPT, 2048, G, bx);
        pg8::EpiPlain E{(bf16*)(ws + WS_ZG), 2048};
        pg8::gemm_phase<pg8::EpiPlain, pg8::StaticOrder, true, true>(lds, g, S, E);
        for (int t = vcu; t < 512; t += G) sample_gemm4(args, lds, t, lane, wave);
        if (BOTH(8)) GRID_BAR();
    }

    if (IN(9)) for (int rep_ = 0; rep_ < ((MK_REPEAT == 9) ? 2 : 1); ++rep_) { peer_topk_phase(args, lds, tid, lane, wave, vcu, G); if (BOTH(9)) GRID_BAR(); }
    if (IN(10)) for (int rep_ = 0; rep_ < ((MK_REPEAT == 10) ? 2 : 1); ++rep_) { if (rep_ == 0) peer_topk_sample_prelude(args, lds, tid, lane, wave, vcu, G, ctl); peer_u_phase(args, lds, tid, lane, wave, ctl, rep_ * 1024); if (BOTH(10)) GRID_BAR(); }
    if (IN(11)) { peer_coef_phase(args, lane, wave, vcu, G); if (BOTH(11)) GRID_BAR(); }
    if (IN(12)) { peer_v_phase(args, lds, tid, lane, wave, ctl); if (BOTH(12)) GRID_BAR(); }
    if (IN(13)) peer_final_phase(args, lane, wave, vcu, G);
#undef IN
#undef BOTH
#undef GRID_BAR
}

extern "C" void kernel_launch(void* const* d_in, const int* in_sizes, int n_in, void* d_out, int out_size, void* d_ws, size_t ws_size, hipStream_t stream) {
    static int grid = 0;
    if (grid == 0) {
        if (n_in != 32 || ws_size < WS_END) { fprintf(stderr, "kernel_launch: built for 32 inputs and >= %zu bytes of workspace; got n_in %d ws %zu; nothing launched\n", (size_t)WS_END, n_in, ws_size); grid = -1; return; }
        int dev = 0, cus = 0, per_cu = 0;
        if (hipGetDevice(&dev) != hipSuccess || hipDeviceGetAttribute(&cus, hipDeviceAttributeMultiprocessorCount, dev) != hipSuccess) { fprintf(stderr, "kernel_launch: device query failed\n"); grid = -1; return; }
        if (hipFuncSetAttribute((const void*)mk_fwd, hipFuncAttributeMaxDynamicSharedMemorySize, LDS_BYTES) != hipSuccess) { fprintf(stderr, "kernel_launch: hipFuncSetAttribute failed\n"); grid = -1; return; }
        if (hipOccupancyMaxActiveBlocksPerMultiprocessor(&per_cu, (const void*)mk_fwd, NTHR, LDS_BYTES) != hipSuccess || per_cu < 1)
            fprintf(stderr, "kernel_launch: note: occupancy query reports %d workgroups per CU\n", per_cu);
        (void)hipGetLastError();
        grid = cus;
    }
    if (grid < 0) return;
    if (hipMemsetAsync((char*)d_ws + WS_CTL, 0, CTL_ZERO_BYTES, stream) != hipSuccess) { fprintf(stderr, "kernel_launch: hipMemsetAsync failed\n"); return; }
    Args a{};
    for (int i = 0; i < 32; ++i) a.in[i] = (const float*)d_in[i];
    a.out = (float*)d_out; a.ws = (unsigned char*)d_ws;
    constexpr int NL = (N_LAUNCHES == PER_PHASE ? PER_PHASE : 1) + ((MK_EXTRA_LO >= 0) ? 1 : 0);
    for (int li = 0; li < NL; ++li) {
        if (N_LAUNCHES == PER_PHASE) { a.ph_lo = li; a.ph_hi = li + 1; } else { a.ph_lo = 0; a.ph_hi = PER_PHASE; }
        if (MK_EXTRA_LO >= 0 && li == NL - 1) { a.ph_lo = MK_EXTRA_LO; a.ph_hi = MK_EXTRA_HI; }
        a.li = li;
        hipLaunchKernelGGL(mk_fwd, dim3(grid), dim3(NTHR), LDS_BYTES, stream, a);
        const hipError_t le = hipPeekAtLastError();
        if (le != hipSuccess) { fprintf(stderr, "kernel_launch: launch %d failed: %s\n", li, hipGetErrorName(le)); break; }
    }
}
```

```cpp
#include <hip/hip_runtime.h>
#include <cstdio>
#include <cstdint>
#define MK_N_LAUNCHES 1
#define MK_REPEAT -1
#define MK_DBGSEL 0
#define MK_EXTRA_LO -1
#define MK_EXTRA_HI -1
namespace pg8 {
#define PG8_LAS __attribute__((address_space(3)))
typedef unsigned short bf16_t;
typedef short bf16x8 __attribute__((ext_vector_type(8)));
typedef float f32x4 __attribute__((ext_vector_type(4)));
typedef unsigned u32x4 __attribute__((ext_vector_type(4)));
constexpr int BM = 256, BK = 64, HALF = 128, HTB = HALF * BK * 2  , STAGE_BYTES = 8 * HTB, NXCD = 8, WGM = 8;

__host__ __device__ __forceinline__ int lds_byte(int r, int c) { const int st = (r >> 4) * 2 + (c >> 5), rr = r & 15, cc = c & 31, ob = rr * 64 + cc * 2; return st * 1024 + (ob ^ (((ob >> 9) & 1) << 5)); }
__host__ __device__ __forceinline__ void stage_rc(int b, int& R, int& C) { const int st = b / 1024, sb = b % 1024, swz = sb ^ (((sb >> 9) & 1) << 5); R = (st >> 1) * 16 + swz / 64; C = (st & 1) * 32 + (swz % 64) / 2; }
__host__ __device__ __forceinline__ int perm32(int rho) { const int n = rho >> 4, i = rho & 15; return 8 * (i >> 2) + 4 * n + (i & 3); }

struct Unit { int pm, pn; };
struct Gemm { const bf16_t* A; const bf16_t* Bt; int M, N, K; };

struct StaticOrder {
    int nM, nN, nwg, G, c;
    __host__ __device__ void init(int M, int N, int G_, int c_) { nM = M / BM; nN = N / BM; nwg = nM * nN; G = G_; c = c_; }
    __host__ __device__ bool next(int i, Unit& u) const {
        const long L = (long)i * G + c; if (L >= nwg) return false;
        int wgid = (int)L; { const int q = nwg / NXCD, r = nwg % NXCD, xcd = wgid % NXCD, off = wgid / NXCD; wgid = (xcd < r ? xcd * (q + 1) : r * (q + 1) + (xcd - r) * q) + off; }
        const int nig = WGM * nN, gid = wgid / nig, fm = gid * WGM, gsz = (nM - fm) < WGM ? (nM - fm) : WGM;
        u.pm = fm + ((wgid % nig) % gsz); u.pn = (wgid % nig) / gsz; return true;
    }
    __device__ __forceinline__ void a_ready(const Unit&) const {}
    __device__ __forceinline__ void done(const Unit&) const {}
};

typedef __bf16 bf16x2_cv __attribute__((ext_vector_type(2))); typedef float f32x2_cv __attribute__((ext_vector_type(2)));
__device__ __forceinline__ unsigned cvt_pk_bf16(float lo, float hi) { return __builtin_bit_cast(unsigned, __builtin_convertvector((f32x2_cv){lo, hi}, bf16x2_cv)); }
__device__ __forceinline__ float bf_lo(unsigned w) { return __uint_as_float(w << 16); }
__device__ __forceinline__ float bf_hi(unsigned w) { return __uint_as_float(w & 0xffff0000u); }
__device__ __forceinline__ float sigm(float x) { return __builtin_amdgcn_rcpf(1.0f + __expf(-x)); }

struct EpiZ {
    static constexpr bool PERM = true, AFTER_DRAIN = false;
    bf16_t *Zc, *Zr, *Zg;
    __device__ __forceinline__ void operator()(const f32x4 (&acc)[2][2][4][2], const Unit& u, int wr, int wc, int fr, int fq) const {
        bf16_t* base; int ldc, colt;
        if (u.pn < 6) { base = Zc; ldc = 1536; colt = u.pn * BM; }
        else if (u.pn < 14) { base = Zr; ldc = 2048; colt = (u.pn - 6) * BM; }
        else { base = Zg; ldc = 2048; colt = (u.pn - 14) * BM; }
        const int row0 = u.pm * BM + wr * 64 + fr, col0 = colt + wc * 32 + 8 * fq;
#pragma unroll
        for (int ai = 0; ai < 2; ++ai)
#pragma unroll
            for (int m = 0; m < 4; ++m) { bf16_t* rowp = base + (size_t)(row0 + ai * HALF + m * 16) * ldc + col0;
#pragma unroll
                for (int bj = 0; bj < 2; ++bj) { const f32x4 v0 = acc[ai][bj][m][0], v1 = acc[ai][bj][m][1];
                    u32x4 w; w.x = cvt_pk_bf16(v0[0], v0[1]); w.y = cvt_pk_bf16(v0[2], v0[3]); w.z = cvt_pk_bf16(v1[0], v1[1]); w.w = cvt_pk_bf16(v1[2], v1[3]);
                    *(u32x4*)(rowp + bj * HALF) = w; } }
    }
};
struct EpiPlain {
    static constexpr bool PERM = true, AFTER_DRAIN = false;
    bf16_t* O; int ldc;
    __device__ __forceinline__ void operator()(const f32x4 (&acc)[2][2][4][2], const Unit& u, int wr, int wc, int fr, int fq) const {
        const int row0 = u.pm * BM + wr * 64 + fr, col0 = u.pn * BM + wc * 32 + 8 * fq;
#pragma unroll
        for (int ai = 0; ai < 2; ++ai)
#pragma unroll
            for (int m = 0; m < 4; ++m) { bf16_t* rowp = O + (size_t)(row0 + ai * HALF + m * 16) * ldc + col0;
#pragma unroll
                for (int bj = 0; bj < 2; ++bj) { const f32x4 v0 = acc[ai][bj][m][0], v1 = acc[ai][bj][m][1];
                    u32x4 w; w.x = cvt_pk_bf16(v0[0], v0[1]); w.y = cvt_pk_bf16(v0[2], v0[3]); w.z = cvt_pk_bf16(v1[0], v1[1]); w.w = cvt_pk_bf16(v1[2], v1[3]);
                    *(u32x4*)(rowp + bj * HALF) = w; } }
    }
};
template <int SECOND> struct EpiGate {
    static constexpr bool PERM = true, AFTER_DRAIN = false;
    const bf16_t* Zg; bf16_t* MG;
    __device__ __forceinline__ void operator()(const f32x4 (&acc)[2][2][4][2], const Unit& u, int wr, int wc, int fr, int fq) const {
        const int row0 = u.pm * BM + wr * 64 + fr, col0 = u.pn * BM + wc * 32 + 8 * fq;
#pragma unroll
        for (int ai = 0; ai < 2; ++ai) {
            u32x4 gw[4][2], pw[4][2];
#pragma unroll
            for (int m = 0; m < 4; ++m) { const int r = row0 + ai * HALF + m * 16;
#pragma unroll
                for (int bj = 0; bj < 2; ++bj) { gw[m][bj] = *(const u32x4*)(Zg + (size_t)r * 2048 + SECOND * 1024 + col0 + bj * HALF);
                    if (SECOND) pw[m][bj] = *(const u32x4*)(MG + (size_t)r * 1024 + col0 + bj * HALF); } }
#pragma unroll
            for (int m = 0; m < 4; ++m) { const int r = row0 + ai * HALF + m * 16; bf16_t* op = MG + (size_t)r * 1024 + col0;
#pragma unroll
                for (int bj = 0; bj < 2; ++bj) { const u32x4 g = gw[m][bj]; f32x4 v0 = acc[ai][bj][m][0], v1 = acc[ai][bj][m][1];
                    v0[0] *= sigm(bf_lo(g.x)); v0[1] *= sigm(bf_hi(g.x)); v0[2] *= sigm(bf_lo(g.y)); v0[3] *= sigm(bf_hi(g.y));
                    v1[0] *= sigm(bf_lo(g.z)); v1[1] *= sigm(bf_hi(g.z)); v1[2] *= sigm(bf_lo(g.w)); v1[3] *= sigm(bf_hi(g.w));
                    if (SECOND) { const u32x4 p = pw[m][bj];
                        v0[0] += bf_lo(p.x); v0[1] += bf_hi(p.x); v0[2] += bf_lo(p.y); v0[3] += bf_hi(p.y);
                        v1[0] += bf_lo(p.z); v1[1] += bf_hi(p.z); v1[2] += bf_lo(p.w); v1[3] += bf_hi(p.w); }
                    u32x4 w; w.x = cvt_pk_bf16(v0[0], v0[1]); w.y = cvt_pk_bf16(v0[2], v0[3]); w.z = cvt_pk_bf16(v1[0], v1[1]); w.w = cvt_pk_bf16(v1[2], v1[3]);
                    *(u32x4*)(op + bj * HALF) = w; } }
        }
    }
};
struct EpiX1 {
    static constexpr bool PERM = false, AFTER_DRAIN = false;
    const float* xp; const float* xs; float* X1; bf16_t* X1B; float* SSP; const float* g2; int nprompt, nrows;
    __device__ __forceinline__ void operator()(const f32x4 (&acc)[2][2][4][2], const Unit& u, int wr, int wc, int fr, int fq) const {
        typedef unsigned u32x2v __attribute__((ext_vector_type(2)));
        const int col0 = u.pn * BM + wc * 32 + 4 * fq;
        f32x4 gq[2][2];
#pragma unroll
        for (int bj = 0; bj < 2; ++bj)
#pragma unroll
            for (int n = 0; n < 2; ++n) gq[bj][n] = *(const f32x4*)(g2 + col0 + bj * HALF + n * 16);
#pragma unroll
        for (int ai = 0; ai < 2; ++ai) {
            f32x4 xv[4][2][2];
#pragma unroll
            for (int m = 0; m < 4; ++m) { int r = u.pm * BM + ai * HALF + wr * 64 + m * 16 + fr; r = r < nrows ? r : nrows - 1;
                const float* xr = r < nprompt ? xp + (size_t)r * 1024 : xs + (size_t)(r - nprompt) * 1024;
#pragma unroll
                for (int bj = 0; bj < 2; ++bj)
#pragma unroll
                    for (int n = 0; n < 2; ++n) xv[m][bj][n] = *(const f32x4*)(xr + col0 + bj * HALF + n * 16); }
#pragma unroll
            for (int m = 0; m < 4; ++m) { const int r = u.pm * BM + ai * HALF + wr * 64 + m * 16 + fr; float ss = 0.f;
#pragma unroll
                for (int bj = 0; bj < 2; ++bj)
#pragma unroll
                    for (int n = 0; n < 2; ++n) { const int c = col0 + bj * HALF + n * 16; const f32x4 o = xv[m][bj][n] + acc[ai][bj][m][n];
                        ss += (o[0] * o[0] + o[1] * o[1]) + (o[2] * o[2] + o[3] * o[3]);
                        const f32x4 q = gq[bj][n]; u32x2v w; w.x = cvt_pk_bf16(o[0] * q[0], o[1] * q[1]); w.y = cvt_pk_bf16(o[2] * q[2], o[3] * q[3]);
                        if (r < nrows) *(u32x2v*)(X1B + (size_t)r * 1024 + c) = w; }
                ss += __shfl_xor(ss, 16); ss += __shfl_xor(ss, 32);
                if (fq == 0 && r < nrows) SSP[(size_t)r * 16 + u.pn * 4 + wc] = ss;
            }
        }
    }
};
template <class Epi, class Sched, bool ALIGN_EPI = false, bool SP2 = false>
__device__ __forceinline__ void gemm_phase(PG8_LAS unsigned char* lds, const Gemm g, const Sched& S, const Epi& E) {
    const int tid = threadIdx.x, wid = __builtin_amdgcn_readfirstlane(tid >> 6), lane = tid & 63, wr = wid >> 2, wc = wid & 3, fr = lane & 15, fq = lane >> 4;
    const int K = g.K, nt = K / BK;
    unsigned voffA[2], voffB[2];
#pragma unroll
    for (int i = 0; i < 2; ++i) { int R, C; stage_rc(tid * 16 + i * 8192, R, C); const int Rb = Epi::PERM ? ((R & ~31) + perm32(R & 31)) : R;
        voffA[i] = (unsigned)(R * K + C) * 2u; voffB[i] = (unsigned)(Rb * K + C) * 2u; }
    const size_t kstep = (size_t)(BK * 2);
    const size_t hstep = (size_t)HALF * K * 2;
    const size_t tstep = 2 * hstep;
    const unsigned ldsw = (unsigned)wid * 1024u;
    const int aoff = lds_byte(wr * 64 + fr, fq * 8), boff = lds_byte(wc * 32 + fr, fq * 8);
#define PG8_SA(b, h) (((b) * 2 + (h)) * HTB)
#define PG8_SB(b, h) ((4 + (b) * 2 + (h)) * HTB)
#define PG8_STAGE(bufoff, gbase, voff) do { _Pragma("unroll") for (int _i = 0; _i < 2; ++_i) \
        __builtin_amdgcn_global_load_lds((const unsigned*)((const char*)(gbase) + (voff)[_i]), (PG8_LAS unsigned*)(lds + (bufoff) + ldsw + _i * 8192), 16, 0, 0); } while (0)
#define PG8_LDA(dst, b, h) do { _Pragma("unroll") for (int m = 0; m < 4; ++m) _Pragma("unroll") for (int k = 0; k < 2; ++k) dst[m][k] = *(const PG8_LAS bf16x8*)(lds + PG8_SA(b, h) + aoff + m * 2048 + k * 1024); } while (0)
#define PG8_LDB(dst, b, h) do { _Pragma("unroll") for (int n = 0; n < 2; ++n) _Pragma("unroll") for (int k = 0; k < 2; ++k) dst[n][k] = *(const PG8_LAS bf16x8*)(lds + PG8_SB(b, h) + boff + n * 2048 + k * 1024); } while (0)
#define PG8_MMA(ai, bj, At, Bt) do { __builtin_amdgcn_s_setprio(1); _Pragma("unroll") for (int m = 0; m < 4; ++m) _Pragma("unroll") for (int n = 0; n < 2; ++n) _Pragma("unroll") for (int k = 0; k < 2; ++k) \
        acc[ai][bj][m][n] = __builtin_amdgcn_mfma_f32_16x16x32_bf16(Bt[n][k], At[m][k], acc[ai][bj][m][n], 0, 0, 0); __builtin_amdgcn_s_setprio(0); } while (0)
#define PG8_WAIT_V(n) asm volatile("s_waitcnt vmcnt(" #n ")" ::: "memory")
#define PG8_WAIT_L(n) asm volatile("s_waitcnt lgkmcnt(" #n ")" ::: "memory")
#define PG8_BAR __builtin_amdgcn_s_barrier()
#define PG8_SCHED __builtin_amdgcn_sched_barrier(0)
    Unit cur, nxt; int ui = 0;
    if (!S.next(0, cur)) return;
    f32x4 acc[2][2][4][2];
#pragma unroll
    for (int a = 0; a < 2; ++a)
#pragma unroll
        for (int b = 0; b < 2; ++b)
#pragma unroll
            for (int m = 0; m < 4; ++m)
#pragma unroll
                for (int n = 0; n < 2; ++n) acc[a][b][m][n] = (f32x4){0.f, 0.f, 0.f, 0.f};
    bf16x8 At[4][2], B0[2][2], B1[2][2];
    const char* cA = (const char*)g.A + (size_t)cur.pm * tstep; const char* cB = (const char*)g.Bt + (size_t)cur.pn * tstep;
    S.a_ready(cur);
    if constexpr (SP2) {
        PG8_STAGE(PG8_SB(0, 0), cB, voffB); PG8_STAGE(PG8_SB(0, 1), cB + hstep, voffB); PG8_STAGE(PG8_SA(0, 0), cA, voffA); PG8_STAGE(PG8_SA(0, 1), cA + hstep, voffA);
        if (wr == 1) PG8_BAR;
        PG8_WAIT_V(2); PG8_BAR;
        PG8_STAGE(PG8_SB(1, 0), cB + kstep, voffB); PG8_STAGE(PG8_SA(1, 0), cA + kstep, voffA); PG8_STAGE(PG8_SB(1, 1), cB + hstep + kstep, voffB);
        PG8_WAIT_V(6); PG8_BAR;
    } else {
        PG8_STAGE(PG8_SB(0, 0), cB, voffB); PG8_STAGE(PG8_SA(0, 0), cA, voffA); PG8_STAGE(PG8_SB(0, 1), cB + hstep, voffB); PG8_STAGE(PG8_SA(0, 1), cA + hstep, voffA);
        if (wr == 1) PG8_BAR;
        PG8_WAIT_V(4); PG8_BAR;
        PG8_STAGE(PG8_SB(1, 0), cB + kstep, voffB); PG8_STAGE(PG8_SA(1, 0), cA + kstep, voffA); PG8_STAGE(PG8_SB(1, 1), cB + hstep + kstep, voffB);
        PG8_WAIT_V(6); PG8_BAR;
    }
    for (;;) {
        const bool has_next = S.next(ui + 1, nxt);
        const char* nA = has_next ? (const char*)g.A + (size_t)nxt.pm * tstep : cA; const char* nB = has_next ? (const char*)g.Bt + (size_t)nxt.pn * tstep : cB;
        for (int t = 0; t < nt; t += 2) {
            const bool last = (t == nt - 2);
            const char* a1 = cA + (size_t)(t + 1) * kstep;
            const char* a2 = last ? nA : cA + (size_t)(t + 2) * kstep; const char* b2 = last ? nB : cB + (size_t)(t + 2) * kstep;
            const char* a3 = a2 + kstep; const char* b3 = b2 + kstep;
            if (last && has_next) S.a_ready(nxt);
            if constexpr (SP2) {
            PG8_LDB(B0, 0, 0); PG8_LDB(B1, 0, 1); PG8_SCHED; PG8_LDA(At, 0, 0); PG8_STAGE(PG8_SA(1, 1), a1 + hstep, voffA);
            PG8_WAIT_V(8); PG8_WAIT_L(0); PG8_BAR; PG8_MMA(0, 0, At, B0); PG8_MMA(0, 1, At, B1); PG8_BAR; PG8_SCHED;
            PG8_LDA(At, 0, 1); PG8_STAGE(PG8_SB(0, 0), b2, voffB); PG8_STAGE(PG8_SB(0, 1), b2 + hstep, voffB); PG8_STAGE(PG8_SA(0, 0), a2, voffA);
            PG8_WAIT_V(8); PG8_WAIT_L(0); PG8_BAR; PG8_MMA(1, 0, At, B0); PG8_MMA(1, 1, At, B1); PG8_BAR; PG8_SCHED;
            PG8_LDB(B0, 1, 0); PG8_LDB(B1, 1, 1); PG8_SCHED; PG8_LDA(At, 1, 0); PG8_STAGE(PG8_SA(0, 1), a2 + hstep, voffA);
            PG8_WAIT_V(8); PG8_WAIT_L(0); PG8_BAR; PG8_MMA(0, 0, At, B0); PG8_MMA(0, 1, At, B1); PG8_BAR; PG8_SCHED;
            PG8_LDA(At, 1, 1); PG8_STAGE(PG8_SB(1, 0), b3, voffB); PG8_STAGE(PG8_SB(1, 1), b3 + hstep, voffB); PG8_STAGE(PG8_SA(1, 0), a3, voffA);
            PG8_WAIT_V(8); PG8_WAIT_L(0); PG8_BAR; PG8_MMA(1, 0, At, B0); PG8_MMA(1, 1, At, B1); PG8_BAR; PG8_SCHED;
            } else {
            PG8_LDB(B0, 0, 0); PG8_SCHED; PG8_LDA(At, 0, 0); PG8_STAGE(PG8_SA(1, 1), a1 + hstep, voffA);
            PG8_WAIT_L(8); PG8_BAR; PG8_WAIT_L(0); PG8_MMA(0, 0, At, B0); PG8_BAR; PG8_SCHED;
            PG8_LDB(B1, 0, 1); PG8_STAGE(PG8_SB(0, 0), b2, voffB);
            PG8_BAR; PG8_WAIT_L(0); PG8_MMA(0, 1, At, B1); PG8_BAR;
            PG8_LDA(At, 0, 1); PG8_STAGE(PG8_SA(0, 0), a2, voffA);
            PG8_BAR; PG8_WAIT_L(0); PG8_MMA(1, 0, At, B0); PG8_BAR; PG8_SCHED;
            PG8_STAGE(PG8_SB(0, 1), b2 + hstep, voffB);
            PG8_WAIT_V(6); PG8_BAR; PG8_MMA(1, 1, At, B1); PG8_BAR;
            PG8_LDB(B0, 1, 0); PG8_SCHED; PG8_LDA(At, 1, 0); PG8_STAGE(PG8_SA(0, 1), a2 + hstep, voffA);
            PG8_WAIT_L(8); PG8_BAR; PG8_WAIT_L(0); PG8_MMA(0, 0, At, B0); PG8_BAR; PG8_SCHED;
            PG8_LDB(B1, 1, 1); PG8_STAGE(PG8_SB(1, 0), b3, voffB);
            PG8_BAR; PG8_WAIT_L(0); PG8_MMA(0, 1, At, B1); PG8_BAR;
            PG8_LDA(At, 1, 1); PG8_STAGE(PG8_SA(1, 0), a3, voffA);
            PG8_BAR; PG8_WAIT_L(0); PG8_MMA(1, 0, At, B0); PG8_BAR; PG8_SCHED;
            PG8_STAGE(PG8_SB(1, 1), b3 + hstep, voffB);
            PG8_WAIT_V(6); PG8_BAR; PG8_MMA(1, 1, At, B1); PG8_BAR;
            }
        }
        if constexpr (ALIGN_EPI) { if (wr == 0) PG8_BAR; }
        if constexpr (!Epi::AFTER_DRAIN) { E(acc, cur, wr, wc, fr, fq); S.done(cur); }
        if (!has_next) break;
#pragma unroll
        for (int a = 0; a < 2; ++a)
#pragma unroll
            for (int b = 0; b < 2; ++b)
#pragma unroll
                for (int m = 0; m < 4; ++m)
#pragma unroll
                    for (int n = 0; n < 2; ++n) acc[a][b][m][n] = (f32x4){0.f, 0.f, 0.f, 0.f};
        cur = nxt; cA = nA; cB = nB; ++ui;
        if constexpr (ALIGN_EPI) { if (wr == 1) PG8_BAR; }
    }
    PG8_WAIT_V(0);
    if constexpr (!ALIGN_EPI) { if (wr == 0) PG8_BAR; }
    PG8_BAR;
    if constexpr (Epi::AFTER_DRAIN) { E.fused(acc, cur, wr, wc, fr, fq, lds, wid, lane); S.done(cur); }
#undef PG8_SA
#undef PG8_SB
#undef PG8_STAGE
#undef PG8_LDA
#undef PG8_LDB
#undef PG8_MMA
#undef PG8_WAIT_V
#undef PG8_WAIT_L
#undef PG8_BAR
#undef PG8_SCHED
}
}
constexpr int NWAVES = 8, NTHR = 512;
#ifndef MK_N_LAUNCHES
#define MK_N_LAUNCHES 1
#endif
constexpr int PER_PHASE = 14;
constexpr int N_LAUNCHES = MK_N_LAUNCHES;

constexpr int DM = 1024, NPROMPT = 32768, NSAMP = 512, NTOK = 33280, NSHIFT = 32, MPAD = 33536, N1 = 5632;
constexpr int SEQ_P = 4096, SEQ_S = 16, NB_P = 8, NB_S = 32;
constexpr size_t O_Y = 0, O_CONV_P = 34078720, O_SHIFT_P = 34086912, O_WKV_P = 34095104, O_CONV_S = 34357248, O_SHIFT_S = 34390016, O_WKV_S = 34422784;
constexpr size_t KiB = 1024, MiB = 1u << 20;
constexpr size_t WS_CTL = 0, CTL_ZERO_BYTES = 64 * KiB;
constexpr size_t WS_W1T = 64 * KiB;
constexpr size_t WS_WPA = WS_W1T + (size_t)N1 * DM * 2;
constexpr size_t WS_WPB = WS_WPA + 1 * MiB;
constexpr size_t WS_WO = WS_WPB + 1 * MiB;
constexpr size_t WS_WQ = WS_WO + 2 * MiB;
constexpr size_t WS_KEYS = WS_WQ + 4 * MiB;
constexpr size_t WS_L2T = WS_KEYS + 512 * KiB;
constexpr size_t WS_SSP = WS_L2T + 256 * KiB;
constexpr size_t WS_UB = WS_SSP + (size_t)MPAD * 16 * 4;
constexpr size_t WS_VB = WS_UB + 16 * MiB;
constexpr size_t WS_A1 = WS_VB + 16 * MiB;
constexpr size_t WS_ZC = WS_A1 + (size_t)MPAD * DM * 2;
constexpr size_t WS_ZR = WS_ZC + (size_t)MPAD * 1536 * 2;
constexpr size_t WS_ZG = WS_ZR + (size_t)MPAD * 2048 * 2;
constexpr size_t WS_END = WS_ZG + (size_t)MPAD * 2048 * 2;
constexpr size_t WS_YL = WS_ZC, WS_ZT = WS_ZC + (size_t)NTOK * 512 * 2, WS_BV = WS_ZC + (size_t)NTOK * 512 * 4;
constexpr size_t WS_EIDX = WS_ZC, WS_GATE = WS_ZC + 16 * MiB, WS_COEF = WS_ZC + 40 * MiB, WS_SS2 = WS_ZC + 64 * MiB, WS_RSTD = WS_ZC + 66 * MiB;
constexpr size_t WS_PART = WS_ZR;
constexpr size_t OB_MB = (size_t)4352 * 4096 * 4;
static_assert(WS_BV + (size_t)NTOK * 512 * 2 <= WS_ZR && OB_MB + (size_t)4352 * 4096 * 2 <= (size_t)NTOK * 1024 * 4, "scan scratch maps");
static_assert(WS_END <= 512 * MiB, "d_ws map must fit 512 MiB");
constexpr float PEER_SU = 32.0f, PEER_SV = 4.0f;
constexpr int CW_BAR = 1024;
constexpr int LDS_BYTES = 163840;
constexpr int LDSCTL_OFF = LDS_BYTES - 512, MISC_OFF = LDSCTL_OFF + 320;

#define GAS __attribute__((address_space(1)))
#define LAS __attribute__((address_space(3)))
typedef unsigned short bf16;
typedef unsigned v4u __attribute__((ext_vector_type(4)));
typedef unsigned v2u __attribute__((ext_vector_type(2)));
typedef float f32x4 __attribute__((ext_vector_type(4)));
typedef short bf16x8 __attribute__((ext_vector_type(8)));
typedef __bf16 bf16x2_t __attribute__((ext_vector_type(2)));
typedef GAS unsigned gu32;
#define RLX_AGENT __ATOMIC_RELAXED, __HIP_MEMORY_SCOPE_AGENT
#define LDS_WAIT() asm volatile("s_waitcnt lgkmcnt(0)" ::: "memory")
#define VM_WAIT() asm volatile("s_waitcnt vmcnt(0)" ::: "memory")
using pg8::cvt_pk_bf16; using pg8::bf_lo; using pg8::bf_hi; using pg8::sigm;
#define XB_TMO      128
#define XB_XCNT(j)  (256  + 64 * (j))
#define XB_XSUB(j)  (1280 + 64 * (j))
#define XB_XGEN(j)  (2304 + 64 * (j))
#define XB_TOP      3328
#define XB_TOPGEN   3392
#define XCD_BAR_WORDS 3456
#define XB_SPIN_CAP (1u << 22)

__device__ __forceinline__ unsigned xb_ld(unsigned* p)              { return __hip_atomic_load(p, __ATOMIC_RELAXED, __HIP_MEMORY_SCOPE_AGENT); }
__device__ __forceinline__ unsigned xb_add(unsigned* p, unsigned v) { return __hip_atomic_fetch_add(p, v, __ATOMIC_RELAXED, __HIP_MEMORY_SCOPE_AGENT); }
__device__ __forceinline__ unsigned xb_xcc_id() { return (unsigned)__builtin_amdgcn_s_getreg((3 << 11) | 20) & 0xFu; }
#define XB_SPIN(cond, bar) do { unsigned _sp = 0; while (cond) { __builtin_amdgcn_s_sleep(1); \
    if ((++_sp & 255u) == 0u) { if (xb_ld(&(bar)[XB_TMO])) break; if (_sp > XB_SPIN_CAP) { atomicAdd(&(bar)[XB_TMO], 1u); break; } } } } while (0)

struct XcdBarrier {
    unsigned* bar; unsigned x;
    volatile LAS unsigned* st;
};

__device__ __forceinline__ XcdBarrier xcd_barrier_post(unsigned* bar, volatile LAS unsigned* st) {
    XcdBarrier b; b.bar = bar; b.x = xb_xcc_id(); b.st = st;
    if (threadIdx.x == 0) (void)xb_add(&bar[XB_XCNT(b.x)], 1u);
    return b;
}
__device__ __forceinline__ void xcd_barrier_complete(unsigned* bar, unsigned x, unsigned& nloc, unsigned& nx) {
    const unsigned G = gridDim.x * gridDim.y * gridDim.z;
    unsigned sum, cnt, mine, sp = 0u;
    for (;;) {
        sum = 0u; cnt = 0u; mine = 0u;
#pragma unroll
        for (unsigned j = 0; j < 16; ++j) { const unsigned c = xb_ld(&bar[XB_XCNT(j)]); sum += c; cnt += (c > 0u) ? 1u : 0u; mine = (j == x) ? c : mine; }
        if (sum == G) break;
        __builtin_amdgcn_s_sleep(1);
        if ((++sp & 255u) == 0u) { if (xb_ld(&bar[XB_TMO])) break; if (sp > XB_SPIN_CAP) { atomicAdd(&bar[XB_TMO], 1u); break; } }
    }
    nloc = mine > 0u ? mine : 1u; nx = cnt > 0u ? cnt : 1u;
}

__device__ __forceinline__ void xcd_barrier(const XcdBarrier& b) {
    asm volatile("s_waitcnt vmcnt(0)" ::: "memory");
    __syncthreads();
    if (threadIdx.x == 0) {
        unsigned* bar = b.bar;
        __builtin_amdgcn_s_waitcnt(0);
        unsigned nloc = b.st[0], nx = b.st[1];
        if (nloc == 0u) { xcd_barrier_complete(bar, b.x, nloc, nx); b.st[0] = nloc; b.st[1] = nx; }
        const unsigned old = xb_add(&bar[XB_XSUB(b.x)], 1u);
        const unsigned gen = old / nloc;
        if (old + 1u == (gen + 1u) * nloc) {
            __builtin_amdgcn_fence(__ATOMIC_RELEASE, "agent");
            asm volatile("s_waitcnt vmcnt(0)" ::: "memory");
            const unsigned og = xb_add(&bar[XB_TOP], 1u);
            const unsigned tg = og / nx;
            if (og + 1u == (tg + 1u) * nx) xb_add(&bar[XB_TOPGEN], 1u);
            else XB_SPIN(xb_ld(&bar[XB_TOPGEN]) == tg, bar);
            __builtin_amdgcn_fence(__ATOMIC_ACQUIRE, "agent");
            xb_add(&bar[XB_XGEN(b.x)], 1u);
            asm volatile("s_waitcnt vmcnt(0)" ::: "memory");
        } else {
            XB_SPIN(xb_ld(&bar[XB_XGEN(b.x)]) == gen, bar);
            __builtin_amdgcn_fence(__ATOMIC_ACQUIRE, "agent");
            asm volatile("s_waitcnt vmcnt(0)" ::: "memory");
        }
    }
    __syncthreads();
}
struct Args { const float* in[32]; float* out; unsigned char* ws; int ph_lo, ph_hi, li, pad; };
enum { I_XP = 0, I_XS, I_SCONV, I_SSHIFT, I_SWKV, I_N1G, I_WIN, I_CONVW, I_MURKV, I_MUWAG, I_W0, I_W1, I_W2, I_A0, I_A1, I_A2, I_G1, I_G2, I_KK, I_KA, I_RK, I_GNW, I_GNB, I_WPA, I_WPB, I_WO, I_N2G, I_WQ, I_KEYS, I_U, I_V, I_NFG };

__device__ __forceinline__ float wave_sum(float v) {
#pragma unroll
    for (int o = 1; o < 64; o <<= 1) v += __shfl_xor(v, o);
    return v;
}
template <int CTRL> __device__ __forceinline__ float dpp_mov(float v) { return __builtin_bit_cast(float, __builtin_amdgcn_update_dpp(0, __builtin_bit_cast(int, v), CTRL, 0xF, 0xF, true)); }
__device__ __forceinline__ float sum4(float v) { v += dpp_mov<0xB1>(v); v += dpp_mov<0x4E>(v); return v; }
__device__ __forceinline__ float sum8(float v) { v = sum4(v); v += dpp_mov<0x141>(v); return v; }
__device__ __forceinline__ float sum16(float v) { v = sum8(v); v += dpp_mov<0x140>(v); return v; }
__device__ __forceinline__ float dot2bf(unsigned w, unsigned x, float acc) { return __builtin_amdgcn_fdot2_f32_bf16(__builtin_bit_cast(bf16x2_t, w), __builtin_bit_cast(bf16x2_t, x), acc, false); }

__device__ __forceinline__ void transpose_item(const float* W, int ldw, int c0, int K, bf16* WT, int nblk, int item, const float* sv, float alpha, float beta, LAS float* scr, int lane) {
    const int kb = item / nblk, nb = item % nblk, k0 = 64 * kb, n0 = 32 * nb;
#pragma unroll 8
    for (int i = 0; i < 32; ++i) { const int kk = 2 * i + (lane >> 5); float s = 1.f; if (sv) s = alpha + beta * sv[k0 + kk];
        scr[kk * 33 + (lane & 31)] = W[(size_t)(k0 + kk) * ldw + c0 + n0 + (lane & 31)] * s; }
    LDS_WAIT();
    const int c = lane & 7;
#pragma unroll
    for (int j = 0; j < 4; ++j) { const int n = (lane >> 3) + 8 * j; const LAS float* s = scr + (8 * c) * 33 + n;
        v4u o; o.x = cvt_pk_bf16(s[0 * 33], s[1 * 33]); o.y = cvt_pk_bf16(s[2 * 33], s[3 * 33]); o.z = cvt_pk_bf16(s[4 * 33], s[5 * 33]); o.w = cvt_pk_bf16(s[6 * 33], s[7 * 33]);
        *(v4u*)(WT + (size_t)(n0 + n) * K + k0 + 8 * c) = o; }
    LDS_WAIT();
}
__device__ __forceinline__ void cvt_stream(const float* src, bf16* dst, size_t n, size_t gt, size_t nthreads) {
    for (size_t i = gt * 8; i < n; i += nthreads * 8) { const f32x4 a = *(const f32x4*)(src + i), b = *(const f32x4*)(src + i + 4);
        v4u o; o.x = cvt_pk_bf16(a[0], a[1]); o.y = cvt_pk_bf16(a[2], a[3]); o.z = cvt_pk_bf16(b[0], b[1]); o.w = cvt_pk_bf16(b[2], b[3]); *(v4u*)(dst + i) = o; }
}
__device__ __forceinline__ void cvt_stream_fp8(const float* src, unsigned char* dst, size_t n, float scale, size_t gt, size_t nthreads) {
    for (size_t i = gt * 16; i < n; i += nthreads * 16) {
        const f32x4 a = *(const f32x4*)(src + i) * scale, b = *(const f32x4*)(src + i + 4) * scale, c = *(const f32x4*)(src + i + 8) * scale, d = *(const f32x4*)(src + i + 12) * scale;
        v4u o; unsigned p;
        p = __builtin_amdgcn_cvt_pk_fp8_f32(a[0], a[1], 0, false); o.x = __builtin_amdgcn_cvt_pk_fp8_f32(a[2], a[3], p, true);
        p = __builtin_amdgcn_cvt_pk_fp8_f32(b[0], b[1], 0, false); o.y = __builtin_amdgcn_cvt_pk_fp8_f32(b[2], b[3], p, true);
        p = __builtin_amdgcn_cvt_pk_fp8_f32(c[0], c[1], 0, false); o.z = __builtin_amdgcn_cvt_pk_fp8_f32(c[2], c[3], p, true);
        p = __builtin_amdgcn_cvt_pk_fp8_f32(d[0], d[1], 0, false); o.w = __builtin_amdgcn_cvt_pk_fp8_f32(d[2], d[3], p, true);
        *(v4u*)(dst + i) = o; }
}
__device__ __forceinline__ void cvt16_fp8_sliced(const float* src, unsigned char* dst, float scale, size_t i) {
    const f32x4 a = *(const f32x4*)(src + i) * scale, b = *(const f32x4*)(src + i + 4) * scale, c = *(const f32x4*)(src + i + 8) * scale, d = *(const f32x4*)(src + i + 12) * scale;
    v4u o; unsigned p;
    p = __builtin_amdgcn_cvt_pk_fp8_f32(a[0], a[1], 0, false); o.x = __builtin_amdgcn_cvt_pk_fp8_f32(a[2], a[3], p, true);
    p = __builtin_amdgcn_cvt_pk_fp8_f32(b[0], b[1], 0, false); o.y = __builtin_amdgcn_cvt_pk_fp8_f32(b[2], b[3], p, true);
    p = __builtin_amdgcn_cvt_pk_fp8_f32(c[0], c[1], 0, false); o.z = __builtin_amdgcn_cvt_pk_fp8_f32(c[2], c[3], p, true);
    p = __builtin_amdgcn_cvt_pk_fp8_f32(d[0], d[1], 0, false); o.w = __builtin_amdgcn_cvt_pk_fp8_f32(d[2], d[3], p, true);
    const size_t e = i >> 10, col = i & 1023;
    *(v4u*)(dst + (col >> 7) * ((size_t)16384 * 128) + e * 128 + (col & 127)) = o;
}
__device__ __forceinline__ void cvt_stream_fp8_sliced(const float* src, unsigned char* dst, float scale, size_t gt, size_t nthreads) {
#pragma unroll 2
    for (size_t i = gt * 16; i < (size_t)16384 * 1024; i += nthreads * 16) {
        const f32x4 a = *(const f32x4*)(src + i) * scale, b = *(const f32x4*)(src + i + 4) * scale, c = *(const f32x4*)(src + i + 8) * scale, d = *(const f32x4*)(src + i + 12) * scale;
        v4u o; unsigned p;
        p = __builtin_amdgcn_cvt_pk_fp8_f32(a[0], a[1], 0, false); o.x = __builtin_amdgcn_cvt_pk_fp8_f32(a[2], a[3], p, true);
        p = __builtin_amdgcn_cvt_pk_fp8_f32(b[0], b[1], 0, false); o.y = __builtin_amdgcn_cvt_pk_fp8_f32(b[2], b[3], p, true);
        p = __builtin_amdgcn_cvt_pk_fp8_f32(c[0], c[1], 0, false); o.z = __builtin_amdgcn_cvt_pk_fp8_f32(c[2], c[3], p, true);
        p = __builtin_amdgcn_cvt_pk_fp8_f32(d[0], d[1], 0, false); o.w = __builtin_amdgcn_cvt_pk_fp8_f32(d[2], d[3], p, true);
        const size_t e = i >> 10, col = i & 1023;
        *(v4u*)(dst + (col >> 7) * ((size_t)16384 * 128) + e * 128 + (col & 127)) = o; }
}
__device__ __forceinline__ void p0_prologue(const Args& A, LAS unsigned char* lds, int tid, int lane, int wave, int vcu, int G) {
    unsigned char* ws = A.ws;
    bf16* W1T = (bf16*)(ws + WS_W1T);
    LAS float* scr = (LAS float*)(lds + wave * 16384);
    const int gw = vcu * NWAVES + wave, NGW = G * NWAVES;
    constexpr int J0 = 16 * 96, J1 = 16 * 64, JL = 16 * 2, JG = 16 * 4, JP = 8 * 32, JO = 16 * 32, JQ = 16 * 64;
    constexpr int JW2 = 16, JG2 = 32;
    constexpr int NITEMS = J0 + J1 + 4 * JL + 2 * JG + 2 * JP + JO + JQ + 2 * JW2 + JG2;
    bf16* L2T = (bf16*)(ws + WS_L2T);
    const float* mu = A.in[I_MUWAG];
    for (int it = gw; it < NITEMS; it += NGW) {
        int r = it;
        if (r < J0) { transpose_item(A.in[I_WIN], 5120, 0, 1024, W1T, 96, r, nullptr, 0.f, 0.f, scr, lane); continue; } r -= J0;
        if (r < J1) { transpose_item(A.in[I_WIN], 5120, 3072, 1024, W1T + (size_t)3584 * 1024, 64, r, nullptr, 0.f, 0.f, scr, lane); continue; } r -= J1;
        if (r < JL) { transpose_item(A.in[I_W1], 64, 0, 1024, W1T + (size_t)3072 * 1024, 2, r, mu, 1.f, -1.f, scr, lane); continue; } r -= JL;
        if (r < JL) { transpose_item(A.in[I_W1], 64, 0, 1024, W1T + (size_t)3328 * 1024, 2, r, mu, 0.f, 1.f, scr, lane); continue; } r -= JL;
        if (r < JL) { transpose_item(A.in[I_A1], 64, 0, 1024, W1T + (size_t)(3072 + 64) * 1024, 2, r, mu + 1024, 1.f, -1.f, scr, lane); continue; } r -= JL;
        if (r < JL) { transpose_item(A.in[I_A1], 64, 0, 1024, W1T + (size_t)(3328 + 64) * 1024, 2, r, mu + 1024, 0.f, 1.f, scr, lane); continue; } r -= JL;
        if (r < JG) { transpose_item(A.in[I_G1], 128, 0, 1024, W1T + (size_t)(3072 + 128) * 1024, 4, r, mu + 2048, 1.f, -1.f, scr, lane); continue; } r -= JG;
        if (r < JG) { transpose_item(A.in[I_G1], 128, 0, 1024, W1T + (size_t)(3328 + 128) * 1024, 4, r, mu + 2048, 0.f, 1.f, scr, lane); continue; } r -= JG;
        if (r < JP) { transpose_item(A.in[I_WPA], 1024, 0, 512, (bf16*)(ws + WS_WPA), 32, r, nullptr, 0.f, 0.f, scr, lane); continue; } r -= JP;
        if (r < JP) { transpose_item(A.in[I_WPB], 1024, 0, 512, (bf16*)(ws + WS_WPB), 32, r, nullptr, 0.f, 0.f, scr, lane); continue; } r -= JP;
        if (r < JO) { transpose_item(A.in[I_WO], 1024, 0, 1024, (bf16*)(ws + WS_WO), 32, r, nullptr, 0.f, 0.f, scr, lane); continue; } r -= JO;
        if (r < JQ) { transpose_item(A.in[I_WQ], 2048, 0, 1024, (bf16*)(ws + WS_WQ), 64, r, nullptr, 0.f, 0.f, scr, lane); continue; } r -= JQ;
        if (r < JW2) { transpose_item(A.in[I_W2], 512, 0, 64, L2T, 16, r, nullptr, 0.f, 0.f, scr, lane); continue; } r -= JW2;
        if (r < JW2) { transpose_item(A.in[I_A2], 512, 0, 64, L2T + (size_t)512 * 64, 16, r, nullptr, 0.f, 0.f, scr, lane); continue; } r -= JW2;
        transpose_item(A.in[I_G2], 512, 0, 128, L2T + (size_t)1024 * 64, 16, r, nullptr, 0.f, 0.f, scr, lane);
    }
    const size_t gt = (size_t)vcu * NTHR + tid, nth = (size_t)G * NTHR;
    if (G != 256) {
        cvt_stream_fp8_sliced(A.in[I_U], ws + WS_UB, PEER_SU, gt, nth);
        cvt_stream_fp8_sliced(A.in[I_V], ws + WS_VB, PEER_SV, gt, nth); }
    cvt_stream(A.in[I_KEYS], (bf16*)(ws + WS_KEYS), (size_t)8 * 2 * 128 * 128, gt, nth);
    bf16* A1 = (bf16*)(ws + WS_A1);
    const f32x4* g1v = (const f32x4*)A.in[I_N1G] + lane;
    for (int m0 = gw; m0 < NTOK; m0 += 2 * NGW) {
        const int m1 = m0 + NGW; const bool two = m1 < NTOK; const int m1c = two ? m1 : m0;
        const f32x4* xr0 = (const f32x4*)(m0 < NPROMPT ? A.in[I_XP] + (size_t)m0 * DM : A.in[I_XS] + (size_t)(m0 - NPROMPT) * DM) + lane;
        const f32x4* xr1 = (const f32x4*)(m1c < NPROMPT ? A.in[I_XP] + (size_t)m1c * DM : A.in[I_XS] + (size_t)(m1c - NPROMPT) * DM) + lane;
        f32x4 v0[4], v1[4]; float s0 = 0.f, s1 = 0.f;
#pragma unroll
        for (int j = 0; j < 4; ++j) { v0[j] = xr0[64 * j]; v1[j] = xr1[64 * j]; }
#pragma unroll
        for (int j = 0; j < 4; ++j) { s0 += (v0[j][0] * v0[j][0] + v0[j][1] * v0[j][1]) + (v0[j][2] * v0[j][2] + v0[j][3] * v0[j][3]);
                                      s1 += (v1[j][0] * v1[j][0] + v1[j][1] * v1[j][1]) + (v1[j][2] * v1[j][2] + v1[j][3] * v1[j][3]); }
#pragma unroll
        for (int o = 1; o < 64; o <<= 1) { s0 += __shfl_xor(s0, o); s1 += __shfl_xor(s1, o); }
        const float r0 = 1.0f / sqrtf(s0 * (1.f / DM) + 1e-6f), r1 = 1.0f / sqrtf(s1 * (1.f / DM) + 1e-6f);
#pragma unroll
        for (int rr = 0; rr < 2; ++rr) {
            if (rr == 1 && !two) break;
            const int m = rr ? m1 : m0; const float rstd = rr ? r1 : r0;
            v2u* o8 = (v2u*)(A1 + (size_t)m * DM) + lane;
            float* so = nullptr;
            if (m < NPROMPT) { if ((m & (SEQ_P - 1)) == SEQ_P - 1) so = A.out + O_SHIFT_P + (size_t)(m / SEQ_P) * DM; }
            else { const int ms = m - NPROMPT; if ((ms & (SEQ_S - 1)) == SEQ_S - 1) so = A.out + O_SHIFT_S + (size_t)(ms / SEQ_S) * DM; }
#pragma unroll
            for (int j = 0; j < 4; ++j) { const f32x4 g = g1v[64 * j]; const f32x4 y = (rr ? v1[j] : v0[j]) * rstd * g;
                v2u w; w.x = cvt_pk_bf16(y[0], y[1]); w.y = cvt_pk_bf16(y[2], y[3]); o8[64 * j] = w;
                if (so) ((f32x4*)so)[lane + 64 * j] = y; }
        }
    }
    for (int m = NTOK + gw; m < MPAD; m += NGW) {
        v2u* o8 = (v2u*)(A1 + (size_t)m * DM) + lane;
        if (m < NTOK + NSHIFT) {
            const f32x4* xr = (const f32x4*)(A.in[I_SSHIFT] + (size_t)(m - NTOK) * DM) + lane;
#pragma unroll
            for (int j = 0; j < 4; ++j) { const f32x4 y = xr[64 * j]; v2u w; w.x = cvt_pk_bf16(y[0], y[1]); w.y = cvt_pk_bf16(y[2], y[3]); o8[64 * j] = w; }
        } else {
#pragma unroll
            for (int j = 0; j < 4; ++j) { v2u w; w.x = 0u; w.y = 0u; o8[64 * j] = w; }
        }
    }
}

__device__ __forceinline__ void unpack8(const v4u w, float (&f)[8]) { f[0] = bf_lo(w.x); f[1] = bf_hi(w.x); f[2] = bf_lo(w.y); f[3] = bf_hi(w.y); f[4] = bf_lo(w.z); f[5] = bf_hi(w.z); f[6] = bf_lo(w.w); f[7] = bf_hi(w.w); }
__device__ __forceinline__ void conv_phase(const Args& A, int gt, int nth) {
    const bf16* Zc = (const bf16*)(A.ws + WS_ZC); bf16* YA = (bf16*)(A.ws + WS_A1);
    const float* cw = A.in[I_CONVW];
    for (int task = gt; task < (NTOK / 16) * 64; task += nth) {
        const int seg = task >> 6, ch = (task & 63) * 8, row0 = seg * 16;
        int b, t0, T; bool prompt = row0 < NPROMPT;
        if (prompt) { b = row0 / SEQ_P; t0 = row0 % SEQ_P; T = SEQ_P; } else { b = (row0 - NPROMPT) / SEQ_S; t0 = 0; T = SEQ_S; }
        float um2[8], um1[8], c0[8], c1[8], c2[8];
#pragma unroll
        for (int i = 0; i < 8; ++i) { c0[i] = cw[ch + i]; c1[i] = cw[512 + ch + i]; c2[i] = cw[1024 + ch + i]; }
        if (t0 == 0) {
            if (prompt) {
#pragma unroll
                for (int i = 0; i < 8; ++i) { um2[i] = 0.f; um1[i] = 0.f; }
            } else { const float* sc = A.in[I_SCONV] + (size_t)b * 2 * 512 + ch;
#pragma unroll
                for (int i = 0; i < 8; ++i) { um2[i] = sc[i]; um1[i] = sc[512 + i]; } }
        } else {
            float a[8], h[8];
            unpack8(*(const v4u*)(Zc + (size_t)(row0 - 2) * 1536 + 512 + ch), a); unpack8(*(const v4u*)(Zc + (size_t)(row0 - 2) * 1536 + 1024 + ch), h);
#pragma unroll
            for (int i = 0; i < 8; ++i) um2[i] = a[i] * h[i];
            unpack8(*(const v4u*)(Zc + (size_t)(row0 - 1) * 1536 + 512 + ch), a); unpack8(*(const v4u*)(Zc + (size_t)(row0 - 1) * 1536 + 1024 + ch), h);
#pragma unroll
            for (int i = 0; i < 8; ++i) um1[i] = a[i] * h[i];
        }
#pragma unroll 4
        for (int t = 0; t < 16; ++t) {
            const size_t row = (size_t)(row0 + t);
            float zb[8], zc[8], zh[8], y[8];
            unpack8(*(const v4u*)(Zc + row * 1536 + ch), zb); unpack8(*(const v4u*)(Zc + row * 1536 + 512 + ch), zc); unpack8(*(const v4u*)(Zc + row * 1536 + 1024 + ch), zh);
#pragma unroll
            for (int i = 0; i < 8; ++i) { const float u = zc[i] * zh[i]; y[i] = zb[i] * (c0[i] * um2[i] + c1[i] * um1[i] + c2[i] * u); um2[i] = um1[i]; um1[i] = u; }
            v4u o; o.x = cvt_pk_bf16(y[0], y[1]); o.y = cvt_pk_bf16(y[2], y[3]); o.z = cvt_pk_bf16(y[4], y[5]); o.w = cvt_pk_bf16(y[6], y[7]);
            *(v4u*)(YA + row * 512 + ch) = o;
        }
        if (t0 + 16 == T) { float* oc = A.out + (prompt ? O_CONV_P : O_CONV_S) + (size_t)b * 2 * 512 + ch;
#pragma unroll
            for (int i = 0; i < 8; ++i) { oc[i] = um2[i]; oc[512 + i] = um1[i]; } }
    }
    bf16* Zr = (bf16*)(A.ws + WS_ZR);
    for (int task = nth - 1 - gt; task < NTOK * 16; task += nth) {
        const int m = task >> 4, cs = task & 15;
        bool hasprev; int prow;
        if (m < NPROMPT) { hasprev = (m & (SEQ_P - 1)) != 0; prow = m - 1; } else { const int ms = m - NPROMPT; hasprev = true; prow = (ms & (SEQ_S - 1)) ? m - 1 : NTOK + ms / SEQ_S; }
        bf16* pap = Zr + (size_t)m * 2048 + 1536 + cs * 16;
        float pa[16], t8[8];
        const v4u a0 = *(const v4u*)pap, a1 = *(const v4u*)(pap + 8);
        v4u b0 = (v4u){0u, 0u, 0u, 0u}, b1 = b0;
        if (hasprev) { const bf16* pbp = Zr + (size_t)prow * 2048 + 1792 + cs * 16; b0 = *(const v4u*)pbp; b1 = *(const v4u*)(pbp + 8); }
        unpack8(a0, t8);
#pragma unroll
        for (int i = 0; i < 8; ++i) pa[i] = t8[i];
        unpack8(a1, t8);
#pragma unroll
        for (int i = 0; i < 8; ++i) pa[8 + i] = t8[i];
        unpack8(b0, t8);
#pragma unroll
        for (int i = 0; i < 8; ++i) pa[i] += t8[i];
        unpack8(b1, t8);
#pragma unroll
        for (int i = 0; i < 8; ++i) pa[8 + i] += t8[i];
#pragma unroll
        for (int i = 0; i < 16; ++i) { float p = pa[i];
            if (cs < 4) p = 1.0f - 2.0f * __builtin_amdgcn_rcpf(__expf(2.0f * p) + 1.0f);
            else if (cs >= 8) p = sigm(p);
            pa[i] = p; }
        v4u o0, o1; o0.x = cvt_pk_bf16(pa[0], pa[1]); o0.y = cvt_pk_bf16(pa[2], pa[3]); o0.z = cvt_pk_bf16(pa[4], pa[5]); o0.w = cvt_pk_bf16(pa[6], pa[7]);
        o1.x = cvt_pk_bf16(pa[8], pa[9]); o1.y = cvt_pk_bf16(pa[10], pa[11]); o1.z = cvt_pk_bf16(pa[12], pa[13]); o1.w = cvt_pk_bf16(pa[14], pa[15]);
        *(v4u*)pap = o0; *(v4u*)(pap + 8) = o1;
    }
}

constexpr int NUNITS_P = NB_P * 8 * 64, NUNITS = NUNITS_P + NB_S * 8;
constexpr int HID_STRIDE = 264, SC_TB = 32;
constexpr int P1_HIDB = 0, P1_LO = 16896, P1_SEQ = 41472, P1_GG = 90624, P1_YY = 98816, P1_ZZ = 107008, P1_BON = 115200;
typedef float f32x2 __attribute__((ext_vector_type(2)));

struct P1Pre { v4u pa0, pa1; v2u zr, zk, zv, pr, pk, pv; };
struct P1Pos { int unit, t0; };
__device__ __forceinline__ void p1_decode(int unit, bool& prompt, int& b, int& h, int& ch, int& T, int& rowbase) {
    prompt = unit < NUNITS_P; b = prompt ? unit >> 9 : (unit - NUNITS_P) >> 3; h = prompt ? (unit >> 6) & 7 : unit & 7; ch = prompt ? unit & 63 : 0;
    T = prompt ? 64 : SEQ_S; rowbase = prompt ? b * SEQ_P + ch * 64 : NPROMPT + b * SEQ_S;
}
__device__ __forceinline__ void p1_rows(int unit, int t0, int tt, size_t& row, size_t& prow, bool& hasprev, int& nb) {
    bool prompt; int b, h, ch, T, rowbase; p1_decode(unit, prompt, b, h, ch, T, rowbase);
    nb = (T - t0) < SC_TB ? (T - t0) : SC_TB;
    const int tloc = tt < nb ? tt : nb - 1, t = t0 + tloc; const bool first = (ch == 0);
    row = (size_t)(rowbase + t); hasprev = (t > 0) || !first || !prompt; prow = ((t > 0) || !first) ? row - 1 : (size_t)(NTOK + b);
}
__device__ __forceinline__ void p1_load(const Args& A, int unit, int t0, int tt, int cs, P1Pre& P) {
    size_t row, prow; bool hasprev; int nb; p1_rows(unit, t0, tt, row, prow, hasprev, nb);
    const int h = unit < NUNITS_P ? (unit >> 6) & 7 : unit & 7, hc = h * 64 + cs * 4;
    const bf16* Zr = (const bf16*)(A.ws + WS_ZR);
    P.pa0 = *(const v4u*)(Zr + row * 2048 + 1536 + cs * 16); P.pa1 = *(const v4u*)(Zr + row * 2048 + 1536 + cs * 16 + 8);
    P.zr = *(const v2u*)(Zr + row * 2048 + hc); P.zk = *(const v2u*)(Zr + row * 2048 + 512 + hc); P.zv = *(const v2u*)(Zr + row * 2048 + 1024 + hc);
    const v2u z2 = (v2u){0u, 0u};
    P.pr = z2; P.pk = z2; P.pv = z2;
    if (hasprev) { P.pr = *(const v2u*)(Zr + prow * 2048 + hc); P.pk = *(const v2u*)(Zr + prow * 2048 + 512 + hc); P.pv = *(const v2u*)(Zr + prow * 2048 + 1024 + hc); }
}
__device__ __forceinline__ bool p1_unit_at(int i, int vcu, int G, int& unit) {
    if (G == 256) { if (i > 16) return false; unit = i < 16 ? vcu * 16 + i : NUNITS_P + vcu; return true; }
    unit = vcu + i * G; return unit < NUNITS;
}

constexpr int WY_OS = 72, WY_TS = 24, WY_LS = 40;
constexpr int WY_AT = 0, WY_RT = WY_AT + 16 * WY_OS * 2, WY_BT = WY_RT + 16 * WY_OS * 2, WY_KT = WY_BT + 16 * WY_OS * 2, WY_BH = WY_KT + 16 * WY_OS * 2,
              WY_KH = WY_BH + 64 * WY_TS * 2, WY_VT = WY_KH + 64 * WY_TS * 2, WY_GC = WY_VT + 64 * WY_TS * 2, WY_BUF = WY_GC + 256;
constexpr int WY_BASE = 0;
constexpr int WY_LAB = WY_BASE + 2 * WY_BUF, WY_LAK = WY_LAB + 1024, WY_MC = WY_LAK + 16 * WY_LS * 2;
static_assert(WY_MC + 16 * WY_LS * 2 <= P1_SEQ, "UT-transform operands must fit over HIDB | LO");
constexpr int WY_XB = 115328, WY_RH = WY_XB + 128 * WY_OS * 2, WY_UT = WY_RH + 8 * 16 * 17 * 4, WY_END = WY_UT + 8 * 16 * WY_TS * 2;
static_assert(WY_END <= LDSCTL_OFF, "LDS map of pass 1");

constexpr int WY_G2 = P1_GG + 2048;
static_assert(WY_G2 + 1024 + 2 * 16 * WY_LS * 2 <= P1_YY, "second Gram set");
__device__ __forceinline__ void p1_wy(f32x4 (&X)[4], const LAS float* SEQ, LAS float* YY, LAS float* ZZ, LAS unsigned char* lds, int nb, int tid, int lane, int wave, int part = 0) {
    const bool pw = wave >= 4; const int nmc = nb >> 4;
    LAS bf16* Xb = (LAS bf16*)(lds + WY_XB); LAS float* RH = (LAS float*)(lds + WY_RH) + wave * 16 * 17; LAS bf16* UT = (LAS bf16*)(lds + WY_UT) + wave * 16 * WY_TS;
    const bf16x8 zero8 = (bf16x8){0, 0, 0, 0, 0, 0, 0, 0};
    for (int mc = 0; mc < nmc; ++mc) {
        asm volatile("" : "+v"(tid));
        LAS unsigned char* ob = lds + WY_BASE + mc * WY_BUF;
        LAS bf16* At = (LAS bf16*)(ob + WY_AT); LAS bf16* Rt = (LAS bf16*)(ob + WY_RT); LAS bf16* Bt = (LAS bf16*)(ob + WY_BT); LAS bf16* Kt = (LAS bf16*)(ob + WY_KT);
        LAS bf16* BhT = (LAS bf16*)(ob + WY_BH); LAS bf16* KhT = (LAS bf16*)(ob + WY_KH); LAS bf16* VT = (LAS bf16*)(ob + WY_VT); LAS float* GC = (LAS float*)(ob + WY_GC);
        const int tl = tid >> 5, c2 = (tid & 31) * 2, s0 = mc * 16;
        f32x2 cum = (f32x2){0.f, 0.f}, tot = cum, lwt = cum;
#pragma unroll
        for (int i = 0; i < 16; ++i) { const f32x2 l2 = *(const LAS f32x2*)(SEQ + (s0 + i) * 384 + 64 + c2); tot += l2; if (i <= tl) cum += l2; if (i == tl) lwt = l2; }
        const LAS float* sp = SEQ + (s0 + tl) * 384 + c2;
        const f32x2 a2 = *(const LAS f32x2*)(sp), b2 = *(const LAS f32x2*)(sp + 128), k2 = *(const LAS f32x2*)(sp + 192), r2 = *(const LAS f32x2*)(sp + 256), v2 = *(const LAS f32x2*)(sp + 320);
        const f32x2 gt = (f32x2){__expf(cum.x), __expf(cum.y)}, gp = (f32x2){__expf(cum.x - lwt.x), __expf(cum.y - lwt.y)}, gi = (f32x2){__expf(-cum.x), __expf(-cum.y)},
                    go = (f32x2){__expf(tot.x - cum.x), __expf(tot.y - cum.y)};
        *(LAS unsigned*)(At + tl * WY_OS + c2) = cvt_pk_bf16(a2.x * gp.x, a2.y * gp.y); *(LAS unsigned*)(Rt + tl * WY_OS + c2) = cvt_pk_bf16(r2.x * gt.x, r2.y * gt.y);
        *(LAS unsigned*)(Bt + tl * WY_OS + c2) = cvt_pk_bf16(b2.x * gi.x, b2.y * gi.y); *(LAS unsigned*)(Kt + tl * WY_OS + c2) = cvt_pk_bf16(k2.x * gi.x, k2.y * gi.y);
        const unsigned bh = cvt_pk_bf16(b2.x * go.x, b2.y * go.y), kh = cvt_pk_bf16(k2.x * go.x, k2.y * go.y), vv = cvt_pk_bf16(v2.x, v2.y);
        {
            const unsigned bh_o = (unsigned)__shfl_xor((int)bh, 32), kh_o = (unsigned)__shfl_xor((int)kh, 32), vv_o = (unsigned)__shfl_xor((int)vv, 32);
            const bool ev = (tl & 1) == 0; const int wo = (ev ? c2 : c2 + 1) * WY_TS + (tl & ~1);
            *(LAS unsigned*)(BhT + wo) = ev ? ((bh & 0xffffu) | (bh_o << 16)) : ((bh_o >> 16) | (bh & 0xffff0000u));
            *(LAS unsigned*)(KhT + wo) = ev ? ((kh & 0xffffu) | (kh_o << 16)) : ((kh_o >> 16) | (kh & 0xffff0000u));
            *(LAS unsigned*)(VT + wo) = ev ? ((vv & 0xffffu) | (vv_o << 16)) : ((vv_o >> 16) | (vv & 0xffff0000u)); }
        if (tl == 0) *(LAS f32x2*)(GC + c2) = (f32x2){__expf(tot.x), __expf(tot.y)};
    }
    __syncthreads();
    {
        asm volatile("" : "+v"(tid));
        const int fr = tid & 15, fq = (tid >> 4) & 3, g_ = wave & 3, m_ = wave >> 2;
        if (m_ < nmc) {
            LAS unsigned char* ob = lds + WY_BASE + m_ * WY_BUF; LAS unsigned char* gs = lds + (m_ ? WY_G2 : WY_LAB);
            LAS float* Lab = (LAS float*)gs; LAS bf16* Lak = (LAS bf16*)(gs + 1024); LAS bf16* Mc = (LAS bf16*)(gs + 1024 + 16 * WY_LS * 2);
            const LAS bf16* ab = (LAS bf16*)(ob + (g_ < 2 ? WY_AT : WY_RT)) + fr * WY_OS + fq * 8; const LAS bf16* bb = (LAS bf16*)(ob + ((g_ & 1) ? WY_KT : WY_BT)) + fr * WY_OS + fq * 8;
            f32x4 g = (f32x4){0.f, 0.f, 0.f, 0.f};
#pragma unroll
            for (int ks = 0; ks < 2; ++ks) g = __builtin_amdgcn_mfma_f32_16x16x32_bf16(*(const LAS bf16x8*)(bb + ks * 32), *(const LAS bf16x8*)(ab + ks * 32), g, 0, 0, 0);
#pragma unroll
            for (int rg = 0; rg < 4; ++rg) { const int tp = 4 * fq + rg; const bool keep = (g_ < 2) ? (fr > tp) : (fr >= tp); g[rg] = keep ? g[rg] : 0.f; }
            if (g_ == 0) *(LAS f32x4*)(Lab + fr * 16 + 4 * fq) = g;
            else { v2u w; w.x = cvt_pk_bf16(g[0], g[1]); w.y = cvt_pk_bf16(g[2], g[3]);
                if (g_ == 1) { *(LAS v2u*)(Lak + fr * WY_LS + 4 * fq) = w; *(LAS v2u*)(Lak + fr * WY_LS + 16 + 4 * fq) = (v2u){0u, 0u}; }
                else if (g_ == 2) *(LAS v2u*)(Mc + fr * WY_LS + 4 * fq) = w; else *(LAS v2u*)(Mc + fr * WY_LS + 16 + 4 * fq) = w; }
        }
    }
    __syncthreads();
    if (MK_DBGSEL == 2 && part) return;
    for (int mc = 0; mc < nmc; ++mc) {
        asm volatile("" : "+v"(tid));
        const int fr = tid & 15, fq = (tid >> 4) & 3;
        LAS unsigned char* ob = lds + WY_BASE + mc * WY_BUF; LAS unsigned char* gs = lds + (mc ? WY_G2 : WY_LAB);
        LAS bf16* At = (LAS bf16*)(ob + WY_AT); LAS bf16* Rt = (LAS bf16*)(ob + WY_RT);
        LAS bf16* BhT = (LAS bf16*)(ob + WY_BH); LAS bf16* KhT = (LAS bf16*)(ob + WY_KH); LAS bf16* VT = (LAS bf16*)(ob + WY_VT); LAS float* GC = (LAS float*)(ob + WY_GC);
        LAS float* Lab = (LAS float*)gs; LAS bf16* Lak = (LAS bf16*)(gs + 1024); LAS bf16* Mc = (LAS bf16*)(gs + 1024 + 16 * WY_LS * 2);
        f32x4 W1 = (f32x4){0.f, 0.f, 0.f, 0.f}, Y0 = W1;
        {
            const LAS bf16* xbp = Xb + (16 * wave + fr) * WY_OS + fq * 8;
#pragma unroll
            for (int ks = 0; ks < 2; ++ks) { const bf16x8 bx = *(const LAS bf16x8*)(xbp + ks * 32);
                W1 = __builtin_amdgcn_mfma_f32_16x16x32_bf16(*(const LAS bf16x8*)(At + fr * WY_OS + ks * 32 + fq * 8), bx, W1, 0, 0, 0);
                Y0 = __builtin_amdgcn_mfma_f32_16x16x32_bf16(*(const LAS bf16x8*)(Rt + fr * WY_OS + ks * 32 + fq * 8), bx, Y0, 0, 0, 0); }
        }
        if (!pw) { const bf16x8 la = *(const LAS bf16x8*)(Lak + fr * WY_LS + fq * 8); const bf16x8 vb0 = *(const LAS bf16x8*)(VT + (16 * wave + fr) * WY_TS + (fq & 1) * 8); const bf16x8 vb = fq < 2 ? vb0 : zero8;
            W1 = __builtin_amdgcn_mfma_f32_16x16x32_bf16(la, vb, W1, 0, 0, 0); }
#pragma unroll
        for (int rg = 0; rg < 4; ++rg) RH[(4 * fq + rg) * 17 + fr] = W1[rg];
        LDS_WAIT();
        {
            float u[16];
#pragma unroll
            for (int t = 0; t < 16; ++t) { if ((t & 3) == 0) asm volatile("" ::: "memory");
                float acc = RH[t * 17 + fr];
                if (!(MK_DBGSEL == 3 && part))
#pragma unroll
                for (int i4 = 0; i4 * 4 < t; ++i4) { const f32x4 l4 = *(const LAS f32x4*)(Lab + t * 16 + i4 * 4);
#pragma unroll
                    for (int e = 0; e < 4; ++e) if (i4 * 4 + e < t) acc += l4[e] * u[i4 * 4 + e]; }
                u[t] = acc; }
            if (fq == 0) { v4u o0, o1; o0.x = cvt_pk_bf16(u[0], u[1]); o0.y = cvt_pk_bf16(u[2], u[3]); o0.z = cvt_pk_bf16(u[4], u[5]); o0.w = cvt_pk_bf16(u[6], u[7]);
                o1.x = cvt_pk_bf16(u[8], u[9]); o1.y = cvt_pk_bf16(u[10], u[11]); o1.z = cvt_pk_bf16(u[12], u[13]); o1.w = cvt_pk_bf16(u[14], u[15]);
                *(LAS v4u*)(UT + fr * WY_TS) = o0; *(LAS v4u*)(UT + fr * WY_TS + 8) = o1; }
        }
        LDS_WAIT();
        {
            const bf16x8 uc = fq < 2 ? *(const LAS bf16x8*)(UT + fr * WY_TS + fq * 8) : (pw ? zero8 : *(const LAS bf16x8*)(VT + (16 * wave + fr) * WY_TS + (fq - 2) * 8));
            Y0 = __builtin_amdgcn_mfma_f32_16x16x32_bf16(*(const LAS bf16x8*)(Mc + fr * WY_LS + fq * 8), uc, Y0, 0, 0, 0);
            LAS float* yo = (pw ? ZZ + 16 * (wave - 4) : YY + 16 * wave) + fr;
#pragma unroll
            for (int rg = 0; rg < 4; ++rg) yo[(mc * 16 + 4 * fq + rg) * 64] = Y0[rg];
#pragma unroll
            for (int j = 0; j < 4; ++j) {
                const bf16x8 bc = fq < 2 ? *(const LAS bf16x8*)(BhT + (16 * j + fr) * WY_TS + fq * 8) : *(const LAS bf16x8*)(KhT + (16 * j + fr) * WY_TS + (fq - 2) * 8);
                X[j] = X[j] * *(const LAS f32x4*)(GC + 16 * j + 4 * fq);
                X[j] = __builtin_amdgcn_mfma_f32_16x16x32_bf16(bc, uc, X[j], 0, 0, 0);
                v2u w; w.x = cvt_pk_bf16(X[j][0], X[j][1]); w.y = cvt_pk_bf16(X[j][2], X[j][3]);
                *(LAS v2u*)(Xb + (16 * wave + fr) * WY_OS + 16 * j + 4 * fq) = w; }
        }
        LDS_WAIT();
    }
}

#define P1_LOAD_PARAMS(HH) do { int lf_ = fr, lq_ = fq, lt_ = tid; asm volatile("" : "+v"(lf_), "+v"(lq_), "+v"(lt_));   \
        const int h_ = (HH), ncol_ = h_ * 64 + ntl * 16 + lf_; \
        _Pragma("unroll") for (int ks = 0; ks < 2; ++ks) { bw[ks] = *(const bf16x8*)(L2T + (size_t)ncol_ * 64 + lq_ * 8 + ks * 32); ba[ks] = *(const bf16x8*)(L2T + (size_t)512 * 64 + (size_t)ncol_ * 64 + lq_ * 8 + ks * 32); } \
        _Pragma("unroll") for (int ks = 0; ks < 4; ++ks) bg[ks] = *(const bf16x8*)(L2T + (size_t)1024 * 64 + (size_t)ncol_ * 128 + lq_ * 8 + ks * 32); \
        if (lt_ < 128) { const int a_ = lt_ >> 4, c_ = (lt_ & 15) * 4; \
            const float* src_ = a_ == 0 ? A.in[I_W0] : a_ == 1 ? A.in[I_A0] : a_ == 2 ? A.in[I_KK] : a_ == 3 ? A.in[I_KA] : a_ == 4 ? A.in[I_RK] : A.in[I_MURKV] + (a_ - 5) * 512; \
            *(LAS f32x4*)(PRM + a_ * 64 + c_) = *(const f32x4*)(src_ + h_ * 64 + c_); } } while (0)
__device__ __forceinline__ void scan_pass1(const Args& A, LAS unsigned char* lds, int tid, int lane, int wave, int vcu, int G, int part = 0) {
    bf16* GB = (bf16*)(A.ws + WS_A1) + (size_t)MPAD * 512;
    bf16* YL = (bf16*)(A.ws + WS_YL); bf16* ZT = (bf16*)(A.ws + WS_ZT); bf16* BV = (bf16*)(A.ws + WS_BV);
    LAS bf16* HIDB = (LAS bf16*)(lds + P1_HIDB); LAS float* LO = (LAS float*)(lds + P1_LO); LAS float* SEQ = (LAS float*)(lds + P1_SEQ);
    LAS float* YY = (LAS float*)(lds + P1_YY); LAS float* ZZ = (LAS float*)(lds + P1_ZZ);
    const bf16* L2T = (const bf16*)(A.ws + WS_L2T);
    const bool prow_wave = wave >= 4;
    const int mt = wave & 1, ntl = wave >> 1;
    int tt = tid >> 4, cs = tid & 15, c4 = cs * 4, fr = lane & 15, fq = lane >> 4;
    f32x4 X[4];
    bf16x8 bw[2], ba[2], bg[4];
    LAS float* PRM = (LAS float*)(lds + P1_GG);
    int cur_h = -1;
    int ui = 0, unit; if (!p1_unit_at(0, vcu, G, unit)) return;
    int t0 = 0; P1Pre pre; p1_load(A, unit, 0, tt, cs, pre);
    for (;;) {
        { int lt_ = tid; asm volatile("" : "+v"(lt_)); tt = lt_ >> 4; cs = lt_ & 15; c4 = cs * 4; fr = lt_ & 15; fq = (lt_ >> 4) & 3; }
        bool prompt; int b, h, ch, T, rowbase; p1_decode(unit, prompt, b, h, ch, T, rowbase);
        const int hc = h * 64 + c4;
        if (t0 == 0 && G == 256 && ui < 8) {
            const size_t i16 = ((size_t)(ui * 256 + vcu) * NTHR + tid) * 16;
            cvt16_fp8_sliced(A.in[I_U], A.ws + WS_UB, PEER_SU, i16); cvt16_fp8_sliced(A.in[I_V], A.ws + WS_VB, PEER_SV, i16); }
        if (t0 == 0) {
            LAS bf16* Xb = (LAS bf16*)(lds + WY_XB);
#pragma unroll
            for (int j = 0; j < 4; ++j) { const int prow_ = 16 * (wave - 4) + fr, c0_ = 16 * j + 4 * fq;
#pragma unroll
                for (int e = 0; e < 4; ++e) X[j][e] = (prow_wave && prow_ == c0_ + e) ? 1.f : 0.f;
                v2u w; w.x = cvt_pk_bf16(X[j][0], X[j][1]); w.y = cvt_pk_bf16(X[j][2], X[j][3]);
                *(LAS v2u*)(Xb + (16 * wave + fr) * WY_OS + c0_) = w; }
        }
        if (h != cur_h) { cur_h = h; P1_LOAD_PARAMS(h); }
        size_t row, prow; bool hasprev; int nb; p1_rows(unit, t0, tt, row, prow, hasprev, nb);
        if (!(MK_DBGSEL == 5 && part)) { *(LAS v4u*)(HIDB + tt * HID_STRIDE + cs * 16) = pre.pa0; *(LAS v4u*)(HIDB + tt * HID_STRIDE + cs * 16 + 8) = pre.pa1; }
        __syncthreads();
        if (!(MK_DBGSEL == 5 && part)) {
            const LAS bf16* ap = HIDB + (mt * 16 + fr) * HID_STRIDE + fq * 8;
            f32x4 cw = (f32x4){0.f, 0.f, 0.f, 0.f}, ca = cw, cg = cw;
#pragma unroll
            for (int ks = 0; ks < 2; ++ks) { cw = __builtin_amdgcn_mfma_f32_16x16x32_bf16(*(const LAS bf16x8*)(ap + ks * 32), bw[ks], cw, 0, 0, 0);
                                             ca = __builtin_amdgcn_mfma_f32_16x16x32_bf16(*(const LAS bf16x8*)(ap + 64 + ks * 32), ba[ks], ca, 0, 0, 0); }
#pragma unroll
            for (int ks = 0; ks < 4; ++ks) cg = __builtin_amdgcn_mfma_f32_16x16x32_bf16(*(const LAS bf16x8*)(ap + 128 + ks * 32), bg[ks], cg, 0, 0, 0);
#pragma unroll
            for (int rg = 0; rg < 4; ++rg) { const int o = (mt * 16 + fq * 4 + rg) * 64 + ntl * 16 + fr; LO[o] = cw[rg]; LO[2048 + o] = ca[rg]; LO[4096 + o] = cg[rg]; }
        }
        __syncthreads();
        if (!(MK_DBGSEL == 5 && part)) {
            const f32x4 w0v = *(const LAS f32x4*)(PRM + c4), a0v = *(const LAS f32x4*)(PRM + 64 + c4), kkv = *(const LAS f32x4*)(PRM + 128 + c4), kav = *(const LAS f32x4*)(PRM + 192 + c4),
                        rkv = *(const LAS f32x4*)(PRM + 256 + c4), mur = *(const LAS f32x4*)(PRM + 320 + c4), muk = *(const LAS f32x4*)(PRM + 384 + c4), muv = *(const LAS f32x4*)(PRM + 448 + c4);
            const f32x4 aw = w0v + *(const LAS f32x4*)(LO + tt * 64 + c4), aa = a0v + *(const LAS f32x4*)(LO + 2048 + tt * 64 + c4), ag = *(const LAS f32x4*)(LO + 4096 + tt * 64 + c4);
            f32x4 r = (f32x4){bf_lo(pre.zr.x), bf_hi(pre.zr.x), bf_lo(pre.zr.y), bf_hi(pre.zr.y)}, k = (f32x4){bf_lo(pre.zk.x), bf_hi(pre.zk.x), bf_lo(pre.zk.y), bf_hi(pre.zk.y)},
                  v = (f32x4){bf_lo(pre.zv.x), bf_hi(pre.zv.x), bf_lo(pre.zv.y), bf_hi(pre.zv.y)};
            const f32x4 rpv = (f32x4){bf_lo(pre.pr.x), bf_hi(pre.pr.x), bf_lo(pre.pr.y), bf_hi(pre.pr.y)}, kpv = (f32x4){bf_lo(pre.pk.x), bf_hi(pre.pk.x), bf_lo(pre.pk.y), bf_hi(pre.pk.y)},
                        vpv = (f32x4){bf_lo(pre.pv.x), bf_hi(pre.pv.x), bf_lo(pre.pv.y), bf_hi(pre.pv.y)};
            r = r + mur * (rpv - r); k = k + muk * (kpv - k); v = v + muv * (vpv - v);
            f32x4 dec, asg, kk, km, av, bv;
            float ssq = 0.f, bon = 0.f;
#pragma unroll
            for (int i = 0; i < 4; ++i) {
                const float x = -aw[i];
                const float sp = fmaxf(x, 0.f) + __logf(1.0f + __expf(-fabsf(x)));
                const float wraw = -sp - 0.5f;
                dec[i] = -__expf(wraw);
                asg[i] = sigm(aa[i]);
                kk[i] = k[i] * kkv[i]; ssq += kk[i] * kk[i];
                km[i] = k[i] * (1.0f + (asg[i] - 1.0f) * kav[i]);
                bon += r[i] * km[i] * rkv[i];
            }
            ssq = sum16(ssq); bon = sum16(bon);
            const float inv = 1.0f / fmaxf(sqrtf(ssq), 1e-12f);
#pragma unroll
            for (int i = 0; i < 4; ++i) { kk[i] *= inv; av[i] = -kk[i]; bv[i] = kk[i] * asg[i]; }
            LAS float* sq_ = SEQ + tt * 384 + c4;
            *(LAS f32x4*)(sq_) = av; *(LAS f32x4*)(sq_ + 64) = dec; *(LAS f32x4*)(sq_ + 128) = bv; *(LAS f32x4*)(sq_ + 192) = km; *(LAS f32x4*)(sq_ + 256) = r; *(LAS f32x4*)(sq_ + 320) = v;
            if (tt < nb) {
                v2u w; w.x = cvt_pk_bf16(ag[0], ag[1]); w.y = cvt_pk_bf16(ag[2], ag[3]); *(v2u*)(GB + row * 512 + hc) = w;
                w.x = cvt_pk_bf16(bon * v[0], bon * v[1]); w.y = cvt_pk_bf16(bon * v[2], bon * v[3]); *(v2u*)(BV + row * 512 + hc) = w;
            }
        }
        int nunit = unit, nt0 = t0 + SC_TB, nui = ui; bool more = true;
        if (nt0 >= T) { nt0 = 0; nui = ui + 1; more = p1_unit_at(nui, vcu, G, nunit); }
        if (more) p1_load(A, nunit, nt0, tt, cs, pre);
        __syncthreads();
        if (!(MK_DBGSEL == 1 && part)) p1_wy(X, SEQ, YY, ZZ, lds, nb, tid, lane, wave, part);
        __syncthreads();
        if (tt < nb) {
            const f32x4 y = *(const LAS f32x4*)(YY + tt * 64 + c4), z = *(const LAS f32x4*)(ZZ + tt * 64 + c4);
            v2u w; w.x = cvt_pk_bf16(y[0], y[1]); w.y = cvt_pk_bf16(y[2], y[3]); *(v2u*)(YL + row * 512 + hc) = w;
            w.x = cvt_pk_bf16(z[0], z[1]); w.y = cvt_pk_bf16(z[2], z[3]); *(v2u*)(ZT + row * 512 + hc) = w;
        }
        if (t0 + SC_TB >= T) {
#pragma unroll
            for (int j = 0; j < 4; ++j) {
                if (!prow_wave) *(f32x4*)((float*)A.out + (size_t)unit * 4096 + (16 * wave + fr) * 64 + 16 * j + 4 * fq) = X[j];
                else { v2u o; o.x = cvt_pk_bf16(X[j][0], X[j][1]); o.y = cvt_pk_bf16(X[j][2], X[j][3]);
                    *(v2u*)((bf16*)((unsigned char*)A.out + OB_MB) + (size_t)unit * 4096 + (16 * (wave - 4) + fr) * 64 + 16 * j + 4 * fq) = o; }
            }
        }
        if (!more) break;
        unit = nunit; t0 = nt0; ui = nui;
    }
    __syncthreads();
}

constexpr int P2_SP = 68, P2_MP = 80, P2_ML = 16 * P2_SP * 4, P2_PL = P2_ML + 64 * P2_MP * 4;
__device__ __forceinline__ void scan_pass2_rows(const float* Sinit, int unit0, int nchunks, int v0, float* outfin, bool slots, const Args& A, LAS unsigned char* lds, int tid, int lane, int wave) {
    LAS float* Sl = (LAS float*)lds; LAS float* Ml = (LAS float*)(lds + P2_ML); LAS float* Pl = (LAS float*)(lds + P2_PL);
    const int nt = wave & 3, kh = wave >> 2, fr = lane & 15, fq = lane >> 4;
    float* NB = (float*)A.out; const bf16* MB = (const bf16*)((const unsigned char*)A.out + OB_MB);
    { const int idx = tid * 2, row = idx >> 6, col = idx & 63;
      const f32x2 s0 = Sinit ? *(const f32x2*)(Sinit + (size_t)(v0 + row) * 64 + col) : (f32x2){0.f, 0.f};
      *(LAS f32x2*)(Sl + row * P2_SP + col) = s0; }
    v4u mreg = *(const v4u*)(MB + (size_t)unit0 * 4096 + tid * 8);
    float nreg[4] = {0.f, 0.f, 0.f, 0.f};
    if (kh == 0) {
#pragma unroll
        for (int rg = 0; rg < 4; ++rg) nreg[rg] = NB[(size_t)unit0 * 4096 + (v0 + fq * 4 + rg) * 64 + nt * 16 + fr]; }
    f32x4 acc = (f32x4){0.f, 0.f, 0.f, 0.f};
    for (int c = 0; c < nchunks; ++c) {
        { const int row = tid >> 3, col = (tid & 7) * 8; LAS float* mp = Ml + row * P2_MP + col;
          *(LAS f32x4*)mp = (f32x4){bf_lo(mreg.x), bf_hi(mreg.x), bf_lo(mreg.y), bf_hi(mreg.y)}; *(LAS f32x4*)(mp + 4) = (f32x4){bf_lo(mreg.z), bf_hi(mreg.z), bf_lo(mreg.w), bf_hi(mreg.w)}; }
        __syncthreads();
        float ncur[4] = {nreg[0], nreg[1], nreg[2], nreg[3]};
        if (c + 1 < nchunks) { mreg = *(const v4u*)(MB + (size_t)(unit0 + c + 1) * 4096 + tid * 8);
            if (kh == 0) {
#pragma unroll
                for (int rg = 0; rg < 4; ++rg) nreg[rg] = NB[(size_t)(unit0 + c + 1) * 4096 + (v0 + fq * 4 + rg) * 64 + nt * 16 + fr]; } }
        f32x4 a0 = (f32x4){0.f, 0.f, 0.f, 0.f}, a1 = a0;
        const LAS float* sp = Sl + fr * P2_SP + kh * 32 + fq; const LAS float* mp = Ml + (kh * 32 + fq) * P2_MP + nt * 16 + fr;
#pragma unroll
        for (int ks = 0; ks < 8; ks += 2) { a0 = __builtin_amdgcn_mfma_f32_16x16x4f32(sp[4 * ks], mp[4 * ks * P2_MP], a0, 0, 0, 0); a1 = __builtin_amdgcn_mfma_f32_16x16x4f32(sp[4 * ks + 4], mp[(4 * ks + 4) * P2_MP], a1, 0, 0, 0); }
        acc = a0 + a1;
        if (kh == 1) *(LAS f32x4*)(Pl + nt * 256 + lane * 4) = acc;
        __syncthreads();
        if (kh == 0) {
            acc = acc + *(const LAS f32x4*)(Pl + nt * 256 + lane * 4) + (f32x4){ncur[0], ncur[1], ncur[2], ncur[3]};
#pragma unroll
            for (int rg = 0; rg < 4; ++rg) { Sl[(fq * 4 + rg) * P2_SP + nt * 16 + fr] = acc[rg];
                if (slots) NB[(size_t)(unit0 + c) * 4096 + (v0 + fq * 4 + rg) * 64 + nt * 16 + fr] = acc[rg]; }
        }
    }
    if (kh == 0) {
#pragma unroll
        for (int rg = 0; rg < 4; ++rg) outfin[(size_t)(v0 + fq * 4 + rg) * 64 + nt * 16 + fr] = acc[rg]; }
    __syncthreads();
}

__device__ __forceinline__ void scan_pass3_wave(const Args& A, int unit, int wq, int lane) {
    const bool prompt = unit < NUNITS_P;
    const int b = prompt ? unit >> 9 : (unit - NUNITS_P) >> 3, h = prompt ? (unit >> 6) & 7 : unit & 7, ch = prompt ? unit & 63 : 0;
    const int T = prompt ? 64 : SEQ_S, rowbase = prompt ? b * SEQ_P + ch * 64 : NPROMPT + b * SEQ_S;
    if (wq * 16 >= T) return;
    const float* S0 = prompt ? (ch > 0 ? (const float*)A.out + (size_t)(unit - 1) * 4096 : nullptr) : A.in[I_SWKV] + (size_t)(b * 8 + h) * 4096;
    const bf16* ZT = (const bf16*)(A.ws + WS_ZT); const bf16* YL = (const bf16*)(A.ws + WS_YL); const bf16* BV = (const bf16*)(A.ws + WS_BV);
    bf16* YB = (bf16*)(A.ws + WS_A1) + (size_t)MPAD * 512;
    const int fr = lane & 15, fq = lane >> 4;
    const size_t row = (size_t)(rowbase + wq * 16 + fr);
    f32x4 acc[4];
#pragma unroll
    for (int mt = 0; mt < 4; ++mt) acc[mt] = (f32x4){0.f, 0.f, 0.f, 0.f};
    if (S0) {
        bf16x8 bz[2];
#pragma unroll
        for (int ks = 0; ks < 2; ++ks) bz[ks] = *(const bf16x8*)(ZT + row * 512 + h * 64 + ks * 32 + fq * 8);
#pragma unroll
        for (int mt = 0; mt < 4; ++mt)
#pragma unroll
            for (int ks = 0; ks < 2; ++ks) { const float* sp = S0 + (size_t)(mt * 16 + fr) * 64 + ks * 32 + fq * 8; const f32x4 s0 = *(const f32x4*)sp, s1 = *(const f32x4*)(sp + 4);
                v4u pk; pk.x = cvt_pk_bf16(s0[0], s0[1]); pk.y = cvt_pk_bf16(s0[2], s0[3]); pk.z = cvt_pk_bf16(s1[0], s1[1]); pk.w = cvt_pk_bf16(s1[2], s1[3]);
                acc[mt] = __builtin_amdgcn_mfma_f32_16x16x32_bf16(__builtin_bit_cast(bf16x8, pk), bz[ks], acc[mt], 0, 0, 0); }
    }
    float sm = 0.f;
#pragma unroll
    for (int mt = 0; mt < 4; ++mt) { const v2u yl = *(const v2u*)(YL + row * 512 + h * 64 + mt * 16 + fq * 4);
        acc[mt][0] += bf_lo(yl.x); acc[mt][1] += bf_hi(yl.x); acc[mt][2] += bf_lo(yl.y); acc[mt][3] += bf_hi(yl.y);
        sm += (acc[mt][0] + acc[mt][1]) + (acc[mt][2] + acc[mt][3]); }
    sm += __shfl_xor(sm, 16); sm += __shfl_xor(sm, 32);
    const float mean = sm * (1.f / 64.f); float sv = 0.f;
#pragma unroll
    for (int mt = 0; mt < 4; ++mt) { acc[mt] = acc[mt] - mean; sv += (acc[mt][0] * acc[mt][0] + acc[mt][1] * acc[mt][1]) + (acc[mt][2] * acc[mt][2] + acc[mt][3] * acc[mt][3]); }
    sv += __shfl_xor(sv, 16); sv += __shfl_xor(sv, 32);
    const float rs = 1.0f / sqrtf(sv * (1.f / 64.f) + 64e-5f);
#pragma unroll
    for (int mt = 0; mt < 4; ++mt) { const int c = h * 64 + mt * 16 + fq * 4;
        const f32x4 gw = *(const f32x4*)(A.in[I_GNW] + c), gb = *(const f32x4*)(A.in[I_GNB] + c);
        const v2u bvw = *(const v2u*)(BV + row * 512 + c), gg = *(const v2u*)(YB + row * 512 + c);
        f32x4 o = acc[mt] * rs * gw + gb + (f32x4){bf_lo(bvw.x), bf_hi(bvw.x), bf_lo(bvw.y), bf_hi(bvw.y)};
        o = o * (f32x4){bf_lo(gg.x), bf_hi(gg.x), bf_lo(gg.y), bf_hi(gg.y)};
        v2u w; w.x = cvt_pk_bf16(o[0], o[1]); w.y = cvt_pk_bf16(o[2], o[3]); *(v2u*)(YB + row * 512 + c) = w; }
}

__device__ __forceinline__ void tk_insert(float (&tv)[16], float x) {
#pragma unroll
    for (int i = 15; i >= 1; --i) tv[i] = __builtin_amdgcn_fmed3f(tv[i - 1], x, tv[i]);
    tv[0] = __builtin_fmaxf(tv[0], x);
}
#define TK_CE(t, i, j) { const float a_ = __builtin_fmaxf(t[i], t[j]); t[j] = __builtin_fminf(t[i], t[j]); t[i] = a_; }
__device__ __forceinline__ void tk_sort16(float (&t)[16]) {
    TK_CE(t, 0, 1) TK_CE(t, 2, 3) TK_CE(t, 0, 2) TK_CE(t, 1, 3) TK_CE(t, 1, 2) TK_CE(t, 4, 5) TK_CE(t, 6, 7) TK_CE(t, 4, 6) TK_CE(t, 5, 7) TK_CE(t, 5, 6) TK_CE(t, 0, 4) TK_CE(t, 2, 6) TK_CE(t, 2, 4) TK_CE(t, 1, 5) TK_CE(t, 3, 7) TK_CE(t, 3, 5) TK_CE(t, 1, 2) TK_CE(t, 3, 4) TK_CE(t, 5, 6) TK_CE(t, 8, 9) TK_CE(t, 10, 11) TK_CE(t, 8, 10) TK_CE(t, 9, 11) TK_CE(t, 9, 10) TK_CE(t, 12, 13) TK_CE(t, 14, 15) TK_CE(t, 12, 14) TK_CE(t, 13, 15) TK_CE(t, 13, 14) TK_CE(t, 8, 12) TK_CE(t, 10, 14) TK_CE(t, 10, 12) TK_CE(t, 9, 13) TK_CE(t, 11, 15) TK_CE(t, 11, 13) TK_CE(t, 9, 10) TK_CE(t, 11, 12) TK_CE(t, 13, 14) TK_CE(t, 0, 8) TK_CE(t, 4, 12) TK_CE(t, 4, 8) TK_CE(t, 2, 10) TK_CE(t, 6, 14) TK_CE(t, 6, 10) TK_CE(t, 2, 4) TK_CE(t, 6, 8) TK_CE(t, 10, 12) TK_CE(t, 1, 9) TK_CE(t, 5, 13) TK_CE(t, 5, 9) TK_CE(t, 3, 11) TK_CE(t, 7, 15) TK_CE(t, 7, 11) TK_CE(t, 3, 5) TK_CE(t, 7, 9) TK_CE(t, 11, 13) TK_CE(t, 1, 2) TK_CE(t, 3, 4) TK_CE(t, 5, 6) TK_CE(t, 7, 8) TK_CE(t, 9, 10) TK_CE(t, 11, 12) TK_CE(t, 13, 14)
}
__device__ __forceinline__ void tk_merge16(float (&tv)[16], const float (&g)[16]) {
#pragma unroll
    for (int i = 0; i < 16; ++i) tv[i] = __builtin_fmaxf(tv[i], g[15 - i]);
#pragma unroll
    for (int s = 8; s >= 1; s >>= 1)
#pragma unroll
        for (int i = 0; i < 16; ++i) if ((i & s) == 0) TK_CE(tv, i, i + s)
}
__device__ __forceinline__ float gelu_tanh(float x) {
    const float u = 0.7978845608028654f * (x + 0.044715f * x * x * x);
    const float th = 1.0f - 2.0f * __builtin_amdgcn_rcpf(__expf(2.0f * u) + 1.0f);
    return 0.5f * x * (1.0f + th);
}
constexpr int NTILE32 = NTOK / 32;
constexpr int CW_QU = 8192, CW_QV = 8192 + 512;

constexpr int TK_STRIDE = 68, TK_BYTES = 64 * TK_STRIDE * 4;
__device__ __forceinline__ void topk_scores64(const bf16* Q, const bf16* KB, LAS float* SC, int t0, int hp, int p, int half, int lane, const bf16x8 (&af)[2][2][4]) {
    const int fr = lane & 15, fq = lane >> 4;
#pragma unroll
    for (int hs = 0; hs < 2; ++hs) {
        const bf16* kbase = KB + (size_t)(((hp + 4 * hs) * 2 + p) * 128 + half * 64 + fr) * 128 + fq * 8;
#pragma unroll
        for (int n = 0; n < 4; ++n) {
            bf16x8 bfr[4];
#pragma unroll
            for (int ks = 0; ks < 4; ++ks) bfr[ks] = *(const bf16x8*)(kbase + (size_t)n * 16 * 128 + ks * 32);
            f32x4 acc0 = (f32x4){0.f, 0.f, 0.f, 0.f}, acc1 = acc0;
#pragma unroll
            for (int ks = 0; ks < 4; ++ks) { acc0 = __builtin_amdgcn_mfma_f32_16x16x32_bf16(af[hs][0][ks], bfr[ks], acc0, 0, 0, 0); acc1 = __builtin_amdgcn_mfma_f32_16x16x32_bf16(af[hs][1][ks], bfr[ks], acc1, 0, 0, 0); }
#pragma unroll
            for (int rg = 0; rg < 4; ++rg) { SC[(hs * 32 + fq * 4 + rg) * TK_STRIDE + n * 16 + fr] = acc0[rg]; SC[(hs * 32 + 16 + fq * 4 + rg) * TK_STRIDE + n * 16 + fr] = acc1[rg]; }
        }
    }
}
constexpr int TK_NPROMPT_UNITS = (NPROMPT / 32) * 4, TK_NSAMPLE_UNITS = (NSAMP / 32) * 4, CW_TKS = 9792;
__device__ __forceinline__ void peer_topk_units(const Args& A, LAS unsigned char* lds, int lane, int wave, int u_first, int u_end, int u_step) {
    const bf16* Q = (const bf16*)(A.ws + WS_ZG); const bf16* KB = (const bf16*)(A.ws + WS_KEYS); const float* SSP = (const float*)(A.ws + WS_SSP);
    unsigned short* EIDX = (unsigned short*)(A.ws + WS_EIDX); float* GATE = (float*)(A.ws + WS_GATE); float* RSTD = (float*)(A.ws + WS_RSTD);
    LAS float* SC = (LAS float*)(lds + wave * TK_BYTES);
    const int fr = lane & 15, fq = lane >> 4, tokl = lane & 31, hsel = lane >> 5;
    for (int u = u_first; u < u_end; u += u_step) {
        const int t0 = (u >> 2) * 32, hp = u & 3, h = hp + 4 * hsel;
        const float* sp = SSP + (size_t)(t0 + tokl) * 16;
        const f32x4 s0 = *(const f32x4*)sp, s1 = *(const f32x4*)(sp + 4), s2 = *(const f32x4*)(sp + 8), s3 = *(const f32x4*)(sp + 12);
        const float ssq = ((s0[0] + s0[1]) + (s0[2] + s0[3])) + ((s1[0] + s1[1]) + (s1[2] + s1[3])) + ((s2[0] + s2[1]) + (s2[2] + s2[3])) + ((s3[0] + s3[1]) + (s3[2] + s3[3]));
        const float rstd = 1.0f / sqrtf(ssq * (1.f / DM) + 1e-6f);
        float tv0[16], tv1[16], cv[16];
#pragma unroll
        for (int p = 0; p < 2; ++p) {
            bf16x8 af[2][2][4];
#pragma unroll
            for (int hs = 0; hs < 2; ++hs)
#pragma unroll
                for (int mt = 0; mt < 2; ++mt) { const bf16* qp = Q + (size_t)(t0 + mt * 16 + fr) * 2048 + (hp + 4 * hs) * 256 + p * 128 + fq * 8;
#pragma unroll
                    for (int ks = 0; ks < 4; ++ks) af[hs][mt][ks] = *(const bf16x8*)(qp + ks * 32); }
            float tv[16];
#pragma unroll
            for (int i = 0; i < 16; ++i) tv[i] = -3.0e38f;
            for (int half = 0; half < 2; ++half) {
                topk_scores64(Q, KB, SC, t0, hp, p, half, lane, af);
                LDS_WAIT();
                const LAS float* mine = SC + lane * TK_STRIDE;
                unsigned kmask = 0xFFFFFF80u; asm volatile("" : "+v"(kmask));
#pragma unroll 1
                for (int n = 0; n < 64; n += 16) {
                    float g[16];
#pragma unroll
                    for (int q = 0; q < 4; ++q) { const f32x4 x4 = *(const LAS f32x4*)(mine + n + 4 * q);
#pragma unroll
                        for (int e = 0; e < 4; ++e) g[4 * q + e] = __uint_as_float((__float_as_uint(x4[e]) & kmask) | (unsigned)(half * 64 + n + 4 * q + e)); }
                    tk_sort16(g); tk_merge16(tv, g);
                }
                LDS_WAIT();
            }
#pragma unroll
            for (int i = 0; i < 16; ++i) { if (p == 0) tv0[i] = tv[i]; else tv1[i] = tv[i]; }
        }
        LAS int* li = (LAS int*)SC + lane * 33;
#pragma unroll
        for (int q = 0; q < 16; ++q) { li[q] = (int)(__float_as_uint(tv0[q]) & 127u); li[16 + q] = (int)(__float_as_uint(tv1[q]) & 127u);
            tv0[q] = __uint_as_float(__float_as_uint(tv0[q]) & 0xFFFFFF80u); tv1[q] = __uint_as_float(__float_as_uint(tv1[q]) & 0xFFFFFF80u); }
#pragma unroll
        for (int q = 0; q < 16; ++q) cv[q] = -3.0e38f;
#pragma unroll
        for (int a = 0; a < 16; ++a)
#pragma unroll
            for (int b = 0; b < 16; ++b) if ((a + 1) * (b + 1) <= 16)
                tk_insert(cv, __uint_as_float((__float_as_uint(tv0[a] + tv1[b]) & 0xFFFFFF00u) | (unsigned)(a * 16 + b)));
        LDS_WAIT();
        float e[16], den = 0.f; unsigned ci[16];
        const float c0 = __uint_as_float(__float_as_uint(cv[0]) & 0xFFFFFF00u);
#pragma unroll
        for (int q = 0; q < 16; ++q) { const unsigned kb = __float_as_uint(cv[q]); const float cq = __uint_as_float(kb & 0xFFFFFF00u);
            e[q] = __expf((cq - c0) * rstd); den += e[q]; ci[q] = (unsigned)(li[(kb >> 4) & 15] * 128 + li[16 + (kb & 15)]); }
        const float inv = 1.0f / den;
        LDS_WAIT();
        {
            const size_t tok = (size_t)(t0 + tokl);
            v4u w0, w1; w0.x = ci[0] | (ci[1] << 16); w0.y = ci[2] | (ci[3] << 16); w0.z = ci[4] | (ci[5] << 16); w0.w = ci[6] | (ci[7] << 16);
            w1.x = ci[8] | (ci[9] << 16); w1.y = ci[10] | (ci[11] << 16); w1.z = ci[12] | (ci[13] << 16); w1.w = ci[14] | (ci[15] << 16);
            *(v4u*)(EIDX + tok * 128 + h * 16) = w0; *(v4u*)(EIDX + tok * 128 + h * 16 + 8) = w1;
#pragma unroll
            for (int q = 0; q < 4; ++q) *(f32x4*)(GATE + tok * 128 + h * 16 + 4 * q) = (f32x4){e[4 * q] * inv, e[4 * q + 1] * inv, e[4 * q + 2] * inv, e[4 * q + 3] * inv};
            if (h == 0) RSTD[tok] = rstd;
        }
    }
}

__device__ __forceinline__ bool peer_topk_split(int G) { return G == 256; }
__device__ __forceinline__ void peer_topk_phase(const Args& A, LAS unsigned char* lds, int tid, int lane, int wave, int vcu, int G) {
    peer_topk_units(A, lds, lane, wave, wave * G + vcu, peer_topk_split(G) ? TK_NPROMPT_UNITS : TK_NPROMPT_UNITS + TK_NSAMPLE_UNITS, G * NWAVES);
}
__device__ __forceinline__ void peer_topk_sample_prelude(const Args& A, LAS unsigned char* lds, int tid, int lane, int wave, int vcu, int G, gu32* ctl) {
    if (!peer_topk_split(G) || (vcu & 31) != 0) return;
    peer_topk_units(A, lds, lane, wave, TK_NPROMPT_UNITS + (vcu >> 5) * NWAVES + wave, TK_NPROMPT_UNITS + TK_NSAMPLE_UNITS, TK_NSAMPLE_UNITS);
    asm volatile("s_waitcnt vmcnt(0)" ::: "memory");
    __syncthreads();
    if (tid == 0) { __builtin_amdgcn_fence(__ATOMIC_RELEASE, "agent"); asm volatile("s_waitcnt vmcnt(0)" ::: "memory"); (void)__hip_atomic_fetch_add((unsigned*)(ctl + CW_TKS), 1u, RLX_AGENT); }
    __syncthreads();
}
__device__ __forceinline__ void peer_topk_sample_wait(gu32* ctl, int tid) {
    if (tid == 0) {
        unsigned sp = 0;
        while (__hip_atomic_load((unsigned*)(ctl + CW_TKS), RLX_AGENT) < (unsigned)(TK_NSAMPLE_UNITS / NWAVES)) { __builtin_amdgcn_s_sleep(2); if (++sp > (1u << 22)) break; }
        __builtin_amdgcn_fence(__ATOMIC_ACQUIRE, "agent");
        asm volatile("s_waitcnt vmcnt(0)" ::: "memory");
    }
    __syncthreads();
}

constexpr int PEER_ITEM = 40, NITEM128 = NTOK / PEER_ITEM;
__device__ __forceinline__ bool peer_next_item(gu32* qbase, int xcc, int& qs, int& slice, int& item, LAS unsigned char* lds, int tid) {
    LAS int* box = (LAS int*)(lds + LDSCTL_OFF + 64);
    for (;;) {
        if (qs >= 8) return false;
        slice = (xcc + qs) & 7;
        if (tid == 0) box[0] = (int)__hip_atomic_fetch_add((unsigned*)(qbase + 64 * slice), 1u, RLX_AGENT);
        __syncthreads();
        item = box[0];
        __syncthreads();
        if (item < NITEM128) return true;
        ++qs;
    }
}

__device__ __forceinline__ void peer_u_phase(const Args& A, LAS unsigned char* lds, int tid, int lane, int wave, gu32* ctl, int qoff) {
    const unsigned char* Uq = A.ws + WS_UB; const bf16* XG = (const bf16*)(A.ws + WS_A1);
    const unsigned short* EIDX = (const unsigned short*)(A.ws + WS_EIDX); float* PART = (float*)(A.ws + WS_PART);
    const int xcc = (int)(xb_xcc_id() & 7u), rg = lane >> 3, c8 = lane & 7;
    LAS int* we = (LAS int*)(lds + wave * 1024);
    int qs = 0, slice, item; bool lists_ready = !peer_topk_split((int)gridDim.x);
    while (peer_next_item(ctl + CW_QU + qoff, xcc, qs, slice, item, lds, tid)) {
        if (!lists_ready && (item + 1) * PEER_ITEM > NPROMPT) { peer_topk_sample_wait(ctl, tid); lists_ready = true; }
        const unsigned char* us = Uq + (size_t)slice * 16384 * 128; const unsigned uoff = (unsigned)c8 * 16u;
        size_t tok = (size_t)(item * PEER_ITEM + wave);
        unsigned pair = *(const unsigned*)(EIDX + tok * 128 + 2 * lane);
        v4u xa = *(const v4u*)(XG + tok * DM + slice * 128 + c8 * 16), xb = *(const v4u*)(XG + tok * DM + slice * 128 + c8 * 16 + 8);
        for (int tt = 0; tt < PEER_ITEM / NWAVES; ++tt) {
            we[2 * lane] = (int)(pair & 0xffffu); we[2 * lane + 1] = (int)(pair >> 16);
            const f32x2 x[8] = {(f32x2){bf_lo(xa.x), bf_hi(xa.x)}, (f32x2){bf_lo(xa.y), bf_hi(xa.y)}, (f32x2){bf_lo(xa.z), bf_hi(xa.z)}, (f32x2){bf_lo(xa.w), bf_hi(xa.w)},
                                (f32x2){bf_lo(xb.x), bf_hi(xb.x)}, (f32x2){bf_lo(xb.y), bf_hi(xb.y)}, (f32x2){bf_lo(xb.z), bf_hi(xb.z)}, (f32x2){bf_lo(xb.w), bf_hi(xb.w)}};
            LDS_WAIT();
            v4u w[16];
#pragma unroll
            for (int it = 0; it < 16; ++it) w[it] = *(const v4u*)(us + (unsigned)(((unsigned)we[it * 8 + rg] << 7) + uoff));
            const size_t ctok = tok;
            if (tt + 1 < PEER_ITEM / NWAVES) { tok += NWAVES; pair = *(const unsigned*)(EIDX + tok * 128 + 2 * lane);
                xa = *(const v4u*)(XG + tok * DM + slice * 128 + c8 * 16); xb = *(const v4u*)(XG + tok * DM + slice * 128 + c8 * 16 + 8); }
            float dlo = 0.f, dhi = 0.f;
#pragma unroll
            for (int it = 0; it < 16; ++it) {
                f32x2 d = __builtin_amdgcn_cvt_pk_f32_fp8(w[it].x, false) * x[0]; d += __builtin_amdgcn_cvt_pk_f32_fp8(w[it].x, true) * x[1];
                d += __builtin_amdgcn_cvt_pk_f32_fp8(w[it].y, false) * x[2]; d += __builtin_amdgcn_cvt_pk_f32_fp8(w[it].y, true) * x[3];
                d += __builtin_amdgcn_cvt_pk_f32_fp8(w[it].z, false) * x[4]; d += __builtin_amdgcn_cvt_pk_f32_fp8(w[it].z, true) * x[5];
                d += __builtin_amdgcn_cvt_pk_f32_fp8(w[it].w, false) * x[6]; d += __builtin_amdgcn_cvt_pk_f32_fp8(w[it].w, true) * x[7];
                const float ds = sum8(d.x + d.y);
                if ((it & 7) == c8) { if (it < 8) dlo = ds; else dhi = ds; }
            }
            float* pp = PART + (ctok * 8 + slice) * 128;
            pp[c8 * 8 + rg] = dlo; pp[(c8 + 8) * 8 + rg] = dhi;
            LDS_WAIT();
        }
    }
}

__device__ __forceinline__ void peer_coef_phase(const Args& A, int lane, int wave, int vcu, int G) {
    const float* PART = (const float*)(A.ws + WS_PART); const float* GATE = (const float*)(A.ws + WS_GATE); const float* RSTD = (const float*)(A.ws + WS_RSTD);
    float* COEF = (float*)(A.ws + WS_COEF);
    for (int tok = vcu * NWAVES + wave; tok < NTOK; tok += G * NWAVES) {
        const float* pp = PART + (size_t)tok * 1024 + 2 * lane;
        f32x2 d = *(const f32x2*)pp;
#pragma unroll
        for (int j = 1; j < 8; ++j) d += *(const f32x2*)(pp + j * 128);
        const float sc = RSTD[tok] * (1.0f / PEER_SU); const f32x2 gt = *(const f32x2*)(GATE + (size_t)tok * 128 + 2 * lane);
        f32x2 cf; cf.x = gt.x * gelu_tanh(d.x * sc) * (1.0f / PEER_SV); cf.y = gt.y * gelu_tanh(d.y * sc) * (1.0f / PEER_SV);
        *(f32x2*)(COEF + (size_t)tok * 128 + 2 * lane) = cf;
    }
}

__device__ __forceinline__ void peer_v_phase(const Args& A, LAS unsigned char* lds, int tid, int lane, int wave, gu32* ctl) {
    const unsigned char* Vq = A.ws + WS_VB;
    const unsigned short* EIDX = (const unsigned short*)(A.ws + WS_EIDX); const float* COEF = (const float*)(A.ws + WS_COEF);
    float* X1 = A.out + O_Y; float* SS2 = (float*)(A.ws + WS_SS2);
    const int xcc = (int)(xb_xcc_id() & 7u), rg = lane >> 3, c8 = lane & 7;
    LAS int* we = (LAS int*)(lds + wave * 8192);
    LAS float* wc = (LAS float*)(we + 128); LAS float* wp = (LAS float*)(we + 256);
    int qs = 0, slice, item;
    while (peer_next_item(ctl + CW_QV, xcc, qs, slice, item, lds, tid)) {
        const unsigned char* vs = Vq + (size_t)slice * 16384 * 128; const unsigned voff = (unsigned)c8 * 16u;
        size_t tok = (size_t)(item * PEER_ITEM + wave);
        unsigned pair = *(const unsigned*)(EIDX + tok * 128 + 2 * lane); f32x2 cf = *(const f32x2*)(COEF + tok * 128 + 2 * lane);
        const bf16* XGv = (const bf16*)(A.ws + WS_A1);
        const f32x2 g2v = *(const f32x2*)(A.in[I_N2G] + slice * 128 + 2 * lane); const f32x2 rg2 = (f32x2){1.0f / g2v.x, 1.0f / g2v.y};
        unsigned xold = *(const unsigned*)(XGv + tok * DM + slice * 128 + 2 * lane);
        for (int tt = 0; tt < PEER_ITEM / NWAVES; ++tt) {
            we[2 * lane] = (int)(pair & 0xffffu); we[2 * lane + 1] = (int)(pair >> 16); *(LAS f32x2*)(wc + 2 * lane) = cf;
            const f32x2 xcur = (f32x2){bf_lo(xold) * rg2.x, bf_hi(xold) * rg2.y}; const size_t ctok = tok;
            LDS_WAIT();
            v4u w[16];
#pragma unroll
            for (int it = 0; it < 16; ++it) w[it] = *(const v4u*)(vs + (unsigned)(((unsigned)we[it * 8 + rg] << 7) + voff));
            if (tt + 1 < PEER_ITEM / NWAVES) { tok += NWAVES; pair = *(const unsigned*)(EIDX + tok * 128 + 2 * lane); cf = *(const f32x2*)(COEF + tok * 128 + 2 * lane);
                xold = *(const unsigned*)(XGv + tok * DM + slice * 128 + 2 * lane); }
            f32x2 o[8];
#pragma unroll
            for (int q = 0; q < 8; ++q) o[q] = (f32x2){0.f, 0.f};
#pragma unroll
            for (int it = 0; it < 16; ++it) {
                const float c = wc[it * 8 + rg]; const f32x2 c2 = (f32x2){c, c};
                o[0] += c2 * __builtin_amdgcn_cvt_pk_f32_fp8(w[it].x, false); o[1] += c2 * __builtin_amdgcn_cvt_pk_f32_fp8(w[it].x, true);
                o[2] += c2 * __builtin_amdgcn_cvt_pk_f32_fp8(w[it].y, false); o[3] += c2 * __builtin_amdgcn_cvt_pk_f32_fp8(w[it].y, true);
                o[4] += c2 * __builtin_amdgcn_cvt_pk_f32_fp8(w[it].z, false); o[5] += c2 * __builtin_amdgcn_cvt_pk_f32_fp8(w[it].z, true);
                o[6] += c2 * __builtin_amdgcn_cvt_pk_f32_fp8(w[it].w, false); o[7] += c2 * __builtin_amdgcn_cvt_pk_f32_fp8(w[it].w, true);
            }
#pragma unroll
            for (int q = 0; q < 4; ++q) *(LAS f32x4*)(wp + rg * 128 + c8 * 16 + 4 * q) = (f32x4){o[2 * q].x, o[2 * q].y, o[2 * q + 1].x, o[2 * q + 1].y};
            LDS_WAIT();
            f32x2 acc = *(const LAS f32x2*)(wp + 2 * lane);
#pragma unroll
            for (int r = 1; r < 8; ++r) acc += *(const LAS f32x2*)(wp + r * 128 + 2 * lane);
            const f32x2 x2 = xcur + acc;
            *(f32x2*)(X1 + ctok * DM + slice * 128 + 2 * lane) = x2;
            float ss = sum16(x2.x * x2.x + x2.y * x2.y); ss += __shfl_xor(ss, 16); ss += __shfl_xor(ss, 32);
            if (lane == 0) SS2[ctok * 8 + slice] = ss;
            LDS_WAIT();
        }
    }
}

__device__ __forceinline__ void peer_final_phase(const Args& A, int lane, int wave, int vcu, int G) {
    float* X1 = A.out + O_Y; const float* SS2 = (const float*)(A.ws + WS_SS2); const float* gf = A.in[I_NFG] + lane * 16;
    const f32x4 g0 = *(const f32x4*)gf, g1 = *(const f32x4*)(gf + 4), g2 = *(const f32x4*)(gf + 8), g3 = *(const f32x4*)(gf + 12);
    for (int tok = vcu * NWAVES + wave; tok < NTOK; tok += G * NWAVES) {
        const f32x4 sa = *(const f32x4*)(SS2 + (size_t)tok * 8), sb = *(const f32x4*)(SS2 + (size_t)tok * 8 + 4);
        const float ss = ((sa[0] + sa[1]) + (sa[2] + sa[3])) + ((sb[0] + sb[1]) + (sb[2] + sb[3]));
        const float rf = 1.0f / sqrtf(ss * (1.f / DM) + 1e-6f);
        float* yr = X1 + (size_t)tok * DM + lane * 16;
        const f32x4 y0 = *(const f32x4*)yr, y1 = *(const f32x4*)(yr + 4), y2 = *(const f32x4*)(yr + 8), y3 = *(const f32x4*)(yr + 12);
        *(f32x4*)yr = y0 * rf * g0; *(f32x4*)(yr + 4) = y1 * rf * g1; *(f32x4*)(yr + 8) = y2 * rf * g2; *(f32x4*)(yr + 12) = y3 * rf * g3;
    }
}

__device__ __forceinline__ void sg_partial(const bf16* Ap, int lda, const bf16* Bp, int ldb, LAS f32x4* red, int lane, int wave) {
    const int fr = lane & 15, fq = lane >> 4;
    bf16x8 a[2][4], b[4][4];
#pragma unroll
    for (int mi = 0; mi < 2; ++mi)
#pragma unroll
        for (int ks = 0; ks < 4; ++ks) a[mi][ks] = *(const bf16x8*)(Ap + (size_t)(16 * mi + fr) * lda + 32 * ks + 8 * fq);
#pragma unroll
    for (int nj = 0; nj < 4; ++nj)
#pragma unroll
        for (int ks = 0; ks < 4; ++ks) b[nj][ks] = *(const bf16x8*)(Bp + (size_t)(16 * nj + fr) * ldb + 32 * ks + 8 * fq);
    f32x4 acc[2][4];
#pragma unroll
    for (int mi = 0; mi < 2; ++mi)
#pragma unroll
        for (int nj = 0; nj < 4; ++nj) acc[mi][nj] = (f32x4){0.f, 0.f, 0.f, 0.f};
#pragma unroll
    for (int ks = 0; ks < 4; ++ks)
#pragma unroll
        for (int mi = 0; mi < 2; ++mi)
#pragma unroll
            for (int nj = 0; nj < 4; ++nj) acc[mi][nj] = __builtin_amdgcn_mfma_f32_16x16x32_bf16(b[nj][ks], a[mi][ks], acc[mi][nj], 0, 0, 0);
#pragma unroll
    for (int mi = 0; mi < 2; ++mi)
#pragma unroll
        for (int nj = 0; nj < 4; ++nj) red[(wave * 8 + mi * 4 + nj) * 64 + lane] = acc[mi][nj];
}
__device__ __forceinline__ f32x4 sg_sum(const LAS f32x4* red, int w0, int nw, int wave, int lane) {
    f32x4 s = red[(w0 * 8 + wave) * 64 + lane];
    for (int w = 1; w < nw; ++w) s += red[((w0 + w) * 8 + wave) * 64 + lane];
    return s;
}
__device__ __forceinline__ void sample_gemm2(const Args& A, LAS unsigned char* lds, int t, int lane, int wave) {
    unsigned char* ws = A.ws; const int fr = lane & 15, fq = lane >> 4;
    const int row0 = NPROMPT + (t >> 4) * 32, col0 = (t & 15) * 64;
    LAS f32x4* red = (LAS f32x4*)lds;
    const bf16* Ab = (const bf16*)(ws + WS_A1) + (wave >= 4 ? (size_t)MPAD * 512 : 0); const bf16* Bb = (const bf16*)(ws + (wave >= 4 ? WS_WPB : WS_WPA));
    sg_partial(Ab + (size_t)row0 * 512 + (wave & 3) * 128, 512, Bb + (size_t)col0 * 512 + (wave & 3) * 128, 512, red, lane, wave);
    const int row = row0 + 16 * (wave >> 2) + fr, c = col0 + 16 * (wave & 3) + 4 * fq;
    const bf16* Zg = (const bf16*)(ws + WS_ZG) + (size_t)row * 2048;
    const v2u ga = *(const v2u*)(Zg + c), gb = *(const v2u*)(Zg + 1024 + c);
    __syncthreads();
    const f32x4 pa = sg_sum(red, 0, 4, wave, lane), pb = sg_sum(red, 4, 4, wave, lane);
    const float o0 = sigm(bf_lo(ga.x)) * pa[0] + sigm(bf_lo(gb.x)) * pb[0], o1 = sigm(bf_hi(ga.x)) * pa[1] + sigm(bf_hi(gb.x)) * pb[1],
                o2 = sigm(bf_lo(ga.y)) * pa[2] + sigm(bf_lo(gb.y)) * pb[2], o3 = sigm(bf_hi(ga.y)) * pa[3] + sigm(bf_hi(gb.y)) * pb[3];
    v2u w; w.x = cvt_pk_bf16(o0, o1); w.y = cvt_pk_bf16(o2, o3); *(v2u*)((bf16*)(ws + WS_ZR) + (size_t)row * 1024 + c) = w;
    __syncthreads();
}
__device__ __forceinline__ void sample_gemm3(const Args& A, LAS unsigned char* lds, int t, int tid, int lane, int wave) {
    unsigned char* ws = A.ws; const int fr = lane & 15, fq = lane >> 4;
    const int row0 = NPROMPT + (t >> 4) * 32, col0 = (t & 15) * 64;
    LAS f32x4* red = (LAS f32x4*)lds; LAS float* ssl = (LAS float*)(lds + 65536);
    sg_partial((const bf16*)(ws + WS_ZR) + (size_t)row0 * 1024 + wave * 128, 1024, (const bf16*)(ws + WS_WO) + (size_t)col0 * 1024 + wave * 128, 1024, red, lane, wave);
    const int row = row0 + 16 * (wave >> 2) + fr, c = col0 + 16 * (wave & 3) + 4 * fq;
    const f32x4 xv = *(const f32x4*)(A.in[I_XS] + (size_t)(row - NPROMPT) * 1024 + c), q = *(const f32x4*)(A.in[I_N2G] + c);
    __syncthreads();
    const f32x4 o = xv + sg_sum(red, 0, 8, wave, lane);
    float ss = (o[0] * o[0] + o[1] * o[1]) + (o[2] * o[2] + o[3] * o[3]);
    v2u w; w.x = cvt_pk_bf16(o[0] * q[0], o[1] * q[1]); w.y = cvt_pk_bf16(o[2] * q[2], o[3] * q[3]); *(v2u*)((bf16*)(ws + WS_A1) + (size_t)row * 1024 + c) = w;
    ss += __shfl_xor(ss, 16); ss += __shfl_xor(ss, 32);
    if (fq == 0) ssl[wave * 16 + fr] = ss;
    __syncthreads();
    if (tid < 32) { const int mi = tid >> 4, r = tid & 15;
        ((float*)(ws + WS_SSP))[(size_t)(row0 + tid) * 16 + (t & 15)] = (ssl[(mi * 4 + 0) * 16 + r] + ssl[(mi * 4 + 1) * 16 + r]) + (ssl[(mi * 4 + 2) * 16 + r] + ssl[(mi * 4 + 3) * 16 + r]); }
}
__device__ __forceinline__ void sample_gemm4(const Args& A, LAS unsigned char* lds, int t, int lane, int wave) {
    unsigned char* ws = A.ws; const int fr = lane & 15, fq = lane >> 4;
    const int row0 = NPROMPT + (t >> 5) * 32, col0 = (t & 31) * 64;
    LAS f32x4* red = (LAS f32x4*)lds;
    sg_partial((const bf16*)(ws + WS_A1) + (size_t)row0 * 1024 + wave * 128, 1024, (const bf16*)(ws + WS_WQ) + (size_t)col0 * 1024 + wave * 128, 1024, red, lane, wave);
    const int row = row0 + 16 * (wave >> 2) + fr, c = col0 + 16 * (wave & 3) + 4 * fq;
    __syncthreads();
    const f32x4 o = sg_sum(red, 0, 8, wave, lane);
    v2u w; w.x = cvt_pk_bf16(o[0], o[1]); w.y = cvt_pk_bf16(o[2], o[3]); *(v2u*)((bf16*)(ws + WS_ZG) + (size_t)row * 2048 + c) = w;
    __syncthreads();
}

__global__ void __launch_bounds__(NTHR, 2) mk_fwd(Args args) {
    extern __shared__ __attribute__((aligned(16))) unsigned char lds_raw[];
    LAS unsigned char* lds = (LAS unsigned char*)lds_raw;
    const int tid = threadIdx.x, lane = tid & 63, wave = __builtin_amdgcn_readfirstlane(tid >> 6);
    const int G = gridDim.x; const int bx = blockIdx.x; const int vcu = (G % 8 == 0) ? (bx % 8) * (G / 8) + bx / 8 : bx;
    gu32* ctl = (gu32*)(args.ws + WS_CTL);
    volatile LAS unsigned* MISC = (volatile LAS unsigned*)(lds + MISC_OFF);
    for (int u = tid; u < (LDS_BYTES - LDSCTL_OFF) / 4; u += NTHR) ((LAS unsigned*)(lds + LDSCTL_OFF))[u] = 0u;
    __syncthreads();
    XcdBarrier bar; bar.bar = (unsigned*)(ctl + CW_BAR) + args.li * XCD_BAR_WORDS; bar.x = 0; bar.st = nullptr;
    if (N_LAUNCHES != PER_PHASE) bar = xcd_barrier_post((unsigned*)(ctl + CW_BAR) + args.li * XCD_BAR_WORDS, MISC + 8);
    const int lo = args.ph_lo, hi = args.ph_hi;
#define IN(k) (lo <= (k) && (k) < hi)
#define BOTH(k) (IN(k) && IN((k) + 1))
#define GRID_BAR() do { if (N_LAUNCHES != PER_PHASE) xcd_barrier(bar); } while (0)
    unsigned char* ws = args.ws;
    bf16* A1 = (bf16*)(ws + WS_A1);

    if (IN(0)) for (int rep_ = 0; rep_ < ((MK_REPEAT == 0) ? 2 : 1); ++rep_) { p0_prologue(args, lds, tid, lane, wave, vcu, G); if (BOTH(0)) GRID_BAR(); }

    if (IN(1)) for (int rep_ = 0; rep_ < ((MK_REPEAT == 1) ? 2 : 1); ++rep_) {
        pg8::Gemm g{A1, (const bf16*)(ws + WS_W1T), MPAD, N1, DM}; pg8::StaticOrder S; S.init(MPAD, N1, G, bx);
        pg8::EpiZ E{(bf16*)(ws + WS_ZC), (bf16*)(ws + WS_ZR), (bf16*)(ws + WS_ZG)};
        pg8::gemm_phase<pg8::EpiZ, pg8::StaticOrder, true, true>(lds, g, S, E);
        if (BOTH(1)) GRID_BAR();
    }

    if (IN(2)) for (int rep_ = 0; rep_ < ((MK_REPEAT == 2) ? 2 : 1); ++rep_) { conv_phase(args, vcu * NTHR + tid, G * NTHR); if (BOTH(2)) GRID_BAR(); }

    if (IN(3)) for (int rep_ = 0; rep_ < ((MK_REPEAT == 3) ? 2 : 1); ++rep_) {
        scan_pass1(args, lds, tid, lane, wave, vcu, G, (MK_REPEAT == 3 && rep_ == 0) ? 1 : 0);
        if (BOTH(3)) GRID_BAR();
    }

    if (IN(4)) {
        for (int u = vcu; u < 512; u += G) {
            if (u < 256) { const int bh = u >> 2, vq = u & 3; scan_pass2_rows(nullptr, bh * 64, 64, vq * 16, args.out + O_WKV_P + (size_t)bh * 4096, true, args, lds, tid, lane, wave); }
            else { const int bh = u - 256;
                for (int vq = 0; vq < 4; ++vq) scan_pass2_rows(args.in[I_SWKV] + (size_t)bh * 4096, NUNITS_P + bh, 1, vq * 16, args.out + O_WKV_S + (size_t)bh * 4096, false, args, lds, tid, lane, wave); }
        }
        if (BOTH(4)) GRID_BAR();
    }

    if (IN(5)) for (int rep_ = 0; rep_ < ((MK_REPEAT == 5) ? 2 : 1); ++rep_) {
        for (int u2 = vcu; u2 < NUNITS / 2; u2 += G) scan_pass3_wave(args, u2 * 2 + (wave >> 2), wave & 3, lane);
        if (BOTH(5)) GRID_BAR();
    }

    if (IN(6)) {
        { pg8::Gemm g{A1, (const bf16*)(ws + WS_WPA), NPROMPT, DM, 512}; pg8::StaticOrder S; S.init(NPROMPT, DM, G, bx);
          pg8::EpiGate<0> E{(const bf16*)(ws + WS_ZG), (bf16*)(ws + WS_ZR)};
          pg8::gemm_phase<pg8::EpiGate<0>, pg8::StaticOrder, true, true>(lds, g, S, E); }
        { pg8::Gemm g{A1 + (size_t)MPAD * 512, (const bf16*)(ws + WS_WPB), NPROMPT, DM, 512}; pg8::StaticOrder S; S.init(NPROMPT, DM, G, bx);
          pg8::EpiGate<1> E{(const bf16*)(ws + WS_ZG), (bf16*)(ws + WS_ZR)};
          pg8::gemm_phase<pg8::EpiGate<1>, pg8::StaticOrder, true, true>(lds, g, S, E); }
        for (int t = vcu; t < 256; t += G) sample_gemm2(args, lds, t, lane, wave);
        if (BOTH(6)) GRID_BAR();
    }

    if (IN(7)) for (int rep_ = 0; rep_ < ((MK_REPEAT == 7) ? 2 : 1); ++rep_) {
        pg8::Gemm g{(const bf16*)(ws + WS_ZR), (const bf16*)(ws + WS_WO), NPROMPT, DM, DM}; pg8::StaticOrder S; S.init(NPROMPT, DM, G, bx);
        pg8::EpiX1 E{args.in[I_XP], args.in[I_XS], args.out + O_Y, A1, (float*)(ws + WS_SSP), args.in[I_N2G], NPROMPT, NTOK};
        pg8::gemm_phase<pg8::EpiX1, pg8::StaticOrder, true, true>(lds, g, S, E);
        for (int t = vcu; t < 256; t += G) sample_gemm3(args, lds, t, tid, lane, wave);
        if (BOTH(7)) GRID_BAR();
    }

    if (IN(8)) for (int rep_ = 0; rep_ < ((MK_REPEAT == 8) ? 2 : 1); ++rep_) {
        pg8::Gemm g{A1, (const bf16*)(ws + WS_WQ), NPROMPT, 2048, DM}; pg8::StaticOrder S; S.init(NPROMPT, 2048, G, bx);
        pg8::EpiPlain E{(bf16*)(ws + WS_ZG), 2048};
        pg8::gemm_phase<pg8::EpiPlain, pg8::StaticOrder, true, true>(lds, g, S, E);
        for (int t = vcu; t < 512; t += G) sample_gemm4(args, lds, t, lane, wave);
        if (BOTH(8)) GRID_BAR();
    }

    if (IN(9)) for (int rep_ = 0; rep_ < ((MK_REPEAT == 9) ? 2 : 1); ++rep_) { peer_topk_phase(args, lds, tid, lane, wave, vcu, G); if (BOTH(9)) GRID_BAR(); }
    if (IN(10)) for (int rep_ = 0; rep_ < ((MK_REPEAT == 10) ? 2 : 1); ++rep_) { if (rep_ == 0) peer_topk_sample_prelude(args, lds, tid, lane, wave, vcu, G, ctl); peer_u_phase(args, lds, tid, lane, wave, ctl, rep_ * 1024); if (BOTH(10)) GRID_BAR(); }
    if (IN(11)) { peer_coef_phase(args, lane, wave, vcu, G); if (BOTH(11)) GRID_BAR(); }
    if (IN(12)) { peer_v_phase(args, lds, tid, lane, wave, ctl); if (BOTH(12)) GRID_BAR(); }
    if (IN(13)) peer_final_phase(args, lane, wave, vcu, G);
#undef IN
#undef BOTH
#undef GRID_BAR
}

extern "C" void kernel_launch(void* const* d_in, const int* in_sizes, int n_in, void* d_out, int out_size, void* d_ws, size_t ws_size, hipStream_t stream) {
    static int grid = 0;
    if (grid == 0) {
        if (n_in != 32 || ws_size < WS_END) { fprintf(stderr, "kernel_launch: built for 32 inputs and >= %zu bytes of workspace; got n_in %d ws %zu; nothing launched\n", (size_t)WS_END, n_in, ws_size); grid = -1; return; }
        int dev = 0, cus = 0, per_cu = 0;
        if (hipGetDevice(&dev) != hipSuccess || hipDeviceGetAttribute(&cus, hipDeviceAttributeMultiprocessorCount, dev) != hipSuccess) { fprintf(stderr, "kernel_launch: device query failed\n"); grid = -1; return; }
        if (hipFuncSetAttribute((const void*)mk_fwd, hipFuncAttributeMaxDynamicSharedMemorySize, LDS_BYTES) != hipSuccess) { fprintf(stderr, "kernel_launch: hipFuncSetAttribute failed\n"); grid = -1; return; }
        if (hipOccupancyMaxActiveBlocksPerMultiprocessor(&per_cu, (const void*)mk_fwd, NTHR, LDS_BYTES) != hipSuccess || per_cu < 1)
            fprintf(stderr, "kernel_launch: note: occupancy query reports %d workgroups per CU\n", per_cu);
        (void)hipGetLastError();
        grid = cus;
    }
    if (grid < 0) return;
    if (hipMemsetAsync((char*)d_ws + WS_CTL, 0, CTL_ZERO_BYTES, stream) != hipSuccess) { fprintf(stderr, "kernel_launch: hipMemsetAsync failed\n"); return; }
    Args a{};
    for (int i = 0; i < 32; ++i) a.in[i] = (const float*)d_in[i];
    a.out = (float*)d_out; a.ws = (unsigned char*)d_ws;
    constexpr int NL = (N_LAUNCHES == PER_PHASE ? PER_PHASE : 1) + ((MK_EXTRA_LO >= 0) ? 1 : 0);
    for (int li = 0; li < NL; ++li) {
        if (N_LAUNCHES == PER_PHASE) { a.ph_lo = li; a.ph_hi = li + 1; } else { a.ph_lo = 0; a.ph_hi = PER_PHASE; }
        if (MK_EXTRA_LO >= 0 && li == NL - 1) { a.ph_lo = MK_EXTRA_LO; a.ph_hi = MK_EXTRA_HI; }
        a.li = li;
        hipLaunchKernelGGL(mk_fwd, dim3(grid), dim3(NTHR), LDS_BYTES, stream, a);
        const hipError_t le = hipPeekAtLastError();
        if (le != hipSuccess) { fprintf(stderr, "kernel_launch: launch %d failed: %s\n", li, hipGetErrorName(le)); break; }
    }
}
```

```cpp
#include <hip/hip_runtime.h>
#include <cstdio>
#include <cstdint>
#define MK_N_LAUNCHES 1
#define MK_REPEAT -1
#define MK_DBGSEL 0
#define MK_EXTRA_LO -1
#define MK_EXTRA_HI -1
namespace pg8 {
#define PG8_LAS __attribute__((address_space(3)))
typedef unsigned short bf16_t;
typedef short bf16x8 __attribute__((ext_vector_type(8)));
typedef float f32x4 __attribute__((ext_vector_type(4)));
typedef unsigned u32x4 __attribute__((ext_vector_type(4)));
constexpr int BM = 256, BK = 64, HALF = 128, HTB = HALF * BK * 2  , STAGE_BYTES = 8 * HTB, NXCD = 8, WGM = 8;

__host__ __device__ __forceinline__ int lds_byte(int r, int c) { const int st = (r >> 4) * 2 + (c >> 5), rr = r & 15, cc = c & 31, ob = rr * 64 + cc * 2; return st * 1024 + (ob ^ (((ob >> 9) & 1) << 5)); }
__host__ __device__ __forceinline__ void stage_rc(int b, int& R, int& C) { const int st = b / 1024, sb = b % 1024, swz = sb ^ (((sb >> 9) & 1) << 5); R = (st >> 1) * 16 + swz / 64; C = (st & 1) * 32 + (swz % 64) / 2; }
__host__ __device__ __forceinline__ int perm32(int rho) { const int n = rho >> 4, i = rho & 15; return 8 * (i >> 2) + 4 * n + (i & 3); }

struct Unit { int pm, pn; };
struct Gemm { const bf16_t* A; const bf16_t* Bt; int M, N, K; };

struct StaticOrder {
    int nM, nN, nwg, G, c;
    __host__ __device__ void init(int M, int N, int G_, int c_) { nM = M / BM; nN = N / BM; nwg = nM * nN; G = G_; c = c_; }
    __host__ __device__ bool next(int i, Unit& u) const {
        const long L = (long)i * G + c; if (L >= nwg) return false;
        int wgid = (int)L; { const int q = nwg / NXCD, r = nwg % NXCD, xcd = wgid % NXCD, off = wgid / NXCD; wgid = (xcd < r ? xcd * (q + 1) : r * (q + 1) + (xcd - r) * q) + off; }
        const int nig = WGM * nN, gid = wgid / nig, fm = gid * WGM, gsz = (nM - fm) < WGM ? (nM - fm) : WGM;
        u.pm = fm + ((wgid % nig) % gsz); u.pn = (wgid % nig) / gsz; return true;
    }
    __device__ __forceinline__ void a_ready(const Unit&) const {}
    __device__ __forceinline__ void done(const Unit&) const {}
};

typedef __bf16 bf16x2_cv __attribute__((ext_vector_type(2))); typedef float f32x2_cv __attribute__((ext_vector_type(2)));
__device__ __forceinline__ unsigned cvt_pk_bf16(float lo, float hi) { return __builtin_bit_cast(unsigned, __builtin_convertvector((f32x2_cv){lo, hi}, bf16x2_cv)); }
__device__ __forceinline__ float bf_lo(unsigned w) { return __uint_as_float(w << 16); }
__device__ __forceinline__ float bf_hi(unsigned w) { return __uint_as_float(w & 0xffff0000u); }
__device__ __forceinline__ float sigm(float x) { return __builtin_amdgcn_rcpf(1.0f + __expf(-x)); }

struct EpiZ {
    static constexpr bool PERM = true, AFTER_DRAIN = false;
    bf16_t *Zc, *Zr, *Zg;
    __device__ __forceinline__ void operator()(const f32x4 (&acc)[2][2][4][2], const Unit& u, int wr, int wc, int fr, int fq) const {
        bf16_t* base; int ldc, colt;
        if (u.pn < 6) { base = Zc; ldc = 1536; colt = u.pn * BM; }
        else if (u.pn < 14) { base = Zr; ldc = 2048; colt = (u.pn - 6) * BM; }
        else { base = Zg; ldc = 2048; colt = (u.pn - 14) * BM; }
        const int row0 = u.pm * BM + wr * 64 + fr, col0 = colt + wc * 32 + 8 * fq;
#pragma unroll
        for (int ai = 0; ai < 2; ++ai)
#pragma unroll
            for (int m = 0; m < 4; ++m) { bf16_t* rowp = base + (size_t)(row0 + ai * HALF + m * 16) * ldc + col0;
#pragma unroll
                for (int bj = 0; bj < 2; ++bj) { const f32x4 v0 = acc[ai][bj][m][0], v1 = acc[ai][bj][m][1];
                    u32x4 w; w.x = cvt_pk_bf16(v0[0], v0[1]); w.y = cvt_pk_bf16(v0[2], v0[3]); w.z = cvt_pk_bf16(v1[0], v1[1]); w.w = cvt_pk_bf16(v1[2], v1[3]);
                    *(u32x4*)(rowp + bj * HALF) = w; } }
    }
};
struct EpiPlain {
    static constexpr bool PERM = true, AFTER_DRAIN = false;
    bf16_t* O; int ldc;
    __device__ __forceinline__ void operator()(const f32x4 (&acc)[2][2][4][2], const Unit& u, int wr, int wc, int fr, int fq) const {
        const int row0 = u.pm * BM + wr * 64 + fr, col0 = u.pn * BM + wc * 32 + 8 * fq;
#pragma unroll
        for (int ai = 0; ai < 2; ++ai)
#pragma unroll
            for (int m = 0; m < 4; ++m) { bf16_t* rowp = O + (size_t)(row0 + ai * HALF + m * 16) * ldc + col0;
#pragma unroll
                for (int bj = 0; bj < 2; ++bj) { const f32x4 v0 = acc[ai][bj][m][0], v1 = acc[ai][bj][m][1];
                    u32x4 w; w.x = cvt_pk_bf16(v0[0], v0[1]); w.y = cvt_pk_bf16(v0[2], v0[3]); w.z = cvt_pk_bf16(v1[0], v1[1]); w.w = cvt_pk_bf16(v1[2], v1[3]);
                    *(u32x4*)(rowp + bj * HALF) = w; } }
    }
};
template <int SECOND> struct EpiGate {
    static constexpr bool PERM = true, AFTER_DRAIN = false;
    const bf16_t* Zg; bf16_t* MG;
    __device__ __forceinline__ void operator()(const f32x4 (&acc)[2][2][4][2], const Unit& u, int wr, int wc, int fr, int fq) const {
        const int row0 = u.pm * BM + wr * 64 + fr, col0 = u.pn * BM + wc * 32 + 8 * fq;
#pragma unroll
        for (int ai = 0; ai < 2; ++ai) {
            u32x4 gw[4][2], pw[4][2];
#pragma unroll
            for (int m = 0; m < 4; ++m) { const int r = row0 + ai * HALF + m * 16;
#pragma unroll
                for (int bj = 0; bj < 2; ++bj) { gw[m][bj] = *(const u32x4*)(Zg + (size_t)r * 2048 + SECOND * 1024 + col0 + bj * HALF);
                    if (SECOND) pw[m][bj] = *(const u32x4*)(MG + (size_t)r * 1024 + col0 + bj * HALF); } }
#pragma unroll
            for (int m = 0; m < 4; ++m) { const int r = row0 + ai * HALF + m * 16; bf16_t* op = MG + (size_t)r * 1024 + col0;
#pragma unroll
                for (int bj = 0; bj < 2; ++bj) { const u32x4 g = gw[m][bj]; f32x4 v0 = acc[ai][bj][m][0], v1 = acc[ai][bj][m][1];
                    v0[0] *= sigm(bf_lo(g.x)); v0[1] *= sigm(bf_hi(g.x)); v0[2] *= sigm(bf_lo(g.y)); v0[3] *= sigm(bf_hi(g.y));
                    v1[0] *= sigm(bf_lo(g.z)); v1[1] *= sigm(bf_hi(g.z)); v1[2] *= sigm(bf_lo(g.w)); v1[3] *= sigm(bf_hi(g.w));
                    if (SECOND) { const u32x4 p = pw[m][bj];
                        v0[0] += bf_lo(p.x); v0[1] += bf_hi(p.x); v0[2] += bf_lo(p.y); v0[3] += bf_hi(p.y);
                        v1[0] += bf_lo(p.z); v1[1] += bf_hi(p.z); v1[2] += bf_lo(p.w); v1[3] += bf_hi(p.w); }
                    u32x4 w; w.x = cvt_pk_bf16(v0[0], v0[1]); w.y = cvt_pk_bf16(v0[2], v0[3]); w.z = cvt_pk_bf16(v1[0], v1[1]); w.w = cvt_pk_bf16(v1[2], v1[3]);
                    *(u32x4*)(op + bj * HALF) = w; } }
        }
    }
};
struct EpiX1 {
    static constexpr bool PERM = false, AFTER_DRAIN = false;
    const float* xp; const float* xs; float* X1; bf16_t* X1B; float* SSP; const float* g2; int nprompt, nrows;
    __device__ __forceinline__ void operator()(const f32x4 (&acc)[2][2][4][2], const Unit& u, int wr, int wc, int fr, int fq) const {
        typedef unsigned u32x2v __attribute__((ext_vector_type(2)));
        const int col0 = u.pn * BM + wc * 32 + 4 * fq;
        f32x4 gq[2][2];
#pragma unroll
        for (int bj = 0; bj < 2; ++bj)
#pragma unroll
            for (int n = 0; n < 2; ++n) gq[bj][n] = *(const f32x4*)(g2 + col0 + bj * HALF + n * 16);
#pragma unroll
        for (int ai = 0; ai < 2; ++ai) {
            f32x4 xv[4][2][2];
#pragma unroll
            for (int m = 0; m < 4; ++m) { int r = u.pm * BM + ai * HALF + wr * 64 + m * 16 + fr; r = r < nrows ? r : nrows - 1;
                const float* xr = r < nprompt ? xp + (size_t)r * 1024 : xs + (size_t)(r - nprompt) * 1024;
#pragma unroll
                for (int bj = 0; bj < 2; ++bj)
#pragma unroll
                    for (int n = 0; n < 2; ++n) xv[m][bj][n] = *(const f32x4*)(xr + col0 + bj * HALF + n * 16); }
#pragma unroll
            for (int m = 0; m < 4; ++m) { const int r = u.pm * BM + ai * HALF + wr * 64 + m * 16 + fr; float ss = 0.f;
#pragma unroll
                for (int bj = 0; bj < 2; ++bj)
#pragma unroll
                    for (int n = 0; n < 2; ++n) { const int c = col0 + bj * HALF + n * 16; const f32x4 o = xv[m][bj][n] + acc[ai][bj][m][n];
                        ss += (o[0] * o[0] + o[1] * o[1]) + (o[2] * o[2] + o[3] * o[3]);
                        const f32x4 q = gq[bj][n]; u32x2v w; w.x = cvt_pk_bf16(o[0] * q[0], o[1] * q[1]); w.y = cvt_pk_bf16(o[2] * q[2], o[3] * q[3]);
                        if (r < nrows) *(u32x2v*)(X1B + (size_t)r * 1024 + c) = w; }
                ss += __shfl_xor(ss, 16); ss += __shfl_xor(ss, 32);
                if (fq == 0 && r < nrows) SSP[(size_t)r * 16 + u.pn * 4 + wc] = ss;
            }
        }
    }
};
template <class Epi, class Sched, bool ALIGN_EPI = false, bool SP2 = false>
__device__ __forceinline__ void gemm_phase(PG8_LAS unsigned char* lds, const Gemm g, const Sched& S, const Epi& E) {
    const int tid = threadIdx.x, wid = __builtin_amdgcn_readfirstlane(tid >> 6), lane = tid & 63, wr = wid >> 2, wc = wid & 3, fr = lane & 15, fq = lane >> 4;
    const int K = g.K, nt = K / BK;
    unsigned voffA[2], voffB[2];
#pragma unroll
    for (int i = 0; i < 2; ++i) { int R, C; stage_rc(tid * 16 + i * 8192, R, C); const int Rb = Epi::PERM ? ((R & ~31) + perm32(R & 31)) : R;
        voffA[i] = (unsigned)(R * K + C) * 2u; voffB[i] = (unsigned)(Rb * K + C) * 2u; }
    const size_t kstep = (size_t)(BK * 2);
    const size_t hstep = (size_t)HALF * K * 2;
    const size_t tstep = 2 * hstep;
    const unsigned ldsw = (unsigned)wid * 1024u;
    const int aoff = lds_byte(wr * 64 + fr, fq * 8), boff = lds_byte(wc * 32 + fr, fq * 8);
#define PG8_SA(b, h) (((b) * 2 + (h)) * HTB)
#define PG8_SB(b, h) ((4 + (b) * 2 + (h)) * HTB)
#define PG8_STAGE(bufoff, gbase, voff) do { _Pragma("unroll") for (int _i = 0; _i < 2; ++_i) \
        __builtin_amdgcn_global_load_lds((const unsigned*)((const char*)(gbase) + (voff)[_i]), (PG8_LAS unsigned*)(lds + (bufoff) + ldsw + _i * 8192), 16, 0, 0); } while (0)
#define PG8_LDA(dst, b, h) do { _Pragma("unroll") for (int m = 0; m < 4; ++m) _Pragma("unroll") for (int k = 0; k < 2; ++k) dst[m][k] = *(const PG8_LAS bf16x8*)(lds + PG8_SA(b, h) + aoff + m * 2048 + k * 1024); } while (0)
#define PG8_LDB(dst, b, h) do { _Pragma("unroll") for (int n = 0; n < 2; ++n) _Pragma("unroll") for (int k = 0; k < 2; ++k) dst[n][k] = *(const PG8_LAS bf16x8*)(lds + PG8_SB(b, h) + boff + n * 2048 + k * 1024); } while (0)
#define PG8_MMA(ai, bj, At, Bt) do { __builtin_amdgcn_s_setprio(1); _Pragma("unroll") for (int m = 0; m < 4; ++m) _Pragma("unroll") for (int n = 0; n < 2; ++n) _Pragma("unroll") for (int k = 0; k < 2; ++k) \
        acc[ai][bj][m][n] = __builtin_amdgcn_mfma_f32_16x16x32_bf16(Bt[n][k], At[m][k], acc[ai][bj][m][n], 0, 0, 0); __builtin_amdgcn_s_setprio(0); } while (0)
#define PG8_WAIT_V(n) asm volatile("s_waitcnt vmcnt(" #n ")" ::: "memory")
#define PG8_WAIT_L(n) asm volatile("s_waitcnt lgkmcnt(" #n ")" ::: "memory")
#define PG8_BAR __builtin_amdgcn_s_barrier()
#define PG8_SCHED __builtin_amdgcn_sched_barrier(0)
    Unit cur, nxt; int ui = 0;
    if (!S.next(0, cur)) return;
    f32x4 acc[2][2][4][2];
#pragma unroll
    for (int a = 0; a < 2; ++a)
#pragma unroll
        for (int b = 0; b < 2; ++b)
#pragma unroll
            for (int m = 0; m < 4; ++m)
#pragma unroll
                for (int n = 0; n < 2; ++n) acc[a][b][m][n] = (f32x4){0.f, 0.f, 0.f, 0.f};
    bf16x8 At[4][2], B0[2][2], B1[2][2];
    const char* cA = (const char*)g.A + (size_t)cur.pm * tstep; const char* cB = (const char*)g.Bt + (size_t)cur.pn * tstep;
    S.a_ready(cur);
    if constexpr (SP2) {
        PG8_STAGE(PG8_SB(0, 0), cB, voffB); PG8_STAGE(PG8_SB(0, 1), cB + hstep, voffB); PG8_STAGE(PG8_SA(0, 0), cA, voffA); PG8_STAGE(PG8_SA(0, 1), cA + hstep, voffA);
        if (wr == 1) PG8_BAR;
        PG8_WAIT_V(2); PG8_BAR;
        PG8_STAGE(PG8_SB(1, 0), cB + kstep, voffB); PG8_STAGE(PG8_SA(1, 0), cA + kstep, voffA); PG8_STAGE(PG8_SB(1, 1), cB + hstep + kstep, voffB);
        PG8_WAIT_V(6); PG8_BAR;
    } else {
        PG8_STAGE(PG8_SB(0, 0), cB, voffB); PG8_STAGE(PG8_SA(0, 0), cA, voffA); PG8_STAGE(PG8_SB(0, 1), cB + hstep, voffB); PG8_STAGE(PG8_SA(0, 1), cA + hstep, voffA);
        if (wr == 1) PG8_BAR;
        PG8_WAIT_V(4); PG8_BAR;
        PG8_STAGE(PG8_SB(1, 0), cB + kstep, voffB); PG8_STAGE(PG8_SA(1, 0), cA + kstep, voffA); PG8_STAGE(PG8_SB(1, 1), cB + hstep + kstep, voffB);
        PG8_WAIT_V(6); PG8_BAR;
    }
    for (;;) {
        const bool has_next = S.next(ui + 1, nxt);
        const char* nA = has_next ? (const char*)g.A + (size_t)nxt.pm * tstep : cA; const char* nB = has_next ? (const char*)g.Bt + (size_t)nxt.pn * tstep : cB;
        for (int t = 0; t < nt; t += 2) {
            const bool last = (t == nt - 2);
            const char* a1 = cA + (size_t)(t + 1) * kstep;
            const char* a2 = last ? nA : cA + (size_t)(t + 2) * kstep; const char* b2 = last ? nB : cB + (size_t)(t + 2) * kstep;
            const char* a3 = a2 + kstep; const char* b3 = b2 + kstep;
            if (last && has_next) S.a_ready(nxt);
            if constexpr (SP2) {
            PG8_LDB(B0, 0, 0); PG8_LDB(B1, 0, 1); PG8_SCHED; PG8_LDA(At, 0, 0); PG8_STAGE(PG8_SA(1, 1), a1 + hstep, voffA);
            PG8_WAIT_V(8); PG8_WAIT_L(0); PG8_BAR; PG8_MMA(0, 0, At, B0); PG8_MMA(0, 1, At, B1); PG8_BAR; PG8_SCHED;
            PG8_LDA(At, 0, 1); PG8_STAGE(PG8_SB(0, 0), b2, voffB); PG8_STAGE(PG8_SB(0, 1), b2 + hstep, voffB); PG8_STAGE(PG8_SA(0, 0), a2, voffA);
            PG8_WAIT_V(8); PG8_WAIT_L(0); PG8_BAR; PG8_MMA(1, 0, At, B0); PG8_MMA(1, 1, At, B1); PG8_BAR; PG8_SCHED;
            PG8_LDB(B0, 1, 0); PG8_LDB(B1, 1, 1); PG8_SCHED; PG8_LDA(At, 1, 0); PG8_STAGE(PG8_SA(0, 1), a2 + hstep, voffA);
            PG8_WAIT_V(8); PG8_WAIT_L(0); PG8_BAR; PG8_MMA(0, 0, At, B0); PG8_MMA(0, 1, At, B1); PG8_BAR; PG8_SCHED;
            PG8_LDA(At, 1, 1); PG8_STAGE(PG8_SB(1, 0), b3, voffB); PG8_STAGE(PG8_SB(1, 1), b3 + hstep, voffB); PG8_STAGE(PG8_SA(1, 0), a3, voffA);
            PG8_WAIT_V(8); PG8_WAIT_L(0); PG8_BAR; PG8_MMA(1, 0, At, B0); PG8_MMA(1, 1, At, B1); PG8_BAR; PG8_SCHED;
            } else {
            PG8_LDB(B0, 0, 0); PG8_SCHED; PG8_LDA(At, 0, 0); PG8_STAGE(PG8_SA(1, 1), a1 + hstep, voffA);
            PG8_WAIT_L(8); PG8_BAR; PG8_WAIT_L(0); PG8_MMA(0, 0, At, B0); PG8_BAR; PG8_SCHED;
            PG8_LDB(B1, 0, 1); PG8_STAGE(PG8_SB(0, 0), b2, voffB);
            PG8_BAR; PG8_WAIT_L(0); PG8_MMA(0, 1, At, B1); PG8_BAR;
            PG8_LDA(At, 0, 1); PG8_STAGE(PG8_SA(0, 0), a2, voffA);
            PG8_BAR; PG8_WAIT_L(0); PG8_MMA(1, 0, At, B0); PG8_BAR; PG8_SCHED;
            PG8_STAGE(PG8_SB(0, 1), b2 + hstep, voffB);
            PG8_WAIT_V(6); PG8_BAR; PG8_MMA(1, 1, At, B1); PG8_BAR;
            PG8_LDB(B0, 1, 0); PG8_SCHED; PG8_LDA(At, 1, 0); PG8_STAGE(PG8_SA(0, 1), a2 + hstep, voffA);
            PG8_WAIT_L(8); PG8_BAR; PG8_WAIT_L(0); PG8_MMA(0, 0, At, B0); PG8_BAR; PG8_SCHED;
            PG8_LDB(B1, 1, 1); PG8_STAGE(PG8_SB(1, 0), b3, voffB);
            PG8_BAR; PG8_WAIT_L(0); PG8_MMA(0, 1, At, B1); PG8_BAR;
            PG8_LDA(At, 1, 1); PG8_STAGE(PG8_SA(1, 0), a3, voffA);
            PG8_BAR; PG8_WAIT_L(0); PG8_MMA(1, 0, At, B0); PG8_BAR; PG8_SCHED;
            PG8_STAGE(PG8_SB(1, 1), b3 + hstep, voffB);
            PG8_WAIT_V(6); PG8_BAR; PG8_MMA(1, 1, At, B1); PG8_BAR;
            }
        }
        if constexpr (ALIGN_EPI) { if (wr == 0) PG8_BAR; }
        if constexpr (!Epi::AFTER_DRAIN) { E(acc, cur, wr, wc, fr, fq); S.done(cur); }
        if (!has_next) break;
#pragma unroll
        for (int a = 0; a < 2; ++a)
#pragma unroll
            for (int b = 0; b < 2; ++b)
#pragma unroll
                for (int m = 0; m < 4; ++m)
#pragma unroll
                    for (int n = 0; n < 2; ++n) acc[a][b][m][n] = (f32x4){0.f, 0.f, 0.f, 0.f};
        cur = nxt; cA = nA; cB = nB; ++ui;
        if constexpr (ALIGN_EPI) { if (wr == 1) PG8_BAR; }
    }
    PG8_WAIT_V(0);
    if constexpr (!ALIGN_EPI) { if (wr == 0) PG8_BAR; }
    PG8_BAR;
    if constexpr (Epi::AFTER_DRAIN) { E.fused(acc, cur, wr, wc, fr, fq, lds, wid, lane); S.done(cur); }
#undef PG8_SA
#undef PG8_SB
#undef PG8_STAGE
#undef PG8_LDA
#undef PG8_LDB
#undef PG8_MMA
#undef PG8_WAIT_V
#undef PG8_WAIT_L
#undef PG8_BAR
#undef PG8_SCHED
}
}
constexpr int NWAVES = 8, NTHR = 512;
#ifndef MK_N_LAUNCHES
#define MK_N_LAUNCHES 1
#endif
constexpr int PER_PHASE = 14;
constexpr int N_LAUNCHES = MK_N_LAUNCHES;

constexpr int DM = 1024, NPROMPT = 32768, NSAMP = 512, NTOK = 33280, NSHIFT = 32, MPAD = 33536, N1 = 5632;
constexpr int SEQ_P = 4096, SEQ_S = 16, NB_P = 8, NB_S = 32;
constexpr size_t O_Y = 0, O_CONV_P = 34078720, O_SHIFT_P = 34086912, O_WKV_P = 34095104, O_CONV_S = 34357248, O_SHIFT_S = 34390016, O_WKV_S = 34422784;
constexpr size_t KiB = 1024, MiB = 1u << 20;
constexpr size_t WS_CTL = 0, CTL_ZERO_BYTES = 64 * KiB;
constexpr size_t WS_W1T = 64 * KiB;
constexpr size_t WS_WPA = WS_W1T + (size_t)N1 * DM * 2;
constexpr size_t WS_WPB = WS_WPA + 1 * MiB;
constexpr size_t WS_WO = WS_WPB + 1 * MiB;
constexpr size_t WS_WQ = WS_WO + 2 * MiB;
constexpr size_t WS_KEYS = WS_WQ + 4 * MiB;
constexpr size_t WS_L2T = WS_KEYS + 512 * KiB;
constexpr size_t WS_SSP = WS_L2T + 256 * KiB;
constexpr size_t WS_UB = WS_SSP + (size_t)MPAD * 16 * 4;
constexpr size_t WS_VB = WS_UB + 16 * MiB;
constexpr size_t WS_A1 = WS_VB + 16 * MiB;
constexpr size_t WS_ZC = WS_A1 + (size_t)MPAD * DM * 2;
constexpr size_t WS_ZR = WS_ZC + (size_t)MPAD * 1536 * 2;
constexpr size_t WS_ZG = WS_ZR + (size_t)MPAD * 2048 * 2;
constexpr size_t WS_END = WS_ZG + (size_t)MPAD * 2048 * 2;
constexpr size_t WS_YL = WS_ZC, WS_ZT = WS_ZC + (size_t)NTOK * 512 * 2, WS_BV = WS_ZC + (size_t)NTOK * 512 * 4;
constexpr size_t WS_EIDX = WS_ZC, WS_GATE = WS_ZC + 16 * MiB, WS_COEF = WS_ZC + 40 * MiB, WS_SS2 = WS_ZC + 64 * MiB, WS_RSTD = WS_ZC + 66 * MiB;
constexpr size_t WS_PART = WS_ZR;
constexpr size_t OB_MB = (size_t)4352 * 4096 * 4;
static_assert(WS_BV + (size_t)NTOK * 512 * 2 <= WS_ZR && OB_MB + (size_t)4352 * 4096 * 2 <= (size_t)NTOK * 1024 * 4, "scan scratch maps");
static_assert(WS_END <= 512 * MiB, "d_ws map must fit 512 MiB");
constexpr float PEER_SU = 32.0f, PEER_SV = 4.0f;
constexpr int CW_BAR = 1024;
constexpr int LDS_BYTES = 163840;
constexpr int LDSCTL_OFF = LDS_BYTES - 512, MISC_OFF = LDSCTL_OFF + 320;

#define GAS __attribute__((address_space(1)))
#define LAS __attribute__((address_space(3)))
typedef unsigned short bf16;
typedef unsigned v4u __attribute__((ext_vector_type(4)));
typedef unsigned v2u __attribute__((ext_vector_type(2)));
typedef float f32x4 __attribute__((ext_vector_type(4)));
typedef short bf16x8 __attribute__((ext_vector_type(8)));
typedef __bf16 bf16x2_t __attribute__((ext_vector_type(2)));
typedef GAS unsigned gu32;
#define RLX_AGENT __ATOMIC_RELAXED, __HIP_MEMORY_SCOPE_AGENT
#define LDS_WAIT() asm volatile("s_waitcnt lgkmcnt(0)" ::: "memory")
#define VM_WAIT() asm volatile("s_waitcnt vmcnt(0)" ::: "memory")
using pg8::cvt_pk_bf16; using pg8::bf_lo; using pg8::bf_hi; using pg8::sigm;
#define XB_TMO      128
#define XB_XCNT(j)  (256  + 64 * (j))
#define XB_XSUB(j)  (1280 + 64 * (j))
#define XB_XGEN(j)  (2304 + 64 * (j))
#define XB_TOP      3328
#define XB_TOPGEN   3392
#define XCD_BAR_WORDS 3456
#define XB_SPIN_CAP (1u << 22)

__device__ __forceinline__ unsigned xb_ld(unsigned* p)              { return __hip_atomic_load(p, __ATOMIC_RELAXED, __HIP_MEMORY_SCOPE_AGENT); }
__device__ __forceinline__ unsigned xb_add(unsigned* p, unsigned v) { return __hip_atomic_fetch_add(p, v, __ATOMIC_RELAXED, __HIP_MEMORY_SCOPE_AGENT); }
__device__ __forceinline__ unsigned xb_xcc_id() { return (unsigned)__builtin_amdgcn_s_getreg((3 << 11) | 20) & 0xFu; }
#define XB_SPIN(cond, bar) do { unsigned _sp = 0; while (cond) { __builtin_amdgcn_s_sleep(1); \
    if ((++_sp & 255u) == 0u) { if (xb_ld(&(bar)[XB_TMO])) break; if (_sp > XB_SPIN_CAP) { atomicAdd(&(bar)[XB_TMO], 1u); break; } } } } while (0)

struct XcdBarrier {
    unsigned* bar; unsigned x;
    volatile LAS unsigned* st;
};

__device__ __forceinline__ XcdBarrier xcd_barrier_post(unsigned* bar, volatile LAS unsigned* st) {
    XcdBarrier b; b.bar = bar; b.x = xb_xcc_id(); b.st = st;
    if (threadIdx.x == 0) (void)xb_add(&bar[XB_XCNT(b.x)], 1u);
    return b;
}
__device__ __forceinline__ void xcd_barrier_complete(unsigned* bar, unsigned x, unsigned& nloc, unsigned& nx) {
    const unsigned G = gridDim.x * gridDim.y * gridDim.z;
    unsigned sum, cnt, mine, sp = 0u;
    for (;;) {
        sum = 0u; cnt = 0u; mine = 0u;
#pragma unroll
        for (unsigned j = 0; j < 16; ++j) { const unsigned c = xb_ld(&bar[XB_XCNT(j)]); sum += c; cnt += (c > 0u) ? 1u : 0u; mine = (j == x) ? c : mine; }
        if (sum == G) break;
        __builtin_amdgcn_s_sleep(1);
        if ((++sp & 255u) == 0u) { if (xb_ld(&bar[XB_TMO])) break; if (sp > XB_SPIN_CAP) { atomicAdd(&bar[XB_TMO], 1u); break; } }
    }
    nloc = mine > 0u ? mine : 1u; nx = cnt > 0u ? cnt : 1u;
}

__device__ __forceinline__ void xcd_barrier(const XcdBarrier& b) {
    asm volatile("s_waitcnt vmcnt(0)" ::: "memory");
    __syncthreads();
    if (threadIdx.x == 0) {
        unsigned* bar = b.bar;
        __builtin_amdgcn_s_waitcnt(0);
        unsigned nloc = b.st[0], nx = b.st[1];
        if (nloc == 0u) { xcd_barrier_complete(bar, b.x, nloc, nx); b.st[0] = nloc; b.st[1] = nx; }
        const unsigned old = xb_add(&bar[XB_XSUB(b.x)], 1u);
        const unsigned gen = old / nloc;
        if (old + 1u == (gen + 1u) * nloc) {
            __builtin_amdgcn_fence(__ATOMIC_RELEASE, "agent");
            asm volatile("s_waitcnt vmcnt(0)" ::: "memory");
            const unsigned og = xb_add(&bar[XB_TOP], 1u);
            const unsigned tg = og / nx;
            if (og + 1u == (tg + 1u) * nx) xb_add(&bar[XB_TOPGEN], 1u);
            else XB_SPIN(xb_ld(&bar[XB_TOPGEN]) == tg, bar);
            __builtin_amdgcn_fence(__ATOMIC_ACQUIRE, "agent");
            xb_add(&bar[XB_XGEN(b.x)], 1u);
            asm volatile("s_waitcnt vmcnt(0)" ::: "memory");
        } else {
            XB_SPIN(xb_ld(&bar[XB_XGEN(b.x)]) == gen, bar);
            __builtin_amdgcn_fence(__ATOMIC_ACQUIRE, "agent");
            asm volatile("s_waitcnt vmcnt(0)" ::: "memory");
        }
    }
    __syncthreads();
}
struct Args { const float* in[32]; float* out; unsigned char* ws; int ph_lo, ph_hi, li, pad; };
enum { I_XP = 0, I_XS, I_SCONV, I_SSHIFT, I_SWKV, I_N1G, I_WIN, I_CONVW, I_MURKV, I_MUWAG, I_W0, I_W1, I_W2, I_A0, I_A1, I_A2, I_G1, I_G2, I_KK, I_KA, I_RK, I_GNW, I_GNB, I_WPA, I_WPB, I_WO, I_N2G, I_WQ, I_KEYS, I_U, I_V, I_NFG };

__device__ __forceinline__ float wave_sum(float v) {
#pragma unroll
    for (int o = 1; o < 64; o <<= 1) v += __shfl_xor(v, o);
    return v;
}
template <int CTRL> __device__ __forceinline__ float dpp_mov(float v) { return __builtin_bit_cast(float, __builtin_amdgcn_update_dpp(0, __builtin_bit_cast(int, v), CTRL, 0xF, 0xF, true)); }
__device__ __forceinline__ float sum4(float v) { v += dpp_mov<0xB1>(v); v += dpp_mov<0x4E>(v); return v; }
__device__ __forceinline__ float sum8(float v) { v = sum4(v); v += dpp_mov<0x141>(v); return v; }
__device__ __forceinline__ float sum16(float v) { v = sum8(v); v += dpp_mov<0x140>(v); return v; }
__device__ __forceinline__ float dot2bf(unsigned w, unsigned x, float acc) { return __builtin_amdgcn_fdot2_f32_bf16(__builtin_bit_cast(bf16x2_t, w), __builtin_bit_cast(bf16x2_t, x), acc, false); }

__device__ __forceinline__ void transpose_item(const float* W, int ldw, int c0, int K, bf16* WT, int nblk, int item, const float* sv, float alpha, float beta, LAS float* scr, int lane) {
    const int kb = item / nblk, nb = item % nblk, k0 = 64 * kb, n0 = 32 * nb;
#pragma unroll 8
    for (int i = 0; i < 32; ++i) { const int kk = 2 * i + (lane >> 5); float s = 1.f; if (sv) s = alpha + beta * sv[k0 + kk];
        scr[kk * 33 + (lane & 31)] = W[(size_t)(k0 + kk) * ldw + c0 + n0 + (lane & 31)] * s; }
    LDS_WAIT();
    const int c = lane & 7;
#pragma unroll
    for (int j = 0; j < 4; ++j) { const int n = (lane >> 3) + 8 * j; const LAS float* s = scr + (8 * c) * 33 + n;
        v4u o; o.x = cvt_pk_bf16(s[0 * 33], s[1 * 33]); o.y = cvt_pk_bf16(s[2 * 33], s[3 * 33]); o.z = cvt_pk_bf16(s[4 * 33], s[5 * 33]); o.w = cvt_pk_bf16(s[6 * 33], s[7 * 33]);
        *(v4u*)(WT + (size_t)(n0 + n) * K + k0 + 8 * c) = o; }
    LDS_WAIT();
}
__device__ __forceinline__ void cvt_stream(const float* src, bf16* dst, size_t n, size_t gt, size_t nthreads) {
    for (size_t i = gt * 8; i < n; i += nthreads * 8) { const f32x4 a = *(const f32x4*)(src + i), b = *(const f32x4*)(src + i + 4);
        v4u o; o.x = cvt_pk_bf16(a[0], a[1]); o.y = cvt_pk_bf16(a[2], a[3]); o.z = cvt_pk_bf16(b[0], b[1]); o.w = cvt_pk_bf16(b[2], b[3]); *(v4u*)(dst + i) = o; }
}
__device__ __forceinline__ void cvt_stream_fp8(const float* src, unsigned char* dst, size_t n, float scale, size_t gt, size_t nthreads) {
    for (size_t i = gt * 16; i < n; i += nthreads * 16) {
        const f32x4 a = *(const f32x4*)(src + i) * scale, b = *(const f32x4*)(src + i + 4) * scale, c = *(const f32x4*)(src + i + 8) * scale, d = *(const f32x4*)(src + i + 12) * scale;
        v4u o; unsigned p;
        p = __builtin_amdgcn_cvt_pk_fp8_f32(a[0], a[1], 0, false); o.x = __builtin_amdgcn_cvt_pk_fp8_f32(a[2], a[3], p, true);
        p = __builtin_amdgcn_cvt_pk_fp8_f32(b[0], b[1], 0, false); o.y = __builtin_amdgcn_cvt_pk_fp8_f32(b[2], b[3], p, true);
        p = __builtin_amdgcn_cvt_pk_fp8_f32(c[0], c[1], 0, false); o.z = __builtin_amdgcn_cvt_pk_fp8_f32(c[2], c[3], p, true);
        p = __builtin_amdgcn_cvt_pk_fp8_f32(d[0], d[1], 0, false); o.w = __builtin_amdgcn_cvt_pk_fp8_f32(d[2], d[3], p, true);
        *(v4u*)(dst + i) = o; }
}
__device__ __forceinline__ void cvt16_fp8_sliced(const float* src, unsigned char* dst, float scale, size_t i) {
    const f32x4 a = *(const f32x4*)(src + i) * scale, b = *(const f32x4*)(src + i + 4) * scale, c = *(const f32x4*)(src + i + 8) * scale, d = *(const f32x4*)(src + i + 12) * scale;
    v4u o; unsigned p;
    p = __builtin_amdgcn_cvt_pk_fp8_f32(a[0], a[1], 0, false); o.x = __builtin_amdgcn_cvt_pk_fp8_f32(a[2], a[3], p, true);
    p = __builtin_amdgcn_cvt_pk_fp8_f32(b[0], b[1], 0, false); o.y = __builtin_amdgcn_cvt_pk_fp8_f32(b[2], b[3], p, true);
    p = __builtin_amdgcn_cvt_pk_fp8_f32(c[0], c[1], 0, false); o.z = __builtin_amdgcn_cvt_pk_fp8_f32(c[2], c[3], p, true);
    p = __builtin_amdgcn_cvt_pk_fp8_f32(d[0], d[1], 0, false); o.w = __builtin_amdgcn_cvt_pk_fp8_f32(d[2], d[3], p, true);
    const size_t e = i >> 10, col = i & 1023;
    *(v4u*)(dst + (col >> 7) * ((size_t)16384 * 128) + e * 128 + (col & 127)) = o;
}
__device__ __forceinline__ void cvt_stream_fp8_sliced(const float* src, unsigned char* dst, float scale, size_t gt, size_t nthreads) {
#pragma unroll 2
    for (size_t i = gt * 16; i < (size_t)16384 * 1024; i += nthreads * 16) {
        const f32x4 a = *(const f32x4*)(src + i) * scale, b = *(const f32x4*)(src + i + 4) * scale, c = *(const f32x4*)(src + i + 8) * scale, d = *(const f32x4*)(src + i + 12) * scale;
        v4u o; unsigned p;
        p = __builtin_amdgcn_cvt_pk_fp8_f32(a[0], a[1], 0, false); o.x = __builtin_amdgcn_cvt_pk_fp8_f32(a[2], a[3], p, true);
        p = __builtin_amdgcn_cvt_pk_fp8_f32(b[0], b[1], 0, false); o.y = __builtin_amdgcn_cvt_pk_fp8_f32(b[2], b[3], p, true);
        p = __builtin_amdgcn_cvt_pk_fp8_f32(c[0], c[1], 0, false); o.z = __builtin_amdgcn_cvt_pk_fp8_f32(c[2], c[3], p, true);
        p = __builtin_amdgcn_cvt_pk_fp8_f32(d[0], d[1], 0, false); o.w = __builtin_amdgcn_cvt_pk_fp8_f32(d[2], d[3], p, true);
        const size_t e = i >> 10, col = i & 1023;
        *(v4u*)(dst + (col >> 7) * ((size_t)16384 * 128) + e * 128 + (col & 127)) = o; }
}
__device__ __forceinline__ void p0_prologue(const Args& A, LAS unsigned char* lds, int tid, int lane, int wave, int vcu, int G) {
    unsigned char* ws = A.ws;
    bf16* W1T = (bf16*)(ws + WS_W1T);
    LAS float* scr = (LAS float*)(lds + wave * 16384);
    const int gw = vcu * NWAVES + wave, NGW = G * NWAVES;
    constexpr int J0 = 16 * 96, J1 = 16 * 64, JL = 16 * 2, JG = 16 * 4, JP = 8 * 32, JO = 16 * 32, JQ = 16 * 64;
    constexpr int JW2 = 16, JG2 = 32;
    constexpr int NITEMS = J0 + J1 + 4 * JL + 2 * JG + 2 * JP + JO + JQ + 2 * JW2 + JG2;
    bf16* L2T = (bf16*)(ws + WS_L2T);
    const float* mu = A.in[I_MUWAG];
    for (int it = gw; it < NITEMS; it += NGW) {
        int r = it;
        if (r < J0) { transpose_item(A.in[I_WIN], 5120, 0, 1024, W1T, 96, r, nullptr, 0.f, 0.f, scr, lane); continue; } r -= J0;
        if (r < J1) { transpose_item(A.in[I_WIN], 5120, 3072, 1024, W1T + (size_t)3584 * 1024, 64, r, nullptr, 0.f, 0.f, scr, lane); continue; } r -= J1;
        if (r < JL) { transpose_item(A.in[I_W1], 64, 0, 1024, W1T + (size_t)3072 * 1024, 2, r, mu, 1.f, -1.f, scr, lane); continue; } r -= JL;
        if (r < JL) { transpose_item(A.in[I_W1], 64, 0, 1024, W1T + (size_t)3328 * 1024, 2, r, mu, 0.f, 1.f, scr, lane); continue; } r -= JL;
        if (r < JL) { transpose_item(A.in[I_A1], 64, 0, 1024, W1T + (size_t)(3072 + 64) * 1024, 2, r, mu + 1024, 1.f, -1.f, scr, lane); continue; } r -= JL;
        if (r < JL) { transpose_item(A.in[I_A1], 64, 0, 1024, W1T + (size_t)(3328 + 64) * 1024, 2, r, mu + 1024, 0.f, 1.f, scr, lane); continue; } r -= JL;
        if (r < JG) { transpose_item(A.in[I_G1], 128, 0, 1024, W1T + (size_t)(3072 + 128) * 1024, 4, r, mu + 2048, 1.f, -1.f, scr, lane); continue; } r -= JG;
        if (r < JG) { transpose_item(A.in[I_G1], 128, 0, 1024, W1T + (size_t)(3328 + 128) * 1024, 4, r, mu + 2048, 0.f, 1.f, scr, lane); continue; } r -= JG;
        if (r < JP) { transpose_item(A.in[I_WPA], 1024, 0, 512, (bf16*)(ws + WS_WPA), 32, r, nullptr, 0.f, 0.f, scr, lane); continue; } r -= JP;
        if (r < JP) { transpose_item(A.in[I_WPB], 1024, 0, 512, (bf16*)(ws + WS_WPB), 32, r, nullptr, 0.f, 0.f, scr, lane); continue; } r -= JP;
        if (r < JO) { transpose_item(A.in[I_WO], 1024, 0, 1024, (bf16*)(ws + WS_WO), 32, r, nullptr, 0.f, 0.f, scr, lane); continue; } r -= JO;
        if (r < JQ) { transpose_item(A.in[I_WQ], 2048, 0, 1024, (bf16*)(ws + WS_WQ), 64, r, nullptr, 0.f, 0.f, scr, lane); continue; } r -= JQ;
        if (r < JW2) { transpose_item(A.in[I_W2], 512, 0, 64, L2T, 16, r, nullptr, 0.f, 0.f, scr, lane); continue; } r -= JW2;
        if (r < JW2) { transpose_item(A.in[I_A2], 512, 0, 64, L2T + (size_t)512 * 64, 16, r, nullptr, 0.f, 0.f, scr, lane); continue; } r -= JW2;
        transpose_item(A.in[I_G2], 512, 0, 128, L2T + (size_t)1024 * 64, 16, r, nullptr, 0.f, 0.f, scr, lane);
    }
    const size_t gt = (size_t)vcu * NTHR + tid, nth = (size_t)G * NTHR;
    if (G != 256) {
        cvt_stream_fp8_sliced(A.in[I_U], ws + WS_UB, PEER_SU, gt, nth);
        cvt_stream_fp8_sliced(A.in[I_V], ws + WS_VB, PEER_SV, gt, nth); }
    cvt_stream(A.in[I_KEYS], (bf16*)(ws + WS_KEYS), (size_t)8 * 2 * 128 * 128, gt, nth);
    bf16* A1 = (bf16*)(ws + WS_A1);
    const f32x4* g1v = (const f32x4*)A.in[I_N1G] + lane;
    for (int m0 = gw; m0 < NTOK; m0 += 2 * NGW) {
        const int m1 = m0 + NGW; const bool two = m1 < NTOK; const int m1c = two ? m1 : m0;
        const f32x4* xr0 = (const f32x4*)(m0 < NPROMPT ? A.in[I_XP] + (size_t)m0 * DM : A.in[I_XS] + (size_t)(m0 - NPROMPT) * DM) + lane;
        const f32x4* xr1 = (const f32x4*)(m1c < NPROMPT ? A.in[I_XP] + (size_t)m1c * DM : A.in[I_XS] + (size_t)(m1c - NPROMPT) * DM) + lane;
        f32x4 v0[4], v1[4]; float s0 = 0.f, s1 = 0.f;
#pragma unroll
        for (int j = 0; j < 4; ++j) { v0[j] = xr0[64 * j]; v1[j] = xr1[64 * j]; }
#pragma unroll
        for (int j = 0; j < 4; ++j) { s0 += (v0[j][0] * v0[j][0] + v0[j][1] * v0[j][1]) + (v0[j][2] * v0[j][2] + v0[j][3] * v0[j][3]);
                                      s1 += (v1[j][0] * v1[j][0] + v1[j][1] * v1[j][1]) + (v1[j][2] * v1[j][2] + v1[j][3] * v1[j][3]); }
#pragma unroll
        for (int o = 1; o < 64; o <<= 1) { s0 += __shfl_xor(s0, o); s1 += __shfl_xor(s1, o); }
        const float r0 = 1.0f / sqrtf(s0 * (1.f / DM) + 1e-6f), r1 = 1.0f / sqrtf(s1 * (1.f / DM) + 1e-6f);
#pragma unroll
        for (int rr = 0; rr < 2; ++rr) {
            if (rr == 1 && !two) break;
            const int m = rr ? m1 : m0; const float rstd = rr ? r1 : r0;
            v2u* o8 = (v2u*)(A1 + (size_t)m * DM) + lane;
            float* so = nullptr;
            if (m < NPROMPT) { if ((m & (SEQ_P - 1)) == SEQ_P - 1) so = A.out + O_SHIFT_P + (size_t)(m / SEQ_P) * DM; }
            else { const int ms = m - NPROMPT; if ((ms & (SEQ_S - 1)) == SEQ_S - 1) so = A.out + O_SHIFT_S + (size_t)(ms / SEQ_S) * DM; }
#pragma unroll
            for (int j = 0; j < 4; ++j) { const f32x4 g = g1v[64 * j]; const f32x4 y = (rr ? v1[j] : v0[j]) * rstd * g;
                v2u w; w.x = cvt_pk_bf16(y[0], y[1]); w.y = cvt_pk_bf16(y[2], y[3]); o8[64 * j] = w;
                if (so) ((f32x4*)so)[lane + 64 * j] = y; }
        }
    }
    for (int m = NTOK + gw; m < MPAD; m += NGW) {
        v2u* o8 = (v2u*)(A1 + (size_t)m * DM) + lane;
        if (m < NTOK + NSHIFT) {
            const f32x4* xr = (const f32x4*)(A.in[I_SSHIFT] + (size_t)(m - NTOK) * DM) + lane;
#pragma unroll
            for (int j = 0; j < 4; ++j) { const f32x4 y = xr[64 * j]; v2u w; w.x = cvt_pk_bf16(y[0], y[1]); w.y = cvt_pk_bf16(y[2], y[3]); o8[64 * j] = w; }
        } else {
#pragma unroll
            for (int j = 0; j < 4; ++j) { v2u w; w.x = 0u; w.y = 0u; o8[64 * j] = w; }
        }
    }
}

__device__ __forceinline__ void unpack8(const v4u w, float (&f)[8]) { f[0] = bf_lo(w.x); f[1] = bf_hi(w.x); f[2] = bf_lo(w.y); f[3] = bf_hi(w.y); f[4] = bf_lo(w.z); f[5] = bf_hi(w.z); f[6] = bf_lo(w.w); f[7] = bf_hi(w.w); }
__device__ __forceinline__ void conv_phase(const Args& A, int gt, int nth) {
    const bf16* Zc = (const bf16*)(A.ws + WS_ZC); bf16* YA = (bf16*)(A.ws + WS_A1);
    const float* cw = A.in[I_CONVW];
    for (int task = gt; task < (NTOK / 16) * 64; task += nth) {
        const int seg = task >> 6, ch = (task & 63) * 8, row0 = seg * 16;
        int b, t0, T; bool prompt = row0 < NPROMPT;
        if (prompt) { b = row0 / SEQ_P; t0 = row0 % SEQ_P; T = SEQ_P; } else { b = (row0 - NPROMPT) / SEQ_S; t0 = 0; T = SEQ_S; }
        float um2[8], um1[8], c0[8], c1[8], c2[8];
#pragma unroll
        for (int i = 0; i < 8; ++i) { c0[i] = cw[ch + i]; c1[i] = cw[512 + ch + i]; c2[i] = cw[1024 + ch + i]; }
        if (t0 == 0) {
            if (prompt) {
#pragma unroll
                for (int i = 0; i < 8; ++i) { um2[i] = 0.f; um1[i] = 0.f; }
            } else { const float* sc = A.in[I_SCONV] + (size_t)b * 2 * 512 + ch;
#pragma unroll
                for (int i = 0; i < 8; ++i) { um2[i] = sc[i]; um1[i] = sc[512 + i]; } }
        } else {
            float a[8], h[8];
            unpack8(*(const v4u*)(Zc + (size_t)(row0 - 2) * 1536 + 512 + ch), a); unpack8(*(const v4u*)(Zc + (size_t)(row0 - 2) * 1536 + 1024 + ch), h);
#pragma unroll
            for (int i = 0; i < 8; ++i) um2[i] = a[i] * h[i];
            unpack8(*(const v4u*)(Zc + (size_t)(row0 - 1) * 1536 + 512 + ch), a); unpack8(*(const v4u*)(Zc + (size_t)(row0 - 1) * 1536 + 1024 + ch), h);
#pragma unroll
            for (int i = 0; i < 8; ++i) um1[i] = a[i] * h[i];
        }
#pragma unroll 4
        for (int t = 0; t < 16; ++t) {
            const size_t row = (size_t)(row0 + t);
            float zb[8], zc[8], zh[8], y[8];
            unpack8(*(const v4u*)(Zc + row * 1536 + ch), zb); unpack8(*(const v4u*)(Zc + row * 1536 + 512 + ch), zc); unpack8(*(const v4u*)(Zc + row * 1536 + 1024 + ch), zh);
#pragma unroll
            for (int i = 0; i < 8; ++i) { const float u = zc[i] * zh[i]; y[i] = zb[i] * (c0[i] * um2[i] + c1[i] * um1[i] + c2[i] * u); um2[i] = um1[i]; um1[i] = u; }
            v4u o; o.x = cvt_pk_bf16(y[0], y[1]); o.y = cvt_pk_bf16(y[2], y[3]); o.z = cvt_pk_bf16(y[4], y[5]); o.w = cvt_pk_bf16(y[6], y[7]);
            *(v4u*)(YA + row * 512 + ch) = o;
        }
        if (t0 + 16 == T) { float* oc = A.out + (prompt ? O_CONV_P : O_CONV_S) + (size_t)b * 2 * 512 + ch;
#pragma unroll
            for (int i = 0; i < 8; ++i) { oc[i] = um2[i]; oc[512 + i] = um1[i]; } }
    }
    bf16* Zr = (bf16*)(A.ws + WS_ZR);
    for (int task = nth - 1 - gt; task < NTOK * 16; task += nth) {
        const int m = task >> 4, cs = task & 15;
        bool hasprev; int prow;
        if (m < NPROMPT) { hasprev = (m & (SEQ_P - 1)) != 0; prow = m - 1; } else { const int ms = m - NPROMPT; hasprev = true; prow = (ms & (SEQ_S - 1)) ? m - 1 : NTOK + ms / SEQ_S; }
        bf16* pap = Zr + (size_t)m * 2048 + 1536 + cs * 16;
        float pa[16], t8[8];
        const v4u a0 = *(const v4u*)pap, a1 = *(const v4u*)(pap + 8);
        v4u b0 = (v4u){0u, 0u, 0u, 0u}, b1 = b0;
        if (hasprev) { const bf16* pbp = Zr + (size_t)prow * 2048 + 1792 + cs * 16; b0 = *(const v4u*)pbp; b1 = *(const v4u*)(pbp + 8); }
        unpack8(a0, t8);
#pragma unroll
        for (int i = 0; i < 8; ++i) pa[i] = t8[i];
        unpack8(a1, t8);
#pragma unroll
        for (int i = 0; i < 8; ++i) pa[8 + i] = t8[i];
        unpack8(b0, t8);
#pragma unroll
        for (int i = 0; i < 8; ++i) pa[i] += t8[i];
        unpack8(b1, t8);
#pragma unroll
        for (int i = 0; i < 8; ++i) pa[8 + i] += t8[i];
#pragma unroll
        for (int i = 0; i < 16; ++i) { float p = pa[i];
            if (cs < 4) p = 1.0f - 2.0f * __builtin_amdgcn_rcpf(__expf(2.0f * p) + 1.0f);
            else if (cs >= 8) p = sigm(p);
            pa[i] = p; }
        v4u o0, o1; o0.x = cvt_pk_bf16(pa[0], pa[1]); o0.y = cvt_pk_bf16(pa[2], pa[3]); o0.z = cvt_pk_bf16(pa[4], pa[5]); o0.w = cvt_pk_bf16(pa[6], pa[7]);
        o1.x = cvt_pk_bf16(pa[8], pa[9]); o1.y = cvt_pk_bf16(pa[10], pa[11]); o1.z = cvt_pk_bf16(pa[12], pa[13]); o1.w = cvt_pk_bf16(pa[14], pa[15]);
        *(v4u*)pap = o0; *(v4u*)(pap + 8) = o1;
    }
}

constexpr int NUNITS_P = NB_P * 8 * 64, NUNITS = NUNITS_P + NB_S * 8;
constexpr int HID_STRIDE = 264, SC_TB = 32;
constexpr int P1_HIDB = 0, P1_LO = 16896, P1_SEQ = 41472, P1_GG = 90624, P1_YY = 98816, P1_ZZ = 107008, P1_BON = 115200;
typedef float f32x2 __attribute__((ext_vector_type(2)));

struct P1Pre { v4u pa0, pa1; v2u zr, zk, zv, pr, pk, pv; };
struct P1Pos { int unit, t0; };
__device__ __forceinline__ void p1_decode(int unit, bool& prompt, int& b, int& h, int& ch, int& T, int& rowbase) {
    prompt = unit < NUNITS_P; b = prompt ? unit >> 9 : (unit - NUNITS_P) >> 3; h = prompt ? (unit >> 6) & 7 : unit & 7; ch = prompt ? unit & 63 : 0;
    T = prompt ? 64 : SEQ_S; rowbase = prompt ? b * SEQ_P + ch * 64 : NPROMPT + b * SEQ_S;
}
__device__ __forceinline__ void p1_rows(int unit, int t0, int tt, size_t& row, size_t& prow, bool& hasprev, int& nb) {
    bool prompt; int b, h, ch, T, rowbase; p1_decode(unit, prompt, b, h, ch, T, rowbase);
    nb = (T - t0) < SC_TB ? (T - t0) : SC_TB;
    const int tloc = tt < nb ? tt : nb - 1, t = t0 + tloc; const bool first = (ch == 0);
    row = (size_t)(rowbase + t); hasprev = (t > 0) || !first || !prompt; prow = ((t > 0) || !first) ? row - 1 : (size_t)(NTOK + b);
}
__device__ __forceinline__ void p1_load(const Args& A, int unit, int t0, int tt, int cs, P1Pre& P) {
    size_t row, prow; bool hasprev; int nb; p1_rows(unit, t0, tt, row, prow, hasprev, nb);
    const int h = unit < NUNITS_P ? (unit >> 6) & 7 : unit & 7, hc = h * 64 + cs * 4;
    const bf16* Zr = (const bf16*)(A.ws + WS_ZR);
    P.pa0 = *(const v4u*)(Zr + row * 2048 + 1536 + cs * 16); P.pa1 = *(const v4u*)(Zr + row * 2048 + 1536 + cs * 16 + 8);
    P.zr = *(const v2u*)(Zr + row * 2048 + hc); P.zk = *(const v2u*)(Zr + row * 2048 + 512 + hc); P.zv = *(const v2u*)(Zr + row * 2048 + 1024 + hc);
    const v2u z2 = (v2u){0u, 0u};
    P.pr = z2; P.pk = z2; P.pv = z2;
    if (hasprev) { P.pr = *(const v2u*)(Zr + prow * 2048 + hc); P.pk = *(const v2u*)(Zr + prow * 2048 + 512 + hc); P.pv = *(const v2u*)(Zr + prow * 2048 + 1024 + hc); }
}
__device__ __forceinline__ bool p1_unit_at(int i, int vcu, int G, int& unit) {
    if (G == 256) { if (i > 16) return false; unit = i < 16 ? vcu * 16 + i : NUNITS_P + vcu; return true; }
    unit = vcu + i * G; return unit < NUNITS;
}

constexpr int WY_OS = 72, WY_TS = 24, WY_LS = 40;
constexpr int WY_AT = 0, WY_RT = WY_AT + 16 * WY_OS * 2, WY_BT = WY_RT + 16 * WY_OS * 2, WY_KT = WY_BT + 16 * WY_OS * 2, WY_BH = WY_KT + 16 * WY_OS * 2,
              WY_KH = WY_BH + 64 * WY_TS * 2, WY_VT = WY_KH + 64 * WY_TS * 2, WY_GC = WY_VT + 64 * WY_TS * 2, WY_BUF = WY_GC + 256;
constexpr int WY_BASE = 0;
constexpr int WY_LAB = WY_BASE + 2 * WY_BUF, WY_LAK = WY_LAB + 1024, WY_MC = WY_LAK + 16 * WY_LS * 2;
static_assert(WY_MC + 16 * WY_LS * 2 <= P1_SEQ, "UT-transform operands must fit over HIDB | LO");
constexpr int WY_XB = 115328, WY_RH = WY_XB + 128 * WY_OS * 2, WY_UT = WY_RH + 8 * 16 * 17 * 4, WY_END = WY_UT + 8 * 16 * WY_TS * 2;
static_assert(WY_END <= LDSCTL_OFF, "LDS map of pass 1");

constexpr int WY_G2 = P1_GG + 2048;
static_assert(WY_G2 + 1024 + 2 * 16 * WY_LS * 2 <= P1_YY, "second Gram set");
__device__ __forceinline__ void p1_wy(f32x4 (&X)[4], const LAS float* SEQ, LAS float* YY, LAS float* ZZ, LAS unsigned char* lds, int nb, int tid, int lane, int wave, int part = 0) {
    const bool pw = wave >= 4; const int nmc = nb >> 4;
    LAS bf16* Xb = (LAS bf16*)(lds + WY_XB); LAS float* RH = (LAS float*)(lds + WY_RH) + wave * 16 * 17; LAS bf16* UT = (LAS bf16*)(lds + WY_UT) + wave * 16 * WY_TS;
    const bf16x8 zero8 = (bf16x8){0, 0, 0, 0, 0, 0, 0, 0};
    for (int mc = 0; mc < nmc; ++mc) {
        asm volatile("" : "+v"(tid));
        LAS unsigned char* ob = lds + WY_BASE + mc * WY_BUF;
        LAS bf16* At = (LAS bf16*)(ob + WY_AT); LAS bf16* Rt = (LAS bf16*)(ob + WY_RT); LAS bf16* Bt = (LAS bf16*)(ob + WY_BT); LAS bf16* Kt = (LAS bf16*)(ob + WY_KT);
        LAS bf16* BhT = (LAS bf16*)(ob + WY_BH); LAS bf16* KhT = (LAS bf16*)(ob + WY_KH); LAS bf16* VT = (LAS bf16*)(ob + WY_VT); LAS float* GC = (LAS float*)(ob + WY_GC);
        const int tl = tid >> 5, c2 = (tid & 31) * 2, s0 = mc * 16;
        f32x2 cum = (f32x2){0.f, 0.f}, tot = cum, lwt = cum;
#pragma unroll
        for (int i = 0; i < 16; ++i) { const f32x2 l2 = *(const LAS f32x2*)(SEQ + (s0 + i) * 384 + 64 + c2); tot += l2; if (i <= tl) cum += l2; if (i == tl) lwt = l2; }
        const LAS float* sp = SEQ + (s0 + tl) * 384 + c2;
        const f32x2 a2 = *(const LAS f32x2*)(sp), b2 = *(const LAS f32x2*)(sp + 128), k2 = *(const LAS f32x2*)(sp + 192), r2 = *(const LAS f32x2*)(sp + 256), v2 = *(const LAS f32x2*)(sp + 320);
        const f32x2 gt = (f32x2){__expf(cum.x), __expf(cum.y)}, gp = (f32x2){__expf(cum.x - lwt.x), __expf(cum.y - lwt.y)}, gi = (f32x2){__expf(-cum.x), __expf(-cum.y)},
                    go = (f32x2){__expf(tot.x - cum.x), __expf(tot.y - cum.y)};
        *(LAS unsigned*)(At + tl * WY_OS + c2) = cvt_pk_bf16(a2.x * gp.x, a2.y * gp.y); *(LAS unsigned*)(Rt + tl * WY_OS + c2) = cvt_pk_bf16(r2.x * gt.x, r2.y * gt.y);
        *(LAS unsigned*)(Bt + tl * WY_OS + c2) = cvt_pk_bf16(b2.x * gi.x, b2.y * gi.y); *(LAS unsigned*)(Kt + tl * WY_OS + c2) = cvt_pk_bf16(k2.x * gi.x, k2.y * gi.y);
        const unsigned bh = cvt_pk_bf16(b2.x * go.x, b2.y * go.y), kh = cvt_pk_bf16(k2.x * go.x, k2.y * go.y), vv = cvt_pk_bf16(v2.x, v2.y);
        {
            const unsigned bh_o = (unsigned)__shfl_xor((int)bh, 32), kh_o = (unsigned)__shfl_xor((int)kh, 32), vv_o = (unsigned)__shfl_xor((int)vv, 32);
            const bool ev = (tl & 1) == 0; const int wo = (ev ? c2 : c2 + 1) * WY_TS + (tl & ~1);
            *(LAS unsigned*)(BhT + wo) = ev ? ((bh & 0xffffu) | (bh_o << 16)) : ((bh_o >> 16) | (bh & 0xffff0000u));
            *(LAS unsigned*)(KhT + wo) = ev ? ((kh & 0xffffu) | (kh_o << 16)) : ((kh_o >> 16) | (kh & 0xffff0000u));
            *(LAS unsigned*)(VT + wo) = ev ? ((vv & 0xffffu) | (vv_o << 16)) : ((vv_o >> 16) | (vv & 0xffff0000u)); }
        if (tl == 0) *(LAS f32x2*)(GC + c2) = (f32x2){__expf(tot.x), __expf(tot.y)};
    }
    __syncthreads();
    {
        asm volatile("" : "+v"(tid));
        const int fr = tid & 15, fq = (tid >> 4) & 3, g_ = wave & 3, m_ = wave >> 2;
        if (m_ < nmc) {
            LAS unsigned char* ob = lds + WY_BASE + m_ * WY_BUF; LAS unsigned char* gs = lds + (m_ ? WY_G2 : WY_LAB);
            LAS float* Lab = (LAS float*)gs; LAS bf16* Lak = (LAS bf16*)(gs + 1024); LAS bf16* Mc = (LAS bf16*)(gs + 1024 + 16 * WY_LS * 2);
            const LAS bf16* ab = (LAS bf16*)(ob + (g_ < 2 ? WY_AT : WY_RT)) + fr * WY_OS + fq * 8; const LAS bf16* bb = (LAS bf16*)(ob + ((g_ & 1) ? WY_KT : WY_BT)) + fr * WY_OS + fq * 8;
            f32x4 g = (f32x4){0.f, 0.f, 0.f, 0.f};
#pragma unroll
            for (int ks = 0; ks < 2; ++ks) g = __builtin_amdgcn_mfma_f32_16x16x32_bf16(*(const LAS bf16x8*)(bb + ks * 32), *(const LAS bf16x8*)(ab + ks * 32), g, 0, 0, 0);
#pragma unroll
            for (int rg = 0; rg < 4; ++rg) { const int tp = 4 * fq + rg; const bool keep = (g_ < 2) ? (fr > tp) : (fr >= tp); g[rg] = keep ? g[rg] : 0.f; }
            if (g_ == 0) *(LAS f32x4*)(Lab + fr * 16 + 4 * fq) = g;
            else { v2u w; w.x = cvt_pk_bf16(g[0], g[1]); w.y = cvt_pk_bf16(g[2], g[3]);
                if (g_ == 1) { *(LAS v2u*)(Lak + fr * WY_LS + 4 * fq) = w; *(LAS v2u*)(Lak + fr * WY_LS + 16 + 4 * fq) = (v2u){0u, 0u}; }
                else if (g_ == 2) *(LAS v2u*)(Mc + fr * WY_LS + 4 * fq) = w; else *(LAS v2u*)(Mc + fr * WY_LS + 16 + 4 * fq) = w; }
        }
    }
    __syncthreads();
    if (MK_DBGSEL == 2 && part) return;
    for (int mc = 0; mc < nmc; ++mc) {
        asm volatile("" : "+v"(tid));
        const int fr = tid & 15, fq = (tid >> 4) & 3;
        LAS unsigned char* ob = lds + WY_BASE + mc * WY_BUF; LAS unsigned char* gs = lds + (mc ? WY_G2 : WY_LAB);
        LAS bf16* At = (LAS bf16*)(ob + WY_AT); LAS bf16* Rt = (LAS bf16*)(ob + WY_RT);
        LAS bf16* BhT = (LAS bf16*)(ob + WY_BH); LAS bf16* KhT = (LAS bf16*)(ob + WY_KH); LAS bf16* VT = (LAS bf16*)(ob + WY_VT); LAS float* GC = (LAS float*)(ob + WY_GC);
        LAS float* Lab = (LAS float*)gs; LAS bf16* Lak = (LAS bf16*)(gs + 1024); LAS bf16* Mc = (LAS bf16*)(gs + 1024 + 16 * WY_LS * 2);
        f32x4 W1 = (f32x4){0.f, 0.f, 0.f, 0.f}, Y0 = W1;
        {
            const LAS bf16* xbp = Xb + (16 * wave + fr) * WY_OS + fq * 8;
#pragma unroll
            for (int ks = 0; ks < 2; ++ks) { const bf16x8 bx = *(const LAS bf16x8*)(xbp + ks * 32);
                W1 = __builtin_amdgcn_mfma_f32_16x16x32_bf16(*(const LAS bf16x8*)(At + fr * WY_OS + ks * 32 + fq * 8), bx, W1, 0, 0, 0);
                Y0 = __builtin_amdgcn_mfma_f32_16x16x32_bf16(*(const LAS bf16x8*)(Rt + fr * WY_OS + ks * 32 + fq * 8), bx, Y0, 0, 0, 0); }
        }
        if (!pw) { const bf16x8 la = *(const LAS bf16x8*)(Lak + fr * WY_LS + fq * 8); const bf16x8 vb0 = *(const LAS bf16x8*)(VT + (16 * wave + fr) * WY_TS + (fq & 1) * 8); const bf16x8 vb = fq < 2 ? vb0 : zero8;
            W1 = __builtin_amdgcn_mfma_f32_16x16x32_bf16(la, vb, W1, 0, 0, 0); }
#pragma unroll
        for (int rg = 0; rg < 4; ++rg) RH[(4 * fq + rg) * 17 + fr] = W1[rg];
        LDS_WAIT();
        {
            float u[16];
#pragma unroll
            for (int t = 0; t < 16; ++t) { if ((t & 3) == 0) asm volatile("" ::: "memory");
                float acc = RH[t * 17 + fr];
                if (!(MK_DBGSEL == 3 && part))
#pragma unroll
                for (int i4 = 0; i4 * 4 < t; ++i4) { const f32x4 l4 = *(const LAS f32x4*)(Lab + t * 16 + i4 * 4);
#pragma unroll
                    for (int e = 0; e < 4; ++e) if (i4 * 4 + e < t) acc += l4[e] * u[i4 * 4 + e]; }
                u[t] = acc; }
            if (fq == 0) { v4u o0, o1; o0.x = cvt_pk_bf16(u[0], u[1]); o0.y = cvt_pk_bf16(u[2], u[3]); o0.z = cvt_pk_bf16(u[4], u[5]); o0.w = cvt_pk_bf16(u[6], u[7]);
                o1.x = cvt_pk_bf16(u[8], u[9]); o1.y = cvt_pk_bf16(u[10], u[11]); o1.z = cvt_pk_bf16(u[12], u[13]); o1.w = cvt_pk_bf16(u[14], u[15]);
                *(LAS v4u*)(UT + fr * WY_TS) = o0; *(LAS v4u*)(UT + fr * WY_TS + 8) = o1; }
        }
        LDS_WAIT();
        {
            const bf16x8 uc = fq < 2 ? *(const LAS bf16x8*)(UT + fr * WY_TS + fq * 8) : (pw ? zero8 : *(const LAS bf16x8*)(VT + (16 * wave + fr) * WY_TS + (fq - 2) * 8));
            Y0 = __builtin_amdgcn_mfma_f32_16x16x32_bf16(*(const LAS bf16x8*)(Mc + fr * WY_LS + fq * 8), uc, Y0, 0, 0, 0);
            LAS float* yo = (pw ? ZZ + 16 * (wave - 4) : YY + 16 * wave) + fr;
#pragma unroll
            for (int rg = 0; rg < 4; ++rg) yo[(mc * 16 + 4 * fq + rg) * 64] = Y0[rg];
#pragma unroll
            for (int j = 0; j < 4; ++j) {
                const bf16x8 bc = fq < 2 ? *(const LAS bf16x8*)(BhT + (16 * j + fr) * WY_TS + fq * 8) : *(const LAS bf16x8*)(KhT + (16 * j + fr) * WY_TS + (fq - 2) * 8);
                X[j] = X[j] * *(const LAS f32x4*)(GC + 16 * j + 4 * fq);
                X[j] = __builtin_amdgcn_mfma_f32_16x16x32_bf16(bc, uc, X[j], 0, 0, 0);
                v2u w; w.x = cvt_pk_bf16(X[j][0], X[j][1]); w.y = cvt_pk_bf16(X[j][2], X[j][3]);
                *(LAS v2u*)(Xb + (16 * wave + fr) * WY_OS + 16 * j + 4 * fq) = w; }
        }
        LDS_WAIT();
    }
}

#define P1_LOAD_PARAMS(HH) do { int lf_ = fr, lq_ = fq, lt_ = tid; asm volatile("" : "+v"(lf_), "+v"(lq_), "+v"(lt_));   \
        const int h_ = (HH), ncol_ = h_ * 64 + ntl * 16 + lf_; \
        _Pragma("unroll") for (int ks = 0; ks < 2; ++ks) { bw[ks] = *(const bf16x8*)(L2T + (size_t)ncol_ * 64 + lq_ * 8 + ks * 32); ba[ks] = *(const bf16x8*)(L2T + (size_t)512 * 64 + (size_t)ncol_ * 64 + lq_ * 8 + ks * 32); } \
        _Pragma("unroll") for (int ks = 0; ks < 4; ++ks) bg[ks] = *(const bf16x8*)(L2T + (size_t)1024 * 64 + (size_t)ncol_ * 128 + lq_ * 8 + ks * 32); \
        if (lt_ < 128) { const int a_ = lt_ >> 4, c_ = (lt_ & 15) * 4; \
            const float* src_ = a_ == 0 ? A.in[I_W0] : a_ == 1 ? A.in[I_A0] : a_ == 2 ? A.in[I_KK] : a_ == 3 ? A.in[I_KA] : a_ == 4 ? A.in[I_RK] : A.in[I_MURKV] + (a_ - 5) * 512; \
            *(LAS f32x4*)(PRM + a_ * 64 + c_) = *(const f32x4*)(src_ + h_ * 64 + c_); } } while (0)
__device__ __forceinline__ void scan_pass1(const Args& A, LAS unsigned char* lds, int tid, int lane, int wave, int vcu, int G, int part = 0) {
    bf16* GB = (bf16*)(A.ws + WS_A1) + (size_t)MPAD * 512;
    bf16* YL = (bf16*)(A.ws + WS_YL); bf16* ZT = (bf16*)(A.ws + WS_ZT); bf16* BV = (bf16*)(A.ws + WS_BV);
    LAS bf16* HIDB = (LAS bf16*)(lds + P1_HIDB); LAS float* LO = (LAS float*)(lds + P1_LO); LAS float* SEQ = (LAS float*)(lds + P1_SEQ);
    LAS float* YY = (LAS float*)(lds + P1_YY); LAS float* ZZ = (LAS float*)(lds + P1_ZZ);
    const bf16* L2T = (const bf16*)(A.ws + WS_L2T);
    const bool prow_wave = wave >= 4;
    const int mt = wave & 1, ntl = wave >> 1;
    int tt = tid >> 4, cs = tid & 15, c4 = cs * 4, fr = lane & 15, fq = lane >> 4;
    f32x4 X[4];
    bf16x8 bw[2], ba[2], bg[4];
    LAS float* PRM = (LAS float*)(lds + P1_GG);
    int cur_h = -1;
    int ui = 0, unit; if (!p1_unit_at(0, vcu, G, unit)) return;
    int t0 = 0; P1Pre pre; p1_load(A, unit, 0, tt, cs, pre);
    for (;;) {
        { int lt_ = tid; asm volatile("" : "+v"(lt_)); tt = lt_ >> 4; cs = lt_ & 15; c4 = cs * 4; fr = lt_ & 15; fq = (lt_ >> 4) & 3; }
        bool prompt; int b, h, ch, T, rowbase; p1_decode(unit, prompt, b, h, ch, T, rowbase);
        const int hc = h * 64 + c4;
        if (t0 == 0 && G == 256 && ui < 8) {
            const size_t i16 = ((size_t)(ui * 256 + vcu) * NTHR + tid) * 16;
            cvt16_fp8_sliced(A.in[I_U], A.ws + WS_UB, PEER_SU, i16); cvt16_fp8_sliced(A.in[I_V], A.ws + WS_VB, PEER_SV, i16); }
        if (t0 == 0) {
            LAS bf16* Xb = (LAS bf16*)(lds + WY_XB);
#pragma unroll
            for (int j = 0; j < 4; ++j) { const int prow_ = 16 * (wave - 4) + fr, c0_ = 16 * j + 4 * fq;
#pragma unroll
                for (int e = 0; e < 4; ++e) X[j][e] = (prow_wave && prow_ == c0_ + e) ? 1.f : 0.f;
                v2u w; w.x = cvt_pk_bf16(X[j][0], X[j][1]); w.y = cvt_pk_bf16(X[j][2], X[j][3]);
                *(LAS v2u*)(Xb + (16 * wave + fr) * WY_OS + c0_) = w; }
        }
        if (h != cur_h) { cur_h = h; P1_LOAD_PARAMS(h); }
        size_t row, prow; bool hasprev; int nb; p1_rows(unit, t0, tt, row, prow, hasprev, nb);
        if (!(MK_DBGSEL == 5 && part)) { *(LAS v4u*)(HIDB + tt * HID_STRIDE + cs * 16) = pre.pa0; *(LAS v4u*)(HIDB + tt * HID_STRIDE + cs * 16 + 8) = pre.pa1; }
        __syncthreads();
        if (!(MK_DBGSEL == 5 && part)) {
            const LAS bf16* ap = HIDB + (mt * 16 + fr) * HID_STRIDE + fq * 8;
            f32x4 cw = (f32x4){0.f, 0.f, 0.f, 0.f}, ca = cw, cg = cw;
#pragma unroll
            for (int ks = 0; ks < 2; ++ks) { cw = __builtin_amdgcn_mfma_f32_16x16x32_bf16(*(const LAS bf16x8*)(ap + ks * 32), bw[ks], cw, 0, 0, 0);
                                             ca = __builtin_amdgcn_mfma_f32_16x16x32_bf16(*(const LAS bf16x8*)(ap + 64 + ks * 32), ba[ks], ca, 0, 0, 0); }
#pragma unroll
            for (int ks = 0; ks < 4; ++ks) cg = __builtin_amdgcn_mfma_f32_16x16x32_bf16(*(const LAS bf16x8*)(ap + 128 + ks * 32), bg[ks], cg, 0, 0, 0);
#pragma unroll
            for (int rg = 0; rg < 4; ++rg) { const int o = (mt * 16 + fq * 4 + rg) * 64 + ntl * 16 + fr; LO[o] = cw[rg]; LO[2048 + o] = ca[rg]; LO[4096 + o] = cg[rg]; }
        }
        __syncthreads();
        if (!(MK_DBGSEL == 5 && part)) {
            const f32x4 w0v = *(const LAS f32x4*)(PRM + c4), a0v = *(const LAS f32x4*)(PRM + 64 + c4), kkv = *(const LAS f32x4*)(PRM + 128 + c4), kav = *(const LAS f32x4*)(PRM + 192 + c4),
                        rkv = *(const LAS f32x4*)(PRM + 256 + c4), mur = *(const LAS f32x4*)(PRM + 320 + c4), muk = *(const LAS f32x4*)(PRM + 384 + c4), muv = *(const LAS f32x4*)(PRM + 448 + c4);
            const f32x4 aw = w0v + *(const LAS f32x4*)(LO + tt * 64 + c4), aa = a0v + *(const LAS f32x4*)(LO + 2048 + tt * 64 + c4), ag = *(const LAS f32x4*)(LO + 4096 + tt * 64 + c4);
            f32x4 r = (f32x4){bf_lo(pre.zr.x), bf_hi(pre.zr.x), bf_lo(pre.zr.y), bf_hi(pre.zr.y)}, k = (f32x4){bf_lo(pre.zk.x), bf_hi(pre.zk.x), bf_lo(pre.zk.y), bf_hi(pre.zk.y)},
                  v = (f32x4){bf_lo(pre.zv.x), bf_hi(pre.zv.x), bf_lo(pre.zv.y), bf_hi(pre.zv.y)};
            const f32x4 rpv = (f32x4){bf_lo(pre.pr.x), bf_hi(pre.pr.x), bf_lo(pre.pr.y), bf_hi(pre.pr.y)}, kpv = (f32x4){bf_lo(pre.pk.x), bf_hi(pre.pk.x), bf_lo(pre.pk.y), bf_hi(pre.pk.y)},
                        vpv = (f32x4){bf_lo(pre.pv.x), bf_hi(pre.pv.x), bf_lo(pre.pv.y), bf_hi(pre.pv.y)};
            r = r + mur * (rpv - r); k = k + muk * (kpv - k); v = v + muv * (vpv - v);
            f32x4 dec, asg, kk, km, av, bv;
            float ssq = 0.f, bon = 0.f;
#pragma unroll
            for (int i = 0; i < 4; ++i) {
                const float x = -aw[i];
                const float sp = fmaxf(x, 0.f) + __logf(1.0f + __expf(-fabsf(x)));
                const float wraw = -sp - 0.5f;
                dec[i] = -__expf(wraw);
                asg[i] = sigm(aa[i]);
                kk[i] = k[i] * kkv[i]; ssq += kk[i] * kk[i];
                km[i] = k[i] * (1.0f + (asg[i] - 1.0f) * kav[i]);
                bon += r[i] * km[i] * rkv[i];
            }
            ssq = sum16(ssq); bon = sum16(bon);
            const float inv = 1.0f / fmaxf(sqrtf(ssq), 1e-12f);
#pragma unroll
            for (int i = 0; i < 4; ++i) { kk[i] *= inv; av[i] = -kk[i]; bv[i] = kk[i] * asg[i]; }
            LAS float* sq_ = SEQ + tt * 384 + c4;
            *(LAS f32x4*)(sq_) = av; *(LAS f32x4*)(sq_ + 64) = dec; *(LAS f32x4*)(sq_ + 128) = bv; *(LAS f32x4*)(sq_ + 192) = km; *(LAS f32x4*)(sq_ + 256) = r; *(LAS f32x4*)(sq_ + 320) = v;
            if (tt < nb) {
                v2u w; w.x = cvt_pk_bf16(ag[0], ag[1]); w.y = cvt_pk_bf16(ag[2], ag[3]); *(v2u*)(GB + row * 512 + hc) = w;
                w.x = cvt_pk_bf16(bon * v[0], bon * v[1]); w.y = cvt_pk_bf16(bon * v[2], bon * v[3]); *(v2u*)(BV + row * 512 + hc) = w;
            }
        }
        int nunit = unit, nt0 = t0 + SC_TB, nui = ui; bool more = true;
        if (nt0 >= T) { nt0 = 0; nui = ui + 1; more = p1_unit_at(nui, vcu, G, nunit); }
        if (more) p1_load(A, nunit, nt0, tt, cs, pre);
        __syncthreads();
        if (!(MK_DBGSEL == 1 && part)) p1_wy(X, SEQ, YY, ZZ, lds, nb, tid, lane, wave, part);
        __syncthreads();
        if (tt < nb) {
            const f32x4 y = *(const LAS f32x4*)(YY + tt * 64 + c4), z = *(const LAS f32x4*)(ZZ + tt * 64 + c4);
            v2u w; w.x = cvt_pk_bf16(y[0], y[1]); w.y = cvt_pk_bf16(y[2], y[3]); *(v2u*)(YL + row * 512 + hc) = w;
            w.x = cvt_pk_bf16(z[0], z[1]); w.y = cvt_pk_bf16(z[2], z[3]); *(v2u*)(ZT + row * 512 + hc) = w;
        }
        if (t0 + SC_TB >= T) {
#pragma unroll
            for (int j = 0; j < 4; ++j) {
                if (!prow_wave) *(f32x4*)((float*)A.out + (size_t)unit * 4096 + (16 * wave + fr) * 64 + 16 * j + 4 * fq) = X[j];
                else { v2u o; o.x = cvt_pk_bf16(X[j][0], X[j][1]); o.y = cvt_pk_bf16(X[j][2], X[j][3]);
                    *(v2u*)((bf16*)((unsigned char*)A.out + OB_MB) + (size_t)unit * 4096 + (16 * (wave - 4) + fr) * 64 + 16 * j + 4 * fq) = o; }
            }
        }
        if (!more) break;
        unit = nunit; t0 = nt0; ui = nui;
    }
    __syncthreads();
}

constexpr int P2_SP = 68, P2_MP = 80, P2_ML = 16 * P2_SP * 4, P2_PL = P2_ML + 64 * P2_MP * 4;
__device__ __forceinline__ void scan_pass2_rows(const float* Sinit, int unit0, int nchunks, int v0, float* outfin, bool slots, const Args& A, LAS unsigned char* lds, int tid, int lane, int wave) {
    LAS float* Sl = (LAS float*)lds; LAS float* Ml = (LAS float*)(lds + P2_ML); LAS float* Pl = (LAS float*)(lds + P2_PL);
    const int nt = wave & 3, kh = wave >> 2, fr = lane & 15, fq = lane >> 4;
    float* NB = (float*)A.out; const bf16* MB = (const bf16*)((const unsigned char*)A.out + OB_MB);
    { const int idx = tid * 2, row = idx >> 6, col = idx & 63;
      const f32x2 s0 = Sinit ? *(const f32x2*)(Sinit + (size_t)(v0 + row) * 64 + col) : (f32x2){0.f, 0.f};
      *(LAS f32x2*)(Sl + row * P2_SP + col) = s0; }
    v4u mreg = *(const v4u*)(MB + (size_t)unit0 * 4096 + tid * 8);
    float nreg[4] = {0.f, 0.f, 0.f, 0.f};
    if (kh == 0) {
#pragma unroll
        for (int rg = 0; rg < 4; ++rg) nreg[rg] = NB[(size_t)unit0 * 4096 + (v0 + fq * 4 + rg) * 64 + nt * 16 + fr]; }
    f32x4 acc = (f32x4){0.f, 0.f, 0.f, 0.f};
    for (int c = 0; c < nchunks; ++c) {
        { const int row = tid >> 3, col = (tid & 7) * 8; LAS float* mp = Ml + row * P2_MP + col;
          *(LAS f32x4*)mp = (f32x4){bf_lo(mreg.x), bf_hi(mreg.x), bf_lo(mreg.y), bf_hi(mreg.y)}; *(LAS f32x4*)(mp + 4) = (f32x4){bf_lo(mreg.z), bf_hi(mreg.z), bf_lo(mreg.w), bf_hi(mreg.w)}; }
        __syncthreads();
        float ncur[4] = {nreg[0], nreg[1], nreg[2], nreg[3]};
        if (c + 1 < nchunks) { mreg = *(const v4u*)(MB + (size_t)(unit0 + c + 1) * 4096 + tid * 8);
            if (kh == 0) {
#pragma unroll
                for (int rg = 0; rg < 4; ++rg) nreg[rg] = NB[(size_t)(unit0 + c + 1) * 4096 + (v0 + fq * 4 + rg) * 64 + nt * 16 + fr]; } }
        f32x4 a0 = (f32x4){0.f, 0.f, 0.f, 0.f}, a1 = a0;
        const LAS float* sp = Sl + fr * P2_SP + kh * 32 + fq; const LAS float* mp = Ml + (kh * 32 + fq) * P2_MP + nt * 16 + fr;
#pragma unroll
        for (int ks = 0; ks < 8; ks += 2) { a0 = __builtin_amdgcn_mfma_f32_16x16x4f32(sp[4 * ks], mp[4 * ks * P2_MP], a0, 0, 0, 0); a1 = __builtin_amdgcn_mfma_f32_16x16x4f32(sp[4 * ks + 4], mp[(4 * ks + 4) * P2_MP], a1, 0, 0, 0); }
        acc = a0 + a1;
        if (kh == 1) *(LAS f32x4*)(Pl + nt * 256 + lane * 4) = acc;
        __syncthreads();
        if (kh == 0) {
            acc = acc + *(const LAS f32x4*)(Pl + nt * 256 + lane * 4) + (f32x4){ncur[0], ncur[1], ncur[2], ncur[3]};
#pragma unroll
            for (int rg = 0; rg < 4; ++rg) { Sl[(fq * 4 + rg) * P2_SP + nt * 16 + fr] = acc[rg];
                if (slots) NB[(size_t)(unit0 + c) * 4096 + (v0 + fq * 4 + rg) * 64 + nt * 16 + fr] = acc[rg]; }
        }
    }
    if (kh == 0) {
#pragma unroll
        for (int rg = 0; rg < 4; ++rg) outfin[(size_t)(v0 + fq * 4 + rg) * 64 + nt * 16 + fr] = acc[rg]; }
    __syncthreads();
}

__device__ __forceinline__ void scan_pass3_wave(const Args& A, int unit, int wq, int lane) {
    const bool prompt = unit < NUNITS_P;
    const int b = prompt ? unit >> 9 : (unit - NUNITS_P) >> 3, h = prompt ? (unit >> 6) & 7 : unit & 7, ch = prompt ? unit & 63 : 0;
    const int T = prompt ? 64 : SEQ_S, rowbase = prompt ? b * SEQ_P + ch * 64 : NPROMPT + b * SEQ_S;
    if (wq * 16 >= T) return;
    const float* S0 = prompt ? (ch > 0 ? (const float*)A.out + (size_t)(unit - 1) * 4096 : nullptr) : A.in[I_SWKV] + (size_t)(b * 8 + h) * 4096;
    const bf16* ZT = (const bf16*)(A.ws + WS_ZT); const bf16* YL = (const bf16*)(A.ws + WS_YL); const bf16* BV = (const bf16*)(A.ws + WS_BV);
    bf16* YB = (bf16*)(A.ws + WS_A1) + (size_t)MPAD * 512;
    const int fr = lane & 15, fq = lane >> 4;
    const size_t row = (size_t)(rowbase + wq * 16 + fr);
    f32x4 acc[4];
#pragma unroll
    for (int mt = 0; mt < 4; ++mt) acc[mt] = (f32x4){0.f, 0.f, 0.f, 0.f};
    if (S0) {
        bf16x8 bz[2];
#pragma unroll
        for (int ks = 0; ks < 2; ++ks) bz[ks] = *(const bf16x8*)(ZT + row * 512 + h * 64 + ks * 32 + fq * 8);
#pragma unroll
        for (int mt = 0; mt < 4; ++mt)
#pragma unroll
            for (int ks = 0; ks < 2; ++ks) { const float* sp = S0 + (size_t)(mt * 16 + fr) * 64 + ks * 32 + fq * 8; const f32x4 s0 = *(const f32x4*)sp, s1 = *(const f32x4*)(sp + 4);
                v4u pk; pk.x = cvt_pk_bf16(s0[0], s0[1]); pk.y = cvt_pk_bf16(s0[2], s0[3]); pk.z = cvt_pk_bf16(s1[0], s1[1]); pk.w = cvt_pk_bf16(s1[2], s1[3]);
                acc[mt] = __builtin_amdgcn_mfma_f32_16x16x32_bf16(__builtin_bit_cast(bf16x8, pk), bz[ks], acc[mt], 0, 0, 0); }
    }
    float sm = 0.f;
#pragma unroll
    for (int mt = 0; mt < 4; ++mt) { const v2u yl = *(const v2u*)(YL + row * 512 + h * 64 + mt * 16 + fq * 4);
        acc[mt][0] += bf_lo(yl.x); acc[mt][1] += bf_hi(yl.x); acc[mt][2] += bf_lo(yl.y); acc[mt][3] += bf_hi(yl.y);
        sm += (acc[mt][0] + acc[mt][1]) + (acc[mt][2] + acc[mt][3]); }
    sm += __shfl_xor(sm, 16); sm += __shfl_xor(sm, 32);
    const float mean = sm * (1.f / 64.f); float sv = 0.f;
#pragma unroll
    for (int mt = 0; mt < 4; ++mt) { acc[mt] = acc[mt] - mean; sv += (acc[mt][0] * acc[mt][0] + acc[mt][1] * acc[mt][1]) + (acc[mt][2] * acc[mt][2] + acc[mt][3] * acc[mt][3]); }
    sv += __shfl_xor(sv, 16); sv += __shfl_xor(sv, 32);
    const float rs = 1.0f / sqrtf(sv * (1.f / 64.f) + 64e-5f);
#pragma unroll
    for (int mt = 0; mt < 4; ++mt) { const int c = h * 64 + mt * 16 + fq * 4;
        const f32x4 gw = *(const f32x4*)(A.in[I_GNW] + c), gb = *(const f32x4*)(A.in[I_GNB] + c);
        const v2u bvw = *(const v2u*)(BV + row * 512 + c), gg = *(const v2u*)(YB + row * 512 + c);
        f32x4 o = acc[mt] * rs * gw + gb + (f32x4){bf_lo(bvw.x), bf_hi(bvw.x), bf_lo(bvw.y), bf_hi(bvw.y)};
        o = o * (f32x4){bf_lo(gg.x), bf_hi(gg.x), bf_lo(gg.y), bf_hi(gg.y)};
        v2u w; w.x = cvt_pk_bf16(o[0], o[1]); w.y = cvt_pk_bf16(o[2], o[3]); *(v2u*)(YB + row * 512 + c) = w; }
}

__device__ __forceinline__ void tk_insert(float (&tv)[16], float x) {
#pragma unroll
    for (int i = 15; i >= 1; --i) tv[i] = __builtin_amdgcn_fmed3f(tv[i - 1], x, tv[i]);
    tv[0] = __builtin_fmaxf(tv[0], x);
}
#define TK_CE(t, i, j) { const float a_ = __builtin_fmaxf(t[i], t[j]); t[j] = __builtin_fminf(t[i], t[j]); t[i] = a_; }
__device__ __forceinline__ void tk_sort16(float (&t)[16]) {
    TK_CE(t, 0, 1) TK_CE(t, 2, 3) TK_CE(t, 0, 2) TK_CE(t, 1, 3) TK_CE(t, 1, 2) TK_CE(t, 4, 5) TK_CE(t, 6, 7) TK_CE(t, 4, 6) TK_CE(t, 5, 7) TK_CE(t, 5, 6) TK_CE(t, 0, 4) TK_CE(t, 2, 6) TK_CE(t, 2, 4) TK_CE(t, 1, 5) TK_CE(t, 3, 7) TK_CE(t, 3, 5) TK_CE(t, 1, 2) TK_CE(t, 3, 4) TK_CE(t, 5, 6) TK_CE(t, 8, 9) TK_CE(t, 10, 11) TK_CE(t, 8, 10) TK_CE(t, 9, 11) TK_CE(t, 9, 10) TK_CE(t, 12, 13) TK_CE(t, 14, 15) TK_CE(t, 12, 14) TK_CE(t, 13, 15) TK_CE(t, 13, 14) TK_CE(t, 8, 12) TK_CE(t, 10, 14) TK_CE(t, 10, 12) TK_CE(t, 9, 13) TK_CE(t, 11, 15) TK_CE(t, 11, 13) TK_CE(t, 9, 10) TK_CE(t, 11, 12) TK_CE(t, 13, 14) TK_CE(t, 0, 8) TK_CE(t, 4, 12) TK_CE(t, 4, 8) TK_CE(t, 2, 10) TK_CE(t, 6, 14) TK_CE(t, 6, 10) TK_CE(t, 2, 4) TK_CE(t, 6, 8) TK_CE(t, 10, 12) TK_CE(t, 1, 9) TK_CE(t, 5, 13) TK_CE(t, 5, 9) TK_CE(t, 3, 11) TK_CE(t, 7, 15) TK_CE(t, 7, 11) TK_CE(t, 3, 5) TK_CE(t, 7, 9) TK_CE(t, 11, 13) TK_CE(t, 1, 2) TK_CE(t, 3, 4) TK_CE(t, 5, 6) TK_CE(t, 7, 8) TK_CE(t, 9, 10) TK_CE(t, 11, 12) TK_CE(t, 13, 14)
}
__device__ __forceinline__ void tk_merge16(float (&tv)[16], const float (&g)[16]) {
#pragma unroll
    for (int i = 0; i < 16; ++i) tv[i] = __builtin_fmaxf(tv[i], g[15 - i]);
#pragma unroll
    for (int s = 8; s >= 1; s >>= 1)
#pragma unroll
        for (int i = 0; i < 16; ++i) if ((i & s) == 0) TK_CE(tv, i, i + s)
}
__device__ __forceinline__ float gelu_tanh(float x) {
    const float u = 0.7978845608028654f * (x + 0.044715f * x * x * x);
    const float th = 1.0f - 2.0f * __builtin_amdgcn_rcpf(__expf(2.0f * u) + 1.0f);
    return 0.5f * x * (1.0f + th);
}
constexpr int NTILE32 = NTOK / 32;
constexpr int CW_QU = 8192, CW_QV = 8192 + 512;

constexpr int TK_STRIDE = 68, TK_BYTES = 64 * TK_STRIDE * 4;
__device__ __forceinline__ void topk_scores64(const bf16* Q, const bf16* KB, LAS float* SC, int t0, int hp, int p, int half, int lane, const bf16x8 (&af)[2][2][4]) {
    const int fr = lane & 15, fq = lane >> 4;
#pragma unroll
    for (int hs = 0; hs < 2; ++hs) {
        const bf16* kbase = KB + (size_t)(((hp + 4 * hs) * 2 + p) * 128 + half * 64 + fr) * 128 + fq * 8;
#pragma unroll
        for (int n = 0; n < 4; ++n) {
            bf16x8 bfr[4];
#pragma unroll
            for (int ks = 0; ks < 4; ++ks) bfr[ks] = *(const bf16x8*)(kbase + (size_t)n * 16 * 128 + ks * 32);
            f32x4 acc0 = (f32x4){0.f, 0.f, 0.f, 0.f}, acc1 = acc0;
#pragma unroll
            for (int ks = 0; ks < 4; ++ks) { acc0 = __builtin_amdgcn_mfma_f32_16x16x32_bf16(af[hs][0][ks], bfr[ks], acc0, 0, 0, 0); acc1 = __builtin_amdgcn_mfma_f32_16x16x32_bf16(af[hs][1][ks], bfr[ks], acc1, 0, 0, 0); }
#pragma unroll
            for (int rg = 0; rg < 4; ++rg) { SC[(hs * 32 + fq * 4 + rg) * TK_STRIDE + n * 16 + fr] = acc0[rg]; SC[(hs * 32 + 16 + fq * 4 + rg) * TK_STRIDE + n * 16 + fr] = acc1[rg]; }
        }
    }
}
constexpr int TK_NPROMPT_UNITS = (NPROMPT / 32) * 4, TK_NSAMPLE_UNITS = (NSAMP / 32) * 4, CW_TKS = 9792;
__device__ __forceinline__ void peer_topk_units(const Args& A, LAS unsigned char* lds, int lane, int wave, int u_first, int u_end, int u_step) {
    const bf16* Q = (const bf16*)(A.ws + WS_ZG); const bf16* KB = (const bf16*)(A.ws + WS_KEYS); const float* SSP = (const float*)(A.ws + WS_SSP);
    unsigned short* EIDX = (unsigned short*)(A.ws + WS_EIDX); float* GATE = (float*)(A.ws + WS_GATE); float* RSTD = (float*)(A.ws + WS_RSTD);
    LAS float* SC = (LAS float*)(lds + wave * TK_BYTES);
    const int fr = lane & 15, fq = lane >> 4, tokl = lane & 31, hsel = lane >> 5;
    for (int u = u_first; u < u_end; u += u_step) {
        const int t0 = (u >> 2) * 32, hp = u & 3, h = hp + 4 * hsel;
        const float* sp = SSP + (size_t)(t0 + tokl) * 16;
        const f32x4 s0 = *(const f32x4*)sp, s1 = *(const f32x4*)(sp + 4), s2 = *(const f32x4*)(sp + 8), s3 = *(const f32x4*)(sp + 12);
        const float ssq = ((s0[0] + s0[1]) + (s0[2] + s0[3])) + ((s1[0] + s1[1]) + (s1[2] + s1[3])) + ((s2[0] + s2[1]) + (s2[2] + s2[3])) + ((s3[0] + s3[1]) + (s3[2] + s3[3]));
        const float rstd = 1.0f / sqrtf(ssq * (1.f / DM) + 1e-6f);
        float tv0[16], tv1[16], cv[16];
#pragma unroll
        for (int p = 0; p < 2; ++p) {
            bf16x8 af[2][2][4];
#pragma unroll
            for (int hs = 0; hs < 2; ++hs)
#pragma unroll
                for (int mt = 0; mt < 2; ++mt) { const bf16* qp = Q + (size_t)(t0 + mt * 16 + fr) * 2048 + (hp + 4 * hs) * 256 + p * 128 + fq * 8;
#pragma unroll
                    for (int ks = 0; ks < 4; ++ks) af[hs][mt][ks] = *(const bf16x8*)(qp + ks * 32); }
            float tv[16];
#pragma unroll
            for (int i = 0; i < 16; ++i) tv[i] = -3.0e38f;
            for (int half = 0; half < 2; ++half) {
                topk_scores64(Q, KB, SC, t0, hp, p, half, lane, af);
                LDS_WAIT();
                const LAS float* mine = SC + lane * TK_STRIDE;
                unsigned kmask = 0xFFFFFF80u; asm volatile("" : "+v"(kmask));
#pragma unroll 1
                for (int n = 0; n < 64; n += 16) {
                    float g[16];
#pragma unroll
                    for (int q = 0; q < 4; ++q) { const f32x4 x4 = *(const LAS f32x4*)(mine + n + 4 * q);
#pragma unroll
                        for (int e = 0; e < 4; ++e) g[4 * q + e] = __uint_as_float((__float_as_uint(x4[e]) & kmask) | (unsigned)(half * 64 + n + 4 * q + e)); }
                    tk_sort16(g); tk_merge16(tv, g);
                }
                LDS_WAIT();
            }
#pragma unroll
            for (int i = 0; i < 16; ++i) { if (p == 0) tv0[i] = tv[i]; else tv1[i] = tv[i]; }
        }
        LAS int* li = (LAS int*)SC + lane * 33;
#pragma unroll
        for (int q = 0; q < 16; ++q) { li[q] = (int)(__float_as_uint(tv0[q]) & 127u); li[16 + q] = (int)(__float_as_uint(tv1[q]) & 127u);
            tv0[q] = __uint_as_float(__float_as_uint(tv0[q]) & 0xFFFFFF80u); tv1[q] = __uint_as_float(__float_as_uint(tv1[q]) & 0xFFFFFF80u); }
#pragma unroll
        for (int q = 0; q < 16; ++q) cv[q] = -3.0e38f;
#pragma unroll
        for (int a = 0; a < 16; ++a)
#pragma unroll
            for (int b = 0; b < 16; ++b) if ((a + 1) * (b + 1) <= 16)
                tk_insert(cv, __uint_as_float((__float_as_uint(tv0[a] + tv1[b]) & 0xFFFFFF00u) | (unsigned)(a * 16 + b)));
        LDS_WAIT();
        float e[16], den = 0.f; unsigned ci[16];
        const float c0 = __uint_as_float(__float_as_uint(cv[0]) & 0xFFFFFF00u);
#pragma unroll
        for (int q = 0; q < 16; ++q) { const unsigned kb = __float_as_uint(cv[q]); const float cq = __uint_as_float(kb & 0xFFFFFF00u);
            e[q] = __expf((cq - c0) * rstd); den += e[q]; ci[q] = (unsigned)(li[(kb >> 4) & 15] * 128 + li[16 + (kb & 15)]); }
        const float inv = 1.0f / den;
        LDS_WAIT();
        {
            const size_t tok = (size_t)(t0 + tokl);
            v4u w0, w1; w0.x = ci[0] | (ci[1] << 16); w0.y = ci[2] | (ci[3] << 16); w0.z = ci[4] | (ci[5] << 16); w0.w = ci[6] | (ci[7] << 16);
            w1.x = ci[8] | (ci[9] << 16); w1.y = ci[10] | (ci[11] << 16); w1.z = ci[12] | (ci[13] << 16); w1.w = ci[14] | (ci[15] << 16);
            *(v4u*)(EIDX + tok * 128 + h * 16) = w0; *(v4u*)(EIDX + tok * 128 + h * 16 + 8) = w1;
#pragma unroll
            for (int q = 0; q < 4; ++q) *(f32x4*)(GATE + tok * 128 + h * 16 + 4 * q) = (f32x4){e[4 * q] * inv, e[4 * q + 1] * inv, e[4 * q + 2] * inv, e[4 * q + 3] * inv};
            if (h == 0) RSTD[tok] = rstd;
        }
    }
}

__device__ __forceinline__ bool peer_topk_split(int G) { return G == 256; }
__device__ __forceinline__ void peer_topk_phase(const Args& A, LAS unsigned char* lds, int tid, int lane, int wave, int vcu, int G) {
    peer_topk_units(A, lds, lane, wave, wave * G + vcu, peer_topk_split(G) ? TK_NPROMPT_UNITS : TK_NPROMPT_UNITS + TK_NSAMPLE_UNITS, G * NWAVES);
}
__device__ __forceinline__ void peer_topk_sample_prelude(const Args& A, LAS unsigned char* lds, int tid, int lane, int wave, int vcu, int G, gu32* ctl) {
    if (!peer_topk_split(G) || (vcu & 31) != 0) return;
    peer_topk_units(A, lds, lane, wave, TK_NPROMPT_UNITS + (vcu >> 5) * NWAVES + wave, TK_NPROMPT_UNITS + TK_NSAMPLE_UNITS, TK_NSAMPLE_UNITS);
    asm volatile("s_waitcnt vmcnt(0)" ::: "memory");
    __syncthreads();
    if (tid == 0) { __builtin_amdgcn_fence(__ATOMIC_RELEASE, "agent"); asm volatile("s_waitcnt vmcnt(0)" ::: "memory"); (void)__hip_atomic_fetch_add((unsigned*)(ctl + CW_TKS), 1u, RLX_AGENT); }
    __syncthreads();
}
__device__ __forceinline__ void peer_topk_sample_wait(gu32* ctl, int tid) {
    if (tid == 0) {
        unsigned sp = 0;
        while (__hip_atomic_load((unsigned*)(ctl + CW_TKS), RLX_AGENT) < (unsigned)(TK_NSAMPLE_UNITS / NWAVES)) { __builtin_amdgcn_s_sleep(2); if (++sp > (1u << 22)) break; }
        __builtin_amdgcn_fence(__ATOMIC_ACQUIRE, "agent");
        asm volatile("s_waitcnt vmcnt(0)" ::: "memory");
    }
    __syncthreads();
}

constexpr int PEER_ITEM = 40, NITEM128 = NTOK / PEER_ITEM;
__device__ __forceinline__ bool peer_next_item(gu32* qbase, int xcc, int& qs, int& slice, int& item, LAS unsigned char* lds, int tid) {
    LAS int* box = (LAS int*)(lds + LDSCTL_OFF + 64);
    for (;;) {
        if (qs >= 8) return false;
        slice = (xcc + qs) & 7;
        if (tid == 0) box[0] = (int)__hip_atomic_fetch_add((unsigned*)(qbase + 64 * slice), 1u, RLX_AGENT);
        __syncthreads();
        item = box[0];
        __syncthreads();
        if (item < NITEM128) return true;
        ++qs;
    }
}

typedef long i64_t;
constexpr float PEER_SX = 1.0f;
constexpr int U_TILE0 = 8192, U_TILEB = 16384;
__device__ __forceinline__ i64_t mk64(unsigned lo, unsigned hi) { return (i64_t)(((unsigned long long)hi << 32) | (unsigned long long)lo); }
__device__ __forceinline__ void peer_u_phase(const Args& A, LAS unsigned char* lds, int tid, int lane, int wave, gu32* ctl, int qoff) {
    const unsigned char* Uq = A.ws + WS_UB; const bf16* XG = (const bf16*)(A.ws + WS_A1);
    const unsigned short* EIDX = (const unsigned short*)(A.ws + WS_EIDX); float* PART = (float*)(A.ws + WS_PART);
    const int xcc = (int)(xb_xcc_id() & 7u), rg = lane >> 3, c8 = lane & 7, m = lane & 15, kq = lane >> 4;
    LAS int* we = (LAS int*)(lds + wave * 1024);
    LAS unsigned char* tile = lds + U_TILE0 + wave * U_TILEB;
    const int ch_e = ((c8 - (rg >> 1)) & 7) * 16, ch_o = ((c8 - 4 - (rg >> 1)) & 7) * 16;
    const int fbase = m * 128 + (kq & 1) * 8, pos0 = (kq >> 1) + (m >> 1);
    int foff[4];
#pragma unroll
    for (int ks = 0; ks < 4; ++ks) foff[ks] = fbase + ((pos0 + 2 * ks) & 7) * 16;
    int qs = 0, slice, item; bool lists_ready = !peer_topk_split((int)gridDim.x);
    while (peer_next_item(ctl + CW_QU + qoff, xcc, qs, slice, item, lds, tid)) {
        if (!lists_ready && (item + 1) * PEER_ITEM > NPROMPT) { peer_topk_sample_wait(ctl, tid); lists_ready = true; }
        const unsigned char* us = Uq + (size_t)slice * 16384 * 128;
        size_t tok = (size_t)(item * PEER_ITEM + wave);
        unsigned pair = *(const unsigned*)(EIDX + tok * 128 + 2 * lane);
        v4u xr[4];
#pragma unroll
        for (int ks = 0; ks < 4; ++ks) xr[ks] = *(const v4u*)(XG + tok * DM + slice * 128 + ks * 32 + kq * 8);
        we[2 * lane] = (int)(pair & 0xffffu); we[2 * lane + 1] = (int)(pair >> 16);
        LDS_WAIT();
        v4u w[16];
#pragma unroll
        for (int it = 0; it < 16; ++it) w[it] = *(const v4u*)(us + (unsigned)(((unsigned)we[it * 8 + rg] << 7) + (unsigned)((it & 1) ? ch_o : ch_e)));
        for (int tt = 0; tt < PEER_ITEM / NWAVES; ++tt) {
            const size_t ctok = tok; const bool more = tt + 1 < PEER_ITEM / NWAVES;
            i64_t bx[4];
#pragma unroll
            for (int ks = 0; ks < 4; ++ks) { const v4u q = xr[ks]; typedef short s16x2 __attribute__((ext_vector_type(2)));
                s16x2 lo = (s16x2){0, 0}, hi = lo;
                unsigned q0 = q.x, q1 = q.y, q2 = q.z, q3 = q.w; asm volatile("" : "+v"(q0), "+v"(q1), "+v"(q2), "+v"(q3));
                lo = __builtin_amdgcn_cvt_scalef32_pk_fp8_bf16(lo, __builtin_bit_cast(bf16x2_t, q0), PEER_SX, false); lo = __builtin_amdgcn_cvt_scalef32_pk_fp8_bf16(lo, __builtin_bit_cast(bf16x2_t, q1), PEER_SX, true);
                hi = __builtin_amdgcn_cvt_scalef32_pk_fp8_bf16(hi, __builtin_bit_cast(bf16x2_t, q2), PEER_SX, false); hi = __builtin_amdgcn_cvt_scalef32_pk_fp8_bf16(hi, __builtin_bit_cast(bf16x2_t, q3), PEER_SX, true);
                bx[ks] = mk64(__builtin_bit_cast(unsigned, lo), __builtin_bit_cast(unsigned, hi)); }
            if (more) { tok += NWAVES; pair = *(const unsigned*)(EIDX + tok * 128 + 2 * lane);
#pragma unroll
                for (int ks = 0; ks < 4; ++ks) xr[ks] = *(const v4u*)(XG + tok * DM + slice * 128 + ks * 32 + kq * 8); }
#pragma unroll
            for (int it = 0; it < 16; ++it) *(LAS v4u*)(tile + it * 1024 + lane * 16) = w[it];
            if (more) {
                we[2 * lane] = (int)(pair & 0xffffu); we[2 * lane + 1] = (int)(pair >> 16);
                LDS_WAIT();
#pragma unroll
                for (int it = 0; it < 16; ++it) w[it] = *(const v4u*)(us + (unsigned)(((unsigned)we[it * 8 + rg] << 7) + (unsigned)((it & 1) ? ch_o : ch_e)));
            } else LDS_WAIT();
            float* pp = PART + (ctok * 8 + slice) * 128;
            f32x4 acc[8];
#pragma unroll
            for (int hf = 0; hf < 2; ++hf) {
                v2u a[4][4];
#pragma unroll
                for (int T4 = 0; T4 < 4; ++T4)
#pragma unroll
                    for (int ks = 0; ks < 4; ++ks) a[T4][ks] = *(const LAS v2u*)(tile + (hf * 4 + T4) * 2048 + foff[ks]);
#pragma unroll
                for (int T4 = 0; T4 < 4; ++T4) acc[hf * 4 + T4] = (f32x4){0.f, 0.f, 0.f, 0.f};
#pragma unroll
                for (int ks = 0; ks < 4; ++ks)
#pragma unroll
                    for (int T4 = 0; T4 < 4; ++T4) acc[hf * 4 + T4] = __builtin_amdgcn_mfma_f32_16x16x32_fp8_fp8(mk64(a[T4][ks].x, a[T4][ks].y), bx[ks], acc[hf * 4 + T4], 0, 0, 0);
            }
            f32x4 val = acc[0];
#pragma unroll
            for (int T = 1; T < 8; ++T) val = ((m & 7) == T) ? acc[T] : val;
            if (m < 8) *(f32x4*)(pp + m * 16 + 4 * kq) = val * (1.0f / PEER_SX);
            LDS_WAIT();
        }
    }
}

__device__ __forceinline__ void peer_coef_phase(const Args& A, int lane, int wave, int vcu, int G) {
    const float* PART = (const float*)(A.ws + WS_PART); const float* GATE = (const float*)(A.ws + WS_GATE); const float* RSTD = (const float*)(A.ws + WS_RSTD);
    float* COEF = (float*)(A.ws + WS_COEF);
    for (int tok = vcu * NWAVES + wave; tok < NTOK; tok += G * NWAVES) {
        const float* pp = PART + (size_t)tok * 1024 + 2 * lane;
        f32x2 d = *(const f32x2*)pp;
#pragma unroll
        for (int j = 1; j < 8; ++j) d += *(const f32x2*)(pp + j * 128);
        const float sc = RSTD[tok] * (1.0f / PEER_SU); const f32x2 gt = *(const f32x2*)(GATE + (size_t)tok * 128 + 2 * lane);
        f32x2 cf; cf.x = gt.x * gelu_tanh(d.x * sc) * (1.0f / PEER_SV); cf.y = gt.y * gelu_tanh(d.y * sc) * (1.0f / PEER_SV);
        *(f32x2*)(COEF + (size_t)tok * 128 + 2 * lane) = cf;
    }
}

__device__ __forceinline__ void peer_v_phase(const Args& A, LAS unsigned char* lds, int tid, int lane, int wave, gu32* ctl) {
    const unsigned char* Vq = A.ws + WS_VB;
    const unsigned short* EIDX = (const unsigned short*)(A.ws + WS_EIDX); const float* COEF = (const float*)(A.ws + WS_COEF);
    float* X1 = A.out + O_Y; float* SS2 = (float*)(A.ws + WS_SS2);
    const int xcc = (int)(xb_xcc_id() & 7u), rg = lane >> 3, c8 = lane & 7;
    LAS int* we = (LAS int*)(lds + wave * 8192);
    LAS float* wc = (LAS float*)(we + 128); LAS float* wp = (LAS float*)(we + 256);
    int qs = 0, slice, item;
    while (peer_next_item(ctl + CW_QV, xcc, qs, slice, item, lds, tid)) {
        const unsigned char* vs = Vq + (size_t)slice * 16384 * 128; const unsigned voff = (unsigned)c8 * 16u;
        size_t tok = (size_t)(item * PEER_ITEM + wave);
        unsigned pair = *(const unsigned*)(EIDX + tok * 128 + 2 * lane); f32x2 cf = *(const f32x2*)(COEF + tok * 128 + 2 * lane);
        const bf16* XGv = (const bf16*)(A.ws + WS_A1);
        const f32x2 g2v = *(const f32x2*)(A.in[I_N2G] + slice * 128 + 2 * lane); const f32x2 rg2 = (f32x2){1.0f / g2v.x, 1.0f / g2v.y};
        unsigned xold = *(const unsigned*)(XGv + tok * DM + slice * 128 + 2 * lane);
        for (int tt = 0; tt < PEER_ITEM / NWAVES; ++tt) {
            we[2 * lane] = (int)(pair & 0xffffu); we[2 * lane + 1] = (int)(pair >> 16); *(LAS f32x2*)(wc + 2 * lane) = cf;
            const f32x2 xcur = (f32x2){bf_lo(xold) * rg2.x, bf_hi(xold) * rg2.y}; const size_t ctok = tok;
            LDS_WAIT();
            v4u w[16];
#pragma unroll
            for (int it = 0; it < 16; ++it) w[it] = *(const v4u*)(vs + (unsigned)(((unsigned)we[it * 8 + rg] << 7) + voff));
            if (tt + 1 < PEER_ITEM / NWAVES) { tok += NWAVES; pair = *(const unsigned*)(EIDX + tok * 128 + 2 * lane); cf = *(const f32x2*)(COEF + tok * 128 + 2 * lane);
                xold = *(const unsigned*)(XGv + tok * DM + slice * 128 + 2 * lane); }
            f32x2 o[8];
#pragma unroll
            for (int q = 0; q < 8; ++q) o[q] = (f32x2){0.f, 0.f};
#pragma unroll
            for (int it = 0; it < 16; ++it) {
                const float c = wc[it * 8 + rg]; const f32x2 c2 = (f32x2){c, c};
                o[0] += c2 * __builtin_amdgcn_cvt_pk_f32_fp8(w[it].x, false); o[1] += c2 * __builtin_amdgcn_cvt_pk_f32_fp8(w[it].x, true);
                o[2] += c2 * __builtin_amdgcn_cvt_pk_f32_fp8(w[it].y, false); o[3] += c2 * __builtin_amdgcn_cvt_pk_f32_fp8(w[it].y, true);
                o[4] += c2 * __builtin_amdgcn_cvt_pk_f32_fp8(w[it].z, false); o[5] += c2 * __builtin_amdgcn_cvt_pk_f32_fp8(w[it].z, true);
                o[6] += c2 * __builtin_amdgcn_cvt_pk_f32_fp8(w[it].w, false); o[7] += c2 * __builtin_amdgcn_cvt_pk_f32_fp8(w[it].w, true);
            }
#pragma unroll
            for (int q = 0; q < 4; ++q) *(LAS f32x4*)(wp + rg * 128 + c8 * 16 + 4 * q) = (f32x4){o[2 * q].x, o[2 * q].y, o[2 * q + 1].x, o[2 * q + 1].y};
            LDS_WAIT();
            f32x2 acc = *(const LAS f32x2*)(wp + 2 * lane);
#pragma unroll
            for (int r = 1; r < 8; ++r) acc += *(const LAS f32x2*)(wp + r * 128 + 2 * lane);
            const f32x2 x2 = xcur + acc;
            *(f32x2*)(X1 + ctok * DM + slice * 128 + 2 * lane) = x2;
            float ss = sum16(x2.x * x2.x + x2.y * x2.y); ss += __shfl_xor(ss, 16); ss += __shfl_xor(ss, 32);
            if (lane == 0) SS2[ctok * 8 + slice] = ss;
            LDS_WAIT();
        }
    }
}

__device__ __forceinline__ void peer_final_phase(const Args& A, int lane, int wave, int vcu, int G) {
    float* X1 = A.out + O_Y; const float* SS2 = (const float*)(A.ws + WS_SS2); const float* gf = A.in[I_NFG] + lane * 16;
    const f32x4 g0 = *(const f32x4*)gf, g1 = *(const f32x4*)(gf + 4), g2 = *(const f32x4*)(gf + 8), g3 = *(const f32x4*)(gf + 12);
    for (int tok = vcu * NWAVES + wave; tok < NTOK; tok += G * NWAVES) {
        const f32x4 sa = *(const f32x4*)(SS2 + (size_t)tok * 8), sb = *(const f32x4*)(SS2 + (size_t)tok * 8 + 4);
        const float ss = ((sa[0] + sa[1]) + (sa[2] + sa[3])) + ((sb[0] + sb[1]) + (sb[2] + sb[3]));
        const float rf = 1.0f / sqrtf(ss * (1.f / DM) + 1e-6f);
        float* yr = X1 + (size_t)tok * DM + lane * 16;
        const f32x4 y0 = *(const f32x4*)yr, y1 = *(const f32x4*)(yr + 4), y2 = *(const f32x4*)(yr + 8), y3 = *(const f32x4*)(yr + 12);
        *(f32x4*)yr = y0 * rf * g0; *(f32x4*)(yr + 4) = y1 * rf * g1; *(f32x4*)(yr + 8) = y2 * rf * g2; *(f32x4*)(yr + 12) = y3 * rf * g3;
    }
}

__device__ __forceinline__ void sg_partial(const bf16* Ap, int lda, const bf16* Bp, int ldb, LAS f32x4* red, int lane, int wave) {
    const int fr = lane & 15, fq = lane >> 4;
    bf16x8 a[2][4], b[4][4];
#pragma unroll
    for (int mi = 0; mi < 2; ++mi)
#pragma unroll
        for (int ks = 0; ks < 4; ++ks) a[mi][ks] = *(const bf16x8*)(Ap + (size_t)(16 * mi + fr) * lda + 32 * ks + 8 * fq);
#pragma unroll
    for (int nj = 0; nj < 4; ++nj)
#pragma unroll
        for (int ks = 0; ks < 4; ++ks) b[nj][ks] = *(const bf16x8*)(Bp + (size_t)(16 * nj + fr) * ldb + 32 * ks + 8 * fq);
    f32x4 acc[2][4];
#pragma unroll
    for (int mi = 0; mi < 2; ++mi)
#pragma unroll
        for (int nj = 0; nj < 4; ++nj) acc[mi][nj] = (f32x4){0.f, 0.f, 0.f, 0.f};
#pragma unroll
    for (int ks = 0; ks < 4; ++ks)
#pragma unroll
        for (int mi = 0; mi < 2; ++mi)
#pragma unroll
            for (int nj = 0; nj < 4; ++nj) acc[mi][nj] = __builtin_amdgcn_mfma_f32_16x16x32_bf16(b[nj][ks], a[mi][ks], acc[mi][nj], 0, 0, 0);
#pragma unroll
    for (int mi = 0; mi < 2; ++mi)
#pragma unroll
        for (int nj = 0; nj < 4; ++nj) red[(wave * 8 + mi * 4 + nj) * 64 + lane] = acc[mi][nj];
}
__device__ __forceinline__ f32x4 sg_sum(const LAS f32x4* red, int w0, int nw, int wave, int lane) {
    f32x4 s = red[(w0 * 8 + wave) * 64 + lane];
    for (int w = 1; w < nw; ++w) s += red[((w0 + w) * 8 + wave) * 64 + lane];
    return s;
}
__device__ __forceinline__ void sample_gemm2(const Args& A, LAS unsigned char* lds, int t, int lane, int wave) {
    unsigned char* ws = A.ws; const int fr = lane & 15, fq = lane >> 4;
    const int row0 = NPROMPT + (t >> 4) * 32, col0 = (t & 15) * 64;
    LAS f32x4* red = (LAS f32x4*)lds;
    const bf16* Ab = (const bf16*)(ws + WS_A1) + (wave >= 4 ? (size_t)MPAD * 512 : 0); const bf16* Bb = (const bf16*)(ws + (wave >= 4 ? WS_WPB : WS_WPA));
    sg_partial(Ab + (size_t)row0 * 512 + (wave & 3) * 128, 512, Bb + (size_t)col0 * 512 + (wave & 3) * 128, 512, red, lane, wave);
    const int row = row0 + 16 * (wave >> 2) + fr, c = col0 + 16 * (wave & 3) + 4 * fq;
    const bf16* Zg = (const bf16*)(ws + WS_ZG) + (size_t)row * 2048;
    const v2u ga = *(const v2u*)(Zg + c), gb = *(const v2u*)(Zg + 1024 + c);
    __syncthreads();
    const f32x4 pa = sg_sum(red, 0, 4, wave, lane), pb = sg_sum(red, 4, 4, wave, lane);
    const float o0 = sigm(bf_lo(ga.x)) * pa[0] + sigm(bf_lo(gb.x)) * pb[0], o1 = sigm(bf_hi(ga.x)) * pa[1] + sigm(bf_hi(gb.x)) * pb[1],
                o2 = sigm(bf_lo(ga.y)) * pa[2] + sigm(bf_lo(gb.y)) * pb[2], o3 = sigm(bf_hi(ga.y)) * pa[3] + sigm(bf_hi(gb.y)) * pb[3];
    v2u w; w.x = cvt_pk_bf16(o0, o1); w.y = cvt_pk_bf16(o2, o3); *(v2u*)((bf16*)(ws + WS_ZR) + (size_t)row * 1024 + c) = w;
    __syncthreads();
}
__device__ __forceinline__ void sample_gemm3(const Args& A, LAS unsigned char* lds, int t, int tid, int lane, int wave) {
    unsigned char* ws = A.ws; const int fr = lane & 15, fq = lane >> 4;
    const int row0 = NPROMPT + (t >> 4) * 32, col0 = (t & 15) * 64;
    LAS f32x4* red = (LAS f32x4*)lds; LAS float* ssl = (LAS float*)(lds + 65536);
    sg_partial((const bf16*)(ws + WS_ZR) + (size_t)row0 * 1024 + wave * 128, 1024, (const bf16*)(ws + WS_WO) + (size_t)col0 * 1024 + wave * 128, 1024, red, lane, wave);
    const int row = row0 + 16 * (wave >> 2) + fr, c = col0 + 16 * (wave & 3) + 4 * fq;
    const f32x4 xv = *(const f32x4*)(A.in[I_XS] + (size_t)(row - NPROMPT) * 1024 + c), q = *(const f32x4*)(A.in[I_N2G] + c);
    __syncthreads();
    const f32x4 o = xv + sg_sum(red, 0, 8, wave, lane);
    float ss = (o[0] * o[0] + o[1] * o[1]) + (o[2] * o[2] + o[3] * o[3]);
    v2u w; w.x = cvt_pk_bf16(o[0] * q[0], o[1] * q[1]); w.y = cvt_pk_bf16(o[2] * q[2], o[3] * q[3]); *(v2u*)((bf16*)(ws + WS_A1) + (size_t)row * 1024 + c) = w;
    ss += __shfl_xor(ss, 16); ss += __shfl_xor(ss, 32);
    if (fq == 0) ssl[wave * 16 + fr] = ss;
    __syncthreads();
    if (tid < 32) { const int mi = tid >> 4, r = tid & 15;
        ((float*)(ws + WS_SSP))[(size_t)(row0 + tid) * 16 + (t & 15)] = (ssl[(mi * 4 + 0) * 16 + r] + ssl[(mi * 4 + 1) * 16 + r]) + (ssl[(mi * 4 + 2) * 16 + r] + ssl[(mi * 4 + 3) * 16 + r]); }
}
__device__ __forceinline__ void sample_gemm4(const Args& A, LAS unsigned char* lds, int t, int lane, int wave) {
    unsigned char* ws = A.ws; const int fr = lane & 15, fq = lane >> 4;
    const int row0 = NPROMPT + (t >> 5) * 32, col0 = (t & 31) * 64;
    LAS f32x4* red = (LAS f32x4*)lds;
    sg_partial((const bf16*)(ws + WS_A1) + (size_t)row0 * 1024 + wave * 128, 1024, (const bf16*)(ws + WS_WQ) + (size_t)col0 * 1024 + wave * 128, 1024, red, lane, wave);
    const int row = row0 + 16 * (wave >> 2) + fr, c = col0 + 16 * (wave & 3) + 4 * fq;
    __syncthreads();
    const f32x4 o = sg_sum(red, 0, 8, wave, lane);
    v2u w; w.x = cvt_pk_bf16(o[0], o[1]); w.y = cvt_pk_bf16(o[2], o[3]); *(v2u*)((bf16*)(ws + WS_ZG) + (size_t)row * 2048 + c) = w;
    __syncthreads();
}

__global__ void __launch_bounds__(NTHR, 2) mk_fwd(Args args) {
    extern __shared__ __attribute__((aligned(16))) unsigned char lds_raw[];
    LAS unsigned char* lds = (LAS unsigned char*)lds_raw;
    const int tid = threadIdx.x, lane = tid & 63, wave = __builtin_amdgcn_readfirstlane(tid >> 6);
    const int G = gridDim.x; const int bx = blockIdx.x; const int vcu = (G % 8 == 0) ? (bx % 8) * (G / 8) + bx / 8 : bx;
    gu32* ctl = (gu32*)(args.ws + WS_CTL);
    volatile LAS unsigned* MISC = (volatile LAS unsigned*)(lds + MISC_OFF);
    for (int u = tid; u < (LDS_BYTES - LDSCTL_OFF) / 4; u += NTHR) ((LAS unsigned*)(lds + LDSCTL_OFF))[u] = 0u;
    __syncthreads();
    XcdBarrier bar; bar.bar = (unsigned*)(ctl + CW_BAR) + args.li * XCD_BAR_WORDS; bar.x = 0; bar.st = nullptr;
    if (N_LAUNCHES != PER_PHASE) bar = xcd_barrier_post((unsigned*)(ctl + CW_BAR) + args.li * XCD_BAR_WORDS, MISC + 8);
    const int lo = args.ph_lo, hi = args.ph_hi;
#define IN(k) (lo <= (k) && (k) < hi)
#define BOTH(k) (IN(k) && IN((k) + 1))
#define GRID_BAR() do { if (N_LAUNCHES != PER_PHASE) xcd_barrier(bar); } while (0)
    unsigned char* ws = args.ws;
    bf16* A1 = (bf16*)(ws + WS_A1);

    if (IN(0)) for (int rep_ = 0; rep_ < ((MK_REPEAT == 0) ? 2 : 1); ++rep_) { p0_prologue(args, lds, tid, lane, wave, vcu, G); if (BOTH(0)) GRID_BAR(); }

    if (IN(1)) for (int rep_ = 0; rep_ < ((MK_REPEAT == 1) ? 2 : 1); ++rep_) {
        pg8::Gemm g{A1, (const bf16*)(ws + WS_W1T), MPAD, N1, DM}; pg8::StaticOrder S; S.init(MPAD, N1, G, bx);
        pg8::EpiZ E{(bf16*)(ws + WS_ZC), (bf16*)(ws + WS_ZR), (bf16*)(ws + WS_ZG)};
        pg8::gemm_phase<pg8::EpiZ, pg8::StaticOrder, true, true>(lds, g, S, E);
        if (BOTH(1)) GRID_BAR();
    }

    if (IN(2)) for (int rep_ = 0; rep_ < ((MK_REPEAT == 2) ? 2 : 1); ++rep_) { conv_phase(args, vcu * NTHR + tid, G * NTHR); if (BOTH(2)) GRID_BAR(); }

    if (IN(3)) for (int rep_ = 0; rep_ < ((MK_REPEAT == 3) ? 2 : 1); ++rep_) {
        scan_pass1(args, lds, tid, lane, wave, vcu, G, (MK_REPEAT == 3 && rep_ == 0) ? 1 : 0);
        if (BOTH(3)) GRID_BAR();
    }

    if (IN(4)) {
        for (int u = vcu; u < 512; u += G) {
            if (u < 256) { const int bh = u >> 2, vq = u & 3; scan_pass2_rows(nullptr, bh * 64, 64, vq * 16, args.out + O_WKV_P + (size_t)bh * 4096, true, args, lds, tid, lane, wave); }
            else { const int bh = u - 256;
                for (int vq = 0; vq < 4; ++vq) scan_pass2_rows(args.in[I_SWKV] + (size_t)bh * 4096, NUNITS_P + bh, 1, vq * 16, args.out + O_WKV_S + (size_t)bh * 4096, false, args, lds, tid, lane, wave); }
        }
        if (BOTH(4)) GRID_BAR();
    }

    if (IN(5)) for (int rep_ = 0; rep_ < ((MK_REPEAT == 5) ? 2 : 1); ++rep_) {
        for (int u2 = vcu; u2 < NUNITS / 2; u2 += G) scan_pass3_wave(args, u2 * 2 + (wave >> 2), wave & 3, lane);
        if (BOTH(5)) GRID_BAR();
    }

    if (IN(6)) {
        { pg8::Gemm g{A1, (const bf16*)(ws + WS_WPA), NPROMPT, DM, 512}; pg8::StaticOrder S; S.init(NPROMPT, DM, G, bx);
          pg8::EpiGate<0> E{(const bf16*)(ws + WS_ZG), (bf16*)(ws + WS_ZR)};
          pg8::gemm_phase<pg8::EpiGate<0>, pg8::StaticOrder, true, true>(lds, g, S, E); }
        { pg8::Gemm g{A1 + (size_t)MPAD * 512, (const bf16*)(ws + WS_WPB), NPROMPT, DM, 512}; pg8::StaticOrder S; S.init(NPROMPT, DM, G, bx);
          pg8::EpiGate<1> E{(const bf16*)(ws + WS_ZG), (bf16*)(ws + WS_ZR)};
          pg8::gemm_phase<pg8::EpiGate<1>, pg8::StaticOrder, true, true>(lds, g, S, E); }
        for (int t = vcu; t < 256; t += G) sample_gemm2(args, lds, t, lane, wave);
        if (BOTH(6)) GRID_BAR();
    }

    if (IN(7)) for (int rep_ = 0; rep_ < ((MK_REPEAT == 7) ? 2 : 1); ++rep_) {
        pg8::Gemm g{(const bf16*)(ws + WS_ZR), (const bf16*)(ws + WS_WO), NPROMPT, DM, DM}; pg8::StaticOrder S; S.init(NPROMPT, DM, G, bx);
        pg8::EpiX1 E{args.in[I_XP], args.in[I_XS], args.out + O_Y, A1, (float*)(ws + WS_SSP), args.in[I_N2G], NPROMPT, NTOK};
        pg8::gemm_phase<pg8::EpiX1, pg8::StaticOrder, true, true>(lds, g, S, E);
        for (int t = vcu; t < 256; t += G) sample_gemm3(args, lds, t, tid, lane, wave);
        if (BOTH(7)) GRID_BAR();
    }

    if (IN(8)) for (int rep_ = 0; rep_ < ((MK_REPEAT == 8) ? 2 : 1); ++rep_) {
        pg8::Gemm g{A1, (const bf16*)(ws + WS_WQ), NPROMPT, 2048, DM}; pg8::StaticOrder S; S.init(NPROMPT, 2048, G, bx);
        pg8::EpiPlain E{(bf16*)(ws + WS_ZG), 2048};
        pg8::gemm_phase<pg8::EpiPlain, pg8::StaticOrder, true, true>(lds, g, S, E);
        for (int t = vcu; t < 512; t += G) sample_gemm4(args, lds, t, lane, wave);
        if (BOTH(8)) GRID_BAR();
    }

    if (IN(9)) for (int rep_ = 0; rep_ < ((MK_REPEAT == 9) ? 2 : 1); ++rep_) { peer_topk_phase(args, lds, tid, lane, wave, vcu, G); if (BOTH(9)) GRID_BAR(); }
    if (IN(10)) for (int rep_ = 0; rep_ < ((MK_REPEAT == 10) ? 2 : 1); ++rep_) { if (rep_ == 0) peer_topk_sample_prelude(args, lds, tid, lane, wave, vcu, G, ctl); peer_u_phase(args, lds, tid, lane, wave, ctl, rep_ * 1024); if (BOTH(10)) GRID_BAR(); }
    if (IN(11)) { peer_coef_phase(args, lane, wave, vcu, G); if (BOTH(11)) GRID_BAR(); }
    if (IN(12)) { peer_v_phase(args, lds, tid, lane, wave, ctl); if (BOTH(12)) GRID_BAR(); }
    if (IN(13)) peer_final_phase(args, lane, wave, vcu, G);
#undef IN
#undef BOTH
#undef GRID_BAR
}

extern "C" void kernel_launch(void* const* d_in, const int* in_sizes, int n_in, void* d_out, int out_size, void* d_ws, size_t ws_size, hipStream_t stream) {
    static int grid = 0;
    if (grid == 0) {
        if (n_in != 32 || ws_size < WS_END) { fprintf(stderr, "kernel_launch: built for 32 inputs and >= %zu bytes of workspace; got n_in %d ws %zu; nothing launched\n", (size_t)WS_END, n_in, ws_size); grid = -1; return; }
        int dev = 0, cus = 0, per_cu = 0;
        if (hipGetDevice(&dev) != hipSuccess || hipDeviceGetAttribute(&cus, hipDeviceAttributeMultiprocessorCount, dev) != hipSuccess) { fprintf(stderr, "kernel_launch: device query failed\n"); grid = -1; return; }
        if (hipFuncSetAttribute((const void*)mk_fwd, hipFuncAttributeMaxDynamicSharedMemorySize, LDS_BYTES) != hipSuccess) { fprintf(stderr, "kernel_launch: hipFuncSetAttribute failed\n"); grid = -1; return; }
        if (hipOccupancyMaxActiveBlocksPerMultiprocessor(&per_cu, (const void*)mk_fwd, NTHR, LDS_BYTES) != hipSuccess || per_cu < 1)
            fprintf(stderr, "kernel_launch: note: occupancy query reports %d workgroups per CU\n", per_cu);
        (void)hipGetLastError();
        grid = cus;
    }
    if (grid < 0) return;
    if (hipMemsetAsync((char*)d_ws + WS_CTL, 0, CTL_ZERO_BYTES, stream) != hipSuccess) { fprintf(stderr, "kernel_launch: hipMemsetAsync failed\n"); return; }
    Args a{};
    for (int i = 0; i < 32; ++i) a.in[i] = (const float*)d_in[i];
    a.out = (float*)d_out; a.ws = (unsigned char*)d_ws;
    constexpr int NL = (N_LAUNCHES == PER_PHASE ? PER_PHASE : 1) + ((MK_EXTRA_LO >= 0) ? 1 : 0);
    for (int li = 0; li < NL; ++li) {
        if (N_LAUNCHES == PER_PHASE) { a.ph_lo = li; a.ph_hi = li + 1; } else { a.ph_lo = 0; a.ph_hi = PER_PHASE; }
        if (MK_EXTRA_LO >= 0 && li == NL - 1) { a.ph_lo = MK_EXTRA_LO; a.ph_hi = MK_EXTRA_HI; }
        a.li = li;
        hipLaunchKernelGGL(mk_fwd, dim3(grid), dim3(NTHR), LDS_BYTES, stream, a);
        const hipError_t le = hipPeekAtLastError();
        if (le != hipSuccess) { fprintf(stderr, "kernel_launch: launch %d failed: %s\n", li, hipGetErrorName(le)); break; }
    }
}
```

```cpp
#include <hip/hip_runtime.h>
#include <cstdio>
#include <cstdint>
#define MK_N_LAUNCHES 1
#define MK_REPEAT -1
#define MK_DBGSEL 0
#define MK_EXTRA_LO -1
#define MK_EXTRA_HI -1
namespace pg8 {
#define PG8_LAS __attribute__((address_space(3)))
typedef unsigned short bf16_t;
typedef short bf16x8 __attribute__((ext_vector_type(8)));
typedef float f32x4 __attribute__((ext_vector_type(4)));
typedef unsigned u32x4 __attribute__((ext_vector_type(4)));
constexpr int BM = 256, BK = 64, HALF = 128, HTB = HALF * BK * 2  , STAGE_BYTES = 8 * HTB, NXCD = 8, WGM = 8;

__host__ __device__ __forceinline__ int lds_byte(int r, int c) { const int st = (r >> 4) * 2 + (c >> 5), rr = r & 15, cc = c & 31, ob = rr * 64 + cc * 2; return st * 1024 + (ob ^ (((ob >> 9) & 1) << 5)); }
__host__ __device__ __forceinline__ void stage_rc(int b, int& R, int& C) { const int st = b / 1024, sb = b % 1024, swz = sb ^ (((sb >> 9) & 1) << 5); R = (st >> 1) * 16 + swz / 64; C = (st & 1) * 32 + (swz % 64) / 2; }
__host__ __device__ __forceinline__ int perm32(int rho) { const int n = rho >> 4, i = rho & 15; return 8 * (i >> 2) + 4 * n + (i & 3); }

struct Unit { int pm, pn; };
struct Gemm { const bf16_t* A; const bf16_t* Bt; int M, N, K; };

struct StaticOrder {
    int nM, nN, nwg, G, c;
    __host__ __device__ void init(int M, int N, int G_, int c_) { nM = M / BM; nN = N / BM; nwg = nM * nN; G = G_; c = c_; }
    __host__ __device__ bool next(int i, Unit& u) const {
        const long L = (long)i * G + c; if (L >= nwg) return false;
        int wgid = (int)L; { const int q = nwg / NXCD, r = nwg % NXCD, xcd = wgid % NXCD, off = wgid / NXCD; wgid = (xcd < r ? xcd * (q + 1) : r * (q + 1) + (xcd - r) * q) + off; }
        const int nig = WGM * nN, gid = wgid / nig, fm = gid * WGM, gsz = (nM - fm) < WGM ? (nM - fm) : WGM;
        u.pm = fm + ((wgid % nig) % gsz); u.pn = (wgid % nig) / gsz; return true;
    }
    __device__ __forceinline__ void a_ready(const Unit&) const {}
    __device__ __forceinline__ void done(const Unit&) const {}
};

typedef __bf16 bf16x2_cv __attribute__((ext_vector_type(2))); typedef float f32x2_cv __attribute__((ext_vector_type(2)));
__device__ __forceinline__ unsigned cvt_pk_bf16(float lo, float hi) { return __builtin_bit_cast(unsigned, __builtin_convertvector((f32x2_cv){lo, hi}, bf16x2_cv)); }
__device__ __forceinline__ float bf_lo(unsigned w) { return __uint_as_float(w << 16); }
__device__ __forceinline__ float bf_hi(unsigned w) { return __uint_as_float(w & 0xffff0000u); }
__device__ __forceinline__ float sigm(float x) { return __builtin_amdgcn_rcpf(1.0f + __expf(-x)); }

struct EpiZ {
    static constexpr bool PERM = true, AFTER_DRAIN = false;
    bf16_t *Zc, *Zr, *Zg;
    __device__ __forceinline__ void operator()(const f32x4 (&acc)[2][2][4][2], const Unit& u, int wr, int wc, int fr, int fq) const {
        bf16_t* base; int ldc, colt;
        if (u.pn < 6) { base = Zc; ldc = 1536; colt = u.pn * BM; }
        else if (u.pn < 14) { base = Zr; ldc = 2048; colt = (u.pn - 6) * BM; }
        else { base = Zg; ldc = 2048; colt = (u.pn - 14) * BM; }
        const int row0 = u.pm * BM + wr * 64 + fr, col0 = colt + wc * 32 + 8 * fq;
#pragma unroll
        for (int ai = 0; ai < 2; ++ai)
#pragma unroll
            for (int m = 0; m < 4; ++m) { bf16_t* rowp = base + (size_t)(row0 + ai * HALF + m * 16) * ldc + col0;
#pragma unroll
                for (int bj = 0; bj < 2; ++bj) { const f32x4 v0 = acc[ai][bj][m][0], v1 = acc[ai][bj][m][1];
                    u32x4 w; w.x = cvt_pk_bf16(v0[0], v0[1]); w.y = cvt_pk_bf16(v0[2], v0[3]); w.z = cvt_pk_bf16(v1[0], v1[1]); w.w = cvt_pk_bf16(v1[2], v1[3]);
                    *(u32x4*)(rowp + bj * HALF) = w; } }
    }
};
struct EpiPlain {
    static constexpr bool PERM = true, AFTER_DRAIN = false;
    bf16_t* O; int ldc;
    __device__ __forceinline__ void operator()(const f32x4 (&acc)[2][2][4][2], const Unit& u, int wr, int wc, int fr, int fq) const {
        const int row0 = u.pm * BM + wr * 64 + fr, col0 = u.pn * BM + wc * 32 + 8 * fq;
#pragma unroll
        for (int ai = 0; ai < 2; ++ai)
#pragma unroll
            for (int m = 0; m < 4; ++m) { bf16_t* rowp = O + (size_t)(row0 + ai * HALF + m * 16) * ldc + col0;
#pragma unroll
                for (int bj = 0; bj < 2; ++bj) { const f32x4 v0 = acc[ai][bj][m][0], v1 = acc[ai][bj][m][1];
                    u32x4 w; w.x = cvt_pk_bf16(v0[0], v0[1]); w.y = cvt_pk_bf16(v0[2], v0[3]); w.z = cvt_pk_bf16(v1[0], v1[1]); w.w = cvt_pk_bf16(v1[2], v1[3]);
                    *(u32x4*)(rowp + bj * HALF) = w; } }
    }
};
template <int SECOND> struct EpiGate {
    static constexpr bool PERM = true, AFTER_DRAIN = false;
    const bf16_t* Zg; bf16_t* MG;
    __device__ __forceinline__ void operator()(const f32x4 (&acc)[2][2][4][2], const Unit& u, int wr, int wc, int fr, int fq) const {
        const int row0 = u.pm * BM + wr * 64 + fr, col0 = u.pn * BM + wc * 32 + 8 * fq;
#pragma unroll
        for (int ai = 0; ai < 2; ++ai) {
            u32x4 gw[4][2], pw[4][2];
#pragma unroll
            for (int m = 0; m < 4; ++m) { const int r = row0 + ai * HALF + m * 16;
#pragma unroll
                for (int bj = 0; bj < 2; ++bj) { gw[m][bj] = *(const u32x4*)(Zg + (size_t)r * 2048 + SECOND * 1024 + col0 + bj * HALF);
                    if (SECOND) pw[m][bj] = *(const u32x4*)(MG + (size_t)r * 1024 + col0 + bj * HALF); } }
#pragma unroll
            for (int m = 0; m < 4; ++m) { const int r = row0 + ai * HALF + m * 16; bf16_t* op = MG + (size_t)r * 1024 + col0;
#pragma unroll
                for (int bj = 0; bj < 2; ++bj) { const u32x4 g = gw[m][bj]; f32x4 v0 = acc[ai][bj][m][0], v1 = acc[ai][bj][m][1];
                    v0[0] *= sigm(bf_lo(g.x)); v0[1] *= sigm(bf_hi(g.x)); v0[2] *= sigm(bf_lo(g.y)); v0[3] *= sigm(bf_hi(g.y));
                    v1[0] *= sigm(bf_lo(g.z)); v1[1] *= sigm(bf_hi(g.z)); v1[2] *= sigm(bf_lo(g.w)); v1[3] *= sigm(bf_hi(g.w));
                    if (SECOND) { const u32x4 p = pw[m][bj];
                        v0[0] += bf_lo(p.x); v0[1] += bf_hi(p.x); v0[2] += bf_lo(p.y); v0[3] += bf_hi(p.y);
                        v1[0] += bf_lo(p.z); v1[1] += bf_hi(p.z); v1[2] += bf_lo(p.w); v1[3] += bf_hi(p.w); }
                    u32x4 w; w.x = cvt_pk_bf16(v0[0], v0[1]); w.y = cvt_pk_bf16(v0[2], v0[3]); w.z = cvt_pk_bf16(v1[0], v1[1]); w.w = cvt_pk_bf16(v1[2], v1[3]);
                    *(u32x4*)(op + bj * HALF) = w; } }
        }
    }
};
struct EpiX1 {
    static constexpr bool PERM = false, AFTER_DRAIN = false;
    const float* xp; const float* xs; float* X1; bf16_t* X1B; float* SSP; const float* g2; int nprompt, nrows;
    __device__ __forceinline__ void operator()(const f32x4 (&acc)[2][2][4][2], const Unit& u, int wr, int wc, int fr, int fq) const {
        typedef unsigned u32x2v __attribute__((ext_vector_type(2)));
        const int col0 = u.pn * BM + wc * 32 + 4 * fq;
        f32x4 gq[2][2];
#pragma unroll
        for (int bj = 0; bj < 2; ++bj)
#pragma unroll
            for (int n = 0; n < 2; ++n) gq[bj][n] = *(const f32x4*)(g2 + col0 + bj * HALF + n * 16);
#pragma unroll
        for (int ai = 0; ai < 2; ++ai) {
            f32x4 xv[4][2][2];
#pragma unroll
            for (int m = 0; m < 4; ++m) { int r = u.pm * BM + ai * HALF + wr * 64 + m * 16 + fr; r = r < nrows ? r : nrows - 1;
                const float* xr = r < nprompt ? xp + (size_t)r * 1024 : xs + (size_t)(r - nprompt) * 1024;
#pragma unroll
                for (int bj = 0; bj < 2; ++bj)
#pragma unroll
                    for (int n = 0; n < 2; ++n) xv[m][bj][n] = *(const f32x4*)(xr + col0 + bj * HALF + n * 16); }
#pragma unroll
            for (int m = 0; m < 4; ++m) { const int r = u.pm * BM + ai * HALF + wr * 64 + m * 16 + fr; float ss = 0.f;
#pragma unroll
                for (int bj = 0; bj < 2; ++bj)
#pragma unroll
                    for (int n = 0; n < 2; ++n) { const int c = col0 + bj * HALF + n * 16; const f32x4 o = xv[m][bj][n] + acc[ai][bj][m][n];
                        ss += (o[0] * o[0] + o[1] * o[1]) + (o[2] * o[2] + o[3] * o[3]);
                        const f32x4 q = gq[bj][n]; u32x2v w; w.x = cvt_pk_bf16(o[0] * q[0], o[1] * q[1]); w.y = cvt_pk_bf16(o[2] * q[2], o[3] * q[3]);
                        if (r < nrows) *(u32x2v*)(X1B + (size_t)r * 1024 + c) = w; }
                ss += __shfl_xor(ss, 16); ss += __shfl_xor(ss, 32);
                if (fq == 0 && r < nrows) SSP[(size_t)r * 16 + u.pn * 4 + wc] = ss;
            }
        }
    }
};
template <class Epi, class Sched, bool ALIGN_EPI = false, bool SP2 = false>
__device__ __forceinline__ void gemm_phase(PG8_LAS unsigned char* lds, const Gemm g, const Sched& S, const Epi& E) {
    const int tid = threadIdx.x, wid = __builtin_amdgcn_readfirstlane(tid >> 6), lane = tid & 63, wr = wid >> 2, wc = wid & 3, fr = lane & 15, fq = lane >> 4;
    const int K = g.K, nt = K / BK;
    unsigned voffA[2], voffB[2];
#pragma unroll
    for (int i = 0; i < 2; ++i) { int R, C; stage_rc(tid * 16 + i * 8192, R, C); const int Rb = Epi::PERM ? ((R & ~31) + perm32(R & 31)) : R;
        voffA[i] = (unsigned)(R * K + C) * 2u; voffB[i] = (unsigned)(Rb * K + C) * 2u; }
    const size_t kstep = (size_t)(BK * 2);
    const size_t hstep = (size_t)HALF * K * 2;
    const size_t tstep = 2 * hstep;
    const unsigned ldsw = (unsigned)wid * 1024u;
    const int aoff = lds_byte(wr * 64 + fr, fq * 8), boff = lds_byte(wc * 32 + fr, fq * 8);
#define PG8_SA(b, h) (((b) * 2 + (h)) * HTB)
#define PG8_SB(b, h) ((4 + (b) * 2 + (h)) * HTB)
#define PG8_STAGE(bufoff, gbase, voff) do { _Pragma("unroll") for (int _i = 0; _i < 2; ++_i) \
        __builtin_amdgcn_global_load_lds((const unsigned*)((const char*)(gbase) + (voff)[_i]), (PG8_LAS unsigned*)(lds + (bufoff) + ldsw + _i * 8192), 16, 0, 0); } while (0)
#define PG8_LDA(dst, b, h) do { _Pragma("unroll") for (int m = 0; m < 4; ++m) _Pragma("unroll") for (int k = 0; k < 2; ++k) dst[m][k] = *(const PG8_LAS bf16x8*)(lds + PG8_SA(b, h) + aoff + m * 2048 + k * 1024); } while (0)
#define PG8_LDB(dst, b, h) do { _Pragma("unroll") for (int n = 0; n < 2; ++n) _Pragma("unroll") for (int k = 0; k < 2; ++k) dst[n][k] = *(const PG8_LAS bf16x8*)(lds + PG8_SB(b, h) + boff + n * 2048 + k * 1024); } while (0)
#define PG8_MMA(ai, bj, At, Bt) do { __builtin_amdgcn_s_setprio(1); _Pragma("unroll") for (int m = 0; m < 4; ++m) _Pragma("unroll") for (int n = 0; n < 2; ++n) _Pragma("unroll") for (int k = 0; k < 2; ++k) \
        acc[ai][bj][m][n] = __builtin_amdgcn_mfma_f32_16x16x32_bf16(Bt[n][k], At[m][k], acc[ai][bj][m][n], 0, 0, 0); __builtin_amdgcn_s_setprio(0); } while (0)
#define PG8_WAIT_V(n) asm volatile("s_waitcnt vmcnt(" #n ")" ::: "memory")
#define PG8_WAIT_L(n) asm volatile("s_waitcnt lgkmcnt(" #n ")" ::: "memory")
#define PG8_BAR __builtin_amdgcn_s_barrier()
#define PG8_SCHED __builtin_amdgcn_sched_barrier(0)
    Unit cur, nxt; int ui = 0;
    if (!S.next(0, cur)) return;
    f32x4 acc[2][2][4][2];
#pragma unroll
    for (int a = 0; a < 2; ++a)
#pragma unroll
        for (int b = 0; b < 2; ++b)
#pragma unroll
            for (int m = 0; m < 4; ++m)
#pragma unroll
                for (int n = 0; n < 2; ++n) acc[a][b][m][n] = (f32x4){0.f, 0.f, 0.f, 0.f};
    bf16x8 At[4][2], B0[2][2], B1[2][2];
    const char* cA = (const char*)g.A + (size_t)cur.pm * tstep; const char* cB = (const char*)g.Bt + (size_t)cur.pn * tstep;
    S.a_ready(cur);
    if constexpr (SP2) {
        PG8_STAGE(PG8_SB(0, 0), cB, voffB); PG8_STAGE(PG8_SB(0, 1), cB + hstep, voffB); PG8_STAGE(PG8_SA(0, 0), cA, voffA); PG8_STAGE(PG8_SA(0, 1), cA + hstep, voffA);
        if (wr == 1) PG8_BAR;
        PG8_WAIT_V(2); PG8_BAR;
        PG8_STAGE(PG8_SB(1, 0), cB + kstep, voffB); PG8_STAGE(PG8_SA(1, 0), cA + kstep, voffA); PG8_STAGE(PG8_SB(1, 1), cB + hstep + kstep, voffB);
        PG8_WAIT_V(6); PG8_BAR;
    } else {
        PG8_STAGE(PG8_SB(0, 0), cB, voffB); PG8_STAGE(PG8_SA(0, 0), cA, voffA); PG8_STAGE(PG8_SB(0, 1), cB + hstep, voffB); PG8_STAGE(PG8_SA(0, 1), cA + hstep, voffA);
        if (wr == 1) PG8_BAR;
        PG8_WAIT_V(4); PG8_BAR;
        PG8_STAGE(PG8_SB(1, 0), cB + kstep, voffB); PG8_STAGE(PG8_SA(1, 0), cA + kstep, voffA); PG8_STAGE(PG8_SB(1, 1), cB + hstep + kstep, voffB);
        PG8_WAIT_V(6); PG8_BAR;
    }
    for (;;) {
        const bool has_next = S.next(ui + 1, nxt);
        const char* nA = has_next ? (const char*)g.A + (size_t)nxt.pm * tstep : cA; const char* nB = has_next ? (const char*)g.Bt + (size_t)nxt.pn * tstep : cB;
        for (int t = 0; t < nt; t += 2) {
            const bool last = (t == nt - 2);
            const char* a1 = cA + (size_t)(t + 1) * kstep;
            const char* a2 = last ? nA : cA + (size_t)(t + 2) * kstep; const char* b2 = last ? nB : cB + (size_t)(t + 2) * kstep;
            const char* a3 = a2 + kstep; const char* b3 = b2 + kstep;
            if (last && has_next) S.a_ready(nxt);
            if constexpr (SP2) {
            PG8_LDB(B0, 0, 0); PG8_LDB(B1, 0, 1); PG8_SCHED; PG8_LDA(At, 0, 0); PG8_STAGE(PG8_SA(1, 1), a1 + hstep, voffA);
            PG8_WAIT_V(8); PG8_WAIT_L(0); PG8_BAR; PG8_MMA(0, 0, At, B0); PG8_MMA(0, 1, At, B1); PG8_BAR; PG8_SCHED;
            PG8_LDA(At, 0, 1); PG8_STAGE(PG8_SB(0, 0), b2, voffB); PG8_STAGE(PG8_SB(0, 1), b2 + hstep, voffB); PG8_STAGE(PG8_SA(0, 0), a2, voffA);
            PG8_WAIT_V(8); PG8_WAIT_L(0); PG8_BAR; PG8_MMA(1, 0, At, B0); PG8_MMA(1, 1, At, B1); PG8_BAR; PG8_SCHED;
            PG8_LDB(B0, 1, 0); PG8_LDB(B1, 1, 1); PG8_SCHED; PG8_LDA(At, 1, 0); PG8_STAGE(PG8_SA(0, 1), a2 + hstep, voffA);
            PG8_WAIT_V(8); PG8_WAIT_L(0); PG8_BAR; PG8_MMA(0, 0, At, B0); PG8_MMA(0, 1, At, B1); PG8_BAR; PG8_SCHED;
            PG8_LDA(At, 1, 1); PG8_STAGE(PG8_SB(1, 0), b3, voffB); PG8_STAGE(PG8_SB(1, 1), b3 + hstep, voffB); PG8_STAGE(PG8_SA(1, 0), a3, voffA);
            PG8_WAIT_V(8); PG8_WAIT_L(0); PG8_BAR; PG8_MMA(1, 0, At, B0); PG8_MMA(1, 1, At, B1); PG8_BAR; PG8_SCHED;
            } else {
            PG8_LDB(B0, 0, 0); PG8_SCHED; PG8_LDA(At, 0, 0); PG8_STAGE(PG8_SA(1, 1), a1 + hstep, voffA);
            PG8_WAIT_L(8); PG8_BAR; PG8_WAIT_L(0); PG8_MMA(0, 0, At, B0); PG8_BAR; PG8_SCHED;
            PG8_LDB(B1, 0, 1); PG8_STAGE(PG8_SB(0, 0), b2, voffB);
            PG8_BAR; PG8_WAIT_L(0); PG8_MMA(0, 1, At, B1); PG8_BAR;
            PG8_LDA(At, 0, 1); PG8_STAGE(PG8_SA(0, 0), a2, voffA);
            PG8_BAR; PG8_WAIT_L(0); PG8_MMA(1, 0, At, B0); PG8_BAR; PG8_SCHED;
            PG8_STAGE(PG8_SB(0, 1), b2 + hstep, voffB);
            PG8_WAIT_V(6); PG8_BAR; PG8_MMA(1, 1, At, B1); PG8_BAR;
            PG8_LDB(B0, 1, 0); PG8_SCHED; PG8_LDA(At, 1, 0); PG8_STAGE(PG8_SA(0, 1), a2 + hstep, voffA);
            PG8_WAIT_L(8); PG8_BAR; PG8_WAIT_L(0); PG8_MMA(0, 0, At, B0); PG8_BAR; PG8_SCHED;
            PG8_LDB(B1, 1, 1); PG8_STAGE(PG8_SB(1, 0), b3, voffB);
            PG8_BAR; PG8_WAIT_L(0); PG8_MMA(0, 1, At, B1); PG8_BAR;
            PG8_LDA(At, 1, 1); PG8_STAGE(PG8_SA(1, 0), a3, voffA);
            PG8_BAR; PG8_WAIT_L(0); PG8_MMA(1, 0, At, B0); PG8_BAR; PG8_SCHED;
            PG8_STAGE(PG8_SB(1, 1), b3 + hstep, voffB);
            PG8_WAIT_V(6); PG8_BAR; PG8_MMA(1, 1, At, B1); PG8_BAR;
            }
        }
        if constexpr (ALIGN_EPI) { if (wr == 0) PG8_BAR; }
        if constexpr (!Epi::AFTER_DRAIN) { E(acc, cur, wr, wc, fr, fq); S.done(cur); }
        if (!has_next) break;
#pragma unroll
        for (int a = 0; a < 2; ++a)
#pragma unroll
            for (int b = 0; b < 2; ++b)
#pragma unroll
                for (int m = 0; m < 4; ++m)
#pragma unroll
                    for (int n = 0; n < 2; ++n) acc[a][b][m][n] = (f32x4){0.f, 0.f, 0.f, 0.f};
        cur = nxt; cA = nA; cB = nB; ++ui;
        if constexpr (ALIGN_EPI) { if (wr == 1) PG8_BAR; }
    }
    PG8_WAIT_V(0);
    if constexpr (!ALIGN_EPI) { if (wr == 0) PG8_BAR; }
    PG8_BAR;
    if constexpr (Epi::AFTER_DRAIN) { E.fused(acc, cur, wr, wc, fr, fq, lds, wid, lane); S.done(cur); }
#undef PG8_SA
#undef PG8_SB
#undef PG8_STAGE
#undef PG8_LDA
#undef PG8_LDB
#undef PG8_MMA
#undef PG8_WAIT_V
#undef PG8_WAIT_L
#undef PG8_BAR
#undef PG8_SCHED
}
}
constexpr int NWAVES = 8, NTHR = 512;
#ifndef MK_N_LAUNCHES
#define MK_N_LAUNCHES 1
#endif
constexpr int PER_PHASE = 14;
constexpr int N_LAUNCHES = MK_N_LAUNCHES;

constexpr int DM = 1024, NPROMPT = 32768, NSAMP = 512, NTOK = 33280, NSHIFT = 32, MPAD = 33536, N1 = 5632;
constexpr int SEQ_P = 4096, SEQ_S = 16, NB_P = 8, NB_S = 32;
constexpr size_t O_Y = 0, O_CONV_P = 34078720, O_SHIFT_P = 34086912, O_WKV_P = 34095104, O_CONV_S = 34357248, O_SHIFT_S = 34390016, O_WKV_S = 34422784;
constexpr size_t KiB = 1024, MiB = 1u << 20;
constexpr size_t WS_CTL = 0, CTL_ZERO_BYTES = 64 * KiB;
constexpr size_t WS_W1T = 64 * KiB;
constexpr size_t WS_WPA = WS_W1T + (size_t)N1 * DM * 2;
constexpr size_t WS_WPB = WS_WPA + 1 * MiB;
constexpr size_t WS_WO = WS_WPB + 1 * MiB;
constexpr size_t WS_WQ = WS_WO + 2 * MiB;
constexpr size_t WS_KEYS = WS_WQ + 4 * MiB;
constexpr size_t WS_L2T = WS_KEYS + 512 * KiB;
constexpr size_t WS_SSP = WS_L2T + 256 * KiB;
constexpr size_t WS_UB = WS_SSP + (size_t)MPAD * 16 * 4;
constexpr size_t WS_VB = WS_UB + 16 * MiB;
constexpr size_t WS_A1 = WS_VB + 16 * MiB;
constexpr size_t WS_ZC = WS_A1 + (size_t)MPAD * DM * 2;
constexpr size_t WS_ZR = WS_ZC + (size_t)MPAD * 1536 * 2;
constexpr size_t WS_ZG = WS_ZR + (size_t)MPAD * 2048 * 2;
constexpr size_t WS_END = WS_ZG + (size_t)MPAD * 2048 * 2;
constexpr size_t WS_YL = WS_ZC, WS_ZT = WS_ZC + (size_t)NTOK * 512 * 2, WS_BV = WS_ZC + (size_t)NTOK * 512 * 4;
constexpr size_t WS_EIDX = WS_ZC, WS_GATE = WS_ZC + 16 * MiB, WS_COEF = WS_ZC + 40 * MiB, WS_SS2 = WS_ZC + 64 * MiB, WS_RSTD = WS_ZC + 66 * MiB;
constexpr size_t WS_PART = WS_ZR;
constexpr size_t OB_MB = (size_t)4352 * 4096 * 4;
static_assert(WS_BV + (size_t)NTOK * 512 * 2 <= WS_ZR && OB_MB + (size_t)4352 * 4096 * 2 <= (size_t)NTOK * 1024 * 4, "scan scratch maps");
static_assert(WS_END <= 512 * MiB, "d_ws map must fit 512 MiB");
constexpr float PEER_SU = 32.0f, PEER_SV = 4.0f;
constexpr int CW_BAR = 1024;
constexpr int LDS_BYTES = 163840;
constexpr int LDSCTL_OFF = LDS_BYTES - 512, MISC_OFF = LDSCTL_OFF + 320;

#define GAS __attribute__((address_space(1)))
#define LAS __attribute__((address_space(3)))
typedef unsigned short bf16;
typedef unsigned v4u __attribute__((ext_vector_type(4)));
typedef unsigned v2u __attribute__((ext_vector_type(2)));
typedef float f32x4 __attribute__((ext_vector_type(4)));
typedef short bf16x8 __attribute__((ext_vector_type(8)));
typedef __bf16 bf16x2_t __attribute__((ext_vector_type(2)));
typedef GAS unsigned gu32;
#define RLX_AGENT __ATOMIC_RELAXED, __HIP_MEMORY_SCOPE_AGENT
#define LDS_WAIT() asm volatile("s_waitcnt lgkmcnt(0)" ::: "memory")
#define VM_WAIT() asm volatile("s_waitcnt vmcnt(0)" ::: "memory")
using pg8::cvt_pk_bf16; using pg8::bf_lo; using pg8::bf_hi; using pg8::sigm;
#define XB_TMO      128
#define XB_XCNT(j)  (256  + 64 * (j))
#define XB_XSUB(j)  (1280 + 64 * (j))
#define XB_XGEN(j)  (2304 + 64 * (j))
#define XB_TOP      3328
#define XB_TOPGEN   3392
#define XCD_BAR_WORDS 3456
#define XB_SPIN_CAP (1u << 22)

__device__ __forceinline__ unsigned xb_ld(unsigned* p)              { return __hip_atomic_load(p, __ATOMIC_RELAXED, __HIP_MEMORY_SCOPE_AGENT); }
__device__ __forceinline__ unsigned xb_add(unsigned* p, unsigned v) { return __hip_atomic_fetch_add(p, v, __ATOMIC_RELAXED, __HIP_MEMORY_SCOPE_AGENT); }
__device__ __forceinline__ unsigned xb_xcc_id() { return (unsigned)__builtin_amdgcn_s_getreg((3 << 11) | 20) & 0xFu; }
#define XB_SPIN(cond, bar) do { unsigned _sp = 0; while (cond) { __builtin_amdgcn_s_sleep(1); \
    if ((++_sp & 255u) == 0u) { if (xb_ld(&(bar)[XB_TMO])) break; if (_sp > XB_SPIN_CAP) { atomicAdd(&(bar)[XB_TMO], 1u); break; } } } } while (0)

struct XcdBarrier {
    unsigned* bar; unsigned x;
    volatile LAS unsigned* st;
};

__device__ __forceinline__ XcdBarrier xcd_barrier_post(unsigned* bar, volatile LAS unsigned* st) {
    XcdBarrier b; b.bar = bar; b.x = xb_xcc_id(); b.st = st;
    if (threadIdx.x == 0) (void)xb_add(&bar[XB_XCNT(b.x)], 1u);
    return b;
}
__device__ __forceinline__ void xcd_barrier_complete(unsigned* bar, unsigned x, unsigned& nloc, unsigned& nx) {
    const unsigned G = gridDim.x * gridDim.y * gridDim.z;
    unsigned sum, cnt, mine, sp = 0u;
    for (;;) {
        sum = 0u; cnt = 0u; mine = 0u;
#pragma unroll
        for (unsigned j = 0; j < 16; ++j) { const unsigned c = xb_ld(&bar[XB_XCNT(j)]); sum += c; cnt += (c > 0u) ? 1u : 0u; mine = (j == x) ? c : mine; }
        if (sum == G) break;
        __builtin_amdgcn_s_sleep(1);
        if ((++sp & 255u) == 0u) { if (xb_ld(&bar[XB_TMO])) break; if (sp > XB_SPIN_CAP) { atomicAdd(&bar[XB_TMO], 1u); break; } }
    }
    nloc = mine > 0u ? mine : 1u; nx = cnt > 0u ? cnt : 1u;
}

__device__ __forceinline__ void xcd_barrier(const XcdBarrier& b) {
    asm volatile("s_waitcnt vmcnt(0)" ::: "memory");
    __syncthreads();
    if (threadIdx.x == 0) {
        unsigned* bar = b.bar;
        __builtin_amdgcn_s_waitcnt(0);
        unsigned nloc = b.st[0], nx = b.st[1];
        if (nloc == 0u) { xcd_barrier_complete(bar, b.x, nloc, nx); b.st[0] = nloc; b.st[1] = nx; }
        const unsigned old = xb_add(&bar[XB_XSUB(b.x)], 1u);
        const unsigned gen = old / nloc;
        if (old + 1u == (gen + 1u) * nloc) {
            __builtin_amdgcn_fence(__ATOMIC_RELEASE, "agent");
            asm volatile("s_waitcnt vmcnt(0)" ::: "memory");
            const unsigned og = xb_add(&bar[XB_TOP], 1u);
            const unsigned tg = og / nx;
            if (og + 1u == (tg + 1u) * nx) xb_add(&bar[XB_TOPGEN], 1u);
            else XB_SPIN(xb_ld(&bar[XB_TOPGEN]) == tg, bar);
            __builtin_amdgcn_fence(__ATOMIC_ACQUIRE, "agent");
            xb_add(&bar[XB_XGEN(b.x)], 1u);
            asm volatile("s_waitcnt vmcnt(0)" ::: "memory");
        } else {
            XB_SPIN(xb_ld(&bar[XB_XGEN(b.x)]) == gen, bar);
            __builtin_amdgcn_fence(__ATOMIC_ACQUIRE, "agent");
            asm volatile("s_waitcnt vmcnt(0)" ::: "memory");
        }
    }
    __syncthreads();
}
struct Args { const float* in[32]; float* out; unsigned char* ws; int ph_lo, ph_hi, li, pad; };
enum { I_XP = 0, I_XS, I_SCONV, I_SSHIFT, I_SWKV, I_N1G, I_WIN, I_CONVW, I_MURKV, I_MUWAG, I_W0, I_W1, I_W2, I_A0, I_A1, I_A2, I_G1, I_G2, I_KK, I_KA, I_RK, I_GNW, I_GNB, I_WPA, I_WPB, I_WO, I_N2G, I_WQ, I_KEYS, I_U, I_V, I_NFG };

__device__ __forceinline__ float wave_sum(float v) {
#pragma unroll
    for (int o = 1; o < 64; o <<= 1) v += __shfl_xor(v, o);
    return v;
}
template <int CTRL> __device__ __forceinline__ float dpp_mov(float v) { return __builtin_bit_cast(float, __builtin_amdgcn_update_dpp(0, __builtin_bit_cast(int, v), CTRL, 0xF, 0xF, true)); }
__device__ __forceinline__ float sum4(float v) { v += dpp_mov<0xB1>(v); v += dpp_mov<0x4E>(v); return v; }
__device__ __forceinline__ float sum8(float v) { v = sum4(v); v += dpp_mov<0x141>(v); return v; }
__device__ __forceinline__ float sum16(float v) { v = sum8(v); v += dpp_mov<0x140>(v); return v; }
__device__ __forceinline__ float dot2bf(unsigned w, unsigned x, float acc) { return __builtin_amdgcn_fdot2_f32_bf16(__builtin_bit_cast(bf16x2_t, w), __builtin_bit_cast(bf16x2_t, x), acc, false); }

__device__ __forceinline__ void transpose_item(const float* W, int ldw, int c0, int K, bf16* WT, int nblk, int item, const float* sv, float alpha, float beta, LAS float* scr, int lane) {
    const int kb = item / nblk, nb = item % nblk, k0 = 64 * kb, n0 = 32 * nb;
#pragma unroll 8
    for (int i = 0; i < 32; ++i) { const int kk = 2 * i + (lane >> 5); float s = 1.f; if (sv) s = alpha + beta * sv[k0 + kk];
        scr[kk * 33 + (lane & 31)] = W[(size_t)(k0 + kk) * ldw + c0 + n0 + (lane & 31)] * s; }
    LDS_WAIT();
    const int c = lane & 7;
#pragma unroll
    for (int j = 0; j < 4; ++j) { const int n = (lane >> 3) + 8 * j; const LAS float* s = scr + (8 * c) * 33 + n;
        v4u o; o.x = cvt_pk_bf16(s[0 * 33], s[1 * 33]); o.y = cvt_pk_bf16(s[2 * 33], s[3 * 33]); o.z = cvt_pk_bf16(s[4 * 33], s[5 * 33]); o.w = cvt_pk_bf16(s[6 * 33], s[7 * 33]);
        *(v4u*)(WT + (size_t)(n0 + n) * K + k0 + 8 * c) = o; }
    LDS_WAIT();
}
__device__ __forceinline__ void cvt_stream(const float* src, bf16* dst, size_t n, size_t gt, size_t nthreads) {
    for (size_t i = gt * 8; i < n; i += nthreads * 8) { const f32x4 a = *(const f32x4*)(src + i), b = *(const f32x4*)(src + i + 4);
        v4u o; o.x = cvt_pk_bf16(a[0], a[1]); o.y = cvt_pk_bf16(a[2], a[3]); o.z = cvt_pk_bf16(b[0], b[1]); o.w = cvt_pk_bf16(b[2], b[3]); *(v4u*)(dst + i) = o; }
}
__device__ __forceinline__ void cvt_stream_fp8(const float* src, unsigned char* dst, size_t n, float scale, size_t gt, size_t nthreads) {
    for (size_t i = gt * 16; i < n; i += nthreads * 16) {
        const f32x4 a = *(const f32x4*)(src + i) * scale, b = *(const f32x4*)(src + i + 4) * scale, c = *(const f32x4*)(src + i + 8) * scale, d = *(const f32x4*)(src + i + 12) * scale;
        v4u o; unsigned p;
        p = __builtin_amdgcn_cvt_pk_fp8_f32(a[0], a[1], 0, false); o.x = __builtin_amdgcn_cvt_pk_fp8_f32(a[2], a[3], p, true);
        p = __builtin_amdgcn_cvt_pk_fp8_f32(b[0], b[1], 0, false); o.y = __builtin_amdgcn_cvt_pk_fp8_f32(b[2], b[3], p, true);
        p = __builtin_amdgcn_cvt_pk_fp8_f32(c[0], c[1], 0, false); o.z = __builtin_amdgcn_cvt_pk_fp8_f32(c[2], c[3], p, true);
        p = __builtin_amdgcn_cvt_pk_fp8_f32(d[0], d[1], 0, false); o.w = __builtin_amdgcn_cvt_pk_fp8_f32(d[2], d[3], p, true);
        *(v4u*)(dst + i) = o; }
}
__device__ __forceinline__ void cvt16_fp8_sliced(const float* src, unsigned char* dst, float scale, size_t i) {
    const f32x4 a = *(const f32x4*)(src + i) * scale, b = *(const f32x4*)(src + i + 4) * scale, c = *(const f32x4*)(src + i + 8) * scale, d = *(const f32x4*)(src + i + 12) * scale;
    v4u o; unsigned p;
    p = __builtin_amdgcn_cvt_pk_fp8_f32(a[0], a[1], 0, false); o.x = __builtin_amdgcn_cvt_pk_fp8_f32(a[2], a[3], p, true);
    p = __builtin_amdgcn_cvt_pk_fp8_f32(b[0], b[1], 0, false); o.y = __builtin_amdgcn_cvt_pk_fp8_f32(b[2], b[3], p, true);
    p = __builtin_amdgcn_cvt_pk_fp8_f32(c[0], c[1], 0, false); o.z = __builtin_amdgcn_cvt_pk_fp8_f32(c[2], c[3], p, true);
    p = __builtin_amdgcn_cvt_pk_fp8_f32(d[0], d[1], 0, false); o.w = __builtin_amdgcn_cvt_pk_fp8_f32(d[2], d[3], p, true);
    const size_t e = i >> 10, col = i & 1023;
    *(v4u*)(dst + (col >> 7) * ((size_t)16384 * 128) + e * 128 + (col & 127)) = o;
}
__device__ __forceinline__ void cvt_stream_fp8_sliced(const float* src, unsigned char* dst, float scale, size_t gt, size_t nthreads) {
#pragma unroll 2
    for (size_t i = gt * 16; i < (size_t)16384 * 1024; i += nthreads * 16) {
        const f32x4 a = *(const f32x4*)(src + i) * scale, b = *(const f32x4*)(src + i + 4) * scale, c = *(const f32x4*)(src + i + 8) * scale, d = *(const f32x4*)(src + i + 12) * scale;
        v4u o; unsigned p;
        p = __builtin_amdgcn_cvt_pk_fp8_f32(a[0], a[1], 0, false); o.x = __builtin_amdgcn_cvt_pk_fp8_f32(a[2], a[3], p, true);
        p = __builtin_amdgcn_cvt_pk_fp8_f32(b[0], b[1], 0, false); o.y = __builtin_amdgcn_cvt_pk_fp8_f32(b[2], b[3], p, true);
        p = __builtin_amdgcn_cvt_pk_fp8_f32(c[0], c[1], 0, false); o.z = __builtin_amdgcn_cvt_pk_fp8_f32(c[2], c[3], p, true);
        p = __builtin_amdgcn_cvt_pk_fp8_f32(d[0], d[1], 0, false); o.w = __builtin_amdgcn_cvt_pk_fp8_f32(d[2], d[3], p, true);
        const size_t e = i >> 10, col = i & 1023;
        *(v4u*)(dst + (col >> 7) * ((size_t)16384 * 128) + e * 128 + (col & 127)) = o; }
}
__device__ __forceinline__ void p0_prologue(const Args& A, LAS unsigned char* lds, int tid, int lane, int wave, int vcu, int G) {
    unsigned char* ws = A.ws;
    bf16* W1T = (bf16*)(ws + WS_W1T);
    LAS float* scr = (LAS float*)(lds + wave * 16384);
    const int gw = vcu * NWAVES + wave, NGW = G * NWAVES;
    constexpr int J0 = 16 * 96, J1 = 16 * 64, JL = 16 * 2, JG = 16 * 4, JP = 8 * 32, JO = 16 * 32, JQ = 16 * 64;
    constexpr int JW2 = 16, JG2 = 32;
    constexpr int NITEMS = J0 + J1 + 4 * JL + 2 * JG + 2 * JP + JO + JQ + 2 * JW2 + JG2;
    bf16* L2T = (bf16*)(ws + WS_L2T);
    const float* mu = A.in[I_MUWAG];
    for (int it = gw; it < NITEMS; it += NGW) {
        int r = it;
        if (r < J0) { transpose_item(A.in[I_WIN], 5120, 0, 1024, W1T, 96, r, nullptr, 0.f, 0.f, scr, lane); continue; } r -= J0;
        if (r < J1) { transpose_item(A.in[I_WIN], 5120, 3072, 1024, W1T + (size_t)3584 * 1024, 64, r, nullptr, 0.f, 0.f, scr, lane); continue; } r -= J1;
        if (r < JL) { transpose_item(A.in[I_W1], 64, 0, 1024, W1T + (size_t)3072 * 1024, 2, r, mu, 1.f, -1.f, scr, lane); continue; } r -= JL;
        if (r < JL) { transpose_item(A.in[I_W1], 64, 0, 1024, W1T + (size_t)3328 * 1024, 2, r, mu, 0.f, 1.f, scr, lane); continue; } r -= JL;
        if (r < JL) { transpose_item(A.in[I_A1], 64, 0, 1024, W1T + (size_t)(3072 + 64) * 1024, 2, r, mu + 1024, 1.f, -1.f, scr, lane); continue; } r -= JL;
        if (r < JL) { transpose_item(A.in[I_A1], 64, 0, 1024, W1T + (size_t)(3328 + 64) * 1024, 2, r, mu + 1024, 0.f, 1.f, scr, lane); continue; } r -= JL;
        if (r < JG) { transpose_item(A.in[I_G1], 128, 0, 1024, W1T + (size_t)(3072 + 128) * 1024, 4, r, mu + 2048, 1.f, -1.f, scr, lane); continue; } r -= JG;
        if (r < JG) { transpose_item(A.in[I_G1], 128, 0, 1024, W1T + (size_t)(3328 + 128) * 1024, 4, r, mu + 2048, 0.f, 1.f, scr, lane); continue; } r -= JG;
        if (r < JP) { transpose_item(A.in[I_WPA], 1024, 0, 512, (bf16*)(ws + WS_WPA), 32, r, nullptr, 0.f, 0.f, scr, lane); continue; } r -= JP;
        if (r < JP) { transpose_item(A.in[I_WPB], 1024, 0, 512, (bf16*)(ws + WS_WPB), 32, r, nullptr, 0.f, 0.f, scr, lane); continue; } r -= JP;
        if (r < JO) { transpose_item(A.in[I_WO], 1024, 0, 1024, (bf16*)(ws + WS_WO), 32, r, nullptr, 0.f, 0.f, scr, lane); continue; } r -= JO;
        if (r < JQ) { transpose_item(A.in[I_WQ], 2048, 0, 1024, (bf16*)(ws + WS_WQ), 64, r, nullptr, 0.f, 0.f, scr, lane); continue; } r -= JQ;
        if (r < JW2) { transpose_item(A.in[I_W2], 512, 0, 64, L2T, 16, r, nullptr, 0.f, 0.f, scr, lane); continue; } r -= JW2;
        if (r < JW2) { transpose_item(A.in[I_A2], 512, 0, 64, L2T + (size_t)512 * 64, 16, r, nullptr, 0.f, 0.f, scr, lane); continue; } r -= JW2;
        transpose_item(A.in[I_G2], 512, 0, 128, L2T + (size_t)1024 * 64, 16, r, nullptr, 0.f, 0.f, scr, lane);
    }
    const size_t gt = (size_t)vcu * NTHR + tid, nth = (size_t)G * NTHR;
    if (G != 256) {
        cvt_stream_fp8_sliced(A.in[I_U], ws + WS_UB, PEER_SU, gt, nth);
        cvt_stream_fp8_sliced(A.in[I_V], ws + WS_VB, PEER_SV, gt, nth); }
    cvt_stream(A.in[I_KEYS], (bf16*)(ws + WS_KEYS), (size_t)8 * 2 * 128 * 128, gt, nth);
    bf16* A1 = (bf16*)(ws + WS_A1);
    const f32x4* g1v = (const f32x4*)A.in[I_N1G] + lane;
    for (int m0 = gw; m0 < NTOK; m0 += 2 * NGW) {
        const int m1 = m0 + NGW; const bool two = m1 < NTOK; const int m1c = two ? m1 : m0;
        const f32x4* xr0 = (const f32x4*)(m0 < NPROMPT ? A.in[I_XP] + (size_t)m0 * DM : A.in[I_XS] + (size_t)(m0 - NPROMPT) * DM) + lane;
        const f32x4* xr1 = (const f32x4*)(m1c < NPROMPT ? A.in[I_XP] + (size_t)m1c * DM : A.in[I_XS] + (size_t)(m1c - NPROMPT) * DM) + lane;
        f32x4 v0[4], v1[4]; float s0 = 0.f, s1 = 0.f;
#pragma unroll
        for (int j = 0; j < 4; ++j) { v0[j] = xr0[64 * j]; v1[j] = xr1[64 * j]; }
#pragma unroll
        for (int j = 0; j < 4; ++j) { s0 += (v0[j][0] * v0[j][0] + v0[j][1] * v0[j][1]) + (v0[j][2] * v0[j][2] + v0[j][3] * v0[j][3]);
                                      s1 += (v1[j][0] * v1[j][0] + v1[j][1] * v1[j][1]) + (v1[j][2] * v1[j][2] + v1[j][3] * v1[j][3]); }
#pragma unroll
        for (int o = 1; o < 64; o <<= 1) { s0 += __shfl_xor(s0, o); s1 += __shfl_xor(s1, o); }
        const float r0 = 1.0f / sqrtf(s0 * (1.f / DM) + 1e-6f), r1 = 1.0f / sqrtf(s1 * (1.f / DM) + 1e-6f);
#pragma unroll
        for (int rr = 0; rr < 2; ++rr) {
            if (rr == 1 && !two) break;
            const int m = rr ? m1 : m0; const float rstd = rr ? r1 : r0;
            v2u* o8 = (v2u*)(A1 + (size_t)m * DM) + lane;
            float* so = nullptr;
            if (m < NPROMPT) { if ((m & (SEQ_P - 1)) == SEQ_P - 1) so = A.out + O_SHIFT_P + (size_t)(m / SEQ_P) * DM; }
            else { const int ms = m - NPROMPT; if ((ms & (SEQ_S - 1)) == SEQ_S - 1) so = A.out + O_SHIFT_S + (size_t)(ms / SEQ_S) * DM; }
#pragma unroll
            for (int j = 0; j < 4; ++j) { const f32x4 g = g1v[64 * j]; const f32x4 y = (rr ? v1[j] : v0[j]) * rstd * g;
                v2u w; w.x = cvt_pk_bf16(y[0], y[1]); w.y = cvt_pk_bf16(y[2], y[3]); o8[64 * j] = w;
                if (so) ((f32x4*)so)[lane + 64 * j] = y; }
        }
    }
    for (int m = NTOK + gw; m < MPAD; m += NGW) {
        v2u* o8 = (v2u*)(A1 + (size_t)m * DM) + lane;
        if (m < NTOK + NSHIFT) {
            const f32x4* xr = (const f32x4*)(A.in[I_SSHIFT] + (size_t)(m - NTOK) * DM) + lane;
#pragma unroll
            for (int j = 0; j < 4; ++j) { const f32x4 y = xr[64 * j]; v2u w; w.x = cvt_pk_bf16(y[0], y[1]); w.y = cvt_pk_bf16(y[2], y[3]); o8[64 * j] = w; }
        } else {
#pragma unroll
            for (int j = 0; j < 4; ++j) { v2u w; w.x = 0u; w.y = 0u; o8[64 * j] = w; }
        }
    }
}

__device__ __forceinline__ void unpack8(const v4u w, float (&f)[8]) { f[0] = bf_lo(w.x); f[1] = bf_hi(w.x); f[2] = bf_lo(w.y); f[3] = bf_hi(w.y); f[4] = bf_lo(w.z); f[5] = bf_hi(w.z); f[6] = bf_lo(w.w); f[7] = bf_hi(w.w); }
__device__ __forceinline__ void conv_phase(const Args& A, int gt, int nth) {
    const bf16* Zc = (const bf16*)(A.ws + WS_ZC); bf16* YA = (bf16*)(A.ws + WS_A1);
    const float* cw = A.in[I_CONVW];
    for (int task = gt; task < (NTOK / 16) * 64; task += nth) {
        const int seg = task >> 6, ch = (task & 63) * 8, row0 = seg * 16;
        int b, t0, T; bool prompt = row0 < NPROMPT;
        if (prompt) { b = row0 / SEQ_P; t0 = row0 % SEQ_P; T = SEQ_P; } else { b = (row0 - NPROMPT) / SEQ_S; t0 = 0; T = SEQ_S; }
        float um2[8], um1[8], c0[8], c1[8], c2[8];
#pragma unroll
        for (int i = 0; i < 8; ++i) { c0[i] = cw[ch + i]; c1[i] = cw[512 + ch + i]; c2[i] = cw[1024 + ch + i]; }
        if (t0 == 0) {
            if (prompt) {
#pragma unroll
                for (int i = 0; i < 8; ++i) { um2[i] = 0.f; um1[i] = 0.f; }
            } else { const float* sc = A.in[I_SCONV] + (size_t)b * 2 * 512 + ch;
#pragma unroll
                for (int i = 0; i < 8; ++i) { um2[i] = sc[i]; um1[i] = sc[512 + i]; } }
        } else {
            float a[8], h[8];
            unpack8(*(const v4u*)(Zc + (size_t)(row0 - 2) * 1536 + 512 + ch), a); unpack8(*(const v4u*)(Zc + (size_t)(row0 - 2) * 1536 + 1024 + ch), h);
#pragma unroll
            for (int i = 0; i < 8; ++i) um2[i] = a[i] * h[i];
            unpack8(*(const v4u*)(Zc + (size_t)(row0 - 1) * 1536 + 512 + ch), a); unpack8(*(const v4u*)(Zc + (size_t)(row0 - 1) * 1536 + 1024 + ch), h);
#pragma unroll
            for (int i = 0; i < 8; ++i) um1[i] = a[i] * h[i];
        }
#pragma unroll 4
        for (int t = 0; t < 16; ++t) {
            const size_t row = (size_t)(row0 + t);
            float zb[8], zc[8], zh[8], y[8];
            unpack8(*(const v4u*)(Zc + row * 1536 + ch), zb); unpack8(*(const v4u*)(Zc + row * 1536 + 512 + ch), zc); unpack8(*(const v4u*)(Zc + row * 1536 + 1024 + ch), zh);
#pragma unroll
            for (int i = 0; i < 8; ++i) { const float u = zc[i] * zh[i]; y[i] = zb[i] * (c0[i] * um2[i] + c1[i] * um1[i] + c2[i] * u); um2[i] = um1[i]; um1[i] = u; }
            v4u o; o.x = cvt_pk_bf16(y[0], y[1]); o.y = cvt_pk_bf16(y[2], y[3]); o.z = cvt_pk_bf16(y[4], y[5]); o.w = cvt_pk_bf16(y[6], y[7]);
            *(v4u*)(YA + row * 512 + ch) = o;
        }
        if (t0 + 16 == T) { float* oc = A.out + (prompt ? O_CONV_P : O_CONV_S) + (size_t)b * 2 * 512 + ch;
#pragma unroll
            for (int i = 0; i < 8; ++i) { oc[i] = um2[i]; oc[512 + i] = um1[i]; } }
    }
    bf16* Zr = (bf16*)(A.ws + WS_ZR);
    for (int task = nth - 1 - gt; task < NTOK * 16; task += nth) {
        const int m = task >> 4, cs = task & 15;
        bool hasprev; int prow;
        if (m < NPROMPT) { hasprev = (m & (SEQ_P - 1)) != 0; prow = m - 1; } else { const int ms = m - NPROMPT; hasprev = true; prow = (ms & (SEQ_S - 1)) ? m - 1 : NTOK + ms / SEQ_S; }
        bf16* pap = Zr + (size_t)m * 2048 + 1536 + cs * 16;
        float pa[16], t8[8];
        const v4u a0 = *(const v4u*)pap, a1 = *(const v4u*)(pap + 8);
        v4u b0 = (v4u){0u, 0u, 0u, 0u}, b1 = b0;
        if (hasprev) { const bf16* pbp = Zr + (size_t)prow * 2048 + 1792 + cs * 16; b0 = *(const v4u*)pbp; b1 = *(const v4u*)(pbp + 8); }
        unpack8(a0, t8);
#pragma unroll
        for (int i = 0; i < 8; ++i) pa[i] = t8[i];
        unpack8(a1, t8);
#pragma unroll
        for (int i = 0; i < 8; ++i) pa[8 + i] = t8[i];
        unpack8(b0, t8);
#pragma unroll
        for (int i = 0; i < 8; ++i) pa[i] += t8[i];
        unpack8(b1, t8);
#pragma unroll
        for (int i = 0; i < 8; ++i) pa[8 + i] += t8[i];
#pragma unroll
        for (int i = 0; i < 16; ++i) { float p = pa[i];
            if (cs < 4) p = 1.0f - 2.0f * __builtin_amdgcn_rcpf(__expf(2.0f * p) + 1.0f);
            else if (cs >= 8) p = sigm(p);
            pa[i] = p; }
        v4u o0, o1; o0.x = cvt_pk_bf16(pa[0], pa[1]); o0.y = cvt_pk_bf16(pa[2], pa[3]); o0.z = cvt_pk_bf16(pa[4], pa[5]); o0.w = cvt_pk_bf16(pa[6], pa[7]);
        o1.x = cvt_pk_bf16(pa[8], pa[9]); o1.y = cvt_pk_bf16(pa[10], pa[11]); o1.z = cvt_pk_bf16(pa[12], pa[13]); o1.w = cvt_pk_bf16(pa[14], pa[15]);
        *(v4u*)pap = o0; *(v4u*)(pap + 8) = o1;
    }
}

constexpr int NUNITS_P = NB_P * 8 * 64, NUNITS = NUNITS_P + NB_S * 8;
constexpr int HID_STRIDE = 264, SC_TB = 32;
constexpr int P1_HIDB = 0, P1_LO = 16896, P1_SEQ = 41472, P1_GG = 90624, P1_YY = 98816, P1_ZZ = 107008, P1_BON = 115200;
typedef float f32x2 __attribute__((ext_vector_type(2)));

struct P1Pre { v4u pa0, pa1; v2u zr, zk, zv, pr, pk, pv; };
struct P1Pos { int unit, t0; };
__device__ __forceinline__ void p1_decode(int unit, bool& prompt, int& b, int& h, int& ch, int& T, int& rowbase) {
    prompt = unit < NUNITS_P; b = prompt ? unit >> 9 : (unit - NUNITS_P) >> 3; h = prompt ? (unit >> 6) & 7 : unit & 7; ch = prompt ? unit & 63 : 0;
    T = prompt ? 64 : SEQ_S; rowbase = prompt ? b * SEQ_P + ch * 64 : NPROMPT + b * SEQ_S;
}
__device__ __forceinline__ void p1_rows(int unit, int t0, int tt, size_t& row, size_t& prow, bool& hasprev, int& nb) {
    bool prompt; int b, h, ch, T, rowbase; p1_decode(unit, prompt, b, h, ch, T, rowbase);
    nb = (T - t0) < SC_TB ? (T - t0) : SC_TB;
    const int tloc = tt < nb ? tt : nb - 1, t = t0 + tloc; const bool first = (ch == 0);
    row = (size_t)(rowbase + t); hasprev = (t > 0) || !first || !prompt; prow = ((t > 0) || !first) ? row - 1 : (size_t)(NTOK + b);
}
__device__ __forceinline__ void p1_load(const Args& A, int unit, int t0, int tt, int cs, P1Pre& P) {
    size_t row, prow; bool hasprev; int nb; p1_rows(unit, t0, tt, row, prow, hasprev, nb);
    const int h = unit < NUNITS_P ? (unit >> 6) & 7 : unit & 7, hc = h * 64 + cs * 4;
    const bf16* Zr = (const bf16*)(A.ws + WS_ZR);
    P.pa0 = *(const v4u*)(Zr + row * 2048 + 1536 + cs * 16); P.pa1 = *(const v4u*)(Zr + row * 2048 + 1536 + cs * 16 + 8);
    P.zr = *(const v2u*)(Zr + row * 2048 + hc); P.zk = *(const v2u*)(Zr + row * 2048 + 512 + hc); P.zv = *(const v2u*)(Zr + row * 2048 + 1024 + hc);
    const v2u z2 = (v2u){0u, 0u};
    P.pr = z2; P.pk = z2; P.pv = z2;
    if (hasprev) { P.pr = *(const v2u*)(Zr + prow * 2048 + hc); P.pk = *(const v2u*)(Zr + prow * 2048 + 512 + hc); P.pv = *(const v2u*)(Zr + prow * 2048 + 1024 + hc); }
}
__device__ __forceinline__ bool p1_unit_at(int i, int vcu, int G, int& unit) {
    if (G == 256) { if (i > 16) return false; unit = i < 16 ? vcu * 16 + i : NUNITS_P + vcu; return true; }
    unit = vcu + i * G; return unit < NUNITS;
}

constexpr int WY_OS = 72, WY_TS = 24, WY_LS = 40;
constexpr int WY_AT = 0, WY_RT = WY_AT + 16 * WY_OS * 2, WY_BT = WY_RT + 16 * WY_OS * 2, WY_KT = WY_BT + 16 * WY_OS * 2, WY_BH = WY_KT + 16 * WY_OS * 2,
              WY_KH = WY_BH + 64 * WY_TS * 2, WY_VT = WY_KH + 64 * WY_TS * 2, WY_GC = WY_VT + 64 * WY_TS * 2, WY_BUF = WY_GC + 256;
constexpr int WY_BASE = 0;
constexpr int WY_LAB = WY_BASE + 2 * WY_BUF, WY_LAK = WY_LAB + 1024, WY_MC = WY_LAK + 16 * WY_LS * 2;
static_assert(WY_MC + 16 * WY_LS * 2 <= P1_SEQ, "UT-transform operands must fit over HIDB | LO");
constexpr int WY_XB = 115328, WY_RH = WY_XB + 128 * WY_OS * 2, WY_UT = WY_RH + 8 * 16 * 17 * 4, WY_END = WY_UT + 8 * 16 * WY_TS * 2;
static_assert(WY_END <= LDSCTL_OFF, "LDS map of pass 1");

constexpr int WY_G2 = P1_GG + 2048;
static_assert(WY_G2 + 1024 + 2 * 16 * WY_LS * 2 <= P1_YY, "second Gram set");
__device__ __forceinline__ void p1_wy(f32x4 (&X)[4], const LAS float* SEQ, LAS float* YY, LAS float* ZZ, LAS unsigned char* lds, int nb, int tid, int lane, int wave, int part = 0) {
    const bool pw = wave >= 4; const int nmc = nb >> 4;
    LAS bf16* Xb = (LAS bf16*)(lds + WY_XB); LAS float* RH = (LAS float*)(lds + WY_RH) + wave * 16 * 17; LAS bf16* UT = (LAS bf16*)(lds + WY_UT) + wave * 16 * WY_TS;
    const bf16x8 zero8 = (bf16x8){0, 0, 0, 0, 0, 0, 0, 0};
    for (int mc = 0; mc < nmc; ++mc) {
        asm volatile("" : "+v"(tid));
        LAS unsigned char* ob = lds + WY_BASE + mc * WY_BUF;
        LAS bf16* At = (LAS bf16*)(ob + WY_AT); LAS bf16* Rt = (LAS bf16*)(ob + WY_RT); LAS bf16* Bt = (LAS bf16*)(ob + WY_BT); LAS bf16* Kt = (LAS bf16*)(ob + WY_KT);
        LAS bf16* BhT = (LAS bf16*)(ob + WY_BH); LAS bf16* KhT = (LAS bf16*)(ob + WY_KH); LAS bf16* VT = (LAS bf16*)(ob + WY_VT); LAS float* GC = (LAS float*)(ob + WY_GC);
        const int tl = tid >> 5, c2 = (tid & 31) * 2, s0 = mc * 16;
        f32x2 cum = (f32x2){0.f, 0.f}, tot = cum, lwt = cum;
#pragma unroll
        for (int i = 0; i < 16; ++i) { const f32x2 l2 = *(const LAS f32x2*)(SEQ + (s0 + i) * 384 + 64 + c2); tot += l2; if (i <= tl) cum += l2; if (i == tl) lwt = l2; }
        const LAS float* sp = SEQ + (s0 + tl) * 384 + c2;
        const f32x2 a2 = *(const LAS f32x2*)(sp), b2 = *(const LAS f32x2*)(sp + 128), k2 = *(const LAS f32x2*)(sp + 192), r2 = *(const LAS f32x2*)(sp + 256), v2 = *(const LAS f32x2*)(sp + 320);
        const f32x2 gt = (f32x2){__expf(cum.x), __expf(cum.y)}, gp = (f32x2){__expf(cum.x - lwt.x), __expf(cum.y - lwt.y)}, gi = (f32x2){__expf(-cum.x), __expf(-cum.y)},
                    go = (f32x2){__expf(tot.x - cum.x), __expf(tot.y - cum.y)};
        *(LAS unsigned*)(At + tl * WY_OS + c2) = cvt_pk_bf16(a2.x * gp.x, a2.y * gp.y); *(LAS unsigned*)(Rt + tl * WY_OS + c2) = cvt_pk_bf16(r2.x * gt.x, r2.y * gt.y);
        *(LAS unsigned*)(Bt + tl * WY_OS + c2) = cvt_pk_bf16(b2.x * gi.x, b2.y * gi.y); *(LAS unsigned*)(Kt + tl * WY_OS + c2) = cvt_pk_bf16(k2.x * gi.x, k2.y * gi.y);
        const unsigned bh = cvt_pk_bf16(b2.x * go.x, b2.y * go.y), kh = cvt_pk_bf16(k2.x * go.x, k2.y * go.y), vv = cvt_pk_bf16(v2.x, v2.y);
        {
            const unsigned bh_o = (unsigned)__shfl_xor((int)bh, 32), kh_o = (unsigned)__shfl_xor((int)kh, 32), vv_o = (unsigned)__shfl_xor((int)vv, 32);
            const bool ev = (tl & 1) == 0; const int wo = (ev ? c2 : c2 + 1) * WY_TS + (tl & ~1);
            *(LAS unsigned*)(BhT + wo) = ev ? ((bh & 0xffffu) | (bh_o << 16)) : ((bh_o >> 16) | (bh & 0xffff0000u));
            *(LAS unsigned*)(KhT + wo) = ev ? ((kh & 0xffffu) | (kh_o << 16)) : ((kh_o >> 16) | (kh & 0xffff0000u));
            *(LAS unsigned*)(VT + wo) = ev ? ((vv & 0xffffu) | (vv_o << 16)) : ((vv_o >> 16) | (vv & 0xffff0000u)); }
        if (tl == 0) *(LAS f32x2*)(GC + c2) = (f32x2){__expf(tot.x), __expf(tot.y)};
    }
    __syncthreads();
    {
        asm volatile("" : "+v"(tid));
        const int fr = tid & 15, fq = (tid >> 4) & 3, g_ = wave & 3, m_ = wave >> 2;
        if (m_ < nmc) {
            LAS unsigned char* ob = lds + WY_BASE + m_ * WY_BUF; LAS unsigned char* gs = lds + (m_ ? WY_G2 : WY_LAB);
            LAS float* Lab = (LAS float*)gs; LAS bf16* Lak = (LAS bf16*)(gs + 1024); LAS bf16* Mc = (LAS bf16*)(gs + 1024 + 16 * WY_LS * 2);
            const LAS bf16* ab = (LAS bf16*)(ob + (g_ < 2 ? WY_AT : WY_RT)) + fr * WY_OS + fq * 8; const LAS bf16* bb = (LAS bf16*)(ob + ((g_ & 1) ? WY_KT : WY_BT)) + fr * WY_OS + fq * 8;
            f32x4 g = (f32x4){0.f, 0.f, 0.f, 0.f};
#pragma unroll
            for (int ks = 0; ks < 2; ++ks) g = __builtin_amdgcn_mfma_f32_16x16x32_bf16(*(const LAS bf16x8*)(bb + ks * 32), *(const LAS bf16x8*)(ab + ks * 32), g, 0, 0, 0);
#pragma unroll
            for (int rg = 0; rg < 4; ++rg) { const int tp = 4 * fq + rg; const bool keep = (g_ < 2) ? (fr > tp) : (fr >= tp); g[rg] = keep ? g[rg] : 0.f; }
            if (g_ == 0) *(LAS f32x4*)(Lab + fr * 16 + 4 * fq) = g;
            else { v2u w; w.x = cvt_pk_bf16(g[0], g[1]); w.y = cvt_pk_bf16(g[2], g[3]);
                if (g_ == 1) { *(LAS v2u*)(Lak + fr * WY_LS + 4 * fq) = w; *(LAS v2u*)(Lak + fr * WY_LS + 16 + 4 * fq) = (v2u){0u, 0u}; }
                else if (g_ == 2) *(LAS v2u*)(Mc + fr * WY_LS + 4 * fq) = w; else *(LAS v2u*)(Mc + fr * WY_LS + 16 + 4 * fq) = w; }
        }
    }
    __syncthreads();
    if (MK_DBGSEL == 2 && part) return;
    for (int mc = 0; mc < nmc; ++mc) {
        asm volatile("" : "+v"(tid));
        const int fr = tid & 15, fq = (tid >> 4) & 3;
        LAS unsigned char* ob = lds + WY_BASE + mc * WY_BUF; LAS unsigned char* gs = lds + (mc ? WY_G2 : WY_LAB);
        LAS bf16* At = (LAS bf16*)(ob + WY_AT); LAS bf16* Rt = (LAS bf16*)(ob + WY_RT);
        LAS bf16* BhT = (LAS bf16*)(ob + WY_BH); LAS bf16* KhT = (LAS bf16*)(ob + WY_KH); LAS bf16* VT = (LAS bf16*)(ob + WY_VT); LAS float* GC = (LAS float*)(ob + WY_GC);
        LAS float* Lab = (LAS float*)gs; LAS bf16* Lak = (LAS bf16*)(gs + 1024); LAS bf16* Mc = (LAS bf16*)(gs + 1024 + 16 * WY_LS * 2);
        f32x4 W1 = (f32x4){0.f, 0.f, 0.f, 0.f}, Y0 = W1;
        {
            const LAS bf16* xbp = Xb + (16 * wave + fr) * WY_OS + fq * 8;
#pragma unroll
            for (int ks = 0; ks < 2; ++ks) { const bf16x8 bx = *(const LAS bf16x8*)(xbp + ks * 32);
                W1 = __builtin_amdgcn_mfma_f32_16x16x32_bf16(*(const LAS bf16x8*)(At + fr * WY_OS + ks * 32 + fq * 8), bx, W1, 0, 0, 0);
                Y0 = __builtin_amdgcn_mfma_f32_16x16x32_bf16(*(const LAS bf16x8*)(Rt + fr * WY_OS + ks * 32 + fq * 8), bx, Y0, 0, 0, 0); }
        }
        if (!pw) { const bf16x8 la = *(const LAS bf16x8*)(Lak + fr * WY_LS + fq * 8); const bf16x8 vb0 = *(const LAS bf16x8*)(VT + (16 * wave + fr) * WY_TS + (fq & 1) * 8); const bf16x8 vb = fq < 2 ? vb0 : zero8;
            W1 = __builtin_amdgcn_mfma_f32_16x16x32_bf16(la, vb, W1, 0, 0, 0); }
#pragma unroll
        for (int rg = 0; rg < 4; ++rg) RH[(4 * fq + rg) * 17 + fr] = W1[rg];
        LDS_WAIT();
        {
            float u[16];
#pragma unroll
            for (int t = 0; t < 16; ++t) { if ((t & 3) == 0) asm volatile("" ::: "memory");
                float acc = RH[t * 17 + fr];
                if (!(MK_DBGSEL == 3 && part))
#pragma unroll
                for (int i4 = 0; i4 * 4 < t; ++i4) { const f32x4 l4 = *(const LAS f32x4*)(Lab + t * 16 + i4 * 4);
#pragma unroll
                    for (int e = 0; e < 4; ++e) if (i4 * 4 + e < t) acc += l4[e] * u[i4 * 4 + e]; }
                u[t] = acc; }
            if (fq == 0) { v4u o0, o1; o0.x = cvt_pk_bf16(u[0], u[1]); o0.y = cvt_pk_bf16(u[2], u[3]); o0.z = cvt_pk_bf16(u[4], u[5]); o0.w = cvt_pk_bf16(u[6], u[7]);
                o1.x = cvt_pk_bf16(u[8], u[9]); o1.y = cvt_pk_bf16(u[10], u[11]); o1.z = cvt_pk_bf16(u[12], u[13]); o1.w = cvt_pk_bf16(u[14], u[15]);
                *(LAS v4u*)(UT + fr * WY_TS) = o0; *(LAS v4u*)(UT + fr * WY_TS + 8) = o1; }
        }
        LDS_WAIT();
        {
            const bf16x8 uc = fq < 2 ? *(const LAS bf16x8*)(UT + fr * WY_TS + fq * 8) : (pw ? zero8 : *(const LAS bf16x8*)(VT + (16 * wave + fr) * WY_TS + (fq - 2) * 8));
            Y0 = __builtin_amdgcn_mfma_f32_16x16x32_bf16(*(const LAS bf16x8*)(Mc + fr * WY_LS + fq * 8), uc, Y0, 0, 0, 0);
            LAS float* yo = (pw ? ZZ + 16 * (wave - 4) : YY + 16 * wave) + fr;
#pragma unroll
            for (int rg = 0; rg < 4; ++rg) yo[(mc * 16 + 4 * fq + rg) * 64] = Y0[rg];
#pragma unroll
            for (int j = 0; j < 4; ++j) {
                const bf16x8 bc = fq < 2 ? *(const LAS bf16x8*)(BhT + (16 * j + fr) * WY_TS + fq * 8) : *(const LAS bf16x8*)(KhT + (16 * j + fr) * WY_TS + (fq - 2) * 8);
                X[j] = X[j] * *(const LAS f32x4*)(GC + 16 * j + 4 * fq);
                X[j] = __builtin_amdgcn_mfma_f32_16x16x32_bf16(bc, uc, X[j], 0, 0, 0);
                v2u w; w.x = cvt_pk_bf16(X[j][0], X[j][1]); w.y = cvt_pk_bf16(X[j][2], X[j][3]);
                *(LAS v2u*)(Xb + (16 * wave + fr) * WY_OS + 16 * j + 4 * fq) = w; }
        }
        LDS_WAIT();
    }
}

#define P1_LOAD_PARAMS(HH) do { int lf_ = fr, lq_ = fq, lt_ = tid; asm volatile("" : "+v"(lf_), "+v"(lq_), "+v"(lt_));   \
        const int h_ = (HH), ncol_ = h_ * 64 + ntl * 16 + lf_; \
        _Pragma("unroll") for (int ks = 0; ks < 2; ++ks) { bw[ks] = *(const bf16x8*)(L2T + (size_t)ncol_ * 64 + lq_ * 8 + ks * 32); ba[ks] = *(const bf16x8*)(L2T + (size_t)512 * 64 + (size_t)ncol_ * 64 + lq_ * 8 + ks * 32); } \
        _Pragma("unroll") for (int ks = 0; ks < 4; ++ks) bg[ks] = *(const bf16x8*)(L2T + (size_t)1024 * 64 + (size_t)ncol_ * 128 + lq_ * 8 + ks * 32); \
        if (lt_ < 128) { const int a_ = lt_ >> 4, c_ = (lt_ & 15) * 4; \
            const float* src_ = a_ == 0 ? A.in[I_W0] : a_ == 1 ? A.in[I_A0] : a_ == 2 ? A.in[I_KK] : a_ == 3 ? A.in[I_KA] : a_ == 4 ? A.in[I_RK] : A.in[I_MURKV] + (a_ - 5) * 512; \
            *(LAS f32x4*)(PRM + a_ * 64 + c_) = *(const f32x4*)(src_ + h_ * 64 + c_); } } while (0)
__device__ __forceinline__ void scan_pass1(const Args& A, LAS unsigned char* lds, int tid, int lane, int wave, int vcu, int G, int part = 0) {
    bf16* GB = (bf16*)(A.ws + WS_A1) + (size_t)MPAD * 512;
    bf16* YL = (bf16*)(A.ws + WS_YL); bf16* ZT = (bf16*)(A.ws + WS_ZT); bf16* BV = (bf16*)(A.ws + WS_BV);
    LAS bf16* HIDB = (LAS bf16*)(lds + P1_HIDB); LAS float* LO = (LAS float*)(lds + P1_LO); LAS float* SEQ = (LAS float*)(lds + P1_SEQ);
    LAS float* YY = (LAS float*)(lds + P1_YY); LAS float* ZZ = (LAS float*)(lds + P1_ZZ);
    const bf16* L2T = (const bf16*)(A.ws + WS_L2T);
    const bool prow_wave = wave >= 4;
    const int mt = wave & 1, ntl = wave >> 1;
    int tt = tid >> 4, cs = tid & 15, c4 = cs * 4, fr = lane & 15, fq = lane >> 4;
    f32x4 X[4];
    bf16x8 bw[2], ba[2], bg[4];
    LAS float* PRM = (LAS float*)(lds + P1_GG);
    int cur_h = -1;
    int ui = 0, unit; if (!p1_unit_at(0, vcu, G, unit)) return;
    int t0 = 0; P1Pre pre; p1_load(A, unit, 0, tt, cs, pre);
    for (;;) {
        { int lt_ = tid; asm volatile("" : "+v"(lt_)); tt = lt_ >> 4; cs = lt_ & 15; c4 = cs * 4; fr = lt_ & 15; fq = (lt_ >> 4) & 3; }
        bool prompt; int b, h, ch, T, rowbase; p1_decode(unit, prompt, b, h, ch, T, rowbase);
        const int hc = h * 64 + c4;
        if (t0 == 0 && G == 256 && ui < 8) {
            const size_t i16 = ((size_t)(ui * 256 + vcu) * NTHR + tid) * 16;
            cvt16_fp8_sliced(A.in[I_U], A.ws + WS_UB, PEER_SU, i16); cvt16_fp8_sliced(A.in[I_V], A.ws + WS_VB, PEER_SV, i16); }
        if (t0 == 0) {
            LAS bf16* Xb = (LAS bf16*)(lds + WY_XB);
#pragma unroll
            for (int j = 0; j < 4; ++j) { const int prow_ = 16 * (wave - 4) + fr, c0_ = 16 * j + 4 * fq;
#pragma unroll
                for (int e = 0; e < 4; ++e) X[j][e] = (prow_wave && prow_ == c0_ + e) ? 1.f : 0.f;
                v2u w; w.x = cvt_pk_bf16(X[j][0], X[j][1]); w.y = cvt_pk_bf16(X[j][2], X[j][3]);
                *(LAS v2u*)(Xb + (16 * wave + fr) * WY_OS + c0_) = w; }
        }
        if (h != cur_h) { cur_h = h; P1_LOAD_PARAMS(h); }
        size_t row, prow; bool hasprev; int nb; p1_rows(unit, t0, tt, row, prow, hasprev, nb);
        if (!(MK_DBGSEL == 5 && part)) { *(LAS v4u*)(HIDB + tt * HID_STRIDE + cs * 16) = pre.pa0; *(LAS v4u*)(HIDB + tt * HID_STRIDE + cs * 16 + 8) = pre.pa1; }
        __syncthreads();
        if (!(MK_DBGSEL == 5 && part)) {
            const LAS bf16* ap = HIDB + (mt * 16 + fr) * HID_STRIDE + fq * 8;
            f32x4 cw = (f32x4){0.f, 0.f, 0.f, 0.f}, ca = cw, cg = cw;
#pragma unroll
            for (int ks = 0; ks < 2; ++ks) { cw = __builtin_amdgcn_mfma_f32_16x16x32_bf16(*(const LAS bf16x8*)(ap + ks * 32), bw[ks], cw, 0, 0, 0);
                                             ca = __builtin_amdgcn_mfma_f32_16x16x32_bf16(*(const LAS bf16x8*)(ap + 64 + ks * 32), ba[ks], ca, 0, 0, 0); }
#pragma unroll
            for (int ks = 0; ks < 4; ++ks) cg = __builtin_amdgcn_mfma_f32_16x16x32_bf16(*(const LAS bf16x8*)(ap + 128 + ks * 32), bg[ks], cg, 0, 0, 0);
#pragma unroll
            for (int rg = 0; rg < 4; ++rg) { const int o = (mt * 16 + fq * 4 + rg) * 64 + ntl * 16 + fr; LO[o] = cw[rg]; LO[2048 + o] = ca[rg]; LO[4096 + o] = cg[rg]; }
        }
        __syncthreads();
        if (!(MK_DBGSEL == 5 && part)) {
            const f32x4 w0v = *(const LAS f32x4*)(PRM + c4), a0v = *(const LAS f32x4*)(PRM + 64 + c4), kkv = *(const LAS f32x4*)(PRM + 128 + c4), kav = *(const LAS f32x4*)(PRM + 192 + c4),
                        rkv = *(const LAS f32x4*)(PRM + 256 + c4), mur = *(const LAS f32x4*)(PRM + 320 + c4), muk = *(const LAS f32x4*)(PRM + 384 + c4), muv = *(const LAS f32x4*)(PRM + 448 + c4);
            const f32x4 aw = w0v + *(const LAS f32x4*)(LO + tt * 64 + c4), aa = a0v + *(const LAS f32x4*)(LO + 2048 + tt * 64 + c4), ag = *(const LAS f32x4*)(LO + 4096 + tt * 64 + c4);
            f32x4 r = (f32x4){bf_lo(pre.zr.x), bf_hi(pre.zr.x), bf_lo(pre.zr.y), bf_hi(pre.zr.y)}, k = (f32x4){bf_lo(pre.zk.x), bf_hi(pre.zk.x), bf_lo(pre.zk.y), bf_hi(pre.zk.y)},
                  v = (f32x4){bf_lo(pre.zv.x), bf_hi(pre.zv.x), bf_lo(pre.zv.y), bf_hi(pre.zv.y)};
            const f32x4 rpv = (f32x4){bf_lo(pre.pr.x), bf_hi(pre.pr.x), bf_lo(pre.pr.y), bf_hi(pre.pr.y)}, kpv = (f32x4){bf_lo(pre.pk.x), bf_hi(pre.pk.x), bf_lo(pre.pk.y), bf_hi(pre.pk.y)},
                        vpv = (f32x4){bf_lo(pre.pv.x), bf_hi(pre.pv.x), bf_lo(pre.pv.y), bf_hi(pre.pv.y)};
            r = r + mur * (rpv - r); k = k + muk * (kpv - k); v = v + muv * (vpv - v);
            f32x4 dec, asg, kk, km, av, bv;
            float ssq = 0.f, bon = 0.f;
#pragma unroll
            for (int i = 0; i < 4; ++i) {
                const float x = -aw[i];
                const float sp = fmaxf(x, 0.f) + __logf(1.0f + __expf(-fabsf(x)));
                const float wraw = -sp - 0.5f;
                dec[i] = -__expf(wraw);
                asg[i] = sigm(aa[i]);
                kk[i] = k[i] * kkv[i]; ssq += kk[i] * kk[i];
                km[i] = k[i] * (1.0f + (asg[i] - 1.0f) * kav[i]);
                bon += r[i] * km[i] * rkv[i];
            }
            ssq = sum16(ssq); bon = sum16(bon);
            const float inv = 1.0f / fmaxf(sqrtf(ssq), 1e-12f);
#pragma unroll
            for (int i = 0; i < 4; ++i) { kk[i] *= inv; av[i] = -kk[i]; bv[i] = kk[i] * asg[i]; }
            LAS float* sq_ = SEQ + tt * 384 + c4;
            *(LAS f32x4*)(sq_) = av; *(LAS f32x4*)(sq_ + 64) = dec; *(LAS f32x4*)(sq_ + 128) = bv; *(LAS f32x4*)(sq_ + 192) = km; *(LAS f32x4*)(sq_ + 256) = r; *(LAS f32x4*)(sq_ + 320) = v;
            if (tt < nb) {
                v2u w; w.x = cvt_pk_bf16(ag[0], ag[1]); w.y = cvt_pk_bf16(ag[2], ag[3]); *(v2u*)(GB + row * 512 + hc) = w;
                w.x = cvt_pk_bf16(bon * v[0], bon * v[1]); w.y = cvt_pk_bf16(bon * v[2], bon * v[3]); *(v2u*)(BV + row * 512 + hc) = w;
            }
        }
        int nunit = unit, nt0 = t0 + SC_TB, nui = ui; bool more = true;
        if (nt0 >= T) { nt0 = 0; nui = ui + 1; more = p1_unit_at(nui, vcu, G, nunit); }
        if (more) p1_load(A, nunit, nt0, tt, cs, pre);
        __syncthreads();
        if (!(MK_DBGSEL == 1 && part)) p1_wy(X, SEQ, YY, ZZ, lds, nb, tid, lane, wave, part);
        __syncthreads();
        if (tt < nb) {
            const f32x4 y = *(const LAS f32x4*)(YY + tt * 64 + c4), z = *(const LAS f32x4*)(ZZ + tt * 64 + c4);
            v2u w; w.x = cvt_pk_bf16(y[0], y[1]); w.y = cvt_pk_bf16(y[2], y[3]); *(v2u*)(YL + row * 512 + hc) = w;
            w.x = cvt_pk_bf16(z[0], z[1]); w.y = cvt_pk_bf16(z[2], z[3]); *(v2u*)(ZT + row * 512 + hc) = w;
        }
        if (t0 + SC_TB >= T) {
#pragma unroll
            for (int j = 0; j < 4; ++j) {
                if (!prow_wave) *(f32x4*)((float*)A.out + (size_t)unit * 4096 + (16 * wave + fr) * 64 + 16 * j + 4 * fq) = X[j];
                else { v2u o; o.x = cvt_pk_bf16(X[j][0], X[j][1]); o.y = cvt_pk_bf16(X[j][2], X[j][3]);
                    *(v2u*)((bf16*)((unsigned char*)A.out + OB_MB) + (size_t)unit * 4096 + (16 * (wave - 4) + fr) * 64 + 16 * j + 4 * fq) = o; }
            }
        }
        if (!more) break;
        unit = nunit; t0 = nt0; ui = nui;
    }
    __syncthreads();
}

constexpr int P2_SP = 68, P2_MP = 80, P2_ML = 16 * P2_SP * 4, P2_PL = P2_ML + 64 * P2_MP * 4;
__device__ __forceinline__ void scan_pass2_rows(const float* Sinit, int unit0, int nchunks, int v0, float* outfin, bool slots, const Args& A, LAS unsigned char* lds, int tid, int lane, int wave) {
    LAS float* Sl = (LAS float*)lds; LAS float* Ml = (LAS float*)(lds + P2_ML); LAS float* Pl = (LAS float*)(lds + P2_PL);
    const int nt = wave & 3, kh = wave >> 2, fr = lane & 15, fq = lane >> 4;
    float* NB = (float*)A.out; const bf16* MB = (const bf16*)((const unsigned char*)A.out + OB_MB);
    { const int idx = tid * 2, row = idx >> 6, col = idx & 63;
      const f32x2 s0 = Sinit ? *(const f32x2*)(Sinit + (size_t)(v0 + row) * 64 + col) : (f32x2){0.f, 0.f};
      *(LAS f32x2*)(Sl + row * P2_SP + col) = s0; }
    v4u mreg = *(const v4u*)(MB + (size_t)unit0 * 4096 + tid * 8);
    float nreg[4] = {0.f, 0.f, 0.f, 0.f};
    if (kh == 0) {
#pragma unroll
        for (int rg = 0; rg < 4; ++rg) nreg[rg] = NB[(size_t)unit0 * 4096 + (v0 + fq * 4 + rg) * 64 + nt * 16 + fr]; }
    f32x4 acc = (f32x4){0.f, 0.f, 0.f, 0.f};
    for (int c = 0; c < nchunks; ++c) {
        { const int row = tid >> 3, col = (tid & 7) * 8; LAS float* mp = Ml + row * P2_MP + col;
          *(LAS f32x4*)mp = (f32x4){bf_lo(mreg.x), bf_hi(mreg.x), bf_lo(mreg.y), bf_hi(mreg.y)}; *(LAS f32x4*)(mp + 4) = (f32x4){bf_lo(mreg.z), bf_hi(mreg.z), bf_lo(mreg.w), bf_hi(mreg.w)}; }
        __syncthreads();
        float ncur[4] = {nreg[0], nreg[1], nreg[2], nreg[3]};
        if (c + 1 < nchunks) { mreg = *(const v4u*)(MB + (size_t)(unit0 + c + 1) * 4096 + tid * 8);
            if (kh == 0) {
#pragma unroll
                for (int rg = 0; rg < 4; ++rg) nreg[rg] = NB[(size_t)(unit0 + c + 1) * 4096 + (v0 + fq * 4 + rg) * 64 + nt * 16 + fr]; } }
        f32x4 a0 = (f32x4){0.f, 0.f, 0.f, 0.f}, a1 = a0;
        const LAS float* sp = Sl + fr * P2_SP + kh * 32 + fq; const LAS float* mp = Ml + (kh * 32 + fq) * P2_MP + nt * 16 + fr;
#pragma unroll
        for (int ks = 0; ks < 8; ks += 2) { a0 = __builtin_amdgcn_mfma_f32_16x16x4f32(sp[4 * ks], mp[4 * ks * P2_MP], a0, 0, 0, 0); a1 = __builtin_amdgcn_mfma_f32_16x16x4f32(sp[4 * ks + 4], mp[(4 * ks + 4) * P2_MP], a1, 0, 0, 0); }
        acc = a0 + a1;
        if (kh == 1) *(LAS f32x4*)(Pl + nt * 256 + lane * 4) = acc;
        __syncthreads();
        if (kh == 0) {
            acc = acc + *(const LAS f32x4*)(Pl + nt * 256 + lane * 4) + (f32x4){ncur[0], ncur[1], ncur[2], ncur[3]};
#pragma unroll
            for (int rg = 0; rg < 4; ++rg) { Sl[(fq * 4 + rg) * P2_SP + nt * 16 + fr] = acc[rg];
                if (slots) NB[(size_t)(unit0 + c) * 4096 + (v0 + fq * 4 + rg) * 64 + nt * 16 + fr] = acc[rg]; }
        }
    }
    if (kh == 0) {
#pragma unroll
        for (int rg = 0; rg < 4; ++rg) outfin[(size_t)(v0 + fq * 4 + rg) * 64 + nt * 16 + fr] = acc[rg]; }
    __syncthreads();
}

__device__ __forceinline__ void scan_pass3_wave(const Args& A, int unit, int wq, int lane) {
    const bool prompt = unit < NUNITS_P;
    const int b = prompt ? unit >> 9 : (unit - NUNITS_P) >> 3, h = prompt ? (unit >> 6) & 7 : unit & 7, ch = prompt ? unit & 63 : 0;
    const int T = prompt ? 64 : SEQ_S, rowbase = prompt ? b * SEQ_P + ch * 64 : NPROMPT + b * SEQ_S;
    if (wq * 16 >= T) return;
    const float* S0 = prompt ? (ch > 0 ? (const float*)A.out + (size_t)(unit - 1) * 4096 : nullptr) : A.in[I_SWKV] + (size_t)(b * 8 + h) * 4096;
    const bf16* ZT = (const bf16*)(A.ws + WS_ZT); const bf16* YL = (const bf16*)(A.ws + WS_YL); const bf16* BV = (const bf16*)(A.ws + WS_BV);
    bf16* YB = (bf16*)(A.ws + WS_A1) + (size_t)MPAD * 512;
    const int fr = lane & 15, fq = lane >> 4;
    const size_t row = (size_t)(rowbase + wq * 16 + fr);
    f32x4 acc[4];
#pragma unroll
    for (int mt = 0; mt < 4; ++mt) acc[mt] = (f32x4){0.f, 0.f, 0.f, 0.f};
    if (S0) {
        bf16x8 bz[2];
#pragma unroll
        for (int ks = 0; ks < 2; ++ks) bz[ks] = *(const bf16x8*)(ZT + row * 512 + h * 64 + ks * 32 + fq * 8);
#pragma unroll
        for (int mt = 0; mt < 4; ++mt)
#pragma unroll
            for (int ks = 0; ks < 2; ++ks) { const float* sp = S0 + (size_t)(mt * 16 + fr) * 64 + ks * 32 + fq * 8; const f32x4 s0 = *(const f32x4*)sp, s1 = *(const f32x4*)(sp + 4);
                v4u pk; pk.x = cvt_pk_bf16(s0[0], s0[1]); pk.y = cvt_pk_bf16(s0[2], s0[3]); pk.z = cvt_pk_bf16(s1[0], s1[1]); pk.w = cvt_pk_bf16(s1[2], s1[3]);
                acc[mt] = __builtin_amdgcn_mfma_f32_16x16x32_bf16(__builtin_bit_cast(bf16x8, pk), bz[ks], acc[mt], 0, 0, 0); }
    }
    float sm = 0.f;
#pragma unroll
    for (int mt = 0; mt < 4; ++mt) { const v2u yl = *(const v2u*)(YL + row * 512 + h * 64 + mt * 16 + fq * 4);
        acc[mt][0] += bf_lo(yl.x); acc[mt][1] += bf_hi(yl.x); acc[mt][2] += bf_lo(yl.y); acc[mt][3] += bf_hi(yl.y);
        sm += (acc[mt][0] + acc[mt][1]) + (acc[mt][2] + acc[mt][3]); }
    sm += __shfl_xor(sm, 16); sm += __shfl_xor(sm, 32);
    const float mean = sm * (1.f / 64.f); float sv = 0.f;
#pragma unroll
    for (int mt = 0; mt < 4; ++mt) { acc[mt] = acc[mt] - mean; sv += (acc[mt][0] * acc[mt][0] + acc[mt][1] * acc[mt][1]) + (acc[mt][2] * acc[mt][2] + acc[mt][3] * acc[mt][3]); }
    sv += __shfl_xor(sv, 16); sv += __shfl_xor(sv, 32);
    const float rs = 1.0f / sqrtf(sv * (1.f / 64.f) + 64e-5f);
#pragma unroll
    for (int mt = 0; mt < 4; ++mt) { const int c = h * 64 + mt * 16 + fq * 4;
        const f32x4 gw = *(const f32x4*)(A.in[I_GNW] + c), gb = *(const f32x4*)(A.in[I_GNB] + c);
        const v2u bvw = *(const v2u*)(BV + row * 512 + c), gg = *(const v2u*)(YB + row * 512 + c);
        f32x4 o = acc[mt] * rs * gw + gb + (f32x4){bf_lo(bvw.x), bf_hi(bvw.x), bf_lo(bvw.y), bf_hi(bvw.y)};
        o = o * (f32x4){bf_lo(gg.x), bf_hi(gg.x), bf_lo(gg.y), bf_hi(gg.y)};
        v2u w; w.x = cvt_pk_bf16(o[0], o[1]); w.y = cvt_pk_bf16(o[2], o[3]); *(v2u*)(YB + row * 512 + c) = w; }
}

__device__ __forceinline__ void tk_insert(float (&tv)[16], float x) {
#pragma unroll
    for (int i = 15; i >= 1; --i) tv[i] = __builtin_amdgcn_fmed3f(tv[i - 1], x, tv[i]);
    tv[0] = __builtin_fmaxf(tv[0], x);
}
#define TK_CE(t, i, j) { const float a_ = __builtin_fmaxf(t[i], t[j]); t[j] = __builtin_fminf(t[i], t[j]); t[i] = a_; }
__device__ __forceinline__ void tk_sort16(float (&t)[16]) {
    TK_CE(t, 0, 1) TK_CE(t, 2, 3) TK_CE(t, 0, 2) TK_CE(t, 1, 3) TK_CE(t, 1, 2) TK_CE(t, 4, 5) TK_CE(t, 6, 7) TK_CE(t, 4, 6) TK_CE(t, 5, 7) TK_CE(t, 5, 6) TK_CE(t, 0, 4) TK_CE(t, 2, 6) TK_CE(t, 2, 4) TK_CE(t, 1, 5) TK_CE(t, 3, 7) TK_CE(t, 3, 5) TK_CE(t, 1, 2) TK_CE(t, 3, 4) TK_CE(t, 5, 6) TK_CE(t, 8, 9) TK_CE(t, 10, 11) TK_CE(t, 8, 10) TK_CE(t, 9, 11) TK_CE(t, 9, 10) TK_CE(t, 12, 13) TK_CE(t, 14, 15) TK_CE(t, 12, 14) TK_CE(t, 13, 15) TK_CE(t, 13, 14) TK_CE(t, 8, 12) TK_CE(t, 10, 14) TK_CE(t, 10, 12) TK_CE(t, 9, 13) TK_CE(t, 11, 15) TK_CE(t, 11, 13) TK_CE(t, 9, 10) TK_CE(t, 11, 12) TK_CE(t, 13, 14) TK_CE(t, 0, 8) TK_CE(t, 4, 12) TK_CE(t, 4, 8) TK_CE(t, 2, 10) TK_CE(t, 6, 14) TK_CE(t, 6, 10) TK_CE(t, 2, 4) TK_CE(t, 6, 8) TK_CE(t, 10, 12) TK_CE(t, 1, 9) TK_CE(t, 5, 13) TK_CE(t, 5, 9) TK_CE(t, 3, 11) TK_CE(t, 7, 15) TK_CE(t, 7, 11) TK_CE(t, 3, 5) TK_CE(t, 7, 9) TK_CE(t, 11, 13) TK_CE(t, 1, 2) TK_CE(t, 3, 4) TK_CE(t, 5, 6) TK_CE(t, 7, 8) TK_CE(t, 9, 10) TK_CE(t, 11, 12) TK_CE(t, 13, 14)
}
__device__ __forceinline__ void tk_merge16(float (&tv)[16], const float (&g)[16]) {
#pragma unroll
    for (int i = 0; i < 16; ++i) tv[i] = __builtin_fmaxf(tv[i], g[15 - i]);
#pragma unroll
    for (int s = 8; s >= 1; s >>= 1)
#pragma unroll
        for (int i = 0; i < 16; ++i) if ((i & s) == 0) TK_CE(tv, i, i + s)
}
__device__ __forceinline__ float gelu_tanh(float x) {
    const float u = 0.7978845608028654f * (x + 0.044715f * x * x * x);
    const float th = 1.0f - 2.0f * __builtin_amdgcn_rcpf(__expf(2.0f * u) + 1.0f);
    return 0.5f * x * (1.0f + th);
}
constexpr int NTILE32 = NTOK / 32;
constexpr int CW_QU = 8192, CW_QV = 8192 + 512;

constexpr int TK_STRIDE = 68, TK_BYTES = 64 * TK_STRIDE * 4;
__device__ __forceinline__ void topk_scores64(const bf16* Q, const bf16* KB, LAS float* SC, int t0, int hp, int p, int half, int lane, const bf16x8 (&af)[2][2][4]) {
    const int fr = lane & 15, fq = lane >> 4;
#pragma unroll
    for (int hs = 0; hs < 2; ++hs) {
        const bf16* kbase = KB + (size_t)(((hp + 4 * hs) * 2 + p) * 128 + half * 64 + fr) * 128 + fq * 8;
#pragma unroll
        for (int n = 0; n < 4; ++n) {
            bf16x8 bfr[4];
#pragma unroll
            for (int ks = 0; ks < 4; ++ks) bfr[ks] = *(const bf16x8*)(kbase + (size_t)n * 16 * 128 + ks * 32);
            f32x4 acc0 = (f32x4){0.f, 0.f, 0.f, 0.f}, acc1 = acc0;
#pragma unroll
            for (int ks = 0; ks < 4; ++ks) { acc0 = __builtin_amdgcn_mfma_f32_16x16x32_bf16(af[hs][0][ks], bfr[ks], acc0, 0, 0, 0); acc1 = __builtin_amdgcn_mfma_f32_16x16x32_bf16(af[hs][1][ks], bfr[ks], acc1, 0, 0, 0); }
#pragma unroll
            for (int rg = 0; rg < 4; ++rg) { SC[(hs * 32 + fq * 4 + rg) * TK_STRIDE + n * 16 + fr] = acc0[rg]; SC[(hs * 32 + 16 + fq * 4 + rg) * TK_STRIDE + n * 16 + fr] = acc1[rg]; }
        }
    }
}
constexpr int TK_NPROMPT_UNITS = (NPROMPT / 32) * 4, TK_NSAMPLE_UNITS = (NSAMP / 32) * 4, CW_TKS = 9792;
__device__ __forceinline__ void peer_topk_units(const Args& A, LAS unsigned char* lds, int lane, int wave, int u_first, int u_end, int u_step) {
    const bf16* Q = (const bf16*)(A.ws + WS_ZG); const bf16* KB = (const bf16*)(A.ws + WS_KEYS); const float* SSP = (const float*)(A.ws + WS_SSP);
    unsigned short* EIDX = (unsigned short*)(A.ws + WS_EIDX); float* GATE = (float*)(A.ws + WS_GATE); float* RSTD = (float*)(A.ws + WS_RSTD);
    LAS float* SC = (LAS float*)(lds + wave * TK_BYTES);
    const int fr = lane & 15, fq = lane >> 4, tokl = lane & 31, hsel = lane >> 5;
    for (int u = u_first; u < u_end; u += u_step) {
        const int t0 = (u >> 2) * 32, hp = u & 3, h = hp + 4 * hsel;
        const float* sp = SSP + (size_t)(t0 + tokl) * 16;
        const f32x4 s0 = *(const f32x4*)sp, s1 = *(const f32x4*)(sp + 4), s2 = *(const f32x4*)(sp + 8), s3 = *(const f32x4*)(sp + 12);
        const float ssq = ((s0[0] + s0[1]) + (s0[2] + s0[3])) + ((s1[0] + s1[1]) + (s1[2] + s1[3])) + ((s2[0] + s2[1]) + (s2[2] + s2[3])) + ((s3[0] + s3[1]) + (s3[2] + s3[3]));
        const float rstd = 1.0f / sqrtf(ssq * (1.f / DM) + 1e-6f);
        float tv0[16], tv1[16], cv[16];
#pragma unroll
        for (int p = 0; p < 2; ++p) {
            bf16x8 af[2][2][4];
#pragma unroll
            for (int hs = 0; hs < 2; ++hs)
#pragma unroll
                for (int mt = 0; mt < 2; ++mt) { const bf16* qp = Q + (size_t)(t0 + mt * 16 + fr) * 2048 + (hp + 4 * hs) * 256 + p * 128 + fq * 8;
#pragma unroll
                    for (int ks = 0; ks < 4; ++ks) af[hs][mt][ks] = *(const bf16x8*)(qp + ks * 32); }
            float tv[16];
#pragma unroll
            for (int i = 0; i < 16; ++i) tv[i] = -3.0e38f;
            for (int half = 0; half < 2; ++half) {
                topk_scores64(Q, KB, SC, t0, hp, p, half, lane, af);
                LDS_WAIT();
                const LAS float* mine = SC + lane * TK_STRIDE;
                unsigned kmask = 0xFFFFFF80u; asm volatile("" : "+v"(kmask));
#pragma unroll 1
                for (int n = 0; n < 64; n += 16) {
                    float g[16];
#pragma unroll
                    for (int q = 0; q < 4; ++q) { const f32x4 x4 = *(const LAS f32x4*)(mine + n + 4 * q);
#pragma unroll
                        for (int e = 0; e < 4; ++e) g[4 * q + e] = __uint_as_float((__float_as_uint(x4[e]) & kmask) | (unsigned)(half * 64 + n + 4 * q + e)); }
                    tk_sort16(g); tk_merge16(tv, g);
                }
                LDS_WAIT();
            }
#pragma unroll
            for (int i = 0; i < 16; ++i) { if (p == 0) tv0[i] = tv[i]; else tv1[i] = tv[i]; }
        }
        LAS int* li = (LAS int*)SC + lane * 33;
#pragma unroll
        for (int q = 0; q < 16; ++q) { li[q] = (int)(__float_as_uint(tv0[q]) & 127u); li[16 + q] = (int)(__float_as_uint(tv1[q]) & 127u);
            tv0[q] = __uint_as_float(__float_as_uint(tv0[q]) & 0xFFFFFF80u); tv1[q] = __uint_as_float(__float_as_uint(tv1[q]) & 0xFFFFFF80u); }
#pragma unroll
        for (int q = 0; q < 16; ++q) cv[q] = -3.0e38f;
#pragma unroll
        for (int a = 0; a < 16; ++a)
#pragma unroll
            for (int b = 0; b < 16; ++b) if ((a + 1) * (b + 1) <= 16)
                tk_insert(cv, __uint_as_float((__float_as_uint(tv0[a] + tv1[b]) & 0xFFFFFF00u) | (unsigned)(a * 16 + b)));
        LDS_WAIT();
        float e[16], den = 0.f; unsigned ci[16];
        const float c0 = __uint_as_float(__float_as_uint(cv[0]) & 0xFFFFFF00u);
#pragma unroll
        for (int q = 0; q < 16; ++q) { const unsigned kb = __float_as_uint(cv[q]); const float cq = __uint_as_float(kb & 0xFFFFFF00u);
            e[q] = __expf((cq - c0) * rstd); den += e[q]; ci[q] = (unsigned)(li[(kb >> 4) & 15] * 128 + li[16 + (kb & 15)]); }
        const float inv = 1.0f / den;
        LDS_WAIT();
        {
            const size_t tok = (size_t)(t0 + tokl);
            v4u w0, w1; w0.x = ci[0] | (ci[1] << 16); w0.y = ci[2] | (ci[3] << 16); w0.z = ci[4] | (ci[5] << 16); w0.w = ci[6] | (ci[7] << 16);
            w1.x = ci[8] | (ci[9] << 16); w1.y = ci[10] | (ci[11] << 16); w1.z = ci[12] | (ci[13] << 16); w1.w = ci[14] | (ci[15] << 16);
            *(v4u*)(EIDX + tok * 128 + h * 16) = w0; *(v4u*)(EIDX + tok * 128 + h * 16 + 8) = w1;
#pragma unroll
            for (int q = 0; q < 4; ++q) *(f32x4*)(GATE + tok * 128 + h * 16 + 4 * q) = (f32x4){e[4 * q] * inv, e[4 * q + 1] * inv, e[4 * q + 2] * inv, e[4 * q + 3] * inv};
            if (h == 0) RSTD[tok] = rstd;
        }
    }
}

__device__ __forceinline__ bool peer_topk_split(int G) { return G == 256; }
__device__ __forceinline__ void peer_topk_phase(const Args& A, LAS unsigned char* lds, int tid, int lane, int wave, int vcu, int G) {
    peer_topk_units(A, lds, lane, wave, wave * G + vcu, peer_topk_split(G) ? TK_NPROMPT_UNITS : TK_NPROMPT_UNITS + TK_NSAMPLE_UNITS, G * NWAVES);
}
__device__ __forceinline__ void peer_topk_sample_prelude(const Args& A, LAS unsigned char* lds, int tid, int lane, int wave, int vcu, int G, gu32* ctl) {
    if (!peer_topk_split(G) || (vcu & 31) != 0) return;
    peer_topk_units(A, lds, lane, wave, TK_NPROMPT_UNITS + (vcu >> 5) * NWAVES + wave, TK_NPROMPT_UNITS + TK_NSAMPLE_UNITS, TK_NSAMPLE_UNITS);
    asm volatile("s_waitcnt vmcnt(0)" ::: "memory");
    __syncthreads();
    if (tid == 0) { __builtin_amdgcn_fence(__ATOMIC_RELEASE, "agent"); asm volatile("s_waitcnt vmcnt(0)" ::: "memory"); (void)__hip_atomic_fetch_add((unsigned*)(ctl + CW_TKS), 1u, RLX_AGENT); }
    __syncthreads();
}
__device__ __forceinline__ void peer_topk_sample_wait(gu32* ctl, int tid) {
    if (tid == 0) {
        unsigned sp = 0;
        while (__hip_atomic_load((unsigned*)(ctl + CW_TKS), RLX_AGENT) < (unsigned)(TK_NSAMPLE_UNITS / NWAVES)) { __builtin_amdgcn_s_sleep(2); if (++sp > (1u << 22)) break; }
        __builtin_amdgcn_fence(__ATOMIC_ACQUIRE, "agent");
        asm volatile("s_waitcnt vmcnt(0)" ::: "memory");
    }
    __syncthreads();
}

constexpr int PEER_ITEM = 40, NITEM128 = NTOK / PEER_ITEM;
__device__ __forceinline__ bool peer_next_item(gu32* qbase, int xcc, int& qs, int& slice, int& item, LAS unsigned char* lds, int tid) {
    LAS int* box = (LAS int*)(lds + LDSCTL_OFF + 64);
    for (;;) {
        if (qs >= 8) return false;
        slice = (xcc + qs) & 7;
        if (tid == 0) box[0] = (int)__hip_atomic_fetch_add((unsigned*)(qbase + 64 * slice), 1u, RLX_AGENT);
        __syncthreads();
        item = box[0];
        __syncthreads();
        if (item < NITEM128) return true;
        ++qs;
    }
}

typedef long i64_t;
constexpr float PEER_SX = 1.0f;
constexpr int U_TILE0 = 8192, U_TILEB = 16384;
__device__ __forceinline__ i64_t mk64(unsigned lo, unsigned hi) { return (i64_t)(((unsigned long long)hi << 32) | (unsigned long long)lo); }
__device__ __forceinline__ void peer_u_phase(const Args& A, LAS unsigned char* lds, int tid, int lane, int wave, gu32* ctl, int qoff) {
    const unsigned char* Uq = A.ws + WS_UB; const bf16* XG = (const bf16*)(A.ws + WS_A1);
    const unsigned short* EIDX = (const unsigned short*)(A.ws + WS_EIDX); float* PART = (float*)(A.ws + WS_PART);
    const int xcc = (int)(xb_xcc_id() & 7u), rg = lane >> 3, c8 = lane & 7, m = lane & 15, kq = lane >> 4;
    LAS int* we = (LAS int*)(lds + wave * 1024);
    LAS unsigned char* tile = lds + U_TILE0 + wave * U_TILEB;
    const int ch_e = ((c8 - (rg >> 1)) & 7) * 16, ch_o = ((c8 - 4 - (rg >> 1)) & 7) * 16;
    const int fbase = m * 128 + (kq & 1) * 8, pos0 = (kq >> 1) + (m >> 1);
    int foff[4];
#pragma unroll
    for (int ks = 0; ks < 4; ++ks) foff[ks] = fbase + ((pos0 + 2 * ks) & 7) * 16;
    int qs = 0, slice, item; bool lists_ready = !peer_topk_split((int)gridDim.x);
    while (peer_next_item(ctl + CW_QU + qoff, xcc, qs, slice, item, lds, tid)) {
        if (!lists_ready && (item + 1) * PEER_ITEM > NPROMPT) { peer_topk_sample_wait(ctl, tid); lists_ready = true; }
        const unsigned char* us = Uq + (size_t)slice * 16384 * 128;
        size_t tok = (size_t)(item * PEER_ITEM + wave);
        unsigned pair = *(const unsigned*)(EIDX + tok * 128 + 2 * lane);
        v4u xr[4];
#pragma unroll
        for (int ks = 0; ks < 4; ++ks) xr[ks] = *(const v4u*)(XG + tok * DM + slice * 128 + ks * 32 + kq * 8);
        we[2 * lane] = (int)(pair & 0xffffu); we[2 * lane + 1] = (int)(pair >> 16);
        LDS_WAIT();
        v4u w[16];
#pragma unroll
        for (int it = 0; it < 16; ++it) w[it] = *(const v4u*)(us + (unsigned)(((unsigned)we[it * 8 + rg] << 7) + (unsigned)((it & 1) ? ch_o : ch_e)));
        for (int tt = 0; tt < PEER_ITEM / NWAVES; ++tt) {
            const size_t ctok = tok; const bool more = tt + 1 < PEER_ITEM / NWAVES;
            i64_t bx[4];
#pragma unroll
            for (int ks = 0; ks < 4; ++ks) { const v4u q = xr[ks]; typedef short s16x2 __attribute__((ext_vector_type(2)));
                s16x2 lo = (s16x2){0, 0}, hi = lo;
                unsigned q0 = q.x, q1 = q.y, q2 = q.z, q3 = q.w; asm volatile("" : "+v"(q0), "+v"(q1), "+v"(q2), "+v"(q3));
                lo = __builtin_amdgcn_cvt_scalef32_pk_fp8_bf16(lo, __builtin_bit_cast(bf16x2_t, q0), PEER_SX, false); lo = __builtin_amdgcn_cvt_scalef32_pk_fp8_bf16(lo, __builtin_bit_cast(bf16x2_t, q1), PEER_SX, true);
                hi = __builtin_amdgcn_cvt_scalef32_pk_fp8_bf16(hi, __builtin_bit_cast(bf16x2_t, q2), PEER_SX, false); hi = __builtin_amdgcn_cvt_scalef32_pk_fp8_bf16(hi, __builtin_bit_cast(bf16x2_t, q3), PEER_SX, true);
                bx[ks] = mk64(__builtin_bit_cast(unsigned, lo), __builtin_bit_cast(unsigned, hi)); }
            if (more) { tok += NWAVES; pair = *(const unsigned*)(EIDX + tok * 128 + 2 * lane);
#pragma unroll
                for (int ks = 0; ks < 4; ++ks) xr[ks] = *(const v4u*)(XG + tok * DM + slice * 128 + ks * 32 + kq * 8); }
#pragma unroll
            for (int it = 0; it < 16; ++it) *(LAS v4u*)(tile + it * 1024 + lane * 16) = w[it];
            if (more) {
                we[2 * lane] = (int)(pair & 0xffffu); we[2 * lane + 1] = (int)(pair >> 16);
                LDS_WAIT();
#pragma unroll
                for (int it = 0; it < 16; ++it) w[it] = *(const v4u*)(us + (unsigned)(((unsigned)we[it * 8 + rg] << 7) + (unsigned)((it & 1) ? ch_o : ch_e)));
            } else LDS_WAIT();
            float* pp = PART + (ctok * 8 + slice) * 128;
            f32x4 acc[8];
#pragma unroll
            for (int hf = 0; hf < 2; ++hf) {
                v2u a[4][4];
#pragma unroll
                for (int T4 = 0; T4 < 4; ++T4)
#pragma unroll
                    for (int ks = 0; ks < 4; ++ks) a[T4][ks] = *(const LAS v2u*)(tile + (hf * 4 + T4) * 2048 + foff[ks]);
#pragma unroll
                for (int T4 = 0; T4 < 4; ++T4) acc[hf * 4 + T4] = (f32x4){0.f, 0.f, 0.f, 0.f};
#pragma unroll
                for (int ks = 0; ks < 4; ++ks)
#pragma unroll
                    for (int T4 = 0; T4 < 4; ++T4) acc[hf * 4 + T4] = __builtin_amdgcn_mfma_f32_16x16x32_fp8_fp8(mk64(a[T4][ks].x, a[T4][ks].y), bx[ks], acc[hf * 4 + T4], 0, 0, 0);
            }
            f32x4 val = acc[0];
#pragma unroll
            for (int T = 1; T < 8; ++T) val = ((m & 7) == T) ? acc[T] : val;
            if (m < 8) *(f32x4*)(pp + m * 16 + 4 * kq) = val * (1.0f / PEER_SX);
            LDS_WAIT();
        }
    }
}

constexpr float PEER_CS = 64.0f;
__device__ __forceinline__ void peer_coef_phase(const Args& A, int lane, int wave, int vcu, int G) {
    const float* PART = (const float*)(A.ws + WS_PART); const float* GATE = (const float*)(A.ws + WS_GATE); const float* RSTD = (const float*)(A.ws + WS_RSTD);
    unsigned char* C8 = A.ws + WS_COEF;
    for (int tok = vcu * NWAVES + wave; tok < NTOK; tok += G * NWAVES) {
        const float* pp = PART + (size_t)tok * 1024 + 2 * lane;
        f32x2 d = *(const f32x2*)pp;
#pragma unroll
        for (int j = 1; j < 8; ++j) d += *(const f32x2*)(pp + j * 128);
        const float sc = RSTD[tok] * (1.0f / PEER_SU); const f32x2 gt = *(const f32x2*)(GATE + (size_t)tok * 128 + 2 * lane);
        f32x2 cf; cf.x = gt.x * gelu_tanh(d.x * sc) * (PEER_CS / PEER_SV); cf.y = gt.y * gelu_tanh(d.y * sc) * (PEER_CS / PEER_SV);
        const unsigned hi = (unsigned)__builtin_amdgcn_cvt_pk_fp8_f32(cf.x, cf.y, 0, false) & 0xffffu;
        const f32x2 bk = __builtin_amdgcn_cvt_pk_f32_fp8(hi, false);
        const unsigned lo = (unsigned)__builtin_amdgcn_cvt_pk_fp8_f32((cf.x - bk.x) * 16.0f, (cf.y - bk.y) * 16.0f, 0, false) & 0xffffu;
        *(unsigned short*)(C8 + (size_t)tok * 256 + 2 * lane) = (unsigned short)hi; *(unsigned short*)(C8 + (size_t)tok * 256 + 128 + 2 * lane) = (unsigned short)lo;
    }
}

typedef int v2i_t __attribute__((ext_vector_type(2)));
__device__ __forceinline__ void peer_v_phase(const Args& A, LAS unsigned char* lds, int tid, int lane, int wave, gu32* ctl) {
    const unsigned char* Vq = A.ws + WS_VB;
    const unsigned short* EIDX = (const unsigned short*)(A.ws + WS_EIDX); const unsigned char* C8 = A.ws + WS_COEF;
    float* X1 = A.out + O_Y; float* SS2 = (float*)(A.ws + WS_SS2); const bf16* XGv = (const bf16*)(A.ws + WS_A1);
    const int xcc = (int)(xb_xcc_id() & 7u), rg = lane >> 3, c8 = lane & 7, m = lane & 15, kq = lane >> 4;
    LAS int* we = (LAS int*)(lds + wave * 1024);
    LAS unsigned char* tile = lds + U_TILE0 + wave * U_TILEB;
    const int ch_e = ((c8 - (rg >> 1)) & 7) * 16, ch_o = ((c8 - 4 - (rg >> 1)) & 7) * 16;
    const int tr_r = (lane & 15) >> 1, tr_p = lane & 1, tr_rot = 4 * (kq & 1) + (tr_r >> 1);
    const int tbase = (8 * kq + tr_r) * 128 + 8 * tr_p;
    int toff[8];
#pragma unroll
    for (int j = 0; j < 8; ++j) toff[j] = tbase + ((j + tr_rot) & 7) * 16;
    int qs = 0, slice, item;
    while (peer_next_item(ctl + CW_QV, xcc, qs, slice, item, lds, tid)) {
        const unsigned char* vs = Vq + (size_t)slice * 16384 * 128;
        size_t tok = (size_t)(item * PEER_ITEM + wave);
        unsigned pair = *(const unsigned*)(EIDX + tok * 128 + 2 * lane);
        v2u cfr[4];
#pragma unroll
        for (int ks = 0; ks < 4; ++ks) cfr[ks] = *(const v2u*)(C8 + tok * 256 + (m & 1) * 128 + ks * 32 + kq * 8);
        const float rga = 1.0f / A.in[I_N2G][slice * 128 + lane], rgb = 1.0f / A.in[I_N2G][slice * 128 + 64 + lane];
        unsigned short xoa = XGv[tok * DM + slice * 128 + lane], xob = XGv[tok * DM + slice * 128 + 64 + lane];
        we[2 * lane] = (int)(pair & 0xffffu); we[2 * lane + 1] = (int)(pair >> 16);
        LDS_WAIT();
        v4u w[16];
#pragma unroll
        for (int it = 0; it < 16; ++it) w[it] = *(const v4u*)(vs + (unsigned)(((unsigned)we[it * 8 + rg] << 7) + (unsigned)((it & 1) ? ch_o : ch_e)));
        for (int tt = 0; tt < PEER_ITEM / NWAVES; ++tt) {
            const size_t ctok = tok; const bool more = tt + 1 < PEER_ITEM / NWAVES;
            i64_t af[4];
#pragma unroll
            for (int ks = 0; ks < 4; ++ks) af[ks] = mk64(cfr[ks].x, cfr[ks].y);
            const float xa = __uint_as_float((unsigned)xoa << 16) * rga, xb = __uint_as_float((unsigned)xob << 16) * rgb;
            if (more) { tok += NWAVES; pair = *(const unsigned*)(EIDX + tok * 128 + 2 * lane);
#pragma unroll
                for (int ks = 0; ks < 4; ++ks) cfr[ks] = *(const v2u*)(C8 + tok * 256 + (m & 1) * 128 + ks * 32 + kq * 8);
                xoa = XGv[tok * DM + slice * 128 + lane]; xob = XGv[tok * DM + slice * 128 + 64 + lane]; }
#pragma unroll
            for (int it = 0; it < 16; ++it) *(LAS v4u*)(tile + it * 1024 + lane * 16) = w[it];
            if (more) {
                we[2 * lane] = (int)(pair & 0xffffu); we[2 * lane + 1] = (int)(pair >> 16);
                LDS_WAIT();
#pragma unroll
                for (int it = 0; it < 16; ++it) w[it] = *(const v4u*)(vs + (unsigned)(((unsigned)we[it * 8 + rg] << 7) + (unsigned)((it & 1) ? ch_o : ch_e)));
            } else LDS_WAIT();
            f32x4 acc[8];
#pragma unroll
            for (int hf = 0; hf < 2; ++hf) {
                v2i_t b[4][4];
#pragma unroll
                for (int j4 = 0; j4 < 4; ++j4)
#pragma unroll
                    for (int ks = 0; ks < 4; ++ks) b[j4][ks] = __builtin_amdgcn_ds_read_tr8_b64_v2i32((LAS v2i_t*)(tile + ks * 4096 + toff[hf * 4 + j4]));
#pragma unroll
                for (int j4 = 0; j4 < 4; ++j4) acc[hf * 4 + j4] = (f32x4){0.f, 0.f, 0.f, 0.f};
#pragma unroll
                for (int ks = 0; ks < 4; ++ks)
#pragma unroll
                    for (int j4 = 0; j4 < 4; ++j4) acc[hf * 4 + j4] = __builtin_amdgcn_mfma_f32_16x16x32_fp8_fp8(af[ks], mk64((unsigned)b[j4][ks].x, (unsigned)b[j4][ks].y), acc[hf * 4 + j4], 0, 0, 0);
            }
            float h0 = acc[0][0], l0 = acc[0][1], h1 = acc[4][0], l1 = acc[4][1];
#pragma unroll
            for (int j = 1; j < 4; ++j) { const bool s = kq == j; h0 = s ? acc[j][0] : h0; l0 = s ? acc[j][1] : l0; h1 = s ? acc[4 + j][0] : h1; l1 = s ? acc[4 + j][1] : l1; }
            const float x2a = xa + (h0 + l0 * (1.0f / 16.0f)) * (1.0f / PEER_CS), x2b = xb + (h1 + l1 * (1.0f / 16.0f)) * (1.0f / PEER_CS);
            X1[ctok * DM + slice * 128 + lane] = x2a; X1[ctok * DM + slice * 128 + 64 + lane] = x2b;
            float ss = sum16(x2a * x2a + x2b * x2b); ss += __shfl_xor(ss, 16); ss += __shfl_xor(ss, 32);
            if (lane == 0) SS2[ctok * 8 + slice] = ss;
            LDS_WAIT();
        }
    }
}

__device__ __forceinline__ void peer_final_phase(const Args& A, int lane, int wave, int vcu, int G) {
    float* X1 = A.out + O_Y; const float* SS2 = (const float*)(A.ws + WS_SS2); const float* gf = A.in[I_NFG] + lane * 16;
    const f32x4 g0 = *(const f32x4*)gf, g1 = *(const f32x4*)(gf + 4), g2 = *(const f32x4*)(gf + 8), g3 = *(const f32x4*)(gf + 12);
    for (int tok = vcu * NWAVES + wave; tok < NTOK; tok += G * NWAVES) {
        const f32x4 sa = *(const f32x4*)(SS2 + (size_t)tok * 8), sb = *(const f32x4*)(SS2 + (size_t)tok * 8 + 4);
        const float ss = ((sa[0] + sa[1]) + (sa[2] + sa[3])) + ((sb[0] + sb[1]) + (sb[2] + sb[3]));
        const float rf = 1.0f / sqrtf(ss * (1.f / DM) + 1e-6f);
        float* yr = X1 + (size_t)tok * DM + lane * 16;
        const f32x4 y0 = *(const f32x4*)yr, y1 = *(const f32x4*)(yr + 4), y2 = *(const f32x4*)(yr + 8), y3 = *(const f32x4*)(yr + 12);
        *(f32x4*)yr = y0 * rf * g0; *(f32x4*)(yr + 4) = y1 * rf * g1; *(f32x4*)(yr + 8) = y2 * rf * g2; *(f32x4*)(yr + 12) = y3 * rf * g3;
    }
}

__device__ __forceinline__ void sg_partial(const bf16* Ap, int lda, const bf16* Bp, int ldb, LAS f32x4* red, int lane, int wave) {
    const int fr = lane & 15, fq = lane >> 4;
    bf16x8 a[2][4], b[4][4];
#pragma unroll
    for (int mi = 0; mi < 2; ++mi)
#pragma unroll
        for (int ks = 0; ks < 4; ++ks) a[mi][ks] = *(const bf16x8*)(Ap + (size_t)(16 * mi + fr) * lda + 32 * ks + 8 * fq);
#pragma unroll
    for (int nj = 0; nj < 4; ++nj)
#pragma unroll
        for (int ks = 0; ks < 4; ++ks) b[nj][ks] = *(const bf16x8*)(Bp + (size_t)(16 * nj + fr) * ldb + 32 * ks + 8 * fq);
    f32x4 acc[2][4];
#pragma unroll
    for (int mi = 0; mi < 2; ++mi)
#pragma unroll
        for (int nj = 0; nj < 4; ++nj) acc[mi][nj] = (f32x4){0.f, 0.f, 0.f, 0.f};
#pragma unroll
    for (int ks = 0; ks < 4; ++ks)
#pragma unroll
        for (int mi = 0; mi < 2; ++mi)
#pragma unroll
            for (int nj = 0; nj < 4; ++nj) acc[mi][nj] = __builtin_amdgcn_mfma_f32_16x16x32_bf16(b[nj][ks], a[mi][ks], acc[mi][nj], 0, 0, 0);
#pragma unroll
    for (int mi = 0; mi < 2; ++mi)
#pragma unroll
        for (int nj = 0; nj < 4; ++nj) red[(wave * 8 + mi * 4 + nj) * 64 + lane] = acc[mi][nj];
}
__device__ __forceinline__ f32x4 sg_sum(const LAS f32x4* red, int w0, int nw, int wave, int lane) {
    f32x4 s = red[(w0 * 8 + wave) * 64 + lane];
    for (int w = 1; w < nw; ++w) s += red[((w0 + w) * 8 + wave) * 64 + lane];
    return s;
}
__device__ __forceinline__ void sample_gemm2(const Args& A, LAS unsigned char* lds, int t, int lane, int wave) {
    unsigned char* ws = A.ws; const int fr = lane & 15, fq = lane >> 4;
    const int row0 = NPROMPT + (t >> 4) * 32, col0 = (t & 15) * 64;
    LAS f32x4* red = (LAS f32x4*)lds;
    const bf16* Ab = (const bf16*)(ws + WS_A1) + (wave >= 4 ? (size_t)MPAD * 512 : 0); const bf16* Bb = (const bf16*)(ws + (wave >= 4 ? WS_WPB : WS_WPA));
    sg_partial(Ab + (size_t)row0 * 512 + (wave & 3) * 128, 512, Bb + (size_t)col0 * 512 + (wave & 3) * 128, 512, red, lane, wave);
    const int row = row0 + 16 * (wave >> 2) + fr, c = col0 + 16 * (wave & 3) + 4 * fq;
    const bf16* Zg = (const bf16*)(ws + WS_ZG) + (size_t)row * 2048;
    const v2u ga = *(const v2u*)(Zg + c), gb = *(const v2u*)(Zg + 1024 + c);
    __syncthreads();
    const f32x4 pa = sg_sum(red, 0, 4, wave, lane), pb = sg_sum(red, 4, 4, wave, lane);
    const float o0 = sigm(bf_lo(ga.x)) * pa[0] + sigm(bf_lo(gb.x)) * pb[0], o1 = sigm(bf_hi(ga.x)) * pa[1] + sigm(bf_hi(gb.x)) * pb[1],
                o2 = sigm(bf_lo(ga.y)) * pa[2] + sigm(bf_lo(gb.y)) * pb[2], o3 = sigm(bf_hi(ga.y)) * pa[3] + sigm(bf_hi(gb.y)) * pb[3];
    v2u w; w.x = cvt_pk_bf16(o0, o1); w.y = cvt_pk_bf16(o2, o3); *(v2u*)((bf16*)(ws + WS_ZR) + (size_t)row * 1024 + c) = w;
    __syncthreads();
}
__device__ __forceinline__ void sample_gemm3(const Args& A, LAS unsigned char* lds, int t, int tid, int lane, int wave) {
    unsigned char* ws = A.ws; const int fr = lane & 15, fq = lane >> 4;
    const int row0 = NPROMPT + (t >> 4) * 32, col0 = (t & 15) * 64;
    LAS f32x4* red = (LAS f32x4*)lds; LAS float* ssl = (LAS float*)(lds + 65536);
    sg_partial((const bf16*)(ws + WS_ZR) + (size_t)row0 * 1024 + wave * 128, 1024, (const bf16*)(ws + WS_WO) + (size_t)col0 * 1024 + wave * 128, 1024, red, lane, wave);
    const int row = row0 + 16 * (wave >> 2) + fr, c = col0 + 16 * (wave & 3) + 4 * fq;
    const f32x4 xv = *(const f32x4*)(A.in[I_XS] + (size_t)(row - NPROMPT) * 1024 + c), q = *(const f32x4*)(A.in[I_N2G] + c);
    __syncthreads();
    const f32x4 o = xv + sg_sum(red, 0, 8, wave, lane);
    float ss = (o[0] * o[0] + o[1] * o[1]) + (o[2] * o[2] + o[3] * o[3]);
    v2u w; w.x = cvt_pk_bf16(o[0] * q[0], o[1] * q[1]); w.y = cvt_pk_bf16(o[2] * q[2], o[3] * q[3]); *(v2u*)((bf16*)(ws + WS_A1) + (size_t)row * 1024 + c) = w;
    ss += __shfl_xor(ss, 16); ss += __shfl_xor(ss, 32);
    if (fq == 0) ssl[wave * 16 + fr] = ss;
    __syncthreads();
    if (tid < 32) { const int mi = tid >> 4, r = tid & 15;
        ((float*)(ws + WS_SSP))[(size_t)(row0 + tid) * 16 + (t & 15)] = (ssl[(mi * 4 + 0) * 16 + r] + ssl[(mi * 4 + 1) * 16 + r]) + (ssl[(mi * 4 + 2) * 16 + r] + ssl[(mi * 4 + 3) * 16 + r]); }
}
__device__ __forceinline__ void sample_gemm4(const Args& A, LAS unsigned char* lds, int t, int lane, int wave) {
    unsigned char* ws = A.ws; const int fr = lane & 15, fq = lane >> 4;
    const int row0 = NPROMPT + (t >> 5) * 32, col0 = (t & 31) * 64;
    LAS f32x4* red = (LAS f32x4*)lds;
    sg_partial((const bf16*)(ws + WS_A1) + (size_t)row0 * 1024 + wave * 128, 1024, (const bf16*)(ws + WS_WQ) + (size_t)col0 * 1024 + wave * 128, 1024, red, lane, wave);
    const int row = row0 + 16 * (wave >> 2) + fr, c = col0 + 16 * (wave & 3) + 4 * fq;
    __syncthreads();
    const f32x4 o = sg_sum(red, 0, 8, wave, lane);
    v2u w; w.x = cvt_pk_bf16(o[0], o[1]); w.y = cvt_pk_bf16(o[2], o[3]); *(v2u*)((bf16*)(ws + WS_ZG) + (size_t)row * 2048 + c) = w;
    __syncthreads();
}

__global__ void __launch_bounds__(NTHR, 2) mk_fwd(Args args) {
    extern __shared__ __attribute__((aligned(16))) unsigned char lds_raw[];
    LAS unsigned char* lds = (LAS unsigned char*)lds_raw;
    const int tid = threadIdx.x, lane = tid & 63, wave = __builtin_amdgcn_readfirstlane(tid >> 6);
    const int G = gridDim.x; const int bx = blockIdx.x; const int vcu = (G % 8 == 0) ? (bx % 8) * (G / 8) + bx / 8 : bx;
    gu32* ctl = (gu32*)(args.ws + WS_CTL);
    volatile LAS unsigned* MISC = (volatile LAS unsigned*)(lds + MISC_OFF);
    for (int u = tid; u < (LDS_BYTES - LDSCTL_OFF) / 4; u += NTHR) ((LAS unsigned*)(lds + LDSCTL_OFF))[u] = 0u;
    __syncthreads();
    XcdBarrier bar; bar.bar = (unsigned*)(ctl + CW_BAR) + args.li * XCD_BAR_WORDS; bar.x = 0; bar.st = nullptr;
    if (N_LAUNCHES != PER_PHASE) bar = xcd_barrier_post((unsigned*)(ctl + CW_BAR) + args.li * XCD_BAR_WORDS, MISC + 8);
    const int lo = args.ph_lo, hi = args.ph_hi;
#define IN(k) (lo <= (k) && (k) < hi)
#define BOTH(k) (IN(k) && IN((k) + 1))
#define GRID_BAR() do { if (N_LAUNCHES != PER_PHASE) xcd_barrier(bar); } while (0)
    unsigned char* ws = args.ws;
    bf16* A1 = (bf16*)(ws + WS_A1);

    if (IN(0)) for (int rep_ = 0; rep_ < ((MK_REPEAT == 0) ? 2 : 1); ++rep_) { p0_prologue(args, lds, tid, lane, wave, vcu, G); if (BOTH(0)) GRID_BAR(); }

    if (IN(1)) for (int rep_ = 0; rep_ < ((MK_REPEAT == 1) ? 2 : 1); ++rep_) {
        pg8::Gemm g{A1, (const bf16*)(ws + WS_W1T), MPAD, N1, DM}; pg8::StaticOrder S; S.init(MPAD, N1, G, bx);
        pg8::EpiZ E{(bf16*)(ws + WS_ZC), (bf16*)(ws + WS_ZR), (bf16*)(ws + WS_ZG)};
        pg8::gemm_phase<pg8::EpiZ, pg8::StaticOrder, true, true>(lds, g, S, E);
        if (BOTH(1)) GRID_BAR();
    }

    if (IN(2)) for (int rep_ = 0; rep_ < ((MK_REPEAT == 2) ? 2 : 1); ++rep_) { conv_phase(args, vcu * NTHR + tid, G * NTHR); if (BOTH(2)) GRID_BAR(); }

    if (IN(3)) for (int rep_ = 0; rep_ < ((MK_REPEAT == 3) ? 2 : 1); ++rep_) {
        scan_pass1(args, lds, tid, lane, wave, vcu, G, (MK_REPEAT == 3 && rep_ == 0) ? 1 : 0);
        if (BOTH(3)) GRID_BAR();
    }

    if (IN(4)) {
        for (int u = vcu; u < 512; u += G) {
            if (u < 256) { const int bh = u >> 2, vq = u & 3; scan_pass2_rows(nullptr, bh * 64, 64, vq * 16, args.out + O_WKV_P + (size_t)bh * 4096, true, args, lds, tid, lane, wave); }
            else { const int bh = u - 256;
                for (int vq = 0; vq < 4; ++vq) scan_pass2_rows(args.in[I_SWKV] + (size_t)bh * 4096, NUNITS_P + bh, 1, vq * 16, args.out + O_WKV_S + (size_t)bh * 4096, false, args, lds, tid, lane, wave); }
        }
        if (BOTH(4)) GRID_BAR();
    }

    if (IN(5)) for (int rep_ = 0; rep_ < ((MK_REPEAT == 5) ? 2 : 1); ++rep_) {
        for (int u2 = vcu; u2 < NUNITS / 2; u2 += G) scan_pass3_wave(args, u2 * 2 + (wave >> 2), wave & 3, lane);
        if (BOTH(5)) GRID_BAR();
    }

    if (IN(6)) {
        { pg8::Gemm g{A1, (const bf16*)(ws + WS_WPA), NPROMPT, DM, 512}; pg8::StaticOrder S; S.init(NPROMPT, DM, G, bx);
          pg8::EpiGate<0> E{(const bf16*)(ws + WS_ZG), (bf16*)(ws + WS_ZR)};
          pg8::gemm_phase<pg8::EpiGate<0>, pg8::StaticOrder, true, true>(lds, g, S, E); }
        { pg8::Gemm g{A1 + (size_t)MPAD * 512, (const bf16*)(ws + WS_WPB), NPROMPT, DM, 512}; pg8::StaticOrder S; S.init(NPROMPT, DM, G, bx);
          pg8::EpiGate<1> E{(const bf16*)(ws + WS_ZG), (bf16*)(ws + WS_ZR)};
          pg8::gemm_phase<pg8::EpiGate<1>, pg8::StaticOrder, true, true>(lds, g, S, E); }
        for (int t = vcu; t < 256; t += G) sample_gemm2(args, lds, t, lane, wave);
        if (BOTH(6)) GRID_BAR();
    }

    if (IN(7)) for (int rep_ = 0; rep_ < ((MK_REPEAT == 7) ? 2 : 1); ++rep_) {
        pg8::Gemm g{(const bf16*)(ws + WS_ZR), (const bf16*)(ws + WS_WO), NPROMPT, DM, DM}; pg8::StaticOrder S; S.init(NPROMPT, DM, G, bx);
        pg8::EpiX1 E{args.in[I_XP], args.in[I_XS], args.out + O_Y, A1, (float*)(ws + WS_SSP), args.in[I_N2G], NPROMPT, NTOK};
        pg8::gemm_phase<pg8::EpiX1, pg8::StaticOrder, true, true>(lds, g, S, E);
        for (int t = vcu; t < 256; t += G) sample_gemm3(args, lds, t, tid, lane, wave);
        if (BOTH(7)) GRID_BAR();
    }

    if (IN(8)) for (int rep_ = 0; rep_ < ((MK_REPEAT == 8) ? 2 : 1); ++rep_) {
        pg8::Gemm g{A1, (const bf16*)(ws + WS_WQ), NPROMPT, 2048, DM}; pg8::StaticOrder S; S.init(NPROMPT, 2048, G, bx);
        pg8::EpiPlain E{(bf16*)(ws + WS_ZG), 2048};
        pg8::gemm_phase<pg8::EpiPlain, pg8::StaticOrder, true, true>(lds, g, S, E);
        for (int t = vcu; t < 512; t += G) sample_gemm4(args, lds, t, lane, wave);
        if (BOTH(8)) GRID_BAR();
    }

    if (IN(9)) for (int rep_ = 0; rep_ < ((MK_REPEAT == 9) ? 2 : 1); ++rep_) { peer_topk_phase(args, lds, tid, lane, wave, vcu, G); if (BOTH(9)) GRID_BAR(); }
    if (IN(10)) for (int rep_ = 0; rep_ < ((MK_REPEAT == 10) ? 2 : 1); ++rep_) { if (rep_ == 0) peer_topk_sample_prelude(args, lds, tid, lane, wave, vcu, G, ctl); peer_u_phase(args, lds, tid, lane, wave, ctl, rep_ * 1024); if (BOTH(10)) GRID_BAR(); }
    if (IN(11)) { peer_coef_phase(args, lane, wave, vcu, G); if (BOTH(11)) GRID_BAR(); }
    if (IN(12)) { peer_v_phase(args, lds, tid, lane, wave, ctl); if (BOTH(12)) GRID_BAR(); }
    if (IN(13)) peer_final_phase(args, lane, wave, vcu, G);
#undef IN
#undef BOTH
#undef GRID_BAR
}

extern "C" void kernel_launch(void* const* d_in, const int* in_sizes, int n_in, void* d_out, int out_size, void* d_ws, size_t ws_size, hipStream_t stream) {
    static int grid = 0;
    if (grid == 0) {
        if (n_in != 32 || ws_size < WS_END) { fprintf(stderr, "kernel_launch: built for 32 inputs and >= %zu bytes of workspace; got n_in %d ws %zu; nothing launched\n", (size_t)WS_END, n_in, ws_size); grid = -1; return; }
        int dev = 0, cus = 0, per_cu = 0;
        if (hipGetDevice(&dev) != hipSuccess || hipDeviceGetAttribute(&cus, hipDeviceAttributeMultiprocessorCount, dev) != hipSuccess) { fprintf(stderr, "kernel_launch: device query failed\n"); grid = -1; return; }
        if (hipFuncSetAttribute((const void*)mk_fwd, hipFuncAttributeMaxDynamicSharedMemorySize, LDS_BYTES) != hipSuccess) { fprintf(stderr, "kernel_launch: hipFuncSetAttribute failed\n"); grid = -1; return; }
        if (hipOccupancyMaxActiveBlocksPerMultiprocessor(&per_cu, (const void*)mk_fwd, NTHR, LDS_BYTES) != hipSuccess || per_cu < 1)
            fprintf(stderr, "kernel_launch: note: occupancy query reports %d workgroups per CU\n", per_cu);
        (void)hipGetLastError();
        grid = cus;
    }
    if (grid < 0) return;
    if (hipMemsetAsync((char*)d_ws + WS_CTL, 0, CTL_ZERO_BYTES, stream) != hipSuccess) { fprintf(stderr, "kernel_launch: hipMemsetAsync failed\n"); return; }
    Args a{};
    for (int i = 0; i < 32; ++i) a.in[i] = (const float*)d_in[i];
    a.out = (float*)d_out; a.ws = (unsigned char*)d_ws;
    constexpr int NL = (N_LAUNCHES == PER_PHASE ? PER_PHASE : 1) + ((MK_EXTRA_LO >= 0) ? 1 : 0);
    for (int li = 0; li < NL; ++li) {
        if (N_LAUNCHES == PER_PHASE) { a.ph_lo = li; a.ph_hi = li + 1; } else { a.ph_lo = 0; a.ph_hi = PER_PHASE; }
        if (MK_EXTRA_LO >= 0 && li == NL - 1) { a.ph_lo = MK_EXTRA_LO; a.ph_hi = MK_EXTRA_HI; }
        a.li = li;
        hipLaunchKernelGGL(mk_fwd, dim3(grid), dim3(NTHR), LDS_BYTES, stream, a);
        const hipError_t le = hipPeekAtLastError();
        if (le != hipSuccess) { fprintf(stderr, "kernel_launch: launch %d failed: %s\n", li, hipGetErrorName(le)); break; }
    }
}
```

```cpp
#include <hip/hip_runtime.h>
#include <cstdio>
#include <cstdint>
#define MK_N_LAUNCHES 1
#define MK_REPEAT -1
#define MK_DBGSEL 0
#define MK_EXTRA_LO -1
#define MK_EXTRA_HI -1
namespace pg8 {
#define PG8_LAS __attribute__((address_space(3)))
typedef unsigned short bf16_t;
typedef short bf16x8 __attribute__((ext_vector_type(8)));
typedef float f32x4 __attribute__((ext_vector_type(4)));
typedef unsigned u32x4 __attribute__((ext_vector_type(4)));
constexpr int BM = 256, BK = 64, HALF = 128, HTB = HALF * BK * 2  , STAGE_BYTES = 8 * HTB, NXCD = 8, WGM = 8;

__host__ __device__ __forceinline__ int lds_byte(int r, int c) { const int st = (r >> 4) * 2 + (c >> 5), rr = r & 15, cc = c & 31, ob = rr * 64 + cc * 2; return st * 1024 + (ob ^ (((ob >> 9) & 1) << 5)); }
__host__ __device__ __forceinline__ void stage_rc(int b, int& R, int& C) { const int st = b / 1024, sb = b % 1024, swz = sb ^ (((sb >> 9) & 1) << 5); R = (st >> 1) * 16 + swz / 64; C = (st & 1) * 32 + (swz % 64) / 2; }
__host__ __device__ __forceinline__ int perm32(int rho) { const int n = rho >> 4, i = rho & 15; return 8 * (i >> 2) + 4 * n + (i & 3); }

struct Unit { int pm, pn; };
struct Gemm { const bf16_t* A; const bf16_t* Bt; int M, N, K; };

struct StaticOrder {
    int nM, nN, nwg, G, c;
    __host__ __device__ void init(int M, int N, int G_, int c_) { nM = M / BM; nN = N / BM; nwg = nM * nN; G = G_; c = c_; }
    __host__ __device__ bool next(int i, Unit& u) const {
        const long L = (long)i * G + c; if (L >= nwg) return false;
        int wgid = (int)L; { const int q = nwg / NXCD, r = nwg % NXCD, xcd = wgid % NXCD, off = wgid / NXCD; wgid = (xcd < r ? xcd * (q + 1) : r * (q + 1) + (xcd - r) * q) + off; }
        const int nig = WGM * nN, gid = wgid / nig, fm = gid * WGM, gsz = (nM - fm) < WGM ? (nM - fm) : WGM;
        u.pm = fm + ((wgid % nig) % gsz); u.pn = (wgid % nig) / gsz; return true;
    }
    __device__ __forceinline__ void a_ready(const Unit&) const {}
    __device__ __forceinline__ void done(const Unit&) const {}
};

typedef __bf16 bf16x2_cv __attribute__((ext_vector_type(2))); typedef float f32x2_cv __attribute__((ext_vector_type(2)));
__device__ __forceinline__ unsigned cvt_pk_bf16(float lo, float hi) { return __builtin_bit_cast(unsigned, __builtin_convertvector((f32x2_cv){lo, hi}, bf16x2_cv)); }
__device__ __forceinline__ float bf_lo(unsigned w) { return __uint_as_float(w << 16); }
__device__ __forceinline__ float bf_hi(unsigned w) { return __uint_as_float(w & 0xffff0000u); }
__device__ __forceinline__ float sigm(float x) { return __builtin_amdgcn_rcpf(1.0f + __expf(-x)); }

struct EpiZ {
    static constexpr bool PERM = true, AFTER_DRAIN = false;
    bf16_t *Zc, *Zr, *Zg;
    __device__ __forceinline__ void operator()(const f32x4 (&acc)[2][2][4][2], const Unit& u, int wr, int wc, int fr, int fq) const {
        bf16_t* base; int ldc, colt;
        if (u.pn < 6) { base = Zc; ldc = 1536; colt = u.pn * BM; }
        else if (u.pn < 14) { base = Zr; ldc = 2048; colt = (u.pn - 6) * BM; }
        else { base = Zg; ldc = 2048; colt = (u.pn - 14) * BM; }
        const int row0 = u.pm * BM + wr * 64 + fr, col0 = colt + wc * 32 + 8 * fq;
#pragma unroll
        for (int ai = 0; ai < 2; ++ai)
#pragma unroll
            for (int m = 0; m < 4; ++m) { bf16_t* rowp = base + (size_t)(row0 + ai * HALF + m * 16) * ldc + col0;
#pragma unroll
                for (int bj = 0; bj < 2; ++bj) { const f32x4 v0 = acc[ai][bj][m][0], v1 = acc[ai][bj][m][1];
                    u32x4 w; w.x = cvt_pk_bf16(v0[0], v0[1]); w.y = cvt_pk_bf16(v0[2], v0[3]); w.z = cvt_pk_bf16(v1[0], v1[1]); w.w = cvt_pk_bf16(v1[2], v1[3]);
                    *(u32x4*)(rowp + bj * HALF) = w; } }
    }
};
struct EpiPlain {
    static constexpr bool PERM = true, AFTER_DRAIN = false;
    bf16_t* O; int ldc;
    __device__ __forceinline__ void operator()(const f32x4 (&acc)[2][2][4][2], const Unit& u, int wr, int wc, int fr, int fq) const {
        const int row0 = u.pm * BM + wr * 64 + fr, col0 = u.pn * BM + wc * 32 + 8 * fq;
#pragma unroll
        for (int ai = 0; ai < 2; ++ai)
#pragma unroll
            for (int m = 0; m < 4; ++m) { bf16_t* rowp = O + (size_t)(row0 + ai * HALF + m * 16) * ldc + col0;
#pragma unroll
                for (int bj = 0; bj < 2; ++bj) { const f32x4 v0 = acc[ai][bj][m][0], v1 = acc[ai][bj][m][1];
                    u32x4 w; w.x = cvt_pk_bf16(v0[0], v0[1]); w.y = cvt_pk_bf16(v0[2], v0[3]); w.z = cvt_pk_bf16(v1[0], v1[1]); w.w = cvt_pk_bf16(v1[2], v1[3]);
                    *(u32x4*)(rowp + bj * HALF) = w; } }
    }
};
template <int SECOND> struct EpiGate {
    static constexpr bool PERM = true, AFTER_DRAIN = false;
    const bf16_t* Zg; bf16_t* MG;
    __device__ __forceinline__ void operator()(const f32x4 (&acc)[2][2][4][2], const Unit& u, int wr, int wc, int fr, int fq) const {
        const int row0 = u.pm * BM + wr * 64 + fr, col0 = u.pn * BM + wc * 32 + 8 * fq;
#pragma unroll
        for (int ai = 0; ai < 2; ++ai) {
            u32x4 gw[4][2], pw[4][2];
#pragma unroll
            for (int m = 0; m < 4; ++m) { const int r = row0 + ai * HALF + m * 16;
#pragma unroll
                for (int bj = 0; bj < 2; ++bj) { gw[m][bj] = *(const u32x4*)(Zg + (size_t)r * 2048 + SECOND * 1024 + col0 + bj * HALF);
                    if (SECOND) pw[m][bj] = *(const u32x4*)(MG + (size_t)r * 1024 + col0 + bj * HALF); } }
#pragma unroll
            for (int m = 0; m < 4; ++m) { const int r = row0 + ai * HALF + m * 16; bf16_t* op = MG + (size_t)r * 1024 + col0;
#pragma unroll
                for (int bj = 0; bj < 2; ++bj) { const u32x4 g = gw[m][bj]; f32x4 v0 = acc[ai][bj][m][0], v1 = acc[ai][bj][m][1];
                    v0[0] *= sigm(bf_lo(g.x)); v0[1] *= sigm(bf_hi(g.x)); v0[2] *= sigm(bf_lo(g.y)); v0[3] *= sigm(bf_hi(g.y));
                    v1[0] *= sigm(bf_lo(g.z)); v1[1] *= sigm(bf_hi(g.z)); v1[2] *= sigm(bf_lo(g.w)); v1[3] *= sigm(bf_hi(g.w));
                    if (SECOND) { const u32x4 p = pw[m][bj];
                        v0[0] += bf_lo(p.x); v0[1] += bf_hi(p.x); v0[2] += bf_lo(p.y); v0[3] += bf_hi(p.y);
                        v1[0] += bf_lo(p.z); v1[1] += bf_hi(p.z); v1[2] += bf_lo(p.w); v1[3] += bf_hi(p.w); }
                    u32x4 w; w.x = cvt_pk_bf16(v0[0], v0[1]); w.y = cvt_pk_bf16(v0[2], v0[3]); w.z = cvt_pk_bf16(v1[0], v1[1]); w.w = cvt_pk_bf16(v1[2], v1[3]);
                    *(u32x4*)(op + bj * HALF) = w; } }
        }
    }
};
struct EpiX1 {
    static constexpr bool PERM = false, AFTER_DRAIN = false;
    const float* xp; const float* xs; float* X1; bf16_t* X1B; float* SSP; const float* g2; int nprompt, nrows;
    __device__ __forceinline__ void operator()(const f32x4 (&acc)[2][2][4][2], const Unit& u, int wr, int wc, int fr, int fq) const {
        typedef unsigned u32x2v __attribute__((ext_vector_type(2)));
        const int col0 = u.pn * BM + wc * 32 + 4 * fq;
        f32x4 gq[2][2];
#pragma unroll
        for (int bj = 0; bj < 2; ++bj)
#pragma unroll
            for (int n = 0; n < 2; ++n) gq[bj][n] = *(const f32x4*)(g2 + col0 + bj * HALF + n * 16);
#pragma unroll
        for (int ai = 0; ai < 2; ++ai) {
            f32x4 xv[4][2][2];
#pragma unroll
            for (int m = 0; m < 4; ++m) { int r = u.pm * BM + ai * HALF + wr * 64 + m * 16 + fr; r = r < nrows ? r : nrows - 1;
                const float* xr = r < nprompt ? xp + (size_t)r * 1024 : xs + (size_t)(r - nprompt) * 1024;
#pragma unroll
                for (int bj = 0; bj < 2; ++bj)
#pragma unroll
                    for (int n = 0; n < 2; ++n) xv[m][bj][n] = *(const f32x4*)(xr + col0 + bj * HALF + n * 16); }
#pragma unroll
            for (int m = 0; m < 4; ++m) { const int r = u.pm * BM + ai * HALF + wr * 64 + m * 16 + fr; float ss = 0.f;
#pragma unroll
                for (int bj = 0; bj < 2; ++bj)
#pragma unroll
                    for (int n = 0; n < 2; ++n) { const int c = col0 + bj * HALF + n * 16; const f32x4 o = xv[m][bj][n] + acc[ai][bj][m][n];
                        ss += (o[0] * o[0] + o[1] * o[1]) + (o[2] * o[2] + o[3] * o[3]);
                        const f32x4 q = gq[bj][n]; u32x2v w; w.x = cvt_pk_bf16(o[0] * q[0], o[1] * q[1]); w.y = cvt_pk_bf16(o[2] * q[2], o[3] * q[3]);
                        if (r < nrows) *(u32x2v*)(X1B + (size_t)r * 1024 + c) = w; }
                ss += __shfl_xor(ss, 16); ss += __shfl_xor(ss, 32);
                if (fq == 0 && r < nrows) SSP[(size_t)r * 16 + u.pn * 4 + wc] = ss;
            }
        }
    }
};
template <class Epi, class Sched, bool ALIGN_EPI = false, bool SP2 = false>
__device__ __forceinline__ void gemm_phase(PG8_LAS unsigned char* lds, const Gemm g, const Sched& S, const Epi& E) {
    const int tid = threadIdx.x, wid = __builtin_amdgcn_readfirstlane(tid >> 6), lane = tid & 63, wr = wid >> 2, wc = wid & 3, fr = lane & 15, fq = lane >> 4;
    const int K = g.K, nt = K / BK;
    unsigned voffA[2], voffB[2];
#pragma unroll
    for (int i = 0; i < 2; ++i) { int R, C; stage_rc(tid * 16 + i * 8192, R, C); const int Rb = Epi::PERM ? ((R & ~31) + perm32(R & 31)) : R;
        voffA[i] = (unsigned)(R * K + C) * 2u; voffB[i] = (unsigned)(Rb * K + C) * 2u; }
    const size_t kstep = (size_t)(BK * 2);
    const size_t hstep = (size_t)HALF * K * 2;
    const size_t tstep = 2 * hstep;
    const unsigned ldsw = (unsigned)wid * 1024u;
    const int aoff = lds_byte(wr * 64 + fr, fq * 8), boff = lds_byte(wc * 32 + fr, fq * 8);
#define PG8_SA(b, h) (((b) * 2 + (h)) * HTB)
#define PG8_SB(b, h) ((4 + (b) * 2 + (h)) * HTB)
#define PG8_STAGE(bufoff, gbase, voff) do { _Pragma("unroll") for (int _i = 0; _i < 2; ++_i) \
        __builtin_amdgcn_global_load_lds((const unsigned*)((const char*)(gbase) + (voff)[_i]), (PG8_LAS unsigned*)(lds + (bufoff) + ldsw + _i * 8192), 16, 0, 0); } while (0)
#define PG8_LDA(dst, b, h) do { _Pragma("unroll") for (int m = 0; m < 4; ++m) _Pragma("unroll") for (int k = 0; k < 2; ++k) dst[m][k] = *(const PG8_LAS bf16x8*)(lds + PG8_SA(b, h) + aoff + m * 2048 + k * 1024); } while (0)
#define PG8_LDB(dst, b, h) do { _Pragma("unroll") for (int n = 0; n < 2; ++n) _Pragma("unroll") for (int k = 0; k < 2; ++k) dst[n][k] = *(const PG8_LAS bf16x8*)(lds + PG8_SB(b, h) + boff + n * 2048 + k * 1024); } while (0)
#define PG8_MMA(ai, bj, At, Bt) do { __builtin_amdgcn_s_setprio(1); _Pragma("unroll") for (int m = 0; m < 4; ++m) _Pragma("unroll") for (int n = 0; n < 2; ++n) _Pragma("unroll") for (int k = 0; k < 2; ++k) \
        acc[ai][bj][m][n] = __builtin_amdgcn_mfma_f32_16x16x32_bf16(Bt[n][k], At[m][k], acc[ai][bj][m][n], 0, 0, 0); __builtin_amdgcn_s_setprio(0); } while (0)
#define PG8_WAIT_V(n) asm volatile("s_waitcnt vmcnt(" #n ")" ::: "memory")
#define PG8_WAIT_L(n) asm volatile("s_waitcnt lgkmcnt(" #n ")" ::: "memory")
#define PG8_BAR __builtin_amdgcn_s_barrier()
#define PG8_SCHED __builtin_amdgcn_sched_barrier(0)
    Unit cur, nxt; int ui = 0;
    if (!S.next(0, cur)) return;
    f32x4 acc[2][2][4][2];
#pragma unroll
    for (int a = 0; a < 2; ++a)
#pragma unroll
        for (int b = 0; b < 2; ++b)
#pragma unroll
            for (int m = 0; m < 4; ++m)
#pragma unroll
                for (int n = 0; n < 2; ++n) acc[a][b][m][n] = (f32x4){0.f, 0.f, 0.f, 0.f};
    bf16x8 At[4][2], B0[2][2], B1[2][2];
    const char* cA = (const char*)g.A + (size_t)cur.pm * tstep; const char* cB = (const char*)g.Bt + (size_t)cur.pn * tstep;
    S.a_ready(cur);
    if constexpr (SP2) {
        PG8_STAGE(PG8_SB(0, 0), cB, voffB); PG8_STAGE(PG8_SB(0, 1), cB + hstep, voffB); PG8_STAGE(PG8_SA(0, 0), cA, voffA); PG8_STAGE(PG8_SA(0, 1), cA + hstep, voffA);
        if (wr == 1) PG8_BAR;
        PG8_WAIT_V(2); PG8_BAR;
        PG8_STAGE(PG8_SB(1, 0), cB + kstep, voffB); PG8_STAGE(PG8_SA(1, 0), cA + kstep, voffA); PG8_STAGE(PG8_SB(1, 1), cB + hstep + kstep, voffB);
        PG8_WAIT_V(6); PG8_BAR;
    } else {
        PG8_STAGE(PG8_SB(0, 0), cB, voffB); PG8_STAGE(PG8_SA(0, 0), cA, voffA); PG8_STAGE(PG8_SB(0, 1), cB + hstep, voffB); PG8_STAGE(PG8_SA(0, 1), cA + hstep, voffA);
        if (wr == 1) PG8_BAR;
        PG8_WAIT_V(4); PG8_BAR;
        PG8_STAGE(PG8_SB(1, 0), cB + kstep, voffB); PG8_STAGE(PG8_SA(1, 0), cA + kstep, voffA); PG8_STAGE(PG8_SB(1, 1), cB + hstep + kstep, voffB);
        PG8_WAIT_V(6); PG8_BAR;
    }
    for (;;) {
        const bool has_next = S.next(ui + 1, nxt);
        const char* nA = has_next ? (const char*)g.A + (size_t)nxt.pm * tstep : cA; const char* nB = has_next ? (const char*)g.Bt + (size_t)nxt.pn * tstep : cB;
        for (int t = 0; t < nt; t += 2) {
            const bool last = (t == nt - 2);
            const char* a1 = cA + (size_t)(t + 1) * kstep;
            const char* a2 = last ? nA : cA + (size_t)(t + 2) * kstep; const char* b2 = last ? nB : cB + (size_t)(t + 2) * kstep;
            const char* a3 = a2 + kstep; const char* b3 = b2 + kstep;
            if (last && has_next) S.a_ready(nxt);
            if constexpr (SP2) {
            PG8_LDB(B0, 0, 0); PG8_LDB(B1, 0, 1); PG8_SCHED; PG8_LDA(At, 0, 0); PG8_STAGE(PG8_SA(1, 1), a1 + hstep, voffA);
            PG8_WAIT_V(8); PG8_WAIT_L(0); PG8_BAR; PG8_MMA(0, 0, At, B0); PG8_MMA(0, 1, At, B1); PG8_BAR; PG8_SCHED;
            PG8_LDA(At, 0, 1); PG8_STAGE(PG8_SB(0, 0), b2, voffB); PG8_STAGE(PG8_SB(0, 1), b2 + hstep, voffB); PG8_STAGE(PG8_SA(0, 0), a2, voffA);
            PG8_WAIT_V(8); PG8_WAIT_L(0); PG8_BAR; PG8_MMA(1, 0, At, B0); PG8_MMA(1, 1, At, B1); PG8_BAR; PG8_SCHED;
            PG8_LDB(B0, 1, 0); PG8_LDB(B1, 1, 1); PG8_SCHED; PG8_LDA(At, 1, 0); PG8_STAGE(PG8_SA(0, 1), a2 + hstep, voffA);
            PG8_WAIT_V(8); PG8_WAIT_L(0); PG8_BAR; PG8_MMA(0, 0, At, B0); PG8_MMA(0, 1, At, B1); PG8_BAR; PG8_SCHED;
            PG8_LDA(At, 1, 1); PG8_STAGE(PG8_SB(1, 0), b3, voffB); PG8_STAGE(PG8_SB(1, 1), b3 + hstep, voffB); PG8_STAGE(PG8_SA(1, 0), a3, voffA);
            PG8_WAIT_V(8); PG8_WAIT_L(0); PG8_BAR; PG8_MMA(1, 0, At, B0); PG8_MMA(1, 1, At, B1); PG8_BAR; PG8_SCHED;
            } else {
            PG8_LDB(B0, 0, 0); PG8_SCHED; PG8_LDA(At, 0, 0); PG8_STAGE(PG8_SA(1, 1), a1 + hstep, voffA);
            PG8_WAIT_L(8); PG8_BAR; PG8_WAIT_L(0); PG8_MMA(0, 0, At, B0); PG8_BAR; PG8_SCHED;
            PG8_LDB(B1, 0, 1); PG8_STAGE(PG8_SB(0, 0), b2, voffB);
            PG8_BAR; PG8_WAIT_L(0); PG8_MMA(0, 1, At, B1); PG8_BAR;
            PG8_LDA(At, 0, 1); PG8_STAGE(PG8_SA(0, 0), a2, voffA);
            PG8_BAR; PG8_WAIT_L(0); PG8_MMA(1, 0, At, B0); PG8_BAR; PG8_SCHED;
            PG8_STAGE(PG8_SB(0, 1), b2 + hstep, voffB);
            PG8_WAIT_V(6); PG8_BAR; PG8_MMA(1, 1, At, B1); PG8_BAR;
            PG8_LDB(B0, 1, 0); PG8_SCHED; PG8_LDA(At, 1, 0); PG8_STAGE(PG8_SA(0, 1), a2 + hstep, voffA);
            PG8_WAIT_L(8); PG8_BAR; PG8_WAIT_L(0); PG8_MMA(0, 0, At, B0); PG8_BAR; PG8_SCHED;
            PG8_LDB(B1, 1, 1); PG8_STAGE(PG8_SB(1, 0), b3, voffB);
            PG8_BAR; PG8_WAIT_L(0); PG8_MMA(0, 1, At, B1); PG8_BAR;
            PG8_LDA(At, 1, 1); PG8_STAGE(PG8_SA(1, 0), a3, voffA);
            PG8_BAR; PG8_WAIT_L(0); PG8_MMA(1, 0, At, B0); PG8_BAR; PG8_SCHED;
            PG8_STAGE(PG8_SB(1, 1), b3 + hstep, voffB);
            PG8_WAIT_V(6); PG8_BAR; PG8_MMA(1, 1, At, B1); PG8_BAR;
            }
        }
        if constexpr (ALIGN_EPI) { if (wr == 0) PG8_BAR; }
        if constexpr (!Epi::AFTER_DRAIN) { E(acc, cur, wr, wc, fr, fq); S.done(cur); }
        if (!has_next) break;
#pragma unroll
        for (int a = 0; a < 2; ++a)
#pragma unroll
            for (int b = 0; b < 2; ++b)
#pragma unroll
                for (int m = 0; m < 4; ++m)
#pragma unroll
                    for (int n = 0; n < 2; ++n) acc[a][b][m][n] = (f32x4){0.f, 0.f, 0.f, 0.f};
        cur = nxt; cA = nA; cB = nB; ++ui;
        if constexpr (ALIGN_EPI) { if (wr == 1) PG8_BAR; }
    }
    PG8_WAIT_V(0);
    if constexpr (!ALIGN_EPI) { if (wr == 0) PG8_BAR; }
    PG8_BAR;
    if constexpr (Epi::AFTER_DRAIN) { E.fused(acc, cur, wr, wc, fr, fq, lds, wid, lane); S.done(cur); }
#undef PG8_SA
#undef PG8_SB
#undef PG8_STAGE
#undef PG8_LDA
#undef PG8_LDB
#undef PG8_MMA
#undef PG8_WAIT_V
#undef PG8_WAIT_L
#undef PG8_BAR
#undef PG8_SCHED
}
}
constexpr int NWAVES = 8, NTHR = 512;
#ifndef MK_N_LAUNCHES
#define MK_N_LAUNCHES 1
#endif
constexpr int PER_PHASE = 14;
constexpr int N_LAUNCHES = MK_N_LAUNCHES;

constexpr int DM = 1024, NPROMPT = 32768, NSAMP = 512, NTOK = 33280, NSHIFT = 32, MPAD = 33536, N1 = 5632;
constexpr int SEQ_P = 4096, SEQ_S = 16, NB_P = 8, NB_S = 32;
constexpr size_t O_Y = 0, O_CONV_P = 34078720, O_SHIFT_P = 34086912, O_WKV_P = 34095104, O_CONV_S = 34357248, O_SHIFT_S = 34390016, O_WKV_S = 34422784;
constexpr size_t KiB = 1024, MiB = 1u << 20;
constexpr size_t WS_CTL = 0, CTL_ZERO_BYTES = 64 * KiB;
constexpr size_t WS_W1T = 64 * KiB;
constexpr size_t WS_WPA = WS_W1T + (size_t)N1 * DM * 2;
constexpr size_t WS_WPB = WS_WPA + 1 * MiB;
constexpr size_t WS_WO = WS_WPB + 1 * MiB;
constexpr size_t WS_WQ = WS_WO + 2 * MiB;
constexpr size_t WS_KEYS = WS_WQ + 4 * MiB;
constexpr size_t WS_L2T = WS_KEYS + 512 * KiB;
constexpr size_t WS_SSP = WS_L2T + 256 * KiB;
constexpr size_t WS_UB = WS_SSP + (size_t)MPAD * 16 * 4;
constexpr size_t WS_VB = WS_UB + 16 * MiB;
constexpr size_t WS_A1 = WS_VB + 16 * MiB;
constexpr size_t WS_ZC = WS_A1 + (size_t)MPAD * DM * 2;
constexpr size_t WS_ZR = WS_ZC + (size_t)MPAD * 1536 * 2;
constexpr size_t WS_ZG = WS_ZR + (size_t)MPAD * 2048 * 2;
constexpr size_t WS_END = WS_ZG + (size_t)MPAD * 2048 * 2;
constexpr size_t WS_YL = WS_ZC, WS_ZT = WS_ZC + (size_t)NTOK * 512 * 2, WS_BV = WS_ZC + (size_t)NTOK * 512 * 4;
constexpr size_t WS_EIDX = WS_ZC, WS_GATE = WS_ZC + 16 * MiB, WS_COEF = WS_ZC + 40 * MiB, WS_SS2 = WS_ZC + 64 * MiB, WS_RSTD = WS_ZC + 66 * MiB;
constexpr size_t WS_PART = WS_ZR;
constexpr size_t OB_MB = (size_t)4352 * 4096 * 4;
static_assert(WS_BV + (size_t)NTOK * 512 * 2 <= WS_ZR && OB_MB + (size_t)4352 * 4096 * 2 <= (size_t)NTOK * 1024 * 4, "scan scratch maps");
static_assert(WS_END <= 512 * MiB, "d_ws map must fit 512 MiB");
constexpr float PEER_SU = 32.0f, PEER_SV = 4.0f;
constexpr int CW_BAR = 1024;
constexpr int LDS_BYTES = 163840;
constexpr int LDSCTL_OFF = LDS_BYTES - 512, MISC_OFF = LDSCTL_OFF + 320;

#define GAS __attribute__((address_space(1)))
#define LAS __attribute__((address_space(3)))
typedef unsigned short bf16;
typedef unsigned v4u __attribute__((ext_vector_type(4)));
typedef unsigned v2u __attribute__((ext_vector_type(2)));
typedef float f32x4 __attribute__((ext_vector_type(4)));
typedef short bf16x8 __attribute__((ext_vector_type(8)));
typedef __bf16 bf16x2_t __attribute__((ext_vector_type(2)));
typedef GAS unsigned gu32;
#define RLX_AGENT __ATOMIC_RELAXED, __HIP_MEMORY_SCOPE_AGENT
#define LDS_WAIT() asm volatile("s_waitcnt lgkmcnt(0)" ::: "memory")
#define VM_WAIT() asm volatile("s_waitcnt vmcnt(0)" ::: "memory")
using pg8::cvt_pk_bf16; using pg8::bf_lo; using pg8::bf_hi; using pg8::sigm;
#define XB_TMO      128
#define XB_XCNT(j)  (256  + 64 * (j))
#define XB_XSUB(j)  (1280 + 64 * (j))
#define XB_XGEN(j)  (2304 + 64 * (j))
#define XB_TOP      3328
#define XB_TOPGEN   3392
#define XCD_BAR_WORDS 3456
#define XB_SPIN_CAP (1u << 22)

__device__ __forceinline__ unsigned xb_ld(unsigned* p)              { return __hip_atomic_load(p, __ATOMIC_RELAXED, __HIP_MEMORY_SCOPE_AGENT); }
__device__ __forceinline__ unsigned xb_add(unsigned* p, unsigned v) { return __hip_atomic_fetch_add(p, v, __ATOMIC_RELAXED, __HIP_MEMORY_SCOPE_AGENT); }
__device__ __forceinline__ unsigned xb_xcc_id() { return (unsigned)__builtin_amdgcn_s_getreg((3 << 11) | 20) & 0xFu; }
#define XB_SPIN(cond, bar) do { unsigned _sp = 0; while (cond) { __builtin_amdgcn_s_sleep(1); \
    if ((++_sp & 255u) == 0u) { if (xb_ld(&(bar)[XB_TMO])) break; if (_sp > XB_SPIN_CAP) { atomicAdd(&(bar)[XB_TMO], 1u); break; } } } } while (0)

struct XcdBarrier {
    unsigned* bar; unsigned x;
    volatile LAS unsigned* st;
};

__device__ __forceinline__ XcdBarrier xcd_barrier_post(unsigned* bar, volatile LAS unsigned* st) {
    XcdBarrier b; b.bar = bar; b.x = xb_xcc_id(); b.st = st;
    if (threadIdx.x == 0) (void)xb_add(&bar[XB_XCNT(b.x)], 1u);
    return b;
}
__device__ __forceinline__ void xcd_barrier_complete(unsigned* bar, unsigned x, unsigned& nloc, unsigned& nx) {
    const unsigned G = gridDim.x * gridDim.y * gridDim.z;
    unsigned sum, cnt, mine, sp = 0u;
    for (;;) {
        sum = 0u; cnt = 0u; mine = 0u;
#pragma unroll
        for (unsigned j = 0; j < 16; ++j) { const unsigned c = xb_ld(&bar[XB_XCNT(j)]); sum += c; cnt += (c > 0u) ? 1u : 0u; mine = (j == x) ? c : mine; }
        if (sum == G) break;
        __builtin_amdgcn_s_sleep(1);
        if ((++sp & 255u) == 0u) { if (xb_ld(&bar[XB_TMO])) break; if (sp > XB_SPIN_CAP) { atomicAdd(&bar[XB_TMO], 1u); break; } }
    }
    nloc = mine > 0u ? mine : 1u; nx = cnt > 0u ? cnt : 1u;
}

__device__ __forceinline__ void xcd_barrier(const XcdBarrier& b) {
    asm volatile("s_waitcnt vmcnt(0)" ::: "memory");
    __syncthreads();
    if (threadIdx.x == 0) {
        unsigned* bar = b.bar;
        __builtin_amdgcn_s_waitcnt(0);
        unsigned nloc = b.st[0], nx = b.st[1];
        if (nloc == 0u) { xcd_barrier_complete(bar, b.x, nloc, nx); b.st[0] = nloc; b.st[1] = nx; }
        const unsigned old = xb_add(&bar[XB_XSUB(b.x)], 1u);
        const unsigned gen = old / nloc;
        if (old + 1u == (gen + 1u) * nloc) {
            __builtin_amdgcn_fence(__ATOMIC_RELEASE, "agent");
            asm volatile("s_waitcnt vmcnt(0)" ::: "memory");
            const unsigned og = xb_add(&bar[XB_TOP], 1u);
            const unsigned tg = og / nx;
            if (og + 1u == (tg + 1u) * nx) xb_add(&bar[XB_TOPGEN], 1u);
            else XB_SPIN(xb_ld(&bar[XB_TOPGEN]) == tg, bar);
            __builtin_amdgcn_fence(__ATOMIC_ACQUIRE, "agent");
            xb_add(&bar[XB_XGEN(b.x)], 1u);
            asm volatile("s_waitcnt vmcnt(0)" ::: "memory");
        } else {
            XB_SPIN(xb_ld(&bar[XB_XGEN(b.x)]) == gen, bar);
            __builtin_amdgcn_fence(__ATOMIC_ACQUIRE, "agent");
            asm volatile("s_waitcnt vmcnt(0)" ::: "memory");
        }
    }
    __syncthreads();
}
struct Args { const float* in[32]; float* out; unsigned char* ws; int ph_lo, ph_hi, li, pad; };
enum { I_XP = 0, I_XS, I_SCONV, I_SSHIFT, I_SWKV, I_N1G, I_WIN, I_CONVW, I_MURKV, I_MUWAG, I_W0, I_W1, I_W2, I_A0, I_A1, I_A2, I_G1, I_G2, I_KK, I_KA, I_RK, I_GNW, I_GNB, I_WPA, I_WPB, I_WO, I_N2G, I_WQ, I_KEYS, I_U, I_V, I_NFG };

__device__ __forceinline__ float wave_sum(float v) {
#pragma unroll
    for (int o = 1; o < 64; o <<= 1) v += __shfl_xor(v, o);
    return v;
}
template <int CTRL> __device__ __forceinline__ float dpp_mov(float v) { return __builtin_bit_cast(float, __builtin_amdgcn_update_dpp(0, __builtin_bit_cast(int, v), CTRL, 0xF, 0xF, true)); }
__device__ __forceinline__ float sum4(float v) { v += dpp_mov<0xB1>(v); v += dpp_mov<0x4E>(v); return v; }
__device__ __forceinline__ float sum8(float v) { v = sum4(v); v += dpp_mov<0x141>(v); return v; }
__device__ __forceinline__ float sum16(float v) { v = sum8(v); v += dpp_mov<0x140>(v); return v; }
__device__ __forceinline__ float dot2bf(unsigned w, unsigned x, float acc) { return __builtin_amdgcn_fdot2_f32_bf16(__builtin_bit_cast(bf16x2_t, w), __builtin_bit_cast(bf16x2_t, x), acc, false); }

__device__ __forceinline__ void transpose_item(const float* W, int ldw, int c0, int K, bf16* WT, int nblk, int item, const float* sv, float alpha, float beta, LAS float* scr, int lane) {
    const int kb = item / nblk, nb = item % nblk, k0 = 64 * kb, n0 = 32 * nb;
#pragma unroll 8
    for (int i = 0; i < 32; ++i) { const int kk = 2 * i + (lane >> 5); float s = 1.f; if (sv) s = alpha + beta * sv[k0 + kk];
        scr[kk * 33 + (lane & 31)] = W[(size_t)(k0 + kk) * ldw + c0 + n0 + (lane & 31)] * s; }
    LDS_WAIT();
    const int c = lane & 7;
#pragma unroll
    for (int j = 0; j < 4; ++j) { const int n = (lane >> 3) + 8 * j; const LAS float* s = scr + (8 * c) * 33 + n;
        v4u o; o.x = cvt_pk_bf16(s[0 * 33], s[1 * 33]); o.y = cvt_pk_bf16(s[2 * 33], s[3 * 33]); o.z = cvt_pk_bf16(s[4 * 33], s[5 * 33]); o.w = cvt_pk_bf16(s[6 * 33], s[7 * 33]);
        *(v4u*)(WT + (size_t)(n0 + n) * K + k0 + 8 * c) = o; }
    LDS_WAIT();
}
__device__ __forceinline__ void cvt_stream(const float* src, bf16* dst, size_t n, size_t gt, size_t nthreads) {
    for (size_t i = gt * 8; i < n; i += nthreads * 8) { const f32x4 a = *(const f32x4*)(src + i), b = *(const f32x4*)(src + i + 4);
        v4u o; o.x = cvt_pk_bf16(a[0], a[1]); o.y = cvt_pk_bf16(a[2], a[3]); o.z = cvt_pk_bf16(b[0], b[1]); o.w = cvt_pk_bf16(b[2], b[3]); *(v4u*)(dst + i) = o; }
}
__device__ __forceinline__ void cvt_stream_fp8(const float* src, unsigned char* dst, size_t n, float scale, size_t gt, size_t nthreads) {
    for (size_t i = gt * 16; i < n; i += nthreads * 16) {
        const f32x4 a = *(const f32x4*)(src + i) * scale, b = *(const f32x4*)(src + i + 4) * scale, c = *(const f32x4*)(src + i + 8) * scale, d = *(const f32x4*)(src + i + 12) * scale;
        v4u o; unsigned p;
        p = __builtin_amdgcn_cvt_pk_fp8_f32(a[0], a[1], 0, false); o.x = __builtin_amdgcn_cvt_pk_fp8_f32(a[2], a[3], p, true);
        p = __builtin_amdgcn_cvt_pk_fp8_f32(b[0], b[1], 0, false); o.y = __builtin_amdgcn_cvt_pk_fp8_f32(b[2], b[3], p, true);
        p = __builtin_amdgcn_cvt_pk_fp8_f32(c[0], c[1], 0, false); o.z = __builtin_amdgcn_cvt_pk_fp8_f32(c[2], c[3], p, true);
        p = __builtin_amdgcn_cvt_pk_fp8_f32(d[0], d[1], 0, false); o.w = __builtin_amdgcn_cvt_pk_fp8_f32(d[2], d[3], p, true);
        *(v4u*)(dst + i) = o; }
}
__device__ __forceinline__ void cvt16_fp8_sliced(const float* src, unsigned char* dst, float scale, size_t i) {
    const f32x4 a = *(const f32x4*)(src + i) * scale, b = *(const f32x4*)(src + i + 4) * scale, c = *(const f32x4*)(src + i + 8) * scale, d = *(const f32x4*)(src + i + 12) * scale;
    v4u o; unsigned p;
    p = __builtin_amdgcn_cvt_pk_fp8_f32(a[0], a[1], 0, false); o.x = __builtin_amdgcn_cvt_pk_fp8_f32(a[2], a[3], p, true);
    p = __builtin_amdgcn_cvt_pk_fp8_f32(b[0], b[1], 0, false); o.y = __builtin_amdgcn_cvt_pk_fp8_f32(b[2], b[3], p, true);
    p = __builtin_amdgcn_cvt_pk_fp8_f32(c[0], c[1], 0, false); o.z = __builtin_amdgcn_cvt_pk_fp8_f32(c[2], c[3], p, true);
    p = __builtin_amdgcn_cvt_pk_fp8_f32(d[0], d[1], 0, false); o.w = __builtin_amdgcn_cvt_pk_fp8_f32(d[2], d[3], p, true);
    const size_t e = i >> 10, col = i & 1023;
    *(v4u*)(dst + (col >> 7) * ((size_t)16384 * 128) + e * 128 + (col & 127)) = o;
}
__device__ __forceinline__ void cvt_stream_fp8_sliced(const float* src, unsigned char* dst, float scale, size_t gt, size_t nthreads) {
#pragma unroll 2
    for (size_t i = gt * 16; i < (size_t)16384 * 1024; i += nthreads * 16) {
        const f32x4 a = *(const f32x4*)(src + i) * scale, b = *(const f32x4*)(src + i + 4) * scale, c = *(const f32x4*)(src + i + 8) * scale, d = *(const f32x4*)(src + i + 12) * scale;
        v4u o; unsigned p;
        p = __builtin_amdgcn_cvt_pk_fp8_f32(a[0], a[1], 0, false); o.x = __builtin_amdgcn_cvt_pk_fp8_f32(a[2], a[3], p, true);
        p = __builtin_amdgcn_cvt_pk_fp8_f32(b[0], b[1], 0, false); o.y = __builtin_amdgcn_cvt_pk_fp8_f32(b[2], b[3], p, true);
        p = __builtin_amdgcn_cvt_pk_fp8_f32(c[0], c[1], 0, false); o.z = __builtin_amdgcn_cvt_pk_fp8_f32(c[2], c[3], p, true);
        p = __builtin_amdgcn_cvt_pk_fp8_f32(d[0], d[1], 0, false); o.w = __builtin_amdgcn_cvt_pk_fp8_f32(d[2], d[3], p, true);
        const size_t e = i >> 10, col = i & 1023;
        *(v4u*)(dst + (col >> 7) * ((size_t)16384 * 128) + e * 128 + (col & 127)) = o; }
}
__device__ __forceinline__ void p0_prologue(const Args& A, LAS unsigned char* lds, int tid, int lane, int wave, int vcu, int G) {
    unsigned char* ws = A.ws;
    bf16* W1T = (bf16*)(ws + WS_W1T);
    LAS float* scr = (LAS float*)(lds + wave * 16384);
    const int gw = vcu * NWAVES + wave, NGW = G * NWAVES;
    constexpr int J0 = 16 * 96, J1 = 16 * 64, JL = 16 * 2, JG = 16 * 4, JP = 8 * 32, JO = 16 * 32, JQ = 16 * 64;
    constexpr int JW2 = 16, JG2 = 32;
    constexpr int NITEMS = J0 + J1 + 4 * JL + 2 * JG + 2 * JP + JO + JQ + 2 * JW2 + JG2;
    bf16* L2T = (bf16*)(ws + WS_L2T);
    const float* mu = A.in[I_MUWAG];
    for (int it = gw; it < NITEMS; it += NGW) {
        int r = it;
        if (r < J0) { transpose_item(A.in[I_WIN], 5120, 0, 1024, W1T, 96, r, nullptr, 0.f, 0.f, scr, lane); continue; } r -= J0;
        if (r < J1) { transpose_item(A.in[I_WIN], 5120, 3072, 1024, W1T + (size_t)3584 * 1024, 64, r, nullptr, 0.f, 0.f, scr, lane); continue; } r -= J1;
        if (r < JL) { transpose_item(A.in[I_W1], 64, 0, 1024, W1T + (size_t)3072 * 1024, 2, r, mu, 1.f, -1.f, scr, lane); continue; } r -= JL;
        if (r < JL) { transpose_item(A.in[I_W1], 64, 0, 1024, W1T + (size_t)3328 * 1024, 2, r, mu, 0.f, 1.f, scr, lane); continue; } r -= JL;
        if (r < JL) { transpose_item(A.in[I_A1], 64, 0, 1024, W1T + (size_t)(3072 + 64) * 1024, 2, r, mu + 1024, 1.f, -1.f, scr, lane); continue; } r -= JL;
        if (r < JL) { transpose_item(A.in[I_A1], 64, 0, 1024, W1T + (size_t)(3328 + 64) * 1024, 2, r, mu + 1024, 0.f, 1.f, scr, lane); continue; } r -= JL;
        if (r < JG) { transpose_item(A.in[I_G1], 128, 0, 1024, W1T + (size_t)(3072 + 128) * 1024, 4, r, mu + 2048, 1.f, -1.f, scr, lane); continue; } r -= JG;
        if (r < JG) { transpose_item(A.in[I_G1], 128, 0, 1024, W1T + (size_t)(3328 + 128) * 1024, 4, r, mu + 2048, 0.f, 1.f, scr, lane); continue; } r -= JG;
        if (r < JP) { transpose_item(A.in[I_WPA], 1024, 0, 512, (bf16*)(ws + WS_WPA), 32, r, nullptr, 0.f, 0.f, scr, lane); continue; } r -= JP;
        if (r < JP) { transpose_item(A.in[I_WPB], 1024, 0, 512, (bf16*)(ws + WS_WPB), 32, r, nullptr, 0.f, 0.f, scr, lane); continue; } r -= JP;
        if (r < JO) { transpose_item(A.in[I_WO], 1024, 0, 1024, (bf16*)(ws + WS_WO), 32, r, nullptr, 0.f, 0.f, scr, lane); continue; } r -= JO;
        if (r < JQ) { transpose_item(A.in[I_WQ], 2048, 0, 1024, (bf16*)(ws + WS_WQ), 64, r, nullptr, 0.f, 0.f, scr, lane); continue; } r -= JQ;
        if (r < JW2) { transpose_item(A.in[I_W2], 512, 0, 64, L2T, 16, r, nullptr, 0.f, 0.f, scr, lane); continue; } r -= JW2;
        if (r < JW2) { transpose_item(A.in[I_A2], 512, 0, 64, L2T + (size_t)512 * 64, 16, r, nullptr, 0.f, 0.f, scr, lane); continue; } r -= JW2;
        transpose_item(A.in[I_G2], 512, 0, 128, L2T + (size_t)1024 * 64, 16, r, nullptr, 0.f, 0.f, scr, lane);
    }
    const size_t gt = (size_t)vcu * NTHR + tid, nth = (size_t)G * NTHR;
    if (G != 256) {
        cvt_stream_fp8_sliced(A.in[I_U], ws + WS_UB, PEER_SU, gt, nth);
        cvt_stream_fp8_sliced(A.in[I_V], ws + WS_VB, PEER_SV, gt, nth); }
    cvt_stream(A.in[I_KEYS], (bf16*)(ws + WS_KEYS), (size_t)8 * 2 * 128 * 128, gt, nth);
    bf16* A1 = (bf16*)(ws + WS_A1);
    const f32x4* g1v = (const f32x4*)A.in[I_N1G] + lane;
    for (int m0 = gw; m0 < NTOK; m0 += 2 * NGW) {
        const int m1 = m0 + NGW; const bool two = m1 < NTOK; const int m1c = two ? m1 : m0;
        const f32x4* xr0 = (const f32x4*)(m0 < NPROMPT ? A.in[I_XP] + (size_t)m0 * DM : A.in[I_XS] + (size_t)(m0 - NPROMPT) * DM) + lane;
        const f32x4* xr1 = (const f32x4*)(m1c < NPROMPT ? A.in[I_XP] + (size_t)m1c * DM : A.in[I_XS] + (size_t)(m1c - NPROMPT) * DM) + lane;
        f32x4 v0[4], v1[4]; float s0 = 0.f, s1 = 0.f;
#pragma unroll
        for (int j = 0; j < 4; ++j) { v0[j] = xr0[64 * j]; v1[j] = xr1[64 * j]; }
#pragma unroll
        for (int j = 0; j < 4; ++j) { s0 += (v0[j][0] * v0[j][0] + v0[j][1] * v0[j][1]) + (v0[j][2] * v0[j][2] + v0[j][3] * v0[j][3]);
                                      s1 += (v1[j][0] * v1[j][0] + v1[j][1] * v1[j][1]) + (v1[j][2] * v1[j][2] + v1[j][3] * v1[j][3]); }
#pragma unroll
        for (int o = 1; o < 64; o <<= 1) { s0 += __shfl_xor(s0, o); s1 += __shfl_xor(s1, o); }
        const float r0 = 1.0f / sqrtf(s0 * (1.f / DM) + 1e-6f), r1 = 1.0f / sqrtf(s1 * (1.f / DM) + 1e-6f);
#pragma unroll
        for (int rr = 0; rr < 2; ++rr) {
            if (rr == 1 && !two) break;
            const int m = rr ? m1 : m0; const float rstd = rr ? r1 : r0;
            v2u* o8 = (v2u*)(A1 + (size_t)m * DM) + lane;
            float* so = nullptr;
            if (m < NPROMPT) { if ((m & (SEQ_P - 1)) == SEQ_P - 1) so = A.out + O_SHIFT_P + (size_t)(m / SEQ_P) * DM; }
            else { const int ms = m - NPROMPT; if ((ms & (SEQ_S - 1)) == SEQ_S - 1) so = A.out + O_SHIFT_S + (size_t)(ms / SEQ_S) * DM; }
#pragma unroll
            for (int j = 0; j < 4; ++j) { const f32x4 g = g1v[64 * j]; const f32x4 y = (rr ? v1[j] : v0[j]) * rstd * g;
                v2u w; w.x = cvt_pk_bf16(y[0], y[1]); w.y = cvt_pk_bf16(y[2], y[3]); o8[64 * j] = w;
                if (so) ((f32x4*)so)[lane + 64 * j] = y; }
        }
    }
    for (int m = NTOK + gw; m < MPAD; m += NGW) {
        v2u* o8 = (v2u*)(A1 + (size_t)m * DM) + lane;
        if (m < NTOK + NSHIFT) {
            const f32x4* xr = (const f32x4*)(A.in[I_SSHIFT] + (size_t)(m - NTOK) * DM) + lane;
#pragma unroll
            for (int j = 0; j < 4; ++j) { const f32x4 y = xr[64 * j]; v2u w; w.x = cvt_pk_bf16(y[0], y[1]); w.y = cvt_pk_bf16(y[2], y[3]); o8[64 * j] = w; }
        } else {
#pragma unroll
            for (int j = 0; j < 4; ++j) { v2u w; w.x = 0u; w.y = 0u; o8[64 * j] = w; }
        }
    }
}

__device__ __forceinline__ void unpack8(const v4u w, float (&f)[8]) { f[0] = bf_lo(w.x); f[1] = bf_hi(w.x); f[2] = bf_lo(w.y); f[3] = bf_hi(w.y); f[4] = bf_lo(w.z); f[5] = bf_hi(w.z); f[6] = bf_lo(w.w); f[7] = bf_hi(w.w); }
__device__ __forceinline__ void conv_phase(const Args& A, int gt, int nth) {
    const bf16* Zc = (const bf16*)(A.ws + WS_ZC); bf16* YA = (bf16*)(A.ws + WS_A1);
    const float* cw = A.in[I_CONVW];
    for (int task = gt; task < (NTOK / 16) * 64; task += nth) {
        const int seg = task >> 6, ch = (task & 63) * 8, row0 = seg * 16;
        int b, t0, T; bool prompt = row0 < NPROMPT;
        if (prompt) { b = row0 / SEQ_P; t0 = row0 % SEQ_P; T = SEQ_P; } else { b = (row0 - NPROMPT) / SEQ_S; t0 = 0; T = SEQ_S; }
        float um2[8], um1[8], c0[8], c1[8], c2[8];
#pragma unroll
        for (int i = 0; i < 8; ++i) { c0[i] = cw[ch + i]; c1[i] = cw[512 + ch + i]; c2[i] = cw[1024 + ch + i]; }
        if (t0 == 0) {
            if (prompt) {
#pragma unroll
                for (int i = 0; i < 8; ++i) { um2[i] = 0.f; um1[i] = 0.f; }
            } else { const float* sc = A.in[I_SCONV] + (size_t)b * 2 * 512 + ch;
#pragma unroll
                for (int i = 0; i < 8; ++i) { um2[i] = sc[i]; um1[i] = sc[512 + i]; } }
        } else {
            float a[8], h[8];
            unpack8(*(const v4u*)(Zc + (size_t)(row0 - 2) * 1536 + 512 + ch), a); unpack8(*(const v4u*)(Zc + (size_t)(row0 - 2) * 1536 + 1024 + ch), h);
#pragma unroll
            for (int i = 0; i < 8; ++i) um2[i] = a[i] * h[i];
            unpack8(*(const v4u*)(Zc + (size_t)(row0 - 1) * 1536 + 512 + ch), a); unpack8(*(const v4u*)(Zc + (size_t)(row0 - 1) * 1536 + 1024 + ch), h);
#pragma unroll
            for (int i = 0; i < 8; ++i) um1[i] = a[i] * h[i];
        }
#pragma unroll 4
        for (int t = 0; t < 16; ++t) {
            const size_t row = (size_t)(row0 + t);
            float zb[8], zc[8], zh[8], y[8];
            unpack8(*(const v4u*)(Zc + row * 1536 + ch), zb); unpack8(*(const v4u*)(Zc + row * 1536 + 512 + ch), zc); unpack8(*(const v4u*)(Zc + row * 1536 + 1024 + ch), zh);
#pragma unroll
            for (int i = 0; i < 8; ++i) { const float u = zc[i] * zh[i]; y[i] = zb[i] * (c0[i] * um2[i] + c1[i] * um1[i] + c2[i] * u); um2[i] = um1[i]; um1[i] = u; }
            v4u o; o.x = cvt_pk_bf16(y[0], y[1]); o.y = cvt_pk_bf16(y[2], y[3]); o.z = cvt_pk_bf16(y[4], y[5]); o.w = cvt_pk_bf16(y[6], y[7]);
            *(v4u*)(YA + row * 512 + ch) = o;
        }
        if (t0 + 16 == T) { float* oc = A.out + (prompt ? O_CONV_P : O_CONV_S) + (size_t)b * 2 * 512 + ch;
#pragma unroll
            for (int i = 0; i < 8; ++i) { oc[i] = um2[i]; oc[512 + i] = um1[i]; } }
    }
    bf16* Zr = (bf16*)(A.ws + WS_ZR);
    for (int task = nth - 1 - gt; task < NTOK * 16; task += nth) {
        const int m = task >> 4, cs = task & 15;
        bool hasprev; int prow;
        if (m < NPROMPT) { hasprev = (m & (SEQ_P - 1)) != 0; prow = m - 1; } else { const int ms = m - NPROMPT; hasprev = true; prow = (ms & (SEQ_S - 1)) ? m - 1 : NTOK + ms / SEQ_S; }
        bf16* pap = Zr + (size_t)m * 2048 + 1536 + cs * 16;
        float pa[16], t8[8];
        const v4u a0 = *(const v4u*)pap, a1 = *(const v4u*)(pap + 8);
        v4u b0 = (v4u){0u, 0u, 0u, 0u}, b1 = b0;
        if (hasprev) { const bf16* pbp = Zr + (size_t)prow * 2048 + 1792 + cs * 16; b0 = *(const v4u*)pbp; b1 = *(const v4u*)(pbp + 8); }
        unpack8(a0, t8);
#pragma unroll
        for (int i = 0; i < 8; ++i) pa[i] = t8[i];
        unpack8(a1, t8);
#pragma unroll
        for (int i = 0; i < 8; ++i) pa[8 + i] = t8[i];
        unpack8(b0, t8);
#pragma unroll
        for (int i = 0; i < 8; ++i) pa[i] += t8[i];
        unpack8(b1, t8);
#pragma unroll
        for (int i = 0; i < 8; ++i) pa[8 + i] += t8[i];
#pragma unroll
        for (int i = 0; i < 16; ++i) { float p = pa[i];
            if (cs < 4) p = 1.0f - 2.0f * __builtin_amdgcn_rcpf(__expf(2.0f * p) + 1.0f);
            else if (cs >= 8) p = sigm(p);
            pa[i] = p; }
        v4u o0, o1; o0.x = cvt_pk_bf16(pa[0], pa[1]); o0.y = cvt_pk_bf16(pa[2], pa[3]); o0.z = cvt_pk_bf16(pa[4], pa[5]); o0.w = cvt_pk_bf16(pa[6], pa[7]);
        o1.x = cvt_pk_bf16(pa[8], pa[9]); o1.y = cvt_pk_bf16(pa[10], pa[11]); o1.z = cvt_pk_bf16(pa[12], pa[13]); o1.w = cvt_pk_bf16(pa[14], pa[15]);
        *(v4u*)pap = o0; *(v4u*)(pap + 8) = o1;
    }
}

constexpr int NUNITS_P = NB_P * 8 * 64, NUNITS = NUNITS_P + NB_S * 8;
constexpr int HID_STRIDE = 264, SC_TB = 32;
constexpr int P1_HIDB = 0, P1_LO = 16896, P1_SEQ = 41472, P1_GG = 90624, P1_YY = 98816, P1_ZZ = 107008, P1_BON = 115200;
typedef float f32x2 __attribute__((ext_vector_type(2)));

struct P1Pre { v4u pa0, pa1; v2u zr, zk, zv, pr, pk, pv; };
struct P1Pos { int unit, t0; };
__device__ __forceinline__ void p1_decode(int unit, bool& prompt, int& b, int& h, int& ch, int& T, int& rowbase) {
    prompt = unit < NUNITS_P; b = prompt ? unit >> 9 : (unit - NUNITS_P) >> 3; h = prompt ? (unit >> 6) & 7 : unit & 7; ch = prompt ? unit & 63 : 0;
    T = prompt ? 64 : SEQ_S; rowbase = prompt ? b * SEQ_P + ch * 64 : NPROMPT + b * SEQ_S;
}
__device__ __forceinline__ void p1_rows(int unit, int t0, int tt, size_t& row, size_t& prow, bool& hasprev, int& nb) {
    bool prompt; int b, h, ch, T, rowbase; p1_decode(unit, prompt, b, h, ch, T, rowbase);
    nb = (T - t0) < SC_TB ? (T - t0) : SC_TB;
    const int tloc = tt < nb ? tt : nb - 1, t = t0 + tloc; const bool first = (ch == 0);
    row = (size_t)(rowbase + t); hasprev = (t > 0) || !first || !prompt; prow = ((t > 0) || !first) ? row - 1 : (size_t)(NTOK + b);
}
__device__ __forceinline__ void p1_load(const Args& A, int unit, int t0, int tt, int cs, P1Pre& P) {
    size_t row, prow; bool hasprev; int nb; p1_rows(unit, t0, tt, row, prow, hasprev, nb);
    const int h = unit < NUNITS_P ? (unit >> 6) & 7 : unit & 7, hc = h * 64 + cs * 4;
    const bf16* Zr = (const bf16*)(A.ws + WS_ZR);
    P.pa0 = *(const v4u*)(Zr + row * 2048 + 1536 + cs * 16); P.pa1 = *(const v4u*)(Zr + row * 2048 + 1536 + cs * 16 + 8);
    P.zr = *(const v2u*)(Zr + row * 2048 + hc); P.zk = *(const v2u*)(Zr + row * 2048 + 512 + hc); P.zv = *(const v2u*)(Zr + row * 2048 + 1024 + hc);
    const v2u z2 = (v2u){0u, 0u};
    P.pr = z2; P.pk = z2; P.pv = z2;
    if (hasprev) { P.pr = *(const v2u*)(Zr + prow * 2048 + hc); P.pk = *(const v2u*)(Zr + prow * 2048 + 512 + hc); P.pv = *(const v2u*)(Zr + prow * 2048 + 1024 + hc); }
}
__device__ __forceinline__ bool p1_unit_at(int i, int vcu, int G, int& unit) {
    if (G == 256) { if (i > 16) return false; unit = i < 16 ? vcu * 16 + i : NUNITS_P + vcu; return true; }
    unit = vcu + i * G; return unit < NUNITS;
}

constexpr int WY_OS = 72, WY_TS = 24, WY_LS = 40;
constexpr int WY_AT = 0, WY_RT = WY_AT + 16 * WY_OS * 2, WY_BT = WY_RT + 16 * WY_OS * 2, WY_KT = WY_BT + 16 * WY_OS * 2, WY_BH = WY_KT + 16 * WY_OS * 2,
              WY_KH = WY_BH + 64 * WY_TS * 2, WY_VT = WY_KH + 64 * WY_TS * 2, WY_GC = WY_VT + 64 * WY_TS * 2, WY_BUF = WY_GC + 256;
constexpr int WY_BASE = 0;
constexpr int WY_LAB = WY_BASE + 2 * WY_BUF, WY_LAK = WY_LAB + 1024, WY_MC = WY_LAK + 16 * WY_LS * 2;
static_assert(WY_MC + 16 * WY_LS * 2 <= P1_SEQ, "UT-transform operands must fit over HIDB | LO");
constexpr int WY_XB = 115328, WY_RH = WY_XB + 128 * WY_OS * 2, WY_UT = WY_RH + 8 * 16 * 17 * 4, WY_END = WY_UT + 8 * 16 * WY_TS * 2;
static_assert(WY_END <= LDSCTL_OFF, "LDS map of pass 1");

constexpr int WY_G2 = P1_GG + 2048;
static_assert(WY_G2 + 1024 + 2 * 16 * WY_LS * 2 <= P1_YY, "second Gram set");
__device__ __forceinline__ void p1_wy(f32x4 (&X)[4], const LAS float* SEQ, LAS float* YY, LAS float* ZZ, LAS unsigned char* lds, int nb, int tid, int lane, int wave, int part = 0) {
    const bool pw = wave >= 4; const int nmc = nb >> 4;
    LAS bf16* Xb = (LAS bf16*)(lds + WY_XB); LAS float* RH = (LAS float*)(lds + WY_RH) + wave * 16 * 17; LAS bf16* UT = (LAS bf16*)(lds + WY_UT) + wave * 16 * WY_TS;
    const bf16x8 zero8 = (bf16x8){0, 0, 0, 0, 0, 0, 0, 0};
    for (int mc = 0; mc < nmc; ++mc) {
        asm volatile("" : "+v"(tid));
        LAS unsigned char* ob = lds + WY_BASE + mc * WY_BUF;
        LAS bf16* At = (LAS bf16*)(ob + WY_AT); LAS bf16* Rt = (LAS bf16*)(ob + WY_RT); LAS bf16* Bt = (LAS bf16*)(ob + WY_BT); LAS bf16* Kt = (LAS bf16*)(ob + WY_KT);
        LAS bf16* BhT = (LAS bf16*)(ob + WY_BH); LAS bf16* KhT = (LAS bf16*)(ob + WY_KH); LAS bf16* VT = (LAS bf16*)(ob + WY_VT); LAS float* GC = (LAS float*)(ob + WY_GC);
        const int tl = tid >> 5, c2 = (tid & 31) * 2, s0 = mc * 16;
        f32x2 cum = (f32x2){0.f, 0.f}, tot = cum, lwt = cum;
#pragma unroll
        for (int i = 0; i < 16; ++i) { const f32x2 l2 = *(const LAS f32x2*)(SEQ + (s0 + i) * 384 + 64 + c2); tot += l2; if (i <= tl) cum += l2; if (i == tl) lwt = l2; }
        const LAS float* sp = SEQ + (s0 + tl) * 384 + c2;
        const f32x2 a2 = *(const LAS f32x2*)(sp), b2 = *(const LAS f32x2*)(sp + 128), k2 = *(const LAS f32x2*)(sp + 192), r2 = *(const LAS f32x2*)(sp + 256), v2 = *(const LAS f32x2*)(sp + 320);
        const f32x2 gt = (f32x2){__expf(cum.x), __expf(cum.y)}, gp = (f32x2){__expf(cum.x - lwt.x), __expf(cum.y - lwt.y)}, gi = (f32x2){__expf(-cum.x), __expf(-cum.y)},
                    go = (f32x2){__expf(tot.x - cum.x), __expf(tot.y - cum.y)};
        *(LAS unsigned*)(At + tl * WY_OS + c2) = cvt_pk_bf16(a2.x * gp.x, a2.y * gp.y); *(LAS unsigned*)(Rt + tl * WY_OS + c2) = cvt_pk_bf16(r2.x * gt.x, r2.y * gt.y);
        *(LAS unsigned*)(Bt + tl * WY_OS + c2) = cvt_pk_bf16(b2.x * gi.x, b2.y * gi.y); *(LAS unsigned*)(Kt + tl * WY_OS + c2) = cvt_pk_bf16(k2.x * gi.x, k2.y * gi.y);
        const unsigned bh = cvt_pk_bf16(b2.x * go.x, b2.y * go.y), kh = cvt_pk_bf16(k2.x * go.x, k2.y * go.y), vv = cvt_pk_bf16(v2.x, v2.y);
        {
            const unsigned bh_o = (unsigned)__shfl_xor((int)bh, 32), kh_o = (unsigned)__shfl_xor((int)kh, 32), vv_o = (unsigned)__shfl_xor((int)vv, 32);
            const bool ev = (tl & 1) == 0; const int wo = (ev ? c2 : c2 + 1) * WY_TS + (tl & ~1);
            *(LAS unsigned*)(BhT + wo) = ev ? ((bh & 0xffffu) | (bh_o << 16)) : ((bh_o >> 16) | (bh & 0xffff0000u));
            *(LAS unsigned*)(KhT + wo) = ev ? ((kh & 0xffffu) | (kh_o << 16)) : ((kh_o >> 16) | (kh & 0xffff0000u));
            *(LAS unsigned*)(VT + wo) = ev ? ((vv & 0xffffu) | (vv_o << 16)) : ((vv_o >> 16) | (vv & 0xffff0000u)); }
        if (tl == 0) *(LAS f32x2*)(GC + c2) = (f32x2){__expf(tot.x), __expf(tot.y)};
    }
    __syncthreads();
    {
        asm volatile("" : "+v"(tid));
        const int fr = tid & 15, fq = (tid >> 4) & 3, g_ = wave & 3, m_ = wave >> 2;
        if (m_ < nmc) {
            LAS unsigned char* ob = lds + WY_BASE + m_ * WY_BUF; LAS unsigned char* gs = lds + (m_ ? WY_G2 : WY_LAB);
            LAS float* Lab = (LAS float*)gs; LAS bf16* Lak = (LAS bf16*)(gs + 1024); LAS bf16* Mc = (LAS bf16*)(gs + 1024 + 16 * WY_LS * 2);
            const LAS bf16* ab = (LAS bf16*)(ob + (g_ < 2 ? WY_AT : WY_RT)) + fr * WY_OS + fq * 8; const LAS bf16* bb = (LAS bf16*)(ob + ((g_ & 1) ? WY_KT : WY_BT)) + fr * WY_OS + fq * 8;
            f32x4 g = (f32x4){0.f, 0.f, 0.f, 0.f};
#pragma unroll
            for (int ks = 0; ks < 2; ++ks) g = __builtin_amdgcn_mfma_f32_16x16x32_bf16(*(const LAS bf16x8*)(bb + ks * 32), *(const LAS bf16x8*)(ab + ks * 32), g, 0, 0, 0);
#pragma unroll
            for (int rg = 0; rg < 4; ++rg) { const int tp = 4 * fq + rg; const bool keep = (g_ < 2) ? (fr > tp) : (fr >= tp); g[rg] = keep ? g[rg] : 0.f; }
            if (g_ == 0) *(LAS f32x4*)(Lab + fr * 16 + 4 * fq) = g;
            else { v2u w; w.x = cvt_pk_bf16(g[0], g[1]); w.y = cvt_pk_bf16(g[2], g[3]);
                if (g_ == 1) { *(LAS v2u*)(Lak + fr * WY_LS + 4 * fq) = w; *(LAS v2u*)(Lak + fr * WY_LS + 16 + 4 * fq) = (v2u){0u, 0u}; }
                else if (g_ == 2) *(LAS v2u*)(Mc + fr * WY_LS + 4 * fq) = w; else *(LAS v2u*)(Mc + fr * WY_LS + 16 + 4 * fq) = w; }
        }
    }
    __syncthreads();
    if (MK_DBGSEL == 2 && part) return;
    for (int mc = 0; mc < nmc; ++mc) {
        asm volatile("" : "+v"(tid));
        const int fr = tid & 15, fq = (tid >> 4) & 3;
        LAS unsigned char* ob = lds + WY_BASE + mc * WY_BUF; LAS unsigned char* gs = lds + (mc ? WY_G2 : WY_LAB);
        LAS bf16* At = (LAS bf16*)(ob + WY_AT); LAS bf16* Rt = (LAS bf16*)(ob + WY_RT);
        LAS bf16* BhT = (LAS bf16*)(ob + WY_BH); LAS bf16* KhT = (LAS bf16*)(ob + WY_KH); LAS bf16* VT = (LAS bf16*)(ob + WY_VT); LAS float* GC = (LAS float*)(ob + WY_GC);
        LAS float* Lab = (LAS float*)gs; LAS bf16* Lak = (LAS bf16*)(gs + 1024); LAS bf16* Mc = (LAS bf16*)(gs + 1024 + 16 * WY_LS * 2);
        f32x4 W1 = (f32x4){0.f, 0.f, 0.f, 0.f}, Y0 = W1;
        {
            const LAS bf16* xbp = Xb + (16 * wave + fr) * WY_OS + fq * 8;
#pragma unroll
            for (int ks = 0; ks < 2; ++ks) { const bf16x8 bx = *(const LAS bf16x8*)(xbp + ks * 32);
                W1 = __builtin_amdgcn_mfma_f32_16x16x32_bf16(*(const LAS bf16x8*)(At + fr * WY_OS + ks * 32 + fq * 8), bx, W1, 0, 0, 0);
                Y0 = __builtin_amdgcn_mfma_f32_16x16x32_bf16(*(const LAS bf16x8*)(Rt + fr * WY_OS + ks * 32 + fq * 8), bx, Y0, 0, 0, 0); }
        }
        if (!pw) { const bf16x8 la = *(const LAS bf16x8*)(Lak + fr * WY_LS + fq * 8); const bf16x8 vb0 = *(const LAS bf16x8*)(VT + (16 * wave + fr) * WY_TS + (fq & 1) * 8); const bf16x8 vb = fq < 2 ? vb0 : zero8;
            W1 = __builtin_amdgcn_mfma_f32_16x16x32_bf16(la, vb, W1, 0, 0, 0); }
#pragma unroll
        for (int rg = 0; rg < 4; ++rg) RH[(4 * fq + rg) * 17 + fr] = W1[rg];
        LDS_WAIT();
        {
            float u[16];
#pragma unroll
            for (int t = 0; t < 16; ++t) { if ((t & 3) == 0) asm volatile("" ::: "memory");
                float acc = RH[t * 17 + fr];
                if (!(MK_DBGSEL == 3 && part))
#pragma unroll
                for (int i4 = 0; i4 * 4 < t; ++i4) { const f32x4 l4 = *(const LAS f32x4*)(Lab + t * 16 + i4 * 4);
#pragma unroll
                    for (int e = 0; e < 4; ++e) if (i4 * 4 + e < t) acc += l4[e] * u[i4 * 4 + e]; }
                u[t] = acc; }
            if (fq == 0) { v4u o0, o1; o0.x = cvt_pk_bf16(u[0], u[1]); o0.y = cvt_pk_bf16(u[2], u[3]); o0.z = cvt_pk_bf16(u[4], u[5]); o0.w = cvt_pk_bf16(u[6], u[7]);
                o1.x = cvt_pk_bf16(u[8], u[9]); o1.y = cvt_pk_bf16(u[10], u[11]); o1.z = cvt_pk_bf16(u[12], u[13]); o1.w = cvt_pk_bf16(u[14], u[15]);
                *(LAS v4u*)(UT + fr * WY_TS) = o0; *(LAS v4u*)(UT + fr * WY_TS + 8) = o1; }
        }
        LDS_WAIT();
        {
            const bf16x8 uc = fq < 2 ? *(const LAS bf16x8*)(UT + fr * WY_TS + fq * 8) : (pw ? zero8 : *(const LAS bf16x8*)(VT + (16 * wave + fr) * WY_TS + (fq - 2) * 8));
            Y0 = __builtin_amdgcn_mfma_f32_16x16x32_bf16(*(const LAS bf16x8*)(Mc + fr * WY_LS + fq * 8), uc, Y0, 0, 0, 0);
            LAS float* yo = (pw ? ZZ + 16 * (wave - 4) : YY + 16 * wave) + fr;
#pragma unroll
            for (int rg = 0; rg < 4; ++rg) yo[(mc * 16 + 4 * fq + rg) * 64] = Y0[rg];
#pragma unroll
            for (int j = 0; j < 4; ++j) {
                const bf16x8 bc = fq < 2 ? *(const LAS bf16x8*)(BhT + (16 * j + fr) * WY_TS + fq * 8) : *(const LAS bf16x8*)(KhT + (16 * j + fr) * WY_TS + (fq - 2) * 8);
                X[j] = X[j] * *(const LAS f32x4*)(GC + 16 * j + 4 * fq);
                X[j] = __builtin_amdgcn_mfma_f32_16x16x32_bf16(bc, uc, X[j], 0, 0, 0);
                v2u w; w.x = cvt_pk_bf16(X[j][0], X[j][1]); w.y = cvt_pk_bf16(X[j][2], X[j][3]);
                *(LAS v2u*)(Xb + (16 * wave + fr) * WY_OS + 16 * j + 4 * fq) = w; }
        }
        LDS_WAIT();
    }
}

#define P1_LOAD_PARAMS(HH) do { int lf_ = fr, lq_ = fq, lt_ = tid; asm volatile("" : "+v"(lf_), "+v"(lq_), "+v"(lt_));   \
        const int h_ = (HH), ncol_ = h_ * 64 + ntl * 16 + lf_; \
        _Pragma("unroll") for (int ks = 0; ks < 2; ++ks) { bw[ks] = *(const bf16x8*)(L2T + (size_t)ncol_ * 64 + lq_ * 8 + ks * 32); ba[ks] = *(const bf16x8*)(L2T + (size_t)512 * 64 + (size_t)ncol_ * 64 + lq_ * 8 + ks * 32); } \
        _Pragma("unroll") for (int ks = 0; ks < 4; ++ks) bg[ks] = *(const bf16x8*)(L2T + (size_t)1024 * 64 + (size_t)ncol_ * 128 + lq_ * 8 + ks * 32); \
        if (lt_ < 128) { const int a_ = lt_ >> 4, c_ = (lt_ & 15) * 4; \
            const float* src_ = a_ == 0 ? A.in[I_W0] : a_ == 1 ? A.in[I_A0] : a_ == 2 ? A.in[I_KK] : a_ == 3 ? A.in[I_KA] : a_ == 4 ? A.in[I_RK] : A.in[I_MURKV] + (a_ - 5) * 512; \
            *(LAS f32x4*)(PRM + a_ * 64 + c_) = *(const f32x4*)(src_ + h_ * 64 + c_); } } while (0)
__device__ __forceinline__ void scan_pass1(const Args& A, LAS unsigned char* lds, int tid, int lane, int wave, int vcu, int G, int part = 0) {
    bf16* GB = (bf16*)(A.ws + WS_A1) + (size_t)MPAD * 512;
    bf16* YL = (bf16*)(A.ws + WS_YL); bf16* ZT = (bf16*)(A.ws + WS_ZT); bf16* BV = (bf16*)(A.ws + WS_BV);
    LAS bf16* HIDB = (LAS bf16*)(lds + P1_HIDB); LAS float* LO = (LAS float*)(lds + P1_LO); LAS float* SEQ = (LAS float*)(lds + P1_SEQ);
    LAS float* YY = (LAS float*)(lds + P1_YY); LAS float* ZZ = (LAS float*)(lds + P1_ZZ);
    const bf16* L2T = (const bf16*)(A.ws + WS_L2T);
    const bool prow_wave = wave >= 4;
    const int mt = wave & 1, ntl = wave >> 1;
    int tt = tid >> 4, cs = tid & 15, c4 = cs * 4, fr = lane & 15, fq = lane >> 4;
    f32x4 X[4];
    bf16x8 bw[2], ba[2], bg[4];
    LAS float* PRM = (LAS float*)(lds + P1_GG);
    int cur_h = -1;
    int ui = 0, unit; if (!p1_unit_at(0, vcu, G, unit)) return;
    int t0 = 0; P1Pre pre; p1_load(A, unit, 0, tt, cs, pre);
    for (;;) {
        { int lt_ = tid; asm volatile("" : "+v"(lt_)); tt = lt_ >> 4; cs = lt_ & 15; c4 = cs * 4; fr = lt_ & 15; fq = (lt_ >> 4) & 3; }
        bool prompt; int b, h, ch, T, rowbase; p1_decode(unit, prompt, b, h, ch, T, rowbase);
        const int hc = h * 64 + c4;
        if (t0 == 0 && G == 256 && ui < 8) {
            const size_t i16 = ((size_t)(ui * 256 + vcu) * NTHR + tid) * 16;
            cvt16_fp8_sliced(A.in[I_U], A.ws + WS_UB, PEER_SU, i16); cvt16_fp8_sliced(A.in[I_V], A.ws + WS_VB, PEER_SV, i16); }
        if (t0 == 0) {
            LAS bf16* Xb = (LAS bf16*)(lds + WY_XB);
#pragma unroll
            for (int j = 0; j < 4; ++j) { const int prow_ = 16 * (wave - 4) + fr, c0_ = 16 * j + 4 * fq;
#pragma unroll
                for (int e = 0; e < 4; ++e) X[j][e] = (prow_wave && prow_ == c0_ + e) ? 1.f : 0.f;
                v2u w; w.x = cvt_pk_bf16(X[j][0], X[j][1]); w.y = cvt_pk_bf16(X[j][2], X[j][3]);
                *(LAS v2u*)(Xb + (16 * wave + fr) * WY_OS + c0_) = w; }
        }
        if (h != cur_h) { cur_h = h; P1_LOAD_PARAMS(h); }
        size_t row, prow; bool hasprev; int nb; p1_rows(unit, t0, tt, row, prow, hasprev, nb);
        if (!(MK_DBGSEL == 5 && part)) { *(LAS v4u*)(HIDB + tt * HID_STRIDE + cs * 16) = pre.pa0; *(LAS v4u*)(HIDB + tt * HID_STRIDE + cs * 16 + 8) = pre.pa1; }
        __syncthreads();
        if (!(MK_DBGSEL == 5 && part)) {
            const LAS bf16* ap = HIDB + (mt * 16 + fr) * HID_STRIDE + fq * 8;
            f32x4 cw = (f32x4){0.f, 0.f, 0.f, 0.f}, ca = cw, cg = cw;
#pragma unroll
            for (int ks = 0; ks < 2; ++ks) { cw = __builtin_amdgcn_mfma_f32_16x16x32_bf16(*(const LAS bf16x8*)(ap + ks * 32), bw[ks], cw, 0, 0, 0);
                                             ca = __builtin_amdgcn_mfma_f32_16x16x32_bf16(*(const LAS bf16x8*)(ap + 64 + ks * 32), ba[ks], ca, 0, 0, 0); }
#pragma unroll
            for (int ks = 0; ks < 4; ++ks) cg = __builtin_amdgcn_mfma_f32_16x16x32_bf16(*(const LAS bf16x8*)(ap + 128 + ks * 32), bg[ks], cg, 0, 0, 0);
#pragma unroll
            for (int rg = 0; rg < 4; ++rg) { const int o = (mt * 16 + fq * 4 + rg) * 64 + ntl * 16 + fr; LO[o] = cw[rg]; LO[2048 + o] = ca[rg]; LO[4096 + o] = cg[rg]; }
        }
        __syncthreads();
        if (!(MK_DBGSEL == 5 && part)) {
            const f32x4 w0v = *(const LAS f32x4*)(PRM + c4), a0v = *(const LAS f32x4*)(PRM + 64 + c4), kkv = *(const LAS f32x4*)(PRM + 128 + c4), kav = *(const LAS f32x4*)(PRM + 192 + c4),
                        rkv = *(const LAS f32x4*)(PRM + 256 + c4), mur = *(const LAS f32x4*)(PRM + 320 + c4), muk = *(const LAS f32x4*)(PRM + 384 + c4), muv = *(const LAS f32x4*)(PRM + 448 + c4);
            const f32x4 aw = w0v + *(const LAS f32x4*)(LO + tt * 64 + c4), aa = a0v + *(const LAS f32x4*)(LO + 2048 + tt * 64 + c4), ag = *(const LAS f32x4*)(LO + 4096 + tt * 64 + c4);
            f32x4 r = (f32x4){bf_lo(pre.zr.x), bf_hi(pre.zr.x), bf_lo(pre.zr.y), bf_hi(pre.zr.y)}, k = (f32x4){bf_lo(pre.zk.x), bf_hi(pre.zk.x), bf_lo(pre.zk.y), bf_hi(pre.zk.y)},
                  v = (f32x4){bf_lo(pre.zv.x), bf_hi(pre.zv.x), bf_lo(pre.zv.y), bf_hi(pre.zv.y)};
            const f32x4 rpv = (f32x4){bf_lo(pre.pr.x), bf_hi(pre.pr.x), bf_lo(pre.pr.y), bf_hi(pre.pr.y)}, kpv = (f32x4){bf_lo(pre.pk.x), bf_hi(pre.pk.x), bf_lo(pre.pk.y), bf_hi(pre.pk.y)},
                        vpv = (f32x4){bf_lo(pre.pv.x), bf_hi(pre.pv.x), bf_lo(pre.pv.y), bf_hi(pre.pv.y)};
            r = r + mur * (rpv - r); k = k + muk * (kpv - k); v = v + muv * (vpv - v);
            f32x4 dec, asg, kk, km, av, bv;
            float ssq = 0.f, bon = 0.f;
#pragma unroll
            for (int i = 0; i < 4; ++i) {
                const float x = -aw[i];
                const float sp = fmaxf(x, 0.f) + __logf(1.0f + __expf(-fabsf(x)));
                const float wraw = -sp - 0.5f;
                dec[i] = -__expf(wraw);
                asg[i] = sigm(aa[i]);
                kk[i] = k[i] * kkv[i]; ssq += kk[i] * kk[i];
                km[i] = k[i] * (1.0f + (asg[i] - 1.0f) * kav[i]);
                bon += r[i] * km[i] * rkv[i];
            }
            ssq = sum16(ssq); bon = sum16(bon);
            const float inv = 1.0f / fmaxf(sqrtf(ssq), 1e-12f);
#pragma unroll
            for (int i = 0; i < 4; ++i) { kk[i] *= inv; av[i] = -kk[i]; bv[i] = kk[i] * asg[i]; }
            LAS float* sq_ = SEQ + tt * 384 + c4;
            *(LAS f32x4*)(sq_) = av; *(LAS f32x4*)(sq_ + 64) = dec; *(LAS f32x4*)(sq_ + 128) = bv; *(LAS f32x4*)(sq_ + 192) = km; *(LAS f32x4*)(sq_ + 256) = r; *(LAS f32x4*)(sq_ + 320) = v;
            if (tt < nb) {
                v2u w; w.x = cvt_pk_bf16(ag[0], ag[1]); w.y = cvt_pk_bf16(ag[2], ag[3]); *(v2u*)(GB + row * 512 + hc) = w;
                w.x = cvt_pk_bf16(bon * v[0], bon * v[1]); w.y = cvt_pk_bf16(bon * v[2], bon * v[3]); *(v2u*)(BV + row * 512 + hc) = w;
            }
        }
        int nunit = unit, nt0 = t0 + SC_TB, nui = ui; bool more = true;
        if (nt0 >= T) { nt0 = 0; nui = ui + 1; more = p1_unit_at(nui, vcu, G, nunit); }
        if (more) p1_load(A, nunit, nt0, tt, cs, pre);
        __syncthreads();
        if (!(MK_DBGSEL == 1 && part)) p1_wy(X, SEQ, YY, ZZ, lds, nb, tid, lane, wave, part);
        __syncthreads();
        if (tt < nb) {
            const f32x4 y = *(const LAS f32x4*)(YY + tt * 64 + c4), z = *(const LAS f32x4*)(ZZ + tt * 64 + c4);
            v2u w; w.x = cvt_pk_bf16(y[0], y[1]); w.y = cvt_pk_bf16(y[2], y[3]); *(v2u*)(YL + row * 512 + hc) = w;
            w.x = cvt_pk_bf16(z[0], z[1]); w.y = cvt_pk_bf16(z[2], z[3]); *(v2u*)(ZT + row * 512 + hc) = w;
        }
        if (t0 + SC_TB >= T) {
#pragma unroll
            for (int j = 0; j < 4; ++j) {
                if (!prow_wave) *(f32x4*)((float*)A.out + (size_t)unit * 4096 + (16 * wave + fr) * 64 + 16 * j + 4 * fq) = X[j];
                else { v2u o; o.x = cvt_pk_bf16(X[j][0], X[j][1]); o.y = cvt_pk_bf16(X[j][2], X[j][3]);
                    *(v2u*)((bf16*)((unsigned char*)A.out + OB_MB) + (size_t)unit * 4096 + (16 * (wave - 4) + fr) * 64 + 16 * j + 4 * fq) = o; }
            }
        }
        if (!more) break;
        unit = nunit; t0 = nt0; ui = nui;
    }
    __syncthreads();
}

constexpr int P2_SP = 68, P2_MP = 80, P2_ML = 16 * P2_SP * 4, P2_PL = P2_ML + 64 * P2_MP * 4;
__device__ __forceinline__ void scan_pass2_rows(const float* Sinit, int unit0, int nchunks, int v0, float* outfin, bool slots, const Args& A, LAS unsigned char* lds, int tid, int lane, int wave) {
    LAS float* Sl = (LAS float*)lds; LAS float* Ml = (LAS float*)(lds + P2_ML); LAS float* Pl = (LAS float*)(lds + P2_PL);
    const int nt = wave & 3, kh = wave >> 2, fr = lane & 15, fq = lane >> 4;
    float* NB = (float*)A.out; const bf16* MB = (const bf16*)((const unsigned char*)A.out + OB_MB);
    { const int idx = tid * 2, row = idx >> 6, col = idx & 63;
      const f32x2 s0 = Sinit ? *(const f32x2*)(Sinit + (size_t)(v0 + row) * 64 + col) : (f32x2){0.f, 0.f};
      *(LAS f32x2*)(Sl + row * P2_SP + col) = s0; }
    v4u mreg = *(const v4u*)(MB + (size_t)unit0 * 4096 + tid * 8);
    float nreg[4] = {0.f, 0.f, 0.f, 0.f};
    if (kh == 0) {
#pragma unroll
        for (int rg = 0; rg < 4; ++rg) nreg[rg] = NB[(size_t)unit0 * 4096 + (v0 + fq * 4 + rg) * 64 + nt * 16 + fr]; }
    f32x4 acc = (f32x4){0.f, 0.f, 0.f, 0.f};
    for (int c = 0; c < nchunks; ++c) {
        { const int row = tid >> 3, col = (tid & 7) * 8; LAS float* mp = Ml + row * P2_MP + col;
          *(LAS f32x4*)mp = (f32x4){bf_lo(mreg.x), bf_hi(mreg.x), bf_lo(mreg.y), bf_hi(mreg.y)}; *(LAS f32x4*)(mp + 4) = (f32x4){bf_lo(mreg.z), bf_hi(mreg.z), bf_lo(mreg.w), bf_hi(mreg.w)}; }
        __syncthreads();
        float ncur[4] = {nreg[0], nreg[1], nreg[2], nreg[3]};
        if (c + 1 < nchunks) { mreg = *(const v4u*)(MB + (size_t)(unit0 + c + 1) * 4096 + tid * 8);
            if (kh == 0) {
#pragma unroll
                for (int rg = 0; rg < 4; ++rg) nreg[rg] = NB[(size_t)(unit0 + c + 1) * 4096 + (v0 + fq * 4 + rg) * 64 + nt * 16 + fr]; } }
        f32x4 a0 = (f32x4){0.f, 0.f, 0.f, 0.f}, a1 = a0;
        const LAS float* sp = Sl + fr * P2_SP + kh * 32 + fq; const LAS float* mp = Ml + (kh * 32 + fq) * P2_MP + nt * 16 + fr;
#pragma unroll
        for (int ks = 0; ks < 8; ks += 2) { a0 = __builtin_amdgcn_mfma_f32_16x16x4f32(sp[4 * ks], mp[4 * ks * P2_MP], a0, 0, 0, 0); a1 = __builtin_amdgcn_mfma_f32_16x16x4f32(sp[4 * ks + 4], mp[(4 * ks + 4) * P2_MP], a1, 0, 0, 0); }
        acc = a0 + a1;
        if (kh == 1) *(LAS f32x4*)(Pl + nt * 256 + lane * 4) = acc;
        __syncthreads();
        if (kh == 0) {
            acc = acc + *(const LAS f32x4*)(Pl + nt * 256 + lane * 4) + (f32x4){ncur[0], ncur[1], ncur[2], ncur[3]};
#pragma unroll
            for (int rg = 0; rg < 4; ++rg) { Sl[(fq * 4 + rg) * P2_SP + nt * 16 + fr] = acc[rg];
                if (slots) NB[(size_t)(unit0 + c) * 4096 + (v0 + fq * 4 + rg) * 64 + nt * 16 + fr] = acc[rg]; }
        }
    }
    if (kh == 0) {
#pragma unroll
        for (int rg = 0; rg < 4; ++rg) outfin[(size_t)(v0 + fq * 4 + rg) * 64 + nt * 16 + fr] = acc[rg]; }
    __syncthreads();
}

__device__ __forceinline__ void scan_pass3_wave(const Args& A, int unit, int wq, int lane) {
    const bool prompt = unit < NUNITS_P;
    const int b = prompt ? unit >> 9 : (unit - NUNITS_P) >> 3, h = prompt ? (unit >> 6) & 7 : unit & 7, ch = prompt ? unit & 63 : 0;
    const int T = prompt ? 64 : SEQ_S, rowbase = prompt ? b * SEQ_P + ch * 64 : NPROMPT + b * SEQ_S;
    if (wq * 16 >= T) return;
    const float* S0 = prompt ? (ch > 0 ? (const float*)A.out + (size_t)(unit - 1) * 4096 : nullptr) : A.in[I_SWKV] + (size_t)(b * 8 + h) * 4096;
    const bf16* ZT = (const bf16*)(A.ws + WS_ZT); const bf16* YL = (const bf16*)(A.ws + WS_YL); const bf16* BV = (const bf16*)(A.ws + WS_BV);
    bf16* YB = (bf16*)(A.ws + WS_A1) + (size_t)MPAD * 512;
    const int fr = lane & 15, fq = lane >> 4;
    const size_t row = (size_t)(rowbase + wq * 16 + fr);
    f32x4 acc[4];
#pragma unroll
    for (int mt = 0; mt < 4; ++mt) acc[mt] = (f32x4){0.f, 0.f, 0.f, 0.f};
    if (S0) {
        bf16x8 bz[2];
#pragma unroll
        for (int ks = 0; ks < 2; ++ks) bz[ks] = *(const bf16x8*)(ZT + row * 512 + h * 64 + ks * 32 + fq * 8);
#pragma unroll
        for (int mt = 0; mt < 4; ++mt)
#pragma unroll
            for (int ks = 0; ks < 2; ++ks) { const float* sp = S0 + (size_t)(mt * 16 + fr) * 64 + ks * 32 + fq * 8; const f32x4 s0 = *(const f32x4*)sp, s1 = *(const f32x4*)(sp + 4);
                v4u pk; pk.x = cvt_pk_bf16(s0[0], s0[1]); pk.y = cvt_pk_bf16(s0[2], s0[3]); pk.z = cvt_pk_bf16(s1[0], s1[1]); pk.w = cvt_pk_bf16(s1[2], s1[3]);
                acc[mt] = __builtin_amdgcn_mfma_f32_16x16x32_bf16(__builtin_bit_cast(bf16x8, pk), bz[ks], acc[mt], 0, 0, 0); }
    }
    float sm = 0.f;
#pragma unroll
    for (int mt = 0; mt < 4; ++mt) { const v2u yl = *(const v2u*)(YL + row * 512 + h * 64 + mt * 16 + fq * 4);
        acc[mt][0] += bf_lo(yl.x); acc[mt][1] += bf_hi(yl.x); acc[mt][2] += bf_lo(yl.y); acc[mt][3] += bf_hi(yl.y);
        sm += (acc[mt][0] + acc[mt][1]) + (acc[mt][2] + acc[mt][3]); }
    sm += __shfl_xor(sm, 16); sm += __shfl_xor(sm, 32);
    const float mean = sm * (1.f / 64.f); float sv = 0.f;
#pragma unroll
    for (int mt = 0; mt < 4; ++mt) { acc[mt] = acc[mt] - mean; sv += (acc[mt][0] * acc[mt][0] + acc[mt][1] * acc[mt][1]) + (acc[mt][2] * acc[mt][2] + acc[mt][3] * acc[mt][3]); }
    sv += __shfl_xor(sv, 16); sv += __shfl_xor(sv, 32);
    const float rs = 1.0f / sqrtf(sv * (1.f / 64.f) + 64e-5f);
#pragma unroll
    for (int mt = 0; mt < 4; ++mt) { const int c = h * 64 + mt * 16 + fq * 4;
        const f32x4 gw = *(const f32x4*)(A.in[I_GNW] + c), gb = *(const f32x4*)(A.in[I_GNB] + c);
        const v2u bvw = *(const v2u*)(BV + row * 512 + c), gg = *(const v2u*)(YB + row * 512 + c);
        f32x4 o = acc[mt] * rs * gw + gb + (f32x4){bf_lo(bvw.x), bf_hi(bvw.x), bf_lo(bvw.y), bf_hi(bvw.y)};
        o = o * (f32x4){bf_lo(gg.x), bf_hi(gg.x), bf_lo(gg.y), bf_hi(gg.y)};
        v2u w; w.x = cvt_pk_bf16(o[0], o[1]); w.y = cvt_pk_bf16(o[2], o[3]); *(v2u*)(YB + row * 512 + c) = w; }
}

__device__ __forceinline__ void tk_insert(float (&tv)[16], float x) {
#pragma unroll
    for (int i = 15; i >= 1; --i) tv[i] = __builtin_amdgcn_fmed3f(tv[i - 1], x, tv[i]);
    tv[0] = __builtin_fmaxf(tv[0], x);
}
#define TK_CE(t, i, j) { const float a_ = __builtin_fmaxf(t[i], t[j]); t[j] = __builtin_fminf(t[i], t[j]); t[i] = a_; }
__device__ __forceinline__ void tk_sort16(float (&t)[16]) {
    TK_CE(t, 0, 1) TK_CE(t, 2, 3) TK_CE(t, 0, 2) TK_CE(t, 1, 3) TK_CE(t, 1, 2) TK_CE(t, 4, 5) TK_CE(t, 6, 7) TK_CE(t, 4, 6) TK_CE(t, 5, 7) TK_CE(t, 5, 6) TK_CE(t, 0, 4) TK_CE(t, 2, 6) TK_CE(t, 2, 4) TK_CE(t, 1, 5) TK_CE(t, 3, 7) TK_CE(t, 3, 5) TK_CE(t, 1, 2) TK_CE(t, 3, 4) TK_CE(t, 5, 6) TK_CE(t, 8, 9) TK_CE(t, 10, 11) TK_CE(t, 8, 10) TK_CE(t, 9, 11) TK_CE(t, 9, 10) TK_CE(t, 12, 13) TK_CE(t, 14, 15) TK_CE(t, 12, 14) TK_CE(t, 13, 15) TK_CE(t, 13, 14) TK_CE(t, 8, 12) TK_CE(t, 10, 14) TK_CE(t, 10, 12) TK_CE(t, 9, 13) TK_CE(t, 11, 15) TK_CE(t, 11, 13) TK_CE(t, 9, 10) TK_CE(t, 11, 12) TK_CE(t, 13, 14) TK_CE(t, 0, 8) TK_CE(t, 4, 12) TK_CE(t, 4, 8) TK_CE(t, 2, 10) TK_CE(t, 6, 14) TK_CE(t, 6, 10) TK_CE(t, 2, 4) TK_CE(t, 6, 8) TK_CE(t, 10, 12) TK_CE(t, 1, 9) TK_CE(t, 5, 13) TK_CE(t, 5, 9) TK_CE(t, 3, 11) TK_CE(t, 7, 15) TK_CE(t, 7, 11) TK_CE(t, 3, 5) TK_CE(t, 7, 9) TK_CE(t, 11, 13) TK_CE(t, 1, 2) TK_CE(t, 3, 4) TK_CE(t, 5, 6) TK_CE(t, 7, 8) TK_CE(t, 9, 10) TK_CE(t, 11, 12) TK_CE(t, 13, 14)
}
__device__ __forceinline__ void tk_merge16(float (&tv)[16], const float (&g)[16]) {
#pragma unroll
    for (int i = 0; i < 16; ++i) tv[i] = __builtin_fmaxf(tv[i], g[15 - i]);
#pragma unroll
    for (int s = 8; s >= 1; s >>= 1)
#pragma unroll
        for (int i = 0; i < 16; ++i) if ((i & s) == 0) TK_CE(tv, i, i + s)
}
__device__ __forceinline__ float gelu_tanh(float x) {
    const float u = 0.7978845608028654f * (x + 0.044715f * x * x * x);
    const float th = 1.0f - 2.0f * __builtin_amdgcn_rcpf(__expf(2.0f * u) + 1.0f);
    return 0.5f * x * (1.0f + th);
}
constexpr int NTILE32 = NTOK / 32;
constexpr int CW_QU = 8192, CW_QV = 8192 + 512;

constexpr int TK_STRIDE = 68, TK_BYTES = 64 * TK_STRIDE * 4;
__device__ __forceinline__ void topk_scores64(const bf16* Q, const bf16* KB, LAS float* SC, int t0, int hp, int p, int half, int lane, const bf16x8 (&af)[2][2][4]) {
    const int fr = lane & 15, fq = lane >> 4;
#pragma unroll
    for (int hs = 0; hs < 2; ++hs) {
        const bf16* kbase = KB + (size_t)(((hp + 4 * hs) * 2 + p) * 128 + half * 64 + fr) * 128 + fq * 8;
#pragma unroll
        for (int n = 0; n < 4; ++n) {
            bf16x8 bfr[4];
#pragma unroll
            for (int ks = 0; ks < 4; ++ks) bfr[ks] = *(const bf16x8*)(kbase + (size_t)n * 16 * 128 + ks * 32);
            f32x4 acc0 = (f32x4){0.f, 0.f, 0.f, 0.f}, acc1 = acc0;
#pragma unroll
            for (int ks = 0; ks < 4; ++ks) { acc0 = __builtin_amdgcn_mfma_f32_16x16x32_bf16(af[hs][0][ks], bfr[ks], acc0, 0, 0, 0); acc1 = __builtin_amdgcn_mfma_f32_16x16x32_bf16(af[hs][1][ks], bfr[ks], acc1, 0, 0, 0); }
#pragma unroll
            for (int rg = 0; rg < 4; ++rg) { SC[(hs * 32 + fq * 4 + rg) * TK_STRIDE + n * 16 + fr] = acc0[rg]; SC[(hs * 32 + 16 + fq * 4 + rg) * TK_STRIDE + n * 16 + fr] = acc1[rg]; }
        }
    }
}
constexpr int TK_NPROMPT_UNITS = (NPROMPT / 32) * 4, TK_NSAMPLE_UNITS = (NSAMP / 32) * 4, CW_TKS = 9792;
__device__ __forceinline__ void peer_topk_units(const Args& A, LAS unsigned char* lds, int lane, int wave, int u_first, int u_end, int u_step) {
    const bf16* Q = (const bf16*)(A.ws + WS_ZG); const bf16* KB = (const bf16*)(A.ws + WS_KEYS); const float* SSP = (const float*)(A.ws + WS_SSP);
    unsigned short* EIDX = (unsigned short*)(A.ws + WS_EIDX); float* GATE = (float*)(A.ws + WS_GATE); float* RSTD = (float*)(A.ws + WS_RSTD);
    LAS float* SC = (LAS float*)(lds + wave * TK_BYTES);
    const int fr = lane & 15, fq = lane >> 4, tokl = lane & 31, hsel = lane >> 5;
    for (int u = u_first; u < u_end; u += u_step) {
        const int t0 = (u >> 2) * 32, hp = u & 3, h = hp + 4 * hsel;
        const float* sp = SSP + (size_t)(t0 + tokl) * 16;
        const f32x4 s0 = *(const f32x4*)sp, s1 = *(const f32x4*)(sp + 4), s2 = *(const f32x4*)(sp + 8), s3 = *(const f32x4*)(sp + 12);
        const float ssq = ((s0[0] + s0[1]) + (s0[2] + s0[3])) + ((s1[0] + s1[1]) + (s1[2] + s1[3])) + ((s2[0] + s2[1]) + (s2[2] + s2[3])) + ((s3[0] + s3[1]) + (s3[2] + s3[3]));
        const float rstd = 1.0f / sqrtf(ssq * (1.f / DM) + 1e-6f);
        float tv0[16], tv1[16], cv[16];
#pragma unroll
        for (int p = 0; p < 2; ++p) {
            bf16x8 af[2][2][4];
#pragma unroll
            for (int hs = 0; hs < 2; ++hs)
#pragma unroll
                for (int mt = 0; mt < 2; ++mt) { const bf16* qp = Q + (size_t)(t0 + mt * 16 + fr) * 2048 + (hp + 4 * hs) * 256 + p * 128 + fq * 8;
#pragma unroll
                    for (int ks = 0; ks < 4; ++ks) af[hs][mt][ks] = *(const bf16x8*)(qp + ks * 32); }
            float tv[16];
#pragma unroll
            for (int i = 0; i < 16; ++i) tv[i] = -3.0e38f;
            for (int half = 0; half < 2; ++half) {
                topk_scores64(Q, KB, SC, t0, hp, p, half, lane, af);
                LDS_WAIT();
                const LAS float* mine = SC + lane * TK_STRIDE;
                unsigned kmask = 0xFFFFFF80u; asm volatile("" : "+v"(kmask));
#pragma unroll 1
                for (int n = 0; n < 64; n += 16) {
                    float g[16];
#pragma unroll
                    for (int q = 0; q < 4; ++q) { const f32x4 x4 = *(const LAS f32x4*)(mine + n + 4 * q);
#pragma unroll
                        for (int e = 0; e < 4; ++e) g[4 * q + e] = __uint_as_float((__float_as_uint(x4[e]) & kmask) | (unsigned)(half * 64 + n + 4 * q + e)); }
                    tk_sort16(g); tk_merge16(tv, g);
                }
                LDS_WAIT();
            }
#pragma unroll
            for (int i = 0; i < 16; ++i) { if (p == 0) tv0[i] = tv[i]; else tv1[i] = tv[i]; }
        }
        LAS int* li = (LAS int*)SC + lane * 33;
#pragma unroll
        for (int q = 0; q < 16; ++q) { li[q] = (int)(__float_as_uint(tv0[q]) & 127u); li[16 + q] = (int)(__float_as_uint(tv1[q]) & 127u);
            tv0[q] = __uint_as_float(__float_as_uint(tv0[q]) & 0xFFFFFF80u); tv1[q] = __uint_as_float(__float_as_uint(tv1[q]) & 0xFFFFFF80u); }
#pragma unroll
        for (int q = 0; q < 16; ++q) cv[q] = -3.0e38f;
#pragma unroll
        for (int a = 0; a < 16; ++a)
#pragma unroll
            for (int b = 0; b < 16; ++b) if ((a + 1) * (b + 1) <= 16)
                tk_insert(cv, __uint_as_float((__float_as_uint(tv0[a] + tv1[b]) & 0xFFFFFF00u) | (unsigned)(a * 16 + b)));
        LDS_WAIT();
        float e[16], den = 0.f; unsigned ci[16];
        const float c0 = __uint_as_float(__float_as_uint(cv[0]) & 0xFFFFFF00u);
#pragma unroll
        for (int q = 0; q < 16; ++q) { const unsigned kb = __float_as_uint(cv[q]); const float cq = __uint_as_float(kb & 0xFFFFFF00u);
            e[q] = __expf((cq - c0) * rstd); den += e[q]; ci[q] = (unsigned)(li[(kb >> 4) & 15] * 128 + li[16 + (kb & 15)]); }
        const float inv = 1.0f / den;
        LDS_WAIT();
        {
            const size_t tok = (size_t)(t0 + tokl);
            v4u w0, w1; w0.x = ci[0] | (ci[1] << 16); w0.y = ci[2] | (ci[3] << 16); w0.z = ci[4] | (ci[5] << 16); w0.w = ci[6] | (ci[7] << 16);
            w1.x = ci[8] | (ci[9] << 16); w1.y = ci[10] | (ci[11] << 16); w1.z = ci[12] | (ci[13] << 16); w1.w = ci[14] | (ci[15] << 16);
            *(v4u*)(EIDX + tok * 128 + h * 16) = w0; *(v4u*)(EIDX + tok * 128 + h * 16 + 8) = w1;
#pragma unroll
            for (int q = 0; q < 4; ++q) *(f32x4*)(GATE + tok * 128 + h * 16 + 4 * q) = (f32x4){e[4 * q] * inv, e[4 * q + 1] * inv, e[4 * q + 2] * inv, e[4 * q + 3] * inv};
            if (h == 0) RSTD[tok] = rstd;
        }
    }
}

__device__ __forceinline__ bool peer_topk_split(int G) { return G == 256; }
__device__ __forceinline__ void peer_topk_phase(const Args& A, LAS unsigned char* lds, int tid, int lane, int wave, int vcu, int G) {
    peer_topk_units(A, lds, lane, wave, wave * G + vcu, peer_topk_split(G) ? TK_NPROMPT_UNITS : TK_NPROMPT_UNITS + TK_NSAMPLE_UNITS, G * NWAVES);
}
__device__ __forceinline__ void peer_topk_sample_prelude(const Args& A, LAS unsigned char* lds, int tid, int lane, int wave, int vcu, int G, gu32* ctl) {
    if (!peer_topk_split(G) || (vcu & 31) != 0) return;
    peer_topk_units(A, lds, lane, wave, TK_NPROMPT_UNITS + (vcu >> 5) * NWAVES + wave, TK_NPROMPT_UNITS + TK_NSAMPLE_UNITS, TK_NSAMPLE_UNITS);
    asm volatile("s_waitcnt vmcnt(0)" ::: "memory");
    __syncthreads();
    if (tid == 0) { __builtin_amdgcn_fence(__ATOMIC_RELEASE, "agent"); asm volatile("s_waitcnt vmcnt(0)" ::: "memory"); (void)__hip_atomic_fetch_add((unsigned*)(ctl + CW_TKS), 1u, RLX_AGENT); }
    __syncthreads();
}
__device__ __forceinline__ void peer_topk_sample_wait(gu32* ctl, int tid) {
    if (tid == 0) {
        unsigned sp = 0;
        while (__hip_atomic_load((unsigned*)(ctl + CW_TKS), RLX_AGENT) < (unsigned)(TK_NSAMPLE_UNITS / NWAVES)) { __builtin_amdgcn_s_sleep(2); if (++sp > (1u << 22)) break; }
        __builtin_amdgcn_fence(__ATOMIC_ACQUIRE, "agent");
        asm volatile("s_waitcnt vmcnt(0)" ::: "memory");
    }
    __syncthreads();
}

constexpr int PEER_ITEM = 40, NITEM128 = NTOK / PEER_ITEM;
__device__ __forceinline__ bool peer_next_item(gu32* qbase, int xcc, int& qs, int& slice, int& item, LAS unsigned char* lds, int tid) {
    LAS int* box = (LAS int*)(lds + LDSCTL_OFF + 64);
    for (;;) {
        if (qs >= 8) return false;
        slice = (xcc + qs) & 7;
        if (tid == 0) box[0] = (int)__hip_atomic_fetch_add((unsigned*)(qbase + 64 * slice), 1u, RLX_AGENT);
        __syncthreads();
        item = box[0];
        __syncthreads();
        if (item < NITEM128) return true;
        ++qs;
    }
}

typedef long i64_t;
constexpr float PEER_SX = 1.0f;
constexpr int U_TILE0 = 8192, U_TILEB = 16384;
__device__ __forceinline__ i64_t mk64(unsigned lo, unsigned hi) { return (i64_t)(((unsigned long long)hi << 32) | (unsigned long long)lo); }
__device__ __forceinline__ void peer_u_phase(const Args& A, LAS unsigned char* lds, int tid, int lane, int wave, gu32* ctl, int qoff) {
    const unsigned char* Uq = A.ws + WS_UB; const bf16* XG = (const bf16*)(A.ws + WS_A1);
    const unsigned short* EIDX = (const unsigned short*)(A.ws + WS_EIDX); bf16* PART = (bf16*)(A.ws + WS_PART);
    const int xcc = (int)(xb_xcc_id() & 7u), rg = lane >> 3, c8 = lane & 7, m = lane & 15, kq = lane >> 4;
    LAS int* we = (LAS int*)(lds + wave * 1024);
    LAS unsigned char* tile = lds + U_TILE0 + wave * U_TILEB;
    const int ch_e = ((c8 - (rg >> 1)) & 7) * 16, ch_o = ((c8 - 4 - (rg >> 1)) & 7) * 16;
    const int fbase = m * 128 + (kq & 1) * 8, pos0 = (kq >> 1) + (m >> 1);
    int foff[4];
#pragma unroll
    for (int ks = 0; ks < 4; ++ks) foff[ks] = fbase + ((pos0 + 2 * ks) & 7) * 16;
    int qs = 0, slice, item; bool lists_ready = !peer_topk_split((int)gridDim.x);
    while (peer_next_item(ctl + CW_QU + qoff, xcc, qs, slice, item, lds, tid)) {
        if (!lists_ready && (item + 1) * PEER_ITEM > NPROMPT) { peer_topk_sample_wait(ctl, tid); lists_ready = true; }
        const unsigned char* us = Uq + (size_t)slice * 16384 * 128;
        size_t tok = (size_t)(item * PEER_ITEM + wave);
        unsigned pair = *(const unsigned*)(EIDX + tok * 128 + 2 * lane);
        v4u xr[4];
#pragma unroll
        for (int ks = 0; ks < 4; ++ks) xr[ks] = *(const v4u*)(XG + tok * DM + slice * 128 + ks * 32 + kq * 8);
        we[2 * lane] = (int)(pair & 0xffffu); we[2 * lane + 1] = (int)(pair >> 16);
        LDS_WAIT();
        v4u w[16];
#pragma unroll
        for (int it = 0; it < 16; ++it) w[it] = *(const v4u*)(us + (unsigned)(((unsigned)we[it * 8 + rg] << 7) + (unsigned)((it & 1) ? ch_o : ch_e)));
        for (int tt = 0; tt < PEER_ITEM / NWAVES; ++tt) {
            const size_t ctok = tok; const bool more = tt + 1 < PEER_ITEM / NWAVES;
            i64_t bx[4];
#pragma unroll
            for (int ks = 0; ks < 4; ++ks) { const v4u q = xr[ks]; typedef short s16x2 __attribute__((ext_vector_type(2)));
                s16x2 lo = (s16x2){0, 0}, hi = lo;
                unsigned q0 = q.x, q1 = q.y, q2 = q.z, q3 = q.w; asm volatile("" : "+v"(q0), "+v"(q1), "+v"(q2), "+v"(q3));
                lo = __builtin_amdgcn_cvt_scalef32_pk_fp8_bf16(lo, __builtin_bit_cast(bf16x2_t, q0), PEER_SX, false); lo = __builtin_amdgcn_cvt_scalef32_pk_fp8_bf16(lo, __builtin_bit_cast(bf16x2_t, q1), PEER_SX, true);
                hi = __builtin_amdgcn_cvt_scalef32_pk_fp8_bf16(hi, __builtin_bit_cast(bf16x2_t, q2), PEER_SX, false); hi = __builtin_amdgcn_cvt_scalef32_pk_fp8_bf16(hi, __builtin_bit_cast(bf16x2_t, q3), PEER_SX, true);
                bx[ks] = mk64(__builtin_bit_cast(unsigned, lo), __builtin_bit_cast(unsigned, hi)); }
            if (more) { tok += NWAVES; pair = *(const unsigned*)(EIDX + tok * 128 + 2 * lane);
#pragma unroll
                for (int ks = 0; ks < 4; ++ks) xr[ks] = *(const v4u*)(XG + tok * DM + slice * 128 + ks * 32 + kq * 8); }
#pragma unroll
            for (int it = 0; it < 16; ++it) *(LAS v4u*)(tile + it * 1024 + lane * 16) = w[it];
            if (more) {
                we[2 * lane] = (int)(pair & 0xffffu); we[2 * lane + 1] = (int)(pair >> 16);
                LDS_WAIT();
#pragma unroll
                for (int it = 0; it < 16; ++it) w[it] = *(const v4u*)(us + (unsigned)(((unsigned)we[it * 8 + rg] << 7) + (unsigned)((it & 1) ? ch_o : ch_e)));
            } else LDS_WAIT();
            bf16* pp = PART + (ctok * 8 + slice) * 128;
            f32x4 acc[8];
#pragma unroll
            for (int hf = 0; hf < 2; ++hf) {
                v2u a[4][4];
#pragma unroll
                for (int T4 = 0; T4 < 4; ++T4)
#pragma unroll
                    for (int ks = 0; ks < 4; ++ks) a[T4][ks] = *(const LAS v2u*)(tile + (hf * 4 + T4) * 2048 + foff[ks]);
#pragma unroll
                for (int T4 = 0; T4 < 4; ++T4) acc[hf * 4 + T4] = (f32x4){0.f, 0.f, 0.f, 0.f};
#pragma unroll
                for (int ks = 0; ks < 4; ++ks)
#pragma unroll
                    for (int T4 = 0; T4 < 4; ++T4) acc[hf * 4 + T4] = __builtin_amdgcn_mfma_f32_16x16x32_fp8_fp8(mk64(a[T4][ks].x, a[T4][ks].y), bx[ks], acc[hf * 4 + T4], 0, 0, 0);
            }
            f32x4 val = acc[0];
#pragma unroll
            for (int T = 1; T < 8; ++T) val = ((m & 7) == T) ? acc[T] : val;
            if (m < 8) { v2u pw; pw.x = cvt_pk_bf16(val[0] * (1.0f / PEER_SX), val[1] * (1.0f / PEER_SX)); pw.y = cvt_pk_bf16(val[2] * (1.0f / PEER_SX), val[3] * (1.0f / PEER_SX)); *(v2u*)(pp + m * 16 + 4 * kq) = pw; }
            LDS_WAIT();
        }
    }
}

constexpr float PEER_CS = 64.0f;
__device__ __forceinline__ void peer_coef_phase(const Args& A, int lane, int wave, int vcu, int G) {
    const bf16* PART = (const bf16*)(A.ws + WS_PART); const float* GATE = (const float*)(A.ws + WS_GATE); const float* RSTD = (const float*)(A.ws + WS_RSTD);
    unsigned char* C8 = A.ws + WS_COEF;
    for (int tok = vcu * NWAVES + wave; tok < NTOK; tok += G * NWAVES) {
        const bf16* pp = PART + (size_t)tok * 1024 + 2 * lane;
        unsigned pw[8];
#pragma unroll
        for (int j = 0; j < 8; ++j) pw[j] = *(const unsigned*)(pp + j * 128);
        f32x2 d = (f32x2){bf_lo(pw[0]), bf_hi(pw[0])};
#pragma unroll
        for (int j = 1; j < 8; ++j) d += (f32x2){bf_lo(pw[j]), bf_hi(pw[j])};
        const float sc = RSTD[tok] * (1.0f / PEER_SU); const f32x2 gt = *(const f32x2*)(GATE + (size_t)tok * 128 + 2 * lane);
        f32x2 cf; cf.x = gt.x * gelu_tanh(d.x * sc) * (PEER_CS / PEER_SV); cf.y = gt.y * gelu_tanh(d.y * sc) * (PEER_CS / PEER_SV);
        const unsigned hi = (unsigned)__builtin_amdgcn_cvt_pk_fp8_f32(cf.x, cf.y, 0, false) & 0xffffu;
        const f32x2 bk = __builtin_amdgcn_cvt_pk_f32_fp8(hi, false);
        const unsigned lo = (unsigned)__builtin_amdgcn_cvt_pk_fp8_f32((cf.x - bk.x) * 16.0f, (cf.y - bk.y) * 16.0f, 0, false) & 0xffffu;
        *(unsigned short*)(C8 + (size_t)tok * 256 + 2 * lane) = (unsigned short)hi; *(unsigned short*)(C8 + (size_t)tok * 256 + 128 + 2 * lane) = (unsigned short)lo;
    }
}

typedef int v2i_t __attribute__((ext_vector_type(2)));
__device__ __forceinline__ void peer_v_phase(const Args& A, LAS unsigned char* lds, int tid, int lane, int wave, gu32* ctl) {
    const unsigned char* Vq = A.ws + WS_VB;
    const unsigned short* EIDX = (const unsigned short*)(A.ws + WS_EIDX); const unsigned char* C8 = A.ws + WS_COEF;
    float* X1 = A.out + O_Y; float* SS2 = (float*)(A.ws + WS_SS2); const bf16* XGv = (const bf16*)(A.ws + WS_A1);
    const int xcc = (int)(xb_xcc_id() & 7u), rg = lane >> 3, c8 = lane & 7, m = lane & 15, kq = lane >> 4;
    LAS int* we = (LAS int*)(lds + wave * 1024);
    LAS unsigned char* tile = lds + U_TILE0 + wave * U_TILEB;
    const int ch_e = ((c8 - (rg >> 1)) & 7) * 16, ch_o = ((c8 - 4 - (rg >> 1)) & 7) * 16;
    const int tr_r = (lane & 15) >> 1, tr_p = lane & 1, tr_rot = 4 * (kq & 1) + (tr_r >> 1);
    const int tbase = (8 * kq + tr_r) * 128 + 8 * tr_p;
    int toff[8];
#pragma unroll
    for (int j = 0; j < 8; ++j) toff[j] = tbase + ((j + tr_rot) & 7) * 16;
    int qs = 0, slice, item;
    while (peer_next_item(ctl + CW_QV, xcc, qs, slice, item, lds, tid)) {
        const unsigned char* vs = Vq + (size_t)slice * 16384 * 128;
        size_t tok = (size_t)(item * PEER_ITEM + wave);
        unsigned pair = *(const unsigned*)(EIDX + tok * 128 + 2 * lane);
        v2u cfr[4];
#pragma unroll
        for (int ks = 0; ks < 4; ++ks) cfr[ks] = *(const v2u*)(C8 + tok * 256 + (m & 1) * 128 + ks * 32 + kq * 8);
        const float rga = 1.0f / A.in[I_N2G][slice * 128 + lane], rgb = 1.0f / A.in[I_N2G][slice * 128 + 64 + lane];
        unsigned short xoa = XGv[tok * DM + slice * 128 + lane], xob = XGv[tok * DM + slice * 128 + 64 + lane];
        we[2 * lane] = (int)(pair & 0xffffu); we[2 * lane + 1] = (int)(pair >> 16);
        LDS_WAIT();
        v4u w[16];
#pragma unroll
        for (int it = 0; it < 16; ++it) w[it] = *(const v4u*)(vs + (unsigned)(((unsigned)we[it * 8 + rg] << 7) + (unsigned)((it & 1) ? ch_o : ch_e)));
        for (int tt = 0; tt < PEER_ITEM / NWAVES; ++tt) {
            const size_t ctok = tok; const bool more = tt + 1 < PEER_ITEM / NWAVES;
            i64_t af[4];
#pragma unroll
            for (int ks = 0; ks < 4; ++ks) af[ks] = mk64(cfr[ks].x, cfr[ks].y);
            const float xa = __uint_as_float((unsigned)xoa << 16) * rga, xb = __uint_as_float((unsigned)xob << 16) * rgb;
            if (more) { tok += NWAVES; pair = *(const unsigned*)(EIDX + tok * 128 + 2 * lane);
#pragma unroll
                for (int ks = 0; ks < 4; ++ks) cfr[ks] = *(const v2u*)(C8 + tok * 256 + (m & 1) * 128 + ks * 32 + kq * 8);
                xoa = XGv[tok * DM + slice * 128 + lane]; xob = XGv[tok * DM + slice * 128 + 64 + lane]; }
#pragma unroll
            for (int it = 0; it < 16; ++it) *(LAS v4u*)(tile + it * 1024 + lane * 16) = w[it];
            if (more) {
                we[2 * lane] = (int)(pair & 0xffffu); we[2 * lane + 1] = (int)(pair >> 16);
                LDS_WAIT();
#pragma unroll
                for (int it = 0; it < 16; ++it) w[it] = *(const v4u*)(vs + (unsigned)(((unsigned)we[it * 8 + rg] << 7) + (unsigned)((it & 1) ? ch_o : ch_e)));
            } else LDS_WAIT();
            f32x4 acc[8];
#pragma unroll
            for (int hf = 0; hf < 2; ++hf) {
                v2i_t b[4][4];
#pragma unroll
                for (int j4 = 0; j4 < 4; ++j4)
#pragma unroll
                    for (int ks = 0; ks < 4; ++ks) b[j4][ks] = __builtin_amdgcn_ds_read_tr8_b64_v2i32((LAS v2i_t*)(tile + ks * 4096 + toff[hf * 4 + j4]));
#pragma unroll
                for (int j4 = 0; j4 < 4; ++j4) acc[hf * 4 + j4] = (f32x4){0.f, 0.f, 0.f, 0.f};
#pragma unroll
                for (int ks = 0; ks < 4; ++ks)
#pragma unroll
                    for (int j4 = 0; j4 < 4; ++j4) acc[hf * 4 + j4] = __builtin_amdgcn_mfma_f32_16x16x32_fp8_fp8(af[ks], mk64((unsigned)b[j4][ks].x, (unsigned)b[j4][ks].y), acc[hf * 4 + j4], 0, 0, 0);
            }
            float h0 = acc[0][0], l0 = acc[0][1], h1 = acc[4][0], l1 = acc[4][1];
#pragma unroll
            for (int j = 1; j < 4; ++j) { const bool s = kq == j; h0 = s ? acc[j][0] : h0; l0 = s ? acc[j][1] : l0; h1 = s ? acc[4 + j][0] : h1; l1 = s ? acc[4 + j][1] : l1; }
            const float x2a = xa + (h0 + l0 * (1.0f / 16.0f)) * (1.0f / PEER_CS), x2b = xb + (h1 + l1 * (1.0f / 16.0f)) * (1.0f / PEER_CS);
            { bf16* xr_ = (bf16*)X1 + ctok * (2 * DM) + slice * 128 + lane;
              xr_[0] = (bf16)(cvt_pk_bf16(x2a, x2a) & 0xffffu); xr_[64] = (bf16)(cvt_pk_bf16(x2b, x2b) & 0xffffu); }
            float ss = sum16(x2a * x2a + x2b * x2b); ss += __shfl_xor(ss, 16); ss += __shfl_xor(ss, 32);
            if (lane == 0) SS2[ctok * 8 + slice] = ss;
            LDS_WAIT();
        }
    }
}

__device__ __forceinline__ void peer_final_phase(const Args& A, int lane, int wave, int vcu, int G) {
    float* X1 = A.out + O_Y; const float* SS2 = (const float*)(A.ws + WS_SS2); const float* gf = A.in[I_NFG] + lane * 16;
    const f32x4 g0 = *(const f32x4*)gf, g1 = *(const f32x4*)(gf + 4), g2 = *(const f32x4*)(gf + 8), g3 = *(const f32x4*)(gf + 12);
    for (int tok = vcu * NWAVES + wave; tok < NTOK; tok += G * NWAVES) {
        const f32x4 sa = *(const f32x4*)(SS2 + (size_t)tok * 8), sb = *(const f32x4*)(SS2 + (size_t)tok * 8 + 4);
        const float ss = ((sa[0] + sa[1]) + (sa[2] + sa[3])) + ((sb[0] + sb[1]) + (sb[2] + sb[3]));
        const float rf = 1.0f / sqrtf(ss * (1.f / DM) + 1e-6f);
        float* yr = X1 + (size_t)tok * DM + lane * 16;
        const v4u s0 = *(const v4u*)((const bf16*)(X1 + (size_t)tok * DM) + lane * 16), s1 = *(const v4u*)((const bf16*)(X1 + (size_t)tok * DM) + lane * 16 + 8);
        const f32x4 y0 = (f32x4){bf_lo(s0.x), bf_hi(s0.x), bf_lo(s0.y), bf_hi(s0.y)}, y1 = (f32x4){bf_lo(s0.z), bf_hi(s0.z), bf_lo(s0.w), bf_hi(s0.w)},
                    y2 = (f32x4){bf_lo(s1.x), bf_hi(s1.x), bf_lo(s1.y), bf_hi(s1.y)}, y3 = (f32x4){bf_lo(s1.z), bf_hi(s1.z), bf_lo(s1.w), bf_hi(s1.w)};
        *(f32x4*)yr = y0 * rf * g0; *(f32x4*)(yr + 4) = y1 * rf * g1; *(f32x4*)(yr + 8) = y2 * rf * g2; *(f32x4*)(yr + 12) = y3 * rf * g3;
    }
}

__device__ __forceinline__ void sg_partial(const bf16* Ap, int lda, const bf16* Bp, int ldb, LAS f32x4* red, int lane, int wave) {
    const int fr = lane & 15, fq = lane >> 4;
    bf16x8 a[2][4], b[4][4];
#pragma unroll
    for (int mi = 0; mi < 2; ++mi)
#pragma unroll
        for (int ks = 0; ks < 4; ++ks) a[mi][ks] = *(const bf16x8*)(Ap + (size_t)(16 * mi + fr) * lda + 32 * ks + 8 * fq);
#pragma unroll
    for (int nj = 0; nj < 4; ++nj)
#pragma unroll
        for (int ks = 0; ks < 4; ++ks) b[nj][ks] = *(const bf16x8*)(Bp + (size_t)(16 * nj + fr) * ldb + 32 * ks + 8 * fq);
    f32x4 acc[2][4];
#pragma unroll
    for (int mi = 0; mi < 2; ++mi)
#pragma unroll
        for (int nj = 0; nj < 4; ++nj) acc[mi][nj] = (f32x4){0.f, 0.f, 0.f, 0.f};
#pragma unroll
    for (int ks = 0; ks < 4; ++ks)
#pragma unroll
        for (int mi = 0; mi < 2; ++mi)
#pragma unroll
            for (int nj = 0; nj < 4; ++nj) acc[mi][nj] = __builtin_amdgcn_mfma_f32_16x16x32_bf16(b[nj][ks], a[mi][ks], acc[mi][nj], 0, 0, 0);
#pragma unroll
    for (int mi = 0; mi < 2; ++mi)
#pragma unroll
        for (int nj = 0; nj < 4; ++nj) red[(wave * 8 + mi * 4 + nj) * 64 + lane] = acc[mi][nj];
}
__device__ __forceinline__ f32x4 sg_sum(const LAS f32x4* red, int w0, int nw, int wave, int lane) {
    f32x4 s = red[(w0 * 8 + wave) * 64 + lane];
    for (int w = 1; w < nw; ++w) s += red[((w0 + w) * 8 + wave) * 64 + lane];
    return s;
}
__device__ __forceinline__ void sample_gemm2(const Args& A, LAS unsigned char* lds, int t, int lane, int wave) {
    unsigned char* ws = A.ws; const int fr = lane & 15, fq = lane >> 4;
    const int row0 = NPROMPT + (t >> 4) * 32, col0 = (t & 15) * 64;
    LAS f32x4* red = (LAS f32x4*)lds;
    const bf16* Ab = (const bf16*)(ws + WS_A1) + (wave >= 4 ? (size_t)MPAD * 512 : 0); const bf16* Bb = (const bf16*)(ws + (wave >= 4 ? WS_WPB : WS_WPA));
    sg_partial(Ab + (size_t)row0 * 512 + (wave & 3) * 128, 512, Bb + (size_t)col0 * 512 + (wave & 3) * 128, 512, red, lane, wave);
    const int row = row0 + 16 * (wave >> 2) + fr, c = col0 + 16 * (wave & 3) + 4 * fq;
    const bf16* Zg = (const bf16*)(ws + WS_ZG) + (size_t)row * 2048;
    const v2u ga = *(const v2u*)(Zg + c), gb = *(const v2u*)(Zg + 1024 + c);
    __syncthreads();
    const f32x4 pa = sg_sum(red, 0, 4, wave, lane), pb = sg_sum(red, 4, 4, wave, lane);
    const float o0 = sigm(bf_lo(ga.x)) * pa[0] + sigm(bf_lo(gb.x)) * pb[0], o1 = sigm(bf_hi(ga.x)) * pa[1] + sigm(bf_hi(gb.x)) * pb[1],
                o2 = sigm(bf_lo(ga.y)) * pa[2] + sigm(bf_lo(gb.y)) * pb[2], o3 = sigm(bf_hi(ga.y)) * pa[3] + sigm(bf_hi(gb.y)) * pb[3];
    v2u w; w.x = cvt_pk_bf16(o0, o1); w.y = cvt_pk_bf16(o2, o3); *(v2u*)((bf16*)(ws + WS_ZR) + (size_t)row * 1024 + c) = w;
    __syncthreads();
}
__device__ __forceinline__ void sample_gemm3(const Args& A, LAS unsigned char* lds, int t, int tid, int lane, int wave) {
    unsigned char* ws = A.ws; const int fr = lane & 15, fq = lane >> 4;
    const int row0 = NPROMPT + (t >> 4) * 32, col0 = (t & 15) * 64;
    LAS f32x4* red = (LAS f32x4*)lds; LAS float* ssl = (LAS float*)(lds + 65536);
    sg_partial((const bf16*)(ws + WS_ZR) + (size_t)row0 * 1024 + wave * 128, 1024, (const bf16*)(ws + WS_WO) + (size_t)col0 * 1024 + wave * 128, 1024, red, lane, wave);
    const int row = row0 + 16 * (wave >> 2) + fr, c = col0 + 16 * (wave & 3) + 4 * fq;
    const f32x4 xv = *(const f32x4*)(A.in[I_XS] + (size_t)(row - NPROMPT) * 1024 + c), q = *(const f32x4*)(A.in[I_N2G] + c);
    __syncthreads();
    const f32x4 o = xv + sg_sum(red, 0, 8, wave, lane);
    float ss = (o[0] * o[0] + o[1] * o[1]) + (o[2] * o[2] + o[3] * o[3]);
    v2u w; w.x = cvt_pk_bf16(o[0] * q[0], o[1] * q[1]); w.y = cvt_pk_bf16(o[2] * q[2], o[3] * q[3]); *(v2u*)((bf16*)(ws + WS_A1) + (size_t)row * 1024 + c) = w;
    ss += __shfl_xor(ss, 16); ss += __shfl_xor(ss, 32);
    if (fq == 0) ssl[wave * 16 + fr] = ss;
    __syncthreads();
    if (tid < 32) { const int mi = tid >> 4, r = tid & 15;
        ((float*)(ws + WS_SSP))[(size_t)(row0 + tid) * 16 + (t & 15)] = (ssl[(mi * 4 + 0) * 16 + r] + ssl[(mi * 4 + 1) * 16 + r]) + (ssl[(mi * 4 + 2) * 16 + r] + ssl[(mi * 4 + 3) * 16 + r]); }
}
__device__ __forceinline__ void sample_gemm4(const Args& A, LAS unsigned char* lds, int t, int lane, int wave) {
    unsigned char* ws = A.ws; const int fr = lane & 15, fq = lane >> 4;
    const int row0 = NPROMPT + (t >> 5) * 32, col0 = (t & 31) * 64;
    LAS f32x4* red = (LAS f32x4*)lds;
    sg_partial((const bf16*)(ws + WS_A1) + (size_t)row0 * 1024 + wave * 128, 1024, (const bf16*)(ws + WS_WQ) + (size_t)col0 * 1024 + wave * 128, 1024, red, lane, wave);
    const int row = row0 + 16 * (wave >> 2) + fr, c = col0 + 16 * (wave & 3) + 4 * fq;
    __syncthreads();
    const f32x4 o = sg_sum(red, 0, 8, wave, lane);
    v2u w; w.x = cvt_pk_bf16(o[0], o[1]); w.y = cvt_pk_bf16(o[2], o[3]); *(v2u*)((bf16*)(ws + WS_ZG) + (size_t)row * 2048 + c) = w;
    __syncthreads();
}

__global__ void __launch_bounds__(NTHR, 2) mk_fwd(Args args) {
    extern __shared__ __attribute__((aligned(16))) unsigned char lds_raw[];
    LAS unsigned char* lds = (LAS unsigned char*)lds_raw;
    const int tid = threadIdx.x, lane = tid & 63, wave = __builtin_amdgcn_readfirstlane(tid >> 6);
    const int G = gridDim.x; const int bx = blockIdx.x; const int vcu = (G % 8 == 0) ? (bx % 8) * (G / 8) + bx / 8 : bx;
    gu32* ctl = (gu32*)(args.ws + WS_CTL);
    volatile LAS unsigned* MISC = (volatile LAS unsigned*)(lds + MISC_OFF);
    for (int u = tid; u < (LDS_BYTES - LDSCTL_OFF) / 4; u += NTHR) ((LAS unsigned*)(lds + LDSCTL_OFF))[u] = 0u;
    __syncthreads();
    XcdBarrier bar; bar.bar = (unsigned*)(ctl + CW_BAR) + args.li * XCD_BAR_WORDS; bar.x = 0; bar.st = nullptr;
    if (N_LAUNCHES != PER_PHASE) bar = xcd_barrier_post((unsigned*)(ctl + CW_BAR) + args.li * XCD_BAR_WORDS, MISC + 8);
    const int lo = args.ph_lo, hi = args.ph_hi;
#define IN(k) (lo <= (k) && (k) < hi)
#define BOTH(k) (IN(k) && IN((k) + 1))
#define GRID_BAR() do { if (N_LAUNCHES != PER_PHASE) xcd_barrier(bar); } while (0)
    unsigned char* ws = args.ws;
    bf16* A1 = (bf16*)(ws + WS_A1);

    if (IN(0)) for (int rep_ = 0; rep_ < ((MK_REPEAT == 0) ? 2 : 1); ++rep_) { p0_prologue(args, lds, tid, lane, wave, vcu, G); if (BOTH(0)) GRID_BAR(); }

    if (IN(1)) for (int rep_ = 0; rep_ < ((MK_REPEAT == 1) ? 2 : 1); ++rep_) {
        pg8::Gemm g{A1, (const bf16*)(ws + WS_W1T), MPAD, N1, DM}; pg8::StaticOrder S; S.init(MPAD, N1, G, bx);
        pg8::EpiZ E{(bf16*)(ws + WS_ZC), (bf16*)(ws + WS_ZR), (bf16*)(ws + WS_ZG)};
        pg8::gemm_phase<pg8::EpiZ, pg8::StaticOrder, true, true>(lds, g, S, E);
        if (BOTH(1)) GRID_BAR();
    }

    if (IN(2)) for (int rep_ = 0; rep_ < ((MK_REPEAT == 2) ? 2 : 1); ++rep_) { conv_phase(args, vcu * NTHR + tid, G * NTHR); if (BOTH(2)) GRID_BAR(); }

    if (IN(3)) for (int rep_ = 0; rep_ < ((MK_REPEAT == 3) ? 2 : 1); ++rep_) {
        scan_pass1(args, lds, tid, lane, wave, vcu, G, (MK_REPEAT == 3 && rep_ == 0) ? 1 : 0);
        if (BOTH(3)) GRID_BAR();
    }

    if (IN(4)) {
        for (int u = vcu; u < 512; u += G) {
            if (u < 256) { const int bh = u >> 2, vq = u & 3; scan_pass2_rows(nullptr, bh * 64, 64, vq * 16, args.out + O_WKV_P + (size_t)bh * 4096, true, args, lds, tid, lane, wave); }
            else { const int bh = u - 256;
                for (int vq = 0; vq < 4; ++vq) scan_pass2_rows(args.in[I_SWKV] + (size_t)bh * 4096, NUNITS_P + bh, 1, vq * 16, args.out + O_WKV_S + (size_t)bh * 4096, false, args, lds, tid, lane, wave); }
        }
        if (BOTH(4)) GRID_BAR();
    }

    if (IN(5)) for (int rep_ = 0; rep_ < ((MK_REPEAT == 5) ? 2 : 1); ++rep_) {
        for (int u2 = vcu; u2 < NUNITS / 2; u2 += G) scan_pass3_wave(args, u2 * 2 + (wave >> 2), wave & 3, lane);
        if (BOTH(5)) GRID_BAR();
    }

    if (IN(6)) {
        { pg8::Gemm g{A1, (const bf16*)(ws + WS_WPA), NPROMPT, DM, 512}; pg8::StaticOrder S; S.init(NPROMPT, DM, G, bx);
          pg8::EpiGate<0> E{(const bf16*)(ws + WS_ZG), (bf16*)(ws + WS_ZR)};
          pg8::gemm_phase<pg8::EpiGate<0>, pg8::StaticOrder, true, true>(lds, g, S, E); }
        { pg8::Gemm g{A1 + (size_t)MPAD * 512, (const bf16*)(ws + WS_WPB), NPROMPT, DM, 512}; pg8::StaticOrder S; S.init(NPROMPT, DM, G, bx);
          pg8::EpiGate<1> E{(const bf16*)(ws + WS_ZG), (bf16*)(ws + WS_ZR)};
          pg8::gemm_phase<pg8::EpiGate<1>, pg8::StaticOrder, true, true>(lds, g, S, E); }
        for (int t = vcu; t < 256; t += G) sample_gemm2(args, lds, t, lane, wave);
        if (BOTH(6)) GRID_BAR();
    }

    if (IN(7)) for (int rep_ = 0; rep_ < ((MK_REPEAT == 7) ? 2 : 1); ++rep_) {
        pg8::Gemm g{(const bf16*)(ws + WS_ZR), (const bf16*)(ws + WS_WO), NPROMPT, DM, DM}; pg8::StaticOrder S; S.init(NPROMPT, DM, G, bx);
        pg8::EpiX1 E{args.in[I_XP], args.in[I_XS], args.out + O_Y, A1, (float*)(ws + WS_SSP), args.in[I_N2G], NPROMPT, NTOK};
        pg8::gemm_phase<pg8::EpiX1, pg8::StaticOrder, true, true>(lds, g, S, E);
        for (int t = vcu; t < 256; t += G) sample_gemm3(args, lds, t, tid, lane, wave);
        if (BOTH(7)) GRID_BAR();
    }

    if (IN(8)) for (int rep_ = 0; rep_ < ((MK_REPEAT == 8) ? 2 : 1); ++rep_) {
        pg8::Gemm g{A1, (const bf16*)(ws + WS_WQ), NPROMPT, 2048, DM}; pg8::StaticOrder S; S.init(NPROMPT, 2048, G, bx);
        pg8::EpiPlain E{(bf16*)(ws + WS_ZG), 2048};
        pg8::gemm_phase<pg8::EpiPlain, pg8::StaticOrder, true, true>(lds, g, S, E);
        for (int t = vcu; t < 512; t += G) sample_gemm4(args, lds, t, lane, wave);
        if (BOTH(8)) GRID_BAR();
    }

    if (IN(9)) for (int rep_ = 0; rep_ < ((MK_REPEAT == 9) ? 2 : 1); ++rep_) { peer_topk_phase(args, lds, tid, lane, wave, vcu, G); if (BOTH(9)) GRID_BAR(); }
    if (IN(10)) for (int rep_ = 0; rep_ < ((MK_REPEAT == 10) ? 2 : 1); ++rep_) { if (rep_ == 0) peer_topk_sample_prelude(args, lds, tid, lane, wave, vcu, G, ctl); peer_u_phase(args, lds, tid, lane, wave, ctl, rep_ * 1024); if (BOTH(10)) GRID_BAR(); }
    if (IN(11)) { peer_coef_phase(args, lane, wave, vcu, G); if (BOTH(11)) GRID_BAR(); }
    if (IN(12)) { peer_v_phase(args, lds, tid, lane, wave, ctl); if (BOTH(12)) GRID_BAR(); }
    if (IN(13)) peer_final_phase(args, lane, wave, vcu, G);
#undef IN
#undef BOTH
#undef GRID_BAR
}

extern "C" void kernel_launch(void* const* d_in, const int* in_sizes, int n_in, void* d_out, int out_size, void* d_ws, size_t ws_size, hipStream_t stream) {
    static int grid = 0;
    if (grid == 0) {
        if (n_in != 32 || ws_size < WS_END) { fprintf(stderr, "kernel_launch: built for 32 inputs and >= %zu bytes of workspace; got n_in %d ws %zu; nothing launched\n", (size_t)WS_END, n_in, ws_size); grid = -1; return; }
        int dev = 0, cus = 0, per_cu = 0;
        if (hipGetDevice(&dev) != hipSuccess || hipDeviceGetAttribute(&cus, hipDeviceAttributeMultiprocessorCount, dev) != hipSuccess) { fprintf(stderr, "kernel_launch: device query failed\n"); grid = -1; return; }
        if (hipFuncSetAttribute((const void*)mk_fwd, hipFuncAttributeMaxDynamicSharedMemorySize, LDS_BYTES) != hipSuccess) { fprintf(stderr, "kernel_launch: hipFuncSetAttribute failed\n"); grid = -1; return; }
        if (hipOccupancyMaxActiveBlocksPerMultiprocessor(&per_cu, (const void*)mk_fwd, NTHR, LDS_BYTES) != hipSuccess || per_cu < 1)
            fprintf(stderr, "kernel_launch: note: occupancy query reports %d workgroups per CU\n", per_cu);
        (void)hipGetLastError();
        grid = cus;
    }
    if (grid < 0) return;
    if (hipMemsetAsync((char*)d_ws + WS_CTL, 0, CTL_ZERO_BYTES, stream) != hipSuccess) { fprintf(stderr, "kernel_launch: hipMemsetAsync failed\n"); return; }
    Args a{};
    for (int i = 0; i < 32; ++i) a.in[i] = (const float*)d_in[i];
    a.out = (float*)d_out; a.ws = (unsigned char*)d_ws;
    constexpr int NL = (N_LAUNCHES == PER_PHASE ? PER_PHASE : 1) + ((MK_EXTRA_LO >= 0) ? 1 : 0);
    for (int li = 0; li < NL; ++li) {
        if (N_LAUNCHES == PER_PHASE) { a.ph_lo = li; a.ph_hi = li + 1; } else { a.ph_lo = 0; a.ph_hi = PER_PHASE; }
        if (MK_EXTRA_LO >= 0 && li == NL - 1) { a.ph_lo = MK_EXTRA_LO; a.ph_hi = MK_EXTRA_HI; }
        a.li = li;
        hipLaunchKernelGGL(mk_fwd, dim3(grid), dim3(NTHR), LDS_BYTES, stream, a);
        const hipError_t le = hipPeekAtLastError();
        if (le != hipSuccess) { fprintf(stderr, "kernel_launch: launch %d failed: %s\n", li, hipGetErrorName(le)); break; }
    }
}
```

```cpp
#include <hip/hip_runtime.h>
#include <cstdio>
#include <cstdint>
#define MK_N_LAUNCHES 1
#define MK_REPEAT -1
#define MK_DBGSEL 0
#define MK_EXTRA_LO -1
#define MK_EXTRA_HI -1
namespace pg8 {
#define PG8_LAS __attribute__((address_space(3)))
typedef unsigned short bf16_t;
typedef short bf16x8 __attribute__((ext_vector_type(8)));
typedef float f32x4 __attribute__((ext_vector_type(4)));
typedef unsigned u32x4 __attribute__((ext_vector_type(4)));
constexpr int BM = 256, BK = 64, HALF = 128, HTB = HALF * BK * 2  , STAGE_BYTES = 8 * HTB, NXCD = 8, WGM = 8;

__host__ __device__ __forceinline__ int lds_byte(int r, int c) { const int st = (r >> 4) * 2 + (c >> 5), rr = r & 15, cc = c & 31, ob = rr * 64 + cc * 2; return st * 1024 + (ob ^ (((ob >> 9) & 1) << 5)); }
__host__ __device__ __forceinline__ void stage_rc(int b, int& R, int& C) { const int st = b / 1024, sb = b % 1024, swz = sb ^ (((sb >> 9) & 1) << 5); R = (st >> 1) * 16 + swz / 64; C = (st & 1) * 32 + (swz % 64) / 2; }
__host__ __device__ __forceinline__ int perm32(int rho) { const int n = rho >> 4, i = rho & 15; return 8 * (i >> 2) + 4 * n + (i & 3); }

struct Unit { int pm, pn; };
struct Gemm { const bf16_t* A; const bf16_t* Bt; int M, N, K; };

struct StaticOrder {
    int nM, nN, nwg, G, c;
    __host__ __device__ void init(int M, int N, int G_, int c_) { nM = M / BM; nN = N / BM; nwg = nM * nN; G = G_; c = c_; }
    __host__ __device__ bool next(int i, Unit& u) const {
        const long L = (long)i * G + c; if (L >= nwg) return false;
        int wgid = (int)L; { const int q = nwg / NXCD, r = nwg % NXCD, xcd = wgid % NXCD, off = wgid / NXCD; wgid = (xcd < r ? xcd * (q + 1) : r * (q + 1) + (xcd - r) * q) + off; }
        const int nig = WGM * nN, gid = wgid / nig, fm = gid * WGM, gsz = (nM - fm) < WGM ? (nM - fm) : WGM;
        u.pm = fm + ((wgid % nig) % gsz); u.pn = (wgid % nig) / gsz; return true;
    }
    __device__ __forceinline__ void a_ready(const Unit&) const {}
    __device__ __forceinline__ void done(const Unit&) const {}
};

typedef __bf16 bf16x2_cv __attribute__((ext_vector_type(2))); typedef float f32x2_cv __attribute__((ext_vector_type(2)));
__device__ __forceinline__ unsigned cvt_pk_bf16(float lo, float hi) { return __builtin_bit_cast(unsigned, __builtin_convertvector((f32x2_cv){lo, hi}, bf16x2_cv)); }
__device__ __forceinline__ float bf_lo(unsigned w) { return __uint_as_float(w << 16); }
__device__ __forceinline__ float bf_hi(unsigned w) { return __uint_as_float(w & 0xffff0000u); }
__device__ __forceinline__ float sigm(float x) { return __builtin_amdgcn_rcpf(1.0f + __expf(-x)); }

struct EpiZ {
    static constexpr bool PERM = true, AFTER_DRAIN = false;
    bf16_t *Zc, *Zr, *Zg;
    __device__ __forceinline__ void operator()(const f32x4 (&acc)[2][2][4][2], const Unit& u, int wr, int wc, int fr, int fq) const {
        bf16_t* base; int ldc, colt;
        if (u.pn < 6) { base = Zc; ldc = 1536; colt = u.pn * BM; }
        else if (u.pn < 14) { base = Zr; ldc = 2048; colt = (u.pn - 6) * BM; }
        else { base = Zg; ldc = 2048; colt = (u.pn - 14) * BM; }
        const int row0 = u.pm * BM + wr * 64 + fr, col0 = colt + wc * 32 + 8 * fq;
#pragma unroll
        for (int ai = 0; ai < 2; ++ai)
#pragma unroll
            for (int m = 0; m < 4; ++m) { bf16_t* rowp = base + (size_t)(row0 + ai * HALF + m * 16) * ldc + col0;
#pragma unroll
                for (int bj = 0; bj < 2; ++bj) { const f32x4 v0 = acc[ai][bj][m][0], v1 = acc[ai][bj][m][1];
                    u32x4 w; w.x = cvt_pk_bf16(v0[0], v0[1]); w.y = cvt_pk_bf16(v0[2], v0[3]); w.z = cvt_pk_bf16(v1[0], v1[1]); w.w = cvt_pk_bf16(v1[2], v1[3]);
                    *(u32x4*)(rowp + bj * HALF) = w; } }
    }
};
struct EpiPlain {
    static constexpr bool PERM = true, AFTER_DRAIN = false;
    bf16_t* O; int ldc;
    __device__ __forceinline__ void operator()(const f32x4 (&acc)[2][2][4][2], const Unit& u, int wr, int wc, int fr, int fq) const {
        const int row0 = u.pm * BM + wr * 64 + fr, col0 = u.pn * BM + wc * 32 + 8 * fq;
#pragma unroll
        for (int ai = 0; ai < 2; ++ai)
#pragma unroll
            for (int m = 0; m < 4; ++m) { bf16_t* rowp = O + (size_t)(row0 + ai * HALF + m * 16) * ldc + col0;
#pragma unroll
                for (int bj = 0; bj < 2; ++bj) { const f32x4 v0 = acc[ai][bj][m][0], v1 = acc[ai][bj][m][1];
                    u32x4 w; w.x = cvt_pk_bf16(v0[0], v0[1]); w.y = cvt_pk_bf16(v0[2], v0[3]); w.z = cvt_pk_bf16(v1[0], v1[1]); w.w = cvt_pk_bf16(v1[2], v1[3]);
                    *(u32x4*)(rowp + bj * HALF) = w; } }
    }
};
template <int SECOND> struct EpiGate {
    static constexpr bool PERM = true, AFTER_DRAIN = false;
    const bf16_t* Zg; bf16_t* MG;
    __device__ __forceinline__ void operator()(const f32x4 (&acc)[2][2][4][2], const Unit& u, int wr, int wc, int fr, int fq) const {
        const int row0 = u.pm * BM + wr * 64 + fr, col0 = u.pn * BM + wc * 32 + 8 * fq;
#pragma unroll
        for (int ai = 0; ai < 2; ++ai) {
            u32x4 gw[4][2], pw[4][2];
#pragma unroll
            for (int m = 0; m < 4; ++m) { const int r = row0 + ai * HALF + m * 16;
#pragma unroll
                for (int bj = 0; bj < 2; ++bj) { gw[m][bj] = *(const u32x4*)(Zg + (size_t)r * 2048 + SECOND * 1024 + col0 + bj * HALF);
                    if (SECOND) pw[m][bj] = *(const u32x4*)(MG + (size_t)r * 1024 + col0 + bj * HALF); } }
#pragma unroll
            for (int m = 0; m < 4; ++m) { const int r = row0 + ai * HALF + m * 16; bf16_t* op = MG + (size_t)r * 1024 + col0;
#pragma unroll
                for (int bj = 0; bj < 2; ++bj) { const u32x4 g = gw[m][bj]; f32x4 v0 = acc[ai][bj][m][0], v1 = acc[ai][bj][m][1];
                    v0[0] *= sigm(bf_lo(g.x)); v0[1] *= sigm(bf_hi(g.x)); v0[2] *= sigm(bf_lo(g.y)); v0[3] *= sigm(bf_hi(g.y));
                    v1[0] *= sigm(bf_lo(g.z)); v1[1] *= sigm(bf_hi(g.z)); v1[2] *= sigm(bf_lo(g.w)); v1[3] *= sigm(bf_hi(g.w));
                    if (SECOND) { const u32x4 p = pw[m][bj];
                        v0[0] += bf_lo(p.x); v0[1] += bf_hi(p.x); v0[2] += bf_lo(p.y); v0[3] += bf_hi(p.y);
                        v1[0] += bf_lo(p.z); v1[1] += bf_hi(p.z); v1[2] += bf_lo(p.w); v1[3] += bf_hi(p.w); }
                    u32x4 w; w.x = cvt_pk_bf16(v0[0], v0[1]); w.y = cvt_pk_bf16(v0[2], v0[3]); w.z = cvt_pk_bf16(v1[0], v1[1]); w.w = cvt_pk_bf16(v1[2], v1[3]);
                    *(u32x4*)(op + bj * HALF) = w; } }
        }
    }
};
struct EpiX1 {
    static constexpr bool PERM = false, AFTER_DRAIN = false;
    const float* xp; const float* xs; float* X1; bf16_t* X1B; float* SSP; const float* g2; int nprompt, nrows;
    __device__ __forceinline__ void operator()(const f32x4 (&acc)[2][2][4][2], const Unit& u, int wr, int wc, int fr, int fq) const {
        typedef unsigned u32x2v __attribute__((ext_vector_type(2)));
        const int col0 = u.pn * BM + wc * 32 + 4 * fq;
        f32x4 gq[2][2];
#pragma unroll
        for (int bj = 0; bj < 2; ++bj)
#pragma unroll
            for (int n = 0; n < 2; ++n) gq[bj][n] = *(const f32x4*)(g2 + col0 + bj * HALF + n * 16);
#pragma unroll
        for (int ai = 0; ai < 2; ++ai) {
            f32x4 xv[4][2][2];
#pragma unroll
            for (int m = 0; m < 4; ++m) { int r = u.pm * BM + ai * HALF + wr * 64 + m * 16 + fr; r = r < nrows ? r : nrows - 1;
                const float* xr = r < nprompt ? xp + (size_t)r * 1024 : xs + (size_t)(r - nprompt) * 1024;
#pragma unroll
                for (int bj = 0; bj < 2; ++bj)
#pragma unroll
                    for (int n = 0; n < 2; ++n) xv[m][bj][n] = *(const f32x4*)(xr + col0 + bj * HALF + n * 16); }
#pragma unroll
            for (int m = 0; m < 4; ++m) { const int r = u.pm * BM + ai * HALF + wr * 64 + m * 16 + fr; float ss = 0.f;
#pragma unroll
                for (int bj = 0; bj < 2; ++bj)
#pragma unroll
                    for (int n = 0; n < 2; ++n) { const int c = col0 + bj * HALF + n * 16; const f32x4 o = xv[m][bj][n] + acc[ai][bj][m][n];
                        ss += (o[0] * o[0] + o[1] * o[1]) + (o[2] * o[2] + o[3] * o[3]);
                        const f32x4 q = gq[bj][n]; u32x2v w; w.x = cvt_pk_bf16(o[0] * q[0], o[1] * q[1]); w.y = cvt_pk_bf16(o[2] * q[2], o[3] * q[3]);
                        if (r < nrows) *(u32x2v*)(X1B + (size_t)r * 1024 + c) = w; }
                ss += __shfl_xor(ss, 16); ss += __shfl_xor(ss, 32);
                if (fq == 0 && r < nrows) SSP[(size_t)r * 16 + u.pn * 4 + wc] = ss;
            }
        }
    }
};
template <class Epi, class Sched, bool ALIGN_EPI = false, bool SP2 = false>
__device__ __forceinline__ void gemm_phase(PG8_LAS unsigned char* lds, const Gemm g, const Sched& S, const Epi& E) {
    const int tid = threadIdx.x, wid = __builtin_amdgcn_readfirstlane(tid >> 6), lane = tid & 63, wr = wid >> 2, wc = wid & 3, fr = lane & 15, fq = lane >> 4;
    const int K = g.K, nt = K / BK;
    unsigned voffA[2], voffB[2];
#pragma unroll
    for (int i = 0; i < 2; ++i) { int R, C; stage_rc(tid * 16 + i * 8192, R, C); const int Rb = Epi::PERM ? ((R & ~31) + perm32(R & 31)) : R;
        voffA[i] = (unsigned)(R * K + C) * 2u; voffB[i] = (unsigned)(Rb * K + C) * 2u; }
    const size_t kstep = (size_t)(BK * 2);
    const size_t hstep = (size_t)HALF * K * 2;
    const size_t tstep = 2 * hstep;
    const unsigned ldsw = (unsigned)wid * 1024u;
    const int aoff = lds_byte(wr * 64 + fr, fq * 8), boff = lds_byte(wc * 32 + fr, fq * 8);
#define PG8_SA(b, h) (((b) * 2 + (h)) * HTB)
#define PG8_SB(b, h) ((4 + (b) * 2 + (h)) * HTB)
#define PG8_STAGE(bufoff, gbase, voff) do { _Pragma("unroll") for (int _i = 0; _i < 2; ++_i) \
        __builtin_amdgcn_global_load_lds((const unsigned*)((const char*)(gbase) + (voff)[_i]), (PG8_LAS unsigned*)(lds + (bufoff) + ldsw + _i * 8192), 16, 0, 0); } while (0)
#define PG8_LDA(dst, b, h) do { _Pragma("unroll") for (int m = 0; m < 4; ++m) _Pragma("unroll") for (int k = 0; k < 2; ++k) dst[m][k] = *(const PG8_LAS bf16x8*)(lds + PG8_SA(b, h) + aoff + m * 2048 + k * 1024); } while (0)
#define PG8_LDB(dst, b, h) do { _Pragma("unroll") for (int n = 0; n < 2; ++n) _Pragma("unroll") for (int k = 0; k < 2; ++k) dst[n][k] = *(const PG8_LAS bf16x8*)(lds + PG8_SB(b, h) + boff + n * 2048 + k * 1024); } while (0)
#define PG8_MMA(ai, bj, At, Bt) do { __builtin_amdgcn_s_setprio(1); _Pragma("unroll") for (int m = 0; m < 4; ++m) _Pragma("unroll") for (int n = 0; n < 2; ++n) _Pragma("unroll") for (int k = 0; k < 2; ++k) \
        acc[ai][bj][m][n] = __builtin_amdgcn_mfma_f32_16x16x32_bf16(Bt[n][k], At[m][k], acc[ai][bj][m][n], 0, 0, 0); __builtin_amdgcn_s_setprio(0); } while (0)
#define PG8_WAIT_V(n) asm volatile("s_waitcnt vmcnt(" #n ")" ::: "memory")
#define PG8_WAIT_L(n) asm volatile("s_waitcnt lgkmcnt(" #n ")" ::: "memory")
#define PG8_BAR __builtin_amdgcn_s_barrier()
#define PG8_SCHED __builtin_amdgcn_sched_barrier(0)
    Unit cur, nxt; int ui = 0;
    if (!S.next(0, cur)) return;
    f32x4 acc[2][2][4][2];
#pragma unroll
    for (int a = 0; a < 2; ++a)
#pragma unroll
        for (int b = 0; b < 2; ++b)
#pragma unroll
            for (int m = 0; m < 4; ++m)
#pragma unroll
                for (int n = 0; n < 2; ++n) acc[a][b][m][n] = (f32x4){0.f, 0.f, 0.f, 0.f};
    bf16x8 At[4][2], B0[2][2], B1[2][2];
    const char* cA = (const char*)g.A + (size_t)cur.pm * tstep; const char* cB = (const char*)g.Bt + (size_t)cur.pn * tstep;
    S.a_ready(cur);
    if constexpr (SP2) {
        PG8_STAGE(PG8_SB(0, 0), cB, voffB); PG8_STAGE(PG8_SB(0, 1), cB + hstep, voffB); PG8_STAGE(PG8_SA(0, 0), cA, voffA); PG8_STAGE(PG8_SA(0, 1), cA + hstep, voffA);
        if (wr == 1) PG8_BAR;
        PG8_WAIT_V(2); PG8_BAR;
        PG8_STAGE(PG8_SB(1, 0), cB + kstep, voffB); PG8_STAGE(PG8_SA(1, 0), cA + kstep, voffA); PG8_STAGE(PG8_SB(1, 1), cB + hstep + kstep, voffB);
        PG8_WAIT_V(6); PG8_BAR;
    } else {
        PG8_STAGE(PG8_SB(0, 0), cB, voffB); PG8_STAGE(PG8_SA(0, 0), cA, voffA); PG8_STAGE(PG8_SB(0, 1), cB + hstep, voffB); PG8_STAGE(PG8_SA(0, 1), cA + hstep, voffA);
        if (wr == 1) PG8_BAR;
        PG8_WAIT_V(4); PG8_BAR;
        PG8_STAGE(PG8_SB(1, 0), cB + kstep, voffB); PG8_STAGE(PG8_SA(1, 0), cA + kstep, voffA); PG8_STAGE(PG8_SB(1, 1), cB + hstep + kstep, voffB);
        PG8_WAIT_V(6); PG8_BAR;
    }
    for (;;) {
        const bool has_next = S.next(ui + 1, nxt);
        const char* nA = has_next ? (const char*)g.A + (size_t)nxt.pm * tstep : cA; const char* nB = has_next ? (const char*)g.Bt + (size_t)nxt.pn * tstep : cB;
        for (int t = 0; t < nt; t += 2) {
            const bool last = (t == nt - 2);
            const char* a1 = cA + (size_t)(t + 1) * kstep;
            const char* a2 = last ? nA : cA + (size_t)(t + 2) * kstep; const char* b2 = last ? nB : cB + (size_t)(t + 2) * kstep;
            const char* a3 = a2 + kstep; const char* b3 = b2 + kstep;
            if (last && has_next) S.a_ready(nxt);
            if constexpr (SP2) {
            PG8_LDB(B0, 0, 0); PG8_LDB(B1, 0, 1); PG8_SCHED; PG8_LDA(At, 0, 0); PG8_STAGE(PG8_SA(1, 1), a1 + hstep, voffA);
            PG8_WAIT_V(8); PG8_WAIT_L(0); PG8_BAR; PG8_MMA(0, 0, At, B0); PG8_MMA(0, 1, At, B1); PG8_BAR; PG8_SCHED;
            PG8_LDA(At, 0, 1); PG8_STAGE(PG8_SB(0, 0), b2, voffB); PG8_STAGE(PG8_SB(0, 1), b2 + hstep, voffB); PG8_STAGE(PG8_SA(0, 0), a2, voffA);
            PG8_WAIT_V(8); PG8_WAIT_L(0); PG8_BAR; PG8_MMA(1, 0, At, B0); PG8_MMA(1, 1, At, B1); PG8_BAR; PG8_SCHED;
            PG8_LDB(B0, 1, 0); PG8_LDB(B1, 1, 1); PG8_SCHED; PG8_LDA(At, 1, 0); PG8_STAGE(PG8_SA(0, 1), a2 + hstep, voffA);
            PG8_WAIT_V(8); PG8_WAIT_L(0); PG8_BAR; PG8_MMA(0, 0, At, B0); PG8_MMA(0, 1, At, B1); PG8_BAR; PG8_SCHED;
            PG8_LDA(At, 1, 1); PG8_STAGE(PG8_SB(1, 0), b3, voffB); PG8_STAGE(PG8_SB(1, 1), b3 + hstep, voffB); PG8_STAGE(PG8_SA(1, 0), a3, voffA);
            PG8_WAIT_V(8); PG8_WAIT_L(0); PG8_BAR; PG8_MMA(1, 0, At, B0); PG8_MMA(1, 1, At, B1); PG8_BAR; PG8_SCHED;
            } else {
            PG8_LDB(B0, 0, 0); PG8_SCHED; PG8_LDA(At, 0, 0); PG8_STAGE(PG8_SA(1, 1), a1 + hstep, voffA);
            PG8_WAIT_L(8); PG8_BAR; PG8_WAIT_L(0); PG8_MMA(0, 0, At, B0); PG8_BAR; PG8_SCHED;
            PG8_LDB(B1, 0, 1); PG8_STAGE(PG8_SB(0, 0), b2, voffB);
            PG8_BAR; PG8_WAIT_L(0); PG8_MMA(0, 1, At, B1); PG8_BAR;
            PG8_LDA(At, 0, 1); PG8_STAGE(PG8_SA(0, 0), a2, voffA);
            PG8_BAR; PG8_WAIT_L(0); PG8_MMA(1, 0, At, B0); PG8_BAR; PG8_SCHED;
            PG8_STAGE(PG8_SB(0, 1), b2 + hstep, voffB);
            PG8_WAIT_V(6); PG8_BAR; PG8_MMA(1, 1, At, B1); PG8_BAR;
            PG8_LDB(B0, 1, 0); PG8_SCHED; PG8_LDA(At, 1, 0); PG8_STAGE(PG8_SA(0, 1), a2 + hstep, voffA);
            PG8_WAIT_L(8); PG8_BAR; PG8_WAIT_L(0); PG8_MMA(0, 0, At, B0); PG8_BAR; PG8_SCHED;
            PG8_LDB(B1, 1, 1); PG8_STAGE(PG8_SB(1, 0), b3, voffB);
            PG8_BAR; PG8_WAIT_L(0); PG8_MMA(0, 1, At, B1); PG8_BAR;
            PG8_LDA(At, 1, 1); PG8_STAGE(PG8_SA(1, 0), a3, voffA);
            PG8_BAR; PG8_WAIT_L(0); PG8_MMA(1, 0, At, B0); PG8_BAR; PG8_SCHED;
            PG8_STAGE(PG8_SB(1, 1), b3 + hstep, voffB);
            PG8_WAIT_V(6); PG8_BAR; PG8_MMA(1, 1, At, B1); PG8_BAR;
            }
        }
        if constexpr (ALIGN_EPI) { if (wr == 0) PG8_BAR; }
        if constexpr (!Epi::AFTER_DRAIN) { E(acc, cur, wr, wc, fr, fq); S.done(cur); }
        if (!has_next) break;
#pragma unroll
        for (int a = 0; a < 2; ++a)
#pragma unroll
            for (int b = 0; b < 2; ++b)
#pragma unroll
                for (int m = 0; m < 4; ++m)
#pragma unroll
                    for (int n = 0; n < 2; ++n) acc[a][b][m][n] = (f32x4){0.f, 0.f, 0.f, 0.f};
        cur = nxt; cA = nA; cB = nB; ++ui;
        if constexpr (ALIGN_EPI) { if (wr == 1) PG8_BAR; }
    }
    PG8_WAIT_V(0);
    if constexpr (!ALIGN_EPI) { if (wr == 0) PG8_BAR; }
    PG8_BAR;
    if constexpr (Epi::AFTER_DRAIN) { E.fused(acc, cur, wr, wc, fr, fq, lds, wid, lane); S.done(cur); }
#undef PG8_SA
#undef PG8_SB
#undef PG8_STAGE
#undef PG8_LDA
#undef PG8_LDB
#undef PG8_MMA
#undef PG8_WAIT_V
#undef PG8_WAIT_L
#undef PG8_BAR
#undef PG8_SCHED
}
}
constexpr int NWAVES = 8, NTHR = 512;
#ifndef MK_N_LAUNCHES
#define MK_N_LAUNCHES 1
#endif
constexpr int PER_PHASE = 14;
constexpr int N_LAUNCHES = MK_N_LAUNCHES;

constexpr int DM = 1024, NPROMPT = 32768, NSAMP = 512, NTOK = 33280, NSHIFT = 32, MPAD = 33536, N1 = 5632;
constexpr int SEQ_P = 4096, SEQ_S = 16, NB_P = 8, NB_S = 32;
constexpr size_t O_Y = 0, O_CONV_P = 34078720, O_SHIFT_P = 34086912, O_WKV_P = 34095104, O_CONV_S = 34357248, O_SHIFT_S = 34390016, O_WKV_S = 34422784;
constexpr size_t KiB = 1024, MiB = 1u << 20;
constexpr size_t WS_CTL = 0, CTL_ZERO_BYTES = 64 * KiB;
constexpr size_t WS_W1T = 64 * KiB;
constexpr size_t WS_WPA = WS_W1T + (size_t)N1 * DM * 2;
constexpr size_t WS_WPB = WS_WPA + 1 * MiB;
constexpr size_t WS_WO = WS_WPB + 1 * MiB;
constexpr size_t WS_WQ = WS_WO + 2 * MiB;
constexpr size_t WS_KEYS = WS_WQ + 4 * MiB;
constexpr size_t WS_L2T = WS_KEYS + 512 * KiB;
constexpr size_t WS_SSP = WS_L2T + 256 * KiB;
constexpr size_t WS_UB = WS_SSP + (size_t)MPAD * 16 * 4;
constexpr size_t WS_VB = WS_UB + 16 * MiB;
constexpr size_t WS_A1 = WS_VB + 16 * MiB;
constexpr size_t WS_ZC = WS_A1 + (size_t)MPAD * DM * 2;
constexpr size_t WS_ZR = WS_ZC + (size_t)MPAD * 1536 * 2;
constexpr size_t WS_ZG = WS_ZR + (size_t)MPAD * 2048 * 2;
constexpr size_t WS_END = WS_ZG + (size_t)MPAD * 2048 * 2;
constexpr size_t WS_YL = WS_ZC, WS_ZT = WS_ZC + (size_t)NTOK * 512 * 2, WS_BV = WS_ZC + (size_t)NTOK * 512 * 4;
constexpr size_t WS_EIDX = WS_ZC, WS_GATE = WS_ZC + 16 * MiB, WS_COEF = WS_ZC + 40 * MiB, WS_SS2 = WS_ZC + 64 * MiB, WS_RSTD = WS_ZC + 66 * MiB;
constexpr size_t WS_PART = WS_ZR;
constexpr size_t OB_MB = (size_t)4352 * 4096 * 4;
static_assert(WS_BV + (size_t)NTOK * 512 * 2 <= WS_ZR && OB_MB + (size_t)4352 * 4096 * 2 <= (size_t)NTOK * 1024 * 4, "scan scratch maps");
static_assert(WS_END <= 512 * MiB, "d_ws map must fit 512 MiB");
constexpr float PEER_SU = 32.0f, PEER_SV = 4.0f;
constexpr int CW_BAR = 1024;
constexpr int LDS_BYTES = 163840;
constexpr int LDSCTL_OFF = LDS_BYTES - 512, MISC_OFF = LDSCTL_OFF + 320;

#define GAS __attribute__((address_space(1)))
#define LAS __attribute__((address_space(3)))
typedef unsigned short bf16;
typedef unsigned v4u __attribute__((ext_vector_type(4)));
typedef unsigned v2u __attribute__((ext_vector_type(2)));
typedef float f32x4 __attribute__((ext_vector_type(4)));
typedef short bf16x8 __attribute__((ext_vector_type(8)));
typedef __bf16 bf16x2_t __attribute__((ext_vector_type(2)));
typedef GAS unsigned gu32;
#define RLX_AGENT __ATOMIC_RELAXED, __HIP_MEMORY_SCOPE_AGENT
#define LDS_WAIT() asm volatile("s_waitcnt lgkmcnt(0)" ::: "memory")
#define VM_WAIT() asm volatile("s_waitcnt vmcnt(0)" ::: "memory")
using pg8::cvt_pk_bf16; using pg8::bf_lo; using pg8::bf_hi; using pg8::sigm;
#define XB_TMO      128
#define XB_XCNT(j)  (256  + 64 * (j))
#define XB_XSUB(j)  (1280 + 64 * (j))
#define XB_XGEN(j)  (2304 + 64 * (j))
#define XB_TOP      3328
#define XB_TOPGEN   3392
#define XCD_BAR_WORDS 3456
#define XB_SPIN_CAP (1u << 22)

__device__ __forceinline__ unsigned xb_ld(unsigned* p)              { return __hip_atomic_load(p, __ATOMIC_RELAXED, __HIP_MEMORY_SCOPE_AGENT); }
__device__ __forceinline__ unsigned xb_add(unsigned* p, unsigned v) { return __hip_atomic_fetch_add(p, v, __ATOMIC_RELAXED, __HIP_MEMORY_SCOPE_AGENT); }
__device__ __forceinline__ unsigned xb_xcc_id() { return (unsigned)__builtin_amdgcn_s_getreg((3 << 11) | 20) & 0xFu; }
#define XB_SPIN(cond, bar) do { unsigned _sp = 0; while (cond) { __builtin_amdgcn_s_sleep(1); \
    if ((++_sp & 255u) == 0u) { if (xb_ld(&(bar)[XB_TMO])) break; if (_sp > XB_SPIN_CAP) { atomicAdd(&(bar)[XB_TMO], 1u); break; } } } } while (0)

struct XcdBarrier {
    unsigned* bar; unsigned x;
    volatile LAS unsigned* st;
};

__device__ __forceinline__ XcdBarrier xcd_barrier_post(unsigned* bar, volatile LAS unsigned* st) {
    XcdBarrier b; b.bar = bar; b.x = xb_xcc_id(); b.st = st;
    if (threadIdx.x == 0) (void)xb_add(&bar[XB_XCNT(b.x)], 1u);
    return b;
}
__device__ __forceinline__ void xcd_barrier_complete(unsigned* bar, unsigned x, unsigned& nloc, unsigned& nx) {
    const unsigned G = gridDim.x * gridDim.y * gridDim.z;
    unsigned sum, cnt, mine, sp = 0u;
    for (;;) {
        sum = 0u; cnt = 0u; mine = 0u;
#pragma unroll
        for (unsigned j = 0; j < 16; ++j) { const unsigned c = xb_ld(&bar[XB_XCNT(j)]); sum += c; cnt += (c > 0u) ? 1u : 0u; mine = (j == x) ? c : mine; }
        if (sum == G) break;
        __builtin_amdgcn_s_sleep(1);
        if ((++sp & 255u) == 0u) { if (xb_ld(&bar[XB_TMO])) break; if (sp > XB_SPIN_CAP) { atomicAdd(&bar[XB_TMO], 1u); break; } }
    }
    nloc = mine > 0u ? mine : 1u; nx = cnt > 0u ? cnt : 1u;
}

__device__ __forceinline__ void xcd_barrier(const XcdBarrier& b) {
    asm volatile("s_waitcnt vmcnt(0)" ::: "memory");
    __syncthreads();
    if (threadIdx.x == 0) {
        unsigned* bar = b.bar;
        __builtin_amdgcn_s_waitcnt(0);
        unsigned nloc = b.st[0], nx = b.st[1];
        if (nloc == 0u) { xcd_barrier_complete(bar, b.x, nloc, nx); b.st[0] = nloc; b.st[1] = nx; }
        const unsigned old = xb_add(&bar[XB_XSUB(b.x)], 1u);
        const unsigned gen = old / nloc;
        if (old + 1u == (gen + 1u) * nloc) {
            __builtin_amdgcn_fence(__ATOMIC_RELEASE, "agent");
            asm volatile("s_waitcnt vmcnt(0)" ::: "memory");
            const unsigned og = xb_add(&bar[XB_TOP], 1u);
            const unsigned tg = og / nx;
            if (og + 1u == (tg + 1u) * nx) xb_add(&bar[XB_TOPGEN], 1u);
            else XB_SPIN(xb_ld(&bar[XB_TOPGEN]) == tg, bar);
            __builtin_amdgcn_fence(__ATOMIC_ACQUIRE, "agent");
            xb_add(&bar[XB_XGEN(b.x)], 1u);
            asm volatile("s_waitcnt vmcnt(0)" ::: "memory");
        } else {
            XB_SPIN(xb_ld(&bar[XB_XGEN(b.x)]) == gen, bar);
            __builtin_amdgcn_fence(__ATOMIC_ACQUIRE, "agent");
            asm volatile("s_waitcnt vmcnt(0)" ::: "memory");
        }
    }
    __syncthreads();
}
struct Args { const float* in[32]; float* out; unsigned char* ws; int ph_lo, ph_hi, li, pad; };
enum { I_XP = 0, I_XS, I_SCONV, I_SSHIFT, I_SWKV, I_N1G, I_WIN, I_CONVW, I_MURKV, I_MUWAG, I_W0, I_W1, I_W2, I_A0, I_A1, I_A2, I_G1, I_G2, I_KK, I_KA, I_RK, I_GNW, I_GNB, I_WPA, I_WPB, I_WO, I_N2G, I_WQ, I_KEYS, I_U, I_V, I_NFG };

__device__ __forceinline__ float wave_sum(float v) {
#pragma unroll
    for (int o = 1; o < 64; o <<= 1) v += __shfl_xor(v, o);
    return v;
}
template <int CTRL> __device__ __forceinline__ float dpp_mov(float v) { return __builtin_bit_cast(float, __builtin_amdgcn_update_dpp(0, __builtin_bit_cast(int, v), CTRL, 0xF, 0xF, true)); }
__device__ __forceinline__ float sum4(float v) { v += dpp_mov<0xB1>(v); v += dpp_mov<0x4E>(v); return v; }
__device__ __forceinline__ float sum8(float v) { v = sum4(v); v += dpp_mov<0x141>(v); return v; }
__device__ __forceinline__ float sum16(float v) { v = sum8(v); v += dpp_mov<0x140>(v); return v; }
__device__ __forceinline__ float dot2bf(unsigned w, unsigned x, float acc) { return __builtin_amdgcn_fdot2_f32_bf16(__builtin_bit_cast(bf16x2_t, w), __builtin_bit_cast(bf16x2_t, x), acc, false); }

__device__ __forceinline__ void transpose_item(const float* W, int ldw, int c0, int K, bf16* WT, int nblk, int item, const float* sv, float alpha, float beta, LAS float* scr, int lane) {
    const int kb = item / nblk, nb = item % nblk, k0 = 64 * kb, n0 = 32 * nb;
#pragma unroll 8
    for (int i = 0; i < 32; ++i) { const int kk = 2 * i + (lane >> 5); float s = 1.f; if (sv) s = alpha + beta * sv[k0 + kk];
        scr[kk * 33 + (lane & 31)] = W[(size_t)(k0 + kk) * ldw + c0 + n0 + (lane & 31)] * s; }
    LDS_WAIT();
    const int c = lane & 7;
#pragma unroll
    for (int j = 0; j < 4; ++j) { const int n = (lane >> 3) + 8 * j; const LAS float* s = scr + (8 * c) * 33 + n;
        v4u o; o.x = cvt_pk_bf16(s[0 * 33], s[1 * 33]); o.y = cvt_pk_bf16(s[2 * 33], s[3 * 33]); o.z = cvt_pk_bf16(s[4 * 33], s[5 * 33]); o.w = cvt_pk_bf16(s[6 * 33], s[7 * 33]);
        *(v4u*)(WT + (size_t)(n0 + n) * K + k0 + 8 * c) = o; }
    LDS_WAIT();
}
__device__ __forceinline__ void cvt_stream(const float* src, bf16* dst, size_t n, size_t gt, size_t nthreads) {
    for (size_t i = gt * 8; i < n; i += nthreads * 8) { const f32x4 a = *(const f32x4*)(src + i), b = *(const f32x4*)(src + i + 4);
        v4u o; o.x = cvt_pk_bf16(a[0], a[1]); o.y = cvt_pk_bf16(a[2], a[3]); o.z = cvt_pk_bf16(b[0], b[1]); o.w = cvt_pk_bf16(b[2], b[3]); *(v4u*)(dst + i) = o; }
}
__device__ __forceinline__ void cvt_stream_fp8(const float* src, unsigned char* dst, size_t n, float scale, size_t gt, size_t nthreads) {
    for (size_t i = gt * 16; i < n; i += nthreads * 16) {
        const f32x4 a = *(const f32x4*)(src + i) * scale, b = *(const f32x4*)(src + i + 4) * scale, c = *(const f32x4*)(src + i + 8) * scale, d = *(const f32x4*)(src + i + 12) * scale;
        v4u o; unsigned p;
        p = __builtin_amdgcn_cvt_pk_fp8_f32(a[0], a[1], 0, false); o.x = __builtin_amdgcn_cvt_pk_fp8_f32(a[2], a[3], p, true);
        p = __builtin_amdgcn_cvt_pk_fp8_f32(b[0], b[1], 0, false); o.y = __builtin_amdgcn_cvt_pk_fp8_f32(b[2], b[3], p, true);
        p = __builtin_amdgcn_cvt_pk_fp8_f32(c[0], c[1], 0, false); o.z = __builtin_amdgcn_cvt_pk_fp8_f32(c[2], c[3], p, true);
        p = __builtin_amdgcn_cvt_pk_fp8_f32(d[0], d[1], 0, false); o.w = __builtin_amdgcn_cvt_pk_fp8_f32(d[2], d[3], p, true);
        *(v4u*)(dst + i) = o; }
}
__device__ __forceinline__ void cvt16_fp8_sliced(const float* src, unsigned char* dst, float scale, size_t i) {
    const f32x4 a = *(const f32x4*)(src + i) * scale, b = *(const f32x4*)(src + i + 4) * scale, c = *(const f32x4*)(src + i + 8) * scale, d = *(const f32x4*)(src + i + 12) * scale;
    v4u o; unsigned p;
    p = __builtin_amdgcn_cvt_pk_fp8_f32(a[0], a[1], 0, false); o.x = __builtin_amdgcn_cvt_pk_fp8_f32(a[2], a[3], p, true);
    p = __builtin_amdgcn_cvt_pk_fp8_f32(b[0], b[1], 0, false); o.y = __builtin_amdgcn_cvt_pk_fp8_f32(b[2], b[3], p, true);
    p = __builtin_amdgcn_cvt_pk_fp8_f32(c[0], c[1], 0, false); o.z = __builtin_amdgcn_cvt_pk_fp8_f32(c[2], c[3], p, true);
    p = __builtin_amdgcn_cvt_pk_fp8_f32(d[0], d[1], 0, false); o.w = __builtin_amdgcn_cvt_pk_fp8_f32(d[2], d[3], p, true);
    const size_t e = i >> 10, col = i & 1023;
    *(v4u*)(dst + (col >> 7) * ((size_t)16384 * 128) + e * 128 + (col & 127)) = o;
}
__device__ __forceinline__ void cvt_stream_fp8_sliced(const float* src, unsigned char* dst, float scale, size_t gt, size_t nthreads) {
#pragma unroll 2
    for (size_t i = gt * 16; i < (size_t)16384 * 1024; i += nthreads * 16) {
        const f32x4 a = *(const f32x4*)(src + i) * scale, b = *(const f32x4*)(src + i + 4) * scale, c = *(const f32x4*)(src + i + 8) * scale, d = *(const f32x4*)(src + i + 12) * scale;
        v4u o; unsigned p;
        p = __builtin_amdgcn_cvt_pk_fp8_f32(a[0], a[1], 0, false); o.x = __builtin_amdgcn_cvt_pk_fp8_f32(a[2], a[3], p, true);
        p = __builtin_amdgcn_cvt_pk_fp8_f32(b[0], b[1], 0, false); o.y = __builtin_amdgcn_cvt_pk_fp8_f32(b[2], b[3], p, true);
        p = __builtin_amdgcn_cvt_pk_fp8_f32(c[0], c[1], 0, false); o.z = __builtin_amdgcn_cvt_pk_fp8_f32(c[2], c[3], p, true);
        p = __builtin_amdgcn_cvt_pk_fp8_f32(d[0], d[1], 0, false); o.w = __builtin_amdgcn_cvt_pk_fp8_f32(d[2], d[3], p, true);
        const size_t e = i >> 10, col = i & 1023;
        *(v4u*)(dst + (col >> 7) * ((size_t)16384 * 128) + e * 128 + (col & 127)) = o; }
}
__device__ __forceinline__ void p0_prologue(const Args& A, LAS unsigned char* lds, int tid, int lane, int wave, int vcu, int G) {
    unsigned char* ws = A.ws;
    bf16* W1T = (bf16*)(ws + WS_W1T);
    LAS float* scr = (LAS float*)(lds + wave * 16384);
    const int gw = vcu * NWAVES + wave, NGW = G * NWAVES;
    constexpr int J0 = 16 * 96, J1 = 16 * 64, JL = 16 * 2, JG = 16 * 4, JP = 8 * 32, JO = 16 * 32, JQ = 16 * 64;
    constexpr int JW2 = 16, JG2 = 32;
    constexpr int NITEMS = J0 + J1 + 4 * JL + 2 * JG + 2 * JP + JO + JQ + 2 * JW2 + JG2;
    bf16* L2T = (bf16*)(ws + WS_L2T);
    const float* mu = A.in[I_MUWAG];
    for (int it = gw; it < NITEMS; it += NGW) {
        int r = it;
        if (r < J0) { transpose_item(A.in[I_WIN], 5120, 0, 1024, W1T, 96, r, nullptr, 0.f, 0.f, scr, lane); continue; } r -= J0;
        if (r < J1) { transpose_item(A.in[I_WIN], 5120, 3072, 1024, W1T + (size_t)3584 * 1024, 64, r, nullptr, 0.f, 0.f, scr, lane); continue; } r -= J1;
        if (r < JL) { transpose_item(A.in[I_W1], 64, 0, 1024, W1T + (size_t)3072 * 1024, 2, r, mu, 1.f, -1.f, scr, lane); continue; } r -= JL;
        if (r < JL) { transpose_item(A.in[I_W1], 64, 0, 1024, W1T + (size_t)3328 * 1024, 2, r, mu, 0.f, 1.f, scr, lane); continue; } r -= JL;
        if (r < JL) { transpose_item(A.in[I_A1], 64, 0, 1024, W1T + (size_t)(3072 + 64) * 1024, 2, r, mu + 1024, 1.f, -1.f, scr, lane); continue; } r -= JL;
        if (r < JL) { transpose_item(A.in[I_A1], 64, 0, 1024, W1T + (size_t)(3328 + 64) * 1024, 2, r, mu + 1024, 0.f, 1.f, scr, lane); continue; } r -= JL;
        if (r < JG) { transpose_item(A.in[I_G1], 128, 0, 1024, W1T + (size_t)(3072 + 128) * 1024, 4, r, mu + 2048, 1.f, -1.f, scr, lane); continue; } r -= JG;
        if (r < JG) { transpose_item(A.in[I_G1], 128, 0, 1024, W1T + (size_t)(3328 + 128) * 1024, 4, r, mu + 2048, 0.f, 1.f, scr, lane); continue; } r -= JG;
        if (r < JP) { transpose_item(A.in[I_WPA], 1024, 0, 512, (bf16*)(ws + WS_WPA), 32, r, nullptr, 0.f, 0.f, scr, lane); continue; } r -= JP;
        if (r < JP) { transpose_item(A.in[I_WPB], 1024, 0, 512, (bf16*)(ws + WS_WPB), 32, r, nullptr, 0.f, 0.f, scr, lane); continue; } r -= JP;
        if (r < JO) { transpose_item(A.in[I_WO], 1024, 0, 1024, (bf16*)(ws + WS_WO), 32, r, nullptr, 0.f, 0.f, scr, lane); continue; } r -= JO;
        if (r < JQ) { transpose_item(A.in[I_WQ], 2048, 0, 1024, (bf16*)(ws + WS_WQ), 64, r, nullptr, 0.f, 0.f, scr, lane); continue; } r -= JQ;
        if (r < JW2) { transpose_item(A.in[I_W2], 512, 0, 64, L2T, 16, r, nullptr, 0.f, 0.f, scr, lane); continue; } r -= JW2;
        if (r < JW2) { transpose_item(A.in[I_A2], 512, 0, 64, L2T + (size_t)512 * 64, 16, r, nullptr, 0.f, 0.f, scr, lane); continue; } r -= JW2;
        transpose_item(A.in[I_G2], 512, 0, 128, L2T + (size_t)1024 * 64, 16, r, nullptr, 0.f, 0.f, scr, lane);
    }
    const size_t gt = (size_t)vcu * NTHR + tid, nth = (size_t)G * NTHR;
    if (G != 256) {
        cvt_stream_fp8_sliced(A.in[I_U], ws + WS_UB, PEER_SU, gt, nth);
        cvt_stream_fp8_sliced(A.in[I_V], ws + WS_VB, PEER_SV, gt, nth); }
    cvt_stream(A.in[I_KEYS], (bf16*)(ws + WS_KEYS), (size_t)8 * 2 * 128 * 128, gt, nth);
    bf16* A1 = (bf16*)(ws + WS_A1);
    const f32x4* g1v = (const f32x4*)A.in[I_N1G] + lane;
    for (int m0 = gw; m0 < NTOK; m0 += 2 * NGW) {
        const int m1 = m0 + NGW; const bool two = m1 < NTOK; const int m1c = two ? m1 : m0;
        const f32x4* xr0 = (const f32x4*)(m0 < NPROMPT ? A.in[I_XP] + (size_t)m0 * DM : A.in[I_XS] + (size_t)(m0 - NPROMPT) * DM) + lane;
        const f32x4* xr1 = (const f32x4*)(m1c < NPROMPT ? A.in[I_XP] + (size_t)m1c * DM : A.in[I_XS] + (size_t)(m1c - NPROMPT) * DM) + lane;
        f32x4 v0[4], v1[4]; float s0 = 0.f, s1 = 0.f;
#pragma unroll
        for (int j = 0; j < 4; ++j) { v0[j] = xr0[64 * j]; v1[j] = xr1[64 * j]; }
#pragma unroll
        for (int j = 0; j < 4; ++j) { s0 += (v0[j][0] * v0[j][0] + v0[j][1] * v0[j][1]) + (v0[j][2] * v0[j][2] + v0[j][3] * v0[j][3]);
                                      s1 += (v1[j][0] * v1[j][0] + v1[j][1] * v1[j][1]) + (v1[j][2] * v1[j][2] + v1[j][3] * v1[j][3]); }
#pragma unroll
        for (int o = 1; o < 64; o <<= 1) { s0 += __shfl_xor(s0, o); s1 += __shfl_xor(s1, o); }
        const float r0 = 1.0f / sqrtf(s0 * (1.f / DM) + 1e-6f), r1 = 1.0f / sqrtf(s1 * (1.f / DM) + 1e-6f);
#pragma unroll
        for (int rr = 0; rr < 2; ++rr) {
            if (rr == 1 && !two) break;
            const int m = rr ? m1 : m0; const float rstd = rr ? r1 : r0;
            v2u* o8 = (v2u*)(A1 + (size_t)m * DM) + lane;
            float* so = nullptr;
            if (m < NPROMPT) { if ((m & (SEQ_P - 1)) == SEQ_P - 1) so = A.out + O_SHIFT_P + (size_t)(m / SEQ_P) * DM; }
            else { const int ms = m - NPROMPT; if ((ms & (SEQ_S - 1)) == SEQ_S - 1) so = A.out + O_SHIFT_S + (size_t)(ms / SEQ_S) * DM; }
#pragma unroll
            for (int j = 0; j < 4; ++j) { const f32x4 g = g1v[64 * j]; const f32x4 y = (rr ? v1[j] : v0[j]) * rstd * g;
                v2u w; w.x = cvt_pk_bf16(y[0], y[1]); w.y = cvt_pk_bf16(y[2], y[3]); o8[64 * j] = w;
                if (so) ((f32x4*)so)[lane + 64 * j] = y; }
        }
    }
    for (int m = NTOK + gw; m < MPAD; m += NGW) {
        v2u* o8 = (v2u*)(A1 + (size_t)m * DM) + lane;
        if (m < NTOK + NSHIFT) {
            const f32x4* xr = (const f32x4*)(A.in[I_SSHIFT] + (size_t)(m - NTOK) * DM) + lane;
#pragma unroll
            for (int j = 0; j < 4; ++j) { const f32x4 y = xr[64 * j]; v2u w; w.x = cvt_pk_bf16(y[0], y[1]); w.y = cvt_pk_bf16(y[2], y[3]); o8[64 * j] = w; }
        } else {
#pragma unroll
            for (int j = 0; j < 4; ++j) { v2u w; w.x = 0u; w.y = 0u; o8[64 * j] = w; }
        }
    }
}

__device__ __forceinline__ void unpack8(const v4u w, float (&f)[8]) { f[0] = bf_lo(w.x); f[1] = bf_hi(w.x); f[2] = bf_lo(w.y); f[3] = bf_hi(w.y); f[4] = bf_lo(w.z); f[5] = bf_hi(w.z); f[6] = bf_lo(w.w); f[7] = bf_hi(w.w); }
__device__ __forceinline__ void conv_phase(const Args& A, int gt, int nth) {
    const bf16* Zc = (const bf16*)(A.ws + WS_ZC); bf16* YA = (bf16*)(A.ws + WS_A1);
    const float* cw = A.in[I_CONVW];
    for (int task = gt; task < (NTOK / 16) * 64; task += nth) {
        const int seg = task >> 6, ch = (task & 63) * 8, row0 = seg * 16;
        int b, t0, T; bool prompt = row0 < NPROMPT;
        if (prompt) { b = row0 / SEQ_P; t0 = row0 % SEQ_P; T = SEQ_P; } else { b = (row0 - NPROMPT) / SEQ_S; t0 = 0; T = SEQ_S; }
        float um2[8], um1[8], c0[8], c1[8], c2[8];
#pragma unroll
        for (int i = 0; i < 8; ++i) { c0[i] = cw[ch + i]; c1[i] = cw[512 + ch + i]; c2[i] = cw[1024 + ch + i]; }
        if (t0 == 0) {
            if (prompt) {
#pragma unroll
                for (int i = 0; i < 8; ++i) { um2[i] = 0.f; um1[i] = 0.f; }
            } else { const float* sc = A.in[I_SCONV] + (size_t)b * 2 * 512 + ch;
#pragma unroll
                for (int i = 0; i < 8; ++i) { um2[i] = sc[i]; um1[i] = sc[512 + i]; } }
        } else {
            float a[8], h[8];
            unpack8(*(const v4u*)(Zc + (size_t)(row0 - 2) * 1536 + 512 + ch), a); unpack8(*(const v4u*)(Zc + (size_t)(row0 - 2) * 1536 + 1024 + ch), h);
#pragma unroll
            for (int i = 0; i < 8; ++i) um2[i] = a[i] * h[i];
            unpack8(*(const v4u*)(Zc + (size_t)(row0 - 1) * 1536 + 512 + ch), a); unpack8(*(const v4u*)(Zc + (size_t)(row0 - 1) * 1536 + 1024 + ch), h);
#pragma unroll
            for (int i = 0; i < 8; ++i) um1[i] = a[i] * h[i];
        }
#pragma unroll 4
        for (int t = 0; t < 16; ++t) {
            const size_t row = (size_t)(row0 + t);
            float zb[8], zc[8], zh[8], y[8];
            unpack8(*(const v4u*)(Zc + row * 1536 + ch), zb); unpack8(*(const v4u*)(Zc + row * 1536 + 512 + ch), zc); unpack8(*(const v4u*)(Zc + row * 1536 + 1024 + ch), zh);
#pragma unroll
            for (int i = 0; i < 8; ++i) { const float u = zc[i] * zh[i]; y[i] = zb[i] * (c0[i] * um2[i] + c1[i] * um1[i] + c2[i] * u); um2[i] = um1[i]; um1[i] = u; }
            v4u o; o.x = cvt_pk_bf16(y[0], y[1]); o.y = cvt_pk_bf16(y[2], y[3]); o.z = cvt_pk_bf16(y[4], y[5]); o.w = cvt_pk_bf16(y[6], y[7]);
            *(v4u*)(YA + row * 512 + ch) = o;
        }
        if (t0 + 16 == T) { float* oc = A.out + (prompt ? O_CONV_P : O_CONV_S) + (size_t)b * 2 * 512 + ch;
#pragma unroll
            for (int i = 0; i < 8; ++i) { oc[i] = um2[i]; oc[512 + i] = um1[i]; } }
    }
    bf16* Zr = (bf16*)(A.ws + WS_ZR);
    for (int task = nth - 1 - gt; task < NTOK * 16; task += nth) {
        const int m = task >> 4, cs = task & 15;
        bool hasprev; int prow;
        if (m < NPROMPT) { hasprev = (m & (SEQ_P - 1)) != 0; prow = m - 1; } else { const int ms = m - NPROMPT; hasprev = true; prow = (ms & (SEQ_S - 1)) ? m - 1 : NTOK + ms / SEQ_S; }
        bf16* pap = Zr + (size_t)m * 2048 + 1536 + cs * 16;
        float pa[16], t8[8];
        const v4u a0 = *(const v4u*)pap, a1 = *(const v4u*)(pap + 8);
        v4u b0 = (v4u){0u, 0u, 0u, 0u}, b1 = b0;
        if (hasprev) { const bf16* pbp = Zr + (size_t)prow * 2048 + 1792 + cs * 16; b0 = *(const v4u*)pbp; b1 = *(const v4u*)(pbp + 8); }
        unpack8(a0, t8);
#pragma unroll
        for (int i = 0; i < 8; ++i) pa[i] = t8[i];
        unpack8(a1, t8);
#pragma unroll
        for (int i = 0; i < 8; ++i) pa[8 + i] = t8[i];
        unpack8(b0, t8);
#pragma unroll
        for (int i = 0; i < 8; ++i) pa[i] += t8[i];
        unpack8(b1, t8);
#pragma unroll
        for (int i = 0; i < 8; ++i) pa[8 + i] += t8[i];
#pragma unroll
        for (int i = 0; i < 16; ++i) { float p = pa[i];
            if (cs < 4) p = 1.0f - 2.0f * __builtin_amdgcn_rcpf(__expf(2.0f * p) + 1.0f);
            else if (cs >= 8) p = sigm(p);
            pa[i] = p; }
        v4u o0, o1; o0.x = cvt_pk_bf16(pa[0], pa[1]); o0.y = cvt_pk_bf16(pa[2], pa[3]); o0.z = cvt_pk_bf16(pa[4], pa[5]); o0.w = cvt_pk_bf16(pa[6], pa[7]);
        o1.x = cvt_pk_bf16(pa[8], pa[9]); o1.y = cvt_pk_bf16(pa[10], pa[11]); o1.z = cvt_pk_bf16(pa[12], pa[13]); o1.w = cvt_pk_bf16(pa[14], pa[15]);
        *(v4u*)pap = o0; *(v4u*)(pap + 8) = o1;
    }
}

constexpr int NUNITS_P = NB_P * 8 * 64, NUNITS = NUNITS_P + NB_S * 8;
constexpr int HID_STRIDE = 264, SC_TB = 32;
constexpr int P1_HIDB = 0, P1_LO = 16896, P1_SEQ = 41472, P1_GG = 90624, P1_YY = 98816, P1_ZZ = 107008, P1_BON = 115200;
typedef float f32x2 __attribute__((ext_vector_type(2)));

struct P1Pre { v4u pa0, pa1; v2u zr, zk, zv, pr, pk, pv; };
struct P1Pos { int unit, t0; };
__device__ __forceinline__ void p1_decode(int unit, bool& prompt, int& b, int& h, int& ch, int& T, int& rowbase) {
    prompt = unit < NUNITS_P; b = prompt ? unit >> 9 : (unit - NUNITS_P) >> 3; h = prompt ? (unit >> 6) & 7 : unit & 7; ch = prompt ? unit & 63 : 0;
    T = prompt ? 64 : SEQ_S; rowbase = prompt ? b * SEQ_P + ch * 64 : NPROMPT + b * SEQ_S;
}
__device__ __forceinline__ void p1_rows(int unit, int t0, int tt, size_t& row, size_t& prow, bool& hasprev, int& nb) {
    bool prompt; int b, h, ch, T, rowbase; p1_decode(unit, prompt, b, h, ch, T, rowbase);
    nb = (T - t0) < SC_TB ? (T - t0) : SC_TB;
    const int tloc = tt < nb ? tt : nb - 1, t = t0 + tloc; const bool first = (ch == 0);
    row = (size_t)(rowbase + t); hasprev = (t > 0) || !first || !prompt; prow = ((t > 0) || !first) ? row - 1 : (size_t)(NTOK + b);
}
__device__ __forceinline__ void p1_load(const Args& A, int unit, int t0, int tt, int cs, P1Pre& P) {
    size_t row, prow; bool hasprev; int nb; p1_rows(unit, t0, tt, row, prow, hasprev, nb);
    const int h = unit < NUNITS_P ? (unit >> 6) & 7 : unit & 7, hc = h * 64 + cs * 4;
    const bf16* Zr = (const bf16*)(A.ws + WS_ZR);
    P.pa0 = *(const v4u*)(Zr + row * 2048 + 1536 + cs * 16); P.pa1 = *(const v4u*)(Zr + row * 2048 + 1536 + cs * 16 + 8);
    P.zr = *(const v2u*)(Zr + row * 2048 + hc); P.zk = *(const v2u*)(Zr + row * 2048 + 512 + hc); P.zv = *(const v2u*)(Zr + row * 2048 + 1024 + hc);
    const v2u z2 = (v2u){0u, 0u};
    P.pr = z2; P.pk = z2; P.pv = z2;
    if (hasprev) { P.pr = *(const v2u*)(Zr + prow * 2048 + hc); P.pk = *(const v2u*)(Zr + prow * 2048 + 512 + hc); P.pv = *(const v2u*)(Zr + prow * 2048 + 1024 + hc); }
}
__device__ __forceinline__ bool p1_unit_at(int i, int vcu, int G, int& unit) {
    if (G == 256) { if (i > 16) return false; unit = i < 16 ? vcu * 16 + i : NUNITS_P + vcu; return true; }
    unit = vcu + i * G; return unit < NUNITS;
}

constexpr int WY_OS = 72, WY_TS = 24, WY_LS = 40;
constexpr int WY_AT = 0, WY_RT = WY_AT + 16 * WY_OS * 2, WY_BT = WY_RT + 16 * WY_OS * 2, WY_KT = WY_BT + 16 * WY_OS * 2, WY_BH = WY_KT + 16 * WY_OS * 2,
              WY_KH = WY_BH + 64 * WY_TS * 2, WY_VT = WY_KH + 64 * WY_TS * 2, WY_GC = WY_VT + 64 * WY_TS * 2, WY_BUF = WY_GC + 256;
constexpr int WY_BASE = 0;
constexpr int WY_LAB = WY_BASE + 2 * WY_BUF, WY_LAK = WY_LAB + 1024, WY_MC = WY_LAK + 16 * WY_LS * 2;
static_assert(WY_MC + 16 * WY_LS * 2 <= P1_SEQ, "UT-transform operands must fit over HIDB | LO");
constexpr int WY_XB = 115328, WY_RH = WY_XB + 128 * WY_OS * 2, WY_UT = WY_RH + 8 * 16 * 17 * 4, WY_END = WY_UT + 8 * 16 * WY_TS * 2;
static_assert(WY_END <= LDSCTL_OFF, "LDS map of pass 1");

constexpr int WY_G2 = P1_GG + 2048;
static_assert(WY_G2 + 1024 + 2 * 16 * WY_LS * 2 <= P1_YY, "second Gram set");
__device__ __forceinline__ void p1_wy(f32x4 (&X)[4], const LAS float* SEQ, LAS float* YY, LAS float* ZZ, LAS unsigned char* lds, int nb, int tid, int lane, int wave, int part = 0) {
    const bool pw = wave >= 4; const int nmc = nb >> 4;
    LAS bf16* Xb = (LAS bf16*)(lds + WY_XB); LAS float* RH = (LAS float*)(lds + WY_RH) + wave * 16 * 17; LAS bf16* UT = (LAS bf16*)(lds + WY_UT) + wave * 16 * WY_TS;
    const bf16x8 zero8 = (bf16x8){0, 0, 0, 0, 0, 0, 0, 0};
    for (int mc = 0; mc < nmc; ++mc) {
        asm volatile("" : "+v"(tid));
        LAS unsigned char* ob = lds + WY_BASE + mc * WY_BUF;
        LAS bf16* At = (LAS bf16*)(ob + WY_AT); LAS bf16* Rt = (LAS bf16*)(ob + WY_RT); LAS bf16* Bt = (LAS bf16*)(ob + WY_BT); LAS bf16* Kt = (LAS bf16*)(ob + WY_KT);
        LAS bf16* BhT = (LAS bf16*)(ob + WY_BH); LAS bf16* KhT = (LAS bf16*)(ob + WY_KH); LAS bf16* VT = (LAS bf16*)(ob + WY_VT); LAS float* GC = (LAS float*)(ob + WY_GC);
        const int tl = tid >> 5, c2 = (tid & 31) * 2, s0 = mc * 16;
        f32x2 cum = (f32x2){0.f, 0.f}, tot = cum, lwt = cum;
#pragma unroll
        for (int i = 0; i < 16; ++i) { const f32x2 l2 = *(const LAS f32x2*)(SEQ + (s0 + i) * 384 + 64 + c2); tot += l2; if (i <= tl) cum += l2; if (i == tl) lwt = l2; }
        const LAS float* sp = SEQ + (s0 + tl) * 384 + c2;
        const f32x2 a2 = *(const LAS f32x2*)(sp), b2 = *(const LAS f32x2*)(sp + 128), k2 = *(const LAS f32x2*)(sp + 192), r2 = *(const LAS f32x2*)(sp + 256), v2 = *(const LAS f32x2*)(sp + 320);
        const f32x2 gt = (f32x2){__expf(cum.x), __expf(cum.y)}, gp = (f32x2){__expf(cum.x - lwt.x), __expf(cum.y - lwt.y)}, gi = (f32x2){__expf(-cum.x), __expf(-cum.y)},
                    go = (f32x2){__expf(tot.x - cum.x), __expf(tot.y - cum.y)};
        *(LAS unsigned*)(At + tl * WY_OS + c2) = cvt_pk_bf16(a2.x * gp.x, a2.y * gp.y); *(LAS unsigned*)(Rt + tl * WY_OS + c2) = cvt_pk_bf16(r2.x * gt.x, r2.y * gt.y);
        *(LAS unsigned*)(Bt + tl * WY_OS + c2) = cvt_pk_bf16(b2.x * gi.x, b2.y * gi.y); *(LAS unsigned*)(Kt + tl * WY_OS + c2) = cvt_pk_bf16(k2.x * gi.x, k2.y * gi.y);
        const unsigned bh = cvt_pk_bf16(b2.x * go.x, b2.y * go.y), kh = cvt_pk_bf16(k2.x * go.x, k2.y * go.y), vv = cvt_pk_bf16(v2.x, v2.y);
        {
            const unsigned bh_o = (unsigned)__shfl_xor((int)bh, 32), kh_o = (unsigned)__shfl_xor((int)kh, 32), vv_o = (unsigned)__shfl_xor((int)vv, 32);
            const bool ev = (tl & 1) == 0; const int wo = (ev ? c2 : c2 + 1) * WY_TS + (tl & ~1);
            *(LAS unsigned*)(BhT + wo) = ev ? ((bh & 0xffffu) | (bh_o << 16)) : ((bh_o >> 16) | (bh & 0xffff0000u));
            *(LAS unsigned*)(KhT + wo) = ev ? ((kh & 0xffffu) | (kh_o << 16)) : ((kh_o >> 16) | (kh & 0xffff0000u));
            *(LAS unsigned*)(VT + wo) = ev ? ((vv & 0xffffu) | (vv_o << 16)) : ((vv_o >> 16) | (vv & 0xffff0000u)); }
        if (tl == 0) *(LAS f32x2*)(GC + c2) = (f32x2){__expf(tot.x), __expf(tot.y)};
    }
    __syncthreads();
    {
        asm volatile("" : "+v"(tid));
        const int fr = tid & 15, fq = (tid >> 4) & 3, g_ = wave & 3, m_ = wave >> 2;
        if (m_ < nmc) {
            LAS unsigned char* ob = lds + WY_BASE + m_ * WY_BUF; LAS unsigned char* gs = lds + (m_ ? WY_G2 : WY_LAB);
            LAS float* Lab = (LAS float*)gs; LAS bf16* Lak = (LAS bf16*)(gs + 1024); LAS bf16* Mc = (LAS bf16*)(gs + 1024 + 16 * WY_LS * 2);
            const LAS bf16* ab = (LAS bf16*)(ob + (g_ < 2 ? WY_AT : WY_RT)) + fr * WY_OS + fq * 8; const LAS bf16* bb = (LAS bf16*)(ob + ((g_ & 1) ? WY_KT : WY_BT)) + fr * WY_OS + fq * 8;
            f32x4 g = (f32x4){0.f, 0.f, 0.f, 0.f};
#pragma unroll
            for (int ks = 0; ks < 2; ++ks) g = __builtin_amdgcn_mfma_f32_16x16x32_bf16(*(const LAS bf16x8*)(bb + ks * 32), *(const LAS bf16x8*)(ab + ks * 32), g, 0, 0, 0);
#pragma unroll
            for (int rg = 0; rg < 4; ++rg) { const int tp = 4 * fq + rg; const bool keep = (g_ < 2) ? (fr > tp) : (fr >= tp); g[rg] = keep ? g[rg] : 0.f; }
            if (g_ == 0) *(LAS f32x4*)(Lab + fr * 16 + 4 * fq) = g;
            else { v2u w; w.x = cvt_pk_bf16(g[0], g[1]); w.y = cvt_pk_bf16(g[2], g[3]);
                if (g_ == 1) { *(LAS v2u*)(Lak + fr * WY_LS + 4 * fq) = w; *(LAS v2u*)(Lak + fr * WY_LS + 16 + 4 * fq) = (v2u){0u, 0u}; }
                else if (g_ == 2) *(LAS v2u*)(Mc + fr * WY_LS + 4 * fq) = w; else *(LAS v2u*)(Mc + fr * WY_LS + 16 + 4 * fq) = w; }
        }
    }
    __syncthreads();
    if (MK_DBGSEL == 2 && part) return;
    for (int mc = 0; mc < nmc; ++mc) {
        asm volatile("" : "+v"(tid));
        const int fr = tid & 15, fq = (tid >> 4) & 3;
        LAS unsigned char* ob = lds + WY_BASE + mc * WY_BUF; LAS unsigned char* gs = lds + (mc ? WY_G2 : WY_LAB);
        LAS bf16* At = (LAS bf16*)(ob + WY_AT); LAS bf16* Rt = (LAS bf16*)(ob + WY_RT);
        LAS bf16* BhT = (LAS bf16*)(ob + WY_BH); LAS bf16* KhT = (LAS bf16*)(ob + WY_KH); LAS bf16* VT = (LAS bf16*)(ob + WY_VT); LAS float* GC = (LAS float*)(ob + WY_GC);
        LAS float* Lab = (LAS float*)gs; LAS bf16* Lak = (LAS bf16*)(gs + 1024); LAS bf16* Mc = (LAS bf16*)(gs + 1024 + 16 * WY_LS * 2);
        f32x4 W1 = (f32x4){0.f, 0.f, 0.f, 0.f}, Y0 = W1;
        {
            const LAS bf16* xbp = Xb + (16 * wave + fr) * WY_OS + fq * 8;
#pragma unroll
            for (int ks = 0; ks < 2; ++ks) { const bf16x8 bx = *(const LAS bf16x8*)(xbp + ks * 32);
                W1 = __builtin_amdgcn_mfma_f32_16x16x32_bf16(*(const LAS bf16x8*)(At + fr * WY_OS + ks * 32 + fq * 8), bx, W1, 0, 0, 0);
                Y0 = __builtin_amdgcn_mfma_f32_16x16x32_bf16(*(const LAS bf16x8*)(Rt + fr * WY_OS + ks * 32 + fq * 8), bx, Y0, 0, 0, 0); }
        }
        if (!pw) { const bf16x8 la = *(const LAS bf16x8*)(Lak + fr * WY_LS + fq * 8); const bf16x8 vb0 = *(const LAS bf16x8*)(VT + (16 * wave + fr) * WY_TS + (fq & 1) * 8); const bf16x8 vb = fq < 2 ? vb0 : zero8;
            W1 = __builtin_amdgcn_mfma_f32_16x16x32_bf16(la, vb, W1, 0, 0, 0); }
#pragma unroll
        for (int rg = 0; rg < 4; ++rg) RH[(4 * fq + rg) * 17 + fr] = W1[rg];
        LDS_WAIT();
        {
            float u[16];
#pragma unroll
            for (int t = 0; t < 16; ++t) { if ((t & 3) == 0) asm volatile("" ::: "memory");
                float acc = RH[t * 17 + fr];
                if (!(MK_DBGSEL == 3 && part))
#pragma unroll
                for (int i4 = 0; i4 * 4 < t; ++i4) { const f32x4 l4 = *(const LAS f32x4*)(Lab + t * 16 + i4 * 4);
#pragma unroll
                    for (int e = 0; e < 4; ++e) if (i4 * 4 + e < t) acc += l4[e] * u[i4 * 4 + e]; }
                u[t] = acc; }
            if (fq == 0) { v4u o0, o1; o0.x = cvt_pk_bf16(u[0], u[1]); o0.y = cvt_pk_bf16(u[2], u[3]); o0.z = cvt_pk_bf16(u[4], u[5]); o0.w = cvt_pk_bf16(u[6], u[7]);
                o1.x = cvt_pk_bf16(u[8], u[9]); o1.y = cvt_pk_bf16(u[10], u[11]); o1.z = cvt_pk_bf16(u[12], u[13]); o1.w = cvt_pk_bf16(u[14], u[15]);
                *(LAS v4u*)(UT + fr * WY_TS) = o0; *(LAS v4u*)(UT + fr * WY_TS + 8) = o1; }
        }
        LDS_WAIT();
        {
            const bf16x8 uc = fq < 2 ? *(const LAS bf16x8*)(UT + fr * WY_TS + fq * 8) : (pw ? zero8 : *(const LAS bf16x8*)(VT + (16 * wave + fr) * WY_TS + (fq - 2) * 8));
            Y0 = __builtin_amdgcn_mfma_f32_16x16x32_bf16(*(const LAS bf16x8*)(Mc + fr * WY_LS + fq * 8), uc, Y0, 0, 0, 0);
            LAS float* yo = (pw ? ZZ + 16 * (wave - 4) : YY + 16 * wave) + fr;
#pragma unroll
            for (int rg = 0; rg < 4; ++rg) yo[(mc * 16 + 4 * fq + rg) * 64] = Y0[rg];
#pragma unroll
            for (int j = 0; j < 4; ++j) {
                const bf16x8 bc = fq < 2 ? *(const LAS bf16x8*)(BhT + (16 * j + fr) * WY_TS + fq * 8) : *(const LAS bf16x8*)(KhT + (16 * j + fr) * WY_TS + (fq - 2) * 8);
                X[j] = X[j] * *(const LAS f32x4*)(GC + 16 * j + 4 * fq);
                X[j] = __builtin_amdgcn_mfma_f32_16x16x32_bf16(bc, uc, X[j], 0, 0, 0);
                v2u w; w.x = cvt_pk_bf16(X[j][0], X[j][1]); w.y = cvt_pk_bf16(X[j][2], X[j][3]);
                *(LAS v2u*)(Xb + (16 * wave + fr) * WY_OS + 16 * j + 4 * fq) = w; }
        }
        LDS_WAIT();
    }
}

#define P1_LOAD_PARAMS(HH) do { int lf_ = fr, lq_ = fq, lt_ = tid; asm volatile("" : "+v"(lf_), "+v"(lq_), "+v"(lt_));   \
        const int h_ = (HH), ncol_ = h_ * 64 + ntl * 16 + lf_; \
        _Pragma("unroll") for (int ks = 0; ks < 2; ++ks) { bw[ks] = *(const bf16x8*)(L2T + (size_t)ncol_ * 64 + lq_ * 8 + ks * 32); ba[ks] = *(const bf16x8*)(L2T + (size_t)512 * 64 + (size_t)ncol_ * 64 + lq_ * 8 + ks * 32); } \
        _Pragma("unroll") for (int ks = 0; ks < 4; ++ks) bg[ks] = *(const bf16x8*)(L2T + (size_t)1024 * 64 + (size_t)ncol_ * 128 + lq_ * 8 + ks * 32); \
        if (lt_ < 128) { const int a_ = lt_ >> 4, c_ = (lt_ & 15) * 4; \
            const float* src_ = a_ == 0 ? A.in[I_W0] : a_ == 1 ? A.in[I_A0] : a_ == 2 ? A.in[I_KK] : a_ == 3 ? A.in[I_KA] : a_ == 4 ? A.in[I_RK] : A.in[I_MURKV] + (a_ - 5) * 512; \
            *(LAS f32x4*)(PRM + a_ * 64 + c_) = *(const f32x4*)(src_ + h_ * 64 + c_); } } while (0)
__device__ __forceinline__ void scan_pass1(const Args& A, LAS unsigned char* lds, int tid, int lane, int wave, int vcu, int G, int part = 0) {
    bf16* GB = (bf16*)(A.ws + WS_A1) + (size_t)MPAD * 512;
    bf16* YL = (bf16*)(A.ws + WS_YL); bf16* ZT = (bf16*)(A.ws + WS_ZT); bf16* BV = (bf16*)(A.ws + WS_BV);
    LAS bf16* HIDB = (LAS bf16*)(lds + P1_HIDB); LAS float* LO = (LAS float*)(lds + P1_LO); LAS float* SEQ = (LAS float*)(lds + P1_SEQ);
    LAS float* YY = (LAS float*)(lds + P1_YY); LAS float* ZZ = (LAS float*)(lds + P1_ZZ);
    const bf16* L2T = (const bf16*)(A.ws + WS_L2T);
    const bool prow_wave = wave >= 4;
    const int mt = wave & 1, ntl = wave >> 1;
    int tt = tid >> 4, cs = tid & 15, c4 = cs * 4, fr = lane & 15, fq = lane >> 4;
    f32x4 X[4];
    bf16x8 bw[2], ba[2], bg[4];
    LAS float* PRM = (LAS float*)(lds + P1_GG);
    int cur_h = -1;
    int ui = 0, unit; if (!p1_unit_at(0, vcu, G, unit)) return;
    int t0 = 0; P1Pre pre; p1_load(A, unit, 0, tt, cs, pre);
    for (;;) {
        { int lt_ = tid; asm volatile("" : "+v"(lt_)); tt = lt_ >> 4; cs = lt_ & 15; c4 = cs * 4; fr = lt_ & 15; fq = (lt_ >> 4) & 3; }
        bool prompt; int b, h, ch, T, rowbase; p1_decode(unit, prompt, b, h, ch, T, rowbase);
        const int hc = h * 64 + c4;
        if (t0 == 0 && G == 256 && ui < 8) {
            const size_t i16 = ((size_t)(ui * 256 + vcu) * NTHR + tid) * 16;
            cvt16_fp8_sliced(A.in[I_U], A.ws + WS_UB, PEER_SU, i16); cvt16_fp8_sliced(A.in[I_V], A.ws + WS_VB, PEER_SV, i16); }
        if (t0 == 0) {
            LAS bf16* Xb = (LAS bf16*)(lds + WY_XB);
#pragma unroll
            for (int j = 0; j < 4; ++j) { const int prow_ = 16 * (wave - 4) + fr, c0_ = 16 * j + 4 * fq;
#pragma unroll
                for (int e = 0; e < 4; ++e) X[j][e] = (prow_wave && prow_ == c0_ + e) ? 1.f : 0.f;
                v2u w; w.x = cvt_pk_bf16(X[j][0], X[j][1]); w.y = cvt_pk_bf16(X[j][2], X[j][3]);
                *(LAS v2u*)(Xb + (16 * wave + fr) * WY_OS + c0_) = w; }
        }
        if (h != cur_h) { cur_h = h; P1_LOAD_PARAMS(h); }
        size_t row, prow; bool hasprev; int nb; p1_rows(unit, t0, tt, row, prow, hasprev, nb);
        if (!(MK_DBGSEL == 5 && part)) { *(LAS v4u*)(HIDB + tt * HID_STRIDE + cs * 16) = pre.pa0; *(LAS v4u*)(HIDB + tt * HID_STRIDE + cs * 16 + 8) = pre.pa1; }
        __syncthreads();
        if (!(MK_DBGSEL == 5 && part)) {
            const LAS bf16* ap = HIDB + (mt * 16 + fr) * HID_STRIDE + fq * 8;
            f32x4 cw = (f32x4){0.f, 0.f, 0.f, 0.f}, ca = cw, cg = cw;
#pragma unroll
            for (int ks = 0; ks < 2; ++ks) { cw = __builtin_amdgcn_mfma_f32_16x16x32_bf16(*(const LAS bf16x8*)(ap + ks * 32), bw[ks], cw, 0, 0, 0);
                                             ca = __builtin_amdgcn_mfma_f32_16x16x32_bf16(*(const LAS bf16x8*)(ap + 64 + ks * 32), ba[ks], ca, 0, 0, 0); }
#pragma unroll
            for (int ks = 0; ks < 4; ++ks) cg = __builtin_amdgcn_mfma_f32_16x16x32_bf16(*(const LAS bf16x8*)(ap + 128 + ks * 32), bg[ks], cg, 0, 0, 0);
#pragma unroll
            for (int rg = 0; rg < 4; ++rg) { const int o = (mt * 16 + fq * 4 + rg) * 64 + ntl * 16 + fr; LO[o] = cw[rg]; LO[2048 + o] = ca[rg]; LO[4096 + o] = cg[rg]; }
        }
        __syncthreads();
        if (!(MK_DBGSEL == 5 && part)) {
            const f32x4 w0v = *(const LAS f32x4*)(PRM + c4), a0v = *(const LAS f32x4*)(PRM + 64 + c4), kkv = *(const LAS f32x4*)(PRM + 128 + c4), kav = *(const LAS f32x4*)(PRM + 192 + c4),
                        rkv = *(const LAS f32x4*)(PRM + 256 + c4), mur = *(const LAS f32x4*)(PRM + 320 + c4), muk = *(const LAS f32x4*)(PRM + 384 + c4), muv = *(const LAS f32x4*)(PRM + 448 + c4);
            const f32x4 aw = w0v + *(const LAS f32x4*)(LO + tt * 64 + c4), aa = a0v + *(const LAS f32x4*)(LO + 2048 + tt * 64 + c4), ag = *(const LAS f32x4*)(LO + 4096 + tt * 64 + c4);
            f32x4 r = (f32x4){bf_lo(pre.zr.x), bf_hi(pre.zr.x), bf_lo(pre.zr.y), bf_hi(pre.zr.y)}, k = (f32x4){bf_lo(pre.zk.x), bf_hi(pre.zk.x), bf_lo(pre.zk.y), bf_hi(pre.zk.y)},
                  v = (f32x4){bf_lo(pre.zv.x), bf_hi(pre.zv.x), bf_lo(pre.zv.y), bf_hi(pre.zv.y)};
            const f32x4 rpv = (f32x4){bf_lo(pre.pr.x), bf_hi(pre.pr.x), bf_lo(pre.pr.y), bf_hi(pre.pr.y)}, kpv = (f32x4){bf_lo(pre.pk.x), bf_hi(pre.pk.x), bf_lo(pre.pk.y), bf_hi(pre.pk.y)},
                        vpv = (f32x4){bf_lo(pre.pv.x), bf_hi(pre.pv.x), bf_lo(pre.pv.y), bf_hi(pre.pv.y)};
            r = r + mur * (rpv - r); k = k + muk * (kpv - k); v = v + muv * (vpv - v);
            f32x4 dec, asg, kk, km, av, bv;
            float ssq = 0.f, bon = 0.f;
#pragma unroll
            for (int i = 0; i < 4; ++i) {
                const float x = -aw[i];
                const float sp = fmaxf(x, 0.f) + __logf(1.0f + __expf(-fabsf(x)));
                const float wraw = -sp - 0.5f;
                dec[i] = -__expf(wraw);
                asg[i] = sigm(aa[i]);
                kk[i] = k[i] * kkv[i]; ssq += kk[i] * kk[i];
                km[i] = k[i] * (1.0f + (asg[i] - 1.0f) * kav[i]);
                bon += r[i] * km[i] * rkv[i];
            }
            ssq = sum16(ssq); bon = sum16(bon);
            const float inv = 1.0f / fmaxf(sqrtf(ssq), 1e-12f);
#pragma unroll
            for (int i = 0; i < 4; ++i) { kk[i] *= inv; av[i] = -kk[i]; bv[i] = kk[i] * asg[i]; }
            LAS float* sq_ = SEQ + tt * 384 + c4;
            *(LAS f32x4*)(sq_) = av; *(LAS f32x4*)(sq_ + 64) = dec; *(LAS f32x4*)(sq_ + 128) = bv; *(LAS f32x4*)(sq_ + 192) = km; *(LAS f32x4*)(sq_ + 256) = r; *(LAS f32x4*)(sq_ + 320) = v;
            if (tt < nb) {
                v2u w; w.x = cvt_pk_bf16(ag[0], ag[1]); w.y = cvt_pk_bf16(ag[2], ag[3]); *(v2u*)(GB + row * 512 + hc) = w;
                w.x = cvt_pk_bf16(bon * v[0], bon * v[1]); w.y = cvt_pk_bf16(bon * v[2], bon * v[3]); *(v2u*)(BV + row * 512 + hc) = w;
            }
        }
        int nunit = unit, nt0 = t0 + SC_TB, nui = ui; bool more = true;
        if (nt0 >= T) { nt0 = 0; nui = ui + 1; more = p1_unit_at(nui, vcu, G, nunit); }
        if (more) p1_load(A, nunit, nt0, tt, cs, pre);
        __syncthreads();
        if (!(MK_DBGSEL == 1 && part)) p1_wy(X, SEQ, YY, ZZ, lds, nb, tid, lane, wave, part);
        __syncthreads();
        if (tt < nb) {
            const f32x4 y = *(const LAS f32x4*)(YY + tt * 64 + c4), z = *(const LAS f32x4*)(ZZ + tt * 64 + c4);
            v2u w; w.x = cvt_pk_bf16(y[0], y[1]); w.y = cvt_pk_bf16(y[2], y[3]); *(v2u*)(YL + row * 512 + hc) = w;
            w.x = cvt_pk_bf16(z[0], z[1]); w.y = cvt_pk_bf16(z[2], z[3]); *(v2u*)(ZT + row * 512 + hc) = w;
        }
        if (t0 + SC_TB >= T) {
#pragma unroll
            for (int j = 0; j < 4; ++j) {
                if (!prow_wave) *(f32x4*)((float*)A.out + (size_t)unit * 4096 + (16 * wave + fr) * 64 + 16 * j + 4 * fq) = X[j];
                else { bf16* mt = (bf16*)((unsigned char*)A.out + OB_MB) + (size_t)unit * 4096 + (16 * j + 4 * fq) * 64 + 16 * (wave - 4) + fr;
                    const unsigned p01 = cvt_pk_bf16(X[j][0], X[j][1]), p23 = cvt_pk_bf16(X[j][2], X[j][3]);
                    mt[0] = (bf16)(p01 & 0xffffu); mt[64] = (bf16)(p01 >> 16); mt[128] = (bf16)(p23 & 0xffffu); mt[192] = (bf16)(p23 >> 16); }
            }
        }
        if (!more) break;
        unit = nunit; t0 = nt0; ui = nui;
    }
    __syncthreads();
}

constexpr int P2_SS = 72, P2_LO = 16 * P2_SS * 2, P2_BUF = 2 * P2_LO;
__device__ __forceinline__ void scan_pass2_rows(const float* Sinit, int unit0, int nchunks, int v0, float* outfin, bool slots, const Args& A, LAS unsigned char* lds, int tid, int lane, int wave) {
    LAS bf16* Shi = (LAS bf16*)lds; LAS bf16* Slo = (LAS bf16*)(lds + P2_LO);
    const int nt = wave & 3, fr = lane & 15, fq = lane >> 4; const bool act = wave < 4;
    float* NB = (float*)A.out; const bf16* MT = (const bf16*)((const unsigned char*)A.out + OB_MB);
    { const int idx = tid * 2, row = idx >> 6, col = idx & 63;
      const f32x2 s0 = Sinit ? *(const f32x2*)(Sinit + (size_t)(v0 + row) * 64 + col) : (f32x2){0.f, 0.f};
      const unsigned hi = cvt_pk_bf16(s0.x, s0.y);
      *(LAS unsigned*)(Shi + row * P2_SS + col) = hi; *(LAS unsigned*)(Slo + row * P2_SS + col) = cvt_pk_bf16(s0.x - bf_lo(hi), s0.y - bf_hi(hi)); }
    bf16x8 mr[4][2]; f32x4 nr[4];
    const size_t moff = (size_t)(16 * nt + fr) * 64 + fq * 8, noff = (size_t)(v0 + fr) * 64 + 16 * nt + 4 * fq;
#pragma unroll
    for (int d = 0; d < 4; ++d) {
        mr[d][0] = (bf16x8){0, 0, 0, 0, 0, 0, 0, 0}; mr[d][1] = mr[d][0]; nr[d] = (f32x4){0.f, 0.f, 0.f, 0.f};
        { const int cc = d < nchunks ? d : nchunks - 1;
            mr[d][0] = *(const bf16x8*)(MT + (size_t)(unit0 + cc) * 4096 + moff); mr[d][1] = *(const bf16x8*)(MT + (size_t)(unit0 + cc) * 4096 + moff + 32);
            nr[d] = *(const f32x4*)(NB + (size_t)(unit0 + cc) * 4096 + noff); }
    }
    f32x4 acc = (f32x4){0.f, 0.f, 0.f, 0.f};
    __syncthreads();
    for (int c0 = 0; c0 < nchunks; c0 += 4) {
#pragma unroll
        for (int d = 0; d < 4; ++d) {
            const int c = c0 + d;
            if (c < nchunks) {
                {
                    LAS bf16* Shi = (LAS bf16*)(lds + (d & 1) * P2_BUF); LAS bf16* Slo = (LAS bf16*)(lds + (d & 1) * P2_BUF + P2_LO);
                    const bf16x8 sh0 = *(const LAS bf16x8*)(Shi + fr * P2_SS + fq * 8), sh1 = *(const LAS bf16x8*)(Shi + fr * P2_SS + 32 + fq * 8),
                                 sl0 = *(const LAS bf16x8*)(Slo + fr * P2_SS + fq * 8), sl1 = *(const LAS bf16x8*)(Slo + fr * P2_SS + 32 + fq * 8);
                    acc = nr[d];
                    acc = __builtin_amdgcn_mfma_f32_16x16x32_bf16(mr[d][0], sh0, acc, 0, 0, 0); acc = __builtin_amdgcn_mfma_f32_16x16x32_bf16(mr[d][1], sh1, acc, 0, 0, 0);
                    acc = __builtin_amdgcn_mfma_f32_16x16x32_bf16(mr[d][0], sl0, acc, 0, 0, 0); acc = __builtin_amdgcn_mfma_f32_16x16x32_bf16(mr[d][1], sl1, acc, 0, 0, 0);
                    const int cn = c + 4 < nchunks ? c + 4 : nchunks - 1;
                    mr[d][0] = *(const bf16x8*)(MT + (size_t)(unit0 + cn) * 4096 + moff); mr[d][1] = *(const bf16x8*)(MT + (size_t)(unit0 + cn) * 4096 + moff + 32);
                    nr[d] = *(const f32x4*)(NB + (size_t)(unit0 + cn) * 4096 + noff);
                }
                if (act) {
                    LAS bf16* Shi = (LAS bf16*)(lds + ((d + 1) & 1) * P2_BUF); LAS bf16* Slo = (LAS bf16*)(lds + ((d + 1) & 1) * P2_BUF + P2_LO);
                    v2u hi; hi.x = cvt_pk_bf16(acc[0], acc[1]); hi.y = cvt_pk_bf16(acc[2], acc[3]);
                    v2u lo; lo.x = cvt_pk_bf16(acc[0] - bf_lo(hi.x), acc[1] - bf_hi(hi.x)); lo.y = cvt_pk_bf16(acc[2] - bf_lo(hi.y), acc[3] - bf_hi(hi.y));
                    *(LAS v2u*)(Shi + fr * P2_SS + 16 * nt + 4 * fq) = hi; *(LAS v2u*)(Slo + fr * P2_SS + 16 * nt + 4 * fq) = lo;
                    if (slots) *(f32x4*)(NB + (size_t)(unit0 + c) * 4096 + noff) = acc;
                }
                __syncthreads();
            }
        }
    }
    if (act) *(f32x4*)(outfin + noff) = acc;
    __syncthreads();
}

__device__ __forceinline__ void scan_pass2_sample(const float* Sinit, int unit, float* outfin, const Args& A, int lane, int wave) {
    const int fr = lane & 15, fq = lane >> 4, rt = wave >> 1;
    const float* NB = (const float*)A.out + (size_t)unit * 4096; const bf16* MT = (const bf16*)((const unsigned char*)A.out + OB_MB) + (size_t)unit * 4096;
    f32x4 sv[2][2];
#pragma unroll
    for (int ks = 0; ks < 2; ++ks) { const float* sp = Sinit + (size_t)(16 * rt + fr) * 64 + 32 * ks + 8 * fq; sv[ks][0] = *(const f32x4*)sp; sv[ks][1] = *(const f32x4*)(sp + 4); }
    bf16x8 mt[2][2]; f32x4 acc[2];
#pragma unroll
    for (int t = 0; t < 2; ++t) { const int nt = 2 * (wave & 1) + t;
        mt[t][0] = *(const bf16x8*)(MT + (size_t)(16 * nt + fr) * 64 + fq * 8); mt[t][1] = *(const bf16x8*)(MT + (size_t)(16 * nt + fr) * 64 + 32 + fq * 8);
        acc[t] = *(const f32x4*)(NB + (size_t)(16 * rt + fr) * 64 + 16 * nt + 4 * fq); }
    bf16x8 sh[2], sl[2];
#pragma unroll
    for (int ks = 0; ks < 2; ++ks) { const f32x4 a = sv[ks][0], b = sv[ks][1];
        v4u h; h.x = cvt_pk_bf16(a[0], a[1]); h.y = cvt_pk_bf16(a[2], a[3]); h.z = cvt_pk_bf16(b[0], b[1]); h.w = cvt_pk_bf16(b[2], b[3]);
        v4u l; l.x = cvt_pk_bf16(a[0] - bf_lo(h.x), a[1] - bf_hi(h.x)); l.y = cvt_pk_bf16(a[2] - bf_lo(h.y), a[3] - bf_hi(h.y));
        l.z = cvt_pk_bf16(b[0] - bf_lo(h.z), b[1] - bf_hi(h.z)); l.w = cvt_pk_bf16(b[2] - bf_lo(h.w), b[3] - bf_hi(h.w));
        sh[ks] = __builtin_bit_cast(bf16x8, h); sl[ks] = __builtin_bit_cast(bf16x8, l); }
#pragma unroll
    for (int t = 0; t < 2; ++t) { const int nt = 2 * (wave & 1) + t;
#pragma unroll
        for (int ks = 0; ks < 2; ++ks) { acc[t] = __builtin_amdgcn_mfma_f32_16x16x32_bf16(mt[t][ks], sh[ks], acc[t], 0, 0, 0); acc[t] = __builtin_amdgcn_mfma_f32_16x16x32_bf16(mt[t][ks], sl[ks], acc[t], 0, 0, 0); }
        *(f32x4*)(outfin + (size_t)(16 * rt + fr) * 64 + 16 * nt + 4 * fq) = acc[t]; }
}

__device__ __forceinline__ void scan_pass3_wave(const Args& A, int unit, int wq, int lane) {
    const bool prompt = unit < NUNITS_P;
    const int b = prompt ? unit >> 9 : (unit - NUNITS_P) >> 3, h = prompt ? (unit >> 6) & 7 : unit & 7, ch = prompt ? unit & 63 : 0;
    const int T = prompt ? 64 : SEQ_S, rowbase = prompt ? b * SEQ_P + ch * 64 : NPROMPT + b * SEQ_S;
    if (wq * 16 >= T) return;
    const float* S0 = prompt ? (ch > 0 ? (const float*)A.out + (size_t)(unit - 1) * 4096 : nullptr) : A.in[I_SWKV] + (size_t)(b * 8 + h) * 4096;
    const bf16* ZT = (const bf16*)(A.ws + WS_ZT); const bf16* YL = (const bf16*)(A.ws + WS_YL); const bf16* BV = (const bf16*)(A.ws + WS_BV);
    bf16* YB = (bf16*)(A.ws + WS_A1) + (size_t)MPAD * 512;
    const int fr = lane & 15, fq = lane >> 4;
    const size_t row = (size_t)(rowbase + wq * 16 + fr);
    f32x4 acc[4];
#pragma unroll
    for (int mt = 0; mt < 4; ++mt) acc[mt] = (f32x4){0.f, 0.f, 0.f, 0.f};
    if (S0) {
        bf16x8 bz[2];
#pragma unroll
        for (int ks = 0; ks < 2; ++ks) bz[ks] = *(const bf16x8*)(ZT + row * 512 + h * 64 + ks * 32 + fq * 8);
#pragma unroll
        for (int mt = 0; mt < 4; ++mt)
#pragma unroll
            for (int ks = 0; ks < 2; ++ks) { const float* sp = S0 + (size_t)(mt * 16 + fr) * 64 + ks * 32 + fq * 8; const f32x4 s0 = *(const f32x4*)sp, s1 = *(const f32x4*)(sp + 4);
                v4u pk; pk.x = cvt_pk_bf16(s0[0], s0[1]); pk.y = cvt_pk_bf16(s0[2], s0[3]); pk.z = cvt_pk_bf16(s1[0], s1[1]); pk.w = cvt_pk_bf16(s1[2], s1[3]);
                acc[mt] = __builtin_amdgcn_mfma_f32_16x16x32_bf16(__builtin_bit_cast(bf16x8, pk), bz[ks], acc[mt], 0, 0, 0); }
    }
    float sm = 0.f;
#pragma unroll
    for (int mt = 0; mt < 4; ++mt) { const v2u yl = *(const v2u*)(YL + row * 512 + h * 64 + mt * 16 + fq * 4);
        acc[mt][0] += bf_lo(yl.x); acc[mt][1] += bf_hi(yl.x); acc[mt][2] += bf_lo(yl.y); acc[mt][3] += bf_hi(yl.y);
        sm += (acc[mt][0] + acc[mt][1]) + (acc[mt][2] + acc[mt][3]); }
    sm += __shfl_xor(sm, 16); sm += __shfl_xor(sm, 32);
    const float mean = sm * (1.f / 64.f); float sv = 0.f;
#pragma unroll
    for (int mt = 0; mt < 4; ++mt) { acc[mt] = acc[mt] - mean; sv += (acc[mt][0] * acc[mt][0] + acc[mt][1] * acc[mt][1]) + (acc[mt][2] * acc[mt][2] + acc[mt][3] * acc[mt][3]); }
    sv += __shfl_xor(sv, 16); sv += __shfl_xor(sv, 32);
    const float rs = 1.0f / sqrtf(sv * (1.f / 64.f) + 64e-5f);
#pragma unroll
    for (int mt = 0; mt < 4; ++mt) { const int c = h * 64 + mt * 16 + fq * 4;
        const f32x4 gw = *(const f32x4*)(A.in[I_GNW] + c), gb = *(const f32x4*)(A.in[I_GNB] + c);
        const v2u bvw = *(const v2u*)(BV + row * 512 + c), gg = *(const v2u*)(YB + row * 512 + c);
        f32x4 o = acc[mt] * rs * gw + gb + (f32x4){bf_lo(bvw.x), bf_hi(bvw.x), bf_lo(bvw.y), bf_hi(bvw.y)};
        o = o * (f32x4){bf_lo(gg.x), bf_hi(gg.x), bf_lo(gg.y), bf_hi(gg.y)};
        v2u w; w.x = cvt_pk_bf16(o[0], o[1]); w.y = cvt_pk_bf16(o[2], o[3]); *(v2u*)(YB + row * 512 + c) = w; }
}

__device__ __forceinline__ void tk_insert(float (&tv)[16], float x) {
#pragma unroll
    for (int i = 15; i >= 1; --i) tv[i] = __builtin_amdgcn_fmed3f(tv[i - 1], x, tv[i]);
    tv[0] = __builtin_fmaxf(tv[0], x);
}
#define TK_CE(t, i, j) { const float a_ = __builtin_fmaxf(t[i], t[j]); t[j] = __builtin_fminf(t[i], t[j]); t[i] = a_; }
__device__ __forceinline__ void tk_sort16(float (&t)[16]) {
    TK_CE(t, 0, 1) TK_CE(t, 2, 3) TK_CE(t, 0, 2) TK_CE(t, 1, 3) TK_CE(t, 1, 2) TK_CE(t, 4, 5) TK_CE(t, 6, 7) TK_CE(t, 4, 6) TK_CE(t, 5, 7) TK_CE(t, 5, 6) TK_CE(t, 0, 4) TK_CE(t, 2, 6) TK_CE(t, 2, 4) TK_CE(t, 1, 5) TK_CE(t, 3, 7) TK_CE(t, 3, 5) TK_CE(t, 1, 2) TK_CE(t, 3, 4) TK_CE(t, 5, 6) TK_CE(t, 8, 9) TK_CE(t, 10, 11) TK_CE(t, 8, 10) TK_CE(t, 9, 11) TK_CE(t, 9, 10) TK_CE(t, 12, 13) TK_CE(t, 14, 15) TK_CE(t, 12, 14) TK_CE(t, 13, 15) TK_CE(t, 13, 14) TK_CE(t, 8, 12) TK_CE(t, 10, 14) TK_CE(t, 10, 12) TK_CE(t, 9, 13) TK_CE(t, 11, 15) TK_CE(t, 11, 13) TK_CE(t, 9, 10) TK_CE(t, 11, 12) TK_CE(t, 13, 14) TK_CE(t, 0, 8) TK_CE(t, 4, 12) TK_CE(t, 4, 8) TK_CE(t, 2, 10) TK_CE(t, 6, 14) TK_CE(t, 6, 10) TK_CE(t, 2, 4) TK_CE(t, 6, 8) TK_CE(t, 10, 12) TK_CE(t, 1, 9) TK_CE(t, 5, 13) TK_CE(t, 5, 9) TK_CE(t, 3, 11) TK_CE(t, 7, 15) TK_CE(t, 7, 11) TK_CE(t, 3, 5) TK_CE(t, 7, 9) TK_CE(t, 11, 13) TK_CE(t, 1, 2) TK_CE(t, 3, 4) TK_CE(t, 5, 6) TK_CE(t, 7, 8) TK_CE(t, 9, 10) TK_CE(t, 11, 12) TK_CE(t, 13, 14)
}
__device__ __forceinline__ void tk_merge16(float (&tv)[16], const float (&g)[16]) {
#pragma unroll
    for (int i = 0; i < 16; ++i) tv[i] = __builtin_fmaxf(tv[i], g[15 - i]);
#pragma unroll
    for (int s = 8; s >= 1; s >>= 1)
#pragma unroll
        for (int i = 0; i < 16; ++i) if ((i & s) == 0) TK_CE(tv, i, i + s)
}
__device__ __forceinline__ float gelu_tanh(float x) {
    const float u = 0.7978845608028654f * (x + 0.044715f * x * x * x);
    const float th = 1.0f - 2.0f * __builtin_amdgcn_rcpf(__expf(2.0f * u) + 1.0f);
    return 0.5f * x * (1.0f + th);
}
constexpr int NTILE32 = NTOK / 32;
constexpr int CW_QU = 8192, CW_QV = 8192 + 512;

constexpr int TK_STRIDE = 68, TK_BYTES = 64 * TK_STRIDE * 4;
__device__ __forceinline__ void topk_scores64(const bf16* Q, const bf16* KB, LAS float* SC, int t0, int hp, int p, int half, int lane, const bf16x8 (&af)[2][2][4]) {
    const int fr = lane & 15, fq = lane >> 4;
#pragma unroll
    for (int hs = 0; hs < 2; ++hs) {
        const bf16* kbase = KB + (size_t)(((hp + 4 * hs) * 2 + p) * 128 + half * 64 + fr) * 128 + fq * 8;
#pragma unroll
        for (int n = 0; n < 4; ++n) {
            bf16x8 bfr[4];
#pragma unroll
            for (int ks = 0; ks < 4; ++ks) bfr[ks] = *(const bf16x8*)(kbase + (size_t)n * 16 * 128 + ks * 32);
            f32x4 acc0 = (f32x4){0.f, 0.f, 0.f, 0.f}, acc1 = acc0;
#pragma unroll
            for (int ks = 0; ks < 4; ++ks) { acc0 = __builtin_amdgcn_mfma_f32_16x16x32_bf16(af[hs][0][ks], bfr[ks], acc0, 0, 0, 0); acc1 = __builtin_amdgcn_mfma_f32_16x16x32_bf16(af[hs][1][ks], bfr[ks], acc1, 0, 0, 0); }
#pragma unroll
            for (int rg = 0; rg < 4; ++rg) { SC[(hs * 32 + fq * 4 + rg) * TK_STRIDE + n * 16 + fr] = acc0[rg]; SC[(hs * 32 + 16 + fq * 4 + rg) * TK_STRIDE + n * 16 + fr] = acc1[rg]; }
        }
    }
}
constexpr int TK_NPROMPT_UNITS = (NPROMPT / 32) * 4, TK_NSAMPLE_UNITS = (NSAMP / 32) * 4, CW_TKS = 9792;
__device__ __forceinline__ void peer_topk_units(const Args& A, LAS unsigned char* lds, int lane, int wave, int u_first, int u_end, int u_step) {
    const bf16* Q = (const bf16*)(A.ws + WS_ZG); const bf16* KB = (const bf16*)(A.ws + WS_KEYS); const float* SSP = (const float*)(A.ws + WS_SSP);
    unsigned short* EIDX = (unsigned short*)(A.ws + WS_EIDX); float* GATE = (float*)(A.ws + WS_GATE); float* RSTD = (float*)(A.ws + WS_RSTD);
    LAS float* SC = (LAS float*)(lds + wave * TK_BYTES);
    const int fr = lane & 15, fq = lane >> 4, tokl = lane & 31, hsel = lane >> 5;
    for (int u = u_first; u < u_end; u += u_step) {
        const int t0 = (u >> 2) * 32, hp = u & 3, h = hp + 4 * hsel;
        const float* sp = SSP + (size_t)(t0 + tokl) * 16;
        const f32x4 s0 = *(const f32x4*)sp, s1 = *(const f32x4*)(sp + 4), s2 = *(const f32x4*)(sp + 8), s3 = *(const f32x4*)(sp + 12);
        const float ssq = ((s0[0] + s0[1]) + (s0[2] + s0[3])) + ((s1[0] + s1[1]) + (s1[2] + s1[3])) + ((s2[0] + s2[1]) + (s2[2] + s2[3])) + ((s3[0] + s3[1]) + (s3[2] + s3[3]));
        const float rstd = 1.0f / sqrtf(ssq * (1.f / DM) + 1e-6f);
        float tv0[16], tv1[16], cv[16];
#pragma unroll
        for (int p = 0; p < 2; ++p) {
            bf16x8 af[2][2][4];
#pragma unroll
            for (int hs = 0; hs < 2; ++hs)
#pragma unroll
                for (int mt = 0; mt < 2; ++mt) { const bf16* qp = Q + (size_t)(t0 + mt * 16 + fr) * 2048 + (hp + 4 * hs) * 256 + p * 128 + fq * 8;
#pragma unroll
                    for (int ks = 0; ks < 4; ++ks) af[hs][mt][ks] = *(const bf16x8*)(qp + ks * 32); }
            float tv[16];
#pragma unroll
            for (int i = 0; i < 16; ++i) tv[i] = -3.0e38f;
            for (int half = 0; half < 2; ++half) {
                topk_scores64(Q, KB, SC, t0, hp, p, half, lane, af);
                LDS_WAIT();
                const LAS float* mine = SC + lane * TK_STRIDE;
                unsigned kmask = 0xFFFFFF80u; asm volatile("" : "+v"(kmask));
#pragma unroll 1
                for (int n = 0; n < 64; n += 16) {
                    float g[16];
#pragma unroll
                    for (int q = 0; q < 4; ++q) { const f32x4 x4 = *(const LAS f32x4*)(mine + n + 4 * q);
#pragma unroll
                        for (int e = 0; e < 4; ++e) g[4 * q + e] = __uint_as_float((__float_as_uint(x4[e]) & kmask) | (unsigned)(half * 64 + n + 4 * q + e)); }
                    tk_sort16(g); tk_merge16(tv, g);
                }
                LDS_WAIT();
            }
#pragma unroll
            for (int i = 0; i < 16; ++i) { if (p == 0) tv0[i] = tv[i]; else tv1[i] = tv[i]; }
        }
        LAS int* li = (LAS int*)SC + lane * 33;
#pragma unroll
        for (int q = 0; q < 16; ++q) { li[q] = (int)(__float_as_uint(tv0[q]) & 127u); li[16 + q] = (int)(__float_as_uint(tv1[q]) & 127u);
            tv0[q] = __uint_as_float(__float_as_uint(tv0[q]) & 0xFFFFFF80u); tv1[q] = __uint_as_float(__float_as_uint(tv1[q]) & 0xFFFFFF80u); }
#pragma unroll
        for (int q = 0; q < 16; ++q) cv[q] = -3.0e38f;
#pragma unroll
        for (int a = 0; a < 16; ++a)
#pragma unroll
            for (int b = 0; b < 16; ++b) if ((a + 1) * (b + 1) <= 16)
                tk_insert(cv, __uint_as_float((__float_as_uint(tv0[a] + tv1[b]) & 0xFFFFFF00u) | (unsigned)(a * 16 + b)));
        LDS_WAIT();
        float e[16], den = 0.f; unsigned ci[16];
        const float c0 = __uint_as_float(__float_as_uint(cv[0]) & 0xFFFFFF00u);
#pragma unroll
        for (int q = 0; q < 16; ++q) { const unsigned kb = __float_as_uint(cv[q]); const float cq = __uint_as_float(kb & 0xFFFFFF00u);
            e[q] = __expf((cq - c0) * rstd); den += e[q]; ci[q] = (unsigned)(li[(kb >> 4) & 15] * 128 + li[16 + (kb & 15)]); }
        const float inv = 1.0f / den;
        LDS_WAIT();
        {
            const size_t tok = (size_t)(t0 + tokl);
            v4u w0, w1; w0.x = ci[0] | (ci[1] << 16); w0.y = ci[2] | (ci[3] << 16); w0.z = ci[4] | (ci[5] << 16); w0.w = ci[6] | (ci[7] << 16);
            w1.x = ci[8] | (ci[9] << 16); w1.y = ci[10] | (ci[11] << 16); w1.z = ci[12] | (ci[13] << 16); w1.w = ci[14] | (ci[15] << 16);
            *(v4u*)(EIDX + tok * 128 + h * 16) = w0; *(v4u*)(EIDX + tok * 128 + h * 16 + 8) = w1;
#pragma unroll
            for (int q = 0; q < 4; ++q) *(f32x4*)(GATE + tok * 128 + h * 16 + 4 * q) = (f32x4){e[4 * q] * inv, e[4 * q + 1] * inv, e[4 * q + 2] * inv, e[4 * q + 3] * inv};
            if (h == 0) RSTD[tok] = rstd;
        }
    }
}

__device__ __forceinline__ bool peer_topk_split(int G) { return G == 256; }
__device__ __forceinline__ void peer_topk_phase(const Args& A, LAS unsigned char* lds, int tid, int lane, int wave, int vcu, int G) {
    peer_topk_units(A, lds, lane, wave, wave * G + vcu, peer_topk_split(G) ? TK_NPROMPT_UNITS : TK_NPROMPT_UNITS + TK_NSAMPLE_UNITS, G * NWAVES);
}
__device__ __forceinline__ void peer_topk_sample_prelude(const Args& A, LAS unsigned char* lds, int tid, int lane, int wave, int vcu, int G, gu32* ctl) {
    if (!peer_topk_split(G) || (vcu & 31) != 0) return;
    peer_topk_units(A, lds, lane, wave, TK_NPROMPT_UNITS + (vcu >> 5) * NWAVES + wave, TK_NPROMPT_UNITS + TK_NSAMPLE_UNITS, TK_NSAMPLE_UNITS);
    asm volatile("s_waitcnt vmcnt(0)" ::: "memory");
    __syncthreads();
    if (tid == 0) { __builtin_amdgcn_fence(__ATOMIC_RELEASE, "agent"); asm volatile("s_waitcnt vmcnt(0)" ::: "memory"); (void)__hip_atomic_fetch_add((unsigned*)(ctl + CW_TKS), 1u, RLX_AGENT); }
    __syncthreads();
}
__device__ __forceinline__ void peer_topk_sample_wait(gu32* ctl, int tid) {
    if (tid == 0) {
        unsigned sp = 0;
        while (__hip_atomic_load((unsigned*)(ctl + CW_TKS), RLX_AGENT) < (unsigned)(TK_NSAMPLE_UNITS / NWAVES)) { __builtin_amdgcn_s_sleep(2); if (++sp > (1u << 22)) break; }
        __builtin_amdgcn_fence(__ATOMIC_ACQUIRE, "agent");
        asm volatile("s_waitcnt vmcnt(0)" ::: "memory");
    }
    __syncthreads();
}

constexpr int PEER_ITEM = 40, NITEM128 = NTOK / PEER_ITEM;
__device__ __forceinline__ bool peer_next_item(gu32* qbase, int xcc, int& qs, int& slice, int& item, LAS unsigned char* lds, int tid) {
    LAS int* box = (LAS int*)(lds + LDSCTL_OFF + 64);
    for (;;) {
        if (qs >= 8) return false;
        slice = (xcc + qs) & 7;
        if (tid == 0) box[0] = (int)__hip_atomic_fetch_add((unsigned*)(qbase + 64 * slice), 1u, RLX_AGENT);
        __syncthreads();
        item = box[0];
        __syncthreads();
        if (item < NITEM128) return true;
        ++qs;
    }
}

typedef long i64_t;
constexpr float PEER_SX = 1.0f;
constexpr int U_TILE0 = 8192, U_TILEB = 16384;
__device__ __forceinline__ i64_t mk64(unsigned lo, unsigned hi) { return (i64_t)(((unsigned long long)hi << 32) | (unsigned long long)lo); }
__device__ __forceinline__ void peer_u_phase(const Args& A, LAS unsigned char* lds, int tid, int lane, int wave, gu32* ctl, int qoff) {
    const unsigned char* Uq = A.ws + WS_UB; const bf16* XG = (const bf16*)(A.ws + WS_A1);
    const unsigned short* EIDX = (const unsigned short*)(A.ws + WS_EIDX); bf16* PART = (bf16*)(A.ws + WS_PART);
    const int xcc = (int)(xb_xcc_id() & 7u), rg = lane >> 3, c8 = lane & 7, m = lane & 15, kq = lane >> 4;
    LAS int* we = (LAS int*)(lds + wave * 1024);
    LAS unsigned char* tile = lds + U_TILE0 + wave * U_TILEB;
    const int ch_e = ((c8 - (rg >> 1)) & 7) * 16, ch_o = ((c8 - 4 - (rg >> 1)) & 7) * 16;
    const int fbase = m * 128 + (kq & 1) * 8, pos0 = (kq >> 1) + (m >> 1);
    int foff[4];
#pragma unroll
    for (int ks = 0; ks < 4; ++ks) foff[ks] = fbase + ((pos0 + 2 * ks) & 7) * 16;
    int qs = 0, slice, item; bool lists_ready = !peer_topk_split((int)gridDim.x);
    while (peer_next_item(ctl + CW_QU + qoff, xcc, qs, slice, item, lds, tid)) {
        if (!lists_ready && (item + 1) * PEER_ITEM > NPROMPT) { peer_topk_sample_wait(ctl, tid); lists_ready = true; }
        const unsigned char* us = Uq + (size_t)slice * 16384 * 128;
        size_t tok = (size_t)(item * PEER_ITEM + wave);
        unsigned pair = *(const unsigned*)(EIDX + tok * 128 + 2 * lane);
        v4u xr[4];
#pragma unroll
        for (int ks = 0; ks < 4; ++ks) xr[ks] = *(const v4u*)(XG + tok * DM + slice * 128 + ks * 32 + kq * 8);
        we[2 * lane] = (int)(pair & 0xffffu); we[2 * lane + 1] = (int)(pair >> 16);
        LDS_WAIT();
        v4u w[16];
#pragma unroll
        for (int it = 0; it < 16; ++it) w[it] = *(const v4u*)(us + (unsigned)(((unsigned)we[it * 8 + rg] << 7) + (unsigned)((it & 1) ? ch_o : ch_e)));
        for (int tt = 0; tt < PEER_ITEM / NWAVES; ++tt) {
            const size_t ctok = tok; const bool more = tt + 1 < PEER_ITEM / NWAVES;
            i64_t bx[4];
#pragma unroll
            for (int ks = 0; ks < 4; ++ks) { const v4u q = xr[ks]; typedef short s16x2 __attribute__((ext_vector_type(2)));
                s16x2 lo = (s16x2){0, 0}, hi = lo;
                unsigned q0 = q.x, q1 = q.y, q2 = q.z, q3 = q.w; asm volatile("" : "+v"(q0), "+v"(q1), "+v"(q2), "+v"(q3));
                lo = __builtin_amdgcn_cvt_scalef32_pk_fp8_bf16(lo, __builtin_bit_cast(bf16x2_t, q0), PEER_SX, false); lo = __builtin_amdgcn_cvt_scalef32_pk_fp8_bf16(lo, __builtin_bit_cast(bf16x2_t, q1), PEER_SX, true);
                hi = __builtin_amdgcn_cvt_scalef32_pk_fp8_bf16(hi, __builtin_bit_cast(bf16x2_t, q2), PEER_SX, false); hi = __builtin_amdgcn_cvt_scalef32_pk_fp8_bf16(hi, __builtin_bit_cast(bf16x2_t, q3), PEER_SX, true);
                bx[ks] = mk64(__builtin_bit_cast(unsigned, lo), __builtin_bit_cast(unsigned, hi)); }
            if (more) { tok += NWAVES; pair = *(const unsigned*)(EIDX + tok * 128 + 2 * lane);
#pragma unroll
                for (int ks = 0; ks < 4; ++ks) xr[ks] = *(const v4u*)(XG + tok * DM + slice * 128 + ks * 32 + kq * 8); }
#pragma unroll
            for (int it = 0; it < 16; ++it) *(LAS v4u*)(tile + it * 1024 + lane * 16) = w[it];
            if (more) {
                we[2 * lane] = (int)(pair & 0xffffu); we[2 * lane + 1] = (int)(pair >> 16);
                LDS_WAIT();
#pragma unroll
                for (int it = 0; it < 16; ++it) w[it] = *(const v4u*)(us + (unsigned)(((unsigned)we[it * 8 + rg] << 7) + (unsigned)((it & 1) ? ch_o : ch_e)));
            } else LDS_WAIT();
            bf16* pp = PART + (ctok * 8 + slice) * 128;
            f32x4 acc[8];
#pragma unroll
            for (int hf = 0; hf < 2; ++hf) {
                v2u a[4][4];
#pragma unroll
                for (int T4 = 0; T4 < 4; ++T4)
#pragma unroll
                    for (int ks = 0; ks < 4; ++ks) a[T4][ks] = *(const LAS v2u*)(tile + (hf * 4 + T4) * 2048 + foff[ks]);
#pragma unroll
                for (int T4 = 0; T4 < 4; ++T4) acc[hf * 4 + T4] = (f32x4){0.f, 0.f, 0.f, 0.f};
#pragma unroll
                for (int ks = 0; ks < 4; ++ks)
#pragma unroll
                    for (int T4 = 0; T4 < 4; ++T4) acc[hf * 4 + T4] = __builtin_amdgcn_mfma_f32_16x16x32_fp8_fp8(mk64(a[T4][ks].x, a[T4][ks].y), bx[ks], acc[hf * 4 + T4], 0, 0, 0);
            }
            f32x4 val = acc[0];
#pragma unroll
            for (int T = 1; T < 8; ++T) val = ((m & 7) == T) ? acc[T] : val;
            if (m < 8) { v2u pw; pw.x = cvt_pk_bf16(val[0] * (1.0f / PEER_SX), val[1] * (1.0f / PEER_SX)); pw.y = cvt_pk_bf16(val[2] * (1.0f / PEER_SX), val[3] * (1.0f / PEER_SX)); *(v2u*)(pp + m * 16 + 4 * kq) = pw; }
            LDS_WAIT();
        }
    }
}

constexpr float PEER_CS = 64.0f;
__device__ __forceinline__ void peer_coef_phase(const Args& A, int lane, int wave, int vcu, int G) {
    const bf16* PART = (const bf16*)(A.ws + WS_PART); const float* GATE = (const float*)(A.ws + WS_GATE); const float* RSTD = (const float*)(A.ws + WS_RSTD);
    unsigned char* C8 = A.ws + WS_COEF;
    for (int tok = vcu * NWAVES + wave; tok < NTOK; tok += G * NWAVES) {
        const bf16* pp = PART + (size_t)tok * 1024 + 2 * lane;
        unsigned pw[8];
#pragma unroll
        for (int j = 0; j < 8; ++j) pw[j] = *(const unsigned*)(pp + j * 128);
        f32x2 d = (f32x2){bf_lo(pw[0]), bf_hi(pw[0])};
#pragma unroll
        for (int j = 1; j < 8; ++j) d += (f32x2){bf_lo(pw[j]), bf_hi(pw[j])};
        const float sc = RSTD[tok] * (1.0f / PEER_SU); const f32x2 gt = *(const f32x2*)(GATE + (size_t)tok * 128 + 2 * lane);
        f32x2 cf; cf.x = gt.x * gelu_tanh(d.x * sc) * (PEER_CS / PEER_SV); cf.y = gt.y * gelu_tanh(d.y * sc) * (PEER_CS / PEER_SV);
        const unsigned hi = (unsigned)__builtin_amdgcn_cvt_pk_fp8_f32(cf.x, cf.y, 0, false) & 0xffffu;
        const f32x2 bk = __builtin_amdgcn_cvt_pk_f32_fp8(hi, false);
        const unsigned lo = (unsigned)__builtin_amdgcn_cvt_pk_fp8_f32((cf.x - bk.x) * 16.0f, (cf.y - bk.y) * 16.0f, 0, false) & 0xffffu;
        *(unsigned short*)(C8 + (size_t)tok * 256 + 2 * lane) = (unsigned short)hi; *(unsigned short*)(C8 + (size_t)tok * 256 + 128 + 2 * lane) = (unsigned short)lo;
    }
}

typedef int v2i_t __attribute__((ext_vector_type(2)));
__device__ __forceinline__ void peer_v_phase(const Args& A, LAS unsigned char* lds, int tid, int lane, int wave, gu32* ctl) {
    const unsigned char* Vq = A.ws + WS_VB;
    const unsigned short* EIDX = (const unsigned short*)(A.ws + WS_EIDX); const unsigned char* C8 = A.ws + WS_COEF;
    float* X1 = A.out + O_Y; float* SS2 = (float*)(A.ws + WS_SS2); const bf16* XGv = (const bf16*)(A.ws + WS_A1);
    const int xcc = (int)(xb_xcc_id() & 7u), rg = lane >> 3, c8 = lane & 7, m = lane & 15, kq = lane >> 4;
    LAS int* we = (LAS int*)(lds + wave * 1024);
    LAS unsigned char* tile = lds + U_TILE0 + wave * U_TILEB;
    const int ch_e = ((c8 - (rg >> 1)) & 7) * 16, ch_o = ((c8 - 4 - (rg >> 1)) & 7) * 16;
    const int tr_r = (lane & 15) >> 1, tr_p = lane & 1, tr_rot = 4 * (kq & 1) + (tr_r >> 1);
    const int tbase = (8 * kq + tr_r) * 128 + 8 * tr_p;
    int toff[8];
#pragma unroll
    for (int j = 0; j < 8; ++j) toff[j] = tbase + ((j + tr_rot) & 7) * 16;
    int qs = 0, slice, item;
    while (peer_next_item(ctl + CW_QV, xcc, qs, slice, item, lds, tid)) {
        const unsigned char* vs = Vq + (size_t)slice * 16384 * 128;
        size_t tok = (size_t)(item * PEER_ITEM + wave);
        unsigned pair = *(const unsigned*)(EIDX + tok * 128 + 2 * lane);
        v2u cfr[4];
#pragma unroll
        for (int ks = 0; ks < 4; ++ks) cfr[ks] = *(const v2u*)(C8 + tok * 256 + (m & 1) * 128 + ks * 32 + kq * 8);
        const float rga = 1.0f / A.in[I_N2G][slice * 128 + lane], rgb = 1.0f / A.in[I_N2G][slice * 128 + 64 + lane];
        unsigned short xoa = XGv[tok * DM + slice * 128 + lane], xob = XGv[tok * DM + slice * 128 + 64 + lane];
        we[2 * lane] = (int)(pair & 0xffffu); we[2 * lane + 1] = (int)(pair >> 16);
        LDS_WAIT();
        v4u w[16];
#pragma unroll
        for (int it = 0; it < 16; ++it) w[it] = *(const v4u*)(vs + (unsigned)(((unsigned)we[it * 8 + rg] << 7) + (unsigned)((it & 1) ? ch_o : ch_e)));
        for (int tt = 0; tt < PEER_ITEM / NWAVES; ++tt) {
            const size_t ctok = tok; const bool more = tt + 1 < PEER_ITEM / NWAVES;
            i64_t af[4];
#pragma unroll
            for (int ks = 0; ks < 4; ++ks) af[ks] = mk64(cfr[ks].x, cfr[ks].y);
            const float xa = __uint_as_float((unsigned)xoa << 16) * rga, xb = __uint_as_float((unsigned)xob << 16) * rgb;
            if (more) { tok += NWAVES; pair = *(const unsigned*)(EIDX + tok * 128 + 2 * lane);
#pragma unroll
                for (int ks = 0; ks < 4; ++ks) cfr[ks] = *(const v2u*)(C8 + tok * 256 + (m & 1) * 128 + ks * 32 + kq * 8);
                xoa = XGv[tok * DM + slice * 128 + lane]; xob = XGv[tok * DM + slice * 128 + 64 + lane]; }
#pragma unroll
            for (int it = 0; it < 16; ++it) *(LAS v4u*)(tile + it * 1024 + lane * 16) = w[it];
            if (more) {
                we[2 * lane] = (int)(pair & 0xffffu); we[2 * lane + 1] = (int)(pair >> 16);
                LDS_WAIT();
#pragma unroll
                for (int it = 0; it < 16; ++it) w[it] = *(const v4u*)(vs + (unsigned)(((unsigned)we[it * 8 + rg] << 7) + (unsigned)((it & 1) ? ch_o : ch_e)));
            } else LDS_WAIT();
            f32x4 acc[8];
#pragma unroll
            for (int hf = 0; hf < 2; ++hf) {
                v2i_t b[4][4];
#pragma unroll
                for (int j4 = 0; j4 < 4; ++j4)
#pragma unroll
                    for (int ks = 0; ks < 4; ++ks) b[j4][ks] = __builtin_amdgcn_ds_read_tr8_b64_v2i32((LAS v2i_t*)(tile + ks * 4096 + toff[hf * 4 + j4]));
#pragma unroll
                for (int j4 = 0; j4 < 4; ++j4) acc[hf * 4 + j4] = (f32x4){0.f, 0.f, 0.f, 0.f};
#pragma unroll
                for (int ks = 0; ks < 4; ++ks)
#pragma unroll
                    for (int j4 = 0; j4 < 4; ++j4) acc[hf * 4 + j4] = __builtin_amdgcn_mfma_f32_16x16x32_fp8_fp8(af[ks], mk64((unsigned)b[j4][ks].x, (unsigned)b[j4][ks].y), acc[hf * 4 + j4], 0, 0, 0);
            }
            float h0 = acc[0][0], l0 = acc[0][1], h1 = acc[4][0], l1 = acc[4][1];
#pragma unroll
            for (int j = 1; j < 4; ++j) { const bool s = kq == j; h0 = s ? acc[j][0] : h0; l0 = s ? acc[j][1] : l0; h1 = s ? acc[4 + j][0] : h1; l1 = s ? acc[4 + j][1] : l1; }
            const float x2a = xa + (h0 + l0 * (1.0f / 16.0f)) * (1.0f / PEER_CS), x2b = xb + (h1 + l1 * (1.0f / 16.0f)) * (1.0f / PEER_CS);
            { bf16* xr_ = (bf16*)X1 + ctok * (2 * DM) + slice * 128 + lane;
              xr_[0] = (bf16)(cvt_pk_bf16(x2a, x2a) & 0xffffu); xr_[64] = (bf16)(cvt_pk_bf16(x2b, x2b) & 0xffffu); }
            float ss = sum16(x2a * x2a + x2b * x2b); ss += __shfl_xor(ss, 16); ss += __shfl_xor(ss, 32);
            if (lane == 0) SS2[ctok * 8 + slice] = ss;
            LDS_WAIT();
        }
    }
}

__device__ __forceinline__ void peer_final_phase(const Args& A, int lane, int wave, int vcu, int G) {
    float* X1 = A.out + O_Y; const float* SS2 = (const float*)(A.ws + WS_SS2); const float* gf = A.in[I_NFG] + lane * 16;
    const f32x4 g0 = *(const f32x4*)gf, g1 = *(const f32x4*)(gf + 4), g2 = *(const f32x4*)(gf + 8), g3 = *(const f32x4*)(gf + 12);
    for (int tok = vcu * NWAVES + wave; tok < NTOK; tok += G * NWAVES) {
        const f32x4 sa = *(const f32x4*)(SS2 + (size_t)tok * 8), sb = *(const f32x4*)(SS2 + (size_t)tok * 8 + 4);
        const float ss = ((sa[0] + sa[1]) + (sa[2] + sa[3])) + ((sb[0] + sb[1]) + (sb[2] + sb[3]));
        const float rf = 1.0f / sqrtf(ss * (1.f / DM) + 1e-6f);
        float* yr = X1 + (size_t)tok * DM + lane * 16;
        const v4u s0 = *(const v4u*)((const bf16*)(X1 + (size_t)tok * DM) + lane * 16), s1 = *(const v4u*)((const bf16*)(X1 + (size_t)tok * DM) + lane * 16 + 8);
        const f32x4 y0 = (f32x4){bf_lo(s0.x), bf_hi(s0.x), bf_lo(s0.y), bf_hi(s0.y)}, y1 = (f32x4){bf_lo(s0.z), bf_hi(s0.z), bf_lo(s0.w), bf_hi(s0.w)},
                    y2 = (f32x4){bf_lo(s1.x), bf_hi(s1.x), bf_lo(s1.y), bf_hi(s1.y)}, y3 = (f32x4){bf_lo(s1.z), bf_hi(s1.z), bf_lo(s1.w), bf_hi(s1.w)};
        *(f32x4*)yr = y0 * rf * g0; *(f32x4*)(yr + 4) = y1 * rf * g1; *(f32x4*)(yr + 8) = y2 * rf * g2; *(f32x4*)(yr + 12) = y3 * rf * g3;
    }
}

__device__ __forceinline__ void sg_partial(const bf16* Ap, int lda, const bf16* Bp, int ldb, LAS f32x4* red, int lane, int wave) {
    const int fr = lane & 15, fq = lane >> 4;
    bf16x8 a[2][4], b[4][4];
#pragma unroll
    for (int mi = 0; mi < 2; ++mi)
#pragma unroll
        for (int ks = 0; ks < 4; ++ks) a[mi][ks] = *(const bf16x8*)(Ap + (size_t)(16 * mi + fr) * lda + 32 * ks + 8 * fq);
#pragma unroll
    for (int nj = 0; nj < 4; ++nj)
#pragma unroll
        for (int ks = 0; ks < 4; ++ks) b[nj][ks] = *(const bf16x8*)(Bp + (size_t)(16 * nj + fr) * ldb + 32 * ks + 8 * fq);
    f32x4 acc[2][4];
#pragma unroll
    for (int mi = 0; mi < 2; ++mi)
#pragma unroll
        for (int nj = 0; nj < 4; ++nj) acc[mi][nj] = (f32x4){0.f, 0.f, 0.f, 0.f};
#pragma unroll
    for (int ks = 0; ks < 4; ++ks)
#pragma unroll
        for (int mi = 0; mi < 2; ++mi)
#pragma unroll
            for (int nj = 0; nj < 4; ++nj) acc[mi][nj] = __builtin_amdgcn_mfma_f32_16x16x32_bf16(b[nj][ks], a[mi][ks], acc[mi][nj], 0, 0, 0);
#pragma unroll
    for (int mi = 0; mi < 2; ++mi)
#pragma unroll
        for (int nj = 0; nj < 4; ++nj) red[(wave * 8 + mi * 4 + nj) * 64 + lane] = acc[mi][nj];
}
__device__ __forceinline__ f32x4 sg_sum(const LAS f32x4* red, int w0, int nw, int wave, int lane) {
    f32x4 s = red[(w0 * 8 + wave) * 64 + lane];
    for (int w = 1; w < nw; ++w) s += red[((w0 + w) * 8 + wave) * 64 + lane];
    return s;
}
__device__ __forceinline__ void sample_gemm2(const Args& A, LAS unsigned char* lds, int t, int lane, int wave) {
    unsigned char* ws = A.ws; const int fr = lane & 15, fq = lane >> 4;
    const int row0 = NPROMPT + (t >> 4) * 32, col0 = (t & 15) * 64;
    LAS f32x4* red = (LAS f32x4*)lds;
    const bf16* Ab = (const bf16*)(ws + WS_A1) + (wave >= 4 ? (size_t)MPAD * 512 : 0); const bf16* Bb = (const bf16*)(ws + (wave >= 4 ? WS_WPB : WS_WPA));
    sg_partial(Ab + (size_t)row0 * 512 + (wave & 3) * 128, 512, Bb + (size_t)col0 * 512 + (wave & 3) * 128, 512, red, lane, wave);
    const int row = row0 + 16 * (wave >> 2) + fr, c = col0 + 16 * (wave & 3) + 4 * fq;
    const bf16* Zg = (const bf16*)(ws + WS_ZG) + (size_t)row * 2048;
    const v2u ga = *(const v2u*)(Zg + c), gb = *(const v2u*)(Zg + 1024 + c);
    __syncthreads();
    const f32x4 pa = sg_sum(red, 0, 4, wave, lane), pb = sg_sum(red, 4, 4, wave, lane);
    const float o0 = sigm(bf_lo(ga.x)) * pa[0] + sigm(bf_lo(gb.x)) * pb[0], o1 = sigm(bf_hi(ga.x)) * pa[1] + sigm(bf_hi(gb.x)) * pb[1],
                o2 = sigm(bf_lo(ga.y)) * pa[2] + sigm(bf_lo(gb.y)) * pb[2], o3 = sigm(bf_hi(ga.y)) * pa[3] + sigm(bf_hi(gb.y)) * pb[3];
    v2u w; w.x = cvt_pk_bf16(o0, o1); w.y = cvt_pk_bf16(o2, o3); *(v2u*)((bf16*)(ws + WS_ZR) + (size_t)row * 1024 + c) = w;
    __syncthreads();
}
__device__ __forceinline__ void sample_gemm3(const Args& A, LAS unsigned char* lds, int t, int tid, int lane, int wave) {
    unsigned char* ws = A.ws; const int fr = lane & 15, fq = lane >> 4;
    const int row0 = NPROMPT + (t >> 4) * 32, col0 = (t & 15) * 64;
    LAS f32x4* red = (LAS f32x4*)lds; LAS float* ssl = (LAS float*)(lds + 65536);
    sg_partial((const bf16*)(ws + WS_ZR) + (size_t)row0 * 1024 + wave * 128, 1024, (const bf16*)(ws + WS_WO) + (size_t)col0 * 1024 + wave * 128, 1024, red, lane, wave);
    const int row = row0 + 16 * (wave >> 2) + fr, c = col0 + 16 * (wave & 3) + 4 * fq;
    const f32x4 xv = *(const f32x4*)(A.in[I_XS] + (size_t)(row - NPROMPT) * 1024 + c), q = *(const f32x4*)(A.in[I_N2G] + c);
    __syncthreads();
    const f32x4 o = xv + sg_sum(red, 0, 8, wave, lane);
    float ss = (o[0] * o[0] + o[1] * o[1]) + (o[2] * o[2] + o[3] * o[3]);
    v2u w; w.x = cvt_pk_bf16(o[0] * q[0], o[1] * q[1]); w.y = cvt_pk_bf16(o[2] * q[2], o[3] * q[3]); *(v2u*)((bf16*)(ws + WS_A1) + (size_t)row * 1024 + c) = w;
    ss += __shfl_xor(ss, 16); ss += __shfl_xor(ss, 32);
    if (fq == 0) ssl[wave * 16 + fr] = ss;
    __syncthreads();
    if (tid < 32) { const int mi = tid >> 4, r = tid & 15;
        ((float*)(ws + WS_SSP))[(size_t)(row0 + tid) * 16 + (t & 15)] = (ssl[(mi * 4 + 0) * 16 + r] + ssl[(mi * 4 + 1) * 16 + r]) + (ssl[(mi * 4 + 2) * 16 + r] + ssl[(mi * 4 + 3) * 16 + r]); }
}
__device__ __forceinline__ void sample_gemm4(const Args& A, LAS unsigned char* lds, int t, int lane, int wave) {
    unsigned char* ws = A.ws; const int fr = lane & 15, fq = lane >> 4;
    const int row0 = NPROMPT + (t >> 5) * 32, col0 = (t & 31) * 64;
    LAS f32x4* red = (LAS f32x4*)lds;
    sg_partial((const bf16*)(ws + WS_A1) + (size_t)row0 * 1024 + wave * 128, 1024, (const bf16*)(ws + WS_WQ) + (size_t)col0 * 1024 + wave * 128, 1024, red, lane, wave);
    const int row = row0 + 16 * (wave >> 2) + fr, c = col0 + 16 * (wave & 3) + 4 * fq;
    __syncthreads();
    const f32x4 o = sg_sum(red, 0, 8, wave, lane);
    v2u w; w.x = cvt_pk_bf16(o[0], o[1]); w.y = cvt_pk_bf16(o[2], o[3]); *(v2u*)((bf16*)(ws + WS_ZG) + (size_t)row * 2048 + c) = w;
    __syncthreads();
}

__global__ void __launch_bounds__(NTHR, 2) mk_fwd(Args args) {
    extern __shared__ __attribute__((aligned(16))) unsigned char lds_raw[];
    LAS unsigned char* lds = (LAS unsigned char*)lds_raw;
    const int tid = threadIdx.x, lane = tid & 63, wave = __builtin_amdgcn_readfirstlane(tid >> 6);
    const int G = gridDim.x; const int bx = blockIdx.x; const int vcu = (G % 8 == 0) ? (bx % 8) * (G / 8) + bx / 8 : bx;
    gu32* ctl = (gu32*)(args.ws + WS_CTL);
    volatile LAS unsigned* MISC = (volatile LAS unsigned*)(lds + MISC_OFF);
    for (int u = tid; u < (LDS_BYTES - LDSCTL_OFF) / 4; u += NTHR) ((LAS unsigned*)(lds + LDSCTL_OFF))[u] = 0u;
    __syncthreads();
    XcdBarrier bar; bar.bar = (unsigned*)(ctl + CW_BAR) + args.li * XCD_BAR_WORDS; bar.x = 0; bar.st = nullptr;
    if (N_LAUNCHES != PER_PHASE) bar = xcd_barrier_post((unsigned*)(ctl + CW_BAR) + args.li * XCD_BAR_WORDS, MISC + 8);
    const int lo = args.ph_lo, hi = args.ph_hi;
#define IN(k) (lo <= (k) && (k) < hi)
#define BOTH(k) (IN(k) && IN((k) + 1))
#define GRID_BAR() do { if (N_LAUNCHES != PER_PHASE) xcd_barrier(bar); } while (0)
    unsigned char* ws = args.ws;
    bf16* A1 = (bf16*)(ws + WS_A1);

    if (IN(0)) for (int rep_ = 0; rep_ < ((MK_REPEAT == 0) ? 2 : 1); ++rep_) { p0_prologue(args, lds, tid, lane, wave, vcu, G); if (BOTH(0)) GRID_BAR(); }

    if (IN(1)) for (int rep_ = 0; rep_ < ((MK_REPEAT == 1) ? 2 : 1); ++rep_) {
        pg8::Gemm g{A1, (const bf16*)(ws + WS_W1T), MPAD, N1, DM}; pg8::StaticOrder S; S.init(MPAD, N1, G, bx);
        pg8::EpiZ E{(bf16*)(ws + WS_ZC), (bf16*)(ws + WS_ZR), (bf16*)(ws + WS_ZG)};
        pg8::gemm_phase<pg8::EpiZ, pg8::StaticOrder, true, true>(lds, g, S, E);
        if (BOTH(1)) GRID_BAR();
    }

    if (IN(2)) for (int rep_ = 0; rep_ < ((MK_REPEAT == 2) ? 2 : 1); ++rep_) { conv_phase(args, vcu * NTHR + tid, G * NTHR); if (BOTH(2)) GRID_BAR(); }

    if (IN(3)) for (int rep_ = 0; rep_ < ((MK_REPEAT == 3) ? 2 : 1); ++rep_) {
        scan_pass1(args, lds, tid, lane, wave, vcu, G, (MK_REPEAT == 3 && rep_ == 0) ? 1 : 0);
        if (BOTH(3)) GRID_BAR();
    }

    if (IN(4)) {
        for (int u = vcu; u < 512; u += G) {
            if (u < 256) { const int bh = u >> 2, vq = u & 3; scan_pass2_rows(nullptr, bh * 64, 64, vq * 16, args.out + O_WKV_P + (size_t)bh * 4096, true, args, lds, tid, lane, wave); }
            else { const int bh = u - 256; scan_pass2_sample(args.in[I_SWKV] + (size_t)bh * 4096, NUNITS_P + bh, args.out + O_WKV_S + (size_t)bh * 4096, args, lane, wave); }
        }
        if (BOTH(4)) GRID_BAR();
    }

    if (IN(5)) for (int rep_ = 0; rep_ < ((MK_REPEAT == 5) ? 2 : 1); ++rep_) {
        for (int u2 = vcu; u2 < NUNITS / 2; u2 += G) scan_pass3_wave(args, u2 * 2 + (wave >> 2), wave & 3, lane);
        if (BOTH(5)) GRID_BAR();
    }

    if (IN(6)) {
        { pg8::Gemm g{A1, (const bf16*)(ws + WS_WPA), NPROMPT, DM, 512}; pg8::StaticOrder S; S.init(NPROMPT, DM, G, bx);
          pg8::EpiGate<0> E{(const bf16*)(ws + WS_ZG), (bf16*)(ws + WS_ZR)};
          pg8::gemm_phase<pg8::EpiGate<0>, pg8::StaticOrder, true, true>(lds, g, S, E); }
        { pg8::Gemm g{A1 + (size_t)MPAD * 512, (const bf16*)(ws + WS_WPB), NPROMPT, DM, 512}; pg8::StaticOrder S; S.init(NPROMPT, DM, G, bx);
          pg8::EpiGate<1> E{(const bf16*)(ws + WS_ZG), (bf16*)(ws + WS_ZR)};
          pg8::gemm_phase<pg8::EpiGate<1>, pg8::StaticOrder, true, true>(lds, g, S, E); }
        for (int t = vcu; t < 256; t += G) sample_gemm2(args, lds, t, lane, wave);
        if (BOTH(6)) GRID_BAR();
    }

    if (IN(7)) for (int rep_ = 0; rep_ < ((MK_REPEAT == 7) ? 2 : 1); ++rep_) {
        pg8::Gemm g{(const bf16*)(ws + WS_ZR), (const bf16*)(ws + WS_WO), NPROMPT, DM, DM}; pg8::StaticOrder S; S.init(NPROMPT, DM, G, bx);
        pg8::EpiX1 E{args.in[I_XP], args.in[I_XS], args.out + O_Y, A1, (float*)(ws + WS_SSP), args.in[I_N2G], NPROMPT, NTOK};
        pg8::gemm_phase<pg8::EpiX1, pg8::StaticOrder, true, true>(lds, g, S, E);
        for (int t = vcu; t < 256; t += G) sample_gemm3(args, lds, t, tid, lane, wave);
        if (BOTH(7)) GRID_BAR();
    }

    if (IN(8)) for (int rep_ = 0; rep_ < ((MK_REPEAT == 8) ? 2 : 1); ++rep_) {
        pg8::Gemm g{A1, (const bf16*)(ws + WS_WQ), NPROMPT, 2048, DM}; pg8::StaticOrder S; S.init(NPROMPT, 2048, G, bx);
        pg8::EpiPlain E{(bf16*)(ws + WS_ZG), 2048};
        pg8::gemm_phase<pg8::EpiPlain, pg8::StaticOrder, true, true>(lds, g, S, E);
        for (int t = vcu; t < 512; t += G) sample_gemm4(args, lds, t, lane, wave);
        if (BOTH(8)) GRID_BAR();
    }

    if (IN(9)) for (int rep_ = 0; rep_ < ((MK_REPEAT == 9) ? 2 : 1); ++rep_) { peer_topk_phase(args, lds, tid, lane, wave, vcu, G); if (BOTH(9)) GRID_BAR(); }
    if (IN(10)) for (int rep_ = 0; rep_ < ((MK_REPEAT == 10) ? 2 : 1); ++rep_) { if (rep_ == 0) peer_topk_sample_prelude(args, lds, tid, lane, wave, vcu, G, ctl); peer_u_phase(args, lds, tid, lane, wave, ctl, rep_ * 1024); if (BOTH(10)) GRID_BAR(); }
    if (IN(11)) { peer_coef_phase(args, lane, wave, vcu, G); if (BOTH(11)) GRID_BAR(); }
    if (IN(12)) { peer_v_phase(args, lds, tid, lane, wave, ctl); if (BOTH(12)) GRID_BAR(); }
    if (IN(13)) peer_final_phase(args, lane, wave, vcu, G);
#undef IN
#undef BOTH
#undef GRID_BAR
}

extern "C" void kernel_launch(void* const* d_in, const int* in_sizes, int n_in, void* d_out, int out_size, void* d_ws, size_t ws_size, hipStream_t stream) {
    static int grid = 0;
    if (grid == 0) {
        if (n_in != 32 || ws_size < WS_END) { fprintf(stderr, "kernel_launch: built for 32 inputs and >= %zu bytes of workspace; got n_in %d ws %zu; nothing launched\n", (size_t)WS_END, n_in, ws_size); grid = -1; return; }
        int dev = 0, cus = 0, per_cu = 0;
        if (hipGetDevice(&dev) != hipSuccess || hipDeviceGetAttribute(&cus, hipDeviceAttributeMultiprocessorCount, dev) != hipSuccess) { fprintf(stderr, "kernel_launch: device query failed\n"); grid = -1; return; }
        if (hipFuncSetAttribute((const void*)mk_fwd, hipFuncAttributeMaxDynamicSharedMemorySize, LDS_BYTES) != hipSuccess) { fprintf(stderr, "kernel_launch: hipFuncSetAttribute failed\n"); grid = -1; return; }
        if (hipOccupancyMaxActiveBlocksPerMultiprocessor(&per_cu, (const void*)mk_fwd, NTHR, LDS_BYTES) != hipSuccess || per_cu < 1)
            fprintf(stderr, "kernel_launch: note: occupancy query reports %d workgroups per CU\n", per_cu);
        (void)hipGetLastError();
        grid = cus;
    }
    if (grid < 0) return;
    if (hipMemsetAsync((char*)d_ws + WS_CTL, 0, CTL_ZERO_BYTES, stream) != hipSuccess) { fprintf(stderr, "kernel_launch: hipMemsetAsync failed\n"); return; }
    Args a{};
    for (int i = 0; i < 32; ++i) a.in[i] = (const float*)d_in[i];
    a.out = (float*)d_out; a.ws = (unsigned char*)d_ws;
    constexpr int NL = (N_LAUNCHES == PER_PHASE ? PER_PHASE : 1) + ((MK_EXTRA_LO >= 0) ? 1 : 0);
    for (int li = 0; li < NL; ++li) {
        if (N_LAUNCHES == PER_PHASE) { a.ph_lo = li; a.ph_hi = li + 1; } else { a.ph_lo = 0; a.ph_hi = PER_PHASE; }
        if (MK_EXTRA_LO >= 0 && li == NL - 1) { a.ph_lo = MK_EXTRA_LO; a.ph_hi = MK_EXTRA_HI; }
        a.li = li;
        hipLaunchKernelGGL(mk_fwd, dim3(grid), dim3(NTHR), LDS_BYTES, stream, a);
        const hipError_t le = hipPeekAtLastError();
        if (le != hipSuccess) { fprintf(stderr, "kernel_launch: launch %d failed: %s\n", li, hipGetErrorName(le)); break; }
    }
}
```

```cpp
#include <hip/hip_runtime.h>
#include <cstdio>
#include <cstdint>
#define MK_N_LAUNCHES 1
#define MK_REPEAT -1
#define MK_DBGSEL 0
#define MK_EXTRA_LO -1
#define MK_EXTRA_HI -1
namespace pg8 {
#define PG8_LAS __attribute__((address_space(3)))
typedef unsigned short bf16_t;
typedef short bf16x8 __attribute__((ext_vector_type(8)));
typedef float f32x4 __attribute__((ext_vector_type(4)));
typedef unsigned u32x4 __attribute__((ext_vector_type(4)));
constexpr int BM = 256, BK = 64, HALF = 128, HTB = HALF * BK * 2  , STAGE_BYTES = 8 * HTB, NXCD = 8, WGM = 8;

__host__ __device__ __forceinline__ int lds_byte(int r, int c) { const int st = (r >> 4) * 2 + (c >> 5), rr = r & 15, cc = c & 31, ob = rr * 64 + cc * 2; return st * 1024 + (ob ^ (((ob >> 9) & 1) << 5)); }
__host__ __device__ __forceinline__ void stage_rc(int b, int& R, int& C) { const int st = b / 1024, sb = b % 1024, swz = sb ^ (((sb >> 9) & 1) << 5); R = (st >> 1) * 16 + swz / 64; C = (st & 1) * 32 + (swz % 64) / 2; }
__host__ __device__ __forceinline__ int perm32(int rho) { const int n = rho >> 4, i = rho & 15; return 8 * (i >> 2) + 4 * n + (i & 3); }

struct Unit { int pm, pn; };
struct Gemm { const bf16_t* A; const bf16_t* Bt; int M, N, K; };

struct StaticOrder {
    int nM, nN, nwg, G, c;
    __host__ __device__ void init(int M, int N, int G_, int c_) { nM = M / BM; nN = N / BM; nwg = nM * nN; G = G_; c = c_; }
    __host__ __device__ bool next(int i, Unit& u) const {
        const long L = (long)i * G + c; if (L >= nwg) return false;
        int wgid = (int)L; { const int q = nwg / NXCD, r = nwg % NXCD, xcd = wgid % NXCD, off = wgid / NXCD; wgid = (xcd < r ? xcd * (q + 1) : r * (q + 1) + (xcd - r) * q) + off; }
        const int nig = WGM * nN, gid = wgid / nig, fm = gid * WGM, gsz = (nM - fm) < WGM ? (nM - fm) : WGM;
        u.pm = fm + ((wgid % nig) % gsz); u.pn = (wgid % nig) / gsz; return true;
    }
    __device__ __forceinline__ void a_ready(const Unit&) const {}
    __device__ __forceinline__ void done(const Unit&) const {}
};

typedef __bf16 bf16x2_cv __attribute__((ext_vector_type(2))); typedef float f32x2_cv __attribute__((ext_vector_type(2)));
__device__ __forceinline__ unsigned cvt_pk_bf16(float lo, float hi) { return __builtin_bit_cast(unsigned, __builtin_convertvector((f32x2_cv){lo, hi}, bf16x2_cv)); }
__device__ __forceinline__ float bf_lo(unsigned w) { return __uint_as_float(w << 16); }
__device__ __forceinline__ float bf_hi(unsigned w) { return __uint_as_float(w & 0xffff0000u); }
__device__ __forceinline__ float sigm(float x) { return __builtin_amdgcn_rcpf(1.0f + __expf(-x)); }

struct EpiZ {
    static constexpr bool PERM = true, AFTER_DRAIN = false;
    bf16_t *Zc, *Zr, *Zg;
    __device__ __forceinline__ void operator()(const f32x4 (&acc)[2][2][4][2], const Unit& u, int wr, int wc, int fr, int fq) const {
        bf16_t* base; int ldc, colt;
        if (u.pn < 6) { base = Zc; ldc = 1536; colt = u.pn * BM; }
        else if (u.pn < 14) { base = Zr; ldc = 2048; colt = (u.pn - 6) * BM; }
        else { base = Zg; ldc = 2048; colt = (u.pn - 14) * BM; }
        const int row0 = u.pm * BM + wr * 64 + fr, col0 = colt + wc * 32 + 8 * fq;
#pragma unroll
        for (int ai = 0; ai < 2; ++ai)
#pragma unroll
            for (int m = 0; m < 4; ++m) { bf16_t* rowp = base + (size_t)(row0 + ai * HALF + m * 16) * ldc + col0;
#pragma unroll
                for (int bj = 0; bj < 2; ++bj) { const f32x4 v0 = acc[ai][bj][m][0], v1 = acc[ai][bj][m][1];
                    u32x4 w; w.x = cvt_pk_bf16(v0[0], v0[1]); w.y = cvt_pk_bf16(v0[2], v0[3]); w.z = cvt_pk_bf16(v1[0], v1[1]); w.w = cvt_pk_bf16(v1[2], v1[3]);
                    *(u32x4*)(rowp + bj * HALF) = w; } }
    }
};
struct EpiPlain {
    static constexpr bool PERM = true, AFTER_DRAIN = false;
    bf16_t* O; int ldc;
    __device__ __forceinline__ void operator()(const f32x4 (&acc)[2][2][4][2], const Unit& u, int wr, int wc, int fr, int fq) const {
        const int row0 = u.pm * BM + wr * 64 + fr, col0 = u.pn * BM + wc * 32 + 8 * fq;
#pragma unroll
        for (int ai = 0; ai < 2; ++ai)
#pragma unroll
            for (int m = 0; m < 4; ++m) { bf16_t* rowp = O + (size_t)(row0 + ai * HALF + m * 16) * ldc + col0;
#pragma unroll
                for (int bj = 0; bj < 2; ++bj) { const f32x4 v0 = acc[ai][bj][m][0], v1 = acc[ai][bj][m][1];
                    u32x4 w; w.x = cvt_pk_bf16(v0[0], v0[1]); w.y = cvt_pk_bf16(v0[2], v0[3]); w.z = cvt_pk_bf16(v1[0], v1[1]); w.w = cvt_pk_bf16(v1[2], v1[3]);
                    *(u32x4*)(rowp + bj * HALF) = w; } }
    }
};
template <int SECOND> struct EpiGate {
    static constexpr bool PERM = true, AFTER_DRAIN = false;
    const bf16_t* Zg; bf16_t* MG;
    __device__ __forceinline__ void operator()(const f32x4 (&acc)[2][2][4][2], const Unit& u, int wr, int wc, int fr, int fq) const {
        const int row0 = u.pm * BM + wr * 64 + fr, col0 = u.pn * BM + wc * 32 + 8 * fq;
#pragma unroll
        for (int ai = 0; ai < 2; ++ai) {
            u32x4 gw[4][2], pw[4][2];
#pragma unroll
            for (int m = 0; m < 4; ++m) { const int r = row0 + ai * HALF + m * 16;
#pragma unroll
                for (int bj = 0; bj < 2; ++bj) { gw[m][bj] = *(const u32x4*)(Zg + (size_t)r * 2048 + SECOND * 1024 + col0 + bj * HALF);
                    if (SECOND) pw[m][bj] = *(const u32x4*)(MG + (size_t)r * 1024 + col0 + bj * HALF); } }
#pragma unroll
            for (int m = 0; m < 4; ++m) { const int r = row0 + ai * HALF + m * 16; bf16_t* op = MG + (size_t)r * 1024 + col0;
#pragma unroll
                for (int bj = 0; bj < 2; ++bj) { const u32x4 g = gw[m][bj]; f32x4 v0 = acc[ai][bj][m][0], v1 = acc[ai][bj][m][1];
                    v0[0] *= sigm(bf_lo(g.x)); v0[1] *= sigm(bf_hi(g.x)); v0[2] *= sigm(bf_lo(g.y)); v0[3] *= sigm(bf_hi(g.y));
                    v1[0] *= sigm(bf_lo(g.z)); v1[1] *= sigm(bf_hi(g.z)); v1[2] *= sigm(bf_lo(g.w)); v1[3] *= sigm(bf_hi(g.w));
                    if (SECOND) { const u32x4 p = pw[m][bj];
                        v0[0] += bf_lo(p.x); v0[1] += bf_hi(p.x); v0[2] += bf_lo(p.y); v0[3] += bf_hi(p.y);
                        v1[0] += bf_lo(p.z); v1[1] += bf_hi(p.z); v1[2] += bf_lo(p.w); v1[3] += bf_hi(p.w); }
                    u32x4 w; w.x = cvt_pk_bf16(v0[0], v0[1]); w.y = cvt_pk_bf16(v0[2], v0[3]); w.z = cvt_pk_bf16(v1[0], v1[1]); w.w = cvt_pk_bf16(v1[2], v1[3]);
                    *(u32x4*)(op + bj * HALF) = w; } }
        }
    }
};
struct EpiX1 {
    static constexpr bool PERM = false, AFTER_DRAIN = false;
    const float* xp; const float* xs; float* X1; bf16_t* X1B; float* SSP; const float* g2; int nprompt, nrows;
    __device__ __forceinline__ void operator()(const f32x4 (&acc)[2][2][4][2], const Unit& u, int wr, int wc, int fr, int fq) const {
        typedef unsigned u32x2v __attribute__((ext_vector_type(2)));
        const int col0 = u.pn * BM + wc * 32 + 4 * fq;
        f32x4 gq[2][2];
#pragma unroll
        for (int bj = 0; bj < 2; ++bj)
#pragma unroll
            for (int n = 0; n < 2; ++n) gq[bj][n] = *(const f32x4*)(g2 + col0 + bj * HALF + n * 16);
#pragma unroll
        for (int ai = 0; ai < 2; ++ai) {
            f32x4 xv[4][2][2];
#pragma unroll
            for (int m = 0; m < 4; ++m) { int r = u.pm * BM + ai * HALF + wr * 64 + m * 16 + fr; r = r < nrows ? r : nrows - 1;
                const float* xr = r < nprompt ? xp + (size_t)r * 1024 : xs + (size_t)(r - nprompt) * 1024;
#pragma unroll
                for (int bj = 0; bj < 2; ++bj)
#pragma unroll
                    for (int n = 0; n < 2; ++n) xv[m][bj][n] = *(const f32x4*)(xr + col0 + bj * HALF + n * 16); }
#pragma unroll
            for (int m = 0; m < 4; ++m) { const int r = u.pm * BM + ai * HALF + wr * 64 + m * 16 + fr; float ss = 0.f;
#pragma unroll
                for (int bj = 0; bj < 2; ++bj)
#pragma unroll
                    for (int n = 0; n < 2; ++n) { const int c = col0 + bj * HALF + n * 16; const f32x4 o = xv[m][bj][n] + acc[ai][bj][m][n];
                        ss += (o[0] * o[0] + o[1] * o[1]) + (o[2] * o[2] + o[3] * o[3]);
                        const f32x4 q = gq[bj][n]; u32x2v w; w.x = cvt_pk_bf16(o[0] * q[0], o[1] * q[1]); w.y = cvt_pk_bf16(o[2] * q[2], o[3] * q[3]);
                        if (r < nrows) *(u32x2v*)(X1B + (size_t)r * 1024 + c) = w; }
                ss += __shfl_xor(ss, 16); ss += __shfl_xor(ss, 32);
                if (fq == 0 && r < nrows) SSP[(size_t)r * 16 + u.pn * 4 + wc] = ss;
            }
        }
    }
};
template <class Epi, class Sched, bool ALIGN_EPI = false, bool SP2 = false>
__device__ __forceinline__ void gemm_phase(PG8_LAS unsigned char* lds, const Gemm g, const Sched& S, const Epi& E) {
    const int tid = threadIdx.x, wid = __builtin_amdgcn_readfirstlane(tid >> 6), lane = tid & 63, wr = wid >> 2, wc = wid & 3, fr = lane & 15, fq = lane >> 4;
    const int K = g.K, nt = K / BK;
    unsigned voffA[2], voffB[2];
#pragma unroll
    for (int i = 0; i < 2; ++i) { int R, C; stage_rc(tid * 16 + i * 8192, R, C); const int Rb = Epi::PERM ? ((R & ~31) + perm32(R & 31)) : R;
        voffA[i] = (unsigned)(R * K + C) * 2u; voffB[i] = (unsigned)(Rb * K + C) * 2u; }
    const size_t kstep = (size_t)(BK * 2);
    const size_t hstep = (size_t)HALF * K * 2;
    const size_t tstep = 2 * hstep;
    const unsigned ldsw = (unsigned)wid * 1024u;
    const int aoff = lds_byte(wr * 64 + fr, fq * 8), boff = lds_byte(wc * 32 + fr, fq * 8);
#define PG8_SA(b, h) (((b) * 2 + (h)) * HTB)
#define PG8_SB(b, h) ((4 + (b) * 2 + (h)) * HTB)
#define PG8_STAGE(bufoff, gbase, voff) do { _Pragma("unroll") for (int _i = 0; _i < 2; ++_i) \
        __builtin_amdgcn_global_load_lds((const unsigned*)((const char*)(gbase) + (voff)[_i]), (PG8_LAS unsigned*)(lds + (bufoff) + ldsw + _i * 8192), 16, 0, 0); } while (0)
#define PG8_LDA(dst, b, h) do { _Pragma("unroll") for (int m = 0; m < 4; ++m) _Pragma("unroll") for (int k = 0; k < 2; ++k) dst[m][k] = *(const PG8_LAS bf16x8*)(lds + PG8_SA(b, h) + aoff + m * 2048 + k * 1024); } while (0)
#define PG8_LDB(dst, b, h) do { _Pragma("unroll") for (int n = 0; n < 2; ++n) _Pragma("unroll") for (int k = 0; k < 2; ++k) dst[n][k] = *(const PG8_LAS bf16x8*)(lds + PG8_SB(b, h) + boff + n * 2048 + k * 1024); } while (0)
#define PG8_MMA(ai, bj, At, Bt) do { __builtin_amdgcn_s_setprio(1); _Pragma("unroll") for (int m = 0; m < 4; ++m) _Pragma("unroll") for (int n = 0; n < 2; ++n) _Pragma("unroll") for (int k = 0; k < 2; ++k) \
        acc[ai][bj][m][n] = __builtin_amdgcn_mfma_f32_16x16x32_bf16(Bt[n][k], At[m][k], acc[ai][bj][m][n], 0, 0, 0); __builtin_amdgcn_s_setprio(0); } while (0)
#define PG8_WAIT_V(n) asm volatile("s_waitcnt vmcnt(" #n ")" ::: "memory")
#define PG8_WAIT_L(n) asm volatile("s_waitcnt lgkmcnt(" #n ")" ::: "memory")
#define PG8_BAR __builtin_amdgcn_s_barrier()
#define PG8_SCHED __builtin_amdgcn_sched_barrier(0)
    Unit cur, nxt; int ui = 0;
    if (!S.next(0, cur)) return;
    f32x4 acc[2][2][4][2];
#pragma unroll
    for (int a = 0; a < 2; ++a)
#pragma unroll
        for (int b = 0; b < 2; ++b)
#pragma unroll
            for (int m = 0; m < 4; ++m)
#pragma unroll
                for (int n = 0; n < 2; ++n) acc[a][b][m][n] = (f32x4){0.f, 0.f, 0.f, 0.f};
    bf16x8 At[4][2], B0[2][2], B1[2][2];
    const char* cA = (const char*)g.A + (size_t)cur.pm * tstep; const char* cB = (const char*)g.Bt + (size_t)cur.pn * tstep;
    S.a_ready(cur);
    if constexpr (SP2) {
        PG8_STAGE(PG8_SB(0, 0), cB, voffB); PG8_STAGE(PG8_SB(0, 1), cB + hstep, voffB); PG8_STAGE(PG8_SA(0, 0), cA, voffA); PG8_STAGE(PG8_SA(0, 1), cA + hstep, voffA);
        if (wr == 1) PG8_BAR;
        PG8_WAIT_V(2); PG8_BAR;
        PG8_STAGE(PG8_SB(1, 0), cB + kstep, voffB); PG8_STAGE(PG8_SA(1, 0), cA + kstep, voffA); PG8_STAGE(PG8_SB(1, 1), cB + hstep + kstep, voffB);
        PG8_WAIT_V(6); PG8_BAR;
    } else {
        PG8_STAGE(PG8_SB(0, 0), cB, voffB); PG8_STAGE(PG8_SA(0, 0), cA, voffA); PG8_STAGE(PG8_SB(0, 1), cB + hstep, voffB); PG8_STAGE(PG8_SA(0, 1), cA + hstep, voffA);
        if (wr == 1) PG8_BAR;
        PG8_WAIT_V(4); PG8_BAR;
        PG8_STAGE(PG8_SB(1, 0), cB + kstep, voffB); PG8_STAGE(PG8_SA(1, 0), cA + kstep, voffA); PG8_STAGE(PG8_SB(1, 1), cB + hstep + kstep, voffB);
        PG8_WAIT_V(6); PG8_BAR;
    }
    for (;;) {
        const bool has_next = S.next(ui + 1, nxt);
        const char* nA = has_next ? (const char*)g.A + (size_t)nxt.pm * tstep : cA; const char* nB = has_next ? (const char*)g.Bt + (size_t)nxt.pn * tstep : cB;
        for (int t = 0; t < nt; t += 2) {
            const bool last = (t == nt - 2);
            const char* a1 = cA + (size_t)(t + 1) * kstep;
            const char* a2 = last ? nA : cA + (size_t)(t + 2) * kstep; const char* b2 = last ? nB : cB + (size_t)(t + 2) * kstep;
            const char* a3 = a2 + kstep; const char* b3 = b2 + kstep;
            if (last && has_next) S.a_ready(nxt);
            if constexpr (SP2) {
            PG8_LDB(B0, 0, 0); PG8_LDB(B1, 0, 1); PG8_SCHED; PG8_LDA(At, 0, 0); PG8_STAGE(PG8_SA(1, 1), a1 + hstep, voffA);
            PG8_WAIT_V(8); PG8_WAIT_L(0); PG8_BAR; PG8_MMA(0, 0, At, B0); PG8_MMA(0, 1, At, B1); PG8_BAR; PG8_SCHED;
            PG8_LDA(At, 0, 1); PG8_STAGE(PG8_SB(0, 0), b2, voffB); PG8_STAGE(PG8_SB(0, 1), b2 + hstep, voffB); PG8_STAGE(PG8_SA(0, 0), a2, voffA);
            PG8_WAIT_V(8); PG8_WAIT_L(0); PG8_BAR; PG8_MMA(1, 0, At, B0); PG8_MMA(1, 1, At, B1); PG8_BAR; PG8_SCHED;
            PG8_LDB(B0, 1, 0); PG8_LDB(B1, 1, 1); PG8_SCHED; PG8_LDA(At, 1, 0); PG8_STAGE(PG8_SA(0, 1), a2 + hstep, voffA);
            PG8_WAIT_V(8); PG8_WAIT_L(0); PG8_BAR; PG8_MMA(0, 0, At, B0); PG8_MMA(0, 1, At, B1); PG8_BAR; PG8_SCHED;
            PG8_LDA(At, 1, 1); PG8_STAGE(PG8_SB(1, 0), b3, voffB); PG8_STAGE(PG8_SB(1, 1), b3 + hstep, voffB); PG8_STAGE(PG8_SA(1, 0), a3, voffA);
            PG8_WAIT_V(8); PG8_WAIT_L(0); PG8_BAR; PG8_MMA(1, 0, At, B0); PG8_MMA(1, 1, At, B1); PG8_BAR; PG8_SCHED;
            } else {
            PG8_LDB(B0, 0, 0); PG8_SCHED; PG8_LDA(At, 0, 0); PG8_STAGE(PG8_SA(1, 1), a1 + hstep, voffA);
            PG8_WAIT_L(8); PG8_BAR; PG8_WAIT_L(0); PG8_MMA(0, 0, At, B0); PG8_BAR; PG8_SCHED;
            PG8_LDB(B1, 0, 1); PG8_STAGE(PG8_SB(0, 0), b2, voffB);
            PG8_BAR; PG8_WAIT_L(0); PG8_MMA(0, 1, At, B1); PG8_BAR;
            PG8_LDA(At, 0, 1); PG8_STAGE(PG8_SA(0, 0), a2, voffA);
            PG8_BAR; PG8_WAIT_L(0); PG8_MMA(1, 0, At, B0); PG8_BAR; PG8_SCHED;
            PG8_STAGE(PG8_SB(0, 1), b2 + hstep, voffB);
            PG8_WAIT_V(6); PG8_BAR; PG8_MMA(1, 1, At, B1); PG8_BAR;
            PG8_LDB(B0, 1, 0); PG8_SCHED; PG8_LDA(At, 1, 0); PG8_STAGE(PG8_SA(0, 1), a2 + hstep, voffA);
            PG8_WAIT_L(8); PG8_BAR; PG8_WAIT_L(0); PG8_MMA(0, 0, At, B0); PG8_BAR; PG8_SCHED;
            PG8_LDB(B1, 1, 1); PG8_STAGE(PG8_SB(1, 0), b3, voffB);
            PG8_BAR; PG8_WAIT_L(0); PG8_MMA(0, 1, At, B1); PG8_BAR;
            PG8_LDA(At, 1, 1); PG8_STAGE(PG8_SA(1, 0), a3, voffA);
            PG8_BAR; PG8_WAIT_L(0); PG8_MMA(1, 0, At, B0); PG8_BAR; PG8_SCHED;
            PG8_STAGE(PG8_SB(1, 1), b3 + hstep, voffB);
            PG8_WAIT_V(6); PG8_BAR; PG8_MMA(1, 1, At, B1); PG8_BAR;
            }
        }
        if constexpr (ALIGN_EPI) { if (wr == 0) PG8_BAR; }
        if constexpr (!Epi::AFTER_DRAIN) { E(acc, cur, wr, wc, fr, fq); S.done(cur); }
        if (!has_next) break;
#pragma unroll
        for (int a = 0; a < 2; ++a)
#pragma unroll
            for (int b = 0; b < 2; ++b)
#pragma unroll
                for (int m = 0; m < 4; ++m)
#pragma unroll
                    for (int n = 0; n < 2; ++n) acc[a][b][m][n] = (f32x4){0.f, 0.f, 0.f, 0.f};
        cur = nxt; cA = nA; cB = nB; ++ui;
        if constexpr (ALIGN_EPI) { if (wr == 1) PG8_BAR; }
    }
    PG8_WAIT_V(0);
    if constexpr (!ALIGN_EPI) { if (wr == 0) PG8_BAR; }
    PG8_BAR;
    if constexpr (Epi::AFTER_DRAIN) { E.fused(acc, cur, wr, wc, fr, fq, lds, wid, lane); S.done(cur); }
#undef PG8_SA
#undef PG8_SB
#undef PG8_STAGE
#undef PG8_LDA
#undef PG8_LDB
#undef PG8_MMA
#undef PG8_WAIT_V
#undef PG8_WAIT_L
#undef PG8_BAR
#undef PG8_SCHED
}
}
constexpr int NWAVES = 8, NTHR = 512;
#ifndef MK_N_LAUNCHES
#define MK_N_LAUNCHES 1
#endif
constexpr int PER_PHASE = 14;
constexpr int N_LAUNCHES = MK_N_LAUNCHES;

constexpr int DM = 1024, NPROMPT = 32768, NSAMP = 512, NTOK = 33280, NSHIFT = 32, MPAD = 33536, N1 = 5632;
constexpr int SEQ_P = 4096, SEQ_S = 16, NB_P = 8, NB_S = 32;
constexpr size_t O_Y = 0, O_CONV_P = 34078720, O_SHIFT_P = 34086912, O_WKV_P = 34095104, O_CONV_S = 34357248, O_SHIFT_S = 34390016, O_WKV_S = 34422784;
constexpr size_t KiB = 1024, MiB = 1u << 20;
constexpr size_t WS_CTL = 0, CTL_ZERO_BYTES = 64 * KiB;
constexpr size_t WS_W1T = 64 * KiB;
constexpr size_t WS_WPA = WS_W1T + (size_t)N1 * DM * 2;
constexpr size_t WS_WPB = WS_WPA + 1 * MiB;
constexpr size_t WS_WO = WS_WPB + 1 * MiB;
constexpr size_t WS_WQ = WS_WO + 2 * MiB;
constexpr size_t WS_KEYS = WS_WQ + 4 * MiB;
constexpr size_t WS_L2T = WS_KEYS + 512 * KiB;
constexpr size_t WS_SSP = WS_L2T + 256 * KiB;
constexpr size_t WS_UB = WS_SSP + (size_t)MPAD * 16 * 4;
constexpr size_t WS_VB = WS_UB + 16 * MiB;
constexpr size_t WS_A1 = WS_VB + 16 * MiB;
constexpr size_t WS_ZC = WS_A1 + (size_t)MPAD * DM * 2;
constexpr size_t WS_ZR = WS_ZC + (size_t)MPAD * 1536 * 2;
constexpr size_t WS_ZG = WS_ZR + (size_t)MPAD * 2048 * 2;
constexpr size_t WS_END = WS_ZG + (size_t)MPAD * 2048 * 2;
constexpr size_t WS_YL = WS_ZC, WS_ZT = WS_ZC + (size_t)NTOK * 512 * 2, WS_BV = WS_ZC + (size_t)NTOK * 512 * 4;
constexpr size_t WS_EIDX = WS_ZC, WS_GATE = WS_ZC + 16 * MiB, WS_COEF = WS_ZC + 40 * MiB, WS_SS2 = WS_ZC + 64 * MiB, WS_RSTD = WS_ZC + 66 * MiB;
constexpr size_t WS_PART = WS_ZR;
constexpr size_t OB_MB = (size_t)4352 * 4096 * 4;
constexpr size_t OB_S0S = OB_MB + (size_t)4352 * 4096 * 2;
static_assert(WS_BV + (size_t)NTOK * 512 * 2 <= WS_ZR && OB_S0S + (size_t)256 * 4096 * 2 <= (size_t)NTOK * 1024 * 4, "scan scratch maps");
static_assert(WS_END <= 512 * MiB, "d_ws map must fit 512 MiB");
constexpr float PEER_SU = 32.0f, PEER_SV = 4.0f;
constexpr int CW_BAR = 1024;
constexpr int LDS_BYTES = 163840;
constexpr int LDSCTL_OFF = LDS_BYTES - 512, MISC_OFF = LDSCTL_OFF + 320;

#define GAS __attribute__((address_space(1)))
#define LAS __attribute__((address_space(3)))
typedef unsigned short bf16;
typedef unsigned v4u __attribute__((ext_vector_type(4)));
typedef unsigned v2u __attribute__((ext_vector_type(2)));
typedef float f32x4 __attribute__((ext_vector_type(4)));
typedef short bf16x8 __attribute__((ext_vector_type(8)));
typedef __bf16 bf16x2_t __attribute__((ext_vector_type(2)));
typedef GAS unsigned gu32;
#define RLX_AGENT __ATOMIC_RELAXED, __HIP_MEMORY_SCOPE_AGENT
#define LDS_WAIT() asm volatile("s_waitcnt lgkmcnt(0)" ::: "memory")
#define VM_WAIT() asm volatile("s_waitcnt vmcnt(0)" ::: "memory")
using pg8::cvt_pk_bf16; using pg8::bf_lo; using pg8::bf_hi; using pg8::sigm;
#define XB_TMO      128
#define XB_XCNT(j)  (256  + 64 * (j))
#define XB_XSUB(j)  (1280 + 64 * (j))
#define XB_XGEN(j)  (2304 + 64 * (j))
#define XB_TOP      3328
#define XB_TOPGEN   3392
#define XCD_BAR_WORDS 3456
#define XB_SPIN_CAP (1u << 22)

__device__ __forceinline__ unsigned xb_ld(unsigned* p)              { return __hip_atomic_load(p, __ATOMIC_RELAXED, __HIP_MEMORY_SCOPE_AGENT); }
__device__ __forceinline__ unsigned xb_add(unsigned* p, unsigned v) { return __hip_atomic_fetch_add(p, v, __ATOMIC_RELAXED, __HIP_MEMORY_SCOPE_AGENT); }
__device__ __forceinline__ unsigned xb_xcc_id() { return (unsigned)__builtin_amdgcn_s_getreg((3 << 11) | 20) & 0xFu; }
#define XB_SPIN(cond, bar) do { unsigned _sp = 0; while (cond) { __builtin_amdgcn_s_sleep(1); \
    if ((++_sp & 255u) == 0u) { if (xb_ld(&(bar)[XB_TMO])) break; if (_sp > XB_SPIN_CAP) { atomicAdd(&(bar)[XB_TMO], 1u); break; } } } } while (0)

struct XcdBarrier {
    unsigned* bar; unsigned x;
    volatile LAS unsigned* st;
};

__device__ __forceinline__ XcdBarrier xcd_barrier_post(unsigned* bar, volatile LAS unsigned* st) {
    XcdBarrier b; b.bar = bar; b.x = xb_xcc_id(); b.st = st;
    if (threadIdx.x == 0) (void)xb_add(&bar[XB_XCNT(b.x)], 1u);
    return b;
}
__device__ __forceinline__ void xcd_barrier_complete(unsigned* bar, unsigned x, unsigned& nloc, unsigned& nx) {
    const unsigned G = gridDim.x * gridDim.y * gridDim.z;
    unsigned sum, cnt, mine, sp = 0u;
    for (;;) {
        sum = 0u; cnt = 0u; mine = 0u;
#pragma unroll
        for (unsigned j = 0; j < 16; ++j) { const unsigned c = xb_ld(&bar[XB_XCNT(j)]); sum += c; cnt += (c > 0u) ? 1u : 0u; mine = (j == x) ? c : mine; }
        if (sum == G) break;
        __builtin_amdgcn_s_sleep(1);
        if ((++sp & 255u) == 0u) { if (xb_ld(&bar[XB_TMO])) break; if (sp > XB_SPIN_CAP) { atomicAdd(&bar[XB_TMO], 1u); break; } }
    }
    nloc = mine > 0u ? mine : 1u; nx = cnt > 0u ? cnt : 1u;
}

__device__ __forceinline__ void xcd_barrier(const XcdBarrier& b) {
    asm volatile("s_waitcnt vmcnt(0)" ::: "memory");
    __syncthreads();
    if (threadIdx.x == 0) {
        unsigned* bar = b.bar;
        __builtin_amdgcn_s_waitcnt(0);
        unsigned nloc = b.st[0], nx = b.st[1];
        if (nloc == 0u) { xcd_barrier_complete(bar, b.x, nloc, nx); b.st[0] = nloc; b.st[1] = nx; }
        const unsigned old = xb_add(&bar[XB_XSUB(b.x)], 1u);
        const unsigned gen = old / nloc;
        if (old + 1u == (gen + 1u) * nloc) {
            __builtin_amdgcn_fence(__ATOMIC_RELEASE, "agent");
            asm volatile("s_waitcnt vmcnt(0)" ::: "memory");
            const unsigned og = xb_add(&bar[XB_TOP], 1u);
            const unsigned tg = og / nx;
            if (og + 1u == (tg + 1u) * nx) xb_add(&bar[XB_TOPGEN], 1u);
            else XB_SPIN(xb_ld(&bar[XB_TOPGEN]) == tg, bar);
            __builtin_amdgcn_fence(__ATOMIC_ACQUIRE, "agent");
            xb_add(&bar[XB_XGEN(b.x)], 1u);
            asm volatile("s_waitcnt vmcnt(0)" ::: "memory");
        } else {
            XB_SPIN(xb_ld(&bar[XB_XGEN(b.x)]) == gen, bar);
            __builtin_amdgcn_fence(__ATOMIC_ACQUIRE, "agent");
            asm volatile("s_waitcnt vmcnt(0)" ::: "memory");
        }
    }
    __syncthreads();
}
struct Args { const float* in[32]; float* out; unsigned char* ws; int ph_lo, ph_hi, li, pad; };
enum { I_XP = 0, I_XS, I_SCONV, I_SSHIFT, I_SWKV, I_N1G, I_WIN, I_CONVW, I_MURKV, I_MUWAG, I_W0, I_W1, I_W2, I_A0, I_A1, I_A2, I_G1, I_G2, I_KK, I_KA, I_RK, I_GNW, I_GNB, I_WPA, I_WPB, I_WO, I_N2G, I_WQ, I_KEYS, I_U, I_V, I_NFG };

__device__ __forceinline__ float wave_sum(float v) {
#pragma unroll
    for (int o = 1; o < 64; o <<= 1) v += __shfl_xor(v, o);
    return v;
}
template <int CTRL> __device__ __forceinline__ float dpp_mov(float v) { return __builtin_bit_cast(float, __builtin_amdgcn_update_dpp(0, __builtin_bit_cast(int, v), CTRL, 0xF, 0xF, true)); }
__device__ __forceinline__ float sum4(float v) { v += dpp_mov<0xB1>(v); v += dpp_mov<0x4E>(v); return v; }
__device__ __forceinline__ float sum8(float v) { v = sum4(v); v += dpp_mov<0x141>(v); return v; }
__device__ __forceinline__ float sum16(float v) { v = sum8(v); v += dpp_mov<0x140>(v); return v; }
__device__ __forceinline__ float dot2bf(unsigned w, unsigned x, float acc) { return __builtin_amdgcn_fdot2_f32_bf16(__builtin_bit_cast(bf16x2_t, w), __builtin_bit_cast(bf16x2_t, x), acc, false); }

__device__ __forceinline__ void transpose_item(const float* W, int ldw, int c0, int K, bf16* WT, int nblk, int item, const float* sv, float alpha, float beta, LAS float* scr, int lane) {
    const int kb = item / nblk, nb = item % nblk, k0 = 64 * kb, n0 = 32 * nb;
#pragma unroll 8
    for (int i = 0; i < 32; ++i) { const int kk = 2 * i + (lane >> 5); float s = 1.f; if (sv) s = alpha + beta * sv[k0 + kk];
        scr[kk * 33 + (lane & 31)] = W[(size_t)(k0 + kk) * ldw + c0 + n0 + (lane & 31)] * s; }
    LDS_WAIT();
    const int c = lane & 7;
#pragma unroll
    for (int j = 0; j < 4; ++j) { const int n = (lane >> 3) + 8 * j; const LAS float* s = scr + (8 * c) * 33 + n;
        v4u o; o.x = cvt_pk_bf16(s[0 * 33], s[1 * 33]); o.y = cvt_pk_bf16(s[2 * 33], s[3 * 33]); o.z = cvt_pk_bf16(s[4 * 33], s[5 * 33]); o.w = cvt_pk_bf16(s[6 * 33], s[7 * 33]);
        *(v4u*)(WT + (size_t)(n0 + n) * K + k0 + 8 * c) = o; }
    LDS_WAIT();
}
__device__ __forceinline__ void cvt_stream(const float* src, bf16* dst, size_t n, size_t gt, size_t nthreads) {
    for (size_t i = gt * 8; i < n; i += nthreads * 8) { const f32x4 a = *(const f32x4*)(src + i), b = *(const f32x4*)(src + i + 4);
        v4u o; o.x = cvt_pk_bf16(a[0], a[1]); o.y = cvt_pk_bf16(a[2], a[3]); o.z = cvt_pk_bf16(b[0], b[1]); o.w = cvt_pk_bf16(b[2], b[3]); *(v4u*)(dst + i) = o; }
}
__device__ __forceinline__ void cvt_stream_fp8(const float* src, unsigned char* dst, size_t n, float scale, size_t gt, size_t nthreads) {
    for (size_t i = gt * 16; i < n; i += nthreads * 16) {
        const f32x4 a = *(const f32x4*)(src + i) * scale, b = *(const f32x4*)(src + i + 4) * scale, c = *(const f32x4*)(src + i + 8) * scale, d = *(const f32x4*)(src + i + 12) * scale;
        v4u o; unsigned p;
        p = __builtin_amdgcn_cvt_pk_fp8_f32(a[0], a[1], 0, false); o.x = __builtin_amdgcn_cvt_pk_fp8_f32(a[2], a[3], p, true);
        p = __builtin_amdgcn_cvt_pk_fp8_f32(b[0], b[1], 0, false); o.y = __builtin_amdgcn_cvt_pk_fp8_f32(b[2], b[3], p, true);
        p = __builtin_amdgcn_cvt_pk_fp8_f32(c[0], c[1], 0, false); o.z = __builtin_amdgcn_cvt_pk_fp8_f32(c[2], c[3], p, true);
        p = __builtin_amdgcn_cvt_pk_fp8_f32(d[0], d[1], 0, false); o.w = __builtin_amdgcn_cvt_pk_fp8_f32(d[2], d[3], p, true);
        *(v4u*)(dst + i) = o; }
}
__device__ __forceinline__ void cvt16_fp8_sliced(const float* src, unsigned char* dst, float scale, size_t i) {
    const f32x4 a = *(const f32x4*)(src + i) * scale, b = *(const f32x4*)(src + i + 4) * scale, c = *(const f32x4*)(src + i + 8) * scale, d = *(const f32x4*)(src + i + 12) * scale;
    v4u o; unsigned p;
    p = __builtin_amdgcn_cvt_pk_fp8_f32(a[0], a[1], 0, false); o.x = __builtin_amdgcn_cvt_pk_fp8_f32(a[2], a[3], p, true);
    p = __builtin_amdgcn_cvt_pk_fp8_f32(b[0], b[1], 0, false); o.y = __builtin_amdgcn_cvt_pk_fp8_f32(b[2], b[3], p, true);
    p = __builtin_amdgcn_cvt_pk_fp8_f32(c[0], c[1], 0, false); o.z = __builtin_amdgcn_cvt_pk_fp8_f32(c[2], c[3], p, true);
    p = __builtin_amdgcn_cvt_pk_fp8_f32(d[0], d[1], 0, false); o.w = __builtin_amdgcn_cvt_pk_fp8_f32(d[2], d[3], p, true);
    const size_t e = i >> 10, col = i & 1023;
    *(v4u*)(dst + (col >> 7) * ((size_t)16384 * 128) + e * 128 + (col & 127)) = o;
}
__device__ __forceinline__ void cvt_stream_fp8_sliced(const float* src, unsigned char* dst, float scale, size_t gt, size_t nthreads) {
#pragma unroll 2
    for (size_t i = gt * 16; i < (size_t)16384 * 1024; i += nthreads * 16) {
        const f32x4 a = *(const f32x4*)(src + i) * scale, b = *(const f32x4*)(src + i + 4) * scale, c = *(const f32x4*)(src + i + 8) * scale, d = *(const f32x4*)(src + i + 12) * scale;
        v4u o; unsigned p;
        p = __builtin_amdgcn_cvt_pk_fp8_f32(a[0], a[1], 0, false); o.x = __builtin_amdgcn_cvt_pk_fp8_f32(a[2], a[3], p, true);
        p = __builtin_amdgcn_cvt_pk_fp8_f32(b[0], b[1], 0, false); o.y = __builtin_amdgcn_cvt_pk_fp8_f32(b[2], b[3], p, true);
        p = __builtin_amdgcn_cvt_pk_fp8_f32(c[0], c[1], 0, false); o.z = __builtin_amdgcn_cvt_pk_fp8_f32(c[2], c[3], p, true);
        p = __builtin_amdgcn_cvt_pk_fp8_f32(d[0], d[1], 0, false); o.w = __builtin_amdgcn_cvt_pk_fp8_f32(d[2], d[3], p, true);
        const size_t e = i >> 10, col = i & 1023;
        *(v4u*)(dst + (col >> 7) * ((size_t)16384 * 128) + e * 128 + (col & 127)) = o; }
}
__device__ __forceinline__ void p0_prologue(const Args& A, LAS unsigned char* lds, int tid, int lane, int wave, int vcu, int G) {
    unsigned char* ws = A.ws;
    bf16* W1T = (bf16*)(ws + WS_W1T);
    LAS float* scr = (LAS float*)(lds + wave * 16384);
    const int gw = vcu * NWAVES + wave, NGW = G * NWAVES;
    constexpr int J0 = 16 * 96, J1 = 16 * 64, JL = 16 * 2, JG = 16 * 4, JP = 8 * 32, JO = 16 * 32, JQ = 16 * 64;
    constexpr int JW2 = 16, JG2 = 32;
    constexpr int NITEMS = J0 + J1 + 4 * JL + 2 * JG + 2 * JP + JO + JQ + 2 * JW2 + JG2;
    bf16* L2T = (bf16*)(ws + WS_L2T);
    const float* mu = A.in[I_MUWAG];
    for (int it = gw; it < NITEMS; it += NGW) {
        int r = it;
        if (r < J0) { transpose_item(A.in[I_WIN], 5120, 0, 1024, W1T, 96, r, nullptr, 0.f, 0.f, scr, lane); continue; } r -= J0;
        if (r < J1) { transpose_item(A.in[I_WIN], 5120, 3072, 1024, W1T + (size_t)3584 * 1024, 64, r, nullptr, 0.f, 0.f, scr, lane); continue; } r -= J1;
        if (r < JL) { transpose_item(A.in[I_W1], 64, 0, 1024, W1T + (size_t)3072 * 1024, 2, r, mu, 1.f, -1.f, scr, lane); continue; } r -= JL;
        if (r < JL) { transpose_item(A.in[I_W1], 64, 0, 1024, W1T + (size_t)3328 * 1024, 2, r, mu, 0.f, 1.f, scr, lane); continue; } r -= JL;
        if (r < JL) { transpose_item(A.in[I_A1], 64, 0, 1024, W1T + (size_t)(3072 + 64) * 1024, 2, r, mu + 1024, 1.f, -1.f, scr, lane); continue; } r -= JL;
        if (r < JL) { transpose_item(A.in[I_A1], 64, 0, 1024, W1T + (size_t)(3328 + 64) * 1024, 2, r, mu + 1024, 0.f, 1.f, scr, lane); continue; } r -= JL;
        if (r < JG) { transpose_item(A.in[I_G1], 128, 0, 1024, W1T + (size_t)(3072 + 128) * 1024, 4, r, mu + 2048, 1.f, -1.f, scr, lane); continue; } r -= JG;
        if (r < JG) { transpose_item(A.in[I_G1], 128, 0, 1024, W1T + (size_t)(3328 + 128) * 1024, 4, r, mu + 2048, 0.f, 1.f, scr, lane); continue; } r -= JG;
        if (r < JP) { transpose_item(A.in[I_WPA], 1024, 0, 512, (bf16*)(ws + WS_WPA), 32, r, nullptr, 0.f, 0.f, scr, lane); continue; } r -= JP;
        if (r < JP) { transpose_item(A.in[I_WPB], 1024, 0, 512, (bf16*)(ws + WS_WPB), 32, r, nullptr, 0.f, 0.f, scr, lane); continue; } r -= JP;
        if (r < JO) { transpose_item(A.in[I_WO], 1024, 0, 1024, (bf16*)(ws + WS_WO), 32, r, nullptr, 0.f, 0.f, scr, lane); continue; } r -= JO;
        if (r < JQ) { transpose_item(A.in[I_WQ], 2048, 0, 1024, (bf16*)(ws + WS_WQ), 64, r, nullptr, 0.f, 0.f, scr, lane); continue; } r -= JQ;
        if (r < JW2) { transpose_item(A.in[I_W2], 512, 0, 64, L2T, 16, r, nullptr, 0.f, 0.f, scr, lane); continue; } r -= JW2;
        if (r < JW2) { transpose_item(A.in[I_A2], 512, 0, 64, L2T + (size_t)512 * 64, 16, r, nullptr, 0.f, 0.f, scr, lane); continue; } r -= JW2;
        transpose_item(A.in[I_G2], 512, 0, 128, L2T + (size_t)1024 * 64, 16, r, nullptr, 0.f, 0.f, scr, lane);
    }
    const size_t gt = (size_t)vcu * NTHR + tid, nth = (size_t)G * NTHR;
    if (G != 256) {
        cvt_stream_fp8_sliced(A.in[I_U], ws + WS_UB, PEER_SU, gt, nth);
        cvt_stream_fp8_sliced(A.in[I_V], ws + WS_VB, PEER_SV, gt, nth); }
    cvt_stream(A.in[I_KEYS], (bf16*)(ws + WS_KEYS), (size_t)8 * 2 * 128 * 128, gt, nth);
    bf16* A1 = (bf16*)(ws + WS_A1);
    const f32x4* g1v = (const f32x4*)A.in[I_N1G] + lane;
    for (int m0 = gw; m0 < NTOK; m0 += 2 * NGW) {
        const int m1 = m0 + NGW; const bool two = m1 < NTOK; const int m1c = two ? m1 : m0;
        const f32x4* xr0 = (const f32x4*)(m0 < NPROMPT ? A.in[I_XP] + (size_t)m0 * DM : A.in[I_XS] + (size_t)(m0 - NPROMPT) * DM) + lane;
        const f32x4* xr1 = (const f32x4*)(m1c < NPROMPT ? A.in[I_XP] + (size_t)m1c * DM : A.in[I_XS] + (size_t)(m1c - NPROMPT) * DM) + lane;
        f32x4 v0[4], v1[4]; float s0 = 0.f, s1 = 0.f;
#pragma unroll
        for (int j = 0; j < 4; ++j) { v0[j] = xr0[64 * j]; v1[j] = xr1[64 * j]; }
#pragma unroll
        for (int j = 0; j < 4; ++j) { s0 += (v0[j][0] * v0[j][0] + v0[j][1] * v0[j][1]) + (v0[j][2] * v0[j][2] + v0[j][3] * v0[j][3]);
                                      s1 += (v1[j][0] * v1[j][0] + v1[j][1] * v1[j][1]) + (v1[j][2] * v1[j][2] + v1[j][3] * v1[j][3]); }
#pragma unroll
        for (int o = 1; o < 64; o <<= 1) { s0 += __shfl_xor(s0, o); s1 += __shfl_xor(s1, o); }
        const float r0 = 1.0f / sqrtf(s0 * (1.f / DM) + 1e-6f), r1 = 1.0f / sqrtf(s1 * (1.f / DM) + 1e-6f);
#pragma unroll
        for (int rr = 0; rr < 2; ++rr) {
            if (rr == 1 && !two) break;
            const int m = rr ? m1 : m0; const float rstd = rr ? r1 : r0;
            v2u* o8 = (v2u*)(A1 + (size_t)m * DM) + lane;
            float* so = nullptr;
            if (m < NPROMPT) { if ((m & (SEQ_P - 1)) == SEQ_P - 1) so = A.out + O_SHIFT_P + (size_t)(m / SEQ_P) * DM; }
            else { const int ms = m - NPROMPT; if ((ms & (SEQ_S - 1)) == SEQ_S - 1) so = A.out + O_SHIFT_S + (size_t)(ms / SEQ_S) * DM; }
#pragma unroll
            for (int j = 0; j < 4; ++j) { const f32x4 g = g1v[64 * j]; const f32x4 y = (rr ? v1[j] : v0[j]) * rstd * g;
                v2u w; w.x = cvt_pk_bf16(y[0], y[1]); w.y = cvt_pk_bf16(y[2], y[3]); o8[64 * j] = w;
                if (so) ((f32x4*)so)[lane + 64 * j] = y; }
        }
    }
    for (int m = NTOK + gw; m < MPAD; m += NGW) {
        v2u* o8 = (v2u*)(A1 + (size_t)m * DM) + lane;
        if (m < NTOK + NSHIFT) {
            const f32x4* xr = (const f32x4*)(A.in[I_SSHIFT] + (size_t)(m - NTOK) * DM) + lane;
#pragma unroll
            for (int j = 0; j < 4; ++j) { const f32x4 y = xr[64 * j]; v2u w; w.x = cvt_pk_bf16(y[0], y[1]); w.y = cvt_pk_bf16(y[2], y[3]); o8[64 * j] = w; }
        } else {
#pragma unroll
            for (int j = 0; j < 4; ++j) { v2u w; w.x = 0u; w.y = 0u; o8[64 * j] = w; }
        }
    }
}

__device__ __forceinline__ void unpack8(const v4u w, float (&f)[8]) { f[0] = bf_lo(w.x); f[1] = bf_hi(w.x); f[2] = bf_lo(w.y); f[3] = bf_hi(w.y); f[4] = bf_lo(w.z); f[5] = bf_hi(w.z); f[6] = bf_lo(w.w); f[7] = bf_hi(w.w); }
__device__ __forceinline__ void conv_phase(const Args& A, int gt, int nth) {
    const bf16* Zc = (const bf16*)(A.ws + WS_ZC); bf16* YA = (bf16*)(A.ws + WS_A1);
    const float* cw = A.in[I_CONVW];
    for (int task = gt; task < (NTOK / 16) * 64; task += nth) {
        const int seg = task >> 6, ch = (task & 63) * 8, row0 = seg * 16;
        int b, t0, T; bool prompt = row0 < NPROMPT;
        if (prompt) { b = row0 / SEQ_P; t0 = row0 % SEQ_P; T = SEQ_P; } else { b = (row0 - NPROMPT) / SEQ_S; t0 = 0; T = SEQ_S; }
        float um2[8], um1[8], c0[8], c1[8], c2[8];
#pragma unroll
        for (int i = 0; i < 8; ++i) { c0[i] = cw[ch + i]; c1[i] = cw[512 + ch + i]; c2[i] = cw[1024 + ch + i]; }
        if (t0 == 0) {
            if (prompt) {
#pragma unroll
                for (int i = 0; i < 8; ++i) { um2[i] = 0.f; um1[i] = 0.f; }
            } else { const float* sc = A.in[I_SCONV] + (size_t)b * 2 * 512 + ch;
#pragma unroll
                for (int i = 0; i < 8; ++i) { um2[i] = sc[i]; um1[i] = sc[512 + i]; } }
        } else {
            float a[8], h[8];
            unpack8(*(const v4u*)(Zc + (size_t)(row0 - 2) * 1536 + 512 + ch), a); unpack8(*(const v4u*)(Zc + (size_t)(row0 - 2) * 1536 + 1024 + ch), h);
#pragma unroll
            for (int i = 0; i < 8; ++i) um2[i] = a[i] * h[i];
            unpack8(*(const v4u*)(Zc + (size_t)(row0 - 1) * 1536 + 512 + ch), a); unpack8(*(const v4u*)(Zc + (size_t)(row0 - 1) * 1536 + 1024 + ch), h);
#pragma unroll
            for (int i = 0; i < 8; ++i) um1[i] = a[i] * h[i];
        }
#pragma unroll 4
        for (int t = 0; t < 16; ++t) {
            const size_t row = (size_t)(row0 + t);
            float zb[8], zc[8], zh[8], y[8];
            unpack8(*(const v4u*)(Zc + row * 1536 + ch), zb); unpack8(*(const v4u*)(Zc + row * 1536 + 512 + ch), zc); unpack8(*(const v4u*)(Zc + row * 1536 + 1024 + ch), zh);
#pragma unroll
            for (int i = 0; i < 8; ++i) { const float u = zc[i] * zh[i]; y[i] = zb[i] * (c0[i] * um2[i] + c1[i] * um1[i] + c2[i] * u); um2[i] = um1[i]; um1[i] = u; }
            v4u o; o.x = cvt_pk_bf16(y[0], y[1]); o.y = cvt_pk_bf16(y[2], y[3]); o.z = cvt_pk_bf16(y[4], y[5]); o.w = cvt_pk_bf16(y[6], y[7]);
            *(v4u*)(YA + row * 512 + ch) = o;
        }
        if (t0 + 16 == T) { float* oc = A.out + (prompt ? O_CONV_P : O_CONV_S) + (size_t)b * 2 * 512 + ch;
#pragma unroll
            for (int i = 0; i < 8; ++i) { oc[i] = um2[i]; oc[512 + i] = um1[i]; } }
    }
    bf16* Zr = (bf16*)(A.ws + WS_ZR);
    for (int task = nth - 1 - gt; task < NTOK * 16; task += nth) {
        const int m = task >> 4, cs = task & 15;
        bool hasprev; int prow;
        if (m < NPROMPT) { hasprev = (m & (SEQ_P - 1)) != 0; prow = m - 1; } else { const int ms = m - NPROMPT; hasprev = true; prow = (ms & (SEQ_S - 1)) ? m - 1 : NTOK + ms / SEQ_S; }
        bf16* pap = Zr + (size_t)m * 2048 + 1536 + cs * 16;
        float pa[16], t8[8];
        const v4u a0 = *(const v4u*)pap, a1 = *(const v4u*)(pap + 8);
        v4u b0 = (v4u){0u, 0u, 0u, 0u}, b1 = b0;
        if (hasprev) { const bf16* pbp = Zr + (size_t)prow * 2048 + 1792 + cs * 16; b0 = *(const v4u*)pbp; b1 = *(const v4u*)(pbp + 8); }
        unpack8(a0, t8);
#pragma unroll
        for (int i = 0; i < 8; ++i) pa[i] = t8[i];
        unpack8(a1, t8);
#pragma unroll
        for (int i = 0; i < 8; ++i) pa[8 + i] = t8[i];
        unpack8(b0, t8);
#pragma unroll
        for (int i = 0; i < 8; ++i) pa[i] += t8[i];
        unpack8(b1, t8);
#pragma unroll
        for (int i = 0; i < 8; ++i) pa[8 + i] += t8[i];
#pragma unroll
        for (int i = 0; i < 16; ++i) { float p = pa[i];
            if (cs < 4) p = 1.0f - 2.0f * __builtin_amdgcn_rcpf(__expf(2.0f * p) + 1.0f);
            else if (cs >= 8) p = sigm(p);
            pa[i] = p; }
        v4u o0, o1; o0.x = cvt_pk_bf16(pa[0], pa[1]); o0.y = cvt_pk_bf16(pa[2], pa[3]); o0.z = cvt_pk_bf16(pa[4], pa[5]); o0.w = cvt_pk_bf16(pa[6], pa[7]);
        o1.x = cvt_pk_bf16(pa[8], pa[9]); o1.y = cvt_pk_bf16(pa[10], pa[11]); o1.z = cvt_pk_bf16(pa[12], pa[13]); o1.w = cvt_pk_bf16(pa[14], pa[15]);
        *(v4u*)pap = o0; *(v4u*)(pap + 8) = o1;
    }
}

constexpr int NUNITS_P = NB_P * 8 * 64, NUNITS = NUNITS_P + NB_S * 8;
constexpr int HID_STRIDE = 264, SC_TB = 32;
constexpr int P1_HIDB = 0, P1_LO = 16896, P1_SEQ = 41472, P1_GG = 90624, P1_YY = 98816, P1_ZZ = 107008, P1_BON = 115200;
typedef float f32x2 __attribute__((ext_vector_type(2)));

struct P1Pre { v4u pa0, pa1; v2u zr, zk, zv, pr, pk, pv; };
struct P1Pos { int unit, t0; };
__device__ __forceinline__ void p1_decode(int unit, bool& prompt, int& b, int& h, int& ch, int& T, int& rowbase) {
    prompt = unit < NUNITS_P; b = prompt ? unit >> 9 : (unit - NUNITS_P) >> 3; h = prompt ? (unit >> 6) & 7 : unit & 7; ch = prompt ? unit & 63 : 0;
    T = prompt ? 64 : SEQ_S; rowbase = prompt ? b * SEQ_P + ch * 64 : NPROMPT + b * SEQ_S;
}
__device__ __forceinline__ void p1_rows(int unit, int t0, int tt, size_t& row, size_t& prow, bool& hasprev, int& nb) {
    bool prompt; int b, h, ch, T, rowbase; p1_decode(unit, prompt, b, h, ch, T, rowbase);
    nb = (T - t0) < SC_TB ? (T - t0) : SC_TB;
    const int tloc = tt < nb ? tt : nb - 1, t = t0 + tloc; const bool first = (ch == 0);
    row = (size_t)(rowbase + t); hasprev = (t > 0) || !first || !prompt; prow = ((t > 0) || !first) ? row - 1 : (size_t)(NTOK + b);
}
__device__ __forceinline__ void p1_load(const Args& A, int unit, int t0, int tt, int cs, P1Pre& P) {
    size_t row, prow; bool hasprev; int nb; p1_rows(unit, t0, tt, row, prow, hasprev, nb);
    const int h = unit < NUNITS_P ? (unit >> 6) & 7 : unit & 7, hc = h * 64 + cs * 4;
    const bf16* Zr = (const bf16*)(A.ws + WS_ZR);
    P.pa0 = *(const v4u*)(Zr + row * 2048 + 1536 + cs * 16); P.pa1 = *(const v4u*)(Zr + row * 2048 + 1536 + cs * 16 + 8);
    P.zr = *(const v2u*)(Zr + row * 2048 + hc); P.zk = *(const v2u*)(Zr + row * 2048 + 512 + hc); P.zv = *(const v2u*)(Zr + row * 2048 + 1024 + hc);
    const v2u z2 = (v2u){0u, 0u};
    P.pr = z2; P.pk = z2; P.pv = z2;
    if (hasprev) { P.pr = *(const v2u*)(Zr + prow * 2048 + hc); P.pk = *(const v2u*)(Zr + prow * 2048 + 512 + hc); P.pv = *(const v2u*)(Zr + prow * 2048 + 1024 + hc); }
}
__device__ __forceinline__ bool p1_unit_at(int i, int vcu, int G, int& unit) {
    if (G == 256) { if (i > 16) return false; unit = i < 16 ? vcu * 16 + i : NUNITS_P + vcu; return true; }
    unit = vcu + i * G; return unit < NUNITS;
}

constexpr int WY_OS = 72, WY_TS = 24, WY_LS = 40;
constexpr int WY_AT = 0, WY_RT = WY_AT + 16 * WY_OS * 2, WY_BT = WY_RT + 16 * WY_OS * 2, WY_KT = WY_BT + 16 * WY_OS * 2, WY_BH = WY_KT + 16 * WY_OS * 2,
              WY_KH = WY_BH + 64 * WY_TS * 2, WY_VT = WY_KH + 64 * WY_TS * 2, WY_GC = WY_VT + 64 * WY_TS * 2, WY_BUF = WY_GC + 256;
constexpr int WY_BASE = 0;
constexpr int WY_LAB = WY_BASE + 2 * WY_BUF, WY_LAK = WY_LAB + 1024, WY_MC = WY_LAK + 16 * WY_LS * 2;
static_assert(WY_MC + 16 * WY_LS * 2 <= P1_SEQ, "UT-transform operands must fit over HIDB | LO");
constexpr int WY_XB = 115328, WY_RH = WY_XB + 128 * WY_OS * 2, WY_UT = WY_RH + 8 * 16 * 17 * 4, WY_END = WY_UT + 8 * 16 * WY_TS * 2;
static_assert(WY_END <= LDSCTL_OFF, "LDS map of pass 1");

constexpr int WY_G2 = P1_GG + 2048;
static_assert(WY_G2 + 1024 + 2 * 16 * WY_LS * 2 <= P1_YY, "second Gram set");
__device__ __forceinline__ void p1_wy(f32x4 (&X)[4], const LAS float* SEQ, LAS float* YY, LAS float* ZZ, LAS unsigned char* lds, int nb, int tid, int lane, int wave, int part = 0) {
    const bool pw = wave >= 4; const int nmc = nb >> 4;
    LAS bf16* Xb = (LAS bf16*)(lds + WY_XB); LAS float* RH = (LAS float*)(lds + WY_RH) + wave * 16 * 17; LAS bf16* UT = (LAS bf16*)(lds + WY_UT) + wave * 16 * WY_TS;
    const bf16x8 zero8 = (bf16x8){0, 0, 0, 0, 0, 0, 0, 0};
    for (int mc = 0; mc < nmc; ++mc) {
        asm volatile("" : "+v"(tid));
        LAS unsigned char* ob = lds + WY_BASE + mc * WY_BUF;
        LAS bf16* At = (LAS bf16*)(ob + WY_AT); LAS bf16* Rt = (LAS bf16*)(ob + WY_RT); LAS bf16* Bt = (LAS bf16*)(ob + WY_BT); LAS bf16* Kt = (LAS bf16*)(ob + WY_KT);
        LAS bf16* BhT = (LAS bf16*)(ob + WY_BH); LAS bf16* KhT = (LAS bf16*)(ob + WY_KH); LAS bf16* VT = (LAS bf16*)(ob + WY_VT); LAS float* GC = (LAS float*)(ob + WY_GC);
        const int tl = tid >> 5, c2 = (tid & 31) * 2, s0 = mc * 16;
        f32x2 cum = (f32x2){0.f, 0.f}, tot = cum, lwt = cum;
#pragma unroll
        for (int i = 0; i < 16; ++i) { const f32x2 l2 = *(const LAS f32x2*)(SEQ + (s0 + i) * 384 + 64 + c2); tot += l2; if (i <= tl) cum += l2; if (i == tl) lwt = l2; }
        const LAS float* sp = SEQ + (s0 + tl) * 384 + c2;
        const f32x2 a2 = *(const LAS f32x2*)(sp), b2 = *(const LAS f32x2*)(sp + 128), k2 = *(const LAS f32x2*)(sp + 192), r2 = *(const LAS f32x2*)(sp + 256), v2 = *(const LAS f32x2*)(sp + 320);
        const f32x2 gt = (f32x2){__expf(cum.x), __expf(cum.y)}, gp = (f32x2){__expf(cum.x - lwt.x), __expf(cum.y - lwt.y)}, gi = (f32x2){__expf(-cum.x), __expf(-cum.y)},
                    go = (f32x2){__expf(tot.x - cum.x), __expf(tot.y - cum.y)};
        *(LAS unsigned*)(At + tl * WY_OS + c2) = cvt_pk_bf16(a2.x * gp.x, a2.y * gp.y); *(LAS unsigned*)(Rt + tl * WY_OS + c2) = cvt_pk_bf16(r2.x * gt.x, r2.y * gt.y);
        *(LAS unsigned*)(Bt + tl * WY_OS + c2) = cvt_pk_bf16(b2.x * gi.x, b2.y * gi.y); *(LAS unsigned*)(Kt + tl * WY_OS + c2) = cvt_pk_bf16(k2.x * gi.x, k2.y * gi.y);
        const unsigned bh = cvt_pk_bf16(b2.x * go.x, b2.y * go.y), kh = cvt_pk_bf16(k2.x * go.x, k2.y * go.y), vv = cvt_pk_bf16(v2.x, v2.y);
        {
            const unsigned bh_o = (unsigned)__shfl_xor((int)bh, 32), kh_o = (unsigned)__shfl_xor((int)kh, 32), vv_o = (unsigned)__shfl_xor((int)vv, 32);
            const bool ev = (tl & 1) == 0; const int wo = (ev ? c2 : c2 + 1) * WY_TS + (tl & ~1);
            *(LAS unsigned*)(BhT + wo) = ev ? ((bh & 0xffffu) | (bh_o << 16)) : ((bh_o >> 16) | (bh & 0xffff0000u));
            *(LAS unsigned*)(KhT + wo) = ev ? ((kh & 0xffffu) | (kh_o << 16)) : ((kh_o >> 16) | (kh & 0xffff0000u));
            *(LAS unsigned*)(VT + wo) = ev ? ((vv & 0xffffu) | (vv_o << 16)) : ((vv_o >> 16) | (vv & 0xffff0000u)); }
        if (tl == 0) *(LAS f32x2*)(GC + c2) = (f32x2){__expf(tot.x), __expf(tot.y)};
    }
    __syncthreads();
    {
        asm volatile("" : "+v"(tid));
        const int fr = tid & 15, fq = (tid >> 4) & 3, g_ = wave & 3, m_ = wave >> 2;
        if (m_ < nmc) {
            LAS unsigned char* ob = lds + WY_BASE + m_ * WY_BUF; LAS unsigned char* gs = lds + (m_ ? WY_G2 : WY_LAB);
            LAS float* Lab = (LAS float*)gs; LAS bf16* Lak = (LAS bf16*)(gs + 1024); LAS bf16* Mc = (LAS bf16*)(gs + 1024 + 16 * WY_LS * 2);
            const LAS bf16* ab = (LAS bf16*)(ob + (g_ < 2 ? WY_AT : WY_RT)) + fr * WY_OS + fq * 8; const LAS bf16* bb = (LAS bf16*)(ob + ((g_ & 1) ? WY_KT : WY_BT)) + fr * WY_OS + fq * 8;
            f32x4 g = (f32x4){0.f, 0.f, 0.f, 0.f};
#pragma unroll
            for (int ks = 0; ks < 2; ++ks) g = __builtin_amdgcn_mfma_f32_16x16x32_bf16(*(const LAS bf16x8*)(bb + ks * 32), *(const LAS bf16x8*)(ab + ks * 32), g, 0, 0, 0);
#pragma unroll
            for (int rg = 0; rg < 4; ++rg) { const int tp = 4 * fq + rg; const bool keep = (g_ < 2) ? (fr > tp) : (fr >= tp); g[rg] = keep ? g[rg] : 0.f; }
            if (g_ == 0) *(LAS f32x4*)(Lab + fr * 16 + 4 * fq) = g;
            else { v2u w; w.x = cvt_pk_bf16(g[0], g[1]); w.y = cvt_pk_bf16(g[2], g[3]);
                if (g_ == 1) { *(LAS v2u*)(Lak + fr * WY_LS + 4 * fq) = w; *(LAS v2u*)(Lak + fr * WY_LS + 16 + 4 * fq) = (v2u){0u, 0u}; }
                else if (g_ == 2) *(LAS v2u*)(Mc + fr * WY_LS + 4 * fq) = w; else *(LAS v2u*)(Mc + fr * WY_LS + 16 + 4 * fq) = w; }
        }
    }
    __syncthreads();
    if (MK_DBGSEL == 2 && part) return;
    for (int mc = 0; mc < nmc; ++mc) {
        asm volatile("" : "+v"(tid));
        const int fr = tid & 15, fq = (tid >> 4) & 3;
        LAS unsigned char* ob = lds + WY_BASE + mc * WY_BUF; LAS unsigned char* gs = lds + (mc ? WY_G2 : WY_LAB);
        LAS bf16* At = (LAS bf16*)(ob + WY_AT); LAS bf16* Rt = (LAS bf16*)(ob + WY_RT);
        LAS bf16* BhT = (LAS bf16*)(ob + WY_BH); LAS bf16* KhT = (LAS bf16*)(ob + WY_KH); LAS bf16* VT = (LAS bf16*)(ob + WY_VT); LAS float* GC = (LAS float*)(ob + WY_GC);
        LAS float* Lab = (LAS float*)gs; LAS bf16* Lak = (LAS bf16*)(gs + 1024); LAS bf16* Mc = (LAS bf16*)(gs + 1024 + 16 * WY_LS * 2);
        f32x4 W1 = (f32x4){0.f, 0.f, 0.f, 0.f}, Y0 = W1;
        {
            const LAS bf16* xbp = Xb + (16 * wave + fr) * WY_OS + fq * 8;
#pragma unroll
            for (int ks = 0; ks < 2; ++ks) { const bf16x8 bx = *(const LAS bf16x8*)(xbp + ks * 32);
                W1 = __builtin_amdgcn_mfma_f32_16x16x32_bf16(*(const LAS bf16x8*)(At + fr * WY_OS + ks * 32 + fq * 8), bx, W1, 0, 0, 0);
                Y0 = __builtin_amdgcn_mfma_f32_16x16x32_bf16(*(const LAS bf16x8*)(Rt + fr * WY_OS + ks * 32 + fq * 8), bx, Y0, 0, 0, 0); }
        }
        if (!pw) { const bf16x8 la = *(const LAS bf16x8*)(Lak + fr * WY_LS + fq * 8); const bf16x8 vb0 = *(const LAS bf16x8*)(VT + (16 * wave + fr) * WY_TS + (fq & 1) * 8); const bf16x8 vb = fq < 2 ? vb0 : zero8;
            W1 = __builtin_amdgcn_mfma_f32_16x16x32_bf16(la, vb, W1, 0, 0, 0); }
#pragma unroll
        for (int rg = 0; rg < 4; ++rg) RH[(4 * fq + rg) * 17 + fr] = W1[rg];
        LDS_WAIT();
        {
            float u[16];
#pragma unroll
            for (int t = 0; t < 16; ++t) { if ((t & 3) == 0) asm volatile("" ::: "memory");
                float acc = RH[t * 17 + fr];
                if (!(MK_DBGSEL == 3 && part))
#pragma unroll
                for (int i4 = 0; i4 * 4 < t; ++i4) { const f32x4 l4 = *(const LAS f32x4*)(Lab + t * 16 + i4 * 4);
#pragma unroll
                    for (int e = 0; e < 4; ++e) if (i4 * 4 + e < t) acc += l4[e] * u[i4 * 4 + e]; }
                u[t] = acc; }
            if (fq == 0) { v4u o0, o1; o0.x = cvt_pk_bf16(u[0], u[1]); o0.y = cvt_pk_bf16(u[2], u[3]); o0.z = cvt_pk_bf16(u[4], u[5]); o0.w = cvt_pk_bf16(u[6], u[7]);
                o1.x = cvt_pk_bf16(u[8], u[9]); o1.y = cvt_pk_bf16(u[10], u[11]); o1.z = cvt_pk_bf16(u[12], u[13]); o1.w = cvt_pk_bf16(u[14], u[15]);
                *(LAS v4u*)(UT + fr * WY_TS) = o0; *(LAS v4u*)(UT + fr * WY_TS + 8) = o1; }
        }
        LDS_WAIT();
        {
            const bf16x8 uc = fq < 2 ? *(const LAS bf16x8*)(UT + fr * WY_TS + fq * 8) : (pw ? zero8 : *(const LAS bf16x8*)(VT + (16 * wave + fr) * WY_TS + (fq - 2) * 8));
            Y0 = __builtin_amdgcn_mfma_f32_16x16x32_bf16(*(const LAS bf16x8*)(Mc + fr * WY_LS + fq * 8), uc, Y0, 0, 0, 0);
            LAS float* yo = (pw ? ZZ + 16 * (wave - 4) : YY + 16 * wave) + fr;
#pragma unroll
            for (int rg = 0; rg < 4; ++rg) yo[(mc * 16 + 4 * fq + rg) * 64] = Y0[rg];
#pragma unroll
            for (int j = 0; j < 4; ++j) {
                const bf16x8 bc = fq < 2 ? *(const LAS bf16x8*)(BhT + (16 * j + fr) * WY_TS + fq * 8) : *(const LAS bf16x8*)(KhT + (16 * j + fr) * WY_TS + (fq - 2) * 8);
                X[j] = X[j] * *(const LAS f32x4*)(GC + 16 * j + 4 * fq);
                X[j] = __builtin_amdgcn_mfma_f32_16x16x32_bf16(bc, uc, X[j], 0, 0, 0);
                v2u w; w.x = cvt_pk_bf16(X[j][0], X[j][1]); w.y = cvt_pk_bf16(X[j][2], X[j][3]);
                *(LAS v2u*)(Xb + (16 * wave + fr) * WY_OS + 16 * j + 4 * fq) = w; }
        }
        LDS_WAIT();
    }
}

#define P1_LOAD_PARAMS(HH) do { int lf_ = fr, lq_ = fq, lt_ = tid; asm volatile("" : "+v"(lf_), "+v"(lq_), "+v"(lt_));   \
        const int h_ = (HH), ncol_ = h_ * 64 + ntl * 16 + lf_; \
        _Pragma("unroll") for (int ks = 0; ks < 2; ++ks) { bw[ks] = *(const bf16x8*)(L2T + (size_t)ncol_ * 64 + lq_ * 8 + ks * 32); ba[ks] = *(const bf16x8*)(L2T + (size_t)512 * 64 + (size_t)ncol_ * 64 + lq_ * 8 + ks * 32); } \
        _Pragma("unroll") for (int ks = 0; ks < 4; ++ks) bg[ks] = *(const bf16x8*)(L2T + (size_t)1024 * 64 + (size_t)ncol_ * 128 + lq_ * 8 + ks * 32); \
        if (lt_ < 128) { const int a_ = lt_ >> 4, c_ = (lt_ & 15) * 4; \
            const float* src_ = a_ == 0 ? A.in[I_W0] : a_ == 1 ? A.in[I_A0] : a_ == 2 ? A.in[I_KK] : a_ == 3 ? A.in[I_KA] : a_ == 4 ? A.in[I_RK] : A.in[I_MURKV] + (a_ - 5) * 512; \
            *(LAS f32x4*)(PRM + a_ * 64 + c_) = *(const f32x4*)(src_ + h_ * 64 + c_); } } while (0)
__device__ __forceinline__ void scan_pass1(const Args& A, LAS unsigned char* lds, int tid, int lane, int wave, int vcu, int G, int part = 0) {
    bf16* GB = (bf16*)(A.ws + WS_A1) + (size_t)MPAD * 512;
    bf16* YL = (bf16*)(A.ws + WS_YL); bf16* ZT = (bf16*)(A.ws + WS_ZT); bf16* BV = (bf16*)(A.ws + WS_BV);
    LAS bf16* HIDB = (LAS bf16*)(lds + P1_HIDB); LAS float* LO = (LAS float*)(lds + P1_LO); LAS float* SEQ = (LAS float*)(lds + P1_SEQ);
    LAS float* YY = (LAS float*)(lds + P1_YY); LAS float* ZZ = (LAS float*)(lds + P1_ZZ);
    const bf16* L2T = (const bf16*)(A.ws + WS_L2T);
    const bool prow_wave = wave >= 4;
    const int mt = wave & 1, ntl = wave >> 1;
    int tt = tid >> 4, cs = tid & 15, c4 = cs * 4, fr = lane & 15, fq = lane >> 4;
    f32x4 X[4];
    bf16x8 bw[2], ba[2], bg[4];
    LAS float* PRM = (LAS float*)(lds + P1_GG);
    int cur_h = -1;
    int ui = 0, unit; if (!p1_unit_at(0, vcu, G, unit)) return;
    int t0 = 0; P1Pre pre; p1_load(A, unit, 0, tt, cs, pre);
    for (;;) {
        { int lt_ = tid; asm volatile("" : "+v"(lt_)); tt = lt_ >> 4; cs = lt_ & 15; c4 = cs * 4; fr = lt_ & 15; fq = (lt_ >> 4) & 3; }
        bool prompt; int b, h, ch, T, rowbase; p1_decode(unit, prompt, b, h, ch, T, rowbase);
        const int hc = h * 64 + c4;
        if (t0 == 0 && G == 256 && ui < 8) {
            const size_t i16 = ((size_t)(ui * 256 + vcu) * NTHR + tid) * 16;
            cvt16_fp8_sliced(A.in[I_U], A.ws + WS_UB, PEER_SU, i16); cvt16_fp8_sliced(A.in[I_V], A.ws + WS_VB, PEER_SV, i16); }
        if (t0 == 0) {
            LAS bf16* Xb = (LAS bf16*)(lds + WY_XB);
#pragma unroll
            for (int j = 0; j < 4; ++j) { const int prow_ = 16 * (wave - 4) + fr, c0_ = 16 * j + 4 * fq;
#pragma unroll
                for (int e = 0; e < 4; ++e) X[j][e] = (prow_wave && prow_ == c0_ + e) ? 1.f : 0.f;
                v2u w; w.x = cvt_pk_bf16(X[j][0], X[j][1]); w.y = cvt_pk_bf16(X[j][2], X[j][3]);
                *(LAS v2u*)(Xb + (16 * wave + fr) * WY_OS + c0_) = w; }
        }
        if (h != cur_h) { cur_h = h; P1_LOAD_PARAMS(h); }
        size_t row, prow; bool hasprev; int nb; p1_rows(unit, t0, tt, row, prow, hasprev, nb);
        if (!(MK_DBGSEL == 5 && part)) { *(LAS v4u*)(HIDB + tt * HID_STRIDE + cs * 16) = pre.pa0; *(LAS v4u*)(HIDB + tt * HID_STRIDE + cs * 16 + 8) = pre.pa1; }
        __syncthreads();
        if (!(MK_DBGSEL == 5 && part)) {
            const LAS bf16* ap = HIDB + (mt * 16 + fr) * HID_STRIDE + fq * 8;
            f32x4 cw = (f32x4){0.f, 0.f, 0.f, 0.f}, ca = cw, cg = cw;
#pragma unroll
            for (int ks = 0; ks < 2; ++ks) { cw = __builtin_amdgcn_mfma_f32_16x16x32_bf16(*(const LAS bf16x8*)(ap + ks * 32), bw[ks], cw, 0, 0, 0);
                                             ca = __builtin_amdgcn_mfma_f32_16x16x32_bf16(*(const LAS bf16x8*)(ap + 64 + ks * 32), ba[ks], ca, 0, 0, 0); }
#pragma unroll
            for (int ks = 0; ks < 4; ++ks) cg = __builtin_amdgcn_mfma_f32_16x16x32_bf16(*(const LAS bf16x8*)(ap + 128 + ks * 32), bg[ks], cg, 0, 0, 0);
#pragma unroll
            for (int rg = 0; rg < 4; ++rg) { const int o = (mt * 16 + fq * 4 + rg) * 64 + ntl * 16 + fr; LO[o] = cw[rg]; LO[2048 + o] = ca[rg]; LO[4096 + o] = cg[rg]; }
        }
        __syncthreads();
        if (!(MK_DBGSEL == 5 && part)) {
            const f32x4 w0v = *(const LAS f32x4*)(PRM + c4), a0v = *(const LAS f32x4*)(PRM + 64 + c4), kkv = *(const LAS f32x4*)(PRM + 128 + c4), kav = *(const LAS f32x4*)(PRM + 192 + c4),
                        rkv = *(const LAS f32x4*)(PRM + 256 + c4), mur = *(const LAS f32x4*)(PRM + 320 + c4), muk = *(const LAS f32x4*)(PRM + 384 + c4), muv = *(const LAS f32x4*)(PRM + 448 + c4);
            const f32x4 aw = w0v + *(const LAS f32x4*)(LO + tt * 64 + c4), aa = a0v + *(const LAS f32x4*)(LO + 2048 + tt * 64 + c4), ag = *(const LAS f32x4*)(LO + 4096 + tt * 64 + c4);
            f32x4 r = (f32x4){bf_lo(pre.zr.x), bf_hi(pre.zr.x), bf_lo(pre.zr.y), bf_hi(pre.zr.y)}, k = (f32x4){bf_lo(pre.zk.x), bf_hi(pre.zk.x), bf_lo(pre.zk.y), bf_hi(pre.zk.y)},
                  v = (f32x4){bf_lo(pre.zv.x), bf_hi(pre.zv.x), bf_lo(pre.zv.y), bf_hi(pre.zv.y)};
            const f32x4 rpv = (f32x4){bf_lo(pre.pr.x), bf_hi(pre.pr.x), bf_lo(pre.pr.y), bf_hi(pre.pr.y)}, kpv = (f32x4){bf_lo(pre.pk.x), bf_hi(pre.pk.x), bf_lo(pre.pk.y), bf_hi(pre.pk.y)},
                        vpv = (f32x4){bf_lo(pre.pv.x), bf_hi(pre.pv.x), bf_lo(pre.pv.y), bf_hi(pre.pv.y)};
            r = r + mur * (rpv - r); k = k + muk * (kpv - k); v = v + muv * (vpv - v);
            f32x4 dec, asg, kk, km, av, bv;
            float ssq = 0.f, bon = 0.f;
#pragma unroll
            for (int i = 0; i < 4; ++i) {
                const float x = -aw[i];
                const float sp = fmaxf(x, 0.f) + __logf(1.0f + __expf(-fabsf(x)));
                const float wraw = -sp - 0.5f;
                dec[i] = -__expf(wraw);
                asg[i] = sigm(aa[i]);
                kk[i] = k[i] * kkv[i]; ssq += kk[i] * kk[i];
                km[i] = k[i] * (1.0f + (asg[i] - 1.0f) * kav[i]);
                bon += r[i] * km[i] * rkv[i];
            }
            ssq = sum16(ssq); bon = sum16(bon);
            const float inv = 1.0f / fmaxf(sqrtf(ssq), 1e-12f);
#pragma unroll
            for (int i = 0; i < 4; ++i) { kk[i] *= inv; av[i] = -kk[i]; bv[i] = kk[i] * asg[i]; }
            LAS float* sq_ = SEQ + tt * 384 + c4;
            *(LAS f32x4*)(sq_) = av; *(LAS f32x4*)(sq_ + 64) = dec; *(LAS f32x4*)(sq_ + 128) = bv; *(LAS f32x4*)(sq_ + 192) = km; *(LAS f32x4*)(sq_ + 256) = r; *(LAS f32x4*)(sq_ + 320) = v;
            if (tt < nb) {
                v2u w; w.x = cvt_pk_bf16(ag[0], ag[1]); w.y = cvt_pk_bf16(ag[2], ag[3]); *(v2u*)(GB + row * 512 + hc) = w;
                w.x = cvt_pk_bf16(bon * v[0], bon * v[1]); w.y = cvt_pk_bf16(bon * v[2], bon * v[3]); *(v2u*)(BV + row * 512 + hc) = w;
            }
        }
        int nunit = unit, nt0 = t0 + SC_TB, nui = ui; bool more = true;
        if (nt0 >= T) { nt0 = 0; nui = ui + 1; more = p1_unit_at(nui, vcu, G, nunit); }
        if (more) p1_load(A, nunit, nt0, tt, cs, pre);
        __syncthreads();
        if (!(MK_DBGSEL == 1 && part)) p1_wy(X, SEQ, YY, ZZ, lds, nb, tid, lane, wave, part);
        __syncthreads();
        if (tt < nb) {
            const f32x4 y = *(const LAS f32x4*)(YY + tt * 64 + c4), z = *(const LAS f32x4*)(ZZ + tt * 64 + c4);
            v2u w; w.x = cvt_pk_bf16(y[0], y[1]); w.y = cvt_pk_bf16(y[2], y[3]); *(v2u*)(YL + row * 512 + hc) = w;
            w.x = cvt_pk_bf16(z[0], z[1]); w.y = cvt_pk_bf16(z[2], z[3]); *(v2u*)(ZT + row * 512 + hc) = w;
        }
        if (t0 + SC_TB >= T) {
#pragma unroll
            for (int j = 0; j < 4; ++j) {
                if (!prow_wave) *(f32x4*)((float*)A.out + (size_t)unit * 4096 + (16 * wave + fr) * 64 + 16 * j + 4 * fq) = X[j];
                else { bf16* mt = (bf16*)((unsigned char*)A.out + OB_MB) + (size_t)unit * 4096 + (16 * j + 4 * fq) * 64 + 16 * (wave - 4) + fr;
                    const unsigned p01 = cvt_pk_bf16(X[j][0], X[j][1]), p23 = cvt_pk_bf16(X[j][2], X[j][3]);
                    mt[0] = (bf16)(p01 & 0xffffu); mt[64] = (bf16)(p01 >> 16); mt[128] = (bf16)(p23 & 0xffffu); mt[192] = (bf16)(p23 >> 16); }
            }
        }
        if (!more) break;
        unit = nunit; t0 = nt0; ui = nui;
    }
    __syncthreads();
}

constexpr int P2_SS = 72, P2_LO = 16 * P2_SS * 2, P2_BUF = 2 * P2_LO;
__device__ __forceinline__ void scan_pass2_rows(const float* Sinit, int unit0, int nchunks, int v0, float* outfin, bool slots, const Args& A, LAS unsigned char* lds, int tid, int lane, int wave) {
    LAS bf16* Shi = (LAS bf16*)lds; LAS bf16* Slo = (LAS bf16*)(lds + P2_LO);
    const int nt = wave & 3, fr = lane & 15, fq = lane >> 4; const bool act = wave < 4;
    float* NB = (float*)A.out; const bf16* MT = (const bf16*)((const unsigned char*)A.out + OB_MB);
    { const int idx = tid * 2, row = idx >> 6, col = idx & 63;
      const f32x2 s0 = Sinit ? *(const f32x2*)(Sinit + (size_t)(v0 + row) * 64 + col) : (f32x2){0.f, 0.f};
      const unsigned hi = cvt_pk_bf16(s0.x, s0.y);
      *(LAS unsigned*)(Shi + row * P2_SS + col) = hi; *(LAS unsigned*)(Slo + row * P2_SS + col) = cvt_pk_bf16(s0.x - bf_lo(hi), s0.y - bf_hi(hi)); }
    bf16x8 mr[4][2]; f32x4 nr[4];
    const size_t moff = (size_t)(16 * nt + fr) * 64 + fq * 8, noff = (size_t)(v0 + fr) * 64 + 16 * nt + 4 * fq;
#pragma unroll
    for (int d = 0; d < 4; ++d) {
        mr[d][0] = (bf16x8){0, 0, 0, 0, 0, 0, 0, 0}; mr[d][1] = mr[d][0]; nr[d] = (f32x4){0.f, 0.f, 0.f, 0.f};
        { const int cc = d < nchunks ? d : nchunks - 1;
            mr[d][0] = *(const bf16x8*)(MT + (size_t)(unit0 + cc) * 4096 + moff); mr[d][1] = *(const bf16x8*)(MT + (size_t)(unit0 + cc) * 4096 + moff + 32);
            nr[d] = *(const f32x4*)(NB + (size_t)(unit0 + cc) * 4096 + noff); }
    }
    f32x4 acc = (f32x4){0.f, 0.f, 0.f, 0.f};
    __syncthreads();
    for (int c0 = 0; c0 < nchunks; c0 += 4) {
#pragma unroll
        for (int d = 0; d < 4; ++d) {
            const int c = c0 + d;
            if (c < nchunks) {
                {
                    LAS bf16* Shi = (LAS bf16*)(lds + (d & 1) * P2_BUF); LAS bf16* Slo = (LAS bf16*)(lds + (d & 1) * P2_BUF + P2_LO);
                    const bf16x8 sh0 = *(const LAS bf16x8*)(Shi + fr * P2_SS + fq * 8), sh1 = *(const LAS bf16x8*)(Shi + fr * P2_SS + 32 + fq * 8),
                                 sl0 = *(const LAS bf16x8*)(Slo + fr * P2_SS + fq * 8), sl1 = *(const LAS bf16x8*)(Slo + fr * P2_SS + 32 + fq * 8);
                    acc = nr[d];
                    acc = __builtin_amdgcn_mfma_f32_16x16x32_bf16(mr[d][0], sh0, acc, 0, 0, 0); acc = __builtin_amdgcn_mfma_f32_16x16x32_bf16(mr[d][1], sh1, acc, 0, 0, 0);
                    acc = __builtin_amdgcn_mfma_f32_16x16x32_bf16(mr[d][0], sl0, acc, 0, 0, 0); acc = __builtin_amdgcn_mfma_f32_16x16x32_bf16(mr[d][1], sl1, acc, 0, 0, 0);
                    const int cn = c + 4 < nchunks ? c + 4 : nchunks - 1;
                    mr[d][0] = *(const bf16x8*)(MT + (size_t)(unit0 + cn) * 4096 + moff); mr[d][1] = *(const bf16x8*)(MT + (size_t)(unit0 + cn) * 4096 + moff + 32);
                    nr[d] = *(const f32x4*)(NB + (size_t)(unit0 + cn) * 4096 + noff);
                }
                if (act) {
                    LAS bf16* Shi = (LAS bf16*)(lds + ((d + 1) & 1) * P2_BUF); LAS bf16* Slo = (LAS bf16*)(lds + ((d + 1) & 1) * P2_BUF + P2_LO);
                    v2u hi; hi.x = cvt_pk_bf16(acc[0], acc[1]); hi.y = cvt_pk_bf16(acc[2], acc[3]);
                    v2u lo; lo.x = cvt_pk_bf16(acc[0] - bf_lo(hi.x), acc[1] - bf_hi(hi.x)); lo.y = cvt_pk_bf16(acc[2] - bf_lo(hi.y), acc[3] - bf_hi(hi.y));
                    *(LAS v2u*)(Shi + fr * P2_SS + 16 * nt + 4 * fq) = hi; *(LAS v2u*)(Slo + fr * P2_SS + 16 * nt + 4 * fq) = lo;
                    if (slots) *(v2u*)((bf16*)(NB + (size_t)(unit0 + c) * 4096) + (size_t)(v0 + fr) * 128 + 16 * nt + 4 * fq) = hi;
                }
                __syncthreads();
            }
        }
    }
    if (act) *(f32x4*)(outfin + noff) = acc;
    __syncthreads();
}

__device__ __forceinline__ void scan_pass2_sample(const float* Sinit, int unit, float* outfin, const Args& A, int lane, int wave) {
    const int fr = lane & 15, fq = lane >> 4, rt = wave >> 1;
    const float* NB = (const float*)A.out + (size_t)unit * 4096; const bf16* MT = (const bf16*)((const unsigned char*)A.out + OB_MB) + (size_t)unit * 4096;
    f32x4 sv[2][2];
#pragma unroll
    for (int ks = 0; ks < 2; ++ks) { const float* sp = Sinit + (size_t)(16 * rt + fr) * 64 + 32 * ks + 8 * fq; sv[ks][0] = *(const f32x4*)sp; sv[ks][1] = *(const f32x4*)(sp + 4); }
    bf16x8 mt[2][2]; f32x4 acc[2];
#pragma unroll
    for (int t = 0; t < 2; ++t) { const int nt = 2 * (wave & 1) + t;
        mt[t][0] = *(const bf16x8*)(MT + (size_t)(16 * nt + fr) * 64 + fq * 8); mt[t][1] = *(const bf16x8*)(MT + (size_t)(16 * nt + fr) * 64 + 32 + fq * 8);
        acc[t] = *(const f32x4*)(NB + (size_t)(16 * rt + fr) * 64 + 16 * nt + 4 * fq); }
    bf16x8 sh[2], sl[2];
#pragma unroll
    for (int ks = 0; ks < 2; ++ks) { const f32x4 a = sv[ks][0], b = sv[ks][1];
        v4u h; h.x = cvt_pk_bf16(a[0], a[1]); h.y = cvt_pk_bf16(a[2], a[3]); h.z = cvt_pk_bf16(b[0], b[1]); h.w = cvt_pk_bf16(b[2], b[3]);
        v4u l; l.x = cvt_pk_bf16(a[0] - bf_lo(h.x), a[1] - bf_hi(h.x)); l.y = cvt_pk_bf16(a[2] - bf_lo(h.y), a[3] - bf_hi(h.y));
        l.z = cvt_pk_bf16(b[0] - bf_lo(h.z), b[1] - bf_hi(h.z)); l.w = cvt_pk_bf16(b[2] - bf_lo(h.w), b[3] - bf_hi(h.w));
        sh[ks] = __builtin_bit_cast(bf16x8, h); sl[ks] = __builtin_bit_cast(bf16x8, l);
        if ((wave & 1) == 0) *(v4u*)((bf16*)((unsigned char*)A.out + OB_S0S) + (size_t)(unit - NUNITS_P) * 4096 + (size_t)(16 * rt + fr) * 64 + 32 * ks + 8 * fq) = h; }
#pragma unroll
    for (int t = 0; t < 2; ++t) { const int nt = 2 * (wave & 1) + t;
#pragma unroll
        for (int ks = 0; ks < 2; ++ks) { acc[t] = __builtin_amdgcn_mfma_f32_16x16x32_bf16(mt[t][ks], sh[ks], acc[t], 0, 0, 0); acc[t] = __builtin_amdgcn_mfma_f32_16x16x32_bf16(mt[t][ks], sl[ks], acc[t], 0, 0, 0); }
        *(f32x4*)(outfin + (size_t)(16 * rt + fr) * 64 + 16 * nt + 4 * fq) = acc[t]; }
}

__device__ __forceinline__ void scan_pass3_wave(const Args& A, int unit, int wq, int lane) {
    const bool prompt = unit < NUNITS_P;
    const int b = prompt ? unit >> 9 : (unit - NUNITS_P) >> 3, h = prompt ? (unit >> 6) & 7 : unit & 7, ch = prompt ? unit & 63 : 0;
    const int T = prompt ? 64 : SEQ_S, rowbase = prompt ? b * SEQ_P + ch * 64 : NPROMPT + b * SEQ_S;
    if (wq * 16 >= T) return;
    const bf16* S0 = prompt ? (ch > 0 ? (const bf16*)((const float*)A.out + (size_t)(unit - 1) * 4096) : (const bf16*)(A.ws + WS_CTL + 49152)) : (const bf16*)((const unsigned char*)A.out + OB_S0S) + (size_t)(b * 8 + h) * 4096;
    const int spitch = prompt ? 128 : 64;
    const bf16* ZT = (const bf16*)(A.ws + WS_ZT); const bf16* YL = (const bf16*)(A.ws + WS_YL); const bf16* BV = (const bf16*)(A.ws + WS_BV);
    bf16* YB = (bf16*)(A.ws + WS_A1) + (size_t)MPAD * 512;
    const int fr = lane & 15, fq = lane >> 4;
    const size_t row = (size_t)(rowbase + wq * 16 + fr);
    bf16x8 bz[2], sa[4][2]; v2u yl[4], bvw[4], gg[4]; f32x4 gw[4], gb[4];
#pragma unroll
    for (int ks = 0; ks < 2; ++ks) bz[ks] = *(const bf16x8*)(ZT + row * 512 + h * 64 + ks * 32 + fq * 8);
#pragma unroll
    for (int mt = 0; mt < 4; ++mt)
#pragma unroll
        for (int ks = 0; ks < 2; ++ks) sa[mt][ks] = *(const bf16x8*)(S0 + (size_t)(mt * 16 + fr) * spitch + ks * 32 + fq * 8);
#pragma unroll
    for (int mt = 0; mt < 4; ++mt) { const int c = h * 64 + mt * 16 + fq * 4;
        yl[mt] = *(const v2u*)(YL + row * 512 + c); bvw[mt] = *(const v2u*)(BV + row * 512 + c); gg[mt] = *(const v2u*)(YB + row * 512 + c);
        gw[mt] = *(const f32x4*)(A.in[I_GNW] + c); gb[mt] = *(const f32x4*)(A.in[I_GNB] + c); }
    f32x4 acc[4];
#pragma unroll
    for (int mt = 0; mt < 4; ++mt) { acc[mt] = (f32x4){0.f, 0.f, 0.f, 0.f};
#pragma unroll
        for (int ks = 0; ks < 2; ++ks) acc[mt] = __builtin_amdgcn_mfma_f32_16x16x32_bf16(sa[mt][ks], bz[ks], acc[mt], 0, 0, 0); }
    float sm = 0.f;
#pragma unroll
    for (int mt = 0; mt < 4; ++mt) { const v2u y = yl[mt];
        acc[mt][0] += bf_lo(y.x); acc[mt][1] += bf_hi(y.x); acc[mt][2] += bf_lo(y.y); acc[mt][3] += bf_hi(y.y);
        sm += (acc[mt][0] + acc[mt][1]) + (acc[mt][2] + acc[mt][3]); }
    sm += __shfl_xor(sm, 16); sm += __shfl_xor(sm, 32);
    const float mean = sm * (1.f / 64.f); float sv = 0.f;
#pragma unroll
    for (int mt = 0; mt < 4; ++mt) { acc[mt] = acc[mt] - mean; sv += (acc[mt][0] * acc[mt][0] + acc[mt][1] * acc[mt][1]) + (acc[mt][2] * acc[mt][2] + acc[mt][3] * acc[mt][3]); }
    sv += __shfl_xor(sv, 16); sv += __shfl_xor(sv, 32);
    const float rs = 1.0f / sqrtf(sv * (1.f / 64.f) + 64e-5f);
#pragma unroll
    for (int mt = 0; mt < 4; ++mt) { const int c = h * 64 + mt * 16 + fq * 4;
        f32x4 o = acc[mt] * rs * gw[mt] + gb[mt] + (f32x4){bf_lo(bvw[mt].x), bf_hi(bvw[mt].x), bf_lo(bvw[mt].y), bf_hi(bvw[mt].y)};
        o = o * (f32x4){bf_lo(gg[mt].x), bf_hi(gg[mt].x), bf_lo(gg[mt].y), bf_hi(gg[mt].y)};
        v2u w; w.x = cvt_pk_bf16(o[0], o[1]); w.y = cvt_pk_bf16(o[2], o[3]); *(v2u*)(YB + row * 512 + c) = w; }
}

__device__ __forceinline__ void tk_insert(float (&tv)[16], float x) {
#pragma unroll
    for (int i = 15; i >= 1; --i) tv[i] = __builtin_amdgcn_fmed3f(tv[i - 1], x, tv[i]);
    tv[0] = __builtin_fmaxf(tv[0], x);
}
#define TK_CE(t, i, j) { const float a_ = __builtin_fmaxf(t[i], t[j]); t[j] = __builtin_fminf(t[i], t[j]); t[i] = a_; }
__device__ __forceinline__ void tk_sort16(float (&t)[16]) {
    TK_CE(t, 0, 1) TK_CE(t, 2, 3) TK_CE(t, 0, 2) TK_CE(t, 1, 3) TK_CE(t, 1, 2) TK_CE(t, 4, 5) TK_CE(t, 6, 7) TK_CE(t, 4, 6) TK_CE(t, 5, 7) TK_CE(t, 5, 6) TK_CE(t, 0, 4) TK_CE(t, 2, 6) TK_CE(t, 2, 4) TK_CE(t, 1, 5) TK_CE(t, 3, 7) TK_CE(t, 3, 5) TK_CE(t, 1, 2) TK_CE(t, 3, 4) TK_CE(t, 5, 6) TK_CE(t, 8, 9) TK_CE(t, 10, 11) TK_CE(t, 8, 10) TK_CE(t, 9, 11) TK_CE(t, 9, 10) TK_CE(t, 12, 13) TK_CE(t, 14, 15) TK_CE(t, 12, 14) TK_CE(t, 13, 15) TK_CE(t, 13, 14) TK_CE(t, 8, 12) TK_CE(t, 10, 14) TK_CE(t, 10, 12) TK_CE(t, 9, 13) TK_CE(t, 11, 15) TK_CE(t, 11, 13) TK_CE(t, 9, 10) TK_CE(t, 11, 12) TK_CE(t, 13, 14) TK_CE(t, 0, 8) TK_CE(t, 4, 12) TK_CE(t, 4, 8) TK_CE(t, 2, 10) TK_CE(t, 6, 14) TK_CE(t, 6, 10) TK_CE(t, 2, 4) TK_CE(t, 6, 8) TK_CE(t, 10, 12) TK_CE(t, 1, 9) TK_CE(t, 5, 13) TK_CE(t, 5, 9) TK_CE(t, 3, 11) TK_CE(t, 7, 15) TK_CE(t, 7, 11) TK_CE(t, 3, 5) TK_CE(t, 7, 9) TK_CE(t, 11, 13) TK_CE(t, 1, 2) TK_CE(t, 3, 4) TK_CE(t, 5, 6) TK_CE(t, 7, 8) TK_CE(t, 9, 10) TK_CE(t, 11, 12) TK_CE(t, 13, 14)
}
__device__ __forceinline__ void tk_merge16(float (&tv)[16], const float (&g)[16]) {
#pragma unroll
    for (int i = 0; i < 16; ++i) tv[i] = __builtin_fmaxf(tv[i], g[15 - i]);
#pragma unroll
    for (int s = 8; s >= 1; s >>= 1)
#pragma unroll
        for (int i = 0; i < 16; ++i) if ((i & s) == 0) TK_CE(tv, i, i + s)
}
__device__ __forceinline__ float gelu_tanh(float x) {
    const float u = 0.7978845608028654f * (x + 0.044715f * x * x * x);
    const float th = 1.0f - 2.0f * __builtin_amdgcn_rcpf(__expf(2.0f * u) + 1.0f);
    return 0.5f * x * (1.0f + th);
}
constexpr int NTILE32 = NTOK / 32;
constexpr int CW_QU = 8192, CW_QV = 8192 + 512;

constexpr int TK_STRIDE = 68, TK_BYTES = 64 * TK_STRIDE * 4;
__device__ __forceinline__ void topk_scores64(const bf16* Q, const bf16* KB, LAS float* SC, int t0, int hp, int p, int half, int lane, const bf16x8 (&af)[2][2][4]) {
    const int fr = lane & 15, fq = lane >> 4;
#pragma unroll
    for (int hs = 0; hs < 2; ++hs) {
        const bf16* kbase = KB + (size_t)(((hp + 4 * hs) * 2 + p) * 128 + half * 64 + fr) * 128 + fq * 8;
#pragma unroll
        for (int n = 0; n < 4; ++n) {
            bf16x8 bfr[4];
#pragma unroll
            for (int ks = 0; ks < 4; ++ks) bfr[ks] = *(const bf16x8*)(kbase + (size_t)n * 16 * 128 + ks * 32);
            f32x4 acc0 = (f32x4){0.f, 0.f, 0.f, 0.f}, acc1 = acc0;
#pragma unroll
            for (int ks = 0; ks < 4; ++ks) { acc0 = __builtin_amdgcn_mfma_f32_16x16x32_bf16(af[hs][0][ks], bfr[ks], acc0, 0, 0, 0); acc1 = __builtin_amdgcn_mfma_f32_16x16x32_bf16(af[hs][1][ks], bfr[ks], acc1, 0, 0, 0); }
#pragma unroll
            for (int rg = 0; rg < 4; ++rg) { SC[(hs * 32 + fq * 4 + rg) * TK_STRIDE + n * 16 + fr] = acc0[rg]; SC[(hs * 32 + 16 + fq * 4 + rg) * TK_STRIDE + n * 16 + fr] = acc1[rg]; }
        }
    }
}
constexpr int TK_NPROMPT_UNITS = (NPROMPT / 32) * 4, TK_NSAMPLE_UNITS = (NSAMP / 32) * 4, CW_TKS = 9792;
__device__ __forceinline__ void peer_topk_units(const Args& A, LAS unsigned char* lds, int lane, int wave, int u_first, int u_end, int u_step) {
    const bf16* Q = (const bf16*)(A.ws + WS_ZG); const bf16* KB = (const bf16*)(A.ws + WS_KEYS); const float* SSP = (const float*)(A.ws + WS_SSP);
    unsigned short* EIDX = (unsigned short*)(A.ws + WS_EIDX); float* GATE = (float*)(A.ws + WS_GATE); float* RSTD = (float*)(A.ws + WS_RSTD);
    LAS float* SC = (LAS float*)(lds + wave * TK_BYTES);
    const int fr = lane & 15, fq = lane >> 4, tokl = lane & 31, hsel = lane >> 5;
    for (int u = u_first; u < u_end; u += u_step) {
        const int t0 = (u >> 2) * 32, hp = u & 3, h = hp + 4 * hsel;
        const float* sp = SSP + (size_t)(t0 + tokl) * 16;
        const f32x4 s0 = *(const f32x4*)sp, s1 = *(const f32x4*)(sp + 4), s2 = *(const f32x4*)(sp + 8), s3 = *(const f32x4*)(sp + 12);
        const float ssq = ((s0[0] + s0[1]) + (s0[2] + s0[3])) + ((s1[0] + s1[1]) + (s1[2] + s1[3])) + ((s2[0] + s2[1]) + (s2[2] + s2[3])) + ((s3[0] + s3[1]) + (s3[2] + s3[3]));
        const float rstd = 1.0f / sqrtf(ssq * (1.f / DM) + 1e-6f);
        float tv0[16], tv1[16], cv[16];
#pragma unroll
        for (int p = 0; p < 2; ++p) {
            bf16x8 af[2][2][4];
#pragma unroll
            for (int hs = 0; hs < 2; ++hs)
#pragma unroll
                for (int mt = 0; mt < 2; ++mt) { const bf16* qp = Q + (size_t)(t0 + mt * 16 + fr) * 2048 + (hp + 4 * hs) * 256 + p * 128 + fq * 8;
#pragma unroll
                    for (int ks = 0; ks < 4; ++ks) af[hs][mt][ks] = *(const bf16x8*)(qp + ks * 32); }
            float tv[16];
#pragma unroll
            for (int i = 0; i < 16; ++i) tv[i] = -3.0e38f;
            for (int half = 0; half < 2; ++half) {
                topk_scores64(Q, KB, SC, t0, hp, p, half, lane, af);
                LDS_WAIT();
                const LAS float* mine = SC + lane * TK_STRIDE;
                unsigned kmask = 0xFFFFFF80u; asm volatile("" : "+v"(kmask));
#pragma unroll 1
                for (int n = 0; n < 64; n += 16) {
                    float g[16];
#pragma unroll
                    for (int q = 0; q < 4; ++q) { const f32x4 x4 = *(const LAS f32x4*)(mine + n + 4 * q);
#pragma unroll
                        for (int e = 0; e < 4; ++e) g[4 * q + e] = __uint_as_float((__float_as_uint(x4[e]) & kmask) | (unsigned)(half * 64 + n + 4 * q + e)); }
                    tk_sort16(g); tk_merge16(tv, g);
                }
                LDS_WAIT();
            }
#pragma unroll
            for (int i = 0; i < 16; ++i) { if (p == 0) tv0[i] = tv[i]; else tv1[i] = tv[i]; }
        }
        LAS int* li = (LAS int*)SC + lane * 33;
#pragma unroll
        for (int q = 0; q < 16; ++q) { li[q] = (int)(__float_as_uint(tv0[q]) & 127u); li[16 + q] = (int)(__float_as_uint(tv1[q]) & 127u);
            tv0[q] = __uint_as_float(__float_as_uint(tv0[q]) & 0xFFFFFF80u); tv1[q] = __uint_as_float(__float_as_uint(tv1[q]) & 0xFFFFFF80u); }
#pragma unroll
        for (int q = 0; q < 16; ++q) cv[q] = -3.0e38f;
#pragma unroll
        for (int a = 0; a < 16; ++a)
#pragma unroll
            for (int b = 0; b < 16; ++b) if ((a + 1) * (b + 1) <= 16)
                tk_insert(cv, __uint_as_float((__float_as_uint(tv0[a] + tv1[b]) & 0xFFFFFF00u) | (unsigned)(a * 16 + b)));
        LDS_WAIT();
        float e[16], den = 0.f; unsigned ci[16];
        const float c0 = __uint_as_float(__float_as_uint(cv[0]) & 0xFFFFFF00u);
#pragma unroll
        for (int q = 0; q < 16; ++q) { const unsigned kb = __float_as_uint(cv[q]); const float cq = __uint_as_float(kb & 0xFFFFFF00u);
            e[q] = __expf((cq - c0) * rstd); den += e[q]; ci[q] = (unsigned)(li[(kb >> 4) & 15] * 128 + li[16 + (kb & 15)]); }
        const float inv = 1.0f / den;
        LDS_WAIT();
        {
            const size_t tok = (size_t)(t0 + tokl);
            v4u w0, w1; w0.x = ci[0] | (ci[1] << 16); w0.y = ci[2] | (ci[3] << 16); w0.z = ci[4] | (ci[5] << 16); w0.w = ci[6] | (ci[7] << 16);
            w1.x = ci[8] | (ci[9] << 16); w1.y = ci[10] | (ci[11] << 16); w1.z = ci[12] | (ci[13] << 16); w1.w = ci[14] | (ci[15] << 16);
            *(v4u*)(EIDX + tok * 128 + h * 16) = w0; *(v4u*)(EIDX + tok * 128 + h * 16 + 8) = w1;
#pragma unroll
            for (int q = 0; q < 4; ++q) *(f32x4*)(GATE + tok * 128 + h * 16 + 4 * q) = (f32x4){e[4 * q] * inv, e[4 * q + 1] * inv, e[4 * q + 2] * inv, e[4 * q + 3] * inv};
            if (h == 0) RSTD[tok] = rstd;
        }
    }
}

__device__ __forceinline__ bool peer_topk_split(int G) { return G == 256; }
__device__ __forceinline__ void peer_topk_phase(const Args& A, LAS unsigned char* lds, int tid, int lane, int wave, int vcu, int G) {
    peer_topk_units(A, lds, lane, wave, wave * G + vcu, peer_topk_split(G) ? TK_NPROMPT_UNITS : TK_NPROMPT_UNITS + TK_NSAMPLE_UNITS, G * NWAVES);
}
__device__ __forceinline__ void peer_topk_sample_prelude(const Args& A, LAS unsigned char* lds, int tid, int lane, int wave, int vcu, int G, gu32* ctl) {
    if (!peer_topk_split(G) || (vcu & 31) != 0) return;
    peer_topk_units(A, lds, lane, wave, TK_NPROMPT_UNITS + (vcu >> 5) * NWAVES + wave, TK_NPROMPT_UNITS + TK_NSAMPLE_UNITS, TK_NSAMPLE_UNITS);
    asm volatile("s_waitcnt vmcnt(0)" ::: "memory");
    __syncthreads();
    if (tid == 0) { __builtin_amdgcn_fence(__ATOMIC_RELEASE, "agent"); asm volatile("s_waitcnt vmcnt(0)" ::: "memory"); (void)__hip_atomic_fetch_add((unsigned*)(ctl + CW_TKS), 1u, RLX_AGENT); }
    __syncthreads();
}
__device__ __forceinline__ void peer_topk_sample_wait(gu32* ctl, int tid) {
    if (tid == 0) {
        unsigned sp = 0;
        while (__hip_atomic_load((unsigned*)(ctl + CW_TKS), RLX_AGENT) < (unsigned)(TK_NSAMPLE_UNITS / NWAVES)) { __builtin_amdgcn_s_sleep(2); if (++sp > (1u << 22)) break; }
        __builtin_amdgcn_fence(__ATOMIC_ACQUIRE, "agent");
        asm volatile("s_waitcnt vmcnt(0)" ::: "memory");
    }
    __syncthreads();
}

constexpr int PEER_ITEM = 40, NITEM128 = NTOK / PEER_ITEM;
__device__ __forceinline__ bool peer_next_item(gu32* qbase, int xcc, int& qs, int& slice, int& item, LAS unsigned char* lds, int tid) {
    LAS int* box = (LAS int*)(lds + LDSCTL_OFF + 64);
    for (;;) {
        if (qs >= 8) return false;
        slice = (xcc + qs) & 7;
        if (tid == 0) box[0] = (int)__hip_atomic_fetch_add((unsigned*)(qbase + 64 * slice), 1u, RLX_AGENT);
        __syncthreads();
        item = box[0];
        __syncthreads();
        if (item < NITEM128) return true;
        ++qs;
    }
}

typedef long i64_t;
constexpr float PEER_SX = 1.0f;
constexpr int U_TILE0 = 8192, U_TILEB = 16384;
__device__ __forceinline__ i64_t mk64(unsigned lo, unsigned hi) { return (i64_t)(((unsigned long long)hi << 32) | (unsigned long long)lo); }
__device__ __forceinline__ void peer_u_phase(const Args& A, LAS unsigned char* lds, int tid, int lane, int wave, gu32* ctl, int qoff) {
    const unsigned char* Uq = A.ws + WS_UB; const bf16* XG = (const bf16*)(A.ws + WS_A1);
    const unsigned short* EIDX = (const unsigned short*)(A.ws + WS_EIDX); bf16* PART = (bf16*)(A.ws + WS_PART);
    const int xcc = (int)(xb_xcc_id() & 7u), rg = lane >> 3, c8 = lane & 7, m = lane & 15, kq = lane >> 4;
    LAS int* we = (LAS int*)(lds + wave * 1024);
    LAS unsigned char* tile = lds + U_TILE0 + wave * U_TILEB;
    const int ch_e = ((c8 - (rg >> 1)) & 7) * 16, ch_o = ((c8 - 4 - (rg >> 1)) & 7) * 16;
    const int fbase = m * 128 + (kq & 1) * 8, pos0 = (kq >> 1) + (m >> 1);
    int foff[4];
#pragma unroll
    for (int ks = 0; ks < 4; ++ks) foff[ks] = fbase + ((pos0 + 2 * ks) & 7) * 16;
    int qs = 0, slice, item; bool lists_ready = !peer_topk_split((int)gridDim.x);
    while (peer_next_item(ctl + CW_QU + qoff, xcc, qs, slice, item, lds, tid)) {
        if (!lists_ready && (item + 1) * PEER_ITEM > NPROMPT) { peer_topk_sample_wait(ctl, tid); lists_ready = true; }
        const unsigned char* us = Uq + (size_t)slice * 16384 * 128;
        size_t tok = (size_t)(item * PEER_ITEM + wave);
        unsigned pair = *(const unsigned*)(EIDX + tok * 128 + 2 * lane);
        v4u xr[4];
#pragma unroll
        for (int ks = 0; ks < 4; ++ks) xr[ks] = *(const v4u*)(XG + tok * DM + slice * 128 + ks * 32 + kq * 8);
        we[2 * lane] = (int)(pair & 0xffffu); we[2 * lane + 1] = (int)(pair >> 16);
        LDS_WAIT();
        v4u w[16];
#pragma unroll
        for (int it = 0; it < 16; ++it) w[it] = *(const v4u*)(us + (unsigned)(((unsigned)we[it * 8 + rg] << 7) + (unsigned)((it & 1) ? ch_o : ch_e)));
        for (int tt = 0; tt < PEER_ITEM / NWAVES; ++tt) {
            const size_t ctok = tok; const bool more = tt + 1 < PEER_ITEM / NWAVES;
            i64_t bx[4];
#pragma unroll
            for (int ks = 0; ks < 4; ++ks) { const v4u q = xr[ks]; typedef short s16x2 __attribute__((ext_vector_type(2)));
                s16x2 lo = (s16x2){0, 0}, hi = lo;
                unsigned q0 = q.x, q1 = q.y, q2 = q.z, q3 = q.w; asm volatile("" : "+v"(q0), "+v"(q1), "+v"(q2), "+v"(q3));
                lo = __builtin_amdgcn_cvt_scalef32_pk_fp8_bf16(lo, __builtin_bit_cast(bf16x2_t, q0), PEER_SX, false); lo = __builtin_amdgcn_cvt_scalef32_pk_fp8_bf16(lo, __builtin_bit_cast(bf16x2_t, q1), PEER_SX, true);
                hi = __builtin_amdgcn_cvt_scalef32_pk_fp8_bf16(hi, __builtin_bit_cast(bf16x2_t, q2), PEER_SX, false); hi = __builtin_amdgcn_cvt_scalef32_pk_fp8_bf16(hi, __builtin_bit_cast(bf16x2_t, q3), PEER_SX, true);
                bx[ks] = mk64(__builtin_bit_cast(unsigned, lo), __builtin_bit_cast(unsigned, hi)); }
            if (more) { tok += NWAVES; pair = *(const unsigned*)(EIDX + tok * 128 + 2 * lane);
#pragma unroll
                for (int ks = 0; ks < 4; ++ks) xr[ks] = *(const v4u*)(XG + tok * DM + slice * 128 + ks * 32 + kq * 8); }
#pragma unroll
            for (int it = 0; it < 16; ++it) *(LAS v4u*)(tile + it * 1024 + lane * 16) = w[it];
            if (more) {
                we[2 * lane] = (int)(pair & 0xffffu); we[2 * lane + 1] = (int)(pair >> 16);
                LDS_WAIT();
#pragma unroll
                for (int it = 0; it < 16; ++it) w[it] = *(const v4u*)(us + (unsigned)(((unsigned)we[it * 8 + rg] << 7) + (unsigned)((it & 1) ? ch_o : ch_e)));
            } else LDS_WAIT();
            bf16* pp = PART + (ctok * 8 + slice) * 128;
            f32x4 acc[8];
#pragma unroll
            for (int hf = 0; hf < 2; ++hf) {
                v2u a[4][4];
#pragma unroll
                for (int T4 = 0; T4 < 4; ++T4)
#pragma unroll
                    for (int ks = 0; ks < 4; ++ks) a[T4][ks] = *(const LAS v2u*)(tile + (hf * 4 + T4) * 2048 + foff[ks]);
#pragma unroll
                for (int T4 = 0; T4 < 4; ++T4) acc[hf * 4 + T4] = (f32x4){0.f, 0.f, 0.f, 0.f};
#pragma unroll
                for (int ks = 0; ks < 4; ++ks)
#pragma unroll
                    for (int T4 = 0; T4 < 4; ++T4) acc[hf * 4 + T4] = __builtin_amdgcn_mfma_f32_16x16x32_fp8_fp8(mk64(a[T4][ks].x, a[T4][ks].y), bx[ks], acc[hf * 4 + T4], 0, 0, 0);
            }
            f32x4 val = acc[0];
#pragma unroll
            for (int T = 1; T < 8; ++T) val = ((m & 7) == T) ? acc[T] : val;
            if (m < 8) { v2u pw; pw.x = cvt_pk_bf16(val[0] * (1.0f / PEER_SX), val[1] * (1.0f / PEER_SX)); pw.y = cvt_pk_bf16(val[2] * (1.0f / PEER_SX), val[3] * (1.0f / PEER_SX)); *(v2u*)(pp + m * 16 + 4 * kq) = pw; }
            LDS_WAIT();
        }
    }
}

constexpr float PEER_CS = 64.0f;
__device__ __forceinline__ void peer_coef_phase(const Args& A, int lane, int wave, int vcu, int G) {
    const bf16* PART = (const bf16*)(A.ws + WS_PART); const float* GATE = (const float*)(A.ws + WS_GATE); const float* RSTD = (const float*)(A.ws + WS_RSTD);
    unsigned char* C8 = A.ws + WS_COEF;
    for (int tok = vcu * NWAVES + wave; tok < NTOK; tok += G * NWAVES) {
        const bf16* pp = PART + (size_t)tok * 1024 + 2 * lane;
        unsigned pw[8];
#pragma unroll
        for (int j = 0; j < 8; ++j) pw[j] = *(const unsigned*)(pp + j * 128);
        f32x2 d = (f32x2){bf_lo(pw[0]), bf_hi(pw[0])};
#pragma unroll
        for (int j = 1; j < 8; ++j) d += (f32x2){bf_lo(pw[j]), bf_hi(pw[j])};
        const float sc = RSTD[tok] * (1.0f / PEER_SU); const f32x2 gt = *(const f32x2*)(GATE + (size_t)tok * 128 + 2 * lane);
        f32x2 cf; cf.x = gt.x * gelu_tanh(d.x * sc) * (PEER_CS / PEER_SV); cf.y = gt.y * gelu_tanh(d.y * sc) * (PEER_CS / PEER_SV);
        const unsigned hi = (unsigned)__builtin_amdgcn_cvt_pk_fp8_f32(cf.x, cf.y, 0, false) & 0xffffu;
        const f32x2 bk = __builtin_amdgcn_cvt_pk_f32_fp8(hi, false);
        const unsigned lo = (unsigned)__builtin_amdgcn_cvt_pk_fp8_f32((cf.x - bk.x) * 16.0f, (cf.y - bk.y) * 16.0f, 0, false) & 0xffffu;
        *(unsigned short*)(C8 + (size_t)tok * 256 + 2 * lane) = (unsigned short)hi; *(unsigned short*)(C8 + (size_t)tok * 256 + 128 + 2 * lane) = (unsigned short)lo;
    }
}

typedef int v2i_t __attribute__((ext_vector_type(2)));
__device__ __forceinline__ void peer_v_phase(const Args& A, LAS unsigned char* lds, int tid, int lane, int wave, gu32* ctl) {
    const unsigned char* Vq = A.ws + WS_VB;
    const unsigned short* EIDX = (const unsigned short*)(A.ws + WS_EIDX); const unsigned char* C8 = A.ws + WS_COEF;
    float* X1 = A.out + O_Y; float* SS2 = (float*)(A.ws + WS_SS2); const bf16* XGv = (const bf16*)(A.ws + WS_A1);
    const int xcc = (int)(xb_xcc_id() & 7u), rg = lane >> 3, c8 = lane & 7, m = lane & 15, kq = lane >> 4;
    LAS int* we = (LAS int*)(lds + wave * 1024);
    LAS unsigned char* tile = lds + U_TILE0 + wave * U_TILEB;
    const int ch_e = ((c8 - (rg >> 1)) & 7) * 16, ch_o = ((c8 - 4 - (rg >> 1)) & 7) * 16;
    const int tr_r = (lane & 15) >> 1, tr_p = lane & 1, tr_rot = 4 * (kq & 1) + (tr_r >> 1);
    const int tbase = (8 * kq + tr_r) * 128 + 8 * tr_p;
    int toff[8];
#pragma unroll
    for (int j = 0; j < 8; ++j) toff[j] = tbase + ((j + tr_rot) & 7) * 16;
    int qs = 0, slice, item;
    while (peer_next_item(ctl + CW_QV, xcc, qs, slice, item, lds, tid)) {
        const unsigned char* vs = Vq + (size_t)slice * 16384 * 128;
        size_t tok = (size_t)(item * PEER_ITEM + wave);
        unsigned pair = *(const unsigned*)(EIDX + tok * 128 + 2 * lane);
        v2u cfr[4];
#pragma unroll
        for (int ks = 0; ks < 4; ++ks) cfr[ks] = *(const v2u*)(C8 + tok * 256 + (m & 1) * 128 + ks * 32 + kq * 8);
        const float rga = 1.0f / A.in[I_N2G][slice * 128 + lane], rgb = 1.0f / A.in[I_N2G][slice * 128 + 64 + lane];
        unsigned short xoa = XGv[tok * DM + slice * 128 + lane], xob = XGv[tok * DM + slice * 128 + 64 + lane];
        we[2 * lane] = (int)(pair & 0xffffu); we[2 * lane + 1] = (int)(pair >> 16);
        LDS_WAIT();
        v4u w[16];
#pragma unroll
        for (int it = 0; it < 16; ++it) w[it] = *(const v4u*)(vs + (unsigned)(((unsigned)we[it * 8 + rg] << 7) + (unsigned)((it & 1) ? ch_o : ch_e)));
        for (int tt = 0; tt < PEER_ITEM / NWAVES; ++tt) {
            const size_t ctok = tok; const bool more = tt + 1 < PEER_ITEM / NWAVES;
            i64_t af[4];
#pragma unroll
            for (int ks = 0; ks < 4; ++ks) af[ks] = mk64(cfr[ks].x, cfr[ks].y);
            const float xa = __uint_as_float((unsigned)xoa << 16) * rga, xb = __uint_as_float((unsigned)xob << 16) * rgb;
            if (more) { tok += NWAVES; pair = *(const unsigned*)(EIDX + tok * 128 + 2 * lane);
#pragma unroll
                for (int ks = 0; ks < 4; ++ks) cfr[ks] = *(const v2u*)(C8 + tok * 256 + (m & 1) * 128 + ks * 32 + kq * 8);
                xoa = XGv[tok * DM + slice * 128 + lane]; xob = XGv[tok * DM + slice * 128 + 64 + lane]; }
#pragma unroll
            for (int it = 0; it < 16; ++it) *(LAS v4u*)(tile + it * 1024 + lane * 16) = w[it];
            if (more) {
                we[2 * lane] = (int)(pair & 0xffffu); we[2 * lane + 1] = (int)(pair >> 16);
                LDS_WAIT();
#pragma unroll
                for (int it = 0; it < 16; ++it) w[it] = *(const v4u*)(vs + (unsigned)(((unsigned)we[it * 8 + rg] << 7) + (unsigned)((it & 1) ? ch_o : ch_e)));
            } else LDS_WAIT();
            f32x4 acc[8];
#pragma unroll
            for (int hf = 0; hf < 2; ++hf) {
                v2i_t b[4][4];
#pragma unroll
                for (int j4 = 0; j4 < 4; ++j4)
#pragma unroll
                    for (int ks = 0; ks < 4; ++ks) b[j4][ks] = __builtin_amdgcn_ds_read_tr8_b64_v2i32((LAS v2i_t*)(tile + ks * 4096 + toff[hf * 4 + j4]));
#pragma unroll
                for (int j4 = 0; j4 < 4; ++j4) acc[hf * 4 + j4] = (f32x4){0.f, 0.f, 0.f, 0.f};
#pragma unroll
                for (int ks = 0; ks < 4; ++ks)
#pragma unroll
                    for (int j4 = 0; j4 < 4; ++j4) acc[hf * 4 + j4] = __builtin_amdgcn_mfma_f32_16x16x32_fp8_fp8(af[ks], mk64((unsigned)b[j4][ks].x, (unsigned)b[j4][ks].y), acc[hf * 4 + j4], 0, 0, 0);
            }
            float h0 = acc[0][0], l0 = acc[0][1], h1 = acc[4][0], l1 = acc[4][1];
#pragma unroll
            for (int j = 1; j < 4; ++j) { const bool s = kq == j; h0 = s ? acc[j][0] : h0; l0 = s ? acc[j][1] : l0; h1 = s ? acc[4 + j][0] : h1; l1 = s ? acc[4 + j][1] : l1; }
            const float x2a = xa + (h0 + l0 * (1.0f / 16.0f)) * (1.0f / PEER_CS), x2b = xb + (h1 + l1 * (1.0f / 16.0f)) * (1.0f / PEER_CS);
            { bf16* xr_ = (bf16*)X1 + ctok * (2 * DM) + slice * 128 + lane;
              xr_[0] = (bf16)(cvt_pk_bf16(x2a, x2a) & 0xffffu); xr_[64] = (bf16)(cvt_pk_bf16(x2b, x2b) & 0xffffu); }
            float ss = sum16(x2a * x2a + x2b * x2b); ss += __shfl_xor(ss, 16); ss += __shfl_xor(ss, 32);
            if (lane == 0) SS2[ctok * 8 + slice] = ss;
            LDS_WAIT();
        }
    }
}

__device__ __forceinline__ void peer_final_phase(const Args& A, int lane, int wave, int vcu, int G) {
    float* X1 = A.out + O_Y; const float* SS2 = (const float*)(A.ws + WS_SS2); const float* gf = A.in[I_NFG] + lane * 16;
    const f32x4 g0 = *(const f32x4*)gf, g1 = *(const f32x4*)(gf + 4), g2 = *(const f32x4*)(gf + 8), g3 = *(const f32x4*)(gf + 12);
    for (int tok = vcu * NWAVES + wave; tok < NTOK; tok += G * NWAVES) {
        const f32x4 sa = *(const f32x4*)(SS2 + (size_t)tok * 8), sb = *(const f32x4*)(SS2 + (size_t)tok * 8 + 4);
        const float ss = ((sa[0] + sa[1]) + (sa[2] + sa[3])) + ((sb[0] + sb[1]) + (sb[2] + sb[3]));
        const float rf = 1.0f / sqrtf(ss * (1.f / DM) + 1e-6f);
        float* yr = X1 + (size_t)tok * DM + lane * 16;
        const v4u s0 = *(const v4u*)((const bf16*)(X1 + (size_t)tok * DM) + lane * 16), s1 = *(const v4u*)((const bf16*)(X1 + (size_t)tok * DM) + lane * 16 + 8);
        const f32x4 y0 = (f32x4){bf_lo(s0.x), bf_hi(s0.x), bf_lo(s0.y), bf_hi(s0.y)}, y1 = (f32x4){bf_lo(s0.z), bf_hi(s0.z), bf_lo(s0.w), bf_hi(s0.w)},
                    y2 = (f32x4){bf_lo(s1.x), bf_hi(s1.x), bf_lo(s1.y), bf_hi(s1.y)}, y3 = (f32x4){bf_lo(s1.z), bf_hi(s1.z), bf_lo(s1.w), bf_hi(s1.w)};
        *(f32x4*)yr = y0 * rf * g0; *(f32x4*)(yr + 4) = y1 * rf * g1; *(f32x4*)(yr + 8) = y2 * rf * g2; *(f32x4*)(yr + 12) = y3 * rf * g3;
    }
}

__device__ __forceinline__ void sg_partial(const bf16* Ap, int lda, const bf16* Bp, int ldb, LAS f32x4* red, int lane, int wave) {
    const int fr = lane & 15, fq = lane >> 4;
    bf16x8 a[2][4], b[4][4];
#pragma unroll
    for (int mi = 0; mi < 2; ++mi)
#pragma unroll
        for (int ks = 0; ks < 4; ++ks) a[mi][ks] = *(const bf16x8*)(Ap + (size_t)(16 * mi + fr) * lda + 32 * ks + 8 * fq);
#pragma unroll
    for (int nj = 0; nj < 4; ++nj)
#pragma unroll
        for (int ks = 0; ks < 4; ++ks) b[nj][ks] = *(const bf16x8*)(Bp + (size_t)(16 * nj + fr) * ldb + 32 * ks + 8 * fq);
    f32x4 acc[2][4];
#pragma unroll
    for (int mi = 0; mi < 2; ++mi)
#pragma unroll
        for (int nj = 0; nj < 4; ++nj) acc[mi][nj] = (f32x4){0.f, 0.f, 0.f, 0.f};
#pragma unroll
    for (int ks = 0; ks < 4; ++ks)
#pragma unroll
        for (int mi = 0; mi < 2; ++mi)
#pragma unroll
            for (int nj = 0; nj < 4; ++nj) acc[mi][nj] = __builtin_amdgcn_mfma_f32_16x16x32_bf16(b[nj][ks], a[mi][ks], acc[mi][nj], 0, 0, 0);
#pragma unroll
    for (int mi = 0; mi < 2; ++mi)
#pragma unroll
        for (int nj = 0; nj < 4; ++nj) red[(wave * 8 + mi * 4 + nj) * 64 + lane] = acc[mi][nj];
}
__device__ __forceinline__ f32x4 sg_sum(const LAS f32x4* red, int w0, int nw, int wave, int lane) {
    f32x4 s = red[(w0 * 8 + wave) * 64 + lane];
    for (int w = 1; w < nw; ++w) s += red[((w0 + w) * 8 + wave) * 64 + lane];
    return s;
}
__device__ __forceinline__ void sample_gemm2(const Args& A, LAS unsigned char* lds, int t, int lane, int wave) {
    unsigned char* ws = A.ws; const int fr = lane & 15, fq = lane >> 4;
    const int row0 = NPROMPT + (t >> 4) * 32, col0 = (t & 15) * 64;
    LAS f32x4* red = (LAS f32x4*)lds;
    const bf16* Ab = (const bf16*)(ws + WS_A1) + (wave >= 4 ? (size_t)MPAD * 512 : 0); const bf16* Bb = (const bf16*)(ws + (wave >= 4 ? WS_WPB : WS_WPA));
    sg_partial(Ab + (size_t)row0 * 512 + (wave & 3) * 128, 512, Bb + (size_t)col0 * 512 + (wave & 3) * 128, 512, red, lane, wave);
    const int row = row0 + 16 * (wave >> 2) + fr, c = col0 + 16 * (wave & 3) + 4 * fq;
    const bf16* Zg = (const bf16*)(ws + WS_ZG) + (size_t)row * 2048;
    const v2u ga = *(const v2u*)(Zg + c), gb = *(const v2u*)(Zg + 1024 + c);
    __syncthreads();
    const f32x4 pa = sg_sum(red, 0, 4, wave, lane), pb = sg_sum(red, 4, 4, wave, lane);
    const float o0 = sigm(bf_lo(ga.x)) * pa[0] + sigm(bf_lo(gb.x)) * pb[0], o1 = sigm(bf_hi(ga.x)) * pa[1] + sigm(bf_hi(gb.x)) * pb[1],
                o2 = sigm(bf_lo(ga.y)) * pa[2] + sigm(bf_lo(gb.y)) * pb[2], o3 = sigm(bf_hi(ga.y)) * pa[3] + sigm(bf_hi(gb.y)) * pb[3];
    v2u w; w.x = cvt_pk_bf16(o0, o1); w.y = cvt_pk_bf16(o2, o3); *(v2u*)((bf16*)(ws + WS_ZR) + (size_t)row * 1024 + c) = w;
    __syncthreads();
}
__device__ __forceinline__ void sample_gemm3(const Args& A, LAS unsigned char* lds, int t, int tid, int lane, int wave) {
    unsigned char* ws = A.ws; const int fr = lane & 15, fq = lane >> 4;
    const int row0 = NPROMPT + (t >> 4) * 32, col0 = (t & 15) * 64;
    LAS f32x4* red = (LAS f32x4*)lds; LAS float* ssl = (LAS float*)(lds + 65536);
    sg_partial((const bf16*)(ws + WS_ZR) + (size_t)row0 * 1024 + wave * 128, 1024, (const bf16*)(ws + WS_WO) + (size_t)col0 * 1024 + wave * 128, 1024, red, lane, wave);
    const int row = row0 + 16 * (wave >> 2) + fr, c = col0 + 16 * (wave & 3) + 4 * fq;
    const f32x4 xv = *(const f32x4*)(A.in[I_XS] + (size_t)(row - NPROMPT) * 1024 + c), q = *(const f32x4*)(A.in[I_N2G] + c);
    __syncthreads();
    const f32x4 o = xv + sg_sum(red, 0, 8, wave, lane);
    float ss = (o[0] * o[0] + o[1] * o[1]) + (o[2] * o[2] + o[3] * o[3]);
    v2u w; w.x = cvt_pk_bf16(o[0] * q[0], o[1] * q[1]); w.y = cvt_pk_bf16(o[2] * q[2], o[3] * q[3]); *(v2u*)((bf16*)(ws + WS_A1) + (size_t)row * 1024 + c) = w;
    ss += __shfl_xor(ss, 16); ss += __shfl_xor(ss, 32);
    if (fq == 0) ssl[wave * 16 + fr] = ss;
    __syncthreads();
    if (tid < 32) { const int mi = tid >> 4, r = tid & 15;
        ((float*)(ws + WS_SSP))[(size_t)(row0 + tid) * 16 + (t & 15)] = (ssl[(mi * 4 + 0) * 16 + r] + ssl[(mi * 4 + 1) * 16 + r]) + (ssl[(mi * 4 + 2) * 16 + r] + ssl[(mi * 4 + 3) * 16 + r]); }
}
__device__ __forceinline__ void sample_gemm4(const Args& A, LAS unsigned char* lds, int t, int lane, int wave) {
    unsigned char* ws = A.ws; const int fr = lane & 15, fq = lane >> 4;
    const int row0 = NPROMPT + (t >> 5) * 32, col0 = (t & 31) * 64;
    LAS f32x4* red = (LAS f32x4*)lds;
    sg_partial((const bf16*)(ws + WS_A1) + (size_t)row0 * 1024 + wave * 128, 1024, (const bf16*)(ws + WS_WQ) + (size_t)col0 * 1024 + wave * 128, 1024, red, lane, wave);
    const int row = row0 + 16 * (wave >> 2) + fr, c = col0 + 16 * (wave & 3) + 4 * fq;
    __syncthreads();
    const f32x4 o = sg_sum(red, 0, 8, wave, lane);
    v2u w; w.x = cvt_pk_bf16(o[0], o[1]); w.y = cvt_pk_bf16(o[2], o[3]); *(v2u*)((bf16*)(ws + WS_ZG) + (size_t)row * 2048 + c) = w;
    __syncthreads();
}

__global__ void __launch_bounds__(NTHR, 2) mk_fwd(Args args) {
    extern __shared__ __attribute__((aligned(16))) unsigned char lds_raw[];
    LAS unsigned char* lds = (LAS unsigned char*)lds_raw;
    const int tid = threadIdx.x, lane = tid & 63, wave = __builtin_amdgcn_readfirstlane(tid >> 6);
    const int G = gridDim.x; const int bx = blockIdx.x; const int vcu = (G % 8 == 0) ? (bx % 8) * (G / 8) + bx / 8 : bx;
    gu32* ctl = (gu32*)(args.ws + WS_CTL);
    volatile LAS unsigned* MISC = (volatile LAS unsigned*)(lds + MISC_OFF);
    for (int u = tid; u < (LDS_BYTES - LDSCTL_OFF) / 4; u += NTHR) ((LAS unsigned*)(lds + LDSCTL_OFF))[u] = 0u;
    __syncthreads();
    XcdBarrier bar; bar.bar = (unsigned*)(ctl + CW_BAR) + args.li * XCD_BAR_WORDS; bar.x = 0; bar.st = nullptr;
    if (N_LAUNCHES != PER_PHASE) bar = xcd_barrier_post((unsigned*)(ctl + CW_BAR) + args.li * XCD_BAR_WORDS, MISC + 8);
    const int lo = args.ph_lo, hi = args.ph_hi;
#define IN(k) (lo <= (k) && (k) < hi)
#define BOTH(k) (IN(k) && IN((k) + 1))
#define GRID_BAR() do { if (N_LAUNCHES != PER_PHASE) xcd_barrier(bar); } while (0)
    unsigned char* ws = args.ws;
    bf16* A1 = (bf16*)(ws + WS_A1);

    if (IN(0)) for (int rep_ = 0; rep_ < ((MK_REPEAT == 0) ? 2 : 1); ++rep_) { p0_prologue(args, lds, tid, lane, wave, vcu, G); if (BOTH(0)) GRID_BAR(); }

    if (IN(1)) for (int rep_ = 0; rep_ < ((MK_REPEAT == 1) ? 2 : 1); ++rep_) {
        pg8::Gemm g{A1, (const bf16*)(ws + WS_W1T), MPAD, N1, DM}; pg8::StaticOrder S; S.init(MPAD, N1, G, bx);
        pg8::EpiZ E{(bf16*)(ws + WS_ZC), (bf16*)(ws + WS_ZR), (bf16*)(ws + WS_ZG)};
        pg8::gemm_phase<pg8::EpiZ, pg8::StaticOrder, true, true>(lds, g, S, E);
        if (BOTH(1)) GRID_BAR();
    }

    if (IN(2)) for (int rep_ = 0; rep_ < ((MK_REPEAT == 2) ? 2 : 1); ++rep_) { conv_phase(args, vcu * NTHR + tid, G * NTHR); if (BOTH(2)) GRID_BAR(); }

    if (IN(3)) for (int rep_ = 0; rep_ < ((MK_REPEAT == 3) ? 2 : 1); ++rep_) {
        scan_pass1(args, lds, tid, lane, wave, vcu, G, (MK_REPEAT == 3 && rep_ == 0) ? 1 : 0);
        if (BOTH(3)) GRID_BAR();
    }

    if (IN(4)) {
        for (int u = vcu; u < 512; u += G) {
            if (u < 256) { const int bh = u >> 2, vq = u & 3; scan_pass2_rows(nullptr, bh * 64, 64, vq * 16, args.out + O_WKV_P + (size_t)bh * 4096, true, args, lds, tid, lane, wave); }
            else { const int bh = u - 256; scan_pass2_sample(args.in[I_SWKV] + (size_t)bh * 4096, NUNITS_P + bh, args.out + O_WKV_S + (size_t)bh * 4096, args, lane, wave); }
        }
        if (BOTH(4)) GRID_BAR();
    }

    if (IN(5)) for (int rep_ = 0; rep_ < ((MK_REPEAT == 5) ? 2 : 1); ++rep_) {
        for (int u2 = vcu; u2 < NUNITS / 2; u2 += G) scan_pass3_wave(args, u2 * 2 + (wave >> 2), wave & 3, lane);
        if (BOTH(5)) GRID_BAR();
    }

    if (IN(6)) {
        { pg8::Gemm g{A1, (const bf16*)(ws + WS_WPA), NPROMPT, DM, 512}; pg8::StaticOrder S; S.init(NPROMPT, DM, G, bx);
          pg8::EpiGate<0> E{(const bf16*)(ws + WS_ZG), (bf16*)(ws + WS_ZR)};
          pg8::gemm_phase<pg8::EpiGate<0>, pg8::StaticOrder, true, true>(lds, g, S, E); }
        { pg8::Gemm g{A1 + (size_t)MPAD * 512, (const bf16*)(ws + WS_WPB), NPROMPT, DM, 512}; pg8::StaticOrder S; S.init(NPROMPT, DM, G, bx);
          pg8::EpiGate<1> E{(const bf16*)(ws + WS_ZG), (bf16*)(ws + WS_ZR)};
          pg8::gemm_phase<pg8::EpiGate<1>, pg8::StaticOrder, true, true>(lds, g, S, E); }
        for (int t = vcu; t < 256; t += G) sample_gemm2(args, lds, t, lane, wave);
        if (BOTH(6)) GRID_BAR();
    }

    if (IN(7)) for (int rep_ = 0; rep_ < ((MK_REPEAT == 7) ? 2 : 1); ++rep_) {
        pg8::Gemm g{(const bf16*)(ws + WS_ZR), (const bf16*)(ws + WS_WO), NPROMPT, DM, DM}; pg8::StaticOrder S; S.init(NPROMPT, DM, G, bx);
        pg8::EpiX1 E{args.in[I_XP], args.in[I_XS], args.out + O_Y, A1, (float*)(ws + WS_SSP), args.in[I_N2G], NPROMPT, NTOK};
        pg8::gemm_phase<pg8::EpiX1, pg8::StaticOrder, true, true>(lds, g, S, E);
        for (int t = vcu; t < 256; t += G) sample_gemm3(args, lds, t, tid, lane, wave);
        if (BOTH(7)) GRID_BAR();
    }

    if (IN(8)) for (int rep_ = 0; rep_ < ((MK_REPEAT == 8) ? 2 : 1); ++rep_) {
        pg8::Gemm g{A1, (const bf16*)(ws + WS_WQ), NPROMPT, 2048, DM}; pg8::StaticOrder S; S.init(NPROMPT, 2048, G, bx);
        pg8::EpiPlain E{(bf16*)(ws + WS_ZG), 2048};
        pg8::gemm_phase<pg8::EpiPlain, pg8::StaticOrder, true, true>(lds, g, S, E);
        for (int t = vcu; t < 512; t += G) sample_gemm4(args, lds, t, lane, wave);
        if (BOTH(8)) GRID_BAR();
    }

    if (IN(9)) for (int rep_ = 0; rep_ < ((MK_REPEAT == 9) ? 2 : 1); ++rep_) { peer_topk_phase(args, lds, tid, lane, wave, vcu, G); if (BOTH(9)) GRID_BAR(); }
    if (IN(10)) for (int rep_ = 0; rep_ < ((MK_REPEAT == 10) ? 2 : 1); ++rep_) { if (rep_ == 0) peer_topk_sample_prelude(args, lds, tid, lane, wave, vcu, G, ctl); peer_u_phase(args, lds, tid, lane, wave, ctl, rep_ * 1024); if (BOTH(10)) GRID_BAR(); }
    if (IN(11)) { peer_coef_phase(args, lane, wave, vcu, G); if (BOTH(11)) GRID_BAR(); }
    if (IN(12)) { peer_v_phase(args, lds, tid, lane, wave, ctl); if (BOTH(12)) GRID_BAR(); }
    if (IN(13)) peer_final_phase(args, lane, wave, vcu, G);
#undef IN
#undef BOTH
#undef GRID_BAR
}

extern "C" void kernel_launch(void* const* d_in, const int* in_sizes, int n_in, void* d_out, int out_size, void* d_ws, size_t ws_size, hipStream_t stream) {
    static int grid = 0;
    if (grid == 0) {
        if (n_in != 32 || ws_size < WS_END) { fprintf(stderr, "kernel_launch: built for 32 inputs and >= %zu bytes of workspace; got n_in %d ws %zu; nothing launched\n", (size_t)WS_END, n_in, ws_size); grid = -1; return; }
        int dev = 0, cus = 0, per_cu = 0;
        if (hipGetDevice(&dev) != hipSuccess || hipDeviceGetAttribute(&cus, hipDeviceAttributeMultiprocessorCount, dev) != hipSuccess) { fprintf(stderr, "kernel_launch: device query failed\n"); grid = -1; return; }
        if (hipFuncSetAttribute((const void*)mk_fwd, hipFuncAttributeMaxDynamicSharedMemorySize, LDS_BYTES) != hipSuccess) { fprintf(stderr, "kernel_launch: hipFuncSetAttribute failed\n"); grid = -1; return; }
        if (hipOccupancyMaxActiveBlocksPerMultiprocessor(&per_cu, (const void*)mk_fwd, NTHR, LDS_BYTES) != hipSuccess || per_cu < 1)
            fprintf(stderr, "kernel_launch: note: occupancy query reports %d workgroups per CU\n", per_cu);
        (void)hipGetLastError();
        grid = cus;
    }
    if (grid < 0) return;
    if (hipMemsetAsync((char*)d_ws + WS_CTL, 0, CTL_ZERO_BYTES, stream) != hipSuccess) { fprintf(stderr, "kernel_launch: hipMemsetAsync failed\n"); return; }
    Args a{};
    for (int i = 0; i < 32; ++i) a.in[i] = (const float*)d_in[i];
    a.out = (float*)d_out; a.ws = (unsigned char*)d_ws;
    constexpr int NL = (N_LAUNCHES == PER_PHASE ? PER_PHASE : 1) + ((MK_EXTRA_LO >= 0) ? 1 : 0);
    for (int li = 0; li < NL; ++li) {
        if (N_LAUNCHES == PER_PHASE) { a.ph_lo = li; a.ph_hi = li + 1; } else { a.ph_lo = 0; a.ph_hi = PER_PHASE; }
        if (MK_EXTRA_LO >= 0 && li == NL - 1) { a.ph_lo = MK_EXTRA_LO; a.ph_hi = MK_EXTRA_HI; }
        a.li = li;
        hipLaunchKernelGGL(mk_fwd, dim3(grid), dim3(NTHR), LDS_BYTES, stream, a);
        const hipError_t le = hipPeekAtLastError();
        if (le != hipSuccess) { fprintf(stderr, "kernel_launch: launch %d failed: %s\n", li, hipGetErrorName(le)); break; }
    }
}
```

```cpp
#include <hip/hip_runtime.h>
#include <cstdio>
#include <cstdint>
#define MK_N_LAUNCHES 1
#define MK_REPEAT -1
#define MK_DBGSEL 0
#define MK_EXTRA_LO -1
#define MK_EXTRA_HI -1
namespace pg8 {
#define PG8_LAS __attribute__((address_space(3)))
typedef unsigned short bf16_t;
typedef short bf16x8 __attribute__((ext_vector_type(8)));
typedef float f32x4 __attribute__((ext_vector_type(4)));
typedef unsigned u32x4 __attribute__((ext_vector_type(4)));
constexpr int BM = 256, BK = 64, HALF = 128, HTB = HALF * BK * 2  , STAGE_BYTES = 8 * HTB, NXCD = 8, WGM = 8;

__host__ __device__ __forceinline__ int lds_byte(int r, int c) { const int st = (r >> 4) * 2 + (c >> 5), rr = r & 15, cc = c & 31, ob = rr * 64 + cc * 2; return st * 1024 + (ob ^ (((ob >> 9) & 1) << 5)); }
__host__ __device__ __forceinline__ void stage_rc(int b, int& R, int& C) { const int st = b / 1024, sb = b % 1024, swz = sb ^ (((sb >> 9) & 1) << 5); R = (st >> 1) * 16 + swz / 64; C = (st & 1) * 32 + (swz % 64) / 2; }
__host__ __device__ __forceinline__ int perm32(int rho) { const int n = rho >> 4, i = rho & 15; return 8 * (i >> 2) + 4 * n + (i & 3); }

struct Unit { int pm, pn; };
struct Gemm { const bf16_t* A; const bf16_t* Bt; int M, N, K; };

struct StaticOrder {
    int nM, nN, nwg, G, c;
    __host__ __device__ void init(int M, int N, int G_, int c_) { nM = M / BM; nN = N / BM; nwg = nM * nN; G = G_; c = c_; }
    __host__ __device__ bool next(int i, Unit& u) const {
        const long L = (long)i * G + c; if (L >= nwg) return false;
        int wgid = (int)L; { const int q = nwg / NXCD, r = nwg % NXCD, xcd = wgid % NXCD, off = wgid / NXCD; wgid = (xcd < r ? xcd * (q + 1) : r * (q + 1) + (xcd - r) * q) + off; }
        const int nig = WGM * nN, gid = wgid / nig, fm = gid * WGM, gsz = (nM - fm) < WGM ? (nM - fm) : WGM;
        u.pm = fm + ((wgid % nig) % gsz); u.pn = (wgid % nig) / gsz; return true;
    }
    __device__ __forceinline__ void a_ready(const Unit&) const {}
    __device__ __forceinline__ void done(const Unit&) const {}
};

typedef __bf16 bf16x2_cv __attribute__((ext_vector_type(2))); typedef float f32x2_cv __attribute__((ext_vector_type(2)));
__device__ __forceinline__ unsigned cvt_pk_bf16(float lo, float hi) { return __builtin_bit_cast(unsigned, __builtin_convertvector((f32x2_cv){lo, hi}, bf16x2_cv)); }
__device__ __forceinline__ float bf_lo(unsigned w) { return __uint_as_float(w << 16); }
__device__ __forceinline__ float bf_hi(unsigned w) { return __uint_as_float(w & 0xffff0000u); }
__device__ __forceinline__ float sigm(float x) { return __builtin_amdgcn_rcpf(1.0f + __expf(-x)); }

struct EpiZ {
    static constexpr bool PERM = true, AFTER_DRAIN = false;
    bf16_t *Zc, *Zr, *Zg;
    __device__ __forceinline__ void operator()(const f32x4 (&acc)[2][2][4][2], const Unit& u, int wr, int wc, int fr, int fq) const {
        bf16_t* base; int ldc, colt;
        if (u.pn < 6) { base = Zc; ldc = 1536; colt = u.pn * BM; }
        else if (u.pn < 14) { base = Zr; ldc = 2048; colt = (u.pn - 6) * BM; }
        else { base = Zg; ldc = 2048; colt = (u.pn - 14) * BM; }
        const int row0 = u.pm * BM + wr * 64 + fr, col0 = colt + wc * 32 + 8 * fq;
#pragma unroll
        for (int ai = 0; ai < 2; ++ai)
#pragma unroll
            for (int m = 0; m < 4; ++m) { bf16_t* rowp = base + (size_t)(row0 + ai * HALF + m * 16) * ldc + col0;
#pragma unroll
                for (int bj = 0; bj < 2; ++bj) { const f32x4 v0 = acc[ai][bj][m][0], v1 = acc[ai][bj][m][1];
                    u32x4 w; w.x = cvt_pk_bf16(v0[0], v0[1]); w.y = cvt_pk_bf16(v0[2], v0[3]); w.z = cvt_pk_bf16(v1[0], v1[1]); w.w = cvt_pk_bf16(v1[2], v1[3]);
                    *(u32x4*)(rowp + bj * HALF) = w; } }
    }
};
struct EpiPlain {
    static constexpr bool PERM = true, AFTER_DRAIN = false;
    bf16_t* O; int ldc;
    __device__ __forceinline__ void operator()(const f32x4 (&acc)[2][2][4][2], const Unit& u, int wr, int wc, int fr, int fq) const {
        const int row0 = u.pm * BM + wr * 64 + fr, col0 = u.pn * BM + wc * 32 + 8 * fq;
#pragma unroll
        for (int ai = 0; ai < 2; ++ai)
#pragma unroll
            for (int m = 0; m < 4; ++m) { bf16_t* rowp = O + (size_t)(row0 + ai * HALF + m * 16) * ldc + col0;
#pragma unroll
                for (int bj = 0; bj < 2; ++bj) { const f32x4 v0 = acc[ai][bj][m][0], v1 = acc[ai][bj][m][1];
                    u32x4 w; w.x = cvt_pk_bf16(v0[0], v0[1]); w.y = cvt_pk_bf16(v0[2], v0[3]); w.z = cvt_pk_bf16(v1[0], v1[1]); w.w = cvt_pk_bf16(v1[2], v1[3]);
                    *(u32x4*)(rowp + bj * HALF) = w; } }
    }
};
template <int SECOND> struct EpiGate {
    static constexpr bool PERM = true, AFTER_DRAIN = false;
    const bf16_t* Zg; bf16_t* MG;
    __device__ __forceinline__ void operator()(const f32x4 (&acc)[2][2][4][2], const Unit& u, int wr, int wc, int fr, int fq) const {
        const int row0 = u.pm * BM + wr * 64 + fr, col0 = u.pn * BM + wc * 32 + 8 * fq;
#pragma unroll
        for (int ai = 0; ai < 2; ++ai) {
            u32x4 gw[4][2], pw[4][2];
#pragma unroll
            for (int m = 0; m < 4; ++m) { const int r = row0 + ai * HALF + m * 16;
#pragma unroll
                for (int bj = 0; bj < 2; ++bj) { gw[m][bj] = *(const u32x4*)(Zg + (size_t)r * 2048 + SECOND * 1024 + col0 + bj * HALF);
                    if (SECOND) pw[m][bj] = *(const u32x4*)(MG + (size_t)r * 1024 + col0 + bj * HALF); } }
#pragma unroll
            for (int m = 0; m < 4; ++m) { const int r = row0 + ai * HALF + m * 16; bf16_t* op = MG + (size_t)r * 1024 + col0;
#pragma unroll
                for (int bj = 0; bj < 2; ++bj) { const u32x4 g = gw[m][bj]; f32x4 v0 = acc[ai][bj][m][0], v1 = acc[ai][bj][m][1];
                    v0[0] *= sigm(bf_lo(g.x)); v0[1] *= sigm(bf_hi(g.x)); v0[2] *= sigm(bf_lo(g.y)); v0[3] *= sigm(bf_hi(g.y));
                    v1[0] *= sigm(bf_lo(g.z)); v1[1] *= sigm(bf_hi(g.z)); v1[2] *= sigm(bf_lo(g.w)); v1[3] *= sigm(bf_hi(g.w));
                    if (SECOND) { const u32x4 p = pw[m][bj];
                        v0[0] += bf_lo(p.x); v0[1] += bf_hi(p.x); v0[2] += bf_lo(p.y); v0[3] += bf_hi(p.y);
                        v1[0] += bf_lo(p.z); v1[1] += bf_hi(p.z); v1[2] += bf_lo(p.w); v1[3] += bf_hi(p.w); }
                    u32x4 w; w.x = cvt_pk_bf16(v0[0], v0[1]); w.y = cvt_pk_bf16(v0[2], v0[3]); w.z = cvt_pk_bf16(v1[0], v1[1]); w.w = cvt_pk_bf16(v1[2], v1[3]);
                    *(u32x4*)(op + bj * HALF) = w; } }
        }
    }
};
struct EpiX1 {
    static constexpr bool PERM = false, AFTER_DRAIN = false;
    const float* xp; const float* xs; float* X1; bf16_t* X1B; float* SSP; const float* g2; int nprompt, nrows;
    __device__ __forceinline__ void operator()(const f32x4 (&acc)[2][2][4][2], const Unit& u, int wr, int wc, int fr, int fq) const {
        typedef unsigned u32x2v __attribute__((ext_vector_type(2)));
        const int col0 = u.pn * BM + wc * 32 + 4 * fq;
        f32x4 gq[2][2];
#pragma unroll
        for (int bj = 0; bj < 2; ++bj)
#pragma unroll
            for (int n = 0; n < 2; ++n) gq[bj][n] = *(const f32x4*)(g2 + col0 + bj * HALF + n * 16);
#pragma unroll
        for (int ai = 0; ai < 2; ++ai) {
            f32x4 xv[4][2][2];
#pragma unroll
            for (int m = 0; m < 4; ++m) { int r = u.pm * BM + ai * HALF + wr * 64 + m * 16 + fr; r = r < nrows ? r : nrows - 1;
                const float* xr = r < nprompt ? xp + (size_t)r * 1024 : xs + (size_t)(r - nprompt) * 1024;
#pragma unroll
                for (int bj = 0; bj < 2; ++bj)
#pragma unroll
                    for (int n = 0; n < 2; ++n) xv[m][bj][n] = *(const f32x4*)(xr + col0 + bj * HALF + n * 16); }
#pragma unroll
            for (int m = 0; m < 4; ++m) { const int r = u.pm * BM + ai * HALF + wr * 64 + m * 16 + fr; float ss = 0.f;
#pragma unroll
                for (int bj = 0; bj < 2; ++bj)
#pragma unroll
                    for (int n = 0; n < 2; ++n) { const int c = col0 + bj * HALF + n * 16; const f32x4 o = xv[m][bj][n] + acc[ai][bj][m][n];
                        ss += (o[0] * o[0] + o[1] * o[1]) + (o[2] * o[2] + o[3] * o[3]);
                        const f32x4 q = gq[bj][n]; u32x2v w; w.x = cvt_pk_bf16(o[0] * q[0], o[1] * q[1]); w.y = cvt_pk_bf16(o[2] * q[2], o[3] * q[3]);
                        if (r < nrows) *(u32x2v*)(X1B + (size_t)r * 1024 + c) = w; }
                ss += __shfl_xor(ss, 16); ss += __shfl_xor(ss, 32);
                if (fq == 0 && r < nrows) SSP[(size_t)r * 16 + u.pn * 4 + wc] = ss;
            }
        }
    }
};
template <class Epi, class Sched, bool ALIGN_EPI = false, bool SP2 = false>
__device__ __forceinline__ void gemm_phase(PG8_LAS unsigned char* lds, const Gemm g, const Sched& S, const Epi& E) {
    const int tid = threadIdx.x, wid = __builtin_amdgcn_readfirstlane(tid >> 6), lane = tid & 63, wr = wid >> 2, wc = wid & 3, fr = lane & 15, fq = lane >> 4;
    const int K = g.K, nt = K / BK;
    unsigned voffA[2], voffB[2];
#pragma unroll
    for (int i = 0; i < 2; ++i) { int R, C; stage_rc(tid * 16 + i * 8192, R, C); const int Rb = Epi::PERM ? ((R & ~31) + perm32(R & 31)) : R;
        voffA[i] = (unsigned)(R * K + C) * 2u; voffB[i] = (unsigned)(Rb * K + C) * 2u; }
    const size_t kstep = (size_t)(BK * 2);
    const size_t hstep = (size_t)HALF * K * 2;
    const size_t tstep = 2 * hstep;
    const unsigned ldsw = (unsigned)wid * 1024u;
    const int aoff = lds_byte(wr * 64 + fr, fq * 8), boff = lds_byte(wc * 32 + fr, fq * 8);
#define PG8_SA(b, h) (((b) * 2 + (h)) * HTB)
#define PG8_SB(b, h) ((4 + (b) * 2 + (h)) * HTB)
#define PG8_STAGE(bufoff, gbase, voff) do { _Pragma("unroll") for (int _i = 0; _i < 2; ++_i) \
        __builtin_amdgcn_global_load_lds((const unsigned*)((const char*)(gbase) + (voff)[_i]), (PG8_LAS unsigned*)(lds + (bufoff) + ldsw + _i * 8192), 16, 0, 0); } while (0)
#define PG8_LDA(dst, b, h) do { _Pragma("unroll") for (int m = 0; m < 4; ++m) _Pragma("unroll") for (int k = 0; k < 2; ++k) dst[m][k] = *(const PG8_LAS bf16x8*)(lds + PG8_SA(b, h) + aoff + m * 2048 + k * 1024); } while (0)
#define PG8_LDB(dst, b, h) do { _Pragma("unroll") for (int n = 0; n < 2; ++n) _Pragma("unroll") for (int k = 0; k < 2; ++k) dst[n][k] = *(const PG8_LAS bf16x8*)(lds + PG8_SB(b, h) + boff + n * 2048 + k * 1024); } while (0)
#define PG8_MMA(ai, bj, At, Bt) do { __builtin_amdgcn_s_setprio(1); _Pragma("unroll") for (int m = 0; m < 4; ++m) _Pragma("unroll") for (int n = 0; n < 2; ++n) _Pragma("unroll") for (int k = 0; k < 2; ++k) \
        acc[ai][bj][m][n] = __builtin_amdgcn_mfma_f32_16x16x32_bf16(Bt[n][k], At[m][k], acc[ai][bj][m][n], 0, 0, 0); __builtin_amdgcn_s_setprio(0); } while (0)
#define PG8_WAIT_V(n) asm volatile("s_waitcnt vmcnt(" #n ")" ::: "memory")
#define PG8_WAIT_L(n) asm volatile("s_waitcnt lgkmcnt(" #n ")" ::: "memory")
#define PG8_BAR __builtin_amdgcn_s_barrier()
#define PG8_SCHED __builtin_amdgcn_sched_barrier(0)
    Unit cur, nxt; int ui = 0;
    if (!S.next(0, cur)) return;
    f32x4 acc[2][2][4][2];
#pragma unroll
    for (int a = 0; a < 2; ++a)
#pragma unroll
        for (int b = 0; b < 2; ++b)
#pragma unroll
            for (int m = 0; m < 4; ++m)
#pragma unroll
                for (int n = 0; n < 2; ++n) acc[a][b][m][n] = (f32x4){0.f, 0.f, 0.f, 0.f};
    bf16x8 At[4][2], B0[2][2], B1[2][2];
    const char* cA = (const char*)g.A + (size_t)cur.pm * tstep; const char* cB = (const char*)g.Bt + (size_t)cur.pn * tstep;
    S.a_ready(cur);
    if constexpr (SP2) {
        PG8_STAGE(PG8_SB(0, 0), cB, voffB); PG8_STAGE(PG8_SB(0, 1), cB + hstep, voffB); PG8_STAGE(PG8_SA(0, 0), cA, voffA); PG8_STAGE(PG8_SA(0, 1), cA + hstep, voffA);
        if (wr == 1) PG8_BAR;
        PG8_WAIT_V(2); PG8_BAR;
        PG8_STAGE(PG8_SB(1, 0), cB + kstep, voffB); PG8_STAGE(PG8_SA(1, 0), cA + kstep, voffA); PG8_STAGE(PG8_SB(1, 1), cB + hstep + kstep, voffB);
        PG8_WAIT_V(6); PG8_BAR;
    } else {
        PG8_STAGE(PG8_SB(0, 0), cB, voffB); PG8_STAGE(PG8_SA(0, 0), cA, voffA); PG8_STAGE(PG8_SB(0, 1), cB + hstep, voffB); PG8_STAGE(PG8_SA(0, 1), cA + hstep, voffA);
        if (wr == 1) PG8_BAR;
        PG8_WAIT_V(4); PG8_BAR;
        PG8_STAGE(PG8_SB(1, 0), cB + kstep, voffB); PG8_STAGE(PG8_SA(1, 0), cA + kstep, voffA); PG8_STAGE(PG8_SB(1, 1), cB + hstep + kstep, voffB);
        PG8_WAIT_V(6); PG8_BAR;
    }
    for (;;) {
        const bool has_next = S.next(ui + 1, nxt);
        const char* nA = has_next ? (const char*)g.A + (size_t)nxt.pm * tstep : cA; const char* nB = has_next ? (const char*)g.Bt + (size_t)nxt.pn * tstep : cB;
        for (int t = 0; t < nt; t += 2) {
            const bool last = (t == nt - 2);
            const char* a1 = cA + (size_t)(t + 1) * kstep;
            const char* a2 = last ? nA : cA + (size_t)(t + 2) * kstep; const char* b2 = last ? nB : cB + (size_t)(t + 2) * kstep;
            const char* a3 = a2 + kstep; const char* b3 = b2 + kstep;
            if (last && has_next) S.a_ready(nxt);
            if constexpr (SP2) {
            PG8_LDB(B0, 0, 0); PG8_LDB(B1, 0, 1); PG8_SCHED; PG8_LDA(At, 0, 0); PG8_STAGE(PG8_SA(1, 1), a1 + hstep, voffA);
            PG8_WAIT_V(8); PG8_WAIT_L(0); PG8_BAR; PG8_MMA(0, 0, At, B0); PG8_MMA(0, 1, At, B1); PG8_BAR; PG8_SCHED;
            PG8_LDA(At, 0, 1); PG8_STAGE(PG8_SB(0, 0), b2, voffB); PG8_STAGE(PG8_SB(0, 1), b2 + hstep, voffB); PG8_STAGE(PG8_SA(0, 0), a2, voffA);
            PG8_WAIT_V(8); PG8_WAIT_L(0); PG8_BAR; PG8_MMA(1, 0, At, B0); PG8_MMA(1, 1, At, B1); PG8_BAR; PG8_SCHED;
            PG8_LDB(B0, 1, 0); PG8_LDB(B1, 1, 1); PG8_SCHED; PG8_LDA(At, 1, 0); PG8_STAGE(PG8_SA(0, 1), a2 + hstep, voffA);
            PG8_WAIT_V(8); PG8_WAIT_L(0); PG8_BAR; PG8_MMA(0, 0, At, B0); PG8_MMA(0, 1, At, B1); PG8_BAR; PG8_SCHED;
            PG8_LDA(At, 1, 1); PG8_STAGE(PG8_SB(1, 0), b3, voffB); PG8_STAGE(PG8_SB(1, 1), b3 + hstep, voffB); PG8_STAGE(PG8_SA(1, 0), a3, voffA);
            PG8_WAIT_V(8); PG8_WAIT_L(0); PG8_BAR; PG8_MMA(1, 0, At, B0); PG8_MMA(1, 1, At, B1); PG8_BAR; PG8_SCHED;
            } else {
            PG8_LDB(B0, 0, 0); PG8_SCHED; PG8_LDA(At, 0, 0); PG8_STAGE(PG8_SA(1, 1), a1 + hstep, voffA);
            PG8_WAIT_L(8); PG8_BAR; PG8_WAIT_L(0); PG8_MMA(0, 0, At, B0); PG8_BAR; PG8_SCHED;
            PG8_LDB(B1, 0, 1); PG8_STAGE(PG8_SB(0, 0), b2, voffB);
            PG8_BAR; PG8_WAIT_L(0); PG8_MMA(0, 1, At, B1); PG8_BAR;
            PG8_LDA(At, 0, 1); PG8_STAGE(PG8_SA(0, 0), a2, voffA);
            PG8_BAR; PG8_WAIT_L(0); PG8_MMA(1, 0, At, B0); PG8_BAR; PG8_SCHED;
            PG8_STAGE(PG8_SB(0, 1), b2 + hstep, voffB);
            PG8_WAIT_V(6); PG8_BAR; PG8_MMA(1, 1, At, B1); PG8_BAR;
            PG8_LDB(B0, 1, 0); PG8_SCHED; PG8_LDA(At, 1, 0); PG8_STAGE(PG8_SA(0, 1), a2 + hstep, voffA);
            PG8_WAIT_L(8); PG8_BAR; PG8_WAIT_L(0); PG8_MMA(0, 0, At, B0); PG8_BAR; PG8_SCHED;
            PG8_LDB(B1, 1, 1); PG8_STAGE(PG8_SB(1, 0), b3, voffB);
            PG8_BAR; PG8_WAIT_L(0); PG8_MMA(0, 1, At, B1); PG8_BAR;
            PG8_LDA(At, 1, 1); PG8_STAGE(PG8_SA(1, 0), a3, voffA);
            PG8_BAR; PG8_WAIT_L(0); PG8_MMA(1, 0, At, B0); PG8_BAR; PG8_SCHED;
            PG8_STAGE(PG8_SB(1, 1), b3 + hstep, voffB);
            PG8_WAIT_V(6); PG8_BAR; PG8_MMA(1, 1, At, B1); PG8_BAR;
            }
        }
        if constexpr (ALIGN_EPI) { if (wr == 0) PG8_BAR; }
        if constexpr (!Epi::AFTER_DRAIN) { E(acc, cur, wr, wc, fr, fq); S.done(cur); }
        if (!has_next) break;
#pragma unroll
        for (int a = 0; a < 2; ++a)
#pragma unroll
            for (int b = 0; b < 2; ++b)
#pragma unroll
                for (int m = 0; m < 4; ++m)
#pragma unroll
                    for (int n = 0; n < 2; ++n) acc[a][b][m][n] = (f32x4){0.f, 0.f, 0.f, 0.f};
        cur = nxt; cA = nA; cB = nB; ++ui;
        if constexpr (ALIGN_EPI) { if (wr == 1) PG8_BAR; }
    }
    PG8_WAIT_V(0);
    if constexpr (!ALIGN_EPI) { if (wr == 0) PG8_BAR; }
    PG8_BAR;
    if constexpr (Epi::AFTER_DRAIN) { E.fused(acc, cur, wr, wc, fr, fq, lds, wid, lane); S.done(cur); }
#undef PG8_SA
#undef PG8_SB
#undef PG8_STAGE
#undef PG8_LDA
#undef PG8_LDB
#undef PG8_MMA
#undef PG8_WAIT_V
#undef PG8_WAIT_L
#undef PG8_BAR
#undef PG8_SCHED
}
}
constexpr int NWAVES = 8, NTHR = 512;
#ifndef MK_N_LAUNCHES
#define MK_N_LAUNCHES 1
#endif
constexpr int PER_PHASE = 14;
constexpr int N_LAUNCHES = MK_N_LAUNCHES;

constexpr int DM = 1024, NPROMPT = 32768, NSAMP = 512, NTOK = 33280, NSHIFT = 32, MPAD = 33536, N1 = 5632;
constexpr int SEQ_P = 4096, SEQ_S = 16, NB_P = 8, NB_S = 32;
constexpr size_t O_Y = 0, O_CONV_P = 34078720, O_SHIFT_P = 34086912, O_WKV_P = 34095104, O_CONV_S = 34357248, O_SHIFT_S = 34390016, O_WKV_S = 34422784;
constexpr size_t KiB = 1024, MiB = 1u << 20;
constexpr size_t WS_CTL = 0, CTL_ZERO_BYTES = 64 * KiB;
constexpr size_t WS_W1T = 64 * KiB;
constexpr size_t WS_WPA = WS_W1T + (size_t)N1 * DM * 2;
constexpr size_t WS_WPB = WS_WPA + 1 * MiB;
constexpr size_t WS_WO = WS_WPB + 1 * MiB;
constexpr size_t WS_WQ = WS_WO + 2 * MiB;
constexpr size_t WS_KEYS = WS_WQ + 4 * MiB;
constexpr size_t WS_L2T = WS_KEYS + 512 * KiB;
constexpr size_t WS_SSP = WS_L2T + 256 * KiB;
constexpr size_t WS_UB = WS_SSP + (size_t)MPAD * 16 * 4;
constexpr size_t WS_VB = WS_UB + 16 * MiB;
constexpr size_t WS_A1 = WS_VB + 16 * MiB;
constexpr size_t WS_ZC = WS_A1 + (size_t)MPAD * DM * 2;
constexpr size_t WS_ZR = WS_ZC + (size_t)MPAD * 1536 * 2;
constexpr size_t WS_ZG = WS_ZR + (size_t)MPAD * 2048 * 2;
constexpr size_t WS_END = WS_ZG + (size_t)MPAD * 2048 * 2;
constexpr size_t WS_YL = WS_ZC, WS_ZT = WS_ZC + (size_t)NTOK * 512 * 2, WS_BV = WS_ZC + (size_t)NTOK * 512 * 4;
constexpr size_t WS_EIDX = WS_ZC, WS_GATE = WS_ZC + 16 * MiB, WS_COEF = WS_ZC + 40 * MiB, WS_SS2 = WS_ZC + 64 * MiB, WS_RSTD = WS_ZC + 66 * MiB;
constexpr size_t WS_PART = WS_ZR;
constexpr size_t OB_MB = (size_t)4352 * 4096 * 4;
constexpr size_t OB_S0S = OB_MB + (size_t)4352 * 4096 * 2;
static_assert(WS_BV + (size_t)NTOK * 512 * 2 <= WS_ZR && OB_S0S + (size_t)256 * 4096 * 2 <= (size_t)NTOK * 1024 * 4, "scan scratch maps");
static_assert(WS_END <= 512 * MiB, "d_ws map must fit 512 MiB");
constexpr float PEER_SU = 32.0f, PEER_SV = 4.0f;
constexpr int CW_BAR = 1024;
constexpr int LDS_BYTES = 163840;
constexpr int LDSCTL_OFF = LDS_BYTES - 512, MISC_OFF = LDSCTL_OFF + 320;

#define GAS __attribute__((address_space(1)))
#define LAS __attribute__((address_space(3)))
typedef unsigned short bf16;
typedef unsigned v4u __attribute__((ext_vector_type(4)));
typedef unsigned v2u __attribute__((ext_vector_type(2)));
typedef float f32x4 __attribute__((ext_vector_type(4)));
typedef short bf16x8 __attribute__((ext_vector_type(8)));
typedef __bf16 bf16x2_t __attribute__((ext_vector_type(2)));
typedef GAS unsigned gu32;
#define RLX_AGENT __ATOMIC_RELAXED, __HIP_MEMORY_SCOPE_AGENT
#define LDS_WAIT() asm volatile("s_waitcnt lgkmcnt(0)" ::: "memory")
#define VM_WAIT() asm volatile("s_waitcnt vmcnt(0)" ::: "memory")
using pg8::cvt_pk_bf16; using pg8::bf_lo; using pg8::bf_hi; using pg8::sigm;
#define XB_TMO      128
#define XB_XCNT(j)  (256  + 64 * (j))
#define XB_XSUB(j)  (1280 + 64 * (j))
#define XB_XGEN(j)  (2304 + 64 * (j))
#define XB_TOP      3328
#define XB_TOPGEN   3392
#define XCD_BAR_WORDS 3456
#define XB_SPIN_CAP (1u << 22)

__device__ __forceinline__ unsigned xb_ld(unsigned* p)              { return __hip_atomic_load(p, __ATOMIC_RELAXED, __HIP_MEMORY_SCOPE_AGENT); }
__device__ __forceinline__ unsigned xb_add(unsigned* p, unsigned v) { return __hip_atomic_fetch_add(p, v, __ATOMIC_RELAXED, __HIP_MEMORY_SCOPE_AGENT); }
__device__ __forceinline__ unsigned xb_xcc_id() { return (unsigned)__builtin_amdgcn_s_getreg((3 << 11) | 20) & 0xFu; }
#define XB_SPIN(cond, bar) do { unsigned _sp = 0; while (cond) { __builtin_amdgcn_s_sleep(1); \
    if ((++_sp & 255u) == 0u) { if (xb_ld(&(bar)[XB_TMO])) break; if (_sp > XB_SPIN_CAP) { atomicAdd(&(bar)[XB_TMO], 1u); break; } } } } while (0)

struct XcdBarrier {
    unsigned* bar; unsigned x;
    volatile LAS unsigned* st;
};

__device__ __forceinline__ XcdBarrier xcd_barrier_post(unsigned* bar, volatile LAS unsigned* st) {
    XcdBarrier b; b.bar = bar; b.x = xb_xcc_id(); b.st = st;
    if (threadIdx.x == 0) (void)xb_add(&bar[XB_XCNT(b.x)], 1u);
    return b;
}
__device__ __forceinline__ void xcd_barrier_complete(unsigned* bar, unsigned x, unsigned& nloc, unsigned& nx) {
    const unsigned G = gridDim.x * gridDim.y * gridDim.z;
    unsigned sum, cnt, mine, sp = 0u;
    for (;;) {
        sum = 0u; cnt = 0u; mine = 0u;
#pragma unroll
        for (unsigned j = 0; j < 16; ++j) { const unsigned c = xb_ld(&bar[XB_XCNT(j)]); sum += c; cnt += (c > 0u) ? 1u : 0u; mine = (j == x) ? c : mine; }
        if (sum == G) break;
        __builtin_amdgcn_s_sleep(1);
        if ((++sp & 255u) == 0u) { if (xb_ld(&bar[XB_TMO])) break; if (sp > XB_SPIN_CAP) { atomicAdd(&bar[XB_TMO], 1u); break; } }
    }
    nloc = mine > 0u ? mine : 1u; nx = cnt > 0u ? cnt : 1u;
}

__device__ __forceinline__ void xcd_barrier(const XcdBarrier& b) {
    asm volatile("s_waitcnt vmcnt(0)" ::: "memory");
    __syncthreads();
    if (threadIdx.x == 0) {
        unsigned* bar = b.bar;
        __builtin_amdgcn_s_waitcnt(0);
        unsigned nloc = b.st[0], nx = b.st[1];
        if (nloc == 0u) { xcd_barrier_complete(bar, b.x, nloc, nx); b.st[0] = nloc; b.st[1] = nx; }
        const unsigned old = xb_add(&bar[XB_XSUB(b.x)], 1u);
        const unsigned gen = old / nloc;
        if (old + 1u == (gen + 1u) * nloc) {
            __builtin_amdgcn_fence(__ATOMIC_RELEASE, "agent");
            asm volatile("s_waitcnt vmcnt(0)" ::: "memory");
            const unsigned og = xb_add(&bar[XB_TOP], 1u);
            const unsigned tg = og / nx;
            if (og + 1u == (tg + 1u) * nx) xb_add(&bar[XB_TOPGEN], 1u);
            else XB_SPIN(xb_ld(&bar[XB_TOPGEN]) == tg, bar);
            __builtin_amdgcn_fence(__ATOMIC_ACQUIRE, "agent");
            xb_add(&bar[XB_XGEN(b.x)], 1u);
            asm volatile("s_waitcnt vmcnt(0)" ::: "memory");
        } else {
            XB_SPIN(xb_ld(&bar[XB_XGEN(b.x)]) == gen, bar);
            __builtin_amdgcn_fence(__ATOMIC_ACQUIRE, "agent");
            asm volatile("s_waitcnt vmcnt(0)" ::: "memory");
        }
    }
    __syncthreads();
}
struct Args { const float* in[32]; float* out; unsigned char* ws; int ph_lo, ph_hi, li, pad; };
enum { I_XP = 0, I_XS, I_SCONV, I_SSHIFT, I_SWKV, I_N1G, I_WIN, I_CONVW, I_MURKV, I_MUWAG, I_W0, I_W1, I_W2, I_A0, I_A1, I_A2, I_G1, I_G2, I_KK, I_KA, I_RK, I_GNW, I_GNB, I_WPA, I_WPB, I_WO, I_N2G, I_WQ, I_KEYS, I_U, I_V, I_NFG };

__device__ __forceinline__ float wave_sum(float v) {
#pragma unroll
    for (int o = 1; o < 64; o <<= 1) v += __shfl_xor(v, o);
    return v;
}
template <int CTRL> __device__ __forceinline__ float dpp_mov(float v) { return __builtin_bit_cast(float, __builtin_amdgcn_update_dpp(0, __builtin_bit_cast(int, v), CTRL, 0xF, 0xF, true)); }
__device__ __forceinline__ float sum4(float v) { v += dpp_mov<0xB1>(v); v += dpp_mov<0x4E>(v); return v; }
__device__ __forceinline__ float sum8(float v) { v = sum4(v); v += dpp_mov<0x141>(v); return v; }
__device__ __forceinline__ float sum16(float v) { v = sum8(v); v += dpp_mov<0x140>(v); return v; }
__device__ __forceinline__ float dot2bf(unsigned w, unsigned x, float acc) { return __builtin_amdgcn_fdot2_f32_bf16(__builtin_bit_cast(bf16x2_t, w), __builtin_bit_cast(bf16x2_t, x), acc, false); }

__device__ __forceinline__ void transpose_item(const float* W, int ldw, int c0, int K, bf16* WT, int nblk, int item, const float* sv, float alpha, float beta, LAS float* scr, int lane) {
    const int kb = item / nblk, nb = item % nblk, k0 = 64 * kb, n0 = 32 * nb;
#pragma unroll 8
    for (int i = 0; i < 32; ++i) { const int kk = 2 * i + (lane >> 5); float s = 1.f; if (sv) s = alpha + beta * sv[k0 + kk];
        scr[kk * 33 + (lane & 31)] = W[(size_t)(k0 + kk) * ldw + c0 + n0 + (lane & 31)] * s; }
    LDS_WAIT();
    const int c = lane & 7;
#pragma unroll
    for (int j = 0; j < 4; ++j) { const int n = (lane >> 3) + 8 * j; const LAS float* s = scr + (8 * c) * 33 + n;
        v4u o; o.x = cvt_pk_bf16(s[0 * 33], s[1 * 33]); o.y = cvt_pk_bf16(s[2 * 33], s[3 * 33]); o.z = cvt_pk_bf16(s[4 * 33], s[5 * 33]); o.w = cvt_pk_bf16(s[6 * 33], s[7 * 33]);
        *(v4u*)(WT + (size_t)(n0 + n) * K + k0 + 8 * c) = o; }
    LDS_WAIT();
}
__device__ __forceinline__ void cvt_stream(const float* src, bf16* dst, size_t n, size_t gt, size_t nthreads) {
    for (size_t i = gt * 8; i < n; i += nthreads * 8) { const f32x4 a = *(const f32x4*)(src + i), b = *(const f32x4*)(src + i + 4);
        v4u o; o.x = cvt_pk_bf16(a[0], a[1]); o.y = cvt_pk_bf16(a[2], a[3]); o.z = cvt_pk_bf16(b[0], b[1]); o.w = cvt_pk_bf16(b[2], b[3]); *(v4u*)(dst + i) = o; }
}
__device__ __forceinline__ void cvt_stream_fp8(const float* src, unsigned char* dst, size_t n, float scale, size_t gt, size_t nthreads) {
    for (size_t i = gt * 16; i < n; i += nthreads * 16) {
        const f32x4 a = *(const f32x4*)(src + i) * scale, b = *(const f32x4*)(src + i + 4) * scale, c = *(const f32x4*)(src + i + 8) * scale, d = *(const f32x4*)(src + i + 12) * scale;
        v4u o; unsigned p;
        p = __builtin_amdgcn_cvt_pk_fp8_f32(a[0], a[1], 0, false); o.x = __builtin_amdgcn_cvt_pk_fp8_f32(a[2], a[3], p, true);
        p = __builtin_amdgcn_cvt_pk_fp8_f32(b[0], b[1], 0, false); o.y = __builtin_amdgcn_cvt_pk_fp8_f32(b[2], b[3], p, true);
        p = __builtin_amdgcn_cvt_pk_fp8_f32(c[0], c[1], 0, false); o.z = __builtin_amdgcn_cvt_pk_fp8_f32(c[2], c[3], p, true);
        p = __builtin_amdgcn_cvt_pk_fp8_f32(d[0], d[1], 0, false); o.w = __builtin_amdgcn_cvt_pk_fp8_f32(d[2], d[3], p, true);
        *(v4u*)(dst + i) = o; }
}
__device__ __forceinline__ void cvt16_fp8_sliced(const float* src, unsigned char* dst, float scale, size_t i) {
    const f32x4 a = *(const f32x4*)(src + i) * scale, b = *(const f32x4*)(src + i + 4) * scale, c = *(const f32x4*)(src + i + 8) * scale, d = *(const f32x4*)(src + i + 12) * scale;
    v4u o; unsigned p;
    p = __builtin_amdgcn_cvt_pk_fp8_f32(a[0], a[1], 0, false); o.x = __builtin_amdgcn_cvt_pk_fp8_f32(a[2], a[3], p, true);
    p = __builtin_amdgcn_cvt_pk_fp8_f32(b[0], b[1], 0, false); o.y = __builtin_amdgcn_cvt_pk_fp8_f32(b[2], b[3], p, true);
    p = __builtin_amdgcn_cvt_pk_fp8_f32(c[0], c[1], 0, false); o.z = __builtin_amdgcn_cvt_pk_fp8_f32(c[2], c[3], p, true);
    p = __builtin_amdgcn_cvt_pk_fp8_f32(d[0], d[1], 0, false); o.w = __builtin_amdgcn_cvt_pk_fp8_f32(d[2], d[3], p, true);
    const size_t e = i >> 10, col = i & 1023;
    *(v4u*)(dst + (col >> 7) * ((size_t)16384 * 128) + e * 128 + (col & 127)) = o;
}
__device__ __forceinline__ void cvt_stream_fp8_sliced(const float* src, unsigned char* dst, float scale, size_t gt, size_t nthreads) {
#pragma unroll 2
    for (size_t i = gt * 16; i < (size_t)16384 * 1024; i += nthreads * 16) {
        const f32x4 a = *(const f32x4*)(src + i) * scale, b = *(const f32x4*)(src + i + 4) * scale, c = *(const f32x4*)(src + i + 8) * scale, d = *(const f32x4*)(src + i + 12) * scale;
        v4u o; unsigned p;
        p = __builtin_amdgcn_cvt_pk_fp8_f32(a[0], a[1], 0, false); o.x = __builtin_amdgcn_cvt_pk_fp8_f32(a[2], a[3], p, true);
        p = __builtin_amdgcn_cvt_pk_fp8_f32(b[0], b[1], 0, false); o.y = __builtin_amdgcn_cvt_pk_fp8_f32(b[2], b[3], p, true);
        p = __builtin_amdgcn_cvt_pk_fp8_f32(c[0], c[1], 0, false); o.z = __builtin_amdgcn_cvt_pk_fp8_f32(c[2], c[3], p, true);
        p = __builtin_amdgcn_cvt_pk_fp8_f32(d[0], d[1], 0, false); o.w = __builtin_amdgcn_cvt_pk_fp8_f32(d[2], d[3], p, true);
        const size_t e = i >> 10, col = i & 1023;
        *(v4u*)(dst + (col >> 7) * ((size_t)16384 * 128) + e * 128 + (col & 127)) = o; }
}
__device__ __forceinline__ void p0_prologue(const Args& A, LAS unsigned char* lds, int tid, int lane, int wave, int vcu, int G) {
    unsigned char* ws = A.ws;
    bf16* W1T = (bf16*)(ws + WS_W1T);
    LAS float* scr = (LAS float*)(lds + wave * 16384);
    const int gw = vcu * NWAVES + wave, NGW = G * NWAVES;
    constexpr int J0 = 16 * 96, J1 = 16 * 64, JL = 16 * 2, JG = 16 * 4, JP = 8 * 32, JO = 16 * 32, JQ = 16 * 64;
    constexpr int JW2 = 16, JG2 = 32;
    constexpr int NITEMS = J0 + J1 + 4 * JL + 2 * JG + 2 * JP + JO + JQ + 2 * JW2 + JG2;
    bf16* L2T = (bf16*)(ws + WS_L2T);
    const float* mu = A.in[I_MUWAG];
    for (int it = gw; it < NITEMS; it += NGW) {
        int r = it;
        if (r < J0) { transpose_item(A.in[I_WIN], 5120, 0, 1024, W1T, 96, r, nullptr, 0.f, 0.f, scr, lane); continue; } r -= J0;
        if (r < J1) { transpose_item(A.in[I_WIN], 5120, 3072, 1024, W1T + (size_t)3584 * 1024, 64, r, nullptr, 0.f, 0.f, scr, lane); continue; } r -= J1;
        if (r < JL) { transpose_item(A.in[I_W1], 64, 0, 1024, W1T + (size_t)3072 * 1024, 2, r, mu, 1.f, -1.f, scr, lane); continue; } r -= JL;
        if (r < JL) { transpose_item(A.in[I_W1], 64, 0, 1024, W1T + (size_t)3328 * 1024, 2, r, mu, 0.f, 1.f, scr, lane); continue; } r -= JL;
        if (r < JL) { transpose_item(A.in[I_A1], 64, 0, 1024, W1T + (size_t)(3072 + 64) * 1024, 2, r, mu + 1024, 1.f, -1.f, scr, lane); continue; } r -= JL;
        if (r < JL) { transpose_item(A.in[I_A1], 64, 0, 1024, W1T + (size_t)(3328 + 64) * 1024, 2, r, mu + 1024, 0.f, 1.f, scr, lane); continue; } r -= JL;
        if (r < JG) { transpose_item(A.in[I_G1], 128, 0, 1024, W1T + (size_t)(3072 + 128) * 1024, 4, r, mu + 2048, 1.f, -1.f, scr, lane); continue; } r -= JG;
        if (r < JG) { transpose_item(A.in[I_G1], 128, 0, 1024, W1T + (size_t)(3328 + 128) * 1024, 4, r, mu + 2048, 0.f, 1.f, scr, lane); continue; } r -= JG;
        if (r < JP) { transpose_item(A.in[I_WPA], 1024, 0, 512, (bf16*)(ws + WS_WPA), 32, r, nullptr, 0.f, 0.f, scr, lane); continue; } r -= JP;
        if (r < JP) { transpose_item(A.in[I_WPB], 1024, 0, 512, (bf16*)(ws + WS_WPB), 32, r, nullptr, 0.f, 0.f, scr, lane); continue; } r -= JP;
        if (r < JO) { transpose_item(A.in[I_WO], 1024, 0, 1024, (bf16*)(ws + WS_WO), 32, r, nullptr, 0.f, 0.f, scr, lane); continue; } r -= JO;
        if (r < JQ) { transpose_item(A.in[I_WQ], 2048, 0, 1024, (bf16*)(ws + WS_WQ), 64, r, nullptr, 0.f, 0.f, scr, lane); continue; } r -= JQ;
        if (r < JW2) { transpose_item(A.in[I_W2], 512, 0, 64, L2T, 16, r, nullptr, 0.f, 0.f, scr, lane); continue; } r -= JW2;
        if (r < JW2) { transpose_item(A.in[I_A2], 512, 0, 64, L2T + (size_t)512 * 64, 16, r, nullptr, 0.f, 0.f, scr, lane); continue; } r -= JW2;
        transpose_item(A.in[I_G2], 512, 0, 128, L2T + (size_t)1024 * 64, 16, r, nullptr, 0.f, 0.f, scr, lane);
    }
    const size_t gt = (size_t)vcu * NTHR + tid, nth = (size_t)G * NTHR;
    if (G != 256) {
        cvt_stream_fp8_sliced(A.in[I_U], ws + WS_UB, PEER_SU, gt, nth);
        cvt_stream_fp8_sliced(A.in[I_V], ws + WS_VB, PEER_SV, gt, nth); }
    cvt_stream(A.in[I_KEYS], (bf16*)(ws + WS_KEYS), (size_t)8 * 2 * 128 * 128, gt, nth);
    bf16* A1 = (bf16*)(ws + WS_A1);
    const f32x4* g1v = (const f32x4*)A.in[I_N1G] + lane;
    for (int m0 = gw; m0 < NTOK; m0 += 2 * NGW) {
        const int m1 = m0 + NGW; const bool two = m1 < NTOK; const int m1c = two ? m1 : m0;
        const f32x4* xr0 = (const f32x4*)(m0 < NPROMPT ? A.in[I_XP] + (size_t)m0 * DM : A.in[I_XS] + (size_t)(m0 - NPROMPT) * DM) + lane;
        const f32x4* xr1 = (const f32x4*)(m1c < NPROMPT ? A.in[I_XP] + (size_t)m1c * DM : A.in[I_XS] + (size_t)(m1c - NPROMPT) * DM) + lane;
        f32x4 v0[4], v1[4]; float s0 = 0.f, s1 = 0.f;
#pragma unroll
        for (int j = 0; j < 4; ++j) { v0[j] = xr0[64 * j]; v1[j] = xr1[64 * j]; }
#pragma unroll
        for (int j = 0; j < 4; ++j) { s0 += (v0[j][0] * v0[j][0] + v0[j][1] * v0[j][1]) + (v0[j][2] * v0[j][2] + v0[j][3] * v0[j][3]);
                                      s1 += (v1[j][0] * v1[j][0] + v1[j][1] * v1[j][1]) + (v1[j][2] * v1[j][2] + v1[j][3] * v1[j][3]); }
#pragma unroll
        for (int o = 1; o < 64; o <<= 1) { s0 += __shfl_xor(s0, o); s1 += __shfl_xor(s1, o); }
        const float r0 = 1.0f / sqrtf(s0 * (1.f / DM) + 1e-6f), r1 = 1.0f / sqrtf(s1 * (1.f / DM) + 1e-6f);
#pragma unroll
        for (int rr = 0; rr < 2; ++rr) {
            if (rr == 1 && !two) break;
            const int m = rr ? m1 : m0; const float rstd = rr ? r1 : r0;
            v2u* o8 = (v2u*)(A1 + (size_t)m * DM) + lane;
            float* so = nullptr;
            if (m < NPROMPT) { if ((m & (SEQ_P - 1)) == SEQ_P - 1) so = A.out + O_SHIFT_P + (size_t)(m / SEQ_P) * DM; }
            else { const int ms = m - NPROMPT; if ((ms & (SEQ_S - 1)) == SEQ_S - 1) so = A.out + O_SHIFT_S + (size_t)(ms / SEQ_S) * DM; }
#pragma unroll
            for (int j = 0; j < 4; ++j) { const f32x4 g = g1v[64 * j]; const f32x4 y = (rr ? v1[j] : v0[j]) * rstd * g;
                v2u w; w.x = cvt_pk_bf16(y[0], y[1]); w.y = cvt_pk_bf16(y[2], y[3]); o8[64 * j] = w;
                if (so) ((f32x4*)so)[lane + 64 * j] = y; }
        }
    }
    for (int m = NTOK + gw; m < MPAD; m += NGW) {
        v2u* o8 = (v2u*)(A1 + (size_t)m * DM) + lane;
        if (m < NTOK + NSHIFT) {
            const f32x4* xr = (const f32x4*)(A.in[I_SSHIFT] + (size_t)(m - NTOK) * DM) + lane;
#pragma unroll
            for (int j = 0; j < 4; ++j) { const f32x4 y = xr[64 * j]; v2u w; w.x = cvt_pk_bf16(y[0], y[1]); w.y = cvt_pk_bf16(y[2], y[3]); o8[64 * j] = w; }
        } else {
#pragma unroll
            for (int j = 0; j < 4; ++j) { v2u w; w.x = 0u; w.y = 0u; o8[64 * j] = w; }
        }
    }
}

__device__ __forceinline__ void unpack8(const v4u w, float (&f)[8]) { f[0] = bf_lo(w.x); f[1] = bf_hi(w.x); f[2] = bf_lo(w.y); f[3] = bf_hi(w.y); f[4] = bf_lo(w.z); f[5] = bf_hi(w.z); f[6] = bf_lo(w.w); f[7] = bf_hi(w.w); }
__device__ __forceinline__ void conv_phase(const Args& A, int gt, int nth) {
    const bf16* Zc = (const bf16*)(A.ws + WS_ZC); bf16* YA = (bf16*)(A.ws + WS_A1);
    const float* cw = A.in[I_CONVW];
    for (int task = gt; task < (NTOK / 16) * 64; task += nth) {
        const int seg = task >> 6, ch = (task & 63) * 8, row0 = seg * 16;
        int b, t0, T; bool prompt = row0 < NPROMPT;
        if (prompt) { b = row0 / SEQ_P; t0 = row0 % SEQ_P; T = SEQ_P; } else { b = (row0 - NPROMPT) / SEQ_S; t0 = 0; T = SEQ_S; }
        float um2[8], um1[8], c0[8], c1[8], c2[8];
#pragma unroll
        for (int i = 0; i < 8; ++i) { c0[i] = cw[ch + i]; c1[i] = cw[512 + ch + i]; c2[i] = cw[1024 + ch + i]; }
        if (t0 == 0) {
            if (prompt) {
#pragma unroll
                for (int i = 0; i < 8; ++i) { um2[i] = 0.f; um1[i] = 0.f; }
            } else { const float* sc = A.in[I_SCONV] + (size_t)b * 2 * 512 + ch;
#pragma unroll
                for (int i = 0; i < 8; ++i) { um2[i] = sc[i]; um1[i] = sc[512 + i]; } }
        } else {
            float a[8], h[8];
            unpack8(*(const v4u*)(Zc + (size_t)(row0 - 2) * 1536 + 512 + ch), a); unpack8(*(const v4u*)(Zc + (size_t)(row0 - 2) * 1536 + 1024 + ch), h);
#pragma unroll
            for (int i = 0; i < 8; ++i) um2[i] = a[i] * h[i];
            unpack8(*(const v4u*)(Zc + (size_t)(row0 - 1) * 1536 + 512 + ch), a); unpack8(*(const v4u*)(Zc + (size_t)(row0 - 1) * 1536 + 1024 + ch), h);
#pragma unroll
            for (int i = 0; i < 8; ++i) um1[i] = a[i] * h[i];
        }
#pragma unroll 4
        for (int t = 0; t < 16; ++t) {
            const size_t row = (size_t)(row0 + t);
            float zb[8], zc[8], zh[8], y[8];
            unpack8(*(const v4u*)(Zc + row * 1536 + ch), zb); unpack8(*(const v4u*)(Zc + row * 1536 + 512 + ch), zc); unpack8(*(const v4u*)(Zc + row * 1536 + 1024 + ch), zh);
#pragma unroll
            for (int i = 0; i < 8; ++i) { const float u = zc[i] * zh[i]; y[i] = zb[i] * (c0[i] * um2[i] + c1[i] * um1[i] + c2[i] * u); um2[i] = um1[i]; um1[i] = u; }
            v4u o; o.x = cvt_pk_bf16(y[0], y[1]); o.y = cvt_pk_bf16(y[2], y[3]); o.z = cvt_pk_bf16(y[4], y[5]); o.w = cvt_pk_bf16(y[6], y[7]);
            *(v4u*)(YA + row * 512 + ch) = o;
        }
        if (t0 + 16 == T) { float* oc = A.out + (prompt ? O_CONV_P : O_CONV_S) + (size_t)b * 2 * 512 + ch;
#pragma unroll
            for (int i = 0; i < 8; ++i) { oc[i] = um2[i]; oc[512 + i] = um1[i]; } }
    }
    bf16* Zr = (bf16*)(A.ws + WS_ZR);
    for (int task = nth - 1 - gt; task < NTOK * 16; task += nth) {
        const int m = task >> 4, cs = task & 15;
        bool hasprev; int prow;
        if (m < NPROMPT) { hasprev = (m & (SEQ_P - 1)) != 0; prow = m - 1; } else { const int ms = m - NPROMPT; hasprev = true; prow = (ms & (SEQ_S - 1)) ? m - 1 : NTOK + ms / SEQ_S; }
        bf16* pap = Zr + (size_t)m * 2048 + 1536 + cs * 16;
        float pa[16], t8[8];
        const v4u a0 = *(const v4u*)pap, a1 = *(const v4u*)(pap + 8);
        v4u b0 = (v4u){0u, 0u, 0u, 0u}, b1 = b0;
        if (hasprev) { const bf16* pbp = Zr + (size_t)prow * 2048 + 1792 + cs * 16; b0 = *(const v4u*)pbp; b1 = *(const v4u*)(pbp + 8); }
        unpack8(a0, t8);
#pragma unroll
        for (int i = 0; i < 8; ++i) pa[i] = t8[i];
        unpack8(a1, t8);
#pragma unroll
        for (int i = 0; i < 8; ++i) pa[8 + i] = t8[i];
        unpack8(b0, t8);
#pragma unroll
        for (int i = 0; i < 8; ++i) pa[i] += t8[i];
        unpack8(b1, t8);
#pragma unroll
        for (int i = 0; i < 8; ++i) pa[8 + i] += t8[i];
#pragma unroll
        for (int i = 0; i < 16; ++i) { float p = pa[i];
            if (cs < 4) p = 1.0f - 2.0f * __builtin_amdgcn_rcpf(__expf(2.0f * p) + 1.0f);
            else if (cs >= 8) p = sigm(p);
            pa[i] = p; }
        v4u o0, o1; o0.x = cvt_pk_bf16(pa[0], pa[1]); o0.y = cvt_pk_bf16(pa[2], pa[3]); o0.z = cvt_pk_bf16(pa[4], pa[5]); o0.w = cvt_pk_bf16(pa[6], pa[7]);
        o1.x = cvt_pk_bf16(pa[8], pa[9]); o1.y = cvt_pk_bf16(pa[10], pa[11]); o1.z = cvt_pk_bf16(pa[12], pa[13]); o1.w = cvt_pk_bf16(pa[14], pa[15]);
        *(v4u*)pap = o0; *(v4u*)(pap + 8) = o1;
    }
}

constexpr int NUNITS_P = NB_P * 8 * 64, NUNITS = NUNITS_P + NB_S * 8;
constexpr int HID_STRIDE = 264, SC_TB = 32;
constexpr int P1_HIDB = 0, P1_LO = 16896, P1_SEQ = 41472, P1_GG = 90624, P1_YY = 98816, P1_ZZ = 107008, P1_BON = 115200;
typedef float f32x2 __attribute__((ext_vector_type(2)));

struct P1Pre { v4u pa0, pa1; v2u zr, zk, zv, pr, pk, pv; };
struct P1Pos { int unit, t0; };
__device__ __forceinline__ void p1_decode(int unit, bool& prompt, int& b, int& h, int& ch, int& T, int& rowbase) {
    prompt = unit < NUNITS_P; b = prompt ? unit >> 9 : (unit - NUNITS_P) >> 3; h = prompt ? (unit >> 6) & 7 : unit & 7; ch = prompt ? unit & 63 : 0;
    T = prompt ? 64 : SEQ_S; rowbase = prompt ? b * SEQ_P + ch * 64 : NPROMPT + b * SEQ_S;
}
__device__ __forceinline__ void p1_rows(int unit, int t0, int tt, size_t& row, size_t& prow, bool& hasprev, int& nb) {
    bool prompt; int b, h, ch, T, rowbase; p1_decode(unit, prompt, b, h, ch, T, rowbase);
    nb = (T - t0) < SC_TB ? (T - t0) : SC_TB;
    const int tloc = tt < nb ? tt : nb - 1, t = t0 + tloc; const bool first = (ch == 0);
    row = (size_t)(rowbase + t); hasprev = (t > 0) || !first || !prompt; prow = ((t > 0) || !first) ? row - 1 : (size_t)(NTOK + b);
}
__device__ __forceinline__ void p1_load(const Args& A, int unit, int t0, int tt, int cs, P1Pre& P) {
    size_t row, prow; bool hasprev; int nb; p1_rows(unit, t0, tt, row, prow, hasprev, nb);
    const int h = unit < NUNITS_P ? (unit >> 6) & 7 : unit & 7, hc = h * 64 + cs * 4;
    const bf16* Zr = (const bf16*)(A.ws + WS_ZR);
    P.pa0 = *(const v4u*)(Zr + row * 2048 + 1536 + cs * 16); P.pa1 = *(const v4u*)(Zr + row * 2048 + 1536 + cs * 16 + 8);
    P.zr = *(const v2u*)(Zr + row * 2048 + hc); P.zk = *(const v2u*)(Zr + row * 2048 + 512 + hc); P.zv = *(const v2u*)(Zr + row * 2048 + 1024 + hc);
    const v2u z2 = (v2u){0u, 0u};
    P.pr = z2; P.pk = z2; P.pv = z2;
    if (hasprev) { P.pr = *(const v2u*)(Zr + prow * 2048 + hc); P.pk = *(const v2u*)(Zr + prow * 2048 + 512 + hc); P.pv = *(const v2u*)(Zr + prow * 2048 + 1024 + hc); }
}
__device__ __forceinline__ bool p1_unit_at(int i, int vcu, int G, int& unit) {
    if (G == 256) { if (i > 16) return false; unit = i < 16 ? vcu * 16 + i : NUNITS_P + vcu; return true; }
    unit = vcu + i * G; return unit < NUNITS;
}

constexpr int WY_OS = 72, WY_TS = 24, WY_LS = 40;
constexpr int WY_AT = 0, WY_RT = WY_AT + 16 * WY_OS * 2, WY_BT = WY_RT + 16 * WY_OS * 2, WY_KT = WY_BT + 16 * WY_OS * 2, WY_BK = WY_KT + 16 * WY_OS * 2,
              WY_VT = WY_BK + 64 * WY_LS * 2, WY_GC = WY_VT + 64 * WY_TS * 2, WY_BUF = WY_GC + 256;
constexpr int WY_BASE = 0;
constexpr int WY_GSET = 1024 + 2 * 16 * WY_LS * 2 + 1024;
constexpr int WY_LAB = WY_BASE + 2 * WY_BUF;
static_assert(WY_LAB + WY_GSET <= P1_SEQ, "UT-transform operands must fit over HIDB | LO");
constexpr int WY_XB = 115328, WY_END = WY_XB + 128 * WY_OS * 2;
static_assert(WY_END <= LDSCTL_OFF, "LDS map of pass 1");

constexpr int WY_G2 = P1_GG + 2048;
static_assert(WY_G2 + WY_GSET <= P1_YY, "second Gram set");
__device__ __forceinline__ void p1_wy(f32x4 (&X)[4], const LAS float* SEQ, LAS float* YY, LAS float* ZZ, LAS unsigned char* lds, int nb, int tid, int lane, int wave, int part = 0) {
    const bool pw = wave >= 4; const int nmc = nb >> 4;
    LAS bf16* Xb = (LAS bf16*)(lds + WY_XB);
    for (int mc = 0; mc < nmc; ++mc) {
        asm volatile("" : "+v"(tid));
        LAS unsigned char* ob = lds + WY_BASE + mc * WY_BUF;
        LAS bf16* At = (LAS bf16*)(ob + WY_AT); LAS bf16* Rt = (LAS bf16*)(ob + WY_RT); LAS bf16* Bt = (LAS bf16*)(ob + WY_BT); LAS bf16* Kt = (LAS bf16*)(ob + WY_KT);
        LAS bf16* BKT = (LAS bf16*)(ob + WY_BK); LAS bf16* VT = (LAS bf16*)(ob + WY_VT); LAS float* GC = (LAS float*)(ob + WY_GC);
        const int tl = tid >> 5, c2 = (tid & 31) * 2, s0 = mc * 16;
        f32x2 cum = (f32x2){0.f, 0.f}, tot = cum, lwt = cum;
#pragma unroll
        for (int i = 0; i < 16; ++i) { const f32x2 l2 = *(const LAS f32x2*)(SEQ + (s0 + i) * 384 + 64 + c2); tot += l2; if (i <= tl) cum += l2; if (i == tl) lwt = l2; }
        const LAS float* sp = SEQ + (s0 + tl) * 384 + c2;
        const f32x2 a2 = *(const LAS f32x2*)(sp), b2 = *(const LAS f32x2*)(sp + 128), k2 = *(const LAS f32x2*)(sp + 192), r2 = *(const LAS f32x2*)(sp + 256), v2 = *(const LAS f32x2*)(sp + 320);
        const f32x2 gt = (f32x2){__expf(cum.x), __expf(cum.y)}, gp = (f32x2){__expf(cum.x - lwt.x), __expf(cum.y - lwt.y)}, gi = (f32x2){__expf(-cum.x), __expf(-cum.y)},
                    go = (f32x2){__expf(tot.x - cum.x), __expf(tot.y - cum.y)};
        *(LAS unsigned*)(At + tl * WY_OS + c2) = cvt_pk_bf16(a2.x * gp.x, a2.y * gp.y); *(LAS unsigned*)(Rt + tl * WY_OS + c2) = cvt_pk_bf16(r2.x * gt.x, r2.y * gt.y);
        *(LAS unsigned*)(Bt + tl * WY_OS + c2) = cvt_pk_bf16(b2.x * gi.x, b2.y * gi.y); *(LAS unsigned*)(Kt + tl * WY_OS + c2) = cvt_pk_bf16(k2.x * gi.x, k2.y * gi.y);
        const unsigned bh = cvt_pk_bf16(b2.x * go.x, b2.y * go.y), kh = cvt_pk_bf16(k2.x * go.x, k2.y * go.y), vv = cvt_pk_bf16(v2.x, v2.y);
        {
            const unsigned bh_o = (unsigned)__shfl_xor((int)bh, 32), kh_o = (unsigned)__shfl_xor((int)kh, 32), vv_o = (unsigned)__shfl_xor((int)vv, 32);
            const bool ev = (tl & 1) == 0; const int col = ev ? c2 : c2 + 1;
            const int wk = col * WY_LS + 8 * (tl >> 2) + (tl & 2), wo = col * WY_TS + (tl & ~1);
            *(LAS unsigned*)(BKT + wk) = ev ? ((bh & 0xffffu) | (bh_o << 16)) : ((bh_o >> 16) | (bh & 0xffff0000u));
            *(LAS unsigned*)(BKT + wk + 4) = ev ? ((kh & 0xffffu) | (kh_o << 16)) : ((kh_o >> 16) | (kh & 0xffff0000u));
            *(LAS unsigned*)(VT + wo) = ev ? ((vv & 0xffffu) | (vv_o << 16)) : ((vv_o >> 16) | (vv & 0xffff0000u)); }
        if (tl == 0) *(LAS f32x2*)(GC + c2) = (f32x2){__expf(tot.x), __expf(tot.y)};
    }
    __syncthreads();
    {
        asm volatile("" : "+v"(tid));
        const int fr = tid & 15, fq = (tid >> 4) & 3, m_ = wave >> 2, g_ = (wave + m_) & 3;
        if (m_ < nmc) {
            LAS unsigned char* ob = lds + WY_BASE + m_ * WY_BUF; LAS unsigned char* gs = lds + (m_ ? WY_G2 : WY_LAB);
            LAS float* Lab = (LAS float*)gs; LAS bf16* Lak = (LAS bf16*)(gs + 1024); LAS bf16* Mc = (LAS bf16*)(gs + 1024 + 16 * WY_LS * 2); LAS float* TT = (LAS float*)(gs + 1024 + 2 * 16 * WY_LS * 2);
            const LAS bf16* ab = (LAS bf16*)(ob + (g_ < 2 ? WY_AT : WY_RT)) + fr * WY_OS + fq * 8; const LAS bf16* bb = (LAS bf16*)(ob + ((g_ & 1) ? WY_KT : WY_BT)) + fr * WY_OS + fq * 8;
            f32x4 g = (f32x4){0.f, 0.f, 0.f, 0.f};
#pragma unroll
            for (int ks = 0; ks < 2; ++ks) g = __builtin_amdgcn_mfma_f32_16x16x32_bf16(*(const LAS bf16x8*)(bb + ks * 32), *(const LAS bf16x8*)(ab + ks * 32), g, 0, 0, 0);
#pragma unroll
            for (int rg = 0; rg < 4; ++rg) { const int tp = 4 * fq + rg; const bool keep = (g_ < 2) ? (fr > tp) : (fr >= tp); g[rg] = keep ? g[rg] : 0.f; }
            if (g_ == 0) {
                *(LAS f32x4*)(Lab + fr * 16 + 4 * fq) = g;
                LDS_WAIT();
                float u[16];
#pragma unroll
                for (int t = 0; t < 16; ++t) { if ((t & 3) == 0) asm volatile("" ::: "memory");
                    float acc = (t == fr) ? 1.0f : 0.0f;
#pragma unroll
                    for (int i4 = 0; i4 * 4 < t; ++i4) { const f32x4 l4 = *(const LAS f32x4*)(Lab + t * 16 + i4 * 4);
#pragma unroll
                        for (int e = 0; e < 4; ++e) if (i4 * 4 + e < t) acc += l4[e] * u[i4 * 4 + e]; }
                    u[t] = acc; }
                if (fq == 0) {
#pragma unroll
                    for (int t = 0; t < 16; ++t) TT[t * 16 + fr] = u[t]; }
            } else { v2u w; w.x = cvt_pk_bf16(g[0], g[1]); w.y = cvt_pk_bf16(g[2], g[3]);
                if (g_ == 1) { *(LAS v2u*)(Lak + fr * WY_LS + 8 * fq + 4) = w; *(LAS v2u*)(Lak + fr * WY_LS + 8 * fq) = (v2u){0u, 0u}; }
                else if (g_ == 2) *(LAS v2u*)(Mc + fr * WY_LS + 8 * fq) = w; else *(LAS v2u*)(Mc + fr * WY_LS + 8 * fq + 4) = w; }
        }
    }
    __syncthreads();
    if (MK_DBGSEL == 2 && part) return;
    for (int mc = 0; mc < nmc; ++mc) {
        asm volatile("" : "+v"(tid));
        const int fr = tid & 15, fq = (tid >> 4) & 3;
        LAS unsigned char* ob = lds + WY_BASE + mc * WY_BUF; LAS unsigned char* gs = lds + (mc ? WY_G2 : WY_LAB);
        LAS bf16* At = (LAS bf16*)(ob + WY_AT); LAS bf16* Rt = (LAS bf16*)(ob + WY_RT);
        LAS bf16* BKT = (LAS bf16*)(ob + WY_BK); LAS bf16* VT = (LAS bf16*)(ob + WY_VT); LAS float* GC = (LAS float*)(ob + WY_GC);
        LAS bf16* Lak = (LAS bf16*)(gs + 1024); LAS bf16* Mc = (LAS bf16*)(gs + 1024 + 16 * WY_LS * 2); LAS float* TT = (LAS float*)(gs + 1024 + 2 * 16 * WY_LS * 2);
        f32x4 W1 = (f32x4){0.f, 0.f, 0.f, 0.f}, Y0 = W1;
        {
            const LAS bf16* xbp = Xb + (16 * wave + fr) * WY_OS + fq * 8;
#pragma unroll
            for (int ks = 0; ks < 2; ++ks) { const bf16x8 bx = *(const LAS bf16x8*)(xbp + ks * 32);
                W1 = __builtin_amdgcn_mfma_f32_16x16x32_bf16(*(const LAS bf16x8*)(At + fr * WY_OS + ks * 32 + fq * 8), bx, W1, 0, 0, 0);
                Y0 = __builtin_amdgcn_mfma_f32_16x16x32_bf16(*(const LAS bf16x8*)(Rt + fr * WY_OS + ks * 32 + fq * 8), bx, Y0, 0, 0, 0); }
        }
        v2u vq = (v2u){0u, 0u};
        if (!pw) vq = *(const LAS v2u*)(VT + (16 * wave + fr) * WY_TS + 4 * fq);
        if (!pw) { v4u vb; vb.x = 0u; vb.y = 0u; vb.z = vq.x; vb.w = vq.y;
            W1 = __builtin_amdgcn_mfma_f32_16x16x32_bf16(*(const LAS bf16x8*)(Lak + fr * WY_LS + fq * 8), __builtin_bit_cast(bf16x8, vb), W1, 0, 0, 0); }
        f32x4 U = (f32x4){0.f, 0.f, 0.f, 0.f};
        if (!(MK_DBGSEL == 3 && part)) {
            const f32x4 tq = *(const LAS f32x4*)(TT + fr * 16 + 4 * fq);
#pragma unroll
            for (int kk = 0; kk < 4; ++kk) U = __builtin_amdgcn_mfma_f32_16x16x4f32(tq[kk], W1[kk], U, 0, 0, 0);
        } else U = W1;
        {
            v4u ucw; ucw.x = cvt_pk_bf16(U[0], U[1]); ucw.y = cvt_pk_bf16(U[2], U[3]); ucw.z = vq.x; ucw.w = vq.y;
            const bf16x8 uc = __builtin_bit_cast(bf16x8, ucw);
            Y0 = __builtin_amdgcn_mfma_f32_16x16x32_bf16(*(const LAS bf16x8*)(Mc + fr * WY_LS + fq * 8), uc, Y0, 0, 0, 0);
            LAS float* yo = (pw ? ZZ + 16 * (wave - 4) : YY + 16 * wave) + fr;
#pragma unroll
            for (int rg = 0; rg < 4; ++rg) yo[(mc * 16 + 4 * fq + rg) * 64] = Y0[rg];
#pragma unroll
            for (int j = 0; j < 4; ++j) {
                const bf16x8 bc = *(const LAS bf16x8*)(BKT + (16 * j + fr) * WY_LS + fq * 8);
                X[j] = X[j] * *(const LAS f32x4*)(GC + 16 * j + 4 * fq);
                X[j] = __builtin_amdgcn_mfma_f32_16x16x32_bf16(bc, uc, X[j], 0, 0, 0);
                v2u w; w.x = cvt_pk_bf16(X[j][0], X[j][1]); w.y = cvt_pk_bf16(X[j][2], X[j][3]);
                *(LAS v2u*)(Xb + (16 * wave + fr) * WY_OS + 16 * j + 4 * fq) = w; }
        }
        LDS_WAIT();
    }
}

#define P1_LOAD_PARAMS(HH) do { int lf_ = fr, lq_ = fq, lt_ = tid; asm volatile("" : "+v"(lf_), "+v"(lq_), "+v"(lt_));   \
        const int h_ = (HH), ncol_ = h_ * 64 + ntl * 16 + lf_; \
        _Pragma("unroll") for (int ks = 0; ks < 2; ++ks) { bw[ks] = *(const bf16x8*)(L2T + (size_t)ncol_ * 64 + lq_ * 8 + ks * 32); ba[ks] = *(const bf16x8*)(L2T + (size_t)512 * 64 + (size_t)ncol_ * 64 + lq_ * 8 + ks * 32); } \
        _Pragma("unroll") for (int ks = 0; ks < 4; ++ks) bg[ks] = *(const bf16x8*)(L2T + (size_t)1024 * 64 + (size_t)ncol_ * 128 + lq_ * 8 + ks * 32); \
        if (lt_ < 128) { const int a_ = lt_ >> 4, c_ = (lt_ & 15) * 4; \
            const float* src_ = a_ == 0 ? A.in[I_W0] : a_ == 1 ? A.in[I_A0] : a_ == 2 ? A.in[I_KK] : a_ == 3 ? A.in[I_KA] : a_ == 4 ? A.in[I_RK] : A.in[I_MURKV] + (a_ - 5) * 512; \
            *(LAS f32x4*)(PRM + a_ * 64 + c_) = *(const f32x4*)(src_ + h_ * 64 + c_); } } while (0)
__device__ __forceinline__ void scan_pass1(const Args& A, LAS unsigned char* lds, int tid, int lane, int wave, int vcu, int G, int part = 0) {
    bf16* GB = (bf16*)(A.ws + WS_A1) + (size_t)MPAD * 512;
    bf16* YL = (bf16*)(A.ws + WS_YL); bf16* ZT = (bf16*)(A.ws + WS_ZT); bf16* BV = (bf16*)(A.ws + WS_BV);
    LAS bf16* HIDB = (LAS bf16*)(lds + P1_HIDB); LAS float* LO = (LAS float*)(lds + P1_LO); LAS float* SEQ = (LAS float*)(lds + P1_SEQ);
    LAS float* YY = (LAS float*)(lds + P1_YY); LAS float* ZZ = (LAS float*)(lds + P1_ZZ);
    const bf16* L2T = (const bf16*)(A.ws + WS_L2T);
    const bool prow_wave = wave >= 4;
    const int mt = wave & 1, ntl = wave >> 1;
    int tt = tid >> 4, cs = tid & 15, c4 = cs * 4, fr = lane & 15, fq = lane >> 4;
    f32x4 X[4];
    bf16x8 bw[2], ba[2], bg[4];
    LAS float* PRM = (LAS float*)(lds + P1_GG);
    int cur_h = -1;
    int ui = 0, unit; if (!p1_unit_at(0, vcu, G, unit)) return;
    int t0 = 0; P1Pre pre; p1_load(A, unit, 0, tt, cs, pre);
    for (;;) {
        { int lt_ = tid; asm volatile("" : "+v"(lt_)); tt = lt_ >> 4; cs = lt_ & 15; c4 = cs * 4; fr = lt_ & 15; fq = (lt_ >> 4) & 3; }
        bool prompt; int b, h, ch, T, rowbase; p1_decode(unit, prompt, b, h, ch, T, rowbase);
        const int hc = h * 64 + c4;
        if (t0 == 0 && G == 256 && ui < 8) {
            const size_t i16 = ((size_t)(ui * 256 + vcu) * NTHR + tid) * 16;
            cvt16_fp8_sliced(A.in[I_U], A.ws + WS_UB, PEER_SU, i16); cvt16_fp8_sliced(A.in[I_V], A.ws + WS_VB, PEER_SV, i16); }
        if (t0 == 0) {
            LAS bf16* Xb = (LAS bf16*)(lds + WY_XB);
#pragma unroll
            for (int j = 0; j < 4; ++j) { const int prow_ = 16 * (wave - 4) + fr, c0_ = 16 * j + 4 * fq;
#pragma unroll
                for (int e = 0; e < 4; ++e) X[j][e] = (prow_wave && prow_ == c0_ + e) ? 1.f : 0.f;
                v2u w; w.x = cvt_pk_bf16(X[j][0], X[j][1]); w.y = cvt_pk_bf16(X[j][2], X[j][3]);
                *(LAS v2u*)(Xb + (16 * wave + fr) * WY_OS + c0_) = w; }
        }
        if (h != cur_h) { cur_h = h; P1_LOAD_PARAMS(h); }
        size_t row, prow; bool hasprev; int nb; p1_rows(unit, t0, tt, row, prow, hasprev, nb);
        if (!(MK_DBGSEL == 5 && part)) { *(LAS v4u*)(HIDB + tt * HID_STRIDE + cs * 16) = pre.pa0; *(LAS v4u*)(HIDB + tt * HID_STRIDE + cs * 16 + 8) = pre.pa1; }
        __syncthreads();
        if (!(MK_DBGSEL == 5 && part)) {
            const LAS bf16* ap = HIDB + (mt * 16 + fr) * HID_STRIDE + fq * 8;
            f32x4 cw = (f32x4){0.f, 0.f, 0.f, 0.f}, ca = cw, cg = cw;
#pragma unroll
            for (int ks = 0; ks < 2; ++ks) { cw = __builtin_amdgcn_mfma_f32_16x16x32_bf16(*(const LAS bf16x8*)(ap + ks * 32), bw[ks], cw, 0, 0, 0);
                                             ca = __builtin_amdgcn_mfma_f32_16x16x32_bf16(*(const LAS bf16x8*)(ap + 64 + ks * 32), ba[ks], ca, 0, 0, 0); }
#pragma unroll
            for (int ks = 0; ks < 4; ++ks) cg = __builtin_amdgcn_mfma_f32_16x16x32_bf16(*(const LAS bf16x8*)(ap + 128 + ks * 32), bg[ks], cg, 0, 0, 0);
#pragma unroll
            for (int rg = 0; rg < 4; ++rg) { const int o = (mt * 16 + fq * 4 + rg) * 64 + ntl * 16 + fr; LO[o] = cw[rg]; LO[2048 + o] = ca[rg]; LO[4096 + o] = cg[rg]; }
        }
        __syncthreads();
        if (!(MK_DBGSEL == 5 && part)) {
            const f32x4 w0v = *(const LAS f32x4*)(PRM + c4), a0v = *(const LAS f32x4*)(PRM + 64 + c4), kkv = *(const LAS f32x4*)(PRM + 128 + c4), kav = *(const LAS f32x4*)(PRM + 192 + c4),
                        rkv = *(const LAS f32x4*)(PRM + 256 + c4), mur = *(const LAS f32x4*)(PRM + 320 + c4), muk = *(const LAS f32x4*)(PRM + 384 + c4), muv = *(const LAS f32x4*)(PRM + 448 + c4);
            const f32x4 aw = w0v + *(const LAS f32x4*)(LO + tt * 64 + c4), aa = a0v + *(const LAS f32x4*)(LO + 2048 + tt * 64 + c4), ag = *(const LAS f32x4*)(LO + 4096 + tt * 64 + c4);
            f32x4 r = (f32x4){bf_lo(pre.zr.x), bf_hi(pre.zr.x), bf_lo(pre.zr.y), bf_hi(pre.zr.y)}, k = (f32x4){bf_lo(pre.zk.x), bf_hi(pre.zk.x), bf_lo(pre.zk.y), bf_hi(pre.zk.y)},
                  v = (f32x4){bf_lo(pre.zv.x), bf_hi(pre.zv.x), bf_lo(pre.zv.y), bf_hi(pre.zv.y)};
            const f32x4 rpv = (f32x4){bf_lo(pre.pr.x), bf_hi(pre.pr.x), bf_lo(pre.pr.y), bf_hi(pre.pr.y)}, kpv = (f32x4){bf_lo(pre.pk.x), bf_hi(pre.pk.x), bf_lo(pre.pk.y), bf_hi(pre.pk.y)},
                        vpv = (f32x4){bf_lo(pre.pv.x), bf_hi(pre.pv.x), bf_lo(pre.pv.y), bf_hi(pre.pv.y)};
            r = r + mur * (rpv - r); k = k + muk * (kpv - k); v = v + muv * (vpv - v);
            f32x4 dec, asg, kk, km, av, bv;
            float ssq = 0.f, bon = 0.f;
#pragma unroll
            for (int i = 0; i < 4; ++i) {
                const float x = -aw[i];
                const float sp = fmaxf(x, 0.f) + __logf(1.0f + __expf(-fabsf(x)));
                const float wraw = -sp - 0.5f;
                dec[i] = -__expf(wraw);
                asg[i] = sigm(aa[i]);
                kk[i] = k[i] * kkv[i]; ssq += kk[i] * kk[i];
                km[i] = k[i] * (1.0f + (asg[i] - 1.0f) * kav[i]);
                bon += r[i] * km[i] * rkv[i];
            }
            ssq = sum16(ssq); bon = sum16(bon);
            const float inv = 1.0f / fmaxf(sqrtf(ssq), 1e-12f);
#pragma unroll
            for (int i = 0; i < 4; ++i) { kk[i] *= inv; av[i] = -kk[i]; bv[i] = kk[i] * asg[i]; }
            LAS float* sq_ = SEQ + tt * 384 + c4;
            *(LAS f32x4*)(sq_) = av; *(LAS f32x4*)(sq_ + 64) = dec; *(LAS f32x4*)(sq_ + 128) = bv; *(LAS f32x4*)(sq_ + 192) = km; *(LAS f32x4*)(sq_ + 256) = r; *(LAS f32x4*)(sq_ + 320) = v;
            if (tt < nb) {
                v2u w; w.x = cvt_pk_bf16(ag[0], ag[1]); w.y = cvt_pk_bf16(ag[2], ag[3]); *(v2u*)(GB + row * 512 + hc) = w;
                w.x = cvt_pk_bf16(bon * v[0], bon * v[1]); w.y = cvt_pk_bf16(bon * v[2], bon * v[3]); *(v2u*)(BV + row * 512 + hc) = w;
            }
        }
        int nunit = unit, nt0 = t0 + SC_TB, nui = ui; bool more = true;
        if (nt0 >= T) { nt0 = 0; nui = ui + 1; more = p1_unit_at(nui, vcu, G, nunit); }
        if (more) p1_load(A, nunit, nt0, tt, cs, pre);
        __syncthreads();
        if (!(MK_DBGSEL == 1 && part)) p1_wy(X, SEQ, YY, ZZ, lds, nb, tid, lane, wave, part);
        __syncthreads();
        if (tt < nb) {
            const f32x4 y = *(const LAS f32x4*)(YY + tt * 64 + c4), z = *(const LAS f32x4*)(ZZ + tt * 64 + c4);
            v2u w; w.x = cvt_pk_bf16(y[0], y[1]); w.y = cvt_pk_bf16(y[2], y[3]); *(v2u*)(YL + row * 512 + hc) = w;
            w.x = cvt_pk_bf16(z[0], z[1]); w.y = cvt_pk_bf16(z[2], z[3]); *(v2u*)(ZT + row * 512 + hc) = w;
        }
        if (t0 + SC_TB >= T) {
#pragma unroll
            for (int j = 0; j < 4; ++j) {
                if (!prow_wave) *(f32x4*)((float*)A.out + (size_t)unit * 4096 + (16 * wave + fr) * 64 + 16 * j + 4 * fq) = X[j];
                else { bf16* mt = (bf16*)((unsigned char*)A.out + OB_MB) + (size_t)unit * 4096 + (16 * j + 4 * fq) * 64 + 16 * (wave - 4) + fr;
                    const unsigned p01 = cvt_pk_bf16(X[j][0], X[j][1]), p23 = cvt_pk_bf16(X[j][2], X[j][3]);
                    mt[0] = (bf16)(p01 & 0xffffu); mt[64] = (bf16)(p01 >> 16); mt[128] = (bf16)(p23 & 0xffffu); mt[192] = (bf16)(p23 >> 16); }
            }
        }
        if (!more) break;
        unit = nunit; t0 = nt0; ui = nui;
    }
    __syncthreads();
}

constexpr int P2_SS = 72, P2_LO = 16 * P2_SS * 2, P2_BUF = 2 * P2_LO;
__device__ __forceinline__ void scan_pass2_rows(const float* Sinit, int unit0, int nchunks, int v0, float* outfin, bool slots, const Args& A, LAS unsigned char* lds, int tid, int lane, int wave) {
    LAS bf16* Shi = (LAS bf16*)lds; LAS bf16* Slo = (LAS bf16*)(lds + P2_LO);
    const int nt = wave & 3, fr = lane & 15, fq = lane >> 4; const bool act = wave < 4;
    float* NB = (float*)A.out; const bf16* MT = (const bf16*)((const unsigned char*)A.out + OB_MB);
    { const int idx = tid * 2, row = idx >> 6, col = idx & 63;
      const f32x2 s0 = Sinit ? *(const f32x2*)(Sinit + (size_t)(v0 + row) * 64 + col) : (f32x2){0.f, 0.f};
      const unsigned hi = cvt_pk_bf16(s0.x, s0.y);
      *(LAS unsigned*)(Shi + row * P2_SS + col) = hi; *(LAS unsigned*)(Slo + row * P2_SS + col) = cvt_pk_bf16(s0.x - bf_lo(hi), s0.y - bf_hi(hi)); }
    bf16x8 mr[4][2]; f32x4 nr[4];
    const size_t moff = (size_t)(16 * nt + fr) * 64 + fq * 8, noff = (size_t)(v0 + fr) * 64 + 16 * nt + 4 * fq;
#pragma unroll
    for (int d = 0; d < 4; ++d) {
        mr[d][0] = (bf16x8){0, 0, 0, 0, 0, 0, 0, 0}; mr[d][1] = mr[d][0]; nr[d] = (f32x4){0.f, 0.f, 0.f, 0.f};
        { const int cc = d < nchunks ? d : nchunks - 1;
            mr[d][0] = *(const bf16x8*)(MT + (size_t)(unit0 + cc) * 4096 + moff); mr[d][1] = *(const bf16x8*)(MT + (size_t)(unit0 + cc) * 4096 + moff + 32);
            nr[d] = *(const f32x4*)(NB + (size_t)(unit0 + cc) * 4096 + noff); }
    }
    f32x4 acc = (f32x4){0.f, 0.f, 0.f, 0.f};
    __syncthreads();
    for (int c0 = 0; c0 < nchunks; c0 += 4) {
#pragma unroll
        for (int d = 0; d < 4; ++d) {
            const int c = c0 + d;
            if (c < nchunks) {
                {
                    LAS bf16* Shi = (LAS bf16*)(lds + (d & 1) * P2_BUF); LAS bf16* Slo = (LAS bf16*)(lds + (d & 1) * P2_BUF + P2_LO);
                    const bf16x8 sh0 = *(const LAS bf16x8*)(Shi + fr * P2_SS + fq * 8), sh1 = *(const LAS bf16x8*)(Shi + fr * P2_SS + 32 + fq * 8),
                                 sl0 = *(const LAS bf16x8*)(Slo + fr * P2_SS + fq * 8), sl1 = *(const LAS bf16x8*)(Slo + fr * P2_SS + 32 + fq * 8);
                    acc = nr[d];
                    acc = __builtin_amdgcn_mfma_f32_16x16x32_bf16(mr[d][0], sh0, acc, 0, 0, 0); acc = __builtin_amdgcn_mfma_f32_16x16x32_bf16(mr[d][1], sh1, acc, 0, 0, 0);
                    acc = __builtin_amdgcn_mfma_f32_16x16x32_bf16(mr[d][0], sl0, acc, 0, 0, 0); acc = __builtin_amdgcn_mfma_f32_16x16x32_bf16(mr[d][1], sl1, acc, 0, 0, 0);
                    const int cn = c + 4 < nchunks ? c + 4 : nchunks - 1;
                    mr[d][0] = *(const bf16x8*)(MT + (size_t)(unit0 + cn) * 4096 + moff); mr[d][1] = *(const bf16x8*)(MT + (size_t)(unit0 + cn) * 4096 + moff + 32);
                    nr[d] = *(const f32x4*)(NB + (size_t)(unit0 + cn) * 4096 + noff);
                }
                if (act) {
                    LAS bf16* Shi = (LAS bf16*)(lds + ((d + 1) & 1) * P2_BUF); LAS bf16* Slo = (LAS bf16*)(lds + ((d + 1) & 1) * P2_BUF + P2_LO);
                    v2u hi; hi.x = cvt_pk_bf16(acc[0], acc[1]); hi.y = cvt_pk_bf16(acc[2], acc[3]);
                    v2u lo; lo.x = cvt_pk_bf16(acc[0] - bf_lo(hi.x), acc[1] - bf_hi(hi.x)); lo.y = cvt_pk_bf16(acc[2] - bf_lo(hi.y), acc[3] - bf_hi(hi.y));
                    *(LAS v2u*)(Shi + fr * P2_SS + 16 * nt + 4 * fq) = hi; *(LAS v2u*)(Slo + fr * P2_SS + 16 * nt + 4 * fq) = lo;
                    if (slots) *(v2u*)((bf16*)(NB + (size_t)(unit0 + c) * 4096) + (size_t)(v0 + fr) * 128 + 16 * nt + 4 * fq) = hi;
                }
                __syncthreads();
            }
        }
    }
    if (act) *(f32x4*)(outfin + noff) = acc;
    __syncthreads();
}

__device__ __forceinline__ void scan_pass2_sample(const float* Sinit, int unit, float* outfin, const Args& A, int lane, int wave) {
    const int fr = lane & 15, fq = lane >> 4, rt = wave >> 1;
    const float* NB = (const float*)A.out + (size_t)unit * 4096; const bf16* MT = (const bf16*)((const unsigned char*)A.out + OB_MB) + (size_t)unit * 4096;
    f32x4 sv[2][2];
#pragma unroll
    for (int ks = 0; ks < 2; ++ks) { const float* sp = Sinit + (size_t)(16 * rt + fr) * 64 + 32 * ks + 8 * fq; sv[ks][0] = *(const f32x4*)sp; sv[ks][1] = *(const f32x4*)(sp + 4); }
    bf16x8 mt[2][2]; f32x4 acc[2];
#pragma unroll
    for (int t = 0; t < 2; ++t) { const int nt = 2 * (wave & 1) + t;
        mt[t][0] = *(const bf16x8*)(MT + (size_t)(16 * nt + fr) * 64 + fq * 8); mt[t][1] = *(const bf16x8*)(MT + (size_t)(16 * nt + fr) * 64 + 32 + fq * 8);
        acc[t] = *(const f32x4*)(NB + (size_t)(16 * rt + fr) * 64 + 16 * nt + 4 * fq); }
    bf16x8 sh[2], sl[2];
#pragma unroll
    for (int ks = 0; ks < 2; ++ks) { const f32x4 a = sv[ks][0], b = sv[ks][1];
        v4u h; h.x = cvt_pk_bf16(a[0], a[1]); h.y = cvt_pk_bf16(a[2], a[3]); h.z = cvt_pk_bf16(b[0], b[1]); h.w = cvt_pk_bf16(b[2], b[3]);
        v4u l; l.x = cvt_pk_bf16(a[0] - bf_lo(h.x), a[1] - bf_hi(h.x)); l.y = cvt_pk_bf16(a[2] - bf_lo(h.y), a[3] - bf_hi(h.y));
        l.z = cvt_pk_bf16(b[0] - bf_lo(h.z), b[1] - bf_hi(h.z)); l.w = cvt_pk_bf16(b[2] - bf_lo(h.w), b[3] - bf_hi(h.w));
        sh[ks] = __builtin_bit_cast(bf16x8, h); sl[ks] = __builtin_bit_cast(bf16x8, l);
        if ((wave & 1) == 0) *(v4u*)((bf16*)((unsigned char*)A.out + OB_S0S) + (size_t)(unit - NUNITS_P) * 4096 + (size_t)(16 * rt + fr) * 64 + 32 * ks + 8 * fq) = h; }
#pragma unroll
    for (int t = 0; t < 2; ++t) { const int nt = 2 * (wave & 1) + t;
#pragma unroll
        for (int ks = 0; ks < 2; ++ks) { acc[t] = __builtin_amdgcn_mfma_f32_16x16x32_bf16(mt[t][ks], sh[ks], acc[t], 0, 0, 0); acc[t] = __builtin_amdgcn_mfma_f32_16x16x32_bf16(mt[t][ks], sl[ks], acc[t], 0, 0, 0); }
        *(f32x4*)(outfin + (size_t)(16 * rt + fr) * 64 + 16 * nt + 4 * fq) = acc[t]; }
}

__device__ __forceinline__ void scan_pass3_wave(const Args& A, int unit, int wq, int lane) {
    const bool prompt = unit < NUNITS_P;
    const int b = prompt ? unit >> 9 : (unit - NUNITS_P) >> 3, h = prompt ? (unit >> 6) & 7 : unit & 7, ch = prompt ? unit & 63 : 0;
    const int T = prompt ? 64 : SEQ_S, rowbase = prompt ? b * SEQ_P + ch * 64 : NPROMPT + b * SEQ_S;
    if (wq * 16 >= T) return;
    const bf16* S0 = prompt ? (ch > 0 ? (const bf16*)((const float*)A.out + (size_t)(unit - 1) * 4096) : (const bf16*)(A.ws + WS_CTL + 49152)) : (const bf16*)((const unsigned char*)A.out + OB_S0S) + (size_t)(b * 8 + h) * 4096;
    const int spitch = prompt ? 128 : 64;
    const bf16* ZT = (const bf16*)(A.ws + WS_ZT); const bf16* YL = (const bf16*)(A.ws + WS_YL); const bf16* BV = (const bf16*)(A.ws + WS_BV);
    bf16* YB = (bf16*)(A.ws + WS_A1) + (size_t)MPAD * 512;
    const int fr = lane & 15, fq = lane >> 4;
    const size_t row = (size_t)(rowbase + wq * 16 + fr);
    bf16x8 bz[2], sa[4][2]; v2u yl[4], bvw[4], gg[4]; f32x4 gw[4], gb[4];
#pragma unroll
    for (int ks = 0; ks < 2; ++ks) bz[ks] = *(const bf16x8*)(ZT + row * 512 + h * 64 + ks * 32 + fq * 8);
#pragma unroll
    for (int mt = 0; mt < 4; ++mt)
#pragma unroll
        for (int ks = 0; ks < 2; ++ks) sa[mt][ks] = *(const bf16x8*)(S0 + (size_t)(mt * 16 + fr) * spitch + ks * 32 + fq * 8);
#pragma unroll
    for (int mt = 0; mt < 4; ++mt) { const int c = h * 64 + mt * 16 + fq * 4;
        yl[mt] = *(const v2u*)(YL + row * 512 + c); bvw[mt] = *(const v2u*)(BV + row * 512 + c); gg[mt] = *(const v2u*)(YB + row * 512 + c);
        gw[mt] = *(const f32x4*)(A.in[I_GNW] + c); gb[mt] = *(const f32x4*)(A.in[I_GNB] + c); }
    f32x4 acc[4];
#pragma unroll
    for (int mt = 0; mt < 4; ++mt) { acc[mt] = (f32x4){0.f, 0.f, 0.f, 0.f};
#pragma unroll
        for (int ks = 0; ks < 2; ++ks) acc[mt] = __builtin_amdgcn_mfma_f32_16x16x32_bf16(sa[mt][ks], bz[ks], acc[mt], 0, 0, 0); }
    float sm = 0.f;
#pragma unroll
    for (int mt = 0; mt < 4; ++mt) { const v2u y = yl[mt];
        acc[mt][0] += bf_lo(y.x); acc[mt][1] += bf_hi(y.x); acc[mt][2] += bf_lo(y.y); acc[mt][3] += bf_hi(y.y);
        sm += (acc[mt][0] + acc[mt][1]) + (acc[mt][2] + acc[mt][3]); }
    sm += __shfl_xor(sm, 16); sm += __shfl_xor(sm, 32);
    const float mean = sm * (1.f / 64.f); float sv = 0.f;
#pragma unroll
    for (int mt = 0; mt < 4; ++mt) { acc[mt] = acc[mt] - mean; sv += (acc[mt][0] * acc[mt][0] + acc[mt][1] * acc[mt][1]) + (acc[mt][2] * acc[mt][2] + acc[mt][3] * acc[mt][3]); }
    sv += __shfl_xor(sv, 16); sv += __shfl_xor(sv, 32);
    const float rs = 1.0f / sqrtf(sv * (1.f / 64.f) + 64e-5f);
#pragma unroll
    for (int mt = 0; mt < 4; ++mt) { const int c = h * 64 + mt * 16 + fq * 4;
        f32x4 o = acc[mt] * rs * gw[mt] + gb[mt] + (f32x4){bf_lo(bvw[mt].x), bf_hi(bvw[mt].x), bf_lo(bvw[mt].y), bf_hi(bvw[mt].y)};
        o = o * (f32x4){bf_lo(gg[mt].x), bf_hi(gg[mt].x), bf_lo(gg[mt].y), bf_hi(gg[mt].y)};
        v2u w; w.x = cvt_pk_bf16(o[0], o[1]); w.y = cvt_pk_bf16(o[2], o[3]); *(v2u*)(YB + row * 512 + c) = w; }
}

__device__ __forceinline__ void tk_insert(float (&tv)[16], float x) {
#pragma unroll
    for (int i = 15; i >= 1; --i) tv[i] = __builtin_amdgcn_fmed3f(tv[i - 1], x, tv[i]);
    tv[0] = __builtin_fmaxf(tv[0], x);
}
#define TK_CE(t, i, j) { const float a_ = __builtin_fmaxf(t[i], t[j]); t[j] = __builtin_fminf(t[i], t[j]); t[i] = a_; }
__device__ __forceinline__ void tk_sort16(float (&t)[16]) {
    TK_CE(t, 0, 1) TK_CE(t, 2, 3) TK_CE(t, 0, 2) TK_CE(t, 1, 3) TK_CE(t, 1, 2) TK_CE(t, 4, 5) TK_CE(t, 6, 7) TK_CE(t, 4, 6) TK_CE(t, 5, 7) TK_CE(t, 5, 6) TK_CE(t, 0, 4) TK_CE(t, 2, 6) TK_CE(t, 2, 4) TK_CE(t, 1, 5) TK_CE(t, 3, 7) TK_CE(t, 3, 5) TK_CE(t, 1, 2) TK_CE(t, 3, 4) TK_CE(t, 5, 6) TK_CE(t, 8, 9) TK_CE(t, 10, 11) TK_CE(t, 8, 10) TK_CE(t, 9, 11) TK_CE(t, 9, 10) TK_CE(t, 12, 13) TK_CE(t, 14, 15) TK_CE(t, 12, 14) TK_CE(t, 13, 15) TK_CE(t, 13, 14) TK_CE(t, 8, 12) TK_CE(t, 10, 14) TK_CE(t, 10, 12) TK_CE(t, 9, 13) TK_CE(t, 11, 15) TK_CE(t, 11, 13) TK_CE(t, 9, 10) TK_CE(t, 11, 12) TK_CE(t, 13, 14) TK_CE(t, 0, 8) TK_CE(t, 4, 12) TK_CE(t, 4, 8) TK_CE(t, 2, 10) TK_CE(t, 6, 14) TK_CE(t, 6, 10) TK_CE(t, 2, 4) TK_CE(t, 6, 8) TK_CE(t, 10, 12) TK_CE(t, 1, 9) TK_CE(t, 5, 13) TK_CE(t, 5, 9) TK_CE(t, 3, 11) TK_CE(t, 7, 15) TK_CE(t, 7, 11) TK_CE(t, 3, 5) TK_CE(t, 7, 9) TK_CE(t, 11, 13) TK_CE(t, 1, 2) TK_CE(t, 3, 4) TK_CE(t, 5, 6) TK_CE(t, 7, 8) TK_CE(t, 9, 10) TK_CE(t, 11, 12) TK_CE(t, 13, 14)
}
__device__ __forceinline__ void tk_merge16(float (&tv)[16], const float (&g)[16]) {
#pragma unroll
    for (int i = 0; i < 16; ++i) tv[i] = __builtin_fmaxf(tv[i], g[15 - i]);
#pragma unroll
    for (int s = 8; s >= 1; s >>= 1)
#pragma unroll
        for (int i = 0; i < 16; ++i) if ((i & s) == 0) TK_CE(tv, i, i + s)
}
__device__ __forceinline__ float gelu_tanh(float x) {
    const float u = 0.7978845608028654f * (x + 0.044715f * x * x * x);
    const float th = 1.0f - 2.0f * __builtin_amdgcn_rcpf(__expf(2.0f * u) + 1.0f);
    return 0.5f * x * (1.0f + th);
}
constexpr int NTILE32 = NTOK / 32;
constexpr int CW_QU = 8192, CW_QV = 8192 + 512;

constexpr int TK_STRIDE = 68, TK_BYTES = 64 * TK_STRIDE * 4;
__device__ __forceinline__ void topk_scores64(const bf16* Q, const bf16* KB, LAS float* SC, int t0, int hp, int p, int half, int lane, const bf16x8 (&af)[2][2][4]) {
    const int fr = lane & 15, fq = lane >> 4;
#pragma unroll
    for (int hs = 0; hs < 2; ++hs) {
        const bf16* kbase = KB + (size_t)(((hp + 4 * hs) * 2 + p) * 128 + half * 64 + fr) * 128 + fq * 8;
#pragma unroll
        for (int n = 0; n < 4; ++n) {
            bf16x8 bfr[4];
#pragma unroll
            for (int ks = 0; ks < 4; ++ks) bfr[ks] = *(const bf16x8*)(kbase + (size_t)n * 16 * 128 + ks * 32);
            f32x4 acc0 = (f32x4){0.f, 0.f, 0.f, 0.f}, acc1 = acc0;
#pragma unroll
            for (int ks = 0; ks < 4; ++ks) { acc0 = __builtin_amdgcn_mfma_f32_16x16x32_bf16(af[hs][0][ks], bfr[ks], acc0, 0, 0, 0); acc1 = __builtin_amdgcn_mfma_f32_16x16x32_bf16(af[hs][1][ks], bfr[ks], acc1, 0, 0, 0); }
#pragma unroll
            for (int rg = 0; rg < 4; ++rg) { SC[(hs * 32 + fq * 4 + rg) * TK_STRIDE + n * 16 + fr] = acc0[rg]; SC[(hs * 32 + 16 + fq * 4 + rg) * TK_STRIDE + n * 16 + fr] = acc1[rg]; }
        }
    }
}
constexpr int TK_NPROMPT_UNITS = (NPROMPT / 32) * 4, TK_NSAMPLE_UNITS = (NSAMP / 32) * 4, CW_TKS = 9792;
__device__ __forceinline__ void peer_topk_units(const Args& A, LAS unsigned char* lds, int lane, int wave, int u_first, int u_end, int u_step) {
    const bf16* Q = (const bf16*)(A.ws + WS_ZG); const bf16* KB = (const bf16*)(A.ws + WS_KEYS); const float* SSP = (const float*)(A.ws + WS_SSP);
    unsigned short* EIDX = (unsigned short*)(A.ws + WS_EIDX); float* GATE = (float*)(A.ws + WS_GATE); float* RSTD = (float*)(A.ws + WS_RSTD);
    LAS float* SC = (LAS float*)(lds + wave * TK_BYTES);
    const int fr = lane & 15, fq = lane >> 4, tokl = lane & 31, hsel = lane >> 5;
    for (int u = u_first; u < u_end; u += u_step) {
        const int t0 = (u >> 2) * 32, hp = u & 3, h = hp + 4 * hsel;
        const float* sp = SSP + (size_t)(t0 + tokl) * 16;
        const f32x4 s0 = *(const f32x4*)sp, s1 = *(const f32x4*)(sp + 4), s2 = *(const f32x4*)(sp + 8), s3 = *(const f32x4*)(sp + 12);
        const float ssq = ((s0[0] + s0[1]) + (s0[2] + s0[3])) + ((s1[0] + s1[1]) + (s1[2] + s1[3])) + ((s2[0] + s2[1]) + (s2[2] + s2[3])) + ((s3[0] + s3[1]) + (s3[2] + s3[3]));
        const float rstd = 1.0f / sqrtf(ssq * (1.f / DM) + 1e-6f);
        float tv0[16], tv1[16], cv[16];
#pragma unroll
        for (int p = 0; p < 2; ++p) {
            bf16x8 af[2][2][4];
#pragma unroll
            for (int hs = 0; hs < 2; ++hs)
#pragma unroll
                for (int mt = 0; mt < 2; ++mt) { const bf16* qp = Q + (size_t)(t0 + mt * 16 + fr) * 2048 + (hp + 4 * hs) * 256 + p * 128 + fq * 8;
#pragma unroll
                    for (int ks = 0; ks < 4; ++ks) af[hs][mt][ks] = *(const bf16x8*)(qp + ks * 32); }
            float tv[16];
#pragma unroll
            for (int i = 0; i < 16; ++i) tv[i] = -3.0e38f;
            for (int half = 0; half < 2; ++half) {
                topk_scores64(Q, KB, SC, t0, hp, p, half, lane, af);
                LDS_WAIT();
                const LAS float* mine = SC + lane * TK_STRIDE;
                unsigned kmask = 0xFFFFFF80u; asm volatile("" : "+v"(kmask));
#pragma unroll 1
                for (int n = 0; n < 64; n += 16) {
                    float g[16];
#pragma unroll
                    for (int q = 0; q < 4; ++q) { const f32x4 x4 = *(const LAS f32x4*)(mine + n + 4 * q);
#pragma unroll
                        for (int e = 0; e < 4; ++e) g[4 * q + e] = __uint_as_float((__float_as_uint(x4[e]) & kmask) | (unsigned)(half * 64 + n + 4 * q + e)); }
                    tk_sort16(g); tk_merge16(tv, g);
                }
                LDS_WAIT();
            }
#pragma unroll
            for (int i = 0; i < 16; ++i) { if (p == 0) tv0[i] = tv[i]; else tv1[i] = tv[i]; }
        }
        LAS int* li = (LAS int*)SC + lane * 33;
#pragma unroll
        for (int q = 0; q < 16; ++q) { li[q] = (int)(__float_as_uint(tv0[q]) & 127u); li[16 + q] = (int)(__float_as_uint(tv1[q]) & 127u);
            tv0[q] = __uint_as_float(__float_as_uint(tv0[q]) & 0xFFFFFF80u); tv1[q] = __uint_as_float(__float_as_uint(tv1[q]) & 0xFFFFFF80u); }
#pragma unroll
        for (int q = 0; q < 16; ++q) cv[q] = -3.0e38f;
#pragma unroll
        for (int a = 0; a < 16; ++a)
#pragma unroll
            for (int b = 0; b < 16; ++b) if ((a + 1) * (b + 1) <= 16)
                tk_insert(cv, __uint_as_float((__float_as_uint(tv0[a] + tv1[b]) & 0xFFFFFF00u) | (unsigned)(a * 16 + b)));
        LDS_WAIT();
        float e[16], den = 0.f; unsigned ci[16];
        const float c0 = __uint_as_float(__float_as_uint(cv[0]) & 0xFFFFFF00u);
#pragma unroll
        for (int q = 0; q < 16; ++q) { const unsigned kb = __float_as_uint(cv[q]); const float cq = __uint_as_float(kb & 0xFFFFFF00u);
            e[q] = __expf((cq - c0) * rstd); den += e[q]; ci[q] = (unsigned)(li[(kb >> 4) & 15] * 128 + li[16 + (kb & 15)]); }
        const float inv = 1.0f / den;
        LDS_WAIT();
        {
            const size_t tok = (size_t)(t0 + tokl);
            v4u w0, w1; w0.x = ci[0] | (ci[1] << 16); w0.y = ci[2] | (ci[3] << 16); w0.z = ci[4] | (ci[5] << 16); w0.w = ci[6] | (ci[7] << 16);
            w1.x = ci[8] | (ci[9] << 16); w1.y = ci[10] | (ci[11] << 16); w1.z = ci[12] | (ci[13] << 16); w1.w = ci[14] | (ci[15] << 16);
            *(v4u*)(EIDX + tok * 128 + h * 16) = w0; *(v4u*)(EIDX + tok * 128 + h * 16 + 8) = w1;
#pragma unroll
            for (int q = 0; q < 4; ++q) *(f32x4*)(GATE + tok * 128 + h * 16 + 4 * q) = (f32x4){e[4 * q] * inv, e[4 * q + 1] * inv, e[4 * q + 2] * inv, e[4 * q + 3] * inv};
            if (h == 0) RSTD[tok] = rstd;
        }
    }
}

__device__ __forceinline__ bool peer_topk_split(int G) { return G == 256; }
__device__ __forceinline__ void peer_topk_phase(const Args& A, LAS unsigned char* lds, int tid, int lane, int wave, int vcu, int G) {
    peer_topk_units(A, lds, lane, wave, wave * G + vcu, peer_topk_split(G) ? TK_NPROMPT_UNITS : TK_NPROMPT_UNITS + TK_NSAMPLE_UNITS, G * NWAVES);
}
__device__ __forceinline__ void peer_topk_sample_prelude(const Args& A, LAS unsigned char* lds, int tid, int lane, int wave, int vcu, int G, gu32* ctl) {
    if (!peer_topk_split(G) || (vcu & 31) != 0) return;
    peer_topk_units(A, lds, lane, wave, TK_NPROMPT_UNITS + (vcu >> 5) * NWAVES + wave, TK_NPROMPT_UNITS + TK_NSAMPLE_UNITS, TK_NSAMPLE_UNITS);
    asm volatile("s_waitcnt vmcnt(0)" ::: "memory");
    __syncthreads();
    if (tid == 0) { __builtin_amdgcn_fence(__ATOMIC_RELEASE, "agent"); asm volatile("s_waitcnt vmcnt(0)" ::: "memory"); (void)__hip_atomic_fetch_add((unsigned*)(ctl + CW_TKS), 1u, RLX_AGENT); }
    __syncthreads();
}
__device__ __forceinline__ void peer_topk_sample_wait(gu32* ctl, int tid) {
    if (tid == 0) {
        unsigned sp = 0;
        while (__hip_atomic_load((unsigned*)(ctl + CW_TKS), RLX_AGENT) < (unsigned)(TK_NSAMPLE_UNITS / NWAVES)) { __builtin_amdgcn_s_sleep(2); if (++sp > (1u << 22)) break; }
        __builtin_amdgcn_fence(__ATOMIC_ACQUIRE, "agent");
        asm volatile("s_waitcnt vmcnt(0)" ::: "memory");
    }
    __syncthreads();
}

constexpr int PEER_ITEM = 40, NITEM128 = NTOK / PEER_ITEM;
__device__ __forceinline__ bool peer_next_item(gu32* qbase, int xcc, int& qs, int& slice, int& item, LAS unsigned char* lds, int tid) {
    LAS int* box = (LAS int*)(lds + LDSCTL_OFF + 64);
    for (;;) {
        if (qs >= 8) return false;
        slice = (xcc + qs) & 7;
        if (tid == 0) box[0] = (int)__hip_atomic_fetch_add((unsigned*)(qbase + 64 * slice), 1u, RLX_AGENT);
        __syncthreads();
        item = box[0];
        __syncthreads();
        if (item < NITEM128) return true;
        ++qs;
    }
}

typedef long i64_t;
constexpr float PEER_SX = 1.0f;
constexpr int U_TILE0 = 8192, U_TILEB = 16384;
__device__ __forceinline__ i64_t mk64(unsigned lo, unsigned hi) { return (i64_t)(((unsigned long long)hi << 32) | (unsigned long long)lo); }
__device__ __forceinline__ void peer_u_phase(const Args& A, LAS unsigned char* lds, int tid, int lane, int wave, gu32* ctl, int qoff) {
    const unsigned char* Uq = A.ws + WS_UB; const bf16* XG = (const bf16*)(A.ws + WS_A1);
    const unsigned short* EIDX = (const unsigned short*)(A.ws + WS_EIDX); bf16* PART = (bf16*)(A.ws + WS_PART);
    const int xcc = (int)(xb_xcc_id() & 7u), rg = lane >> 3, c8 = lane & 7, m = lane & 15, kq = lane >> 4;
    LAS int* we = (LAS int*)(lds + wave * 1024);
    LAS unsigned char* tile = lds + U_TILE0 + wave * U_TILEB;
    const int ch_e = ((c8 - (rg >> 1)) & 7) * 16, ch_o = ((c8 - 4 - (rg >> 1)) & 7) * 16;
    const int fbase = m * 128 + (kq & 1) * 8, pos0 = (kq >> 1) + (m >> 1);
    int foff[4];
#pragma unroll
    for (int ks = 0; ks < 4; ++ks) foff[ks] = fbase + ((pos0 + 2 * ks) & 7) * 16;
    int qs = 0, slice, item; bool lists_ready = !peer_topk_split((int)gridDim.x);
    while (peer_next_item(ctl + CW_QU + qoff, xcc, qs, slice, item, lds, tid)) {
        if (!lists_ready && (item + 1) * PEER_ITEM > NPROMPT) { peer_topk_sample_wait(ctl, tid); lists_ready = true; }
        const unsigned char* us = Uq + (size_t)slice * 16384 * 128;
        size_t tok = (size_t)(item * PEER_ITEM + wave);
        unsigned pair = *(const unsigned*)(EIDX + tok * 128 + 2 * lane);
        v4u xr[4];
#pragma unroll
        for (int ks = 0; ks < 4; ++ks) xr[ks] = *(const v4u*)(XG + tok * DM + slice * 128 + ks * 32 + kq * 8);
        we[2 * lane] = (int)(pair & 0xffffu); we[2 * lane + 1] = (int)(pair >> 16);
        LDS_WAIT();
        v4u w[16];
#pragma unroll
        for (int it = 0; it < 16; ++it) w[it] = *(const v4u*)(us + (unsigned)(((unsigned)we[it * 8 + rg] << 7) + (unsigned)((it & 1) ? ch_o : ch_e)));
        for (int tt = 0; tt < PEER_ITEM / NWAVES; ++tt) {
            const size_t ctok = tok; const bool more = tt + 1 < PEER_ITEM / NWAVES;
            i64_t bx[4];
#pragma unroll
            for (int ks = 0; ks < 4; ++ks) { const v4u q = xr[ks]; typedef short s16x2 __attribute__((ext_vector_type(2)));
                s16x2 lo = (s16x2){0, 0}, hi = lo;
                unsigned q0 = q.x, q1 = q.y, q2 = q.z, q3 = q.w; asm volatile("" : "+v"(q0), "+v"(q1), "+v"(q2), "+v"(q3));
                lo = __builtin_amdgcn_cvt_scalef32_pk_fp8_bf16(lo, __builtin_bit_cast(bf16x2_t, q0), PEER_SX, false); lo = __builtin_amdgcn_cvt_scalef32_pk_fp8_bf16(lo, __builtin_bit_cast(bf16x2_t, q1), PEER_SX, true);
                hi = __builtin_amdgcn_cvt_scalef32_pk_fp8_bf16(hi, __builtin_bit_cast(bf16x2_t, q2), PEER_SX, false); hi = __builtin_amdgcn_cvt_scalef32_pk_fp8_bf16(hi, __builtin_bit_cast(bf16x2_t, q3), PEER_SX, true);
                bx[ks] = mk64(__builtin_bit_cast(unsigned, lo), __builtin_bit_cast(unsigned, hi)); }
            if (more) { tok += NWAVES; pair = *(const unsigned*)(EIDX + tok * 128 + 2 * lane);
#pragma unroll
                for (int ks = 0; ks < 4; ++ks) xr[ks] = *(const v4u*)(XG + tok * DM + slice * 128 + ks * 32 + kq * 8); }
#pragma unroll
            for (int it = 0; it < 16; ++it) *(LAS v4u*)(tile + it * 1024 + lane * 16) = w[it];
            if (more) {
                we[2 * lane] = (int)(pair & 0xffffu); we[2 * lane + 1] = (int)(pair >> 16);
                LDS_WAIT();
#pragma unroll
                for (int it = 0; it < 16; ++it) w[it] = *(const v4u*)(us + (unsigned)(((unsigned)we[it * 8 + rg] << 7) + (unsigned)((it & 1) ? ch_o : ch_e)));
            } else LDS_WAIT();
            bf16* pp = PART + (ctok * 8 + slice) * 128;
            f32x4 acc[8];
#pragma unroll
            for (int hf = 0; hf < 2; ++hf) {
                v2u a[4][4];
#pragma unroll
                for (int T4 = 0; T4 < 4; ++T4)
#pragma unroll
                    for (int ks = 0; ks < 4; ++ks) a[T4][ks] = *(const LAS v2u*)(tile + (hf * 4 + T4) * 2048 + foff[ks]);
#pragma unroll
                for (int T4 = 0; T4 < 4; ++T4) acc[hf * 4 + T4] = (f32x4){0.f, 0.f, 0.f, 0.f};
#pragma unroll
                for (int ks = 0; ks < 4; ++ks)
#pragma unroll
                    for (int T4 = 0; T4 < 4; ++T4) acc[hf * 4 + T4] = __builtin_amdgcn_mfma_f32_16x16x32_fp8_fp8(mk64(a[T4][ks].x, a[T4][ks].y), bx[ks], acc[hf * 4 + T4], 0, 0, 0);
            }
            f32x4 val = acc[0];
#pragma unroll
            for (int T = 1; T < 8; ++T) val = ((m & 7) == T) ? acc[T] : val;
            if (m < 8) { v2u pw; pw.x = cvt_pk_bf16(val[0] * (1.0f / PEER_SX), val[1] * (1.0f / PEER_SX)); pw.y = cvt_pk_bf16(val[2] * (1.0f / PEER_SX), val[3] * (1.0f / PEER_SX)); *(v2u*)(pp + m * 16 + 4 * kq) = pw; }
            LDS_WAIT();
        }
    }
}

constexpr float PEER_CS = 64.0f;
__device__ __forceinline__ void peer_coef_phase(const Args& A, int lane, int wave, int vcu, int G) {
    const bf16* PART = (const bf16*)(A.ws + WS_PART); const float* GATE = (const float*)(A.ws + WS_GATE); const float* RSTD = (const float*)(A.ws + WS_RSTD);
    unsigned char* C8 = A.ws + WS_COEF;
    for (int tok = vcu * NWAVES + wave; tok < NTOK; tok += G * NWAVES) {
        const bf16* pp = PART + (size_t)tok * 1024 + 2 * lane;
        unsigned pw[8];
#pragma unroll
        for (int j = 0; j < 8; ++j) pw[j] = *(const unsigned*)(pp + j * 128);
        f32x2 d = (f32x2){bf_lo(pw[0]), bf_hi(pw[0])};
#pragma unroll
        for (int j = 1; j < 8; ++j) d += (f32x2){bf_lo(pw[j]), bf_hi(pw[j])};
        const float sc = RSTD[tok] * (1.0f / PEER_SU); const f32x2 gt = *(const f32x2*)(GATE + (size_t)tok * 128 + 2 * lane);
        f32x2 cf; cf.x = gt.x * gelu_tanh(d.x * sc) * (PEER_CS / PEER_SV); cf.y = gt.y * gelu_tanh(d.y * sc) * (PEER_CS / PEER_SV);
        const unsigned hi = (unsigned)__builtin_amdgcn_cvt_pk_fp8_f32(cf.x, cf.y, 0, false) & 0xffffu;
        const f32x2 bk = __builtin_amdgcn_cvt_pk_f32_fp8(hi, false);
        const unsigned lo = (unsigned)__builtin_amdgcn_cvt_pk_fp8_f32((cf.x - bk.x) * 16.0f, (cf.y - bk.y) * 16.0f, 0, false) & 0xffffu;
        *(unsigned short*)(C8 + (size_t)tok * 256 + 2 * lane) = (unsigned short)hi; *(unsigned short*)(C8 + (size_t)tok * 256 + 128 + 2 * lane) = (unsigned short)lo;
    }
}

typedef int v2i_t __attribute__((ext_vector_type(2)));
__device__ __forceinline__ void peer_v_phase(const Args& A, LAS unsigned char* lds, int tid, int lane, int wave, gu32* ctl) {
    const unsigned char* Vq = A.ws + WS_VB;
    const unsigned short* EIDX = (const unsigned short*)(A.ws + WS_EIDX); const unsigned char* C8 = A.ws + WS_COEF;
    float* X1 = A.out + O_Y; float* SS2 = (float*)(A.ws + WS_SS2); const bf16* XGv = (const bf16*)(A.ws + WS_A1);
    const int xcc = (int)(xb_xcc_id() & 7u), rg = lane >> 3, c8 = lane & 7, m = lane & 15, kq = lane >> 4;
    LAS int* we = (LAS int*)(lds + wave * 1024);
    LAS unsigned char* tile = lds + U_TILE0 + wave * U_TILEB;
    const int ch_e = ((c8 - (rg >> 1)) & 7) * 16, ch_o = ((c8 - 4 - (rg >> 1)) & 7) * 16;
    const int tr_r = (lane & 15) >> 1, tr_p = lane & 1, tr_rot = 4 * (kq & 1) + (tr_r >> 1);
    const int tbase = (8 * kq + tr_r) * 128 + 8 * tr_p;
    int toff[8];
#pragma unroll
    for (int j = 0; j < 8; ++j) toff[j] = tbase + ((j + tr_rot) & 7) * 16;
    int qs = 0, slice, item;
    while (peer_next_item(ctl + CW_QV, xcc, qs, slice, item, lds, tid)) {
        const unsigned char* vs = Vq + (size_t)slice * 16384 * 128;
        size_t tok = (size_t)(item * PEER_ITEM + wave);
        unsigned pair = *(const unsigned*)(EIDX + tok * 128 + 2 * lane);
        v2u cfr[4];
#pragma unroll
        for (int ks = 0; ks < 4; ++ks) cfr[ks] = *(const v2u*)(C8 + tok * 256 + (m & 1) * 128 + ks * 32 + kq * 8);
        const float rga = 1.0f / A.in[I_N2G][slice * 128 + lane], rgb = 1.0f / A.in[I_N2G][slice * 128 + 64 + lane];
        unsigned short xoa = XGv[tok * DM + slice * 128 + lane], xob = XGv[tok * DM + slice * 128 + 64 + lane];
        we[2 * lane] = (int)(pair & 0xffffu); we[2 * lane + 1] = (int)(pair >> 16);
        LDS_WAIT();
        v4u w[16];
#pragma unroll
        for (int it = 0; it < 16; ++it) w[it] = *(const v4u*)(vs + (unsigned)(((unsigned)we[it * 8 + rg] << 7) + (unsigned)((it & 1) ? ch_o : ch_e)));
        for (int tt = 0; tt < PEER_ITEM / NWAVES; ++tt) {
            const size_t ctok = tok; const bool more = tt + 1 < PEER_ITEM / NWAVES;
            i64_t af[4];
#pragma unroll
            for (int ks = 0; ks < 4; ++ks) af[ks] = mk64(cfr[ks].x, cfr[ks].y);
            const float xa = __uint_as_float((unsigned)xoa << 16) * rga, xb = __uint_as_float((unsigned)xob << 16) * rgb;
            if (more) { tok += NWAVES; pair = *(const unsigned*)(EIDX + tok * 128 + 2 * lane);
#pragma unroll
                for (int ks = 0; ks < 4; ++ks) cfr[ks] = *(const v2u*)(C8 + tok * 256 + (m & 1) * 128 + ks * 32 + kq * 8);
                xoa = XGv[tok * DM + slice * 128 + lane]; xob = XGv[tok * DM + slice * 128 + 64 + lane]; }
#pragma unroll
            for (int it = 0; it < 16; ++it) *(LAS v4u*)(tile + it * 1024 + lane * 16) = w[it];
            if (more) {
                we[2 * lane] = (int)(pair & 0xffffu); we[2 * lane + 1] = (int)(pair >> 16);
                LDS_WAIT();
#pragma unroll
                for (int it = 0; it < 16; ++it) w[it] = *(const v4u*)(vs + (unsigned)(((unsigned)we[it * 8 + rg] << 7) + (unsigned)((it & 1) ? ch_o : ch_e)));
            } else LDS_WAIT();
            f32x4 acc[8];
#pragma unroll
            for (int hf = 0; hf < 2; ++hf) {
                v2i_t b[4][4];
#pragma unroll
                for (int j4 = 0; j4 < 4; ++j4)
#pragma unroll
                    for (int ks = 0; ks < 4; ++ks) b[j4][ks] = __builtin_amdgcn_ds_read_tr8_b64_v2i32((LAS v2i_t*)(tile + ks * 4096 + toff[hf * 4 + j4]));
#pragma unroll
                for (int j4 = 0; j4 < 4; ++j4) acc[hf * 4 + j4] = (f32x4){0.f, 0.f, 0.f, 0.f};
#pragma unroll
                for (int ks = 0; ks < 4; ++ks)
#pragma unroll
                    for (int j4 = 0; j4 < 4; ++j4) acc[hf * 4 + j4] = __builtin_amdgcn_mfma_f32_16x16x32_fp8_fp8(af[ks], mk64((unsigned)b[j4][ks].x, (unsigned)b[j4][ks].y), acc[hf * 4 + j4], 0, 0, 0);
            }
            float h0 = acc[0][0], l0 = acc[0][1], h1 = acc[4][0], l1 = acc[4][1];
#pragma unroll
            for (int j = 1; j < 4; ++j) { const bool s = kq == j; h0 = s ? acc[j][0] : h0; l0 = s ? acc[j][1] : l0; h1 = s ? acc[4 + j][0] : h1; l1 = s ? acc[4 + j][1] : l1; }
            const float x2a = xa + (h0 + l0 * (1.0f / 16.0f)) * (1.0f / PEER_CS), x2b = xb + (h1 + l1 * (1.0f / 16.0f)) * (1.0f / PEER_CS);
            { bf16* xr_ = (bf16*)X1 + ctok * (2 * DM) + slice * 128 + lane;
              xr_[0] = (bf16)(cvt_pk_bf16(x2a, x2a) & 0xffffu); xr_[64] = (bf16)(cvt_pk_bf16(x2b, x2b) & 0xffffu); }
            float ss = sum16(x2a * x2a + x2b * x2b); ss += __shfl_xor(ss, 16); ss += __shfl_xor(ss, 32);
            if (lane == 0) SS2[ctok * 8 + slice] = ss;
            LDS_WAIT();
        }
    }
}

__device__ __forceinline__ void peer_final_phase(const Args& A, int lane, int wave, int vcu, int G) {
    float* X1 = A.out + O_Y; const float* SS2 = (const float*)(A.ws + WS_SS2); const float* gf = A.in[I_NFG] + lane * 16;
    const f32x4 g0 = *(const f32x4*)gf, g1 = *(const f32x4*)(gf + 4), g2 = *(const f32x4*)(gf + 8), g3 = *(const f32x4*)(gf + 12);
    for (int tok = vcu * NWAVES + wave; tok < NTOK; tok += G * NWAVES) {
        const f32x4 sa = *(const f32x4*)(SS2 + (size_t)tok * 8), sb = *(const f32x4*)(SS2 + (size_t)tok * 8 + 4);
        const float ss = ((sa[0] + sa[1]) + (sa[2] + sa[3])) + ((sb[0] + sb[1]) + (sb[2] + sb[3]));
        const float rf = 1.0f / sqrtf(ss * (1.f / DM) + 1e-6f);
        float* yr = X1 + (size_t)tok * DM + lane * 16;
        const v4u s0 = *(const v4u*)((const bf16*)(X1 + (size_t)tok * DM) + lane * 16), s1 = *(const v4u*)((const bf16*)(X1 + (size_t)tok * DM) + lane * 16 + 8);
        const f32x4 y0 = (f32x4){bf_lo(s0.x), bf_hi(s0.x), bf_lo(s0.y), bf_hi(s0.y)}, y1 = (f32x4){bf_lo(s0.z), bf_hi(s0.z), bf_lo(s0.w), bf_hi(s0.w)},
                    y2 = (f32x4){bf_lo(s1.x), bf_hi(s1.x), bf_lo(s1.y), bf_hi(s1.y)}, y3 = (f32x4){bf_lo(s1.z), bf_hi(s1.z), bf_lo(s1.w), bf_hi(s1.w)};
        *(f32x4*)yr = y0 * rf * g0; *(f32x4*)(yr + 4) = y1 * rf * g1; *(f32x4*)(yr + 8) = y2 * rf * g2; *(f32x4*)(yr + 12) = y3 * rf * g3;
    }
}

__device__ __forceinline__ void sg_partial(const bf16* Ap, int lda, const bf16* Bp, int ldb, LAS f32x4* red, int lane, int wave) {
    const int fr = lane & 15, fq = lane >> 4;
    bf16x8 a[2][4], b[4][4];
#pragma unroll
    for (int mi = 0; mi < 2; ++mi)
#pragma unroll
        for (int ks = 0; ks < 4; ++ks) a[mi][ks] = *(const bf16x8*)(Ap + (size_t)(16 * mi + fr) * lda + 32 * ks + 8 * fq);
#pragma unroll
    for (int nj = 0; nj < 4; ++nj)
#pragma unroll
        for (int ks = 0; ks < 4; ++ks) b[nj][ks] = *(const bf16x8*)(Bp + (size_t)(16 * nj + fr) * ldb + 32 * ks + 8 * fq);
    f32x4 acc[2][4];
#pragma unroll
    for (int mi = 0; mi < 2; ++mi)
#pragma unroll
        for (int nj = 0; nj < 4; ++nj) acc[mi][nj] = (f32x4){0.f, 0.f, 0.f, 0.f};
#pragma unroll
    for (int ks = 0; ks < 4; ++ks)
#pragma unroll
        for (int mi = 0; mi < 2; ++mi)
#pragma unroll
            for (int nj = 0; nj < 4; ++nj) acc[mi][nj] = __builtin_amdgcn_mfma_f32_16x16x32_bf16(b[nj][ks], a[mi][ks], acc[mi][nj], 0, 0, 0);
#pragma unroll
    for (int mi = 0; mi < 2; ++mi)
#pragma unroll
        for (int nj = 0; nj < 4; ++nj) red[(wave * 8 + mi * 4 + nj) * 64 + lane] = acc[mi][nj];
}
__device__ __forceinline__ f32x4 sg_sum(const LAS f32x4* red, int w0, int nw, int wave, int lane) {
    f32x4 s = red[(w0 * 8 + wave) * 64 + lane];
    for (int w = 1; w < nw; ++w) s += red[((w0 + w) * 8 + wave) * 64 + lane];
    return s;
}
__device__ __forceinline__ void sample_gemm2(const Args& A, LAS unsigned char* lds, int t, int lane, int wave) {
    unsigned char* ws = A.ws; const int fr = lane & 15, fq = lane >> 4;
    const int row0 = NPROMPT + (t >> 4) * 32, col0 = (t & 15) * 64;
    LAS f32x4* red = (LAS f32x4*)lds;
    const bf16* Ab = (const bf16*)(ws + WS_A1) + (wave >= 4 ? (size_t)MPAD * 512 : 0); const bf16* Bb = (const bf16*)(ws + (wave >= 4 ? WS_WPB : WS_WPA));
    sg_partial(Ab + (size_t)row0 * 512 + (wave & 3) * 128, 512, Bb + (size_t)col0 * 512 + (wave & 3) * 128, 512, red, lane, wave);
    const int row = row0 + 16 * (wave >> 2) + fr, c = col0 + 16 * (wave & 3) + 4 * fq;
    const bf16* Zg = (const bf16*)(ws + WS_ZG) + (size_t)row * 2048;
    const v2u ga = *(const v2u*)(Zg + c), gb = *(const v2u*)(Zg + 1024 + c);
    __syncthreads();
    const f32x4 pa = sg_sum(red, 0, 4, wave, lane), pb = sg_sum(red, 4, 4, wave, lane);
    const float o0 = sigm(bf_lo(ga.x)) * pa[0] + sigm(bf_lo(gb.x)) * pb[0], o1 = sigm(bf_hi(ga.x)) * pa[1] + sigm(bf_hi(gb.x)) * pb[1],
                o2 = sigm(bf_lo(ga.y)) * pa[2] + sigm(bf_lo(gb.y)) * pb[2], o3 = sigm(bf_hi(ga.y)) * pa[3] + sigm(bf_hi(gb.y)) * pb[3];
    v2u w; w.x = cvt_pk_bf16(o0, o1); w.y = cvt_pk_bf16(o2, o3); *(v2u*)((bf16*)(ws + WS_ZR) + (size_t)row * 1024 + c) = w;
    __syncthreads();
}
__device__ __forceinline__ void sample_gemm3(const Args& A, LAS unsigned char* lds, int t, int tid, int lane, int wave) {
    unsigned char* ws = A.ws; const int fr = lane & 15, fq = lane >> 4;
    const int row0 = NPROMPT + (t >> 4) * 32, col0 = (t & 15) * 64;
    LAS f32x4* red = (LAS f32x4*)lds; LAS float* ssl = (LAS float*)(lds + 65536);
    sg_partial((const bf16*)(ws + WS_ZR) + (size_t)row0 * 1024 + wave * 128, 1024, (const bf16*)(ws + WS_WO) + (size_t)col0 * 1024 + wave * 128, 1024, red, lane, wave);
    const int row = row0 + 16 * (wave >> 2) + fr, c = col0 + 16 * (wave & 3) + 4 * fq;
    const f32x4 xv = *(const f32x4*)(A.in[I_XS] + (size_t)(row - NPROMPT) * 1024 + c), q = *(const f32x4*)(A.in[I_N2G] + c);
    __syncthreads();
    const f32x4 o = xv + sg_sum(red, 0, 8, wave, lane);
    float ss = (o[0] * o[0] + o[1] * o[1]) + (o[2] * o[2] + o[3] * o[3]);
    v2u w; w.x = cvt_pk_bf16(o[0] * q[0], o[1] * q[1]); w.y = cvt_pk_bf16(o[2] * q[2], o[3] * q[3]); *(v2u*)((bf16*)(ws + WS_A1) + (size_t)row * 1024 + c) = w;
    ss += __shfl_xor(ss, 16); ss += __shfl_xor(ss, 32);
    if (fq == 0) ssl[wave * 16 + fr] = ss;
    __syncthreads();
    if (tid < 32) { const int mi = tid >> 4, r = tid & 15;
        ((float*)(ws + WS_SSP))[(size_t)(row0 + tid) * 16 + (t & 15)] = (ssl[(mi * 4 + 0) * 16 + r] + ssl[(mi * 4 + 1) * 16 + r]) + (ssl[(mi * 4 + 2) * 16 + r] + ssl[(mi * 4 + 3) * 16 + r]); }
}
__device__ __forceinline__ void sample_gemm4(const Args& A, LAS unsigned char* lds, int t, int lane, int wave) {
    unsigned char* ws = A.ws; const int fr = lane & 15, fq = lane >> 4;
    const int row0 = NPROMPT + (t >> 5) * 32, col0 = (t & 31) * 64;
    LAS f32x4* red = (LAS f32x4*)lds;
    sg_partial((const bf16*)(ws + WS_A1) + (size_t)row0 * 1024 + wave * 128, 1024, (const bf16*)(ws + WS_WQ) + (size_t)col0 * 1024 + wave * 128, 1024, red, lane, wave);
    const int row = row0 + 16 * (wave >> 2) + fr, c = col0 + 16 * (wave & 3) + 4 * fq;
    __syncthreads();
    const f32x4 o = sg_sum(red, 0, 8, wave, lane);
    v2u w; w.x = cvt_pk_bf16(o[0], o[1]); w.y = cvt_pk_bf16(o[2], o[3]); *(v2u*)((bf16*)(ws + WS_ZG) + (size_t)row * 2048 + c) = w;
    __syncthreads();
}

__global__ void __launch_bounds__(NTHR, 2) mk_fwd(Args args) {
    extern __shared__ __attribute__((aligned(16))) unsigned char lds_raw[];
    LAS unsigned char* lds = (LAS unsigned char*)lds_raw;
    const int tid = threadIdx.x, lane = tid & 63, wave = __builtin_amdgcn_readfirstlane(tid >> 6);
    const int G = gridDim.x; const int bx = blockIdx.x; const int vcu = (G % 8 == 0) ? (bx % 8) * (G / 8) + bx / 8 : bx;
    gu32* ctl = (gu32*)(args.ws + WS_CTL);
    volatile LAS unsigned* MISC = (volatile LAS unsigned*)(lds + MISC_OFF);
    for (int u = tid; u < (LDS_BYTES - LDSCTL_OFF) / 4; u += NTHR) ((LAS unsigned*)(lds + LDSCTL_OFF))[u] = 0u;
    __syncthreads();
    XcdBarrier bar; bar.bar = (unsigned*)(ctl + CW_BAR) + args.li * XCD_BAR_WORDS; bar.x = 0; bar.st = nullptr;
    if (N_LAUNCHES != PER_PHASE) bar = xcd_barrier_post((unsigned*)(ctl + CW_BAR) + args.li * XCD_BAR_WORDS, MISC + 8);
    const int lo = args.ph_lo, hi = args.ph_hi;
#define IN(k) (lo <= (k) && (k) < hi)
#define BOTH(k) (IN(k) && IN((k) + 1))
#define GRID_BAR() do { if (N_LAUNCHES != PER_PHASE) xcd_barrier(bar); } while (0)
    unsigned char* ws = args.ws;
    bf16* A1 = (bf16*)(ws + WS_A1);

    if (IN(0)) for (int rep_ = 0; rep_ < ((MK_REPEAT == 0) ? 2 : 1); ++rep_) { p0_prologue(args, lds, tid, lane, wave, vcu, G); if (BOTH(0)) GRID_BAR(); }

    if (IN(1)) for (int rep_ = 0; rep_ < ((MK_REPEAT == 1) ? 2 : 1); ++rep_) {
        pg8::Gemm g{A1, (const bf16*)(ws + WS_W1T), MPAD, N1, DM}; pg8::StaticOrder S; S.init(MPAD, N1, G, bx);
        pg8::EpiZ E{(bf16*)(ws + WS_ZC), (bf16*)(ws + WS_ZR), (bf16*)(ws + WS_ZG)};
        pg8::gemm_phase<pg8::EpiZ, pg8::StaticOrder, true, true>(lds, g, S, E);
        if (BOTH(1)) GRID_BAR();
    }

    if (IN(2)) for (int rep_ = 0; rep_ < ((MK_REPEAT == 2) ? 2 : 1); ++rep_) { conv_phase(args, vcu * NTHR + tid, G * NTHR); if (BOTH(2)) GRID_BAR(); }

    if (IN(3)) for (int rep_ = 0; rep_ < ((MK_REPEAT == 3) ? 2 : 1); ++rep_) {
        scan_pass1(args, lds, tid, lane, wave, vcu, G, (MK_REPEAT == 3 && rep_ == 0) ? 1 : 0);
        if (BOTH(3)) GRID_BAR();
    }

    if (IN(4)) {
        for (int u = vcu; u < 512; u += G) {
            if (u < 256) { const int bh = u >> 2, vq = u & 3; scan_pass2_rows(nullptr, bh * 64, 64, vq * 16, args.out + O_WKV_P + (size_t)bh * 4096, true, args, lds, tid, lane, wave); }
            else { const int bh = u - 256; scan_pass2_sample(args.in[I_SWKV] + (size_t)bh * 4096, NUNITS_P + bh, args.out + O_WKV_S + (size_t)bh * 4096, args, lane, wave); }
        }
        if (BOTH(4)) GRID_BAR();
    }

    if (IN(5)) for (int rep_ = 0; rep_ < ((MK_REPEAT == 5) ? 2 : 1); ++rep_) {
        for (int u2 = vcu; u2 < NUNITS / 2; u2 += G) scan_pass3_wave(args, u2 * 2 + (wave >> 2), wave & 3, lane);
        if (BOTH(5)) GRID_BAR();
    }

    if (IN(6)) {
        { pg8::Gemm g{A1, (const bf16*)(ws + WS_WPA), NPROMPT, DM, 512}; pg8::StaticOrder S; S.init(NPROMPT, DM, G, bx);
          pg8::EpiGate<0> E{(const bf16*)(ws + WS_ZG), (bf16*)(ws + WS_ZR)};
          pg8::gemm_phase<pg8::EpiGate<0>, pg8::StaticOrder, true, true>(lds, g, S, E); }
        { pg8::Gemm g{A1 + (size_t)MPAD * 512, (const bf16*)(ws + WS_WPB), NPROMPT, DM, 512}; pg8::StaticOrder S; S.init(NPROMPT, DM, G, bx);
          pg8::EpiGate<1> E{(const bf16*)(ws + WS_ZG), (bf16*)(ws + WS_ZR)};
          pg8::gemm_phase<pg8::EpiGate<1>, pg8::StaticOrder, true, true>(lds, g, S, E); }
        for (int t = vcu; t < 256; t += G) sample_gemm2(args, lds, t, lane, wave);
        if (BOTH(6)) GRID_BAR();
    }

    if (IN(7)) for (int rep_ = 0; rep_ < ((MK_REPEAT == 7) ? 2 : 1); ++rep_) {
        pg8::Gemm g{(const bf16*)(ws + WS_ZR), (const bf16*)(ws + WS_WO), NPROMPT, DM, DM}; pg8::StaticOrder S; S.init(NPROMPT, DM, G, bx);
        pg8::EpiX1 E{args.in[I_XP], args.in[I_XS], args.out + O_Y, A1, (float*)(ws + WS_SSP), args.in[I_N2G], NPROMPT, NTOK};
        pg8::gemm_phase<pg8::EpiX1, pg8::StaticOrder, true, true>(lds, g, S, E);
        for (int t = vcu; t < 256; t += G) sample_gemm3(args, lds, t, tid, lane, wave);
        if (BOTH(7)) GRID_BAR();
    }

    if (IN(8)) for (int rep_ = 0; rep_ < ((MK_REPEAT == 8) ? 2 : 1); ++rep_) {
        pg8::Gemm g{A1, (const bf16*)(ws + WS_WQ), NPROMPT, 2048, DM}; pg8::StaticOrder S; S.init(NPROMPT, 2048, G, bx);
        pg8::EpiPlain E{(bf16*)(ws + WS_ZG), 2048};
        pg8::gemm_phase<pg8::EpiPlain, pg8::StaticOrder, true, true>(lds, g, S, E);
        for (int t = vcu; t < 512; t += G) sample_gemm4(args, lds, t, lane, wave);
        if (BOTH(8)) GRID_BAR();
    }

    if (IN(9)) for (int rep_ = 0; rep_ < ((MK_REPEAT == 9) ? 2 : 1); ++rep_) { peer_topk_phase(args, lds, tid, lane, wave, vcu, G); if (BOTH(9)) GRID_BAR(); }
    if (IN(10)) for (int rep_ = 0; rep_ < ((MK_REPEAT == 10) ? 2 : 1); ++rep_) { if (rep_ == 0) peer_topk_sample_prelude(args, lds, tid, lane, wave, vcu, G, ctl); peer_u_phase(args, lds, tid, lane, wave, ctl, rep_ * 1024); if (BOTH(10)) GRID_BAR(); }
    if (IN(11)) { peer_coef_phase(args, lane, wave, vcu, G); if (BOTH(11)) GRID_BAR(); }
    if (IN(12)) { peer_v_phase(args, lds, tid, lane, wave, ctl); if (BOTH(12)) GRID_BAR(); }
    if (IN(13)) peer_final_phase(args, lane, wave, vcu, G);
#undef IN
#undef BOTH
#undef GRID_BAR
}

extern "C" void kernel_launch(void* const* d_in, const int* in_sizes, int n_in, void* d_out, int out_size, void* d_ws, size_t ws_size, hipStream_t stream) {
    static int grid = 0;
    if (grid == 0) {
        if (n_in != 32 || ws_size < WS_END) { fprintf(stderr, "kernel_launch: built for 32 inputs and >= %zu bytes of workspace; got n_in %d ws %zu; nothing launched\n", (size_t)WS_END, n_in, ws_size); grid = -1; return; }
        int dev = 0, cus = 0, per_cu = 0;
        if (hipGetDevice(&dev) != hipSuccess || hipDeviceGetAttribute(&cus, hipDeviceAttributeMultiprocessorCount, dev) != hipSuccess) { fprintf(stderr, "kernel_launch: device query failed\n"); grid = -1; return; }
        if (hipFuncSetAttribute((const void*)mk_fwd, hipFuncAttributeMaxDynamicSharedMemorySize, LDS_BYTES) != hipSuccess) { fprintf(stderr, "kernel_launch: hipFuncSetAttribute failed\n"); grid = -1; return; }
        if (hipOccupancyMaxActiveBlocksPerMultiprocessor(&per_cu, (const void*)mk_fwd, NTHR, LDS_BYTES) != hipSuccess || per_cu < 1)
            fprintf(stderr, "kernel_launch: note: occupancy query reports %d workgroups per CU\n", per_cu);
        (void)hipGetLastError();
        grid = cus;
    }
    if (grid < 0) return;
    if (hipMemsetAsync((char*)d_ws + WS_CTL, 0, CTL_ZERO_BYTES, stream) != hipSuccess) { fprintf(stderr, "kernel_launch: hipMemsetAsync failed\n"); return; }
    Args a{};
    for (int i = 0; i < 32; ++i) a.in[i] = (const float*)d_in[i];
    a.out = (float*)d_out; a.ws = (unsigned char*)d_ws;
    constexpr int NL = (N_LAUNCHES == PER_PHASE ? PER_PHASE : 1) + ((MK_EXTRA_LO >= 0) ? 1 : 0);
    for (int li = 0; li < NL; ++li) {
        if (N_LAUNCHES == PER_PHASE) { a.ph_lo = li; a.ph_hi = li + 1; } else { a.ph_lo = 0; a.ph_hi = PER_PHASE; }
        if (MK_EXTRA_LO >= 0 && li == NL - 1) { a.ph_lo = MK_EXTRA_LO; a.ph_hi = MK_EXTRA_HI; }
        a.li = li;
        hipLaunchKernelGGL(mk_fwd, dim3(grid), dim3(NTHR), LDS_BYTES, stream, a);
        const hipError_t le = hipPeekAtLastError();
        if (le != hipSuccess) { fprintf(stderr, "kernel_launch: launch %d failed: %s\n", li, hipGetErrorName(le)); break; }
    }
}
```

```cpp
#include <hip/hip_runtime.h>
#include <cstdio>
#include <cstdint>
#define MK_N_LAUNCHES 1
#define MK_REPEAT -1
#define MK_DBGSEL 0
#define MK_EXTRA_LO -1
#define MK_EXTRA_HI -1
namespace pg8 {
#define PG8_LAS __attribute__((address_space(3)))
typedef unsigned short bf16_t;
typedef short bf16x8 __attribute__((ext_vector_type(8)));
typedef float f32x4 __attribute__((ext_vector_type(4)));
typedef unsigned u32x4 __attribute__((ext_vector_type(4)));
constexpr int BM = 256, BK = 64, HALF = 128, HTB = HALF * BK * 2  , STAGE_BYTES = 8 * HTB, NXCD = 8, WGM = 8;

__host__ __device__ __forceinline__ int lds_byte(int r, int c) { const int st = (r >> 4) * 2 + (c >> 5), rr = r & 15, cc = c & 31, ob = rr * 64 + cc * 2; return st * 1024 + (ob ^ (((ob >> 9) & 1) << 5)); }
__host__ __device__ __forceinline__ void stage_rc(int b, int& R, int& C) { const int st = b / 1024, sb = b % 1024, swz = sb ^ (((sb >> 9) & 1) << 5); R = (st >> 1) * 16 + swz / 64; C = (st & 1) * 32 + (swz % 64) / 2; }
__host__ __device__ __forceinline__ int perm32(int rho) { const int n = rho >> 4, i = rho & 15; return 8 * (i >> 2) + 4 * n + (i & 3); }

struct Unit { int pm, pn; };
struct Gemm { const bf16_t* A; const bf16_t* Bt; int M, N, K; };

struct StaticOrder {
    int nM, nN, nwg, G, c;
    __host__ __device__ void init(int M, int N, int G_, int c_) { nM = M / BM; nN = N / BM; nwg = nM * nN; G = G_; c = c_; }
    __host__ __device__ bool next(int i, Unit& u) const {
        const long L = (long)i * G + c; if (L >= nwg) return false;
        int wgid = (int)L; { const int q = nwg / NXCD, r = nwg % NXCD, xcd = wgid % NXCD, off = wgid / NXCD; wgid = (xcd < r ? xcd * (q + 1) : r * (q + 1) + (xcd - r) * q) + off; }
        const int nig = WGM * nN, gid = wgid / nig, fm = gid * WGM, gsz = (nM - fm) < WGM ? (nM - fm) : WGM;
        u.pm = fm + ((wgid % nig) % gsz); u.pn = (wgid % nig) / gsz; return true;
    }
    __device__ __forceinline__ void a_ready(const Unit&) const {}
    __device__ __forceinline__ void done(const Unit&) const {}
};

typedef __bf16 bf16x2_cv __attribute__((ext_vector_type(2))); typedef float f32x2_cv __attribute__((ext_vector_type(2)));
__device__ __forceinline__ unsigned cvt_pk_bf16(float lo, float hi) { return __builtin_bit_cast(unsigned, __builtin_convertvector((f32x2_cv){lo, hi}, bf16x2_cv)); }
__device__ __forceinline__ float bf_lo(unsigned w) { return __uint_as_float(w << 16); }
__device__ __forceinline__ float bf_hi(unsigned w) { return __uint_as_float(w & 0xffff0000u); }
__device__ __forceinline__ float sigm(float x) { return __builtin_amdgcn_rcpf(1.0f + __expf(-x)); }

struct EpiZ {
    static constexpr bool PERM = true, AFTER_DRAIN = false;
    bf16_t *Zc, *Zr, *Zg;
    __device__ __forceinline__ void operator()(const f32x4 (&acc)[2][2][4][2], const Unit& u, int wr, int wc, int fr, int fq) const {
        typedef unsigned u32x2e __attribute__((ext_vector_type(2)));
        const int row0 = u.pm * BM + wr * 64 + fr;
        if (u.pn >= 2 && u.pn < 6) {
#pragma unroll
            for (int ai = 0; ai < 2; ++ai)
#pragma unroll
                for (int m = 0; m < 4; ++m) { bf16_t* rowp = Zc + (size_t)(row0 + ai * HALF + m * 16) * 1024 + 512 + (u.pn - 2) * 128 + wc * 16 + 4 * fq;
#pragma unroll
                    for (int bj = 0; bj < 2; ++bj) { const f32x4 v0 = acc[ai][bj][m][0], v1 = acc[ai][bj][m][1];
                        u32x2e w; w.x = cvt_pk_bf16(v0[0] * v0[1], v0[2] * v0[3]); w.y = cvt_pk_bf16(v1[0] * v1[1], v1[2] * v1[3]);
                        *(u32x2e*)(rowp + bj * 64) = w; } }
            return;
        }
        bf16_t* base; int ldc, colt;
        if (u.pn < 2) { base = Zc; ldc = 1024; colt = u.pn * BM; }
        else if (u.pn < 14) { base = Zr; ldc = 2048; colt = (u.pn - 6) * BM; }
        else { base = Zg; ldc = 2048; colt = (u.pn - 14) * BM; }
        const int col0 = colt + wc * 32 + 8 * fq;
#pragma unroll
        for (int ai = 0; ai < 2; ++ai)
#pragma unroll
            for (int m = 0; m < 4; ++m) { bf16_t* rowp = base + (size_t)(row0 + ai * HALF + m * 16) * ldc + col0;
#pragma unroll
                for (int bj = 0; bj < 2; ++bj) { const f32x4 v0 = acc[ai][bj][m][0], v1 = acc[ai][bj][m][1];
                    u32x4 w; w.x = cvt_pk_bf16(v0[0], v0[1]); w.y = cvt_pk_bf16(v0[2], v0[3]); w.z = cvt_pk_bf16(v1[0], v1[1]); w.w = cvt_pk_bf16(v1[2], v1[3]);
                    *(u32x4*)(rowp + bj * HALF) = w; } }
    }
};
struct EpiPlain {
    static constexpr bool PERM = true, AFTER_DRAIN = false;
    bf16_t* O; int ldc;
    __device__ __forceinline__ void operator()(const f32x4 (&acc)[2][2][4][2], const Unit& u, int wr, int wc, int fr, int fq) const {
        const int row0 = u.pm * BM + wr * 64 + fr, col0 = u.pn * BM + wc * 32 + 8 * fq;
#pragma unroll
        for (int ai = 0; ai < 2; ++ai)
#pragma unroll
            for (int m = 0; m < 4; ++m) { bf16_t* rowp = O + (size_t)(row0 + ai * HALF + m * 16) * ldc + col0;
#pragma unroll
                for (int bj = 0; bj < 2; ++bj) { const f32x4 v0 = acc[ai][bj][m][0], v1 = acc[ai][bj][m][1];
                    u32x4 w; w.x = cvt_pk_bf16(v0[0], v0[1]); w.y = cvt_pk_bf16(v0[2], v0[3]); w.z = cvt_pk_bf16(v1[0], v1[1]); w.w = cvt_pk_bf16(v1[2], v1[3]);
                    *(u32x4*)(rowp + bj * HALF) = w; } }
    }
};
template <int SECOND> struct EpiGate {
    static constexpr bool PERM = true, AFTER_DRAIN = false;
    const bf16_t* Zg; bf16_t* MG;
    __device__ __forceinline__ void operator()(const f32x4 (&acc)[2][2][4][2], const Unit& u, int wr, int wc, int fr, int fq) const {
        const int row0 = u.pm * BM + wr * 64 + fr, col0 = u.pn * BM + wc * 32 + 8 * fq;
#pragma unroll
        for (int ai = 0; ai < 2; ++ai) {
            u32x4 gw[4][2], pw[4][2];
#pragma unroll
            for (int m = 0; m < 4; ++m) { const int r = row0 + ai * HALF + m * 16;
#pragma unroll
                for (int bj = 0; bj < 2; ++bj) { gw[m][bj] = *(const u32x4*)(Zg + (size_t)r * 2048 + SECOND * 1024 + col0 + bj * HALF);
                    if (SECOND) pw[m][bj] = *(const u32x4*)(MG + (size_t)r * 1024 + col0 + bj * HALF); } }
#pragma unroll
            for (int m = 0; m < 4; ++m) { const int r = row0 + ai * HALF + m * 16; bf16_t* op = MG + (size_t)r * 1024 + col0;
#pragma unroll
                for (int bj = 0; bj < 2; ++bj) { const u32x4 g = gw[m][bj]; f32x4 v0 = acc[ai][bj][m][0], v1 = acc[ai][bj][m][1];
                    v0[0] *= sigm(bf_lo(g.x)); v0[1] *= sigm(bf_hi(g.x)); v0[2] *= sigm(bf_lo(g.y)); v0[3] *= sigm(bf_hi(g.y));
                    v1[0] *= sigm(bf_lo(g.z)); v1[1] *= sigm(bf_hi(g.z)); v1[2] *= sigm(bf_lo(g.w)); v1[3] *= sigm(bf_hi(g.w));
                    if (SECOND) { const u32x4 p = pw[m][bj];
                        v0[0] += bf_lo(p.x); v0[1] += bf_hi(p.x); v0[2] += bf_lo(p.y); v0[3] += bf_hi(p.y);
                        v1[0] += bf_lo(p.z); v1[1] += bf_hi(p.z); v1[2] += bf_lo(p.w); v1[3] += bf_hi(p.w); }
                    u32x4 w; w.x = cvt_pk_bf16(v0[0], v0[1]); w.y = cvt_pk_bf16(v0[2], v0[3]); w.z = cvt_pk_bf16(v1[0], v1[1]); w.w = cvt_pk_bf16(v1[2], v1[3]);
                    *(u32x4*)(op + bj * HALF) = w; } }
        }
    }
};
struct EpiX1 {
    static constexpr bool PERM = false, AFTER_DRAIN = false;
    const float* xp; const float* xs; float* X1; bf16_t* X1B; float* SSP; const float* g2; int nprompt, nrows;
    __device__ __forceinline__ void operator()(const f32x4 (&acc)[2][2][4][2], const Unit& u, int wr, int wc, int fr, int fq) const {
        typedef unsigned u32x2v __attribute__((ext_vector_type(2)));
        const int col0 = u.pn * BM + wc * 32 + 4 * fq;
        f32x4 gq[2][2];
#pragma unroll
        for (int bj = 0; bj < 2; ++bj)
#pragma unroll
            for (int n = 0; n < 2; ++n) gq[bj][n] = *(const f32x4*)(g2 + col0 + bj * HALF + n * 16);
#pragma unroll
        for (int ai = 0; ai < 2; ++ai) {
            f32x4 xv[4][2][2];
#pragma unroll
            for (int m = 0; m < 4; ++m) { int r = u.pm * BM + ai * HALF + wr * 64 + m * 16 + fr; r = r < nrows ? r : nrows - 1;
                const float* xr = r < nprompt ? xp + (size_t)r * 1024 : xs + (size_t)(r - nprompt) * 1024;
#pragma unroll
                for (int bj = 0; bj < 2; ++bj)
#pragma unroll
                    for (int n = 0; n < 2; ++n) xv[m][bj][n] = *(const f32x4*)(xr + col0 + bj * HALF + n * 16); }
#pragma unroll
            for (int m = 0; m < 4; ++m) { const int r = u.pm * BM + ai * HALF + wr * 64 + m * 16 + fr; float ss = 0.f;
#pragma unroll
                for (int bj = 0; bj < 2; ++bj)
#pragma unroll
                    for (int n = 0; n < 2; ++n) { const int c = col0 + bj * HALF + n * 16; const f32x4 o = xv[m][bj][n] + acc[ai][bj][m][n];
                        ss += (o[0] * o[0] + o[1] * o[1]) + (o[2] * o[2] + o[3] * o[3]);
                        const f32x4 q = gq[bj][n]; u32x2v w; w.x = cvt_pk_bf16(o[0] * q[0], o[1] * q[1]); w.y = cvt_pk_bf16(o[2] * q[2], o[3] * q[3]);
                        if (r < nrows) *(u32x2v*)(X1B + (size_t)r * 1024 + c) = w; }
                ss += __shfl_xor(ss, 16); ss += __shfl_xor(ss, 32);
                if (fq == 0 && r < nrows) SSP[(size_t)r * 16 + u.pn * 4 + wc] = ss;
            }
        }
    }
};
template <class Epi, class Sched, bool ALIGN_EPI = false, bool SP2 = false>
__device__ __forceinline__ void gemm_phase(PG8_LAS unsigned char* lds, const Gemm g, const Sched& S, const Epi& E) {
    const int tid = threadIdx.x, wid = __builtin_amdgcn_readfirstlane(tid >> 6), lane = tid & 63, wr = wid >> 2, wc = wid & 3, fr = lane & 15, fq = lane >> 4;
    const int K = g.K, nt = K / BK;
    unsigned voffA[2], voffB[2];
#pragma unroll
    for (int i = 0; i < 2; ++i) { int R, C; stage_rc(tid * 16 + i * 8192, R, C); const int Rb = Epi::PERM ? ((R & ~31) + perm32(R & 31)) : R;
        voffA[i] = (unsigned)(R * K + C) * 2u; voffB[i] = (unsigned)(Rb * K + C) * 2u; }
    const size_t kstep = (size_t)(BK * 2);
    const size_t hstep = (size_t)HALF * K * 2;
    const size_t tstep = 2 * hstep;
    const unsigned ldsw = (unsigned)wid * 1024u;
    const int aoff = lds_byte(wr * 64 + fr, fq * 8), boff = lds_byte(wc * 32 + fr, fq * 8);
#define PG8_SA(b, h) (((b) * 2 + (h)) * HTB)
#define PG8_SB(b, h) ((4 + (b) * 2 + (h)) * HTB)
#define PG8_STAGE(bufoff, gbase, voff) do { _Pragma("unroll") for (int _i = 0; _i < 2; ++_i) \
        __builtin_amdgcn_global_load_lds((const unsigned*)((const char*)(gbase) + (voff)[_i]), (PG8_LAS unsigned*)(lds + (bufoff) + ldsw + _i * 8192), 16, 0, 0); } while (0)
#define PG8_LDA(dst, b, h) do { _Pragma("unroll") for (int m = 0; m < 4; ++m) _Pragma("unroll") for (int k = 0; k < 2; ++k) dst[m][k] = *(const PG8_LAS bf16x8*)(lds + PG8_SA(b, h) + aoff + m * 2048 + k * 1024); } while (0)
#define PG8_LDB(dst, b, h) do { _Pragma("unroll") for (int n = 0; n < 2; ++n) _Pragma("unroll") for (int k = 0; k < 2; ++k) dst[n][k] = *(const PG8_LAS bf16x8*)(lds + PG8_SB(b, h) + boff + n * 2048 + k * 1024); } while (0)
#define PG8_MMA(ai, bj, At, Bt) do { __builtin_amdgcn_s_setprio(1); _Pragma("unroll") for (int m = 0; m < 4; ++m) _Pragma("unroll") for (int n = 0; n < 2; ++n) _Pragma("unroll") for (int k = 0; k < 2; ++k) \
        acc[ai][bj][m][n] = __builtin_amdgcn_mfma_f32_16x16x32_bf16(Bt[n][k], At[m][k], acc[ai][bj][m][n], 0, 0, 0); __builtin_amdgcn_s_setprio(0); } while (0)
#define PG8_WAIT_V(n) asm volatile("s_waitcnt vmcnt(" #n ")" ::: "memory")
#define PG8_WAIT_L(n) asm volatile("s_waitcnt lgkmcnt(" #n ")" ::: "memory")
#define PG8_BAR __builtin_amdgcn_s_barrier()
#define PG8_SCHED __builtin_amdgcn_sched_barrier(0)
    Unit cur, nxt; int ui = 0;
    if (!S.next(0, cur)) return;
    f32x4 acc[2][2][4][2];
#pragma unroll
    for (int a = 0; a < 2; ++a)
#pragma unroll
        for (int b = 0; b < 2; ++b)
#pragma unroll
            for (int m = 0; m < 4; ++m)
#pragma unroll
                for (int n = 0; n < 2; ++n) acc[a][b][m][n] = (f32x4){0.f, 0.f, 0.f, 0.f};
    bf16x8 At[4][2], B0[2][2], B1[2][2];
    const char* cA = (const char*)g.A + (size_t)cur.pm * tstep; const char* cB = (const char*)g.Bt + (size_t)cur.pn * tstep;
    S.a_ready(cur);
    if constexpr (SP2) {
        PG8_STAGE(PG8_SB(0, 0), cB, voffB); PG8_STAGE(PG8_SB(0, 1), cB + hstep, voffB); PG8_STAGE(PG8_SA(0, 0), cA, voffA); PG8_STAGE(PG8_SA(0, 1), cA + hstep, voffA);
        if (wr == 1) PG8_BAR;
        PG8_WAIT_V(2); PG8_BAR;
        PG8_STAGE(PG8_SB(1, 0), cB + kstep, voffB); PG8_STAGE(PG8_SA(1, 0), cA + kstep, voffA); PG8_STAGE(PG8_SB(1, 1), cB + hstep + kstep, voffB);
        PG8_WAIT_V(6); PG8_BAR;
    } else {
        PG8_STAGE(PG8_SB(0, 0), cB, voffB); PG8_STAGE(PG8_SA(0, 0), cA, voffA); PG8_STAGE(PG8_SB(0, 1), cB + hstep, voffB); PG8_STAGE(PG8_SA(0, 1), cA + hstep, voffA);
        if (wr == 1) PG8_BAR;
        PG8_WAIT_V(4); PG8_BAR;
        PG8_STAGE(PG8_SB(1, 0), cB + kstep, voffB); PG8_STAGE(PG8_SA(1, 0), cA + kstep, voffA); PG8_STAGE(PG8_SB(1, 1), cB + hstep + kstep, voffB);
        PG8_WAIT_V(6); PG8_BAR;
    }
    for (;;) {
        const bool has_next = S.next(ui + 1, nxt);
        const char* nA = has_next ? (const char*)g.A + (size_t)nxt.pm * tstep : cA; const char* nB = has_next ? (const char*)g.Bt + (size_t)nxt.pn * tstep : cB;
        for (int t = 0; t < nt; t += 2) {
            const bool last = (t == nt - 2);
            const char* a1 = cA + (size_t)(t + 1) * kstep;
            const char* a2 = last ? nA : cA + (size_t)(t + 2) * kstep; const char* b2 = last ? nB : cB + (size_t)(t + 2) * kstep;
            const char* a3 = a2 + kstep; const char* b3 = b2 + kstep;
            if (last && has_next) S.a_ready(nxt);
            if constexpr (SP2) {
            PG8_LDB(B0, 0, 0); PG8_LDB(B1, 0, 1); PG8_SCHED; PG8_LDA(At, 0, 0); PG8_STAGE(PG8_SA(1, 1), a1 + hstep, voffA);
            PG8_WAIT_V(8); PG8_WAIT_L(0); PG8_BAR; PG8_MMA(0, 0, At, B0); PG8_MMA(0, 1, At, B1); PG8_BAR; PG8_SCHED;
            PG8_LDA(At, 0, 1); PG8_STAGE(PG8_SB(0, 0), b2, voffB); PG8_STAGE(PG8_SB(0, 1), b2 + hstep, voffB); PG8_STAGE(PG8_SA(0, 0), a2, voffA);
            PG8_WAIT_V(8); PG8_WAIT_L(0); PG8_BAR; PG8_MMA(1, 0, At, B0); PG8_MMA(1, 1, At, B1); PG8_BAR; PG8_SCHED;
            PG8_LDB(B0, 1, 0); PG8_LDB(B1, 1, 1); PG8_SCHED; PG8_LDA(At, 1, 0); PG8_STAGE(PG8_SA(0, 1), a2 + hstep, voffA);
            PG8_WAIT_V(8); PG8_WAIT_L(0); PG8_BAR; PG8_MMA(0, 0, At, B0); PG8_MMA(0, 1, At, B1); PG8_BAR; PG8_SCHED;
            PG8_LDA(At, 1, 1); PG8_STAGE(PG8_SB(1, 0), b3, voffB); PG8_STAGE(PG8_SB(1, 1), b3 + hstep, voffB); PG8_STAGE(PG8_SA(1, 0), a3, voffA);
            PG8_WAIT_V(8); PG8_WAIT_L(0); PG8_BAR; PG8_MMA(1, 0, At, B0); PG8_MMA(1, 1, At, B1); PG8_BAR; PG8_SCHED;
            } else {
            PG8_LDB(B0, 0, 0); PG8_SCHED; PG8_LDA(At, 0, 0); PG8_STAGE(PG8_SA(1, 1), a1 + hstep, voffA);
            PG8_WAIT_L(8); PG8_BAR; PG8_WAIT_L(0); PG8_MMA(0, 0, At, B0); PG8_BAR; PG8_SCHED;
            PG8_LDB(B1, 0, 1); PG8_STAGE(PG8_SB(0, 0), b2, voffB);
            PG8_BAR; PG8_WAIT_L(0); PG8_MMA(0, 1, At, B1); PG8_BAR;
            PG8_LDA(At, 0, 1); PG8_STAGE(PG8_SA(0, 0), a2, voffA);
            PG8_BAR; PG8_WAIT_L(0); PG8_MMA(1, 0, At, B0); PG8_BAR; PG8_SCHED;
            PG8_STAGE(PG8_SB(0, 1), b2 + hstep, voffB);
            PG8_WAIT_V(6); PG8_BAR; PG8_MMA(1, 1, At, B1); PG8_BAR;
            PG8_LDB(B0, 1, 0); PG8_SCHED; PG8_LDA(At, 1, 0); PG8_STAGE(PG8_SA(0, 1), a2 + hstep, voffA);
            PG8_WAIT_L(8); PG8_BAR; PG8_WAIT_L(0); PG8_MMA(0, 0, At, B0); PG8_BAR; PG8_SCHED;
            PG8_LDB(B1, 1, 1); PG8_STAGE(PG8_SB(1, 0), b3, voffB);
            PG8_BAR; PG8_WAIT_L(0); PG8_MMA(0, 1, At, B1); PG8_BAR;
            PG8_LDA(At, 1, 1); PG8_STAGE(PG8_SA(1, 0), a3, voffA);
            PG8_BAR; PG8_WAIT_L(0); PG8_MMA(1, 0, At, B0); PG8_BAR; PG8_SCHED;
            PG8_STAGE(PG8_SB(1, 1), b3 + hstep, voffB);
            PG8_WAIT_V(6); PG8_BAR; PG8_MMA(1, 1, At, B1); PG8_BAR;
            }
        }
        if constexpr (ALIGN_EPI) { if (wr == 0) PG8_BAR; }
        if constexpr (!Epi::AFTER_DRAIN) { E(acc, cur, wr, wc, fr, fq); S.done(cur); }
        if (!has_next) break;
#pragma unroll
        for (int a = 0; a < 2; ++a)
#pragma unroll
            for (int b = 0; b < 2; ++b)
#pragma unroll
                for (int m = 0; m < 4; ++m)
#pragma unroll
                    for (int n = 0; n < 2; ++n) acc[a][b][m][n] = (f32x4){0.f, 0.f, 0.f, 0.f};
        cur = nxt; cA = nA; cB = nB; ++ui;
        if constexpr (ALIGN_EPI) { if (wr == 1) PG8_BAR; }
    }
    PG8_WAIT_V(0);
    if constexpr (!ALIGN_EPI) { if (wr == 0) PG8_BAR; }
    PG8_BAR;
    if constexpr (Epi::AFTER_DRAIN) { E.fused(acc, cur, wr, wc, fr, fq, lds, wid, lane); S.done(cur); }
#undef PG8_SA
#undef PG8_SB
#undef PG8_STAGE
#undef PG8_LDA
#undef PG8_LDB
#undef PG8_MMA
#undef PG8_WAIT_V
#undef PG8_WAIT_L
#undef PG8_BAR
#undef PG8_SCHED
}
}
constexpr int NWAVES = 8, NTHR = 512;
#ifndef MK_N_LAUNCHES
#define MK_N_LAUNCHES 1
#endif
constexpr int PER_PHASE = 14;
constexpr int N_LAUNCHES = MK_N_LAUNCHES;

constexpr int DM = 1024, NPROMPT = 32768, NSAMP = 512, NTOK = 33280, NSHIFT = 32, MPAD = 33536, N1 = 5632;
constexpr int SEQ_P = 4096, SEQ_S = 16, NB_P = 8, NB_S = 32;
constexpr size_t O_Y = 0, O_CONV_P = 34078720, O_SHIFT_P = 34086912, O_WKV_P = 34095104, O_CONV_S = 34357248, O_SHIFT_S = 34390016, O_WKV_S = 34422784;
constexpr size_t KiB = 1024, MiB = 1u << 20;
constexpr size_t WS_CTL = 0, CTL_ZERO_BYTES = 64 * KiB;
constexpr size_t WS_W1T = 64 * KiB;
constexpr size_t WS_WPA = WS_W1T + (size_t)N1 * DM * 2;
constexpr size_t WS_WPB = WS_WPA + 1 * MiB;
constexpr size_t WS_WO = WS_WPB + 1 * MiB;
constexpr size_t WS_WQ = WS_WO + 2 * MiB;
constexpr size_t WS_KEYS = WS_WQ + 4 * MiB;
constexpr size_t WS_L2T = WS_KEYS + 512 * KiB;
constexpr size_t WS_SSP = WS_L2T + 256 * KiB;
constexpr size_t WS_UB = WS_SSP + (size_t)MPAD * 16 * 4;
constexpr size_t WS_VB = WS_UB + 16 * MiB;
constexpr size_t WS_A1 = WS_VB + 16 * MiB;
constexpr size_t WS_ZC = WS_A1 + (size_t)MPAD * DM * 2;
constexpr size_t WS_ZR = WS_ZC + (size_t)MPAD * 1536 * 2;
constexpr size_t WS_ZG = WS_ZR + (size_t)MPAD * 2048 * 2;
constexpr size_t WS_END = WS_ZG + (size_t)MPAD * 2048 * 2;
constexpr size_t WS_YL = WS_ZC, WS_ZT = WS_ZC + (size_t)NTOK * 512 * 2, WS_BV = WS_ZC + (size_t)NTOK * 512 * 4;
constexpr size_t WS_EIDX = WS_ZC, WS_GATE = WS_ZC + 16 * MiB, WS_COEF = WS_ZC + 40 * MiB, WS_SS2 = WS_ZC + 64 * MiB, WS_RSTD = WS_ZC + 66 * MiB;
constexpr size_t WS_PART = WS_ZR;
constexpr size_t OB_MB = (size_t)4352 * 4096 * 4;
constexpr size_t OB_S0S = OB_MB + (size_t)4352 * 4096 * 2;
static_assert(WS_BV + (size_t)NTOK * 512 * 2 <= WS_ZR && OB_S0S + (size_t)256 * 4096 * 2 <= (size_t)NTOK * 1024 * 4, "scan scratch maps");
static_assert(WS_END <= 512 * MiB, "d_ws map must fit 512 MiB");
constexpr float PEER_SU = 32.0f, PEER_SV = 4.0f;
constexpr int CW_BAR = 1024;
constexpr int LDS_BYTES = 163840;
constexpr int LDSCTL_OFF = LDS_BYTES - 512, MISC_OFF = LDSCTL_OFF + 320;

#define GAS __attribute__((address_space(1)))
#define LAS __attribute__((address_space(3)))
typedef unsigned short bf16;
typedef unsigned v4u __attribute__((ext_vector_type(4)));
typedef unsigned v2u __attribute__((ext_vector_type(2)));
typedef float f32x4 __attribute__((ext_vector_type(4)));
typedef short bf16x8 __attribute__((ext_vector_type(8)));
typedef __bf16 bf16x2_t __attribute__((ext_vector_type(2)));
typedef GAS unsigned gu32;
#define RLX_AGENT __ATOMIC_RELAXED, __HIP_MEMORY_SCOPE_AGENT
#define LDS_WAIT() asm volatile("s_waitcnt lgkmcnt(0)" ::: "memory")
#define VM_WAIT() asm volatile("s_waitcnt vmcnt(0)" ::: "memory")
using pg8::cvt_pk_bf16; using pg8::bf_lo; using pg8::bf_hi; using pg8::sigm;
#define XB_TMO      128
#define XB_XCNT(j)  (256  + 64 * (j))
#define XB_XSUB(j)  (1280 + 64 * (j))
#define XB_XGEN(j)  (2304 + 64 * (j))
#define XB_TOP      3328
#define XB_TOPGEN   3392
#define XCD_BAR_WORDS 3456
#define XB_SPIN_CAP (1u << 22)

__device__ __forceinline__ unsigned xb_ld(unsigned* p)              { return __hip_atomic_load(p, __ATOMIC_RELAXED, __HIP_MEMORY_SCOPE_AGENT); }
__device__ __forceinline__ unsigned xb_add(unsigned* p, unsigned v) { return __hip_atomic_fetch_add(p, v, __ATOMIC_RELAXED, __HIP_MEMORY_SCOPE_AGENT); }
__device__ __forceinline__ unsigned xb_xcc_id() { return (unsigned)__builtin_amdgcn_s_getreg((3 << 11) | 20) & 0xFu; }
#define XB_SPIN(cond, bar) do { unsigned _sp = 0; while (cond) { __builtin_amdgcn_s_sleep(1); \
    if ((++_sp & 255u) == 0u) { if (xb_ld(&(bar)[XB_TMO])) break; if (_sp > XB_SPIN_CAP) { atomicAdd(&(bar)[XB_TMO], 1u); break; } } } } while (0)

struct XcdBarrier {
    unsigned* bar; unsigned x;
    volatile LAS unsigned* st;
};

__device__ __forceinline__ XcdBarrier xcd_barrier_post(unsigned* bar, volatile LAS unsigned* st) {
    XcdBarrier b; b.bar = bar; b.x = xb_xcc_id(); b.st = st;
    if (threadIdx.x == 0) (void)xb_add(&bar[XB_XCNT(b.x)], 1u);
    return b;
}
__device__ __forceinline__ void xcd_barrier_complete(unsigned* bar, unsigned x, unsigned& nloc, unsigned& nx) {
    const unsigned G = gridDim.x * gridDim.y * gridDim.z;
    unsigned sum, cnt, mine, sp = 0u;
    for (;;) {
        sum = 0u; cnt = 0u; mine = 0u;
#pragma unroll
        for (unsigned j = 0; j < 16; ++j) { const unsigned c = xb_ld(&bar[XB_XCNT(j)]); sum += c; cnt += (c > 0u) ? 1u : 0u; mine = (j == x) ? c : mine; }
        if (sum == G) break;
        __builtin_amdgcn_s_sleep(1);
        if ((++sp & 255u) == 0u) { if (xb_ld(&bar[XB_TMO])) break; if (sp > XB_SPIN_CAP) { atomicAdd(&bar[XB_TMO], 1u); break; } }
    }
    nloc = mine > 0u ? mine : 1u; nx = cnt > 0u ? cnt : 1u;
}

__device__ __forceinline__ void xcd_barrier(const XcdBarrier& b) {
    asm volatile("s_waitcnt vmcnt(0)" ::: "memory");
    __syncthreads();
    if (threadIdx.x == 0) {
        unsigned* bar = b.bar;
        __builtin_amdgcn_s_waitcnt(0);
        unsigned nloc = b.st[0], nx = b.st[1];
        if (nloc == 0u) { xcd_barrier_complete(bar, b.x, nloc, nx); b.st[0] = nloc; b.st[1] = nx; }
        const unsigned old = xb_add(&bar[XB_XSUB(b.x)], 1u);
        const unsigned gen = old / nloc;
        if (old + 1u == (gen + 1u) * nloc) {
            __builtin_amdgcn_fence(__ATOMIC_RELEASE, "agent");
            asm volatile("s_waitcnt vmcnt(0)" ::: "memory");
            const unsigned og = xb_add(&bar[XB_TOP], 1u);
            const unsigned tg = og / nx;
            if (og + 1u == (tg + 1u) * nx) xb_add(&bar[XB_TOPGEN], 1u);
            else XB_SPIN(xb_ld(&bar[XB_TOPGEN]) == tg, bar);
            __builtin_amdgcn_fence(__ATOMIC_ACQUIRE, "agent");
            xb_add(&bar[XB_XGEN(b.x)], 1u);
            asm volatile("s_waitcnt vmcnt(0)" ::: "memory");
        } else {
            XB_SPIN(xb_ld(&bar[XB_XGEN(b.x)]) == gen, bar);
            __builtin_amdgcn_fence(__ATOMIC_ACQUIRE, "agent");
            asm volatile("s_waitcnt vmcnt(0)" ::: "memory");
        }
    }
    __syncthreads();
}
struct Args { const float* in[32]; float* out; unsigned char* ws; int ph_lo, ph_hi, li, pad; };
enum { I_XP = 0, I_XS, I_SCONV, I_SSHIFT, I_SWKV, I_N1G, I_WIN, I_CONVW, I_MURKV, I_MUWAG, I_W0, I_W1, I_W2, I_A0, I_A1, I_A2, I_G1, I_G2, I_KK, I_KA, I_RK, I_GNW, I_GNB, I_WPA, I_WPB, I_WO, I_N2G, I_WQ, I_KEYS, I_U, I_V, I_NFG };

__device__ __forceinline__ float wave_sum(float v) {
#pragma unroll
    for (int o = 1; o < 64; o <<= 1) v += __shfl_xor(v, o);
    return v;
}
template <int CTRL> __device__ __forceinline__ float dpp_mov(float v) { return __builtin_bit_cast(float, __builtin_amdgcn_update_dpp(0, __builtin_bit_cast(int, v), CTRL, 0xF, 0xF, true)); }
__device__ __forceinline__ float sum4(float v) { v += dpp_mov<0xB1>(v); v += dpp_mov<0x4E>(v); return v; }
__device__ __forceinline__ float sum8(float v) { v = sum4(v); v += dpp_mov<0x141>(v); return v; }
__device__ __forceinline__ float sum16(float v) { v = sum8(v); v += dpp_mov<0x140>(v); return v; }
__device__ __forceinline__ float dot2bf(unsigned w, unsigned x, float acc) { return __builtin_amdgcn_fdot2_f32_bf16(__builtin_bit_cast(bf16x2_t, w), __builtin_bit_cast(bf16x2_t, x), acc, false); }

__device__ __forceinline__ void transpose_item(const float* W, int ldw, int c0, int K, bf16* WT, int nblk, int item, const float* sv, float alpha, float beta, LAS float* scr, int lane, int rstride = 1) {
    const int kb = item / nblk, nb = item % nblk, k0 = 64 * kb, n0 = 32 * nb;
#pragma unroll 8
    for (int i = 0; i < 32; ++i) { const int kk = 2 * i + (lane >> 5); float s = 1.f; if (sv) s = alpha + beta * sv[k0 + kk];
        scr[kk * 33 + (lane & 31)] = W[(size_t)(k0 + kk) * ldw + c0 + n0 + (lane & 31)] * s; }
    LDS_WAIT();
    const int c = lane & 7;
#pragma unroll
    for (int j = 0; j < 4; ++j) { const int n = (lane >> 3) + 8 * j; const LAS float* s = scr + (8 * c) * 33 + n;
        v4u o; o.x = cvt_pk_bf16(s[0 * 33], s[1 * 33]); o.y = cvt_pk_bf16(s[2 * 33], s[3 * 33]); o.z = cvt_pk_bf16(s[4 * 33], s[5 * 33]); o.w = cvt_pk_bf16(s[6 * 33], s[7 * 33]);
        *(v4u*)(WT + (size_t)((n0 + n) * rstride) * K + k0 + 8 * c) = o; }
    LDS_WAIT();
}
__device__ __forceinline__ void cvt_stream(const float* src, bf16* dst, size_t n, size_t gt, size_t nthreads) {
    for (size_t i = gt * 8; i < n; i += nthreads * 8) { const f32x4 a = *(const f32x4*)(src + i), b = *(const f32x4*)(src + i + 4);
        v4u o; o.x = cvt_pk_bf16(a[0], a[1]); o.y = cvt_pk_bf16(a[2], a[3]); o.z = cvt_pk_bf16(b[0], b[1]); o.w = cvt_pk_bf16(b[2], b[3]); *(v4u*)(dst + i) = o; }
}
__device__ __forceinline__ void cvt_stream_fp8(const float* src, unsigned char* dst, size_t n, float scale, size_t gt, size_t nthreads) {
    for (size_t i = gt * 16; i < n; i += nthreads * 16) {
        const f32x4 a = *(const f32x4*)(src + i) * scale, b = *(const f32x4*)(src + i + 4) * scale, c = *(const f32x4*)(src + i + 8) * scale, d = *(const f32x4*)(src + i + 12) * scale;
        v4u o; unsigned p;
        p = __builtin_amdgcn_cvt_pk_fp8_f32(a[0], a[1], 0, false); o.x = __builtin_amdgcn_cvt_pk_fp8_f32(a[2], a[3], p, true);
        p = __builtin_amdgcn_cvt_pk_fp8_f32(b[0], b[1], 0, false); o.y = __builtin_amdgcn_cvt_pk_fp8_f32(b[2], b[3], p, true);
        p = __builtin_amdgcn_cvt_pk_fp8_f32(c[0], c[1], 0, false); o.z = __builtin_amdgcn_cvt_pk_fp8_f32(c[2], c[3], p, true);
        p = __builtin_amdgcn_cvt_pk_fp8_f32(d[0], d[1], 0, false); o.w = __builtin_amdgcn_cvt_pk_fp8_f32(d[2], d[3], p, true);
        *(v4u*)(dst + i) = o; }
}
__device__ __forceinline__ void cvt16_fp8_sliced(const float* src, unsigned char* dst, float scale, size_t i) {
    const f32x4 a = *(const f32x4*)(src + i) * scale, b = *(const f32x4*)(src + i + 4) * scale, c = *(const f32x4*)(src + i + 8) * scale, d = *(const f32x4*)(src + i + 12) * scale;
    v4u o; unsigned p;
    p = __builtin_amdgcn_cvt_pk_fp8_f32(a[0], a[1], 0, false); o.x = __builtin_amdgcn_cvt_pk_fp8_f32(a[2], a[3], p, true);
    p = __builtin_amdgcn_cvt_pk_fp8_f32(b[0], b[1], 0, false); o.y = __builtin_amdgcn_cvt_pk_fp8_f32(b[2], b[3], p, true);
    p = __builtin_amdgcn_cvt_pk_fp8_f32(c[0], c[1], 0, false); o.z = __builtin_amdgcn_cvt_pk_fp8_f32(c[2], c[3], p, true);
    p = __builtin_amdgcn_cvt_pk_fp8_f32(d[0], d[1], 0, false); o.w = __builtin_amdgcn_cvt_pk_fp8_f32(d[2], d[3], p, true);
    const size_t e = i >> 10, col = i & 1023;
    *(v4u*)(dst + (col >> 7) * ((size_t)16384 * 128) + e * 128 + (col & 127)) = o;
}
__device__ __forceinline__ void cvt_stream_fp8_sliced(const float* src, unsigned char* dst, float scale, size_t gt, size_t nthreads) {
#pragma unroll 2
    for (size_t i = gt * 16; i < (size_t)16384 * 1024; i += nthreads * 16) {
        const f32x4 a = *(const f32x4*)(src + i) * scale, b = *(const f32x4*)(src + i + 4) * scale, c = *(const f32x4*)(src + i + 8) * scale, d = *(const f32x4*)(src + i + 12) * scale;
        v4u o; unsigned p;
        p = __builtin_amdgcn_cvt_pk_fp8_f32(a[0], a[1], 0, false); o.x = __builtin_amdgcn_cvt_pk_fp8_f32(a[2], a[3], p, true);
        p = __builtin_amdgcn_cvt_pk_fp8_f32(b[0], b[1], 0, false); o.y = __builtin_amdgcn_cvt_pk_fp8_f32(b[2], b[3], p, true);
        p = __builtin_amdgcn_cvt_pk_fp8_f32(c[0], c[1], 0, false); o.z = __builtin_amdgcn_cvt_pk_fp8_f32(c[2], c[3], p, true);
        p = __builtin_amdgcn_cvt_pk_fp8_f32(d[0], d[1], 0, false); o.w = __builtin_amdgcn_cvt_pk_fp8_f32(d[2], d[3], p, true);
        const size_t e = i >> 10, col = i & 1023;
        *(v4u*)(dst + (col >> 7) * ((size_t)16384 * 128) + e * 128 + (col & 127)) = o; }
}
__device__ __forceinline__ void p0_prologue(const Args& A, LAS unsigned char* lds, int tid, int lane, int wave, int vcu, int G) {
    unsigned char* ws = A.ws;
    bf16* W1T = (bf16*)(ws + WS_W1T);
    LAS float* scr = (LAS float*)(lds + wave * 16384);
    const int gw = vcu * NWAVES + wave, NGW = G * NWAVES;
    constexpr int J0 = 16 * 96, JB_ = 16 * 16, J1 = 16 * 64, JL = 16 * 2, JG = 16 * 4, JP = 8 * 32, JO = 16 * 32, JQ = 16 * 64;
    constexpr int JW2 = 16, JG2 = 32;
    constexpr int NITEMS = J0 + J1 + 4 * JL + 2 * JG + 2 * JP + JO + JQ + 2 * JW2 + JG2;
    bf16* L2T = (bf16*)(ws + WS_L2T);
    const float* mu = A.in[I_MUWAG];
    for (int it = gw; it < NITEMS; it += NGW) {
        int r = it;
        if (r < J0) {
            if (r < JB_) transpose_item(A.in[I_WIN], 5120, 0, 1024, W1T, 16, r, nullptr, 0.f, 0.f, scr, lane);
            else if (r < 2 * JB_) transpose_item(A.in[I_WIN], 5120, 512, 1024, W1T + (size_t)512 * 1024, 16, r - JB_, nullptr, 0.f, 0.f, scr, lane, 2);
            else if (r < 3 * JB_) transpose_item(A.in[I_WIN], 5120, 1024, 1024, W1T + (size_t)513 * 1024, 16, r - 2 * JB_, nullptr, 0.f, 0.f, scr, lane, 2);
            else transpose_item(A.in[I_WIN], 5120, 1536, 1024, W1T + (size_t)1536 * 1024, 48, r - 3 * JB_, nullptr, 0.f, 0.f, scr, lane);
            continue; } r -= J0;
        if (r < J1) { transpose_item(A.in[I_WIN], 5120, 3072, 1024, W1T + (size_t)3584 * 1024, 64, r, nullptr, 0.f, 0.f, scr, lane); continue; } r -= J1;
        if (r < JL) { transpose_item(A.in[I_W1], 64, 0, 1024, W1T + (size_t)3072 * 1024, 2, r, mu, 1.f, -1.f, scr, lane); continue; } r -= JL;
        if (r < JL) { transpose_item(A.in[I_W1], 64, 0, 1024, W1T + (size_t)3328 * 1024, 2, r, mu, 0.f, 1.f, scr, lane); continue; } r -= JL;
        if (r < JL) { transpose_item(A.in[I_A1], 64, 0, 1024, W1T + (size_t)(3072 + 64) * 1024, 2, r, mu + 1024, 1.f, -1.f, scr, lane); continue; } r -= JL;
        if (r < JL) { transpose_item(A.in[I_A1], 64, 0, 1024, W1T + (size_t)(3328 + 64) * 1024, 2, r, mu + 1024, 0.f, 1.f, scr, lane); continue; } r -= JL;
        if (r < JG) { transpose_item(A.in[I_G1], 128, 0, 1024, W1T + (size_t)(3072 + 128) * 1024, 4, r, mu + 2048, 1.f, -1.f, scr, lane); continue; } r -= JG;
        if (r < JG) { transpose_item(A.in[I_G1], 128, 0, 1024, W1T + (size_t)(3328 + 128) * 1024, 4, r, mu + 2048, 0.f, 1.f, scr, lane); continue; } r -= JG;
        if (r < JP) { transpose_item(A.in[I_WPA], 1024, 0, 512, (bf16*)(ws + WS_WPA), 32, r, nullptr, 0.f, 0.f, scr, lane); continue; } r -= JP;
        if (r < JP) { transpose_item(A.in[I_WPB], 1024, 0, 512, (bf16*)(ws + WS_WPB), 32, r, nullptr, 0.f, 0.f, scr, lane); continue; } r -= JP;
        if (r < JO) { transpose_item(A.in[I_WO], 1024, 0, 1024, (bf16*)(ws + WS_WO), 32, r, nullptr, 0.f, 0.f, scr, lane); continue; } r -= JO;
        if (r < JQ) { transpose_item(A.in[I_WQ], 2048, 0, 1024, (bf16*)(ws + WS_WQ), 64, r, nullptr, 0.f, 0.f, scr, lane); continue; } r -= JQ;
        if (r < JW2) { transpose_item(A.in[I_W2], 512, 0, 64, L2T, 16, r, nullptr, 0.f, 0.f, scr, lane); continue; } r -= JW2;
        if (r < JW2) { transpose_item(A.in[I_A2], 512, 0, 64, L2T + (size_t)512 * 64, 16, r, nullptr, 0.f, 0.f, scr, lane); continue; } r -= JW2;
        transpose_item(A.in[I_G2], 512, 0, 128, L2T + (size_t)1024 * 64, 16, r, nullptr, 0.f, 0.f, scr, lane);
    }
    const size_t gt = (size_t)vcu * NTHR + tid, nth = (size_t)G * NTHR;
    if (G != 256) {
        cvt_stream_fp8_sliced(A.in[I_U], ws + WS_UB, PEER_SU, gt, nth);
        cvt_stream_fp8_sliced(A.in[I_V], ws + WS_VB, PEER_SV, gt, nth); }
    cvt_stream(A.in[I_KEYS], (bf16*)(ws + WS_KEYS), (size_t)8 * 2 * 128 * 128, gt, nth);
    bf16* A1 = (bf16*)(ws + WS_A1);
    const f32x4* g1v = (const f32x4*)A.in[I_N1G] + lane;
    for (int m0 = gw; m0 < NTOK; m0 += 2 * NGW) {
        const int m1 = m0 + NGW; const bool two = m1 < NTOK; const int m1c = two ? m1 : m0;
        const f32x4* xr0 = (const f32x4*)(m0 < NPROMPT ? A.in[I_XP] + (size_t)m0 * DM : A.in[I_XS] + (size_t)(m0 - NPROMPT) * DM) + lane;
        const f32x4* xr1 = (const f32x4*)(m1c < NPROMPT ? A.in[I_XP] + (size_t)m1c * DM : A.in[I_XS] + (size_t)(m1c - NPROMPT) * DM) + lane;
        f32x4 v0[4], v1[4]; float s0 = 0.f, s1 = 0.f;
#pragma unroll
        for (int j = 0; j < 4; ++j) { v0[j] = xr0[64 * j]; v1[j] = xr1[64 * j]; }
#pragma unroll
        for (int j = 0; j < 4; ++j) { s0 += (v0[j][0] * v0[j][0] + v0[j][1] * v0[j][1]) + (v0[j][2] * v0[j][2] + v0[j][3] * v0[j][3]);
                                      s1 += (v1[j][0] * v1[j][0] + v1[j][1] * v1[j][1]) + (v1[j][2] * v1[j][2] + v1[j][3] * v1[j][3]); }
#pragma unroll
        for (int o = 1; o < 64; o <<= 1) { s0 += __shfl_xor(s0, o); s1 += __shfl_xor(s1, o); }
        const float r0 = 1.0f / sqrtf(s0 * (1.f / DM) + 1e-6f), r1 = 1.0f / sqrtf(s1 * (1.f / DM) + 1e-6f);
#pragma unroll
        for (int rr = 0; rr < 2; ++rr) {
            if (rr == 1 && !two) break;
            const int m = rr ? m1 : m0; const float rstd = rr ? r1 : r0;
            v2u* o8 = (v2u*)(A1 + (size_t)m * DM) + lane;
            float* so = nullptr;
            if (m < NPROMPT) { if ((m & (SEQ_P - 1)) == SEQ_P - 1) so = A.out + O_SHIFT_P + (size_t)(m / SEQ_P) * DM; }
            else { const int ms = m - NPROMPT; if ((ms & (SEQ_S - 1)) == SEQ_S - 1) so = A.out + O_SHIFT_S + (size_t)(ms / SEQ_S) * DM; }
#pragma unroll
            for (int j = 0; j < 4; ++j) { const f32x4 g = g1v[64 * j]; const f32x4 y = (rr ? v1[j] : v0[j]) * rstd * g;
                v2u w; w.x = cvt_pk_bf16(y[0], y[1]); w.y = cvt_pk_bf16(y[2], y[3]); o8[64 * j] = w;
                if (so) ((f32x4*)so)[lane + 64 * j] = y; }
        }
    }
    for (int m = NTOK + gw; m < MPAD; m += NGW) {
        v2u* o8 = (v2u*)(A1 + (size_t)m * DM) + lane;
        if (m < NTOK + NSHIFT) {
            const f32x4* xr = (const f32x4*)(A.in[I_SSHIFT] + (size_t)(m - NTOK) * DM) + lane;
#pragma unroll
            for (int j = 0; j < 4; ++j) { const f32x4 y = xr[64 * j]; v2u w; w.x = cvt_pk_bf16(y[0], y[1]); w.y = cvt_pk_bf16(y[2], y[3]); o8[64 * j] = w; }
        } else {
#pragma unroll
            for (int j = 0; j < 4; ++j) { v2u w; w.x = 0u; w.y = 0u; o8[64 * j] = w; }
        }
    }
}

__device__ __forceinline__ void unpack8(const v4u w, float (&f)[8]) { f[0] = bf_lo(w.x); f[1] = bf_hi(w.x); f[2] = bf_lo(w.y); f[3] = bf_hi(w.y); f[4] = bf_lo(w.z); f[5] = bf_hi(w.z); f[6] = bf_lo(w.w); f[7] = bf_hi(w.w); }
__device__ __forceinline__ void conv_phase(const Args& A, int gt, int nth) {
    const bf16* Zc = (const bf16*)(A.ws + WS_ZC); bf16* YA = (bf16*)(A.ws + WS_A1);
    const float* cw = A.in[I_CONVW];
    for (int task = gt; task < (NTOK / 16) * 64; task += nth) {
        const int seg = task >> 6, ch = (task & 63) * 8, row0 = seg * 16;
        int b, t0, T; bool prompt = row0 < NPROMPT;
        if (prompt) { b = row0 / SEQ_P; t0 = row0 % SEQ_P; T = SEQ_P; } else { b = (row0 - NPROMPT) / SEQ_S; t0 = 0; T = SEQ_S; }
        float um2[8], um1[8], c0[8], c1[8], c2[8];
#pragma unroll
        for (int i = 0; i < 8; ++i) { c0[i] = cw[ch + i]; c1[i] = cw[512 + ch + i]; c2[i] = cw[1024 + ch + i]; }
        if (t0 == 0) {
            if (prompt) {
#pragma unroll
                for (int i = 0; i < 8; ++i) { um2[i] = 0.f; um1[i] = 0.f; }
            } else { const float* sc = A.in[I_SCONV] + (size_t)b * 2 * 512 + ch;
#pragma unroll
                for (int i = 0; i < 8; ++i) { um2[i] = sc[i]; um1[i] = sc[512 + i]; } }
        } else {
            unpack8(*(const v4u*)(Zc + (size_t)(row0 - 2) * 1024 + 512 + ch), um2); unpack8(*(const v4u*)(Zc + (size_t)(row0 - 1) * 1024 + 512 + ch), um1);
        }
#pragma unroll 4
        for (int t = 0; t < 16; ++t) {
            const size_t row = (size_t)(row0 + t);
            float zb[8], zu[8], y[8];
            unpack8(*(const v4u*)(Zc + row * 1024 + ch), zb); unpack8(*(const v4u*)(Zc + row * 1024 + 512 + ch), zu);
#pragma unroll
            for (int i = 0; i < 8; ++i) { const float u = zu[i]; y[i] = zb[i] * (c0[i] * um2[i] + c1[i] * um1[i] + c2[i] * u); um2[i] = um1[i]; um1[i] = u; }
            v4u o; o.x = cvt_pk_bf16(y[0], y[1]); o.y = cvt_pk_bf16(y[2], y[3]); o.z = cvt_pk_bf16(y[4], y[5]); o.w = cvt_pk_bf16(y[6], y[7]);
            *(v4u*)(YA + row * 512 + ch) = o;
        }
        if (t0 + 16 == T) { float* oc = A.out + (prompt ? O_CONV_P : O_CONV_S) + (size_t)b * 2 * 512 + ch;
#pragma unroll
            for (int i = 0; i < 8; ++i) { oc[i] = um2[i]; oc[512 + i] = um1[i]; } }
    }
    bf16* Zr = (bf16*)(A.ws + WS_ZR);
    for (int task = nth - 1 - gt; task < NTOK * 16; task += nth) {
        const int m = task >> 4, cs = task & 15;
        bool hasprev; int prow;
        if (m < NPROMPT) { hasprev = (m & (SEQ_P - 1)) != 0; prow = m - 1; } else { const int ms = m - NPROMPT; hasprev = true; prow = (ms & (SEQ_S - 1)) ? m - 1 : NTOK + ms / SEQ_S; }
        bf16* pap = Zr + (size_t)m * 2048 + 1536 + cs * 16;
        float pa[16], t8[8];
        const v4u a0 = *(const v4u*)pap, a1 = *(const v4u*)(pap + 8);
        v4u b0 = (v4u){0u, 0u, 0u, 0u}, b1 = b0;
        if (hasprev) { const bf16* pbp = Zr + (size_t)prow * 2048 + 1792 + cs * 16; b0 = *(const v4u*)pbp; b1 = *(const v4u*)(pbp + 8); }
        unpack8(a0, t8);
#pragma unroll
        for (int i = 0; i < 8; ++i) pa[i] = t8[i];
        unpack8(a1, t8);
#pragma unroll
        for (int i = 0; i < 8; ++i) pa[8 + i] = t8[i];
        unpack8(b0, t8);
#pragma unroll
        for (int i = 0; i < 8; ++i) pa[i] += t8[i];
        unpack8(b1, t8);
#pragma unroll
        for (int i = 0; i < 8; ++i) pa[8 + i] += t8[i];
#pragma unroll
        for (int i = 0; i < 16; ++i) { float p = pa[i];
            if (cs < 4) p = 1.0f - 2.0f * __builtin_amdgcn_rcpf(__expf(2.0f * p) + 1.0f);
            else if (cs >= 8) p = sigm(p);
            pa[i] = p; }
        v4u o0, o1; o0.x = cvt_pk_bf16(pa[0], pa[1]); o0.y = cvt_pk_bf16(pa[2], pa[3]); o0.z = cvt_pk_bf16(pa[4], pa[5]); o0.w = cvt_pk_bf16(pa[6], pa[7]);
        o1.x = cvt_pk_bf16(pa[8], pa[9]); o1.y = cvt_pk_bf16(pa[10], pa[11]); o1.z = cvt_pk_bf16(pa[12], pa[13]); o1.w = cvt_pk_bf16(pa[14], pa[15]);
        *(v4u*)pap = o0; *(v4u*)(pap + 8) = o1;
    }
}

constexpr int NUNITS_P = NB_P * 8 * 64, NUNITS = NUNITS_P + NB_S * 8;
constexpr int HID_STRIDE = 264, SC_TB = 32;
constexpr int P1_HIDB = 0, P1_LO = 16896, P1_SEQ = 41472, P1_GG = 90624, P1_YY = 98816, P1_ZZ = 107008, P1_BON = 115200;
typedef float f32x2 __attribute__((ext_vector_type(2)));

struct P1Pre { v4u pa0, pa1; v2u zr, zk, zv, pr, pk, pv; };
struct P1Pos { int unit, t0; };
__device__ __forceinline__ void p1_decode(int unit, bool& prompt, int& b, int& h, int& ch, int& T, int& rowbase) {
    prompt = unit < NUNITS_P; b = prompt ? unit >> 9 : (unit - NUNITS_P) >> 3; h = prompt ? (unit >> 6) & 7 : unit & 7; ch = prompt ? unit & 63 : 0;
    T = prompt ? 64 : SEQ_S; rowbase = prompt ? b * SEQ_P + ch * 64 : NPROMPT + b * SEQ_S;
}
__device__ __forceinline__ void p1_rows(int unit, int t0, int tt, size_t& row, size_t& prow, bool& hasprev, int& nb) {
    bool prompt; int b, h, ch, T, rowbase; p1_decode(unit, prompt, b, h, ch, T, rowbase);
    nb = (T - t0) < SC_TB ? (T - t0) : SC_TB;
    const int tloc = tt < nb ? tt : nb - 1, t = t0 + tloc; const bool first = (ch == 0);
    row = (size_t)(rowbase + t); hasprev = (t > 0) || !first || !prompt; prow = ((t > 0) || !first) ? row - 1 : (size_t)(NTOK + b);
}
__device__ __forceinline__ void p1_load(const Args& A, int unit, int t0, int tt, int cs, P1Pre& P) {
    size_t row, prow; bool hasprev; int nb; p1_rows(unit, t0, tt, row, prow, hasprev, nb);
    const int h = unit < NUNITS_P ? (unit >> 6) & 7 : unit & 7, hc = h * 64 + cs * 4;
    const bf16* Zr = (const bf16*)(A.ws + WS_ZR);
    P.pa0 = *(const v4u*)(Zr + row * 2048 + 1536 + cs * 16); P.pa1 = *(const v4u*)(Zr + row * 2048 + 1536 + cs * 16 + 8);
    P.zr = *(const v2u*)(Zr + row * 2048 + hc); P.zk = *(const v2u*)(Zr + row * 2048 + 512 + hc); P.zv = *(const v2u*)(Zr + row * 2048 + 1024 + hc);
    const v2u z2 = (v2u){0u, 0u};
    P.pr = z2; P.pk = z2; P.pv = z2;
    if (hasprev) { P.pr = *(const v2u*)(Zr + prow * 2048 + hc); P.pk = *(const v2u*)(Zr + prow * 2048 + 512 + hc); P.pv = *(const v2u*)(Zr + prow * 2048 + 1024 + hc); }
}
__device__ __forceinline__ bool p1_unit_at(int i, int vcu, int G, int& unit) {
    if (G == 256) { if (i > 16) return false; unit = i < 16 ? vcu * 16 + i : NUNITS_P + vcu; return true; }
    unit = vcu + i * G; return unit < NUNITS;
}

constexpr int WY_OS = 72, WY_TS = 24, WY_LS = 40;
constexpr int WY_AT = 0, WY_RT = WY_AT + 16 * WY_OS * 2, WY_BT = WY_RT + 16 * WY_OS * 2, WY_KT = WY_BT + 16 * WY_OS * 2, WY_BK = WY_KT + 16 * WY_OS * 2,
              WY_VT = WY_BK + 64 * WY_LS * 2, WY_GC = WY_VT + 64 * WY_TS * 2, WY_BUF = WY_GC + 256;
constexpr int WY_BASE = 0;
constexpr int WY_GSET = 1024 + 2 * 16 * WY_LS * 2 + 1024;
constexpr int WY_LAB = WY_BASE + 2 * WY_BUF;
static_assert(WY_LAB + WY_GSET <= P1_SEQ, "UT-transform operands must fit over HIDB | LO");
constexpr int WY_XB = 115328, WY_END = WY_XB + 128 * WY_OS * 2;
static_assert(WY_END <= LDSCTL_OFF, "LDS map of pass 1");

constexpr int WY_G2 = P1_GG + 2048;
static_assert(WY_G2 + WY_GSET <= P1_YY, "second Gram set");
__device__ __forceinline__ void p1_wy(f32x4 (&X)[4], const LAS float* SEQ, LAS float* YY, LAS float* ZZ, LAS unsigned char* lds, int nb, int tid, int lane, int wave, int part = 0) {
    const bool pw = wave >= 4; const int nmc = nb >> 4;
    LAS bf16* Xb = (LAS bf16*)(lds + WY_XB);
    for (int mc = 0; mc < nmc; ++mc) {
        asm volatile("" : "+v"(tid));
        LAS unsigned char* ob = lds + WY_BASE + mc * WY_BUF;
        LAS bf16* At = (LAS bf16*)(ob + WY_AT); LAS bf16* Rt = (LAS bf16*)(ob + WY_RT); LAS bf16* Bt = (LAS bf16*)(ob + WY_BT); LAS bf16* Kt = (LAS bf16*)(ob + WY_KT);
        LAS bf16* BKT = (LAS bf16*)(ob + WY_BK); LAS bf16* VT = (LAS bf16*)(ob + WY_VT); LAS float* GC = (LAS float*)(ob + WY_GC);
        const int tl = tid >> 5, c2 = (tid & 31) * 2, s0 = mc * 16;
        f32x2 cum = (f32x2){0.f, 0.f}, tot = cum, lwt = cum;
#pragma unroll
        for (int i = 0; i < 16; ++i) { const f32x2 l2 = *(const LAS f32x2*)(SEQ + (s0 + i) * 384 + 64 + c2); tot += l2; if (i <= tl) cum += l2; if (i == tl) lwt = l2; }
        const LAS float* sp = SEQ + (s0 + tl) * 384 + c2;
        const f32x2 a2 = *(const LAS f32x2*)(sp), b2 = *(const LAS f32x2*)(sp + 128), k2 = *(const LAS f32x2*)(sp + 192), r2 = *(const LAS f32x2*)(sp + 256), v2 = *(const LAS f32x2*)(sp + 320);
        const f32x2 gt = (f32x2){__expf(cum.x), __expf(cum.y)}, gp = (f32x2){__expf(cum.x - lwt.x), __expf(cum.y - lwt.y)}, gi = (f32x2){__expf(-cum.x), __expf(-cum.y)},
                    go = (f32x2){__expf(tot.x - cum.x), __expf(tot.y - cum.y)};
        *(LAS unsigned*)(At + tl * WY_OS + c2) = cvt_pk_bf16(a2.x * gp.x, a2.y * gp.y); *(LAS unsigned*)(Rt + tl * WY_OS + c2) = cvt_pk_bf16(r2.x * gt.x, r2.y * gt.y);
        *(LAS unsigned*)(Bt + tl * WY_OS + c2) = cvt_pk_bf16(b2.x * gi.x, b2.y * gi.y); *(LAS unsigned*)(Kt + tl * WY_OS + c2) = cvt_pk_bf16(k2.x * gi.x, k2.y * gi.y);
        const unsigned bh = cvt_pk_bf16(b2.x * go.x, b2.y * go.y), kh = cvt_pk_bf16(k2.x * go.x, k2.y * go.y), vv = cvt_pk_bf16(v2.x, v2.y);
        {
            const unsigned bh_o = (unsigned)__shfl_xor((int)bh, 32), kh_o = (unsigned)__shfl_xor((int)kh, 32), vv_o = (unsigned)__shfl_xor((int)vv, 32);
            const bool ev = (tl & 1) == 0; const int col = ev ? c2 : c2 + 1;
            const int wk = col * WY_LS + 8 * (tl >> 2) + (tl & 2), wo = col * WY_TS + (tl & ~1);
            *(LAS unsigned*)(BKT + wk) = ev ? ((bh & 0xffffu) | (bh_o << 16)) : ((bh_o >> 16) | (bh & 0xffff0000u));
            *(LAS unsigned*)(BKT + wk + 4) = ev ? ((kh & 0xffffu) | (kh_o << 16)) : ((kh_o >> 16) | (kh & 0xffff0000u));
            *(LAS unsigned*)(VT + wo) = ev ? ((vv & 0xffffu) | (vv_o << 16)) : ((vv_o >> 16) | (vv & 0xffff0000u)); }
        if (tl == 0) *(LAS f32x2*)(GC + c2) = (f32x2){__expf(tot.x), __expf(tot.y)};
    }
    __syncthreads();
    {
        asm volatile("" : "+v"(tid));
        const int fr = tid & 15, fq = (tid >> 4) & 3, m_ = wave >> 2, g_ = (wave + m_) & 3;
        if (m_ < nmc) {
            LAS unsigned char* ob = lds + WY_BASE + m_ * WY_BUF; LAS unsigned char* gs = lds + (m_ ? WY_G2 : WY_LAB);
            LAS float* Lab = (LAS float*)gs; LAS bf16* Lak = (LAS bf16*)(gs + 1024); LAS bf16* Mc = (LAS bf16*)(gs + 1024 + 16 * WY_LS * 2); LAS float* TT = (LAS float*)(gs + 1024 + 2 * 16 * WY_LS * 2);
            const LAS bf16* ab = (LAS bf16*)(ob + (g_ < 2 ? WY_AT : WY_RT)) + fr * WY_OS + fq * 8; const LAS bf16* bb = (LAS bf16*)(ob + ((g_ & 1) ? WY_KT : WY_BT)) + fr * WY_OS + fq * 8;
            f32x4 g = (f32x4){0.f, 0.f, 0.f, 0.f};
#pragma unroll
            for (int ks = 0; ks < 2; ++ks) g = __builtin_amdgcn_mfma_f32_16x16x32_bf16(*(const LAS bf16x8*)(bb + ks * 32), *(const LAS bf16x8*)(ab + ks * 32), g, 0, 0, 0);
#pragma unroll
            for (int rg = 0; rg < 4; ++rg) { const int tp = 4 * fq + rg; const bool keep = (g_ < 2) ? (fr > tp) : (fr >= tp); g[rg] = keep ? g[rg] : 0.f; }
            if (g_ == 0) {
                *(LAS f32x4*)(Lab + fr * 16 + 4 * fq) = g;
                LDS_WAIT();
                float u[16];
#pragma unroll
                for (int t = 0; t < 16; ++t) { if ((t & 3) == 0) asm volatile("" ::: "memory");
                    float acc = (t == fr) ? 1.0f : 0.0f;
#pragma unroll
                    for (int i4 = 0; i4 * 4 < t; ++i4) { const f32x4 l4 = *(const LAS f32x4*)(Lab + t * 16 + i4 * 4);
#pragma unroll
                        for (int e = 0; e < 4; ++e) if (i4 * 4 + e < t) acc += l4[e] * u[i4 * 4 + e]; }
                    u[t] = acc; }
                if (fq == 0) {
#pragma unroll
                    for (int t = 0; t < 16; ++t) TT[t * 16 + fr] = u[t]; }
            } else { v2u w; w.x = cvt_pk_bf16(g[0], g[1]); w.y = cvt_pk_bf16(g[2], g[3]);
                if (g_ == 1) { *(LAS v2u*)(Lak + fr * WY_LS + 8 * fq + 4) = w; *(LAS v2u*)(Lak + fr * WY_LS + 8 * fq) = (v2u){0u, 0u}; }
                else if (g_ == 2) *(LAS v2u*)(Mc + fr * WY_LS + 8 * fq) = w; else *(LAS v2u*)(Mc + fr * WY_LS + 8 * fq + 4) = w; }
        }
    }
    __syncthreads();
    if (MK_DBGSEL == 2 && part) return;
    for (int mc = 0; mc < nmc; ++mc) {
        asm volatile("" : "+v"(tid));
        const int fr = tid & 15, fq = (tid >> 4) & 3;
        LAS unsigned char* ob = lds + WY_BASE + mc * WY_BUF; LAS unsigned char* gs = lds + (mc ? WY_G2 : WY_LAB);
        LAS bf16* At = (LAS bf16*)(ob + WY_AT); LAS bf16* Rt = (LAS bf16*)(ob + WY_RT);
        LAS bf16* BKT = (LAS bf16*)(ob + WY_BK); LAS bf16* VT = (LAS bf16*)(ob + WY_VT); LAS float* GC = (LAS float*)(ob + WY_GC);
        LAS bf16* Lak = (LAS bf16*)(gs + 1024); LAS bf16* Mc = (LAS bf16*)(gs + 1024 + 16 * WY_LS * 2); LAS float* TT = (LAS float*)(gs + 1024 + 2 * 16 * WY_LS * 2);
        f32x4 W1 = (f32x4){0.f, 0.f, 0.f, 0.f}, Y0 = W1;
        {
            const LAS bf16* xbp = Xb + (16 * wave + fr) * WY_OS + fq * 8;
#pragma unroll
            for (int ks = 0; ks < 2; ++ks) { const bf16x8 bx = *(const LAS bf16x8*)(xbp + ks * 32);
                W1 = __builtin_amdgcn_mfma_f32_16x16x32_bf16(*(const LAS bf16x8*)(At + fr * WY_OS + ks * 32 + fq * 8), bx, W1, 0, 0, 0);
                Y0 = __builtin_amdgcn_mfma_f32_16x16x32_bf16(*(const LAS bf16x8*)(Rt + fr * WY_OS + ks * 32 + fq * 8), bx, Y0, 0, 0, 0); }
        }
        v2u vq = (v2u){0u, 0u};
        if (!pw) vq = *(const LAS v2u*)(VT + (16 * wave + fr) * WY_TS + 4 * fq);
        if (!pw) { v4u vb; vb.x = 0u; vb.y = 0u; vb.z = vq.x; vb.w = vq.y;
            W1 = __builtin_amdgcn_mfma_f32_16x16x32_bf16(*(const LAS bf16x8*)(Lak + fr * WY_LS + fq * 8), __builtin_bit_cast(bf16x8, vb), W1, 0, 0, 0); }
        f32x4 U = (f32x4){0.f, 0.f, 0.f, 0.f};
        if (!(MK_DBGSEL == 3 && part)) {
            const f32x4 tq = *(const LAS f32x4*)(TT + fr * 16 + 4 * fq);
#pragma unroll
            for (int kk = 0; kk < 4; ++kk) U = __builtin_amdgcn_mfma_f32_16x16x4f32(tq[kk], W1[kk], U, 0, 0, 0);
        } else U = W1;
        {
            v4u ucw; ucw.x = cvt_pk_bf16(U[0], U[1]); ucw.y = cvt_pk_bf16(U[2], U[3]); ucw.z = vq.x; ucw.w = vq.y;
            const bf16x8 uc = __builtin_bit_cast(bf16x8, ucw);
            Y0 = __builtin_amdgcn_mfma_f32_16x16x32_bf16(*(const LAS bf16x8*)(Mc + fr * WY_LS + fq * 8), uc, Y0, 0, 0, 0);
            LAS float* yo = (pw ? ZZ + 16 * (wave - 4) : YY + 16 * wave) + fr;
#pragma unroll
            for (int rg = 0; rg < 4; ++rg) yo[(mc * 16 + 4 * fq + rg) * 64] = Y0[rg];
#pragma unroll
            for (int j = 0; j < 4; ++j) {
                const bf16x8 bc = *(const LAS bf16x8*)(BKT + (16 * j + fr) * WY_LS + fq * 8);
                X[j] = X[j] * *(const LAS f32x4*)(GC + 16 * j + 4 * fq);
                X[j] = __builtin_amdgcn_mfma_f32_16x16x32_bf16(bc, uc, X[j], 0, 0, 0);
                v2u w; w.x = cvt_pk_bf16(X[j][0], X[j][1]); w.y = cvt_pk_bf16(X[j][2], X[j][3]);
                *(LAS v2u*)(Xb + (16 * wave + fr) * WY_OS + 16 * j + 4 * fq) = w; }
        }
        LDS_WAIT();
    }
}

#define P1_LOAD_PARAMS(HH) do { int lf_ = fr, lq_ = fq, lt_ = tid; asm volatile("" : "+v"(lf_), "+v"(lq_), "+v"(lt_));   \
        const int h_ = (HH), ncol_ = h_ * 64 + ntl * 16 + lf_; \
        _Pragma("unroll") for (int ks = 0; ks < 2; ++ks) { bw[ks] = *(const bf16x8*)(L2T + (size_t)ncol_ * 64 + lq_ * 8 + ks * 32); ba[ks] = *(const bf16x8*)(L2T + (size_t)512 * 64 + (size_t)ncol_ * 64 + lq_ * 8 + ks * 32); } \
        _Pragma("unroll") for (int ks = 0; ks < 4; ++ks) bg[ks] = *(const bf16x8*)(L2T + (size_t)1024 * 64 + (size_t)ncol_ * 128 + lq_ * 8 + ks * 32); \
        if (lt_ < 128) { const int a_ = lt_ >> 4, c_ = (lt_ & 15) * 4; \
            const float* src_ = a_ == 0 ? A.in[I_W0] : a_ == 1 ? A.in[I_A0] : a_ == 2 ? A.in[I_KK] : a_ == 3 ? A.in[I_KA] : a_ == 4 ? A.in[I_RK] : A.in[I_MURKV] + (a_ - 5) * 512; \
            *(LAS f32x4*)(PRM + a_ * 64 + c_) = *(const f32x4*)(src_ + h_ * 64 + c_); } } while (0)
__device__ __forceinline__ void scan_pass1(const Args& A, LAS unsigned char* lds, int tid, int lane, int wave, int vcu, int G, int part = 0) {
    bf16* GB = (bf16*)(A.ws + WS_A1) + (size_t)MPAD * 512;
    bf16* YL = (bf16*)(A.ws + WS_YL); bf16* ZT = (bf16*)(A.ws + WS_ZT); bf16* BV = (bf16*)(A.ws + WS_BV);
    LAS bf16* HIDB = (LAS bf16*)(lds + P1_SEQ);
    LAS float* LO = (LAS float*)(lds + P1_LO); LAS float* SEQ = (LAS float*)(lds + P1_SEQ);
    LAS float* YY = (LAS float*)(lds + P1_YY); LAS float* ZZ = (LAS float*)(lds + P1_ZZ);
    const bf16* L2T = (const bf16*)(A.ws + WS_L2T);
    const bool prow_wave = wave >= 4;
    const int mt = wave & 1, ntl = wave >> 1;
    int tt = tid >> 4, cs = tid & 15, c4 = cs * 4, fr = lane & 15, fq = lane >> 4;
    f32x4 X[4];
    bf16x8 bw[2], ba[2], bg[4];
    LAS float* PRM = (LAS float*)(lds + P1_GG);
    int cur_h = -1;
    int ui = 0, unit; if (!p1_unit_at(0, vcu, G, unit)) return;
    int t0 = 0; P1Pre pre; p1_load(A, unit, 0, tt, cs, pre);
    *(LAS v4u*)(HIDB + tt * HID_STRIDE + cs * 16) = pre.pa0; *(LAS v4u*)(HIDB + tt * HID_STRIDE + cs * 16 + 8) = pre.pa1;
    __syncthreads();
    for (;;) {
        { int lt_ = tid; asm volatile("" : "+v"(lt_)); tt = lt_ >> 4; cs = lt_ & 15; c4 = cs * 4; fr = lt_ & 15; fq = (lt_ >> 4) & 3; }
        bool prompt; int b, h, ch, T, rowbase; p1_decode(unit, prompt, b, h, ch, T, rowbase);
        const int hc = h * 64 + c4;
        if (t0 == 0 && G == 256 && ui < 8) {
            const size_t i16 = ((size_t)(ui * 256 + vcu) * NTHR + tid) * 16;
            cvt16_fp8_sliced(A.in[I_U], A.ws + WS_UB, PEER_SU, i16); cvt16_fp8_sliced(A.in[I_V], A.ws + WS_VB, PEER_SV, i16); }
        if (t0 == 0) {
            LAS bf16* Xb = (LAS bf16*)(lds + WY_XB);
#pragma unroll
            for (int j = 0; j < 4; ++j) { const int prow_ = 16 * (wave - 4) + fr, c0_ = 16 * j + 4 * fq;
#pragma unroll
                for (int e = 0; e < 4; ++e) X[j][e] = (prow_wave && prow_ == c0_ + e) ? 1.f : 0.f;
                v2u w; w.x = cvt_pk_bf16(X[j][0], X[j][1]); w.y = cvt_pk_bf16(X[j][2], X[j][3]);
                *(LAS v2u*)(Xb + (16 * wave + fr) * WY_OS + c0_) = w; }
        }
        if (h != cur_h) { cur_h = h; P1_LOAD_PARAMS(h); }
        size_t row, prow; bool hasprev; int nb; p1_rows(unit, t0, tt, row, prow, hasprev, nb);
        if (!(MK_DBGSEL == 5 && part)) {
            const LAS bf16* ap = HIDB + (mt * 16 + fr) * HID_STRIDE + fq * 8;
            f32x4 cw = (f32x4){0.f, 0.f, 0.f, 0.f}, ca = cw, cg = cw;
#pragma unroll
            for (int ks = 0; ks < 2; ++ks) { cw = __builtin_amdgcn_mfma_f32_16x16x32_bf16(*(const LAS bf16x8*)(ap + ks * 32), bw[ks], cw, 0, 0, 0);
                                             ca = __builtin_amdgcn_mfma_f32_16x16x32_bf16(*(const LAS bf16x8*)(ap + 64 + ks * 32), ba[ks], ca, 0, 0, 0); }
#pragma unroll
            for (int ks = 0; ks < 4; ++ks) cg = __builtin_amdgcn_mfma_f32_16x16x32_bf16(*(const LAS bf16x8*)(ap + 128 + ks * 32), bg[ks], cg, 0, 0, 0);
#pragma unroll
            for (int rg = 0; rg < 4; ++rg) { const int o = (mt * 16 + fq * 4 + rg) * 64 + ntl * 16 + fr; LO[o] = cw[rg]; LO[2048 + o] = ca[rg]; LO[4096 + o] = cg[rg]; }
        }
        __syncthreads();
        if (!(MK_DBGSEL == 5 && part)) {
            const f32x4 w0v = *(const LAS f32x4*)(PRM + c4), a0v = *(const LAS f32x4*)(PRM + 64 + c4), kkv = *(const LAS f32x4*)(PRM + 128 + c4), kav = *(const LAS f32x4*)(PRM + 192 + c4),
                        rkv = *(const LAS f32x4*)(PRM + 256 + c4), mur = *(const LAS f32x4*)(PRM + 320 + c4), muk = *(const LAS f32x4*)(PRM + 384 + c4), muv = *(const LAS f32x4*)(PRM + 448 + c4);
            const f32x4 aw = w0v + *(const LAS f32x4*)(LO + tt * 64 + c4), aa = a0v + *(const LAS f32x4*)(LO + 2048 + tt * 64 + c4), ag = *(const LAS f32x4*)(LO + 4096 + tt * 64 + c4);
            f32x4 r = (f32x4){bf_lo(pre.zr.x), bf_hi(pre.zr.x), bf_lo(pre.zr.y), bf_hi(pre.zr.y)}, k = (f32x4){bf_lo(pre.zk.x), bf_hi(pre.zk.x), bf_lo(pre.zk.y), bf_hi(pre.zk.y)},
                  v = (f32x4){bf_lo(pre.zv.x), bf_hi(pre.zv.x), bf_lo(pre.zv.y), bf_hi(pre.zv.y)};
            const f32x4 rpv = (f32x4){bf_lo(pre.pr.x), bf_hi(pre.pr.x), bf_lo(pre.pr.y), bf_hi(pre.pr.y)}, kpv = (f32x4){bf_lo(pre.pk.x), bf_hi(pre.pk.x), bf_lo(pre.pk.y), bf_hi(pre.pk.y)},
                        vpv = (f32x4){bf_lo(pre.pv.x), bf_hi(pre.pv.x), bf_lo(pre.pv.y), bf_hi(pre.pv.y)};
            r = r + mur * (rpv - r); k = k + muk * (kpv - k); v = v + muv * (vpv - v);
            f32x4 dec, asg, kk, km, av, bv;
            float ssq = 0.f, bon = 0.f;
#pragma unroll
            for (int i = 0; i < 4; ++i) {
                const float x = -aw[i];
                const float sp = fmaxf(x, 0.f) + __logf(1.0f + __expf(-fabsf(x)));
                const float wraw = -sp - 0.5f;
                dec[i] = -__expf(wraw);
                asg[i] = sigm(aa[i]);
                kk[i] = k[i] * kkv[i]; ssq += kk[i] * kk[i];
                km[i] = k[i] * (1.0f + (asg[i] - 1.0f) * kav[i]);
                bon += r[i] * km[i] * rkv[i];
            }
            ssq = sum16(ssq); bon = sum16(bon);
            const float inv = 1.0f / fmaxf(sqrtf(ssq), 1e-12f);
#pragma unroll
            for (int i = 0; i < 4; ++i) { kk[i] *= inv; av[i] = -kk[i]; bv[i] = kk[i] * asg[i]; }
            LAS float* sq_ = SEQ + tt * 384 + c4;
            *(LAS f32x4*)(sq_) = av; *(LAS f32x4*)(sq_ + 64) = dec; *(LAS f32x4*)(sq_ + 128) = bv; *(LAS f32x4*)(sq_ + 192) = km; *(LAS f32x4*)(sq_ + 256) = r; *(LAS f32x4*)(sq_ + 320) = v;
            if (tt < nb) {
                v2u w; w.x = cvt_pk_bf16(ag[0], ag[1]); w.y = cvt_pk_bf16(ag[2], ag[3]); *(v2u*)(GB + row * 512 + hc) = w;
                w.x = cvt_pk_bf16(bon * v[0], bon * v[1]); w.y = cvt_pk_bf16(bon * v[2], bon * v[3]); *(v2u*)(BV + row * 512 + hc) = w;
            }
        }
        int nunit = unit, nt0 = t0 + SC_TB, nui = ui; bool more = true;
        if (nt0 >= T) { nt0 = 0; nui = ui + 1; more = p1_unit_at(nui, vcu, G, nunit); }
        if (more) p1_load(A, nunit, nt0, tt, cs, pre);
        __syncthreads();
        if (!(MK_DBGSEL == 1 && part)) p1_wy(X, SEQ, YY, ZZ, lds, nb, tid, lane, wave, part);
        if (more) { *(LAS v4u*)(HIDB + tt * HID_STRIDE + cs * 16) = pre.pa0; *(LAS v4u*)(HIDB + tt * HID_STRIDE + cs * 16 + 8) = pre.pa1; }
        __syncthreads();
        if (tt < nb) {
            const f32x4 y = *(const LAS f32x4*)(YY + tt * 64 + c4), z = *(const LAS f32x4*)(ZZ + tt * 64 + c4);
            v2u w; w.x = cvt_pk_bf16(y[0], y[1]); w.y = cvt_pk_bf16(y[2], y[3]); *(v2u*)(YL + row * 512 + hc) = w;
            w.x = cvt_pk_bf16(z[0], z[1]); w.y = cvt_pk_bf16(z[2], z[3]); *(v2u*)(ZT + row * 512 + hc) = w;
        }
        if (t0 + SC_TB >= T) {
#pragma unroll
            for (int j = 0; j < 4; ++j) {
                if (!prow_wave) *(f32x4*)((float*)A.out + (size_t)unit * 4096 + (16 * wave + fr) * 64 + 16 * j + 4 * fq) = X[j];
                else { bf16* mt = (bf16*)((unsigned char*)A.out + OB_MB) + (size_t)unit * 4096 + (16 * j + 4 * fq) * 64 + 16 * (wave - 4) + fr;
                    const unsigned p01 = cvt_pk_bf16(X[j][0], X[j][1]), p23 = cvt_pk_bf16(X[j][2], X[j][3]);
                    mt[0] = (bf16)(p01 & 0xffffu); mt[64] = (bf16)(p01 >> 16); mt[128] = (bf16)(p23 & 0xffffu); mt[192] = (bf16)(p23 >> 16); }
            }
        }
        if (!more) break;
        unit = nunit; t0 = nt0; ui = nui;
    }
    __syncthreads();
}

constexpr int P2_SS = 72, P2_LO = 16 * P2_SS * 2, P2_BUF = 2 * P2_LO;
__device__ __forceinline__ void scan_pass2_rows(const float* Sinit, int unit0, int nchunks, int v0, float* outfin, bool slots, const Args& A, LAS unsigned char* lds, int tid, int lane, int wave) {
    LAS bf16* Shi = (LAS bf16*)lds; LAS bf16* Slo = (LAS bf16*)(lds + P2_LO);
    const int nt = wave & 3, fr = lane & 15, fq = lane >> 4; const bool act = wave < 4;
    float* NB = (float*)A.out; const bf16* MT = (const bf16*)((const unsigned char*)A.out + OB_MB);
    { const int idx = tid * 2, row = idx >> 6, col = idx & 63;
      const f32x2 s0 = Sinit ? *(const f32x2*)(Sinit + (size_t)(v0 + row) * 64 + col) : (f32x2){0.f, 0.f};
      const unsigned hi = cvt_pk_bf16(s0.x, s0.y);
      *(LAS unsigned*)(Shi + row * P2_SS + col) = hi; *(LAS unsigned*)(Slo + row * P2_SS + col) = cvt_pk_bf16(s0.x - bf_lo(hi), s0.y - bf_hi(hi)); }
    bf16x8 mr[4][2]; f32x4 nr[4];
    const size_t moff = (size_t)(16 * nt + fr) * 64 + fq * 8, noff = (size_t)(v0 + fr) * 64 + 16 * nt + 4 * fq;
#pragma unroll
    for (int d = 0; d < 4; ++d) {
        mr[d][0] = (bf16x8){0, 0, 0, 0, 0, 0, 0, 0}; mr[d][1] = mr[d][0]; nr[d] = (f32x4){0.f, 0.f, 0.f, 0.f};
        { const int cc = d < nchunks ? d : nchunks - 1;
            mr[d][0] = *(const bf16x8*)(MT + (size_t)(unit0 + cc) * 4096 + moff); mr[d][1] = *(const bf16x8*)(MT + (size_t)(unit0 + cc) * 4096 + moff + 32);
            nr[d] = *(const f32x4*)(NB + (size_t)(unit0 + cc) * 4096 + noff); }
    }
    f32x4 acc = (f32x4){0.f, 0.f, 0.f, 0.f};
    __syncthreads();
    for (int c0 = 0; c0 < nchunks; c0 += 4) {
#pragma unroll
        for (int d = 0; d < 4; ++d) {
            const int c = c0 + d;
            if (c < nchunks) {
                {
                    LAS bf16* Shi = (LAS bf16*)(lds + (d & 1) * P2_BUF); LAS bf16* Slo = (LAS bf16*)(lds + (d & 1) * P2_BUF + P2_LO);
                    const bf16x8 sh0 = *(const LAS bf16x8*)(Shi + fr * P2_SS + fq * 8), sh1 = *(const LAS bf16x8*)(Shi + fr * P2_SS + 32 + fq * 8),
                                 sl0 = *(const LAS bf16x8*)(Slo + fr * P2_SS + fq * 8), sl1 = *(const LAS bf16x8*)(Slo + fr * P2_SS + 32 + fq * 8);
                    acc = nr[d];
                    acc = __builtin_amdgcn_mfma_f32_16x16x32_bf16(mr[d][0], sh0, acc, 0, 0, 0); acc = __builtin_amdgcn_mfma_f32_16x16x32_bf16(mr[d][1], sh1, acc, 0, 0, 0);
                    acc = __builtin_amdgcn_mfma_f32_16x16x32_bf16(mr[d][0], sl0, acc, 0, 0, 0); acc = __builtin_amdgcn_mfma_f32_16x16x32_bf16(mr[d][1], sl1, acc, 0, 0, 0);
                    const int cn = c + 4 < nchunks ? c + 4 : nchunks - 1;
                    mr[d][0] = *(const bf16x8*)(MT + (size_t)(unit0 + cn) * 4096 + moff); mr[d][1] = *(const bf16x8*)(MT + (size_t)(unit0 + cn) * 4096 + moff + 32);
                    nr[d] = *(const f32x4*)(NB + (size_t)(unit0 + cn) * 4096 + noff);
                }
                if (act) {
                    LAS bf16* Shi = (LAS bf16*)(lds + ((d + 1) & 1) * P2_BUF); LAS bf16* Slo = (LAS bf16*)(lds + ((d + 1) & 1) * P2_BUF + P2_LO);
                    v2u hi; hi.x = cvt_pk_bf16(acc[0], acc[1]); hi.y = cvt_pk_bf16(acc[2], acc[3]);
                    v2u lo; lo.x = cvt_pk_bf16(acc[0] - bf_lo(hi.x), acc[1] - bf_hi(hi.x)); lo.y = cvt_pk_bf16(acc[2] - bf_lo(hi.y), acc[3] - bf_hi(hi.y));
                    *(LAS v2u*)(Shi + fr * P2_SS + 16 * nt + 4 * fq) = hi; *(LAS v2u*)(Slo + fr * P2_SS + 16 * nt + 4 * fq) = lo;
                    if (slots) *(v2u*)((bf16*)(NB + (size_t)(unit0 + c) * 4096) + (size_t)(v0 + fr) * 128 + 16 * nt + 4 * fq) = hi;
                }
                __syncthreads();
            }
        }
    }
    if (act) *(f32x4*)(outfin + noff) = acc;
    __syncthreads();
}

__device__ __forceinline__ void scan_pass2_sample(const float* Sinit, int unit, float* outfin, const Args& A, int lane, int wave) {
    const int fr = lane & 15, fq = lane >> 4, rt = wave >> 1;
    const float* NB = (const float*)A.out + (size_t)unit * 4096; const bf16* MT = (const bf16*)((const unsigned char*)A.out + OB_MB) + (size_t)unit * 4096;
    f32x4 sv[2][2];
#pragma unroll
    for (int ks = 0; ks < 2; ++ks) { const float* sp = Sinit + (size_t)(16 * rt + fr) * 64 + 32 * ks + 8 * fq; sv[ks][0] = *(const f32x4*)sp; sv[ks][1] = *(const f32x4*)(sp + 4); }
    bf16x8 mt[2][2]; f32x4 acc[2];
#pragma unroll
    for (int t = 0; t < 2; ++t) { const int nt = 2 * (wave & 1) + t;
        mt[t][0] = *(const bf16x8*)(MT + (size_t)(16 * nt + fr) * 64 + fq * 8); mt[t][1] = *(const bf16x8*)(MT + (size_t)(16 * nt + fr) * 64 + 32 + fq * 8);
        acc[t] = *(const f32x4*)(NB + (size_t)(16 * rt + fr) * 64 + 16 * nt + 4 * fq); }
    bf16x8 sh[2], sl[2];
#pragma unroll
    for (int ks = 0; ks < 2; ++ks) { const f32x4 a = sv[ks][0], b = sv[ks][1];
        v4u h; h.x = cvt_pk_bf16(a[0], a[1]); h.y = cvt_pk_bf16(a[2], a[3]); h.z = cvt_pk_bf16(b[0], b[1]); h.w = cvt_pk_bf16(b[2], b[3]);
        v4u l; l.x = cvt_pk_bf16(a[0] - bf_lo(h.x), a[1] - bf_hi(h.x)); l.y = cvt_pk_bf16(a[2] - bf_lo(h.y), a[3] - bf_hi(h.y));
        l.z = cvt_pk_bf16(b[0] - bf_lo(h.z), b[1] - bf_hi(h.z)); l.w = cvt_pk_bf16(b[2] - bf_lo(h.w), b[3] - bf_hi(h.w));
        sh[ks] = __builtin_bit_cast(bf16x8, h); sl[ks] = __builtin_bit_cast(bf16x8, l);
        if ((wave & 1) == 0) *(v4u*)((bf16*)((unsigned char*)A.out + OB_S0S) + (size_t)(unit - NUNITS_P) * 4096 + (size_t)(16 * rt + fr) * 64 + 32 * ks + 8 * fq) = h; }
#pragma unroll
    for (int t = 0; t < 2; ++t) { const int nt = 2 * (wave & 1) + t;
#pragma unroll
        for (int ks = 0; ks < 2; ++ks) { acc[t] = __builtin_amdgcn_mfma_f32_16x16x32_bf16(mt[t][ks], sh[ks], acc[t], 0, 0, 0); acc[t] = __builtin_amdgcn_mfma_f32_16x16x32_bf16(mt[t][ks], sl[ks], acc[t], 0, 0, 0); }
        *(f32x4*)(outfin + (size_t)(16 * rt + fr) * 64 + 16 * nt + 4 * fq) = acc[t]; }
}

__device__ __forceinline__ void scan_pass3_wave(const Args& A, int unit, int wq, int lane) {
    const bool prompt = unit < NUNITS_P;
    const int b = prompt ? unit >> 9 : (unit - NUNITS_P) >> 3, h = prompt ? (unit >> 6) & 7 : unit & 7, ch = prompt ? unit & 63 : 0;
    const int T = prompt ? 64 : SEQ_S, rowbase = prompt ? b * SEQ_P + ch * 64 : NPROMPT + b * SEQ_S;
    if (wq * 16 >= T) return;
    const bf16* S0 = prompt ? (ch > 0 ? (const bf16*)((const float*)A.out + (size_t)(unit - 1) * 4096) : (const bf16*)(A.ws + WS_CTL + 49152)) : (const bf16*)((const unsigned char*)A.out + OB_S0S) + (size_t)(b * 8 + h) * 4096;
    const int spitch = prompt ? 128 : 64;
    const bf16* ZT = (const bf16*)(A.ws + WS_ZT); const bf16* YL = (const bf16*)(A.ws + WS_YL); const bf16* BV = (const bf16*)(A.ws + WS_BV);
    bf16* YB = (bf16*)(A.ws + WS_A1) + (size_t)MPAD * 512;
    const int fr = lane & 15, fq = lane >> 4;
    const size_t row = (size_t)(rowbase + wq * 16 + fr);
    bf16x8 bz[2], sa[4][2]; v2u yl[4], bvw[4], gg[4]; f32x4 gw[4], gb[4];
#pragma unroll
    for (int ks = 0; ks < 2; ++ks) bz[ks] = *(const bf16x8*)(ZT + row * 512 + h * 64 + ks * 32 + fq * 8);
#pragma unroll
    for (int mt = 0; mt < 4; ++mt)
#pragma unroll
        for (int ks = 0; ks < 2; ++ks) sa[mt][ks] = *(const bf16x8*)(S0 + (size_t)(mt * 16 + fr) * spitch + ks * 32 + fq * 8);
#pragma unroll
    for (int mt = 0; mt < 4; ++mt) { const int c = h * 64 + mt * 16 + fq * 4;
        yl[mt] = *(const v2u*)(YL + row * 512 + c); bvw[mt] = *(const v2u*)(BV + row * 512 + c); gg[mt] = *(const v2u*)(YB + row * 512 + c);
        gw[mt] = *(const f32x4*)(A.in[I_GNW] + c); gb[mt] = *(const f32x4*)(A.in[I_GNB] + c); }
    f32x4 acc[4];
#pragma unroll
    for (int mt = 0; mt < 4; ++mt) { acc[mt] = (f32x4){0.f, 0.f, 0.f, 0.f};
#pragma unroll
        for (int ks = 0; ks < 2; ++ks) acc[mt] = __builtin_amdgcn_mfma_f32_16x16x32_bf16(sa[mt][ks], bz[ks], acc[mt], 0, 0, 0); }
    float sm = 0.f;
#pragma unroll
    for (int mt = 0; mt < 4; ++mt) { const v2u y = yl[mt];
        acc[mt][0] += bf_lo(y.x); acc[mt][1] += bf_hi(y.x); acc[mt][2] += bf_lo(y.y); acc[mt][3] += bf_hi(y.y);
        sm += (acc[mt][0] + acc[mt][1]) + (acc[mt][2] + acc[mt][3]); }
    sm += __shfl_xor(sm, 16); sm += __shfl_xor(sm, 32);
    const float mean = sm * (1.f / 64.f); float sv = 0.f;
#pragma unroll
    for (int mt = 0; mt < 4; ++mt) { acc[mt] = acc[mt] - mean; sv += (acc[mt][0] * acc[mt][0] + acc[mt][1] * acc[mt][1]) + (acc[mt][2] * acc[mt][2] + acc[mt][3] * acc[mt][3]); }
    sv += __shfl_xor(sv, 16); sv += __shfl_xor(sv, 32);
    const float rs = 1.0f / sqrtf(sv * (1.f / 64.f) + 64e-5f);
#pragma unroll
    for (int mt = 0; mt < 4; ++mt) { const int c = h * 64 + mt * 16 + fq * 4;
        f32x4 o = acc[mt] * rs * gw[mt] + gb[mt] + (f32x4){bf_lo(bvw[mt].x), bf_hi(bvw[mt].x), bf_lo(bvw[mt].y), bf_hi(bvw[mt].y)};
        o = o * (f32x4){bf_lo(gg[mt].x), bf_hi(gg[mt].x), bf_lo(gg[mt].y), bf_hi(gg[mt].y)};
        v2u w; w.x = cvt_pk_bf16(o[0], o[1]); w.y = cvt_pk_bf16(o[2], o[3]); *(v2u*)(YB + row * 512 + c) = w; }
}

__device__ __forceinline__ void tk_insert(float (&tv)[16], float x) {
#pragma unroll
    for (int i = 15; i >= 1; --i) tv[i] = __builtin_amdgcn_fmed3f(tv[i - 1], x, tv[i]);
    tv[0] = __builtin_fmaxf(tv[0], x);
}
#define TK_CE(t, i, j) { const float a_ = __builtin_fmaxf(t[i], t[j]); t[j] = __builtin_fminf(t[i], t[j]); t[i] = a_; }
__device__ __forceinline__ void tk_sort16(float (&t)[16]) {
    TK_CE(t, 0, 1) TK_CE(t, 2, 3) TK_CE(t, 0, 2) TK_CE(t, 1, 3) TK_CE(t, 1, 2) TK_CE(t, 4, 5) TK_CE(t, 6, 7) TK_CE(t, 4, 6) TK_CE(t, 5, 7) TK_CE(t, 5, 6) TK_CE(t, 0, 4) TK_CE(t, 2, 6) TK_CE(t, 2, 4) TK_CE(t, 1, 5) TK_CE(t, 3, 7) TK_CE(t, 3, 5) TK_CE(t, 1, 2) TK_CE(t, 3, 4) TK_CE(t, 5, 6) TK_CE(t, 8, 9) TK_CE(t, 10, 11) TK_CE(t, 8, 10) TK_CE(t, 9, 11) TK_CE(t, 9, 10) TK_CE(t, 12, 13) TK_CE(t, 14, 15) TK_CE(t, 12, 14) TK_CE(t, 13, 15) TK_CE(t, 13, 14) TK_CE(t, 8, 12) TK_CE(t, 10, 14) TK_CE(t, 10, 12) TK_CE(t, 9, 13) TK_CE(t, 11, 15) TK_CE(t, 11, 13) TK_CE(t, 9, 10) TK_CE(t, 11, 12) TK_CE(t, 13, 14) TK_CE(t, 0, 8) TK_CE(t, 4, 12) TK_CE(t, 4, 8) TK_CE(t, 2, 10) TK_CE(t, 6, 14) TK_CE(t, 6, 10) TK_CE(t, 2, 4) TK_CE(t, 6, 8) TK_CE(t, 10, 12) TK_CE(t, 1, 9) TK_CE(t, 5, 13) TK_CE(t, 5, 9) TK_CE(t, 3, 11) TK_CE(t, 7, 15) TK_CE(t, 7, 11) TK_CE(t, 3, 5) TK_CE(t, 7, 9) TK_CE(t, 11, 13) TK_CE(t, 1, 2) TK_CE(t, 3, 4) TK_CE(t, 5, 6) TK_CE(t, 7, 8) TK_CE(t, 9, 10) TK_CE(t, 11, 12) TK_CE(t, 13, 14)
}
__device__ __forceinline__ void tk_merge16(float (&tv)[16], const float (&g)[16]) {
#pragma unroll
    for (int i = 0; i < 16; ++i) tv[i] = __builtin_fmaxf(tv[i], g[15 - i]);
#pragma unroll
    for (int s = 8; s >= 1; s >>= 1)
#pragma unroll
        for (int i = 0; i < 16; ++i) if ((i & s) == 0) TK_CE(tv, i, i + s)
}
__device__ __forceinline__ float gelu_tanh(float x) {
    const float u = 0.7978845608028654f * (x + 0.044715f * x * x * x);
    const float th = 1.0f - 2.0f * __builtin_amdgcn_rcpf(__expf(2.0f * u) + 1.0f);
    return 0.5f * x * (1.0f + th);
}
constexpr int NTILE32 = NTOK / 32;
constexpr int CW_QU = 8192, CW_QV = 8192 + 512;

constexpr int TK_STRIDE = 68, TK_BYTES = 64 * TK_STRIDE * 4;
__device__ __forceinline__ void topk_scores64(const bf16* Q, const bf16* KB, LAS float* SC, int t0, int hp, int p, int half, int lane, const bf16x8 (&af)[2][2][4]) {
    const int fr = lane & 15, fq = lane >> 4;
#pragma unroll
    for (int hs = 0; hs < 2; ++hs) {
        const bf16* kbase = KB + (size_t)(((hp + 4 * hs) * 2 + p) * 128 + half * 64 + fr) * 128 + fq * 8;
#pragma unroll
        for (int n = 0; n < 4; ++n) {
            bf16x8 bfr[4];
#pragma unroll
            for (int ks = 0; ks < 4; ++ks) bfr[ks] = *(const bf16x8*)(kbase + (size_t)n * 16 * 128 + ks * 32);
            f32x4 acc0 = (f32x4){0.f, 0.f, 0.f, 0.f}, acc1 = acc0;
#pragma unroll
            for (int ks = 0; ks < 4; ++ks) { acc0 = __builtin_amdgcn_mfma_f32_16x16x32_bf16(af[hs][0][ks], bfr[ks], acc0, 0, 0, 0); acc1 = __builtin_amdgcn_mfma_f32_16x16x32_bf16(af[hs][1][ks], bfr[ks], acc1, 0, 0, 0); }
#pragma unroll
            for (int rg = 0; rg < 4; ++rg) { SC[(hs * 32 + fq * 4 + rg) * TK_STRIDE + n * 16 + fr] = acc0[rg]; SC[(hs * 32 + 16 + fq * 4 + rg) * TK_STRIDE + n * 16 + fr] = acc1[rg]; }
        }
    }
}
constexpr int TK_NPROMPT_UNITS = (NPROMPT / 32) * 4, TK_NSAMPLE_UNITS = (NSAMP / 32) * 4, CW_TKS = 9792;
__device__ __forceinline__ void peer_topk_units(const Args& A, LAS unsigned char* lds, int lane, int wave, int u_first, int u_end, int u_step) {
    const bf16* Q = (const bf16*)(A.ws + WS_ZG); const bf16* KB = (const bf16*)(A.ws + WS_KEYS); const float* SSP = (const float*)(A.ws + WS_SSP);
    unsigned short* EIDX = (unsigned short*)(A.ws + WS_EIDX); float* GATE = (float*)(A.ws + WS_GATE); float* RSTD = (float*)(A.ws + WS_RSTD);
    LAS float* SC = (LAS float*)(lds + wave * TK_BYTES);
    const int fr = lane & 15, fq = lane >> 4, tokl = lane & 31, hsel = lane >> 5;
    for (int u = u_first; u < u_end; u += u_step) {
        const int t0 = (u >> 2) * 32, hp = u & 3, h = hp + 4 * hsel;
        const float* sp = SSP + (size_t)(t0 + tokl) * 16;
        const f32x4 s0 = *(const f32x4*)sp, s1 = *(const f32x4*)(sp + 4), s2 = *(const f32x4*)(sp + 8), s3 = *(const f32x4*)(sp + 12);
        const float ssq = ((s0[0] + s0[1]) + (s0[2] + s0[3])) + ((s1[0] + s1[1]) + (s1[2] + s1[3])) + ((s2[0] + s2[1]) + (s2[2] + s2[3])) + ((s3[0] + s3[1]) + (s3[2] + s3[3]));
        const float rstd = 1.0f / sqrtf(ssq * (1.f / DM) + 1e-6f);
        float tv0[16], tv1[16], cv[16];
#pragma unroll
        for (int p = 0; p < 2; ++p) {
            bf16x8 af[2][2][4];
#pragma unroll
            for (int hs = 0; hs < 2; ++hs)
#pragma unroll
                for (int mt = 0; mt < 2; ++mt) { const bf16* qp = Q + (size_t)(t0 + mt * 16 + fr) * 2048 + (hp + 4 * hs) * 256 + p * 128 + fq * 8;
#pragma unroll
                    for (int ks = 0; ks < 4; ++ks) af[hs][mt][ks] = *(const bf16x8*)(qp + ks * 32); }
            float tv[16];
#pragma unroll
            for (int i = 0; i < 16; ++i) tv[i] = -3.0e38f;
            for (int half = 0; half < 2; ++half) {
                topk_scores64(Q, KB, SC, t0, hp, p, half, lane, af);
                LDS_WAIT();
                const LAS float* mine = SC + lane * TK_STRIDE;
                unsigned kmask = 0xFFFFFF80u; asm volatile("" : "+v"(kmask));
#pragma unroll 1
                for (int n = 0; n < 64; n += 16) {
                    float g[16];
#pragma unroll
                    for (int q = 0; q < 4; ++q) { const f32x4 x4 = *(const LAS f32x4*)(mine + n + 4 * q);
#pragma unroll
                        for (int e = 0; e < 4; ++e) g[4 * q + e] = __uint_as_float((__float_as_uint(x4[e]) & kmask) | (unsigned)(half * 64 + n + 4 * q + e)); }
                    tk_sort16(g); tk_merge16(tv, g);
                }
                LDS_WAIT();
            }
#pragma unroll
            for (int i = 0; i < 16; ++i) { if (p == 0) tv0[i] = tv[i]; else tv1[i] = tv[i]; }
        }
        LAS int* li = (LAS int*)SC + lane * 33;
#pragma unroll
        for (int q = 0; q < 16; ++q) { li[q] = (int)(__float_as_uint(tv0[q]) & 127u); li[16 + q] = (int)(__float_as_uint(tv1[q]) & 127u);
            tv0[q] = __uint_as_float(__float_as_uint(tv0[q]) & 0xFFFFFF80u); tv1[q] = __uint_as_float(__float_as_uint(tv1[q]) & 0xFFFFFF80u); }
#pragma unroll
        for (int q = 0; q < 16; ++q) cv[q] = -3.0e38f;
#pragma unroll
        for (int a = 0; a < 16; ++a)
#pragma unroll
            for (int b = 0; b < 16; ++b) if ((a + 1) * (b + 1) <= 16)
                tk_insert(cv, __uint_as_float((__float_as_uint(tv0[a] + tv1[b]) & 0xFFFFFF00u) | (unsigned)(a * 16 + b)));
        LDS_WAIT();
        float e[16], den = 0.f; unsigned ci[16];
        const float c0 = __uint_as_float(__float_as_uint(cv[0]) & 0xFFFFFF00u);
#pragma unroll
        for (int q = 0; q < 16; ++q) { const unsigned kb = __float_as_uint(cv[q]); const float cq = __uint_as_float(kb & 0xFFFFFF00u);
            e[q] = __expf((cq - c0) * rstd); den += e[q]; ci[q] = (unsigned)(li[(kb >> 4) & 15] * 128 + li[16 + (kb & 15)]); }
        const float inv = 1.0f / den;
        LDS_WAIT();
        {
            const size_t tok = (size_t)(t0 + tokl);
            v4u w0, w1; w0.x = ci[0] | (ci[1] << 16); w0.y = ci[2] | (ci[3] << 16); w0.z = ci[4] | (ci[5] << 16); w0.w = ci[6] | (ci[7] << 16);
            w1.x = ci[8] | (ci[9] << 16); w1.y = ci[10] | (ci[11] << 16); w1.z = ci[12] | (ci[13] << 16); w1.w = ci[14] | (ci[15] << 16);
            *(v4u*)(EIDX + tok * 128 + h * 16) = w0; *(v4u*)(EIDX + tok * 128 + h * 16 + 8) = w1;
#pragma unroll
            for (int q = 0; q < 4; ++q) *(f32x4*)(GATE + tok * 128 + h * 16 + 4 * q) = (f32x4){e[4 * q] * inv, e[4 * q + 1] * inv, e[4 * q + 2] * inv, e[4 * q + 3] * inv};
            if (h == 0) RSTD[tok] = rstd;
        }
    }
}

__device__ __forceinline__ bool peer_topk_split(int G) { return G == 256; }
__device__ __forceinline__ void peer_topk_phase(const Args& A, LAS unsigned char* lds, int tid, int lane, int wave, int vcu, int G) {
    peer_topk_units(A, lds, lane, wave, wave * G + vcu, peer_topk_split(G) ? TK_NPROMPT_UNITS : TK_NPROMPT_UNITS + TK_NSAMPLE_UNITS, G * NWAVES);
}
__device__ __forceinline__ void peer_topk_sample_prelude(const Args& A, LAS unsigned char* lds, int tid, int lane, int wave, int vcu, int G, gu32* ctl) {
    if (!peer_topk_split(G) || (vcu & 31) != 0) return;
    peer_topk_units(A, lds, lane, wave, TK_NPROMPT_UNITS + (vcu >> 5) * NWAVES + wave, TK_NPROMPT_UNITS + TK_NSAMPLE_UNITS, TK_NSAMPLE_UNITS);
    asm volatile("s_waitcnt vmcnt(0)" ::: "memory");
    __syncthreads();
    if (tid == 0) { __builtin_amdgcn_fence(__ATOMIC_RELEASE, "agent"); asm volatile("s_waitcnt vmcnt(0)" ::: "memory"); (void)__hip_atomic_fetch_add((unsigned*)(ctl + CW_TKS), 1u, RLX_AGENT); }
    __syncthreads();
}
__device__ __forceinline__ void peer_topk_sample_wait(gu32* ctl, int tid) {
    if (tid == 0) {
        unsigned sp = 0;
        while (__hip_atomic_load((unsigned*)(ctl + CW_TKS), RLX_AGENT) < (unsigned)(TK_NSAMPLE_UNITS / NWAVES)) { __builtin_amdgcn_s_sleep(2); if (++sp > (1u << 22)) break; }
        __builtin_amdgcn_fence(__ATOMIC_ACQUIRE, "agent");
        asm volatile("s_waitcnt vmcnt(0)" ::: "memory");
    }
    __syncthreads();
}

constexpr int PEER_ITEM = 80, NITEM128 = NTOK / PEER_ITEM;
__device__ __forceinline__ bool peer_next_item(gu32* qbase, int xcc, int& qs, int& slice, int& item, LAS unsigned char* lds, int tid) {
    LAS int* box = (LAS int*)(lds + LDSCTL_OFF + 64);
    for (;;) {
        if (qs >= 8) return false;
        slice = (xcc + qs) & 7;
        if (tid == 0) box[0] = (int)__hip_atomic_fetch_add((unsigned*)(qbase + 64 * slice), 1u, RLX_AGENT);
        __syncthreads();
        item = box[0];
        __syncthreads();
        if (item < NITEM128) return true;
        ++qs;
    }
}

typedef long i64_t;
constexpr float PEER_SX = 1.0f;
constexpr int U_TILE0 = 8192, U_TILEB = 16384;
__device__ __forceinline__ i64_t mk64(unsigned lo, unsigned hi) { return (i64_t)(((unsigned long long)hi << 32) | (unsigned long long)lo); }
__device__ __forceinline__ void peer_u_phase(const Args& A, LAS unsigned char* lds, int tid, int lane, int wave, gu32* ctl, int qoff) {
    const unsigned char* Uq = A.ws + WS_UB; const bf16* XG = (const bf16*)(A.ws + WS_A1);
    const unsigned short* EIDX = (const unsigned short*)(A.ws + WS_EIDX); bf16* PART = (bf16*)(A.ws + WS_PART);
    const int xcc = (int)(xb_xcc_id() & 7u), rg = lane >> 3, c8 = lane & 7, m = lane & 15, kq = lane >> 4;
    LAS int* we = (LAS int*)(lds + wave * 1024);
    LAS unsigned char* tile = lds + U_TILE0 + wave * U_TILEB;
    const int ch_e = ((c8 - (rg >> 1)) & 7) * 16, ch_o = ((c8 - 4 - (rg >> 1)) & 7) * 16;
    const int fbase = m * 128 + (kq & 1) * 8, pos0 = (kq >> 1) + (m >> 1);
    int foff[4];
#pragma unroll
    for (int ks = 0; ks < 4; ++ks) foff[ks] = fbase + ((pos0 + 2 * ks) & 7) * 16;
    int qs = 0, slice, item; bool lists_ready = !peer_topk_split((int)gridDim.x);
    while (peer_next_item(ctl + CW_QU + qoff, xcc, qs, slice, item, lds, tid)) {
        if (!lists_ready && (item + 1) * PEER_ITEM > NPROMPT) { peer_topk_sample_wait(ctl, tid); lists_ready = true; }
        const unsigned char* us = Uq + (size_t)slice * 16384 * 128;
        size_t tok = (size_t)(item * PEER_ITEM + wave);
        unsigned pair = *(const unsigned*)(EIDX + tok * 128 + 2 * lane);
        v4u xr[4];
#pragma unroll
        for (int ks = 0; ks < 4; ++ks) xr[ks] = *(const v4u*)(XG + tok * DM + slice * 128 + ks * 32 + kq * 8);
        we[2 * lane] = (int)(pair & 0xffffu); we[2 * lane + 1] = (int)(pair >> 16);
        LDS_WAIT();
        v4u w[16];
#pragma unroll
        for (int it = 0; it < 16; ++it) w[it] = *(const v4u*)(us + (unsigned)(((unsigned)we[it * 8 + rg] << 7) + (unsigned)((it & 1) ? ch_o : ch_e)));
        for (int tt = 0; tt < PEER_ITEM / NWAVES; ++tt) {
            const size_t ctok = tok; const bool more = tt + 1 < PEER_ITEM / NWAVES;
            i64_t bx[4];
#pragma unroll
            for (int ks = 0; ks < 4; ++ks) { const v4u q = xr[ks]; typedef short s16x2 __attribute__((ext_vector_type(2)));
                s16x2 lo = (s16x2){0, 0}, hi = lo;
                unsigned q0 = q.x, q1 = q.y, q2 = q.z, q3 = q.w; asm volatile("" : "+v"(q0), "+v"(q1), "+v"(q2), "+v"(q3));
                lo = __builtin_amdgcn_cvt_scalef32_pk_fp8_bf16(lo, __builtin_bit_cast(bf16x2_t, q0), PEER_SX, false); lo = __builtin_amdgcn_cvt_scalef32_pk_fp8_bf16(lo, __builtin_bit_cast(bf16x2_t, q1), PEER_SX, true);
                hi = __builtin_amdgcn_cvt_scalef32_pk_fp8_bf16(hi, __builtin_bit_cast(bf16x2_t, q2), PEER_SX, false); hi = __builtin_amdgcn_cvt_scalef32_pk_fp8_bf16(hi, __builtin_bit_cast(bf16x2_t, q3), PEER_SX, true);
                bx[ks] = mk64(__builtin_bit_cast(unsigned, lo), __builtin_bit_cast(unsigned, hi)); }
            if (more) { tok += NWAVES; pair = *(const unsigned*)(EIDX + tok * 128 + 2 * lane);
#pragma unroll
                for (int ks = 0; ks < 4; ++ks) xr[ks] = *(const v4u*)(XG + tok * DM + slice * 128 + ks * 32 + kq * 8); }
#pragma unroll
            for (int it = 0; it < 16; ++it) *(LAS v4u*)(tile + it * 1024 + lane * 16) = w[it];
            if (more) {
                we[2 * lane] = (int)(pair & 0xffffu); we[2 * lane + 1] = (int)(pair >> 16);
                LDS_WAIT();
#pragma unroll
                for (int it = 0; it < 16; ++it) w[it] = *(const v4u*)(us + (unsigned)(((unsigned)we[it * 8 + rg] << 7) + (unsigned)((it & 1) ? ch_o : ch_e)));
            } else LDS_WAIT();
            bf16* pp = PART + (ctok * 8 + slice) * 128;
            f32x4 acc[8];
#pragma unroll
            for (int hf = 0; hf < 2; ++hf) {
                v2u a[4][4];
#pragma unroll
                for (int T4 = 0; T4 < 4; ++T4)
#pragma unroll
                    for (int ks = 0; ks < 4; ++ks) a[T4][ks] = *(const LAS v2u*)(tile + (hf * 4 + T4) * 2048 + foff[ks]);
#pragma unroll
                for (int T4 = 0; T4 < 4; ++T4) acc[hf * 4 + T4] = (f32x4){0.f, 0.f, 0.f, 0.f};
#pragma unroll
                for (int ks = 0; ks < 4; ++ks)
#pragma unroll
                    for (int T4 = 0; T4 < 4; ++T4) acc[hf * 4 + T4] = __builtin_amdgcn_mfma_f32_16x16x32_fp8_fp8(mk64(a[T4][ks].x, a[T4][ks].y), bx[ks], acc[hf * 4 + T4], 0, 0, 0);
            }
            f32x4 val = acc[0];
#pragma unroll
            for (int T = 1; T < 8; ++T) val = ((m & 7) == T) ? acc[T] : val;
            if (m < 8) { v2u pw; pw.x = cvt_pk_bf16(val[0] * (1.0f / PEER_SX), val[1] * (1.0f / PEER_SX)); pw.y = cvt_pk_bf16(val[2] * (1.0f / PEER_SX), val[3] * (1.0f / PEER_SX)); *(v2u*)(pp + m * 16 + 4 * kq) = pw; }
            LDS_WAIT();
        }
    }
}

constexpr float PEER_CS = 64.0f;
__device__ __forceinline__ void peer_coef_phase(const Args& A, int lane, int wave, int vcu, int G) {
    const bf16* PART = (const bf16*)(A.ws + WS_PART); const float* GATE = (const float*)(A.ws + WS_GATE); const float* RSTD = (const float*)(A.ws + WS_RSTD);
    unsigned char* C8 = A.ws + WS_COEF;
    for (int tok = vcu * NWAVES + wave; tok < NTOK; tok += G * NWAVES) {
        const bf16* pp = PART + (size_t)tok * 1024 + 2 * lane;
        unsigned pw[8];
#pragma unroll
        for (int j = 0; j < 8; ++j) pw[j] = *(const unsigned*)(pp + j * 128);
        f32x2 d = (f32x2){bf_lo(pw[0]), bf_hi(pw[0])};
#pragma unroll
        for (int j = 1; j < 8; ++j) d += (f32x2){bf_lo(pw[j]), bf_hi(pw[j])};
        const float sc = RSTD[tok] * (1.0f / PEER_SU); const f32x2 gt = *(const f32x2*)(GATE + (size_t)tok * 128 + 2 * lane);
        f32x2 cf; cf.x = gt.x * gelu_tanh(d.x * sc) * (PEER_CS / PEER_SV); cf.y = gt.y * gelu_tanh(d.y * sc) * (PEER_CS / PEER_SV);
        const unsigned hi = (unsigned)__builtin_amdgcn_cvt_pk_fp8_f32(cf.x, cf.y, 0, false) & 0xffffu;
        const f32x2 bk = __builtin_amdgcn_cvt_pk_f32_fp8(hi, false);
        const unsigned lo = (unsigned)__builtin_amdgcn_cvt_pk_fp8_f32((cf.x - bk.x) * 16.0f, (cf.y - bk.y) * 16.0f, 0, false) & 0xffffu;
        *(unsigned short*)(C8 + (size_t)tok * 256 + 2 * lane) = (unsigned short)hi; *(unsigned short*)(C8 + (size_t)tok * 256 + 128 + 2 * lane) = (unsigned short)lo;
    }
}

typedef int v2i_t __attribute__((ext_vector_type(2)));
__device__ __forceinline__ void peer_v_phase(const Args& A, LAS unsigned char* lds, int tid, int lane, int wave, gu32* ctl) {
    const unsigned char* Vq = A.ws + WS_VB;
    const unsigned short* EIDX = (const unsigned short*)(A.ws + WS_EIDX); const unsigned char* C8 = A.ws + WS_COEF;
    float* X1 = A.out + O_Y; float* SS2 = (float*)(A.ws + WS_SS2); const bf16* XGv = (const bf16*)(A.ws + WS_A1);
    const int xcc = (int)(xb_xcc_id() & 7u), rg = lane >> 3, c8 = lane & 7, m = lane & 15, kq = lane >> 4;
    LAS int* we = (LAS int*)(lds + wave * 1024);
    LAS unsigned char* tile = lds + U_TILE0 + wave * U_TILEB;
    const int ch_e = ((c8 - (rg >> 1)) & 7) * 16, ch_o = ((c8 - 4 - (rg >> 1)) & 7) * 16;
    const int tr_r = (lane & 15) >> 1, tr_p = lane & 1, tr_rot = 4 * (kq & 1) + (tr_r >> 1);
    const int tbase = (8 * kq + tr_r) * 128 + 8 * tr_p;
    int toff[8];
#pragma unroll
    for (int j = 0; j < 8; ++j) toff[j] = tbase + ((j + tr_rot) & 7) * 16;
    int qs = 0, slice, item;
    while (peer_next_item(ctl + CW_QV, xcc, qs, slice, item, lds, tid)) {
        const unsigned char* vs = Vq + (size_t)slice * 16384 * 128;
        size_t tok = (size_t)(item * PEER_ITEM + wave);
        unsigned pair = *(const unsigned*)(EIDX + tok * 128 + 2 * lane);
        v2u cfr[4];
#pragma unroll
        for (int ks = 0; ks < 4; ++ks) cfr[ks] = *(const v2u*)(C8 + tok * 256 + (m & 1) * 128 + ks * 32 + kq * 8);
        const float rga = 1.0f / A.in[I_N2G][slice * 128 + lane], rgb = 1.0f / A.in[I_N2G][slice * 128 + 64 + lane];
        unsigned short xoa = XGv[tok * DM + slice * 128 + lane], xob = XGv[tok * DM + slice * 128 + 64 + lane];
        we[2 * lane] = (int)(pair & 0xffffu); we[2 * lane + 1] = (int)(pair >> 16);
        LDS_WAIT();
        v4u w[16];
#pragma unroll
        for (int it = 0; it < 16; ++it) w[it] = *(const v4u*)(vs + (unsigned)(((unsigned)we[it * 8 + rg] << 7) + (unsigned)((it & 1) ? ch_o : ch_e)));
        for (int tt = 0; tt < PEER_ITEM / NWAVES; ++tt) {
            const size_t ctok = tok; const bool more = tt + 1 < PEER_ITEM / NWAVES;
            i64_t af[4];
#pragma unroll
            for (int ks = 0; ks < 4; ++ks) af[ks] = mk64(cfr[ks].x, cfr[ks].y);
            const float xa = __uint_as_float((unsigned)xoa << 16) * rga, xb = __uint_as_float((unsigned)xob << 16) * rgb;
            if (more) { tok += NWAVES; pair = *(const unsigned*)(EIDX + tok * 128 + 2 * lane);
#pragma unroll
                for (int ks = 0; ks < 4; ++ks) cfr[ks] = *(const v2u*)(C8 + tok * 256 + (m & 1) * 128 + ks * 32 + kq * 8);
                xoa = XGv[tok * DM + slice * 128 + lane]; xob = XGv[tok * DM + slice * 128 + 64 + lane]; }
#pragma unroll
            for (int it = 0; it < 16; ++it) *(LAS v4u*)(tile + it * 1024 + lane * 16) = w[it];
            if (more) {
                we[2 * lane] = (int)(pair & 0xffffu); we[2 * lane + 1] = (int)(pair >> 16);
                LDS_WAIT();
#pragma unroll
                for (int it = 0; it < 16; ++it) w[it] = *(const v4u*)(vs + (unsigned)(((unsigned)we[it * 8 + rg] << 7) + (unsigned)((it & 1) ? ch_o : ch_e)));
            } else LDS_WAIT();
            f32x4 acc[8];
#pragma unroll
            for (int hf = 0; hf < 2; ++hf) {
                v2i_t b[4][4];
#pragma unroll
                for (int j4 = 0; j4 < 4; ++j4)
#pragma unroll
                    for (int ks = 0; ks < 4; ++ks) b[j4][ks] = __builtin_amdgcn_ds_read_tr8_b64_v2i32((LAS v2i_t*)(tile + ks * 4096 + toff[hf * 4 + j4]));
#pragma unroll
                for (int j4 = 0; j4 < 4; ++j4) acc[hf * 4 + j4] = (f32x4){0.f, 0.f, 0.f, 0.f};
#pragma unroll
                for (int ks = 0; ks < 4; ++ks)
#pragma unroll
                    for (int j4 = 0; j4 < 4; ++j4) acc[hf * 4 + j4] = __builtin_amdgcn_mfma_f32_16x16x32_fp8_fp8(af[ks], mk64((unsigned)b[j4][ks].x, (unsigned)b[j4][ks].y), acc[hf * 4 + j4], 0, 0, 0);
            }
            float h0 = acc[0][0], l0 = acc[0][1], h1 = acc[4][0], l1 = acc[4][1];
#pragma unroll
            for (int j = 1; j < 4; ++j) { const bool s = kq == j; h0 = s ? acc[j][0] : h0; l0 = s ? acc[j][1] : l0; h1 = s ? acc[4 + j][0] : h1; l1 = s ? acc[4 + j][1] : l1; }
            const float x2a = xa + (h0 + l0 * (1.0f / 16.0f)) * (1.0f / PEER_CS), x2b = xb + (h1 + l1 * (1.0f / 16.0f)) * (1.0f / PEER_CS);
            { bf16* xr_ = (bf16*)X1 + ctok * (2 * DM) + slice * 128 + lane;
              xr_[0] = (bf16)(cvt_pk_bf16(x2a, x2a) & 0xffffu); xr_[64] = (bf16)(cvt_pk_bf16(x2b, x2b) & 0xffffu); }
            float ss = sum16(x2a * x2a + x2b * x2b); ss += __shfl_xor(ss, 16); ss += __shfl_xor(ss, 32);
            if (lane == 0) SS2[ctok * 8 + slice] = ss;
            LDS_WAIT();
        }
    }
}

__device__ __forceinline__ void peer_final_phase(const Args& A, int lane, int wave, int vcu, int G) {
    float* X1 = A.out + O_Y; const float* SS2 = (const float*)(A.ws + WS_SS2); const float* gf = A.in[I_NFG] + lane * 16;
    const f32x4 g0 = *(const f32x4*)gf, g1 = *(const f32x4*)(gf + 4), g2 = *(const f32x4*)(gf + 8), g3 = *(const f32x4*)(gf + 12);
    for (int tok = vcu * NWAVES + wave; tok < NTOK; tok += G * NWAVES) {
        const f32x4 sa = *(const f32x4*)(SS2 + (size_t)tok * 8), sb = *(const f32x4*)(SS2 + (size_t)tok * 8 + 4);
        const float ss = ((sa[0] + sa[1]) + (sa[2] + sa[3])) + ((sb[0] + sb[1]) + (sb[2] + sb[3]));
        const float rf = 1.0f / sqrtf(ss * (1.f / DM) + 1e-6f);
        float* yr = X1 + (size_t)tok * DM + lane * 16;
        const v4u s0 = *(const v4u*)((const bf16*)(X1 + (size_t)tok * DM) + lane * 16), s1 = *(const v4u*)((const bf16*)(X1 + (size_t)tok * DM) + lane * 16 + 8);
        const f32x4 y0 = (f32x4){bf_lo(s0.x), bf_hi(s0.x), bf_lo(s0.y), bf_hi(s0.y)}, y1 = (f32x4){bf_lo(s0.z), bf_hi(s0.z), bf_lo(s0.w), bf_hi(s0.w)},
                    y2 = (f32x4){bf_lo(s1.x), bf_hi(s1.x), bf_lo(s1.y), bf_hi(s1.y)}, y3 = (f32x4){bf_lo(s1.z), bf_hi(s1.z), bf_lo(s1.w), bf_hi(s1.w)};
        *(f32x4*)yr = y0 * rf * g0; *(f32x4*)(yr + 4) = y1 * rf * g1; *(f32x4*)(yr + 8) = y2 * rf * g2; *(f32x4*)(yr + 12) = y3 * rf * g3;
    }
}

__device__ __forceinline__ void sg_partial(const bf16* Ap, int lda, const bf16* Bp, int ldb, LAS f32x4* red, int lane, int wave) {
    const int fr = lane & 15, fq = lane >> 4;
    bf16x8 a[2][4], b[4][4];
#pragma unroll
    for (int mi = 0; mi < 2; ++mi)
#pragma unroll
        for (int ks = 0; ks < 4; ++ks) a[mi][ks] = *(const bf16x8*)(Ap + (size_t)(16 * mi + fr) * lda + 32 * ks + 8 * fq);
#pragma unroll
    for (int nj = 0; nj < 4; ++nj)
#pragma unroll
        for (int ks = 0; ks < 4; ++ks) b[nj][ks] = *(const bf16x8*)(Bp + (size_t)(16 * nj + fr) * ldb + 32 * ks + 8 * fq);
    f32x4 acc[2][4];
#pragma unroll
    for (int mi = 0; mi < 2; ++mi)
#pragma unroll
        for (int nj = 0; nj < 4; ++nj) acc[mi][nj] = (f32x4){0.f, 0.f, 0.f, 0.f};
#pragma unroll
    for (int ks = 0; ks < 4; ++ks)
#pragma unroll
        for (int mi = 0; mi < 2; ++mi)
#pragma unroll
            for (int nj = 0; nj < 4; ++nj) acc[mi][nj] = __builtin_amdgcn_mfma_f32_16x16x32_bf16(b[nj][ks], a[mi][ks], acc[mi][nj], 0, 0, 0);
#pragma unroll
    for (int mi = 0; mi < 2; ++mi)
#pragma unroll
        for (int nj = 0; nj < 4; ++nj) red[(wave * 8 + mi * 4 + nj) * 64 + lane] = acc[mi][nj];
}
__device__ __forceinline__ f32x4 sg_sum(const LAS f32x4* red, int w0, int nw, int wave, int lane) {
    f32x4 s = red[(w0 * 8 + wave) * 64 + lane];
    for (int w = 1; w < nw; ++w) s += red[((w0 + w) * 8 + wave) * 64 + lane];
    return s;
}
__device__ __forceinline__ void sample_gemm2(const Args& A, LAS unsigned char* lds, int t, int lane, int wave) {
    unsigned char* ws = A.ws; const int fr = lane & 15, fq = lane >> 4;
    const int row0 = NPROMPT + (t >> 4) * 32, col0 = (t & 15) * 64;
    LAS f32x4* red = (LAS f32x4*)lds;
    const bf16* Ab = (const bf16*)(ws + WS_A1) + (wave >= 4 ? (size_t)MPAD * 512 : 0); const bf16* Bb = (const bf16*)(ws + (wave >= 4 ? WS_WPB : WS_WPA));
    sg_partial(Ab + (size_t)row0 * 512 + (wave & 3) * 128, 512, Bb + (size_t)col0 * 512 + (wave & 3) * 128, 512, red, lane, wave);
    const int row = row0 + 16 * (wave >> 2) + fr, c = col0 + 16 * (wave & 3) + 4 * fq;
    const bf16* Zg = (const bf16*)(ws + WS_ZG) + (size_t)row * 2048;
    const v2u ga = *(const v2u*)(Zg + c), gb = *(const v2u*)(Zg + 1024 + c);
    __syncthreads();
    const f32x4 pa = sg_sum(red, 0, 4, wave, lane), pb = sg_sum(red, 4, 4, wave, lane);
    const float o0 = sigm(bf_lo(ga.x)) * pa[0] + sigm(bf_lo(gb.x)) * pb[0], o1 = sigm(bf_hi(ga.x)) * pa[1] + sigm(bf_hi(gb.x)) * pb[1],
                o2 = sigm(bf_lo(ga.y)) * pa[2] + sigm(bf_lo(gb.y)) * pb[2], o3 = sigm(bf_hi(ga.y)) * pa[3] + sigm(bf_hi(gb.y)) * pb[3];
    v2u w; w.x = cvt_pk_bf16(o0, o1); w.y = cvt_pk_bf16(o2, o3); *(v2u*)((bf16*)(ws + WS_ZR) + (size_t)row * 1024 + c) = w;
    __syncthreads();
}
__device__ __forceinline__ void sample_gemm3(const Args& A, LAS unsigned char* lds, int t, int tid, int lane, int wave) {
    unsigned char* ws = A.ws; const int fr = lane & 15, fq = lane >> 4;
    const int row0 = NPROMPT + (t >> 4) * 32, col0 = (t & 15) * 64;
    LAS f32x4* red = (LAS f32x4*)lds; LAS float* ssl = (LAS float*)(lds + 65536);
    sg_partial((const bf16*)(ws + WS_ZR) + (size_t)row0 * 1024 + wave * 128, 1024, (const bf16*)(ws + WS_WO) + (size_t)col0 * 1024 + wave * 128, 1024, red, lane, wave);
    const int row = row0 + 16 * (wave >> 2) + fr, c = col0 + 16 * (wave & 3) + 4 * fq;
    const f32x4 xv = *(const f32x4*)(A.in[I_XS] + (size_t)(row - NPROMPT) * 1024 + c), q = *(const f32x4*)(A.in[I_N2G] + c);
    __syncthreads();
    const f32x4 o = xv + sg_sum(red, 0, 8, wave, lane);
    float ss = (o[0] * o[0] + o[1] * o[1]) + (o[2] * o[2] + o[3] * o[3]);
    v2u w; w.x = cvt_pk_bf16(o[0] * q[0], o[1] * q[1]); w.y = cvt_pk_bf16(o[2] * q[2], o[3] * q[3]); *(v2u*)((bf16*)(ws + WS_A1) + (size_t)row * 1024 + c) = w;
    ss += __shfl_xor(ss, 16); ss += __shfl_xor(ss, 32);
    if (fq == 0) ssl[wave * 16 + fr] = ss;
    __syncthreads();
    if (tid < 32) { const int mi = tid >> 4, r = tid & 15;
        ((float*)(ws + WS_SSP))[(size_t)(row0 + tid) * 16 + (t & 15)] = (ssl[(mi * 4 + 0) * 16 + r] + ssl[(mi * 4 + 1) * 16 + r]) + (ssl[(mi * 4 + 2) * 16 + r] + ssl[(mi * 4 + 3) * 16 + r]); }
}
__device__ __forceinline__ void sample_gemm4(const Args& A, LAS unsigned char* lds, int t, int lane, int wave) {
    unsigned char* ws = A.ws; const int fr = lane & 15, fq = lane >> 4;
    const int row0 = NPROMPT + (t >> 5) * 32, col0 = (t & 31) * 64;
    LAS f32x4* red = (LAS f32x4*)lds;
    sg_partial((const bf16*)(ws + WS_A1) + (size_t)row0 * 1024 + wave * 128, 1024, (const bf16*)(ws + WS_WQ) + (size_t)col0 * 1024 + wave * 128, 1024, red, lane, wave);
    const int row = row0 + 16 * (wave >> 2) + fr, c = col0 + 16 * (wave & 3) + 4 * fq;
    __syncthreads();
    const f32x4 o = sg_sum(red, 0, 8, wave, lane);
    v2u w; w.x = cvt_pk_bf16(o[0], o[1]); w.y = cvt_pk_bf16(o[2], o[3]); *(v2u*)((bf16*)(ws + WS_ZG) + (size_t)row * 2048 + c) = w;
    __syncthreads();
}

__global__ void __launch_bounds__(NTHR, 2) mk_fwd(Args args) {
    extern __shared__ __attribute__((aligned(16))) unsigned char lds_raw[];
    LAS unsigned char* lds = (LAS unsigned char*)lds_raw;
    const int tid = threadIdx.x, lane = tid & 63, wave = __builtin_amdgcn_readfirstlane(tid >> 6);
    const int G = gridDim.x; const int bx = blockIdx.x; const int vcu = (G % 8 == 0) ? (bx % 8) * (G / 8) + bx / 8 : bx;
    gu32* ctl = (gu32*)(args.ws + WS_CTL);
    volatile LAS unsigned* MISC = (volatile LAS unsigned*)(lds + MISC_OFF);
    for (int u = tid; u < (LDS_BYTES - LDSCTL_OFF) / 4; u += NTHR) ((LAS unsigned*)(lds + LDSCTL_OFF))[u] = 0u;
    __syncthreads();
    XcdBarrier bar; bar.bar = (unsigned*)(ctl + CW_BAR) + args.li * XCD_BAR_WORDS; bar.x = 0; bar.st = nullptr;
    if (N_LAUNCHES != PER_PHASE) bar = xcd_barrier_post((unsigned*)(ctl + CW_BAR) + args.li * XCD_BAR_WORDS, MISC + 8);
    const int lo = args.ph_lo, hi = args.ph_hi;
#define IN(k) (lo <= (k) && (k) < hi)
#define BOTH(k) (IN(k) && IN((k) + 1))
#define GRID_BAR() do { if (N_LAUNCHES != PER_PHASE) xcd_barrier(bar); } while (0)
    unsigned char* ws = args.ws;
    bf16* A1 = (bf16*)(ws + WS_A1);

    if (IN(0)) for (int rep_ = 0; rep_ < ((MK_REPEAT == 0) ? 2 : 1); ++rep_) { p0_prologue(args, lds, tid, lane, wave, vcu, G); if (BOTH(0)) GRID_BAR(); }

    if (IN(1)) for (int rep_ = 0; rep_ < ((MK_REPEAT == 1) ? 2 : 1); ++rep_) {
        pg8::Gemm g{A1, (const bf16*)(ws + WS_W1T), MPAD, N1, DM}; pg8::StaticOrder S; S.init(MPAD, N1, G, bx);
        pg8::EpiZ E{(bf16*)(ws + WS_ZC), (bf16*)(ws + WS_ZR), (bf16*)(ws + WS_ZG)};
        pg8::gemm_phase<pg8::EpiZ, pg8::StaticOrder, true, true>(lds, g, S, E);
        if (BOTH(1)) GRID_BAR();
    }

    if (IN(2)) for (int rep_ = 0; rep_ < ((MK_REPEAT == 2) ? 2 : 1); ++rep_) { conv_phase(args, vcu * NTHR + tid, G * NTHR); if (BOTH(2)) GRID_BAR(); }

    if (IN(3)) for (int rep_ = 0; rep_ < ((MK_REPEAT == 3) ? 2 : 1); ++rep_) {
        scan_pass1(args, lds, tid, lane, wave, vcu, G, (MK_REPEAT == 3 && rep_ == 0) ? 1 : 0);
        if (BOTH(3)) GRID_BAR();
    }

    if (IN(4)) {
        for (int u = vcu; u < 512; u += G) {
            if (u < 256) { const int bh = u >> 2, vq = u & 3; scan_pass2_rows(nullptr, bh * 64, 64, vq * 16, args.out + O_WKV_P + (size_t)bh * 4096, true, args, lds, tid, lane, wave); }
            else { const int bh = u - 256; scan_pass2_sample(args.in[I_SWKV] + (size_t)bh * 4096, NUNITS_P + bh, args.out + O_WKV_S + (size_t)bh * 4096, args, lane, wave); }
        }
        if (BOTH(4)) GRID_BAR();
    }

    if (IN(5)) for (int rep_ = 0; rep_ < ((MK_REPEAT == 5) ? 2 : 1); ++rep_) {
        for (int u2 = vcu; u2 < NUNITS / 2; u2 += G) scan_pass3_wave(args, u2 * 2 + (wave >> 2), wave & 3, lane);
        if (BOTH(5)) GRID_BAR();
    }

    if (IN(6)) {
        { pg8::Gemm g{A1, (const bf16*)(ws + WS_WPA), NPROMPT, DM, 512}; pg8::StaticOrder S; S.init(NPROMPT, DM, G, bx);
          pg8::EpiGate<0> E{(const bf16*)(ws + WS_ZG), (bf16*)(ws + WS_ZR)};
          pg8::gemm_phase<pg8::EpiGate<0>, pg8::StaticOrder, true, true>(lds, g, S, E); }
        { pg8::Gemm g{A1 + (size_t)MPAD * 512, (const bf16*)(ws + WS_WPB), NPROMPT, DM, 512}; pg8::StaticOrder S; S.init(NPROMPT, DM, G, bx);
          pg8::EpiGate<1> E{(const bf16*)(ws + WS_ZG), (bf16*)(ws + WS_ZR)};
          pg8::gemm_phase<pg8::EpiGate<1>, pg8::StaticOrder, true, true>(lds, g, S, E); }
        for (int t = vcu; t < 256; t += G) sample_gemm2(args, lds, t, lane, wave);
        if (BOTH(6)) GRID_BAR();
    }

    if (IN(7)) for (int rep_ = 0; rep_ < ((MK_REPEAT == 7) ? 2 : 1); ++rep_) {
        pg8::Gemm g{(const bf16*)(ws + WS_ZR), (const bf16*)(ws + WS_WO), NPROMPT, DM, DM}; pg8::StaticOrder S; S.init(NPROMPT, DM, G, bx);
        pg8::EpiX1 E{args.in[I_XP], args.in[I_XS], args.out + O_Y, A1, (float*)(ws + WS_SSP), args.in[I_N2G], NPROMPT, NTOK};
        pg8::gemm_phase<pg8::EpiX1, pg8::StaticOrder, true, true>(lds, g, S, E);
        for (int t = vcu; t < 256; t += G) sample_gemm3(args, lds, t, tid, lane, wave);
        if (BOTH(7)) GRID_BAR();
    }

    if (IN(8)) for (int rep_ = 0; rep_ < ((MK_REPEAT == 8) ? 2 : 1); ++rep_) {
        pg8::Gemm g{A1, (const bf16*)(ws + WS_WQ), NPROMPT, 2048, DM}; pg8::StaticOrder S; S.init(NPROMPT, 2048, G, bx);
        pg8::EpiPlain E{(bf16*)(ws + WS_ZG), 2048};
        pg8::gemm_phase<pg8::EpiPlain, pg8::StaticOrder, true, true>(lds, g, S, E);
        for (int t = vcu; t < 512; t += G) sample_gemm4(args, lds, t, lane, wave);
        if (BOTH(8)) GRID_BAR();
    }

    if (IN(9)) for (int rep_ = 0; rep_ < ((MK_REPEAT == 9) ? 2 : 1); ++rep_) { peer_topk_phase(args, lds, tid, lane, wave, vcu, G); if (BOTH(9)) GRID_BAR(); }
    if (IN(10)) for (int rep_ = 0; rep_ < ((MK_REPEAT == 10) ? 2 : 1); ++rep_) { if (rep_ == 0) peer_topk_sample_prelude(args, lds, tid, lane, wave, vcu, G, ctl); peer_u_phase(args, lds, tid, lane, wave, ctl, rep_ * 1024); if (BOTH(10)) GRID_BAR(); }
    if (IN(11)) { peer_coef_phase(args, lane, wave, vcu, G); if (BOTH(11)) GRID_BAR(); }
    if (IN(12)) { peer_v_phase(args, lds, tid, lane, wave, ctl); if (BOTH(12)) GRID_BAR(); }
    if (IN(13)) peer_final_phase(args, lane, wave, vcu, G);
#undef IN
#undef BOTH
#undef GRID_BAR
}

extern "C" void kernel_launch(void* const* d_in, const int* in_sizes, int n_in, void* d_out, int out_size, void* d_ws, size_t ws_size, hipStream_t stream) {
    static int grid = 0;
    if (grid == 0) {
        if (n_in != 32 || ws_size < WS_END) { fprintf(stderr, "kernel_launch: built for 32 inputs and >= %zu bytes of workspace; got n_in %d ws %zu; nothing launched\n", (size_t)WS_END, n_in, ws_size); grid = -1; return; }
        int dev = 0, cus = 0, per_cu = 0;
        if (hipGetDevice(&dev) != hipSuccess || hipDeviceGetAttribute(&cus, hipDeviceAttributeMultiprocessorCount, dev) != hipSuccess) { fprintf(stderr, "kernel_launch: device query failed\n"); grid = -1; return; }
        if (hipFuncSetAttribute((const void*)mk_fwd, hipFuncAttributeMaxDynamicSharedMemorySize, LDS_BYTES) != hipSuccess) { fprintf(stderr, "kernel_launch: hipFuncSetAttribute failed\n"); grid = -1; return; }
        if (hipOccupancyMaxActiveBlocksPerMultiprocessor(&per_cu, (const void*)mk_fwd, NTHR, LDS_BYTES) != hipSuccess || per_cu < 1)
            fprintf(stderr, "kernel_launch: note: occupancy query reports %d workgroups per CU\n", per_cu);
        (void)hipGetLastError();
        grid = cus;
    }
    if (grid < 0) return;
    if (hipMemsetAsync((char*)d_ws + WS_CTL, 0, CTL_ZERO_BYTES, stream) != hipSuccess) { fprintf(stderr, "kernel_launch: hipMemsetAsync failed\n"); return; }
    Args a{};
    for (int i = 0; i < 32; ++i) a.in[i] = (const float*)d_in[i];
    a.out = (float*)d_out; a.ws = (unsigned char*)d_ws;
    constexpr int NL = (N_LAUNCHES == PER_PHASE ? PER_PHASE : 1) + ((MK_EXTRA_LO >= 0) ? 1 : 0);
    for (int li = 0; li < NL; ++li) {
        if (N_LAUNCHES == PER_PHASE) { a.ph_lo = li; a.ph_hi = li + 1; } else { a.ph_lo = 0; a.ph_hi = PER_PHASE; }
        if (MK_EXTRA_LO >= 0 && li == NL - 1) { a.ph_lo = MK_EXTRA_LO; a.ph_hi = MK_EXTRA_HI; }
        a.li = li;
        hipLaunchKernelGGL(mk_fwd, dim3(grid), dim3(NTHR), LDS_BYTES, stream, a);
        const hipError_t le = hipPeekAtLastError();
        if (le != hipSuccess) { fprintf(stderr, "kernel_launch: launch %d failed: %s\n", li, hipGetErrorName(le)); break; }
    }
}
```

```cpp
#include <hip/hip_runtime.h>
#include <cstdio>
#include <cstdint>
#define MK_N_LAUNCHES 1
#define MK_REPEAT -1
#define MK_DBGSEL 0
#define MK_EXTRA_LO -1
#define MK_EXTRA_HI -1
namespace pg8 {
#define PG8_LAS __attribute__((address_space(3)))
typedef unsigned short bf16_t;
typedef short bf16x8 __attribute__((ext_vector_type(8)));
typedef float f32x4 __attribute__((ext_vector_type(4)));
typedef unsigned u32x4 __attribute__((ext_vector_type(4)));
constexpr int BM = 256, BK = 64, HALF = 128, HTB = HALF * BK * 2  , STAGE_BYTES = 8 * HTB, NXCD = 8, WGM = 8;

__host__ __device__ __forceinline__ int lds_byte(int r, int c) { const int st = (r >> 4) * 2 + (c >> 5), rr = r & 15, cc = c & 31, ob = rr * 64 + cc * 2; return st * 1024 + (ob ^ (((ob >> 9) & 1) << 5)); }
__host__ __device__ __forceinline__ void stage_rc(int b, int& R, int& C) { const int st = b / 1024, sb = b % 1024, swz = sb ^ (((sb >> 9) & 1) << 5); R = (st >> 1) * 16 + swz / 64; C = (st & 1) * 32 + (swz % 64) / 2; }
__host__ __device__ __forceinline__ int perm32(int rho) { const int n = rho >> 4, i = rho & 15; return 8 * (i >> 2) + 4 * n + (i & 3); }

struct Unit { int pm, pn; };
struct Gemm { const bf16_t* A; const bf16_t* Bt; int M, N, K; };

struct StaticOrder {
    int nM, nN, nwg, G, c;
    __host__ __device__ void init(int M, int N, int G_, int c_) { nM = M / BM; nN = N / BM; nwg = nM * nN; G = G_; c = c_; }
    __host__ __device__ bool next(int i, Unit& u) const {
        const long L = (long)i * G + c; if (L >= nwg) return false;
        int wgid = (int)L; { const int q = nwg / NXCD, r = nwg % NXCD, xcd = wgid % NXCD, off = wgid / NXCD; wgid = (xcd < r ? xcd * (q + 1) : r * (q + 1) + (xcd - r) * q) + off; }
        const int nig = WGM * nN, gid = wgid / nig, fm = gid * WGM, gsz = (nM - fm) < WGM ? (nM - fm) : WGM;
        u.pm = fm + ((wgid % nig) % gsz); u.pn = (wgid % nig) / gsz; return true;
    }
    __device__ __forceinline__ void a_ready(const Unit&) const {}
    __device__ __forceinline__ void done(const Unit&) const {}
};

typedef __bf16 bf16x2_cv __attribute__((ext_vector_type(2))); typedef float f32x2_cv __attribute__((ext_vector_type(2)));
__device__ __forceinline__ unsigned cvt_pk_bf16(float lo, float hi) { return __builtin_bit_cast(unsigned, __builtin_convertvector((f32x2_cv){lo, hi}, bf16x2_cv)); }
__device__ __forceinline__ float bf_lo(unsigned w) { return __uint_as_float(w << 16); }
__device__ __forceinline__ float bf_hi(unsigned w) { return __uint_as_float(w & 0xffff0000u); }
__device__ __forceinline__ float sigm(float x) { return __builtin_amdgcn_rcpf(1.0f + __expf(-x)); }

struct EpiZ {
    static constexpr bool PERM = true, AFTER_DRAIN = false;
    bf16_t *Zc, *Zr, *Zg;
    __device__ __forceinline__ void operator()(const f32x4 (&acc)[2][2][4][2], const Unit& u, int wr, int wc, int fr, int fq) const {
        typedef unsigned u32x2e __attribute__((ext_vector_type(2)));
        const int row0 = u.pm * BM + wr * 64 + fr;
        if (u.pn >= 2 && u.pn < 6) {
#pragma unroll
            for (int ai = 0; ai < 2; ++ai)
#pragma unroll
                for (int m = 0; m < 4; ++m) { bf16_t* rowp = Zc + (size_t)(row0 + ai * HALF + m * 16) * 1024 + 512 + (u.pn - 2) * 128 + wc * 16 + 4 * fq;
#pragma unroll
                    for (int bj = 0; bj < 2; ++bj) { const f32x4 v0 = acc[ai][bj][m][0], v1 = acc[ai][bj][m][1];
                        u32x2e w; w.x = cvt_pk_bf16(v0[0] * v0[1], v0[2] * v0[3]); w.y = cvt_pk_bf16(v1[0] * v1[1], v1[2] * v1[3]);
                        *(u32x2e*)(rowp + bj * 64) = w; } }
            return;
        }
        bf16_t* base; int ldc, colt;
        if (u.pn < 2) { base = Zc; ldc = 1024; colt = u.pn * BM; }
        else if (u.pn < 14) { base = Zr; ldc = 2048; colt = (u.pn - 6) * BM; }
        else { base = Zg; ldc = 2048; colt = (u.pn - 14) * BM; }
        const int col0 = colt + wc * 32 + 8 * fq;
#pragma unroll
        for (int ai = 0; ai < 2; ++ai)
#pragma unroll
            for (int m = 0; m < 4; ++m) { bf16_t* rowp = base + (size_t)(row0 + ai * HALF + m * 16) * ldc + col0;
#pragma unroll
                for (int bj = 0; bj < 2; ++bj) { const f32x4 v0 = acc[ai][bj][m][0], v1 = acc[ai][bj][m][1];
                    u32x4 w; w.x = cvt_pk_bf16(v0[0], v0[1]); w.y = cvt_pk_bf16(v0[2], v0[3]); w.z = cvt_pk_bf16(v1[0], v1[1]); w.w = cvt_pk_bf16(v1[2], v1[3]);
                    *(u32x4*)(rowp + bj * HALF) = w; } }
    }
};
struct EpiPlain {
    static constexpr bool PERM = true, AFTER_DRAIN = false;
    bf16_t* O; int ldc;
    __device__ __forceinline__ void operator()(const f32x4 (&acc)[2][2][4][2], const Unit& u, int wr, int wc, int fr, int fq) const {
        const int row0 = u.pm * BM + wr * 64 + fr, col0 = u.pn * BM + wc * 32 + 8 * fq;
#pragma unroll
        for (int ai = 0; ai < 2; ++ai)
#pragma unroll
            for (int m = 0; m < 4; ++m) { bf16_t* rowp = O + (size_t)(row0 + ai * HALF + m * 16) * ldc + col0;
#pragma unroll
                for (int bj = 0; bj < 2; ++bj) { const f32x4 v0 = acc[ai][bj][m][0], v1 = acc[ai][bj][m][1];
                    u32x4 w; w.x = cvt_pk_bf16(v0[0], v0[1]); w.y = cvt_pk_bf16(v0[2], v0[3]); w.z = cvt_pk_bf16(v1[0], v1[1]); w.w = cvt_pk_bf16(v1[2], v1[3]);
                    *(u32x4*)(rowp + bj * HALF) = w; } }
    }
};
template <int SECOND> struct EpiGate {
    static constexpr bool PERM = true, AFTER_DRAIN = false;
    const bf16_t* Zg; bf16_t* MG;
    __device__ __forceinline__ void operator()(const f32x4 (&acc)[2][2][4][2], const Unit& u, int wr, int wc, int fr, int fq) const {
        const int row0 = u.pm * BM + wr * 64 + fr, col0 = u.pn * BM + wc * 32 + 8 * fq;
#pragma unroll
        for (int ai = 0; ai < 2; ++ai) {
            u32x4 gw[4][2], pw[4][2];
#pragma unroll
            for (int m = 0; m < 4; ++m) { const int r = row0 + ai * HALF + m * 16;
#pragma unroll
                for (int bj = 0; bj < 2; ++bj) { gw[m][bj] = *(const u32x4*)(Zg + (size_t)r * 2048 + SECOND * 1024 + col0 + bj * HALF);
                    if (SECOND) pw[m][bj] = *(const u32x4*)(MG + (size_t)r * 1024 + col0 + bj * HALF); } }
#pragma unroll
            for (int m = 0; m < 4; ++m) { const int r = row0 + ai * HALF + m * 16; bf16_t* op = MG + (size_t)r * 1024 + col0;
#pragma unroll
                for (int bj = 0; bj < 2; ++bj) { const u32x4 g = gw[m][bj]; f32x4 v0 = acc[ai][bj][m][0], v1 = acc[ai][bj][m][1];
                    v0[0] *= sigm(bf_lo(g.x)); v0[1] *= sigm(bf_hi(g.x)); v0[2] *= sigm(bf_lo(g.y)); v0[3] *= sigm(bf_hi(g.y));
                    v1[0] *= sigm(bf_lo(g.z)); v1[1] *= sigm(bf_hi(g.z)); v1[2] *= sigm(bf_lo(g.w)); v1[3] *= sigm(bf_hi(g.w));
                    if (SECOND) { const u32x4 p = pw[m][bj];
                        v0[0] += bf_lo(p.x); v0[1] += bf_hi(p.x); v0[2] += bf_lo(p.y); v0[3] += bf_hi(p.y);
                        v1[0] += bf_lo(p.z); v1[1] += bf_hi(p.z); v1[2] += bf_lo(p.w); v1[3] += bf_hi(p.w); }
                    u32x4 w; w.x = cvt_pk_bf16(v0[0], v0[1]); w.y = cvt_pk_bf16(v0[2], v0[3]); w.z = cvt_pk_bf16(v1[0], v1[1]); w.w = cvt_pk_bf16(v1[2], v1[3]);
                    *(u32x4*)(op + bj * HALF) = w; } }
        }
    }
};
struct EpiX1 {
    static constexpr bool PERM = false, AFTER_DRAIN = false;
    const float* xp; const float* xs; float* X1; bf16_t* X1B; float* SSP; const float* g2; int nprompt, nrows;
    __device__ __forceinline__ void operator()(const f32x4 (&acc)[2][2][4][2], const Unit& u, int wr, int wc, int fr, int fq) const {
        typedef unsigned u32x2v __attribute__((ext_vector_type(2)));
        const int col0 = u.pn * BM + wc * 32 + 4 * fq;
        f32x4 gq[2][2];
#pragma unroll
        for (int bj = 0; bj < 2; ++bj)
#pragma unroll
            for (int n = 0; n < 2; ++n) gq[bj][n] = *(const f32x4*)(g2 + col0 + bj * HALF + n * 16);
#pragma unroll
        for (int ai = 0; ai < 2; ++ai) {
            f32x4 xv[4][2][2];
#pragma unroll
            for (int m = 0; m < 4; ++m) { int r = u.pm * BM + ai * HALF + wr * 64 + m * 16 + fr; r = r < nrows ? r : nrows - 1;
                const float* xr = r < nprompt ? xp + (size_t)r * 1024 : xs + (size_t)(r - nprompt) * 1024;
#pragma unroll
                for (int bj = 0; bj < 2; ++bj)
#pragma unroll
                    for (int n = 0; n < 2; ++n) xv[m][bj][n] = *(const f32x4*)(xr + col0 + bj * HALF + n * 16); }
#pragma unroll
            for (int m = 0; m < 4; ++m) { const int r = u.pm * BM + ai * HALF + wr * 64 + m * 16 + fr; float ss = 0.f;
#pragma unroll
                for (int bj = 0; bj < 2; ++bj)
#pragma unroll
                    for (int n = 0; n < 2; ++n) { const int c = col0 + bj * HALF + n * 16; const f32x4 o = xv[m][bj][n] + acc[ai][bj][m][n];
                        ss += (o[0] * o[0] + o[1] * o[1]) + (o[2] * o[2] + o[3] * o[3]);
                        const f32x4 q = gq[bj][n]; u32x2v w; w.x = cvt_pk_bf16(o[0] * q[0], o[1] * q[1]); w.y = cvt_pk_bf16(o[2] * q[2], o[3] * q[3]);
                        if (r < nrows) *(u32x2v*)(X1B + (size_t)r * 1024 + c) = w; }
                ss += __shfl_xor(ss, 16); ss += __shfl_xor(ss, 32);
                if (fq == 0 && r < nrows) SSP[(size_t)r * 16 + u.pn * 4 + wc] = ss;
            }
        }
    }
};
template <class Epi, class Sched, bool ALIGN_EPI = false, bool SP2 = false>
__device__ __forceinline__ void gemm_phase(PG8_LAS unsigned char* lds, const Gemm g, const Sched& S, const Epi& E) {
    const int tid = threadIdx.x, wid = __builtin_amdgcn_readfirstlane(tid >> 6), lane = tid & 63, wr = wid >> 2, wc = wid & 3, fr = lane & 15, fq = lane >> 4;
    const int K = g.K, nt = K / BK;
    unsigned voffA[2], voffB[2];
#pragma unroll
    for (int i = 0; i < 2; ++i) { int R, C; stage_rc(tid * 16 + i * 8192, R, C); const int Rb = Epi::PERM ? ((R & ~31) + perm32(R & 31)) : R;
        voffA[i] = (unsigned)(R * K + C) * 2u; voffB[i] = (unsigned)(Rb * K + C) * 2u; }
    const size_t kstep = (size_t)(BK * 2);
    const size_t hstep = (size_t)HALF * K * 2;
    const size_t tstep = 2 * hstep;
    const unsigned ldsw = (unsigned)wid * 1024u;
    const int aoff = lds_byte(wr * 64 + fr, fq * 8), boff = lds_byte(wc * 32 + fr, fq * 8);
#define PG8_SA(b, h) (((b) * 2 + (h)) * HTB)
#define PG8_SB(b, h) ((4 + (b) * 2 + (h)) * HTB)
#define PG8_STAGE(bufoff, gbase, voff) do { _Pragma("unroll") for (int _i = 0; _i < 2; ++_i) \
        __builtin_amdgcn_global_load_lds((const unsigned*)((const char*)(gbase) + (voff)[_i]), (PG8_LAS unsigned*)(lds + (bufoff) + ldsw + _i * 8192), 16, 0, 0); } while (0)
#define PG8_LDA(dst, b, h) do { _Pragma("unroll") for (int m = 0; m < 4; ++m) _Pragma("unroll") for (int k = 0; k < 2; ++k) dst[m][k] = *(const PG8_LAS bf16x8*)(lds + PG8_SA(b, h) + aoff + m * 2048 + k * 1024); } while (0)
#define PG8_LDB(dst, b, h) do { _Pragma("unroll") for (int n = 0; n < 2; ++n) _Pragma("unroll") for (int k = 0; k < 2; ++k) dst[n][k] = *(const PG8_LAS bf16x8*)(lds + PG8_SB(b, h) + boff + n * 2048 + k * 1024); } while (0)
#define PG8_MMA(ai, bj, At, Bt) do { __builtin_amdgcn_s_setprio(1); _Pragma("unroll") for (int m = 0; m < 4; ++m) _Pragma("unroll") for (int n = 0; n < 2; ++n) _Pragma("unroll") for (int k = 0; k < 2; ++k) \
        acc[ai][bj][m][n] = __builtin_amdgcn_mfma_f32_16x16x32_bf16(Bt[n][k], At[m][k], acc[ai][bj][m][n], 0, 0, 0); __builtin_amdgcn_s_setprio(0); } while (0)
#define PG8_WAIT_V(n) asm volatile("s_waitcnt vmcnt(" #n ")" ::: "memory")
#define PG8_WAIT_L(n) asm volatile("s_waitcnt lgkmcnt(" #n ")" ::: "memory")
#define PG8_BAR __builtin_amdgcn_s_barrier()
#define PG8_SCHED __builtin_amdgcn_sched_barrier(0)
    Unit cur, nxt; int ui = 0;
    if (!S.next(0, cur)) return;
    f32x4 acc[2][2][4][2];
#pragma unroll
    for (int a = 0; a < 2; ++a)
#pragma unroll
        for (int b = 0; b < 2; ++b)
#pragma unroll
            for (int m = 0; m < 4; ++m)
#pragma unroll
                for (int n = 0; n < 2; ++n) acc[a][b][m][n] = (f32x4){0.f, 0.f, 0.f, 0.f};
    bf16x8 At[4][2], B0[2][2], B1[2][2];
    const char* cA = (const char*)g.A + (size_t)cur.pm * tstep; const char* cB = (const char*)g.Bt + (size_t)cur.pn * tstep;
    S.a_ready(cur);
    if constexpr (SP2) {
        PG8_STAGE(PG8_SB(0, 0), cB, voffB); PG8_STAGE(PG8_SB(0, 1), cB + hstep, voffB); PG8_STAGE(PG8_SA(0, 0), cA, voffA); PG8_STAGE(PG8_SA(0, 1), cA + hstep, voffA);
        if (wr == 1) PG8_BAR;
        PG8_WAIT_V(2); PG8_BAR;
        PG8_STAGE(PG8_SB(1, 0), cB + kstep, voffB); PG8_STAGE(PG8_SA(1, 0), cA + kstep, voffA); PG8_STAGE(PG8_SB(1, 1), cB + hstep + kstep, voffB);
        PG8_WAIT_V(6); PG8_BAR;
    } else {
        PG8_STAGE(PG8_SB(0, 0), cB, voffB); PG8_STAGE(PG8_SA(0, 0), cA, voffA); PG8_STAGE(PG8_SB(0, 1), cB + hstep, voffB); PG8_STAGE(PG8_SA(0, 1), cA + hstep, voffA);
        if (wr == 1) PG8_BAR;
        PG8_WAIT_V(4); PG8_BAR;
        PG8_STAGE(PG8_SB(1, 0), cB + kstep, voffB); PG8_STAGE(PG8_SA(1, 0), cA + kstep, voffA); PG8_STAGE(PG8_SB(1, 1), cB + hstep + kstep, voffB);
        PG8_WAIT_V(6); PG8_BAR;
    }
    for (;;) {
        const bool has_next = S.next(ui + 1, nxt);
        const char* nA = has_next ? (const char*)g.A + (size_t)nxt.pm * tstep : cA; const char* nB = has_next ? (const char*)g.Bt + (size_t)nxt.pn * tstep : cB;
        for (int t = 0; t < nt; t += 2) {
            const bool last = (t == nt - 2);
            const char* a1 = cA + (size_t)(t + 1) * kstep;
            const char* a2 = last ? nA : cA + (size_t)(t + 2) * kstep; const char* b2 = last ? nB : cB + (size_t)(t + 2) * kstep;
            const char* a3 = a2 + kstep; const char* b3 = b2 + kstep;
            if (last && has_next) S.a_ready(nxt);
            if constexpr (SP2) {
            PG8_LDB(B0, 0, 0); PG8_LDB(B1, 0, 1); PG8_SCHED; PG8_LDA(At, 0, 0); PG8_STAGE(PG8_SA(1, 1), a1 + hstep, voffA);
            PG8_WAIT_V(8); PG8_WAIT_L(0); PG8_BAR; PG8_MMA(0, 0, At, B0); PG8_MMA(0, 1, At, B1); PG8_BAR; PG8_SCHED;
            PG8_LDA(At, 0, 1); PG8_STAGE(PG8_SB(0, 0), b2, voffB); PG8_STAGE(PG8_SB(0, 1), b2 + hstep, voffB); PG8_STAGE(PG8_SA(0, 0), a2, voffA);
            PG8_WAIT_V(8); PG8_WAIT_L(0); PG8_BAR; PG8_MMA(1, 0, At, B0); PG8_MMA(1, 1, At, B1); PG8_BAR; PG8_SCHED;
            PG8_LDB(B0, 1, 0); PG8_LDB(B1, 1, 1); PG8_SCHED; PG8_LDA(At, 1, 0); PG8_STAGE(PG8_SA(0, 1), a2 + hstep, voffA);
            PG8_WAIT_V(8); PG8_WAIT_L(0); PG8_BAR; PG8_MMA(0, 0, At, B0); PG8_MMA(0, 1, At, B1); PG8_BAR; PG8_SCHED;
            PG8_LDA(At, 1, 1); PG8_STAGE(PG8_SB(1, 0), b3, voffB); PG8_STAGE(PG8_SB(1, 1), b3 + hstep, voffB); PG8_STAGE(PG8_SA(1, 0), a3, voffA);
            PG8_WAIT_V(8); PG8_WAIT_L(0); PG8_BAR; PG8_MMA(1, 0, At, B0); PG8_MMA(1, 1, At, B1); PG8_BAR; PG8_SCHED;
            } else {
            PG8_LDB(B0, 0, 0); PG8_SCHED; PG8_LDA(At, 0, 0); PG8_STAGE(PG8_SA(1, 1), a1 + hstep, voffA);
            PG8_WAIT_L(8); PG8_BAR; PG8_WAIT_L(0); PG8_MMA(0, 0, At, B0); PG8_BAR; PG8_SCHED;
            PG8_LDB(B1, 0, 1); PG8_STAGE(PG8_SB(0, 0), b2, voffB);
            PG8_BAR; PG8_WAIT_L(0); PG8_MMA(0, 1, At, B1); PG8_BAR;
            PG8_LDA(At, 0, 1); PG8_STAGE(PG8_SA(0, 0), a2, voffA);
            PG8_BAR; PG8_WAIT_L(0); PG8_MMA(1, 0, At, B0); PG8_BAR; PG8_SCHED;
            PG8_STAGE(PG8_SB(0, 1), b2 + hstep, voffB);
            PG8_WAIT_V(6); PG8_BAR; PG8_MMA(1, 1, At, B1); PG8_BAR;
            PG8_LDB(B0, 1, 0); PG8_SCHED; PG8_LDA(At, 1, 0); PG8_STAGE(PG8_SA(0, 1), a2 + hstep, voffA);
            PG8_WAIT_L(8); PG8_BAR; PG8_WAIT_L(0); PG8_MMA(0, 0, At, B0); PG8_BAR; PG8_SCHED;
            PG8_LDB(B1, 1, 1); PG8_STAGE(PG8_SB(1, 0), b3, voffB);
            PG8_BAR; PG8_WAIT_L(0); PG8_MMA(0, 1, At, B1); PG8_BAR;
            PG8_LDA(At, 1, 1); PG8_STAGE(PG8_SA(1, 0), a3, voffA);
            PG8_BAR; PG8_WAIT_L(0); PG8_MMA(1, 0, At, B0); PG8_BAR; PG8_SCHED;
            PG8_STAGE(PG8_SB(1, 1), b3 + hstep, voffB);
            PG8_WAIT_V(6); PG8_BAR; PG8_MMA(1, 1, At, B1); PG8_BAR;
            }
        }
        if constexpr (ALIGN_EPI) { if (wr == 0) PG8_BAR; }
        if constexpr (!Epi::AFTER_DRAIN) { E(acc, cur, wr, wc, fr, fq); S.done(cur); }
        if (!has_next) break;
#pragma unroll
        for (int a = 0; a < 2; ++a)
#pragma unroll
            for (int b = 0; b < 2; ++b)
#pragma unroll
                for (int m = 0; m < 4; ++m)
#pragma unroll
                    for (int n = 0; n < 2; ++n) acc[a][b][m][n] = (f32x4){0.f, 0.f, 0.f, 0.f};
        cur = nxt; cA = nA; cB = nB; ++ui;
        if constexpr (ALIGN_EPI) { if (wr == 1) PG8_BAR; }
    }
    PG8_WAIT_V(0);
    if constexpr (!ALIGN_EPI) { if (wr == 0) PG8_BAR; }
    PG8_BAR;
    if constexpr (Epi::AFTER_DRAIN) { E.fused(acc, cur, wr, wc, fr, fq, lds, wid, lane); S.done(cur); }
#undef PG8_SA
#undef PG8_SB
#undef PG8_STAGE
#undef PG8_LDA
#undef PG8_LDB
#undef PG8_MMA
#undef PG8_WAIT_V
#undef PG8_WAIT_L
#undef PG8_BAR
#undef PG8_SCHED
}
}
constexpr int NWAVES = 8, NTHR = 512;
#ifndef MK_N_LAUNCHES
#define MK_N_LAUNCHES 1
#endif
constexpr int PER_PHASE = 14;
constexpr int N_LAUNCHES = MK_N_LAUNCHES;

constexpr int DM = 1024, NPROMPT = 32768, NSAMP = 512, NTOK = 33280, NSHIFT = 32, MPAD = 33536, N1 = 5632;
constexpr int SEQ_P = 4096, SEQ_S = 16, NB_P = 8, NB_S = 32;
constexpr size_t O_Y = 0, O_CONV_P = 34078720, O_SHIFT_P = 34086912, O_WKV_P = 34095104, O_CONV_S = 34357248, O_SHIFT_S = 34390016, O_WKV_S = 34422784;
constexpr size_t KiB = 1024, MiB = 1u << 20;
constexpr size_t WS_CTL = 0, CTL_ZERO_BYTES = 64 * KiB;
constexpr size_t WS_W1T = 64 * KiB;
constexpr size_t WS_WPA = WS_W1T + (size_t)N1 * DM * 2;
constexpr size_t WS_WPB = WS_WPA + 1 * MiB;
constexpr size_t WS_WO = WS_WPB + 1 * MiB;
constexpr size_t WS_WQ = WS_WO + 2 * MiB;
constexpr size_t WS_KEYS = WS_WQ + 4 * MiB;
constexpr size_t WS_L2T = WS_KEYS + 512 * KiB;
constexpr size_t WS_SSP = WS_L2T + 256 * KiB;
constexpr size_t WS_UB = WS_SSP + (size_t)MPAD * 16 * 4;
constexpr size_t WS_VB = WS_UB + 16 * MiB;
constexpr size_t WS_A1 = WS_VB + 16 * MiB;
constexpr size_t WS_ZC = WS_A1 + (size_t)MPAD * DM * 2;
constexpr size_t WS_ZR = WS_ZC + (size_t)MPAD * 1536 * 2;
constexpr size_t WS_ZG = WS_ZR + (size_t)MPAD * 2048 * 2;
constexpr size_t WS_END = WS_ZG + (size_t)MPAD * 2048 * 2;
constexpr size_t WS_YL = WS_ZC, WS_ZT = WS_ZC + (size_t)NTOK * 512 * 2, WS_BV = WS_ZC + (size_t)NTOK * 512 * 4;
constexpr size_t WS_EIDX = WS_ZC, WS_GATE = WS_ZC + 16 * MiB, WS_COEF = WS_ZC + 40 * MiB, WS_SS2 = WS_ZC + 64 * MiB, WS_RSTD = WS_ZC + 66 * MiB;
constexpr size_t WS_PART = WS_ZR;
constexpr size_t OB_MB = (size_t)4352 * 4096 * 4;
constexpr size_t OB_S0S = OB_MB + (size_t)4352 * 4096 * 2;
static_assert(WS_BV + (size_t)NTOK * 512 * 2 <= WS_ZR && OB_S0S + (size_t)256 * 4096 * 2 <= (size_t)NTOK * 1024 * 4, "scan scratch maps");
static_assert(WS_END <= 512 * MiB, "d_ws map must fit 512 MiB");
constexpr float PEER_SU = 32.0f, PEER_SV = 4.0f;
constexpr int CW_BAR = 1024;
constexpr int LDS_BYTES = 163840;
constexpr int LDSCTL_OFF = LDS_BYTES - 512, MISC_OFF = LDSCTL_OFF + 320;

#define GAS __attribute__((address_space(1)))
#define LAS __attribute__((address_space(3)))
typedef unsigned short bf16;
typedef unsigned v4u __attribute__((ext_vector_type(4)));
typedef unsigned v2u __attribute__((ext_vector_type(2)));
typedef float f32x4 __attribute__((ext_vector_type(4)));
typedef short bf16x8 __attribute__((ext_vector_type(8)));
typedef __bf16 bf16x2_t __attribute__((ext_vector_type(2)));
typedef GAS unsigned gu32;
#define RLX_AGENT __ATOMIC_RELAXED, __HIP_MEMORY_SCOPE_AGENT
#define LDS_WAIT() asm volatile("s_waitcnt lgkmcnt(0)" ::: "memory")
#define VM_WAIT() asm volatile("s_waitcnt vmcnt(0)" ::: "memory")
using pg8::cvt_pk_bf16; using pg8::bf_lo; using pg8::bf_hi; using pg8::sigm;
#define XB_TMO      128
#define XB_XCNT(j)  (256  + 64 * (j))
#define XB_XSUB(j)  (1280 + 64 * (j))
#define XB_XGEN(j)  (2304 + 64 * (j))
#define XB_TOP      3328
#define XB_TOPGEN   3392
#define XCD_BAR_WORDS 3456
#define XB_SPIN_CAP (1u << 22)

__device__ __forceinline__ unsigned xb_ld(unsigned* p)              { return __hip_atomic_load(p, __ATOMIC_RELAXED, __HIP_MEMORY_SCOPE_AGENT); }
__device__ __forceinline__ unsigned xb_add(unsigned* p, unsigned v) { return __hip_atomic_fetch_add(p, v, __ATOMIC_RELAXED, __HIP_MEMORY_SCOPE_AGENT); }
__device__ __forceinline__ unsigned xb_xcc_id() { return (unsigned)__builtin_amdgcn_s_getreg((3 << 11) | 20) & 0xFu; }
#define XB_SPIN(cond, bar) do { unsigned _sp = 0; while (cond) { __builtin_amdgcn_s_sleep(1); \
    if ((++_sp & 255u) == 0u) { if (xb_ld(&(bar)[XB_TMO])) break; if (_sp > XB_SPIN_CAP) { atomicAdd(&(bar)[XB_TMO], 1u); break; } } } } while (0)

struct XcdBarrier {
    unsigned* bar; unsigned x;
    volatile LAS unsigned* st;
};

__device__ __forceinline__ XcdBarrier xcd_barrier_post(unsigned* bar, volatile LAS unsigned* st) {
    XcdBarrier b; b.bar = bar; b.x = xb_xcc_id(); b.st = st;
    if (threadIdx.x == 0) (void)xb_add(&bar[XB_XCNT(b.x)], 1u);
    return b;
}
__device__ __forceinline__ void xcd_barrier_complete(unsigned* bar, unsigned x, unsigned& nloc, unsigned& nx) {
    const unsigned G = gridDim.x * gridDim.y * gridDim.z;
    unsigned sum, cnt, mine, sp = 0u;
    for (;;) {
        sum = 0u; cnt = 0u; mine = 0u;
#pragma unroll
        for (unsigned j = 0; j < 16; ++j) { const unsigned c = xb_ld(&bar[XB_XCNT(j)]); sum += c; cnt += (c > 0u) ? 1u : 0u; mine = (j == x) ? c : mine; }
        if (sum == G) break;
        __builtin_amdgcn_s_sleep(1);
        if ((++sp & 255u) == 0u) { if (xb_ld(&bar[XB_TMO])) break; if (sp > XB_SPIN_CAP) { atomicAdd(&bar[XB_TMO], 1u); break; } }
    }
    nloc = mine > 0u ? mine : 1u; nx = cnt > 0u ? cnt : 1u;
}

__device__ __forceinline__ void xcd_barrier(const XcdBarrier& b) {
    asm volatile("s_waitcnt vmcnt(0)" ::: "memory");
    __syncthreads();
    if (threadIdx.x == 0) {
        unsigned* bar = b.bar;
        __builtin_amdgcn_s_waitcnt(0);
        unsigned nloc = b.st[0], nx = b.st[1];
        if (nloc == 0u) { xcd_barrier_complete(bar, b.x, nloc, nx); b.st[0] = nloc; b.st[1] = nx; }
        const unsigned old = xb_add(&bar[XB_XSUB(b.x)], 1u);
        const unsigned gen = old / nloc;
        if (old + 1u == (gen + 1u) * nloc) {
            __builtin_amdgcn_fence(__ATOMIC_RELEASE, "agent");
            asm volatile("s_waitcnt vmcnt(0)" ::: "memory");
            const unsigned og = xb_add(&bar[XB_TOP], 1u);
            const unsigned tg = og / nx;
            if (og + 1u == (tg + 1u) * nx) xb_add(&bar[XB_TOPGEN], 1u);
            else XB_SPIN(xb_ld(&bar[XB_TOPGEN]) == tg, bar);
            __builtin_amdgcn_fence(__ATOMIC_ACQUIRE, "agent");
            xb_add(&bar[XB_XGEN(b.x)], 1u);
            asm volatile("s_waitcnt vmcnt(0)" ::: "memory");
        } else {
            XB_SPIN(xb_ld(&bar[XB_XGEN(b.x)]) == gen, bar);
            __builtin_amdgcn_fence(__ATOMIC_ACQUIRE, "agent");
            asm volatile("s_waitcnt vmcnt(0)" ::: "memory");
        }
    }
    __syncthreads();
}
struct Args { const float* in[32]; float* out; unsigned char* ws; int ph_lo, ph_hi, li, pad; };
enum { I_XP = 0, I_XS, I_SCONV, I_SSHIFT, I_SWKV, I_N1G, I_WIN, I_CONVW, I_MURKV, I_MUWAG, I_W0, I_W1, I_W2, I_A0, I_A1, I_A2, I_G1, I_G2, I_KK, I_KA, I_RK, I_GNW, I_GNB, I_WPA, I_WPB, I_WO, I_N2G, I_WQ, I_KEYS, I_U, I_V, I_NFG };

__device__ __forceinline__ float wave_sum(float v) {
#pragma unroll
    for (int o = 1; o < 64; o <<= 1) v += __shfl_xor(v, o);
    return v;
}
template <int CTRL> __device__ __forceinline__ float dpp_mov(float v) { return __builtin_bit_cast(float, __builtin_amdgcn_update_dpp(0, __builtin_bit_cast(int, v), CTRL, 0xF, 0xF, true)); }
__device__ __forceinline__ float sum4(float v) { v += dpp_mov<0xB1>(v); v += dpp_mov<0x4E>(v); return v; }
__device__ __forceinline__ float sum8(float v) { v = sum4(v); v += dpp_mov<0x141>(v); return v; }
__device__ __forceinline__ float sum16(float v) { v = sum8(v); v += dpp_mov<0x140>(v); return v; }
__device__ __forceinline__ float dot2bf(unsigned w, unsigned x, float acc) { return __builtin_amdgcn_fdot2_f32_bf16(__builtin_bit_cast(bf16x2_t, w), __builtin_bit_cast(bf16x2_t, x), acc, false); }

__device__ __forceinline__ void transpose_item(const float* W, int ldw, int c0, int K, bf16* WT, int nblk, int item, const float* sv, float alpha, float beta, LAS float* scr, int lane, int rstride = 1) {
    const int kb = item / nblk, nb = item % nblk, k0 = 64 * kb, n0 = 32 * nb;
#pragma unroll 8
    for (int i = 0; i < 32; ++i) { const int kk = 2 * i + (lane >> 5); float s = 1.f; if (sv) s = alpha + beta * sv[k0 + kk];
        scr[kk * 33 + (lane & 31)] = W[(size_t)(k0 + kk) * ldw + c0 + n0 + (lane & 31)] * s; }
    LDS_WAIT();
    const int c = lane & 7;
#pragma unroll
    for (int j = 0; j < 4; ++j) { const int n = (lane >> 3) + 8 * j; const LAS float* s = scr + (8 * c) * 33 + n;
        v4u o; o.x = cvt_pk_bf16(s[0 * 33], s[1 * 33]); o.y = cvt_pk_bf16(s[2 * 33], s[3 * 33]); o.z = cvt_pk_bf16(s[4 * 33], s[5 * 33]); o.w = cvt_pk_bf16(s[6 * 33], s[7 * 33]);
        *(v4u*)(WT + (size_t)((n0 + n) * rstride) * K + k0 + 8 * c) = o; }
    LDS_WAIT();
}
__device__ __forceinline__ void cvt_stream(const float* src, bf16* dst, size_t n, size_t gt, size_t nthreads) {
    for (size_t i = gt * 8; i < n; i += nthreads * 8) { const f32x4 a = *(const f32x4*)(src + i), b = *(const f32x4*)(src + i + 4);
        v4u o; o.x = cvt_pk_bf16(a[0], a[1]); o.y = cvt_pk_bf16(a[2], a[3]); o.z = cvt_pk_bf16(b[0], b[1]); o.w = cvt_pk_bf16(b[2], b[3]); *(v4u*)(dst + i) = o; }
}
__device__ __forceinline__ void cvt_stream_fp8(const float* src, unsigned char* dst, size_t n, float scale, size_t gt, size_t nthreads) {
    for (size_t i = gt * 16; i < n; i += nthreads * 16) {
        const f32x4 a = *(const f32x4*)(src + i) * scale, b = *(const f32x4*)(src + i + 4) * scale, c = *(const f32x4*)(src + i + 8) * scale, d = *(const f32x4*)(src + i + 12) * scale;
        v4u o; unsigned p;
        p = __builtin_amdgcn_cvt_pk_fp8_f32(a[0], a[1], 0, false); o.x = __builtin_amdgcn_cvt_pk_fp8_f32(a[2], a[3], p, true);
        p = __builtin_amdgcn_cvt_pk_fp8_f32(b[0], b[1], 0, false); o.y = __builtin_amdgcn_cvt_pk_fp8_f32(b[2], b[3], p, true);
        p = __builtin_amdgcn_cvt_pk_fp8_f32(c[0], c[1], 0, false); o.z = __builtin_amdgcn_cvt_pk_fp8_f32(c[2], c[3], p, true);
        p = __builtin_amdgcn_cvt_pk_fp8_f32(d[0], d[1], 0, false); o.w = __builtin_amdgcn_cvt_pk_fp8_f32(d[2], d[3], p, true);
        *(v4u*)(dst + i) = o; }
}
__device__ __forceinline__ void cvt16_fp8_sliced(const float* src, unsigned char* dst, float scale, size_t i) {
    const f32x4 a = *(const f32x4*)(src + i) * scale, b = *(const f32x4*)(src + i + 4) * scale, c = *(const f32x4*)(src + i + 8) * scale, d = *(const f32x4*)(src + i + 12) * scale;
    v4u o; unsigned p;
    p = __builtin_amdgcn_cvt_pk_fp8_f32(a[0], a[1], 0, false); o.x = __builtin_amdgcn_cvt_pk_fp8_f32(a[2], a[3], p, true);
    p = __builtin_amdgcn_cvt_pk_fp8_f32(b[0], b[1], 0, false); o.y = __builtin_amdgcn_cvt_pk_fp8_f32(b[2], b[3], p, true);
    p = __builtin_amdgcn_cvt_pk_fp8_f32(c[0], c[1], 0, false); o.z = __builtin_amdgcn_cvt_pk_fp8_f32(c[2], c[3], p, true);
    p = __builtin_amdgcn_cvt_pk_fp8_f32(d[0], d[1], 0, false); o.w = __builtin_amdgcn_cvt_pk_fp8_f32(d[2], d[3], p, true);
    const size_t e = i >> 10, col = i & 1023;
    *(v4u*)(dst + (col >> 7) * ((size_t)16384 * 128) + e * 128 + (col & 127)) = o;
}
__device__ __forceinline__ void cvt_stream_fp8_sliced(const float* src, unsigned char* dst, float scale, size_t gt, size_t nthreads) {
#pragma unroll 2
    for (size_t i = gt * 16; i < (size_t)16384 * 1024; i += nthreads * 16) {
        const f32x4 a = *(const f32x4*)(src + i) * scale, b = *(const f32x4*)(src + i + 4) * scale, c = *(const f32x4*)(src + i + 8) * scale, d = *(const f32x4*)(src + i + 12) * scale;
        v4u o; unsigned p;
        p = __builtin_amdgcn_cvt_pk_fp8_f32(a[0], a[1], 0, false); o.x = __builtin_amdgcn_cvt_pk_fp8_f32(a[2], a[3], p, true);
        p = __builtin_amdgcn_cvt_pk_fp8_f32(b[0], b[1], 0, false); o.y = __builtin_amdgcn_cvt_pk_fp8_f32(b[2], b[3], p, true);
        p = __builtin_amdgcn_cvt_pk_fp8_f32(c[0], c[1], 0, false); o.z = __builtin_amdgcn_cvt_pk_fp8_f32(c[2], c[3], p, true);
        p = __builtin_amdgcn_cvt_pk_fp8_f32(d[0], d[1], 0, false); o.w = __builtin_amdgcn_cvt_pk_fp8_f32(d[2], d[3], p, true);
        const size_t e = i >> 10, col = i & 1023;
        *(v4u*)(dst + (col >> 7) * ((size_t)16384 * 128) + e * 128 + (col & 127)) = o; }
}
__device__ __forceinline__ void p0_prologue(const Args& A, LAS unsigned char* lds, int tid, int lane, int wave, int vcu, int G) {
    unsigned char* ws = A.ws;
    bf16* W1T = (bf16*)(ws + WS_W1T);
    LAS float* scr = (LAS float*)(lds + wave * 16384);
    const int gw = vcu * NWAVES + wave, NGW = G * NWAVES;
    constexpr int J0 = 16 * 96, JB_ = 16 * 16, J1 = 16 * 64, JL = 16 * 2, JG = 16 * 4, JP = 8 * 32, JO = 16 * 32, JQ = 16 * 64;
    constexpr int JW2 = 16, JG2 = 32;
    constexpr int NITEMS = J0 + J1 + 4 * JL + 2 * JG + 2 * JP + JO + JQ + 2 * JW2 + JG2;
    bf16* L2T = (bf16*)(ws + WS_L2T);
    const float* mu = A.in[I_MUWAG];
    for (int it = gw; it < NITEMS; it += NGW) {
        int r = it;
        if (r < J0) {
            if (r < JB_) transpose_item(A.in[I_WIN], 5120, 0, 1024, W1T, 16, r, nullptr, 0.f, 0.f, scr, lane);
            else if (r < 2 * JB_) transpose_item(A.in[I_WIN], 5120, 512, 1024, W1T + (size_t)512 * 1024, 16, r - JB_, nullptr, 0.f, 0.f, scr, lane, 2);
            else if (r < 3 * JB_) transpose_item(A.in[I_WIN], 5120, 1024, 1024, W1T + (size_t)513 * 1024, 16, r - 2 * JB_, nullptr, 0.f, 0.f, scr, lane, 2);
            else transpose_item(A.in[I_WIN], 5120, 1536, 1024, W1T + (size_t)1536 * 1024, 48, r - 3 * JB_, nullptr, 0.f, 0.f, scr, lane);
            continue; } r -= J0;
        if (r < J1) { transpose_item(A.in[I_WIN], 5120, 3072, 1024, W1T + (size_t)3584 * 1024, 64, r, nullptr, 0.f, 0.f, scr, lane); continue; } r -= J1;
        if (r < JL) { transpose_item(A.in[I_W1], 64, 0, 1024, W1T + (size_t)3072 * 1024, 2, r, mu, 1.f, -1.f, scr, lane); continue; } r -= JL;
        if (r < JL) { transpose_item(A.in[I_W1], 64, 0, 1024, W1T + (size_t)3328 * 1024, 2, r, mu, 0.f, 1.f, scr, lane); continue; } r -= JL;
        if (r < JL) { transpose_item(A.in[I_A1], 64, 0, 1024, W1T + (size_t)(3072 + 64) * 1024, 2, r, mu + 1024, 1.f, -1.f, scr, lane); continue; } r -= JL;
        if (r < JL) { transpose_item(A.in[I_A1], 64, 0, 1024, W1T + (size_t)(3328 + 64) * 1024, 2, r, mu + 1024, 0.f, 1.f, scr, lane); continue; } r -= JL;
        if (r < JG) { transpose_item(A.in[I_G1], 128, 0, 1024, W1T + (size_t)(3072 + 128) * 1024, 4, r, mu + 2048, 1.f, -1.f, scr, lane); continue; } r -= JG;
        if (r < JG) { transpose_item(A.in[I_G1], 128, 0, 1024, W1T + (size_t)(3328 + 128) * 1024, 4, r, mu + 2048, 0.f, 1.f, scr, lane); continue; } r -= JG;
        if (r < JP) { transpose_item(A.in[I_WPA], 1024, 0, 512, (bf16*)(ws + WS_WPA), 32, r, nullptr, 0.f, 0.f, scr, lane); continue; } r -= JP;
        if (r < JP) { transpose_item(A.in[I_WPB], 1024, 0, 512, (bf16*)(ws + WS_WPB), 32, r, nullptr, 0.f, 0.f, scr, lane); continue; } r -= JP;
        if (r < JO) { transpose_item(A.in[I_WO], 1024, 0, 1024, (bf16*)(ws + WS_WO), 32, r, nullptr, 0.f, 0.f, scr, lane); continue; } r -= JO;
        if (r < JQ) { transpose_item(A.in[I_WQ], 2048, 0, 1024, (bf16*)(ws + WS_WQ), 64, r, nullptr, 0.f, 0.f, scr, lane); continue; } r -= JQ;
        if (r < JW2) { transpose_item(A.in[I_W2], 512, 0, 64, L2T, 16, r, nullptr, 0.f, 0.f, scr, lane); continue; } r -= JW2;
        if (r < JW2) { transpose_item(A.in[I_A2], 512, 0, 64, L2T + (size_t)512 * 64, 16, r, nullptr, 0.f, 0.f, scr, lane); continue; } r -= JW2;
        transpose_item(A.in[I_G2], 512, 0, 128, L2T + (size_t)1024 * 64, 16, r, nullptr, 0.f, 0.f, scr, lane);
    }
    const size_t gt = (size_t)vcu * NTHR + tid, nth = (size_t)G * NTHR;
    if (G != 256) {
        cvt_stream_fp8_sliced(A.in[I_U], ws + WS_UB, PEER_SU, gt, nth);
        cvt_stream_fp8_sliced(A.in[I_V], ws + WS_VB, PEER_SV, gt, nth); }
    cvt_stream(A.in[I_KEYS], (bf16*)(ws + WS_KEYS), (size_t)8 * 2 * 128 * 128, gt, nth);
    bf16* A1 = (bf16*)(ws + WS_A1);
    const f32x4* g1v = (const f32x4*)A.in[I_N1G] + lane;
    for (int m0 = gw; m0 < NTOK; m0 += 2 * NGW) {
        const int m1 = m0 + NGW; const bool two = m1 < NTOK; const int m1c = two ? m1 : m0;
        const f32x4* xr0 = (const f32x4*)(m0 < NPROMPT ? A.in[I_XP] + (size_t)m0 * DM : A.in[I_XS] + (size_t)(m0 - NPROMPT) * DM) + lane;
        const f32x4* xr1 = (const f32x4*)(m1c < NPROMPT ? A.in[I_XP] + (size_t)m1c * DM : A.in[I_XS] + (size_t)(m1c - NPROMPT) * DM) + lane;
        f32x4 v0[4], v1[4]; float s0 = 0.f, s1 = 0.f;
#pragma unroll
        for (int j = 0; j < 4; ++j) { v0[j] = xr0[64 * j]; v1[j] = xr1[64 * j]; }
#pragma unroll
        for (int j = 0; j < 4; ++j) { s0 += (v0[j][0] * v0[j][0] + v0[j][1] * v0[j][1]) + (v0[j][2] * v0[j][2] + v0[j][3] * v0[j][3]);
                                      s1 += (v1[j][0] * v1[j][0] + v1[j][1] * v1[j][1]) + (v1[j][2] * v1[j][2] + v1[j][3] * v1[j][3]); }
#pragma unroll
        for (int o = 1; o < 64; o <<= 1) { s0 += __shfl_xor(s0, o); s1 += __shfl_xor(s1, o); }
        const float r0 = __builtin_amdgcn_rsqf(s0 * (1.f / DM) + 1e-6f), r1 = __builtin_amdgcn_rsqf(s1 * (1.f / DM) + 1e-6f);
#pragma unroll
        for (int rr = 0; rr < 2; ++rr) {
            if (rr == 1 && !two) break;
            const int m = rr ? m1 : m0; const float rstd = rr ? r1 : r0;
            v2u* o8 = (v2u*)(A1 + (size_t)m * DM) + lane;
            float* so = nullptr;
            if (m < NPROMPT) { if ((m & (SEQ_P - 1)) == SEQ_P - 1) so = A.out + O_SHIFT_P + (size_t)(m / SEQ_P) * DM; }
            else { const int ms = m - NPROMPT; if ((ms & (SEQ_S - 1)) == SEQ_S - 1) so = A.out + O_SHIFT_S + (size_t)(ms / SEQ_S) * DM; }
#pragma unroll
            for (int j = 0; j < 4; ++j) { const f32x4 g = g1v[64 * j]; const f32x4 y = (rr ? v1[j] : v0[j]) * rstd * g;
                v2u w; w.x = cvt_pk_bf16(y[0], y[1]); w.y = cvt_pk_bf16(y[2], y[3]); o8[64 * j] = w;
                if (so) ((f32x4*)so)[lane + 64 * j] = y; }
        }
    }
    for (int m = NTOK + gw; m < MPAD; m += NGW) {
        v2u* o8 = (v2u*)(A1 + (size_t)m * DM) + lane;
        if (m < NTOK + NSHIFT) {
            const f32x4* xr = (const f32x4*)(A.in[I_SSHIFT] + (size_t)(m - NTOK) * DM) + lane;
#pragma unroll
            for (int j = 0; j < 4; ++j) { const f32x4 y = xr[64 * j]; v2u w; w.x = cvt_pk_bf16(y[0], y[1]); w.y = cvt_pk_bf16(y[2], y[3]); o8[64 * j] = w; }
        } else {
#pragma unroll
            for (int j = 0; j < 4; ++j) { v2u w; w.x = 0u; w.y = 0u; o8[64 * j] = w; }
        }
    }
}

__device__ __forceinline__ void unpack8(const v4u w, float (&f)[8]) { f[0] = bf_lo(w.x); f[1] = bf_hi(w.x); f[2] = bf_lo(w.y); f[3] = bf_hi(w.y); f[4] = bf_lo(w.z); f[5] = bf_hi(w.z); f[6] = bf_lo(w.w); f[7] = bf_hi(w.w); }
__device__ __forceinline__ void conv_phase(const Args& A, int gt, int nth) {
    const bf16* Zc = (const bf16*)(A.ws + WS_ZC); bf16* YA = (bf16*)(A.ws + WS_A1);
    const float* cw = A.in[I_CONVW];
    for (int task = gt; task < (NTOK / 16) * 64; task += nth) {
        const int seg = task >> 6, ch = (task & 63) * 8, row0 = seg * 16;
        int b, t0, T; bool prompt = row0 < NPROMPT;
        if (prompt) { b = row0 / SEQ_P; t0 = row0 % SEQ_P; T = SEQ_P; } else { b = (row0 - NPROMPT) / SEQ_S; t0 = 0; T = SEQ_S; }
        float um2[8], um1[8], c0[8], c1[8], c2[8];
#pragma unroll
        for (int i = 0; i < 8; ++i) { c0[i] = cw[ch + i]; c1[i] = cw[512 + ch + i]; c2[i] = cw[1024 + ch + i]; }
        if (t0 == 0) {
            if (prompt) {
#pragma unroll
                for (int i = 0; i < 8; ++i) { um2[i] = 0.f; um1[i] = 0.f; }
            } else { const float* sc = A.in[I_SCONV] + (size_t)b * 2 * 512 + ch;
#pragma unroll
                for (int i = 0; i < 8; ++i) { um2[i] = sc[i]; um1[i] = sc[512 + i]; } }
        } else {
            unpack8(*(const v4u*)(Zc + (size_t)(row0 - 2) * 1024 + 512 + ch), um2); unpack8(*(const v4u*)(Zc + (size_t)(row0 - 1) * 1024 + 512 + ch), um1);
        }
#pragma unroll 4
        for (int t = 0; t < 16; ++t) {
            const size_t row = (size_t)(row0 + t);
            float zb[8], zu[8], y[8];
            unpack8(*(const v4u*)(Zc + row * 1024 + ch), zb); unpack8(*(const v4u*)(Zc + row * 1024 + 512 + ch), zu);
#pragma unroll
            for (int i = 0; i < 8; ++i) { const float u = zu[i]; y[i] = zb[i] * (c0[i] * um2[i] + c1[i] * um1[i] + c2[i] * u); um2[i] = um1[i]; um1[i] = u; }
            v4u o; o.x = cvt_pk_bf16(y[0], y[1]); o.y = cvt_pk_bf16(y[2], y[3]); o.z = cvt_pk_bf16(y[4], y[5]); o.w = cvt_pk_bf16(y[6], y[7]);
            *(v4u*)(YA + row * 512 + ch) = o;
        }
        if (t0 + 16 == T) { float* oc = A.out + (prompt ? O_CONV_P : O_CONV_S) + (size_t)b * 2 * 512 + ch;
#pragma unroll
            for (int i = 0; i < 8; ++i) { oc[i] = um2[i]; oc[512 + i] = um1[i]; } }
    }
    bf16* Zr = (bf16*)(A.ws + WS_ZR);
    for (int task = nth - 1 - gt; task < NTOK * 16; task += nth) {
        const int m = task >> 4, cs = task & 15;
        bool hasprev; int prow;
        if (m < NPROMPT) { hasprev = (m & (SEQ_P - 1)) != 0; prow = m - 1; } else { const int ms = m - NPROMPT; hasprev = true; prow = (ms & (SEQ_S - 1)) ? m - 1 : NTOK + ms / SEQ_S; }
        bf16* pap = Zr + (size_t)m * 2048 + 1536 + cs * 16;
        float pa[16], t8[8];
        const v4u a0 = *(const v4u*)pap, a1 = *(const v4u*)(pap + 8);
        v4u b0 = (v4u){0u, 0u, 0u, 0u}, b1 = b0;
        if (hasprev) { const bf16* pbp = Zr + (size_t)prow * 2048 + 1792 + cs * 16; b0 = *(const v4u*)pbp; b1 = *(const v4u*)(pbp + 8); }
        unpack8(a0, t8);
#pragma unroll
        for (int i = 0; i < 8; ++i) pa[i] = t8[i];
        unpack8(a1, t8);
#pragma unroll
        for (int i = 0; i < 8; ++i) pa[8 + i] = t8[i];
        unpack8(b0, t8);
#pragma unroll
        for (int i = 0; i < 8; ++i) pa[i] += t8[i];
        unpack8(b1, t8);
#pragma unroll
        for (int i = 0; i < 8; ++i) pa[8 + i] += t8[i];
#pragma unroll
        for (int i = 0; i < 16; ++i) { float p = pa[i];
            if (cs < 4) p = 1.0f - 2.0f * __builtin_amdgcn_rcpf(__expf(2.0f * p) + 1.0f);
            else if (cs >= 8) p = sigm(p);
            pa[i] = p; }
        v4u o0, o1; o0.x = cvt_pk_bf16(pa[0], pa[1]); o0.y = cvt_pk_bf16(pa[2], pa[3]); o0.z = cvt_pk_bf16(pa[4], pa[5]); o0.w = cvt_pk_bf16(pa[6], pa[7]);
        o1.x = cvt_pk_bf16(pa[8], pa[9]); o1.y = cvt_pk_bf16(pa[10], pa[11]); o1.z = cvt_pk_bf16(pa[12], pa[13]); o1.w = cvt_pk_bf16(pa[14], pa[15]);
        *(v4u*)pap = o0; *(v4u*)(pap + 8) = o1;
    }
}

constexpr int NUNITS_P = NB_P * 8 * 64, NUNITS = NUNITS_P + NB_S * 8;
constexpr int HID_STRIDE = 264, SC_TB = 32;
constexpr int P1_HIDB = 0, P1_LO = 16896, P1_SEQ = 41472, P1_GG = 90624, P1_YY = 98816, P1_ZZ = 107008, P1_BON = 115200;
typedef float f32x2 __attribute__((ext_vector_type(2)));

struct P1Pre { v4u pa0, pa1; v2u zr, zk, zv, pr, pk, pv; };
struct P1Pos { int unit, t0; };
__device__ __forceinline__ void p1_decode(int unit, bool& prompt, int& b, int& h, int& ch, int& T, int& rowbase) {
    prompt = unit < NUNITS_P; b = prompt ? unit >> 9 : (unit - NUNITS_P) >> 3; h = prompt ? (unit >> 6) & 7 : unit & 7; ch = prompt ? unit & 63 : 0;
    T = prompt ? 64 : SEQ_S; rowbase = prompt ? b * SEQ_P + ch * 64 : NPROMPT + b * SEQ_S;
}
__device__ __forceinline__ void p1_rows(int unit, int t0, int tt, size_t& row, size_t& prow, bool& hasprev, int& nb) {
    bool prompt; int b, h, ch, T, rowbase; p1_decode(unit, prompt, b, h, ch, T, rowbase);
    nb = (T - t0) < SC_TB ? (T - t0) : SC_TB;
    const int tloc = tt < nb ? tt : nb - 1, t = t0 + tloc; const bool first = (ch == 0);
    row = (size_t)(rowbase + t); hasprev = (t > 0) || !first || !prompt; prow = ((t > 0) || !first) ? row - 1 : (size_t)(NTOK + b);
}
__device__ __forceinline__ void p1_load(const Args& A, int unit, int t0, int tt, int cs, P1Pre& P) {
    size_t row, prow; bool hasprev; int nb; p1_rows(unit, t0, tt, row, prow, hasprev, nb);
    const int h = unit < NUNITS_P ? (unit >> 6) & 7 : unit & 7, hc = h * 64 + cs * 4;
    const bf16* Zr = (const bf16*)(A.ws + WS_ZR);
    P.pa0 = *(const v4u*)(Zr + row * 2048 + 1536 + cs * 16); P.pa1 = *(const v4u*)(Zr + row * 2048 + 1536 + cs * 16 + 8);
    P.zr = *(const v2u*)(Zr + row * 2048 + hc); P.zk = *(const v2u*)(Zr + row * 2048 + 512 + hc); P.zv = *(const v2u*)(Zr + row * 2048 + 1024 + hc);
    const v2u z2 = (v2u){0u, 0u};
    P.pr = z2; P.pk = z2; P.pv = z2;
    if (hasprev) { P.pr = *(const v2u*)(Zr + prow * 2048 + hc); P.pk = *(const v2u*)(Zr + prow * 2048 + 512 + hc); P.pv = *(const v2u*)(Zr + prow * 2048 + 1024 + hc); }
}
__device__ __forceinline__ bool p1_unit_at(int i, int vcu, int G, int& unit) {
    if (G == 256) { if (i > 16) return false; unit = i < 16 ? vcu * 16 + i : NUNITS_P + vcu; return true; }
    unit = vcu + i * G; return unit < NUNITS;
}

constexpr int WY_OS = 72, WY_TS = 24, WY_LS = 40;
constexpr int WY_AT = 0, WY_RT = WY_AT + 16 * WY_OS * 2, WY_BT = WY_RT + 16 * WY_OS * 2, WY_KT = WY_BT + 16 * WY_OS * 2, WY_BK = WY_KT + 16 * WY_OS * 2,
              WY_VT = WY_BK + 64 * WY_LS * 2, WY_GC = WY_VT + 64 * WY_TS * 2, WY_BUF = WY_GC + 256;
constexpr int WY_BASE = 0;
constexpr int WY_GSET = 1024 + 2 * 16 * WY_LS * 2 + 1024;
constexpr int WY_LAB = WY_BASE + 2 * WY_BUF;
static_assert(WY_LAB + WY_GSET <= P1_SEQ, "UT-transform operands must fit over HIDB | LO");
constexpr int WY_XB = 115328, WY_END = WY_XB + 128 * WY_OS * 2;
static_assert(WY_END <= LDSCTL_OFF, "LDS map of pass 1");

constexpr int WY_G2 = P1_GG + 2048;
static_assert(WY_G2 + WY_GSET <= P1_YY, "second Gram set");
__device__ __forceinline__ void p1_wy(f32x4 (&X)[4], const LAS float* SEQ, LAS float* YY, LAS float* ZZ, LAS unsigned char* lds, int nb, int tid, int lane, int wave, int part = 0) {
    const bool pw = wave >= 4; const int nmc = nb >> 4;
    LAS bf16* Xb = (LAS bf16*)(lds + WY_XB);
    for (int mc = 0; mc < nmc; ++mc) {
        asm volatile("" : "+v"(tid));
        LAS unsigned char* ob = lds + WY_BASE + mc * WY_BUF;
        LAS bf16* At = (LAS bf16*)(ob + WY_AT); LAS bf16* Rt = (LAS bf16*)(ob + WY_RT); LAS bf16* Bt = (LAS bf16*)(ob + WY_BT); LAS bf16* Kt = (LAS bf16*)(ob + WY_KT);
        LAS bf16* BKT = (LAS bf16*)(ob + WY_BK); LAS bf16* VT = (LAS bf16*)(ob + WY_VT); LAS float* GC = (LAS float*)(ob + WY_GC);
        const int tl = tid >> 5, c2 = (tid & 31) * 2, s0 = mc * 16;
        f32x2 cum = (f32x2){0.f, 0.f}, tot = cum, lwt = cum;
#pragma unroll
        for (int i = 0; i < 16; ++i) { const f32x2 l2 = *(const LAS f32x2*)(SEQ + (s0 + i) * 384 + 64 + c2); tot += l2; if (i <= tl) cum += l2; if (i == tl) lwt = l2; }
        const LAS float* sp = SEQ + (s0 + tl) * 384 + c2;
        const f32x2 a2 = *(const LAS f32x2*)(sp), b2 = *(const LAS f32x2*)(sp + 128), k2 = *(const LAS f32x2*)(sp + 192), r2 = *(const LAS f32x2*)(sp + 256), v2 = *(const LAS f32x2*)(sp + 320);
        const f32x2 gt = (f32x2){__builtin_amdgcn_exp2f(cum.x), __builtin_amdgcn_exp2f(cum.y)}, gp = (f32x2){__builtin_amdgcn_exp2f(cum.x - lwt.x), __builtin_amdgcn_exp2f(cum.y - lwt.y)},
                    gi = (f32x2){__builtin_amdgcn_exp2f(-cum.x), __builtin_amdgcn_exp2f(-cum.y)}, go = (f32x2){__builtin_amdgcn_exp2f(tot.x - cum.x), __builtin_amdgcn_exp2f(tot.y - cum.y)};
        *(LAS unsigned*)(At + tl * WY_OS + c2) = cvt_pk_bf16(a2.x * gp.x, a2.y * gp.y); *(LAS unsigned*)(Rt + tl * WY_OS + c2) = cvt_pk_bf16(r2.x * gt.x, r2.y * gt.y);
        *(LAS unsigned*)(Bt + tl * WY_OS + c2) = cvt_pk_bf16(b2.x * gi.x, b2.y * gi.y); *(LAS unsigned*)(Kt + tl * WY_OS + c2) = cvt_pk_bf16(k2.x * gi.x, k2.y * gi.y);
        const unsigned bh = cvt_pk_bf16(b2.x * go.x, b2.y * go.y), kh = cvt_pk_bf16(k2.x * go.x, k2.y * go.y), vv = cvt_pk_bf16(v2.x, v2.y);
        {
            const unsigned bh_o = (unsigned)__shfl_xor((int)bh, 32), kh_o = (unsigned)__shfl_xor((int)kh, 32), vv_o = (unsigned)__shfl_xor((int)vv, 32);
            const bool ev = (tl & 1) == 0; const int col = ev ? c2 : c2 + 1;
            const int wk = col * WY_LS + 8 * (tl >> 2) + (tl & 2), wo = col * WY_TS + (tl & ~1);
            *(LAS unsigned*)(BKT + wk) = ev ? ((bh & 0xffffu) | (bh_o << 16)) : ((bh_o >> 16) | (bh & 0xffff0000u));
            *(LAS unsigned*)(BKT + wk + 4) = ev ? ((kh & 0xffffu) | (kh_o << 16)) : ((kh_o >> 16) | (kh & 0xffff0000u));
            *(LAS unsigned*)(VT + wo) = ev ? ((vv & 0xffffu) | (vv_o << 16)) : ((vv_o >> 16) | (vv & 0xffff0000u)); }
        if (tl == 0) *(LAS f32x2*)(GC + c2) = (f32x2){__builtin_amdgcn_exp2f(tot.x), __builtin_amdgcn_exp2f(tot.y)};
    }
    __syncthreads();
    {
        asm volatile("" : "+v"(tid));
        const int fr = tid & 15, fq = (tid >> 4) & 3, m_ = wave >> 2, g_ = (wave + m_) & 3;
        if (m_ < nmc) {
            LAS unsigned char* ob = lds + WY_BASE + m_ * WY_BUF; LAS unsigned char* gs = lds + (m_ ? WY_G2 : WY_LAB);
            LAS float* Lab = (LAS float*)gs; LAS bf16* Lak = (LAS bf16*)(gs + 1024); LAS bf16* Mc = (LAS bf16*)(gs + 1024 + 16 * WY_LS * 2); LAS float* TT = (LAS float*)(gs + 1024 + 2 * 16 * WY_LS * 2);
            const LAS bf16* ab = (LAS bf16*)(ob + (g_ < 2 ? WY_AT : WY_RT)) + fr * WY_OS + fq * 8; const LAS bf16* bb = (LAS bf16*)(ob + ((g_ & 1) ? WY_KT : WY_BT)) + fr * WY_OS + fq * 8;
            f32x4 g = (f32x4){0.f, 0.f, 0.f, 0.f};
#pragma unroll
            for (int ks = 0; ks < 2; ++ks) g = __builtin_amdgcn_mfma_f32_16x16x32_bf16(*(const LAS bf16x8*)(bb + ks * 32), *(const LAS bf16x8*)(ab + ks * 32), g, 0, 0, 0);
#pragma unroll
            for (int rg = 0; rg < 4; ++rg) { const int tp = 4 * fq + rg; const bool keep = (g_ < 2) ? (fr > tp) : (fr >= tp); g[rg] = keep ? g[rg] : 0.f; }
            if (g_ == 0) {
                *(LAS f32x4*)(Lab + fr * 16 + 4 * fq) = g;
                LDS_WAIT();
                float u[16];
#pragma unroll
                for (int t = 0; t < 16; ++t) { if ((t & 3) == 0) asm volatile("" ::: "memory");
                    float acc = (t == fr) ? 1.0f : 0.0f;
#pragma unroll
                    for (int i4 = 0; i4 * 4 < t; ++i4) { const f32x4 l4 = *(const LAS f32x4*)(Lab + t * 16 + i4 * 4);
#pragma unroll
                        for (int e = 0; e < 4; ++e) if (i4 * 4 + e < t) acc += l4[e] * u[i4 * 4 + e]; }
                    u[t] = acc; }
                if (fq == 0) {
#pragma unroll
                    for (int t = 0; t < 16; ++t) TT[t * 16 + fr] = u[t]; }
            } else { v2u w; w.x = cvt_pk_bf16(g[0], g[1]); w.y = cvt_pk_bf16(g[2], g[3]);
                if (g_ == 1) { *(LAS v2u*)(Lak + fr * WY_LS + 8 * fq + 4) = w; *(LAS v2u*)(Lak + fr * WY_LS + 8 * fq) = (v2u){0u, 0u}; }
                else if (g_ == 2) *(LAS v2u*)(Mc + fr * WY_LS + 8 * fq) = w; else *(LAS v2u*)(Mc + fr * WY_LS + 8 * fq + 4) = w; }
        }
    }
    __syncthreads();
    if (MK_DBGSEL == 2 && part) return;
    for (int mc = 0; mc < nmc; ++mc) {
        asm volatile("" : "+v"(tid));
        const int fr = tid & 15, fq = (tid >> 4) & 3;
        LAS unsigned char* ob = lds + WY_BASE + mc * WY_BUF; LAS unsigned char* gs = lds + (mc ? WY_G2 : WY_LAB);
        LAS bf16* At = (LAS bf16*)(ob + WY_AT); LAS bf16* Rt = (LAS bf16*)(ob + WY_RT);
        LAS bf16* BKT = (LAS bf16*)(ob + WY_BK); LAS bf16* VT = (LAS bf16*)(ob + WY_VT); LAS float* GC = (LAS float*)(ob + WY_GC);
        LAS bf16* Lak = (LAS bf16*)(gs + 1024); LAS bf16* Mc = (LAS bf16*)(gs + 1024 + 16 * WY_LS * 2); LAS float* TT = (LAS float*)(gs + 1024 + 2 * 16 * WY_LS * 2);
        f32x4 W1 = (f32x4){0.f, 0.f, 0.f, 0.f}, Y0 = W1;
        {
            const LAS bf16* xbp = Xb + (16 * wave + fr) * WY_OS + fq * 8;
#pragma unroll
            for (int ks = 0; ks < 2; ++ks) { const bf16x8 bx = *(const LAS bf16x8*)(xbp + ks * 32);
                W1 = __builtin_amdgcn_mfma_f32_16x16x32_bf16(*(const LAS bf16x8*)(At + fr * WY_OS + ks * 32 + fq * 8), bx, W1, 0, 0, 0);
                Y0 = __builtin_amdgcn_mfma_f32_16x16x32_bf16(*(const LAS bf16x8*)(Rt + fr * WY_OS + ks * 32 + fq * 8), bx, Y0, 0, 0, 0); }
        }
        v2u vq = (v2u){0u, 0u};
        if (!pw) vq = *(const LAS v2u*)(VT + (16 * wave + fr) * WY_TS + 4 * fq);
        if (!pw) { v4u vb; vb.x = 0u; vb.y = 0u; vb.z = vq.x; vb.w = vq.y;
            W1 = __builtin_amdgcn_mfma_f32_16x16x32_bf16(*(const LAS bf16x8*)(Lak + fr * WY_LS + fq * 8), __builtin_bit_cast(bf16x8, vb), W1, 0, 0, 0); }
        f32x4 U = (f32x4){0.f, 0.f, 0.f, 0.f};
        if (!(MK_DBGSEL == 3 && part)) {
            const f32x4 tq = *(const LAS f32x4*)(TT + fr * 16 + 4 * fq);
#pragma unroll
            for (int kk = 0; kk < 4; ++kk) U = __builtin_amdgcn_mfma_f32_16x16x4f32(tq[kk], W1[kk], U, 0, 0, 0);
        } else U = W1;
        {
            v4u ucw; ucw.x = cvt_pk_bf16(U[0], U[1]); ucw.y = cvt_pk_bf16(U[2], U[3]); ucw.z = vq.x; ucw.w = vq.y;
            const bf16x8 uc = __builtin_bit_cast(bf16x8, ucw);
            Y0 = __builtin_amdgcn_mfma_f32_16x16x32_bf16(*(const LAS bf16x8*)(Mc + fr * WY_LS + fq * 8), uc, Y0, 0, 0, 0);
            LAS float* yo = (pw ? ZZ + 16 * (wave - 4) : YY + 16 * wave) + fr;
#pragma unroll
            for (int rg = 0; rg < 4; ++rg) yo[(mc * 16 + 4 * fq + rg) * 64] = Y0[rg];
#pragma unroll
            for (int j = 0; j < 4; ++j) {
                const bf16x8 bc = *(const LAS bf16x8*)(BKT + (16 * j + fr) * WY_LS + fq * 8);
                X[j] = X[j] * *(const LAS f32x4*)(GC + 16 * j + 4 * fq);
                X[j] = __builtin_amdgcn_mfma_f32_16x16x32_bf16(bc, uc, X[j], 0, 0, 0);
                v2u w; w.x = cvt_pk_bf16(X[j][0], X[j][1]); w.y = cvt_pk_bf16(X[j][2], X[j][3]);
                *(LAS v2u*)(Xb + (16 * wave + fr) * WY_OS + 16 * j + 4 * fq) = w; }
        }
        LDS_WAIT();
    }
}

#define P1_LOAD_PARAMS(HH) do { int lf_ = fr, lq_ = fq, lt_ = tid; asm volatile("" : "+v"(lf_), "+v"(lq_), "+v"(lt_));   \
        const int h_ = (HH), ncol_ = h_ * 64 + ntl * 16 + lf_; \
        _Pragma("unroll") for (int ks = 0; ks < 2; ++ks) { bw[ks] = *(const bf16x8*)(L2T + (size_t)ncol_ * 64 + lq_ * 8 + ks * 32); ba[ks] = *(const bf16x8*)(L2T + (size_t)512 * 64 + (size_t)ncol_ * 64 + lq_ * 8 + ks * 32); } \
        _Pragma("unroll") for (int ks = 0; ks < 4; ++ks) bg[ks] = *(const bf16x8*)(L2T + (size_t)1024 * 64 + (size_t)ncol_ * 128 + lq_ * 8 + ks * 32); \
        if (lt_ < 128) { const int a_ = lt_ >> 4, c_ = (lt_ & 15) * 4; \
            const float* src_ = a_ == 0 ? A.in[I_W0] : a_ == 1 ? A.in[I_A0] : a_ == 2 ? A.in[I_KK] : a_ == 3 ? A.in[I_KA] : a_ == 4 ? A.in[I_RK] : A.in[I_MURKV] + (a_ - 5) * 512; \
            *(LAS f32x4*)(PRM + a_ * 64 + c_) = *(const f32x4*)(src_ + h_ * 64 + c_); } } while (0)
__device__ __forceinline__ void scan_pass1(const Args& A, LAS unsigned char* lds, int tid, int lane, int wave, int vcu, int G, int part = 0) {
    bf16* GB = (bf16*)(A.ws + WS_A1) + (size_t)MPAD * 512;
    bf16* YL = (bf16*)(A.ws + WS_YL); bf16* ZT = (bf16*)(A.ws + WS_ZT); bf16* BV = (bf16*)(A.ws + WS_BV);
    LAS bf16* HIDB = (LAS bf16*)(lds + P1_SEQ);
    LAS float* LO = (LAS float*)(lds + P1_LO); LAS float* SEQ = (LAS float*)(lds + P1_SEQ);
    LAS float* YY = (LAS float*)(lds + P1_YY); LAS float* ZZ = (LAS float*)(lds + P1_ZZ);
    const bf16* L2T = (const bf16*)(A.ws + WS_L2T);
    const bool prow_wave = wave >= 4;
    const int mt = wave & 1, ntl = wave >> 1;
    int tt = tid >> 4, cs = tid & 15, c4 = cs * 4, fr = lane & 15, fq = lane >> 4;
    f32x4 X[4];
    bf16x8 bw[2], ba[2], bg[4];
    LAS float* PRM = (LAS float*)(lds + P1_GG);
    int cur_h = -1;
    int ui = 0, unit; if (!p1_unit_at(0, vcu, G, unit)) return;
    int t0 = 0; P1Pre pre; p1_load(A, unit, 0, tt, cs, pre);
    *(LAS v4u*)(HIDB + tt * HID_STRIDE + cs * 16) = pre.pa0; *(LAS v4u*)(HIDB + tt * HID_STRIDE + cs * 16 + 8) = pre.pa1;
    __syncthreads();
    for (;;) {
        { int lt_ = tid; asm volatile("" : "+v"(lt_)); tt = lt_ >> 4; cs = lt_ & 15; c4 = cs * 4; fr = lt_ & 15; fq = (lt_ >> 4) & 3; }
        bool prompt; int b, h, ch, T, rowbase; p1_decode(unit, prompt, b, h, ch, T, rowbase);
        const int hc = h * 64 + c4;
        if (t0 == 0 && G == 256 && ui < 8) {
            const size_t i16 = ((size_t)(ui * 256 + vcu) * NTHR + tid) * 16;
            cvt16_fp8_sliced(A.in[I_U], A.ws + WS_UB, PEER_SU, i16); cvt16_fp8_sliced(A.in[I_V], A.ws + WS_VB, PEER_SV, i16); }
        if (t0 == 0) {
            LAS bf16* Xb = (LAS bf16*)(lds + WY_XB);
#pragma unroll
            for (int j = 0; j < 4; ++j) { const int prow_ = 16 * (wave - 4) + fr, c0_ = 16 * j + 4 * fq;
#pragma unroll
                for (int e = 0; e < 4; ++e) X[j][e] = (prow_wave && prow_ == c0_ + e) ? 1.f : 0.f;
                v2u w; w.x = cvt_pk_bf16(X[j][0], X[j][1]); w.y = cvt_pk_bf16(X[j][2], X[j][3]);
                *(LAS v2u*)(Xb + (16 * wave + fr) * WY_OS + c0_) = w; }
        }
        if (h != cur_h) { cur_h = h; P1_LOAD_PARAMS(h); }
        size_t row, prow; bool hasprev; int nb; p1_rows(unit, t0, tt, row, prow, hasprev, nb);
        if (!(MK_DBGSEL == 5 && part)) {
            const LAS bf16* ap = HIDB + (mt * 16 + fr) * HID_STRIDE + fq * 8;
            f32x4 cw = (f32x4){0.f, 0.f, 0.f, 0.f}, ca = cw, cg = cw;
#pragma unroll
            for (int ks = 0; ks < 2; ++ks) { cw = __builtin_amdgcn_mfma_f32_16x16x32_bf16(*(const LAS bf16x8*)(ap + ks * 32), bw[ks], cw, 0, 0, 0);
                                             ca = __builtin_amdgcn_mfma_f32_16x16x32_bf16(*(const LAS bf16x8*)(ap + 64 + ks * 32), ba[ks], ca, 0, 0, 0); }
#pragma unroll
            for (int ks = 0; ks < 4; ++ks) cg = __builtin_amdgcn_mfma_f32_16x16x32_bf16(*(const LAS bf16x8*)(ap + 128 + ks * 32), bg[ks], cg, 0, 0, 0);
#pragma unroll
            for (int rg = 0; rg < 4; ++rg) { const int o = (mt * 16 + fq * 4 + rg) * 64 + ntl * 16 + fr; LO[o] = cw[rg]; LO[2048 + o] = ca[rg]; LO[4096 + o] = cg[rg]; }
        }
        __syncthreads();
        if (!(MK_DBGSEL == 5 && part)) {
            const f32x4 w0v = *(const LAS f32x4*)(PRM + c4), a0v = *(const LAS f32x4*)(PRM + 64 + c4), kkv = *(const LAS f32x4*)(PRM + 128 + c4), kav = *(const LAS f32x4*)(PRM + 192 + c4),
                        rkv = *(const LAS f32x4*)(PRM + 256 + c4), mur = *(const LAS f32x4*)(PRM + 320 + c4), muk = *(const LAS f32x4*)(PRM + 384 + c4), muv = *(const LAS f32x4*)(PRM + 448 + c4);
            const f32x4 aw = w0v + *(const LAS f32x4*)(LO + tt * 64 + c4), aa = a0v + *(const LAS f32x4*)(LO + 2048 + tt * 64 + c4), ag = *(const LAS f32x4*)(LO + 4096 + tt * 64 + c4);
            f32x4 r = (f32x4){bf_lo(pre.zr.x), bf_hi(pre.zr.x), bf_lo(pre.zr.y), bf_hi(pre.zr.y)}, k = (f32x4){bf_lo(pre.zk.x), bf_hi(pre.zk.x), bf_lo(pre.zk.y), bf_hi(pre.zk.y)},
                  v = (f32x4){bf_lo(pre.zv.x), bf_hi(pre.zv.x), bf_lo(pre.zv.y), bf_hi(pre.zv.y)};
            const f32x4 rpv = (f32x4){bf_lo(pre.pr.x), bf_hi(pre.pr.x), bf_lo(pre.pr.y), bf_hi(pre.pr.y)}, kpv = (f32x4){bf_lo(pre.pk.x), bf_hi(pre.pk.x), bf_lo(pre.pk.y), bf_hi(pre.pk.y)},
                        vpv = (f32x4){bf_lo(pre.pv.x), bf_hi(pre.pv.x), bf_lo(pre.pv.y), bf_hi(pre.pv.y)};
            r = r + mur * (rpv - r); k = k + muk * (kpv - k); v = v + muv * (vpv - v);
            f32x4 dec, asg, kk, km, av, bv;
            float ssq = 0.f, bon = 0.f;
#pragma unroll
            for (int i = 0; i < 4; ++i) {
                dec[i] = -0.87503877491453f * sigm(aw[i]);
                asg[i] = sigm(aa[i]);
                kk[i] = k[i] * kkv[i]; ssq += kk[i] * kk[i];
                km[i] = k[i] * (1.0f + (asg[i] - 1.0f) * kav[i]);
                bon += r[i] * km[i] * rkv[i];
            }
            ssq = sum16(ssq); bon = sum16(bon);
            const float inv = fminf(__builtin_amdgcn_rsqf(ssq), 1e12f);
#pragma unroll
            for (int i = 0; i < 4; ++i) { kk[i] *= inv; av[i] = -kk[i]; bv[i] = kk[i] * asg[i]; }
            LAS float* sq_ = SEQ + tt * 384 + c4;
            *(LAS f32x4*)(sq_) = av; *(LAS f32x4*)(sq_ + 64) = dec; *(LAS f32x4*)(sq_ + 128) = bv; *(LAS f32x4*)(sq_ + 192) = km; *(LAS f32x4*)(sq_ + 256) = r; *(LAS f32x4*)(sq_ + 320) = v;
            if (tt < nb) {
                v2u w; w.x = cvt_pk_bf16(ag[0], ag[1]); w.y = cvt_pk_bf16(ag[2], ag[3]); *(v2u*)(GB + row * 512 + hc) = w;
                w.x = cvt_pk_bf16(bon * v[0], bon * v[1]); w.y = cvt_pk_bf16(bon * v[2], bon * v[3]); *(v2u*)(BV + row * 512 + hc) = w;
            }
        }
        int nunit = unit, nt0 = t0 + SC_TB, nui = ui; bool more = true;
        if (nt0 >= T) { nt0 = 0; nui = ui + 1; more = p1_unit_at(nui, vcu, G, nunit); }
        if (more) p1_load(A, nunit, nt0, tt, cs, pre);
        __syncthreads();
        if (!(MK_DBGSEL == 1 && part)) p1_wy(X, SEQ, YY, ZZ, lds, nb, tid, lane, wave, part);
        if (more) { *(LAS v4u*)(HIDB + tt * HID_STRIDE + cs * 16) = pre.pa0; *(LAS v4u*)(HIDB + tt * HID_STRIDE + cs * 16 + 8) = pre.pa1; }
        __syncthreads();
        if (tt < nb) {
            const f32x4 y = *(const LAS f32x4*)(YY + tt * 64 + c4), z = *(const LAS f32x4*)(ZZ + tt * 64 + c4);
            v2u w; w.x = cvt_pk_bf16(y[0], y[1]); w.y = cvt_pk_bf16(y[2], y[3]); *(v2u*)(YL + row * 512 + hc) = w;
            w.x = cvt_pk_bf16(z[0], z[1]); w.y = cvt_pk_bf16(z[2], z[3]); *(v2u*)(ZT + row * 512 + hc) = w;
        }
        if (t0 + SC_TB >= T) {
#pragma unroll
            for (int j = 0; j < 4; ++j) {
                if (!prow_wave) *(f32x4*)((float*)A.out + (size_t)unit * 4096 + (16 * wave + fr) * 64 + 16 * j + 4 * fq) = X[j];
                else { bf16* mt = (bf16*)((unsigned char*)A.out + OB_MB) + (size_t)unit * 4096 + (16 * j + 4 * fq) * 64 + 16 * (wave - 4) + fr;
                    const unsigned p01 = cvt_pk_bf16(X[j][0], X[j][1]), p23 = cvt_pk_bf16(X[j][2], X[j][3]);
                    mt[0] = (bf16)(p01 & 0xffffu); mt[64] = (bf16)(p01 >> 16); mt[128] = (bf16)(p23 & 0xffffu); mt[192] = (bf16)(p23 >> 16); }
            }
        }
        if (!more) break;
        unit = nunit; t0 = nt0; ui = nui;
    }
    __syncthreads();
}

constexpr int P2_SS = 72, P2_LO = 16 * P2_SS * 2, P2_BUF = 2 * P2_LO;
__device__ __forceinline__ void scan_pass2_rows(const float* Sinit, int unit0, int nchunks, int v0, float* outfin, bool slots, const Args& A, LAS unsigned char* lds, int tid, int lane, int wave) {
    LAS bf16* Shi = (LAS bf16*)lds; LAS bf16* Slo = (LAS bf16*)(lds + P2_LO);
    const int nt = wave & 3, fr = lane & 15, fq = lane >> 4; const bool act = wave < 4;
    float* NB = (float*)A.out; const bf16* MT = (const bf16*)((const unsigned char*)A.out + OB_MB);
    { const int idx = tid * 2, row = idx >> 6, col = idx & 63;
      const f32x2 s0 = Sinit ? *(const f32x2*)(Sinit + (size_t)(v0 + row) * 64 + col) : (f32x2){0.f, 0.f};
      const unsigned hi = cvt_pk_bf16(s0.x, s0.y);
      *(LAS unsigned*)(Shi + row * P2_SS + col) = hi; *(LAS unsigned*)(Slo + row * P2_SS + col) = cvt_pk_bf16(s0.x - bf_lo(hi), s0.y - bf_hi(hi)); }
    bf16x8 mr[4][2]; f32x4 nr[4];
    const size_t moff = (size_t)(16 * nt + fr) * 64 + fq * 8, noff = (size_t)(v0 + fr) * 64 + 16 * nt + 4 * fq;
#pragma unroll
    for (int d = 0; d < 4; ++d) {
        mr[d][0] = (bf16x8){0, 0, 0, 0, 0, 0, 0, 0}; mr[d][1] = mr[d][0]; nr[d] = (f32x4){0.f, 0.f, 0.f, 0.f};
        { const int cc = d < nchunks ? d : nchunks - 1;
            mr[d][0] = *(const bf16x8*)(MT + (size_t)(unit0 + cc) * 4096 + moff); mr[d][1] = *(const bf16x8*)(MT + (size_t)(unit0 + cc) * 4096 + moff + 32);
            nr[d] = *(const f32x4*)(NB + (size_t)(unit0 + cc) * 4096 + noff); }
    }
    f32x4 acc = (f32x4){0.f, 0.f, 0.f, 0.f};
    __syncthreads();
    for (int c0 = 0; c0 < nchunks; c0 += 4) {
#pragma unroll
        for (int d = 0; d < 4; ++d) {
            const int c = c0 + d;
            if (c < nchunks) {
                {
                    LAS bf16* Shi = (LAS bf16*)(lds + (d & 1) * P2_BUF); LAS bf16* Slo = (LAS bf16*)(lds + (d & 1) * P2_BUF + P2_LO);
                    const bf16x8 sh0 = *(const LAS bf16x8*)(Shi + fr * P2_SS + fq * 8), sh1 = *(const LAS bf16x8*)(Shi + fr * P2_SS + 32 + fq * 8),
                                 sl0 = *(const LAS bf16x8*)(Slo + fr * P2_SS + fq * 8), sl1 = *(const LAS bf16x8*)(Slo + fr * P2_SS + 32 + fq * 8);
                    acc = nr[d];
                    acc = __builtin_amdgcn_mfma_f32_16x16x32_bf16(mr[d][0], sh0, acc, 0, 0, 0); acc = __builtin_amdgcn_mfma_f32_16x16x32_bf16(mr[d][1], sh1, acc, 0, 0, 0);
                    acc = __builtin_amdgcn_mfma_f32_16x16x32_bf16(mr[d][0], sl0, acc, 0, 0, 0); acc = __builtin_amdgcn_mfma_f32_16x16x32_bf16(mr[d][1], sl1, acc, 0, 0, 0);
                    const int cn = c + 4 < nchunks ? c + 4 : nchunks - 1;
                    mr[d][0] = *(const bf16x8*)(MT + (size_t)(unit0 + cn) * 4096 + moff); mr[d][1] = *(const bf16x8*)(MT + (size_t)(unit0 + cn) * 4096 + moff + 32);
                    nr[d] = *(const f32x4*)(NB + (size_t)(unit0 + cn) * 4096 + noff);
                }
                if (act) {
                    LAS bf16* Shi = (LAS bf16*)(lds + ((d + 1) & 1) * P2_BUF); LAS bf16* Slo = (LAS bf16*)(lds + ((d + 1) & 1) * P2_BUF + P2_LO);
                    v2u hi; hi.x = cvt_pk_bf16(acc[0], acc[1]); hi.y = cvt_pk_bf16(acc[2], acc[3]);
                    v2u lo; lo.x = cvt_pk_bf16(acc[0] - bf_lo(hi.x), acc[1] - bf_hi(hi.x)); lo.y = cvt_pk_bf16(acc[2] - bf_lo(hi.y), acc[3] - bf_hi(hi.y));
                    *(LAS v2u*)(Shi + fr * P2_SS + 16 * nt + 4 * fq) = hi; *(LAS v2u*)(Slo + fr * P2_SS + 16 * nt + 4 * fq) = lo;
                    if (slots) *(v2u*)((bf16*)(NB + (size_t)(unit0 + c) * 4096) + (size_t)(v0 + fr) * 128 + 16 * nt + 4 * fq) = hi;
                }
                __syncthreads();
            }
        }
    }
    if (act) *(f32x4*)(outfin + noff) = acc;
    __syncthreads();
}

__device__ __forceinline__ void scan_pass2_sample(const float* Sinit, int unit, float* outfin, const Args& A, int lane, int wave) {
    const int fr = lane & 15, fq = lane >> 4, rt = wave >> 1;
    const float* NB = (const float*)A.out + (size_t)unit * 4096; const bf16* MT = (const bf16*)((const unsigned char*)A.out + OB_MB) + (size_t)unit * 4096;
    f32x4 sv[2][2];
#pragma unroll
    for (int ks = 0; ks < 2; ++ks) { const float* sp = Sinit + (size_t)(16 * rt + fr) * 64 + 32 * ks + 8 * fq; sv[ks][0] = *(const f32x4*)sp; sv[ks][1] = *(const f32x4*)(sp + 4); }
    bf16x8 mt[2][2]; f32x4 acc[2];
#pragma unroll
    for (int t = 0; t < 2; ++t) { const int nt = 2 * (wave & 1) + t;
        mt[t][0] = *(const bf16x8*)(MT + (size_t)(16 * nt + fr) * 64 + fq * 8); mt[t][1] = *(const bf16x8*)(MT + (size_t)(16 * nt + fr) * 64 + 32 + fq * 8);
        acc[t] = *(const f32x4*)(NB + (size_t)(16 * rt + fr) * 64 + 16 * nt + 4 * fq); }
    bf16x8 sh[2], sl[2];
#pragma unroll
    for (int ks = 0; ks < 2; ++ks) { const f32x4 a = sv[ks][0], b = sv[ks][1];
        v4u h; h.x = cvt_pk_bf16(a[0], a[1]); h.y = cvt_pk_bf16(a[2], a[3]); h.z = cvt_pk_bf16(b[0], b[1]); h.w = cvt_pk_bf16(b[2], b[3]);
        v4u l; l.x = cvt_pk_bf16(a[0] - bf_lo(h.x), a[1] - bf_hi(h.x)); l.y = cvt_pk_bf16(a[2] - bf_lo(h.y), a[3] - bf_hi(h.y));
        l.z = cvt_pk_bf16(b[0] - bf_lo(h.z), b[1] - bf_hi(h.z)); l.w = cvt_pk_bf16(b[2] - bf_lo(h.w), b[3] - bf_hi(h.w));
        sh[ks] = __builtin_bit_cast(bf16x8, h); sl[ks] = __builtin_bit_cast(bf16x8, l);
        if ((wave & 1) == 0) *(v4u*)((bf16*)((unsigned char*)A.out + OB_S0S) + (size_t)(unit - NUNITS_P) * 4096 + (size_t)(16 * rt + fr) * 64 + 32 * ks + 8 * fq) = h; }
#pragma unroll
    for (int t = 0; t < 2; ++t) { const int nt = 2 * (wave & 1) + t;
#pragma unroll
        for (int ks = 0; ks < 2; ++ks) { acc[t] = __builtin_amdgcn_mfma_f32_16x16x32_bf16(mt[t][ks], sh[ks], acc[t], 0, 0, 0); acc[t] = __builtin_amdgcn_mfma_f32_16x16x32_bf16(mt[t][ks], sl[ks], acc[t], 0, 0, 0); }
        *(f32x4*)(outfin + (size_t)(16 * rt + fr) * 64 + 16 * nt + 4 * fq) = acc[t]; }
}

__device__ __forceinline__ void scan_pass3_wave(const Args& A, int unit, int wq, int lane) {
    const bool prompt = unit < NUNITS_P;
    const int b = prompt ? unit >> 9 : (unit - NUNITS_P) >> 3, h = prompt ? (unit >> 6) & 7 : unit & 7, ch = prompt ? unit & 63 : 0;
    const int T = prompt ? 64 : SEQ_S, rowbase = prompt ? b * SEQ_P + ch * 64 : NPROMPT + b * SEQ_S;
    if (wq * 16 >= T) return;
    const bf16* S0 = prompt ? (ch > 0 ? (const bf16*)((const float*)A.out + (size_t)(unit - 1) * 4096) : (const bf16*)(A.ws + WS_CTL + 49152)) : (const bf16*)((const unsigned char*)A.out + OB_S0S) + (size_t)(b * 8 + h) * 4096;
    const int spitch = prompt ? 128 : 64;
    const bf16* ZT = (const bf16*)(A.ws + WS_ZT); const bf16* YL = (const bf16*)(A.ws + WS_YL); const bf16* BV = (const bf16*)(A.ws + WS_BV);
    bf16* YB = (bf16*)(A.ws + WS_A1) + (size_t)MPAD * 512;
    const int fr = lane & 15, fq = lane >> 4;
    const size_t row = (size_t)(rowbase + wq * 16 + fr);
    bf16x8 bz[2], sa[4][2]; v2u yl[4], bvw[4], gg[4]; f32x4 gw[4], gb[4];
#pragma unroll
    for (int ks = 0; ks < 2; ++ks) bz[ks] = *(const bf16x8*)(ZT + row * 512 + h * 64 + ks * 32 + fq * 8);
#pragma unroll
    for (int mt = 0; mt < 4; ++mt)
#pragma unroll
        for (int ks = 0; ks < 2; ++ks) sa[mt][ks] = *(const bf16x8*)(S0 + (size_t)(mt * 16 + fr) * spitch + ks * 32 + fq * 8);
#pragma unroll
    for (int mt = 0; mt < 4; ++mt) { const int c = h * 64 + mt * 16 + fq * 4;
        yl[mt] = *(const v2u*)(YL + row * 512 + c); bvw[mt] = *(const v2u*)(BV + row * 512 + c); gg[mt] = *(const v2u*)(YB + row * 512 + c);
        gw[mt] = *(const f32x4*)(A.in[I_GNW] + c); gb[mt] = *(const f32x4*)(A.in[I_GNB] + c); }
    f32x4 acc[4];
#pragma unroll
    for (int mt = 0; mt < 4; ++mt) { acc[mt] = (f32x4){0.f, 0.f, 0.f, 0.f};
#pragma unroll
        for (int ks = 0; ks < 2; ++ks) acc[mt] = __builtin_amdgcn_mfma_f32_16x16x32_bf16(sa[mt][ks], bz[ks], acc[mt], 0, 0, 0); }
    float sm = 0.f;
#pragma unroll
    for (int mt = 0; mt < 4; ++mt) { const v2u y = yl[mt];
        acc[mt][0] += bf_lo(y.x); acc[mt][1] += bf_hi(y.x); acc[mt][2] += bf_lo(y.y); acc[mt][3] += bf_hi(y.y);
        sm += (acc[mt][0] + acc[mt][1]) + (acc[mt][2] + acc[mt][3]); }
    sm += __shfl_xor(sm, 16); sm += __shfl_xor(sm, 32);
    const float mean = sm * (1.f / 64.f); float sv = 0.f;
#pragma unroll
    for (int mt = 0; mt < 4; ++mt) { acc[mt] = acc[mt] - mean; sv += (acc[mt][0] * acc[mt][0] + acc[mt][1] * acc[mt][1]) + (acc[mt][2] * acc[mt][2] + acc[mt][3] * acc[mt][3]); }
    sv += __shfl_xor(sv, 16); sv += __shfl_xor(sv, 32);
    const float rs = __builtin_amdgcn_rsqf(sv * (1.f / 64.f) + 64e-5f);
#pragma unroll
    for (int mt = 0; mt < 4; ++mt) { const int c = h * 64 + mt * 16 + fq * 4;
        f32x4 o = acc[mt] * rs * gw[mt] + gb[mt] + (f32x4){bf_lo(bvw[mt].x), bf_hi(bvw[mt].x), bf_lo(bvw[mt].y), bf_hi(bvw[mt].y)};
        o = o * (f32x4){bf_lo(gg[mt].x), bf_hi(gg[mt].x), bf_lo(gg[mt].y), bf_hi(gg[mt].y)};
        v2u w; w.x = cvt_pk_bf16(o[0], o[1]); w.y = cvt_pk_bf16(o[2], o[3]); *(v2u*)(YB + row * 512 + c) = w; }
}

__device__ __forceinline__ void tk_insert(float (&tv)[16], float x) {
#pragma unroll
    for (int i = 15; i >= 1; --i) tv[i] = __builtin_amdgcn_fmed3f(tv[i - 1], x, tv[i]);
    tv[0] = __builtin_fmaxf(tv[0], x);
}
#define TK_CE(t, i, j) { const float a_ = __builtin_fmaxf(t[i], t[j]); t[j] = __builtin_fminf(t[i], t[j]); t[i] = a_; }
__device__ __forceinline__ void tk_sort16(float (&t)[16]) {
    TK_CE(t, 0, 1) TK_CE(t, 2, 3) TK_CE(t, 0, 2) TK_CE(t, 1, 3) TK_CE(t, 1, 2) TK_CE(t, 4, 5) TK_CE(t, 6, 7) TK_CE(t, 4, 6) TK_CE(t, 5, 7) TK_CE(t, 5, 6) TK_CE(t, 0, 4) TK_CE(t, 2, 6) TK_CE(t, 2, 4) TK_CE(t, 1, 5) TK_CE(t, 3, 7) TK_CE(t, 3, 5) TK_CE(t, 1, 2) TK_CE(t, 3, 4) TK_CE(t, 5, 6) TK_CE(t, 8, 9) TK_CE(t, 10, 11) TK_CE(t, 8, 10) TK_CE(t, 9, 11) TK_CE(t, 9, 10) TK_CE(t, 12, 13) TK_CE(t, 14, 15) TK_CE(t, 12, 14) TK_CE(t, 13, 15) TK_CE(t, 13, 14) TK_CE(t, 8, 12) TK_CE(t, 10, 14) TK_CE(t, 10, 12) TK_CE(t, 9, 13) TK_CE(t, 11, 15) TK_CE(t, 11, 13) TK_CE(t, 9, 10) TK_CE(t, 11, 12) TK_CE(t, 13, 14) TK_CE(t, 0, 8) TK_CE(t, 4, 12) TK_CE(t, 4, 8) TK_CE(t, 2, 10) TK_CE(t, 6, 14) TK_CE(t, 6, 10) TK_CE(t, 2, 4) TK_CE(t, 6, 8) TK_CE(t, 10, 12) TK_CE(t, 1, 9) TK_CE(t, 5, 13) TK_CE(t, 5, 9) TK_CE(t, 3, 11) TK_CE(t, 7, 15) TK_CE(t, 7, 11) TK_CE(t, 3, 5) TK_CE(t, 7, 9) TK_CE(t, 11, 13) TK_CE(t, 1, 2) TK_CE(t, 3, 4) TK_CE(t, 5, 6) TK_CE(t, 7, 8) TK_CE(t, 9, 10) TK_CE(t, 11, 12) TK_CE(t, 13, 14)
}
__device__ __forceinline__ void tk_merge16(float (&tv)[16], const float (&g)[16]) {
#pragma unroll
    for (int i = 0; i < 16; ++i) tv[i] = __builtin_fmaxf(tv[i], g[15 - i]);
#pragma unroll
    for (int s = 8; s >= 1; s >>= 1)
#pragma unroll
        for (int i = 0; i < 16; ++i) if ((i & s) == 0) TK_CE(tv, i, i + s)
}
__device__ __forceinline__ float gelu_tanh(float x) {
    const float u = 0.7978845608028654f * (x + 0.044715f * x * x * x);
    const float th = 1.0f - 2.0f * __builtin_amdgcn_rcpf(__expf(2.0f * u) + 1.0f);
    return 0.5f * x * (1.0f + th);
}
constexpr int NTILE32 = NTOK / 32;
constexpr int CW_QU = 8192, CW_QV = 8192 + 512;

constexpr int TK_STRIDE = 68, TK_BYTES = 64 * TK_STRIDE * 4;
__device__ __forceinline__ void topk_scores64(const bf16* Q, const bf16* KB, LAS float* SC, int t0, int hp, int p, int half, int lane, const bf16x8 (&af)[2][2][4]) {
    const int fr = lane & 15, fq = lane >> 4;
#pragma unroll
    for (int hs = 0; hs < 2; ++hs) {
        const bf16* kbase = KB + (size_t)(((hp + 4 * hs) * 2 + p) * 128 + half * 64 + fr) * 128 + fq * 8;
#pragma unroll
        for (int n = 0; n < 4; ++n) {
            bf16x8 bfr[4];
#pragma unroll
            for (int ks = 0; ks < 4; ++ks) bfr[ks] = *(const bf16x8*)(kbase + (size_t)n * 16 * 128 + ks * 32);
            f32x4 acc0 = (f32x4){0.f, 0.f, 0.f, 0.f}, acc1 = acc0;
#pragma unroll
            for (int ks = 0; ks < 4; ++ks) { acc0 = __builtin_amdgcn_mfma_f32_16x16x32_bf16(af[hs][0][ks], bfr[ks], acc0, 0, 0, 0); acc1 = __builtin_amdgcn_mfma_f32_16x16x32_bf16(af[hs][1][ks], bfr[ks], acc1, 0, 0, 0); }
#pragma unroll
            for (int rg = 0; rg < 4; ++rg) { SC[(hs * 32 + fq * 4 + rg) * TK_STRIDE + n * 16 + fr] = acc0[rg]; SC[(hs * 32 + 16 + fq * 4 + rg) * TK_STRIDE + n * 16 + fr] = acc1[rg]; }
        }
    }
}
constexpr int TK_NPROMPT_UNITS = (NPROMPT / 32) * 4, TK_NSAMPLE_UNITS = (NSAMP / 32) * 4, CW_TKS = 9792;
__device__ __forceinline__ void peer_topk_units(const Args& A, LAS unsigned char* lds, int lane, int wave, int u_first, int u_end, int u_step) {
    const bf16* Q = (const bf16*)(A.ws + WS_ZG); const bf16* KB = (const bf16*)(A.ws + WS_KEYS); const float* SSP = (const float*)(A.ws + WS_SSP);
    unsigned short* EIDX = (unsigned short*)(A.ws + WS_EIDX); float* GATE = (float*)(A.ws + WS_GATE); float* RSTD = (float*)(A.ws + WS_RSTD);
    LAS float* SC = (LAS float*)(lds + wave * TK_BYTES);
    const int fr = lane & 15, fq = lane >> 4, tokl = lane & 31, hsel = lane >> 5;
    for (int u = u_first; u < u_end; u += u_step) {
        const int t0 = (u >> 2) * 32, hp = u & 3, h = hp + 4 * hsel;
        const float* sp = SSP + (size_t)(t0 + tokl) * 16;
        const f32x4 s0 = *(const f32x4*)sp, s1 = *(const f32x4*)(sp + 4), s2 = *(const f32x4*)(sp + 8), s3 = *(const f32x4*)(sp + 12);
        const float ssq = ((s0[0] + s0[1]) + (s0[2] + s0[3])) + ((s1[0] + s1[1]) + (s1[2] + s1[3])) + ((s2[0] + s2[1]) + (s2[2] + s2[3])) + ((s3[0] + s3[1]) + (s3[2] + s3[3]));
        const float rstd = __builtin_amdgcn_rsqf(ssq * (1.f / DM) + 1e-6f);
        float tv0[16], tv1[16], cv[16];
#pragma unroll
        for (int p = 0; p < 2; ++p) {
            bf16x8 af[2][2][4];
#pragma unroll
            for (int hs = 0; hs < 2; ++hs)
#pragma unroll
                for (int mt = 0; mt < 2; ++mt) { const bf16* qp = Q + (size_t)(t0 + mt * 16 + fr) * 2048 + (hp + 4 * hs) * 256 + p * 128 + fq * 8;
#pragma unroll
                    for (int ks = 0; ks < 4; ++ks) af[hs][mt][ks] = *(const bf16x8*)(qp + ks * 32); }
            float tv[16];
#pragma unroll
            for (int i = 0; i < 16; ++i) tv[i] = -3.0e38f;
            for (int half = 0; half < 2; ++half) {
                topk_scores64(Q, KB, SC, t0, hp, p, half, lane, af);
                LDS_WAIT();
                const LAS float* mine = SC + lane * TK_STRIDE;
                unsigned kmask = 0xFFFFFF80u; asm volatile("" : "+v"(kmask));
#pragma unroll 1
                for (int n = 0; n < 64; n += 16) {
                    float g[16];
#pragma unroll
                    for (int q = 0; q < 4; ++q) { const f32x4 x4 = *(const LAS f32x4*)(mine + n + 4 * q);
#pragma unroll
                        for (int e = 0; e < 4; ++e) g[4 * q + e] = __uint_as_float((__float_as_uint(x4[e]) & kmask) | (unsigned)(half * 64 + n + 4 * q + e)); }
                    tk_sort16(g); tk_merge16(tv, g);
                }
                LDS_WAIT();
            }
#pragma unroll
            for (int i = 0; i < 16; ++i) { if (p == 0) tv0[i] = tv[i]; else tv1[i] = tv[i]; }
        }
        LAS int* li = (LAS int*)SC + lane * 33;
#pragma unroll
        for (int q = 0; q < 16; ++q) { li[q] = (int)(__float_as_uint(tv0[q]) & 127u); li[16 + q] = (int)(__float_as_uint(tv1[q]) & 127u);
            tv0[q] = __uint_as_float(__float_as_uint(tv0[q]) & 0xFFFFFF80u); tv1[q] = __uint_as_float(__float_as_uint(tv1[q]) & 0xFFFFFF80u); }
#pragma unroll
        for (int q = 0; q < 16; ++q) cv[q] = -3.0e38f;
#pragma unroll
        for (int a = 0; a < 16; ++a)
#pragma unroll
            for (int b = 0; b < 16; ++b) if ((a + 1) * (b + 1) <= 16)
                tk_insert(cv, __uint_as_float((__float_as_uint(tv0[a] + tv1[b]) & 0xFFFFFF00u) | (unsigned)(a * 16 + b)));
        LDS_WAIT();
        float e[16], den = 0.f; unsigned ci[16];
        const float c0 = __uint_as_float(__float_as_uint(cv[0]) & 0xFFFFFF00u);
#pragma unroll
        for (int q = 0; q < 16; ++q) { const unsigned kb = __float_as_uint(cv[q]); const float cq = __uint_as_float(kb & 0xFFFFFF00u);
            e[q] = __expf((cq - c0) * rstd); den += e[q]; ci[q] = (unsigned)(li[(kb >> 4) & 15] * 128 + li[16 + (kb & 15)]); }
        const float inv = __builtin_amdgcn_rcpf(den);
        LDS_WAIT();
        {
            const size_t tok = (size_t)(t0 + tokl);
            v4u w0, w1; w0.x = ci[0] | (ci[1] << 16); w0.y = ci[2] | (ci[3] << 16); w0.z = ci[4] | (ci[5] << 16); w0.w = ci[6] | (ci[7] << 16);
            w1.x = ci[8] | (ci[9] << 16); w1.y = ci[10] | (ci[11] << 16); w1.z = ci[12] | (ci[13] << 16); w1.w = ci[14] | (ci[15] << 16);
            *(v4u*)(EIDX + tok * 128 + h * 16) = w0; *(v4u*)(EIDX + tok * 128 + h * 16 + 8) = w1;
#pragma unroll
            for (int q = 0; q < 4; ++q) *(f32x4*)(GATE + tok * 128 + h * 16 + 4 * q) = (f32x4){e[4 * q] * inv, e[4 * q + 1] * inv, e[4 * q + 2] * inv, e[4 * q + 3] * inv};
            if (h == 0) RSTD[tok] = rstd;
        }
    }
}

__device__ __forceinline__ bool peer_topk_split(int G) { return G == 256; }
__device__ __forceinline__ void peer_topk_phase(const Args& A, LAS unsigned char* lds, int tid, int lane, int wave, int vcu, int G) {
    peer_topk_units(A, lds, lane, wave, wave * G + vcu, peer_topk_split(G) ? TK_NPROMPT_UNITS : TK_NPROMPT_UNITS + TK_NSAMPLE_UNITS, G * NWAVES);
}
__device__ __forceinline__ void peer_topk_sample_prelude(const Args& A, LAS unsigned char* lds, int tid, int lane, int wave, int vcu, int G, gu32* ctl) {
    if (!peer_topk_split(G) || (vcu & 31) != 0) return;
    peer_topk_units(A, lds, lane, wave, TK_NPROMPT_UNITS + (vcu >> 5) * NWAVES + wave, TK_NPROMPT_UNITS + TK_NSAMPLE_UNITS, TK_NSAMPLE_UNITS);
    asm volatile("s_waitcnt vmcnt(0)" ::: "memory");
    __syncthreads();
    if (tid == 0) { __builtin_amdgcn_fence(__ATOMIC_RELEASE, "agent"); asm volatile("s_waitcnt vmcnt(0)" ::: "memory"); (void)__hip_atomic_fetch_add((unsigned*)(ctl + CW_TKS), 1u, RLX_AGENT); }
    __syncthreads();
}
__device__ __forceinline__ void peer_topk_sample_wait(gu32* ctl, int tid) {
    if (tid == 0) {
        unsigned sp = 0;
        while (__hip_atomic_load((unsigned*)(ctl + CW_TKS), RLX_AGENT) < (unsigned)(TK_NSAMPLE_UNITS / NWAVES)) { __builtin_amdgcn_s_sleep(2); if (++sp > (1u << 22)) break; }
        __builtin_amdgcn_fence(__ATOMIC_ACQUIRE, "agent");
        asm volatile("s_waitcnt vmcnt(0)" ::: "memory");
    }
    __syncthreads();
}

constexpr int PEER_ITEM = 80, NITEM128 = NTOK / PEER_ITEM;
__device__ __forceinline__ bool peer_next_item(gu32* qbase, int xcc, int& qs, int& slice, int& item, LAS unsigned char* lds, int tid) {
    LAS int* box = (LAS int*)(lds + LDSCTL_OFF + 64);
    for (;;) {
        if (qs >= 8) return false;
        slice = (xcc + qs) & 7;
        if (tid == 0) box[0] = (int)__hip_atomic_fetch_add((unsigned*)(qbase + 64 * slice), 1u, RLX_AGENT);
        __syncthreads();
        item = box[0];
        __syncthreads();
        if (item < NITEM128) return true;
        ++qs;
    }
}

typedef long i64_t;
constexpr float PEER_SX = 1.0f;
constexpr int U_TILE0 = 8192, U_TILEB = 16384;
__device__ __forceinline__ i64_t mk64(unsigned lo, unsigned hi) { return (i64_t)(((unsigned long long)hi << 32) | (unsigned long long)lo); }
__device__ __forceinline__ void peer_u_phase(const Args& A, LAS unsigned char* lds, int tid, int lane, int wave, gu32* ctl, int qoff) {
    const unsigned char* Uq = A.ws + WS_UB; const bf16* XG = (const bf16*)(A.ws + WS_A1);
    const unsigned short* EIDX = (const unsigned short*)(A.ws + WS_EIDX); bf16* PART = (bf16*)(A.ws + WS_PART);
    const int xcc = (int)(xb_xcc_id() & 7u), rg = lane >> 3, c8 = lane & 7, m = lane & 15, kq = lane >> 4;
    LAS int* we = (LAS int*)(lds + wave * 1024);
    LAS unsigned char* tile = lds + U_TILE0 + wave * U_TILEB;
    const int ch_e = ((c8 - (rg >> 1)) & 7) * 16, ch_o = ((c8 - 4 - (rg >> 1)) & 7) * 16;
    const int fbase = m * 128 + (kq & 1) * 8, pos0 = (kq >> 1) + (m >> 1);
    int foff[4];
#pragma unroll
    for (int ks = 0; ks < 4; ++ks) foff[ks] = fbase + ((pos0 + 2 * ks) & 7) * 16;
    int qs = 0, slice, item; bool lists_ready = !peer_topk_split((int)gridDim.x);
    while (peer_next_item(ctl + CW_QU + qoff, xcc, qs, slice, item, lds, tid)) {
        if (!lists_ready && (item + 1) * PEER_ITEM > NPROMPT) { peer_topk_sample_wait(ctl, tid); lists_ready = true; }
        const unsigned char* us = Uq + (size_t)slice * 16384 * 128;
        size_t tok = (size_t)(item * PEER_ITEM + wave);
        unsigned pair = *(const unsigned*)(EIDX + tok * 128 + 2 * lane);
        v4u xr[4];
#pragma unroll
        for (int ks = 0; ks < 4; ++ks) xr[ks] = *(const v4u*)(XG + tok * DM + slice * 128 + ks * 32 + kq * 8);
        we[2 * lane] = (int)(pair & 0xffffu); we[2 * lane + 1] = (int)(pair >> 16);
        LDS_WAIT();
        v4u w[16];
#pragma unroll
        for (int it = 0; it < 16; ++it) w[it] = *(const v4u*)(us + (unsigned)(((unsigned)we[it * 8 + rg] << 7) + (unsigned)((it & 1) ? ch_o : ch_e)));
        for (int tt = 0; tt < PEER_ITEM / NWAVES; ++tt) {
            const size_t ctok = tok; const bool more = tt + 1 < PEER_ITEM / NWAVES;
            i64_t bx[4];
#pragma unroll
            for (int ks = 0; ks < 4; ++ks) { const v4u q = xr[ks]; typedef short s16x2 __attribute__((ext_vector_type(2)));
                s16x2 lo = (s16x2){0, 0}, hi = lo;
                unsigned q0 = q.x, q1 = q.y, q2 = q.z, q3 = q.w; asm volatile("" : "+v"(q0), "+v"(q1), "+v"(q2), "+v"(q3));
                lo = __builtin_amdgcn_cvt_scalef32_pk_fp8_bf16(lo, __builtin_bit_cast(bf16x2_t, q0), PEER_SX, false); lo = __builtin_amdgcn_cvt_scalef32_pk_fp8_bf16(lo, __builtin_bit_cast(bf16x2_t, q1), PEER_SX, true);
                hi = __builtin_amdgcn_cvt_scalef32_pk_fp8_bf16(hi, __builtin_bit_cast(bf16x2_t, q2), PEER_SX, false); hi = __builtin_amdgcn_cvt_scalef32_pk_fp8_bf16(hi, __builtin_bit_cast(bf16x2_t, q3), PEER_SX, true);
                bx[ks] = mk64(__builtin_bit_cast(unsigned, lo), __builtin_bit_cast(unsigned, hi)); }
            if (more) { tok += NWAVES; pair = *(const unsigned*)(EIDX + tok * 128 + 2 * lane);
#pragma unroll
                for (int ks = 0; ks < 4; ++ks) xr[ks] = *(const v4u*)(XG + tok * DM + slice * 128 + ks * 32 + kq * 8); }
#pragma unroll
            for (int it = 0; it < 16; ++it) *(LAS v4u*)(tile + it * 1024 + lane * 16) = w[it];
            if (more) {
                we[2 * lane] = (int)(pair & 0xffffu); we[2 * lane + 1] = (int)(pair >> 16);
                LDS_WAIT();
#pragma unroll
                for (int it = 0; it < 16; ++it) w[it] = *(const v4u*)(us + (unsigned)(((unsigned)we[it * 8 + rg] << 7) + (unsigned)((it & 1) ? ch_o : ch_e)));
            } else LDS_WAIT();
            bf16* pp = PART + (ctok * 8 + slice) * 128;
            f32x4 acc[8];
#pragma unroll
            for (int hf = 0; hf < 2; ++hf) {
                v2u a[4][4];
#pragma unroll
                for (int T4 = 0; T4 < 4; ++T4)
#pragma unroll
                    for (int ks = 0; ks < 4; ++ks) a[T4][ks] = *(const LAS v2u*)(tile + (hf * 4 + T4) * 2048 + foff[ks]);
#pragma unroll
                for (int T4 = 0; T4 < 4; ++T4) acc[hf * 4 + T4] = (f32x4){0.f, 0.f, 0.f, 0.f};
#pragma unroll
                for (int ks = 0; ks < 4; ++ks)
#pragma unroll
                    for (int T4 = 0; T4 < 4; ++T4) acc[hf * 4 + T4] = __builtin_amdgcn_mfma_f32_16x16x32_fp8_fp8(mk64(a[T4][ks].x, a[T4][ks].y), bx[ks], acc[hf * 4 + T4], 0, 0, 0);
            }
            f32x4 val = acc[0];
#pragma unroll
            for (int T = 1; T < 8; ++T) val = ((m & 7) == T) ? acc[T] : val;
            if (m < 8) { v2u pw; pw.x = cvt_pk_bf16(val[0] * (1.0f / PEER_SX), val[1] * (1.0f / PEER_SX)); pw.y = cvt_pk_bf16(val[2] * (1.0f / PEER_SX), val[3] * (1.0f / PEER_SX)); *(v2u*)(pp + m * 16 + 4 * kq) = pw; }
            LDS_WAIT();
        }
    }
}

constexpr float PEER_CS = 64.0f;
__device__ __forceinline__ void peer_coef_phase(const Args& A, int lane, int wave, int vcu, int G) {
    const bf16* PART = (const bf16*)(A.ws + WS_PART); const float* GATE = (const float*)(A.ws + WS_GATE); const float* RSTD = (const float*)(A.ws + WS_RSTD);
    unsigned char* C8 = A.ws + WS_COEF;
    for (int tok = vcu * NWAVES + wave; tok < NTOK; tok += G * NWAVES) {
        const bf16* pp = PART + (size_t)tok * 1024 + 2 * lane;
        unsigned pw[8];
#pragma unroll
        for (int j = 0; j < 8; ++j) pw[j] = *(const unsigned*)(pp + j * 128);
        f32x2 d = (f32x2){bf_lo(pw[0]), bf_hi(pw[0])};
#pragma unroll
        for (int j = 1; j < 8; ++j) d += (f32x2){bf_lo(pw[j]), bf_hi(pw[j])};
        const float sc = RSTD[tok] * (1.0f / PEER_SU); const f32x2 gt = *(const f32x2*)(GATE + (size_t)tok * 128 + 2 * lane);
        f32x2 cf; cf.x = gt.x * gelu_tanh(d.x * sc) * (PEER_CS / PEER_SV); cf.y = gt.y * gelu_tanh(d.y * sc) * (PEER_CS / PEER_SV);
        const unsigned hi = (unsigned)__builtin_amdgcn_cvt_pk_fp8_f32(cf.x, cf.y, 0, false) & 0xffffu;
        const f32x2 bk = __builtin_amdgcn_cvt_pk_f32_fp8(hi, false);
        const unsigned lo = (unsigned)__builtin_amdgcn_cvt_pk_fp8_f32((cf.x - bk.x) * 16.0f, (cf.y - bk.y) * 16.0f, 0, false) & 0xffffu;
        *(unsigned short*)(C8 + (size_t)tok * 256 + 2 * lane) = (unsigned short)hi; *(unsigned short*)(C8 + (size_t)tok * 256 + 128 + 2 * lane) = (unsigned short)lo;
    }
}

typedef int v2i_t __attribute__((ext_vector_type(2)));
__device__ __forceinline__ void peer_v_phase(const Args& A, LAS unsigned char* lds, int tid, int lane, int wave, gu32* ctl) {
    const unsigned char* Vq = A.ws + WS_VB;
    const unsigned short* EIDX = (const unsigned short*)(A.ws + WS_EIDX); const unsigned char* C8 = A.ws + WS_COEF;
    float* X1 = A.out + O_Y; float* SS2 = (float*)(A.ws + WS_SS2); const bf16* XGv = (const bf16*)(A.ws + WS_A1);
    const int xcc = (int)(xb_xcc_id() & 7u), rg = lane >> 3, c8 = lane & 7, m = lane & 15, kq = lane >> 4;
    LAS int* we = (LAS int*)(lds + wave * 1024);
    LAS unsigned char* tile = lds + U_TILE0 + wave * U_TILEB;
    const int ch_e = ((c8 - (rg >> 1)) & 7) * 16, ch_o = ((c8 - 4 - (rg >> 1)) & 7) * 16;
    const int tr_r = (lane & 15) >> 1, tr_p = lane & 1, tr_rot = 4 * (kq & 1) + (tr_r >> 1);
    const int tbase = (8 * kq + tr_r) * 128 + 8 * tr_p;
    int toff[8];
#pragma unroll
    for (int j = 0; j < 8; ++j) toff[j] = tbase + ((j + tr_rot) & 7) * 16;
    int qs = 0, slice, item;
    while (peer_next_item(ctl + CW_QV, xcc, qs, slice, item, lds, tid)) {
        const unsigned char* vs = Vq + (size_t)slice * 16384 * 128;
        size_t tok = (size_t)(item * PEER_ITEM + wave);
        unsigned pair = *(const unsigned*)(EIDX + tok * 128 + 2 * lane);
        v2u cfr[4];
#pragma unroll
        for (int ks = 0; ks < 4; ++ks) cfr[ks] = *(const v2u*)(C8 + tok * 256 + (m & 1) * 128 + ks * 32 + kq * 8);
        const float rga = 1.0f / A.in[I_N2G][slice * 128 + lane], rgb = 1.0f / A.in[I_N2G][slice * 128 + 64 + lane];
        unsigned short xoa = XGv[tok * DM + slice * 128 + lane], xob = XGv[tok * DM + slice * 128 + 64 + lane];
        we[2 * lane] = (int)(pair & 0xffffu); we[2 * lane + 1] = (int)(pair >> 16);
        LDS_WAIT();
        v4u w[16];
#pragma unroll
        for (int it = 0; it < 16; ++it) w[it] = *(const v4u*)(vs + (unsigned)(((unsigned)we[it * 8 + rg] << 7) + (unsigned)((it & 1) ? ch_o : ch_e)));
        for (int tt = 0; tt < PEER_ITEM / NWAVES; ++tt) {
            const size_t ctok = tok; const bool more = tt + 1 < PEER_ITEM / NWAVES;
            i64_t af[4];
#pragma unroll
            for (int ks = 0; ks < 4; ++ks) af[ks] = mk64(cfr[ks].x, cfr[ks].y);
            const float xa = __uint_as_float((unsigned)xoa << 16) * rga, xb = __uint_as_float((unsigned)xob << 16) * rgb;
            if (more) { tok += NWAVES; pair = *(const unsigned*)(EIDX + tok * 128 + 2 * lane);
#pragma unroll
                for (int ks = 0; ks < 4; ++ks) cfr[ks] = *(const v2u*)(C8 + tok * 256 + (m & 1) * 128 + ks * 32 + kq * 8);
                xoa = XGv[tok * DM + slice * 128 + lane]; xob = XGv[tok * DM + slice * 128 + 64 + lane]; }
#pragma unroll
            for (int it = 0; it < 16; ++it) *(LAS v4u*)(tile + it * 1024 + lane * 16) = w[it];
            if (more) {
                we[2 * lane] = (int)(pair & 0xffffu); we[2 * lane + 1] = (int)(pair >> 16);
                LDS_WAIT();
#pragma unroll
                for (int it = 0; it < 16; ++it) w[it] = *(const v4u*)(vs + (unsigned)(((unsigned)we[it * 8 + rg] << 7) + (unsigned)((it & 1) ? ch_o : ch_e)));
            } else LDS_WAIT();
            f32x4 acc[8];
#pragma unroll
            for (int hf = 0; hf < 2; ++hf) {
                v2i_t b[4][4];
#pragma unroll
                for (int j4 = 0; j4 < 4; ++j4)
#pragma unroll
                    for (int ks = 0; ks < 4; ++ks) b[j4][ks] = __builtin_amdgcn_ds_read_tr8_b64_v2i32((LAS v2i_t*)(tile + ks * 4096 + toff[hf * 4 + j4]));
#pragma unroll
                for (int j4 = 0; j4 < 4; ++j4) acc[hf * 4 + j4] = (f32x4){0.f, 0.f, 0.f, 0.f};
#pragma unroll
                for (int ks = 0; ks < 4; ++ks)
#pragma unroll
                    for (int j4 = 0; j4 < 4; ++j4) acc[hf * 4 + j4] = __builtin_amdgcn_mfma_f32_16x16x32_fp8_fp8(af[ks], mk64((unsigned)b[j4][ks].x, (unsigned)b[j4][ks].y), acc[hf * 4 + j4], 0, 0, 0);
            }
            float h0 = acc[0][0], l0 = acc[0][1], h1 = acc[4][0], l1 = acc[4][1];
#pragma unroll
            for (int j = 1; j < 4; ++j) { const bool s = kq == j; h0 = s ? acc[j][0] : h0; l0 = s ? acc[j][1] : l0; h1 = s ? acc[4 + j][0] : h1; l1 = s ? acc[4 + j][1] : l1; }
            const float x2a = xa + (h0 + l0 * (1.0f / 16.0f)) * (1.0f / PEER_CS), x2b = xb + (h1 + l1 * (1.0f / 16.0f)) * (1.0f / PEER_CS);
            { bf16* xr_ = (bf16*)X1 + ctok * (2 * DM) + slice * 128 + lane;
              xr_[0] = (bf16)(cvt_pk_bf16(x2a, x2a) & 0xffffu); xr_[64] = (bf16)(cvt_pk_bf16(x2b, x2b) & 0xffffu); }
            float ss = sum16(x2a * x2a + x2b * x2b); ss += __shfl_xor(ss, 16); ss += __shfl_xor(ss, 32);
            if (lane == 0) SS2[ctok * 8 + slice] = ss;
            LDS_WAIT();
        }
    }
}

__device__ __forceinline__ void peer_final_phase(const Args& A, int lane, int wave, int vcu, int G) {
    float* X1 = A.out + O_Y; const float* SS2 = (const float*)(A.ws + WS_SS2); const float* gf = A.in[I_NFG] + lane * 16;
    const f32x4 g0 = *(const f32x4*)gf, g1 = *(const f32x4*)(gf + 4), g2 = *(const f32x4*)(gf + 8), g3 = *(const f32x4*)(gf + 12);
    for (int tok = vcu * NWAVES + wave; tok < NTOK; tok += G * NWAVES) {
        const f32x4 sa = *(const f32x4*)(SS2 + (size_t)tok * 8), sb = *(const f32x4*)(SS2 + (size_t)tok * 8 + 4);
        const float ss = ((sa[0] + sa[1]) + (sa[2] + sa[3])) + ((sb[0] + sb[1]) + (sb[2] + sb[3]));
        const float rf = __builtin_amdgcn_rsqf(ss * (1.f / DM) + 1e-6f);
        float* yr = X1 + (size_t)tok * DM + lane * 16;
        const v4u s0 = *(const v4u*)((const bf16*)(X1 + (size_t)tok * DM) + lane * 16), s1 = *(const v4u*)((const bf16*)(X1 + (size_t)tok * DM) + lane * 16 + 8);
        const f32x4 y0 = (f32x4){bf_lo(s0.x), bf_hi(s0.x), bf_lo(s0.y), bf_hi(s0.y)}, y1 = (f32x4){bf_lo(s0.z), bf_hi(s0.z), bf_lo(s0.w), bf_hi(s0.w)},
                    y2 = (f32x4){bf_lo(s1.x), bf_hi(s1.x), bf_lo(s1.y), bf_hi(s1.y)}, y3 = (f32x4){bf_lo(s1.z), bf_hi(s1.z), bf_lo(s1.w), bf_hi(s1.w)};
        *(f32x4*)yr = y0 * rf * g0; *(f32x4*)(yr + 4) = y1 * rf * g1; *(f32x4*)(yr + 8) = y2 * rf * g2; *(f32x4*)(yr + 12) = y3 * rf * g3;
    }
}

__device__ __forceinline__ void sg_partial(const bf16* Ap, int lda, const bf16* Bp, int ldb, LAS f32x4* red, int lane, int wave) {
    const int fr = lane & 15, fq = lane >> 4;
    bf16x8 a[2][4], b[4][4];
#pragma unroll
    for (int mi = 0; mi < 2; ++mi)
#pragma unroll
        for (int ks = 0; ks < 4; ++ks) a[mi][ks] = *(const bf16x8*)(Ap + (size_t)(16 * mi + fr) * lda + 32 * ks + 8 * fq);
#pragma unroll
    for (int nj = 0; nj < 4; ++nj)
#pragma unroll
        for (int ks = 0; ks < 4; ++ks) b[nj][ks] = *(const bf16x8*)(Bp + (size_t)(16 * nj + fr) * ldb + 32 * ks + 8 * fq);
    f32x4 acc[2][4];
#pragma unroll
    for (int mi = 0; mi < 2; ++mi)
#pragma unroll
        for (int nj = 0; nj < 4; ++nj) acc[mi][nj] = (f32x4){0.f, 0.f, 0.f, 0.f};
#pragma unroll
    for (int ks = 0; ks < 4; ++ks)
#pragma unroll
        for (int mi = 0; mi < 2; ++mi)
#pragma unroll
            for (int nj = 0; nj < 4; ++nj) acc[mi][nj] = __builtin_amdgcn_mfma_f32_16x16x32_bf16(b[nj][ks], a[mi][ks], acc[mi][nj], 0, 0, 0);
#pragma unroll
    for (int mi = 0; mi < 2; ++mi)
#pragma unroll
        for (int nj = 0; nj < 4; ++nj) red[(wave * 8 + mi * 4 + nj) * 64 + lane] = acc[mi][nj];
}
__device__ __forceinline__ f32x4 sg_sum(const LAS f32x4* red, int w0, int nw, int wave, int lane) {
    f32x4 s = red[(w0 * 8 + wave) * 64 + lane];
    for (int w = 1; w < nw; ++w) s += red[((w0 + w) * 8 + wave) * 64 + lane];
    return s;
}
__device__ __forceinline__ void sample_gemm2(const Args& A, LAS unsigned char* lds, int t, int lane, int wave) {
    unsigned char* ws = A.ws; const int fr = lane & 15, fq = lane >> 4;
    const int row0 = NPROMPT + (t >> 4) * 32, col0 = (t & 15) * 64;
    LAS f32x4* red = (LAS f32x4*)lds;
    const bf16* Ab = (const bf16*)(ws + WS_A1) + (wave >= 4 ? (size_t)MPAD * 512 : 0); const bf16* Bb = (const bf16*)(ws + (wave >= 4 ? WS_WPB : WS_WPA));
    sg_partial(Ab + (size_t)row0 * 512 + (wave & 3) * 128, 512, Bb + (size_t)col0 * 512 + (wave & 3) * 128, 512, red, lane, wave);
    const int row = row0 + 16 * (wave >> 2) + fr, c = col0 + 16 * (wave & 3) + 4 * fq;
    const bf16* Zg = (const bf16*)(ws + WS_ZG) + (size_t)row * 2048;
    const v2u ga = *(const v2u*)(Zg + c), gb = *(const v2u*)(Zg + 1024 + c);
    __syncthreads();
    const f32x4 pa = sg_sum(red, 0, 4, wave, lane), pb = sg_sum(red, 4, 4, wave, lane);
    const float o0 = sigm(bf_lo(ga.x)) * pa[0] + sigm(bf_lo(gb.x)) * pb[0], o1 = sigm(bf_hi(ga.x)) * pa[1] + sigm(bf_hi(gb.x)) * pb[1],
                o2 = sigm(bf_lo(ga.y)) * pa[2] + sigm(bf_lo(gb.y)) * pb[2], o3 = sigm(bf_hi(ga.y)) * pa[3] + sigm(bf_hi(gb.y)) * pb[3];
    v2u w; w.x = cvt_pk_bf16(o0, o1); w.y = cvt_pk_bf16(o2, o3); *(v2u*)((bf16*)(ws + WS_ZR) + (size_t)row * 1024 + c) = w;
    __syncthreads();
}
__device__ __forceinline__ void sample_gemm3(const Args& A, LAS unsigned char* lds, int t, int tid, int lane, int wave) {
    unsigned char* ws = A.ws; const int fr = lane & 15, fq = lane >> 4;
    const int row0 = NPROMPT + (t >> 4) * 32, col0 = (t & 15) * 64;
    LAS f32x4* red = (LAS f32x4*)lds; LAS float* ssl = (LAS float*)(lds + 65536);
    sg_partial((const bf16*)(ws + WS_ZR) + (size_t)row0 * 1024 + wave * 128, 1024, (const bf16*)(ws + WS_WO) + (size_t)col0 * 1024 + wave * 128, 1024, red, lane, wave);
    const int row = row0 + 16 * (wave >> 2) + fr, c = col0 + 16 * (wave & 3) + 4 * fq;
    const f32x4 xv = *(const f32x4*)(A.in[I_XS] + (size_t)(row - NPROMPT) * 1024 + c), q = *(const f32x4*)(A.in[I_N2G] + c);
    __syncthreads();
    const f32x4 o = xv + sg_sum(red, 0, 8, wave, lane);
    float ss = (o[0] * o[0] + o[1] * o[1]) + (o[2] * o[2] + o[3] * o[3]);
    v2u w; w.x = cvt_pk_bf16(o[0] * q[0], o[1] * q[1]); w.y = cvt_pk_bf16(o[2] * q[2], o[3] * q[3]); *(v2u*)((bf16*)(ws + WS_A1) + (size_t)row * 1024 + c) = w;
    ss += __shfl_xor(ss, 16); ss += __shfl_xor(ss, 32);
    if (fq == 0) ssl[wave * 16 + fr] = ss;
    __syncthreads();
    if (tid < 32) { const int mi = tid >> 4, r = tid & 15;
        ((float*)(ws + WS_SSP))[(size_t)(row0 + tid) * 16 + (t & 15)] = (ssl[(mi * 4 + 0) * 16 + r] + ssl[(mi * 4 + 1) * 16 + r]) + (ssl[(mi * 4 + 2) * 16 + r] + ssl[(mi * 4 + 3) * 16 + r]); }
}
__device__ __forceinline__ void sample_gemm4(const Args& A, LAS unsigned char* lds, int t, int lane, int wave) {
    unsigned char* ws = A.ws; const int fr = lane & 15, fq = lane >> 4;
    const int row0 = NPROMPT + (t >> 5) * 32, col0 = (t & 31) * 64;
    LAS f32x4* red = (LAS f32x4*)lds;
    sg_partial((const bf16*)(ws + WS_A1) + (size_t)row0 * 1024 + wave * 128, 1024, (const bf16*)(ws + WS_WQ) + (size_t)col0 * 1024 + wave * 128, 1024, red, lane, wave);
    const int row = row0 + 16 * (wave >> 2) + fr, c = col0 + 16 * (wave & 3) + 4 * fq;
    __syncthreads();
    const f32x4 o = sg_sum(red, 0, 8, wave, lane);
    v2u w; w.x = cvt_pk_bf16(o[0], o[1]); w.y = cvt_pk_bf16(o[2], o[3]); *(v2u*)((bf16*)(ws + WS_ZG) + (size_t)row * 2048 + c) = w;
    __syncthreads();
}

__global__ void __launch_bounds__(NTHR, 2) mk_fwd(Args args) {
    extern __shared__ __attribute__((aligned(16))) unsigned char lds_raw[];
    LAS unsigned char* lds = (LAS unsigned char*)lds_raw;
    const int tid = threadIdx.x, lane = tid & 63, wave = __builtin_amdgcn_readfirstlane(tid >> 6);
    const int G = gridDim.x; const int bx = blockIdx.x; const int vcu = (G % 8 == 0) ? (bx % 8) * (G / 8) + bx / 8 : bx;
    gu32* ctl = (gu32*)(args.ws + WS_CTL);
    volatile LAS unsigned* MISC = (volatile LAS unsigned*)(lds + MISC_OFF);
    for (int u = tid; u < (LDS_BYTES - LDSCTL_OFF) / 4; u += NTHR) ((LAS unsigned*)(lds + LDSCTL_OFF))[u] = 0u;
    __syncthreads();
    XcdBarrier bar; bar.bar = (unsigned*)(ctl + CW_BAR) + args.li * XCD_BAR_WORDS; bar.x = 0; bar.st = nullptr;
    if (N_LAUNCHES != PER_PHASE) bar = xcd_barrier_post((unsigned*)(ctl + CW_BAR) + args.li * XCD_BAR_WORDS, MISC + 8);
    const int lo = args.ph_lo, hi = args.ph_hi;
#define IN(k) (lo <= (k) && (k) < hi)
#define BOTH(k) (IN(k) && IN((k) + 1))
#define GRID_BAR() do { if (N_LAUNCHES != PER_PHASE) xcd_barrier(bar); } while (0)
    unsigned char* ws = args.ws;
    bf16* A1 = (bf16*)(ws + WS_A1);

    if (IN(0)) for (int rep_ = 0; rep_ < ((MK_REPEAT == 0) ? 2 : 1); ++rep_) { p0_prologue(args, lds, tid, lane, wave, vcu, G); if (BOTH(0)) GRID_BAR(); }

    if (IN(1)) for (int rep_ = 0; rep_ < ((MK_REPEAT == 1) ? 2 : 1); ++rep_) {
        pg8::Gemm g{A1, (const bf16*)(ws + WS_W1T), MPAD, N1, DM}; pg8::StaticOrder S; S.init(MPAD, N1, G, bx);
        pg8::EpiZ E{(bf16*)(ws + WS_ZC), (bf16*)(ws + WS_ZR), (bf16*)(ws + WS_ZG)};
        pg8::gemm_phase<pg8::EpiZ, pg8::StaticOrder, true, true>(lds, g, S, E);
        if (BOTH(1)) GRID_BAR();
    }

    if (IN(2)) for (int rep_ = 0; rep_ < ((MK_REPEAT == 2) ? 2 : 1); ++rep_) { conv_phase(args, vcu * NTHR + tid, G * NTHR); if (BOTH(2)) GRID_BAR(); }

    if (IN(3)) for (int rep_ = 0; rep_ < ((MK_REPEAT == 3) ? 2 : 1); ++rep_) {
        scan_pass1(args, lds, tid, lane, wave, vcu, G, (MK_REPEAT == 3 && rep_ == 0) ? 1 : 0);
        if (BOTH(3)) GRID_BAR();
    }

    if (IN(4)) {
        for (int u = vcu; u < 512; u += G) {
            if (u < 256) { const int bh = u >> 2, vq = u & 3; scan_pass2_rows(nullptr, bh * 64, 64, vq * 16, args.out + O_WKV_P + (size_t)bh * 4096, true, args, lds, tid, lane, wave); }
            else { const int bh = u - 256; scan_pass2_sample(args.in[I_SWKV] + (size_t)bh * 4096, NUNITS_P + bh, args.out + O_WKV_S + (size_t)bh * 4096, args, lane, wave); }
        }
        if (BOTH(4)) GRID_BAR();
    }

    if (IN(5)) for (int rep_ = 0; rep_ < ((MK_REPEAT == 5) ? 2 : 1); ++rep_) {
        for (int u2 = vcu; u2 < NUNITS / 2; u2 += G) scan_pass3_wave(args, u2 * 2 + (wave >> 2), wave & 3, lane);
        if (BOTH(5)) GRID_BAR();
    }

    if (IN(6)) {
        { pg8::Gemm g{A1, (const bf16*)(ws + WS_WPA), NPROMPT, DM, 512}; pg8::StaticOrder S; S.init(NPROMPT, DM, G, bx);
          pg8::EpiGate<0> E{(const bf16*)(ws + WS_ZG), (bf16*)(ws + WS_ZR)};
          pg8::gemm_phase<pg8::EpiGate<0>, pg8::StaticOrder, true, true>(lds, g, S, E); }
        { pg8::Gemm g{A1 + (size_t)MPAD * 512, (const bf16*)(ws + WS_WPB), NPROMPT, DM, 512}; pg8::StaticOrder S; S.init(NPROMPT, DM, G, bx);
          pg8::EpiGate<1> E{(const bf16*)(ws + WS_ZG), (bf16*)(ws + WS_ZR)};
          pg8::gemm_phase<pg8::EpiGate<1>, pg8::StaticOrder, true, true>(lds, g, S, E); }
        for (int t = vcu; t < 256; t += G) sample_gemm2(args, lds, t, lane, wave);
        if (BOTH(6)) GRID_BAR();
    }

    if (IN(7)) for (int rep_ = 0; rep_ < ((MK_REPEAT == 7) ? 2 : 1); ++rep_) {
        pg8::Gemm g{(const bf16*)(ws + WS_ZR), (const bf16*)(ws + WS_WO), NPROMPT, DM, DM}; pg8::StaticOrder S; S.init(NPROMPT, DM, G, bx);
        pg8::EpiX1 E{args.in[I_XP], args.in[I_XS], args.out + O_Y, A1, (float*)(ws + WS_SSP), args.in[I_N2G], NPROMPT, NTOK};
        pg8::gemm_phase<pg8::EpiX1, pg8::StaticOrder, true, true>(lds, g, S, E);
        for (int t = vcu; t < 256; t += G) sample_gemm3(args, lds, t, tid, lane, wave);
        if (BOTH(7)) GRID_BAR();
    }

    if (IN(8)) for (int rep_ = 0; rep_ < ((MK_REPEAT == 8) ? 2 : 1); ++rep_) {
        pg8::Gemm g{A1, (const bf16*)(ws + WS_WQ), NPROMPT, 2048, DM}; pg8::StaticOrder S; S.init(NPROMPT, 2048, G, bx);
        pg8::EpiPlain E{(bf16*)(ws + WS_ZG), 2048};
        pg8::gemm_phase<pg8::EpiPlain, pg8::StaticOrder, true, true>(lds, g, S, E);
        for (int t = vcu; t < 512; t += G) sample_gemm4(args, lds, t, lane, wave);
        if (BOTH(8)) GRID_BAR();
    }

    if (IN(9)) for (int rep_ = 0; rep_ < ((MK_REPEAT == 9) ? 2 : 1); ++rep_) { peer_topk_phase(args, lds, tid, lane, wave, vcu, G); if (BOTH(9)) GRID_BAR(); }
    if (IN(10)) for (int rep_ = 0; rep_ < ((MK_REPEAT == 10) ? 2 : 1); ++rep_) { if (rep_ == 0) peer_topk_sample_prelude(args, lds, tid, lane, wave, vcu, G, ctl); peer_u_phase(args, lds, tid, lane, wave, ctl, rep_ * 1024); if (BOTH(10)) GRID_BAR(); }
    if (IN(11)) { peer_coef_phase(args, lane, wave, vcu, G); if (BOTH(11)) GRID_BAR(); }
    if (IN(12)) { peer_v_phase(args, lds, tid, lane, wave, ctl); if (BOTH(12)) GRID_BAR(); }
    if (IN(13)) peer_final_phase(args, lane, wave, vcu, G);
#undef IN
#undef BOTH
#undef GRID_BAR
}

extern "C" void kernel_launch(void* const* d_in, const int* in_sizes, int n_in, void* d_out, int out_size, void* d_ws, size_t ws_size, hipStream_t stream) {
    static int grid = 0;
    if (grid == 0) {
        if (n_in != 32 || ws_size < WS_END) { fprintf(stderr, "kernel_launch: built for 32 inputs and >= %zu bytes of workspace; got n_in %d ws %zu; nothing launched\n", (size_t)WS_END, n_in, ws_size); grid = -1; return; }
        int dev = 0, cus = 0, per_cu = 0;
        if (hipGetDevice(&dev) != hipSuccess || hipDeviceGetAttribute(&cus, hipDeviceAttributeMultiprocessorCount, dev) != hipSuccess) { fprintf(stderr, "kernel_launch: device query failed\n"); grid = -1; return; }
        if (hipFuncSetAttribute((const void*)mk_fwd, hipFuncAttributeMaxDynamicSharedMemorySize, LDS_BYTES) != hipSuccess) { fprintf(stderr, "kernel_launch: hipFuncSetAttribute failed\n"); grid = -1; return; }
        if (hipOccupancyMaxActiveBlocksPerMultiprocessor(&per_cu, (const void*)mk_fwd, NTHR, LDS_BYTES) != hipSuccess || per_cu < 1)
            fprintf(stderr, "kernel_launch: note: occupancy query reports %d workgroups per CU\n", per_cu);
        (void)hipGetLastError();
        grid = cus;
    }
    if (grid < 0) return;
    if (hipMemsetAsync((char*)d_ws + WS_CTL, 0, CTL_ZERO_BYTES, stream) != hipSuccess) { fprintf(stderr, "kernel_launch: hipMemsetAsync failed\n"); return; }
    Args a{};
    for (int i = 0; i < 32; ++i) a.in[i] = (const float*)d_in[i];
    a.out = (float*)d_out; a.ws = (unsigned char*)d_ws;
    constexpr int NL = (N_LAUNCHES == PER_PHASE ? PER_PHASE : 1) + ((MK_EXTRA_LO >= 0) ? 1 : 0);
    for (int li = 0; li < NL; ++li) {
        if (N_LAUNCHES == PER_PHASE) { a.ph_lo = li; a.ph_hi = li + 1; } else { a.ph_lo = 0; a.ph_hi = PER_PHASE; }
        if (MK_EXTRA_LO >= 0 && li == NL - 1) { a.ph_lo = MK_EXTRA_LO; a.ph_hi = MK_EXTRA_HI; }
        a.li = li;
        hipLaunchKernelGGL(mk_fwd, dim3(grid), dim3(NTHR), LDS_BYTES, stream, a);
        const hipError_t le = hipPeekAtLastError();
        if (le != hipSuccess) { fprintf(stderr, "kernel_launch: launch %d failed: %s\n", li, hipGetErrorName(le)); break; }
    }
}
```

```cpp
#include <hip/hip_runtime.h>
#include <cstdio>
#include <cstdint>
#define MK_N_LAUNCHES 1
#define MK_REPEAT -1
#define MK_DBGSEL 0
#define MK_EXTRA_LO -1
#define MK_EXTRA_HI -1
namespace pg8 {
#define PG8_LAS __attribute__((address_space(3)))
typedef unsigned short bf16_t;
typedef short bf16x8 __attribute__((ext_vector_type(8)));
typedef float f32x4 __attribute__((ext_vector_type(4)));
typedef unsigned u32x4 __attribute__((ext_vector_type(4)));
constexpr int BM = 256, BK = 64, HALF = 128, HTB = HALF * BK * 2  , STAGE_BYTES = 8 * HTB, NXCD = 8, WGM = 8;

__host__ __device__ __forceinline__ int lds_byte(int r, int c) { const int st = (r >> 4) * 2 + (c >> 5), rr = r & 15, cc = c & 31, ob = rr * 64 + cc * 2; return st * 1024 + (ob ^ (((ob >> 9) & 1) << 5)); }
__host__ __device__ __forceinline__ void stage_rc(int b, int& R, int& C) { const int st = b / 1024, sb = b % 1024, swz = sb ^ (((sb >> 9) & 1) << 5); R = (st >> 1) * 16 + swz / 64; C = (st & 1) * 32 + (swz % 64) / 2; }
__host__ __device__ __forceinline__ int perm32(int rho) { const int n = rho >> 4, i = rho & 15; return 8 * (i >> 2) + 4 * n + (i & 3); }

struct Unit { int pm, pn; };
struct Gemm { const bf16_t* A; const bf16_t* Bt; int M, N, K; };

struct StaticOrder {
    int nM, nN, nwg, G, c;
    __host__ __device__ void init(int M, int N, int G_, int c_) { nM = M / BM; nN = N / BM; nwg = nM * nN; G = G_; c = c_; }
    __host__ __device__ bool next(int i, Unit& u) const {
        const long L = (long)i * G + c; if (L >= nwg) return false;
        int wgid = (int)L; { const int q = nwg / NXCD, r = nwg % NXCD, xcd = wgid % NXCD, off = wgid / NXCD; wgid = (xcd < r ? xcd * (q + 1) : r * (q + 1) + (xcd - r) * q) + off; }
        const int nig = WGM * nN, gid = wgid / nig, fm = gid * WGM, gsz = (nM - fm) < WGM ? (nM - fm) : WGM;
        u.pm = fm + ((wgid % nig) % gsz); u.pn = (wgid % nig) / gsz; return true;
    }
    __device__ __forceinline__ void a_ready(const Unit&) const {}
    __device__ __forceinline__ void done(const Unit&) const {}
};

typedef __bf16 bf16x2_cv __attribute__((ext_vector_type(2))); typedef float f32x2_cv __attribute__((ext_vector_type(2)));
__device__ __forceinline__ unsigned cvt_pk_bf16(float lo, float hi) { return __builtin_bit_cast(unsigned, __builtin_convertvector((f32x2_cv){lo, hi}, bf16x2_cv)); }
__device__ __forceinline__ float bf_lo(unsigned w) { return __uint_as_float(w << 16); }
__device__ __forceinline__ float bf_hi(unsigned w) { return __uint_as_float(w & 0xffff0000u); }
__device__ __forceinline__ float sigm(float x) { return __builtin_amdgcn_rcpf(1.0f + __expf(-x)); }

struct EpiZ {
    static constexpr bool PERM = true, AFTER_DRAIN = false;
    bf16_t *Zc, *Zr, *Zg;
    __device__ __forceinline__ void operator()(const f32x4 (&acc)[2][2][4][2], const Unit& u, int wr, int wc, int fr, int fq) const {
        typedef unsigned u32x2e __attribute__((ext_vector_type(2)));
        const int row0 = u.pm * BM + wr * 64 + fr;
        if (u.pn >= 2 && u.pn < 6) {
#pragma unroll
            for (int ai = 0; ai < 2; ++ai)
#pragma unroll
                for (int m = 0; m < 4; ++m) { bf16_t* rowp = Zc + (size_t)(row0 + ai * HALF + m * 16) * 1024 + 512 + (u.pn - 2) * 128 + wc * 16 + 4 * fq;
#pragma unroll
                    for (int bj = 0; bj < 2; ++bj) { const f32x4 v0 = acc[ai][bj][m][0], v1 = acc[ai][bj][m][1];
                        u32x2e w; w.x = cvt_pk_bf16(v0[0] * v0[1], v0[2] * v0[3]); w.y = cvt_pk_bf16(v1[0] * v1[1], v1[2] * v1[3]);
                        *(u32x2e*)(rowp + bj * 64) = w; } }
            return;
        }
        bf16_t* base; int ldc, colt;
        if (u.pn < 2) { base = Zc; ldc = 1024; colt = u.pn * BM; }
        else if (u.pn < 14) { base = Zr; ldc = 2048; colt = (u.pn - 6) * BM; }
        else { base = Zg; ldc = 2048; colt = (u.pn - 14) * BM; }
        const int col0 = colt + wc * 32 + 8 * fq;
#pragma unroll
        for (int ai = 0; ai < 2; ++ai)
#pragma unroll
            for (int m = 0; m < 4; ++m) { bf16_t* rowp = base + (size_t)(row0 + ai * HALF + m * 16) * ldc + col0;
#pragma unroll
                for (int bj = 0; bj < 2; ++bj) { const f32x4 v0 = acc[ai][bj][m][0], v1 = acc[ai][bj][m][1];
                    u32x4 w; w.x = cvt_pk_bf16(v0[0], v0[1]); w.y = cvt_pk_bf16(v0[2], v0[3]); w.z = cvt_pk_bf16(v1[0], v1[1]); w.w = cvt_pk_bf16(v1[2], v1[3]);
                    *(u32x4*)(rowp + bj * HALF) = w; } }
    }
};
struct EpiPlain {
    static constexpr bool PERM = true, AFTER_DRAIN = false;
    bf16_t* O; int ldc;
    __device__ __forceinline__ void operator()(const f32x4 (&acc)[2][2][4][2], const Unit& u, int wr, int wc, int fr, int fq) const {
        const int row0 = u.pm * BM + wr * 64 + fr, col0 = u.pn * BM + wc * 32 + 8 * fq;
#pragma unroll
        for (int ai = 0; ai < 2; ++ai)
#pragma unroll
            for (int m = 0; m < 4; ++m) { bf16_t* rowp = O + (size_t)(row0 + ai * HALF + m * 16) * ldc + col0;
#pragma unroll
                for (int bj = 0; bj < 2; ++bj) { const f32x4 v0 = acc[ai][bj][m][0], v1 = acc[ai][bj][m][1];
                    u32x4 w; w.x = cvt_pk_bf16(v0[0], v0[1]); w.y = cvt_pk_bf16(v0[2], v0[3]); w.z = cvt_pk_bf16(v1[0], v1[1]); w.w = cvt_pk_bf16(v1[2], v1[3]);
                    *(u32x4*)(rowp + bj * HALF) = w; } }
    }
};
template <int SECOND> struct EpiGate {
    static constexpr bool PERM = true, AFTER_DRAIN = false;
    const bf16_t* Zg; bf16_t* MG;
    __device__ __forceinline__ void operator()(const f32x4 (&acc)[2][2][4][2], const Unit& u, int wr, int wc, int fr, int fq) const {
        const int row0 = u.pm * BM + wr * 64 + fr, col0 = u.pn * BM + wc * 32 + 8 * fq;
#pragma unroll
        for (int ai = 0; ai < 2; ++ai) {
            u32x4 gw[4][2], pw[4][2];
#pragma unroll
            for (int m = 0; m < 4; ++m) { const int r = row0 + ai * HALF + m * 16;
#pragma unroll
                for (int bj = 0; bj < 2; ++bj) { gw[m][bj] = *(const u32x4*)(Zg + (size_t)r * 2048 + SECOND * 1024 + col0 + bj * HALF);
                    if (SECOND) pw[m][bj] = *(const u32x4*)(MG + (size_t)r * 1024 + col0 + bj * HALF); } }
#pragma unroll
            for (int m = 0; m < 4; ++m) { const int r = row0 + ai * HALF + m * 16; bf16_t* op = MG + (size_t)r * 1024 + col0;
#pragma unroll
                for (int bj = 0; bj < 2; ++bj) { const u32x4 g = gw[m][bj]; f32x4 v0 = acc[ai][bj][m][0], v1 = acc[ai][bj][m][1];
                    v0[0] *= sigm(bf_lo(g.x)); v0[1] *= sigm(bf_hi(g.x)); v0[2] *= sigm(bf_lo(g.y)); v0[3] *= sigm(bf_hi(g.y));
                    v1[0] *= sigm(bf_lo(g.z)); v1[1] *= sigm(bf_hi(g.z)); v1[2] *= sigm(bf_lo(g.w)); v1[3] *= sigm(bf_hi(g.w));
                    if (SECOND) { const u32x4 p = pw[m][bj];
                        v0[0] += bf_lo(p.x); v0[1] += bf_hi(p.x); v0[2] += bf_lo(p.y); v0[3] += bf_hi(p.y);
                        v1[0] += bf_lo(p.z); v1[1] += bf_hi(p.z); v1[2] += bf_lo(p.w); v1[3] += bf_hi(p.w); }
                    u32x4 w; w.x = cvt_pk_bf16(v0[0], v0[1]); w.y = cvt_pk_bf16(v0[2], v0[3]); w.z = cvt_pk_bf16(v1[0], v1[1]); w.w = cvt_pk_bf16(v1[2], v1[3]);
                    *(u32x4*)(op + bj * HALF) = w; } }
        }
    }
};
struct EpiX1 {
    static constexpr bool PERM = false, AFTER_DRAIN = false;
    const float* xp; const float* xs; float* X1; bf16_t* X1B; float* SSP; const float* g2; int nprompt, nrows;
    __device__ __forceinline__ void operator()(const f32x4 (&acc)[2][2][4][2], const Unit& u, int wr, int wc, int fr, int fq) const {
        typedef unsigned u32x2v __attribute__((ext_vector_type(2)));
        const int col0 = u.pn * BM + wc * 32 + 4 * fq;
        f32x4 gq[2][2];
#pragma unroll
        for (int bj = 0; bj < 2; ++bj)
#pragma unroll
            for (int n = 0; n < 2; ++n) gq[bj][n] = *(const f32x4*)(g2 + col0 + bj * HALF + n * 16);
#pragma unroll
        for (int ai = 0; ai < 2; ++ai) {
            f32x4 xv[4][2][2];
#pragma unroll
            for (int m = 0; m < 4; ++m) { int r = u.pm * BM + ai * HALF + wr * 64 + m * 16 + fr; r = r < nrows ? r : nrows - 1;
                const float* xr = r < nprompt ? xp + (size_t)r * 1024 : xs + (size_t)(r - nprompt) * 1024;
#pragma unroll
                for (int bj = 0; bj < 2; ++bj)
#pragma unroll
                    for (int n = 0; n < 2; ++n) xv[m][bj][n] = *(const f32x4*)(xr + col0 + bj * HALF + n * 16); }
#pragma unroll
            for (int m = 0; m < 4; ++m) { const int r = u.pm * BM + ai * HALF + wr * 64 + m * 16 + fr; float ss = 0.f;
#pragma unroll
                for (int bj = 0; bj < 2; ++bj)
#pragma unroll
                    for (int n = 0; n < 2; ++n) { const int c = col0 + bj * HALF + n * 16; const f32x4 o = xv[m][bj][n] + acc[ai][bj][m][n];
                        ss += (o[0] * o[0] + o[1] * o[1]) + (o[2] * o[2] + o[3] * o[3]);
                        const f32x4 q = gq[bj][n]; u32x2v w; w.x = cvt_pk_bf16(o[0] * q[0], o[1] * q[1]); w.y = cvt_pk_bf16(o[2] * q[2], o[3] * q[3]);
                        if (r < nrows) *(u32x2v*)(X1B + (size_t)r * 1024 + c) = w; }
                ss += __shfl_xor(ss, 16); ss += __shfl_xor(ss, 32);
                if (fq == 0 && r < nrows) SSP[(size_t)r * 16 + u.pn * 4 + wc] = ss;
            }
        }
    }
};
template <class Epi, class Sched, bool ALIGN_EPI = false, bool SP2 = false>
__device__ __forceinline__ void gemm_phase(PG8_LAS unsigned char* lds, const Gemm g, const Sched& S, const Epi& E) {
    const int tid = threadIdx.x, wid = __builtin_amdgcn_readfirstlane(tid >> 6), lane = tid & 63, wr = wid >> 2, wc = wid & 3, fr = lane & 15, fq = lane >> 4;
    const int K = g.K, nt = K / BK;
    unsigned voffA[2], voffB[2];
#pragma unroll
    for (int i = 0; i < 2; ++i) { int R, C; stage_rc(tid * 16 + i * 8192, R, C); const int Rb = Epi::PERM ? ((R & ~31) + perm32(R & 31)) : R;
        voffA[i] = (unsigned)(R * K + C) * 2u; voffB[i] = (unsigned)(Rb * K + C) * 2u; }
    const size_t kstep = (size_t)(BK * 2);
    const size_t hstep = (size_t)HALF * K * 2;
    const size_t tstep = 2 * hstep;
    const unsigned ldsw = (unsigned)wid * 1024u;
    const int aoff = lds_byte(wr * 64 + fr, fq * 8), boff = lds_byte(wc * 32 + fr, fq * 8);
#define PG8_SA(b, h) (((b) * 2 + (h)) * HTB)
#define PG8_SB(b, h) ((4 + (b) * 2 + (h)) * HTB)
#define PG8_STAGE(bufoff, gbase, voff) do { _Pragma("unroll") for (int _i = 0; _i < 2; ++_i) \
        __builtin_amdgcn_global_load_lds((const unsigned*)((const char*)(gbase) + (voff)[_i]), (PG8_LAS unsigned*)(lds + (bufoff) + ldsw + _i * 8192), 16, 0, 0); } while (0)
#define PG8_LDA(dst, b, h) do { _Pragma("unroll") for (int m = 0; m < 4; ++m) _Pragma("unroll") for (int k = 0; k < 2; ++k) dst[m][k] = *(const PG8_LAS bf16x8*)(lds + PG8_SA(b, h) + aoff + m * 2048 + k * 1024); } while (0)
#define PG8_LDB(dst, b, h) do { _Pragma("unroll") for (int n = 0; n < 2; ++n) _Pragma("unroll") for (int k = 0; k < 2; ++k) dst[n][k] = *(const PG8_LAS bf16x8*)(lds + PG8_SB(b, h) + boff + n * 2048 + k * 1024); } while (0)
#define PG8_MMA(ai, bj, At, Bt) do { __builtin_amdgcn_s_setprio(1); _Pragma("unroll") for (int m = 0; m < 4; ++m) _Pragma("unroll") for (int n = 0; n < 2; ++n) _Pragma("unroll") for (int k = 0; k < 2; ++k) \
        acc[ai][bj][m][n] = __builtin_amdgcn_mfma_f32_16x16x32_bf16(Bt[n][k], At[m][k], acc[ai][bj][m][n], 0, 0, 0); __builtin_amdgcn_s_setprio(0); } while (0)
#define PG8_WAIT_V(n) asm volatile("s_waitcnt vmcnt(" #n ")" ::: "memory")
#define PG8_WAIT_L(n) asm volatile("s_waitcnt lgkmcnt(" #n ")" ::: "memory")
#define PG8_BAR __builtin_amdgcn_s_barrier()
#define PG8_SCHED __builtin_amdgcn_sched_barrier(0)
    Unit cur, nxt; int ui = 0;
    if (!S.next(0, cur)) return;
    f32x4 acc[2][2][4][2];
#pragma unroll
    for (int a = 0; a < 2; ++a)
#pragma unroll
        for (int b = 0; b < 2; ++b)
#pragma unroll
            for (int m = 0; m < 4; ++m)
#pragma unroll
                for (int n = 0; n < 2; ++n) acc[a][b][m][n] = (f32x4){0.f, 0.f, 0.f, 0.f};
    bf16x8 At[4][2], B0[2][2], B1[2][2];
    const char* cA = (const char*)g.A + (size_t)cur.pm * tstep; const char* cB = (const char*)g.Bt + (size_t)cur.pn * tstep;
    S.a_ready(cur);
    if constexpr (SP2) {
        PG8_STAGE(PG8_SB(0, 0), cB, voffB); PG8_STAGE(PG8_SB(0, 1), cB + hstep, voffB); PG8_STAGE(PG8_SA(0, 0), cA, voffA); PG8_STAGE(PG8_SA(0, 1), cA + hstep, voffA);
        if (wr == 1) PG8_BAR;
        PG8_WAIT_V(2); PG8_BAR;
        PG8_STAGE(PG8_SB(1, 0), cB + kstep, voffB); PG8_STAGE(PG8_SA(1, 0), cA + kstep, voffA); PG8_STAGE(PG8_SB(1, 1), cB + hstep + kstep, voffB);
        PG8_WAIT_V(6); PG8_BAR;
    } else {
        PG8_STAGE(PG8_SB(0, 0), cB, voffB); PG8_STAGE(PG8_SA(0, 0), cA, voffA); PG8_STAGE(PG8_SB(0, 1), cB + hstep, voffB); PG8_STAGE(PG8_SA(0, 1), cA + hstep, voffA);
        if (wr == 1) PG8_BAR;
        PG8_WAIT_V(4); PG8_BAR;
        PG8_STAGE(PG8_SB(1, 0), cB + kstep, voffB); PG8_STAGE(PG8_SA(1, 0), cA + kstep, voffA); PG8_STAGE(PG8_SB(1, 1), cB + hstep + kstep, voffB);
        PG8_WAIT_V(6); PG8_BAR;
    }
    for (;;) {
        const bool has_next = S.next(ui + 1, nxt);
        const char* nA = has_next ? (const char*)g.A + (size_t)nxt.pm * tstep : cA; const char* nB = has_next ? (const char*)g.Bt + (size_t)nxt.pn * tstep : cB;
        for (int t = 0; t < nt; t += 2) {
            const bool last = (t == nt - 2);
            const char* a1 = cA + (size_t)(t + 1) * kstep;
            const char* a2 = last ? nA : cA + (size_t)(t + 2) * kstep; const char* b2 = last ? nB : cB + (size_t)(t + 2) * kstep;
            const char* a3 = a2 + kstep; const char* b3 = b2 + kstep;
            if (last && has_next) S.a_ready(nxt);
            if constexpr (SP2) {
            PG8_LDB(B0, 0, 0); PG8_LDB(B1, 0, 1); PG8_SCHED; PG8_LDA(At, 0, 0); PG8_STAGE(PG8_SA(1, 1), a1 + hstep, voffA);
            PG8_WAIT_V(8); PG8_WAIT_L(0); PG8_BAR; PG8_MMA(0, 0, At, B0); PG8_MMA(0, 1, At, B1); PG8_BAR; PG8_SCHED;
            PG8_LDA(At, 0, 1); PG8_STAGE(PG8_SB(0, 0), b2, voffB); PG8_STAGE(PG8_SB(0, 1), b2 + hstep, voffB); PG8_STAGE(PG8_SA(0, 0), a2, voffA);
            PG8_WAIT_V(8); PG8_WAIT_L(0); PG8_BAR; PG8_MMA(1, 0, At, B0); PG8_MMA(1, 1, At, B1); PG8_BAR; PG8_SCHED;
            PG8_LDB(B0, 1, 0); PG8_LDB(B1, 1, 1); PG8_SCHED; PG8_LDA(At, 1, 0); PG8_STAGE(PG8_SA(0, 1), a2 + hstep, voffA);
            PG8_WAIT_V(8); PG8_WAIT_L(0); PG8_BAR; PG8_MMA(0, 0, At, B0); PG8_MMA(0, 1, At, B1); PG8_BAR; PG8_SCHED;
            PG8_LDA(At, 1, 1); PG8_STAGE(PG8_SB(1, 0), b3, voffB); PG8_STAGE(PG8_SB(1, 1), b3 + hstep, voffB); PG8_STAGE(PG8_SA(1, 0), a3, voffA);
            PG8_WAIT_V(8); PG8_WAIT_L(0); PG8_BAR; PG8_MMA(1, 0, At, B0); PG8_MMA(1, 1, At, B1); PG8_BAR; PG8_SCHED;
            } else {
            PG8_LDB(B0, 0, 0); PG8_SCHED; PG8_LDA(At, 0, 0); PG8_STAGE(PG8_SA(1, 1), a1 + hstep, voffA);
            PG8_WAIT_L(8); PG8_BAR; PG8_WAIT_L(0); PG8_MMA(0, 0, At, B0); PG8_BAR; PG8_SCHED;
            PG8_LDB(B1, 0, 1); PG8_STAGE(PG8_SB(0, 0), b2, voffB);
            PG8_BAR; PG8_WAIT_L(0); PG8_MMA(0, 1, At, B1); PG8_BAR;
            PG8_LDA(At, 0, 1); PG8_STAGE(PG8_SA(0, 0), a2, voffA);
            PG8_BAR; PG8_WAIT_L(0); PG8_MMA(1, 0, At, B0); PG8_BAR; PG8_SCHED;
            PG8_STAGE(PG8_SB(0, 1), b2 + hstep, voffB);
            PG8_WAIT_V(6); PG8_BAR; PG8_MMA(1, 1, At, B1); PG8_BAR;
            PG8_LDB(B0, 1, 0); PG8_SCHED; PG8_LDA(At, 1, 0); PG8_STAGE(PG8_SA(0, 1), a2 + hstep, voffA);
            PG8_WAIT_L(8); PG8_BAR; PG8_WAIT_L(0); PG8_MMA(0, 0, At, B0); PG8_BAR; PG8_SCHED;
            PG8_LDB(B1, 1, 1); PG8_STAGE(PG8_SB(1, 0), b3, voffB);
            PG8_BAR; PG8_WAIT_L(0); PG8_MMA(0, 1, At, B1); PG8_BAR;
            PG8_LDA(At, 1, 1); PG8_STAGE(PG8_SA(1, 0), a3, voffA);
            PG8_BAR; PG8_WAIT_L(0); PG8_MMA(1, 0, At, B0); PG8_BAR; PG8_SCHED;
            PG8_STAGE(PG8_SB(1, 1), b3 + hstep, voffB);
            PG8_WAIT_V(6); PG8_BAR; PG8_MMA(1, 1, At, B1); PG8_BAR;
            }
        }
        if constexpr (ALIGN_EPI) { if (wr == 0) PG8_BAR; }
        if constexpr (!Epi::AFTER_DRAIN) { E(acc, cur, wr, wc, fr, fq); S.done(cur); }
        if (!has_next) break;
#pragma unroll
        for (int a = 0; a < 2; ++a)
#pragma unroll
            for (int b = 0; b < 2; ++b)
#pragma unroll
                for (int m = 0; m < 4; ++m)
#pragma unroll
                    for (int n = 0; n < 2; ++n) acc[a][b][m][n] = (f32x4){0.f, 0.f, 0.f, 0.f};
        cur = nxt; cA = nA; cB = nB; ++ui;
        if constexpr (ALIGN_EPI) { if (wr == 1) PG8_BAR; }
    }
    PG8_WAIT_V(0);
    if constexpr (!ALIGN_EPI) { if (wr == 0) PG8_BAR; }
    PG8_BAR;
    if constexpr (Epi::AFTER_DRAIN) { E.fused(acc, cur, wr, wc, fr, fq, lds, wid, lane); S.done(cur); }
#undef PG8_SA
#undef PG8_SB
#undef PG8_STAGE
#undef PG8_LDA
#undef PG8_LDB
#undef PG8_MMA
#undef PG8_WAIT_V
#undef PG8_WAIT_L
#undef PG8_BAR
#undef PG8_SCHED
}
}
constexpr int NWAVES = 8, NTHR = 512;
#ifndef MK_N_LAUNCHES
#define MK_N_LAUNCHES 1
#endif
constexpr int PER_PHASE = 14;
constexpr int N_LAUNCHES = MK_N_LAUNCHES;

constexpr int DM = 1024, NPROMPT = 32768, NSAMP = 512, NTOK = 33280, NSHIFT = 32, MPAD = 33536, N1 = 5632;
constexpr int SEQ_P = 4096, SEQ_S = 16, NB_P = 8, NB_S = 32;
constexpr size_t O_Y = 0, O_CONV_P = 34078720, O_SHIFT_P = 34086912, O_WKV_P = 34095104, O_CONV_S = 34357248, O_SHIFT_S = 34390016, O_WKV_S = 34422784;
constexpr size_t KiB = 1024, MiB = 1u << 20;
constexpr size_t WS_CTL = 0, CTL_ZERO_BYTES = 64 * KiB;
constexpr size_t WS_W1T = 64 * KiB;
constexpr size_t WS_WPA = WS_W1T + (size_t)N1 * DM * 2;
constexpr size_t WS_WPB = WS_WPA + 1 * MiB;
constexpr size_t WS_WO = WS_WPB + 1 * MiB;
constexpr size_t WS_WQ = WS_WO + 2 * MiB;
constexpr size_t WS_KEYS = WS_WQ + 4 * MiB;
constexpr size_t WS_L2T = WS_KEYS + 512 * KiB;
constexpr size_t WS_SSP = WS_L2T + 256 * KiB;
constexpr size_t WS_UB = WS_SSP + (size_t)MPAD * 16 * 4;
constexpr size_t WS_VB = WS_UB + 16 * MiB;
constexpr size_t WS_A1 = WS_VB + 16 * MiB;
constexpr size_t WS_ZC = WS_A1 + (size_t)MPAD * DM * 2;
constexpr size_t WS_ZR = WS_ZC + (size_t)MPAD * 1536 * 2;
constexpr size_t WS_ZG = WS_ZR + (size_t)MPAD * 2048 * 2;
constexpr size_t WS_END = WS_ZG + (size_t)MPAD * 2048 * 2;
constexpr size_t WS_YL = WS_ZC, WS_ZT = WS_ZC + (size_t)NTOK * 512 * 2, WS_BV = WS_ZC + (size_t)NTOK * 512 * 4;
constexpr size_t WS_EIDX = WS_ZC, WS_GATE = WS_ZC + 16 * MiB, WS_COEF = WS_ZC + 40 * MiB, WS_SS2 = WS_ZC + 64 * MiB, WS_RSTD = WS_ZC + 66 * MiB;
constexpr size_t WS_PART = WS_ZR;
constexpr size_t OB_MB = (size_t)4352 * 4096 * 4;
constexpr size_t OB_S0S = OB_MB + (size_t)4352 * 4096 * 2;
static_assert(WS_BV + (size_t)NTOK * 512 * 2 <= WS_ZR && OB_S0S + (size_t)256 * 4096 * 2 <= (size_t)NTOK * 1024 * 4, "scan scratch maps");
static_assert(WS_END <= 512 * MiB, "d_ws map must fit 512 MiB");
constexpr float PEER_SU = 32.0f, PEER_SV = 4.0f;
constexpr int CW_BAR = 1024;
constexpr int LDS_BYTES = 163840;
constexpr int LDSCTL_OFF = LDS_BYTES - 512, MISC_OFF = LDSCTL_OFF + 320;

#define GAS __attribute__((address_space(1)))
#define LAS __attribute__((address_space(3)))
typedef unsigned short bf16;
typedef unsigned v4u __attribute__((ext_vector_type(4)));
typedef unsigned v2u __attribute__((ext_vector_type(2)));
typedef float f32x4 __attribute__((ext_vector_type(4)));
typedef short bf16x8 __attribute__((ext_vector_type(8)));
typedef __bf16 bf16x2_t __attribute__((ext_vector_type(2)));
typedef GAS unsigned gu32;
#define RLX_AGENT __ATOMIC_RELAXED, __HIP_MEMORY_SCOPE_AGENT
#define LDS_WAIT() asm volatile("s_waitcnt lgkmcnt(0)" ::: "memory")
#define VM_WAIT() asm volatile("s_waitcnt vmcnt(0)" ::: "memory")
using pg8::cvt_pk_bf16; using pg8::bf_lo; using pg8::bf_hi; using pg8::sigm;
#define XB_TMO      128
#define XB_XCNT(j)  (256  + 64 * (j))
#define XB_XSUB(j)  (1280 + 64 * (j))
#define XB_XGEN(j)  (2304 + 64 * (j))
#define XB_TOP      3328
#define XB_TOPGEN   3392
#define XCD_BAR_WORDS 3456
#define XB_SPIN_CAP (1u << 22)

__device__ __forceinline__ unsigned xb_ld(unsigned* p)              { return __hip_atomic_load(p, __ATOMIC_RELAXED, __HIP_MEMORY_SCOPE_AGENT); }
__device__ __forceinline__ unsigned xb_add(unsigned* p, unsigned v) { return __hip_atomic_fetch_add(p, v, __ATOMIC_RELAXED, __HIP_MEMORY_SCOPE_AGENT); }
__device__ __forceinline__ unsigned xb_xcc_id() { return (unsigned)__builtin_amdgcn_s_getreg((3 << 11) | 20) & 0xFu; }
#define XB_SPIN(cond, bar) do { unsigned _sp = 0; while (cond) { __builtin_amdgcn_s_sleep(1); \
    if ((++_sp & 255u) == 0u) { if (xb_ld(&(bar)[XB_TMO])) break; if (_sp > XB_SPIN_CAP) { atomicAdd(&(bar)[XB_TMO], 1u); break; } } } } while (0)

struct XcdBarrier {
    unsigned* bar; unsigned x;
    volatile LAS unsigned* st;
};

__device__ __forceinline__ XcdBarrier xcd_barrier_post(unsigned* bar, volatile LAS unsigned* st) {
    XcdBarrier b; b.bar = bar; b.x = xb_xcc_id(); b.st = st;
    if (threadIdx.x == 0) (void)xb_add(&bar[XB_XCNT(b.x)], 1u);
    return b;
}
__device__ __forceinline__ void xcd_barrier_complete(unsigned* bar, unsigned x, unsigned& nloc, unsigned& nx) {
    const unsigned G = gridDim.x * gridDim.y * gridDim.z;
    unsigned sum, cnt, mine, sp = 0u;
    for (;;) {
        sum = 0u; cnt = 0u; mine = 0u;
#pragma unroll
        for (unsigned j = 0; j < 16; ++j) { const unsigned c = xb_ld(&bar[XB_XCNT(j)]); sum += c; cnt += (c > 0u) ? 1u : 0u; mine = (j == x) ? c : mine; }
        if (sum == G) break;
        __builtin_amdgcn_s_sleep(1);
        if ((++sp & 255u) == 0u) { if (xb_ld(&bar[XB_TMO])) break; if (sp > XB_SPIN_CAP) { atomicAdd(&bar[XB_TMO], 1u); break; } }
    }
    nloc = mine > 0u ? mine : 1u; nx = cnt > 0u ? cnt : 1u;
}

__device__ __forceinline__ void xcd_barrier(const XcdBarrier& b) {
    asm volatile("s_waitcnt vmcnt(0)" ::: "memory");
    __syncthreads();
    if (threadIdx.x == 0) {
        unsigned* bar = b.bar;
        __builtin_amdgcn_s_waitcnt(0);
        unsigned nloc = b.st[0], nx = b.st[1];
        if (nloc == 0u) { xcd_barrier_complete(bar, b.x, nloc, nx); b.st[0] = nloc; b.st[1] = nx; }
        const unsigned old = xb_add(&bar[XB_XSUB(b.x)], 1u);
        const unsigned gen = old / nloc;
        if (old + 1u == (gen + 1u) * nloc) {
            __builtin_amdgcn_fence(__ATOMIC_RELEASE, "agent");
            asm volatile("s_waitcnt vmcnt(0)" ::: "memory");
            const unsigned og = xb_add(&bar[XB_TOP], 1u);
            const unsigned tg = og / nx;
            if (og + 1u == (tg + 1u) * nx) xb_add(&bar[XB_TOPGEN], 1u);
            else XB_SPIN(xb_ld(&bar[XB_TOPGEN]) == tg, bar);
            __builtin_amdgcn_fence(__ATOMIC_ACQUIRE, "agent");
            xb_add(&bar[XB_XGEN(b.x)], 1u);
            asm volatile("s_waitcnt vmcnt(0)" ::: "memory");
        } else {
            XB_SPIN(xb_ld(&bar[XB_XGEN(b.x)]) == gen, bar);
            __builtin_amdgcn_fence(__ATOMIC_ACQUIRE, "agent");
            asm volatile("s_waitcnt vmcnt(0)" ::: "memory");
        }
    }
    __syncthreads();
}
struct Args { const float* in[32]; float* out; unsigned char* ws; int ph_lo, ph_hi, li, pad; };
enum { I_XP = 0, I_XS, I_SCONV, I_SSHIFT, I_SWKV, I_N1G, I_WIN, I_CONVW, I_MURKV, I_MUWAG, I_W0, I_W1, I_W2, I_A0, I_A1, I_A2, I_G1, I_G2, I_KK, I_KA, I_RK, I_GNW, I_GNB, I_WPA, I_WPB, I_WO, I_N2G, I_WQ, I_KEYS, I_U, I_V, I_NFG };

__device__ __forceinline__ float wave_sum(float v) {
#pragma unroll
    for (int o = 1; o < 64; o <<= 1) v += __shfl_xor(v, o);
    return v;
}
template <int CTRL> __device__ __forceinline__ float dpp_mov(float v) { return __builtin_bit_cast(float, __builtin_amdgcn_update_dpp(0, __builtin_bit_cast(int, v), CTRL, 0xF, 0xF, true)); }
__device__ __forceinline__ float sum4(float v) { v += dpp_mov<0xB1>(v); v += dpp_mov<0x4E>(v); return v; }
__device__ __forceinline__ float sum8(float v) { v = sum4(v); v += dpp_mov<0x141>(v); return v; }
__device__ __forceinline__ float sum16(float v) { v = sum8(v); v += dpp_mov<0x140>(v); return v; }
__device__ __forceinline__ float dot2bf(unsigned w, unsigned x, float acc) { return __builtin_amdgcn_fdot2_f32_bf16(__builtin_bit_cast(bf16x2_t, w), __builtin_bit_cast(bf16x2_t, x), acc, false); }

__device__ __forceinline__ void transpose_item(const float* W, int ldw, int c0, int K, bf16* WT, int nblk, int item, const float* sv, float alpha, float beta, LAS float* scr, int lane, int rstride = 1) {
    const int kb = item / nblk, nb = item % nblk, k0 = 64 * kb, n0 = 32 * nb;
    float wv[32];
#pragma unroll
    for (int i = 0; i < 32; ++i) wv[i] = W[(size_t)(k0 + 2 * i + (lane >> 5)) * ldw + c0 + n0 + (lane & 31)];
#pragma unroll
    for (int i = 0; i < 32; ++i) { const int kk = 2 * i + (lane >> 5); float s = 1.f; if (sv) s = alpha + beta * sv[k0 + kk];
        scr[kk * 33 + (lane & 31)] = wv[i] * s; }
    LDS_WAIT();
    const int c = lane & 7;
#pragma unroll
    for (int j = 0; j < 4; ++j) { const int n = (lane >> 3) + 8 * j; const LAS float* s = scr + (8 * c) * 33 + n;
        v4u o; o.x = cvt_pk_bf16(s[0 * 33], s[1 * 33]); o.y = cvt_pk_bf16(s[2 * 33], s[3 * 33]); o.z = cvt_pk_bf16(s[4 * 33], s[5 * 33]); o.w = cvt_pk_bf16(s[6 * 33], s[7 * 33]);
        *(v4u*)(WT + (size_t)((n0 + n) * rstride) * K + k0 + 8 * c) = o; }
    LDS_WAIT();
}
__device__ __forceinline__ void cvt_stream(const float* src, bf16* dst, size_t n, size_t gt, size_t nthreads) {
    for (size_t i = gt * 8; i < n; i += nthreads * 8) { const f32x4 a = *(const f32x4*)(src + i), b = *(const f32x4*)(src + i + 4);
        v4u o; o.x = cvt_pk_bf16(a[0], a[1]); o.y = cvt_pk_bf16(a[2], a[3]); o.z = cvt_pk_bf16(b[0], b[1]); o.w = cvt_pk_bf16(b[2], b[3]); *(v4u*)(dst + i) = o; }
}
__device__ __forceinline__ void cvt_stream_fp8(const float* src, unsigned char* dst, size_t n, float scale, size_t gt, size_t nthreads) {
    for (size_t i = gt * 16; i < n; i += nthreads * 16) {
        const f32x4 a = *(const f32x4*)(src + i) * scale, b = *(const f32x4*)(src + i + 4) * scale, c = *(const f32x4*)(src + i + 8) * scale, d = *(const f32x4*)(src + i + 12) * scale;
        v4u o; unsigned p;
        p = __builtin_amdgcn_cvt_pk_fp8_f32(a[0], a[1], 0, false); o.x = __builtin_amdgcn_cvt_pk_fp8_f32(a[2], a[3], p, true);
        p = __builtin_amdgcn_cvt_pk_fp8_f32(b[0], b[1], 0, false); o.y = __builtin_amdgcn_cvt_pk_fp8_f32(b[2], b[3], p, true);
        p = __builtin_amdgcn_cvt_pk_fp8_f32(c[0], c[1], 0, false); o.z = __builtin_amdgcn_cvt_pk_fp8_f32(c[2], c[3], p, true);
        p = __builtin_amdgcn_cvt_pk_fp8_f32(d[0], d[1], 0, false); o.w = __builtin_amdgcn_cvt_pk_fp8_f32(d[2], d[3], p, true);
        *(v4u*)(dst + i) = o; }
}
__device__ __forceinline__ void cvt16_fp8_sliced(const float* src, unsigned char* dst, float scale, size_t i) {
    const f32x4 a = *(const f32x4*)(src + i) * scale, b = *(const f32x4*)(src + i + 4) * scale, c = *(const f32x4*)(src + i + 8) * scale, d = *(const f32x4*)(src + i + 12) * scale;
    v4u o; unsigned p;
    p = __builtin_amdgcn_cvt_pk_fp8_f32(a[0], a[1], 0, false); o.x = __builtin_amdgcn_cvt_pk_fp8_f32(a[2], a[3], p, true);
    p = __builtin_amdgcn_cvt_pk_fp8_f32(b[0], b[1], 0, false); o.y = __builtin_amdgcn_cvt_pk_fp8_f32(b[2], b[3], p, true);
    p = __builtin_amdgcn_cvt_pk_fp8_f32(c[0], c[1], 0, false); o.z = __builtin_amdgcn_cvt_pk_fp8_f32(c[2], c[3], p, true);
    p = __builtin_amdgcn_cvt_pk_fp8_f32(d[0], d[1], 0, false); o.w = __builtin_amdgcn_cvt_pk_fp8_f32(d[2], d[3], p, true);
    const size_t e = i >> 10, col = i & 1023;
    *(v4u*)(dst + (col >> 7) * ((size_t)16384 * 128) + e * 128 + (col & 127)) = o;
}
__device__ __forceinline__ void cvt_stream_fp8_sliced(const float* src, unsigned char* dst, float scale, size_t gt, size_t nthreads) {
#pragma unroll 2
    for (size_t i = gt * 16; i < (size_t)16384 * 1024; i += nthreads * 16) {
        const f32x4 a = *(const f32x4*)(src + i) * scale, b = *(const f32x4*)(src + i + 4) * scale, c = *(const f32x4*)(src + i + 8) * scale, d = *(const f32x4*)(src + i + 12) * scale;
        v4u o; unsigned p;
        p = __builtin_amdgcn_cvt_pk_fp8_f32(a[0], a[1], 0, false); o.x = __builtin_amdgcn_cvt_pk_fp8_f32(a[2], a[3], p, true);
        p = __builtin_amdgcn_cvt_pk_fp8_f32(b[0], b[1], 0, false); o.y = __builtin_amdgcn_cvt_pk_fp8_f32(b[2], b[3], p, true);
        p = __builtin_amdgcn_cvt_pk_fp8_f32(c[0], c[1], 0, false); o.z = __builtin_amdgcn_cvt_pk_fp8_f32(c[2], c[3], p, true);
        p = __builtin_amdgcn_cvt_pk_fp8_f32(d[0], d[1], 0, false); o.w = __builtin_amdgcn_cvt_pk_fp8_f32(d[2], d[3], p, true);
        const size_t e = i >> 10, col = i & 1023;
        *(v4u*)(dst + (col >> 7) * ((size_t)16384 * 128) + e * 128 + (col & 127)) = o; }
}
__device__ __forceinline__ void p0_prologue(const Args& A, LAS unsigned char* lds, int tid, int lane, int wave, int vcu, int G) {
    unsigned char* ws = A.ws;
    bf16* W1T = (bf16*)(ws + WS_W1T);
    LAS float* scr = (LAS float*)(lds + wave * 16384);
    const int gw = vcu * NWAVES + wave, NGW = G * NWAVES;
    constexpr int J0 = 16 * 96, JB_ = 16 * 16, J1 = 16 * 64, JL = 16 * 2, JG = 16 * 4, JP = 8 * 32, JO = 16 * 32, JQ = 16 * 64;
    constexpr int JW2 = 16, JG2 = 32;
    constexpr int NITEMS = J0 + J1 + 4 * JL + 2 * JG + 2 * JP + JO + JQ + 2 * JW2 + JG2;
    bf16* L2T = (bf16*)(ws + WS_L2T);
    const float* mu = A.in[I_MUWAG];
    for (int it = gw; it < NITEMS; it += NGW) {
        int r = it;
        if (r < J0) {
            if (r < JB_) transpose_item(A.in[I_WIN], 5120, 0, 1024, W1T, 16, r, nullptr, 0.f, 0.f, scr, lane);
            else if (r < 2 * JB_) transpose_item(A.in[I_WIN], 5120, 512, 1024, W1T + (size_t)512 * 1024, 16, r - JB_, nullptr, 0.f, 0.f, scr, lane, 2);
            else if (r < 3 * JB_) transpose_item(A.in[I_WIN], 5120, 1024, 1024, W1T + (size_t)513 * 1024, 16, r - 2 * JB_, nullptr, 0.f, 0.f, scr, lane, 2);
            else transpose_item(A.in[I_WIN], 5120, 1536, 1024, W1T + (size_t)1536 * 1024, 48, r - 3 * JB_, nullptr, 0.f, 0.f, scr, lane);
            continue; } r -= J0;
        if (r < J1) { transpose_item(A.in[I_WIN], 5120, 3072, 1024, W1T + (size_t)3584 * 1024, 64, r, nullptr, 0.f, 0.f, scr, lane); continue; } r -= J1;
        if (r < JL) { transpose_item(A.in[I_W1], 64, 0, 1024, W1T + (size_t)3072 * 1024, 2, r, mu, 1.f, -1.f, scr, lane); continue; } r -= JL;
        if (r < JL) { transpose_item(A.in[I_W1], 64, 0, 1024, W1T + (size_t)3328 * 1024, 2, r, mu, 0.f, 1.f, scr, lane); continue; } r -= JL;
        if (r < JL) { transpose_item(A.in[I_A1], 64, 0, 1024, W1T + (size_t)(3072 + 64) * 1024, 2, r, mu + 1024, 1.f, -1.f, scr, lane); continue; } r -= JL;
        if (r < JL) { transpose_item(A.in[I_A1], 64, 0, 1024, W1T + (size_t)(3328 + 64) * 1024, 2, r, mu + 1024, 0.f, 1.f, scr, lane); continue; } r -= JL;
        if (r < JG) { transpose_item(A.in[I_G1], 128, 0, 1024, W1T + (size_t)(3072 + 128) * 1024, 4, r, mu + 2048, 1.f, -1.f, scr, lane); continue; } r -= JG;
        if (r < JG) { transpose_item(A.in[I_G1], 128, 0, 1024, W1T + (size_t)(3328 + 128) * 1024, 4, r, mu + 2048, 0.f, 1.f, scr, lane); continue; } r -= JG;
        if (r < JP) { transpose_item(A.in[I_WPA], 1024, 0, 512, (bf16*)(ws + WS_WPA), 32, r, nullptr, 0.f, 0.f, scr, lane); continue; } r -= JP;
        if (r < JP) { transpose_item(A.in[I_WPB], 1024, 0, 512, (bf16*)(ws + WS_WPB), 32, r, nullptr, 0.f, 0.f, scr, lane); continue; } r -= JP;
        if (r < JO) { transpose_item(A.in[I_WO], 1024, 0, 1024, (bf16*)(ws + WS_WO), 32, r, nullptr, 0.f, 0.f, scr, lane); continue; } r -= JO;
        if (r < JQ) { transpose_item(A.in[I_WQ], 2048, 0, 1024, (bf16*)(ws + WS_WQ), 64, r, nullptr, 0.f, 0.f, scr, lane); continue; } r -= JQ;
        if (r < JW2) { transpose_item(A.in[I_W2], 512, 0, 64, L2T, 16, r, nullptr, 0.f, 0.f, scr, lane); continue; } r -= JW2;
        if (r < JW2) { transpose_item(A.in[I_A2], 512, 0, 64, L2T + (size_t)512 * 64, 16, r, nullptr, 0.f, 0.f, scr, lane); continue; } r -= JW2;
        transpose_item(A.in[I_G2], 512, 0, 128, L2T + (size_t)1024 * 64, 16, r, nullptr, 0.f, 0.f, scr, lane);
    }
    const size_t gt = (size_t)vcu * NTHR + tid, nth = (size_t)G * NTHR;
    if (G != 256) {
        cvt_stream_fp8_sliced(A.in[I_U], ws + WS_UB, PEER_SU, gt, nth);
        cvt_stream_fp8_sliced(A.in[I_V], ws + WS_VB, PEER_SV, gt, nth); }
    cvt_stream(A.in[I_KEYS], (bf16*)(ws + WS_KEYS), (size_t)8 * 2 * 128 * 128, gt, nth);
    bf16* A1 = (bf16*)(ws + WS_A1);
    const f32x4* g1v = (const f32x4*)A.in[I_N1G] + lane;
    for (int m0 = gw; m0 < NTOK; m0 += 2 * NGW) {
        const int m1 = m0 + NGW; const bool two = m1 < NTOK; const int m1c = two ? m1 : m0;
        const f32x4* xr0 = (const f32x4*)(m0 < NPROMPT ? A.in[I_XP] + (size_t)m0 * DM : A.in[I_XS] + (size_t)(m0 - NPROMPT) * DM) + lane;
        const f32x4* xr1 = (const f32x4*)(m1c < NPROMPT ? A.in[I_XP] + (size_t)m1c * DM : A.in[I_XS] + (size_t)(m1c - NPROMPT) * DM) + lane;
        f32x4 v0[4], v1[4]; float s0 = 0.f, s1 = 0.f;
#pragma unroll
        for (int j = 0; j < 4; ++j) { v0[j] = xr0[64 * j]; v1[j] = xr1[64 * j]; }
#pragma unroll
        for (int j = 0; j < 4; ++j) { s0 += (v0[j][0] * v0[j][0] + v0[j][1] * v0[j][1]) + (v0[j][2] * v0[j][2] + v0[j][3] * v0[j][3]);
                                      s1 += (v1[j][0] * v1[j][0] + v1[j][1] * v1[j][1]) + (v1[j][2] * v1[j][2] + v1[j][3] * v1[j][3]); }
#pragma unroll
        for (int o = 1; o < 64; o <<= 1) { s0 += __shfl_xor(s0, o); s1 += __shfl_xor(s1, o); }
        const float r0 = __builtin_amdgcn_rsqf(s0 * (1.f / DM) + 1e-6f), r1 = __builtin_amdgcn_rsqf(s1 * (1.f / DM) + 1e-6f);
#pragma unroll
        for (int rr = 0; rr < 2; ++rr) {
            if (rr == 1 && !two) break;
            const int m = rr ? m1 : m0; const float rstd = rr ? r1 : r0;
            v2u* o8 = (v2u*)(A1 + (size_t)m * DM) + lane;
            float* so = nullptr;
            if (m < NPROMPT) { if ((m & (SEQ_P - 1)) == SEQ_P - 1) so = A.out + O_SHIFT_P + (size_t)(m / SEQ_P) * DM; }
            else { const int ms = m - NPROMPT; if ((ms & (SEQ_S - 1)) == SEQ_S - 1) so = A.out + O_SHIFT_S + (size_t)(ms / SEQ_S) * DM; }
#pragma unroll
            for (int j = 0; j < 4; ++j) { const f32x4 g = g1v[64 * j]; const f32x4 y = (rr ? v1[j] : v0[j]) * rstd * g;
                v2u w; w.x = cvt_pk_bf16(y[0], y[1]); w.y = cvt_pk_bf16(y[2], y[3]); o8[64 * j] = w;
                if (so) ((f32x4*)so)[lane + 64 * j] = y; }
        }
    }
    for (int m = NTOK + gw; m < MPAD; m += NGW) {
        v2u* o8 = (v2u*)(A1 + (size_t)m * DM) + lane;
        if (m < NTOK + NSHIFT) {
            const f32x4* xr = (const f32x4*)(A.in[I_SSHIFT] + (size_t)(m - NTOK) * DM) + lane;
#pragma unroll
            for (int j = 0; j < 4; ++j) { const f32x4 y = xr[64 * j]; v2u w; w.x = cvt_pk_bf16(y[0], y[1]); w.y = cvt_pk_bf16(y[2], y[3]); o8[64 * j] = w; }
        } else {
#pragma unroll
            for (int j = 0; j < 4; ++j) { v2u w; w.x = 0u; w.y = 0u; o8[64 * j] = w; }
        }
    }
}

__device__ __forceinline__ void unpack8(const v4u w, float (&f)[8]) { f[0] = bf_lo(w.x); f[1] = bf_hi(w.x); f[2] = bf_lo(w.y); f[3] = bf_hi(w.y); f[4] = bf_lo(w.z); f[5] = bf_hi(w.z); f[6] = bf_lo(w.w); f[7] = bf_hi(w.w); }
__device__ __forceinline__ void conv_phase(const Args& A, int gt, int nth) {
    const bf16* Zc = (const bf16*)(A.ws + WS_ZC); bf16* YA = (bf16*)(A.ws + WS_A1);
    const float* cw = A.in[I_CONVW];
    for (int task = gt; task < (NTOK / 16) * 64; task += nth) {
        const int seg = task >> 6, ch = (task & 63) * 8, row0 = seg * 16;
        int b, t0, T; bool prompt = row0 < NPROMPT;
        if (prompt) { b = row0 / SEQ_P; t0 = row0 % SEQ_P; T = SEQ_P; } else { b = (row0 - NPROMPT) / SEQ_S; t0 = 0; T = SEQ_S; }
        float um2[8], um1[8], c0[8], c1[8], c2[8];
#pragma unroll
        for (int i = 0; i < 8; ++i) { c0[i] = cw[ch + i]; c1[i] = cw[512 + ch + i]; c2[i] = cw[1024 + ch + i]; }
        if (t0 == 0) {
            if (prompt) {
#pragma unroll
                for (int i = 0; i < 8; ++i) { um2[i] = 0.f; um1[i] = 0.f; }
            } else { const float* sc = A.in[I_SCONV] + (size_t)b * 2 * 512 + ch;
#pragma unroll
                for (int i = 0; i < 8; ++i) { um2[i] = sc[i]; um1[i] = sc[512 + i]; } }
        } else {
            unpack8(*(const v4u*)(Zc + (size_t)(row0 - 2) * 1024 + 512 + ch), um2); unpack8(*(const v4u*)(Zc + (size_t)(row0 - 1) * 1024 + 512 + ch), um1);
        }
#pragma unroll 4
        for (int t = 0; t < 16; ++t) {
            const size_t row = (size_t)(row0 + t);
            float zb[8], zu[8], y[8];
            unpack8(*(const v4u*)(Zc + row * 1024 + ch), zb); unpack8(*(const v4u*)(Zc + row * 1024 + 512 + ch), zu);
#pragma unroll
            for (int i = 0; i < 8; ++i) { const float u = zu[i]; y[i] = zb[i] * (c0[i] * um2[i] + c1[i] * um1[i] + c2[i] * u); um2[i] = um1[i]; um1[i] = u; }
            v4u o; o.x = cvt_pk_bf16(y[0], y[1]); o.y = cvt_pk_bf16(y[2], y[3]); o.z = cvt_pk_bf16(y[4], y[5]); o.w = cvt_pk_bf16(y[6], y[7]);
            *(v4u*)(YA + row * 512 + ch) = o;
        }
        if (t0 + 16 == T) { float* oc = A.out + (prompt ? O_CONV_P : O_CONV_S) + (size_t)b * 2 * 512 + ch;
#pragma unroll
            for (int i = 0; i < 8; ++i) { oc[i] = um2[i]; oc[512 + i] = um1[i]; } }
    }
    bf16* Zr = (bf16*)(A.ws + WS_ZR);
    for (int task = nth - 1 - gt; task < NTOK * 16; task += nth) {
        const int m = task >> 4, cs = task & 15;
        bool hasprev; int prow;
        if (m < NPROMPT) { hasprev = (m & (SEQ_P - 1)) != 0; prow = m - 1; } else { const int ms = m - NPROMPT; hasprev = true; prow = (ms & (SEQ_S - 1)) ? m - 1 : NTOK + ms / SEQ_S; }
        bf16* pap = Zr + (size_t)m * 2048 + 1536 + cs * 16;
        float pa[16], t8[8];
        const v4u a0 = *(const v4u*)pap, a1 = *(const v4u*)(pap + 8);
        v4u b0 = (v4u){0u, 0u, 0u, 0u}, b1 = b0;
        if (hasprev) { const bf16* pbp = Zr + (size_t)prow * 2048 + 1792 + cs * 16; b0 = *(const v4u*)pbp; b1 = *(const v4u*)(pbp + 8); }
        unpack8(a0, t8);
#pragma unroll
        for (int i = 0; i < 8; ++i) pa[i] = t8[i];
        unpack8(a1, t8);
#pragma unroll
        for (int i = 0; i < 8; ++i) pa[8 + i] = t8[i];
        unpack8(b0, t8);
#pragma unroll
        for (int i = 0; i < 8; ++i) pa[i] += t8[i];
        unpack8(b1, t8);
#pragma unroll
        for (int i = 0; i < 8; ++i) pa[8 + i] += t8[i];
#pragma unroll
        for (int i = 0; i < 16; ++i) { float p = pa[i];
            if (cs < 4) p = 1.0f - 2.0f * __builtin_amdgcn_rcpf(__expf(2.0f * p) + 1.0f);
            else if (cs >= 8) p = sigm(p);
            pa[i] = p; }
        v4u o0, o1; o0.x = cvt_pk_bf16(pa[0], pa[1]); o0.y = cvt_pk_bf16(pa[2], pa[3]); o0.z = cvt_pk_bf16(pa[4], pa[5]); o0.w = cvt_pk_bf16(pa[6], pa[7]);
        o1.x = cvt_pk_bf16(pa[8], pa[9]); o1.y = cvt_pk_bf16(pa[10], pa[11]); o1.z = cvt_pk_bf16(pa[12], pa[13]); o1.w = cvt_pk_bf16(pa[14], pa[15]);
        *(v4u*)pap = o0; *(v4u*)(pap + 8) = o1;
    }
}

constexpr int NUNITS_P = NB_P * 8 * 64, NUNITS = NUNITS_P + NB_S * 8;
constexpr int HID_STRIDE = 264, SC_TB = 32;
constexpr int P1_HIDB = 0, P1_LO = 16896, P1_SEQ = 41472, P1_GG = 90624, P1_YY = 98816, P1_ZZ = 107008, P1_BON = 115200;
typedef float f32x2 __attribute__((ext_vector_type(2)));

struct P1Pre { v4u pa0, pa1; v2u zr, zk, zv, pr, pk, pv; };
struct P1Pos { int unit, t0; };
__device__ __forceinline__ void p1_decode(int unit, bool& prompt, int& b, int& h, int& ch, int& T, int& rowbase) {
    prompt = unit < NUNITS_P; b = prompt ? unit >> 9 : (unit - NUNITS_P) >> 3; h = prompt ? (unit >> 6) & 7 : unit & 7; ch = prompt ? unit & 63 : 0;
    T = prompt ? 64 : SEQ_S; rowbase = prompt ? b * SEQ_P + ch * 64 : NPROMPT + b * SEQ_S;
}
__device__ __forceinline__ void p1_rows(int unit, int t0, int tt, size_t& row, size_t& prow, bool& hasprev, int& nb) {
    bool prompt; int b, h, ch, T, rowbase; p1_decode(unit, prompt, b, h, ch, T, rowbase);
    nb = (T - t0) < SC_TB ? (T - t0) : SC_TB;
    const int tloc = tt < nb ? tt : nb - 1, t = t0 + tloc; const bool first = (ch == 0);
    row = (size_t)(rowbase + t); hasprev = (t > 0) || !first || !prompt; prow = ((t > 0) || !first) ? row - 1 : (size_t)(NTOK + b);
}
__device__ __forceinline__ void p1_load(const Args& A, int unit, int t0, int tt, int cs, P1Pre& P) {
    size_t row, prow; bool hasprev; int nb; p1_rows(unit, t0, tt, row, prow, hasprev, nb);
    const int h = unit < NUNITS_P ? (unit >> 6) & 7 : unit & 7, hc = h * 64 + cs * 4;
    const bf16* Zr = (const bf16*)(A.ws + WS_ZR);
    P.pa0 = *(const v4u*)(Zr + row * 2048 + 1536 + cs * 16); P.pa1 = *(const v4u*)(Zr + row * 2048 + 1536 + cs * 16 + 8);
    P.zr = *(const v2u*)(Zr + row * 2048 + hc); P.zk = *(const v2u*)(Zr + row * 2048 + 512 + hc); P.zv = *(const v2u*)(Zr + row * 2048 + 1024 + hc);
    const v2u z2 = (v2u){0u, 0u};
    P.pr = z2; P.pk = z2; P.pv = z2;
    if (hasprev) { P.pr = *(const v2u*)(Zr + prow * 2048 + hc); P.pk = *(const v2u*)(Zr + prow * 2048 + 512 + hc); P.pv = *(const v2u*)(Zr + prow * 2048 + 1024 + hc); }
}
__device__ __forceinline__ bool p1_unit_at(int i, int vcu, int G, int& unit) {
    if (G == 256) { if (i > 16) return false; unit = i < 16 ? vcu * 16 + i : NUNITS_P + vcu; return true; }
    unit = vcu + i * G; return unit < NUNITS;
}

constexpr int WY_OS = 72, WY_TS = 24, WY_LS = 40;
constexpr int WY_AT = 0, WY_RT = WY_AT + 16 * WY_OS * 2, WY_BT = WY_RT + 16 * WY_OS * 2, WY_KT = WY_BT + 16 * WY_OS * 2, WY_BK = WY_KT + 16 * WY_OS * 2,
              WY_VT = WY_BK + 64 * WY_LS * 2, WY_GC = WY_VT + 64 * WY_TS * 2, WY_BUF = WY_GC + 256;
constexpr int WY_BASE = 0;
constexpr int WY_GSET = 1024 + 2 * 16 * WY_LS * 2 + 1024;
constexpr int WY_LAB = WY_BASE + 2 * WY_BUF;
static_assert(WY_LAB + WY_GSET <= P1_SEQ, "UT-transform operands must fit over HIDB | LO");
constexpr int WY_XB = 115328, WY_END = WY_XB + 128 * WY_OS * 2;
static_assert(WY_END <= LDSCTL_OFF, "LDS map of pass 1");

constexpr int WY_G2 = P1_GG + 2048;
static_assert(WY_G2 + WY_GSET <= P1_YY, "second Gram set");
__device__ __forceinline__ void p1_wy(f32x4 (&X)[4], const LAS float* SEQ, LAS float* YY, LAS float* ZZ, LAS unsigned char* lds, int nb, int tid, int lane, int wave, int part = 0) {
    const bool pw = wave >= 4; const int nmc = nb >> 4;
    LAS bf16* Xb = (LAS bf16*)(lds + WY_XB);
    for (int mc = 0; mc < nmc; ++mc) {
        asm volatile("" : "+v"(tid));
        LAS unsigned char* ob = lds + WY_BASE + mc * WY_BUF;
        LAS bf16* At = (LAS bf16*)(ob + WY_AT); LAS bf16* Rt = (LAS bf16*)(ob + WY_RT); LAS bf16* Bt = (LAS bf16*)(ob + WY_BT); LAS bf16* Kt = (LAS bf16*)(ob + WY_KT);
        LAS bf16* BKT = (LAS bf16*)(ob + WY_BK); LAS bf16* VT = (LAS bf16*)(ob + WY_VT); LAS float* GC = (LAS float*)(ob + WY_GC);
        const int tl = tid >> 5, c2 = (tid & 31) * 2, s0 = mc * 16;
        f32x2 cum = (f32x2){0.f, 0.f}, tot = cum, lwt = cum;
#pragma unroll
        for (int i = 0; i < 16; ++i) { const f32x2 l2 = *(const LAS f32x2*)(SEQ + (s0 + i) * 384 + 64 + c2); tot += l2; if (i <= tl) cum += l2; if (i == tl) lwt = l2; }
        const LAS float* sp = SEQ + (s0 + tl) * 384 + c2;
        const f32x2 a2 = *(const LAS f32x2*)(sp), b2 = *(const LAS f32x2*)(sp + 128), k2 = *(const LAS f32x2*)(sp + 192), r2 = *(const LAS f32x2*)(sp + 256), v2 = *(const LAS f32x2*)(sp + 320);
        const f32x2 gt = (f32x2){__builtin_amdgcn_exp2f(cum.x), __builtin_amdgcn_exp2f(cum.y)}, gp = (f32x2){__builtin_amdgcn_exp2f(cum.x - lwt.x), __builtin_amdgcn_exp2f(cum.y - lwt.y)},
                    gi = (f32x2){__builtin_amdgcn_exp2f(-cum.x), __builtin_amdgcn_exp2f(-cum.y)}, go = (f32x2){__builtin_amdgcn_exp2f(tot.x - cum.x), __builtin_amdgcn_exp2f(tot.y - cum.y)};
        *(LAS unsigned*)(At + tl * WY_OS + c2) = cvt_pk_bf16(a2.x * gp.x, a2.y * gp.y); *(LAS unsigned*)(Rt + tl * WY_OS + c2) = cvt_pk_bf16(r2.x * gt.x, r2.y * gt.y);
        *(LAS unsigned*)(Bt + tl * WY_OS + c2) = cvt_pk_bf16(b2.x * gi.x, b2.y * gi.y); *(LAS unsigned*)(Kt + tl * WY_OS + c2) = cvt_pk_bf16(k2.x * gi.x, k2.y * gi.y);
        const unsigned bh = cvt_pk_bf16(b2.x * go.x, b2.y * go.y), kh = cvt_pk_bf16(k2.x * go.x, k2.y * go.y), vv = cvt_pk_bf16(v2.x, v2.y);
        {
            const unsigned bh_o = (unsigned)__shfl_xor((int)bh, 32), kh_o = (unsigned)__shfl_xor((int)kh, 32), vv_o = (unsigned)__shfl_xor((int)vv, 32);
            const bool ev = (tl & 1) == 0; const int col = ev ? c2 : c2 + 1;
            const int wk = col * WY_LS + 8 * (tl >> 2) + (tl & 2), wo = col * WY_TS + (tl & ~1);
            *(LAS unsigned*)(BKT + wk) = ev ? ((bh & 0xffffu) | (bh_o << 16)) : ((bh_o >> 16) | (bh & 0xffff0000u));
            *(LAS unsigned*)(BKT + wk + 4) = ev ? ((kh & 0xffffu) | (kh_o << 16)) : ((kh_o >> 16) | (kh & 0xffff0000u));
            *(LAS unsigned*)(VT + wo) = ev ? ((vv & 0xffffu) | (vv_o << 16)) : ((vv_o >> 16) | (vv & 0xffff0000u)); }
        if (tl == 0) *(LAS f32x2*)(GC + c2) = (f32x2){__builtin_amdgcn_exp2f(tot.x), __builtin_amdgcn_exp2f(tot.y)};
    }
    __syncthreads();
    {
        asm volatile("" : "+v"(tid));
        const int fr = tid & 15, fq = (tid >> 4) & 3, m_ = wave >> 2, g_ = (wave + m_) & 3;
        if (m_ < nmc) {
            LAS unsigned char* ob = lds + WY_BASE + m_ * WY_BUF; LAS unsigned char* gs = lds + (m_ ? WY_G2 : WY_LAB);
            LAS float* Lab = (LAS float*)gs; LAS bf16* Lak = (LAS bf16*)(gs + 1024); LAS bf16* Mc = (LAS bf16*)(gs + 1024 + 16 * WY_LS * 2); LAS float* TT = (LAS float*)(gs + 1024 + 2 * 16 * WY_LS * 2);
            const LAS bf16* ab = (LAS bf16*)(ob + (g_ < 2 ? WY_AT : WY_RT)) + fr * WY_OS + fq * 8; const LAS bf16* bb = (LAS bf16*)(ob + ((g_ & 1) ? WY_KT : WY_BT)) + fr * WY_OS + fq * 8;
            f32x4 g = (f32x4){0.f, 0.f, 0.f, 0.f};
#pragma unroll
            for (int ks = 0; ks < 2; ++ks) g = __builtin_amdgcn_mfma_f32_16x16x32_bf16(*(const LAS bf16x8*)(bb + ks * 32), *(const LAS bf16x8*)(ab + ks * 32), g, 0, 0, 0);
#pragma unroll
            for (int rg = 0; rg < 4; ++rg) { const int tp = 4 * fq + rg; const bool keep = (g_ < 2) ? (fr > tp) : (fr >= tp); g[rg] = keep ? g[rg] : 0.f; }
            if (g_ == 0) {
                *(LAS f32x4*)(Lab + fr * 16 + 4 * fq) = g;
                LDS_WAIT();
                float u[16];
#pragma unroll
                for (int t = 0; t < 16; ++t) { if ((t & 3) == 0) asm volatile("" ::: "memory");
                    float acc = (t == fr) ? 1.0f : 0.0f;
#pragma unroll
                    for (int i4 = 0; i4 * 4 < t; ++i4) { const f32x4 l4 = *(const LAS f32x4*)(Lab + t * 16 + i4 * 4);
#pragma unroll
                        for (int e = 0; e < 4; ++e) if (i4 * 4 + e < t) acc += l4[e] * u[i4 * 4 + e]; }
                    u[t] = acc; }
                if (fq == 0) {
#pragma unroll
                    for (int t = 0; t < 16; ++t) TT[t * 16 + fr] = u[t]; }
            } else { v2u w; w.x = cvt_pk_bf16(g[0], g[1]); w.y = cvt_pk_bf16(g[2], g[3]);
                if (g_ == 1) { *(LAS v2u*)(Lak + fr * WY_LS + 8 * fq + 4) = w; *(LAS v2u*)(Lak + fr * WY_LS + 8 * fq) = (v2u){0u, 0u}; }
                else if (g_ == 2) *(LAS v2u*)(Mc + fr * WY_LS + 8 * fq) = w; else *(LAS v2u*)(Mc + fr * WY_LS + 8 * fq + 4) = w; }
        }
    }
    __syncthreads();
    if (MK_DBGSEL == 2 && part) return;
    for (int mc = 0; mc < nmc; ++mc) {
        asm volatile("" : "+v"(tid));
        const int fr = tid & 15, fq = (tid >> 4) & 3;
        LAS unsigned char* ob = lds + WY_BASE + mc * WY_BUF; LAS unsigned char* gs = lds + (mc ? WY_G2 : WY_LAB);
        LAS bf16* At = (LAS bf16*)(ob + WY_AT); LAS bf16* Rt = (LAS bf16*)(ob + WY_RT);
        LAS bf16* BKT = (LAS bf16*)(ob + WY_BK); LAS bf16* VT = (LAS bf16*)(ob + WY_VT); LAS float* GC = (LAS float*)(ob + WY_GC);
        LAS bf16* Lak = (LAS bf16*)(gs + 1024); LAS bf16* Mc = (LAS bf16*)(gs + 1024 + 16 * WY_LS * 2); LAS float* TT = (LAS float*)(gs + 1024 + 2 * 16 * WY_LS * 2);
        f32x4 W1 = (f32x4){0.f, 0.f, 0.f, 0.f}, Y0 = W1;
        {
            const LAS bf16* xbp = Xb + (16 * wave + fr) * WY_OS + fq * 8;
#pragma unroll
            for (int ks = 0; ks < 2; ++ks) { const bf16x8 bx = *(const LAS bf16x8*)(xbp + ks * 32);
                W1 = __builtin_amdgcn_mfma_f32_16x16x32_bf16(*(const LAS bf16x8*)(At + fr * WY_OS + ks * 32 + fq * 8), bx, W1, 0, 0, 0);
                Y0 = __builtin_amdgcn_mfma_f32_16x16x32_bf16(*(const LAS bf16x8*)(Rt + fr * WY_OS + ks * 32 + fq * 8), bx, Y0, 0, 0, 0); }
        }
        v2u vq = (v2u){0u, 0u};
        if (!pw) vq = *(const LAS v2u*)(VT + (16 * wave + fr) * WY_TS + 4 * fq);
        if (!pw) { v4u vb; vb.x = 0u; vb.y = 0u; vb.z = vq.x; vb.w = vq.y;
            W1 = __builtin_amdgcn_mfma_f32_16x16x32_bf16(*(const LAS bf16x8*)(Lak + fr * WY_LS + fq * 8), __builtin_bit_cast(bf16x8, vb), W1, 0, 0, 0); }
        f32x4 U = (f32x4){0.f, 0.f, 0.f, 0.f};
        if (!(MK_DBGSEL == 3 && part)) {
            const f32x4 tq = *(const LAS f32x4*)(TT + fr * 16 + 4 * fq);
#pragma unroll
            for (int kk = 0; kk < 4; ++kk) U = __builtin_amdgcn_mfma_f32_16x16x4f32(tq[kk], W1[kk], U, 0, 0, 0);
        } else U = W1;
        {
            v4u ucw; ucw.x = cvt_pk_bf16(U[0], U[1]); ucw.y = cvt_pk_bf16(U[2], U[3]); ucw.z = vq.x; ucw.w = vq.y;
            const bf16x8 uc = __builtin_bit_cast(bf16x8, ucw);
            Y0 = __builtin_amdgcn_mfma_f32_16x16x32_bf16(*(const LAS bf16x8*)(Mc + fr * WY_LS + fq * 8), uc, Y0, 0, 0, 0);
            LAS float* yo = (pw ? ZZ + 16 * (wave - 4) : YY + 16 * wave) + fr;
#pragma unroll
            for (int rg = 0; rg < 4; ++rg) yo[(mc * 16 + 4 * fq + rg) * 64] = Y0[rg];
#pragma unroll
            for (int j = 0; j < 4; ++j) {
                const bf16x8 bc = *(const LAS bf16x8*)(BKT + (16 * j + fr) * WY_LS + fq * 8);
                X[j] = X[j] * *(const LAS f32x4*)(GC + 16 * j + 4 * fq);
                X[j] = __builtin_amdgcn_mfma_f32_16x16x32_bf16(bc, uc, X[j], 0, 0, 0);
                v2u w; w.x = cvt_pk_bf16(X[j][0], X[j][1]); w.y = cvt_pk_bf16(X[j][2], X[j][3]);
                *(LAS v2u*)(Xb + (16 * wave + fr) * WY_OS + 16 * j + 4 * fq) = w; }
        }
        LDS_WAIT();
    }
}

#define P1_LOAD_PARAMS(HH) do { int lf_ = fr, lq_ = fq, lt_ = tid; asm volatile("" : "+v"(lf_), "+v"(lq_), "+v"(lt_));   \
        const int h_ = (HH), ncol_ = h_ * 64 + ntl * 16 + lf_; \
        _Pragma("unroll") for (int ks = 0; ks < 2; ++ks) { bw[ks] = *(const bf16x8*)(L2T + (size_t)ncol_ * 64 + lq_ * 8 + ks * 32); ba[ks] = *(const bf16x8*)(L2T + (size_t)512 * 64 + (size_t)ncol_ * 64 + lq_ * 8 + ks * 32); } \
        _Pragma("unroll") for (int ks = 0; ks < 4; ++ks) bg[ks] = *(const bf16x8*)(L2T + (size_t)1024 * 64 + (size_t)ncol_ * 128 + lq_ * 8 + ks * 32); \
        if (lt_ < 128) { const int a_ = lt_ >> 4, c_ = (lt_ & 15) * 4; \
            const float* src_ = a_ == 0 ? A.in[I_W0] : a_ == 1 ? A.in[I_A0] : a_ == 2 ? A.in[I_KK] : a_ == 3 ? A.in[I_KA] : a_ == 4 ? A.in[I_RK] : A.in[I_MURKV] + (a_ - 5) * 512; \
            *(LAS f32x4*)(PRM + a_ * 64 + c_) = *(const f32x4*)(src_ + h_ * 64 + c_); } } while (0)
__device__ __forceinline__ void scan_pass1(const Args& A, LAS unsigned char* lds, int tid, int lane, int wave, int vcu, int G, int part = 0) {
    bf16* GB = (bf16*)(A.ws + WS_A1) + (size_t)MPAD * 512;
    bf16* YL = (bf16*)(A.ws + WS_YL); bf16* ZT = (bf16*)(A.ws + WS_ZT); bf16* BV = (bf16*)(A.ws + WS_BV);
    LAS bf16* HIDB = (LAS bf16*)(lds + P1_SEQ);
    LAS float* LO = (LAS float*)(lds + P1_LO); LAS float* SEQ = (LAS float*)(lds + P1_SEQ);
    LAS float* YY = (LAS float*)(lds + P1_YY); LAS float* ZZ = (LAS float*)(lds + P1_ZZ);
    const bf16* L2T = (const bf16*)(A.ws + WS_L2T);
    const bool prow_wave = wave >= 4;
    const int mt = wave & 1, ntl = wave >> 1;
    int tt = tid >> 4, cs = tid & 15, c4 = cs * 4, fr = lane & 15, fq = lane >> 4;
    f32x4 X[4];
    bf16x8 bw[2], ba[2], bg[4];
    LAS float* PRM = (LAS float*)(lds + P1_GG);
    int cur_h = -1;
    int ui = 0, unit; if (!p1_unit_at(0, vcu, G, unit)) return;
    int t0 = 0; P1Pre pre; p1_load(A, unit, 0, tt, cs, pre);
    *(LAS v4u*)(HIDB + tt * HID_STRIDE + cs * 16) = pre.pa0; *(LAS v4u*)(HIDB + tt * HID_STRIDE + cs * 16 + 8) = pre.pa1;
    __syncthreads();
    for (;;) {
        { int lt_ = tid; asm volatile("" : "+v"(lt_)); tt = lt_ >> 4; cs = lt_ & 15; c4 = cs * 4; fr = lt_ & 15; fq = (lt_ >> 4) & 3; }
        bool prompt; int b, h, ch, T, rowbase; p1_decode(unit, prompt, b, h, ch, T, rowbase);
        const int hc = h * 64 + c4;
        if (t0 == 0 && G == 256 && ui < 8) {
            const size_t i16 = ((size_t)(ui * 256 + vcu) * NTHR + tid) * 16;
            cvt16_fp8_sliced(A.in[I_U], A.ws + WS_UB, PEER_SU, i16); cvt16_fp8_sliced(A.in[I_V], A.ws + WS_VB, PEER_SV, i16); }
        if (t0 == 0) {
            LAS bf16* Xb = (LAS bf16*)(lds + WY_XB);
#pragma unroll
            for (int j = 0; j < 4; ++j) { const int prow_ = 16 * (wave - 4) + fr, c0_ = 16 * j + 4 * fq;
#pragma unroll
                for (int e = 0; e < 4; ++e) X[j][e] = (prow_wave && prow_ == c0_ + e) ? 1.f : 0.f;
                v2u w; w.x = cvt_pk_bf16(X[j][0], X[j][1]); w.y = cvt_pk_bf16(X[j][2], X[j][3]);
                *(LAS v2u*)(Xb + (16 * wave + fr) * WY_OS + c0_) = w; }
        }
        if (h != cur_h) { cur_h = h; P1_LOAD_PARAMS(h); }
        size_t row, prow; bool hasprev; int nb; p1_rows(unit, t0, tt, row, prow, hasprev, nb);
        if (!(MK_DBGSEL == 5 && part)) {
            const LAS bf16* ap = HIDB + (mt * 16 + fr) * HID_STRIDE + fq * 8;
            f32x4 cw = (f32x4){0.f, 0.f, 0.f, 0.f}, ca = cw, cg = cw;
#pragma unroll
            for (int ks = 0; ks < 2; ++ks) { cw = __builtin_amdgcn_mfma_f32_16x16x32_bf16(*(const LAS bf16x8*)(ap + ks * 32), bw[ks], cw, 0, 0, 0);
                                             ca = __builtin_amdgcn_mfma_f32_16x16x32_bf16(*(const LAS bf16x8*)(ap + 64 + ks * 32), ba[ks], ca, 0, 0, 0); }
#pragma unroll
            for (int ks = 0; ks < 4; ++ks) cg = __builtin_amdgcn_mfma_f32_16x16x32_bf16(*(const LAS bf16x8*)(ap + 128 + ks * 32), bg[ks], cg, 0, 0, 0);
#pragma unroll
            for (int rg = 0; rg < 4; ++rg) { const int o = (mt * 16 + fq * 4 + rg) * 64 + ntl * 16 + fr; LO[o] = cw[rg]; LO[2048 + o] = ca[rg]; LO[4096 + o] = cg[rg]; }
        }
        __syncthreads();
        if (!(MK_DBGSEL == 5 && part)) {
            const f32x4 w0v = *(const LAS f32x4*)(PRM + c4), a0v = *(const LAS f32x4*)(PRM + 64 + c4), kkv = *(const LAS f32x4*)(PRM + 128 + c4), kav = *(const LAS f32x4*)(PRM + 192 + c4),
                        rkv = *(const LAS f32x4*)(PRM + 256 + c4), mur = *(const LAS f32x4*)(PRM + 320 + c4), muk = *(const LAS f32x4*)(PRM + 384 + c4), muv = *(const LAS f32x4*)(PRM + 448 + c4);
            const f32x4 aw = w0v + *(const LAS f32x4*)(LO + tt * 64 + c4), aa = a0v + *(const LAS f32x4*)(LO + 2048 + tt * 64 + c4), ag = *(const LAS f32x4*)(LO + 4096 + tt * 64 + c4);
            f32x4 r = (f32x4){bf_lo(pre.zr.x), bf_hi(pre.zr.x), bf_lo(pre.zr.y), bf_hi(pre.zr.y)}, k = (f32x4){bf_lo(pre.zk.x), bf_hi(pre.zk.x), bf_lo(pre.zk.y), bf_hi(pre.zk.y)},
                  v = (f32x4){bf_lo(pre.zv.x), bf_hi(pre.zv.x), bf_lo(pre.zv.y), bf_hi(pre.zv.y)};
            const f32x4 rpv = (f32x4){bf_lo(pre.pr.x), bf_hi(pre.pr.x), bf_lo(pre.pr.y), bf_hi(pre.pr.y)}, kpv = (f32x4){bf_lo(pre.pk.x), bf_hi(pre.pk.x), bf_lo(pre.pk.y), bf_hi(pre.pk.y)},
                        vpv = (f32x4){bf_lo(pre.pv.x), bf_hi(pre.pv.x), bf_lo(pre.pv.y), bf_hi(pre.pv.y)};
            r = r + mur * (rpv - r); k = k + muk * (kpv - k); v = v + muv * (vpv - v);
            f32x4 dec, asg, kk, km, av, bv;
            float ssq = 0.f, bon = 0.f;
#pragma unroll
            for (int i = 0; i < 4; ++i) {
                dec[i] = -0.87503877491453f * sigm(aw[i]);
                asg[i] = sigm(aa[i]);
                kk[i] = k[i] * kkv[i]; ssq += kk[i] * kk[i];
                km[i] = k[i] * (1.0f + (asg[i] - 1.0f) * kav[i]);
                bon += r[i] * km[i] * rkv[i];
            }
            ssq = sum16(ssq); bon = sum16(bon);
            const float inv = fminf(__builtin_amdgcn_rsqf(ssq), 1e12f);
#pragma unroll
            for (int i = 0; i < 4; ++i) { kk[i] *= inv; av[i] = -kk[i]; bv[i] = kk[i] * asg[i]; }
            LAS float* sq_ = SEQ + tt * 384 + c4;
            *(LAS f32x4*)(sq_) = av; *(LAS f32x4*)(sq_ + 64) = dec; *(LAS f32x4*)(sq_ + 128) = bv; *(LAS f32x4*)(sq_ + 192) = km; *(LAS f32x4*)(sq_ + 256) = r; *(LAS f32x4*)(sq_ + 320) = v;
            if (tt < nb) {
                v2u w; w.x = cvt_pk_bf16(ag[0], ag[1]); w.y = cvt_pk_bf16(ag[2], ag[3]); *(v2u*)(GB + row * 512 + hc) = w;
                w.x = cvt_pk_bf16(bon * v[0], bon * v[1]); w.y = cvt_pk_bf16(bon * v[2], bon * v[3]); *(v2u*)(BV + row * 512 + hc) = w;
            }
        }
        int nunit = unit, nt0 = t0 + SC_TB, nui = ui; bool more = true;
        if (nt0 >= T) { nt0 = 0; nui = ui + 1; more = p1_unit_at(nui, vcu, G, nunit); }
        if (more) p1_load(A, nunit, nt0, tt, cs, pre);
        __syncthreads();
        if (!(MK_DBGSEL == 1 && part)) p1_wy(X, SEQ, YY, ZZ, lds, nb, tid, lane, wave, part);
        if (more) { *(LAS v4u*)(HIDB + tt * HID_STRIDE + cs * 16) = pre.pa0; *(LAS v4u*)(HIDB + tt * HID_STRIDE + cs * 16 + 8) = pre.pa1; }
        __syncthreads();
        if (tt < nb) {
            const f32x4 y = *(const LAS f32x4*)(YY + tt * 64 + c4), z = *(const LAS f32x4*)(ZZ + tt * 64 + c4);
            v2u w; w.x = cvt_pk_bf16(y[0], y[1]); w.y = cvt_pk_bf16(y[2], y[3]); *(v2u*)(YL + row * 512 + hc) = w;
            w.x = cvt_pk_bf16(z[0], z[1]); w.y = cvt_pk_bf16(z[2], z[3]); *(v2u*)(ZT + row * 512 + hc) = w;
        }
        if (t0 + SC_TB >= T) {
#pragma unroll
            for (int j = 0; j < 4; ++j) {
                if (!prow_wave) *(f32x4*)((float*)A.out + (size_t)unit * 4096 + (16 * wave + fr) * 64 + 16 * j + 4 * fq) = X[j];
                else { bf16* mt = (bf16*)((unsigned char*)A.out + OB_MB) + (size_t)unit * 4096 + (16 * j + 4 * fq) * 64 + 16 * (wave - 4) + fr;
                    const unsigned p01 = cvt_pk_bf16(X[j][0], X[j][1]), p23 = cvt_pk_bf16(X[j][2], X[j][3]);
                    mt[0] = (bf16)(p01 & 0xffffu); mt[64] = (bf16)(p01 >> 16); mt[128] = (bf16)(p23 & 0xffffu); mt[192] = (bf16)(p23 >> 16); }
            }
        }
        if (!more) break;
        unit = nunit; t0 = nt0; ui = nui;
    }
    __syncthreads();
}

constexpr int P2_SS = 72, P2_LO = 16 * P2_SS * 2, P2_BUF = 2 * P2_LO;
__device__ __forceinline__ void scan_pass2_rows(const float* Sinit, int unit0, int nchunks, int v0, float* outfin, bool slots, const Args& A, LAS unsigned char* lds, int tid, int lane, int wave) {
    LAS bf16* Shi = (LAS bf16*)lds; LAS bf16* Slo = (LAS bf16*)(lds + P2_LO);
    const int nt = wave & 3, fr = lane & 15, fq = lane >> 4; const bool act = wave < 4;
    float* NB = (float*)A.out; const bf16* MT = (const bf16*)((const unsigned char*)A.out + OB_MB);
    { const int idx = tid * 2, row = idx >> 6, col = idx & 63;
      const f32x2 s0 = Sinit ? *(const f32x2*)(Sinit + (size_t)(v0 + row) * 64 + col) : (f32x2){0.f, 0.f};
      const unsigned hi = cvt_pk_bf16(s0.x, s0.y);
      *(LAS unsigned*)(Shi + row * P2_SS + col) = hi; *(LAS unsigned*)(Slo + row * P2_SS + col) = cvt_pk_bf16(s0.x - bf_lo(hi), s0.y - bf_hi(hi)); }
    bf16x8 mr[4][2]; f32x4 nr[4];
    const size_t moff = (size_t)(16 * nt + fr) * 64 + fq * 8, noff = (size_t)(v0 + fr) * 64 + 16 * nt + 4 * fq;
#pragma unroll
    for (int d = 0; d < 4; ++d) {
        mr[d][0] = (bf16x8){0, 0, 0, 0, 0, 0, 0, 0}; mr[d][1] = mr[d][0]; nr[d] = (f32x4){0.f, 0.f, 0.f, 0.f};
        { const int cc = d < nchunks ? d : nchunks - 1;
            mr[d][0] = *(const bf16x8*)(MT + (size_t)(unit0 + cc) * 4096 + moff); mr[d][1] = *(const bf16x8*)(MT + (size_t)(unit0 + cc) * 4096 + moff + 32);
            nr[d] = *(const f32x4*)(NB + (size_t)(unit0 + cc) * 4096 + noff); }
    }
    f32x4 acc = (f32x4){0.f, 0.f, 0.f, 0.f};
    __syncthreads();
    for (int c0 = 0; c0 < nchunks; c0 += 4) {
#pragma unroll
        for (int d = 0; d < 4; ++d) {
            const int c = c0 + d;
            if (c < nchunks) {
                {
                    LAS bf16* Shi = (LAS bf16*)(lds + (d & 1) * P2_BUF); LAS bf16* Slo = (LAS bf16*)(lds + (d & 1) * P2_BUF + P2_LO);
                    const bf16x8 sh0 = *(const LAS bf16x8*)(Shi + fr * P2_SS + fq * 8), sh1 = *(const LAS bf16x8*)(Shi + fr * P2_SS + 32 + fq * 8),
                                 sl0 = *(const LAS bf16x8*)(Slo + fr * P2_SS + fq * 8), sl1 = *(const LAS bf16x8*)(Slo + fr * P2_SS + 32 + fq * 8);
                    acc = nr[d];
                    acc = __builtin_amdgcn_mfma_f32_16x16x32_bf16(mr[d][0], sh0, acc, 0, 0, 0); acc = __builtin_amdgcn_mfma_f32_16x16x32_bf16(mr[d][1], sh1, acc, 0, 0, 0);
                    acc = __builtin_amdgcn_mfma_f32_16x16x32_bf16(mr[d][0], sl0, acc, 0, 0, 0); acc = __builtin_amdgcn_mfma_f32_16x16x32_bf16(mr[d][1], sl1, acc, 0, 0, 0);
                    const int cn = c + 4 < nchunks ? c + 4 : nchunks - 1;
                    mr[d][0] = *(const bf16x8*)(MT + (size_t)(unit0 + cn) * 4096 + moff); mr[d][1] = *(const bf16x8*)(MT + (size_t)(unit0 + cn) * 4096 + moff + 32);
                    nr[d] = *(const f32x4*)(NB + (size_t)(unit0 + cn) * 4096 + noff);
                }
                if (act) {
                    LAS bf16* Shi = (LAS bf16*)(lds + ((d + 1) & 1) * P2_BUF); LAS bf16* Slo = (LAS bf16*)(lds + ((d + 1) & 1) * P2_BUF + P2_LO);
                    v2u hi; hi.x = cvt_pk_bf16(acc[0], acc[1]); hi.y = cvt_pk_bf16(acc[2], acc[3]);
                    v2u lo; lo.x = cvt_pk_bf16(acc[0] - bf_lo(hi.x), acc[1] - bf_hi(hi.x)); lo.y = cvt_pk_bf16(acc[2] - bf_lo(hi.y), acc[3] - bf_hi(hi.y));
                    *(LAS v2u*)(Shi + fr * P2_SS + 16 * nt + 4 * fq) = hi; *(LAS v2u*)(Slo + fr * P2_SS + 16 * nt + 4 * fq) = lo;
                    if (slots) *(v2u*)((bf16*)(NB + (size_t)(unit0 + c) * 4096) + (size_t)(v0 + fr) * 128 + 16 * nt + 4 * fq) = hi;
                }
                __syncthreads();
            }
        }
    }
    if (act) *(f32x4*)(outfin + noff) = acc;
    __syncthreads();
}

__device__ __forceinline__ void scan_pass2_sample(const float* Sinit, int unit, float* outfin, const Args& A, int lane, int wave) {
    const int fr = lane & 15, fq = lane >> 4, rt = wave >> 1;
    const float* NB = (const float*)A.out + (size_t)unit * 4096; const bf16* MT = (const bf16*)((const unsigned char*)A.out + OB_MB) + (size_t)unit * 4096;
    f32x4 sv[2][2];
#pragma unroll
    for (int ks = 0; ks < 2; ++ks) { const float* sp = Sinit + (size_t)(16 * rt + fr) * 64 + 32 * ks + 8 * fq; sv[ks][0] = *(const f32x4*)sp; sv[ks][1] = *(const f32x4*)(sp + 4); }
    bf16x8 mt[2][2]; f32x4 acc[2];
#pragma unroll
    for (int t = 0; t < 2; ++t) { const int nt = 2 * (wave & 1) + t;
        mt[t][0] = *(const bf16x8*)(MT + (size_t)(16 * nt + fr) * 64 + fq * 8); mt[t][1] = *(const bf16x8*)(MT + (size_t)(16 * nt + fr) * 64 + 32 + fq * 8);
        acc[t] = *(const f32x4*)(NB + (size_t)(16 * rt + fr) * 64 + 16 * nt + 4 * fq); }
    bf16x8 sh[2], sl[2];
#pragma unroll
    for (int ks = 0; ks < 2; ++ks) { const f32x4 a = sv[ks][0], b = sv[ks][1];
        v4u h; h.x = cvt_pk_bf16(a[0], a[1]); h.y = cvt_pk_bf16(a[2], a[3]); h.z = cvt_pk_bf16(b[0], b[1]); h.w = cvt_pk_bf16(b[2], b[3]);
        v4u l; l.x = cvt_pk_bf16(a[0] - bf_lo(h.x), a[1] - bf_hi(h.x)); l.y = cvt_pk_bf16(a[2] - bf_lo(h.y), a[3] - bf_hi(h.y));
        l.z = cvt_pk_bf16(b[0] - bf_lo(h.z), b[1] - bf_hi(h.z)); l.w = cvt_pk_bf16(b[2] - bf_lo(h.w), b[3] - bf_hi(h.w));
        sh[ks] = __builtin_bit_cast(bf16x8, h); sl[ks] = __builtin_bit_cast(bf16x8, l);
        if ((wave & 1) == 0) *(v4u*)((bf16*)((unsigned char*)A.out + OB_S0S) + (size_t)(unit - NUNITS_P) * 4096 + (size_t)(16 * rt + fr) * 64 + 32 * ks + 8 * fq) = h; }
#pragma unroll
    for (int t = 0; t < 2; ++t) { const int nt = 2 * (wave & 1) + t;
#pragma unroll
        for (int ks = 0; ks < 2; ++ks) { acc[t] = __builtin_amdgcn_mfma_f32_16x16x32_bf16(mt[t][ks], sh[ks], acc[t], 0, 0, 0); acc[t] = __builtin_amdgcn_mfma_f32_16x16x32_bf16(mt[t][ks], sl[ks], acc[t], 0, 0, 0); }
        *(f32x4*)(outfin + (size_t)(16 * rt + fr) * 64 + 16 * nt + 4 * fq) = acc[t]; }
}

__device__ __forceinline__ void scan_pass3_wave(const Args& A, int unit, int wq, int lane) {
    const bool prompt = unit < NUNITS_P;
    const int b = prompt ? unit >> 9 : (unit - NUNITS_P) >> 3, h = prompt ? (unit >> 6) & 7 : unit & 7, ch = prompt ? unit & 63 : 0;
    const int T = prompt ? 64 : SEQ_S, rowbase = prompt ? b * SEQ_P + ch * 64 : NPROMPT + b * SEQ_S;
    if (wq * 16 >= T) return;
    const bf16* S0 = prompt ? (ch > 0 ? (const bf16*)((const float*)A.out + (size_t)(unit - 1) * 4096) : (const bf16*)(A.ws + WS_CTL + 49152)) : (const bf16*)((const unsigned char*)A.out + OB_S0S) + (size_t)(b * 8 + h) * 4096;
    const int spitch = prompt ? 128 : 64;
    const bf16* ZT = (const bf16*)(A.ws + WS_ZT); const bf16* YL = (const bf16*)(A.ws + WS_YL); const bf16* BV = (const bf16*)(A.ws + WS_BV);
    bf16* YB = (bf16*)(A.ws + WS_A1) + (size_t)MPAD * 512;
    const int fr = lane & 15, fq = lane >> 4;
    const size_t row = (size_t)(rowbase + wq * 16 + fr);
    bf16x8 bz[2], sa[4][2]; v2u yl[4], bvw[4], gg[4]; f32x4 gw[4], gb[4];
#pragma unroll
    for (int ks = 0; ks < 2; ++ks) bz[ks] = *(const bf16x8*)(ZT + row * 512 + h * 64 + ks * 32 + fq * 8);
#pragma unroll
    for (int mt = 0; mt < 4; ++mt)
#pragma unroll
        for (int ks = 0; ks < 2; ++ks) sa[mt][ks] = *(const bf16x8*)(S0 + (size_t)(mt * 16 + fr) * spitch + ks * 32 + fq * 8);
#pragma unroll
    for (int mt = 0; mt < 4; ++mt) { const int c = h * 64 + mt * 16 + fq * 4;
        yl[mt] = *(const v2u*)(YL + row * 512 + c); bvw[mt] = *(const v2u*)(BV + row * 512 + c); gg[mt] = *(const v2u*)(YB + row * 512 + c);
        gw[mt] = *(const f32x4*)(A.in[I_GNW] + c); gb[mt] = *(const f32x4*)(A.in[I_GNB] + c); }
    f32x4 acc[4];
#pragma unroll
    for (int mt = 0; mt < 4; ++mt) { acc[mt] = (f32x4){0.f, 0.f, 0.f, 0.f};
#pragma unroll
        for (int ks = 0; ks < 2; ++ks) acc[mt] = __builtin_amdgcn_mfma_f32_16x16x32_bf16(sa[mt][ks], bz[ks], acc[mt], 0, 0, 0); }
    float sm = 0.f;
#pragma unroll
    for (int mt = 0; mt < 4; ++mt) { const v2u y = yl[mt];
        acc[mt][0] += bf_lo(y.x); acc[mt][1] += bf_hi(y.x); acc[mt][2] += bf_lo(y.y); acc[mt][3] += bf_hi(y.y);
        sm += (acc[mt][0] + acc[mt][1]) + (acc[mt][2] + acc[mt][3]); }
    sm += __shfl_xor(sm, 16); sm += __shfl_xor(sm, 32);
    const float mean = sm * (1.f / 64.f); float sv = 0.f;
#pragma unroll
    for (int mt = 0; mt < 4; ++mt) { acc[mt] = acc[mt] - mean; sv += (acc[mt][0] * acc[mt][0] + acc[mt][1] * acc[mt][1]) + (acc[mt][2] * acc[mt][2] + acc[mt][3] * acc[mt][3]); }
    sv += __shfl_xor(sv, 16); sv += __shfl_xor(sv, 32);
    const float rs = __builtin_amdgcn_rsqf(sv * (1.f / 64.f) + 64e-5f);
#pragma unroll
    for (int mt = 0; mt < 4; ++mt) { const int c = h * 64 + mt * 16 + fq * 4;
        f32x4 o = acc[mt] * rs * gw[mt] + gb[mt] + (f32x4){bf_lo(bvw[mt].x), bf_hi(bvw[mt].x), bf_lo(bvw[mt].y), bf_hi(bvw[mt].y)};
        o = o * (f32x4){bf_lo(gg[mt].x), bf_hi(gg[mt].x), bf_lo(gg[mt].y), bf_hi(gg[mt].y)};
        v2u w; w.x = cvt_pk_bf16(o[0], o[1]); w.y = cvt_pk_bf16(o[2], o[3]); *(v2u*)(YB + row * 512 + c) = w; }
}

__device__ __forceinline__ void tk_insert(float (&tv)[16], float x) {
#pragma unroll
    for (int i = 15; i >= 1; --i) tv[i] = __builtin_amdgcn_fmed3f(tv[i - 1], x, tv[i]);
    tv[0] = __builtin_fmaxf(tv[0], x);
}
#define TK_CE(t, i, j) { const float a_ = __builtin_fmaxf(t[i], t[j]); t[j] = __builtin_fminf(t[i], t[j]); t[i] = a_; }
__device__ __forceinline__ void tk_sort16(float (&t)[16]) {
    TK_CE(t, 0, 1) TK_CE(t, 2, 3) TK_CE(t, 0, 2) TK_CE(t, 1, 3) TK_CE(t, 1, 2) TK_CE(t, 4, 5) TK_CE(t, 6, 7) TK_CE(t, 4, 6) TK_CE(t, 5, 7) TK_CE(t, 5, 6) TK_CE(t, 0, 4) TK_CE(t, 2, 6) TK_CE(t, 2, 4) TK_CE(t, 1, 5) TK_CE(t, 3, 7) TK_CE(t, 3, 5) TK_CE(t, 1, 2) TK_CE(t, 3, 4) TK_CE(t, 5, 6) TK_CE(t, 8, 9) TK_CE(t, 10, 11) TK_CE(t, 8, 10) TK_CE(t, 9, 11) TK_CE(t, 9, 10) TK_CE(t, 12, 13) TK_CE(t, 14, 15) TK_CE(t, 12, 14) TK_CE(t, 13, 15) TK_CE(t, 13, 14) TK_CE(t, 8, 12) TK_CE(t, 10, 14) TK_CE(t, 10, 12) TK_CE(t, 9, 13) TK_CE(t, 11, 15) TK_CE(t, 11, 13) TK_CE(t, 9, 10) TK_CE(t, 11, 12) TK_CE(t, 13, 14) TK_CE(t, 0, 8) TK_CE(t, 4, 12) TK_CE(t, 4, 8) TK_CE(t, 2, 10) TK_CE(t, 6, 14) TK_CE(t, 6, 10) TK_CE(t, 2, 4) TK_CE(t, 6, 8) TK_CE(t, 10, 12) TK_CE(t, 1, 9) TK_CE(t, 5, 13) TK_CE(t, 5, 9) TK_CE(t, 3, 11) TK_CE(t, 7, 15) TK_CE(t, 7, 11) TK_CE(t, 3, 5) TK_CE(t, 7, 9) TK_CE(t, 11, 13) TK_CE(t, 1, 2) TK_CE(t, 3, 4) TK_CE(t, 5, 6) TK_CE(t, 7, 8) TK_CE(t, 9, 10) TK_CE(t, 11, 12) TK_CE(t, 13, 14)
}
__device__ __forceinline__ void tk_merge16(float (&tv)[16], const float (&g)[16]) {
#pragma unroll
    for (int i = 0; i < 16; ++i) tv[i] = __builtin_fmaxf(tv[i], g[15 - i]);
#pragma unroll
    for (int s = 8; s >= 1; s >>= 1)
#pragma unroll
        for (int i = 0; i < 16; ++i) if ((i & s) == 0) TK_CE(tv, i, i + s)
}
__device__ __forceinline__ float gelu_tanh(float x) {
    const float u = 0.7978845608028654f * (x + 0.044715f * x * x * x);
    const float th = 1.0f - 2.0f * __builtin_amdgcn_rcpf(__expf(2.0f * u) + 1.0f);
    return 0.5f * x * (1.0f + th);
}
constexpr int NTILE32 = NTOK / 32;
constexpr int CW_QU = 8192, CW_QV = 8192 + 512;

constexpr int TK_STRIDE = 68, TK_BYTES = 64 * TK_STRIDE * 4;
__device__ __forceinline__ void topk_scores64(const bf16* Q, const bf16* KB, LAS float* SC, int t0, int hp, int p, int half, int lane, const bf16x8 (&af)[2][2][4]) {
    const int fr = lane & 15, fq = lane >> 4;
#pragma unroll
    for (int hs = 0; hs < 2; ++hs) {
        const bf16* kbase = KB + (size_t)(((hp + 4 * hs) * 2 + p) * 128 + half * 64 + fr) * 128 + fq * 8;
#pragma unroll
        for (int n = 0; n < 4; ++n) {
            bf16x8 bfr[4];
#pragma unroll
            for (int ks = 0; ks < 4; ++ks) bfr[ks] = *(const bf16x8*)(kbase + (size_t)n * 16 * 128 + ks * 32);
            f32x4 acc0 = (f32x4){0.f, 0.f, 0.f, 0.f}, acc1 = acc0;
#pragma unroll
            for (int ks = 0; ks < 4; ++ks) { acc0 = __builtin_amdgcn_mfma_f32_16x16x32_bf16(af[hs][0][ks], bfr[ks], acc0, 0, 0, 0); acc1 = __builtin_amdgcn_mfma_f32_16x16x32_bf16(af[hs][1][ks], bfr[ks], acc1, 0, 0, 0); }
#pragma unroll
            for (int rg = 0; rg < 4; ++rg) { SC[(hs * 32 + fq * 4 + rg) * TK_STRIDE + n * 16 + fr] = acc0[rg]; SC[(hs * 32 + 16 + fq * 4 + rg) * TK_STRIDE + n * 16 + fr] = acc1[rg]; }
        }
    }
}
constexpr int TK_NPROMPT_UNITS = (NPROMPT / 32) * 4, TK_NSAMPLE_UNITS = (NSAMP / 32) * 4, CW_TKS = 9792;
__device__ __forceinline__ void peer_topk_units(const Args& A, LAS unsigned char* lds, int lane, int wave, int u_first, int u_end, int u_step) {
    const bf16* Q = (const bf16*)(A.ws + WS_ZG); const bf16* KB = (const bf16*)(A.ws + WS_KEYS); const float* SSP = (const float*)(A.ws + WS_SSP);
    unsigned short* EIDX = (unsigned short*)(A.ws + WS_EIDX); float* GATE = (float*)(A.ws + WS_GATE); float* RSTD = (float*)(A.ws + WS_RSTD);
    LAS float* SC = (LAS float*)(lds + wave * TK_BYTES);
    const int fr = lane & 15, fq = lane >> 4, tokl = lane & 31, hsel = lane >> 5;
    for (int u = u_first; u < u_end; u += u_step) {
        const int t0 = (u >> 2) * 32, hp = u & 3, h = hp + 4 * hsel;
        const float* sp = SSP + (size_t)(t0 + tokl) * 16;
        const f32x4 s0 = *(const f32x4*)sp, s1 = *(const f32x4*)(sp + 4), s2 = *(const f32x4*)(sp + 8), s3 = *(const f32x4*)(sp + 12);
        const float ssq = ((s0[0] + s0[1]) + (s0[2] + s0[3])) + ((s1[0] + s1[1]) + (s1[2] + s1[3])) + ((s2[0] + s2[1]) + (s2[2] + s2[3])) + ((s3[0] + s3[1]) + (s3[2] + s3[3]));
        const float rstd = __builtin_amdgcn_rsqf(ssq * (1.f / DM) + 1e-6f);
        float tv0[16], tv1[16], cv[16];
#pragma unroll
        for (int p = 0; p < 2; ++p) {
            bf16x8 af[2][2][4];
#pragma unroll
            for (int hs = 0; hs < 2; ++hs)
#pragma unroll
                for (int mt = 0; mt < 2; ++mt) { const bf16* qp = Q + (size_t)(t0 + mt * 16 + fr) * 2048 + (hp + 4 * hs) * 256 + p * 128 + fq * 8;
#pragma unroll
                    for (int ks = 0; ks < 4; ++ks) af[hs][mt][ks] = *(const bf16x8*)(qp + ks * 32); }
            float tv[16];
#pragma unroll
            for (int i = 0; i < 16; ++i) tv[i] = -3.0e38f;
            for (int half = 0; half < 2; ++half) {
                topk_scores64(Q, KB, SC, t0, hp, p, half, lane, af);
                LDS_WAIT();
                const LAS float* mine = SC + lane * TK_STRIDE;
                unsigned kmask = 0xFFFFFF80u; asm volatile("" : "+v"(kmask));
#pragma unroll 1
                for (int n = 0; n < 64; n += 16) {
                    float g[16];
#pragma unroll
                    for (int q = 0; q < 4; ++q) { const f32x4 x4 = *(const LAS f32x4*)(mine + n + 4 * q);
#pragma unroll
                        for (int e = 0; e < 4; ++e) g[4 * q + e] = __uint_as_float((__float_as_uint(x4[e]) & kmask) | (unsigned)(half * 64 + n + 4 * q + e)); }
                    tk_sort16(g); tk_merge16(tv, g);
                }
                LDS_WAIT();
            }
#pragma unroll
            for (int i = 0; i < 16; ++i) { if (p == 0) tv0[i] = tv[i]; else tv1[i] = tv[i]; }
        }
        LAS int* li = (LAS int*)SC + lane * 33;
#pragma unroll
        for (int q = 0; q < 16; ++q) { li[q] = (int)(__float_as_uint(tv0[q]) & 127u); li[16 + q] = (int)(__float_as_uint(tv1[q]) & 127u);
            tv0[q] = __uint_as_float(__float_as_uint(tv0[q]) & 0xFFFFFF80u); tv1[q] = __uint_as_float(__float_as_uint(tv1[q]) & 0xFFFFFF80u); }
#pragma unroll
        for (int q = 0; q < 16; ++q) cv[q] = -3.0e38f;
#pragma unroll
        for (int a = 0; a < 16; ++a)
#pragma unroll
            for (int b = 0; b < 16; ++b) if ((a + 1) * (b + 1) <= 16)
                tk_insert(cv, __uint_as_float((__float_as_uint(tv0[a] + tv1[b]) & 0xFFFFFF00u) | (unsigned)(a * 16 + b)));
        LDS_WAIT();
        float e[16], den = 0.f; unsigned ci[16];
        const float c0 = __uint_as_float(__float_as_uint(cv[0]) & 0xFFFFFF00u);
#pragma unroll
        for (int q = 0; q < 16; ++q) { const unsigned kb = __float_as_uint(cv[q]); const float cq = __uint_as_float(kb & 0xFFFFFF00u);
            e[q] = __expf((cq - c0) * rstd); den += e[q]; ci[q] = (unsigned)(li[(kb >> 4) & 15] * 128 + li[16 + (kb & 15)]); }
        const float inv = __builtin_amdgcn_rcpf(den);
        LDS_WAIT();
        {
            const size_t tok = (size_t)(t0 + tokl);
            v4u w0, w1; w0.x = ci[0] | (ci[1] << 16); w0.y = ci[2] | (ci[3] << 16); w0.z = ci[4] | (ci[5] << 16); w0.w = ci[6] | (ci[7] << 16);
            w1.x = ci[8] | (ci[9] << 16); w1.y = ci[10] | (ci[11] << 16); w1.z = ci[12] | (ci[13] << 16); w1.w = ci[14] | (ci[15] << 16);
            *(v4u*)(EIDX + tok * 128 + h * 16) = w0; *(v4u*)(EIDX + tok * 128 + h * 16 + 8) = w1;
#pragma unroll
            for (int q = 0; q < 4; ++q) *(f32x4*)(GATE + tok * 128 + h * 16 + 4 * q) = (f32x4){e[4 * q] * inv, e[4 * q + 1] * inv, e[4 * q + 2] * inv, e[4 * q + 3] * inv};
            if (h == 0) RSTD[tok] = rstd;
        }
    }
}

__device__ __forceinline__ bool peer_topk_split(int G) { return G == 256; }
__device__ __forceinline__ void peer_topk_phase(const Args& A, LAS unsigned char* lds, int tid, int lane, int wave, int vcu, int G) {
    peer_topk_units(A, lds, lane, wave, wave * G + vcu, peer_topk_split(G) ? TK_NPROMPT_UNITS : TK_NPROMPT_UNITS + TK_NSAMPLE_UNITS, G * NWAVES);
}
__device__ __forceinline__ void peer_topk_sample_prelude(const Args& A, LAS unsigned char* lds, int tid, int lane, int wave, int vcu, int G, gu32* ctl) {
    if (!peer_topk_split(G) || (vcu & 31) != 0) return;
    peer_topk_units(A, lds, lane, wave, TK_NPROMPT_UNITS + (vcu >> 5) * NWAVES + wave, TK_NPROMPT_UNITS + TK_NSAMPLE_UNITS, TK_NSAMPLE_UNITS);
    asm volatile("s_waitcnt vmcnt(0)" ::: "memory");
    __syncthreads();
    if (tid == 0) { __builtin_amdgcn_fence(__ATOMIC_RELEASE, "agent"); asm volatile("s_waitcnt vmcnt(0)" ::: "memory"); (void)__hip_atomic_fetch_add((unsigned*)(ctl + CW_TKS), 1u, RLX_AGENT); }
    __syncthreads();
}
__device__ __forceinline__ void peer_topk_sample_wait(gu32* ctl, int tid) {
    if (tid == 0) {
        unsigned sp = 0;
        while (__hip_atomic_load((unsigned*)(ctl + CW_TKS), RLX_AGENT) < (unsigned)(TK_NSAMPLE_UNITS / NWAVES)) { __builtin_amdgcn_s_sleep(2); if (++sp > (1u << 22)) break; }
        __builtin_amdgcn_fence(__ATOMIC_ACQUIRE, "agent");
        asm volatile("s_waitcnt vmcnt(0)" ::: "memory");
    }
    __syncthreads();
}

constexpr int PEER_ITEM = 80, NITEM128 = NTOK / PEER_ITEM;
__device__ __forceinline__ bool peer_next_item(gu32* qbase, int xcc, int& qs, int& slice, int& item, LAS unsigned char* lds, int tid) {
    LAS int* box = (LAS int*)(lds + LDSCTL_OFF + 64);
    for (;;) {
        if (qs >= 8) return false;
        slice = (xcc + qs) & 7;
        if (tid == 0) box[0] = (int)__hip_atomic_fetch_add((unsigned*)(qbase + 64 * slice), 1u, RLX_AGENT);
        __syncthreads();
        item = box[0];
        __syncthreads();
        if (item < NITEM128) return true;
        ++qs;
    }
}

typedef long i64_t;
constexpr float PEER_SX = 1.0f;
constexpr int U_TILE0 = 8192, U_TILEB = 16384;
__device__ __forceinline__ i64_t mk64(unsigned lo, unsigned hi) { return (i64_t)(((unsigned long long)hi << 32) | (unsigned long long)lo); }
__device__ __forceinline__ void peer_u_phase(const Args& A, LAS unsigned char* lds, int tid, int lane, int wave, gu32* ctl, int qoff) {
    const unsigned char* Uq = A.ws + WS_UB; const bf16* XG = (const bf16*)(A.ws + WS_A1);
    const unsigned short* EIDX = (const unsigned short*)(A.ws + WS_EIDX); bf16* PART = (bf16*)(A.ws + WS_PART);
    const int xcc = (int)(xb_xcc_id() & 7u), rg = lane >> 3, c8 = lane & 7, m = lane & 15, kq = lane >> 4;
    LAS int* we = (LAS int*)(lds + wave * 1024);
    LAS unsigned char* tile = lds + U_TILE0 + wave * U_TILEB;
    const int ch_e = ((c8 - (rg >> 1)) & 7) * 16, ch_o = ((c8 - 4 - (rg >> 1)) & 7) * 16;
    const int fbase = m * 128 + (kq & 1) * 8, pos0 = (kq >> 1) + (m >> 1);
    int foff[4];
#pragma unroll
    for (int ks = 0; ks < 4; ++ks) foff[ks] = fbase + ((pos0 + 2 * ks) & 7) * 16;
    int qs = 0, slice, item; bool lists_ready = !peer_topk_split((int)gridDim.x);
    while (peer_next_item(ctl + CW_QU + qoff, xcc, qs, slice, item, lds, tid)) {
        if (!lists_ready && (item + 1) * PEER_ITEM > NPROMPT) { peer_topk_sample_wait(ctl, tid); lists_ready = true; }
        const unsigned char* us = Uq + (size_t)slice * 16384 * 128;
        size_t tok = (size_t)(item * PEER_ITEM + wave);
        unsigned pair = *(const unsigned*)(EIDX + tok * 128 + 2 * lane);
        v4u xr[4];
#pragma unroll
        for (int ks = 0; ks < 4; ++ks) xr[ks] = *(const v4u*)(XG + tok * DM + slice * 128 + ks * 32 + kq * 8);
        we[2 * lane] = (int)(pair & 0xffffu); we[2 * lane + 1] = (int)(pair >> 16);
        LDS_WAIT();
        v4u w[16];
#pragma unroll
        for (int it = 0; it < 16; ++it) w[it] = *(const v4u*)(us + (unsigned)(((unsigned)we[it * 8 + rg] << 7) + (unsigned)((it & 1) ? ch_o : ch_e)));
        for (int tt = 0; tt < PEER_ITEM / NWAVES; ++tt) {
            const size_t ctok = tok; const bool more = tt + 1 < PEER_ITEM / NWAVES;
            i64_t bx[4];
#pragma unroll
            for (int ks = 0; ks < 4; ++ks) { const v4u q = xr[ks]; typedef short s16x2 __attribute__((ext_vector_type(2)));
                s16x2 lo = (s16x2){0, 0}, hi = lo;
                unsigned q0 = q.x, q1 = q.y, q2 = q.z, q3 = q.w; asm volatile("" : "+v"(q0), "+v"(q1), "+v"(q2), "+v"(q3));
                lo = __builtin_amdgcn_cvt_scalef32_pk_fp8_bf16(lo, __builtin_bit_cast(bf16x2_t, q0), PEER_SX, false); lo = __builtin_amdgcn_cvt_scalef32_pk_fp8_bf16(lo, __builtin_bit_cast(bf16x2_t, q1), PEER_SX, true);
                hi = __builtin_amdgcn_cvt_scalef32_pk_fp8_bf16(hi, __builtin_bit_cast(bf16x2_t, q2), PEER_SX, false); hi = __builtin_amdgcn_cvt_scalef32_pk_fp8_bf16(hi, __builtin_bit_cast(bf16x2_t, q3), PEER_SX, true);
                bx[ks] = mk64(__builtin_bit_cast(unsigned, lo), __builtin_bit_cast(unsigned, hi)); }
            if (more) { tok += NWAVES; pair = *(const unsigned*)(EIDX + tok * 128 + 2 * lane);
#pragma unroll
                for (int ks = 0; ks < 4; ++ks) xr[ks] = *(const v4u*)(XG + tok * DM + slice * 128 + ks * 32 + kq * 8); }
#pragma unroll
            for (int it = 0; it < 16; ++it) *(LAS v4u*)(tile + it * 1024 + lane * 16) = w[it];
            if (more) {
                we[2 * lane] = (int)(pair & 0xffffu); we[2 * lane + 1] = (int)(pair >> 16);
                LDS_WAIT();
#pragma unroll
                for (int it = 0; it < 16; ++it) w[it] = *(const v4u*)(us + (unsigned)(((unsigned)we[it * 8 + rg] << 7) + (unsigned)((it & 1) ? ch_o : ch_e)));
            } else LDS_WAIT();
            bf16* pp = PART + (ctok * 8 + slice) * 128;
            f32x4 acc[8];
#pragma unroll
            for (int hf = 0; hf < 2; ++hf) {
                v2u a[4][4];
#pragma unroll
                for (int T4 = 0; T4 < 4; ++T4)
#pragma unroll
                    for (int ks = 0; ks < 4; ++ks) a[T4][ks] = *(const LAS v2u*)(tile + (hf * 4 + T4) * 2048 + foff[ks]);
#pragma unroll
                for (int T4 = 0; T4 < 4; ++T4) acc[hf * 4 + T4] = (f32x4){0.f, 0.f, 0.f, 0.f};
#pragma unroll
                for (int ks = 0; ks < 4; ++ks)
#pragma unroll
                    for (int T4 = 0; T4 < 4; ++T4) acc[hf * 4 + T4] = __builtin_amdgcn_mfma_f32_16x16x32_fp8_fp8(mk64(a[T4][ks].x, a[T4][ks].y), bx[ks], acc[hf * 4 + T4], 0, 0, 0);
            }
            f32x4 val = acc[0];
#pragma unroll
            for (int T = 1; T < 8; ++T) val = ((m & 7) == T) ? acc[T] : val;
            if (m < 8) { v2u pw; pw.x = cvt_pk_bf16(val[0] * (1.0f / PEER_SX), val[1] * (1.0f / PEER_SX)); pw.y = cvt_pk_bf16(val[2] * (1.0f / PEER_SX), val[3] * (1.0f / PEER_SX)); *(v2u*)(pp + m * 16 + 4 * kq) = pw; }
            LDS_WAIT();
        }
    }
}

constexpr float PEER_CS = 64.0f;
__device__ __forceinline__ void peer_coef_phase(const Args& A, int lane, int wave, int vcu, int G) {
    const bf16* PART = (const bf16*)(A.ws + WS_PART); const float* GATE = (const float*)(A.ws + WS_GATE); const float* RSTD = (const float*)(A.ws + WS_RSTD);
    unsigned char* C8 = A.ws + WS_COEF;
    for (int tok = vcu * NWAVES + wave; tok < NTOK; tok += G * NWAVES) {
        const bf16* pp = PART + (size_t)tok * 1024 + 2 * lane;
        unsigned pw[8];
#pragma unroll
        for (int j = 0; j < 8; ++j) pw[j] = *(const unsigned*)(pp + j * 128);
        f32x2 d = (f32x2){bf_lo(pw[0]), bf_hi(pw[0])};
#pragma unroll
        for (int j = 1; j < 8; ++j) d += (f32x2){bf_lo(pw[j]), bf_hi(pw[j])};
        const float sc = RSTD[tok] * (1.0f / PEER_SU); const f32x2 gt = *(const f32x2*)(GATE + (size_t)tok * 128 + 2 * lane);
        f32x2 cf; cf.x = gt.x * gelu_tanh(d.x * sc) * (PEER_CS / PEER_SV); cf.y = gt.y * gelu_tanh(d.y * sc) * (PEER_CS / PEER_SV);
        const unsigned hi = (unsigned)__builtin_amdgcn_cvt_pk_fp8_f32(cf.x, cf.y, 0, false) & 0xffffu;
        const f32x2 bk = __builtin_amdgcn_cvt_pk_f32_fp8(hi, false);
        const unsigned lo = (unsigned)__builtin_amdgcn_cvt_pk_fp8_f32((cf.x - bk.x) * 16.0f, (cf.y - bk.y) * 16.0f, 0, false) & 0xffffu;
        *(unsigned short*)(C8 + (size_t)tok * 256 + 2 * lane) = (unsigned short)hi; *(unsigned short*)(C8 + (size_t)tok * 256 + 128 + 2 * lane) = (unsigned short)lo;
    }
}

typedef int v2i_t __attribute__((ext_vector_type(2)));
__device__ __forceinline__ void peer_v_phase(const Args& A, LAS unsigned char* lds, int tid, int lane, int wave, gu32* ctl) {
    const unsigned char* Vq = A.ws + WS_VB;
    const unsigned short* EIDX = (const unsigned short*)(A.ws + WS_EIDX); const unsigned char* C8 = A.ws + WS_COEF;
    float* X1 = A.out + O_Y; float* SS2 = (float*)(A.ws + WS_SS2); const bf16* XGv = (const bf16*)(A.ws + WS_A1);
    const int xcc = (int)(xb_xcc_id() & 7u), rg = lane >> 3, c8 = lane & 7, m = lane & 15, kq = lane >> 4;
    LAS int* we = (LAS int*)(lds + wave * 1024);
    LAS unsigned char* tile = lds + U_TILE0 + wave * U_TILEB;
    const int ch_e = ((c8 - (rg >> 1)) & 7) * 16, ch_o = ((c8 - 4 - (rg >> 1)) & 7) * 16;
    const int tr_r = (lane & 15) >> 1, tr_p = lane & 1, tr_rot = 4 * (kq & 1) + (tr_r >> 1);
    const int tbase = (8 * kq + tr_r) * 128 + 8 * tr_p;
    int toff[8];
#pragma unroll
    for (int j = 0; j < 8; ++j) toff[j] = tbase + ((j + tr_rot) & 7) * 16;
    int qs = 0, slice, item;
    while (peer_next_item(ctl + CW_QV, xcc, qs, slice, item, lds, tid)) {
        const unsigned char* vs = Vq + (size_t)slice * 16384 * 128;
        size_t tok = (size_t)(item * PEER_ITEM + wave);
        unsigned pair = *(const unsigned*)(EIDX + tok * 128 + 2 * lane);
        v2u cfr[4];
#pragma unroll
        for (int ks = 0; ks < 4; ++ks) cfr[ks] = *(const v2u*)(C8 + tok * 256 + (m & 1) * 128 + ks * 32 + kq * 8);
        const float rga = 1.0f / A.in[I_N2G][slice * 128 + lane], rgb = 1.0f / A.in[I_N2G][slice * 128 + 64 + lane];
        unsigned short xoa = XGv[tok * DM + slice * 128 + lane], xob = XGv[tok * DM + slice * 128 + 64 + lane];
        we[2 * lane] = (int)(pair & 0xffffu); we[2 * lane + 1] = (int)(pair >> 16);
        LDS_WAIT();
        v4u w[16];
#pragma unroll
        for (int it = 0; it < 16; ++it) w[it] = *(const v4u*)(vs + (unsigned)(((unsigned)we[it * 8 + rg] << 7) + (unsigned)((it & 1) ? ch_o : ch_e)));
        for (int tt = 0; tt < PEER_ITEM / NWAVES; ++tt) {
            const size_t ctok = tok; const bool more = tt + 1 < PEER_ITEM / NWAVES;
            i64_t af[4];
#pragma unroll
            for (int ks = 0; ks < 4; ++ks) af[ks] = mk64(cfr[ks].x, cfr[ks].y);
            const float xa = __uint_as_float((unsigned)xoa << 16) * rga, xb = __uint_as_float((unsigned)xob << 16) * rgb;
            if (more) { tok += NWAVES; pair = *(const unsigned*)(EIDX + tok * 128 + 2 * lane);
#pragma unroll
                for (int ks = 0; ks < 4; ++ks) cfr[ks] = *(const v2u*)(C8 + tok * 256 + (m & 1) * 128 + ks * 32 + kq * 8);
                xoa = XGv[tok * DM + slice * 128 + lane]; xob = XGv[tok * DM + slice * 128 + 64 + lane]; }
#pragma unroll
            for (int it = 0; it < 16; ++it) *(LAS v4u*)(tile + it * 1024 + lane * 16) = w[it];
            if (more) {
                we[2 * lane] = (int)(pair & 0xffffu); we[2 * lane + 1] = (int)(pair >> 16);
                LDS_WAIT();
#pragma unroll
                for (int it = 0; it < 16; ++it) w[it] = *(const v4u*)(vs + (unsigned)(((unsigned)we[it * 8 + rg] << 7) + (unsigned)((it & 1) ? ch_o : ch_e)));
            } else LDS_WAIT();
            f32x4 acc[8];
#pragma unroll
            for (int hf = 0; hf < 2; ++hf) {
                v2i_t b[4][4];
#pragma unroll
                for (int j4 = 0; j4 < 4; ++j4)
#pragma unroll
                    for (int ks = 0; ks < 4; ++ks) b[j4][ks] = __builtin_amdgcn_ds_read_tr8_b64_v2i32((LAS v2i_t*)(tile + ks * 4096 + toff[hf * 4 + j4]));
#pragma unroll
                for (int j4 = 0; j4 < 4; ++j4) acc[hf * 4 + j4] = (f32x4){0.f, 0.f, 0.f, 0.f};
#pragma unroll
                for (int ks = 0; ks < 4; ++ks)
#pragma unroll
                    for (int j4 = 0; j4 < 4; ++j4) acc[hf * 4 + j4] = __builtin_amdgcn_mfma_f32_16x16x32_fp8_fp8(af[ks], mk64((unsigned)b[j4][ks].x, (unsigned)b[j4][ks].y), acc[hf * 4 + j4], 0, 0, 0);
            }
            float h0 = acc[0][0], l0 = acc[0][1], h1 = acc[4][0], l1 = acc[4][1];
#pragma unroll
            for (int j = 1; j < 4; ++j) { const bool s = kq == j; h0 = s ? acc[j][0] : h0; l0 = s ? acc[j][1] : l0; h1 = s ? acc[4 + j][0] : h1; l1 = s ? acc[4 + j][1] : l1; }
            const float x2a = xa + (h0 + l0 * (1.0f / 16.0f)) * (1.0f / PEER_CS), x2b = xb + (h1 + l1 * (1.0f / 16.0f)) * (1.0f / PEER_CS);
            { bf16* xr_ = (bf16*)X1 + ctok * (2 * DM) + slice * 128 + lane;
              xr_[0] = (bf16)(cvt_pk_bf16(x2a, x2a) & 0xffffu); xr_[64] = (bf16)(cvt_pk_bf16(x2b, x2b) & 0xffffu); }
            float ss = sum16(x2a * x2a + x2b * x2b); ss += __shfl_xor(ss, 16); ss += __shfl_xor(ss, 32);
            if (lane == 0) SS2[ctok * 8 + slice] = ss;
            LDS_WAIT();
        }
    }
}

__device__ __forceinline__ void peer_final_phase(const Args& A, int lane, int wave, int vcu, int G) {
    float* X1 = A.out + O_Y; const float* SS2 = (const float*)(A.ws + WS_SS2); const float* gf = A.in[I_NFG] + lane * 16;
    const f32x4 g0 = *(const f32x4*)gf, g1 = *(const f32x4*)(gf + 4), g2 = *(const f32x4*)(gf + 8), g3 = *(const f32x4*)(gf + 12);
    for (int tok = vcu * NWAVES + wave; tok < NTOK; tok += G * NWAVES) {
        const f32x4 sa = *(const f32x4*)(SS2 + (size_t)tok * 8), sb = *(const f32x4*)(SS2 + (size_t)tok * 8 + 4);
        const float ss = ((sa[0] + sa[1]) + (sa[2] + sa[3])) + ((sb[0] + sb[1]) + (sb[2] + sb[3]));
        const float rf = __builtin_amdgcn_rsqf(ss * (1.f / DM) + 1e-6f);
        float* yr = X1 + (size_t)tok * DM + lane * 16;
        const v4u s0 = *(const v4u*)((const bf16*)(X1 + (size_t)tok * DM) + lane * 16), s1 = *(const v4u*)((const bf16*)(X1 + (size_t)tok * DM) + lane * 16 + 8);
        const f32x4 y0 = (f32x4){bf_lo(s0.x), bf_hi(s0.x), bf_lo(s0.y), bf_hi(s0.y)}, y1 = (f32x4){bf_lo(s0.z), bf_hi(s0.z), bf_lo(s0.w), bf_hi(s0.w)},
                    y2 = (f32x4){bf_lo(s1.x), bf_hi(s1.x), bf_lo(s1.y), bf_hi(s1.y)}, y3 = (f32x4){bf_lo(s1.z), bf_hi(s1.z), bf_lo(s1.w), bf_hi(s1.w)};
        *(f32x4*)yr = y0 * rf * g0; *(f32x4*)(yr + 4) = y1 * rf * g1; *(f32x4*)(yr + 8) = y2 * rf * g2; *(f32x4*)(yr + 12) = y3 * rf * g3;
    }
}

__device__ __forceinline__ void sg_partial(const bf16* Ap, int lda, const bf16* Bp, int ldb, LAS f32x4* red, int lane, int wave) {
    const int fr = lane & 15, fq = lane >> 4;
    bf16x8 a[2][4], b[4][4];
#pragma unroll
    for (int mi = 0; mi < 2; ++mi)
#pragma unroll
        for (int ks = 0; ks < 4; ++ks) a[mi][ks] = *(const bf16x8*)(Ap + (size_t)(16 * mi + fr) * lda + 32 * ks + 8 * fq);
#pragma unroll
    for (int nj = 0; nj < 4; ++nj)
#pragma unroll
        for (int ks = 0; ks < 4; ++ks) b[nj][ks] = *(const bf16x8*)(Bp + (size_t)(16 * nj + fr) * ldb + 32 * ks + 8 * fq);
    f32x4 acc[2][4];
#pragma unroll
    for (int mi = 0; mi < 2; ++mi)
#pragma unroll
        for (int nj = 0; nj < 4; ++nj) acc[mi][nj] = (f32x4){0.f, 0.f, 0.f, 0.f};
#pragma unroll
    for (int ks = 0; ks < 4; ++ks)
#pragma unroll
        for (int mi = 0; mi < 2; ++mi)
#pragma unroll
            for (int nj = 0; nj < 4; ++nj) acc[mi][nj] = __builtin_amdgcn_mfma_f32_16x16x32_bf16(b[nj][ks], a[mi][ks], acc[mi][nj], 0, 0, 0);
#pragma unroll
    for (int mi = 0; mi < 2; ++mi)
#pragma unroll
        for (int nj = 0; nj < 4; ++nj) red[(wave * 8 + mi * 4 + nj) * 64 + lane] = acc[mi][nj];
}
__device__ __forceinline__ f32x4 sg_sum(const LAS f32x4* red, int w0, int nw, int wave, int lane) {
    f32x4 s = red[(w0 * 8 + wave) * 64 + lane];
    for (int w = 1; w < nw; ++w) s += red[((w0 + w) * 8 + wave) * 64 + lane];
    return s;
}
__device__ __forceinline__ void sample_gemm2(const Args& A, LAS unsigned char* lds, int t, int lane, int wave) {
    unsigned char* ws = A.ws; const int fr = lane & 15, fq = lane >> 4;
    const int row0 = NPROMPT + (t >> 4) * 32, col0 = (t & 15) * 64;
    LAS f32x4* red = (LAS f32x4*)lds;
    const bf16* Ab = (const bf16*)(ws + WS_A1) + (wave >= 4 ? (size_t)MPAD * 512 : 0); const bf16* Bb = (const bf16*)(ws + (wave >= 4 ? WS_WPB : WS_WPA));
    sg_partial(Ab + (size_t)row0 * 512 + (wave & 3) * 128, 512, Bb + (size_t)col0 * 512 + (wave & 3) * 128, 512, red, lane, wave);
    const int row = row0 + 16 * (wave >> 2) + fr, c = col0 + 16 * (wave & 3) + 4 * fq;
    const bf16* Zg = (const bf16*)(ws + WS_ZG) + (size_t)row * 2048;
    const v2u ga = *(const v2u*)(Zg + c), gb = *(const v2u*)(Zg + 1024 + c);
    __syncthreads();
    const f32x4 pa = sg_sum(red, 0, 4, wave, lane), pb = sg_sum(red, 4, 4, wave, lane);
    const float o0 = sigm(bf_lo(ga.x)) * pa[0] + sigm(bf_lo(gb.x)) * pb[0], o1 = sigm(bf_hi(ga.x)) * pa[1] + sigm(bf_hi(gb.x)) * pb[1],
                o2 = sigm(bf_lo(ga.y)) * pa[2] + sigm(bf_lo(gb.y)) * pb[2], o3 = sigm(bf_hi(ga.y)) * pa[3] + sigm(bf_hi(gb.y)) * pb[3];
    v2u w; w.x = cvt_pk_bf16(o0, o1); w.y = cvt_pk_bf16(o2, o3); *(v2u*)((bf16*)(ws + WS_ZR) + (size_t)row * 1024 + c) = w;
    __syncthreads();
}
__device__ __forceinline__ void sample_gemm3(const Args& A, LAS unsigned char* lds, int t, int tid, int lane, int wave) {
    unsigned char* ws = A.ws; const int fr = lane & 15, fq = lane >> 4;
    const int row0 = NPROMPT + (t >> 4) * 32, col0 = (t & 15) * 64;
    LAS f32x4* red = (LAS f32x4*)lds; LAS float* ssl = (LAS float*)(lds + 65536);
    sg_partial((const bf16*)(ws + WS_ZR) + (size_t)row0 * 1024 + wave * 128, 1024, (const bf16*)(ws + WS_WO) + (size_t)col0 * 1024 + wave * 128, 1024, red, lane, wave);
    const int row = row0 + 16 * (wave >> 2) + fr, c = col0 + 16 * (wave & 3) + 4 * fq;
    const f32x4 xv = *(const f32x4*)(A.in[I_XS] + (size_t)(row - NPROMPT) * 1024 + c), q = *(const f32x4*)(A.in[I_N2G] + c);
    __syncthreads();
    const f32x4 o = xv + sg_sum(red, 0, 8, wave, lane);
    float ss = (o[0] * o[0] + o[1] * o[1]) + (o[2] * o[2] + o[3] * o[3]);
    v2u w; w.x = cvt_pk_bf16(o[0] * q[0], o[1] * q[1]); w.y = cvt_pk_bf16(o[2] * q[2], o[3] * q[3]); *(v2u*)((bf16*)(ws + WS_A1) + (size_t)row * 1024 + c) = w;
    ss += __shfl_xor(ss, 16); ss += __shfl_xor(ss, 32);
    if (fq == 0) ssl[wave * 16 + fr] = ss;
    __syncthreads();
    if (tid < 32) { const int mi = tid >> 4, r = tid & 15;
        ((float*)(ws + WS_SSP))[(size_t)(row0 + tid) * 16 + (t & 15)] = (ssl[(mi * 4 + 0) * 16 + r] + ssl[(mi * 4 + 1) * 16 + r]) + (ssl[(mi * 4 + 2) * 16 + r] + ssl[(mi * 4 + 3) * 16 + r]); }
}
__device__ __forceinline__ void sample_gemm4(const Args& A, LAS unsigned char* lds, int t, int lane, int wave) {
    unsigned char* ws = A.ws; const int fr = lane & 15, fq = lane >> 4;
    const int row0 = NPROMPT + (t >> 5) * 32, col0 = (t & 31) * 64;
    LAS f32x4* red = (LAS f32x4*)lds;
    sg_partial((const bf16*)(ws + WS_A1) + (size_t)row0 * 1024 + wave * 128, 1024, (const bf16*)(ws + WS_WQ) + (size_t)col0 * 1024 + wave * 128, 1024, red, lane, wave);
    const int row = row0 + 16 * (wave >> 2) + fr, c = col0 + 16 * (wave & 3) + 4 * fq;
    __syncthreads();
    const f32x4 o = sg_sum(red, 0, 8, wave, lane);
    v2u w; w.x = cvt_pk_bf16(o[0], o[1]); w.y = cvt_pk_bf16(o[2], o[3]); *(v2u*)((bf16*)(ws + WS_ZG) + (size_t)row * 2048 + c) = w;
    __syncthreads();
}

__global__ void __launch_bounds__(NTHR, 2) mk_fwd(Args args) {
    extern __shared__ __attribute__((aligned(16))) unsigned char lds_raw[];
    LAS unsigned char* lds = (LAS unsigned char*)lds_raw;
    const int tid = threadIdx.x, lane = tid & 63, wave = __builtin_amdgcn_readfirstlane(tid >> 6);
    const int G = gridDim.x; const int bx = blockIdx.x; const int vcu = (G % 8 == 0) ? (bx % 8) * (G / 8) + bx / 8 : bx;
    gu32* ctl = (gu32*)(args.ws + WS_CTL);
    volatile LAS unsigned* MISC = (volatile LAS unsigned*)(lds + MISC_OFF);
    for (int u = tid; u < (LDS_BYTES - LDSCTL_OFF) / 4; u += NTHR) ((LAS unsigned*)(lds + LDSCTL_OFF))[u] = 0u;
    __syncthreads();
    XcdBarrier bar; bar.bar = (unsigned*)(ctl + CW_BAR) + args.li * XCD_BAR_WORDS; bar.x = 0; bar.st = nullptr;
    if (N_LAUNCHES != PER_PHASE) bar = xcd_barrier_post((unsigned*)(ctl + CW_BAR) + args.li * XCD_BAR_WORDS, MISC + 8);
    const int lo = args.ph_lo, hi = args.ph_hi;
#define IN(k) (lo <= (k) && (k) < hi)
#define BOTH(k) (IN(k) && IN((k) + 1))
#define GRID_BAR() do { if (N_LAUNCHES != PER_PHASE) xcd_barrier(bar); } while (0)
    unsigned char* ws = args.ws;
    bf16* A1 = (bf16*)(ws + WS_A1);

    if (IN(0)) for (int rep_ = 0; rep_ < ((MK_REPEAT == 0) ? 2 : 1); ++rep_) { p0_prologue(args, lds, tid, lane, wave, vcu, G); if (BOTH(0)) GRID_BAR(); }

    if (IN(1)) for (int rep_ = 0; rep_ < ((MK_REPEAT == 1) ? 2 : 1); ++rep_) {
        pg8::Gemm g{A1, (const bf16*)(ws + WS_W1T), MPAD, N1, DM}; pg8::StaticOrder S; S.init(MPAD, N1, G, bx);
        pg8::EpiZ E{(bf16*)(ws + WS_ZC), (bf16*)(ws + WS_ZR), (bf16*)(ws + WS_ZG)};
        pg8::gemm_phase<pg8::EpiZ, pg8::StaticOrder, true, true>(lds, g, S, E);
        if (BOTH(1)) GRID_BAR();
    }

    if (IN(2)) for (int rep_ = 0; rep_ < ((MK_REPEAT == 2) ? 2 : 1); ++rep_) { conv_phase(args, vcu * NTHR + tid, G * NTHR); if (BOTH(2)) GRID_BAR(); }

    if (IN(3)) for (int rep_ = 0; rep_ < ((MK_REPEAT == 3) ? 2 : 1); ++rep_) {
        scan_pass1(args, lds, tid, lane, wave, vcu, G, (MK_REPEAT == 3 && rep_ == 0) ? 1 : 0);
        if (BOTH(3)) GRID_BAR();
    }

    if (IN(4)) {
        for (int u = vcu; u < 512; u += G) {
            if (u < 256) { const int bh = u >> 2, vq = u & 3; scan_pass2_rows(nullptr, bh * 64, 64, vq * 16, args.out + O_WKV_P + (size_t)bh * 4096, true, args, lds, tid, lane, wave); }
            else { const int bh = u - 256; scan_pass2_sample(args.in[I_SWKV] + (size_t)bh * 4096, NUNITS_P + bh, args.out + O_WKV_S + (size_t)bh * 4096, args, lane, wave); }
        }
        if (BOTH(4)) GRID_BAR();
    }

    if (IN(5)) for (int rep_ = 0; rep_ < ((MK_REPEAT == 5) ? 2 : 1); ++rep_) {
        for (int u2 = vcu; u2 < NUNITS / 2; u2 += G) scan_pass3_wave(args, u2 * 2 + (wave >> 2), wave & 3, lane);
        if (BOTH(5)) GRID_BAR();
    }

    if (IN(6)) {
        { pg8::Gemm g{A1, (const bf16*)(ws + WS_WPA), NPROMPT, DM, 512}; pg8::StaticOrder S; S.init(NPROMPT, DM, G, bx);
          pg8::EpiGate<0> E{(const bf16*)(ws + WS_ZG), (bf16*)(ws + WS_ZR)};
          pg8::gemm_phase<pg8::EpiGate<0>, pg8::StaticOrder, true, true>(lds, g, S, E); }
        { pg8::Gemm g{A1 + (size_t)MPAD * 512, (const bf16*)(ws + WS_WPB), NPROMPT, DM, 512}; pg8::StaticOrder S; S.init(NPROMPT, DM, G, bx);
          pg8::EpiGate<1> E{(const bf16*)(ws + WS_ZG), (bf16*)(ws + WS_ZR)};
          pg8::gemm_phase<pg8::EpiGate<1>, pg8::StaticOrder, true, true>(lds, g, S, E); }
        for (int t = vcu; t < 256; t += G) sample_gemm2(args, lds, t, lane, wave);
        if (BOTH(6)) GRID_BAR();
    }

    if (IN(7)) for (int rep_ = 0; rep_ < ((MK_REPEAT == 7) ? 2 : 1); ++rep_) {
        pg8::Gemm g{(const bf16*)(ws + WS_ZR), (const bf16*)(ws + WS_WO), NPROMPT, DM, DM}; pg8::StaticOrder S; S.init(NPROMPT, DM, G, bx);
        pg8::EpiX1 E{args.in[I_XP], args.in[I_XS], args.out + O_Y, A1, (float*)(ws + WS_SSP), args.in[I_N2G], NPROMPT, NTOK};
        pg8::gemm_phase<pg8::EpiX1, pg8::StaticOrder, true, true>(lds, g, S, E);
        for (int t = vcu; t < 256; t += G) sample_gemm3(args, lds, t, tid, lane, wave);
        if (BOTH(7)) GRID_BAR();
    }

    if (IN(8)) for (int rep_ = 0; rep_ < ((MK_REPEAT == 8) ? 2 : 1); ++rep_) {
        pg8::Gemm g{A1, (const bf16*)(ws + WS_WQ), NPROMPT, 2048, DM}; pg8::StaticOrder S; S.init(NPROMPT, 2048, G, bx);
        pg8::EpiPlain E{(bf16*)(ws + WS_ZG), 2048};
        pg8::gemm_phase<pg8::EpiPlain, pg8::StaticOrder, true, true>(lds, g, S, E);
        for (int t = vcu; t < 512; t += G) sample_gemm4(args, lds, t, lane, wave);
        if (BOTH(8)) GRID_BAR();
    }

    if (IN(9)) for (int rep_ = 0; rep_ < ((MK_REPEAT == 9) ? 2 : 1); ++rep_) { peer_topk_phase(args, lds, tid, lane, wave, vcu, G); if (BOTH(9)) GRID_BAR(); }
    if (IN(10)) for (int rep_ = 0; rep_ < ((MK_REPEAT == 10) ? 2 : 1); ++rep_) { if (rep_ == 0) peer_topk_sample_prelude(args, lds, tid, lane, wave, vcu, G, ctl); peer_u_phase(args, lds, tid, lane, wave, ctl, rep_ * 1024); if (BOTH(10)) GRID_BAR(); }
    if (IN(11)) { peer_coef_phase(args, lane, wave, vcu, G); if (BOTH(11)) GRID_BAR(); }
    if (IN(12)) { peer_v_phase(args, lds, tid, lane, wave, ctl); if (BOTH(12)) GRID_BAR(); }
    if (IN(13)) peer_final_phase(args, lane, wave, vcu, G);
#undef IN
#undef BOTH
#undef GRID_BAR
}

extern "C" void kernel_launch(void* const* d_in, const int* in_sizes, int n_in, void* d_out, int out_size, void* d_ws, size_t ws_size, hipStream_t stream) {
    static int grid = 0;
    if (grid == 0) {
        if (n_in != 32 || ws_size < WS_END) { fprintf(stderr, "kernel_launch: built for 32 inputs and >= %zu bytes of workspace; got n_in %d ws %zu; nothing launched\n", (size_t)WS_END, n_in, ws_size); grid = -1; return; }
        int dev = 0, cus = 0, per_cu = 0;
        if (hipGetDevice(&dev) != hipSuccess || hipDeviceGetAttribute(&cus, hipDeviceAttributeMultiprocessorCount, dev) != hipSuccess) { fprintf(stderr, "kernel_launch: device query failed\n"); grid = -1; return; }
        if (hipFuncSetAttribute((const void*)mk_fwd, hipFuncAttributeMaxDynamicSharedMemorySize, LDS_BYTES) != hipSuccess) { fprintf(stderr, "kernel_launch: hipFuncSetAttribute failed\n"); grid = -1; return; }
        if (hipOccupancyMaxActiveBlocksPerMultiprocessor(&per_cu, (const void*)mk_fwd, NTHR, LDS_BYTES) != hipSuccess || per_cu < 1)
            fprintf(stderr, "kernel_launch: note: occupancy query reports %d workgroups per CU\n", per_cu);
        (void)hipGetLastError();
        grid = cus;
    }
    if (grid < 0) return;
    if (hipMemsetAsync((char*)d_ws + WS_CTL, 0, CTL_ZERO_BYTES, stream) != hipSuccess) { fprintf(stderr, "kernel_launch: hipMemsetAsync failed\n"); return; }
    Args a{};
    for (int i = 0; i < 32; ++i) a.in[i] = (const float*)d_in[i];
    a.out = (float*)d_out; a.ws = (unsigned char*)d_ws;
    constexpr int NL = (N_LAUNCHES == PER_PHASE ? PER_PHASE : 1) + ((MK_EXTRA_LO >= 0) ? 1 : 0);
    for (int li = 0; li < NL; ++li) {
        if (N_LAUNCHES == PER_PHASE) { a.ph_lo = li; a.ph_hi = li + 1; } else { a.ph_lo = 0; a.ph_hi = PER_PHASE; }
        if (MK_EXTRA_LO >= 0 && li == NL - 1) { a.ph_lo = MK_EXTRA_LO; a.ph_hi = MK_EXTRA_HI; }
        a.li = li;
        hipLaunchKernelGGL(mk_fwd, dim3(grid), dim3(NTHR), LDS_BYTES, stream, a);
        const hipError_t le = hipPeekAtLastError();
        if (le != hipSuccess) { fprintf(stderr, "kernel_launch: launch %d failed: %s\n", li, hipGetErrorName(le)); break; }
    }
}
```

```cpp
#include <hip/hip_runtime.h>
#include <cstdio>
#include <cstdint>
#define MK_N_LAUNCHES 1
#define MK_REPEAT -1
#define MK_DBGSEL 0
#define MK_EXTRA_LO -1
#define MK_EXTRA_HI -1
namespace pg8 {
#define PG8_LAS __attribute__((address_space(3)))
typedef unsigned short bf16_t;
typedef short bf16x8 __attribute__((ext_vector_type(8)));
typedef float f32x4 __attribute__((ext_vector_type(4)));
typedef unsigned u32x4 __attribute__((ext_vector_type(4)));
constexpr int BM = 256, BK = 64, HALF = 128, HTB = HALF * BK * 2  , STAGE_BYTES = 8 * HTB, NXCD = 8, WGM = 8;

__host__ __device__ __forceinline__ int lds_byte(int r, int c) { const int st = (r >> 4) * 2 + (c >> 5), rr = r & 15, cc = c & 31, ob = rr * 64 + cc * 2; return st * 1024 + (ob ^ (((ob >> 9) & 1) << 5)); }
__host__ __device__ __forceinline__ void stage_rc(int b, int& R, int& C) { const int st = b / 1024, sb = b % 1024, swz = sb ^ (((sb >> 9) & 1) << 5); R = (st >> 1) * 16 + swz / 64; C = (st & 1) * 32 + (swz % 64) / 2; }
__host__ __device__ __forceinline__ int perm32(int rho) { const int n = rho >> 4, i = rho & 15; return 8 * (i >> 2) + 4 * n + (i & 3); }

struct Unit { int pm, pn; };
struct Gemm { const bf16_t* A; const bf16_t* Bt; int M, N, K; };

struct StaticOrder {
    int nM, nN, nwg, G, c;
    __host__ __device__ void init(int M, int N, int G_, int c_) { nM = M / BM; nN = N / BM; nwg = nM * nN; G = G_; c = c_; }
    __host__ __device__ bool next(int i, Unit& u) const {
        const long L = (long)i * G + c; if (L >= nwg) return false;
        int wgid = (int)L; { const int q = nwg / NXCD, r = nwg % NXCD, xcd = wgid % NXCD, off = wgid / NXCD; wgid = (xcd < r ? xcd * (q + 1) : r * (q + 1) + (xcd - r) * q) + off; }
        const int nig = WGM * nN, gid = wgid / nig, fm = gid * WGM, gsz = (nM - fm) < WGM ? (nM - fm) : WGM;
        u.pm = fm + ((wgid % nig) % gsz); u.pn = (wgid % nig) / gsz; return true;
    }
    __device__ __forceinline__ void a_ready(const Unit&) const {}
    __device__ __forceinline__ void done(const Unit&) const {}
};

typedef __bf16 bf16x2_cv __attribute__((ext_vector_type(2))); typedef float f32x2_cv __attribute__((ext_vector_type(2)));
__device__ __forceinline__ unsigned cvt_pk_bf16(float lo, float hi) { return __builtin_bit_cast(unsigned, __builtin_convertvector((f32x2_cv){lo, hi}, bf16x2_cv)); }
__device__ __forceinline__ float bf_lo(unsigned w) { return __uint_as_float(w << 16); }
__device__ __forceinline__ float bf_hi(unsigned w) { return __uint_as_float(w & 0xffff0000u); }
__device__ __forceinline__ float sigm(float x) { return __builtin_amdgcn_rcpf(1.0f + __expf(-x)); }

struct EpiZ {
    static constexpr bool PERM = true, AFTER_DRAIN = false;
    bf16_t *Zc, *Zr, *Zg;
    __device__ __forceinline__ void operator()(const f32x4 (&acc)[2][2][4][2], const Unit& u, int wr, int wc, int fr, int fq) const {
        typedef unsigned u32x2e __attribute__((ext_vector_type(2)));
        const int row0 = u.pm * BM + wr * 64 + fr;
        if (u.pn >= 2 && u.pn < 6) {
#pragma unroll
            for (int ai = 0; ai < 2; ++ai)
#pragma unroll
                for (int m = 0; m < 4; ++m) { bf16_t* rowp = Zc + (size_t)(row0 + ai * HALF + m * 16) * 1024 + 512 + (u.pn - 2) * 128 + wc * 16 + 4 * fq;
#pragma unroll
                    for (int bj = 0; bj < 2; ++bj) { const f32x4 v0 = acc[ai][bj][m][0], v1 = acc[ai][bj][m][1];
                        u32x2e w; w.x = cvt_pk_bf16(v0[0] * v0[1], v0[2] * v0[3]); w.y = cvt_pk_bf16(v1[0] * v1[1], v1[2] * v1[3]);
                        *(u32x2e*)(rowp + bj * 64) = w; } }
            return;
        }
        bf16_t* base; int ldc, colt;
        if (u.pn < 2) { base = Zc; ldc = 1024; colt = u.pn * BM; }
        else if (u.pn < 14) { base = Zr; ldc = 2048; colt = (u.pn - 6) * BM; }
        else { base = Zg; ldc = 2048; colt = (u.pn - 14) * BM; }
        const int col0 = colt + wc * 32 + 8 * fq;
#pragma unroll
        for (int ai = 0; ai < 2; ++ai)
#pragma unroll
            for (int m = 0; m < 4; ++m) { bf16_t* rowp = base + (size_t)(row0 + ai * HALF + m * 16) * ldc + col0;
#pragma unroll
                for (int bj = 0; bj < 2; ++bj) { const f32x4 v0 = acc[ai][bj][m][0], v1 = acc[ai][bj][m][1];
                    u32x4 w; w.x = cvt_pk_bf16(v0[0], v0[1]); w.y = cvt_pk_bf16(v0[2], v0[3]); w.z = cvt_pk_bf16(v1[0], v1[1]); w.w = cvt_pk_bf16(v1[2], v1[3]);
                    *(u32x4*)(rowp + bj * HALF) = w; } }
    }
};
struct EpiPlain {
    static constexpr bool PERM = true, AFTER_DRAIN = false;
    bf16_t* O; int ldc;
    __device__ __forceinline__ void operator()(const f32x4 (&acc)[2][2][4][2], const Unit& u, int wr, int wc, int fr, int fq) const {
        const int row0 = u.pm * BM + wr * 64 + fr, col0 = u.pn * BM + wc * 32 + 8 * fq;
#pragma unroll
        for (int ai = 0; ai < 2; ++ai)
#pragma unroll
            for (int m = 0; m < 4; ++m) { bf16_t* rowp = O + (size_t)(row0 + ai * HALF + m * 16) * ldc + col0;
#pragma unroll
                for (int bj = 0; bj < 2; ++bj) { const f32x4 v0 = acc[ai][bj][m][0], v1 = acc[ai][bj][m][1];
                    u32x4 w; w.x = cvt_pk_bf16(v0[0], v0[1]); w.y = cvt_pk_bf16(v0[2], v0[3]); w.z = cvt_pk_bf16(v1[0], v1[1]); w.w = cvt_pk_bf16(v1[2], v1[3]);
                    *(u32x4*)(rowp + bj * HALF) = w; } }
    }
};
template <int SECOND> struct EpiGate {
    static constexpr bool PERM = true, AFTER_DRAIN = false;
    const bf16_t* Zg; bf16_t* MG;
    __device__ __forceinline__ void operator()(const f32x4 (&acc)[2][2][4][2], const Unit& u, int wr, int wc, int fr, int fq) const {
        const int row0 = u.pm * BM + wr * 64 + fr, col0 = u.pn * BM + wc * 32 + 8 * fq;
#pragma unroll
        for (int ai = 0; ai < 2; ++ai) {
            u32x4 gw[4][2], pw[4][2];
#pragma unroll
            for (int m = 0; m < 4; ++m) { const int r = row0 + ai * HALF + m * 16;
#pragma unroll
                for (int bj = 0; bj < 2; ++bj) { gw[m][bj] = *(const u32x4*)(Zg + (size_t)r * 2048 + SECOND * 1024 + col0 + bj * HALF);
                    if (SECOND) pw[m][bj] = *(const u32x4*)(MG + (size_t)r * 1024 + col0 + bj * HALF); } }
#pragma unroll
            for (int m = 0; m < 4; ++m) { const int r = row0 + ai * HALF + m * 16; bf16_t* op = MG + (size_t)r * 1024 + col0;
#pragma unroll
                for (int bj = 0; bj < 2; ++bj) { const u32x4 g = gw[m][bj]; f32x4 v0 = acc[ai][bj][m][0], v1 = acc[ai][bj][m][1];
                    v0[0] *= sigm(bf_lo(g.x)); v0[1] *= sigm(bf_hi(g.x)); v0[2] *= sigm(bf_lo(g.y)); v0[3] *= sigm(bf_hi(g.y));
                    v1[0] *= sigm(bf_lo(g.z)); v1[1] *= sigm(bf_hi(g.z)); v1[2] *= sigm(bf_lo(g.w)); v1[3] *= sigm(bf_hi(g.w));
                    if (SECOND) { const u32x4 p = pw[m][bj];
                        v0[0] += bf_lo(p.x); v0[1] += bf_hi(p.x); v0[2] += bf_lo(p.y); v0[3] += bf_hi(p.y);
                        v1[0] += bf_lo(p.z); v1[1] += bf_hi(p.z); v1[2] += bf_lo(p.w); v1[3] += bf_hi(p.w); }
                    u32x4 w; w.x = cvt_pk_bf16(v0[0], v0[1]); w.y = cvt_pk_bf16(v0[2], v0[3]); w.z = cvt_pk_bf16(v1[0], v1[1]); w.w = cvt_pk_bf16(v1[2], v1[3]);
                    *(u32x4*)(op + bj * HALF) = w; } }
        }
    }
};
struct EpiX1 {
    static constexpr bool PERM = false, AFTER_DRAIN = false;
    const float* xp; const float* xs; float* X1; bf16_t* X1B; float* SSP; const float* g2; int nprompt, nrows;
    __device__ __forceinline__ void operator()(const f32x4 (&acc)[2][2][4][2], const Unit& u, int wr, int wc, int fr, int fq) const {
        typedef unsigned u32x2v __attribute__((ext_vector_type(2)));
        const int col0 = u.pn * BM + wc * 32 + 4 * fq;
        f32x4 gq[2][2];
#pragma unroll
        for (int bj = 0; bj < 2; ++bj)
#pragma unroll
            for (int n = 0; n < 2; ++n) gq[bj][n] = *(const f32x4*)(g2 + col0 + bj * HALF + n * 16);
#pragma unroll
        for (int ai = 0; ai < 2; ++ai) {
            f32x4 xv[4][2][2];
#pragma unroll
            for (int m = 0; m < 4; ++m) { int r = u.pm * BM + ai * HALF + wr * 64 + m * 16 + fr; r = r < nrows ? r : nrows - 1;
                const float* xr = r < nprompt ? xp + (size_t)r * 1024 : xs + (size_t)(r - nprompt) * 1024;
#pragma unroll
                for (int bj = 0; bj < 2; ++bj)
#pragma unroll
                    for (int n = 0; n < 2; ++n) xv[m][bj][n] = *(const f32x4*)(xr + col0 + bj * HALF + n * 16); }
#pragma unroll
            for (int m = 0; m < 4; ++m) { const int r = u.pm * BM + ai * HALF + wr * 64 + m * 16 + fr; float ss = 0.f;
#pragma unroll
                for (int bj = 0; bj < 2; ++bj)
#pragma unroll
                    for (int n = 0; n < 2; ++n) { const int c = col0 + bj * HALF + n * 16; const f32x4 o = xv[m][bj][n] + acc[ai][bj][m][n];
                        ss += (o[0] * o[0] + o[1] * o[1]) + (o[2] * o[2] + o[3] * o[3]);
                        const f32x4 q = gq[bj][n]; u32x2v w; w.x = cvt_pk_bf16(o[0] * q[0], o[1] * q[1]); w.y = cvt_pk_bf16(o[2] * q[2], o[3] * q[3]);
                        if (r < nrows) *(u32x2v*)(X1B + (size_t)r * 1024 + c) = w; }
                ss += __shfl_xor(ss, 16); ss += __shfl_xor(ss, 32);
                if (fq == 0 && r < nrows) SSP[(size_t)r * 16 + u.pn * 4 + wc] = ss;
            }
        }
    }
};
template <class Epi, class Sched, bool ALIGN_EPI = false, bool SP2 = false>
__device__ __forceinline__ void gemm_phase(PG8_LAS unsigned char* lds, const Gemm g, const Sched& S, const Epi& E) {
    const int tid = threadIdx.x, wid = __builtin_amdgcn_readfirstlane(tid >> 6), lane = tid & 63, wr = wid >> 2, wc = wid & 3, fr = lane & 15, fq = lane >> 4;
    const int K = g.K, nt = K / BK;
    unsigned voffA[2], voffB[2];
#pragma unroll
    for (int i = 0; i < 2; ++i) { int R, C; stage_rc(tid * 16 + i * 8192, R, C); const int Rb = Epi::PERM ? ((R & ~31) + perm32(R & 31)) : R;
        voffA[i] = (unsigned)(R * K + C) * 2u; voffB[i] = (unsigned)(Rb * K + C) * 2u; }
    const size_t kstep = (size_t)(BK * 2);
    const size_t hstep = (size_t)HALF * K * 2;
    const size_t tstep = 2 * hstep;
    const unsigned ldsw = (unsigned)wid * 1024u;
    const int aoff = lds_byte(wr * 64 + fr, fq * 8), boff = lds_byte(wc * 32 + fr, fq * 8);
#define PG8_SA(b, h) (((b) * 2 + (h)) * HTB)
#define PG8_SB(b, h) ((4 + (b) * 2 + (h)) * HTB)
#define PG8_STAGE(bufoff, gbase, voff) do { _Pragma("unroll") for (int _i = 0; _i < 2; ++_i) \
        __builtin_amdgcn_global_load_lds((const unsigned*)((const char*)(gbase) + (voff)[_i]), (PG8_LAS unsigned*)(lds + (bufoff) + ldsw + _i * 8192), 16, 0, 0); } while (0)
#define PG8_LDA(dst, b, h) do { _Pragma("unroll") for (int m = 0; m < 4; ++m) _Pragma("unroll") for (int k = 0; k < 2; ++k) dst[m][k] = *(const PG8_LAS bf16x8*)(lds + PG8_SA(b, h) + aoff + m * 2048 + k * 1024); } while (0)
#define PG8_LDB(dst, b, h) do { _Pragma("unroll") for (int n = 0; n < 2; ++n) _Pragma("unroll") for (int k = 0; k < 2; ++k) dst[n][k] = *(const PG8_LAS bf16x8*)(lds + PG8_SB(b, h) + boff + n * 2048 + k * 1024); } while (0)
#define PG8_MMA(ai, bj, At, Bt) do { __builtin_amdgcn_s_setprio(1); _Pragma("unroll") for (int m = 0; m < 4; ++m) _Pragma("unroll") for (int n = 0; n < 2; ++n) _Pragma("unroll") for (int k = 0; k < 2; ++k) \
        acc[ai][bj][m][n] = __builtin_amdgcn_mfma_f32_16x16x32_bf16(Bt[n][k], At[m][k], acc[ai][bj][m][n], 0, 0, 0); __builtin_amdgcn_s_setprio(0); } while (0)
#define PG8_WAIT_V(n) asm volatile("s_waitcnt vmcnt(" #n ")" ::: "memory")
#define PG8_WAIT_L(n) asm volatile("s_waitcnt lgkmcnt(" #n ")" ::: "memory")
#define PG8_BAR __builtin_amdgcn_s_barrier()
#define PG8_SCHED __builtin_amdgcn_sched_barrier(0)
    Unit cur, nxt; int ui = 0;
    if (!S.next(0, cur)) return;
    f32x4 acc[2][2][4][2];
#pragma unroll
    for (int a = 0; a < 2; ++a)
#pragma unroll
        for (int b = 0; b < 2; ++b)
#pragma unroll
            for (int m = 0; m < 4; ++m)
#pragma unroll
                for (int n = 0; n < 2; ++n) acc[a][b][m][n] = (f32x4){0.f, 0.f, 0.f, 0.f};
    bf16x8 At[4][2], B0[2][2], B1[2][2];
    const char* cA = (const char*)g.A + (size_t)cur.pm * tstep; const char* cB = (const char*)g.Bt + (size_t)cur.pn * tstep;
    S.a_ready(cur);
    if constexpr (SP2) {
        PG8_STAGE(PG8_SB(0, 0), cB, voffB); PG8_STAGE(PG8_SB(0, 1), cB + hstep, voffB); PG8_STAGE(PG8_SA(0, 0), cA, voffA); PG8_STAGE(PG8_SA(0, 1), cA + hstep, voffA);
        if (wr == 1) PG8_BAR;
        PG8_WAIT_V(2); PG8_BAR;
        PG8_STAGE(PG8_SB(1, 0), cB + kstep, voffB); PG8_STAGE(PG8_SA(1, 0), cA + kstep, voffA); PG8_STAGE(PG8_SB(1, 1), cB + hstep + kstep, voffB);
        PG8_WAIT_V(6); PG8_BAR;
    } else {
        PG8_STAGE(PG8_SB(0, 0), cB, voffB); PG8_STAGE(PG8_SA(0, 0), cA, voffA); PG8_STAGE(PG8_SB(0, 1), cB + hstep, voffB); PG8_STAGE(PG8_SA(0, 1), cA + hstep, voffA);
        if (wr == 1) PG8_BAR;
        PG8_WAIT_V(4); PG8_BAR;
        PG8_STAGE(PG8_SB(1, 0), cB + kstep, voffB); PG8_STAGE(PG8_SA(1, 0), cA + kstep, voffA); PG8_STAGE(PG8_SB(1, 1), cB + hstep + kstep, voffB);
        PG8_WAIT_V(6); PG8_BAR;
    }
    for (;;) {
        const bool has_next = S.next(ui + 1, nxt);
        const char* nA = has_next ? (const char*)g.A + (size_t)nxt.pm * tstep : cA; const char* nB = has_next ? (const char*)g.Bt + (size_t)nxt.pn * tstep : cB;
        for (int t = 0; t < nt; t += 2) {
            const bool last = (t == nt - 2);
            const char* a1 = cA + (size_t)(t + 1) * kstep;
            const char* a2 = last ? nA : cA + (size_t)(t + 2) * kstep; const char* b2 = last ? nB : cB + (size_t)(t + 2) * kstep;
            const char* a3 = a2 + kstep; const char* b3 = b2 + kstep;
            if (last && has_next) S.a_ready(nxt);
            if constexpr (SP2) {
            PG8_LDB(B0, 0, 0); PG8_LDB(B1, 0, 1); PG8_SCHED; PG8_LDA(At, 0, 0); PG8_STAGE(PG8_SA(1, 1), a1 + hstep, voffA);
            PG8_WAIT_V(8); PG8_WAIT_L(0); PG8_BAR; PG8_MMA(0, 0, At, B0); PG8_MMA(0, 1, At, B1); PG8_BAR; PG8_SCHED;
            PG8_LDA(At, 0, 1); PG8_STAGE(PG8_SB(0, 0), b2, voffB); PG8_STAGE(PG8_SB(0, 1), b2 + hstep, voffB); PG8_STAGE(PG8_SA(0, 0), a2, voffA);
            PG8_WAIT_V(8); PG8_WAIT_L(0); PG8_BAR; PG8_MMA(1, 0, At, B0); PG8_MMA(1, 1, At, B1); PG8_BAR; PG8_SCHED;
            PG8_LDB(B0, 1, 0); PG8_LDB(B1, 1, 1); PG8_SCHED; PG8_LDA(At, 1, 0); PG8_STAGE(PG8_SA(0, 1), a2 + hstep, voffA);
            PG8_WAIT_V(8); PG8_WAIT_L(0); PG8_BAR; PG8_MMA(0, 0, At, B0); PG8_MMA(0, 1, At, B1); PG8_BAR; PG8_SCHED;
            PG8_LDA(At, 1, 1); PG8_STAGE(PG8_SB(1, 0), b3, voffB); PG8_STAGE(PG8_SB(1, 1), b3 + hstep, voffB); PG8_STAGE(PG8_SA(1, 0), a3, voffA);
            PG8_WAIT_V(8); PG8_WAIT_L(0); PG8_BAR; PG8_MMA(1, 0, At, B0); PG8_MMA(1, 1, At, B1); PG8_BAR; PG8_SCHED;
            } else {
            PG8_LDB(B0, 0, 0); PG8_SCHED; PG8_LDA(At, 0, 0); PG8_STAGE(PG8_SA(1, 1), a1 + hstep, voffA);
            PG8_WAIT_L(8); PG8_BAR; PG8_WAIT_L(0); PG8_MMA(0, 0, At, B0); PG8_BAR; PG8_SCHED;
            PG8_LDB(B1, 0, 1); PG8_STAGE(PG8_SB(0, 0), b2, voffB);
            PG8_BAR; PG8_WAIT_L(0); PG8_MMA(0, 1, At, B1); PG8_BAR;
            PG8_LDA(At, 0, 1); PG8_STAGE(PG8_SA(0, 0), a2, voffA);
            PG8_BAR; PG8_WAIT_L(0); PG8_MMA(1, 0, At, B0); PG8_BAR; PG8_SCHED;
            PG8_STAGE(PG8_SB(0, 1), b2 + hstep, voffB);
            PG8_WAIT_V(6); PG8_BAR; PG8_MMA(1, 1, At, B1); PG8_BAR;
            PG8_LDB(B0, 1, 0); PG8_SCHED; PG8_LDA(At, 1, 0); PG8_STAGE(PG8_SA(0, 1), a2 + hstep, voffA);
            PG8_WAIT_L(8); PG8_BAR; PG8_WAIT_L(0); PG8_MMA(0, 0, At, B0); PG8_BAR; PG8_SCHED;
            PG8_LDB(B1, 1, 1); PG8_STAGE(PG8_SB(1, 0), b3, voffB);
            PG8_BAR; PG8_WAIT_L(0); PG8_MMA(0, 1, At, B1); PG8_BAR;
            PG8_LDA(At, 1, 1); PG8_STAGE(PG8_SA(1, 0), a3, voffA);
            PG8_BAR; PG8_WAIT_L(0); PG8_MMA(1, 0, At, B0); PG8_BAR; PG8_SCHED;
            PG8_STAGE(PG8_SB(1, 1), b3 + hstep, voffB);
            PG8_WAIT_V(6); PG8_BAR; PG8_MMA(1, 1, At, B1); PG8_BAR;
            }
        }
        if constexpr (ALIGN_EPI) { if (wr == 0) PG8_BAR; }
        if constexpr (!Epi::AFTER_DRAIN) { E(acc, cur, wr, wc, fr, fq); S.done(cur); }
        if (!has_next) break;
#pragma unroll
        for (int a = 0; a < 2; ++a)
#pragma unroll
            for (int b = 0; b < 2; ++b)
#pragma unroll
                for (int m = 0; m < 4; ++m)
#pragma unroll
                    for (int n = 0; n < 2; ++n) acc[a][b][m][n] = (f32x4){0.f, 0.f, 0.f, 0.f};
        cur = nxt; cA = nA; cB = nB; ++ui;
        if constexpr (ALIGN_EPI) { if (wr == 1) PG8_BAR; }
    }
    PG8_WAIT_V(0);
    if constexpr (!ALIGN_EPI) { if (wr == 0) PG8_BAR; }
    PG8_BAR;
    if constexpr (Epi::AFTER_DRAIN) { E.fused(acc, cur, wr, wc, fr, fq, lds, wid, lane); S.done(cur); }
#undef PG8_SA
#undef PG8_SB
#undef PG8_STAGE
#undef PG8_LDA
#undef PG8_LDB
#undef PG8_MMA
#undef PG8_WAIT_V
#undef PG8_WAIT_L
#undef PG8_BAR
#undef PG8_SCHED
}
}
constexpr int NWAVES = 8, NTHR = 512;
#ifndef MK_N_LAUNCHES
#define MK_N_LAUNCHES 1
#endif
constexpr int PER_PHASE = 14;
constexpr int N_LAUNCHES = MK_N_LAUNCHES;

constexpr int DM = 1024, NPROMPT = 32768, NSAMP = 512, NTOK = 33280, NSHIFT = 32, MPAD = 33536, N1 = 5632;
constexpr int SEQ_P = 4096, SEQ_S = 16, NB_P = 8, NB_S = 32;
constexpr size_t O_Y = 0, O_CONV_P = 34078720, O_SHIFT_P = 34086912, O_WKV_P = 34095104, O_CONV_S = 34357248, O_SHIFT_S = 34390016, O_WKV_S = 34422784;
constexpr size_t KiB = 1024, MiB = 1u << 20;
constexpr size_t WS_CTL = 0, CTL_ZERO_BYTES = 64 * KiB;
constexpr size_t WS_W1T = 64 * KiB;
constexpr size_t WS_WPA = WS_W1T + (size_t)N1 * DM * 2;
constexpr size_t WS_WPB = WS_WPA + 1 * MiB;
constexpr size_t WS_WO = WS_WPB + 1 * MiB;
constexpr size_t WS_WQ = WS_WO + 2 * MiB;
constexpr size_t WS_KEYS = WS_WQ + 4 * MiB;
constexpr size_t WS_L2T = WS_KEYS + 512 * KiB;
constexpr size_t WS_SSP = WS_L2T + 256 * KiB;
constexpr size_t WS_UB = WS_SSP + (size_t)MPAD * 16 * 4;
constexpr size_t WS_VB = WS_UB + 16 * MiB;
constexpr size_t WS_A1 = WS_VB + 16 * MiB;
constexpr size_t WS_ZC = WS_A1 + (size_t)MPAD * DM * 2;
constexpr size_t WS_ZR = WS_ZC + (size_t)MPAD * 1536 * 2;
constexpr size_t WS_ZG = WS_ZR + (size_t)MPAD * 2048 * 2;
constexpr size_t WS_END = WS_ZG + (size_t)MPAD * 2048 * 2;
constexpr size_t WS_YL = WS_ZC, WS_ZT = WS_ZC + (size_t)NTOK * 512 * 2, WS_BV = WS_ZC + (size_t)NTOK * 512 * 4;
constexpr size_t WS_EIDX = WS_ZC, WS_GATE = WS_ZC + 16 * MiB, WS_COEF = WS_ZC + 40 * MiB, WS_SS2 = WS_ZC + 64 * MiB, WS_RSTD = WS_ZC + 66 * MiB;
constexpr size_t WS_PART = WS_ZR;
constexpr size_t OB_MB = (size_t)4352 * 4096 * 4;
constexpr size_t OB_S0S = OB_MB + (size_t)4352 * 4096 * 2;
static_assert(WS_BV + (size_t)NTOK * 512 * 2 <= WS_ZR && OB_S0S + (size_t)256 * 4096 * 2 <= (size_t)NTOK * 1024 * 4, "scan scratch maps");
static_assert(WS_END <= 512 * MiB, "d_ws map must fit 512 MiB");
constexpr float PEER_SU = 32.0f, PEER_SV = 4.0f;
constexpr int CW_BAR = 1024;
constexpr int LDS_BYTES = 163840;
constexpr int LDSCTL_OFF = LDS_BYTES - 512, MISC_OFF = LDSCTL_OFF + 320;

#define GAS __attribute__((address_space(1)))
#define LAS __attribute__((address_space(3)))
typedef unsigned short bf16;
typedef unsigned v4u __attribute__((ext_vector_type(4)));
typedef unsigned v2u __attribute__((ext_vector_type(2)));
typedef float f32x4 __attribute__((ext_vector_type(4)));
typedef short bf16x8 __attribute__((ext_vector_type(8)));
typedef __bf16 bf16x2_t __attribute__((ext_vector_type(2)));
typedef GAS unsigned gu32;
#define RLX_AGENT __ATOMIC_RELAXED, __HIP_MEMORY_SCOPE_AGENT
#define LDS_WAIT() asm volatile("s_waitcnt lgkmcnt(0)" ::: "memory")
#define VM_WAIT() asm volatile("s_waitcnt vmcnt(0)" ::: "memory")
using pg8::cvt_pk_bf16; using pg8::bf_lo; using pg8::bf_hi; using pg8::sigm;
#define XB_TMO      128
#define XB_XCNT(j)  (256  + 64 * (j))
#define XB_XSUB(j)  (1280 + 64 * (j))
#define XB_XGEN(j)  (2304 + 64 * (j))
#define XB_TOP      3328
#define XB_TOPGEN   3392
#define XCD_BAR_WORDS 3456
#define XB_SPIN_CAP (1u << 22)

__device__ __forceinline__ unsigned xb_ld(unsigned* p)              { return __hip_atomic_load(p, __ATOMIC_RELAXED, __HIP_MEMORY_SCOPE_AGENT); }
__device__ __forceinline__ unsigned xb_add(unsigned* p, unsigned v) { return __hip_atomic_fetch_add(p, v, __ATOMIC_RELAXED, __HIP_MEMORY_SCOPE_AGENT); }
__device__ __forceinline__ unsigned xb_xcc_id() { return (unsigned)__builtin_amdgcn_s_getreg((3 << 11) | 20) & 0xFu; }
#define XB_SPIN(cond, bar) do { unsigned _sp = 0; while (cond) { __builtin_amdgcn_s_sleep(1); \
    if ((++_sp & 255u) == 0u) { if (xb_ld(&(bar)[XB_TMO])) break; if (_sp > XB_SPIN_CAP) { atomicAdd(&(bar)[XB_TMO], 1u); break; } } } } while (0)

struct XcdBarrier {
    unsigned* bar; unsigned x;
    volatile LAS unsigned* st;
};

__device__ __forceinline__ XcdBarrier xcd_barrier_post(unsigned* bar, volatile LAS unsigned* st) {
    XcdBarrier b; b.bar = bar; b.x = xb_xcc_id(); b.st = st;
    if (threadIdx.x == 0) (void)xb_add(&bar[XB_XCNT(b.x)], 1u);
    return b;
}
__device__ __forceinline__ void xcd_barrier_complete(unsigned* bar, unsigned x, unsigned& nloc, unsigned& nx) {
    const unsigned G = gridDim.x * gridDim.y * gridDim.z;
    unsigned sum, cnt, mine, sp = 0u;
    for (;;) {
        sum = 0u; cnt = 0u; mine = 0u;
#pragma unroll
        for (unsigned j = 0; j < 16; ++j) { const unsigned c = xb_ld(&bar[XB_XCNT(j)]); sum += c; cnt += (c > 0u) ? 1u : 0u; mine = (j == x) ? c : mine; }
        if (sum == G) break;
        __builtin_amdgcn_s_sleep(1);
        if ((++sp & 255u) == 0u) { if (xb_ld(&bar[XB_TMO])) break; if (sp > XB_SPIN_CAP) { atomicAdd(&bar[XB_TMO], 1u); break; } }
    }
    nloc = mine > 0u ? mine : 1u; nx = cnt > 0u ? cnt : 1u;
}

__device__ __forceinline__ void xcd_barrier(const XcdBarrier& b) {
    asm volatile("s_waitcnt vmcnt(0)" ::: "memory");
    __syncthreads();
    if (threadIdx.x == 0) {
        unsigned* bar = b.bar;
        __builtin_amdgcn_s_waitcnt(0);
        unsigned nloc = b.st[0], nx = b.st[1];
        if (nloc == 0u) { xcd_barrier_complete(bar, b.x, nloc, nx); b.st[0] = nloc; b.st[1] = nx; }
        const unsigned old = xb_add(&bar[XB_XSUB(b.x)], 1u);
        const unsigned gen = old / nloc;
        if (old + 1u == (gen + 1u) * nloc) {
            __builtin_amdgcn_fence(__ATOMIC_RELEASE, "agent");
            asm volatile("s_waitcnt vmcnt(0)" ::: "memory");
            const unsigned og = xb_add(&bar[XB_TOP], 1u);
            const unsigned tg = og / nx;
            if (og + 1u == (tg + 1u) * nx) xb_add(&bar[XB_TOPGEN], 1u);
            else XB_SPIN(xb_ld(&bar[XB_TOPGEN]) == tg, bar);
            __builtin_amdgcn_fence(__ATOMIC_ACQUIRE, "agent");
            xb_add(&bar[XB_XGEN(b.x)], 1u);
            asm volatile("s_waitcnt vmcnt(0)" ::: "memory");
        } else {
            XB_SPIN(xb_ld(&bar[XB_XGEN(b.x)]) == gen, bar);
            __builtin_amdgcn_fence(__ATOMIC_ACQUIRE, "agent");
            asm volatile("s_waitcnt vmcnt(0)" ::: "memory");
        }
    }
    __syncthreads();
}
struct Args { const float* in[32]; float* out; unsigned char* ws; int ph_lo, ph_hi, li, pad; };
enum { I_XP = 0, I_XS, I_SCONV, I_SSHIFT, I_SWKV, I_N1G, I_WIN, I_CONVW, I_MURKV, I_MUWAG, I_W0, I_W1, I_W2, I_A0, I_A1, I_A2, I_G1, I_G2, I_KK, I_KA, I_RK, I_GNW, I_GNB, I_WPA, I_WPB, I_WO, I_N2G, I_WQ, I_KEYS, I_U, I_V, I_NFG };

__device__ __forceinline__ float wave_sum(float v) {
#pragma unroll
    for (int o = 1; o < 64; o <<= 1) v += __shfl_xor(v, o);
    return v;
}
template <int CTRL> __device__ __forceinline__ float dpp_mov(float v) { return __builtin_bit_cast(float, __builtin_amdgcn_update_dpp(0, __builtin_bit_cast(int, v), CTRL, 0xF, 0xF, true)); }
__device__ __forceinline__ float sum4(float v) { v += dpp_mov<0xB1>(v); v += dpp_mov<0x4E>(v); return v; }
__device__ __forceinline__ float sum8(float v) { v = sum4(v); v += dpp_mov<0x141>(v); return v; }
__device__ __forceinline__ float sum16(float v) { v = sum8(v); v += dpp_mov<0x140>(v); return v; }
__device__ __forceinline__ float dot2bf(unsigned w, unsigned x, float acc) { return __builtin_amdgcn_fdot2_f32_bf16(__builtin_bit_cast(bf16x2_t, w), __builtin_bit_cast(bf16x2_t, x), acc, false); }

__device__ __forceinline__ void transpose_item(const float* W, int ldw, int c0, int K, bf16* WT, int nblk, int item, const float* sv, float alpha, float beta, LAS float* scr, int lane, int rstride = 1) {
    const int kb = item / nblk, nb = item % nblk, k0 = 64 * kb, n0 = 32 * nb;
    float wv[32];
#pragma unroll
    for (int i = 0; i < 32; ++i) wv[i] = W[(size_t)(k0 + 2 * i + (lane >> 5)) * ldw + c0 + n0 + (lane & 31)];
#pragma unroll
    for (int i = 0; i < 32; ++i) { const int kk = 2 * i + (lane >> 5); float s = 1.f; if (sv) s = alpha + beta * sv[k0 + kk];
        scr[kk * 33 + (lane & 31)] = wv[i] * s; }
    LDS_WAIT();
    const int c = lane & 7;
#pragma unroll
    for (int j = 0; j < 4; ++j) { const int n = (lane >> 3) + 8 * j; const LAS float* s = scr + (8 * c) * 33 + n;
        v4u o; o.x = cvt_pk_bf16(s[0 * 33], s[1 * 33]); o.y = cvt_pk_bf16(s[2 * 33], s[3 * 33]); o.z = cvt_pk_bf16(s[4 * 33], s[5 * 33]); o.w = cvt_pk_bf16(s[6 * 33], s[7 * 33]);
        *(v4u*)(WT + (size_t)((n0 + n) * rstride) * K + k0 + 8 * c) = o; }
    LDS_WAIT();
}
__device__ __forceinline__ void cvt_stream(const float* src, bf16* dst, size_t n, size_t gt, size_t nthreads) {
    for (size_t i = gt * 8; i < n; i += nthreads * 8) { const f32x4 a = *(const f32x4*)(src + i), b = *(const f32x4*)(src + i + 4);
        v4u o; o.x = cvt_pk_bf16(a[0], a[1]); o.y = cvt_pk_bf16(a[2], a[3]); o.z = cvt_pk_bf16(b[0], b[1]); o.w = cvt_pk_bf16(b[2], b[3]); *(v4u*)(dst + i) = o; }
}
__device__ __forceinline__ void cvt_stream_fp8(const float* src, unsigned char* dst, size_t n, float scale, size_t gt, size_t nthreads) {
    for (size_t i = gt * 16; i < n; i += nthreads * 16) {
        const f32x4 a = *(const f32x4*)(src + i) * scale, b = *(const f32x4*)(src + i + 4) * scale, c = *(const f32x4*)(src + i + 8) * scale, d = *(const f32x4*)(src + i + 12) * scale;
        v4u o; unsigned p;
        p = __builtin_amdgcn_cvt_pk_fp8_f32(a[0], a[1], 0, false); o.x = __builtin_amdgcn_cvt_pk_fp8_f32(a[2], a[3], p, true);
        p = __builtin_amdgcn_cvt_pk_fp8_f32(b[0], b[1], 0, false); o.y = __builtin_amdgcn_cvt_pk_fp8_f32(b[2], b[3], p, true);
        p = __builtin_amdgcn_cvt_pk_fp8_f32(c[0], c[1], 0, false); o.z = __builtin_amdgcn_cvt_pk_fp8_f32(c[2], c[3], p, true);
        p = __builtin_amdgcn_cvt_pk_fp8_f32(d[0], d[1], 0, false); o.w = __builtin_amdgcn_cvt_pk_fp8_f32(d[2], d[3], p, true);
        *(v4u*)(dst + i) = o; }
}
__device__ __forceinline__ void cvt16_fp8_sliced(const float* src, unsigned char* dst, float scale, size_t i) {
    const f32x4 a = *(const f32x4*)(src + i) * scale, b = *(const f32x4*)(src + i + 4) * scale, c = *(const f32x4*)(src + i + 8) * scale, d = *(const f32x4*)(src + i + 12) * scale;
    v4u o; unsigned p;
    p = __builtin_amdgcn_cvt_pk_fp8_f32(a[0], a[1], 0, false); o.x = __builtin_amdgcn_cvt_pk_fp8_f32(a[2], a[3], p, true);
    p = __builtin_amdgcn_cvt_pk_fp8_f32(b[0], b[1], 0, false); o.y = __builtin_amdgcn_cvt_pk_fp8_f32(b[2], b[3], p, true);
    p = __builtin_amdgcn_cvt_pk_fp8_f32(c[0], c[1], 0, false); o.z = __builtin_amdgcn_cvt_pk_fp8_f32(c[2], c[3], p, true);
    p = __builtin_amdgcn_cvt_pk_fp8_f32(d[0], d[1], 0, false); o.w = __builtin_amdgcn_cvt_pk_fp8_f32(d[2], d[3], p, true);
    const size_t e = i >> 10, col = i & 1023;
    *(v4u*)(dst + (col >> 7) * ((size_t)16384 * 128) + e * 128 + (col & 127)) = o;
}
__device__ __forceinline__ void cvt_stream_fp8_sliced(const float* src, unsigned char* dst, float scale, size_t gt, size_t nthreads) {
#pragma unroll 2
    for (size_t i = gt * 16; i < (size_t)16384 * 1024; i += nthreads * 16) {
        const f32x4 a = *(const f32x4*)(src + i) * scale, b = *(const f32x4*)(src + i + 4) * scale, c = *(const f32x4*)(src + i + 8) * scale, d = *(const f32x4*)(src + i + 12) * scale;
        v4u o; unsigned p;
        p = __builtin_amdgcn_cvt_pk_fp8_f32(a[0], a[1], 0, false); o.x = __builtin_amdgcn_cvt_pk_fp8_f32(a[2], a[3], p, true);
        p = __builtin_amdgcn_cvt_pk_fp8_f32(b[0], b[1], 0, false); o.y = __builtin_amdgcn_cvt_pk_fp8_f32(b[2], b[3], p, true);
        p = __builtin_amdgcn_cvt_pk_fp8_f32(c[0], c[1], 0, false); o.z = __builtin_amdgcn_cvt_pk_fp8_f32(c[2], c[3], p, true);
        p = __builtin_amdgcn_cvt_pk_fp8_f32(d[0], d[1], 0, false); o.w = __builtin_amdgcn_cvt_pk_fp8_f32(d[2], d[3], p, true);
        const size_t e = i >> 10, col = i & 1023;
        *(v4u*)(dst + (col >> 7) * ((size_t)16384 * 128) + e * 128 + (col & 127)) = o; }
}
__device__ __forceinline__ void p0_prologue(const Args& A, LAS unsigned char* lds, int tid, int lane, int wave, int vcu, int G) {
    unsigned char* ws = A.ws;
    bf16* W1T = (bf16*)(ws + WS_W1T);
    LAS float* scr = (LAS float*)(lds + wave * 16384);
    const int gw = vcu * NWAVES + wave, NGW = G * NWAVES;
    constexpr int J0 = 16 * 96, JB_ = 16 * 16, J1 = 16 * 64, JL = 16 * 2, JG = 16 * 4, JP = 8 * 32, JO = 16 * 32, JQ = 16 * 64;
    constexpr int JW2 = 16, JG2 = 32;
    constexpr int NITEMS = J0 + J1 + 4 * JL + 2 * JG + 2 * JP + JO + JQ + 2 * JW2 + JG2;
    bf16* L2T = (bf16*)(ws + WS_L2T);
    const float* mu = A.in[I_MUWAG];
    for (int it = gw; it < NITEMS; it += NGW) {
        int r = it;
        if (r < J0) {
            if (r < JB_) transpose_item(A.in[I_WIN], 5120, 0, 1024, W1T, 16, r, nullptr, 0.f, 0.f, scr, lane);
            else if (r < 2 * JB_) transpose_item(A.in[I_WIN], 5120, 512, 1024, W1T + (size_t)512 * 1024, 16, r - JB_, nullptr, 0.f, 0.f, scr, lane, 2);
            else if (r < 3 * JB_) transpose_item(A.in[I_WIN], 5120, 1024, 1024, W1T + (size_t)513 * 1024, 16, r - 2 * JB_, nullptr, 0.f, 0.f, scr, lane, 2);
            else transpose_item(A.in[I_WIN], 5120, 1536, 1024, W1T + (size_t)1536 * 1024, 48, r - 3 * JB_, nullptr, 0.f, 0.f, scr, lane);
            continue; } r -= J0;
        if (r < J1) { transpose_item(A.in[I_WIN], 5120, 3072, 1024, W1T + (size_t)3584 * 1024, 64, r, nullptr, 0.f, 0.f, scr, lane); continue; } r -= J1;
        if (r < JL) { transpose_item(A.in[I_W1], 64, 0, 1024, W1T + (size_t)3072 * 1024, 2, r, mu, 1.f, -1.f, scr, lane); continue; } r -= JL;
        if (r < JL) { transpose_item(A.in[I_W1], 64, 0, 1024, W1T + (size_t)3328 * 1024, 2, r, mu, 0.f, 1.f, scr, lane); continue; } r -= JL;
        if (r < JL) { transpose_item(A.in[I_A1], 64, 0, 1024, W1T + (size_t)(3072 + 64) * 1024, 2, r, mu + 1024, 1.f, -1.f, scr, lane); continue; } r -= JL;
        if (r < JL) { transpose_item(A.in[I_A1], 64, 0, 1024, W1T + (size_t)(3328 + 64) * 1024, 2, r, mu + 1024, 0.f, 1.f, scr, lane); continue; } r -= JL;
        if (r < JG) { transpose_item(A.in[I_G1], 128, 0, 1024, W1T + (size_t)(3072 + 128) * 1024, 4, r, mu + 2048, 1.f, -1.f, scr, lane); continue; } r -= JG;
        if (r < JG) { transpose_item(A.in[I_G1], 128, 0, 1024, W1T + (size_t)(3328 + 128) * 1024, 4, r, mu + 2048, 0.f, 1.f, scr, lane); continue; } r -= JG;
        if (r < JP) { transpose_item(A.in[I_WPA], 1024, 0, 512, (bf16*)(ws + WS_WPA), 32, r, nullptr, 0.f, 0.f, scr, lane); continue; } r -= JP;
        if (r < JP) { transpose_item(A.in[I_WPB], 1024, 0, 512, (bf16*)(ws + WS_WPB), 32, r, nullptr, 0.f, 0.f, scr, lane); continue; } r -= JP;
        if (r < JO) { transpose_item(A.in[I_WO], 1024, 0, 1024, (bf16*)(ws + WS_WO), 32, r, nullptr, 0.f, 0.f, scr, lane); continue; } r -= JO;
        if (r < JQ) { transpose_item(A.in[I_WQ], 2048, 0, 1024, (bf16*)(ws + WS_WQ), 64, r, nullptr, 0.f, 0.f, scr, lane); continue; } r -= JQ;
        if (r < JW2) { transpose_item(A.in[I_W2], 512, 0, 64, L2T, 16, r, nullptr, 0.f, 0.f, scr, lane); continue; } r -= JW2;
        if (r < JW2) { transpose_item(A.in[I_A2], 512, 0, 64, L2T + (size_t)512 * 64, 16, r, nullptr, 0.f, 0.f, scr, lane); continue; } r -= JW2;
        transpose_item(A.in[I_G2], 512, 0, 128, L2T + (size_t)1024 * 64, 16, r, nullptr, 0.f, 0.f, scr, lane);
    }
    const size_t gt = (size_t)vcu * NTHR + tid, nth = (size_t)G * NTHR;
    if (G != 256) {
        cvt_stream_fp8_sliced(A.in[I_U], ws + WS_UB, PEER_SU, gt, nth);
        cvt_stream_fp8_sliced(A.in[I_V], ws + WS_VB, PEER_SV, gt, nth); }
    cvt_stream(A.in[I_KEYS], (bf16*)(ws + WS_KEYS), (size_t)8 * 2 * 128 * 128, gt, nth);
    bf16* A1 = (bf16*)(ws + WS_A1);
    const f32x4* g1v = (const f32x4*)A.in[I_N1G] + lane;
    for (int m0 = gw; m0 < NTOK; m0 += 2 * NGW) {
        const int m1 = m0 + NGW; const bool two = m1 < NTOK; const int m1c = two ? m1 : m0;
        const f32x4* xr0 = (const f32x4*)(m0 < NPROMPT ? A.in[I_XP] + (size_t)m0 * DM : A.in[I_XS] + (size_t)(m0 - NPROMPT) * DM) + lane;
        const f32x4* xr1 = (const f32x4*)(m1c < NPROMPT ? A.in[I_XP] + (size_t)m1c * DM : A.in[I_XS] + (size_t)(m1c - NPROMPT) * DM) + lane;
        f32x4 v0[4], v1[4]; float s0 = 0.f, s1 = 0.f;
#pragma unroll
        for (int j = 0; j < 4; ++j) { v0[j] = xr0[64 * j]; v1[j] = xr1[64 * j]; }
#pragma unroll
        for (int j = 0; j < 4; ++j) { s0 += (v0[j][0] * v0[j][0] + v0[j][1] * v0[j][1]) + (v0[j][2] * v0[j][2] + v0[j][3] * v0[j][3]);
                                      s1 += (v1[j][0] * v1[j][0] + v1[j][1] * v1[j][1]) + (v1[j][2] * v1[j][2] + v1[j][3] * v1[j][3]); }
#pragma unroll
        for (int o = 1; o < 64; o <<= 1) { s0 += __shfl_xor(s0, o); s1 += __shfl_xor(s1, o); }
        const float r0 = __builtin_amdgcn_rsqf(s0 * (1.f / DM) + 1e-6f), r1 = __builtin_amdgcn_rsqf(s1 * (1.f / DM) + 1e-6f);
#pragma unroll
        for (int rr = 0; rr < 2; ++rr) {
            if (rr == 1 && !two) break;
            const int m = rr ? m1 : m0; const float rstd = rr ? r1 : r0;
            v2u* o8 = (v2u*)(A1 + (size_t)m * DM) + lane;
            float* so = nullptr;
            if (m < NPROMPT) { if ((m & (SEQ_P - 1)) == SEQ_P - 1) so = A.out + O_SHIFT_P + (size_t)(m / SEQ_P) * DM; }
            else { const int ms = m - NPROMPT; if ((ms & (SEQ_S - 1)) == SEQ_S - 1) so = A.out + O_SHIFT_S + (size_t)(ms / SEQ_S) * DM; }
#pragma unroll
            for (int j = 0; j < 4; ++j) { const f32x4 g = g1v[64 * j]; const f32x4 y = (rr ? v1[j] : v0[j]) * rstd * g;
                v2u w; w.x = cvt_pk_bf16(y[0], y[1]); w.y = cvt_pk_bf16(y[2], y[3]); o8[64 * j] = w;
                if (so) ((f32x4*)so)[lane + 64 * j] = y; }
        }
    }
    for (int m = NTOK + gw; m < MPAD; m += NGW) {
        v2u* o8 = (v2u*)(A1 + (size_t)m * DM) + lane;
        if (m < NTOK + NSHIFT) {
            const f32x4* xr = (const f32x4*)(A.in[I_SSHIFT] + (size_t)(m - NTOK) * DM) + lane;
#pragma unroll
            for (int j = 0; j < 4; ++j) { const f32x4 y = xr[64 * j]; v2u w; w.x = cvt_pk_bf16(y[0], y[1]); w.y = cvt_pk_bf16(y[2], y[3]); o8[64 * j] = w; }
        } else {
#pragma unroll
            for (int j = 0; j < 4; ++j) { v2u w; w.x = 0u; w.y = 0u; o8[64 * j] = w; }
        }
    }
}

__device__ __forceinline__ void unpack8(const v4u w, float (&f)[8]) { f[0] = bf_lo(w.x); f[1] = bf_hi(w.x); f[2] = bf_lo(w.y); f[3] = bf_hi(w.y); f[4] = bf_lo(w.z); f[5] = bf_hi(w.z); f[6] = bf_lo(w.w); f[7] = bf_hi(w.w); }
__device__ __forceinline__ void conv_phase(const Args& A, int gt, int nth) {
    const bf16* Zc = (const bf16*)(A.ws + WS_ZC); bf16* YA = (bf16*)(A.ws + WS_A1);
    const float* cw = A.in[I_CONVW];
    for (int task = gt; task < (NTOK / 16) * 64; task += nth) {
        const int seg = task >> 6, ch = (task & 63) * 8, row0 = seg * 16;
        int b, t0, T; bool prompt = row0 < NPROMPT;
        if (prompt) { b = row0 / SEQ_P; t0 = row0 % SEQ_P; T = SEQ_P; } else { b = (row0 - NPROMPT) / SEQ_S; t0 = 0; T = SEQ_S; }
        float um2[8], um1[8], c0[8], c1[8], c2[8];
#pragma unroll
        for (int i = 0; i < 8; ++i) { c0[i] = cw[ch + i]; c1[i] = cw[512 + ch + i]; c2[i] = cw[1024 + ch + i]; }
        if (t0 == 0) {
            if (prompt) {
#pragma unroll
                for (int i = 0; i < 8; ++i) { um2[i] = 0.f; um1[i] = 0.f; }
            } else { const float* sc = A.in[I_SCONV] + (size_t)b * 2 * 512 + ch;
#pragma unroll
                for (int i = 0; i < 8; ++i) { um2[i] = sc[i]; um1[i] = sc[512 + i]; } }
        } else {
            unpack8(*(const v4u*)(Zc + (size_t)(row0 - 2) * 1024 + 512 + ch), um2); unpack8(*(const v4u*)(Zc + (size_t)(row0 - 1) * 1024 + 512 + ch), um1);
        }
#pragma unroll 4
        for (int t = 0; t < 16; ++t) {
            const size_t row = (size_t)(row0 + t);
            float zb[8], zu[8], y[8];
            unpack8(*(const v4u*)(Zc + row * 1024 + ch), zb); unpack8(*(const v4u*)(Zc + row * 1024 + 512 + ch), zu);
#pragma unroll
            for (int i = 0; i < 8; ++i) { const float u = zu[i]; y[i] = zb[i] * (c0[i] * um2[i] + c1[i] * um1[i] + c2[i] * u); um2[i] = um1[i]; um1[i] = u; }
            v4u o; o.x = cvt_pk_bf16(y[0], y[1]); o.y = cvt_pk_bf16(y[2], y[3]); o.z = cvt_pk_bf16(y[4], y[5]); o.w = cvt_pk_bf16(y[6], y[7]);
            *(v4u*)(YA + row * 512 + ch) = o;
        }
        if (t0 + 16 == T) { float* oc = A.out + (prompt ? O_CONV_P : O_CONV_S) + (size_t)b * 2 * 512 + ch;
#pragma unroll
            for (int i = 0; i < 8; ++i) { oc[i] = um2[i]; oc[512 + i] = um1[i]; } }
    }
    bf16* Zr = (bf16*)(A.ws + WS_ZR);
    for (int task = nth - 1 - gt; task < NTOK * 16; task += nth) {
        const int m = task >> 4, cs = task & 15;
        bool hasprev; int prow;
        if (m < NPROMPT) { hasprev = (m & (SEQ_P - 1)) != 0; prow = m - 1; } else { const int ms = m - NPROMPT; hasprev = true; prow = (ms & (SEQ_S - 1)) ? m - 1 : NTOK + ms / SEQ_S; }
        bf16* pap = Zr + (size_t)m * 2048 + 1536 + cs * 16;
        float pa[16], t8[8];
        const v4u a0 = *(const v4u*)pap, a1 = *(const v4u*)(pap + 8);
        v4u b0 = (v4u){0u, 0u, 0u, 0u}, b1 = b0;
        if (hasprev) { const bf16* pbp = Zr + (size_t)prow * 2048 + 1792 + cs * 16; b0 = *(const v4u*)pbp; b1 = *(const v4u*)(pbp + 8); }
        unpack8(a0, t8);
#pragma unroll
        for (int i = 0; i < 8; ++i) pa[i] = t8[i];
        unpack8(a1, t8);
#pragma unroll
        for (int i = 0; i < 8; ++i) pa[8 + i] = t8[i];
        unpack8(b0, t8);
#pragma unroll
        for (int i = 0; i < 8; ++i) pa[i] += t8[i];
        unpack8(b1, t8);
#pragma unroll
        for (int i = 0; i < 8; ++i) pa[8 + i] += t8[i];
#pragma unroll
        for (int i = 0; i < 16; ++i) { float p = pa[i];
            if (cs < 4) p = 1.0f - 2.0f * __builtin_amdgcn_rcpf(__expf(2.0f * p) + 1.0f);
            else if (cs >= 8) p = sigm(p);
            pa[i] = p; }
        v4u o0, o1; o0.x = cvt_pk_bf16(pa[0], pa[1]); o0.y = cvt_pk_bf16(pa[2], pa[3]); o0.z = cvt_pk_bf16(pa[4], pa[5]); o0.w = cvt_pk_bf16(pa[6], pa[7]);
        o1.x = cvt_pk_bf16(pa[8], pa[9]); o1.y = cvt_pk_bf16(pa[10], pa[11]); o1.z = cvt_pk_bf16(pa[12], pa[13]); o1.w = cvt_pk_bf16(pa[14], pa[15]);
        *(v4u*)pap = o0; *(v4u*)(pap + 8) = o1;
    }
}

constexpr int NUNITS_P = NB_P * 8 * 64, NUNITS = NUNITS_P + NB_S * 8;
constexpr int HID_STRIDE = 264, SC_TB = 32;
constexpr int P1_HIDB = 0, P1_LO = 16896, P1_SEQ = 41472, P1_GG = 90624, P1_YY = 98816, P1_ZZ = 107008, P1_BON = 115200;
typedef float f32x2 __attribute__((ext_vector_type(2)));

struct P1Pre { v4u pa0, pa1; v2u zr, zk, zv, pr, pk, pv; };
struct P1Pos { int unit, t0; };
__device__ __forceinline__ void p1_decode(int unit, bool& prompt, int& b, int& h, int& ch, int& T, int& rowbase) {
    prompt = unit < NUNITS_P; b = prompt ? unit >> 9 : (unit - NUNITS_P) >> 3; h = prompt ? (unit >> 6) & 7 : unit & 7; ch = prompt ? unit & 63 : 0;
    T = prompt ? 64 : SEQ_S; rowbase = prompt ? b * SEQ_P + ch * 64 : NPROMPT + b * SEQ_S;
}
__device__ __forceinline__ void p1_rows(int unit, int t0, int tt, size_t& row, size_t& prow, bool& hasprev, int& nb) {
    bool prompt; int b, h, ch, T, rowbase; p1_decode(unit, prompt, b, h, ch, T, rowbase);
    nb = (T - t0) < SC_TB ? (T - t0) : SC_TB;
    const int tloc = tt < nb ? tt : nb - 1, t = t0 + tloc; const bool first = (ch == 0);
    row = (size_t)(rowbase + t); hasprev = (t > 0) || !first || !prompt; prow = ((t > 0) || !first) ? row - 1 : (size_t)(NTOK + b);
}
__device__ __forceinline__ void p1_load(const Args& A, int unit, int t0, int tt, int cs, P1Pre& P) {
    size_t row, prow; bool hasprev; int nb; p1_rows(unit, t0, tt, row, prow, hasprev, nb);
    const int h = unit < NUNITS_P ? (unit >> 6) & 7 : unit & 7, hc = h * 64 + cs * 4;
    const bf16* Zr = (const bf16*)(A.ws + WS_ZR);
    P.pa0 = *(const v4u*)(Zr + row * 2048 + 1536 + cs * 16); P.pa1 = *(const v4u*)(Zr + row * 2048 + 1536 + cs * 16 + 8);
    P.zr = *(const v2u*)(Zr + row * 2048 + hc); P.zk = *(const v2u*)(Zr + row * 2048 + 512 + hc); P.zv = *(const v2u*)(Zr + row * 2048 + 1024 + hc);
    const v2u z2 = (v2u){0u, 0u};
    P.pr = z2; P.pk = z2; P.pv = z2;
    if (hasprev) { P.pr = *(const v2u*)(Zr + prow * 2048 + hc); P.pk = *(const v2u*)(Zr + prow * 2048 + 512 + hc); P.pv = *(const v2u*)(Zr + prow * 2048 + 1024 + hc); }
}
__device__ __forceinline__ bool p1_unit_at(int i, int vcu, int G, int& unit) {
    if (G == 256) { if (i > 16) return false; unit = i < 16 ? vcu * 16 + i : NUNITS_P + vcu; return true; }
    unit = vcu + i * G; return unit < NUNITS;
}

constexpr int WY_OS = 72, WY_TS = 24, WY_LS = 40;
constexpr int WY_AT = 0, WY_RT = WY_AT + 16 * WY_OS * 2, WY_BT = WY_RT + 16 * WY_OS * 2, WY_KT = WY_BT + 16 * WY_OS * 2, WY_BK = WY_KT + 16 * WY_OS * 2,
              WY_VT = WY_BK + 64 * WY_LS * 2, WY_GC = WY_VT + 64 * WY_TS * 2, WY_BUF = WY_GC + 256;
constexpr int WY_BASE = 0;
constexpr int WY_GSET = 1024 + 2 * 16 * WY_LS * 2 + 1024;
constexpr int WY_LAB = WY_BASE + 2 * WY_BUF;
static_assert(WY_LAB + WY_GSET <= P1_SEQ, "UT-transform operands must fit over HIDB | LO");
constexpr int WY_XB = 115328, WY_END = WY_XB + 128 * WY_OS * 2;
static_assert(WY_END <= LDSCTL_OFF, "LDS map of pass 1");

constexpr int WY_G2 = P1_GG + 2048;
static_assert(WY_G2 + WY_GSET <= P1_YY, "second Gram set");
__device__ __forceinline__ void p1_wy(f32x4 (&X)[4], const LAS float* SEQ, LAS float* YY, LAS float* ZZ, LAS unsigned char* lds, int nb, int tid, int lane, int wave, int part = 0) {
    const bool pw = wave >= 4; const int nmc = nb >> 4;
    LAS bf16* Xb = (LAS bf16*)(lds + WY_XB);
    for (int mc = 0; mc < nmc; ++mc) {
        asm volatile("" : "+v"(tid));
        LAS unsigned char* ob = lds + WY_BASE + mc * WY_BUF;
        LAS bf16* At = (LAS bf16*)(ob + WY_AT); LAS bf16* Rt = (LAS bf16*)(ob + WY_RT); LAS bf16* Bt = (LAS bf16*)(ob + WY_BT); LAS bf16* Kt = (LAS bf16*)(ob + WY_KT);
        LAS bf16* BKT = (LAS bf16*)(ob + WY_BK); LAS bf16* VT = (LAS bf16*)(ob + WY_VT); LAS float* GC = (LAS float*)(ob + WY_GC);
        const int tl = tid >> 5, c2 = (tid & 31) * 2, s0 = mc * 16;
        f32x2 cum = (f32x2){0.f, 0.f}, tot = cum, lwt = cum;
#pragma unroll
        for (int i = 0; i < 16; ++i) { const f32x2 l2 = *(const LAS f32x2*)(SEQ + (s0 + i) * 384 + 64 + c2); tot += l2; if (i <= tl) cum += l2; if (i == tl) lwt = l2; }
        const LAS float* sp = SEQ + (s0 + tl) * 384 + c2;
        const f32x2 a2 = *(const LAS f32x2*)(sp), b2 = *(const LAS f32x2*)(sp + 128), k2 = *(const LAS f32x2*)(sp + 192), r2 = *(const LAS f32x2*)(sp + 256), v2 = *(const LAS f32x2*)(sp + 320);
        const f32x2 gt = (f32x2){__builtin_amdgcn_exp2f(cum.x), __builtin_amdgcn_exp2f(cum.y)}, gp = (f32x2){__builtin_amdgcn_exp2f(cum.x - lwt.x), __builtin_amdgcn_exp2f(cum.y - lwt.y)},
                    gi = (f32x2){__builtin_amdgcn_exp2f(-cum.x), __builtin_amdgcn_exp2f(-cum.y)}, go = (f32x2){__builtin_amdgcn_exp2f(tot.x - cum.x), __builtin_amdgcn_exp2f(tot.y - cum.y)};
        *(LAS unsigned*)(At + tl * WY_OS + c2) = cvt_pk_bf16(a2.x * gp.x, a2.y * gp.y); *(LAS unsigned*)(Rt + tl * WY_OS + c2) = cvt_pk_bf16(r2.x * gt.x, r2.y * gt.y);
        *(LAS unsigned*)(Bt + tl * WY_OS + c2) = cvt_pk_bf16(b2.x * gi.x, b2.y * gi.y); *(LAS unsigned*)(Kt + tl * WY_OS + c2) = cvt_pk_bf16(k2.x * gi.x, k2.y * gi.y);
        const unsigned bh = cvt_pk_bf16(b2.x * go.x, b2.y * go.y), kh = cvt_pk_bf16(k2.x * go.x, k2.y * go.y), vv = cvt_pk_bf16(v2.x, v2.y);
        {
            const unsigned bh_o = (unsigned)__shfl_xor((int)bh, 32), kh_o = (unsigned)__shfl_xor((int)kh, 32), vv_o = (unsigned)__shfl_xor((int)vv, 32);
            const bool ev = (tl & 1) == 0; const int col = ev ? c2 : c2 + 1;
            const int wk = col * WY_LS + 8 * (tl >> 2) + (tl & 2), wo = col * WY_TS + (tl & ~1);
            *(LAS unsigned*)(BKT + wk) = ev ? ((bh & 0xffffu) | (bh_o << 16)) : ((bh_o >> 16) | (bh & 0xffff0000u));
            *(LAS unsigned*)(BKT + wk + 4) = ev ? ((kh & 0xffffu) | (kh_o << 16)) : ((kh_o >> 16) | (kh & 0xffff0000u));
            *(LAS unsigned*)(VT + wo) = ev ? ((vv & 0xffffu) | (vv_o << 16)) : ((vv_o >> 16) | (vv & 0xffff0000u)); }
        if (tl == 0) *(LAS f32x2*)(GC + c2) = (f32x2){__builtin_amdgcn_exp2f(tot.x), __builtin_amdgcn_exp2f(tot.y)};
    }
    __syncthreads();
    {
        asm volatile("" : "+v"(tid));
        const int fr = tid & 15, fq = (tid >> 4) & 3, m_ = wave >> 2, g_ = (wave + m_) & 3;
        if (m_ < nmc) {
            LAS unsigned char* ob = lds + WY_BASE + m_ * WY_BUF; LAS unsigned char* gs = lds + (m_ ? WY_G2 : WY_LAB);
            LAS float* Lab = (LAS float*)gs; LAS bf16* Lak = (LAS bf16*)(gs + 1024); LAS bf16* Mc = (LAS bf16*)(gs + 1024 + 16 * WY_LS * 2); LAS float* TT = (LAS float*)(gs + 1024 + 2 * 16 * WY_LS * 2);
            const LAS bf16* ab = (LAS bf16*)(ob + (g_ < 2 ? WY_AT : WY_RT)) + fr * WY_OS + fq * 8; const LAS bf16* bb = (LAS bf16*)(ob + ((g_ & 1) ? WY_KT : WY_BT)) + fr * WY_OS + fq * 8;
            f32x4 g = (f32x4){0.f, 0.f, 0.f, 0.f};
#pragma unroll
            for (int ks = 0; ks < 2; ++ks) g = __builtin_amdgcn_mfma_f32_16x16x32_bf16(*(const LAS bf16x8*)(bb + ks * 32), *(const LAS bf16x8*)(ab + ks * 32), g, 0, 0, 0);
#pragma unroll
            for (int rg = 0; rg < 4; ++rg) { const int tp = 4 * fq + rg; const bool keep = (g_ < 2) ? (fr > tp) : (fr >= tp); g[rg] = keep ? g[rg] : 0.f; }
            if (g_ == 0) {
                *(LAS f32x4*)(Lab + fr * 16 + 4 * fq) = g;
                LDS_WAIT();
                float u[16];
#pragma unroll
                for (int t = 0; t < 16; ++t) { if ((t & 3) == 0) asm volatile("" ::: "memory");
                    float acc = (t == fr) ? 1.0f : 0.0f;
#pragma unroll
                    for (int i4 = 0; i4 * 4 < t; ++i4) { const f32x4 l4 = *(const LAS f32x4*)(Lab + t * 16 + i4 * 4);
#pragma unroll
                        for (int e = 0; e < 4; ++e) if (i4 * 4 + e < t) acc += l4[e] * u[i4 * 4 + e]; }
                    u[t] = acc; }
                if (fq == 0) {
#pragma unroll
                    for (int t = 0; t < 16; ++t) TT[t * 16 + fr] = u[t]; }
            } else { v2u w; w.x = cvt_pk_bf16(g[0], g[1]); w.y = cvt_pk_bf16(g[2], g[3]);
                if (g_ == 1) { *(LAS v2u*)(Lak + fr * WY_LS + 8 * fq + 4) = w; *(LAS v2u*)(Lak + fr * WY_LS + 8 * fq) = (v2u){0u, 0u}; }
                else if (g_ == 2) *(LAS v2u*)(Mc + fr * WY_LS + 8 * fq) = w; else *(LAS v2u*)(Mc + fr * WY_LS + 8 * fq + 4) = w; }
        }
    }
    __syncthreads();
    if (MK_DBGSEL == 2 && part) return;
    for (int mc = 0; mc < nmc; ++mc) {
        asm volatile("" : "+v"(tid));
        const int fr = tid & 15, fq = (tid >> 4) & 3;
        LAS unsigned char* ob = lds + WY_BASE + mc * WY_BUF; LAS unsigned char* gs = lds + (mc ? WY_G2 : WY_LAB);
        LAS bf16* At = (LAS bf16*)(ob + WY_AT); LAS bf16* Rt = (LAS bf16*)(ob + WY_RT);
        LAS bf16* BKT = (LAS bf16*)(ob + WY_BK); LAS bf16* VT = (LAS bf16*)(ob + WY_VT); LAS float* GC = (LAS float*)(ob + WY_GC);
        LAS bf16* Lak = (LAS bf16*)(gs + 1024); LAS bf16* Mc = (LAS bf16*)(gs + 1024 + 16 * WY_LS * 2); LAS float* TT = (LAS float*)(gs + 1024 + 2 * 16 * WY_LS * 2);
        f32x4 W1 = (f32x4){0.f, 0.f, 0.f, 0.f}, Y0 = W1;
        {
            const LAS bf16* xbp = Xb + (16 * wave + fr) * WY_OS + fq * 8;
#pragma unroll
            for (int ks = 0; ks < 2; ++ks) { const bf16x8 bx = *(const LAS bf16x8*)(xbp + ks * 32);
                W1 = __builtin_amdgcn_mfma_f32_16x16x32_bf16(*(const LAS bf16x8*)(At + fr * WY_OS + ks * 32 + fq * 8), bx, W1, 0, 0, 0);
                Y0 = __builtin_amdgcn_mfma_f32_16x16x32_bf16(*(const LAS bf16x8*)(Rt + fr * WY_OS + ks * 32 + fq * 8), bx, Y0, 0, 0, 0); }
        }
        v2u vq = (v2u){0u, 0u};
        if (!pw) vq = *(const LAS v2u*)(VT + (16 * wave + fr) * WY_TS + 4 * fq);
        if (!pw) { v4u vb; vb.x = 0u; vb.y = 0u; vb.z = vq.x; vb.w = vq.y;
            W1 = __builtin_amdgcn_mfma_f32_16x16x32_bf16(*(const LAS bf16x8*)(Lak + fr * WY_LS + fq * 8), __builtin_bit_cast(bf16x8, vb), W1, 0, 0, 0); }
        f32x4 U = (f32x4){0.f, 0.f, 0.f, 0.f};
        if (!(MK_DBGSEL == 3 && part)) {
            const f32x4 tq = *(const LAS f32x4*)(TT + fr * 16 + 4 * fq);
#pragma unroll
            for (int kk = 0; kk < 4; ++kk) U = __builtin_amdgcn_mfma_f32_16x16x4f32(tq[kk], W1[kk], U, 0, 0, 0);
        } else U = W1;
        {
            v4u ucw; ucw.x = cvt_pk_bf16(U[0], U[1]); ucw.y = cvt_pk_bf16(U[2], U[3]); ucw.z = vq.x; ucw.w = vq.y;
            const bf16x8 uc = __builtin_bit_cast(bf16x8, ucw);
            Y0 = __builtin_amdgcn_mfma_f32_16x16x32_bf16(*(const LAS bf16x8*)(Mc + fr * WY_LS + fq * 8), uc, Y0, 0, 0, 0);
            LAS float* yo = (pw ? ZZ + 16 * (wave - 4) : YY + 16 * wave) + fr;
#pragma unroll
            for (int rg = 0; rg < 4; ++rg) yo[(mc * 16 + 4 * fq + rg) * 64] = Y0[rg];
#pragma unroll
            for (int j = 0; j < 4; ++j) {
                const bf16x8 bc = *(const LAS bf16x8*)(BKT + (16 * j + fr) * WY_LS + fq * 8);
                X[j] = X[j] * *(const LAS f32x4*)(GC + 16 * j + 4 * fq);
                X[j] = __builtin_amdgcn_mfma_f32_16x16x32_bf16(bc, uc, X[j], 0, 0, 0);
                v2u w; w.x = cvt_pk_bf16(X[j][0], X[j][1]); w.y = cvt_pk_bf16(X[j][2], X[j][3]);
                *(LAS v2u*)(Xb + (16 * wave + fr) * WY_OS + 16 * j + 4 * fq) = w; }
        }
        LDS_WAIT();
    }
}

#define P1_LOAD_PARAMS(HH) do { int lf_ = fr, lq_ = fq, lt_ = tid; asm volatile("" : "+v"(lf_), "+v"(lq_), "+v"(lt_));   \
        const int h_ = (HH), ncol_ = h_ * 64 + ntl * 16 + lf_; \
        _Pragma("unroll") for (int ks = 0; ks < 2; ++ks) { bw[ks] = *(const bf16x8*)(L2T + (size_t)ncol_ * 64 + lq_ * 8 + ks * 32); ba[ks] = *(const bf16x8*)(L2T + (size_t)512 * 64 + (size_t)ncol_ * 64 + lq_ * 8 + ks * 32); } \
        _Pragma("unroll") for (int ks = 0; ks < 4; ++ks) bg[ks] = *(const bf16x8*)(L2T + (size_t)1024 * 64 + (size_t)ncol_ * 128 + lq_ * 8 + ks * 32); \
        if (lt_ < 128) { const int a_ = lt_ >> 4, c_ = (lt_ & 15) * 4; \
            const float* src_ = a_ == 0 ? A.in[I_W0] : a_ == 1 ? A.in[I_A0] : a_ == 2 ? A.in[I_KK] : a_ == 3 ? A.in[I_KA] : a_ == 4 ? A.in[I_RK] : A.in[I_MURKV] + (a_ - 5) * 512; \
            *(LAS f32x4*)(PRM + a_ * 64 + c_) = *(const f32x4*)(src_ + h_ * 64 + c_); } } while (0)
__device__ __forceinline__ void scan_pass1(const Args& A, LAS unsigned char* lds, int tid, int lane, int wave, int vcu, int G, int part = 0) {
    bf16* GB = (bf16*)(A.ws + WS_A1) + (size_t)MPAD * 512;
    bf16* YL = (bf16*)(A.ws + WS_YL); bf16* ZT = (bf16*)(A.ws + WS_ZT); bf16* BV = (bf16*)(A.ws + WS_BV);
    LAS bf16* HIDB = (LAS bf16*)(lds + P1_SEQ);
    LAS float* LO = (LAS float*)(lds + P1_LO); LAS float* SEQ = (LAS float*)(lds + P1_SEQ);
    LAS float* YY = (LAS float*)(lds + P1_YY); LAS float* ZZ = (LAS float*)(lds + P1_ZZ);
    const bf16* L2T = (const bf16*)(A.ws + WS_L2T);
    const bool prow_wave = wave >= 4;
    const int mt = wave & 1, ntl = wave >> 1;
    int tt = tid >> 4, cs = tid & 15, c4 = cs * 4, fr = lane & 15, fq = lane >> 4;
    f32x4 X[4];
    bf16x8 bw[2], ba[2], bg[4];
    LAS float* PRM = (LAS float*)(lds + P1_GG);
    int cur_h = -1;
    int ui = 0, unit; if (!p1_unit_at(0, vcu, G, unit)) return;
    int t0 = 0; P1Pre pre; p1_load(A, unit, 0, tt, cs, pre);
    *(LAS v4u*)(HIDB + tt * HID_STRIDE + cs * 16) = pre.pa0; *(LAS v4u*)(HIDB + tt * HID_STRIDE + cs * 16 + 8) = pre.pa1;
    __syncthreads();
    for (;;) {
        { int lt_ = tid; asm volatile("" : "+v"(lt_)); tt = lt_ >> 4; cs = lt_ & 15; c4 = cs * 4; fr = lt_ & 15; fq = (lt_ >> 4) & 3; }
        bool prompt; int b, h, ch, T, rowbase; p1_decode(unit, prompt, b, h, ch, T, rowbase);
        const int hc = h * 64 + c4;
        if (t0 == 0 && G == 256 && ui < 8) {
            const size_t i16 = ((size_t)(ui * 256 + vcu) * NTHR + tid) * 16;
            cvt16_fp8_sliced(A.in[I_U], A.ws + WS_UB, PEER_SU, i16); cvt16_fp8_sliced(A.in[I_V], A.ws + WS_VB, PEER_SV, i16); }
        if (t0 == 0) {
            LAS bf16* Xb = (LAS bf16*)(lds + WY_XB);
#pragma unroll
            for (int j = 0; j < 4; ++j) { const int prow_ = 16 * (wave - 4) + fr, c0_ = 16 * j + 4 * fq;
#pragma unroll
                for (int e = 0; e < 4; ++e) X[j][e] = (prow_wave && prow_ == c0_ + e) ? 1.f : 0.f;
                v2u w; w.x = cvt_pk_bf16(X[j][0], X[j][1]); w.y = cvt_pk_bf16(X[j][2], X[j][3]);
                *(LAS v2u*)(Xb + (16 * wave + fr) * WY_OS + c0_) = w; }
        }
        if (h != cur_h) { cur_h = h; P1_LOAD_PARAMS(h); }
        size_t row, prow; bool hasprev; int nb; p1_rows(unit, t0, tt, row, prow, hasprev, nb);
        if (!(MK_DBGSEL == 5 && part)) {
            const LAS bf16* ap = HIDB + (mt * 16 + fr) * HID_STRIDE + fq * 8;
            f32x4 cw = (f32x4){0.f, 0.f, 0.f, 0.f}, ca = cw, cg = cw;
#pragma unroll
            for (int ks = 0; ks < 2; ++ks) { cw = __builtin_amdgcn_mfma_f32_16x16x32_bf16(*(const LAS bf16x8*)(ap + ks * 32), bw[ks], cw, 0, 0, 0);
                                             ca = __builtin_amdgcn_mfma_f32_16x16x32_bf16(*(const LAS bf16x8*)(ap + 64 + ks * 32), ba[ks], ca, 0, 0, 0); }
#pragma unroll
            for (int ks = 0; ks < 4; ++ks) cg = __builtin_amdgcn_mfma_f32_16x16x32_bf16(*(const LAS bf16x8*)(ap + 128 + ks * 32), bg[ks], cg, 0, 0, 0);
#pragma unroll
            for (int rg = 0; rg < 4; ++rg) { const int o = (mt * 16 + fq * 4 + rg) * 64 + ntl * 16 + fr; LO[o] = cw[rg]; LO[2048 + o] = ca[rg]; LO[4096 + o] = cg[rg]; }
        }
        __syncthreads();
        if (!(MK_DBGSEL == 5 && part)) {
            const f32x4 w0v = *(const LAS f32x4*)(PRM + c4), a0v = *(const LAS f32x4*)(PRM + 64 + c4), kkv = *(const LAS f32x4*)(PRM + 128 + c4), kav = *(const LAS f32x4*)(PRM + 192 + c4),
                        rkv = *(const LAS f32x4*)(PRM + 256 + c4), mur = *(const LAS f32x4*)(PRM + 320 + c4), muk = *(const LAS f32x4*)(PRM + 384 + c4), muv = *(const LAS f32x4*)(PRM + 448 + c4);
            const f32x4 aw = w0v + *(const LAS f32x4*)(LO + tt * 64 + c4), aa = a0v + *(const LAS f32x4*)(LO + 2048 + tt * 64 + c4), ag = *(const LAS f32x4*)(LO + 4096 + tt * 64 + c4);
            f32x4 r = (f32x4){bf_lo(pre.zr.x), bf_hi(pre.zr.x), bf_lo(pre.zr.y), bf_hi(pre.zr.y)}, k = (f32x4){bf_lo(pre.zk.x), bf_hi(pre.zk.x), bf_lo(pre.zk.y), bf_hi(pre.zk.y)},
                  v = (f32x4){bf_lo(pre.zv.x), bf_hi(pre.zv.x), bf_lo(pre.zv.y), bf_hi(pre.zv.y)};
            const f32x4 rpv = (f32x4){bf_lo(pre.pr.x), bf_hi(pre.pr.x), bf_lo(pre.pr.y), bf_hi(pre.pr.y)}, kpv = (f32x4){bf_lo(pre.pk.x), bf_hi(pre.pk.x), bf_lo(pre.pk.y), bf_hi(pre.pk.y)},
                        vpv = (f32x4){bf_lo(pre.pv.x), bf_hi(pre.pv.x), bf_lo(pre.pv.y), bf_hi(pre.pv.y)};
            r = r + mur * (rpv - r); k = k + muk * (kpv - k); v = v + muv * (vpv - v);
            f32x4 dec, asg, kk, km, av, bv;
            float ssq = 0.f, bon = 0.f;
#pragma unroll
            for (int i = 0; i < 4; ++i) {
                dec[i] = -0.87503877491453f * sigm(aw[i]);
                asg[i] = sigm(aa[i]);
                kk[i] = k[i] * kkv[i]; ssq += kk[i] * kk[i];
                km[i] = k[i] * (1.0f + (asg[i] - 1.0f) * kav[i]);
                bon += r[i] * km[i] * rkv[i];
            }
            ssq = sum16(ssq); bon = sum16(bon);
            const float inv = fminf(__builtin_amdgcn_rsqf(ssq), 1e12f);
#pragma unroll
            for (int i = 0; i < 4; ++i) { kk[i] *= inv; av[i] = -kk[i]; bv[i] = kk[i] * asg[i]; }
            LAS float* sq_ = SEQ + tt * 384 + c4;
            *(LAS f32x4*)(sq_) = av; *(LAS f32x4*)(sq_ + 64) = dec; *(LAS f32x4*)(sq_ + 128) = bv; *(LAS f32x4*)(sq_ + 192) = km; *(LAS f32x4*)(sq_ + 256) = r; *(LAS f32x4*)(sq_ + 320) = v;
            if (tt < nb) {
                v2u w; w.x = cvt_pk_bf16(ag[0], ag[1]); w.y = cvt_pk_bf16(ag[2], ag[3]); *(v2u*)(GB + row * 512 + hc) = w;
                w.x = cvt_pk_bf16(bon * v[0], bon * v[1]); w.y = cvt_pk_bf16(bon * v[2], bon * v[3]); *(v2u*)(BV + row * 512 + hc) = w;
            }
        }
        int nunit = unit, nt0 = t0 + SC_TB, nui = ui; bool more = true;
        if (nt0 >= T) { nt0 = 0; nui = ui + 1; more = p1_unit_at(nui, vcu, G, nunit); }
        if (more) p1_load(A, nunit, nt0, tt, cs, pre);
        __syncthreads();
        if (!(MK_DBGSEL == 1 && part)) p1_wy(X, SEQ, YY, ZZ, lds, nb, tid, lane, wave, part);
        if (more) { *(LAS v4u*)(HIDB + tt * HID_STRIDE + cs * 16) = pre.pa0; *(LAS v4u*)(HIDB + tt * HID_STRIDE + cs * 16 + 8) = pre.pa1; }
        __syncthreads();
        if (tt < nb) {
            const f32x4 y = *(const LAS f32x4*)(YY + tt * 64 + c4), z = *(const LAS f32x4*)(ZZ + tt * 64 + c4);
            v2u w; w.x = cvt_pk_bf16(y[0], y[1]); w.y = cvt_pk_bf16(y[2], y[3]); *(v2u*)(YL + row * 512 + hc) = w;
            w.x = cvt_pk_bf16(z[0], z[1]); w.y = cvt_pk_bf16(z[2], z[3]); *(v2u*)(ZT + row * 512 + hc) = w;
        }
        if (t0 + SC_TB >= T) {
#pragma unroll
            for (int j = 0; j < 4; ++j) {
                if (!prow_wave) *(f32x4*)((float*)A.out + (size_t)unit * 4096 + (16 * wave + fr) * 64 + 16 * j + 4 * fq) = X[j];
                else { bf16* mt = (bf16*)((unsigned char*)A.out + OB_MB) + (size_t)unit * 4096 + (16 * j + 4 * fq) * 64 + 16 * (wave - 4) + fr;
                    const unsigned p01 = cvt_pk_bf16(X[j][0], X[j][1]), p23 = cvt_pk_bf16(X[j][2], X[j][3]);
                    mt[0] = (bf16)(p01 & 0xffffu); mt[64] = (bf16)(p01 >> 16); mt[128] = (bf16)(p23 & 0xffffu); mt[192] = (bf16)(p23 >> 16); }
            }
        }
        if (!more) break;
        unit = nunit; t0 = nt0; ui = nui;
    }
    __syncthreads();
}

constexpr int P2_SS = 72, P2_LO = 16 * P2_SS * 2, P2_BUF = 2 * P2_LO;
__device__ __forceinline__ void scan_pass2_rows(const float* Sinit, int unit0, int nchunks, int v0, float* outfin, bool slots, const Args& A, LAS unsigned char* lds, int tid, int lane, int wave) {
    LAS bf16* Shi = (LAS bf16*)lds; LAS bf16* Slo = (LAS bf16*)(lds + P2_LO);
    const int nt = wave & 3, fr = lane & 15, fq = lane >> 4; const bool act = wave < 4;
    float* NB = (float*)A.out; const bf16* MT = (const bf16*)((const unsigned char*)A.out + OB_MB);
    { const int idx = tid * 2, row = idx >> 6, col = idx & 63;
      const f32x2 s0 = Sinit ? *(const f32x2*)(Sinit + (size_t)(v0 + row) * 64 + col) : (f32x2){0.f, 0.f};
      const unsigned hi = cvt_pk_bf16(s0.x, s0.y);
      *(LAS unsigned*)(Shi + row * P2_SS + col) = hi; *(LAS unsigned*)(Slo + row * P2_SS + col) = cvt_pk_bf16(s0.x - bf_lo(hi), s0.y - bf_hi(hi)); }
    bf16x8 mr[4][2]; f32x4 nr[4];
    const size_t moff = (size_t)(16 * nt + fr) * 64 + fq * 8, noff = (size_t)(v0 + fr) * 64 + 16 * nt + 4 * fq;
#pragma unroll
    for (int d = 0; d < 4; ++d) {
        mr[d][0] = (bf16x8){0, 0, 0, 0, 0, 0, 0, 0}; mr[d][1] = mr[d][0]; nr[d] = (f32x4){0.f, 0.f, 0.f, 0.f};
        { const int cc = d < nchunks ? d : nchunks - 1;
            mr[d][0] = *(const bf16x8*)(MT + (size_t)(unit0 + cc) * 4096 + moff); mr[d][1] = *(const bf16x8*)(MT + (size_t)(unit0 + cc) * 4096 + moff + 32);
            nr[d] = *(const f32x4*)(NB + (size_t)(unit0 + cc) * 4096 + noff); }
    }
    f32x4 acc = (f32x4){0.f, 0.f, 0.f, 0.f};
    __syncthreads();
    for (int c0 = 0; c0 < nchunks; c0 += 4) {
#pragma unroll
        for (int d = 0; d < 4; ++d) {
            const int c = c0 + d;
            if (c < nchunks) {
                {
                    LAS bf16* Shi = (LAS bf16*)(lds + (d & 1) * P2_BUF); LAS bf16* Slo = (LAS bf16*)(lds + (d & 1) * P2_BUF + P2_LO);
                    const bf16x8 sh0 = *(const LAS bf16x8*)(Shi + fr * P2_SS + fq * 8), sh1 = *(const LAS bf16x8*)(Shi + fr * P2_SS + 32 + fq * 8),
                                 sl0 = *(const LAS bf16x8*)(Slo + fr * P2_SS + fq * 8), sl1 = *(const LAS bf16x8*)(Slo + fr * P2_SS + 32 + fq * 8);
                    acc = nr[d];
                    acc = __builtin_amdgcn_mfma_f32_16x16x32_bf16(mr[d][0], sh0, acc, 0, 0, 0); acc = __builtin_amdgcn_mfma_f32_16x16x32_bf16(mr[d][1], sh1, acc, 0, 0, 0);
                    acc = __builtin_amdgcn_mfma_f32_16x16x32_bf16(mr[d][0], sl0, acc, 0, 0, 0); acc = __builtin_amdgcn_mfma_f32_16x16x32_bf16(mr[d][1], sl1, acc, 0, 0, 0);
                    const int cn = c + 4 < nchunks ? c + 4 : nchunks - 1;
                    mr[d][0] = *(const bf16x8*)(MT + (size_t)(unit0 + cn) * 4096 + moff); mr[d][1] = *(const bf16x8*)(MT + (size_t)(unit0 + cn) * 4096 + moff + 32);
                    nr[d] = *(const f32x4*)(NB + (size_t)(unit0 + cn) * 4096 + noff);
                }
                if (act) {
                    LAS bf16* Shi = (LAS bf16*)(lds + ((d + 1) & 1) * P2_BUF); LAS bf16* Slo = (LAS bf16*)(lds + ((d + 1) & 1) * P2_BUF + P2_LO);
                    v2u hi; hi.x = cvt_pk_bf16(acc[0], acc[1]); hi.y = cvt_pk_bf16(acc[2], acc[3]);
                    v2u lo; lo.x = cvt_pk_bf16(acc[0] - bf_lo(hi.x), acc[1] - bf_hi(hi.x)); lo.y = cvt_pk_bf16(acc[2] - bf_lo(hi.y), acc[3] - bf_hi(hi.y));
                    *(LAS v2u*)(Shi + fr * P2_SS + 16 * nt + 4 * fq) = hi; *(LAS v2u*)(Slo + fr * P2_SS + 16 * nt + 4 * fq) = lo;
                    if (slots) *(v2u*)((bf16*)(NB + (size_t)(unit0 + c) * 4096) + (size_t)(v0 + fr) * 128 + 16 * nt + 4 * fq) = hi;
                }
                __syncthreads();
            }
        }
    }
    if (act) *(f32x4*)(outfin + noff) = acc;
    __syncthreads();
}

__device__ __forceinline__ void scan_pass2_sample(const float* Sinit, int unit, float* outfin, const Args& A, int lane, int wave) {
    const int fr = lane & 15, fq = lane >> 4, rt = wave >> 1;
    const float* NB = (const float*)A.out + (size_t)unit * 4096; const bf16* MT = (const bf16*)((const unsigned char*)A.out + OB_MB) + (size_t)unit * 4096;
    f32x4 sv[2][2];
#pragma unroll
    for (int ks = 0; ks < 2; ++ks) { const float* sp = Sinit + (size_t)(16 * rt + fr) * 64 + 32 * ks + 8 * fq; sv[ks][0] = *(const f32x4*)sp; sv[ks][1] = *(const f32x4*)(sp + 4); }
    bf16x8 mt[2][2]; f32x4 acc[2];
#pragma unroll
    for (int t = 0; t < 2; ++t) { const int nt = 2 * (wave & 1) + t;
        mt[t][0] = *(const bf16x8*)(MT + (size_t)(16 * nt + fr) * 64 + fq * 8); mt[t][1] = *(const bf16x8*)(MT + (size_t)(16 * nt + fr) * 64 + 32 + fq * 8);
        acc[t] = *(const f32x4*)(NB + (size_t)(16 * rt + fr) * 64 + 16 * nt + 4 * fq); }
    bf16x8 sh[2], sl[2];
#pragma unroll
    for (int ks = 0; ks < 2; ++ks) { const f32x4 a = sv[ks][0], b = sv[ks][1];
        v4u h; h.x = cvt_pk_bf16(a[0], a[1]); h.y = cvt_pk_bf16(a[2], a[3]); h.z = cvt_pk_bf16(b[0], b[1]); h.w = cvt_pk_bf16(b[2], b[3]);
        v4u l; l.x = cvt_pk_bf16(a[0] - bf_lo(h.x), a[1] - bf_hi(h.x)); l.y = cvt_pk_bf16(a[2] - bf_lo(h.y), a[3] - bf_hi(h.y));
        l.z = cvt_pk_bf16(b[0] - bf_lo(h.z), b[1] - bf_hi(h.z)); l.w = cvt_pk_bf16(b[2] - bf_lo(h.w), b[3] - bf_hi(h.w));
        sh[ks] = __builtin_bit_cast(bf16x8, h); sl[ks] = __builtin_bit_cast(bf16x8, l);
        if ((wave & 1) == 0) *(v4u*)((bf16*)((unsigned char*)A.out + OB_S0S) + (size_t)(unit - NUNITS_P) * 4096 + (size_t)(16 * rt + fr) * 64 + 32 * ks + 8 * fq) = h; }
#pragma unroll
    for (int t = 0; t < 2; ++t) { const int nt = 2 * (wave & 1) + t;
#pragma unroll
        for (int ks = 0; ks < 2; ++ks) { acc[t] = __builtin_amdgcn_mfma_f32_16x16x32_bf16(mt[t][ks], sh[ks], acc[t], 0, 0, 0); acc[t] = __builtin_amdgcn_mfma_f32_16x16x32_bf16(mt[t][ks], sl[ks], acc[t], 0, 0, 0); }
        *(f32x4*)(outfin + (size_t)(16 * rt + fr) * 64 + 16 * nt + 4 * fq) = acc[t]; }
}

__device__ __forceinline__ void scan_pass3_wave(const Args& A, int unit, int wq, int lane) {
    const bool prompt = unit < NUNITS_P;
    const int b = prompt ? unit >> 9 : (unit - NUNITS_P) >> 3, h = prompt ? (unit >> 6) & 7 : unit & 7, ch = prompt ? unit & 63 : 0;
    const int T = prompt ? 64 : SEQ_S, rowbase = prompt ? b * SEQ_P + ch * 64 : NPROMPT + b * SEQ_S;
    if (wq * 16 >= T) return;
    const bf16* S0 = prompt ? (ch > 0 ? (const bf16*)((const float*)A.out + (size_t)(unit - 1) * 4096) : (const bf16*)(A.ws + WS_CTL + 49152)) : (const bf16*)((const unsigned char*)A.out + OB_S0S) + (size_t)(b * 8 + h) * 4096;
    const int spitch = prompt ? 128 : 64;
    const bf16* ZT = (const bf16*)(A.ws + WS_ZT); const bf16* YL = (const bf16*)(A.ws + WS_YL); const bf16* BV = (const bf16*)(A.ws + WS_BV);
    bf16* YB = (bf16*)(A.ws + WS_A1) + (size_t)MPAD * 512;
    const int fr = lane & 15, fq = lane >> 4;
    const size_t row = (size_t)(rowbase + wq * 16 + fr);
    bf16x8 bz[2], sa[4][2]; v2u yl[4], bvw[4], gg[4]; f32x4 gw[4], gb[4];
#pragma unroll
    for (int ks = 0; ks < 2; ++ks) bz[ks] = *(const bf16x8*)(ZT + row * 512 + h * 64 + ks * 32 + fq * 8);
#pragma unroll
    for (int mt = 0; mt < 4; ++mt)
#pragma unroll
        for (int ks = 0; ks < 2; ++ks) sa[mt][ks] = *(const bf16x8*)(S0 + (size_t)(mt * 16 + fr) * spitch + ks * 32 + fq * 8);
#pragma unroll
    for (int mt = 0; mt < 4; ++mt) { const int c = h * 64 + mt * 16 + fq * 4;
        yl[mt] = *(const v2u*)(YL + row * 512 + c); bvw[mt] = *(const v2u*)(BV + row * 512 + c); gg[mt] = *(const v2u*)(YB + row * 512 + c);
        gw[mt] = *(const f32x4*)(A.in[I_GNW] + c); gb[mt] = *(const f32x4*)(A.in[I_GNB] + c); }
    f32x4 acc[4];
#pragma unroll
    for (int mt = 0; mt < 4; ++mt) { acc[mt] = (f32x4){0.f, 0.f, 0.f, 0.f};
#pragma unroll
        for (int ks = 0; ks < 2; ++ks) acc[mt] = __builtin_amdgcn_mfma_f32_16x16x32_bf16(sa[mt][ks], bz[ks], acc[mt], 0, 0, 0); }
    float sm = 0.f;
#pragma unroll
    for (int mt = 0; mt < 4; ++mt) { const v2u y = yl[mt];
        acc[mt][0] += bf_lo(y.x); acc[mt][1] += bf_hi(y.x); acc[mt][2] += bf_lo(y.y); acc[mt][3] += bf_hi(y.y);
        sm += (acc[mt][0] + acc[mt][1]) + (acc[mt][2] + acc[mt][3]); }
    sm += __shfl_xor(sm, 16); sm += __shfl_xor(sm, 32);
    const float mean = sm * (1.f / 64.f); float sv = 0.f;
#pragma unroll
    for (int mt = 0; mt < 4; ++mt) { acc[mt] = acc[mt] - mean; sv += (acc[mt][0] * acc[mt][0] + acc[mt][1] * acc[mt][1]) + (acc[mt][2] * acc[mt][2] + acc[mt][3] * acc[mt][3]); }
    sv += __shfl_xor(sv, 16); sv += __shfl_xor(sv, 32);
    const float rs = __builtin_amdgcn_rsqf(sv * (1.f / 64.f) + 64e-5f);
#pragma unroll
    for (int mt = 0; mt < 4; ++mt) { const int c = h * 64 + mt * 16 + fq * 4;
        f32x4 o = acc[mt] * rs * gw[mt] + gb[mt] + (f32x4){bf_lo(bvw[mt].x), bf_hi(bvw[mt].x), bf_lo(bvw[mt].y), bf_hi(bvw[mt].y)};
        o = o * (f32x4){bf_lo(gg[mt].x), bf_hi(gg[mt].x), bf_lo(gg[mt].y), bf_hi(gg[mt].y)};
        v2u w; w.x = cvt_pk_bf16(o[0], o[1]); w.y = cvt_pk_bf16(o[2], o[3]); *(v2u*)(YB + row * 512 + c) = w; }
}

__device__ __forceinline__ void tk_insert(float (&tv)[16], float x) {
#pragma unroll
    for (int i = 15; i >= 1; --i) tv[i] = __builtin_amdgcn_fmed3f(tv[i - 1], x, tv[i]);
    tv[0] = __builtin_fmaxf(tv[0], x);
}
#define TK_CE(t, i, j) { const float a_ = __builtin_fmaxf(t[i], t[j]); t[j] = __builtin_fminf(t[i], t[j]); t[i] = a_; }
__device__ __forceinline__ void tk_sort16(float (&t)[16]) {
    TK_CE(t, 0, 1) TK_CE(t, 2, 3) TK_CE(t, 0, 2) TK_CE(t, 1, 3) TK_CE(t, 1, 2) TK_CE(t, 4, 5) TK_CE(t, 6, 7) TK_CE(t, 4, 6) TK_CE(t, 5, 7) TK_CE(t, 5, 6) TK_CE(t, 0, 4) TK_CE(t, 2, 6) TK_CE(t, 2, 4) TK_CE(t, 1, 5) TK_CE(t, 3, 7) TK_CE(t, 3, 5) TK_CE(t, 1, 2) TK_CE(t, 3, 4) TK_CE(t, 5, 6) TK_CE(t, 8, 9) TK_CE(t, 10, 11) TK_CE(t, 8, 10) TK_CE(t, 9, 11) TK_CE(t, 9, 10) TK_CE(t, 12, 13) TK_CE(t, 14, 15) TK_CE(t, 12, 14) TK_CE(t, 13, 15) TK_CE(t, 13, 14) TK_CE(t, 8, 12) TK_CE(t, 10, 14) TK_CE(t, 10, 12) TK_CE(t, 9, 13) TK_CE(t, 11, 15) TK_CE(t, 11, 13) TK_CE(t, 9, 10) TK_CE(t, 11, 12) TK_CE(t, 13, 14) TK_CE(t, 0, 8) TK_CE(t, 4, 12) TK_CE(t, 4, 8) TK_CE(t, 2, 10) TK_CE(t, 6, 14) TK_CE(t, 6, 10) TK_CE(t, 2, 4) TK_CE(t, 6, 8) TK_CE(t, 10, 12) TK_CE(t, 1, 9) TK_CE(t, 5, 13) TK_CE(t, 5, 9) TK_CE(t, 3, 11) TK_CE(t, 7, 15) TK_CE(t, 7, 11) TK_CE(t, 3, 5) TK_CE(t, 7, 9) TK_CE(t, 11, 13) TK_CE(t, 1, 2) TK_CE(t, 3, 4) TK_CE(t, 5, 6) TK_CE(t, 7, 8) TK_CE(t, 9, 10) TK_CE(t, 11, 12) TK_CE(t, 13, 14)
}
__device__ __forceinline__ void tk_merge16(float (&tv)[16], const float (&g)[16]) {
#pragma unroll
    for (int i = 0; i < 16; ++i) tv[i] = __builtin_fmaxf(tv[i], g[15 - i]);
#pragma unroll
    for (int s = 8; s >= 1; s >>= 1)
#pragma unroll
        for (int i = 0; i < 16; ++i) if ((i & s) == 0) TK_CE(tv, i, i + s)
}
__device__ __forceinline__ float gelu_tanh(float x) {
    const float u = 0.7978845608028654f * (x + 0.044715f * x * x * x);
    const float th = 1.0f - 2.0f * __builtin_amdgcn_rcpf(__expf(2.0f * u) + 1.0f);
    return 0.5f * x * (1.0f + th);
}
constexpr int NTILE32 = NTOK / 32;
constexpr int CW_QU = 8192, CW_QV = 8192 + 512;

constexpr int TK_STRIDE = 68, TK_BYTES = 64 * TK_STRIDE * 4;
__device__ __forceinline__ void topk_scores64(const bf16* Q, const bf16* KB, LAS float* SC, int t0, int hp, int p, int half, int lane, const bf16x8 (&af)[2][2][4]) {
    const int fr = lane & 15, fq = lane >> 4;
#pragma unroll
    for (int hs = 0; hs < 2; ++hs) {
        const bf16* kbase = KB + (size_t)(((hp + 4 * hs) * 2 + p) * 128 + half * 64 + fr) * 128 + fq * 8;
#pragma unroll
        for (int n = 0; n < 4; ++n) {
            bf16x8 bfr[4];
#pragma unroll
            for (int ks = 0; ks < 4; ++ks) bfr[ks] = *(const bf16x8*)(kbase + (size_t)n * 16 * 128 + ks * 32);
            f32x4 acc0 = (f32x4){0.f, 0.f, 0.f, 0.f}, acc1 = acc0;
#pragma unroll
            for (int ks = 0; ks < 4; ++ks) { acc0 = __builtin_amdgcn_mfma_f32_16x16x32_bf16(af[hs][0][ks], bfr[ks], acc0, 0, 0, 0); acc1 = __builtin_amdgcn_mfma_f32_16x16x32_bf16(af[hs][1][ks], bfr[ks], acc1, 0, 0, 0); }
#pragma unroll
            for (int rg = 0; rg < 4; ++rg) { SC[(hs * 32 + fq * 4 + rg) * TK_STRIDE + n * 16 + fr] = acc0[rg]; SC[(hs * 32 + 16 + fq * 4 + rg) * TK_STRIDE + n * 16 + fr] = acc1[rg]; }
        }
    }
}
constexpr int TK_NPROMPT_UNITS = (NPROMPT / 32) * 4, TK_NSAMPLE_UNITS = (NSAMP / 32) * 4, CW_TKS = 9792;
__device__ __forceinline__ void peer_topk_units(const Args& A, LAS unsigned char* lds, int lane, int wave, int u_first, int u_end, int u_step) {
    const bf16* Q = (const bf16*)(A.ws + WS_ZG); const bf16* KB = (const bf16*)(A.ws + WS_KEYS); const float* SSP = (const float*)(A.ws + WS_SSP);
    unsigned short* EIDX = (unsigned short*)(A.ws + WS_EIDX); float* GATE = (float*)(A.ws + WS_GATE); float* RSTD = (float*)(A.ws + WS_RSTD);
    LAS float* SC = (LAS float*)(lds + wave * TK_BYTES);
    const int fr = lane & 15, fq = lane >> 4, tokl = lane & 31, hsel = lane >> 5;
    for (int u = u_first; u < u_end; u += u_step) {
        const int t0 = (u >> 2) * 32, hp = u & 3, h = hp + 4 * hsel;
        const float* sp = SSP + (size_t)(t0 + tokl) * 16;
        const f32x4 s0 = *(const f32x4*)sp, s1 = *(const f32x4*)(sp + 4), s2 = *(const f32x4*)(sp + 8), s3 = *(const f32x4*)(sp + 12);
        const float ssq = ((s0[0] + s0[1]) + (s0[2] + s0[3])) + ((s1[0] + s1[1]) + (s1[2] + s1[3])) + ((s2[0] + s2[1]) + (s2[2] + s2[3])) + ((s3[0] + s3[1]) + (s3[2] + s3[3]));
        const float rstd = __builtin_amdgcn_rsqf(ssq * (1.f / DM) + 1e-6f);
        float tv0[16], tv1[16], cv[16];
#pragma unroll
        for (int p = 0; p < 2; ++p) {
            bf16x8 af[2][2][4];
#pragma unroll
            for (int hs = 0; hs < 2; ++hs)
#pragma unroll
                for (int mt = 0; mt < 2; ++mt) { const bf16* qp = Q + (size_t)(t0 + mt * 16 + fr) * 2048 + (hp + 4 * hs) * 256 + p * 128 + fq * 8;
#pragma unroll
                    for (int ks = 0; ks < 4; ++ks) af[hs][mt][ks] = *(const bf16x8*)(qp + ks * 32); }
            float tv[16];
#pragma unroll
            for (int i = 0; i < 16; ++i) tv[i] = -3.0e38f;
            for (int half = 0; half < 2; ++half) {
                topk_scores64(Q, KB, SC, t0, hp, p, half, lane, af);
                LDS_WAIT();
                const LAS float* mine = SC + lane * TK_STRIDE;
                unsigned kmask = 0xFFFFFF80u; asm volatile("" : "+v"(kmask));
#pragma unroll 1
                for (int n = 0; n < 64; n += 16) {
                    float g[16];
#pragma unroll
                    for (int q = 0; q < 4; ++q) { const f32x4 x4 = *(const LAS f32x4*)(mine + n + 4 * q);
#pragma unroll
                        for (int e = 0; e < 4; ++e) g[4 * q + e] = __uint_as_float((__float_as_uint(x4[e]) & kmask) | (unsigned)(half * 64 + n + 4 * q + e)); }
                    tk_sort16(g); tk_merge16(tv, g);
                }
                LDS_WAIT();
            }
#pragma unroll
            for (int i = 0; i < 16; ++i) { if (p == 0) tv0[i] = tv[i]; else tv1[i] = tv[i]; }
        }
        LAS int* li = (LAS int*)SC + lane * 33;
#pragma unroll
        for (int q = 0; q < 16; ++q) { li[q] = (int)(__float_as_uint(tv0[q]) & 127u); li[16 + q] = (int)(__float_as_uint(tv1[q]) & 127u);
            tv0[q] = __uint_as_float(__float_as_uint(tv0[q]) & 0xFFFFFF80u); tv1[q] = __uint_as_float(__float_as_uint(tv1[q]) & 0xFFFFFF80u); }
#pragma unroll
        for (int q = 0; q < 16; ++q) cv[q] = -3.0e38f;
#pragma unroll
        for (int a = 0; a < 16; ++a)
#pragma unroll
            for (int b = 0; b < 16; ++b) if ((a + 1) * (b + 1) <= 16)
                tk_insert(cv, __uint_as_float((__float_as_uint(tv0[a] + tv1[b]) & 0xFFFFFF00u) | (unsigned)(a * 16 + b)));
        LDS_WAIT();
        float e[16], den = 0.f; unsigned ci[16];
        const float c0 = __uint_as_float(__float_as_uint(cv[0]) & 0xFFFFFF00u);
#pragma unroll
        for (int q = 0; q < 16; ++q) { const unsigned kb = __float_as_uint(cv[q]); const float cq = __uint_as_float(kb & 0xFFFFFF00u);
            e[q] = __expf((cq - c0) * rstd); den += e[q]; ci[q] = (unsigned)(li[(kb >> 4) & 15] * 128 + li[16 + (kb & 15)]); }
        const float inv = __builtin_amdgcn_rcpf(den);
        LDS_WAIT();
        {
            const size_t tok = (size_t)(t0 + tokl);
            v4u w0, w1; w0.x = ci[0] | (ci[1] << 16); w0.y = ci[2] | (ci[3] << 16); w0.z = ci[4] | (ci[5] << 16); w0.w = ci[6] | (ci[7] << 16);
            w1.x = ci[8] | (ci[9] << 16); w1.y = ci[10] | (ci[11] << 16); w1.z = ci[12] | (ci[13] << 16); w1.w = ci[14] | (ci[15] << 16);
            *(v4u*)(EIDX + tok * 128 + h * 16) = w0; *(v4u*)(EIDX + tok * 128 + h * 16 + 8) = w1;
#pragma unroll
            for (int q = 0; q < 4; ++q) *(f32x4*)(GATE + tok * 128 + h * 16 + 4 * q) = (f32x4){e[4 * q] * inv, e[4 * q + 1] * inv, e[4 * q + 2] * inv, e[4 * q + 3] * inv};
            if (h == 0) RSTD[tok] = rstd;
        }
    }
}

__device__ __forceinline__ bool peer_topk_split(int G) { return G == 256; }
__device__ __forceinline__ void peer_topk_phase(const Args& A, LAS unsigned char* lds, int tid, int lane, int wave, int vcu, int G) {
    peer_topk_units(A, lds, lane, wave, wave * G + vcu, peer_topk_split(G) ? TK_NPROMPT_UNITS : TK_NPROMPT_UNITS + TK_NSAMPLE_UNITS, G * NWAVES);
}
__device__ __forceinline__ void peer_topk_sample_prelude(const Args& A, LAS unsigned char* lds, int tid, int lane, int wave, int vcu, int G, gu32* ctl) {
    if (!peer_topk_split(G) || (vcu & 31) != 0) return;
    peer_topk_units(A, lds, lane, wave, TK_NPROMPT_UNITS + (vcu >> 5) * NWAVES + wave, TK_NPROMPT_UNITS + TK_NSAMPLE_UNITS, TK_NSAMPLE_UNITS);
    asm volatile("s_waitcnt vmcnt(0)" ::: "memory");
    __syncthreads();
    if (tid == 0) { __builtin_amdgcn_fence(__ATOMIC_RELEASE, "agent"); asm volatile("s_waitcnt vmcnt(0)" ::: "memory"); (void)__hip_atomic_fetch_add((unsigned*)(ctl + CW_TKS), 1u, RLX_AGENT); }
    __syncthreads();
}
__device__ __forceinline__ void peer_topk_sample_wait(gu32* ctl, int tid) {
    if (tid == 0) {
        unsigned sp = 0;
        while (__hip_atomic_load((unsigned*)(ctl + CW_TKS), RLX_AGENT) < (unsigned)(TK_NSAMPLE_UNITS / NWAVES)) { __builtin_amdgcn_s_sleep(2); if (++sp > (1u << 22)) break; }
        __builtin_amdgcn_fence(__ATOMIC_ACQUIRE, "agent");
        asm volatile("s_waitcnt vmcnt(0)" ::: "memory");
    }
    __syncthreads();
}

constexpr int PEER_ITEM = 80, NITEM128 = NTOK / PEER_ITEM;
__device__ __forceinline__ bool peer_next_item(gu32* qbase, int xcc, int& qs, int& slice, int& item, LAS unsigned char* lds, int tid) {
    LAS int* box = (LAS int*)(lds + LDSCTL_OFF + 64);
    for (;;) {
        if (qs >= 8) return false;
        slice = (xcc + qs) & 7;
        if (tid == 0) box[0] = (int)__hip_atomic_fetch_add((unsigned*)(qbase + 64 * slice), 1u, RLX_AGENT);
        __syncthreads();
        item = box[0];
        __syncthreads();
        if (item < NITEM128) return true;
        ++qs;
    }
}

typedef long i64_t;
constexpr float PEER_SX = 1.0f;
constexpr int U_TILE0 = 8192, U_TILEB = 16384;
__device__ __forceinline__ i64_t mk64(unsigned lo, unsigned hi) { return (i64_t)(((unsigned long long)hi << 32) | (unsigned long long)lo); }
__device__ __forceinline__ void peer_u_phase(const Args& A, LAS unsigned char* lds, int tid, int lane, int wave, gu32* ctl, int qoff) {
    const unsigned char* Uq = A.ws + WS_UB; const bf16* XG = (const bf16*)(A.ws + WS_A1);
    const unsigned short* EIDX = (const unsigned short*)(A.ws + WS_EIDX); bf16* PART = (bf16*)(A.ws + WS_PART);
    const int xcc = (int)(xb_xcc_id() & 7u), rg = lane >> 3, c8 = lane & 7, m = lane & 15, kq = lane >> 4;
    LAS int* we = (LAS int*)(lds + wave * 1024);
    LAS unsigned char* tile = lds + U_TILE0 + wave * U_TILEB;
    const int ch_e = ((c8 - (rg >> 1)) & 7) * 16, ch_o = ((c8 - 4 - (rg >> 1)) & 7) * 16;
    const int fbase = m * 128 + (kq & 1) * 8, pos0 = (kq >> 1) + (m >> 1);
    int foff[4];
#pragma unroll
    for (int ks = 0; ks < 4; ++ks) foff[ks] = fbase + ((pos0 + 2 * ks) & 7) * 16;
    int qs = 0, slice, item; bool lists_ready = !peer_topk_split((int)gridDim.x);
    while (peer_next_item(ctl + CW_QU + qoff, xcc, qs, slice, item, lds, tid)) {
        if (!lists_ready && (item + 1) * PEER_ITEM > NPROMPT) { peer_topk_sample_wait(ctl, tid); lists_ready = true; }
        const unsigned char* us = Uq + (size_t)slice * 16384 * 128;
        size_t tok = (size_t)(item * PEER_ITEM + wave);
        unsigned pair = *(const unsigned*)(EIDX + tok * 128 + 2 * lane);
        v4u xr[4];
#pragma unroll
        for (int ks = 0; ks < 4; ++ks) xr[ks] = *(const v4u*)(XG + tok * DM + slice * 128 + ks * 32 + kq * 8);
        we[2 * lane] = (int)(pair & 0xffffu); we[2 * lane + 1] = (int)(pair >> 16);
        LDS_WAIT();
        v4u w[16];
#pragma unroll
        for (int it = 0; it < 16; ++it) w[it] = *(const v4u*)(us + (unsigned)(((unsigned)we[it * 8 + rg] << 7) + (unsigned)((it & 1) ? ch_o : ch_e)));
        for (int tt = 0; tt < PEER_ITEM / NWAVES; ++tt) {
            const size_t ctok = tok; const bool more = tt + 1 < PEER_ITEM / NWAVES;
            i64_t bx[4];
#pragma unroll
            for (int ks = 0; ks < 4; ++ks) { const v4u q = xr[ks]; typedef short s16x2 __attribute__((ext_vector_type(2)));
                s16x2 lo = (s16x2){0, 0}, hi = lo;
                unsigned q0 = q.x, q1 = q.y, q2 = q.z, q3 = q.w; asm volatile("" : "+v"(q0), "+v"(q1), "+v"(q2), "+v"(q3));
                lo = __builtin_amdgcn_cvt_scalef32_pk_fp8_bf16(lo, __builtin_bit_cast(bf16x2_t, q0), PEER_SX, false); lo = __builtin_amdgcn_cvt_scalef32_pk_fp8_bf16(lo, __builtin_bit_cast(bf16x2_t, q1), PEER_SX, true);
                hi = __builtin_amdgcn_cvt_scalef32_pk_fp8_bf16(hi, __builtin_bit_cast(bf16x2_t, q2), PEER_SX, false); hi = __builtin_amdgcn_cvt_scalef32_pk_fp8_bf16(hi, __builtin_bit_cast(bf16x2_t, q3), PEER_SX, true);
                bx[ks] = mk64(__builtin_bit_cast(unsigned, lo), __builtin_bit_cast(unsigned, hi)); }
            if (more) { tok += NWAVES; pair = *(const unsigned*)(EIDX + tok * 128 + 2 * lane);
#pragma unroll
                for (int ks = 0; ks < 4; ++ks) xr[ks] = *(const v4u*)(XG + tok * DM + slice * 128 + ks * 32 + kq * 8); }
#pragma unroll
            for (int it = 0; it < 16; ++it) *(LAS v4u*)(tile + it * 1024 + lane * 16) = w[it];
            if (more) {
                we[2 * lane] = (int)(pair & 0xffffu); we[2 * lane + 1] = (int)(pair >> 16);
                LDS_WAIT();
#pragma unroll
                for (int it = 0; it < 16; ++it) w[it] = *(const v4u*)(us + (unsigned)(((unsigned)we[it * 8 + rg] << 7) + (unsigned)((it & 1) ? ch_o : ch_e)));
            } else LDS_WAIT();
            bf16* pp = PART + (ctok * 8 + slice) * 128;
            f32x4 acc[8];
#pragma unroll
            for (int hf = 0; hf < 2; ++hf) {
                v2u a[4][4];
#pragma unroll
                for (int T4 = 0; T4 < 4; ++T4)
#pragma unroll
                    for (int ks = 0; ks < 4; ++ks) a[T4][ks] = *(const LAS v2u*)(tile + (hf * 4 + T4) * 2048 + foff[ks]);
#pragma unroll
                for (int T4 = 0; T4 < 4; ++T4) acc[hf * 4 + T4] = (f32x4){0.f, 0.f, 0.f, 0.f};
#pragma unroll
                for (int ks = 0; ks < 4; ++ks)
#pragma unroll
                    for (int T4 = 0; T4 < 4; ++T4) acc[hf * 4 + T4] = __builtin_amdgcn_mfma_f32_16x16x32_fp8_fp8(mk64(a[T4][ks].x, a[T4][ks].y), bx[ks], acc[hf * 4 + T4], 0, 0, 0);
            }
            f32x4 val = acc[0];
#pragma unroll
            for (int T = 1; T < 8; ++T) val = ((m & 7) == T) ? acc[T] : val;
            if (m < 8) { v2u pw; pw.x = cvt_pk_bf16(val[0] * (1.0f / PEER_SX), val[1] * (1.0f / PEER_SX)); pw.y = cvt_pk_bf16(val[2] * (1.0f / PEER_SX), val[3] * (1.0f / PEER_SX)); *(v2u*)(pp + m * 16 + 4 * kq) = pw; }
            LDS_WAIT();
        }
    }
}

constexpr float PEER_CS = 64.0f;
__device__ __forceinline__ void peer_coef_phase(const Args& A, int lane, int wave, int vcu, int G) {
    const bf16* PART = (const bf16*)(A.ws + WS_PART); const float* GATE = (const float*)(A.ws + WS_GATE); const float* RSTD = (const float*)(A.ws + WS_RSTD);
    unsigned char* C8 = A.ws + WS_COEF;
    for (int tok = vcu * NWAVES + wave; tok < NTOK; tok += G * NWAVES) {
        const bf16* pp = PART + (size_t)tok * 1024 + 2 * lane;
        unsigned pw[8];
#pragma unroll
        for (int j = 0; j < 8; ++j) pw[j] = *(const unsigned*)(pp + j * 128);
        f32x2 d = (f32x2){bf_lo(pw[0]), bf_hi(pw[0])};
#pragma unroll
        for (int j = 1; j < 8; ++j) d += (f32x2){bf_lo(pw[j]), bf_hi(pw[j])};
        const float sc = RSTD[tok] * (1.0f / PEER_SU); const f32x2 gt = *(const f32x2*)(GATE + (size_t)tok * 128 + 2 * lane);
        f32x2 cf; cf.x = gt.x * gelu_tanh(d.x * sc) * (PEER_CS / PEER_SV); cf.y = gt.y * gelu_tanh(d.y * sc) * (PEER_CS / PEER_SV);
        const unsigned hi = (unsigned)__builtin_amdgcn_cvt_pk_fp8_f32(cf.x, cf.y, 0, false) & 0xffffu;
        const f32x2 bk = __builtin_amdgcn_cvt_pk_f32_fp8(hi, false);
        const unsigned lo = (unsigned)__builtin_amdgcn_cvt_pk_fp8_f32((cf.x - bk.x) * 16.0f, (cf.y - bk.y) * 16.0f, 0, false) & 0xffffu;
        *(unsigned short*)(C8 + (size_t)tok * 256 + 2 * lane) = (unsigned short)hi; *(unsigned short*)(C8 + (size_t)tok * 256 + 128 + 2 * lane) = (unsigned short)lo;
    }
}

typedef int v2i_t __attribute__((ext_vector_type(2)));
__device__ __forceinline__ void peer_v_phase(const Args& A, LAS unsigned char* lds, int tid, int lane, int wave, gu32* ctl) {
    const unsigned char* Vq = A.ws + WS_VB;
    const unsigned short* EIDX = (const unsigned short*)(A.ws + WS_EIDX); const unsigned char* C8 = A.ws + WS_COEF;
    float* X1 = A.out + O_Y; float* SS2 = (float*)(A.ws + WS_SS2); const bf16* XGv = (const bf16*)(A.ws + WS_A1);
    const int xcc = (int)(xb_xcc_id() & 7u), rg = lane >> 3, c8 = lane & 7, m = lane & 15, kq = lane >> 4;
    LAS int* we = (LAS int*)(lds + wave * 1024);
    LAS unsigned char* tile = lds + U_TILE0 + wave * U_TILEB;
    const int ch_e = ((c8 - (rg >> 1)) & 7) * 16, ch_o = ((c8 - 4 - (rg >> 1)) & 7) * 16;
    const int tr_r = (lane & 15) >> 1, tr_p = lane & 1, tr_rot = 4 * (kq & 1) + (tr_r >> 1);
    const int tbase = (8 * kq + tr_r) * 128 + 8 * tr_p;
    int toff[8];
#pragma unroll
    for (int j = 0; j < 8; ++j) toff[j] = tbase + ((j + tr_rot) & 7) * 16;
    int qs = 0, slice, item;
    while (peer_next_item(ctl + CW_QV, xcc, qs, slice, item, lds, tid)) {
        const unsigned char* vs = Vq + (size_t)slice * 16384 * 128;
        size_t tok = (size_t)(item * PEER_ITEM + wave);
        unsigned pair = *(const unsigned*)(EIDX + tok * 128 + 2 * lane);
        v2u cfr[4];
#pragma unroll
        for (int ks = 0; ks < 4; ++ks) cfr[ks] = *(const v2u*)(C8 + tok * 256 + (m & 1) * 128 + ks * 32 + kq * 8);
        const float rga = 1.0f / A.in[I_N2G][slice * 128 + lane], rgb = 1.0f / A.in[I_N2G][slice * 128 + 64 + lane];
        unsigned short xoa = XGv[tok * DM + slice * 128 + lane], xob = XGv[tok * DM + slice * 128 + 64 + lane];
        we[2 * lane] = (int)(pair & 0xffffu); we[2 * lane + 1] = (int)(pair >> 16);
        LDS_WAIT();
        v4u w[16];
#pragma unroll
        for (int it = 0; it < 16; ++it) w[it] = *(const v4u*)(vs + (unsigned)(((unsigned)we[it * 8 + rg] << 7) + (unsigned)((it & 1) ? ch_o : ch_e)));
        for (int tt = 0; tt < PEER_ITEM / NWAVES; ++tt) {
            const size_t ctok = tok; const bool more = tt + 1 < PEER_ITEM / NWAVES;
            i64_t af[4];
#pragma unroll
            for (int ks = 0; ks < 4; ++ks) af[ks] = mk64(cfr[ks].x, cfr[ks].y);
            const float xa = __uint_as_float((unsigned)xoa << 16) * rga, xb = __uint_as_float((unsigned)xob << 16) * rgb;
            if (more) { tok += NWAVES; pair = *(const unsigned*)(EIDX + tok * 128 + 2 * lane);
#pragma unroll
                for (int ks = 0; ks < 4; ++ks) cfr[ks] = *(const v2u*)(C8 + tok * 256 + (m & 1) * 128 + ks * 32 + kq * 8);
                xoa = XGv[tok * DM + slice * 128 + lane]; xob = XGv[tok * DM + slice * 128 + 64 + lane]; }
#pragma unroll
            for (int it = 0; it < 16; ++it) *(LAS v4u*)(tile + it * 1024 + lane * 16) = w[it];
            if (more) {
                we[2 * lane] = (int)(pair & 0xffffu); we[2 * lane + 1] = (int)(pair >> 16);
                LDS_WAIT();
#pragma unroll
                for (int it = 0; it < 16; ++it) w[it] = *(const v4u*)(vs + (unsigned)(((unsigned)we[it * 8 + rg] << 7) + (unsigned)((it & 1) ? ch_o : ch_e)));
            } else LDS_WAIT();
            f32x4 acc[8];
#pragma unroll
            for (int hf = 0; hf < 2; ++hf) {
                v2i_t b[4][4];
#pragma unroll
                for (int j4 = 0; j4 < 4; ++j4)
#pragma unroll
                    for (int ks = 0; ks < 4; ++ks) b[j4][ks] = __builtin_amdgcn_ds_read_tr8_b64_v2i32((LAS v2i_t*)(tile + ks * 4096 + toff[hf * 4 + j4]));
#pragma unroll
                for (int j4 = 0; j4 < 4; ++j4) acc[hf * 4 + j4] = (f32x4){0.f, 0.f, 0.f, 0.f};
#pragma unroll
                for (int ks = 0; ks < 4; ++ks)
#pragma unroll
                    for (int j4 = 0; j4 < 4; ++j4) acc[hf * 4 + j4] = __builtin_amdgcn_mfma_f32_16x16x32_fp8_fp8(af[ks], mk64((unsigned)b[j4][ks].x, (unsigned)b[j4][ks].y), acc[hf * 4 + j4], 0, 0, 0);
            }
            float h0 = acc[0][0], l0 = acc[0][1], h1 = acc[4][0], l1 = acc[4][1];
#pragma unroll
            for (int j = 1; j < 4; ++j) { const bool s = kq == j; h0 = s ? acc[j][0] : h0; l0 = s ? acc[j][1] : l0; h1 = s ? acc[4 + j][0] : h1; l1 = s ? acc[4 + j][1] : l1; }
            const float x2a = xa + (h0 + l0 * (1.0f / 16.0f)) * (1.0f / PEER_CS), x2b = xb + (h1 + l1 * (1.0f / 16.0f)) * (1.0f / PEER_CS);
            { bf16* xr_ = (bf16*)X1 + ctok * (2 * DM) + slice * 128 + lane;
              xr_[0] = (bf16)(cvt_pk_bf16(x2a, x2a) & 0xffffu); xr_[64] = (bf16)(cvt_pk_bf16(x2b, x2b) & 0xffffu); }
            float ss = sum16(x2a * x2a + x2b * x2b); ss += __shfl_xor(ss, 16); ss += __shfl_xor(ss, 32);
            if (lane == 0) SS2[ctok * 8 + slice] = ss;
            LDS_WAIT();
        }
    }
}

__device__ __forceinline__ void peer_final_phase(const Args& A, int lane, int wave, int vcu, int G) {
    float* X1 = A.out + O_Y; const float* SS2 = (const float*)(A.ws + WS_SS2); const float* gf = A.in[I_NFG] + lane * 16;
    const f32x4 g0 = *(const f32x4*)gf, g1 = *(const f32x4*)(gf + 4), g2 = *(const f32x4*)(gf + 8), g3 = *(const f32x4*)(gf + 12);
    const int NW = G * NWAVES;
    for (int tok0 = vcu * NWAVES + wave; tok0 < NTOK; tok0 += 4 * NW) {
        f32x4 sa[4], sb[4]; v4u s0[4], s1[4];
#pragma unroll
        for (int j = 0; j < 4; ++j) { const int tok = tok0 + j * NW < NTOK ? tok0 + j * NW : tok0;
            sa[j] = *(const f32x4*)(SS2 + (size_t)tok * 8); sb[j] = *(const f32x4*)(SS2 + (size_t)tok * 8 + 4);
            s0[j] = *(const v4u*)((const bf16*)(X1 + (size_t)tok * DM) + lane * 16); s1[j] = *(const v4u*)((const bf16*)(X1 + (size_t)tok * DM) + lane * 16 + 8); }
#pragma unroll
        for (int j = 0; j < 4; ++j) { const int tok = tok0 + j * NW;
            if (tok < NTOK) {
                const float ss = ((sa[j][0] + sa[j][1]) + (sa[j][2] + sa[j][3])) + ((sb[j][0] + sb[j][1]) + (sb[j][2] + sb[j][3]));
                const float rf = __builtin_amdgcn_rsqf(ss * (1.f / DM) + 1e-6f);
                float* yr = X1 + (size_t)tok * DM + lane * 16; const v4u q0 = s0[j], q1 = s1[j];
                const f32x4 y0 = (f32x4){bf_lo(q0.x), bf_hi(q0.x), bf_lo(q0.y), bf_hi(q0.y)}, y1 = (f32x4){bf_lo(q0.z), bf_hi(q0.z), bf_lo(q0.w), bf_hi(q0.w)},
                            y2 = (f32x4){bf_lo(q1.x), bf_hi(q1.x), bf_lo(q1.y), bf_hi(q1.y)}, y3 = (f32x4){bf_lo(q1.z), bf_hi(q1.z), bf_lo(q1.w), bf_hi(q1.w)};
                *(f32x4*)yr = y0 * rf * g0; *(f32x4*)(yr + 4) = y1 * rf * g1; *(f32x4*)(yr + 8) = y2 * rf * g2; *(f32x4*)(yr + 12) = y3 * rf * g3;
            } }
    }
}

__device__ __forceinline__ void sg_partial(const bf16* Ap, int lda, const bf16* Bp, int ldb, LAS f32x4* red, int lane, int wave) {
    const int fr = lane & 15, fq = lane >> 4;
    bf16x8 a[2][4], b[4][4];
#pragma unroll
    for (int mi = 0; mi < 2; ++mi)
#pragma unroll
        for (int ks = 0; ks < 4; ++ks) a[mi][ks] = *(const bf16x8*)(Ap + (size_t)(16 * mi + fr) * lda + 32 * ks + 8 * fq);
#pragma unroll
    for (int nj = 0; nj < 4; ++nj)
#pragma unroll
        for (int ks = 0; ks < 4; ++ks) b[nj][ks] = *(const bf16x8*)(Bp + (size_t)(16 * nj + fr) * ldb + 32 * ks + 8 * fq);
    f32x4 acc[2][4];
#pragma unroll
    for (int mi = 0; mi < 2; ++mi)
#pragma unroll
        for (int nj = 0; nj < 4; ++nj) acc[mi][nj] = (f32x4){0.f, 0.f, 0.f, 0.f};
#pragma unroll
    for (int ks = 0; ks < 4; ++ks)
#pragma unroll
        for (int mi = 0; mi < 2; ++mi)
#pragma unroll
            for (int nj = 0; nj < 4; ++nj) acc[mi][nj] = __builtin_amdgcn_mfma_f32_16x16x32_bf16(b[nj][ks], a[mi][ks], acc[mi][nj], 0, 0, 0);
#pragma unroll
    for (int mi = 0; mi < 2; ++mi)
#pragma unroll
        for (int nj = 0; nj < 4; ++nj) red[(wave * 8 + mi * 4 + nj) * 64 + lane] = acc[mi][nj];
}
__device__ __forceinline__ f32x4 sg_sum(const LAS f32x4* red, int w0, int nw, int wave, int lane) {
    f32x4 s = red[(w0 * 8 + wave) * 64 + lane];
    for (int w = 1; w < nw; ++w) s += red[((w0 + w) * 8 + wave) * 64 + lane];
    return s;
}
__device__ __forceinline__ void sample_gemm2(const Args& A, LAS unsigned char* lds, int t, int lane, int wave) {
    unsigned char* ws = A.ws; const int fr = lane & 15, fq = lane >> 4;
    const int row0 = NPROMPT + (t >> 4) * 32, col0 = (t & 15) * 64;
    LAS f32x4* red = (LAS f32x4*)lds;
    const bf16* Ab = (const bf16*)(ws + WS_A1) + (wave >= 4 ? (size_t)MPAD * 512 : 0); const bf16* Bb = (const bf16*)(ws + (wave >= 4 ? WS_WPB : WS_WPA));
    sg_partial(Ab + (size_t)row0 * 512 + (wave & 3) * 128, 512, Bb + (size_t)col0 * 512 + (wave & 3) * 128, 512, red, lane, wave);
    const int row = row0 + 16 * (wave >> 2) + fr, c = col0 + 16 * (wave & 3) + 4 * fq;
    const bf16* Zg = (const bf16*)(ws + WS_ZG) + (size_t)row * 2048;
    const v2u ga = *(const v2u*)(Zg + c), gb = *(const v2u*)(Zg + 1024 + c);
    __syncthreads();
    const f32x4 pa = sg_sum(red, 0, 4, wave, lane), pb = sg_sum(red, 4, 4, wave, lane);
    const float o0 = sigm(bf_lo(ga.x)) * pa[0] + sigm(bf_lo(gb.x)) * pb[0], o1 = sigm(bf_hi(ga.x)) * pa[1] + sigm(bf_hi(gb.x)) * pb[1],
                o2 = sigm(bf_lo(ga.y)) * pa[2] + sigm(bf_lo(gb.y)) * pb[2], o3 = sigm(bf_hi(ga.y)) * pa[3] + sigm(bf_hi(gb.y)) * pb[3];
    v2u w; w.x = cvt_pk_bf16(o0, o1); w.y = cvt_pk_bf16(o2, o3); *(v2u*)((bf16*)(ws + WS_ZR) + (size_t)row * 1024 + c) = w;
    __syncthreads();
}
__device__ __forceinline__ void sample_gemm3(const Args& A, LAS unsigned char* lds, int t, int tid, int lane, int wave) {
    unsigned char* ws = A.ws; const int fr = lane & 15, fq = lane >> 4;
    const int row0 = NPROMPT + (t >> 4) * 32, col0 = (t & 15) * 64;
    LAS f32x4* red = (LAS f32x4*)lds; LAS float* ssl = (LAS float*)(lds + 65536);
    sg_partial((const bf16*)(ws + WS_ZR) + (size_t)row0 * 1024 + wave * 128, 1024, (const bf16*)(ws + WS_WO) + (size_t)col0 * 1024 + wave * 128, 1024, red, lane, wave);
    const int row = row0 + 16 * (wave >> 2) + fr, c = col0 + 16 * (wave & 3) + 4 * fq;
    const f32x4 xv = *(const f32x4*)(A.in[I_XS] + (size_t)(row - NPROMPT) * 1024 + c), q = *(const f32x4*)(A.in[I_N2G] + c);
    __syncthreads();
    const f32x4 o = xv + sg_sum(red, 0, 8, wave, lane);
    float ss = (o[0] * o[0] + o[1] * o[1]) + (o[2] * o[2] + o[3] * o[3]);
    v2u w; w.x = cvt_pk_bf16(o[0] * q[0], o[1] * q[1]); w.y = cvt_pk_bf16(o[2] * q[2], o[3] * q[3]); *(v2u*)((bf16*)(ws + WS_A1) + (size_t)row * 1024 + c) = w;
    ss += __shfl_xor(ss, 16); ss += __shfl_xor(ss, 32);
    if (fq == 0) ssl[wave * 16 + fr] = ss;
    __syncthreads();
    if (tid < 32) { const int mi = tid >> 4, r = tid & 15;
        ((float*)(ws + WS_SSP))[(size_t)(row0 + tid) * 16 + (t & 15)] = (ssl[(mi * 4 + 0) * 16 + r] + ssl[(mi * 4 + 1) * 16 + r]) + (ssl[(mi * 4 + 2) * 16 + r] + ssl[(mi * 4 + 3) * 16 + r]); }
}
__device__ __forceinline__ void sample_gemm4(const Args& A, LAS unsigned char* lds, int t, int lane, int wave) {
    unsigned char* ws = A.ws; const int fr = lane & 15, fq = lane >> 4;
    const int row0 = NPROMPT + (t >> 5) * 32, col0 = (t & 31) * 64;
    LAS f32x4* red = (LAS f32x4*)lds;
    sg_partial((const bf16*)(ws + WS_A1) + (size_t)row0 * 1024 + wave * 128, 1024, (const bf16*)(ws + WS_WQ) + (size_t)col0 * 1024 + wave * 128, 1024, red, lane, wave);
    const int row = row0 + 16 * (wave >> 2) + fr, c = col0 + 16 * (wave & 3) + 4 * fq;
    __syncthreads();
    const f32x4 o = sg_sum(red, 0, 8, wave, lane);
    v2u w; w.x = cvt_pk_bf16(o[0], o[1]); w.y = cvt_pk_bf16(o[2], o[3]); *(v2u*)((bf16*)(ws + WS_ZG) + (size_t)row * 2048 + c) = w;
    __syncthreads();
}

__global__ void __launch_bounds__(NTHR, 2) mk_fwd(Args args) {
    extern __shared__ __attribute__((aligned(16))) unsigned char lds_raw[];
    LAS unsigned char* lds = (LAS unsigned char*)lds_raw;
    const int tid = threadIdx.x, lane = tid & 63, wave = __builtin_amdgcn_readfirstlane(tid >> 6);
    const int G = gridDim.x; const int bx = blockIdx.x; const int vcu = (G % 8 == 0) ? (bx % 8) * (G / 8) + bx / 8 : bx;
    gu32* ctl = (gu32*)(args.ws + WS_CTL);
    volatile LAS unsigned* MISC = (volatile LAS unsigned*)(lds + MISC_OFF);
    for (int u = tid; u < (LDS_BYTES - LDSCTL_OFF) / 4; u += NTHR) ((LAS unsigned*)(lds + LDSCTL_OFF))[u] = 0u;
    __syncthreads();
    XcdBarrier bar; bar.bar = (unsigned*)(ctl + CW_BAR) + args.li * XCD_BAR_WORDS; bar.x = 0; bar.st = nullptr;
    if (N_LAUNCHES != PER_PHASE) bar = xcd_barrier_post((unsigned*)(ctl + CW_BAR) + args.li * XCD_BAR_WORDS, MISC + 8);
    const int lo = args.ph_lo, hi = args.ph_hi;
#define IN(k) (lo <= (k) && (k) < hi)
#define BOTH(k) (IN(k) && IN((k) + 1))
#define GRID_BAR() do { if (N_LAUNCHES != PER_PHASE) xcd_barrier(bar); } while (0)
    unsigned char* ws = args.ws;
    bf16* A1 = (bf16*)(ws + WS_A1);

    if (IN(0)) for (int rep_ = 0; rep_ < ((MK_REPEAT == 0) ? 2 : 1); ++rep_) { p0_prologue(args, lds, tid, lane, wave, vcu, G); if (BOTH(0)) GRID_BAR(); }

    if (IN(1)) for (int rep_ = 0; rep_ < ((MK_REPEAT == 1) ? 2 : 1); ++rep_) {
        pg8::Gemm g{A1, (const bf16*)(ws + WS_W1T), MPAD, N1, DM}; pg8::StaticOrder S; S.init(MPAD, N1, G, bx);
        pg8::EpiZ E{(bf16*)(ws + WS_ZC), (bf16*)(ws + WS_ZR), (bf16*)(ws + WS_ZG)};
        pg8::gemm_phase<pg8::EpiZ, pg8::StaticOrder, true, true>(lds, g, S, E);
        if (BOTH(1)) GRID_BAR();
    }

    if (IN(2)) for (int rep_ = 0; rep_ < ((MK_REPEAT == 2) ? 2 : 1); ++rep_) { conv_phase(args, vcu * NTHR + tid, G * NTHR); if (BOTH(2)) GRID_BAR(); }

    if (IN(3)) for (int rep_ = 0; rep_ < ((MK_REPEAT == 3) ? 2 : 1); ++rep_) {
        scan_pass1(args, lds, tid, lane, wave, vcu, G, (MK_REPEAT == 3 && rep_ == 0) ? 1 : 0);
        if (BOTH(3)) GRID_BAR();
    }

    if (IN(4)) {
        for (int u = vcu; u < 512; u += G) {
            if (u < 256) { const int bh = u >> 2, vq = u & 3; scan_pass2_rows(nullptr, bh * 64, 64, vq * 16, args.out + O_WKV_P + (size_t)bh * 4096, true, args, lds, tid, lane, wave); }
            else { const int bh = u - 256; scan_pass2_sample(args.in[I_SWKV] + (size_t)bh * 4096, NUNITS_P + bh, args.out + O_WKV_S + (size_t)bh * 4096, args, lane, wave); }
        }
        if (BOTH(4)) GRID_BAR();
    }

    if (IN(5)) for (int rep_ = 0; rep_ < ((MK_REPEAT == 5) ? 2 : 1); ++rep_) {
        for (int u2 = vcu; u2 < NUNITS / 2; u2 += G) scan_pass3_wave(args, u2 * 2 + (wave >> 2), wave & 3, lane);
        if (BOTH(5)) GRID_BAR();
    }

    if (IN(6)) {
        { pg8::Gemm g{A1, (const bf16*)(ws + WS_WPA), NPROMPT, DM, 512}; pg8::StaticOrder S; S.init(NPROMPT, DM, G, bx);
          pg8::EpiGate<0> E{(const bf16*)(ws + WS_ZG), (bf16*)(ws + WS_ZR)};
          pg8::gemm_phase<pg8::EpiGate<0>, pg8::StaticOrder, true, true>(lds, g, S, E); }
        { pg8::Gemm g{A1 + (size_t)MPAD * 512, (const bf16*)(ws + WS_WPB), NPROMPT, DM, 512}; pg8::StaticOrder S; S.init(NPROMPT, DM, G, bx);
          pg8::EpiGate<1> E{(const bf16*)(ws + WS_ZG), (bf16*)(ws + WS_ZR)};
          pg8::gemm_phase<pg8::EpiGate<1>, pg8::StaticOrder, true, true>(lds, g, S, E); }
        for (int t = vcu; t < 256; t += G) sample_gemm2(args, lds, t, lane, wave);
        if (BOTH(6)) GRID_BAR();
    }

    if (IN(7)) for (int rep_ = 0; rep_ < ((MK_REPEAT == 7) ? 2 : 1); ++rep_) {
        pg8::Gemm g{(const bf16*)(ws + WS_ZR), (const bf16*)(ws + WS_WO), NPROMPT, DM, DM}; pg8::StaticOrder S; S.init(NPROMPT, DM, G, bx);
        pg8::EpiX1 E{args.in[I_XP], args.in[I_XS], args.out + O_Y, A1, (float*)(ws + WS_SSP), args.in[I_N2G], NPROMPT, NTOK};
        pg8::gemm_phase<pg8::EpiX1, pg8::StaticOrder, true, true>(lds, g, S, E);
        for (int t = vcu; t < 256; t += G) sample_gemm3(args, lds, t, tid, lane, wave);
        if (BOTH(7)) GRID_BAR();
    }

    if (IN(8)) for (int rep_ = 0; rep_ < ((MK_REPEAT == 8) ? 2 : 1); ++rep_) {
        pg8::Gemm g{A1, (const bf16*)(ws + WS_WQ), NPROMPT, 2048, DM}; pg8::StaticOrder S; S.init(NPROMPT, 2048, G, bx);
        pg8::EpiPlain E{(bf16*)(ws + WS_ZG), 2048};
        pg8::gemm_phase<pg8::EpiPlain, pg8::StaticOrder, true, true>(lds, g, S, E);
        for (int t = vcu; t < 512; t += G) sample_gemm4(args, lds, t, lane, wave);
        if (BOTH(8)) GRID_BAR();
    }

    if (IN(9)) for (int rep_ = 0; rep_ < ((MK_REPEAT == 9) ? 2 : 1); ++rep_) { peer_topk_phase(args, lds, tid, lane, wave, vcu, G); if (BOTH(9)) GRID_BAR(); }
    if (IN(10)) for (int rep_ = 0; rep_ < ((MK_REPEAT == 10) ? 2 : 1); ++rep_) { if (rep_ == 0) peer_topk_sample_prelude(args, lds, tid, lane, wave, vcu, G, ctl); peer_u_phase(args, lds, tid, lane, wave, ctl, rep_ * 1024); if (BOTH(10)) GRID_BAR(); }
    if (IN(11)) { peer_coef_phase(args, lane, wave, vcu, G); if (BOTH(11)) GRID_BAR(); }
    if (IN(12)) { peer_v_phase(args, lds, tid, lane, wave, ctl); if (BOTH(12)) GRID_BAR(); }
    if (IN(13)) peer_final_phase(args, lane, wave, vcu, G);
#undef IN
#undef BOTH
#undef GRID_BAR
}

extern "C" void kernel_launch(void* const* d_in, const int* in_sizes, int n_in, void* d_out, int out_size, void* d_ws, size_t ws_size, hipStream_t stream) {
    static int grid = 0;
    if (grid == 0) {
        if (n_in != 32 || ws_size < WS_END) { fprintf(stderr, "kernel_launch: built for 32 inputs and >= %zu bytes of workspace; got n_in %d ws %zu; nothing launched\n", (size_t)WS_END, n_in, ws_size); grid = -1; return; }
        int dev = 0, cus = 0, per_cu = 0;
        if (hipGetDevice(&dev) != hipSuccess || hipDeviceGetAttribute(&cus, hipDeviceAttributeMultiprocessorCount, dev) != hipSuccess) { fprintf(stderr, "kernel_launch: device query failed\n"); grid = -1; return; }
        if (hipFuncSetAttribute((const void*)mk_fwd, hipFuncAttributeMaxDynamicSharedMemorySize, LDS_BYTES) != hipSuccess) { fprintf(stderr, "kernel_launch: hipFuncSetAttribute failed\n"); grid = -1; return; }
        if (hipOccupancyMaxActiveBlocksPerMultiprocessor(&per_cu, (const void*)mk_fwd, NTHR, LDS_BYTES) != hipSuccess || per_cu < 1)
            fprintf(stderr, "kernel_launch: note: occupancy query reports %d workgroups per CU\n", per_cu);
        (void)hipGetLastError();
        grid = cus;
    }
    if (grid < 0) return;
    if (hipMemsetAsync((char*)d_ws + WS_CTL, 0, CTL_ZERO_BYTES, stream) != hipSuccess) { fprintf(stderr, "kernel_launch: hipMemsetAsync failed\n"); return; }
    Args a{};
    for (int i = 0; i < 32; ++i) a.in[i] = (const float*)d_in[i];
    a.out = (float*)d_out; a.ws = (unsigned char*)d_ws;
    constexpr int NL = (N_LAUNCHES == PER_PHASE ? PER_PHASE : 1) + ((MK_EXTRA_LO >= 0) ? 1 : 0);
    for (int li = 0; li < NL; ++li) {
        if (N_LAUNCHES == PER_PHASE) { a.ph_lo = li; a.ph_hi = li + 1; } else { a.ph_lo = 0; a.ph_hi = PER_PHASE; }
        if (MK_EXTRA_LO >= 0 && li == NL - 1) { a.ph_lo = MK_EXTRA_LO; a.ph_hi = MK_EXTRA_HI; }
        a.li = li;
        hipLaunchKernelGGL(mk_fwd, dim3(grid), dim3(NTHR), LDS_BYTES, stream, a);
        const hipError_t le = hipPeekAtLastError();
        if (le != hipSuccess) { fprintf(stderr, "kernel_launch: launch %d failed: %s\n", li, hipGetErrorName(le)); break; }
    }
}
```
